# Optimizing an MI355X kernel written in HIP

```python
import math
import functools
import jax
import jax.numpy as jnp
from jax import lax
import numpy as np

D_MODEL = 1024
BATCH = 16
SEQ = 2048
DEPTH = 2

GRID_W = 64
CTX_LEN = 256
F32 = jnp.float32

HY_W = 384
HY_ORDER = 2
HY_SHORT = 3
HY_EMB = 33
HY_HID = 64
RET_HEADS = 6
RET_DH = 64
RET_W = RET_HEADS * RET_DH
RET_CHUNK = 64
ROPE_BASE = 10000.0
ML_HEADS = 4
ML_DH = 64
ML_W = ML_HEADS * ML_DH
ML_SHORT = 3
ML_CHUNK = 64

MIX_W = HY_W + RET_W + ML_W
N_BRANCH = 3
HY_OFF = 0
RET_OFF = HY_OFF + 3 * HY_W
ML_OFF = RET_OFF + 4 * RET_W
MLG_OFF = ML_OFF + 4 * ML_W
GATE_OFF = MLG_OFF + 4 * ML_HEADS
N_IN = GATE_OFF + N_BRANCH * D_MODEL

D_FF = ((8 * D_MODEL // 3 + 127) // 128) * 128
N_EXPERTS = 8
TOP_K = 2
N_DENSE = (DEPTH + 1) // 2
N_MOE = DEPTH // 2
EPS = 1e-6

kernel_name = 'hybrid_hyena_retnet_mlstm_moe_dit'


def rmsnorm(x, g):
    xf = x.astype(F32)
    y = xf * lax.rsqrt(jnp.mean(xf * xf, axis=-1, keepdims=True) + EPS)
    return (y * g.astype(F32)).astype(x.dtype)


def modulate(h, shift, scale):
    return h * (1 + scale) + shift


def head_norm(x):
    mu = jnp.mean(x, axis=-1, keepdims=True)
    xc = x - mu
    return xc * lax.rsqrt(jnp.mean(xc * xc, axis=-1, keepdims=True) + EPS)


def split_heads(x, n_heads):
    b, l, w = x.shape
    return x.reshape(b, l, n_heads, w // n_heads).transpose(0, 2, 1, 3)


def merge_heads(x):
    b, h, l, d = x.shape
    return x.transpose(0, 2, 1, 3).reshape(b, l, h * d)


def short_conv(u, w):
    k_w = w.shape[0]
    l = u.shape[1]
    pad = k_w // 2
    up = jnp.pad(u, ((0, 0), (pad, k_w - 1 - pad), (0, 0)))
    return sum(up[:, j:j + l] * w[j] for j in range(k_w))


def to_chunks(x, ch):
    b, h, l = x.shape[:3]
    x = x.reshape(b, h, l // ch, ch, *x.shape[3:])
    return jnp.moveaxis(x, 2, 0)


def from_chunks(y):
    n, b, h, ch = y.shape[:4]
    return jnp.moveaxis(y, 0, 2).reshape(b, h, n * ch, *y.shape[4:])


def flip_seq(a):
    return jnp.flip(a, axis=2)


def hyena_filters(length, p):
    pos = jnp.arange(length, dtype=F32)
    t = pos / max(length - 1, 1)
    n_bands = (HY_EMB - 1) // 2
    bands = jnp.linspace(1e-4, n_bands - 1, n_bands, dtype=F32)
    z = (2.0 * math.pi * pos / length)[:, None] * bands[None, :]
    feats = jnp.concatenate([t[:, None], jnp.cos(z), -jnp.sin(z)], axis=-1)
    hid = jnp.sin(feats @ p['hy_f1'].astype(F32) + p['hy_fb1'].astype(F32))
    hid = jnp.sin(hid @ p['hy_f2'].astype(F32) + p['hy_fb2'].astype(F32))
    h = hid @ p['hy_f3'].astype(F32)
    window = jnp.exp(-t[:, None] * jnp.abs(p['hy_decay'].astype(F32))[None, :])
    return (h * window).reshape(length, HY_ORDER, 2, HY_W)


def long_conv(u, h_fwd, h_bwd, skip):
    b, l, ch = u.shape
    filt = jnp.concatenate([h_fwd, jnp.zeros((1, ch), F32), h_bwd[1:][::-1]], axis=0)
    u_f = jnp.fft.rfft(u.astype(F32), n=2 * l, axis=1)
    k_f = jnp.fft.rfft(filt, axis=0)
    y = jnp.fft.irfft(u_f * k_f[None], n=2 * l, axis=1)[:, :l]
    return y + u.astype(F32) * skip.astype(F32)


def hyena_branch(u, p):
    length = u.shape[1]
    u = short_conv(u, p['hy_conv'])
    v, x1, x2 = jnp.split(u, 3, axis=-1)
    filt = hyena_filters(length, p)
    z = v.astype(F32)
    for o, gate in enumerate((x1, x2)):
        z = gate.astype(F32) * long_conv(z, filt[:, o, 0], filt[:, o, 1], p['hy_skip'][o])
    return z


def rotary_tables(row_id, col_id):
    q4 = RET_DH // 4
    inv = 1.0 / (ROPE_BASE ** (jnp.arange(q4, dtype=F32) / q4))
    ang_r = row_id.astype(F32)[:, None] * inv[None, :]
    ang_c = col_id.astype(F32)[:, None] * inv[None, :]
    return (jnp.cos(ang_r), jnp.sin(ang_r), jnp.cos(ang_c), jnp.sin(ang_c))


def apply_axial_rotary(x, rope):
    cos_r, sin_r, cos_c, sin_c = rope
    half = RET_DH // 2
    q4 = half // 2

    def rot(y, cs, sn):
        y1, y2 = y[..., :q4], y[..., q4:]
        return jnp.concatenate([y1 * cs - y2 * sn, y1 * sn + y2 * cs], axis=-1)

    return jnp.concatenate([rot(x[..., :half], cos_r, sin_r), rot(x[..., half:], cos_c, sin_c)], axis=-1)


def retention_inputs(u, rope):
    seg = u[..., RET_OFF:ML_OFF].astype(F32)
    q, k, v, g = jnp.split(seg, 4, axis=-1)
    q = split_heads(q, RET_HEADS) * RET_DH ** -0.5
    k = split_heads(k, RET_HEADS)
    v = split_heads(v, RET_HEADS)
    if rope is not None:
        q = apply_axial_rotary(q, rope)
        k = apply_axial_rotary(k, rope)
    return q, k, v, g


def retention_scan(q, k, v, log_g, s0):
    idx = jnp.arange(RET_CHUNK, dtype=F32)
    rel = idx[:, None] - idx[None, :]
    causal = rel >= 0
    intra_decay = jnp.where(causal, jnp.exp(jnp.where(causal, rel, 0.0) * log_g[:, None, None]), 0.0)
    q_decay = jnp.exp((idx + 1.0) * log_g[:, None])
    k_decay = jnp.exp((RET_CHUNK - 1.0 - idx) * log_g[:, None])
    chunk_decay = jnp.exp(RET_CHUNK * log_g)[:, None, None]

    def step(s, qkv):
        qc, kc, vc = qkv
        scores = jnp.einsum('bhtd,bhsd->bhts', qc, kc) * intra_decay
        o = jnp.einsum('bhts,bhse->bhte', scores, vc) + jnp.einsum('bhtd,bhde->bhte', qc, s) * q_decay[..., None]
        s = s * chunk_decay + jnp.einsum('bhsd,bhse->bhde', kc * k_decay[..., None], vc)
        return s, o

    s_fin, o = lax.scan(step, s0, (to_chunks(q, RET_CHUNK), to_chunks(k, RET_CHUNK), to_chunks(v, RET_CHUNK)))
    return from_chunks(o), s_fin


def retention_bidir(q, k, v, log_gamma, s_fwd0, s_bwd0):
    o_f, s_f = retention_scan(q, k, v, log_gamma[0], s_fwd0)
    o_b, s_b = retention_scan(flip_seq(q), flip_seq(k), flip_seq(v), log_gamma[1], s_bwd0)
    return o_f + flip_seq(o_b), s_f, s_b


def retention_out(o, g):
    return merge_heads(head_norm(o)) * jax.nn.silu(g)


def mlstm_inputs(u, p):
    b, l = u.shape[:2]
    qk = jax.nn.silu(short_conv(u[..., ML_OFF:ML_OFF + 2 * ML_W], p['ml_conv'])).astype(F32)
    q = split_heads(qk[..., :ML_W], ML_HEADS)
    k = split_heads(qk[..., ML_W:], ML_HEADS) * ML_DH ** -0.5
    v = split_heads(u[..., ML_OFF + 2 * ML_W:ML_OFF + 3 * ML_W].astype(F32), ML_HEADS)
    o = u[..., ML_OFF + 3 * ML_W:MLG_OFF].astype(F32)
    gates = u[..., MLG_OFF:GATE_OFF].astype(F32).reshape(b, l, 2, 2, ML_HEADS) + p['ml_gate_bias'].astype(F32)
    gates = jnp.moveaxis(gates, 1, -1)
    return q, k, v, o, gates[:, :, 0], jax.nn.log_sigmoid(gates[:, :, 1])


def mlstm_scan(q, k, v, ig, lf, state):
    idx = jnp.arange(ML_CHUNK)
    causal = idx[:, None] >= idx[None, :]

    def step(carry, inp):
        c_mat, n_vec, m = carry
        qc, kc, vc, ic, fc = inp
        b = jnp.cumsum(fc, axis=-1)
        dlog = jnp.where(causal, b[..., :, None] - b[..., None, :] + ic[..., None, :], -jnp.inf)
        inter = b + m[..., None]
        m_t = jnp.maximum(inter, jnp.max(dlog, axis=-1))
        w = jnp.exp(dlog - m_t[..., None])
        a = jnp.exp(inter - m_t)
        s = jnp.einsum('bhtd,bhsd->bhts', qc, kc) * w
        num = jnp.einsum('bhts,bhse->bhte', s, vc) + a[..., None] * jnp.einsum('bhtd,bhde->bhte', qc, c_mat)
        den = jnp.sum(s, axis=-1) + a * jnp.einsum('bhtd,bhd->bht', qc, n_vec)
        h = num / jnp.maximum(jnp.abs(den), jnp.exp(-m_t))[..., None]
        b_last = b[..., -1]
        wlog = b_last[..., None] - b + ic
        m_new = jnp.maximum(b_last + m, jnp.max(wlog, axis=-1))
        wk = jnp.exp(wlog - m_new[..., None])
        a_s = jnp.exp(b_last + m - m_new)
        c_mat = a_s[..., None, None] * c_mat + jnp.einsum('bhs,bhsd,bhse->bhde', wk, kc, vc)
        n_vec = a_s[..., None] * n_vec + jnp.einsum('bhs,bhsd->bhd', wk, kc)
        return (c_mat, n_vec, m_new), h

    xs = (to_chunks(q, ML_CHUNK), to_chunks(k, ML_CHUNK), to_chunks(v, ML_CHUNK),
          to_chunks(ig, ML_CHUNK), to_chunks(lf, ML_CHUNK))
    state, h = lax.scan(step, state, xs)
    return from_chunks(h), state


def mlstm_bidir(q, k, v, ig, lf, st_fwd0, st_bwd0):
    h_f, st_f = mlstm_scan(q, k, v, ig[:, 0], lf[:, 0], st_fwd0)
    h_b, st_b = mlstm_scan(flip_seq(q), flip_seq(k), flip_seq(v), flip_seq(ig[:, 1]), flip_seq(lf[:, 1]), st_bwd0)
    return h_f + flip_seq(h_b), st_f, st_b


def mlstm_out(h, o):
    return jax.nn.sigmoid(o) * merge_heads(head_norm(h))


def merge_branches(u, ys, p):
    b, l = u.shape[:2]
    gates = jax.nn.sigmoid(u[..., GATE_OFF:].reshape(b, l, N_BRANCH, D_MODEL))
    bounds = (0, HY_W, HY_W + RET_W, MIX_W)
    acc = 0
    for i, y in enumerate(ys):
        acc = acc + gates[:, :, i] * (y.astype(u.dtype) @ p['w_up'][bounds[i]:bounds[i + 1]])
    return acc @ p['w_out']


def mixer(h_lat, h_ctx, rope, p, need_ctx):
    batch = h_lat.shape[0]
    u_lat = h_lat @ p['w_in'] + p['b_in']
    u_ctx = h_ctx @ p['w_in'] + p['b_in']
    log_gamma = jax.nn.log_sigmoid(p['ret_decay'].astype(F32))
    s0 = jnp.zeros((batch, RET_HEADS, RET_DH, RET_DH), F32)
    q_c, k_c, v_c, g_c = retention_inputs(u_ctx, None)
    r_ctx, s_fwd, s_bwd = retention_bidir(q_c, k_c, v_c, log_gamma, s0, s0)
    q_l, k_l, v_l, g_l = retention_inputs(u_lat, rope)
    r_lat, _, _ = retention_bidir(q_l, k_l, v_l, log_gamma, s_fwd, s_bwd)
    st0 = (jnp.zeros((batch, ML_HEADS, ML_DH, ML_DH), F32),
           jnp.zeros((batch, ML_HEADS, ML_DH), F32),
           jnp.zeros((batch, ML_HEADS), F32))
    mq_c, mk_c, mv_c, mo_c, ig_c, lf_c = mlstm_inputs(u_ctx, p)
    m_ctx, st_fwd, st_bwd = mlstm_bidir(mq_c, mk_c, mv_c, ig_c, lf_c, st0, st0)
    mq_l, mk_l, mv_l, mo_l, ig_l, lf_l = mlstm_inputs(u_lat, p)
    m_lat, _, _ = mlstm_bidir(mq_l, mk_l, mv_l, ig_l, lf_l, st_fwd, st_bwd)
    y_lat = merge_branches(u_lat, (hyena_branch(u_lat[..., HY_OFF:RET_OFF], p),
                                   retention_out(r_lat, g_l),
                                   mlstm_out(m_lat, mo_l)), p)
    if not need_ctx:
        return y_lat, None
    y_ctx = merge_branches(u_ctx, (hyena_branch(u_ctx[..., HY_OFF:RET_OFF], p),
                                   retention_out(r_ctx, g_c),
                                   mlstm_out(m_ctx, mo_c)), p)
    return y_lat, y_ctx


def swiglu(h, w1, w3, w2):
    return (jax.nn.silu(h @ w1) * (h @ w3)) @ w2


def moe_ffn(h, w_router, b_router, w1, w3, w2):
    logits = (h @ w_router + b_router).astype(F32)
    top_val, top_idx = lax.top_k(logits, TOP_K)
    top_w = jax.nn.softmax(top_val, axis=-1)
    combine = jnp.sum(jax.nn.one_hot(top_idx, N_EXPERTS, dtype=F32) * top_w[..., None], axis=-2).astype(h.dtype)
    out = 0
    for e in range(N_EXPERTS):
        out = out + combine[..., e:e + 1] * swiglu(h, w1[e], w3[e], w2[e])
    return out


def setup_inputs(seed: int = 0) -> dict:
    key = jax.random.key(seed)
    ks = jax.random.split(key, 40)

    def nrm(k, shape, s):
        return jax.random.normal(k, shape, F32) * s

    x = nrm(ks[0], (BATCH, SEQ, D_MODEL), 1.0)
    c = nrm(ks[1], (BATCH, D_MODEL), 1.0)
    ctx = nrm(ks[2], (BATCH, CTX_LEN, D_MODEL), 1.0)
    c_ctx = nrm(ks[3], (D_MODEL,), 1.0)
    w_mod = nrm(ks[4], (DEPTH, D_MODEL, 6 * D_MODEL), 0.5 * D_MODEL ** -0.5)
    b_mod = nrm(ks[5], (DEPTH, 6 * D_MODEL), 0.02)
    g_mix = 1.0 + nrm(ks[6], (DEPTH, D_MODEL), 0.02)
    g_ffn = 1.0 + nrm(ks[7], (DEPTH, D_MODEL), 0.02)
    w_in = nrm(ks[8], (DEPTH, D_MODEL, N_IN), D_MODEL ** -0.5)
    b_in = nrm(ks[9], (DEPTH, N_IN), 0.02)
    hy_conv = nrm(ks[10], (DEPTH, HY_SHORT, 3 * HY_W), HY_SHORT ** -0.5)
    hy_f1 = nrm(ks[11], (DEPTH, HY_EMB, HY_HID), HY_EMB ** -0.5)
    hy_fb1 = nrm(ks[12], (DEPTH, HY_HID), 0.1)
    hy_f2 = nrm(ks[13], (DEPTH, HY_HID, HY_HID), HY_HID ** -0.5)
    hy_fb2 = nrm(ks[14], (DEPTH, HY_HID), 0.1)
    hy_f3 = nrm(ks[15], (DEPTH, HY_HID, HY_ORDER * 2 * HY_W), 0.01)
    base_decay = jnp.linspace(abs(math.log(1e-2)) / 1.5, abs(math.log(1e-2)) / 0.3, HY_W, dtype=F32)
    base_decay = jnp.broadcast_to(base_decay[None, :], (HY_ORDER * 2, HY_W)).reshape(-1)
    hy_decay = base_decay * (1.0 + nrm(ks[16], (DEPTH, HY_ORDER * 2 * HY_W), 0.05))
    hy_skip = nrm(ks[17], (DEPTH, HY_ORDER, HY_W), 0.5)
    gamma = 1.0 - 2.0 ** (-5.0 - jnp.arange(RET_HEADS, dtype=F32))
    ret_decay = jnp.log(gamma / (1.0 - gamma)) + nrm(ks[18], (DEPTH, 2, RET_HEADS), 0.1)
    ml_conv = nrm(ks[19], (DEPTH, ML_SHORT, 2 * ML_W), ML_SHORT ** -0.5)
    ig_bias = nrm(ks[20], (DEPTH, 2, ML_HEADS), 0.1)
    fg_bias = jnp.linspace(3.0, 6.0, ML_HEADS, dtype=F32) + nrm(ks[21], (DEPTH, 2, ML_HEADS), 0.1)
    ml_gate_bias = jnp.stack([ig_bias, fg_bias], axis=2)
    row_scale = jnp.concatenate([jnp.full((HY_W,), HY_W ** -0.5, F32),
                                 jnp.full((RET_W,), RET_W ** -0.5, F32),
                                 jnp.full((ML_W,), ML_W ** -0.5, F32)])
    w_up = nrm(ks[22], (DEPTH, MIX_W, D_MODEL), 1.0) * row_scale[:, None]
    w_out = nrm(ks[23], (DEPTH, D_MODEL, D_MODEL), D_MODEL ** -0.5)
    ffn_w1 = nrm(ks[24], (N_DENSE, D_MODEL, D_FF), D_MODEL ** -0.5)
    ffn_w3 = nrm(ks[25], (N_DENSE, D_MODEL, D_FF), D_MODEL ** -0.5)
    ffn_w2 = nrm(ks[26], (N_DENSE, D_FF, D_MODEL), D_FF ** -0.5)
    moe_router = nrm(ks[27], (N_MOE, D_MODEL, N_EXPERTS), D_MODEL ** -0.5)
    moe_router_b = nrm(ks[28], (N_MOE, N_EXPERTS), 0.01)
    moe_w1 = nrm(ks[29], (N_MOE, N_EXPERTS, D_MODEL, D_FF), D_MODEL ** -0.5)
    moe_w3 = nrm(ks[30], (N_MOE, N_EXPERTS, D_MODEL, D_FF), D_MODEL ** -0.5)
    moe_w2 = nrm(ks[31], (N_MOE, N_EXPERTS, D_FF, D_MODEL), D_FF ** -0.5)
    g_final = 1.0 + nrm(ks[32], (D_MODEL,), 0.02)
    return {'x': x, 'c': c, 'ctx': ctx, 'c_ctx': c_ctx, 'w_mod': w_mod, 'b_mod': b_mod,
            'g_mix': g_mix, 'g_ffn': g_ffn, 'w_in': w_in, 'b_in': b_in, 'hy_conv': hy_conv,
            'hy_f1': hy_f1, 'hy_fb1': hy_fb1, 'hy_f2': hy_f2, 'hy_fb2': hy_fb2, 'hy_f3': hy_f3,
            'hy_decay': hy_decay, 'hy_skip': hy_skip, 'ret_decay': ret_decay, 'ml_conv': ml_conv,
            'ml_gate_bias': ml_gate_bias, 'w_up': w_up, 'w_out': w_out, 'ffn_w1': ffn_w1,
            'ffn_w3': ffn_w3, 'ffn_w2': ffn_w2, 'moe_router': moe_router, 'moe_router_b': moe_router_b,
            'moe_w1': moe_w1, 'moe_w3': moe_w3, 'moe_w2': moe_w2, 'g_final': g_final}


def reference(x, c, ctx, c_ctx, w_mod, b_mod, g_mix, g_ffn, w_in, b_in, hy_conv, hy_f1, hy_fb1,
              hy_f2, hy_fb2, hy_f3, hy_decay, hy_skip, ret_decay, ml_conv, ml_gate_bias, w_up, w_out,
              ffn_w1, ffn_w3, ffn_w2, moe_router, moe_router_b, moe_w1, moe_w3, moe_w2, g_final):
    batch, n_lat, _ = x.shape
    ROWS = n_lat // GRID_W
    row_id = jnp.broadcast_to(jnp.arange(ROWS)[:, None], (ROWS, GRID_W)).reshape(-1)
    col_id = jnp.broadcast_to(jnp.arange(GRID_W)[None, :], (ROWS, GRID_W)).reshape(-1)
    rope = rotary_tables(row_id, col_id)
    s_lat = jax.nn.silu(c)
    s_ctx = jax.nn.silu(c_ctx)
    xl, xc = x, ctx
    for layer in range(DEPTH):
        last = layer == DEPTH - 1
        mod_l = (s_lat @ w_mod[layer] + b_mod[layer]).reshape(batch, 6, 1, D_MODEL)
        mod_c = (s_ctx @ w_mod[layer] + b_mod[layer]).reshape(6, D_MODEL)
        p = {'w_in': w_in[layer], 'b_in': b_in[layer], 'hy_conv': hy_conv[layer],
             'hy_f1': hy_f1[layer], 'hy_fb1': hy_fb1[layer], 'hy_f2': hy_f2[layer],
             'hy_fb2': hy_fb2[layer], 'hy_f3': hy_f3[layer], 'hy_decay': hy_decay[layer],
             'hy_skip': hy_skip[layer], 'ret_decay': ret_decay[layer], 'ml_conv': ml_conv[layer],
             'ml_gate_bias': ml_gate_bias[layer], 'w_up': w_up[layer], 'w_out': w_out[layer]}
        hl = modulate(rmsnorm(xl, g_mix[layer]), mod_l[:, 0], mod_l[:, 1])
        hc = modulate(rmsnorm(xc, g_mix[layer]), mod_c[0], mod_c[1])
        yl, yc = mixer(hl, hc, rope, p, not last)
        xl = xl + mod_l[:, 2] * yl
        if not last:
            xc = xc + mod_c[2] * yc
        j = layer // 2
        if layer % 2 == 0:
            ffn = functools.partial(swiglu, w1=ffn_w1[j], w3=ffn_w3[j], w2=ffn_w2[j])
        else:
            ffn = functools.partial(moe_ffn, w_router=moe_router[j], b_router=moe_router_b[j],
                                    w1=moe_w1[j], w3=moe_w3[j], w2=moe_w2[j])
        fl = modulate(rmsnorm(xl, g_ffn[layer]), mod_l[:, 3], mod_l[:, 4])
        xl = xl + mod_l[:, 5] * ffn(fl)
        if not last:
            fc = modulate(rmsnorm(xc, g_ffn[layer]), mod_c[3], mod_c[4])
            xc = xc + mod_c[5] * ffn(fc)
    return rmsnorm(xl, g_final)
```

```cpp
#include <hip/hip_runtime.h>
#include <stdint.h>
#include <stdio.h>

#define LAS __attribute__((address_space(3)))
typedef unsigned short bf16;
typedef short bf16x8 __attribute__((ext_vector_type(8)));
typedef float f32x4 __attribute__((ext_vector_type(4)));
typedef unsigned u32x4 __attribute__((ext_vector_type(4)));
typedef unsigned u32x2 __attribute__((ext_vector_type(2)));

constexpr int D = 1024, NB = 16, LL = 2048, LC = 256;
constexpr int TOKL = NB * LL, TOKC = NB * LC, TOK = TOKL + TOKC;
constexpr int HYW = 384, RETW = 384, MLW = 256;
constexpr int NIN = 6800, NW1 = 3840, NGATE = 3072, NWP = 6912;
constexpr int DFF = 2816, NFF1 = 5632, NE = 8;
constexpr int NWAVES = 8, NTHR = 512;
constexpr int MAXTILES = 272, PASS_TILES = 64, NPASS = 5;

constexpr size_t MiB = 1u << 20;
constexpr size_t WS_CTL = 0, CTL_ZERO_BYTES = 1 * MiB;
constexpr size_t WS_MOD = 1 * MiB;
constexpr size_t WS_BIAS = 2 * MiB;
constexpr size_t WS_ROPE = 2 * MiB + 256 * 1024;
constexpr size_t WS_TOPE = 3 * MiB;
constexpr size_t WS_TOPW = 3 * MiB + 256 * 1024;
constexpr size_t WS_TOPP = 3 * MiB + 512 * 1024;
constexpr size_t WS_SLOT = 3 * MiB + 768 * 1024;
constexpr size_t WS_ROWIDX = 4 * MiB;
constexpr size_t WS_TILEE = 4 * MiB + 512 * 1024;
constexpr size_t WS_FTL = 5 * MiB;
constexpr size_t WS_FTC = 17 * MiB;
constexpr size_t WS_WIN = 18 * MiB;
constexpr size_t WS_WUP = 32 * MiB;
constexpr size_t WS_WOUT = 34 * MiB;
constexpr size_t WS_XC = 36 * MiB;
constexpr size_t WS_H = 52 * MiB;
constexpr size_t WS_Y = 124 * MiB;
constexpr size_t WS_U = 196 * MiB;
constexpr size_t WS_RET = WS_U;
constexpr size_t WS_ML = WS_U + 108 * MiB;
constexpr size_t WS_MLG = WS_U + 180 * MiB;
constexpr size_t WS_OB = WS_U + 183 * MiB;
constexpr size_t WS_YHTL = WS_U + 228 * MiB;
constexpr size_t WS_YHTC = WS_U + 252 * MiB;
constexpr size_t WS_HYTL = WS_U + 255 * MiB;
constexpr size_t WS_HYTC = WS_U + 327 * MiB;
constexpr size_t WS_END = WS_U + 336 * MiB;
constexpr size_t WS_GATES = WS_U;
constexpr size_t WS_ACT = WS_U;
constexpr size_t WS_W13 = WS_U + 204 * MiB;
constexpr size_t WS_W2 = WS_U + 216 * MiB;
constexpr size_t WS_MW13 = WS_Y;
constexpr size_t WS_MW2 = WS_Y + 88 * MiB;
constexpr size_t WS_MACT = WS_Y + 132 * MiB;
constexpr size_t WS_EOUT = WS_Y + 220 * MiB;
static_assert(WS_EOUT + (size_t)MAXTILES * 256 * 1024 * 2 <= WS_END, "map");
static_assert(WS_GATES + (size_t)TOK * NGATE * 2 <= WS_YHTL, "gates overlay");

constexpr int CW_BAR = 4096;
constexpr int CW_CNT = 16384;

constexpr int LDS_BYTES = 147456;
constexpr int MISC_OFF = 147456 - 256;

__device__ __forceinline__ float bf2f(bf16 b) { return __uint_as_float(((unsigned)b) << 16); }
__device__ __forceinline__ unsigned f2bf(float f) { unsigned u = __float_as_uint(f); return (u + 0x7fffu + ((u >> 16) & 1u)) >> 16; }
__device__ __forceinline__ unsigned pk2(float lo, float hi) { return f2bf(lo) | (f2bf(hi) << 16); }
__device__ __forceinline__ float wave_sum(float v) {
#pragma unroll
    for (int o = 1; o < 64; o <<= 1) v += __shfl_xor(v, o);
    return v;
}
__device__ __forceinline__ float sigmoidf_(float x) { return 1.0f / (1.0f + __expf(-x)); }
__device__ __forceinline__ float siluf_(float x) { return x / (1.0f + __expf(-x)); }

#define XB_TMO      128
#define XB_XCNT(j)  (256  + 64 * (j))
#define XB_XSUB(j)  (1280 + 64 * (j))
#define XB_XGEN(j)  (2304 + 64 * (j))
#define XB_TOP      3328
#define XB_TOPGEN   3392
#define XCD_BAR_WORDS 3456
#define XB_SPIN_CAP (1u << 22)
__device__ __forceinline__ unsigned xb_ld(unsigned* p)              { return __hip_atomic_load(p, __ATOMIC_RELAXED, __HIP_MEMORY_SCOPE_AGENT); }
__device__ __forceinline__ unsigned xb_add(unsigned* p, unsigned v) { return __hip_atomic_fetch_add(p, v, __ATOMIC_RELAXED, __HIP_MEMORY_SCOPE_AGENT); }
__device__ __forceinline__ unsigned xb_xcc_id() { return (unsigned)__builtin_amdgcn_s_getreg((3 << 11) | 20) & 0xFu; }
#define XB_SPIN(cond, bar) do { unsigned _sp = 0; while (cond) { __builtin_amdgcn_s_sleep(1); \
    if ((++_sp & 255u) == 0u) { if (xb_ld(&(bar)[XB_TMO])) break; if (_sp > XB_SPIN_CAP) { atomicAdd(&(bar)[XB_TMO], 1u); break; } } } } while (0)
struct XcdBarrier { unsigned* bar; unsigned x; volatile LAS unsigned* st; };
__device__ __forceinline__ XcdBarrier xcd_barrier_post(unsigned* bar, volatile LAS unsigned* st) {
    XcdBarrier b; b.bar = bar; b.x = xb_xcc_id(); b.st = st;
    if (threadIdx.x == 0) (void)xb_add(&bar[XB_XCNT(b.x)], 1u);
    return b;
}
__device__ __forceinline__ void xcd_barrier_complete(unsigned* bar, unsigned x, unsigned& nloc, unsigned& nx) {
    const unsigned G = gridDim.x * gridDim.y * gridDim.z;
    unsigned sum, cnt, mine, sp = 0u;
    for (;;) {
        sum = 0u; cnt = 0u; mine = 0u;
#pragma unroll 1
        for (unsigned j = 0; j < 16; ++j) { const unsigned c = xb_ld(&bar[XB_XCNT(j)]); sum += c; cnt += (c > 0u) ? 1u : 0u; }
        mine = xb_ld(&bar[XB_XCNT(x)]);
        if (sum == G) break;
        __builtin_amdgcn_s_sleep(1);
        if ((++sp & 255u) == 0u) { if (xb_ld(&bar[XB_TMO])) break; if (sp > XB_SPIN_CAP) { atomicAdd(&bar[XB_TMO], 1u); break; } }
    }
    nloc = mine > 0u ? mine : 1u; nx = cnt > 0u ? cnt : 1u;
}
__device__ __forceinline__ void xcd_barrier(const XcdBarrier& b) {
    asm volatile("s_waitcnt vmcnt(0)" ::: "memory");
    __syncthreads();
    if (threadIdx.x == 0) {
        unsigned* bar = b.bar;
        __builtin_amdgcn_s_waitcnt(0);
        unsigned nloc = b.st[0], nx = b.st[1];
        if (nloc == 0u) { xcd_barrier_complete(bar, b.x, nloc, nx); b.st[0] = nloc; b.st[1] = nx; }
        const unsigned old = xb_add(&bar[XB_XSUB(b.x)], 1u);
        const unsigned gen = old / nloc;
        if (old + 1u == (gen + 1u) * nloc) {
            __builtin_amdgcn_fence(__ATOMIC_RELEASE, "agent");
            asm volatile("s_waitcnt vmcnt(0)" ::: "memory");
            const unsigned og = xb_add(&bar[XB_TOP], 1u);
            const unsigned tg = og / nx;
            if (og + 1u == (tg + 1u) * nx) xb_add(&bar[XB_TOPGEN], 1u);
            else XB_SPIN(xb_ld(&bar[XB_TOPGEN]) == tg, bar);
            __builtin_amdgcn_fence(__ATOMIC_ACQUIRE, "agent");
            xb_add(&bar[XB_XGEN(b.x)], 1u);
            asm volatile("s_waitcnt vmcnt(0)" ::: "memory");
        } else {
            XB_SPIN(xb_ld(&bar[XB_XGEN(b.x)]) == gen, bar);
            __builtin_amdgcn_fence(__ATOMIC_ACQUIRE, "agent");
            asm volatile("s_waitcnt vmcnt(0)" ::: "memory");
        }
    }
    __syncthreads();
}

struct Params { const float* in[32]; float* out; unsigned char* ws; };
enum { I_X = 0, I_C, I_CTX, I_CCTX, I_WMOD, I_BMOD, I_GMIX, I_GFFN, I_WIN, I_BIN, I_HYCONV, I_HYF1, I_HYFB1, I_HYF2, I_HYFB2, I_HYF3, I_HYDECAY,
       I_HYSKIP, I_RETDECAY, I_MLCONV, I_MLGB, I_WUP, I_WOUT, I_FW1, I_FW3, I_FW2, I_ROUTER, I_ROUTERB, I_MW1, I_MW3, I_MW2, I_GFINAL };

struct Frame {
    LAS unsigned char* lds;
    unsigned char* ws;
    int tid, lane, wave, G, wg;
};
#define WSP(T, off) ((T*)(F.ws + (off)))
constexpr int PTAB_OFF = 147456 - 1024;
__device__ __forceinline__ const float* inp(const Frame& F, int i) {
    const LAS unsigned* t = (const LAS unsigned*)(F.lds + PTAB_OFF) + 2 * i;
    const unsigned lo = __builtin_amdgcn_readfirstlane(t[0]), hi = __builtin_amdgcn_readfirstlane(t[1]);
    return (const float*)(((unsigned long long)hi << 32) | lo);
}
__device__ __forceinline__ float* outp(const Frame& F) { return (float*)inp(F, 32); }

__device__ __forceinline__ int row_batch(int row) { return row < TOKL ? (row >> 11) : ((row - TOKL) >> 8); }
__device__ __forceinline__ const float* mod_ptr(const Frame& F, int layer, int row, int which) {
    const int r = row < TOKL ? (row >> 11) : 16;
    return WSP(const float, WS_MOD) + ((size_t)(layer * 17 + r) * 6 + which) * 1024;
}

template <class RowMap>
__device__ __forceinline__ void tr_item(const float* W, int K, int N, bf16* WT, int ldT, RowMap rm, LAS float* scr, int item, int lane) {
    const int nblk = (N + 31) / 32, kb = item / nblk, nb = item % nblk, k0 = 64 * kb, n0 = 32 * nb;
#pragma unroll 8
    for (int i = 0; i < 32; ++i) { const int kk = 2 * i + (lane >> 5); const int n = n0 + (lane & 31); scr[kk * 33 + (lane & 31)] = (n < N) ? W[(size_t)(k0 + kk) * N + n] : 0.f; }
    asm volatile("s_waitcnt lgkmcnt(0)" ::: "memory");
    const int c = lane & 7;
#pragma unroll
    for (int j = 0; j < 4; ++j) { const int nl = (lane >> 3) + 8 * j; const int n = n0 + nl; const LAS float* s = scr + (8 * c) * 33 + nl;
        u32x4 o; o.x = pk2(s[0 * 33], s[1 * 33]); o.y = pk2(s[2 * 33], s[3 * 33]); o.z = pk2(s[4 * 33], s[5 * 33]); o.w = pk2(s[6 * 33], s[7 * 33]);
        if (n < N) *(u32x4*)(WT + (size_t)rm(n) * ldT + k0 + 8 * c) = o; }
    asm volatile("s_waitcnt lgkmcnt(0)" ::: "memory");
}
struct RmId { __device__ __forceinline__ int operator()(int n) const { return n; } };
__device__ __forceinline__ int win_row(int n) {
    if (n < 1152) return n;
    if (n < 2688) return 1280 + (n - 1152);
    if (n < 3712) return 2816 + (n - 2688);
    if (n < 3728) return 1152 + (n - 3712);
    return 3840 + (n - 3728);
}
struct RmWin { __device__ __forceinline__ int operator()(int n) const { return win_row(n); } };
struct RmW1 { __device__ __forceinline__ int operator()(int n) const { return (n >> 4) * 32 + (n & 15); } };
struct RmW3 { __device__ __forceinline__ int operator()(int n) const { return (n >> 4) * 32 + 16 + (n & 15); } };

__device__ __forceinline__ void conv_weights_win(Frame& F, int layer, int gw, int NGW, LAS float* scr) {
    const float* W = inp(F, I_WIN) + (size_t)layer * D * NIN;
    const int items = (D / 64) * ((NIN + 31) / 32);
    for (int it = gw; it < items; it += NGW) tr_item(W, D, NIN, WSP(bf16, WS_WIN), D, RmWin(), scr, it, F.lane);
    bf16* wt = WSP(bf16, WS_WIN);
    for (int i = gw * 64 + F.lane; i < 112 * 1024 / 8; i += NGW * 64) *(u32x4*)(wt + (size_t)1168 * 1024 + (size_t)i * 8) = (u32x4){0u, 0u, 0u, 0u};
}
__device__ __forceinline__ void conv_weights_upout(Frame& F, int layer, int gw, int NGW, LAS float* scr) {
    const int items = (D / 64) * (D / 32);
    for (int it = gw; it < items; it += NGW) tr_item(inp(F, I_WUP) + (size_t)layer * D * D, D, D, WSP(bf16, WS_WUP), D, RmId(), scr, it, F.lane);
    for (int it = gw; it < items; it += NGW) tr_item(inp(F, I_WOUT) + (size_t)layer * D * D, D, D, WSP(bf16, WS_WOUT), D, RmId(), scr, it, F.lane);
}
__device__ __forceinline__ void conv_weights_ffn(const float* w1, const float* w3, const float* w2, bf16* w13t, bf16* w2t, int gw, int NGW, LAS float* scr, int lane) {
    const int i1 = (D / 64) * (DFF / 32), i2 = (DFF / 64) * (D / 32);
    for (int it = gw; it < i1; it += NGW) tr_item(w1, D, DFF, w13t, D, RmW1(), scr, it, lane);
    for (int it = gw; it < i1; it += NGW) tr_item(w3, D, DFF, w13t, D, RmW3(), scr, it, lane);
    for (int it = gw; it < i2; it += NGW) tr_item(w2, DFF, D, w2t, DFF, RmId(), scr, it, lane);
}

__device__ __forceinline__ void filter_item(Frame& F, int layer, int L, bf16* FT  , int pb, int ch, LAS float* tile  ) {
    const float* f1 = inp(F, I_HYF1) + layer * 33 * 64; const float* fb1 = inp(F, I_HYFB1) + layer * 64;
    const float* f2 = inp(F, I_HYF2) + layer * 64 * 64; const float* fb2 = inp(F, I_HYFB2) + layer * 64;
    const float* f3 = inp(F, I_HYF3) + (size_t)layer * 64 * 1536; const float* dec = inp(F, I_HYDECAY) + layer * 1536;
    const int lane = F.lane, n = ch * 64 + lane;
    const float b1 = fb1[lane], b2 = fb2[lane], adec = fabsf(dec[n]);
    for (int pl = 0; pl < 64; ++pl) {
        const int pos = pb * 64 + pl;
        const float t = (float)pos / (float)(L - 1);
        const float w = 6.283185307179586f * (float)pos / (float)L;
        float feat = 0.f;
        if (lane == 0) feat = t;
        else if (lane < 17) { const float band = 1e-4f + (float)(lane - 1) * ((15.0f - 1e-4f) / 15.0f); feat = cosf(w * band); }
        else if (lane < 33) { const float band = 1e-4f + (float)(lane - 17) * ((15.0f - 1e-4f) / 15.0f); feat = -sinf(w * band); }
        float a1 = b1;
        for (int i = 0; i < 33; ++i) a1 += __shfl(feat, i) * f1[i * 64 + lane];
        const float h1 = sinf(a1);
        float a2 = b2;
        for (int i = 0; i < 64; ++i) a2 += __shfl(h1, i) * f2[i * 64 + lane];
        const float h2 = sinf(a2);
        float a3 = 0.f;
        for (int i = 0; i < 64; ++i) a3 += __shfl(h2, i) * f3[i * 1536 + n];
        tile[pl * 65 + lane] = a3 * expf(-t * adec);
    }
    asm volatile("s_waitcnt lgkmcnt(0)" ::: "memory");
    const int pos = pb * 64 + lane;
    for (int cl = 0; cl < 64; ++cl) {
        const int nn = ch * 64 + cl, o = nn / 768, dir = (nn / 384) & 1, c = nn % 384;
        bf16* dst = FT + (size_t)(o * 384 + c) * (2 * L);
        const float v = tile[lane * 65 + cl];
        if (dir == 0) dst[L - pos] = (bf16)f2bf(v);
        else if (pos > 0) dst[L + pos] = (bf16)f2bf(v);
    }
    asm volatile("s_waitcnt lgkmcnt(0)" ::: "memory");
}

__device__ __forceinline__ void phase_p0(Frame& F) {
    const int gw = F.wg * NWAVES + F.wave, NGW = F.G * NWAVES;
    LAS float* sl = (LAS float*)F.lds;
    LAS float* red = (LAS float*)(F.lds + 17 * 4096);
    for (int i = F.tid; i < 17 * 1024; i += NTHR) { const int r = i >> 10, k = i & 1023; const float v = r < 16 ? inp(F, I_C)[r * 1024 + k] : inp(F, I_CCTX)[k]; sl[i] = siluf_(v); }
    __syncthreads();
    for (int item = F.wg; item < 2 * 384; item += F.G) {
        const int layer = item / 384, n0 = (item % 384) * 16, j = F.tid & 15, kp = F.tid >> 4;
        const float* W = inp(F, I_WMOD) + (size_t)layer * D * 6144;
        float acc[17];
#pragma unroll
        for (int r = 0; r < 17; ++r) acc[r] = 0.f;
        for (int k = kp * 32; k < kp * 32 + 32; ++k) { const float w = W[(size_t)k * 6144 + n0 + j];
#pragma unroll
            for (int r = 0; r < 17; ++r) acc[r] += sl[r * 1024 + k] * w; }
#pragma unroll
        for (int r = 0; r < 17; ++r) red[(kp * 17 + r) * 16 + j] = acc[r];
        __syncthreads();
        if (F.tid < 272) { const int r = F.tid >> 4, jj = F.tid & 15; float s = inp(F, I_BMOD)[layer * 6144 + n0 + jj];
            for (int q = 0; q < 32; ++q) s += red[(q * 17 + r) * 16 + jj];
            WSP(float, WS_MOD)[(size_t)(layer * 17 + r) * 6144 + n0 + jj] = s; }
        __syncthreads();
    }
    __syncthreads();
    LAS float* scr = (LAS float*)(F.lds + F.wave * 8704);
    conv_weights_win(F, 0, gw, NGW, scr);
    conv_weights_upout(F, 0, gw, NGW, scr);
    for (int i = gw * 64 + F.lane; i < 2048 * 32; i += NGW * 64) {
        const int t = i >> 5, j = i & 31, half = j >> 4, ii = j & 15;
        const float inv = 1.0f / powf(10000.0f, (float)ii / 16.0f);
        const float ang = (float)(half == 0 ? (t >> 6) : (t & 63)) * inv;
        WSP(float, WS_ROPE)[t * 64 + half * 32 + ii] = cosf(ang);
        WSP(float, WS_ROPE)[t * 64 + half * 32 + 16 + ii] = sinf(ang);
    }
    __syncthreads();
    LAS float* ftile = (LAS float*)(F.lds + F.wave * 16640);
    for (int it = gw; it < 1536 + 96; it += NGW) {
        if (it < 1536) { const int layer = it / 768, r = it % 768; filter_item(F, layer, LL, WSP(bf16, WS_FTL) + (size_t)layer * 2 * 384 * 4096, r / 24, r % 24, ftile); }
        else { const int r = it - 1536; filter_item(F, 0, LC, WSP(bf16, WS_FTC), r / 24, r % 24, ftile); }
    }
}
__device__ __forceinline__ void write_bias(Frame& F) {
    const int gt = (F.wg * NWAVES + F.wave) * 64 + F.lane, NGT = F.G * NTHR;
    for (int i = gt; i < 2 * NWP; i += NGT) {
        const int l = i / NWP, r = i % NWP; float v = 0.f;
        int n = -1;
        if (r < 1152) n = r; else if (r < 1168) n = 3712 + (r - 1152); else if (r < 1280) n = -1; else if (r < 2816) n = 1152 + (r - 1280); else if (r < 3840) n = 2688 + (r - 2816); else n = 3728 + (r - 3840);
        if (n >= 0) v = inp(F, I_BIN)[l * NIN + n];
        WSP(float, WS_BIAS)[i] = v;
    }
}

__device__ __forceinline__ void norm_mod_row(const float* xrow, const float* g, const float* shift, const float* scale, bf16* orow, int lane, float* keep  ) {
    f32x4 v[4]; float s = 0.f;
#pragma unroll
    for (int j = 0; j < 4; ++j) { v[j] = *(const f32x4*)(xrow + 256 * j + 4 * lane); s += (v[j].x * v[j].x + v[j].y * v[j].y) + (v[j].z * v[j].z + v[j].w * v[j].w); }
    const float r = rsqrtf(wave_sum(s) * (1.0f / 1024.0f) + 1e-6f);
#pragma unroll
    for (int j = 0; j < 4; ++j) {
        const f32x4 gg = *(const f32x4*)(g + 256 * j + 4 * lane), sh = *(const f32x4*)(shift + 256 * j + 4 * lane), sc = *(const f32x4*)(scale + 256 * j + 4 * lane);
        f32x4 o;
        o.x = (v[j].x * r * gg.x) * (1.f + sc.x) + sh.x; o.y = (v[j].y * r * gg.y) * (1.f + sc.y) + sh.y;
        o.z = (v[j].z * r * gg.z) * (1.f + sc.z) + sh.z; o.w = (v[j].w * r * gg.w) * (1.f + sc.w) + sh.w;
        if (keep) { keep[4 * j + 0] = o.x; keep[4 * j + 1] = o.y; keep[4 * j + 2] = o.z; keep[4 * j + 3] = o.w; }
        u32x2 w; w.x = pk2(o.x, o.y); w.y = pk2(o.z, o.w);
        *(u32x2*)(orow + 256 * j + 4 * lane) = w;
    }
}
__device__ __forceinline__ const float* xrow_ptr(const Frame& F, int row, bool from_input) {
    if (row < TOKL) return (from_input ? inp(F, I_X) : outp(F)) + (size_t)row * D;
    return (from_input ? inp(F, I_CTX) : WSP(const float, WS_XC)) + (size_t)(row - TOKL) * D;
}
__device__ __forceinline__ void phase_norm(Frame& F, int layer, int nrows, bool from_input, int which) {
    const int gw = F.wg * NWAVES + F.wave, NGW = F.G * NWAVES;
    const float* g = inp(F, which == 0 ? I_GMIX : I_GFFN) + layer * D;
    for (int row = gw; row < nrows; row += NGW)
        norm_mod_row(xrow_ptr(F, row, from_input), g, mod_ptr(F, layer, row, which), mod_ptr(F, layer, row, which + 1), WSP(bf16, WS_H) + (size_t)row * D, F.lane, nullptr);
}

struct RowsId { __device__ __forceinline__ int operator()(int r) const { return r; } };
struct RowsGather { const int* idx; __device__ __forceinline__ int operator()(int r) const { return idx[r]; } };
template <class Epi, class Rows>
__device__ __forceinline__ void gemm_simple_tile(const bf16* A, int lda, const bf16* Bt, int ldb, int K, int rt, int ct, const Epi& E, const Rows& R, int lane) {
    const int fr = lane & 15, fq = lane >> 4;
    f32x4 acc[4][4];
#pragma unroll
    for (int mi = 0; mi < 4; ++mi)
#pragma unroll
        for (int ni = 0; ni < 4; ++ni) acc[mi][ni] = (f32x4){0.f, 0.f, 0.f, 0.f};
    const bf16* ap[4]; const bf16* bp[4];
#pragma unroll
    for (int mi = 0; mi < 4; ++mi) ap[mi] = A + (size_t)R(rt * 64 + mi * 16 + fr) * lda + fq * 8;
#pragma unroll
    for (int ni = 0; ni < 4; ++ni) bp[ni] = Bt + (size_t)(ct * 64 + ni * 16 + fr) * ldb + fq * 8;
#pragma unroll 1
    for (int k0 = 0; k0 < K; k0 += 32) {
        if constexpr (Epi::HORNER) {
            if (k0 == 384 || k0 == 768) {
                const int seg = (k0 == 384) ? 0 : 1;
#pragma unroll
                for (int mi = 0; mi < 4; ++mi)
#pragma unroll
                    for (int ni = 0; ni < 4; ++ni) acc[mi][ni] = E.rescale(seg, rt * 64 + mi * 16 + fr, ct * 64 + ni * 16 + 4 * fq, acc[mi][ni]);
            }
        }
        bf16x8 a[4], b[4];
#pragma unroll
        for (int mi = 0; mi < 4; ++mi) a[mi] = *(const bf16x8*)(ap[mi] + k0);
#pragma unroll
        for (int ni = 0; ni < 4; ++ni) b[ni] = *(const bf16x8*)(bp[ni] + k0);
#pragma unroll
        for (int mi = 0; mi < 4; ++mi)
#pragma unroll
            for (int ni = 0; ni < 4; ++ni) acc[mi][ni] = __builtin_amdgcn_mfma_f32_16x16x32_bf16(b[ni], a[mi], acc[mi][ni], 0, 0, 0);
    }
#pragma unroll
    for (int mi = 0; mi < 4; ++mi) {
        const int r = rt * 64 + mi * 16 + fr;
        if constexpr (Epi::PAIR) {
#pragma unroll
            for (int ni = 0; ni < 4; ni += 2) E.store_pair(r, ct * 32 + (ni >> 1) * 16 + 4 * fq, acc[mi][ni], acc[mi][ni + 1]);
        } else {
#pragma unroll
            for (int ni = 0; ni < 4; ++ni) E.store(r, ct * 64 + ni * 16 + 4 * fq, acc[mi][ni]);
        }
    }
}
template <class Epi, class Rows>
__device__ __forceinline__ void gemm_simple(Frame& F, const bf16* A, int lda, const bf16* Bt, int ldb, int K, int M, int N, const Epi& E, const Rows& R) {
    const int gw = F.wg * NWAVES + F.wave, NGW = F.G * NWAVES;
    const int nct = N / 64, nrt = M / 64;
    for (int u = gw; u < nct * nrt; u += NGW) gemm_simple_tile(A, lda, Bt, ldb, K, u / nct, u % nct, E, R, F.lane);
}

__device__ __forceinline__ void st_bf16x4(bf16* p, f32x4 v) { u32x2 w; w.x = pk2(v.x, v.y); w.y = pk2(v.z, v.w); *(u32x2*)p = w; }
__device__ __forceinline__ f32x4 ld_bf16x4(const bf16* p) { const u32x2 w = *(const u32x2*)p; f32x4 v; v.x = __uint_as_float(w.x << 16); v.y = __uint_as_float(w.x & 0xffff0000u); v.z = __uint_as_float(w.y << 16); v.w = __uint_as_float(w.y & 0xffff0000u); return v; }

struct EpiWin {
    static constexpr bool HORNER = false, PAIR = false;
    const float* bias; bf16 *hytl, *hytc, *ret, *ml; float* mlg;
    __device__ __forceinline__ f32x4 rescale(int, int, int, f32x4 v) const { return v; }
    __device__ __forceinline__ void store(int row, int col, f32x4 v) const {
        v += *(const f32x4*)(bias + col);
        if (col < 1152) {
            if (row < TOKL) { const int b = row >> 11, t = row & 2047; bf16* d = hytl + ((size_t)(b * 1152 + col)) * 2048 + t;
                d[0] = (bf16)f2bf(v.x); d[2048] = (bf16)f2bf(v.y); d[4096] = (bf16)f2bf(v.z); d[6144] = (bf16)f2bf(v.w); }
            else { const int r = row - TOKL, b = r >> 8, t = r & 255; bf16* d = hytc + ((size_t)(b * 1152 + col)) * 256 + t;
                d[0] = (bf16)f2bf(v.x); d[256] = (bf16)f2bf(v.y); d[512] = (bf16)f2bf(v.z); d[768] = (bf16)f2bf(v.w); }
        } else if (col < 1168) { *(f32x4*)(mlg + (size_t)row * 16 + (col - 1152)) = v; }
        else if (col < 1280) { }
        else if (col < 2816) st_bf16x4(ret + (size_t)row * 1536 + (col - 1280), v);
        else st_bf16x4(ml + (size_t)row * 1024 + (col - 2816), v);
    }
};
struct EpiGate {
    static constexpr bool HORNER = false, PAIR = false;
    const float* bias; bf16* gates;
    __device__ __forceinline__ f32x4 rescale(int, int, int, f32x4 v) const { return v; }
    __device__ __forceinline__ void store(int row, int col, f32x4 v) const {
        v += *(const f32x4*)(bias + col);
        f32x4 g; g.x = fmaxf(sigmoidf_(v.x), 1e-20f); g.y = fmaxf(sigmoidf_(v.y), 1e-20f); g.z = fmaxf(sigmoidf_(v.z), 1e-20f); g.w = fmaxf(sigmoidf_(v.w), 1e-20f);
        st_bf16x4(gates + (size_t)row * NGATE + col, g);
    }
};
struct EpiUp {
    static constexpr bool HORNER = true, PAIR = false;
    const bf16* gates; bf16* acc_out;
    __device__ __forceinline__ f32x4 rescale(int seg, int row, int col, f32x4 v) const {
        const f32x4 a = ld_bf16x4(gates + (size_t)row * NGATE + seg * 1024 + col), b = ld_bf16x4(gates + (size_t)row * NGATE + (seg + 1) * 1024 + col);
        v.x *= a.x / b.x; v.y *= a.y / b.y; v.z *= a.z / b.z; v.w *= a.w / b.w; return v;
    }
    __device__ __forceinline__ void store(int row, int col, f32x4 v) const {
        const f32x4 g = ld_bf16x4(gates + (size_t)row * NGATE + 2048 + col);
        st_bf16x4(acc_out + (size_t)row * D + col, v * g);
    }
};
struct EpiResid {
    static constexpr bool HORNER = false, PAIR = false;
    const float *xin_l, *xin_c; float *xout_l, *xout_c; const float* modbase; int which;
    __device__ __forceinline__ f32x4 rescale(int, int, int, f32x4 v) const { return v; }
    __device__ __forceinline__ void store(int row, int col, f32x4 v) const {
        const int r = row < TOKL ? (row >> 11) : 16;
        const f32x4 m = *(const f32x4*)(modbase + ((size_t)r * 6 + which) * 1024 + col);
        if (row < TOKL) { const size_t o = (size_t)row * D + col; *(f32x4*)(xout_l + o) = *(const f32x4*)(xin_l + o) + m * v; }
        else { const size_t o = (size_t)(row - TOKL) * D + col; *(f32x4*)(xout_c + o) = *(const f32x4*)(xin_c + o) + m * v; }
    }
};
struct EpiSwiglu {
    static constexpr bool HORNER = false, PAIR = true;
    bf16* act; int row_off;
    __device__ __forceinline__ f32x4 rescale(int, int, int, f32x4 v) const { return v; }
    __device__ __forceinline__ void store_pair(int row, int col, f32x4 a, f32x4 b) const {
        f32x4 o; o.x = siluf_(a.x) * b.x; o.y = siluf_(a.y) * b.y; o.z = siluf_(a.z) * b.z; o.w = siluf_(a.w) * b.w;
        st_bf16x4(act + (size_t)(row - row_off) * DFF + col, o);
    }
};
struct EpiBf16Out {
    static constexpr bool HORNER = false, PAIR = false;
    bf16* out; int ld; int row_add;
    __device__ __forceinline__ f32x4 rescale(int, int, int, f32x4 v) const { return v; }
    __device__ __forceinline__ void store(int row, int col, f32x4 v) const { st_bf16x4(out + (size_t)(row + row_add) * ld + col, v); }
};

constexpr int ZPITCH_L = (LL + 8) * 2, ZPITCH_C = (LC + 8) * 2;
template <int L>
__device__ __forceinline__ float conv3_at(const bf16* base  , int t, float w0, float w1, float w2) {
    const float a = t > 0 ? bf2f(base[t - 1]) : 0.f, b = bf2f(base[t]), c = t < L - 1 ? bf2f(base[t + 1]) : 0.f;
    return w0 * a + w1 * b + w2 * c;
}
template <int L>
__device__ __forceinline__ void hyena_unit_naive(Frame& F, int layer, int c, const bf16* hyt  , const bf16* ft  , bf16* yht  ) {
    constexpr int ZP = (L + 8) * 2;
    constexpr int PER = L / 32;
    constexpr int SUB = 8;
    LAS unsigned char* zimg0 = F.lds;
    LAS unsigned char* zimg1 = F.lds + 16 * ZP;
    LAS bf16* tf = (LAS bf16*)(F.lds + 32 * ZP);
    const float* cw = inp(F, I_HYCONV) + layer * 3 * 1152;
    const float* skip = inp(F, I_HYSKIP) + layer * 2 * 384;
    __syncthreads();
    {
        const int b = F.tid >> 5, seg = F.tid & 31; const bf16* src = hyt + ((size_t)(b * 1152 + c)) * L;
        const float w0 = cw[c], w1 = cw[1152 + c], w2 = cw[2304 + c];
#pragma unroll 2
        for (int j = 0; j < PER; ++j) { const int t = seg * PER + j; *(LAS bf16*)(zimg0 + b * ZP + t * 2) = (bf16)f2bf(conv3_at<L>(src, t, w0, w1, w2)); }
    }
#pragma unroll 1
    for (int o = 0; o < 2; ++o) {
        LAS unsigned char* zs = o == 0 ? zimg0 : zimg1;
        LAS unsigned char* zd = o == 0 ? zimg1 : zimg0;
        const bf16* fsrc = ft + ((size_t)(o * 384 + c)) * (2 * L);
        for (int i = F.tid; i < 2 * L; i += NTHR) tf[i] = i == 0 ? (bf16)0 : fsrc[i];
        __syncthreads();
        const int b = F.tid & 15, tg = F.tid >> 4;
        const int gcol = (o == 0 ? 384 : 768) + c;
        const bf16* gsrc = hyt + ((size_t)(b * 1152 + gcol)) * L;
        const float w0 = cw[gcol], w1 = cw[1152 + gcol], w2 = cw[2304 + gcol], sk = skip[o * 384 + c];
#pragma unroll 1
        for (int sb = 0; sb < PER / SUB; ++sb) {
            const int t0 = tg * PER + sb * SUB;
            float acc[SUB];
#pragma unroll
            for (int j = 0; j < SUB; ++j) acc[j] = 0.f;
#pragma unroll 1
            for (int s0 = 0; s0 < L; s0 += 8) {
                float z[8];
                { const bf16x8 zz = *(const LAS bf16x8*)(zs + b * ZP + s0 * 2);
#pragma unroll
                  for (int i = 0; i < 8; ++i) z[i] = bf2f((bf16)zz[i]); }
                float win[SUB + 7];
                const int wb = L + s0 - t0 - (SUB - 1);
#pragma unroll
                for (int i = 0; i < SUB + 7; ++i) win[i] = bf2f(tf[wb + i]);
#pragma unroll
                for (int j = 0; j < SUB; ++j)
#pragma unroll
                    for (int i = 0; i < 8; ++i) acc[j] += win[(SUB - 1) - j + i] * z[i];
            }
#pragma unroll
            for (int j = 0; j < SUB; ++j) {
                const int t = t0 + j;
                const float zt = bf2f(*(LAS bf16*)(zs + b * ZP + t * 2));
                const float ov = conv3_at<L>(gsrc, t, w0, w1, w2) * (acc[j] + sk * zt);
                *(LAS bf16*)(zd + b * ZP + t * 2) = (bf16)f2bf(ov);
            }
        }
        __syncthreads();
    }
#pragma unroll 2
    for (int i = F.tid; i < 16 * (L / 8); i += NTHR) {
        const int b = i / (L / 8), ch = i % (L / 8);
        *(u32x4*)(yht + ((size_t)(b * 384 + c)) * L + ch * 8) = *(const LAS u32x4*)(zimg0 + b * ZP + ch * 16);
    }
}

__device__ __forceinline__ void chain_naive(Frame& F, int layer, int chain) {
    const int lane = F.lane;
    const bool is_ret = chain < 192;
    int b, h, dir;
    if (is_ret) { b = chain / 12; const int r = chain % 12; h = r >> 1; dir = r & 1; }
    else { const int i = chain - 192; b = i >> 3; h = (i & 7) >> 1; dir = i & 1; }
    const bf16* RET = WSP(const bf16, WS_RET); const bf16* ML = WSP(const bf16, WS_ML); const float* MLG = WSP(const float, WS_MLG);
    const float* rope = WSP(const float, WS_ROPE);
    bf16* Y = WSP(bf16, WS_Y); bf16* OB = WSP(bf16, WS_OB);
    float gam = 0.f;
    if (is_ret) gam = sigmoidf_(inp(F, I_RETDECAY)[layer * 12 + dir * 6 + h]);
    const float* mlc = inp(F, I_MLCONV) + layer * 3 * 512;
    const float bi = is_ret ? 0.f : inp(F, I_MLGB)[layer * 16 + dir * 8 + h], bfg = is_ret ? 0.f : inp(F, I_MLGB)[layer * 16 + dir * 8 + 4 + h];
    const float qw0 = mlc[h * 64 + lane], qw1 = mlc[512 + h * 64 + lane], qw2 = mlc[1024 + h * 64 + lane];
    const float kw0 = mlc[256 + h * 64 + lane], kw1 = mlc[512 + 256 + h * 64 + lane], kw2 = mlc[1024 + 256 + h * 64 + lane];
    float S[64];
#pragma unroll
    for (int d = 0; d < 64; ++d) S[d] = 0.f;
    float nv = 0.f;
    for (int step = 0; step < LC + LL; ++step) {
        int row, tpos, L; bool lat;
        if (step < LC) { tpos = dir ? (LC - 1 - step) : step; row = TOKL + b * LC + tpos; L = LC; lat = false; }
        else { const int s2 = step - LC; tpos = dir ? (LL - 1 - s2) : s2; row = b * LL + tpos; L = LL; lat = true; }
        float q, k, v, Fm, Im;
        if (is_ret) {
            const bf16* base = RET + (size_t)row * 1536;
            float qs = bf2f(base[h * 64 + lane]), ks = bf2f(base[384 + h * 64 + lane]);
            v = bf2f(base[768 + h * 64 + lane]);
            if (lat) {
                const float qp = bf2f(base[h * 64 + (lane ^ 16)]), kp = bf2f(base[384 + h * 64 + (lane ^ 16)]);
                const int half = lane >> 5, ii = lane & 15, hi = (lane >> 4) & 1;
                const float cs = rope[tpos * 64 + half * 32 + ii], sn = rope[tpos * 64 + half * 32 + 16 + ii];
                q = hi == 0 ? qs * cs - qp * sn : qp * sn + qs * cs;
                k = hi == 0 ? ks * cs - kp * sn : kp * sn + ks * cs;
            } else { q = qs; k = ks; }
            q *= 0.125f; Fm = gam; Im = 1.f;
        } else {
            const bf16* base = ML + (size_t)row * 1024;
            const float q0 = tpos > 0 ? bf2f(base[-1024 + h * 64 + lane]) : 0.f, q1 = bf2f(base[h * 64 + lane]), q2 = tpos < L - 1 ? bf2f(base[1024 + h * 64 + lane]) : 0.f;
            const float k0 = tpos > 0 ? bf2f(base[-1024 + 256 + h * 64 + lane]) : 0.f, k1 = bf2f(base[256 + h * 64 + lane]), k2 = tpos < L - 1 ? bf2f(base[1024 + 256 + h * 64 + lane]) : 0.f;
            q = siluf_(qw0 * q0 + qw1 * q1 + qw2 * q2);
            k = siluf_(kw0 * k0 + kw1 * k1 + kw2 * k2) * 0.125f;
            v = bf2f(base[512 + h * 64 + lane]);
            const float ig = MLG[(size_t)row * 16 + dir * 8 + h] + bi, fg = MLG[(size_t)row * 16 + dir * 8 + 4 + h] + bfg;
            Fm = sigmoidf_(fg); Im = __expf(ig);
        }
        float num = 0.f;
        const float iv = Im * v;
#pragma unroll
        for (int d = 0; d < 64; ++d) {
            const float kd = __int_as_float(__builtin_amdgcn_readlane(__float_as_int(k), d));
            const float qd = __int_as_float(__builtin_amdgcn_readlane(__float_as_int(q), d));
            S[d] = Fm * S[d] + kd * iv;
            num += qd * S[d];
        }
        float o = num;
        if (!is_ret) { nv = Fm * nv + Im * k; const float den = wave_sum(q * nv); o = num / fmaxf(fabsf(den), 1.f); }
        const int cof = is_ret ? (h * 64 + lane) : (384 + h * 64 + lane);
        if (dir == 0) Y[(size_t)row * D + 384 + cof] = (bf16)f2bf(o);
        else OB[(size_t)row * 640 + cof] = (bf16)f2bf(o);
    }
}

__device__ __forceinline__ void phase_mix(Frame& F, int layer) {
    const bool last = layer == 1;
    const bf16* ftl = WSP(const bf16, WS_FTL) + (size_t)layer * 2 * 384 * 4096;
    for (int u = F.wg; u < 384; u += F.G) hyena_unit_naive<LL>(F, layer, u, WSP(const bf16, WS_HYTL), ftl, WSP(bf16, WS_YHTL));
    if (!last) for (int u = F.wg; u < 384; u += F.G) hyena_unit_naive<LC>(F, layer, u, WSP(const bf16, WS_HYTC), WSP(const bf16, WS_FTC), WSP(bf16, WS_YHTC));
    for (int c = F.wg + F.wave * F.G; c < 320; c += F.G * NWAVES) chain_naive(F, layer, c);
}

__device__ __forceinline__ void phase_combine(Frame& F, int layer) {
    const bool last = layer == 1;
    const int gw = F.wg * NWAVES + F.wave, NGW = F.G * NWAVES, lane = F.lane;
    const int nrows = last ? TOKL : TOK;
    bf16* Y = WSP(bf16, WS_Y); const bf16* OB = WSP(const bf16, WS_OB); const bf16* RET = WSP(const bf16, WS_RET); const bf16* ML = WSP(const bf16, WS_ML);
    for (int row = gw; row < nrows; row += NGW) {
#pragma unroll
        for (int hh = 0; hh < 10; ++hh) {
            const int cof = hh * 64 + lane;
            const float x = bf2f(Y[(size_t)row * D + 384 + cof]) + bf2f(OB[(size_t)row * 640 + cof]);
            const float mu = wave_sum(x) * (1.f / 64.f), xc = x - mu;
            const float var = wave_sum(xc * xc) * (1.f / 64.f);
            const float nrm = xc * rsqrtf(var + 1e-6f);
            float gate;
            if (hh < 6) gate = siluf_(bf2f(RET[(size_t)row * 1536 + 1152 + cof]));
            else gate = sigmoidf_(bf2f(ML[(size_t)row * 1024 + 768 + (cof - 384)]));
            Y[(size_t)row * D + 384 + cof] = (bf16)f2bf(nrm * gate);
        }
    }
    LAS float* scr = (LAS float*)(F.lds + F.wave * 16640);
    const int nitL = NB * 6 * 32, nitC = last ? 0 : NB * 6 * 4;
    for (int it = gw; it < nitL + nitC; it += NGW) {
        const bf16* src; int L, rowbase, b, cb, tb;
        if (it < nitL) { b = it / 192; const int r = it % 192; cb = r / 32; tb = r % 32; L = LL; src = WSP(const bf16, WS_YHTL); rowbase = b * LL; }
        else { const int i2 = it - nitL; b = i2 / 24; const int r = i2 % 24; cb = r / 4; tb = r % 4; L = LC; src = WSP(const bf16, WS_YHTC); rowbase = TOKL + b * LC; }
        for (int cc = 0; cc < 64; ++cc) scr[cc * 65 + lane] = bf2f(src[((size_t)(b * 384 + cb * 64 + cc)) * L + tb * 64 + lane]);
        asm volatile("s_waitcnt lgkmcnt(0)" ::: "memory");
        for (int tt = 0; tt < 64; ++tt) Y[(size_t)(rowbase + tb * 64 + tt) * D + cb * 64 + lane] = (bf16)f2bf(scr[lane * 65 + tt]);
        asm volatile("s_waitcnt lgkmcnt(0)" ::: "memory");
    }
}

__device__ __forceinline__ void phase_norm_router(Frame& F) {
    const int gw = F.wg * NWAVES + F.wave, NGW = F.G * NWAVES, lane = F.lane;
    const float* g = inp(F, I_GFFN) + 1 * D; const float* wr = inp(F, I_ROUTER); const float* br = inp(F, I_ROUTERB);
    unsigned* cnt = WSP(unsigned, WS_CTL) + CW_CNT;
    for (int row = gw; row < TOKL; row += NGW) {
        float keep[16];
        norm_mod_row(xrow_ptr(F, row, false), g, mod_ptr(F, 1, row, 3), mod_ptr(F, 1, row, 4), WSP(bf16, WS_H) + (size_t)row * D, lane, keep);
        float lg[8];
#pragma unroll
        for (int e = 0; e < 8; ++e) lg[e] = 0.f;
#pragma unroll
        for (int j = 0; j < 4; ++j)
#pragma unroll
            for (int i = 0; i < 4; ++i) { const int k = 256 * j + 4 * lane + i; const f32x4 w0 = *(const f32x4*)(wr + k * 8), w1 = *(const f32x4*)(wr + k * 8 + 4); const float x = keep[4 * j + i];
                lg[0] += x * w0.x; lg[1] += x * w0.y; lg[2] += x * w0.z; lg[3] += x * w0.w; lg[4] += x * w1.x; lg[5] += x * w1.y; lg[6] += x * w1.z; lg[7] += x * w1.w; }
#pragma unroll
        for (int e = 0; e < 8; ++e) lg[e] = wave_sum(lg[e]) + br[e];
        int e0 = 0; float v0 = lg[0];
#pragma unroll
        for (int e = 1; e < 8; ++e) if (lg[e] > v0) { v0 = lg[e]; e0 = e; }
        int e1 = -1; float v1 = -3.0e38f;
#pragma unroll
        for (int e = 0; e < 8; ++e) if (e != e0 && lg[e] > v1) { v1 = lg[e]; e1 = e; }
        const float w1 = 1.f / (1.f + __expf(v0 - v1)), w0 = 1.f - w1;
        if (lane == 0) {
            const unsigned p0 = atomicAdd(cnt + e0, 1u), p1 = atomicAdd(cnt + e1, 1u);
            WSP(int, WS_TOPE)[row * 2] = e0; WSP(int, WS_TOPE)[row * 2 + 1] = e1;
            WSP(float, WS_TOPW)[row * 2] = w0; WSP(float, WS_TOPW)[row * 2 + 1] = w1;
            WSP(int, WS_TOPP)[row * 2] = (int)p0; WSP(int, WS_TOPP)[row * 2 + 1] = (int)p1;
        }
    }
}
__device__ __forceinline__ void phase_route_tables(Frame& F) {
    const unsigned* cnt = WSP(const unsigned, WS_CTL) + CW_CNT;
    int off[9]; off[0] = 0;
#pragma unroll
    for (int e = 0; e < 8; ++e) { const int c = (int)__hip_atomic_load(cnt + e, __ATOMIC_RELAXED, __HIP_MEMORY_SCOPE_AGENT); off[e + 1] = off[e] + ((c + 255) >> 8) * 256; }
    const int gt = F.wg * NTHR + F.tid, NGT = F.G * NTHR;
    int* rowidx = WSP(int, WS_ROWIDX); int* slot = WSP(int, WS_SLOT); int* tilee = WSP(int, WS_TILEE);
    for (int i = gt; i < MAXTILES * 256; i += NGT) {
        int e = 0;
#pragma unroll
        for (int q = 1; q < 8; ++q) if (i >= off[q]) e = q;
        const int c = (int)cnt[e];
        if (i >= off[8] || i - off[e] >= c) rowidx[i] = 0;
    }
    for (int i = gt; i < TOKL * 2; i += NGT) {
        const int e = WSP(const int, WS_TOPE)[i], pos = WSP(const int, WS_TOPP)[i];
        int o = 0;
#pragma unroll
        for (int q = 0; q < 8; ++q) if (e == q) o = off[q];
        const int s = o + pos; slot[i] = s; rowidx[s] = i >> 1;
    }
    for (int i = gt; i < MAXTILES + 1; i += NGT) {
        if (i == MAXTILES) tilee[MAXTILES] = off[8] >> 8;
        else { int e = 0;
#pragma unroll
            for (int q = 1; q < 8; ++q) if (i * 256 >= off[q]) e = q;
            tilee[i] = e; }
    }
}

__device__ __forceinline__ void moe_pass_gemm1(Frame& F, int t0, int t1) {
    const int gw = F.wg * NWAVES + F.wave, NGW = F.G * NWAVES;
    const int* tilee = WSP(const int, WS_TILEE); RowsGather R{WSP(const int, WS_ROWIDX)};
    const int nct = NFF1 / 64, nunits = (t1 - t0) * 4 * nct;
    EpiSwiglu E{WSP(bf16, WS_MACT), t0 * 256};
    for (int u = gw; u < nunits; u += NGW) {
        const int rt = u / nct, ct = u % nct, tile = t0 + (rt >> 2);
        const bf16* Bt = WSP(const bf16, WS_MW13) + (size_t)tilee[tile] * NFF1 * D;
        gemm_simple_tile(WSP(const bf16, WS_H), D, Bt, D, D, t0 * 4 + rt, ct, E, R, F.lane);
    }
}
__device__ __forceinline__ void moe_pass_gemm2(Frame& F, int t0, int t1) {
    const int gw = F.wg * NWAVES + F.wave, NGW = F.G * NWAVES;
    const int* tilee = WSP(const int, WS_TILEE);
    const int nct = D / 64, nunits = (t1 - t0) * 4 * nct;
    EpiBf16Out E{WSP(bf16, WS_EOUT), D, t0 * 256};
    for (int u = gw; u < nunits; u += NGW) {
        const int rt = u / nct, ct = u % nct, tile = t0 + (rt >> 2);
        const bf16* Bt = WSP(const bf16, WS_MW2) + (size_t)tilee[tile] * D * DFF;
        gemm_simple_tile(WSP(const bf16, WS_MACT), DFF, Bt, DFF, DFF, rt, ct, E, RowsId(), F.lane);
    }
}
__device__ __forceinline__ void phase_final(Frame& F) {
    const int gw = F.wg * NWAVES + F.wave, NGW = F.G * NWAVES, lane = F.lane;
    const float* gf = inp(F, I_GFINAL); const bf16* eo = WSP(const bf16, WS_EOUT);
    for (int row = gw; row < TOKL; row += NGW) {
        const int s0 = WSP(const int, WS_SLOT)[row * 2], s1 = WSP(const int, WS_SLOT)[row * 2 + 1];
        const float w0 = WSP(const float, WS_TOPW)[row * 2], w1 = WSP(const float, WS_TOPW)[row * 2 + 1];
        const float* m5 = mod_ptr(F, 1, row, 5);
        float* xr = outp(F) + (size_t)row * D;
        f32x4 v[4]; float s = 0.f;
#pragma unroll
        for (int j = 0; j < 4; ++j) {
            const int c = 256 * j + 4 * lane;
            const f32x4 a = ld_bf16x4(eo + (size_t)s0 * D + c), b = ld_bf16x4(eo + (size_t)s1 * D + c), m = *(const f32x4*)(m5 + c);
            v[j] = *(const f32x4*)(xr + c) + m * (a * w0 + b * w1);
            s += (v[j].x * v[j].x + v[j].y * v[j].y) + (v[j].z * v[j].z + v[j].w * v[j].w);
        }
        const float r = rsqrtf(wave_sum(s) * (1.f / 1024.f) + 1e-6f);
#pragma unroll
        for (int j = 0; j < 4; ++j) { const int c = 256 * j + 4 * lane; const f32x4 g = *(const f32x4*)(gf + c); *(f32x4*)(xr + c) = v[j] * r * g; }
    }
}

__global__ void __launch_bounds__(NTHR, 2) hybrid_fwd(Params prm) {
    extern __shared__ __attribute__((aligned(16))) unsigned char lds_raw[];
    Frame F;
    F.lds = (LAS unsigned char*)lds_raw; F.ws = prm.ws;
    F.tid = threadIdx.x; F.lane = F.tid & 63; F.wave = __builtin_amdgcn_readfirstlane(F.tid >> 6); F.G = gridDim.x; F.wg = blockIdx.x;
    volatile LAS unsigned* MISC = (volatile LAS unsigned*)(F.lds + MISC_OFF);
    if (F.tid < 64) MISC[F.tid] = 0u;
    if (F.tid < 33) { const unsigned long long v = F.tid < 32 ? (unsigned long long)prm.in[F.tid] : (unsigned long long)prm.out; *(LAS unsigned long long*)(F.lds + PTAB_OFF + 8 * F.tid) = v; }
    __syncthreads();
    XcdBarrier bar = xcd_barrier_post(WSP(unsigned, WS_CTL) + CW_BAR, MISC + 8);
#define RELAUNDER() do { { unsigned long long _w = (unsigned long long)F.ws; asm volatile("" : "+s"(_w)); F.ws = (unsigned char*)_w; } \
        { unsigned _t = (unsigned)F.tid; asm volatile("" : "+v"(_t)); F.tid = (int)_t; F.lane = F.tid & 63; F.wave = __builtin_amdgcn_readfirstlane(F.tid >> 6); } \
        { unsigned _g = (unsigned)F.G, _b = (unsigned)F.wg; asm volatile("" : "+s"(_g), "+s"(_b)); F.G = (int)_g; F.wg = (int)_b; } \
        { unsigned _l = (unsigned)(size_t)F.lds; asm volatile("" : "+s"(_l)); F.lds = (LAS unsigned char*)(size_t)_l; } } while (0)
#define GRID_BAR() do { { unsigned long long _b = (unsigned long long)bar.bar; asm volatile("" : "+s"(_b)); bar.bar = (unsigned*)_b; } xcd_barrier(bar); RELAUNDER(); } while (0)

    phase_p0(F); write_bias(F);
    GRID_BAR();
#pragma unroll 1
    for (int layer = 0; layer < 2; ++layer) {
        const bool last = layer == 1;
        const int rows_all = TOK, rows_out = last ? TOKL : TOK;
        const float* modbase = WSP(const float, WS_MOD) + (size_t)layer * 17 * 6144;
        phase_norm(F, layer, rows_all, !last, 0);
        GRID_BAR();
        { EpiWin E{WSP(const float, WS_BIAS) + layer * NWP, WSP(bf16, WS_HYTL), WSP(bf16, WS_HYTC), WSP(bf16, WS_RET), WSP(bf16, WS_ML), WSP(float, WS_MLG)};
          gemm_simple(F, WSP(const bf16, WS_H), D, WSP(const bf16, WS_WIN), D, D, rows_all, NW1, E, RowsId()); }
        GRID_BAR();
        phase_mix(F, layer);
        GRID_BAR();
        phase_combine(F, layer);
        GRID_BAR();
        { EpiGate E{WSP(const float, WS_BIAS) + layer * NWP + NW1, WSP(bf16, WS_GATES)};
          gemm_simple(F, WSP(const bf16, WS_H), D, WSP(const bf16, WS_WIN) + (size_t)NW1 * D, D, D, rows_out, NGATE, E, RowsId()); }
        GRID_BAR();
        { EpiUp E{WSP(const bf16, WS_GATES), WSP(bf16, WS_H)};
          gemm_simple(F, WSP(const bf16, WS_Y), D, WSP(const bf16, WS_WUP), D, D, rows_out, D, E, RowsId()); }
        GRID_BAR();
        { EpiResid E{last ? outp(F) : inp(F, I_X), last ? WSP(const float, WS_XC) : inp(F, I_CTX), outp(F), WSP(float, WS_XC), modbase, 2};
          gemm_simple(F, WSP(const bf16, WS_H), D, WSP(const bf16, WS_WOUT), D, D, rows_out, D, E, RowsId()); }
        GRID_BAR();
        if (!last) {
            phase_norm(F, layer, rows_out, false, 3);
            { const int gw = F.wg * NWAVES + F.wave, NGW = F.G * NWAVES; LAS float* scr = (LAS float*)(F.lds + F.wave * 8704);
              conv_weights_ffn(inp(F, I_FW1), inp(F, I_FW3), inp(F, I_FW2), WSP(bf16, WS_W13), WSP(bf16, WS_W2), gw, NGW, scr, F.lane);
              conv_weights_win(F, 1, gw, NGW, scr);
              conv_weights_upout(F, 1, gw, NGW, scr); }
            GRID_BAR();
            { EpiSwiglu E{WSP(bf16, WS_ACT), 0};
              gemm_simple(F, WSP(const bf16, WS_H), D, WSP(const bf16, WS_W13), D, D, rows_out, NFF1, E, RowsId()); }
            GRID_BAR();
            { EpiResid E{outp(F), WSP(const float, WS_XC), outp(F), WSP(float, WS_XC), modbase, 5};
              gemm_simple(F, WSP(const bf16, WS_ACT), DFF, WSP(const bf16, WS_W2), DFF, DFF, rows_out, D, E, RowsId()); }
            GRID_BAR();
        }
    }
    phase_norm_router(F);
    { const int gw = F.wg * NWAVES + F.wave, NGW = F.G * NWAVES; LAS float* scr = (LAS float*)(F.lds + F.wave * 8704);
#pragma unroll 1
      for (int e = 0; e < NE; ++e)
          conv_weights_ffn(inp(F, I_MW1) + (size_t)e * D * DFF, inp(F, I_MW3) + (size_t)e * D * DFF, inp(F, I_MW2) + (size_t)e * DFF * D,
                           WSP(bf16, WS_MW13) + (size_t)e * NFF1 * D, WSP(bf16, WS_MW2) + (size_t)e * D * DFF, gw, NGW, scr, F.lane); }
    GRID_BAR();
    phase_route_tables(F);
    GRID_BAR();
    const int ntiles = WSP(const int, WS_TILEE)[MAXTILES];
#pragma unroll 1
    for (int p = 0; p < NPASS; ++p) {
        const int t0 = p * PASS_TILES, t1 = min(ntiles, t0 + PASS_TILES);
        if (t0 < t1) moe_pass_gemm1(F, t0, t1);
        GRID_BAR();
        if (t0 < t1) moe_pass_gemm2(F, t0, t1);
        GRID_BAR();
    }
    phase_final(F);
}

extern "C" void kernel_launch(void* const* d_in, const int* in_sizes, int n_in, void* d_out, int out_size, void* d_ws, size_t ws_size, hipStream_t stream) {
    static int grid = 0;
    if (grid == 0) {
        if (n_in != 32 || out_size != TOKL * D || ws_size < WS_END) { fprintf(stderr, "kernel_launch: unexpected arguments (n_in %d, out %d, ws %zu)\n", n_in, out_size, ws_size); grid = -1; return; }
        int dev = 0, cus = 0;
        if (hipGetDevice(&dev) != hipSuccess || hipDeviceGetAttribute(&cus, hipDeviceAttributeMultiprocessorCount, dev) != hipSuccess) { grid = -1; return; }
        if (hipFuncSetAttribute((const void*)hybrid_fwd, hipFuncAttributeMaxDynamicSharedMemorySize, LDS_BYTES) != hipSuccess) { grid = -1; return; }
        int per_cu = 0;
        (void)hipOccupancyMaxActiveBlocksPerMultiprocessor(&per_cu, (const void*)hybrid_fwd, NTHR, LDS_BYTES);
        (void)hipGetLastError();
        grid = cus;
    }
    if (grid < 0) return;
    (void)hipMemsetAsync((char*)d_ws + WS_CTL, 0, CTL_ZERO_BYTES, stream);
    Params p{};
    for (int i = 0; i < 32; ++i) p.in[i] = (const float*)d_in[i];
    p.out = (float*)d_out; p.ws = (unsigned char*)d_ws;
    hipLaunchKernelGGL(hybrid_fwd, dim3(grid), dim3(NTHR), LDS_BYTES, stream, p);
}
```

```cpp
#include <hip/hip_runtime.h>
#include <stdint.h>
#include <stdio.h>

#define LAS __attribute__((address_space(3)))
typedef unsigned short bf16;
typedef short bf16x8 __attribute__((ext_vector_type(8)));
typedef float f32x4 __attribute__((ext_vector_type(4)));
typedef unsigned u32x4 __attribute__((ext_vector_type(4)));
typedef unsigned u32x2 __attribute__((ext_vector_type(2)));

constexpr int D = 1024, NB = 16, LL = 2048, LC = 256;
constexpr int TOKL = NB * LL, TOKC = NB * LC, TOK = TOKL + TOKC;
constexpr int HYW = 384, RETW = 384, MLW = 256;
constexpr int NIN = 6800, NW1 = 3840, NGATE = 3072, NWP = 6912;
constexpr int DFF = 2816, NFF1 = 5632, NE = 8;
constexpr int NWAVES = 8, NTHR = 512;
constexpr int MAXTILES = 272, PASS_TILES = 64, NPASS = 5;

constexpr size_t MiB = 1u << 20;
constexpr size_t WS_CTL = 0, CTL_ZERO_BYTES = 1 * MiB;
constexpr size_t WS_MOD = 1 * MiB;
constexpr size_t WS_BIAS = 2 * MiB;
constexpr size_t WS_ROPE = 2 * MiB + 256 * 1024;
constexpr size_t WS_TOPE = 3 * MiB;
constexpr size_t WS_TOPW = 3 * MiB + 256 * 1024;
constexpr size_t WS_TOPP = 3 * MiB + 512 * 1024;
constexpr size_t WS_SLOT = 3 * MiB + 768 * 1024;
constexpr size_t WS_ROWIDX = 4 * MiB;
constexpr size_t WS_TILEE = 4 * MiB + 512 * 1024;
constexpr size_t WS_FTL = 5 * MiB;
constexpr size_t WS_FTC = 17 * MiB;
constexpr size_t WS_WIN = 18 * MiB;
constexpr size_t WS_WUP = 32 * MiB;
constexpr size_t WS_WOUT = 34 * MiB;
constexpr size_t WS_XC = 36 * MiB;
constexpr size_t WS_H = 52 * MiB;
constexpr size_t WS_Y = 124 * MiB;
constexpr size_t WS_U = 196 * MiB;
constexpr size_t WS_RET = WS_U;
constexpr size_t WS_ML = WS_U + 108 * MiB;
constexpr size_t WS_MLG = WS_U + 180 * MiB;
constexpr size_t WS_OB = WS_U + 183 * MiB;
constexpr size_t WS_YHTL = WS_U + 228 * MiB;
constexpr size_t WS_YHTC = WS_U + 252 * MiB;
constexpr size_t WS_HYTL = WS_U + 255 * MiB;
constexpr size_t WS_HYTC = WS_U + 327 * MiB;
constexpr size_t WS_END = WS_U + 336 * MiB;
constexpr size_t WS_GATES = WS_U;
constexpr size_t WS_ACT = WS_U;
constexpr size_t WS_W13 = WS_U + 204 * MiB;
constexpr size_t WS_W2 = WS_U + 216 * MiB;
constexpr size_t WS_MW13 = WS_Y;
constexpr size_t WS_MW2 = WS_Y + 88 * MiB;
constexpr size_t WS_MACT = WS_Y + 132 * MiB;
constexpr size_t WS_EOUT = WS_Y + 220 * MiB;
static_assert(WS_EOUT + (size_t)MAXTILES * 256 * 1024 * 2 <= WS_END, "map");
static_assert(WS_GATES + (size_t)TOK * NGATE * 2 <= WS_YHTL, "gates overlay");

constexpr int CW_BAR = 4096;
constexpr int CW_CNT = 16384;

constexpr int LDS_BYTES = 147456;
constexpr int MISC_OFF = 147456 - 256;

__device__ __forceinline__ float bf2f(bf16 b) { return __uint_as_float(((unsigned)b) << 16); }
__device__ __forceinline__ unsigned f2bf(float f) { unsigned u = __float_as_uint(f); return (u + 0x7fffu + ((u >> 16) & 1u)) >> 16; }
__device__ __forceinline__ unsigned pk2(float lo, float hi) { return f2bf(lo) | (f2bf(hi) << 16); }
__device__ __forceinline__ float wave_sum(float v) {
#pragma unroll
    for (int o = 1; o < 64; o <<= 1) v += __shfl_xor(v, o);
    return v;
}
__device__ __forceinline__ float sigmoidf_(float x) { return 1.0f / (1.0f + __expf(-x)); }
__device__ __forceinline__ float siluf_(float x) { return x / (1.0f + __expf(-x)); }

#define XB_TMO      128
#define XB_XCNT(j)  (256  + 64 * (j))
#define XB_XSUB(j)  (1280 + 64 * (j))
#define XB_XGEN(j)  (2304 + 64 * (j))
#define XB_TOP      3328
#define XB_TOPGEN   3392
#define XCD_BAR_WORDS 3456
#define XB_SPIN_CAP (1u << 22)
__device__ __forceinline__ unsigned xb_ld(unsigned* p)              { return __hip_atomic_load(p, __ATOMIC_RELAXED, __HIP_MEMORY_SCOPE_AGENT); }
__device__ __forceinline__ unsigned xb_add(unsigned* p, unsigned v) { return __hip_atomic_fetch_add(p, v, __ATOMIC_RELAXED, __HIP_MEMORY_SCOPE_AGENT); }
__device__ __forceinline__ unsigned xb_xcc_id() { return (unsigned)__builtin_amdgcn_s_getreg((3 << 11) | 20) & 0xFu; }
#define XB_SPIN(cond, bar) do { unsigned _sp = 0; while (cond) { __builtin_amdgcn_s_sleep(1); \
    if ((++_sp & 255u) == 0u) { if (xb_ld(&(bar)[XB_TMO])) break; if (_sp > XB_SPIN_CAP) { atomicAdd(&(bar)[XB_TMO], 1u); break; } } } } while (0)
struct XcdBarrier { unsigned* bar; unsigned x; volatile LAS unsigned* st; };
__device__ __forceinline__ XcdBarrier xcd_barrier_post(unsigned* bar, volatile LAS unsigned* st) {
    XcdBarrier b; b.bar = bar; b.x = xb_xcc_id(); b.st = st;
    if (threadIdx.x == 0) (void)xb_add(&bar[XB_XCNT(b.x)], 1u);
    return b;
}
__device__ __forceinline__ void xcd_barrier_complete(unsigned* bar, unsigned x, unsigned& nloc, unsigned& nx) {
    const unsigned G = gridDim.x * gridDim.y * gridDim.z;
    unsigned sum, cnt, mine, sp = 0u;
    for (;;) {
        sum = 0u; cnt = 0u; mine = 0u;
#pragma unroll 1
        for (unsigned j = 0; j < 16; ++j) { const unsigned c = xb_ld(&bar[XB_XCNT(j)]); sum += c; cnt += (c > 0u) ? 1u : 0u; }
        mine = xb_ld(&bar[XB_XCNT(x)]);
        if (sum == G) break;
        __builtin_amdgcn_s_sleep(1);
        if ((++sp & 255u) == 0u) { if (xb_ld(&bar[XB_TMO])) break; if (sp > XB_SPIN_CAP) { atomicAdd(&bar[XB_TMO], 1u); break; } }
    }
    nloc = mine > 0u ? mine : 1u; nx = cnt > 0u ? cnt : 1u;
}
__device__ __forceinline__ void xcd_barrier(const XcdBarrier& b) {
    asm volatile("s_waitcnt vmcnt(0)" ::: "memory");
    __syncthreads();
    if (threadIdx.x == 0) {
        unsigned* bar = b.bar;
        __builtin_amdgcn_s_waitcnt(0);
        unsigned nloc = b.st[0], nx = b.st[1];
        if (nloc == 0u) { xcd_barrier_complete(bar, b.x, nloc, nx); b.st[0] = nloc; b.st[1] = nx; }
        const unsigned old = xb_add(&bar[XB_XSUB(b.x)], 1u);
        const unsigned gen = old / nloc;
        if (old + 1u == (gen + 1u) * nloc) {
            __builtin_amdgcn_fence(__ATOMIC_RELEASE, "agent");
            asm volatile("s_waitcnt vmcnt(0)" ::: "memory");
            const unsigned og = xb_add(&bar[XB_TOP], 1u);
            const unsigned tg = og / nx;
            if (og + 1u == (tg + 1u) * nx) xb_add(&bar[XB_TOPGEN], 1u);
            else XB_SPIN(xb_ld(&bar[XB_TOPGEN]) == tg, bar);
            __builtin_amdgcn_fence(__ATOMIC_ACQUIRE, "agent");
            xb_add(&bar[XB_XGEN(b.x)], 1u);
            asm volatile("s_waitcnt vmcnt(0)" ::: "memory");
        } else {
            XB_SPIN(xb_ld(&bar[XB_XGEN(b.x)]) == gen, bar);
            __builtin_amdgcn_fence(__ATOMIC_ACQUIRE, "agent");
            asm volatile("s_waitcnt vmcnt(0)" ::: "memory");
        }
    }
    __syncthreads();
}

struct Params { const float* in[32]; float* out; unsigned char* ws; };
enum { I_X = 0, I_C, I_CTX, I_CCTX, I_WMOD, I_BMOD, I_GMIX, I_GFFN, I_WIN, I_BIN, I_HYCONV, I_HYF1, I_HYFB1, I_HYF2, I_HYFB2, I_HYF3, I_HYDECAY,
       I_HYSKIP, I_RETDECAY, I_MLCONV, I_MLGB, I_WUP, I_WOUT, I_FW1, I_FW3, I_FW2, I_ROUTER, I_ROUTERB, I_MW1, I_MW3, I_MW2, I_GFINAL };

struct Frame {
    LAS unsigned char* lds;
    unsigned char* ws;
    int tid, lane, wave, G, wg;
};
#define WSP(T, off) ((T*)(F.ws + (off)))
constexpr int PTAB_OFF = 147456 - 1024;
__device__ __forceinline__ const float* inp(const Frame& F, int i) {
    const LAS unsigned* t = (const LAS unsigned*)(F.lds + PTAB_OFF) + 2 * i;
    const unsigned lo = __builtin_amdgcn_readfirstlane(t[0]), hi = __builtin_amdgcn_readfirstlane(t[1]);
    return (const float*)(((unsigned long long)hi << 32) | lo);
}
__device__ __forceinline__ float* outp(const Frame& F) { return (float*)inp(F, 32); }

__device__ __forceinline__ int row_batch(int row) { return row < TOKL ? (row >> 11) : ((row - TOKL) >> 8); }
__device__ __forceinline__ const float* mod_ptr(const Frame& F, int layer, int row, int which) {
    const int r = row < TOKL ? (row >> 11) : 16;
    return WSP(const float, WS_MOD) + ((size_t)(layer * 17 + r) * 6 + which) * 1024;
}

template <class RowMap>
__device__ __forceinline__ void tr_item(const float* W, int K, int N, bf16* WT, int ldT, RowMap rm, LAS float* scr, int item, int lane) {
    const int nblk = (N + 31) / 32, kb = item / nblk, nb = item % nblk, k0 = 64 * kb, n0 = 32 * nb;
#pragma unroll 8
    for (int i = 0; i < 32; ++i) { const int kk = 2 * i + (lane >> 5); const int n = n0 + (lane & 31); scr[kk * 33 + (lane & 31)] = (n < N) ? W[(size_t)(k0 + kk) * N + n] : 0.f; }
    asm volatile("s_waitcnt lgkmcnt(0)" ::: "memory");
    const int c = lane & 7;
#pragma unroll
    for (int j = 0; j < 4; ++j) { const int nl = (lane >> 3) + 8 * j; const int n = n0 + nl; const LAS float* s = scr + (8 * c) * 33 + nl;
        u32x4 o; o.x = pk2(s[0 * 33], s[1 * 33]); o.y = pk2(s[2 * 33], s[3 * 33]); o.z = pk2(s[4 * 33], s[5 * 33]); o.w = pk2(s[6 * 33], s[7 * 33]);
        if (n < N) *(u32x4*)(WT + (size_t)rm(n) * ldT + k0 + 8 * c) = o; }
    asm volatile("s_waitcnt lgkmcnt(0)" ::: "memory");
}
struct RmId { __device__ __forceinline__ int operator()(int n) const { return n; } };
__device__ __forceinline__ int win_row(int n) {
    if (n < 1152) return n;
    if (n < 2688) return 1280 + (n - 1152);
    if (n < 3712) return 2816 + (n - 2688);
    if (n < 3728) return 1152 + (n - 3712);
    return 3840 + (n - 3728);
}
struct RmWin { __device__ __forceinline__ int operator()(int n) const { return win_row(n); } };
struct RmW1 { __device__ __forceinline__ int operator()(int n) const { return (n >> 4) * 32 + (n & 15); } };
struct RmW3 { __device__ __forceinline__ int operator()(int n) const { return (n >> 4) * 32 + 16 + (n & 15); } };

__device__ __forceinline__ void conv_weights_win(Frame& F, int layer, int gw, int NGW, LAS float* scr) {
    const float* W = inp(F, I_WIN) + (size_t)layer * D * NIN;
    const int items = (D / 64) * ((NIN + 31) / 32);
    for (int it = gw; it < items; it += NGW) tr_item(W, D, NIN, WSP(bf16, WS_WIN), D, RmWin(), scr, it, F.lane);
    bf16* wt = WSP(bf16, WS_WIN);
    for (int i = gw * 64 + F.lane; i < 112 * 1024 / 8; i += NGW * 64) *(u32x4*)(wt + (size_t)1168 * 1024 + (size_t)i * 8) = (u32x4){0u, 0u, 0u, 0u};
}
__device__ __forceinline__ void conv_weights_upout(Frame& F, int layer, int gw, int NGW, LAS float* scr) {
    const int items = (D / 64) * (D / 32);
    for (int it = gw; it < items; it += NGW) tr_item(inp(F, I_WUP) + (size_t)layer * D * D, D, D, WSP(bf16, WS_WUP), D, RmId(), scr, it, F.lane);
    for (int it = gw; it < items; it += NGW) tr_item(inp(F, I_WOUT) + (size_t)layer * D * D, D, D, WSP(bf16, WS_WOUT), D, RmId(), scr, it, F.lane);
}
__device__ __forceinline__ void conv_weights_ffn(const float* w1, const float* w3, const float* w2, bf16* w13t, bf16* w2t, int gw, int NGW, LAS float* scr, int lane) {
    const int i1 = (D / 64) * (DFF / 32), i2 = (DFF / 64) * (D / 32);
    for (int it = gw; it < i1; it += NGW) tr_item(w1, D, DFF, w13t, D, RmW1(), scr, it, lane);
    for (int it = gw; it < i1; it += NGW) tr_item(w3, D, DFF, w13t, D, RmW3(), scr, it, lane);
    for (int it = gw; it < i2; it += NGW) tr_item(w2, DFF, D, w2t, DFF, RmId(), scr, it, lane);
}

__device__ __forceinline__ void filter_item(Frame& F, int layer, int L, bf16* FT  , int pb, int ch, LAS float* tile  ) {
    const float* f1 = inp(F, I_HYF1) + layer * 33 * 64; const float* fb1 = inp(F, I_HYFB1) + layer * 64;
    const float* f2 = inp(F, I_HYF2) + layer * 64 * 64; const float* fb2 = inp(F, I_HYFB2) + layer * 64;
    const float* f3 = inp(F, I_HYF3) + (size_t)layer * 64 * 1536; const float* dec = inp(F, I_HYDECAY) + layer * 1536;
    const int lane = F.lane, n = ch * 64 + lane;
    const float b1 = fb1[lane], b2 = fb2[lane], adec = fabsf(dec[n]);
    for (int pl = 0; pl < 64; ++pl) {
        const int pos = pb * 64 + pl;
        const float t = (float)pos / (float)(L - 1);
        const float w = 6.283185307179586f * (float)pos / (float)L;
        float feat = 0.f;
        if (lane == 0) feat = t;
        else if (lane < 17) { const float band = 1e-4f + (float)(lane - 1) * ((15.0f - 1e-4f) / 15.0f); feat = cosf(w * band); }
        else if (lane < 33) { const float band = 1e-4f + (float)(lane - 17) * ((15.0f - 1e-4f) / 15.0f); feat = -sinf(w * band); }
        float a1 = b1;
        for (int i = 0; i < 33; ++i) a1 += __shfl(feat, i) * f1[i * 64 + lane];
        const float h1 = sinf(a1);
        float a2 = b2;
        for (int i = 0; i < 64; ++i) a2 += __shfl(h1, i) * f2[i * 64 + lane];
        const float h2 = sinf(a2);
        float a3 = 0.f;
        for (int i = 0; i < 64; ++i) a3 += __shfl(h2, i) * f3[i * 1536 + n];
        tile[pl * 65 + lane] = a3 * expf(-t * adec);
    }
    asm volatile("s_waitcnt lgkmcnt(0)" ::: "memory");
    const int pos = pb * 64 + lane;
    for (int cl = 0; cl < 64; ++cl) {
        const int nn = ch * 64 + cl, o = nn / 768, dir = (nn / 384) & 1, c = nn % 384;
        bf16* dst = FT + (size_t)(o * 384 + c) * (2 * L);
        const float v = tile[lane * 65 + cl];
        if (dir == 0) dst[L - pos] = (bf16)f2bf(v);
        else if (pos > 0) dst[L + pos] = (bf16)f2bf(v);
    }
    asm volatile("s_waitcnt lgkmcnt(0)" ::: "memory");
}

__device__ __forceinline__ void phase_p0(Frame& F) {
    const int gw = F.wg * NWAVES + F.wave, NGW = F.G * NWAVES;
    LAS float* sl = (LAS float*)F.lds;
    LAS float* red = (LAS float*)(F.lds + 17 * 4096);
    for (int i = F.tid; i < 17 * 1024; i += NTHR) { const int r = i >> 10, k = i & 1023; const float v = r < 16 ? inp(F, I_C)[r * 1024 + k] : inp(F, I_CCTX)[k]; sl[i] = siluf_(v); }
    __syncthreads();
    for (int item = F.wg; item < 2 * 384; item += F.G) {
        const int layer = item / 384, n0 = (item % 384) * 16, j = F.tid & 15, kp = F.tid >> 4;
        const float* W = inp(F, I_WMOD) + (size_t)layer * D * 6144;
        float acc[17];
#pragma unroll
        for (int r = 0; r < 17; ++r) acc[r] = 0.f;
        for (int k = kp * 32; k < kp * 32 + 32; ++k) { const float w = W[(size_t)k * 6144 + n0 + j];
#pragma unroll
            for (int r = 0; r < 17; ++r) acc[r] += sl[r * 1024 + k] * w; }
#pragma unroll
        for (int r = 0; r < 17; ++r) red[(kp * 17 + r) * 16 + j] = acc[r];
        __syncthreads();
        if (F.tid < 272) { const int r = F.tid >> 4, jj = F.tid & 15; float s = inp(F, I_BMOD)[layer * 6144 + n0 + jj];
            for (int q = 0; q < 32; ++q) s += red[(q * 17 + r) * 16 + jj];
            WSP(float, WS_MOD)[(size_t)(layer * 17 + r) * 6144 + n0 + jj] = s; }
        __syncthreads();
    }
    __syncthreads();
    LAS float* scr = (LAS float*)(F.lds + F.wave * 8704);
    conv_weights_win(F, 0, gw, NGW, scr);
    conv_weights_upout(F, 0, gw, NGW, scr);
    for (int i = gw * 64 + F.lane; i < 2048 * 32; i += NGW * 64) {
        const int t = i >> 5, j = i & 31, half = j >> 4, ii = j & 15;
        const float inv = 1.0f / powf(10000.0f, (float)ii / 16.0f);
        const float ang = (float)(half == 0 ? (t >> 6) : (t & 63)) * inv;
        WSP(float, WS_ROPE)[t * 64 + half * 32 + ii] = cosf(ang);
        WSP(float, WS_ROPE)[t * 64 + half * 32 + 16 + ii] = sinf(ang);
    }
    __syncthreads();
    LAS float* ftile = (LAS float*)(F.lds + F.wave * 16640);
    for (int it = gw; it < 1536 + 96; it += NGW) {
        if (it < 1536) { const int layer = it / 768, r = it % 768; filter_item(F, layer, LL, WSP(bf16, WS_FTL) + (size_t)layer * 2 * 384 * 4096, r / 24, r % 24, ftile); }
        else { const int r = it - 1536; filter_item(F, 0, LC, WSP(bf16, WS_FTC), r / 24, r % 24, ftile); }
    }
}
__device__ __forceinline__ void write_bias(Frame& F) {
    const int gt = (F.wg * NWAVES + F.wave) * 64 + F.lane, NGT = F.G * NTHR;
    for (int i = gt; i < 2 * NWP; i += NGT) {
        const int l = i / NWP, r = i % NWP; float v = 0.f;
        int n = -1;
        if (r < 1152) n = r; else if (r < 1168) n = 3712 + (r - 1152); else if (r < 1280) n = -1; else if (r < 2816) n = 1152 + (r - 1280); else if (r < 3840) n = 2688 + (r - 2816); else n = 3728 + (r - 3840);
        if (n >= 0) v = inp(F, I_BIN)[l * NIN + n];
        WSP(float, WS_BIAS)[i] = v;
    }
}

__device__ __forceinline__ void norm_mod_row(const float* xrow, const float* g, const float* shift, const float* scale, bf16* orow, int lane, float* keep  ) {
    f32x4 v[4]; float s = 0.f;
#pragma unroll
    for (int j = 0; j < 4; ++j) { v[j] = *(const f32x4*)(xrow + 256 * j + 4 * lane); s += (v[j].x * v[j].x + v[j].y * v[j].y) + (v[j].z * v[j].z + v[j].w * v[j].w); }
    const float r = rsqrtf(wave_sum(s) * (1.0f / 1024.0f) + 1e-6f);
#pragma unroll
    for (int j = 0; j < 4; ++j) {
        const f32x4 gg = *(const f32x4*)(g + 256 * j + 4 * lane), sh = *(const f32x4*)(shift + 256 * j + 4 * lane), sc = *(const f32x4*)(scale + 256 * j + 4 * lane);
        f32x4 o;
        o.x = (v[j].x * r * gg.x) * (1.f + sc.x) + sh.x; o.y = (v[j].y * r * gg.y) * (1.f + sc.y) + sh.y;
        o.z = (v[j].z * r * gg.z) * (1.f + sc.z) + sh.z; o.w = (v[j].w * r * gg.w) * (1.f + sc.w) + sh.w;
        if (keep) { keep[4 * j + 0] = o.x; keep[4 * j + 1] = o.y; keep[4 * j + 2] = o.z; keep[4 * j + 3] = o.w; }
        u32x2 w; w.x = pk2(o.x, o.y); w.y = pk2(o.z, o.w);
        *(u32x2*)(orow + 256 * j + 4 * lane) = w;
    }
}
__device__ __forceinline__ const float* xrow_ptr(const Frame& F, int row, bool from_input) {
    if (row < TOKL) return (from_input ? inp(F, I_X) : outp(F)) + (size_t)row * D;
    return (from_input ? inp(F, I_CTX) : WSP(const float, WS_XC)) + (size_t)(row - TOKL) * D;
}
__device__ __forceinline__ void phase_norm(Frame& F, int layer, int nrows, bool from_input, int which) {
    const int gw = F.wg * NWAVES + F.wave, NGW = F.G * NWAVES;
    const float* g = inp(F, which == 0 ? I_GMIX : I_GFFN) + layer * D;
    for (int row = gw; row < nrows; row += NGW)
        norm_mod_row(xrow_ptr(F, row, from_input), g, mod_ptr(F, layer, row, which), mod_ptr(F, layer, row, which + 1), WSP(bf16, WS_H) + (size_t)row * D, F.lane, nullptr);
}

struct RowsId { __device__ __forceinline__ int operator()(int r) const { return r; } };
struct RowsGather { const int* idx; __device__ __forceinline__ int operator()(int r) const { return idx[r]; } };
template <class Epi, class Rows>
__device__ __forceinline__ void gemm_simple_tile(const bf16* A, int lda, const bf16* Bt, int ldb, int K, int rt, int ct, const Epi& E, const Rows& R, int lane) {
    const int fr = lane & 15, fq = lane >> 4;
    f32x4 acc[4][4];
#pragma unroll
    for (int mi = 0; mi < 4; ++mi)
#pragma unroll
        for (int ni = 0; ni < 4; ++ni) acc[mi][ni] = (f32x4){0.f, 0.f, 0.f, 0.f};
    const bf16* ap[4]; const bf16* bp[4];
#pragma unroll
    for (int mi = 0; mi < 4; ++mi) ap[mi] = A + (size_t)R(rt * 64 + mi * 16 + fr) * lda + fq * 8;
#pragma unroll
    for (int ni = 0; ni < 4; ++ni) bp[ni] = Bt + (size_t)(ct * 64 + ni * 16 + fr) * ldb + fq * 8;
#pragma unroll 1
    for (int k0 = 0; k0 < K; k0 += 32) {
        if constexpr (Epi::HORNER) {
            if (k0 == 384 || k0 == 768) {
                const int seg = (k0 == 384) ? 0 : 1;
#pragma unroll
                for (int mi = 0; mi < 4; ++mi)
#pragma unroll
                    for (int ni = 0; ni < 4; ++ni) acc[mi][ni] = E.rescale(seg, rt * 64 + mi * 16 + fr, ct * 64 + ni * 16 + 4 * fq, acc[mi][ni]);
            }
        }
        bf16x8 a[4], b[4];
#pragma unroll
        for (int mi = 0; mi < 4; ++mi) a[mi] = *(const bf16x8*)(ap[mi] + k0);
#pragma unroll
        for (int ni = 0; ni < 4; ++ni) b[ni] = *(const bf16x8*)(bp[ni] + k0);
#pragma unroll
        for (int mi = 0; mi < 4; ++mi)
#pragma unroll
            for (int ni = 0; ni < 4; ++ni) acc[mi][ni] = __builtin_amdgcn_mfma_f32_16x16x32_bf16(b[ni], a[mi], acc[mi][ni], 0, 0, 0);
    }
#pragma unroll
    for (int mi = 0; mi < 4; ++mi) {
        const int r = rt * 64 + mi * 16 + fr;
        if constexpr (Epi::PAIR) {
#pragma unroll
            for (int ni = 0; ni < 4; ni += 2) E.store_pair(r, ct * 32 + (ni >> 1) * 16 + 4 * fq, acc[mi][ni], acc[mi][ni + 1]);
        } else {
#pragma unroll
            for (int ni = 0; ni < 4; ++ni) E.store(r, ct * 64 + ni * 16 + 4 * fq, acc[mi][ni]);
        }
    }
}
template <class Epi, class Rows>
__device__ __forceinline__ void gemm_simple(Frame& F, const bf16* A, int lda, const bf16* Bt, int ldb, int K, int M, int N, const Epi& E, const Rows& R) {
    const int gw = F.wg * NWAVES + F.wave, NGW = F.G * NWAVES;
    const int nct = N / 64, nrt = M / 64;
    for (int u = gw; u < nct * nrt; u += NGW) gemm_simple_tile(A, lda, Bt, ldb, K, u / nct, u % nct, E, R, F.lane);
}

namespace pg8 {
constexpr int BM = 256, BK = 64, HALF = 128, HTB = HALF * BK * 2, STAGE_BYTES = 8 * HTB, NXCD = 8, WGM = 8;
__device__ __forceinline__ int lds_byte(int r, int c) { const int st = (r >> 4) * 2 + (c >> 5), rr = r & 15, cc = c & 31, ob = rr * 64 + cc * 2; return st * 1024 + (ob ^ (((ob >> 9) & 1) << 5)); }
__device__ __forceinline__ void stage_rc(int b, int& R, int& C) { const int st = b / 1024, sb = b % 1024, swz = sb ^ (((sb >> 9) & 1) << 5); R = (st >> 1) * 16 + swz / 64; C = (st & 1) * 32 + (swz % 64) / 2; }
struct Unit { int pm, pn; };
struct OrderPlain {
    static constexpr bool GATHER = false;
    int nM, nN, nwg, G, c;
    __device__ __forceinline__ void init(int nM_, int nN_, int G_, int c_) { nM = nM_; nN = nN_; nwg = nM * nN; G = G_; c = c_; }
    __device__ __forceinline__ bool next(int i, Unit& u) const {
        const long L = (long)i * G + c; if (L >= nwg) return false;
        int wgid = (int)L; { const int q = nwg / NXCD, r = nwg % NXCD, xcd = wgid % NXCD, off = wgid / NXCD; wgid = (xcd < r ? xcd * (q + 1) : r * (q + 1) + (xcd - r) * q) + off; }
        const int nig = WGM * nN, gid = wgid / nig, fm = gid * WGM, gsz = (nM - fm) < WGM ? (nM - fm) : WGM;
        u.pm = fm + ((wgid % nig) % gsz); u.pn = (wgid % nig) / gsz; return true;
    }
    __device__ __forceinline__ int arow(int r) const { return r; }
    __device__ __forceinline__ size_t boff(const Unit&) const { return 0; }
};
struct OrderMoe {
    static constexpr bool GATHER = true;
    OrderPlain o; const int* rowidx; const int* tilee; int t0; size_t bstride; bool gather;
    __device__ __forceinline__ bool next(int i, Unit& u) const { return o.next(i, u); }
    __device__ __forceinline__ int arow(int r) const { return gather ? rowidx[t0 * 256 + r] : r; }
    __device__ __forceinline__ size_t boff(const Unit& u) const { return (size_t)tilee[t0 + u.pm] * bstride; }
};

template <class Epi, class Sched>
__device__ __forceinline__ void gemm_phase(LAS unsigned char* lds, const bf16* A, int lda, const bf16* Bt, int ldb, int K, const Sched& S, const Epi& E) {
    unsigned tid_u = threadIdx.x; asm volatile("" : "+v"(tid_u));
    const int tid = (int)tid_u, wid = __builtin_amdgcn_readfirstlane(tid >> 6), lane = tid & 63, wr = wid >> 2, wc = wid & 3, fr = lane & 15, fq = lane >> 4;
    const int nt = K / BK;
    unsigned voffB[2];
    { int sR[2], sC[2];
#pragma unroll
      for (int i = 0; i < 2; ++i) { stage_rc(tid * 16 + i * 8192, sR[i], sC[i]); voffB[i] = (unsigned)(sR[i] * ldb + sC[i]) * 2u; } }
#define PG8_GATHER_OFFS(pm_) do { unsigned _t = (unsigned)tid; asm volatile("" : "+v"(_t)); _Pragma("unroll") for (int i = 0; i < 2; ++i) { int _R, _C; stage_rc((int)_t * 16 + i * 8192, _R, _C); \
        vc0[i] = (unsigned)((size_t)S.arow((pm_) * BM + _R) * lda + _C) * 2u; vc1[i] = (unsigned)((size_t)S.arow((pm_) * BM + HALF + _R) * lda + _C) * 2u; } } while (0)
    const size_t kstep = (size_t)(BK * 2);
    const size_t hstepB = (size_t)HALF * ldb * 2, tstepB = 2 * hstepB;
    const unsigned ldsw = (unsigned)wid * 1024u;
    const int aoff = lds_byte(wr * 64 + fr, fq * 8), boff = lds_byte(wc * 32 + fr, fq * 8);
#define PG8_SA(b, h) (((b) * 2 + (h)) * HTB)
#define PG8_SB(b, h) ((4 + (b) * 2 + (h)) * HTB)
#define PG8_STAGE2(bufoff, gbase, v0, v1) do { \
        __builtin_amdgcn_global_load_lds((const unsigned*)((const char*)(gbase) + (v0)), (LAS unsigned*)(lds + (bufoff) + ldsw), 16, 0, 0); \
        __builtin_amdgcn_global_load_lds((const unsigned*)((const char*)(gbase) + (v1)), (LAS unsigned*)(lds + (bufoff) + ldsw + 8192), 16, 0, 0); } while (0)
#define PG8_STAGEB(bufoff, gbase) PG8_STAGE2(bufoff, gbase, voffB[0], voffB[1])
#define PG8_LDA(dst, b, h) do { _Pragma("unroll") for (int m = 0; m < 4; ++m) _Pragma("unroll") for (int k = 0; k < 2; ++k) dst[m][k] = *(const LAS bf16x8*)(lds + PG8_SA(b, h) + aoff + m * 2048 + k * 1024); } while (0)
#define PG8_LDB(dst, b, h) do { _Pragma("unroll") for (int n = 0; n < 2; ++n) _Pragma("unroll") for (int k = 0; k < 2; ++k) dst[n][k] = *(const LAS bf16x8*)(lds + PG8_SB(b, h) + boff + n * 2048 + k * 1024); } while (0)
#define PG8_MMA(ai, bj, At, Bt_) do { __builtin_amdgcn_s_setprio(1); _Pragma("unroll") for (int m = 0; m < 4; ++m) _Pragma("unroll") for (int n = 0; n < 2; ++n) _Pragma("unroll") for (int k = 0; k < 2; ++k) \
        acc[ai][bj][m][n] = __builtin_amdgcn_mfma_f32_16x16x32_bf16(Bt_[n][k], At[m][k], acc[ai][bj][m][n], 0, 0, 0); __builtin_amdgcn_s_setprio(0); } while (0)
#define PG8_WAIT_V(n) asm volatile("s_waitcnt vmcnt(" #n ")" ::: "memory")
#define PG8_WAIT_L(n) asm volatile("s_waitcnt lgkmcnt(" #n ")" ::: "memory")
#define PG8_BAR __builtin_amdgcn_s_barrier()
#define PG8_SCHED __builtin_amdgcn_sched_barrier(0)
    Unit cur, nxt; int ui = 0;
    if (!S.next(0, cur)) return;
    f32x4 acc[2][2][4][2];
#pragma unroll
    for (int a = 0; a < 2; ++a)
#pragma unroll
        for (int b = 0; b < 2; ++b)
#pragma unroll
            for (int m = 0; m < 4; ++m)
#pragma unroll
                for (int n = 0; n < 2; ++n) acc[a][b][m][n] = (f32x4){0.f, 0.f, 0.f, 0.f};
    bf16x8 At[4][2], B0[2][2], B1[2][2];
    constexpr bool GA = Sched::GATHER;
    const size_t hstepA = GA ? 0 : (size_t)HALF * lda * 2, tstepA = (size_t)BM * lda * 2;
    unsigned vc0[2], vc1[2];
    if constexpr (GA) { PG8_GATHER_OFFS(cur.pm); }
    else { int sR, sC;
#pragma unroll
        for (int i = 0; i < 2; ++i) { stage_rc(tid * 16 + i * 8192, sR, sC); vc0[i] = (unsigned)(sR * lda + sC) * 2u; vc1[i] = 0u; } }
#define VC0(i) vc0[i]
#define VC1(i) (GA ? vc1[i] : vc0[i])
#define VN0(i) vc0[i]
#define VN1(i) VC1(i)
    const char* cA = GA ? (const char*)A : (const char*)A + (size_t)cur.pm * tstepA;
    const char* cB = (const char*)Bt + S.boff(cur) * 2 + (size_t)cur.pn * tstepB;
    PG8_STAGEB(PG8_SB(0, 0), cB); PG8_STAGE2(PG8_SA(0, 0), cA, VC0(0), VC0(1)); PG8_STAGEB(PG8_SB(0, 1), cB + hstepB); PG8_STAGE2(PG8_SA(0, 1), cA + hstepA, VC1(0), VC1(1));
    if (wr == 1) PG8_BAR;
    PG8_WAIT_V(4); PG8_BAR;
    PG8_STAGEB(PG8_SB(1, 0), cB + kstep); PG8_STAGE2(PG8_SA(1, 0), cA + kstep, VC0(0), VC0(1)); PG8_STAGEB(PG8_SB(1, 1), cB + hstepB + kstep);
    PG8_WAIT_V(6); PG8_BAR;
    for (;;) {
        const bool has_next = S.next(ui + 1, nxt);
        const char* nB = cB; const char* nA = cA;
        if (has_next) {
            nB = (const char*)Bt + S.boff(nxt) * 2 + (size_t)nxt.pn * tstepB;
            if constexpr (!GA) nA = (const char*)A + (size_t)nxt.pm * tstepA;
        }
        for (int t = 0; t < nt; t += 2) {
            const bool last = (t == nt - 2);
            if constexpr (Epi::HORNER) {
                if (t == 6 || t == 12) {
                    asm volatile("" ::: "memory");
                    const int seg = (t == 6) ? 0 : 1;
                    int hpm = cur.pm, hpn = cur.pn; asm volatile("" : "+s"(hpm), "+s"(hpn));
                    unsigned hln = (unsigned)lane; asm volatile("" : "+v"(hln)); const int hfr = (int)(hln & 15u), hfq = (int)(hln >> 4);
#pragma unroll
                    for (int ai = 0; ai < 2; ++ai)
#pragma unroll
                        for (int m = 0; m < 4; ++m) {
#pragma unroll
                            for (int bj = 0; bj < 2; ++bj)
#pragma unroll
                                for (int n = 0; n < 2; ++n)
                                    acc[ai][bj][m][n] = E.rescale(seg, hpm * BM + ai * HALF + wr * 64 + m * 16 + hfr, hpn * BM + bj * HALF + wc * 32 + n * 16 + 4 * hfq, acc[ai][bj][m][n]);
                            asm volatile("" : "+v"(acc[ai][0][m][0]), "+v"(acc[ai][0][m][1]), "+v"(acc[ai][1][m][0]), "+v"(acc[ai][1][m][1]) :: "memory");
                        }
                    asm volatile("s_waitcnt vmcnt(0)" ::: "memory");
                }
            }
            const char* a1 = cA + (size_t)(t + 1) * kstep;
            const char* a2 = last ? nA : cA + (size_t)(t + 2) * kstep; const char* b2 = last ? nB : cB + (size_t)(t + 2) * kstep;
            const char* a3 = a2 + kstep; const char* b3 = b2 + kstep;
            PG8_LDB(B0, 0, 0); PG8_SCHED; PG8_LDA(At, 0, 0); PG8_STAGE2(PG8_SA(1, 1), a1 + hstepA, VC1(0), VC1(1));
            if constexpr (GA) { if (last && has_next) { asm volatile("" ::: "memory"); PG8_GATHER_OFFS(nxt.pm); asm volatile("" ::: "memory"); } }
            PG8_WAIT_L(8); PG8_BAR; PG8_WAIT_L(0); PG8_MMA(0, 0, At, B0); PG8_BAR; PG8_SCHED;
            PG8_LDB(B1, 0, 1); PG8_STAGEB(PG8_SB(0, 0), b2);
            PG8_BAR; PG8_WAIT_L(0); PG8_MMA(0, 1, At, B1); PG8_BAR;
            PG8_LDA(At, 0, 1); PG8_STAGE2(PG8_SA(0, 0), a2, VN0(0), VN0(1));
            PG8_BAR; PG8_WAIT_L(0); PG8_MMA(1, 0, At, B0); PG8_BAR; PG8_SCHED;
            PG8_STAGEB(PG8_SB(0, 1), b2 + hstepB);
            PG8_WAIT_V(6); PG8_BAR; PG8_MMA(1, 1, At, B1); PG8_BAR;
            PG8_LDB(B0, 1, 0); PG8_SCHED; PG8_LDA(At, 1, 0); PG8_STAGE2(PG8_SA(0, 1), a2 + hstepA, VN1(0), VN1(1));
            PG8_WAIT_L(8); PG8_BAR; PG8_WAIT_L(0); PG8_MMA(0, 0, At, B0); PG8_BAR; PG8_SCHED;
            PG8_LDB(B1, 1, 1); PG8_STAGEB(PG8_SB(1, 0), b3);
            PG8_BAR; PG8_WAIT_L(0); PG8_MMA(0, 1, At, B1); PG8_BAR;
            PG8_LDA(At, 1, 1); PG8_STAGE2(PG8_SA(1, 0), a3, VN0(0), VN0(1));
            PG8_BAR; PG8_WAIT_L(0); PG8_MMA(1, 0, At, B0); PG8_BAR; PG8_SCHED;
            PG8_STAGEB(PG8_SB(1, 1), b3 + hstepB);
            PG8_WAIT_V(6); PG8_BAR; PG8_MMA(1, 1, At, B1); PG8_BAR;
        }
        {
            int epm = cur.pm, epn = cur.pn; asm volatile("" : "+s"(epm), "+s"(epn));
            unsigned eln = (unsigned)lane; asm volatile("" : "+v"(eln)); const int efr = (int)(eln & 15u), efq = (int)(eln >> 4);
#pragma unroll
            for (int ai = 0; ai < 2; ++ai)
#pragma unroll
                for (int m = 0; m < 4; ++m) {
                    const int row = epm * BM + ai * HALF + wr * 64 + m * 16 + efr;
#pragma unroll
                    for (int bj = 0; bj < 2; ++bj) {
                        if constexpr (Epi::PAIR) E.store_pair(row, epn * (BM / 2) + bj * (HALF / 2) + wc * 16 + 4 * efq, acc[ai][bj][m][0], acc[ai][bj][m][1]);
                        else {
#pragma unroll
                            for (int n = 0; n < 2; ++n) E.store(row, epn * BM + bj * HALF + wc * 32 + n * 16 + 4 * efq, acc[ai][bj][m][n]);
                        }
                    }
                }
        }
        if (!has_next) break;
#pragma unroll
        for (int a = 0; a < 2; ++a)
#pragma unroll
            for (int b = 0; b < 2; ++b)
#pragma unroll
                for (int m = 0; m < 4; ++m)
#pragma unroll
                    for (int n = 0; n < 2; ++n) acc[a][b][m][n] = (f32x4){0.f, 0.f, 0.f, 0.f};
        cur = nxt; cB = nB; cA = nA; ++ui;
    }
    PG8_WAIT_V(0);
    if (wr == 0) PG8_BAR;
    PG8_BAR;
#undef PG8_GATHER_OFFS
#undef VC0
#undef VC1
#undef VN0
#undef VN1
#undef PG8_SA
#undef PG8_SB
#undef PG8_STAGE2
#undef PG8_STAGEB
#undef PG8_LDA
#undef PG8_LDB
#undef PG8_MMA
#undef PG8_WAIT_V
#undef PG8_WAIT_L
#undef PG8_BAR
#undef PG8_SCHED
}
}

template <class Epi>
__device__ __forceinline__ void gemm_fast(Frame& F, const bf16* A, int lda, const bf16* Bt, int ldb, int K, int M, int N, const Epi& E) {
    pg8::OrderPlain S; S.init(M / 256, N / 256, F.G, F.wg);
    pg8::gemm_phase(F.lds, A, lda, Bt, ldb, K, S, E);
}
#ifndef FAST_PLAIN
#define FAST_PLAIN 1
#endif
#ifndef FAST_HORNER
#define FAST_HORNER 1
#endif
#ifndef FAST_MOE
#define FAST_MOE 1
#endif

__device__ __forceinline__ void st_bf16x4(bf16* p, f32x4 v) { u32x2 w; w.x = pk2(v.x, v.y); w.y = pk2(v.z, v.w); *(u32x2*)p = w; }
__device__ __forceinline__ f32x4 ld_bf16x4(const bf16* p) { const u32x2 w = *(const u32x2*)p; f32x4 v; v.x = __uint_as_float(w.x << 16); v.y = __uint_as_float(w.x & 0xffff0000u); v.z = __uint_as_float(w.y << 16); v.w = __uint_as_float(w.y & 0xffff0000u); return v; }

struct EpiWin {
    static constexpr bool HORNER = false, PAIR = false;
    const float* bias; bf16 *hytl, *hytc, *ret, *ml; float* mlg;
    __device__ __forceinline__ f32x4 rescale(int, int, int, f32x4 v) const { return v; }
    __device__ __forceinline__ void store(int row, int col, f32x4 v) const {
        v += *(const f32x4*)(bias + col);
        if (col < 1152) {
            if (row < TOKL) { const int b = row >> 11, t = row & 2047; bf16* d = hytl + ((size_t)(b * 1152 + col)) * 2048 + t;
                d[0] = (bf16)f2bf(v.x); d[2048] = (bf16)f2bf(v.y); d[4096] = (bf16)f2bf(v.z); d[6144] = (bf16)f2bf(v.w); }
            else { const int r = row - TOKL, b = r >> 8, t = r & 255; bf16* d = hytc + ((size_t)(b * 1152 + col)) * 256 + t;
                d[0] = (bf16)f2bf(v.x); d[256] = (bf16)f2bf(v.y); d[512] = (bf16)f2bf(v.z); d[768] = (bf16)f2bf(v.w); }
        } else if (col < 1168) { *(f32x4*)(mlg + (size_t)row * 16 + (col - 1152)) = v; }
        else if (col < 1280) { }
        else if (col < 2816) st_bf16x4(ret + (size_t)row * 1536 + (col - 1280), v);
        else st_bf16x4(ml + (size_t)row * 1024 + (col - 2816), v);
    }
};
struct EpiGate {
    static constexpr bool HORNER = false, PAIR = false;
    const float* bias; bf16* gates;
    __device__ __forceinline__ f32x4 rescale(int, int, int, f32x4 v) const { return v; }
    __device__ __forceinline__ void store(int row, int col, f32x4 v) const {
        v += *(const f32x4*)(bias + col);
        f32x4 g; g.x = fmaxf(sigmoidf_(v.x), 1e-20f); g.y = fmaxf(sigmoidf_(v.y), 1e-20f); g.z = fmaxf(sigmoidf_(v.z), 1e-20f); g.w = fmaxf(sigmoidf_(v.w), 1e-20f);
        st_bf16x4(gates + (size_t)row * NGATE + col, g);
    }
};
struct EpiUp {
    static constexpr bool HORNER = true, PAIR = false;
    const bf16* gates; bf16* acc_out;
    __device__ __forceinline__ f32x4 rescale(int seg, int row, int col, f32x4 v) const {
        const f32x4 a = ld_bf16x4(gates + (size_t)row * NGATE + seg * 1024 + col), b = ld_bf16x4(gates + (size_t)row * NGATE + (seg + 1) * 1024 + col);
        v.x *= a.x * __builtin_amdgcn_rcpf(b.x); v.y *= a.y * __builtin_amdgcn_rcpf(b.y); v.z *= a.z * __builtin_amdgcn_rcpf(b.z); v.w *= a.w * __builtin_amdgcn_rcpf(b.w); return v;
    }
    __device__ __forceinline__ void store(int row, int col, f32x4 v) const {
        const f32x4 g = ld_bf16x4(gates + (size_t)row * NGATE + 2048 + col);
        st_bf16x4(acc_out + (size_t)row * D + col, v * g);
    }
};
struct EpiResid {
    static constexpr bool HORNER = false, PAIR = false;
    const float *xin_l, *xin_c; float *xout_l, *xout_c; const float* modbase; int which;
    __device__ __forceinline__ f32x4 rescale(int, int, int, f32x4 v) const { return v; }
    __device__ __forceinline__ void store(int row, int col, f32x4 v) const {
        const int r = row < TOKL ? (row >> 11) : 16;
        const f32x4 m = *(const f32x4*)(modbase + ((size_t)r * 6 + which) * 1024 + col);
        if (row < TOKL) { const size_t o = (size_t)row * D + col; *(f32x4*)(xout_l + o) = *(const f32x4*)(xin_l + o) + m * v; }
        else { const size_t o = (size_t)(row - TOKL) * D + col; *(f32x4*)(xout_c + o) = *(const f32x4*)(xin_c + o) + m * v; }
    }
};
struct EpiSwiglu {
    static constexpr bool HORNER = false, PAIR = true;
    bf16* act; int row_off;
    __device__ __forceinline__ f32x4 rescale(int, int, int, f32x4 v) const { return v; }
    __device__ __forceinline__ void store_pair(int row, int col, f32x4 a, f32x4 b) const {
        f32x4 o; o.x = siluf_(a.x) * b.x; o.y = siluf_(a.y) * b.y; o.z = siluf_(a.z) * b.z; o.w = siluf_(a.w) * b.w;
        st_bf16x4(act + (size_t)(row - row_off) * DFF + col, o);
    }
};
struct EpiBf16Out {
    static constexpr bool HORNER = false, PAIR = false;
    bf16* out; int ld; int row_add;
    __device__ __forceinline__ f32x4 rescale(int, int, int, f32x4 v) const { return v; }
    __device__ __forceinline__ void store(int row, int col, f32x4 v) const { st_bf16x4(out + (size_t)(row + row_add) * ld + col, v); }
};

constexpr int ZPITCH_L = (LL + 8) * 2, ZPITCH_C = (LC + 8) * 2;
template <int L>
__device__ __forceinline__ float conv3_at(const bf16* base  , int t, float w0, float w1, float w2) {
    const float a = t > 0 ? bf2f(base[t - 1]) : 0.f, b = bf2f(base[t]), c = t < L - 1 ? bf2f(base[t + 1]) : 0.f;
    return w0 * a + w1 * b + w2 * c;
}
template <int L>
__device__ __forceinline__ void hyena_unit_naive(Frame& F, int layer, int c, const bf16* hyt  , const bf16* ft  , bf16* yht  ) {
    constexpr int ZP = (L + 8) * 2;
    constexpr int PER = L / 32;
    constexpr int SUB = 8;
    LAS unsigned char* zimg0 = F.lds;
    LAS unsigned char* zimg1 = F.lds + 16 * ZP;
    LAS bf16* tf = (LAS bf16*)(F.lds + 32 * ZP);
    const float* cw = inp(F, I_HYCONV) + layer * 3 * 1152;
    const float* skip = inp(F, I_HYSKIP) + layer * 2 * 384;
    __syncthreads();
    {
        const int b = F.tid >> 5, seg = F.tid & 31; const bf16* src = hyt + ((size_t)(b * 1152 + c)) * L;
        const float w0 = cw[c], w1 = cw[1152 + c], w2 = cw[2304 + c];
#pragma unroll 2
        for (int j = 0; j < PER; ++j) { const int t = seg * PER + j; *(LAS bf16*)(zimg0 + b * ZP + t * 2) = (bf16)f2bf(conv3_at<L>(src, t, w0, w1, w2)); }
    }
#pragma unroll 1
    for (int o = 0; o < 2; ++o) {
        LAS unsigned char* zs = o == 0 ? zimg0 : zimg1;
        LAS unsigned char* zd = o == 0 ? zimg1 : zimg0;
        const bf16* fsrc = ft + ((size_t)(o * 384 + c)) * (2 * L);
        for (int i = F.tid; i < 2 * L; i += NTHR) tf[i] = i == 0 ? (bf16)0 : fsrc[i];
        __syncthreads();
        const int b = F.tid & 15, tg = F.tid >> 4;
        const int gcol = (o == 0 ? 384 : 768) + c;
        const bf16* gsrc = hyt + ((size_t)(b * 1152 + gcol)) * L;
        const float w0 = cw[gcol], w1 = cw[1152 + gcol], w2 = cw[2304 + gcol], sk = skip[o * 384 + c];
#pragma unroll 1
        for (int sb = 0; sb < PER / SUB; ++sb) {
            const int t0 = tg * PER + sb * SUB;
            float acc[SUB];
#pragma unroll
            for (int j = 0; j < SUB; ++j) acc[j] = 0.f;
#pragma unroll 1
            for (int s0 = 0; s0 < L; s0 += 8) {
                float z[8];
                { const bf16x8 zz = *(const LAS bf16x8*)(zs + b * ZP + s0 * 2);
#pragma unroll
                  for (int i = 0; i < 8; ++i) z[i] = bf2f((bf16)zz[i]); }
                float win[SUB + 7];
                const int wb = L + s0 - t0 - (SUB - 1);
#pragma unroll
                for (int i = 0; i < SUB + 7; ++i) win[i] = bf2f(tf[wb + i]);
#pragma unroll
                for (int j = 0; j < SUB; ++j)
#pragma unroll
                    for (int i = 0; i < 8; ++i) acc[j] += win[(SUB - 1) - j + i] * z[i];
            }
#pragma unroll
            for (int j = 0; j < SUB; ++j) {
                const int t = t0 + j;
                const float zt = bf2f(*(LAS bf16*)(zs + b * ZP + t * 2));
                const float ov = conv3_at<L>(gsrc, t, w0, w1, w2) * (acc[j] + sk * zt);
                *(LAS bf16*)(zd + b * ZP + t * 2) = (bf16)f2bf(ov);
            }
        }
        __syncthreads();
    }
#pragma unroll 2
    for (int i = F.tid; i < 16 * (L / 8); i += NTHR) {
        const int b = i / (L / 8), ch = i % (L / 8);
        *(u32x4*)(yht + ((size_t)(b * 384 + c)) * L + ch * 8) = *(const LAS u32x4*)(zimg0 + b * ZP + ch * 16);
    }
}

__device__ __forceinline__ void chain_naive(Frame& F, int layer, int chain) {
    const int lane = F.lane;
    const bool is_ret = chain < 192;
    int b, h, dir;
    if (is_ret) { b = chain / 12; const int r = chain % 12; h = r >> 1; dir = r & 1; }
    else { const int i = chain - 192; b = i >> 3; h = (i & 7) >> 1; dir = i & 1; }
    const bf16* RET = WSP(const bf16, WS_RET); const bf16* ML = WSP(const bf16, WS_ML); const float* MLG = WSP(const float, WS_MLG);
    const float* rope = WSP(const float, WS_ROPE);
    bf16* Y = WSP(bf16, WS_Y); bf16* OB = WSP(bf16, WS_OB);
    float gam = 0.f;
    if (is_ret) gam = sigmoidf_(inp(F, I_RETDECAY)[layer * 12 + dir * 6 + h]);
    const float* mlc = inp(F, I_MLCONV) + layer * 3 * 512;
    const float bi = is_ret ? 0.f : inp(F, I_MLGB)[layer * 16 + dir * 8 + h], bfg = is_ret ? 0.f : inp(F, I_MLGB)[layer * 16 + dir * 8 + 4 + h];
    const float qw0 = mlc[h * 64 + lane], qw1 = mlc[512 + h * 64 + lane], qw2 = mlc[1024 + h * 64 + lane];
    const float kw0 = mlc[256 + h * 64 + lane], kw1 = mlc[512 + 256 + h * 64 + lane], kw2 = mlc[1024 + 256 + h * 64 + lane];
    float S[64];
#pragma unroll
    for (int d = 0; d < 64; ++d) S[d] = 0.f;
    float nv = 0.f;
    for (int step = 0; step < LC + LL; ++step) {
        int row, tpos, L; bool lat;
        if (step < LC) { tpos = dir ? (LC - 1 - step) : step; row = TOKL + b * LC + tpos; L = LC; lat = false; }
        else { const int s2 = step - LC; tpos = dir ? (LL - 1 - s2) : s2; row = b * LL + tpos; L = LL; lat = true; }
        float q, k, v, Fm, Im;
        if (is_ret) {
            const bf16* base = RET + (size_t)row * 1536;
            float qs = bf2f(base[h * 64 + lane]), ks = bf2f(base[384 + h * 64 + lane]);
            v = bf2f(base[768 + h * 64 + lane]);
            if (lat) {
                const float qp = bf2f(base[h * 64 + (lane ^ 16)]), kp = bf2f(base[384 + h * 64 + (lane ^ 16)]);
                const int half = lane >> 5, ii = lane & 15, hi = (lane >> 4) & 1;
                const float cs = rope[tpos * 64 + half * 32 + ii], sn = rope[tpos * 64 + half * 32 + 16 + ii];
                q = hi == 0 ? qs * cs - qp * sn : qp * sn + qs * cs;
                k = hi == 0 ? ks * cs - kp * sn : kp * sn + ks * cs;
            } else { q = qs; k = ks; }
            q *= 0.125f; Fm = gam; Im = 1.f;
        } else {
            const bf16* base = ML + (size_t)row * 1024;
            const float q0 = tpos > 0 ? bf2f(base[-1024 + h * 64 + lane]) : 0.f, q1 = bf2f(base[h * 64 + lane]), q2 = tpos < L - 1 ? bf2f(base[1024 + h * 64 + lane]) : 0.f;
            const float k0 = tpos > 0 ? bf2f(base[-1024 + 256 + h * 64 + lane]) : 0.f, k1 = bf2f(base[256 + h * 64 + lane]), k2 = tpos < L - 1 ? bf2f(base[1024 + 256 + h * 64 + lane]) : 0.f;
            q = siluf_(qw0 * q0 + qw1 * q1 + qw2 * q2);
            k = siluf_(kw0 * k0 + kw1 * k1 + kw2 * k2) * 0.125f;
            v = bf2f(base[512 + h * 64 + lane]);
            const float ig = MLG[(size_t)row * 16 + dir * 8 + h] + bi, fg = MLG[(size_t)row * 16 + dir * 8 + 4 + h] + bfg;
            Fm = sigmoidf_(fg); Im = __expf(ig);
        }
        float num = 0.f;
        const float iv = Im * v;
#pragma unroll
        for (int d = 0; d < 64; ++d) {
            const float kd = __int_as_float(__builtin_amdgcn_readlane(__float_as_int(k), d));
            const float qd = __int_as_float(__builtin_amdgcn_readlane(__float_as_int(q), d));
            S[d] = Fm * S[d] + kd * iv;
            num += qd * S[d];
        }
        float o = num;
        if (!is_ret) { nv = Fm * nv + Im * k; const float den = wave_sum(q * nv); o = num / fmaxf(fabsf(den), 1.f); }
        const int cof = is_ret ? (h * 64 + lane) : (384 + h * 64 + lane);
        if (dir == 0) Y[(size_t)row * D + 384 + cof] = (bf16)f2bf(o);
        else OB[(size_t)row * 640 + cof] = (bf16)f2bf(o);
    }
}

__device__ __forceinline__ void phase_mix(Frame& F, int layer) {
    const bool last = layer == 1;
    const bf16* ftl = WSP(const bf16, WS_FTL) + (size_t)layer * 2 * 384 * 4096;
    for (int u = F.wg; u < 384; u += F.G) hyena_unit_naive<LL>(F, layer, u, WSP(const bf16, WS_HYTL), ftl, WSP(bf16, WS_YHTL));
    if (!last) for (int u = F.wg; u < 384; u += F.G) hyena_unit_naive<LC>(F, layer, u, WSP(const bf16, WS_HYTC), WSP(const bf16, WS_FTC), WSP(bf16, WS_YHTC));
    for (int c = F.wg + F.wave * F.G; c < 320; c += F.G * NWAVES) chain_naive(F, layer, c);
}

__device__ __forceinline__ void phase_combine(Frame& F, int layer) {
    const bool last = layer == 1;
    const int gw = F.wg * NWAVES + F.wave, NGW = F.G * NWAVES, lane = F.lane;
    const int nrows = last ? TOKL : TOK;
    bf16* Y = WSP(bf16, WS_Y); const bf16* OB = WSP(const bf16, WS_OB); const bf16* RET = WSP(const bf16, WS_RET); const bf16* ML = WSP(const bf16, WS_ML);
    for (int row = gw; row < nrows; row += NGW) {
#pragma unroll
        for (int hh = 0; hh < 10; ++hh) {
            const int cof = hh * 64 + lane;
            const float x = bf2f(Y[(size_t)row * D + 384 + cof]) + bf2f(OB[(size_t)row * 640 + cof]);
            const float mu = wave_sum(x) * (1.f / 64.f), xc = x - mu;
            const float var = wave_sum(xc * xc) * (1.f / 64.f);
            const float nrm = xc * rsqrtf(var + 1e-6f);
            float gate;
            if (hh < 6) gate = siluf_(bf2f(RET[(size_t)row * 1536 + 1152 + cof]));
            else gate = sigmoidf_(bf2f(ML[(size_t)row * 1024 + 768 + (cof - 384)]));
            Y[(size_t)row * D + 384 + cof] = (bf16)f2bf(nrm * gate);
        }
    }
    LAS float* scr = (LAS float*)(F.lds + F.wave * 16640);
    const int nitL = NB * 6 * 32, nitC = last ? 0 : NB * 6 * 4;
    for (int it = gw; it < nitL + nitC; it += NGW) {
        const bf16* src; int L, rowbase, b, cb, tb;
        if (it < nitL) { b = it / 192; const int r = it % 192; cb = r / 32; tb = r % 32; L = LL; src = WSP(const bf16, WS_YHTL); rowbase = b * LL; }
        else { const int i2 = it - nitL; b = i2 / 24; const int r = i2 % 24; cb = r / 4; tb = r % 4; L = LC; src = WSP(const bf16, WS_YHTC); rowbase = TOKL + b * LC; }
        for (int cc = 0; cc < 64; ++cc) scr[cc * 65 + lane] = bf2f(src[((size_t)(b * 384 + cb * 64 + cc)) * L + tb * 64 + lane]);
        asm volatile("s_waitcnt lgkmcnt(0)" ::: "memory");
        for (int tt = 0; tt < 64; ++tt) Y[(size_t)(rowbase + tb * 64 + tt) * D + cb * 64 + lane] = (bf16)f2bf(scr[lane * 65 + tt]);
        asm volatile("s_waitcnt lgkmcnt(0)" ::: "memory");
    }
}

__device__ __forceinline__ void phase_norm_router(Frame& F) {
    const int gw = F.wg * NWAVES + F.wave, NGW = F.G * NWAVES, lane = F.lane;
    const float* g = inp(F, I_GFFN) + 1 * D; const float* wr = inp(F, I_ROUTER); const float* br = inp(F, I_ROUTERB);
    unsigned* cnt = WSP(unsigned, WS_CTL) + CW_CNT;
    for (int row = gw; row < TOKL; row += NGW) {
        float keep[16];
        norm_mod_row(xrow_ptr(F, row, false), g, mod_ptr(F, 1, row, 3), mod_ptr(F, 1, row, 4), WSP(bf16, WS_H) + (size_t)row * D, lane, keep);
        float lg[8];
#pragma unroll
        for (int e = 0; e < 8; ++e) lg[e] = 0.f;
#pragma unroll
        for (int j = 0; j < 4; ++j)
#pragma unroll
            for (int i = 0; i < 4; ++i) { const int k = 256 * j + 4 * lane + i; const f32x4 w0 = *(const f32x4*)(wr + k * 8), w1 = *(const f32x4*)(wr + k * 8 + 4); const float x = keep[4 * j + i];
                lg[0] += x * w0.x; lg[1] += x * w0.y; lg[2] += x * w0.z; lg[3] += x * w0.w; lg[4] += x * w1.x; lg[5] += x * w1.y; lg[6] += x * w1.z; lg[7] += x * w1.w; }
#pragma unroll
        for (int e = 0; e < 8; ++e) lg[e] = wave_sum(lg[e]) + br[e];
        int e0 = 0; float v0 = lg[0];
#pragma unroll
        for (int e = 1; e < 8; ++e) if (lg[e] > v0) { v0 = lg[e]; e0 = e; }
        int e1 = -1; float v1 = -3.0e38f;
#pragma unroll
        for (int e = 0; e < 8; ++e) if (e != e0 && lg[e] > v1) { v1 = lg[e]; e1 = e; }
        const float w1 = 1.f / (1.f + __expf(v0 - v1)), w0 = 1.f - w1;
        if (lane == 0) {
            const unsigned p0 = atomicAdd(cnt + e0, 1u), p1 = atomicAdd(cnt + e1, 1u);
            WSP(int, WS_TOPE)[row * 2] = e0; WSP(int, WS_TOPE)[row * 2 + 1] = e1;
            WSP(float, WS_TOPW)[row * 2] = w0; WSP(float, WS_TOPW)[row * 2 + 1] = w1;
            WSP(int, WS_TOPP)[row * 2] = (int)p0; WSP(int, WS_TOPP)[row * 2 + 1] = (int)p1;
        }
    }
}
__device__ __forceinline__ void phase_route_tables(Frame& F) {
    const unsigned* cnt = WSP(const unsigned, WS_CTL) + CW_CNT;
    int off[9]; off[0] = 0;
#pragma unroll
    for (int e = 0; e < 8; ++e) { const int c = (int)__hip_atomic_load(cnt + e, __ATOMIC_RELAXED, __HIP_MEMORY_SCOPE_AGENT); off[e + 1] = off[e] + ((c + 255) >> 8) * 256; }
    const int gt = F.wg * NTHR + F.tid, NGT = F.G * NTHR;
    int* rowidx = WSP(int, WS_ROWIDX); int* slot = WSP(int, WS_SLOT); int* tilee = WSP(int, WS_TILEE);
    for (int i = gt; i < MAXTILES * 256; i += NGT) {
        int e = 0;
#pragma unroll
        for (int q = 1; q < 8; ++q) if (i >= off[q]) e = q;
        const int c = (int)cnt[e];
        if (i >= off[8] || i - off[e] >= c) rowidx[i] = 0;
    }
    for (int i = gt; i < TOKL * 2; i += NGT) {
        const int e = WSP(const int, WS_TOPE)[i], pos = WSP(const int, WS_TOPP)[i];
        int o = 0;
#pragma unroll
        for (int q = 0; q < 8; ++q) if (e == q) o = off[q];
        const int s = o + pos; slot[i] = s; rowidx[s] = i >> 1;
    }
    for (int i = gt; i < MAXTILES + 1; i += NGT) {
        if (i == MAXTILES) tilee[MAXTILES] = off[8] >> 8;
        else { int e = 0;
#pragma unroll
            for (int q = 1; q < 8; ++q) if (i * 256 >= off[q]) e = q;
            tilee[i] = e; }
    }
}

__device__ __forceinline__ void moe_pass_gemm1(Frame& F, int t0, int t1) {
    const int gw = F.wg * NWAVES + F.wave, NGW = F.G * NWAVES;
    const int* tilee = WSP(const int, WS_TILEE); RowsGather R{WSP(const int, WS_ROWIDX)};
    const int nct = NFF1 / 64, nunits = (t1 - t0) * 4 * nct;
    EpiSwiglu E{WSP(bf16, WS_MACT), t0 * 256};
    for (int u = gw; u < nunits; u += NGW) {
        const int rt = u / nct, ct = u % nct, tile = t0 + (rt >> 2);
        const bf16* Bt = WSP(const bf16, WS_MW13) + (size_t)tilee[tile] * NFF1 * D;
        gemm_simple_tile(WSP(const bf16, WS_H), D, Bt, D, D, t0 * 4 + rt, ct, E, R, F.lane);
    }
}
__device__ __forceinline__ void moe_pass_gemm2(Frame& F, int t0, int t1) {
    const int gw = F.wg * NWAVES + F.wave, NGW = F.G * NWAVES;
    const int* tilee = WSP(const int, WS_TILEE);
    const int nct = D / 64, nunits = (t1 - t0) * 4 * nct;
    EpiBf16Out E{WSP(bf16, WS_EOUT), D, t0 * 256};
    for (int u = gw; u < nunits; u += NGW) {
        const int rt = u / nct, ct = u % nct, tile = t0 + (rt >> 2);
        const bf16* Bt = WSP(const bf16, WS_MW2) + (size_t)tilee[tile] * D * DFF;
        gemm_simple_tile(WSP(const bf16, WS_MACT), DFF, Bt, DFF, DFF, rt, ct, E, RowsId(), F.lane);
    }
}
__device__ __forceinline__ void moe_pass_gemm1_fast(Frame& F, int t0, int t1) {
    pg8::OrderMoe S; S.o.init(t1 - t0, NFF1 / 256, F.G, F.wg); S.rowidx = WSP(const int, WS_ROWIDX); S.tilee = WSP(const int, WS_TILEE); S.t0 = t0; S.bstride = (size_t)NFF1 * D; S.gather = true;
    EpiSwiglu E{WSP(bf16, WS_MACT), 0};
    pg8::gemm_phase(F.lds, WSP(const bf16, WS_H), D, WSP(const bf16, WS_MW13), D, D, S, E);
}
__device__ __forceinline__ void moe_pass_gemm2_fast(Frame& F, int t0, int t1) {
    pg8::OrderMoe S; S.o.init(t1 - t0, D / 256, F.G, F.wg); S.rowidx = WSP(const int, WS_ROWIDX); S.tilee = WSP(const int, WS_TILEE); S.t0 = t0; S.bstride = (size_t)D * DFF; S.gather = false;
    EpiBf16Out E{WSP(bf16, WS_EOUT), D, t0 * 256};
    pg8::gemm_phase(F.lds, WSP(const bf16, WS_MACT), DFF, WSP(const bf16, WS_MW2), DFF, DFF, S, E);
}
__device__ __forceinline__ void phase_final(Frame& F) {
    const int gw = F.wg * NWAVES + F.wave, NGW = F.G * NWAVES, lane = F.lane;
    const float* gf = inp(F, I_GFINAL); const bf16* eo = WSP(const bf16, WS_EOUT);
    for (int row = gw; row < TOKL; row += NGW) {
        const int s0 = WSP(const int, WS_SLOT)[row * 2], s1 = WSP(const int, WS_SLOT)[row * 2 + 1];
        const float w0 = WSP(const float, WS_TOPW)[row * 2], w1 = WSP(const float, WS_TOPW)[row * 2 + 1];
        const float* m5 = mod_ptr(F, 1, row, 5);
        float* xr = outp(F) + (size_t)row * D;
        f32x4 v[4]; float s = 0.f;
#pragma unroll
        for (int j = 0; j < 4; ++j) {
            const int c = 256 * j + 4 * lane;
            const f32x4 a = ld_bf16x4(eo + (size_t)s0 * D + c), b = ld_bf16x4(eo + (size_t)s1 * D + c), m = *(const f32x4*)(m5 + c);
            v[j] = *(const f32x4*)(xr + c) + m * (a * w0 + b * w1);
            s += (v[j].x * v[j].x + v[j].y * v[j].y) + (v[j].z * v[j].z + v[j].w * v[j].w);
        }
        const float r = rsqrtf(wave_sum(s) * (1.f / 1024.f) + 1e-6f);
#pragma unroll
        for (int j = 0; j < 4; ++j) { const int c = 256 * j + 4 * lane; const f32x4 g = *(const f32x4*)(gf + c); *(f32x4*)(xr + c) = v[j] * r * g; }
    }
}

__global__ void __launch_bounds__(NTHR, 2) hybrid_fwd(Params prm) {
    extern __shared__ __attribute__((aligned(16))) unsigned char lds_raw[];
    Frame F;
    F.lds = (LAS unsigned char*)lds_raw; F.ws = prm.ws;
    F.tid = threadIdx.x; F.lane = F.tid & 63; F.wave = __builtin_amdgcn_readfirstlane(F.tid >> 6); F.G = gridDim.x; F.wg = blockIdx.x;
    volatile LAS unsigned* MISC = (volatile LAS unsigned*)(F.lds + MISC_OFF);
    if (F.tid < 64) MISC[F.tid] = 0u;
    if (F.tid < 33) { const unsigned long long v = F.tid < 32 ? (unsigned long long)prm.in[F.tid] : (unsigned long long)prm.out; *(LAS unsigned long long*)(F.lds + PTAB_OFF + 8 * F.tid) = v; }
    __syncthreads();
    XcdBarrier bar = xcd_barrier_post(WSP(unsigned, WS_CTL) + CW_BAR, MISC + 8);
#define RELAUNDER() do { { unsigned long long _w = (unsigned long long)F.ws; asm volatile("" : "+s"(_w)); F.ws = (unsigned char*)_w; } \
        { unsigned _t = (unsigned)F.tid; asm volatile("" : "+v"(_t)); F.tid = (int)_t; F.lane = F.tid & 63; F.wave = __builtin_amdgcn_readfirstlane(F.tid >> 6); } \
        { unsigned _g = (unsigned)F.G, _b = (unsigned)F.wg; asm volatile("" : "+s"(_g), "+s"(_b)); F.G = (int)_g; F.wg = (int)_b; } \
        { unsigned _l = (unsigned)(size_t)F.lds; asm volatile("" : "+s"(_l)); F.lds = (LAS unsigned char*)(size_t)_l; } } while (0)
#define GRID_BAR() do { { unsigned long long _b = (unsigned long long)bar.bar; asm volatile("" : "+s"(_b)); bar.bar = (unsigned*)_b; } xcd_barrier(bar); RELAUNDER(); } while (0)

    phase_p0(F); write_bias(F);
    GRID_BAR();
#pragma unroll 1
    for (int layer = 0; layer < 2; ++layer) {
        const bool last = layer == 1;
        const int rows_all = TOK, rows_out = last ? TOKL : TOK;
        const float* modbase = WSP(const float, WS_MOD) + (size_t)layer * 17 * 6144;
        phase_norm(F, layer, rows_all, !last, 0);
        GRID_BAR();
        { EpiWin E{WSP(const float, WS_BIAS) + layer * NWP, WSP(bf16, WS_HYTL), WSP(bf16, WS_HYTC), WSP(bf16, WS_RET), WSP(bf16, WS_ML), WSP(float, WS_MLG)};
          if (FAST_PLAIN) gemm_fast(F, WSP(const bf16, WS_H), D, WSP(const bf16, WS_WIN), D, D, rows_all, NW1, E);
          else gemm_simple(F, WSP(const bf16, WS_H), D, WSP(const bf16, WS_WIN), D, D, rows_all, NW1, E, RowsId()); }
        GRID_BAR();
        phase_mix(F, layer);
        GRID_BAR();
        phase_combine(F, layer);
        GRID_BAR();
        { EpiGate E{WSP(const float, WS_BIAS) + layer * NWP + NW1, WSP(bf16, WS_GATES)};
          if (FAST_PLAIN) gemm_fast(F, WSP(const bf16, WS_H), D, WSP(const bf16, WS_WIN) + (size_t)NW1 * D, D, D, rows_out, NGATE, E);
          else gemm_simple(F, WSP(const bf16, WS_H), D, WSP(const bf16, WS_WIN) + (size_t)NW1 * D, D, D, rows_out, NGATE, E, RowsId()); }
        GRID_BAR();
        { EpiUp E{WSP(const bf16, WS_GATES), WSP(bf16, WS_H)};
          if (FAST_HORNER) gemm_fast(F, WSP(const bf16, WS_Y), D, WSP(const bf16, WS_WUP), D, D, rows_out, D, E);
          else gemm_simple(F, WSP(const bf16, WS_Y), D, WSP(const bf16, WS_WUP), D, D, rows_out, D, E, RowsId()); }
        GRID_BAR();
        { EpiResid E{last ? outp(F) : inp(F, I_X), last ? WSP(const float, WS_XC) : inp(F, I_CTX), outp(F), WSP(float, WS_XC), modbase, 2};
          if (FAST_PLAIN) gemm_fast(F, WSP(const bf16, WS_H), D, WSP(const bf16, WS_WOUT), D, D, rows_out, D, E);
          else gemm_simple(F, WSP(const bf16, WS_H), D, WSP(const bf16, WS_WOUT), D, D, rows_out, D, E, RowsId()); }
        GRID_BAR();
        if (!last) {
            phase_norm(F, layer, rows_out, false, 3);
            { const int gw = F.wg * NWAVES + F.wave, NGW = F.G * NWAVES; LAS float* scr = (LAS float*)(F.lds + F.wave * 8704);
              conv_weights_ffn(inp(F, I_FW1), inp(F, I_FW3), inp(F, I_FW2), WSP(bf16, WS_W13), WSP(bf16, WS_W2), gw, NGW, scr, F.lane);
              conv_weights_win(F, 1, gw, NGW, scr);
              conv_weights_upout(F, 1, gw, NGW, scr); }
            GRID_BAR();
            { EpiSwiglu E{WSP(bf16, WS_ACT), 0};
              if (FAST_PLAIN) gemm_fast(F, WSP(const bf16, WS_H), D, WSP(const bf16, WS_W13), D, D, rows_out, NFF1, E);
              else gemm_simple(F, WSP(const bf16, WS_H), D, WSP(const bf16, WS_W13), D, D, rows_out, NFF1, E, RowsId()); }
            GRID_BAR();
            { EpiResid E{outp(F), WSP(const float, WS_XC), outp(F), WSP(float, WS_XC), modbase, 5};
              if (FAST_PLAIN) gemm_fast(F, WSP(const bf16, WS_ACT), DFF, WSP(const bf16, WS_W2), DFF, DFF, rows_out, D, E);
              else gemm_simple(F, WSP(const bf16, WS_ACT), DFF, WSP(const bf16, WS_W2), DFF, DFF, rows_out, D, E, RowsId()); }
            GRID_BAR();
        }
    }
    phase_norm_router(F);
    { const int gw = F.wg * NWAVES + F.wave, NGW = F.G * NWAVES; LAS float* scr = (LAS float*)(F.lds + F.wave * 8704);
#pragma unroll 1
      for (int e = 0; e < NE; ++e)
          conv_weights_ffn(inp(F, I_MW1) + (size_t)e * D * DFF, inp(F, I_MW3) + (size_t)e * D * DFF, inp(F, I_MW2) + (size_t)e * DFF * D,
                           WSP(bf16, WS_MW13) + (size_t)e * NFF1 * D, WSP(bf16, WS_MW2) + (size_t)e * D * DFF, gw, NGW, scr, F.lane); }
    GRID_BAR();
    phase_route_tables(F);
    GRID_BAR();
    const int ntiles = __builtin_amdgcn_readfirstlane(WSP(const int, WS_TILEE)[MAXTILES]);
#pragma unroll 1
    for (int p = 0; p < NPASS; ++p) {
        const int t0 = p * PASS_TILES, t1 = min(ntiles, t0 + PASS_TILES);
        if (t0 < t1) { if (FAST_MOE) moe_pass_gemm1_fast(F, t0, t1); else moe_pass_gemm1(F, t0, t1); }
        GRID_BAR();
        if (t0 < t1) { if (FAST_MOE) moe_pass_gemm2_fast(F, t0, t1); else moe_pass_gemm2(F, t0, t1); }
        GRID_BAR();
    }
    phase_final(F);
}

extern "C" void kernel_launch(void* const* d_in, const int* in_sizes, int n_in, void* d_out, int out_size, void* d_ws, size_t ws_size, hipStream_t stream) {
    static int grid = 0;
    if (grid == 0) {
        if (n_in != 32 || out_size != TOKL * D || ws_size < WS_END) { fprintf(stderr, "kernel_launch: unexpected arguments (n_in %d, out %d, ws %zu)\n", n_in, out_size, ws_size); grid = -1; return; }
        int dev = 0, cus = 0;
        if (hipGetDevice(&dev) != hipSuccess || hipDeviceGetAttribute(&cus, hipDeviceAttributeMultiprocessorCount, dev) != hipSuccess) { grid = -1; return; }
        if (hipFuncSetAttribute((const void*)hybrid_fwd, hipFuncAttributeMaxDynamicSharedMemorySize, LDS_BYTES) != hipSuccess) { grid = -1; return; }
        int per_cu = 0;
        (void)hipOccupancyMaxActiveBlocksPerMultiprocessor(&per_cu, (const void*)hybrid_fwd, NTHR, LDS_BYTES);
        (void)hipGetLastError();
        grid = cus;
    }
    if (grid < 0) return;
    (void)hipMemsetAsync((char*)d_ws + WS_CTL, 0, CTL_ZERO_BYTES, stream);
    Params p{};
    for (int i = 0; i < 32; ++i) p.in[i] = (const float*)d_in[i];
    p.out = (float*)d_out; p.ws = (unsigned char*)d_ws;
    hipLaunchKernelGGL(hybrid_fwd, dim3(grid), dim3(NTHR), LDS_BYTES, stream, p);
}
```

```cpp
#include <hip/hip_runtime.h>
#include <stdint.h>
#include <stdio.h>

#define LAS __attribute__((address_space(3)))
typedef unsigned short bf16;
typedef short bf16x8 __attribute__((ext_vector_type(8)));
typedef float f32x4 __attribute__((ext_vector_type(4)));
typedef unsigned u32x4 __attribute__((ext_vector_type(4)));
typedef unsigned u32x2 __attribute__((ext_vector_type(2)));

constexpr int D = 1024, NB = 16, LL = 2048, LC = 256;
constexpr int TOKL = NB * LL, TOKC = NB * LC, TOK = TOKL + TOKC;
constexpr int HYW = 384, RETW = 384, MLW = 256;
constexpr int NIN = 6800, NW1 = 3840, NGATE = 3072, NWP = 6912;
constexpr int DFF = 2816, NFF1 = 5632, NE = 8;
constexpr int NWAVES = 8, NTHR = 512;
constexpr int MAXTILES = 272, PASS_TILES = 64, NPASS = 5;

constexpr size_t MiB = 1u << 20;
constexpr size_t WS_CTL = 0, CTL_ZERO_BYTES = 1 * MiB;
constexpr size_t WS_MOD = 1 * MiB;
constexpr size_t WS_BIAS = 2 * MiB;
constexpr size_t WS_ROPE = 2 * MiB + 256 * 1024;
constexpr size_t WS_TOPE = 3 * MiB;
constexpr size_t WS_TOPW = 3 * MiB + 256 * 1024;
constexpr size_t WS_TOPP = 3 * MiB + 512 * 1024;
constexpr size_t WS_SLOT = 3 * MiB + 768 * 1024;
constexpr size_t WS_ROWIDX = 4 * MiB;
constexpr size_t WS_TILEE = 4 * MiB + 512 * 1024;
constexpr size_t WS_FTL = 5 * MiB;
constexpr size_t WS_FTC = 17 * MiB;
constexpr size_t WS_WIN = 18 * MiB;
constexpr size_t WS_WUP = 32 * MiB;
constexpr size_t WS_WOUT = 34 * MiB;
constexpr size_t WS_XC = 36 * MiB;
constexpr size_t WS_H = 52 * MiB;
constexpr size_t WS_Y = 124 * MiB;
constexpr size_t WS_U = 196 * MiB;
constexpr size_t WS_RET = WS_U;
constexpr size_t WS_ML = WS_U + 108 * MiB;
constexpr size_t WS_MLG = WS_U + 180 * MiB;
constexpr size_t WS_OB = WS_U + 183 * MiB;
constexpr size_t WS_YHTL = WS_U + 228 * MiB;
constexpr size_t WS_YHTC = WS_U + 252 * MiB;
constexpr size_t WS_HYTL = WS_U + 255 * MiB;
constexpr size_t WS_HYTC = WS_U + 327 * MiB;
constexpr size_t WS_END = WS_U + 336 * MiB;
constexpr size_t WS_GATES = WS_U;
constexpr size_t WS_ACT = WS_U;
constexpr size_t WS_W13 = WS_U + 204 * MiB;
constexpr size_t WS_W2 = WS_U + 216 * MiB;
constexpr size_t WS_MW13 = WS_Y;
constexpr size_t WS_MW2 = WS_Y + 88 * MiB;
constexpr size_t WS_MACT = WS_Y + 132 * MiB;
constexpr size_t WS_EOUT = WS_Y + 220 * MiB;
static_assert(WS_EOUT + (size_t)MAXTILES * 256 * 1024 * 2 <= WS_END, "map");
static_assert(WS_GATES + (size_t)TOK * NGATE * 2 <= WS_YHTL, "gates overlay");

constexpr int CW_BAR = 4096;
constexpr int CW_CNT = 16384;

constexpr int LDS_BYTES = 147456;
constexpr int MISC_OFF = 147456 - 256;

__device__ __forceinline__ float bf2f(bf16 b) { return __uint_as_float(((unsigned)b) << 16); }
__device__ __forceinline__ unsigned f2bf(float f) { unsigned u = __float_as_uint(f); return (u + 0x7fffu + ((u >> 16) & 1u)) >> 16; }
__device__ __forceinline__ unsigned pk2(float lo, float hi) { return f2bf(lo) | (f2bf(hi) << 16); }
__device__ __forceinline__ float wave_sum(float v) {
#pragma unroll
    for (int o = 1; o < 64; o <<= 1) v += __shfl_xor(v, o);
    return v;
}
__device__ __forceinline__ float sigmoidf_(float x) { return 1.0f / (1.0f + __expf(-x)); }
__device__ __forceinline__ float siluf_(float x) { return x / (1.0f + __expf(-x)); }

#define XB_TMO      128
#define XB_XCNT(j)  (256  + 64 * (j))
#define XB_XSUB(j)  (1280 + 64 * (j))
#define XB_XGEN(j)  (2304 + 64 * (j))
#define XB_TOP      3328
#define XB_TOPGEN   3392
#define XCD_BAR_WORDS 3456
#define XB_SPIN_CAP (1u << 22)
__device__ __forceinline__ unsigned xb_ld(unsigned* p)              { return __hip_atomic_load(p, __ATOMIC_RELAXED, __HIP_MEMORY_SCOPE_AGENT); }
__device__ __forceinline__ unsigned xb_add(unsigned* p, unsigned v) { return __hip_atomic_fetch_add(p, v, __ATOMIC_RELAXED, __HIP_MEMORY_SCOPE_AGENT); }
__device__ __forceinline__ unsigned xb_xcc_id() { return (unsigned)__builtin_amdgcn_s_getreg((3 << 11) | 20) & 0xFu; }
#define XB_SPIN(cond, bar) do { unsigned _sp = 0; while (cond) { __builtin_amdgcn_s_sleep(1); \
    if ((++_sp & 255u) == 0u) { if (xb_ld(&(bar)[XB_TMO])) break; if (_sp > XB_SPIN_CAP) { atomicAdd(&(bar)[XB_TMO], 1u); break; } } } } while (0)
struct XcdBarrier { unsigned* bar; unsigned x; volatile LAS unsigned* st; };
__device__ __forceinline__ XcdBarrier xcd_barrier_post(unsigned* bar, volatile LAS unsigned* st) {
    XcdBarrier b; b.bar = bar; b.x = xb_xcc_id(); b.st = st;
    if (threadIdx.x == 0) (void)xb_add(&bar[XB_XCNT(b.x)], 1u);
    return b;
}
__device__ __forceinline__ void xcd_barrier_complete(unsigned* bar, unsigned x, unsigned& nloc, unsigned& nx) {
    const unsigned G = gridDim.x * gridDim.y * gridDim.z;
    unsigned sum, cnt, mine, sp = 0u;
    for (;;) {
        sum = 0u; cnt = 0u; mine = 0u;
#pragma unroll 1
        for (unsigned j = 0; j < 16; ++j) { const unsigned c = xb_ld(&bar[XB_XCNT(j)]); sum += c; cnt += (c > 0u) ? 1u : 0u; }
        mine = xb_ld(&bar[XB_XCNT(x)]);
        if (sum == G) break;
        __builtin_amdgcn_s_sleep(1);
        if ((++sp & 255u) == 0u) { if (xb_ld(&bar[XB_TMO])) break; if (sp > XB_SPIN_CAP) { atomicAdd(&bar[XB_TMO], 1u); break; } }
    }
    nloc = mine > 0u ? mine : 1u; nx = cnt > 0u ? cnt : 1u;
}
__device__ __forceinline__ void xcd_barrier(const XcdBarrier& b) {
    asm volatile("s_waitcnt vmcnt(0)" ::: "memory");
    __syncthreads();
    if (threadIdx.x == 0) {
        unsigned* bar = b.bar;
        __builtin_amdgcn_s_waitcnt(0);
        unsigned nloc = b.st[0], nx = b.st[1];
        if (nloc == 0u) { xcd_barrier_complete(bar, b.x, nloc, nx); b.st[0] = nloc; b.st[1] = nx; }
        const unsigned old = xb_add(&bar[XB_XSUB(b.x)], 1u);
        const unsigned gen = old / nloc;
        if (old + 1u == (gen + 1u) * nloc) {
            __builtin_amdgcn_fence(__ATOMIC_RELEASE, "agent");
            asm volatile("s_waitcnt vmcnt(0)" ::: "memory");
            const unsigned og = xb_add(&bar[XB_TOP], 1u);
            const unsigned tg = og / nx;
            if (og + 1u == (tg + 1u) * nx) xb_add(&bar[XB_TOPGEN], 1u);
            else XB_SPIN(xb_ld(&bar[XB_TOPGEN]) == tg, bar);
            __builtin_amdgcn_fence(__ATOMIC_ACQUIRE, "agent");
            xb_add(&bar[XB_XGEN(b.x)], 1u);
            asm volatile("s_waitcnt vmcnt(0)" ::: "memory");
        } else {
            XB_SPIN(xb_ld(&bar[XB_XGEN(b.x)]) == gen, bar);
            __builtin_amdgcn_fence(__ATOMIC_ACQUIRE, "agent");
            asm volatile("s_waitcnt vmcnt(0)" ::: "memory");
        }
    }
    __syncthreads();
}

struct Params { const float* in[32]; float* out; unsigned char* ws; };
enum { I_X = 0, I_C, I_CTX, I_CCTX, I_WMOD, I_BMOD, I_GMIX, I_GFFN, I_WIN, I_BIN, I_HYCONV, I_HYF1, I_HYFB1, I_HYF2, I_HYFB2, I_HYF3, I_HYDECAY,
       I_HYSKIP, I_RETDECAY, I_MLCONV, I_MLGB, I_WUP, I_WOUT, I_FW1, I_FW3, I_FW2, I_ROUTER, I_ROUTERB, I_MW1, I_MW3, I_MW2, I_GFINAL };

struct Frame {
    LAS unsigned char* lds;
    unsigned char* ws;
    int tid, lane, wave, G, wg;
};
#define WSP(T, off) ((T*)(F.ws + (off)))
constexpr int PTAB_OFF = 147456 - 1024;
__device__ __forceinline__ const float* inp(const Frame& F, int i) {
    const LAS unsigned* t = (const LAS unsigned*)(F.lds + PTAB_OFF) + 2 * i;
    const unsigned lo = __builtin_amdgcn_readfirstlane(t[0]), hi = __builtin_amdgcn_readfirstlane(t[1]);
    return (const float*)(((unsigned long long)hi << 32) | lo);
}
__device__ __forceinline__ float* outp(const Frame& F) { return (float*)inp(F, 32); }

__device__ __forceinline__ int row_batch(int row) { return row < TOKL ? (row >> 11) : ((row - TOKL) >> 8); }
__device__ __forceinline__ const float* mod_ptr(const Frame& F, int layer, int row, int which) {
    const int r = row < TOKL ? (row >> 11) : 16;
    return WSP(const float, WS_MOD) + ((size_t)(layer * 17 + r) * 6 + which) * 1024;
}

template <class RowMap>
__device__ __forceinline__ void tr_item(const float* W, int K, int N, bf16* WT, int ldT, RowMap rm, LAS float* scr, int item, int lane) {
    const int nblk = (N + 31) / 32, kb = item / nblk, nb = item % nblk, k0 = 64 * kb, n0 = 32 * nb;
#pragma unroll 8
    for (int i = 0; i < 32; ++i) { const int kk = 2 * i + (lane >> 5); const int n = n0 + (lane & 31); scr[kk * 33 + (lane & 31)] = (n < N) ? W[(size_t)(k0 + kk) * N + n] : 0.f; }
    asm volatile("s_waitcnt lgkmcnt(0)" ::: "memory");
    const int c = lane & 7;
#pragma unroll
    for (int j = 0; j < 4; ++j) { const int nl = (lane >> 3) + 8 * j; const int n = n0 + nl; const LAS float* s = scr + (8 * c) * 33 + nl;
        u32x4 o; o.x = pk2(s[0 * 33], s[1 * 33]); o.y = pk2(s[2 * 33], s[3 * 33]); o.z = pk2(s[4 * 33], s[5 * 33]); o.w = pk2(s[6 * 33], s[7 * 33]);
        if (n < N) *(u32x4*)(WT + (size_t)rm(n) * ldT + k0 + 8 * c) = o; }
    asm volatile("s_waitcnt lgkmcnt(0)" ::: "memory");
}
struct RmId { __device__ __forceinline__ int operator()(int n) const { return n; } };
__device__ __forceinline__ int win_row(int n) {
    if (n < 1152) return n;
    if (n < 2688) return 1280 + (n - 1152);
    if (n < 3712) return 2816 + (n - 2688);
    if (n < 3728) return 1152 + (n - 3712);
    return 3840 + (n - 3728);
}
struct RmWin { __device__ __forceinline__ int operator()(int n) const { return win_row(n); } };
struct RmW1 { __device__ __forceinline__ int operator()(int n) const { return (n >> 4) * 32 + (n & 15); } };
struct RmW3 { __device__ __forceinline__ int operator()(int n) const { return (n >> 4) * 32 + 16 + (n & 15); } };

__device__ __forceinline__ void conv_weights_win(Frame& F, int layer, int gw, int NGW, LAS float* scr) {
    const float* W = inp(F, I_WIN) + (size_t)layer * D * NIN;
    const int items = (D / 64) * ((NIN + 31) / 32);
    for (int it = gw; it < items; it += NGW) tr_item(W, D, NIN, WSP(bf16, WS_WIN), D, RmWin(), scr, it, F.lane);
    bf16* wt = WSP(bf16, WS_WIN);
    for (int i = gw * 64 + F.lane; i < 112 * 1024 / 8; i += NGW * 64) *(u32x4*)(wt + (size_t)1168 * 1024 + (size_t)i * 8) = (u32x4){0u, 0u, 0u, 0u};
}
__device__ __forceinline__ void conv_weights_upout(Frame& F, int layer, int gw, int NGW, LAS float* scr) {
    const int items = (D / 64) * (D / 32);
    for (int it = gw; it < items; it += NGW) tr_item(inp(F, I_WUP) + (size_t)layer * D * D, D, D, WSP(bf16, WS_WUP), D, RmId(), scr, it, F.lane);
    for (int it = gw; it < items; it += NGW) tr_item(inp(F, I_WOUT) + (size_t)layer * D * D, D, D, WSP(bf16, WS_WOUT), D, RmId(), scr, it, F.lane);
}
__device__ __forceinline__ void conv_weights_ffn(const float* w1, const float* w3, const float* w2, bf16* w13t, bf16* w2t, int gw, int NGW, LAS float* scr, int lane) {
    const int i1 = (D / 64) * (DFF / 32), i2 = (DFF / 64) * (D / 32);
    for (int it = gw; it < i1; it += NGW) tr_item(w1, D, DFF, w13t, D, RmW1(), scr, it, lane);
    for (int it = gw; it < i1; it += NGW) tr_item(w3, D, DFF, w13t, D, RmW3(), scr, it, lane);
    for (int it = gw; it < i2; it += NGW) tr_item(w2, DFF, D, w2t, DFF, RmId(), scr, it, lane);
}

__device__ __forceinline__ void filter_item(Frame& F, int layer, int L, bf16* FT  , int pb, int ch, LAS float* tile  ) {
    const float* f1 = inp(F, I_HYF1) + layer * 33 * 64; const float* fb1 = inp(F, I_HYFB1) + layer * 64;
    const float* f2 = inp(F, I_HYF2) + layer * 64 * 64; const float* fb2 = inp(F, I_HYFB2) + layer * 64;
    const float* f3 = inp(F, I_HYF3) + (size_t)layer * 64 * 1536; const float* dec = inp(F, I_HYDECAY) + layer * 1536;
    const int lane = F.lane, n = ch * 64 + lane;
    const float b1 = fb1[lane], b2 = fb2[lane], adec = fabsf(dec[n]);
    for (int pl = 0; pl < 64; ++pl) {
        const int pos = pb * 64 + pl;
        const float t = (float)pos / (float)(L - 1);
        const float w = 6.283185307179586f * (float)pos / (float)L;
        float feat = 0.f;
        if (lane == 0) feat = t;
        else if (lane < 17) { const float band = 1e-4f + (float)(lane - 1) * ((15.0f - 1e-4f) / 15.0f); feat = cosf(w * band); }
        else if (lane < 33) { const float band = 1e-4f + (float)(lane - 17) * ((15.0f - 1e-4f) / 15.0f); feat = -sinf(w * band); }
        float a1 = b1;
        for (int i = 0; i < 33; ++i) a1 += __shfl(feat, i) * f1[i * 64 + lane];
        const float h1 = sinf(a1);
        float a2 = b2;
        for (int i = 0; i < 64; ++i) a2 += __shfl(h1, i) * f2[i * 64 + lane];
        const float h2 = sinf(a2);
        float a3 = 0.f;
        for (int i = 0; i < 64; ++i) a3 += __shfl(h2, i) * f3[i * 1536 + n];
        tile[pl * 65 + lane] = a3 * expf(-t * adec);
    }
    asm volatile("s_waitcnt lgkmcnt(0)" ::: "memory");
    const int pos = pb * 64 + lane;
    for (int cl = 0; cl < 64; ++cl) {
        const int nn = ch * 64 + cl, o = nn / 768, dir = (nn / 384) & 1, c = nn % 384;
        bf16* dst = FT + (size_t)(o * 384 + c) * (2 * L);
        const float v = tile[lane * 65 + cl];
        if (dir == 0) dst[L - pos] = (bf16)f2bf(v);
        else if (pos > 0) dst[L + pos] = (bf16)f2bf(v);
    }
    asm volatile("s_waitcnt lgkmcnt(0)" ::: "memory");
}

__device__ __forceinline__ void phase_p0(Frame& F) {
    const int gw = F.wg * NWAVES + F.wave, NGW = F.G * NWAVES;
    LAS float* sl = (LAS float*)F.lds;
    LAS float* red = (LAS float*)(F.lds + 17 * 4096);
    for (int i = F.tid; i < 17 * 1024; i += NTHR) { const int r = i >> 10, k = i & 1023; const float v = r < 16 ? inp(F, I_C)[r * 1024 + k] : inp(F, I_CCTX)[k]; sl[i] = siluf_(v); }
    __syncthreads();
    for (int item = F.wg; item < 2 * 384; item += F.G) {
        const int layer = item / 384, n0 = (item % 384) * 16, j = F.tid & 15, kp = F.tid >> 4;
        const float* W = inp(F, I_WMOD) + (size_t)layer * D * 6144;
        float acc[17];
#pragma unroll
        for (int r = 0; r < 17; ++r) acc[r] = 0.f;
        for (int k = kp * 32; k < kp * 32 + 32; ++k) { const float w = W[(size_t)k * 6144 + n0 + j];
#pragma unroll
            for (int r = 0; r < 17; ++r) acc[r] += sl[r * 1024 + k] * w; }
#pragma unroll
        for (int r = 0; r < 17; ++r) red[(kp * 17 + r) * 16 + j] = acc[r];
        __syncthreads();
        if (F.tid < 272) { const int r = F.tid >> 4, jj = F.tid & 15; float s = inp(F, I_BMOD)[layer * 6144 + n0 + jj];
            for (int q = 0; q < 32; ++q) s += red[(q * 17 + r) * 16 + jj];
            WSP(float, WS_MOD)[(size_t)(layer * 17 + r) * 6144 + n0 + jj] = s; }
        __syncthreads();
    }
    __syncthreads();
    LAS float* scr = (LAS float*)(F.lds + F.wave * 8704);
    conv_weights_win(F, 0, gw, NGW, scr);
    conv_weights_upout(F, 0, gw, NGW, scr);
    for (int i = gw * 64 + F.lane; i < 2048 * 32; i += NGW * 64) {
        const int t = i >> 5, j = i & 31, half = j >> 4, ii = j & 15;
        const float inv = 1.0f / powf(10000.0f, (float)ii / 16.0f);
        const float ang = (float)(half == 0 ? (t >> 6) : (t & 63)) * inv;
        WSP(float, WS_ROPE)[t * 64 + half * 32 + ii] = cosf(ang);
        WSP(float, WS_ROPE)[t * 64 + half * 32 + 16 + ii] = sinf(ang);
    }
    __syncthreads();
    LAS float* ftile = (LAS float*)(F.lds + F.wave * 16640);
    for (int it = gw; it < 1536 + 96; it += NGW) {
        if (it < 1536) { const int layer = it / 768, r = it % 768; filter_item(F, layer, LL, WSP(bf16, WS_FTL) + (size_t)layer * 2 * 384 * 4096, r / 24, r % 24, ftile); }
        else { const int r = it - 1536; filter_item(F, 0, LC, WSP(bf16, WS_FTC), r / 24, r % 24, ftile); }
    }
}
__device__ __forceinline__ void write_bias(Frame& F) {
    const int gt = (F.wg * NWAVES + F.wave) * 64 + F.lane, NGT = F.G * NTHR;
    for (int i = gt; i < 2 * NWP; i += NGT) {
        const int l = i / NWP, r = i % NWP; float v = 0.f;
        int n = -1;
        if (r < 1152) n = r; else if (r < 1168) n = 3712 + (r - 1152); else if (r < 1280) n = -1; else if (r < 2816) n = 1152 + (r - 1280); else if (r < 3840) n = 2688 + (r - 2816); else n = 3728 + (r - 3840);
        if (n >= 0) v = inp(F, I_BIN)[l * NIN + n];
        WSP(float, WS_BIAS)[i] = v;
    }
}

__device__ __forceinline__ void norm_mod_row(const float* xrow, const float* g, const float* shift, const float* scale, bf16* orow, int lane, float* keep  ) {
    f32x4 v[4]; float s = 0.f;
#pragma unroll
    for (int j = 0; j < 4; ++j) { v[j] = *(const f32x4*)(xrow + 256 * j + 4 * lane); s += (v[j].x * v[j].x + v[j].y * v[j].y) + (v[j].z * v[j].z + v[j].w * v[j].w); }
    const float r = rsqrtf(wave_sum(s) * (1.0f / 1024.0f) + 1e-6f);
#pragma unroll
    for (int j = 0; j < 4; ++j) {
        const f32x4 gg = *(const f32x4*)(g + 256 * j + 4 * lane), sh = *(const f32x4*)(shift + 256 * j + 4 * lane), sc = *(const f32x4*)(scale + 256 * j + 4 * lane);
        f32x4 o;
        o.x = (v[j].x * r * gg.x) * (1.f + sc.x) + sh.x; o.y = (v[j].y * r * gg.y) * (1.f + sc.y) + sh.y;
        o.z = (v[j].z * r * gg.z) * (1.f + sc.z) + sh.z; o.w = (v[j].w * r * gg.w) * (1.f + sc.w) + sh.w;
        if (keep) { keep[4 * j + 0] = o.x; keep[4 * j + 1] = o.y; keep[4 * j + 2] = o.z; keep[4 * j + 3] = o.w; }
        u32x2 w; w.x = pk2(o.x, o.y); w.y = pk2(o.z, o.w);
        *(u32x2*)(orow + 256 * j + 4 * lane) = w;
    }
}
__device__ __forceinline__ const float* xrow_ptr(const Frame& F, int row, bool from_input) {
    if (row < TOKL) return (from_input ? inp(F, I_X) : outp(F)) + (size_t)row * D;
    return (from_input ? inp(F, I_CTX) : WSP(const float, WS_XC)) + (size_t)(row - TOKL) * D;
}
__device__ __forceinline__ void phase_norm(Frame& F, int layer, int nrows, bool from_input, int which) {
    const int gw = F.wg * NWAVES + F.wave, NGW = F.G * NWAVES;
    const float* g = inp(F, which == 0 ? I_GMIX : I_GFFN) + layer * D;
    for (int row = gw; row < nrows; row += NGW)
        norm_mod_row(xrow_ptr(F, row, from_input), g, mod_ptr(F, layer, row, which), mod_ptr(F, layer, row, which + 1), WSP(bf16, WS_H) + (size_t)row * D, F.lane, nullptr);
}

struct RowsId { __device__ __forceinline__ int operator()(int r) const { return r; } };
struct RowsGather { const int* idx; __device__ __forceinline__ int operator()(int r) const { return idx[r]; } };
template <class Epi, class Rows>
__device__ __forceinline__ void gemm_simple_tile(const bf16* A, int lda, const bf16* Bt, int ldb, int K, int rt, int ct, const Epi& E, const Rows& R, int lane) {
    const int fr = lane & 15, fq = lane >> 4;
    f32x4 acc[4][4];
#pragma unroll
    for (int mi = 0; mi < 4; ++mi)
#pragma unroll
        for (int ni = 0; ni < 4; ++ni) acc[mi][ni] = (f32x4){0.f, 0.f, 0.f, 0.f};
    const bf16* ap[4]; const bf16* bp[4];
#pragma unroll
    for (int mi = 0; mi < 4; ++mi) ap[mi] = A + (size_t)R(rt * 64 + mi * 16 + fr) * lda + fq * 8;
#pragma unroll
    for (int ni = 0; ni < 4; ++ni) bp[ni] = Bt + (size_t)(ct * 64 + ni * 16 + fr) * ldb + fq * 8;
#pragma unroll 1
    for (int k0 = 0; k0 < K; k0 += 32) {
        if constexpr (Epi::HORNER) {
            if (k0 == 384 || k0 == 768) {
                const int seg = (k0 == 384) ? 0 : 1;
#pragma unroll
                for (int mi = 0; mi < 4; ++mi)
#pragma unroll
                    for (int ni = 0; ni < 4; ++ni) acc[mi][ni] = E.rescale(seg, rt * 64 + mi * 16 + fr, ct * 64 + ni * 16 + 4 * fq, acc[mi][ni]);
            }
        }
        bf16x8 a[4], b[4];
#pragma unroll
        for (int mi = 0; mi < 4; ++mi) a[mi] = *(const bf16x8*)(ap[mi] + k0);
#pragma unroll
        for (int ni = 0; ni < 4; ++ni) b[ni] = *(const bf16x8*)(bp[ni] + k0);
#pragma unroll
        for (int mi = 0; mi < 4; ++mi)
#pragma unroll
            for (int ni = 0; ni < 4; ++ni) acc[mi][ni] = __builtin_amdgcn_mfma_f32_16x16x32_bf16(b[ni], a[mi], acc[mi][ni], 0, 0, 0);
    }
#pragma unroll
    for (int mi = 0; mi < 4; ++mi) {
        const int r = rt * 64 + mi * 16 + fr;
        if constexpr (Epi::PAIR) {
#pragma unroll
            for (int ni = 0; ni < 4; ni += 2) E.store_pair(r, ct * 32 + (ni >> 1) * 16 + 4 * fq, acc[mi][ni], acc[mi][ni + 1]);
        } else {
#pragma unroll
            for (int ni = 0; ni < 4; ++ni) E.store(r, ct * 64 + ni * 16 + 4 * fq, acc[mi][ni]);
        }
    }
}
template <class Epi, class Rows>
__device__ __forceinline__ void gemm_simple(Frame& F, const bf16* A, int lda, const bf16* Bt, int ldb, int K, int M, int N, const Epi& E, const Rows& R) {
    const int gw = F.wg * NWAVES + F.wave, NGW = F.G * NWAVES;
    const int nct = N / 64, nrt = M / 64;
    for (int u = gw; u < nct * nrt; u += NGW) gemm_simple_tile(A, lda, Bt, ldb, K, u / nct, u % nct, E, R, F.lane);
}

namespace pg8 {
constexpr int BM = 256, BK = 64, HALF = 128, HTB = HALF * BK * 2, STAGE_BYTES = 8 * HTB, NXCD = 8, WGM = 8;
__device__ __forceinline__ int lds_byte(int r, int c) { const int st = (r >> 4) * 2 + (c >> 5), rr = r & 15, cc = c & 31, ob = rr * 64 + cc * 2; return st * 1024 + (ob ^ (((ob >> 9) & 1) << 5)); }
__device__ __forceinline__ void stage_rc(int b, int& R, int& C) { const int st = b / 1024, sb = b % 1024, swz = sb ^ (((sb >> 9) & 1) << 5); R = (st >> 1) * 16 + swz / 64; C = (st & 1) * 32 + (swz % 64) / 2; }
struct Unit { int pm, pn; };
struct OrderPlain {
    static constexpr bool GATHER = false;
    int nM, nN, nwg, G, c;
    __device__ __forceinline__ void init(int nM_, int nN_, int G_, int c_) { nM = nM_; nN = nN_; nwg = nM * nN; G = G_; c = c_; }
    __device__ __forceinline__ bool next(int i, Unit& u) const {
        const long L = (long)i * G + c; if (L >= nwg) return false;
        int wgid = (int)L; { const int q = nwg / NXCD, r = nwg % NXCD, xcd = wgid % NXCD, off = wgid / NXCD; wgid = (xcd < r ? xcd * (q + 1) : r * (q + 1) + (xcd - r) * q) + off; }
        const int nig = WGM * nN, gid = wgid / nig, fm = gid * WGM, gsz = (nM - fm) < WGM ? (nM - fm) : WGM;
        u.pm = fm + ((wgid % nig) % gsz); u.pn = (wgid % nig) / gsz; return true;
    }
    __device__ __forceinline__ int arow(int r) const { return r; }
    __device__ __forceinline__ size_t boff(const Unit&) const { return 0; }
};
struct OrderMoe {
    static constexpr bool GATHER = true;
    OrderPlain o; const int* rowidx; const int* tilee; int t0; size_t bstride; bool gather;
    __device__ __forceinline__ bool next(int i, Unit& u) const { return o.next(i, u); }
    __device__ __forceinline__ int arow(int r) const { return gather ? rowidx[t0 * 256 + r] : r; }
    __device__ __forceinline__ size_t boff(const Unit& u) const { return (size_t)tilee[t0 + u.pm] * bstride; }
};

template <class Epi, class Sched>
__device__ __forceinline__ void gemm_phase(LAS unsigned char* lds, const bf16* A, int lda, const bf16* Bt, int ldb, int K, const Sched& S, const Epi& E) {
    unsigned tid_u = threadIdx.x; asm volatile("" : "+v"(tid_u));
    const int tid = (int)tid_u, wid = __builtin_amdgcn_readfirstlane(tid >> 6), lane = tid & 63, wr = wid >> 2, wc = wid & 3, fr = lane & 15, fq = lane >> 4;
    const int nt = K / BK;
    unsigned voffB[2];
    { int sR[2], sC[2];
#pragma unroll
      for (int i = 0; i < 2; ++i) { stage_rc(tid * 16 + i * 8192, sR[i], sC[i]); voffB[i] = (unsigned)(sR[i] * ldb + sC[i]) * 2u; } }
#define PG8_GATHER_OFFS(pm_) do { unsigned _t = (unsigned)tid; asm volatile("" : "+v"(_t)); _Pragma("unroll") for (int i = 0; i < 2; ++i) { int _R, _C; stage_rc((int)_t * 16 + i * 8192, _R, _C); \
        vc0[i] = (unsigned)((size_t)S.arow((pm_) * BM + _R) * lda + _C) * 2u; vc1[i] = (unsigned)((size_t)S.arow((pm_) * BM + HALF + _R) * lda + _C) * 2u; } } while (0)
    const size_t kstep = (size_t)(BK * 2);
    const size_t hstepB = (size_t)HALF * ldb * 2, tstepB = 2 * hstepB;
    const unsigned ldsw = (unsigned)wid * 1024u;
    const int aoff = lds_byte(wr * 64 + fr, fq * 8), boff = lds_byte(wc * 32 + fr, fq * 8);
#define PG8_SA(b, h) (((b) * 2 + (h)) * HTB)
#define PG8_SB(b, h) ((4 + (b) * 2 + (h)) * HTB)
#define PG8_STAGE2(bufoff, gbase, v0, v1) do { \
        __builtin_amdgcn_global_load_lds((const unsigned*)((const char*)(gbase) + (v0)), (LAS unsigned*)(lds + (bufoff) + ldsw), 16, 0, 0); \
        __builtin_amdgcn_global_load_lds((const unsigned*)((const char*)(gbase) + (v1)), (LAS unsigned*)(lds + (bufoff) + ldsw + 8192), 16, 0, 0); } while (0)
#define PG8_STAGEB(bufoff, gbase) PG8_STAGE2(bufoff, gbase, voffB[0], voffB[1])
#define PG8_LDA(dst, b, h) do { _Pragma("unroll") for (int m = 0; m < 4; ++m) _Pragma("unroll") for (int k = 0; k < 2; ++k) dst[m][k] = *(const LAS bf16x8*)(lds + PG8_SA(b, h) + aoff + m * 2048 + k * 1024); } while (0)
#define PG8_LDB(dst, b, h) do { _Pragma("unroll") for (int n = 0; n < 2; ++n) _Pragma("unroll") for (int k = 0; k < 2; ++k) dst[n][k] = *(const LAS bf16x8*)(lds + PG8_SB(b, h) + boff + n * 2048 + k * 1024); } while (0)
#define PG8_MMA(ai, bj, At, Bt_) do { __builtin_amdgcn_s_setprio(1); _Pragma("unroll") for (int m = 0; m < 4; ++m) _Pragma("unroll") for (int n = 0; n < 2; ++n) _Pragma("unroll") for (int k = 0; k < 2; ++k) \
        acc[ai][bj][m][n] = __builtin_amdgcn_mfma_f32_16x16x32_bf16(Bt_[n][k], At[m][k], acc[ai][bj][m][n], 0, 0, 0); __builtin_amdgcn_s_setprio(0); } while (0)
#define PG8_WAIT_V(n) asm volatile("s_waitcnt vmcnt(" #n ")" ::: "memory")
#define PG8_WAIT_L(n) asm volatile("s_waitcnt lgkmcnt(" #n ")" ::: "memory")
#define PG8_BAR __builtin_amdgcn_s_barrier()
#define PG8_SCHED __builtin_amdgcn_sched_barrier(0)
    Unit cur, nxt; int ui = 0;
    if (!S.next(0, cur)) return;
    f32x4 acc[2][2][4][2];
#pragma unroll
    for (int a = 0; a < 2; ++a)
#pragma unroll
        for (int b = 0; b < 2; ++b)
#pragma unroll
            for (int m = 0; m < 4; ++m)
#pragma unroll
                for (int n = 0; n < 2; ++n) acc[a][b][m][n] = (f32x4){0.f, 0.f, 0.f, 0.f};
    bf16x8 At[4][2], B0[2][2], B1[2][2];
    constexpr bool GA = Sched::GATHER;
    const size_t hstepA = GA ? 0 : (size_t)HALF * lda * 2, tstepA = (size_t)BM * lda * 2;
    unsigned vc0[2], vc1[2];
    if constexpr (GA) { PG8_GATHER_OFFS(cur.pm); }
    else { int sR, sC;
#pragma unroll
        for (int i = 0; i < 2; ++i) { stage_rc(tid * 16 + i * 8192, sR, sC); vc0[i] = (unsigned)(sR * lda + sC) * 2u; vc1[i] = 0u; } }
#define VC0(i) vc0[i]
#define VC1(i) (GA ? vc1[i] : vc0[i])
#define VN0(i) vc0[i]
#define VN1(i) VC1(i)
    const char* cA = GA ? (const char*)A : (const char*)A + (size_t)cur.pm * tstepA;
    const char* cB = (const char*)Bt + S.boff(cur) * 2 + (size_t)cur.pn * tstepB;
    PG8_STAGEB(PG8_SB(0, 0), cB); PG8_STAGE2(PG8_SA(0, 0), cA, VC0(0), VC0(1)); PG8_STAGEB(PG8_SB(0, 1), cB + hstepB); PG8_STAGE2(PG8_SA(0, 1), cA + hstepA, VC1(0), VC1(1));
    if (wr == 1) PG8_BAR;
    PG8_WAIT_V(4); PG8_BAR;
    PG8_STAGEB(PG8_SB(1, 0), cB + kstep); PG8_STAGE2(PG8_SA(1, 0), cA + kstep, VC0(0), VC0(1)); PG8_STAGEB(PG8_SB(1, 1), cB + hstepB + kstep);
    PG8_WAIT_V(6); PG8_BAR;
    for (;;) {
        const bool has_next = S.next(ui + 1, nxt);
        const char* nB = cB; const char* nA = cA;
        if (has_next) {
            nB = (const char*)Bt + S.boff(nxt) * 2 + (size_t)nxt.pn * tstepB;
            if constexpr (!GA) nA = (const char*)A + (size_t)nxt.pm * tstepA;
        }
        for (int t = 0; t < nt; t += 2) {
            const bool last = (t == nt - 2);
            if constexpr (Epi::HORNER) {
                if (t == 6 || t == 12) {
                    asm volatile("" ::: "memory");
                    const int seg = (t == 6) ? 0 : 1;
                    int hpm = cur.pm, hpn = cur.pn; asm volatile("" : "+s"(hpm), "+s"(hpn));
                    unsigned hln = (unsigned)lane; asm volatile("" : "+v"(hln)); const int hfr = (int)(hln & 15u), hfq = (int)(hln >> 4);
#pragma unroll
                    for (int ai = 0; ai < 2; ++ai)
#pragma unroll
                        for (int m = 0; m < 4; ++m) {
#pragma unroll
                            for (int bj = 0; bj < 2; ++bj)
#pragma unroll
                                for (int n = 0; n < 2; ++n)
                                    acc[ai][bj][m][n] = E.rescale(seg, hpm * BM + ai * HALF + wr * 64 + m * 16 + hfr, hpn * BM + bj * HALF + wc * 32 + n * 16 + 4 * hfq, acc[ai][bj][m][n]);
                            asm volatile("" : "+v"(acc[ai][0][m][0]), "+v"(acc[ai][0][m][1]), "+v"(acc[ai][1][m][0]), "+v"(acc[ai][1][m][1]) :: "memory");
                        }
                    asm volatile("s_waitcnt vmcnt(0)" ::: "memory");
                }
            }
            const char* a1 = cA + (size_t)(t + 1) * kstep;
            const char* a2 = last ? nA : cA + (size_t)(t + 2) * kstep; const char* b2 = last ? nB : cB + (size_t)(t + 2) * kstep;
            const char* a3 = a2 + kstep; const char* b3 = b2 + kstep;
            PG8_LDB(B0, 0, 0); PG8_SCHED; PG8_LDA(At, 0, 0); PG8_STAGE2(PG8_SA(1, 1), a1 + hstepA, VC1(0), VC1(1));
            if constexpr (GA) { if (last && has_next) { asm volatile("" ::: "memory"); PG8_GATHER_OFFS(nxt.pm); asm volatile("" ::: "memory"); } }
            PG8_WAIT_L(8); PG8_BAR; PG8_WAIT_L(0); PG8_MMA(0, 0, At, B0); PG8_BAR; PG8_SCHED;
            PG8_LDB(B1, 0, 1); PG8_STAGEB(PG8_SB(0, 0), b2);
            PG8_BAR; PG8_WAIT_L(0); PG8_MMA(0, 1, At, B1); PG8_BAR;
            PG8_LDA(At, 0, 1); PG8_STAGE2(PG8_SA(0, 0), a2, VN0(0), VN0(1));
            PG8_BAR; PG8_WAIT_L(0); PG8_MMA(1, 0, At, B0); PG8_BAR; PG8_SCHED;
            PG8_STAGEB(PG8_SB(0, 1), b2 + hstepB);
            PG8_WAIT_V(6); PG8_BAR; PG8_MMA(1, 1, At, B1); PG8_BAR;
            PG8_LDB(B0, 1, 0); PG8_SCHED; PG8_LDA(At, 1, 0); PG8_STAGE2(PG8_SA(0, 1), a2 + hstepA, VN1(0), VN1(1));
            PG8_WAIT_L(8); PG8_BAR; PG8_WAIT_L(0); PG8_MMA(0, 0, At, B0); PG8_BAR; PG8_SCHED;
            PG8_LDB(B1, 1, 1); PG8_STAGEB(PG8_SB(1, 0), b3);
            PG8_BAR; PG8_WAIT_L(0); PG8_MMA(0, 1, At, B1); PG8_BAR;
            PG8_LDA(At, 1, 1); PG8_STAGE2(PG8_SA(1, 0), a3, VN0(0), VN0(1));
            PG8_BAR; PG8_WAIT_L(0); PG8_MMA(1, 0, At, B0); PG8_BAR; PG8_SCHED;
            PG8_STAGEB(PG8_SB(1, 1), b3 + hstepB);
            PG8_WAIT_V(6); PG8_BAR; PG8_MMA(1, 1, At, B1); PG8_BAR;
        }
        {
            int epm = cur.pm, epn = cur.pn; asm volatile("" : "+s"(epm), "+s"(epn));
            unsigned eln = (unsigned)lane; asm volatile("" : "+v"(eln)); const int efr = (int)(eln & 15u), efq = (int)(eln >> 4);
#pragma unroll
            for (int ai = 0; ai < 2; ++ai)
#pragma unroll
                for (int m = 0; m < 4; ++m) {
                    const int row = epm * BM + ai * HALF + wr * 64 + m * 16 + efr;
#pragma unroll
                    for (int bj = 0; bj < 2; ++bj) {
                        if constexpr (Epi::PAIR) E.store_pair(row, epn * (BM / 2) + bj * (HALF / 2) + wc * 16 + 4 * efq, acc[ai][bj][m][0], acc[ai][bj][m][1]);
                        else {
#pragma unroll
                            for (int n = 0; n < 2; ++n) E.store(row, epn * BM + bj * HALF + wc * 32 + n * 16 + 4 * efq, acc[ai][bj][m][n]);
                        }
                    }
                }
        }
        if (!has_next) break;
#pragma unroll
        for (int a = 0; a < 2; ++a)
#pragma unroll
            for (int b = 0; b < 2; ++b)
#pragma unroll
                for (int m = 0; m < 4; ++m)
#pragma unroll
                    for (int n = 0; n < 2; ++n) acc[a][b][m][n] = (f32x4){0.f, 0.f, 0.f, 0.f};
        cur = nxt; cB = nB; cA = nA; ++ui;
    }
    PG8_WAIT_V(0);
    if (wr == 0) PG8_BAR;
    PG8_BAR;
#undef PG8_GATHER_OFFS
#undef VC0
#undef VC1
#undef VN0
#undef VN1
#undef PG8_SA
#undef PG8_SB
#undef PG8_STAGE2
#undef PG8_STAGEB
#undef PG8_LDA
#undef PG8_LDB
#undef PG8_MMA
#undef PG8_WAIT_V
#undef PG8_WAIT_L
#undef PG8_BAR
#undef PG8_SCHED
}
}

template <class Epi>
__device__ __forceinline__ void gemm_fast(Frame& F, const bf16* A, int lda, const bf16* Bt, int ldb, int K, int M, int N, const Epi& E) {
    pg8::OrderPlain S; S.init(M / 256, N / 256, F.G, F.wg);
    pg8::gemm_phase(F.lds, A, lda, Bt, ldb, K, S, E);
}
#ifndef FAST_PLAIN
#define FAST_PLAIN 1
#endif
#ifndef FAST_HORNER
#define FAST_HORNER 1
#endif
#ifndef FAST_MOE
#define FAST_MOE 1
#endif

__device__ __forceinline__ void st_bf16x4(bf16* p, f32x4 v) { u32x2 w; w.x = pk2(v.x, v.y); w.y = pk2(v.z, v.w); *(u32x2*)p = w; }
__device__ __forceinline__ f32x4 ld_bf16x4(const bf16* p) { const u32x2 w = *(const u32x2*)p; f32x4 v; v.x = __uint_as_float(w.x << 16); v.y = __uint_as_float(w.x & 0xffff0000u); v.z = __uint_as_float(w.y << 16); v.w = __uint_as_float(w.y & 0xffff0000u); return v; }

struct EpiWin {
    static constexpr bool HORNER = false, PAIR = false;
    const float* bias; bf16 *hytl, *hytc, *ret, *ml; float* mlg;
    __device__ __forceinline__ f32x4 rescale(int, int, int, f32x4 v) const { return v; }
    __device__ __forceinline__ void store(int row, int col, f32x4 v) const {
        v += *(const f32x4*)(bias + col);
        if (col < 1152) {
            if (row < TOKL) { const int b = row >> 11, t = row & 2047; bf16* d = hytl + ((size_t)(b * 1152 + col)) * 2048 + t;
                d[0] = (bf16)f2bf(v.x); d[2048] = (bf16)f2bf(v.y); d[4096] = (bf16)f2bf(v.z); d[6144] = (bf16)f2bf(v.w); }
            else { const int r = row - TOKL, b = r >> 8, t = r & 255; bf16* d = hytc + ((size_t)(b * 1152 + col)) * 256 + t;
                d[0] = (bf16)f2bf(v.x); d[256] = (bf16)f2bf(v.y); d[512] = (bf16)f2bf(v.z); d[768] = (bf16)f2bf(v.w); }
        } else if (col < 1168) { *(f32x4*)(mlg + (size_t)row * 16 + (col - 1152)) = v; }
        else if (col < 1280) { }
        else if (col < 2816) st_bf16x4(ret + (size_t)row * 1536 + (col - 1280), v);
        else st_bf16x4(ml + (size_t)row * 1024 + (col - 2816), v);
    }
};
struct EpiGate {
    static constexpr bool HORNER = false, PAIR = false;
    const float* bias; bf16* gates;
    __device__ __forceinline__ f32x4 rescale(int, int, int, f32x4 v) const { return v; }
    __device__ __forceinline__ void store(int row, int col, f32x4 v) const {
        v += *(const f32x4*)(bias + col);
        f32x4 g; g.x = fmaxf(sigmoidf_(v.x), 1e-20f); g.y = fmaxf(sigmoidf_(v.y), 1e-20f); g.z = fmaxf(sigmoidf_(v.z), 1e-20f); g.w = fmaxf(sigmoidf_(v.w), 1e-20f);
        st_bf16x4(gates + (size_t)row * NGATE + col, g);
    }
};
struct EpiUp {
    static constexpr bool HORNER = true, PAIR = false;
    const bf16* gates; bf16* acc_out;
    __device__ __forceinline__ f32x4 rescale(int seg, int row, int col, f32x4 v) const {
        const f32x4 a = ld_bf16x4(gates + (size_t)row * NGATE + seg * 1024 + col), b = ld_bf16x4(gates + (size_t)row * NGATE + (seg + 1) * 1024 + col);
        v.x *= a.x * __builtin_amdgcn_rcpf(b.x); v.y *= a.y * __builtin_amdgcn_rcpf(b.y); v.z *= a.z * __builtin_amdgcn_rcpf(b.z); v.w *= a.w * __builtin_amdgcn_rcpf(b.w); return v;
    }
    __device__ __forceinline__ void store(int row, int col, f32x4 v) const {
        const f32x4 g = ld_bf16x4(gates + (size_t)row * NGATE + 2048 + col);
        st_bf16x4(acc_out + (size_t)row * D + col, v * g);
    }
};
struct EpiResid {
    static constexpr bool HORNER = false, PAIR = false;
    const float *xin_l, *xin_c; float *xout_l, *xout_c; const float* modbase; int which;
    __device__ __forceinline__ f32x4 rescale(int, int, int, f32x4 v) const { return v; }
    __device__ __forceinline__ void store(int row, int col, f32x4 v) const {
        const int r = row < TOKL ? (row >> 11) : 16;
        const f32x4 m = *(const f32x4*)(modbase + ((size_t)r * 6 + which) * 1024 + col);
        if (row < TOKL) { const size_t o = (size_t)row * D + col; *(f32x4*)(xout_l + o) = *(const f32x4*)(xin_l + o) + m * v; }
        else { const size_t o = (size_t)(row - TOKL) * D + col; *(f32x4*)(xout_c + o) = *(const f32x4*)(xin_c + o) + m * v; }
    }
};
struct EpiSwiglu {
    static constexpr bool HORNER = false, PAIR = true;
    bf16* act; int row_off;
    __device__ __forceinline__ f32x4 rescale(int, int, int, f32x4 v) const { return v; }
    __device__ __forceinline__ void store_pair(int row, int col, f32x4 a, f32x4 b) const {
        f32x4 o; o.x = siluf_(a.x) * b.x; o.y = siluf_(a.y) * b.y; o.z = siluf_(a.z) * b.z; o.w = siluf_(a.w) * b.w;
        st_bf16x4(act + (size_t)(row - row_off) * DFF + col, o);
    }
};
struct EpiBf16Out {
    static constexpr bool HORNER = false, PAIR = false;
    bf16* out; int ld; int row_add;
    __device__ __forceinline__ f32x4 rescale(int, int, int, f32x4 v) const { return v; }
    __device__ __forceinline__ void store(int row, int col, f32x4 v) const { st_bf16x4(out + (size_t)(row + row_add) * ld + col, v); }
};

constexpr int ZPITCH_L = (LL + 8) * 2, ZPITCH_C = (LC + 8) * 2;
template <int L>
__device__ __forceinline__ float conv3_at(const bf16* base  , int t, float w0, float w1, float w2) {
    const float a = t > 0 ? bf2f(base[t - 1]) : 0.f, b = bf2f(base[t]), c = t < L - 1 ? bf2f(base[t + 1]) : 0.f;
    return w0 * a + w1 * b + w2 * c;
}
template <int L>
__device__ __forceinline__ void hyena_unit_naive(Frame& F, int layer, int c, const bf16* hyt  , const bf16* ft  , bf16* yht  ) {
    constexpr int ZP = (L + 8) * 2;
    constexpr int PER = L / 32;
    constexpr int SUB = 8;
    LAS unsigned char* zimg0 = F.lds;
    LAS unsigned char* zimg1 = F.lds + 16 * ZP;
    LAS bf16* tf = (LAS bf16*)(F.lds + 32 * ZP);
    const float* cw = inp(F, I_HYCONV) + layer * 3 * 1152;
    const float* skip = inp(F, I_HYSKIP) + layer * 2 * 384;
    __syncthreads();
    {
        const int b = F.tid >> 5, seg = F.tid & 31; const bf16* src = hyt + ((size_t)(b * 1152 + c)) * L;
        const float w0 = cw[c], w1 = cw[1152 + c], w2 = cw[2304 + c];
#pragma unroll 2
        for (int j = 0; j < PER; ++j) { const int t = seg * PER + j; *(LAS bf16*)(zimg0 + b * ZP + t * 2) = (bf16)f2bf(conv3_at<L>(src, t, w0, w1, w2)); }
    }
#pragma unroll 1
    for (int o = 0; o < 2; ++o) {
        LAS unsigned char* zs = o == 0 ? zimg0 : zimg1;
        LAS unsigned char* zd = o == 0 ? zimg1 : zimg0;
        const bf16* fsrc = ft + ((size_t)(o * 384 + c)) * (2 * L);
        for (int i = F.tid; i < 2 * L; i += NTHR) tf[i] = i == 0 ? (bf16)0 : fsrc[i];
        __syncthreads();
        const int b = F.tid & 15, tg = F.tid >> 4;
        const int gcol = (o == 0 ? 384 : 768) + c;
        const bf16* gsrc = hyt + ((size_t)(b * 1152 + gcol)) * L;
        const float w0 = cw[gcol], w1 = cw[1152 + gcol], w2 = cw[2304 + gcol], sk = skip[o * 384 + c];
#pragma unroll 1
        for (int sb = 0; sb < PER / SUB; ++sb) {
            const int t0 = tg * PER + sb * SUB;
            float acc[SUB];
#pragma unroll
            for (int j = 0; j < SUB; ++j) acc[j] = 0.f;
#pragma unroll 1
            for (int s0 = 0; s0 < L; s0 += 8) {
                float z[8];
                { const bf16x8 zz = *(const LAS bf16x8*)(zs + b * ZP + s0 * 2);
#pragma unroll
                  for (int i = 0; i < 8; ++i) z[i] = bf2f((bf16)zz[i]); }
                float win[SUB + 7];
                const int wb = L + s0 - t0 - (SUB - 1);
#pragma unroll
                for (int i = 0; i < SUB + 7; ++i) win[i] = bf2f(tf[wb + i]);
#pragma unroll
                for (int j = 0; j < SUB; ++j)
#pragma unroll
                    for (int i = 0; i < 8; ++i) acc[j] += win[(SUB - 1) - j + i] * z[i];
            }
#pragma unroll
            for (int j = 0; j < SUB; ++j) {
                const int t = t0 + j;
                const float zt = bf2f(*(LAS bf16*)(zs + b * ZP + t * 2));
                const float ov = conv3_at<L>(gsrc, t, w0, w1, w2) * (acc[j] + sk * zt);
                *(LAS bf16*)(zd + b * ZP + t * 2) = (bf16)f2bf(ov);
            }
        }
        __syncthreads();
    }
#pragma unroll 2
    for (int i = F.tid; i < 16 * (L / 8); i += NTHR) {
        const int b = i / (L / 8), ch = i % (L / 8);
        *(u32x4*)(yht + ((size_t)(b * 384 + c)) * L + ch * 8) = *(const LAS u32x4*)(zimg0 + b * ZP + ch * 16);
    }
}

__device__ __forceinline__ void chain_naive(Frame& F, int layer, int chain) {
    const int lane = F.lane;
    const bool is_ret = chain < 192;
    int b, h, dir;
    if (is_ret) { b = chain / 12; const int r = chain % 12; h = r >> 1; dir = r & 1; }
    else { const int i = chain - 192; b = i >> 3; h = (i & 7) >> 1; dir = i & 1; }
    const bf16* RET = WSP(const bf16, WS_RET); const bf16* ML = WSP(const bf16, WS_ML); const float* MLG = WSP(const float, WS_MLG);
    const float* rope = WSP(const float, WS_ROPE);
    bf16* Y = WSP(bf16, WS_Y); bf16* OB = WSP(bf16, WS_OB);
    float gam = 0.f;
    if (is_ret) gam = sigmoidf_(inp(F, I_RETDECAY)[layer * 12 + dir * 6 + h]);
    const float* mlc = inp(F, I_MLCONV) + layer * 3 * 512;
    const float bi = is_ret ? 0.f : inp(F, I_MLGB)[layer * 16 + dir * 8 + h], bfg = is_ret ? 0.f : inp(F, I_MLGB)[layer * 16 + dir * 8 + 4 + h];
    const float qw0 = mlc[h * 64 + lane], qw1 = mlc[512 + h * 64 + lane], qw2 = mlc[1024 + h * 64 + lane];
    const float kw0 = mlc[256 + h * 64 + lane], kw1 = mlc[512 + 256 + h * 64 + lane], kw2 = mlc[1024 + 256 + h * 64 + lane];
    float S[64];
#pragma unroll
    for (int d = 0; d < 64; ++d) S[d] = 0.f;
    float nv = 0.f;
    for (int step = 0; step < LC + LL; ++step) {
        int row, tpos, L; bool lat;
        if (step < LC) { tpos = dir ? (LC - 1 - step) : step; row = TOKL + b * LC + tpos; L = LC; lat = false; }
        else { const int s2 = step - LC; tpos = dir ? (LL - 1 - s2) : s2; row = b * LL + tpos; L = LL; lat = true; }
        float q, k, v, Fm, Im;
        if (is_ret) {
            const bf16* base = RET + (size_t)row * 1536;
            float qs = bf2f(base[h * 64 + lane]), ks = bf2f(base[384 + h * 64 + lane]);
            v = bf2f(base[768 + h * 64 + lane]);
            if (lat) {
                const float qp = bf2f(base[h * 64 + (lane ^ 16)]), kp = bf2f(base[384 + h * 64 + (lane ^ 16)]);
                const int half = lane >> 5, ii = lane & 15, hi = (lane >> 4) & 1;
                const float cs = rope[tpos * 64 + half * 32 + ii], sn = rope[tpos * 64 + half * 32 + 16 + ii];
                q = hi == 0 ? qs * cs - qp * sn : qp * sn + qs * cs;
                k = hi == 0 ? ks * cs - kp * sn : kp * sn + ks * cs;
            } else { q = qs; k = ks; }
            q *= 0.125f; Fm = gam; Im = 1.f;
        } else {
            const bf16* base = ML + (size_t)row * 1024;
            const float q0 = tpos > 0 ? bf2f(base[-1024 + h * 64 + lane]) : 0.f, q1 = bf2f(base[h * 64 + lane]), q2 = tpos < L - 1 ? bf2f(base[1024 + h * 64 + lane]) : 0.f;
            const float k0 = tpos > 0 ? bf2f(base[-1024 + 256 + h * 64 + lane]) : 0.f, k1 = bf2f(base[256 + h * 64 + lane]), k2 = tpos < L - 1 ? bf2f(base[1024 + 256 + h * 64 + lane]) : 0.f;
            q = siluf_(qw0 * q0 + qw1 * q1 + qw2 * q2);
            k = siluf_(kw0 * k0 + kw1 * k1 + kw2 * k2) * 0.125f;
            v = bf2f(base[512 + h * 64 + lane]);
            const float ig = MLG[(size_t)row * 16 + dir * 8 + h] + bi, fg = MLG[(size_t)row * 16 + dir * 8 + 4 + h] + bfg;
            Fm = sigmoidf_(fg); Im = __expf(ig);
        }
        float num = 0.f;
        const float iv = Im * v;
#pragma unroll
        for (int d = 0; d < 64; ++d) {
            const float kd = __int_as_float(__builtin_amdgcn_readlane(__float_as_int(k), d));
            const float qd = __int_as_float(__builtin_amdgcn_readlane(__float_as_int(q), d));
            S[d] = Fm * S[d] + kd * iv;
            num += qd * S[d];
        }
        float o = num;
        if (!is_ret) { nv = Fm * nv + Im * k; const float den = wave_sum(q * nv); o = num / fmaxf(fabsf(den), 1.f); }
        const int cof = is_ret ? (h * 64 + lane) : (384 + h * 64 + lane);
        if (dir == 0) Y[(size_t)row * D + 384 + cof] = (bf16)f2bf(o);
        else OB[(size_t)row * 640 + cof] = (bf16)f2bf(o);
    }
}

constexpr int CH_PITCH = 144;
constexpr int CH_IMG = 64 * CH_PITCH;
constexpr int CH_WAVE_LDS = 3 * CH_IMG + 1024 + 256;
__device__ __forceinline__ void ds_tr16x8(unsigned addr, u32x2 (&lo)[4], u32x2 (&hi)[4]) {
    asm volatile("ds_read_b64_tr_b16 %0, %8\n\tds_read_b64_tr_b16 %1, %8 offset:32\n\tds_read_b64_tr_b16 %2, %8 offset:64\n\tds_read_b64_tr_b16 %3, %8 offset:96\n\t"
                 "ds_read_b64_tr_b16 %4, %8 offset:2304\n\tds_read_b64_tr_b16 %5, %8 offset:2336\n\tds_read_b64_tr_b16 %6, %8 offset:2368\n\tds_read_b64_tr_b16 %7, %8 offset:2400\n\t"
                 "s_waitcnt lgkmcnt(0)"
                 : "=&v"(lo[0]), "=&v"(lo[1]), "=&v"(lo[2]), "=&v"(lo[3]), "=&v"(hi[0]), "=&v"(hi[1]), "=&v"(hi[2]), "=&v"(hi[3]) : "v"(addr) : "memory");
}
static_assert(16 * CH_PITCH == 2304, "ds_tr16x8 offsets");
__device__ __forceinline__ float log_sigmoid_(float x) { return fminf(x, 0.f) - log1pf(__expf(-fabsf(x))); }
__device__ __forceinline__ bf16x8 mk_frag(u32x2 lo, u32x2 hi) { u32x4 w; w.x = lo.x; w.y = lo.y; w.z = hi.x; w.w = hi.y; return __builtin_bit_cast(bf16x8, w); }

template <bool IS_ML>
__device__ __forceinline__ void chain_fast(Frame& F, int layer, int b, int h, int dir, LAS unsigned char* img) {
    constexpr int NET = 4;
    const int lane = F.lane, fr = lane & 15, fq = lane >> 4;
    LAS unsigned char* Qi = img; LAS unsigned char* Ki = img + CH_IMG; LAS unsigned char* Vi = img + 2 * CH_IMG;
    const unsigned qa = (unsigned)(size_t)Qi, ka = (unsigned)(size_t)Ki, va = (unsigned)(size_t)Vi;
    const bf16* RET = WSP(const bf16, WS_RET); const bf16* ML = WSP(const bf16, WS_ML); const float* MLG = WSP(const float, WS_MLG);
    const float* rope = WSP(const float, WS_ROPE);
    bf16* Y = WSP(bf16, WS_Y); bf16* OB = WSP(bf16, WS_OB);
    float lgam = 0.f, bi_ = 0.f, bf_ = 0.f;
    if (!IS_ML) lgam = log_sigmoid_(inp(F, I_RETDECAY)[layer * 12 + dir * 6 + h]);
    else { bi_ = inp(F, I_MLGB)[layer * 16 + dir * 8 + h]; bf_ = inp(F, I_MLGB)[layer * 16 + dir * 8 + 4 + h]; }
    const float* mlc = inp(F, I_MLCONV) + layer * 3 * 512;
    f32x4 C[4][NET];
#pragma unroll
    for (int dt = 0; dt < 4; ++dt)
#pragma unroll
        for (int et = 0; et < NET; ++et) C[dt][et] = (f32x4){0.f, 0.f, 0.f, 0.f};
    const int cq = lane & 7, pr0 = lane >> 3;
    LAS float* nvec = (LAS float*)(img + 3 * CH_IMG + 1024);
    if (IS_ML) nvec[lane] = 0.f;
    const LAS float* nq = nvec + 4 * fq;
#pragma unroll 1
    for (int step = 0; step < 36; ++step) {
        int rowbase, t0, L; bool lat;
        if (step < 4) { const int cc = dir ? 3 - step : step; rowbase = TOKL + b * LC + cc * 64; t0 = cc * 64; L = LC; lat = false; }
        else { const int cc = dir ? 35 - step : step - 4; rowbase = b * LL + cc * 64; t0 = cc * 64; L = LL; lat = true; }
#pragma unroll 1
        for (int i = 0; i < 8; ++i) {
            const int p = pr0 + 8 * i, tl = dir ? 63 - p : p, row = rowbase + tl, tpos = t0 + tl;
            float qv[8], kv[8]; u32x4 vraw;
            if (!IS_ML) {
                const bf16* base = RET + (size_t)row * 1536 + h * 64;
                const u32x4 qr = *(const u32x4*)(base + 8 * cq), kr = *(const u32x4*)(base + 384 + 8 * cq); vraw = *(const u32x4*)(base + 768 + 8 * cq);
                const unsigned qw[4] = {qr.x, qr.y, qr.z, qr.w}, kw[4] = {kr.x, kr.y, kr.z, kr.w};
#pragma unroll
                for (int j = 0; j < 4; ++j) { qv[2 * j] = __uint_as_float(qw[j] << 16); qv[2 * j + 1] = __uint_as_float(qw[j] & 0xffff0000u); kv[2 * j] = __uint_as_float(kw[j] << 16); kv[2 * j + 1] = __uint_as_float(kw[j] & 0xffff0000u); }
                if (lat) {
                    const u32x4 qpr = *(const u32x4*)(base + 8 * (cq ^ 2)), kpr = *(const u32x4*)(base + 384 + 8 * (cq ^ 2));
                    const unsigned qpw[4] = {qpr.x, qpr.y, qpr.z, qpr.w}, kpw[4] = {kpr.x, kpr.y, kpr.z, kpr.w};
                    const int half = cq >> 2, hi = (cq >> 1) & 1, i0 = 8 * (cq & 1);
                    const float* rp = rope + tpos * 64 + half * 32 + i0;
                    const f32x4 c0 = *(const f32x4*)(rp), c1 = *(const f32x4*)(rp + 4), s0 = *(const f32x4*)(rp + 16), s1 = *(const f32x4*)(rp + 20);
                    const float cs[8] = {c0.x, c0.y, c0.z, c0.w, c1.x, c1.y, c1.z, c1.w}, sn[8] = {s0.x, s0.y, s0.z, s0.w, s1.x, s1.y, s1.z, s1.w};
#pragma unroll
                    for (int j = 0; j < 8; ++j) {
                        const float qp = (j & 1) ? __uint_as_float(qpw[j >> 1] & 0xffff0000u) : __uint_as_float(qpw[j >> 1] << 16);
                        const float kp = (j & 1) ? __uint_as_float(kpw[j >> 1] & 0xffff0000u) : __uint_as_float(kpw[j >> 1] << 16);
                        qv[j] = hi ? qp * sn[j] + qv[j] * cs[j] : qv[j] * cs[j] - qp * sn[j];
                        kv[j] = hi ? kp * sn[j] + kv[j] * cs[j] : kv[j] * cs[j] - kp * sn[j];
                    }
                }
#pragma unroll
                for (int j = 0; j < 8; ++j) qv[j] *= 0.125f;
            } else {
                const bf16* base = ML + (size_t)row * 1024 + h * 64 + 8 * cq;
                const u32x4 z4 = (u32x4){0u, 0u, 0u, 0u};
                const float* wq = mlc + h * 64 + 8 * cq; asm volatile("" : "+v"(wq));
                vraw = *(const u32x4*)(base + 512);
#pragma unroll
                for (int qk = 0; qk < 2; ++qk) {
                    const bf16* bb = base + 256 * qk; const float* ww = wq + 256 * qk;
                    const u32x4 r1 = *(const u32x4*)(bb), r0 = tpos > 0 ? *(const u32x4*)(bb - 1024) : z4, r2 = tpos < L - 1 ? *(const u32x4*)(bb + 1024) : z4;
                    const unsigned a0[4] = {r0.x, r0.y, r0.z, r0.w}, a1[4] = {r1.x, r1.y, r1.z, r1.w}, a2[4] = {r2.x, r2.y, r2.z, r2.w};
#pragma unroll
                    for (int j = 0; j < 8; ++j) {
                        const float x0 = (j & 1) ? __uint_as_float(a0[j >> 1] & 0xffff0000u) : __uint_as_float(a0[j >> 1] << 16);
                        const float x1 = (j & 1) ? __uint_as_float(a1[j >> 1] & 0xffff0000u) : __uint_as_float(a1[j >> 1] << 16);
                        const float x2 = (j & 1) ? __uint_as_float(a2[j >> 1] & 0xffff0000u) : __uint_as_float(a2[j >> 1] << 16);
                        const float r = siluf_(ww[j] * x0 + ww[512 + j] * x1 + ww[1024 + j] * x2);
                        if (qk == 0) qv[j] = r; else kv[j] = r * 0.125f;
                    }
                    if (qk == 0) asm volatile("" : "+v"(qv[0]), "+v"(qv[1]), "+v"(qv[2]), "+v"(qv[3]), "+v"(qv[4]), "+v"(qv[5]), "+v"(qv[6]), "+v"(qv[7]) :: "memory");
                }
            }
            u32x4 qo, ko; qo.x = pk2(qv[0], qv[1]); qo.y = pk2(qv[2], qv[3]); qo.z = pk2(qv[4], qv[5]); qo.w = pk2(qv[6], qv[7]);
            ko.x = pk2(kv[0], kv[1]); ko.y = pk2(kv[2], kv[3]); ko.z = pk2(kv[4], kv[5]); ko.w = pk2(kv[6], kv[7]);
            *(LAS u32x4*)(Qi + p * CH_PITCH + 16 * cq) = qo; *(LAS u32x4*)(Ki + p * CH_PITCH + 16 * cq) = ko; *(LAS u32x4*)(Vi + p * CH_PITCH + 16 * cq) = vraw;
        }
        __builtin_amdgcn_sched_barrier(0);
        float f_p, i_p;
        { const int tl = dir ? 63 - lane : lane, row = rowbase + tl;
          if (!IS_ML) { f_p = lgam; i_p = 0.f; }
          else { i_p = MLG[(size_t)row * 16 + dir * 8 + h] + bi_; f_p = log_sigmoid_(MLG[(size_t)row * 16 + dir * 8 + 4 + h] + bf_); } }
        float bsum = f_p;
#pragma unroll
        for (int o = 1; o < 64; o <<= 1) { const float t = __shfl_up(bsum, o); if (lane >= o) bsum += t; }
        LAS float* gv = (LAS float*)(img + 3 * CH_IMG);
        const float b63 = __shfl(bsum, 63);
        const float adec = __expf(b63);
        gv[lane] = bsum; gv[64 + lane] = bsum - i_p; gv[128 + lane] = __expf(bsum); gv[192 + lane] = __expf(b63 - (bsum - i_p));
        asm volatile("s_waitcnt lgkmcnt(0)" ::: "memory");
        const LAS float* gq = gv + 4 * fq;
        const bf16x8 ones = (fr == 0) ? (bf16x8){0x3F80, 0x3F80, 0x3F80, 0x3F80, 0x3F80, 0x3F80, 0x3F80, 0x3F80} : (bf16x8){0, 0, 0, 0, 0, 0, 0, 0};
        const int tr_q = fr >> 2, tr_p = fr & 3;
#pragma unroll 1
        for (int pt = 0; pt < 4; ++pt) {
            f32x4 ST[4];
            bf16x8 qn[2];
#pragma unroll
            for (int kk = 0; kk < 2; ++kk) qn[kk] = *(const LAS bf16x8*)(Qi + (16 * pt + fr) * CH_PITCH + (32 * kk + 8 * fq) * 2);
#pragma unroll
            for (int st = 0; st < 4; ++st) {
                ST[st] = (f32x4){0.f, 0.f, 0.f, 0.f};
                if (st <= pt) {
#pragma unroll
                    for (int kk = 0; kk < 2; ++kk) { const bf16x8 kf = *(const LAS bf16x8*)(Ki + (16 * st + fr) * CH_PITCH + (32 * kk + 8 * fq) * 2); ST[st] = __builtin_amdgcn_mfma_f32_16x16x32_bf16(kf, qn[kk], ST[st], 0, 0, 0); }
                }
            }
            const float bp = gv[16 * pt + fr];
#pragma unroll
            for (int st = 0; st < 4; ++st) {
                if (st <= pt) {
                    const f32x4 bis = *(const LAS f32x4*)(gq + 64 + 16 * st);
#pragma unroll
                    for (int j = 0; j < 4; ++j) { const int sidx = 16 * st + 4 * fq + j; const float w = (sidx <= 16 * pt + fr) ? __expf(bp - bis[j]) : 0.f; ST[st][j] *= w; }
                }
            }
            __builtin_amdgcn_sched_barrier(0);
            f32x4 acc[NET], accd = (f32x4){0.f, 0.f, 0.f, 0.f};
#pragma unroll
            for (int et = 0; et < NET; ++et) acc[et] = (f32x4){0.f, 0.f, 0.f, 0.f};
#pragma unroll
            for (int kk = 0; kk < 2; ++kk) {
                const u32x2 lo = *(const LAS u32x2*)(Qi + (16 * pt + fr) * CH_PITCH + (32 * kk + 4 * fq) * 2), hi = *(const LAS u32x2*)(Qi + (16 * pt + fr) * CH_PITCH + (32 * kk + 16 + 4 * fq) * 2);
                const bf16x8 qs = mk_frag(lo, hi);
#pragma unroll
                for (int et = 0; et < NET; ++et) {
                    u32x4 w; w.x = pk2(C[2 * kk][et].x, C[2 * kk][et].y); w.y = pk2(C[2 * kk][et].z, C[2 * kk][et].w); w.z = pk2(C[2 * kk + 1][et].x, C[2 * kk + 1][et].y); w.w = pk2(C[2 * kk + 1][et].z, C[2 * kk + 1][et].w);
                    acc[et] = __builtin_amdgcn_mfma_f32_16x16x32_bf16(qs, __builtin_bit_cast(bf16x8, w), acc[et], 0, 0, 0);
                }
                if (IS_ML) {
                    const f32x4 n0 = *(const LAS f32x4*)(nq + 32 * kk), n1 = *(const LAS f32x4*)(nq + 32 * kk + 16);
                    u32x4 w; w.x = pk2(n0.x, n0.y); w.y = pk2(n0.z, n0.w); w.z = pk2(n1.x, n1.y); w.w = pk2(n1.z, n1.w);
                    if (fr != 0) w = (u32x4){0u, 0u, 0u, 0u};
                    accd = __builtin_amdgcn_mfma_f32_16x16x32_bf16(qs, __builtin_bit_cast(bf16x8, w), accd, 0, 0, 0);
                }
            }
            { const f32x4 ap = *(const LAS f32x4*)(gq + 128 + 16 * pt);
#pragma unroll
              for (int j = 0; j < 4; ++j) {
#pragma unroll
                for (int et = 0; et < NET; ++et) acc[et][j] *= ap[j];
                accd[j] *= ap[j]; } }
            __builtin_amdgcn_sched_barrier(0);
#pragma unroll
            for (int kk = 0; kk < 2; ++kk) {
                if (2 * kk <= pt) {
                    u32x4 w; w.x = pk2(ST[2 * kk].x, ST[2 * kk].y); w.y = pk2(ST[2 * kk].z, ST[2 * kk].w); w.z = pk2(ST[2 * kk + 1].x, ST[2 * kk + 1].y); w.w = pk2(ST[2 * kk + 1].z, ST[2 * kk + 1].w);
                    const bf16x8 pf = __builtin_bit_cast(bf16x8, w);
                    u32x2 vlo[4], vhi[4];
                    ds_tr16x8(va + (32 * kk + 4 * fq + tr_q) * CH_PITCH + 8 * tr_p, vlo, vhi);
#pragma unroll
                    for (int et = 0; et < 4; ++et) acc[et] = __builtin_amdgcn_mfma_f32_16x16x32_bf16(pf, mk_frag(vlo[et], vhi[et]), acc[et], 0, 0, 0);
                    if (IS_ML) accd = __builtin_amdgcn_mfma_f32_16x16x32_bf16(pf, ones, accd, 0, 0, 0);
                }
            }
            __builtin_amdgcn_sched_barrier(0);
#pragma unroll
            for (int j = 0; j < 4; ++j) {
                const int p = 16 * pt + 4 * fq + j, tl = dir ? 63 - p : p, row = rowbase + tl;
                float inv = 1.f;
                if (IS_ML) { const float den = __shfl(accd[j], lane & 48); inv = 1.f / fmaxf(fabsf(den), 1.f); }
#pragma unroll
                for (int et = 0; et < 4; ++et) {
                    const float o = acc[et][j] * inv;
                    const int cof = (IS_ML ? 384 : 0) + h * 64 + 16 * et + fr;
                    if (dir == 0) Y[(size_t)row * D + 384 + cof] = (bf16)f2bf(o); else OB[(size_t)row * 640 + cof] = (bf16)f2bf(o);
                }
            }
        }
        __builtin_amdgcn_sched_barrier(0);
#pragma unroll
        for (int dt = 0; dt < 4; ++dt)
#pragma unroll
            for (int et = 0; et < NET; ++et) C[dt][et] *= adec;
        f32x4 accn[4];
        if (IS_ML) {
#pragma unroll
            for (int dt = 0; dt < 4; ++dt) { accn[dt] = *(const LAS f32x4*)(nq + 16 * dt) * adec; if (fr != 0) accn[dt] = (f32x4){0.f, 0.f, 0.f, 0.f}; }
        }
#pragma unroll
        for (int kk = 0; kk < 2; ++kk) {
            u32x2 vlo[4], vhi[4], klo[4], khi[4];
            ds_tr16x8(va + (32 * kk + 4 * fq + tr_q) * CH_PITCH + 8 * tr_p, vlo, vhi);
            ds_tr16x8(ka + (32 * kk + 4 * fq + tr_q) * CH_PITCH + 8 * tr_p, klo, khi);
            const f32x4 wl = *(const LAS f32x4*)(gq + 192 + 32 * kk), wh = *(const LAS f32x4*)(gq + 192 + 32 * kk + 16);
#pragma unroll
            for (int dt = 0; dt < 4; ++dt) {
                u32x4 w;
                w.x = pk2(__uint_as_float(klo[dt].x << 16) * wl[0], __uint_as_float(klo[dt].x & 0xffff0000u) * wl[1]);
                w.y = pk2(__uint_as_float(klo[dt].y << 16) * wl[2], __uint_as_float(klo[dt].y & 0xffff0000u) * wl[3]);
                w.z = pk2(__uint_as_float(khi[dt].x << 16) * wh[0], __uint_as_float(khi[dt].x & 0xffff0000u) * wh[1]);
                w.w = pk2(__uint_as_float(khi[dt].y << 16) * wh[2], __uint_as_float(khi[dt].y & 0xffff0000u) * wh[3]);
                const bf16x8 kf = __builtin_bit_cast(bf16x8, w);
#pragma unroll
                for (int et = 0; et < 4; ++et) C[dt][et] = __builtin_amdgcn_mfma_f32_16x16x32_bf16(kf, mk_frag(vlo[et], vhi[et]), C[dt][et], 0, 0, 0);
                if (IS_ML) accn[dt] = __builtin_amdgcn_mfma_f32_16x16x32_bf16(kf, ones, accn[dt], 0, 0, 0);
            }
        }
        if (IS_ML) { if (fr == 0) {
#pragma unroll
            for (int dt = 0; dt < 4; ++dt) *(LAS f32x4*)(nvec + 4 * fq + 16 * dt) = accn[dt]; } }
        asm volatile("s_waitcnt lgkmcnt(0)" ::: "memory");
    }
}

#ifndef FAST_CHAIN
#define FAST_CHAIN 1
#endif
constexpr int NCHWG = 80;
__device__ __forceinline__ void phase_mix(Frame& F, int layer) {
    const bool last = layer == 1;
    const bf16* ftl = WSP(const bf16, WS_FTL) + (size_t)layer * 2 * 384 * 4096;
    if (FAST_CHAIN) {
        if (F.wg < NCHWG) {
            if (F.wave < 4) {
                const int c = F.wg * 4 + F.wave;
                LAS unsigned char* img = F.lds + F.wave * CH_WAVE_LDS;
                if (c < 192) { const int b = c / 12, r = c % 12; chain_fast<false>(F, layer, b, r >> 1, r & 1, img); }
                else { const int i = c - 192; chain_fast<true>(F, layer, i >> 3, (i & 7) >> 1, i & 1, img); }
            }
        } else {
            const int nh = F.G - NCHWG, w = F.wg - NCHWG;
            for (int u = w; u < 384; u += nh) hyena_unit_naive<LL>(F, layer, u, WSP(const bf16, WS_HYTL), ftl, WSP(bf16, WS_YHTL));
            if (!last) for (int u = w; u < 384; u += nh) hyena_unit_naive<LC>(F, layer, u, WSP(const bf16, WS_HYTC), WSP(const bf16, WS_FTC), WSP(bf16, WS_YHTC));
        }
    } else {
        for (int u = F.wg; u < 384; u += F.G) hyena_unit_naive<LL>(F, layer, u, WSP(const bf16, WS_HYTL), ftl, WSP(bf16, WS_YHTL));
        if (!last) for (int u = F.wg; u < 384; u += F.G) hyena_unit_naive<LC>(F, layer, u, WSP(const bf16, WS_HYTC), WSP(const bf16, WS_FTC), WSP(bf16, WS_YHTC));
        for (int c = F.wg + F.wave * F.G; c < 320; c += F.G * NWAVES) chain_naive(F, layer, c);
    }
}

__device__ __forceinline__ void phase_combine(Frame& F, int layer) {
    const bool last = layer == 1;
    const int gw = F.wg * NWAVES + F.wave, NGW = F.G * NWAVES, lane = F.lane;
    const int nrows = last ? TOKL : TOK;
    bf16* Y = WSP(bf16, WS_Y); const bf16* OB = WSP(const bf16, WS_OB); const bf16* RET = WSP(const bf16, WS_RET); const bf16* ML = WSP(const bf16, WS_ML);
    for (int row = gw; row < nrows; row += NGW) {
#pragma unroll
        for (int hh = 0; hh < 10; ++hh) {
            const int cof = hh * 64 + lane;
            const float x = bf2f(Y[(size_t)row * D + 384 + cof]) + bf2f(OB[(size_t)row * 640 + cof]);
            const float mu = wave_sum(x) * (1.f / 64.f), xc = x - mu;
            const float var = wave_sum(xc * xc) * (1.f / 64.f);
            const float nrm = xc * rsqrtf(var + 1e-6f);
            float gate;
            if (hh < 6) gate = siluf_(bf2f(RET[(size_t)row * 1536 + 1152 + cof]));
            else gate = sigmoidf_(bf2f(ML[(size_t)row * 1024 + 768 + (cof - 384)]));
            Y[(size_t)row * D + 384 + cof] = (bf16)f2bf(nrm * gate);
        }
    }
    LAS float* scr = (LAS float*)(F.lds + F.wave * 16640);
    const int nitL = NB * 6 * 32, nitC = last ? 0 : NB * 6 * 4;
    for (int it = gw; it < nitL + nitC; it += NGW) {
        const bf16* src; int L, rowbase, b, cb, tb;
        if (it < nitL) { b = it / 192; const int r = it % 192; cb = r / 32; tb = r % 32; L = LL; src = WSP(const bf16, WS_YHTL); rowbase = b * LL; }
        else { const int i2 = it - nitL; b = i2 / 24; const int r = i2 % 24; cb = r / 4; tb = r % 4; L = LC; src = WSP(const bf16, WS_YHTC); rowbase = TOKL + b * LC; }
        for (int cc = 0; cc < 64; ++cc) scr[cc * 65 + lane] = bf2f(src[((size_t)(b * 384 + cb * 64 + cc)) * L + tb * 64 + lane]);
        asm volatile("s_waitcnt lgkmcnt(0)" ::: "memory");
        for (int tt = 0; tt < 64; ++tt) Y[(size_t)(rowbase + tb * 64 + tt) * D + cb * 64 + lane] = (bf16)f2bf(scr[lane * 65 + tt]);
        asm volatile("s_waitcnt lgkmcnt(0)" ::: "memory");
    }
}

__device__ __forceinline__ void phase_norm_router(Frame& F) {
    const int gw = F.wg * NWAVES + F.wave, NGW = F.G * NWAVES, lane = F.lane;
    const float* g = inp(F, I_GFFN) + 1 * D; const float* wr = inp(F, I_ROUTER); const float* br = inp(F, I_ROUTERB);
    unsigned* cnt = WSP(unsigned, WS_CTL) + CW_CNT;
    for (int row = gw; row < TOKL; row += NGW) {
        float keep[16];
        norm_mod_row(xrow_ptr(F, row, false), g, mod_ptr(F, 1, row, 3), mod_ptr(F, 1, row, 4), WSP(bf16, WS_H) + (size_t)row * D, lane, keep);
        float lg[8];
#pragma unroll
        for (int e = 0; e < 8; ++e) lg[e] = 0.f;
#pragma unroll
        for (int j = 0; j < 4; ++j)
#pragma unroll
            for (int i = 0; i < 4; ++i) { const int k = 256 * j + 4 * lane + i; const f32x4 w0 = *(const f32x4*)(wr + k * 8), w1 = *(const f32x4*)(wr + k * 8 + 4); const float x = keep[4 * j + i];
                lg[0] += x * w0.x; lg[1] += x * w0.y; lg[2] += x * w0.z; lg[3] += x * w0.w; lg[4] += x * w1.x; lg[5] += x * w1.y; lg[6] += x * w1.z; lg[7] += x * w1.w; }
#pragma unroll
        for (int e = 0; e < 8; ++e) lg[e] = wave_sum(lg[e]) + br[e];
        int e0 = 0; float v0 = lg[0];
#pragma unroll
        for (int e = 1; e < 8; ++e) if (lg[e] > v0) { v0 = lg[e]; e0 = e; }
        int e1 = -1; float v1 = -3.0e38f;
#pragma unroll
        for (int e = 0; e < 8; ++e) if (e != e0 && lg[e] > v1) { v1 = lg[e]; e1 = e; }
        const float w1 = 1.f / (1.f + __expf(v0 - v1)), w0 = 1.f - w1;
        if (lane == 0) {
            const unsigned p0 = atomicAdd(cnt + e0, 1u), p1 = atomicAdd(cnt + e1, 1u);
            WSP(int, WS_TOPE)[row * 2] = e0; WSP(int, WS_TOPE)[row * 2 + 1] = e1;
            WSP(float, WS_TOPW)[row * 2] = w0; WSP(float, WS_TOPW)[row * 2 + 1] = w1;
            WSP(int, WS_TOPP)[row * 2] = (int)p0; WSP(int, WS_TOPP)[row * 2 + 1] = (int)p1;
        }
    }
}
__device__ __forceinline__ void phase_route_tables(Frame& F) {
    const unsigned* cnt = WSP(const unsigned, WS_CTL) + CW_CNT;
    int off[9]; off[0] = 0;
#pragma unroll
    for (int e = 0; e < 8; ++e) { const int c = (int)__hip_atomic_load(cnt + e, __ATOMIC_RELAXED, __HIP_MEMORY_SCOPE_AGENT); off[e + 1] = off[e] + ((c + 255) >> 8) * 256; }
    const int gt = F.wg * NTHR + F.tid, NGT = F.G * NTHR;
    int* rowidx = WSP(int, WS_ROWIDX); int* slot = WSP(int, WS_SLOT); int* tilee = WSP(int, WS_TILEE);
    for (int i = gt; i < MAXTILES * 256; i += NGT) {
        int e = 0;
#pragma unroll
        for (int q = 1; q < 8; ++q) if (i >= off[q]) e = q;
        const int c = (int)cnt[e];
        if (i >= off[8] || i - off[e] >= c) rowidx[i] = 0;
    }
    for (int i = gt; i < TOKL * 2; i += NGT) {
        const int e = WSP(const int, WS_TOPE)[i], pos = WSP(const int, WS_TOPP)[i];
        int o = 0;
#pragma unroll
        for (int q = 0; q < 8; ++q) if (e == q) o = off[q];
        const int s = o + pos; slot[i] = s; rowidx[s] = i >> 1;
    }
    for (int i = gt; i < MAXTILES + 1; i += NGT) {
        if (i == MAXTILES) tilee[MAXTILES] = off[8] >> 8;
        else { int e = 0;
#pragma unroll
            for (int q = 1; q < 8; ++q) if (i * 256 >= off[q]) e = q;
            tilee[i] = e; }
    }
}

__device__ __forceinline__ void moe_pass_gemm1(Frame& F, int t0, int t1) {
    const int gw = F.wg * NWAVES + F.wave, NGW = F.G * NWAVES;
    const int* tilee = WSP(const int, WS_TILEE); RowsGather R{WSP(const int, WS_ROWIDX)};
    const int nct = NFF1 / 64, nunits = (t1 - t0) * 4 * nct;
    EpiSwiglu E{WSP(bf16, WS_MACT), t0 * 256};
    for (int u = gw; u < nunits; u += NGW) {
        const int rt = u / nct, ct = u % nct, tile = t0 + (rt >> 2);
        const bf16* Bt = WSP(const bf16, WS_MW13) + (size_t)tilee[tile] * NFF1 * D;
        gemm_simple_tile(WSP(const bf16, WS_H), D, Bt, D, D, t0 * 4 + rt, ct, E, R, F.lane);
    }
}
__device__ __forceinline__ void moe_pass_gemm2(Frame& F, int t0, int t1) {
    const int gw = F.wg * NWAVES + F.wave, NGW = F.G * NWAVES;
    const int* tilee = WSP(const int, WS_TILEE);
    const int nct = D / 64, nunits = (t1 - t0) * 4 * nct;
    EpiBf16Out E{WSP(bf16, WS_EOUT), D, t0 * 256};
    for (int u = gw; u < nunits; u += NGW) {
        const int rt = u / nct, ct = u % nct, tile = t0 + (rt >> 2);
        const bf16* Bt = WSP(const bf16, WS_MW2) + (size_t)tilee[tile] * D * DFF;
        gemm_simple_tile(WSP(const bf16, WS_MACT), DFF, Bt, DFF, DFF, rt, ct, E, RowsId(), F.lane);
    }
}
__device__ __forceinline__ void moe_pass_gemm1_fast(Frame& F, int t0, int t1) {
    pg8::OrderMoe S; S.o.init(t1 - t0, NFF1 / 256, F.G, F.wg); S.rowidx = WSP(const int, WS_ROWIDX); S.tilee = WSP(const int, WS_TILEE); S.t0 = t0; S.bstride = (size_t)NFF1 * D; S.gather = true;
    EpiSwiglu E{WSP(bf16, WS_MACT), 0};
    pg8::gemm_phase(F.lds, WSP(const bf16, WS_H), D, WSP(const bf16, WS_MW13), D, D, S, E);
}
__device__ __forceinline__ void moe_pass_gemm2_fast(Frame& F, int t0, int t1) {
    pg8::OrderMoe S; S.o.init(t1 - t0, D / 256, F.G, F.wg); S.rowidx = WSP(const int, WS_ROWIDX); S.tilee = WSP(const int, WS_TILEE); S.t0 = t0; S.bstride = (size_t)D * DFF; S.gather = false;
    EpiBf16Out E{WSP(bf16, WS_EOUT), D, t0 * 256};
    pg8::gemm_phase(F.lds, WSP(const bf16, WS_MACT), DFF, WSP(const bf16, WS_MW2), DFF, DFF, S, E);
}
__device__ __forceinline__ void phase_final(Frame& F) {
    const int gw = F.wg * NWAVES + F.wave, NGW = F.G * NWAVES, lane = F.lane;
    const float* gf = inp(F, I_GFINAL); const bf16* eo = WSP(const bf16, WS_EOUT);
    for (int row = gw; row < TOKL; row += NGW) {
        const int s0 = WSP(const int, WS_SLOT)[row * 2], s1 = WSP(const int, WS_SLOT)[row * 2 + 1];
        const float w0 = WSP(const float, WS_TOPW)[row * 2], w1 = WSP(const float, WS_TOPW)[row * 2 + 1];
        const float* m5 = mod_ptr(F, 1, row, 5);
        float* xr = outp(F) + (size_t)row * D;
        f32x4 v[4]; float s = 0.f;
#pragma unroll
        for (int j = 0; j < 4; ++j) {
            const int c = 256 * j + 4 * lane;
            const f32x4 a = ld_bf16x4(eo + (size_t)s0 * D + c), b = ld_bf16x4(eo + (size_t)s1 * D + c), m = *(const f32x4*)(m5 + c);
            v[j] = *(const f32x4*)(xr + c) + m * (a * w0 + b * w1);
            s += (v[j].x * v[j].x + v[j].y * v[j].y) + (v[j].z * v[j].z + v[j].w * v[j].w);
        }
        const float r = rsqrtf(wave_sum(s) * (1.f / 1024.f) + 1e-6f);
#pragma unroll
        for (int j = 0; j < 4; ++j) { const int c = 256 * j + 4 * lane; const f32x4 g = *(const f32x4*)(gf + c); *(f32x4*)(xr + c) = v[j] * r * g; }
    }
}

__global__ void __launch_bounds__(NTHR, 2) hybrid_fwd(Params prm) {
    extern __shared__ __attribute__((aligned(16))) unsigned char lds_raw[];
    Frame F;
    F.lds = (LAS unsigned char*)lds_raw; F.ws = prm.ws;
    F.tid = threadIdx.x; F.lane = F.tid & 63; F.wave = __builtin_amdgcn_readfirstlane(F.tid >> 6); F.G = gridDim.x; F.wg = blockIdx.x;
    volatile LAS unsigned* MISC = (volatile LAS unsigned*)(F.lds + MISC_OFF);
    if (F.tid < 64) MISC[F.tid] = 0u;
    if (F.tid < 33) { const unsigned long long v = F.tid < 32 ? (unsigned long long)prm.in[F.tid] : (unsigned long long)prm.out; *(LAS unsigned long long*)(F.lds + PTAB_OFF + 8 * F.tid) = v; }
    __syncthreads();
    XcdBarrier bar = xcd_barrier_post(WSP(unsigned, WS_CTL) + CW_BAR, MISC + 8);
#define RELAUNDER() do { { unsigned long long _w = (unsigned long long)F.ws; asm volatile("" : "+s"(_w)); F.ws = (unsigned char*)_w; } \
        { unsigned _t = (unsigned)F.tid; asm volatile("" : "+v"(_t)); F.tid = (int)_t; F.lane = F.tid & 63; F.wave = __builtin_amdgcn_readfirstlane(F.tid >> 6); } \
        { unsigned _g = (unsigned)F.G, _b = (unsigned)F.wg; asm volatile("" : "+s"(_g), "+s"(_b)); F.G = (int)_g; F.wg = (int)_b; } \
        { unsigned _l = (unsigned)(size_t)F.lds; asm volatile("" : "+s"(_l)); F.lds = (LAS unsigned char*)(size_t)_l; } } while (0)
#define GRID_BAR() do { { unsigned long long _b = (unsigned long long)bar.bar; unsigned _x = bar.x; asm volatile("" : "+s"(_b), "+s"(_x)); bar.bar = (unsigned*)_b; bar.x = _x; } xcd_barrier(bar); RELAUNDER(); } while (0)

    phase_p0(F); write_bias(F);
    GRID_BAR();
#pragma unroll 1
    for (int layer = 0; layer < 2; ++layer) {
        const bool last = layer == 1;
        const int rows_all = TOK, rows_out = last ? TOKL : TOK;
        const float* modbase = WSP(const float, WS_MOD) + (size_t)layer * 17 * 6144;
        phase_norm(F, layer, rows_all, !last, 0);
        GRID_BAR();
        { EpiWin E{WSP(const float, WS_BIAS) + layer * NWP, WSP(bf16, WS_HYTL), WSP(bf16, WS_HYTC), WSP(bf16, WS_RET), WSP(bf16, WS_ML), WSP(float, WS_MLG)};
          if (FAST_PLAIN) gemm_fast(F, WSP(const bf16, WS_H), D, WSP(const bf16, WS_WIN), D, D, rows_all, NW1, E);
          else gemm_simple(F, WSP(const bf16, WS_H), D, WSP(const bf16, WS_WIN), D, D, rows_all, NW1, E, RowsId()); }
        GRID_BAR();
        phase_mix(F, layer);
        GRID_BAR();
        phase_combine(F, layer);
        GRID_BAR();
        { EpiGate E{WSP(const float, WS_BIAS) + layer * NWP + NW1, WSP(bf16, WS_GATES)};
          if (FAST_PLAIN) gemm_fast(F, WSP(const bf16, WS_H), D, WSP(const bf16, WS_WIN) + (size_t)NW1 * D, D, D, rows_out, NGATE, E);
          else gemm_simple(F, WSP(const bf16, WS_H), D, WSP(const bf16, WS_WIN) + (size_t)NW1 * D, D, D, rows_out, NGATE, E, RowsId()); }
        GRID_BAR();
        { EpiUp E{WSP(const bf16, WS_GATES), WSP(bf16, WS_H)};
          if (FAST_HORNER) gemm_fast(F, WSP(const bf16, WS_Y), D, WSP(const bf16, WS_WUP), D, D, rows_out, D, E);
          else gemm_simple(F, WSP(const bf16, WS_Y), D, WSP(const bf16, WS_WUP), D, D, rows_out, D, E, RowsId()); }
        GRID_BAR();
        { EpiResid E{last ? outp(F) : inp(F, I_X), last ? WSP(const float, WS_XC) : inp(F, I_CTX), outp(F), WSP(float, WS_XC), modbase, 2};
          if (FAST_PLAIN) gemm_fast(F, WSP(const bf16, WS_H), D, WSP(const bf16, WS_WOUT), D, D, rows_out, D, E);
          else gemm_simple(F, WSP(const bf16, WS_H), D, WSP(const bf16, WS_WOUT), D, D, rows_out, D, E, RowsId()); }
        GRID_BAR();
        if (!last) {
            phase_norm(F, layer, rows_out, false, 3);
            { const int gw = F.wg * NWAVES + F.wave, NGW = F.G * NWAVES; LAS float* scr = (LAS float*)(F.lds + F.wave * 8704);
              conv_weights_ffn(inp(F, I_FW1), inp(F, I_FW3), inp(F, I_FW2), WSP(bf16, WS_W13), WSP(bf16, WS_W2), gw, NGW, scr, F.lane);
              conv_weights_win(F, 1, gw, NGW, scr);
              conv_weights_upout(F, 1, gw, NGW, scr); }
            GRID_BAR();
            { EpiSwiglu E{WSP(bf16, WS_ACT), 0};
              if (FAST_PLAIN) gemm_fast(F, WSP(const bf16, WS_H), D, WSP(const bf16, WS_W13), D, D, rows_out, NFF1, E);
              else gemm_simple(F, WSP(const bf16, WS_H), D, WSP(const bf16, WS_W13), D, D, rows_out, NFF1, E, RowsId()); }
            GRID_BAR();
            { EpiResid E{outp(F), WSP(const float, WS_XC), outp(F), WSP(float, WS_XC), modbase, 5};
              if (FAST_PLAIN) gemm_fast(F, WSP(const bf16, WS_ACT), DFF, WSP(const bf16, WS_W2), DFF, DFF, rows_out, D, E);
              else gemm_simple(F, WSP(const bf16, WS_ACT), DFF, WSP(const bf16, WS_W2), DFF, DFF, rows_out, D, E, RowsId()); }
            GRID_BAR();
        }
    }
    phase_norm_router(F);
    { const int gw = F.wg * NWAVES + F.wave, NGW = F.G * NWAVES; LAS float* scr = (LAS float*)(F.lds + F.wave * 8704);
#pragma unroll 1
      for (int e = 0; e < NE; ++e)
          conv_weights_ffn(inp(F, I_MW1) + (size_t)e * D * DFF, inp(F, I_MW3) + (size_t)e * D * DFF, inp(F, I_MW2) + (size_t)e * DFF * D,
                           WSP(bf16, WS_MW13) + (size_t)e * NFF1 * D, WSP(bf16, WS_MW2) + (size_t)e * D * DFF, gw, NGW, scr, F.lane); }
    GRID_BAR();
    phase_route_tables(F);
    GRID_BAR();
    const int ntiles = __builtin_amdgcn_readfirstlane(WSP(const int, WS_TILEE)[MAXTILES]);
#pragma unroll 1
    for (int p = 0; p < NPASS; ++p) {
        const int t0 = p * PASS_TILES, t1 = min(ntiles, t0 + PASS_TILES);
        if (t0 < t1) { if (FAST_MOE) moe_pass_gemm1_fast(F, t0, t1); else moe_pass_gemm1(F, t0, t1); }
        GRID_BAR();
        if (t0 < t1) { if (FAST_MOE) moe_pass_gemm2_fast(F, t0, t1); else moe_pass_gemm2(F, t0, t1); }
        GRID_BAR();
    }
    phase_final(F);
}

extern "C" void kernel_launch(void* const* d_in, const int* in_sizes, int n_in, void* d_out, int out_size, void* d_ws, size_t ws_size, hipStream_t stream) {
    static int grid = 0;
    if (grid == 0) {
        if (n_in != 32 || out_size != TOKL * D || ws_size < WS_END) { fprintf(stderr, "kernel_launch: unexpected arguments (n_in %d, out %d, ws %zu)\n", n_in, out_size, ws_size); grid = -1; return; }
        int dev = 0, cus = 0;
        if (hipGetDevice(&dev) != hipSuccess || hipDeviceGetAttribute(&cus, hipDeviceAttributeMultiprocessorCount, dev) != hipSuccess) { grid = -1; return; }
        if (hipFuncSetAttribute((const void*)hybrid_fwd, hipFuncAttributeMaxDynamicSharedMemorySize, LDS_BYTES) != hipSuccess) { grid = -1; return; }
        int per_cu = 0;
        (void)hipOccupancyMaxActiveBlocksPerMultiprocessor(&per_cu, (const void*)hybrid_fwd, NTHR, LDS_BYTES);
        (void)hipGetLastError();
        grid = cus;
    }
    if (grid < 0) return;
    (void)hipMemsetAsync((char*)d_ws + WS_CTL, 0, CTL_ZERO_BYTES, stream);
    Params p{};
    for (int i = 0; i < 32; ++i) p.in[i] = (const float*)d_in[i];
    p.out = (float*)d_out; p.ws = (unsigned char*)d_ws;
    hipLaunchKernelGGL(hybrid_fwd, dim3(grid), dim3(NTHR), LDS_BYTES, stream, p);
}
```

```cpp
#include <hip/hip_runtime.h>
#include <stdint.h>
#include <stdio.h>

#define LAS __attribute__((address_space(3)))
typedef unsigned short bf16;
typedef short bf16x8 __attribute__((ext_vector_type(8)));
typedef float f32x4 __attribute__((ext_vector_type(4)));
typedef unsigned u32x4 __attribute__((ext_vector_type(4)));
typedef unsigned u32x2 __attribute__((ext_vector_type(2)));

constexpr int D = 1024, NB = 16, LL = 2048, LC = 256;
constexpr int TOKL = NB * LL, TOKC = NB * LC, TOK = TOKL + TOKC;
constexpr int HYW = 384, RETW = 384, MLW = 256;
constexpr int NIN = 6800, NW1 = 3840, NGATE = 3072, NWP = 6912;
constexpr int DFF = 2816, NFF1 = 5632, NE = 8;
constexpr int NWAVES = 8, NTHR = 512;
constexpr int MAXTILES = 272, PASS_TILES = 64, NPASS = 5;

constexpr size_t MiB = 1u << 20;
constexpr size_t WS_CTL = 0, CTL_ZERO_BYTES = 1 * MiB;
constexpr size_t WS_MOD = 1 * MiB;
constexpr size_t WS_BIAS = 2 * MiB;
constexpr size_t WS_ROPE = 2 * MiB + 256 * 1024;
constexpr size_t WS_TOPE = 3 * MiB;
constexpr size_t WS_TOPW = 3 * MiB + 256 * 1024;
constexpr size_t WS_TOPP = 3 * MiB + 512 * 1024;
constexpr size_t WS_SLOT = 3 * MiB + 768 * 1024;
constexpr size_t WS_ROWIDX = 4 * MiB;
constexpr size_t WS_TILEE = 4 * MiB + 512 * 1024;
constexpr size_t WS_FTL = 5 * MiB;
constexpr size_t WS_FTC = 17 * MiB;
constexpr size_t WS_WIN = 18 * MiB;
constexpr size_t WS_WUP = 32 * MiB;
constexpr size_t WS_WOUT = 34 * MiB;
constexpr size_t WS_XC = 36 * MiB;
constexpr size_t WS_H = 52 * MiB;
constexpr size_t WS_Y = 124 * MiB;
constexpr size_t WS_U = 196 * MiB;
constexpr size_t WS_RET = WS_U;
constexpr size_t WS_ML = WS_U + 108 * MiB;
constexpr size_t WS_MLG = WS_U + 180 * MiB;
constexpr size_t WS_OB = WS_U + 183 * MiB;
constexpr size_t WS_YHTL = WS_U + 228 * MiB;
constexpr size_t WS_YHTC = WS_U + 252 * MiB;
constexpr size_t WS_HYTL = WS_U + 255 * MiB;
constexpr size_t WS_HYTC = WS_U + 327 * MiB;
constexpr size_t WS_END = WS_U + 336 * MiB;
constexpr size_t WS_GATES = WS_U;
constexpr size_t WS_ACT = WS_U;
constexpr size_t WS_W13 = WS_U + 204 * MiB;
constexpr size_t WS_W2 = WS_U + 216 * MiB;
constexpr size_t WS_MW13 = WS_Y;
constexpr size_t WS_MW2 = WS_Y + 88 * MiB;
constexpr size_t WS_MACT = WS_Y + 132 * MiB;
constexpr size_t WS_EOUT = WS_Y + 220 * MiB;
static_assert(WS_EOUT + (size_t)MAXTILES * 256 * 1024 * 2 <= WS_END, "map");
static_assert(WS_GATES + (size_t)TOK * NGATE * 2 <= WS_YHTL, "gates overlay");

constexpr int CW_BAR = 4096;
constexpr int CW_CNT = 16384;

constexpr int LDS_BYTES = 147456;
constexpr int MISC_OFF = 147456 - 256;

__device__ __forceinline__ float bf2f(bf16 b) { return __uint_as_float(((unsigned)b) << 16); }
__device__ __forceinline__ unsigned f2bf(float f) { unsigned u = __float_as_uint(f); return (u + 0x7fffu + ((u >> 16) & 1u)) >> 16; }
__device__ __forceinline__ unsigned pk2(float lo, float hi) { return f2bf(lo) | (f2bf(hi) << 16); }
__device__ __forceinline__ float wave_sum(float v) {
#pragma unroll
    for (int o = 1; o < 64; o <<= 1) v += __shfl_xor(v, o);
    return v;
}
__device__ __forceinline__ float sigmoidf_(float x) { return 1.0f / (1.0f + __expf(-x)); }
__device__ __forceinline__ float siluf_(float x) { return x / (1.0f + __expf(-x)); }

#define XB_TMO      128
#define XB_XCNT(j)  (256  + 64 * (j))
#define XB_XSUB(j)  (1280 + 64 * (j))
#define XB_XGEN(j)  (2304 + 64 * (j))
#define XB_TOP      3328
#define XB_TOPGEN   3392
#define XCD_BAR_WORDS 3456
#define XB_SPIN_CAP (1u << 22)
__device__ __forceinline__ unsigned xb_ld(unsigned* p)              { return __hip_atomic_load(p, __ATOMIC_RELAXED, __HIP_MEMORY_SCOPE_AGENT); }
__device__ __forceinline__ unsigned xb_add(unsigned* p, unsigned v) { return __hip_atomic_fetch_add(p, v, __ATOMIC_RELAXED, __HIP_MEMORY_SCOPE_AGENT); }
__device__ __forceinline__ unsigned xb_xcc_id() { return (unsigned)__builtin_amdgcn_s_getreg((3 << 11) | 20) & 0xFu; }
#define XB_SPIN(cond, bar) do { unsigned _sp = 0; while (cond) { __builtin_amdgcn_s_sleep(1); \
    if ((++_sp & 255u) == 0u) { if (xb_ld(&(bar)[XB_TMO])) break; if (_sp > XB_SPIN_CAP) { atomicAdd(&(bar)[XB_TMO], 1u); break; } } } } while (0)
struct XcdBarrier { unsigned* bar; unsigned x; volatile LAS unsigned* st; };
__device__ __forceinline__ XcdBarrier xcd_barrier_post(unsigned* bar, volatile LAS unsigned* st) {
    XcdBarrier b; b.bar = bar; b.x = xb_xcc_id(); b.st = st;
    if (threadIdx.x == 0) (void)xb_add(&bar[XB_XCNT(b.x)], 1u);
    return b;
}
__device__ __forceinline__ void xcd_barrier_complete(unsigned* bar, unsigned x, unsigned& nloc, unsigned& nx) {
    const unsigned G = gridDim.x * gridDim.y * gridDim.z;
    unsigned sum, cnt, mine, sp = 0u;
    for (;;) {
        sum = 0u; cnt = 0u; mine = 0u;
#pragma unroll 1
        for (unsigned j = 0; j < 16; ++j) { const unsigned c = xb_ld(&bar[XB_XCNT(j)]); sum += c; cnt += (c > 0u) ? 1u : 0u; }
        mine = xb_ld(&bar[XB_XCNT(x)]);
        if (sum == G) break;
        __builtin_amdgcn_s_sleep(1);
        if ((++sp & 255u) == 0u) { if (xb_ld(&bar[XB_TMO])) break; if (sp > XB_SPIN_CAP) { atomicAdd(&bar[XB_TMO], 1u); break; } }
    }
    nloc = mine > 0u ? mine : 1u; nx = cnt > 0u ? cnt : 1u;
}
__device__ __forceinline__ void xcd_barrier(const XcdBarrier& b) {
    asm volatile("s_waitcnt vmcnt(0)" ::: "memory");
    __syncthreads();
    if (threadIdx.x == 0) {
        unsigned* bar = b.bar;
        __builtin_amdgcn_s_waitcnt(0);
        unsigned nloc = b.st[0], nx = b.st[1];
        if (nloc == 0u) { xcd_barrier_complete(bar, b.x, nloc, nx); b.st[0] = nloc; b.st[1] = nx; }
        const unsigned old = xb_add(&bar[XB_XSUB(b.x)], 1u);
        const unsigned gen = old / nloc;
        if (old + 1u == (gen + 1u) * nloc) {
            __builtin_amdgcn_fence(__ATOMIC_RELEASE, "agent");
            asm volatile("s_waitcnt vmcnt(0)" ::: "memory");
            const unsigned og = xb_add(&bar[XB_TOP], 1u);
            const unsigned tg = og / nx;
            if (og + 1u == (tg + 1u) * nx) xb_add(&bar[XB_TOPGEN], 1u);
            else XB_SPIN(xb_ld(&bar[XB_TOPGEN]) == tg, bar);
            __builtin_amdgcn_fence(__ATOMIC_ACQUIRE, "agent");
            xb_add(&bar[XB_XGEN(b.x)], 1u);
            asm volatile("s_waitcnt vmcnt(0)" ::: "memory");
        } else {
            XB_SPIN(xb_ld(&bar[XB_XGEN(b.x)]) == gen, bar);
            __builtin_amdgcn_fence(__ATOMIC_ACQUIRE, "agent");
            asm volatile("s_waitcnt vmcnt(0)" ::: "memory");
        }
    }
    __syncthreads();
}

struct Params { const float* in[32]; float* out; unsigned char* ws; };
enum { I_X = 0, I_C, I_CTX, I_CCTX, I_WMOD, I_BMOD, I_GMIX, I_GFFN, I_WIN, I_BIN, I_HYCONV, I_HYF1, I_HYFB1, I_HYF2, I_HYFB2, I_HYF3, I_HYDECAY,
       I_HYSKIP, I_RETDECAY, I_MLCONV, I_MLGB, I_WUP, I_WOUT, I_FW1, I_FW3, I_FW2, I_ROUTER, I_ROUTERB, I_MW1, I_MW3, I_MW2, I_GFINAL };

struct Frame {
    LAS unsigned char* lds;
    unsigned char* ws;
    int tid, lane, wave, G, wg;
};
#define WSP(T, off) ((T*)(F.ws + (off)))
constexpr int PTAB_OFF = 147456 - 1024;
__device__ __forceinline__ const float* inp(const Frame& F, int i) {
    const LAS unsigned* t = (const LAS unsigned*)(F.lds + PTAB_OFF) + 2 * i;
    const unsigned lo = __builtin_amdgcn_readfirstlane(t[0]), hi = __builtin_amdgcn_readfirstlane(t[1]);
    return (const float*)(((unsigned long long)hi << 32) | lo);
}
__device__ __forceinline__ float* outp(const Frame& F) { return (float*)inp(F, 32); }

__device__ __forceinline__ int row_batch(int row) { return row < TOKL ? (row >> 11) : ((row - TOKL) >> 8); }
__device__ __forceinline__ const float* mod_ptr(const Frame& F, int layer, int row, int which) {
    const int r = row < TOKL ? (row >> 11) : 16;
    return WSP(const float, WS_MOD) + ((size_t)(layer * 17 + r) * 6 + which) * 1024;
}

template <class RowMap>
__device__ __forceinline__ void tr_item(const float* W, int K, int N, bf16* WT, int ldT, RowMap rm, LAS float* scr, int item, int lane) {
    const int nblk = (N + 31) / 32, kb = item / nblk, nb = item % nblk, k0 = 64 * kb, n0 = 32 * nb;
#pragma unroll 8
    for (int i = 0; i < 32; ++i) { const int kk = 2 * i + (lane >> 5); const int n = n0 + (lane & 31); scr[kk * 33 + (lane & 31)] = (n < N) ? W[(size_t)(k0 + kk) * N + n] : 0.f; }
    asm volatile("s_waitcnt lgkmcnt(0)" ::: "memory");
    const int c = lane & 7;
#pragma unroll
    for (int j = 0; j < 4; ++j) { const int nl = (lane >> 3) + 8 * j; const int n = n0 + nl; const LAS float* s = scr + (8 * c) * 33 + nl;
        u32x4 o; o.x = pk2(s[0 * 33], s[1 * 33]); o.y = pk2(s[2 * 33], s[3 * 33]); o.z = pk2(s[4 * 33], s[5 * 33]); o.w = pk2(s[6 * 33], s[7 * 33]);
        if (n < N) *(u32x4*)(WT + (size_t)rm(n) * ldT + k0 + 8 * c) = o; }
    asm volatile("s_waitcnt lgkmcnt(0)" ::: "memory");
}
struct RmId { __device__ __forceinline__ int operator()(int n) const { return n; } };
__device__ __forceinline__ int win_row(int n) {
    if (n < 1152) return n;
    if (n < 2688) return 1280 + (n - 1152);
    if (n < 3712) return 2816 + (n - 2688);
    if (n < 3728) return 1152 + (n - 3712);
    return 3840 + (n - 3728);
}
struct RmWin { __device__ __forceinline__ int operator()(int n) const { return win_row(n); } };
struct RmW1 { __device__ __forceinline__ int operator()(int n) const { return (n >> 4) * 32 + (n & 15); } };
struct RmW3 { __device__ __forceinline__ int operator()(int n) const { return (n >> 4) * 32 + 16 + (n & 15); } };

__device__ __forceinline__ void conv_weights_win(Frame& F, int layer, int gw, int NGW, LAS float* scr) {
    const float* W = inp(F, I_WIN) + (size_t)layer * D * NIN;
    const int items = (D / 64) * ((NIN + 31) / 32);
    for (int it = gw; it < items; it += NGW) tr_item(W, D, NIN, WSP(bf16, WS_WIN), D, RmWin(), scr, it, F.lane);
    bf16* wt = WSP(bf16, WS_WIN);
    for (int i = gw * 64 + F.lane; i < 112 * 1024 / 8; i += NGW * 64) *(u32x4*)(wt + (size_t)1168 * 1024 + (size_t)i * 8) = (u32x4){0u, 0u, 0u, 0u};
}
__device__ __forceinline__ void conv_weights_upout(Frame& F, int layer, int gw, int NGW, LAS float* scr) {
    const int items = (D / 64) * (D / 32);
    for (int it = gw; it < items; it += NGW) tr_item(inp(F, I_WUP) + (size_t)layer * D * D, D, D, WSP(bf16, WS_WUP), D, RmId(), scr, it, F.lane);
    for (int it = gw; it < items; it += NGW) tr_item(inp(F, I_WOUT) + (size_t)layer * D * D, D, D, WSP(bf16, WS_WOUT), D, RmId(), scr, it, F.lane);
}
__device__ __forceinline__ void conv_weights_ffn(const float* w1, const float* w3, const float* w2, bf16* w13t, bf16* w2t, int gw, int NGW, LAS float* scr, int lane) {
    const int i1 = (D / 64) * (DFF / 32), i2 = (DFF / 64) * (D / 32);
    for (int it = gw; it < i1; it += NGW) tr_item(w1, D, DFF, w13t, D, RmW1(), scr, it, lane);
    for (int it = gw; it < i1; it += NGW) tr_item(w3, D, DFF, w13t, D, RmW3(), scr, it, lane);
    for (int it = gw; it < i2; it += NGW) tr_item(w2, DFF, D, w2t, DFF, RmId(), scr, it, lane);
}

__device__ __forceinline__ void filter_item(Frame& F, int layer, int L, bf16* FT  , int pb, int ch, LAS float* tile  ) {
    const float* f1 = inp(F, I_HYF1) + layer * 33 * 64; const float* fb1 = inp(F, I_HYFB1) + layer * 64;
    const float* f2 = inp(F, I_HYF2) + layer * 64 * 64; const float* fb2 = inp(F, I_HYFB2) + layer * 64;
    const float* f3 = inp(F, I_HYF3) + (size_t)layer * 64 * 1536; const float* dec = inp(F, I_HYDECAY) + layer * 1536;
    const int lane = F.lane, n = ch * 64 + lane;
    const float b1 = fb1[lane], b2 = fb2[lane], adec = fabsf(dec[n]);
    for (int pl = 0; pl < 64; ++pl) {
        const int pos = pb * 64 + pl;
        const float t = (float)pos / (float)(L - 1);
        const float w = 6.283185307179586f * (float)pos / (float)L;
        float feat = 0.f;
        if (lane == 0) feat = t;
        else if (lane < 17) { const float band = 1e-4f + (float)(lane - 1) * ((15.0f - 1e-4f) / 15.0f); feat = cosf(w * band); }
        else if (lane < 33) { const float band = 1e-4f + (float)(lane - 17) * ((15.0f - 1e-4f) / 15.0f); feat = -sinf(w * band); }
        float a1 = b1;
        for (int i = 0; i < 33; ++i) a1 += __shfl(feat, i) * f1[i * 64 + lane];
        const float h1 = sinf(a1);
        float a2 = b2;
        for (int i = 0; i < 64; ++i) a2 += __shfl(h1, i) * f2[i * 64 + lane];
        const float h2 = sinf(a2);
        float a3 = 0.f;
        for (int i = 0; i < 64; ++i) a3 += __shfl(h2, i) * f3[i * 1536 + n];
        tile[pl * 65 + lane] = a3 * expf(-t * adec);
    }
    asm volatile("s_waitcnt lgkmcnt(0)" ::: "memory");
    const int pos = pb * 64 + lane;
    for (int cl = 0; cl < 64; ++cl) {
        const int nn = ch * 64 + cl, o = nn / 768, dir = (nn / 384) & 1, c = nn % 384;
        bf16* dst = FT + (size_t)(o * 384 + c) * (2 * L);
        const float v = tile[lane * 65 + cl];
        if (dir == 0) dst[L - pos] = (bf16)f2bf(v);
        else if (pos > 0) dst[L + pos] = (bf16)f2bf(v);
    }
    asm volatile("s_waitcnt lgkmcnt(0)" ::: "memory");
}

__device__ __forceinline__ void phase_p0(Frame& F) {
    const int gw = F.wg * NWAVES + F.wave, NGW = F.G * NWAVES;
    LAS float* sl = (LAS float*)F.lds;
    LAS float* red = (LAS float*)(F.lds + 17 * 4096);
    for (int i = F.tid; i < 17 * 1024; i += NTHR) { const int r = i >> 10, k = i & 1023; const float v = r < 16 ? inp(F, I_C)[r * 1024 + k] : inp(F, I_CCTX)[k]; sl[i] = siluf_(v); }
    __syncthreads();
    for (int item = F.wg; item < 2 * 384; item += F.G) {
        const int layer = item / 384, n0 = (item % 384) * 16, j = F.tid & 15, kp = F.tid >> 4;
        const float* W = inp(F, I_WMOD) + (size_t)layer * D * 6144;
        float acc[17];
#pragma unroll
        for (int r = 0; r < 17; ++r) acc[r] = 0.f;
        for (int k = kp * 32; k < kp * 32 + 32; ++k) { const float w = W[(size_t)k * 6144 + n0 + j];
#pragma unroll
            for (int r = 0; r < 17; ++r) acc[r] += sl[r * 1024 + k] * w; }
#pragma unroll
        for (int r = 0; r < 17; ++r) red[(kp * 17 + r) * 16 + j] = acc[r];
        __syncthreads();
        if (F.tid < 272) { const int r = F.tid >> 4, jj = F.tid & 15; float s = inp(F, I_BMOD)[layer * 6144 + n0 + jj];
            for (int q = 0; q < 32; ++q) s += red[(q * 17 + r) * 16 + jj];
            WSP(float, WS_MOD)[(size_t)(layer * 17 + r) * 6144 + n0 + jj] = s; }
        __syncthreads();
    }
    __syncthreads();
    LAS float* scr = (LAS float*)(F.lds + F.wave * 8704);
    conv_weights_win(F, 0, gw, NGW, scr);
    conv_weights_upout(F, 0, gw, NGW, scr);
    for (int i = gw * 64 + F.lane; i < 2048 * 32; i += NGW * 64) {
        const int t = i >> 5, j = i & 31, half = j >> 4, ii = j & 15;
        const float inv = 1.0f / powf(10000.0f, (float)ii / 16.0f);
        const float ang = (float)(half == 0 ? (t >> 6) : (t & 63)) * inv;
        WSP(float, WS_ROPE)[t * 64 + half * 32 + ii] = cosf(ang);
        WSP(float, WS_ROPE)[t * 64 + half * 32 + 16 + ii] = sinf(ang);
    }
    __syncthreads();
    LAS float* ftile = (LAS float*)(F.lds + F.wave * 16640);
    for (int it = gw; it < 1536 + 96; it += NGW) {
        if (it < 1536) { const int layer = it / 768, r = it % 768; filter_item(F, layer, LL, WSP(bf16, WS_FTL) + (size_t)layer * 2 * 384 * 4096, r / 24, r % 24, ftile); }
        else { const int r = it - 1536; filter_item(F, 0, LC, WSP(bf16, WS_FTC), r / 24, r % 24, ftile); }
    }
}
__device__ __forceinline__ void write_bias(Frame& F) {
    const int gt = (F.wg * NWAVES + F.wave) * 64 + F.lane, NGT = F.G * NTHR;
    for (int i = gt; i < 2 * NWP; i += NGT) {
        const int l = i / NWP, r = i % NWP; float v = 0.f;
        int n = -1;
        if (r < 1152) n = r; else if (r < 1168) n = 3712 + (r - 1152); else if (r < 1280) n = -1; else if (r < 2816) n = 1152 + (r - 1280); else if (r < 3840) n = 2688 + (r - 2816); else n = 3728 + (r - 3840);
        if (n >= 0) v = inp(F, I_BIN)[l * NIN + n];
        WSP(float, WS_BIAS)[i] = v;
    }
}

__device__ __forceinline__ void norm_mod_row(const float* xrow, const float* g, const float* shift, const float* scale, bf16* orow, int lane, float* keep  ) {
    f32x4 v[4]; float s = 0.f;
#pragma unroll
    for (int j = 0; j < 4; ++j) { v[j] = *(const f32x4*)(xrow + 256 * j + 4 * lane); s += (v[j].x * v[j].x + v[j].y * v[j].y) + (v[j].z * v[j].z + v[j].w * v[j].w); }
    const float r = rsqrtf(wave_sum(s) * (1.0f / 1024.0f) + 1e-6f);
#pragma unroll
    for (int j = 0; j < 4; ++j) {
        const f32x4 gg = *(const f32x4*)(g + 256 * j + 4 * lane), sh = *(const f32x4*)(shift + 256 * j + 4 * lane), sc = *(const f32x4*)(scale + 256 * j + 4 * lane);
        f32x4 o;
        o.x = (v[j].x * r * gg.x) * (1.f + sc.x) + sh.x; o.y = (v[j].y * r * gg.y) * (1.f + sc.y) + sh.y;
        o.z = (v[j].z * r * gg.z) * (1.f + sc.z) + sh.z; o.w = (v[j].w * r * gg.w) * (1.f + sc.w) + sh.w;
        if (keep) { keep[4 * j + 0] = o.x; keep[4 * j + 1] = o.y; keep[4 * j + 2] = o.z; keep[4 * j + 3] = o.w; }
        u32x2 w; w.x = pk2(o.x, o.y); w.y = pk2(o.z, o.w);
        *(u32x2*)(orow + 256 * j + 4 * lane) = w;
    }
}
__device__ __forceinline__ const float* xrow_ptr(const Frame& F, int row, bool from_input) {
    if (row < TOKL) return (from_input ? inp(F, I_X) : outp(F)) + (size_t)row * D;
    return (from_input ? inp(F, I_CTX) : WSP(const float, WS_XC)) + (size_t)(row - TOKL) * D;
}
__device__ __forceinline__ void phase_norm(Frame& F, int layer, int nrows, bool from_input, int which) {
    const int gw = F.wg * NWAVES + F.wave, NGW = F.G * NWAVES;
    const float* g = inp(F, which == 0 ? I_GMIX : I_GFFN) + layer * D;
    for (int row = gw; row < nrows; row += NGW)
        norm_mod_row(xrow_ptr(F, row, from_input), g, mod_ptr(F, layer, row, which), mod_ptr(F, layer, row, which + 1), WSP(bf16, WS_H) + (size_t)row * D, F.lane, nullptr);
}

struct RowsId { __device__ __forceinline__ int operator()(int r) const { return r; } };
struct RowsGather { const int* idx; __device__ __forceinline__ int operator()(int r) const { return idx[r]; } };
template <class Epi, class Rows>
__device__ __forceinline__ void gemm_simple_tile(const bf16* A, int lda, const bf16* Bt, int ldb, int K, int rt, int ct, const Epi& E, const Rows& R, int lane) {
    const int fr = lane & 15, fq = lane >> 4;
    f32x4 acc[4][4];
#pragma unroll
    for (int mi = 0; mi < 4; ++mi)
#pragma unroll
        for (int ni = 0; ni < 4; ++ni) acc[mi][ni] = (f32x4){0.f, 0.f, 0.f, 0.f};
    const bf16* ap[4]; const bf16* bp[4];
#pragma unroll
    for (int mi = 0; mi < 4; ++mi) ap[mi] = A + (size_t)R(rt * 64 + mi * 16 + fr) * lda + fq * 8;
#pragma unroll
    for (int ni = 0; ni < 4; ++ni) bp[ni] = Bt + (size_t)(ct * 64 + ni * 16 + fr) * ldb + fq * 8;
#pragma unroll 1
    for (int k0 = 0; k0 < K; k0 += 32) {
        if constexpr (Epi::HORNER) {
            if (k0 == 384 || k0 == 768) {
                const int seg = (k0 == 384) ? 0 : 1;
#pragma unroll
                for (int mi = 0; mi < 4; ++mi)
#pragma unroll
                    for (int ni = 0; ni < 4; ++ni) acc[mi][ni] = E.rescale(seg, rt * 64 + mi * 16 + fr, ct * 64 + ni * 16 + 4 * fq, acc[mi][ni]);
            }
        }
        bf16x8 a[4], b[4];
#pragma unroll
        for (int mi = 0; mi < 4; ++mi) a[mi] = *(const bf16x8*)(ap[mi] + k0);
#pragma unroll
        for (int ni = 0; ni < 4; ++ni) b[ni] = *(const bf16x8*)(bp[ni] + k0);
#pragma unroll
        for (int mi = 0; mi < 4; ++mi)
#pragma unroll
            for (int ni = 0; ni < 4; ++ni) acc[mi][ni] = __builtin_amdgcn_mfma_f32_16x16x32_bf16(b[ni], a[mi], acc[mi][ni], 0, 0, 0);
    }
#pragma unroll
    for (int mi = 0; mi < 4; ++mi) {
        const int r = rt * 64 + mi * 16 + fr;
        if constexpr (Epi::PAIR) {
#pragma unroll
            for (int ni = 0; ni < 4; ni += 2) E.store_pair(r, ct * 32 + (ni >> 1) * 16 + 4 * fq, acc[mi][ni], acc[mi][ni + 1]);
        } else {
#pragma unroll
            for (int ni = 0; ni < 4; ++ni) E.store(r, ct * 64 + ni * 16 + 4 * fq, acc[mi][ni]);
        }
    }
}
template <class Epi, class Rows>
__device__ __forceinline__ void gemm_simple(Frame& F, const bf16* A, int lda, const bf16* Bt, int ldb, int K, int M, int N, const Epi& E, const Rows& R) {
    const int gw = F.wg * NWAVES + F.wave, NGW = F.G * NWAVES;
    const int nct = N / 64, nrt = M / 64;
    for (int u = gw; u < nct * nrt; u += NGW) gemm_simple_tile(A, lda, Bt, ldb, K, u / nct, u % nct, E, R, F.lane);
}

namespace pg8 {
constexpr int BM = 256, BK = 64, HALF = 128, HTB = HALF * BK * 2, STAGE_BYTES = 8 * HTB, NXCD = 8, WGM = 8;
__device__ __forceinline__ int lds_byte(int r, int c) { const int st = (r >> 4) * 2 + (c >> 5), rr = r & 15, cc = c & 31, ob = rr * 64 + cc * 2; return st * 1024 + (ob ^ (((ob >> 9) & 1) << 5)); }
__device__ __forceinline__ void stage_rc(int b, int& R, int& C) { const int st = b / 1024, sb = b % 1024, swz = sb ^ (((sb >> 9) & 1) << 5); R = (st >> 1) * 16 + swz / 64; C = (st & 1) * 32 + (swz % 64) / 2; }
struct Unit { int pm, pn; };
struct OrderPlain {
    static constexpr bool GATHER = false;
    int nM, nN, nwg, G, c;
    __device__ __forceinline__ void init(int nM_, int nN_, int G_, int c_) { nM = nM_; nN = nN_; nwg = nM * nN; G = G_; c = c_; }
    __device__ __forceinline__ bool next(int i, Unit& u) const {
        const long L = (long)i * G + c; if (L >= nwg) return false;
        int wgid = (int)L; { const int q = nwg / NXCD, r = nwg % NXCD, xcd = wgid % NXCD, off = wgid / NXCD; wgid = (xcd < r ? xcd * (q + 1) : r * (q + 1) + (xcd - r) * q) + off; }
        const int nig = WGM * nN, gid = wgid / nig, fm = gid * WGM, gsz = (nM - fm) < WGM ? (nM - fm) : WGM;
        u.pm = fm + ((wgid % nig) % gsz); u.pn = (wgid % nig) / gsz; return true;
    }
    __device__ __forceinline__ int arow(int r) const { return r; }
    __device__ __forceinline__ size_t boff(const Unit&) const { return 0; }
};
struct OrderMoe {
    static constexpr bool GATHER = true;
    OrderPlain o; const int* rowidx; const int* tilee; int t0; size_t bstride; bool gather;
    __device__ __forceinline__ bool next(int i, Unit& u) const { return o.next(i, u); }
    __device__ __forceinline__ int arow(int r) const { return gather ? rowidx[t0 * 256 + r] : r; }
    __device__ __forceinline__ size_t boff(const Unit& u) const { return (size_t)tilee[t0 + u.pm] * bstride; }
};

template <class Epi, class Sched>
__device__ __forceinline__ void gemm_phase(LAS unsigned char* lds, const bf16* A, int lda, const bf16* Bt, int ldb, int K, const Sched& S, const Epi& E) {
    unsigned tid_u = threadIdx.x; asm volatile("" : "+v"(tid_u));
    const int tid = (int)tid_u, wid = __builtin_amdgcn_readfirstlane(tid >> 6), lane = tid & 63, wr = wid >> 2, wc = wid & 3, fr = lane & 15, fq = lane >> 4;
    const int nt = K / BK;
    unsigned voffB[2];
    { int sR[2], sC[2];
#pragma unroll
      for (int i = 0; i < 2; ++i) { stage_rc(tid * 16 + i * 8192, sR[i], sC[i]); voffB[i] = (unsigned)(sR[i] * ldb + sC[i]) * 2u; } }
#define PG8_GATHER_OFFS(pm_) do { unsigned _t = (unsigned)tid; asm volatile("" : "+v"(_t)); _Pragma("unroll") for (int i = 0; i < 2; ++i) { int _R, _C; stage_rc((int)_t * 16 + i * 8192, _R, _C); \
        vc0[i] = (unsigned)((size_t)S.arow((pm_) * BM + _R) * lda + _C) * 2u; vc1[i] = (unsigned)((size_t)S.arow((pm_) * BM + HALF + _R) * lda + _C) * 2u; } } while (0)
    const size_t kstep = (size_t)(BK * 2);
    const size_t hstepB = (size_t)HALF * ldb * 2, tstepB = 2 * hstepB;
    const unsigned ldsw = (unsigned)wid * 1024u;
    const int aoff = lds_byte(wr * 64 + fr, fq * 8), boff = lds_byte(wc * 32 + fr, fq * 8);
#define PG8_SA(b, h) (((b) * 2 + (h)) * HTB)
#define PG8_SB(b, h) ((4 + (b) * 2 + (h)) * HTB)
#define PG8_STAGE2(bufoff, gbase, v0, v1) do { \
        __builtin_amdgcn_global_load_lds((const unsigned*)((const char*)(gbase) + (v0)), (LAS unsigned*)(lds + (bufoff) + ldsw), 16, 0, 0); \
        __builtin_amdgcn_global_load_lds((const unsigned*)((const char*)(gbase) + (v1)), (LAS unsigned*)(lds + (bufoff) + ldsw + 8192), 16, 0, 0); } while (0)
#define PG8_STAGEB(bufoff, gbase) PG8_STAGE2(bufoff, gbase, voffB[0], voffB[1])
#define PG8_LDA(dst, b, h) do { _Pragma("unroll") for (int m = 0; m < 4; ++m) _Pragma("unroll") for (int k = 0; k < 2; ++k) dst[m][k] = *(const LAS bf16x8*)(lds + PG8_SA(b, h) + aoff + m * 2048 + k * 1024); } while (0)
#define PG8_LDB(dst, b, h) do { _Pragma("unroll") for (int n = 0; n < 2; ++n) _Pragma("unroll") for (int k = 0; k < 2; ++k) dst[n][k] = *(const LAS bf16x8*)(lds + PG8_SB(b, h) + boff + n * 2048 + k * 1024); } while (0)
#define PG8_MMA(ai, bj, At, Bt_) do { __builtin_amdgcn_s_setprio(1); _Pragma("unroll") for (int m = 0; m < 4; ++m) _Pragma("unroll") for (int n = 0; n < 2; ++n) _Pragma("unroll") for (int k = 0; k < 2; ++k) \
        acc[ai][bj][m][n] = __builtin_amdgcn_mfma_f32_16x16x32_bf16(Bt_[n][k], At[m][k], acc[ai][bj][m][n], 0, 0, 0); __builtin_amdgcn_s_setprio(0); } while (0)
#define PG8_WAIT_V(n) asm volatile("s_waitcnt vmcnt(" #n ")" ::: "memory")
#define PG8_WAIT_L(n) asm volatile("s_waitcnt lgkmcnt(" #n ")" ::: "memory")
#define PG8_BAR __builtin_amdgcn_s_barrier()
#define PG8_SCHED __builtin_amdgcn_sched_barrier(0)
    Unit cur, nxt; int ui = 0;
    if (!S.next(0, cur)) return;
    f32x4 acc[2][2][4][2];
#pragma unroll
    for (int a = 0; a < 2; ++a)
#pragma unroll
        for (int b = 0; b < 2; ++b)
#pragma unroll
            for (int m = 0; m < 4; ++m)
#pragma unroll
                for (int n = 0; n < 2; ++n) acc[a][b][m][n] = (f32x4){0.f, 0.f, 0.f, 0.f};
    bf16x8 At[4][2], B0[2][2], B1[2][2];
    constexpr bool GA = Sched::GATHER;
    const size_t hstepA = GA ? 0 : (size_t)HALF * lda * 2, tstepA = (size_t)BM * lda * 2;
    unsigned vc0[2], vc1[2];
    if constexpr (GA) { PG8_GATHER_OFFS(cur.pm); }
    else { int sR, sC;
#pragma unroll
        for (int i = 0; i < 2; ++i) { stage_rc(tid * 16 + i * 8192, sR, sC); vc0[i] = (unsigned)(sR * lda + sC) * 2u; vc1[i] = 0u; } }
#define VC0(i) vc0[i]
#define VC1(i) (GA ? vc1[i] : vc0[i])
#define VN0(i) vc0[i]
#define VN1(i) VC1(i)
    const char* cA = GA ? (const char*)A : (const char*)A + (size_t)cur.pm * tstepA;
    const char* cB = (const char*)Bt + S.boff(cur) * 2 + (size_t)cur.pn * tstepB;
    PG8_STAGEB(PG8_SB(0, 0), cB); PG8_STAGE2(PG8_SA(0, 0), cA, VC0(0), VC0(1)); PG8_STAGEB(PG8_SB(0, 1), cB + hstepB); PG8_STAGE2(PG8_SA(0, 1), cA + hstepA, VC1(0), VC1(1));
    if (wr == 1) PG8_BAR;
    PG8_WAIT_V(4); PG8_BAR;
    PG8_STAGEB(PG8_SB(1, 0), cB + kstep); PG8_STAGE2(PG8_SA(1, 0), cA + kstep, VC0(0), VC0(1)); PG8_STAGEB(PG8_SB(1, 1), cB + hstepB + kstep);
    PG8_WAIT_V(6); PG8_BAR;
    for (;;) {
        const bool has_next = S.next(ui + 1, nxt);
        const char* nB = cB; const char* nA = cA;
        if (has_next) {
            nB = (const char*)Bt + S.boff(nxt) * 2 + (size_t)nxt.pn * tstepB;
            if constexpr (!GA) nA = (const char*)A + (size_t)nxt.pm * tstepA;
        }
        for (int t = 0; t < nt; t += 2) {
            const bool last = (t == nt - 2);
            if constexpr (Epi::HORNER) {
                if (t == 6 || t == 12) {
                    asm volatile("" ::: "memory");
                    const int seg = (t == 6) ? 0 : 1;
                    int hpm = cur.pm, hpn = cur.pn; asm volatile("" : "+s"(hpm), "+s"(hpn));
                    unsigned hln = (unsigned)lane; asm volatile("" : "+v"(hln)); const int hfr = (int)(hln & 15u), hfq = (int)(hln >> 4);
#pragma unroll
                    for (int ai = 0; ai < 2; ++ai)
#pragma unroll
                        for (int m = 0; m < 4; ++m) {
#pragma unroll
                            for (int bj = 0; bj < 2; ++bj)
#pragma unroll
                                for (int n = 0; n < 2; ++n)
                                    acc[ai][bj][m][n] = E.rescale(seg, hpm * BM + ai * HALF + wr * 64 + m * 16 + hfr, hpn * BM + bj * HALF + wc * 32 + n * 16 + 4 * hfq, acc[ai][bj][m][n]);
                            asm volatile("" : "+v"(acc[ai][0][m][0]), "+v"(acc[ai][0][m][1]), "+v"(acc[ai][1][m][0]), "+v"(acc[ai][1][m][1]) :: "memory");
                        }
                    asm volatile("s_waitcnt vmcnt(0)" ::: "memory");
                }
            }
            const char* a1 = cA + (size_t)(t + 1) * kstep;
            const char* a2 = last ? nA : cA + (size_t)(t + 2) * kstep; const char* b2 = last ? nB : cB + (size_t)(t + 2) * kstep;
            const char* a3 = a2 + kstep; const char* b3 = b2 + kstep;
            PG8_LDB(B0, 0, 0); PG8_SCHED; PG8_LDA(At, 0, 0); PG8_STAGE2(PG8_SA(1, 1), a1 + hstepA, VC1(0), VC1(1));
            if constexpr (GA) { if (last && has_next) { asm volatile("" ::: "memory"); PG8_GATHER_OFFS(nxt.pm); asm volatile("" ::: "memory"); } }
            PG8_WAIT_L(8); PG8_BAR; PG8_WAIT_L(0); PG8_MMA(0, 0, At, B0); PG8_BAR; PG8_SCHED;
            PG8_LDB(B1, 0, 1); PG8_STAGEB(PG8_SB(0, 0), b2);
            PG8_BAR; PG8_WAIT_L(0); PG8_MMA(0, 1, At, B1); PG8_BAR;
            PG8_LDA(At, 0, 1); PG8_STAGE2(PG8_SA(0, 0), a2, VN0(0), VN0(1));
            PG8_BAR; PG8_WAIT_L(0); PG8_MMA(1, 0, At, B0); PG8_BAR; PG8_SCHED;
            PG8_STAGEB(PG8_SB(0, 1), b2 + hstepB);
            PG8_WAIT_V(6); PG8_BAR; PG8_MMA(1, 1, At, B1); PG8_BAR;
            PG8_LDB(B0, 1, 0); PG8_SCHED; PG8_LDA(At, 1, 0); PG8_STAGE2(PG8_SA(0, 1), a2 + hstepA, VN1(0), VN1(1));
            PG8_WAIT_L(8); PG8_BAR; PG8_WAIT_L(0); PG8_MMA(0, 0, At, B0); PG8_BAR; PG8_SCHED;
            PG8_LDB(B1, 1, 1); PG8_STAGEB(PG8_SB(1, 0), b3);
            PG8_BAR; PG8_WAIT_L(0); PG8_MMA(0, 1, At, B1); PG8_BAR;
            PG8_LDA(At, 1, 1); PG8_STAGE2(PG8_SA(1, 0), a3, VN0(0), VN0(1));
            PG8_BAR; PG8_WAIT_L(0); PG8_MMA(1, 0, At, B0); PG8_BAR; PG8_SCHED;
            PG8_STAGEB(PG8_SB(1, 1), b3 + hstepB);
            PG8_WAIT_V(6); PG8_BAR; PG8_MMA(1, 1, At, B1); PG8_BAR;
        }
        {
            int epm = cur.pm, epn = cur.pn; asm volatile("" : "+s"(epm), "+s"(epn));
            unsigned eln = (unsigned)lane; asm volatile("" : "+v"(eln)); const int efr = (int)(eln & 15u), efq = (int)(eln >> 4);
#pragma unroll
            for (int ai = 0; ai < 2; ++ai)
#pragma unroll
                for (int m = 0; m < 4; ++m) {
                    const int row = epm * BM + ai * HALF + wr * 64 + m * 16 + efr;
#pragma unroll
                    for (int bj = 0; bj < 2; ++bj) {
                        if constexpr (Epi::PAIR) E.store_pair(row, epn * (BM / 2) + bj * (HALF / 2) + wc * 16 + 4 * efq, acc[ai][bj][m][0], acc[ai][bj][m][1]);
                        else {
#pragma unroll
                            for (int n = 0; n < 2; ++n) E.store(row, epn * BM + bj * HALF + wc * 32 + n * 16 + 4 * efq, acc[ai][bj][m][n]);
                        }
                    }
                }
        }
        if (!has_next) break;
#pragma unroll
        for (int a = 0; a < 2; ++a)
#pragma unroll
            for (int b = 0; b < 2; ++b)
#pragma unroll
                for (int m = 0; m < 4; ++m)
#pragma unroll
                    for (int n = 0; n < 2; ++n) acc[a][b][m][n] = (f32x4){0.f, 0.f, 0.f, 0.f};
        cur = nxt; cB = nB; cA = nA; ++ui;
    }
    PG8_WAIT_V(0);
    if (wr == 0) PG8_BAR;
    PG8_BAR;
#undef PG8_GATHER_OFFS
#undef VC0
#undef VC1
#undef VN0
#undef VN1
#undef PG8_SA
#undef PG8_SB
#undef PG8_STAGE2
#undef PG8_STAGEB
#undef PG8_LDA
#undef PG8_LDB
#undef PG8_MMA
#undef PG8_WAIT_V
#undef PG8_WAIT_L
#undef PG8_BAR
#undef PG8_SCHED
}
}

template <class Epi>
__device__ __forceinline__ void gemm_fast(Frame& F, const bf16* A, int lda, const bf16* Bt, int ldb, int K, int M, int N, const Epi& E) {
    pg8::OrderPlain S; S.init(M / 256, N / 256, F.G, F.wg);
    pg8::gemm_phase(F.lds, A, lda, Bt, ldb, K, S, E);
}
#ifndef FAST_PLAIN
#define FAST_PLAIN 1
#endif
#ifndef FAST_HORNER
#define FAST_HORNER 1
#endif
#ifndef FAST_MOE
#define FAST_MOE 1
#endif

__device__ __forceinline__ void st_bf16x4(bf16* p, f32x4 v) { u32x2 w; w.x = pk2(v.x, v.y); w.y = pk2(v.z, v.w); *(u32x2*)p = w; }
__device__ __forceinline__ f32x4 ld_bf16x4(const bf16* p) { const u32x2 w = *(const u32x2*)p; f32x4 v; v.x = __uint_as_float(w.x << 16); v.y = __uint_as_float(w.x & 0xffff0000u); v.z = __uint_as_float(w.y << 16); v.w = __uint_as_float(w.y & 0xffff0000u); return v; }

struct EpiWin {
    static constexpr bool HORNER = false, PAIR = false;
    const float* bias; bf16 *hytl, *hytc, *ret, *ml; float* mlg;
    __device__ __forceinline__ f32x4 rescale(int, int, int, f32x4 v) const { return v; }
    __device__ __forceinline__ void store(int row, int col, f32x4 v) const {
        v += *(const f32x4*)(bias + col);
        if (col < 1152) {
            if (row < TOKL) { const int b = row >> 11, t = row & 2047; bf16* d = hytl + ((size_t)(b * 1152 + col)) * 2048 + t;
                d[0] = (bf16)f2bf(v.x); d[2048] = (bf16)f2bf(v.y); d[4096] = (bf16)f2bf(v.z); d[6144] = (bf16)f2bf(v.w); }
            else { const int r = row - TOKL, b = r >> 8, t = r & 255; bf16* d = hytc + ((size_t)(b * 1152 + col)) * 256 + t;
                d[0] = (bf16)f2bf(v.x); d[256] = (bf16)f2bf(v.y); d[512] = (bf16)f2bf(v.z); d[768] = (bf16)f2bf(v.w); }
        } else if (col < 1168) { *(f32x4*)(mlg + (size_t)row * 16 + (col - 1152)) = v; }
        else if (col < 1280) { }
        else if (col < 2816) st_bf16x4(ret + (size_t)row * 1536 + (col - 1280), v);
        else st_bf16x4(ml + (size_t)row * 1024 + (col - 2816), v);
    }
};
struct EpiGate {
    static constexpr bool HORNER = false, PAIR = false;
    const float* bias; bf16* gates;
    __device__ __forceinline__ f32x4 rescale(int, int, int, f32x4 v) const { return v; }
    __device__ __forceinline__ void store(int row, int col, f32x4 v) const {
        v += *(const f32x4*)(bias + col);
        f32x4 g; g.x = fmaxf(sigmoidf_(v.x), 1e-20f); g.y = fmaxf(sigmoidf_(v.y), 1e-20f); g.z = fmaxf(sigmoidf_(v.z), 1e-20f); g.w = fmaxf(sigmoidf_(v.w), 1e-20f);
        st_bf16x4(gates + (size_t)row * NGATE + col, g);
    }
};
struct EpiUp {
    static constexpr bool HORNER = true, PAIR = false;
    const bf16* gates; bf16* acc_out;
    __device__ __forceinline__ f32x4 rescale(int seg, int row, int col, f32x4 v) const {
        const f32x4 a = ld_bf16x4(gates + (size_t)row * NGATE + seg * 1024 + col), b = ld_bf16x4(gates + (size_t)row * NGATE + (seg + 1) * 1024 + col);
        v.x *= a.x * __builtin_amdgcn_rcpf(b.x); v.y *= a.y * __builtin_amdgcn_rcpf(b.y); v.z *= a.z * __builtin_amdgcn_rcpf(b.z); v.w *= a.w * __builtin_amdgcn_rcpf(b.w); return v;
    }
    __device__ __forceinline__ void store(int row, int col, f32x4 v) const {
        const f32x4 g = ld_bf16x4(gates + (size_t)row * NGATE + 2048 + col);
        st_bf16x4(acc_out + (size_t)row * D + col, v * g);
    }
};
struct EpiResid {
    static constexpr bool HORNER = false, PAIR = false;
    const float *xin_l, *xin_c; float *xout_l, *xout_c; const float* modbase; int which;
    __device__ __forceinline__ f32x4 rescale(int, int, int, f32x4 v) const { return v; }
    __device__ __forceinline__ void store(int row, int col, f32x4 v) const {
        const int r = row < TOKL ? (row >> 11) : 16;
        const f32x4 m = *(const f32x4*)(modbase + ((size_t)r * 6 + which) * 1024 + col);
        if (row < TOKL) { const size_t o = (size_t)row * D + col; *(f32x4*)(xout_l + o) = *(const f32x4*)(xin_l + o) + m * v; }
        else { const size_t o = (size_t)(row - TOKL) * D + col; *(f32x4*)(xout_c + o) = *(const f32x4*)(xin_c + o) + m * v; }
    }
};
struct EpiSwiglu {
    static constexpr bool HORNER = false, PAIR = true;
    bf16* act; int row_off;
    __device__ __forceinline__ f32x4 rescale(int, int, int, f32x4 v) const { return v; }
    __device__ __forceinline__ void store_pair(int row, int col, f32x4 a, f32x4 b) const {
        f32x4 o; o.x = siluf_(a.x) * b.x; o.y = siluf_(a.y) * b.y; o.z = siluf_(a.z) * b.z; o.w = siluf_(a.w) * b.w;
        st_bf16x4(act + (size_t)(row - row_off) * DFF + col, o);
    }
};
struct EpiBf16Out {
    static constexpr bool HORNER = false, PAIR = false;
    bf16* out; int ld; int row_add;
    __device__ __forceinline__ f32x4 rescale(int, int, int, f32x4 v) const { return v; }
    __device__ __forceinline__ void store(int row, int col, f32x4 v) const { st_bf16x4(out + (size_t)(row + row_add) * ld + col, v); }
};

constexpr int ZPITCH_L = (LL + 8) * 2, ZPITCH_C = (LC + 8) * 2;
template <int L>
__device__ __forceinline__ float conv3_at(const bf16* base  , int t, float w0, float w1, float w2) {
    const float a = t > 0 ? bf2f(base[t - 1]) : 0.f, b = bf2f(base[t]), c = t < L - 1 ? bf2f(base[t + 1]) : 0.f;
    return w0 * a + w1 * b + w2 * c;
}
template <int L>
__device__ __forceinline__ void hyena_unit_naive(Frame& F, int layer, int c, const bf16* hyt  , const bf16* ft  , bf16* yht  ) {
    constexpr int ZP = (L + 8) * 2;
    constexpr int PER = L / 32;
    constexpr int SUB = 8;
    LAS unsigned char* zimg0 = F.lds;
    LAS unsigned char* zimg1 = F.lds + 16 * ZP;
    LAS bf16* tf = (LAS bf16*)(F.lds + 32 * ZP);
    const float* cw = inp(F, I_HYCONV) + layer * 3 * 1152;
    const float* skip = inp(F, I_HYSKIP) + layer * 2 * 384;
    __syncthreads();
    {
        const int b = F.tid >> 5, seg = F.tid & 31; const bf16* src = hyt + ((size_t)(b * 1152 + c)) * L;
        const float w0 = cw[c], w1 = cw[1152 + c], w2 = cw[2304 + c];
#pragma unroll 2
        for (int j = 0; j < PER; ++j) { const int t = seg * PER + j; *(LAS bf16*)(zimg0 + b * ZP + t * 2) = (bf16)f2bf(conv3_at<L>(src, t, w0, w1, w2)); }
    }
#pragma unroll 1
    for (int o = 0; o < 2; ++o) {
        LAS unsigned char* zs = o == 0 ? zimg0 : zimg1;
        LAS unsigned char* zd = o == 0 ? zimg1 : zimg0;
        const bf16* fsrc = ft + ((size_t)(o * 384 + c)) * (2 * L);
        for (int i = F.tid; i < 2 * L; i += NTHR) tf[i] = i == 0 ? (bf16)0 : fsrc[i];
        __syncthreads();
        const int b = F.tid & 15, tg = F.tid >> 4;
        const int gcol = (o == 0 ? 384 : 768) + c;
        const bf16* gsrc = hyt + ((size_t)(b * 1152 + gcol)) * L;
        const float w0 = cw[gcol], w1 = cw[1152 + gcol], w2 = cw[2304 + gcol], sk = skip[o * 384 + c];
#pragma unroll 1
        for (int sb = 0; sb < PER / SUB; ++sb) {
            const int t0 = tg * PER + sb * SUB;
            float acc[SUB];
#pragma unroll
            for (int j = 0; j < SUB; ++j) acc[j] = 0.f;
#pragma unroll 1
            for (int s0 = 0; s0 < L; s0 += 8) {
                float z[8];
                { const bf16x8 zz = *(const LAS bf16x8*)(zs + b * ZP + s0 * 2);
#pragma unroll
                  for (int i = 0; i < 8; ++i) z[i] = bf2f((bf16)zz[i]); }
                float win[SUB + 7];
                const int wb = L + s0 - t0 - (SUB - 1);
#pragma unroll
                for (int i = 0; i < SUB + 7; ++i) win[i] = bf2f(tf[wb + i]);
#pragma unroll
                for (int j = 0; j < SUB; ++j)
#pragma unroll
                    for (int i = 0; i < 8; ++i) acc[j] += win[(SUB - 1) - j + i] * z[i];
            }
#pragma unroll
            for (int j = 0; j < SUB; ++j) {
                const int t = t0 + j;
                const float zt = bf2f(*(LAS bf16*)(zs + b * ZP + t * 2));
                const float ov = conv3_at<L>(gsrc, t, w0, w1, w2) * (acc[j] + sk * zt);
                *(LAS bf16*)(zd + b * ZP + t * 2) = (bf16)f2bf(ov);
            }
        }
        __syncthreads();
    }
#pragma unroll 2
    for (int i = F.tid; i < 16 * (L / 8); i += NTHR) {
        const int b = i / (L / 8), ch = i % (L / 8);
        *(u32x4*)(yht + ((size_t)(b * 384 + c)) * L + ch * 8) = *(const LAS u32x4*)(zimg0 + b * ZP + ch * 16);
    }
}

template <int L>
__device__ __forceinline__ void hyena_unit_fast(Frame& F, int layer, int c, const bf16* hyt  , const bf16* ft  , bf16* yht  ) {
    constexpr int ZP = (L + 8) * 2;
    constexpr int PER = L / 32;
    constexpr int I = L / 128;
    constexpr int SPAN = L / 4, NSTEP = L / 32;
    LAS unsigned char* zimg0 = F.lds;
    LAS unsigned char* zimg1 = F.lds + 16 * ZP;
    LAS bf16* tf = (LAS bf16*)(F.lds + 32 * ZP);
    const float* cw = inp(F, I_HYCONV) + layer * 3 * 1152;
    const float* skip = inp(F, I_HYSKIP) + layer * 2 * 384;
    const int lane = F.lane, fr = lane & 15, fq = lane >> 4, w = F.wave;
    __syncthreads();
    {
        const int b = F.tid >> 5, seg = F.tid & 31; const bf16* src = hyt + ((size_t)(b * 1152 + c)) * L;
        const float w0 = cw[c], w1 = cw[1152 + c], w2 = cw[2304 + c];
#pragma unroll 2
        for (int j = 0; j < PER; ++j) { const int t = seg * PER + j; *(LAS bf16*)(zimg0 + b * ZP + t * 2) = (bf16)f2bf(conv3_at<L>(src, t, w0, w1, w2)); }
    }
    const int tbase = SPAN * (w >> 1) + 16 * (w & 1);
    const int flane = L - tbase + 8 * fq - fr;
#pragma unroll 1
    for (int o = 0; o < 2; ++o) {
        LAS unsigned char* zs = o == 0 ? zimg0 : zimg1;
        LAS unsigned char* zd = o == 0 ? zimg1 : zimg0;
        const bf16* fsrc = ft + ((size_t)(o * 384 + c)) * (2 * L);
        for (int i = F.tid; i < 2 * L; i += NTHR) tf[i] = i == 0 ? (bf16)0 : fsrc[i];
        __syncthreads();
        f32x4 acc[I];
#pragma unroll
        for (int i = 0; i < I; ++i) acc[i] = (f32x4){0.f, 0.f, 0.f, 0.f};
        bf16x8 ring[I];
#pragma unroll
        for (int i = 1; i < I; ++i) __builtin_memcpy(&ring[(I - i) % I], (const LAS unsigned char*)tf + 2 * (flane - 32 * i), 16);
        const LAS unsigned char* zrow = zs + fr * ZP + 16 * fq;
#pragma unroll 1
        for (int j0 = 0; j0 < NSTEP; j0 += I) {
#pragma unroll
            for (int jj = 0; jj < I; ++jj) {
                const int j = j0 + jj;
                __builtin_memcpy(&ring[jj], (const LAS unsigned char*)tf + 2 * (flane + 32 * j), 16);
                const bf16x8 zf = *(const LAS bf16x8*)(zrow + 64 * j);
#pragma unroll
                for (int i = 0; i < I; ++i) acc[i] = __builtin_amdgcn_mfma_f32_16x16x32_bf16(ring[(jj - i + I) % I], zf, acc[i], 0, 0, 0);
            }
        }
        const int gcol = (o == 0 ? 384 : 768) + c;
        const bf16* gsrc = hyt + ((size_t)(fr * 1152 + gcol)) * L;
        const float w0 = cw[gcol], w1 = cw[1152 + gcol], w2 = cw[2304 + gcol], sk = skip[o * 384 + c];
        bf16* dst = yht + ((size_t)(fr * 384 + c)) * L;
#pragma unroll
        for (int i = 0; i < I; ++i) {
            asm volatile("" ::: "memory");
            const int t = tbase + 32 * i + 4 * fq;
            const u32x2 zr = *(const LAS u32x2*)(zs + fr * ZP + t * 2);
            const u32x2 gr = *(const u32x2*)(gsrc + t);
            const float gm = t > 0 ? bf2f(gsrc[t - 1]) : 0.f, gp = t + 4 < L ? bf2f(gsrc[t + 4]) : 0.f;
            const float g0 = __uint_as_float(gr.x << 16), g1 = __uint_as_float(gr.x & 0xffff0000u), g2 = __uint_as_float(gr.y << 16), g3 = __uint_as_float(gr.y & 0xffff0000u);
            const float z0 = __uint_as_float(zr.x << 16), z1 = __uint_as_float(zr.x & 0xffff0000u), z2 = __uint_as_float(zr.y << 16), z3 = __uint_as_float(zr.y & 0xffff0000u);
            const float o0 = (w0 * gm + w1 * g0 + w2 * g1) * (acc[i].x + sk * z0), o1 = (w0 * g0 + w1 * g1 + w2 * g2) * (acc[i].y + sk * z1);
            const float o2 = (w0 * g1 + w1 * g2 + w2 * g3) * (acc[i].z + sk * z2), o3 = (w0 * g2 + w1 * g3 + w2 * gp) * (acc[i].w + sk * z3);
            u32x2 ov; ov.x = pk2(o0, o1); ov.y = pk2(o2, o3);
            if (o == 0) *(LAS u32x2*)(zd + fr * ZP + t * 2) = ov;
            else *(u32x2*)(dst + t) = ov;
        }
        __syncthreads();
    }
}

__device__ __forceinline__ void chain_naive(Frame& F, int layer, int chain) {
    const int lane = F.lane;
    const bool is_ret = chain < 192;
    int b, h, dir;
    if (is_ret) { b = chain / 12; const int r = chain % 12; h = r >> 1; dir = r & 1; }
    else { const int i = chain - 192; b = i >> 3; h = (i & 7) >> 1; dir = i & 1; }
    const bf16* RET = WSP(const bf16, WS_RET); const bf16* ML = WSP(const bf16, WS_ML); const float* MLG = WSP(const float, WS_MLG);
    const float* rope = WSP(const float, WS_ROPE);
    bf16* Y = WSP(bf16, WS_Y); bf16* OB = WSP(bf16, WS_OB);
    float gam = 0.f;
    if (is_ret) gam = sigmoidf_(inp(F, I_RETDECAY)[layer * 12 + dir * 6 + h]);
    const float* mlc = inp(F, I_MLCONV) + layer * 3 * 512;
    const float bi = is_ret ? 0.f : inp(F, I_MLGB)[layer * 16 + dir * 8 + h], bfg = is_ret ? 0.f : inp(F, I_MLGB)[layer * 16 + dir * 8 + 4 + h];
    const float qw0 = mlc[h * 64 + lane], qw1 = mlc[512 + h * 64 + lane], qw2 = mlc[1024 + h * 64 + lane];
    const float kw0 = mlc[256 + h * 64 + lane], kw1 = mlc[512 + 256 + h * 64 + lane], kw2 = mlc[1024 + 256 + h * 64 + lane];
    float S[64];
#pragma unroll
    for (int d = 0; d < 64; ++d) S[d] = 0.f;
    float nv = 0.f;
    for (int step = 0; step < LC + LL; ++step) {
        int row, tpos, L; bool lat;
        if (step < LC) { tpos = dir ? (LC - 1 - step) : step; row = TOKL + b * LC + tpos; L = LC; lat = false; }
        else { const int s2 = step - LC; tpos = dir ? (LL - 1 - s2) : s2; row = b * LL + tpos; L = LL; lat = true; }
        float q, k, v, Fm, Im;
        if (is_ret) {
            const bf16* base = RET + (size_t)row * 1536;
            float qs = bf2f(base[h * 64 + lane]), ks = bf2f(base[384 + h * 64 + lane]);
            v = bf2f(base[768 + h * 64 + lane]);
            if (lat) {
                const float qp = bf2f(base[h * 64 + (lane ^ 16)]), kp = bf2f(base[384 + h * 64 + (lane ^ 16)]);
                const int half = lane >> 5, ii = lane & 15, hi = (lane >> 4) & 1;
                const float cs = rope[tpos * 64 + half * 32 + ii], sn = rope[tpos * 64 + half * 32 + 16 + ii];
                q = hi == 0 ? qs * cs - qp * sn : qp * sn + qs * cs;
                k = hi == 0 ? ks * cs - kp * sn : kp * sn + ks * cs;
            } else { q = qs; k = ks; }
            q *= 0.125f; Fm = gam; Im = 1.f;
        } else {
            const bf16* base = ML + (size_t)row * 1024;
            const float q0 = tpos > 0 ? bf2f(base[-1024 + h * 64 + lane]) : 0.f, q1 = bf2f(base[h * 64 + lane]), q2 = tpos < L - 1 ? bf2f(base[1024 + h * 64 + lane]) : 0.f;
            const float k0 = tpos > 0 ? bf2f(base[-1024 + 256 + h * 64 + lane]) : 0.f, k1 = bf2f(base[256 + h * 64 + lane]), k2 = tpos < L - 1 ? bf2f(base[1024 + 256 + h * 64 + lane]) : 0.f;
            q = siluf_(qw0 * q0 + qw1 * q1 + qw2 * q2);
            k = siluf_(kw0 * k0 + kw1 * k1 + kw2 * k2) * 0.125f;
            v = bf2f(base[512 + h * 64 + lane]);
            const float ig = MLG[(size_t)row * 16 + dir * 8 + h] + bi, fg = MLG[(size_t)row * 16 + dir * 8 + 4 + h] + bfg;
            Fm = sigmoidf_(fg); Im = __expf(ig);
        }
        float num = 0.f;
        const float iv = Im * v;
#pragma unroll
        for (int d = 0; d < 64; ++d) {
            const float kd = __int_as_float(__builtin_amdgcn_readlane(__float_as_int(k), d));
            const float qd = __int_as_float(__builtin_amdgcn_readlane(__float_as_int(q), d));
            S[d] = Fm * S[d] + kd * iv;
            num += qd * S[d];
        }
        float o = num;
        if (!is_ret) { nv = Fm * nv + Im * k; const float den = wave_sum(q * nv); o = num / fmaxf(fabsf(den), 1.f); }
        const int cof = is_ret ? (h * 64 + lane) : (384 + h * 64 + lane);
        if (dir == 0) Y[(size_t)row * D + 384 + cof] = (bf16)f2bf(o);
        else OB[(size_t)row * 640 + cof] = (bf16)f2bf(o);
    }
}

constexpr int CH_PITCH = 144;
constexpr int CH_IMG = 64 * CH_PITCH;
constexpr int CH_WAVE_LDS = 3 * CH_IMG + 1024 + 256;
__device__ __forceinline__ void ds_tr16x8(unsigned addr, u32x2 (&lo)[4], u32x2 (&hi)[4]) {
    asm volatile("ds_read_b64_tr_b16 %0, %8\n\tds_read_b64_tr_b16 %1, %8 offset:32\n\tds_read_b64_tr_b16 %2, %8 offset:64\n\tds_read_b64_tr_b16 %3, %8 offset:96\n\t"
                 "ds_read_b64_tr_b16 %4, %8 offset:2304\n\tds_read_b64_tr_b16 %5, %8 offset:2336\n\tds_read_b64_tr_b16 %6, %8 offset:2368\n\tds_read_b64_tr_b16 %7, %8 offset:2400\n\t"
                 "s_waitcnt lgkmcnt(0)"
                 : "=&v"(lo[0]), "=&v"(lo[1]), "=&v"(lo[2]), "=&v"(lo[3]), "=&v"(hi[0]), "=&v"(hi[1]), "=&v"(hi[2]), "=&v"(hi[3]) : "v"(addr) : "memory");
}
static_assert(16 * CH_PITCH == 2304, "ds_tr16x8 offsets");
__device__ __forceinline__ float log_sigmoid_(float x) { return fminf(x, 0.f) - log1pf(__expf(-fabsf(x))); }
__device__ __forceinline__ bf16x8 mk_frag(u32x2 lo, u32x2 hi) { u32x4 w; w.x = lo.x; w.y = lo.y; w.z = hi.x; w.w = hi.y; return __builtin_bit_cast(bf16x8, w); }

template <bool IS_ML>
__device__ __forceinline__ void chain_fast(Frame& F, int layer, int b, int h, int dir, LAS unsigned char* img) {
    constexpr int NET = 4;
    const int lane = F.lane, fr = lane & 15, fq = lane >> 4;
    LAS unsigned char* Qi = img; LAS unsigned char* Ki = img + CH_IMG; LAS unsigned char* Vi = img + 2 * CH_IMG;
    const unsigned qa = (unsigned)(size_t)Qi, ka = (unsigned)(size_t)Ki, va = (unsigned)(size_t)Vi;
    const bf16* RET = WSP(const bf16, WS_RET); const bf16* ML = WSP(const bf16, WS_ML); const float* MLG = WSP(const float, WS_MLG);
    const float* rope = WSP(const float, WS_ROPE);
    bf16* Y = WSP(bf16, WS_Y); bf16* OB = WSP(bf16, WS_OB);
    float lgam = 0.f, bi_ = 0.f, bf_ = 0.f;
    if (!IS_ML) lgam = log_sigmoid_(inp(F, I_RETDECAY)[layer * 12 + dir * 6 + h]);
    else { bi_ = inp(F, I_MLGB)[layer * 16 + dir * 8 + h]; bf_ = inp(F, I_MLGB)[layer * 16 + dir * 8 + 4 + h]; }
    const float* mlc = inp(F, I_MLCONV) + layer * 3 * 512;
    f32x4 C[4][NET];
#pragma unroll
    for (int dt = 0; dt < 4; ++dt)
#pragma unroll
        for (int et = 0; et < NET; ++et) C[dt][et] = (f32x4){0.f, 0.f, 0.f, 0.f};
    const int cq = lane & 7, pr0 = lane >> 3;
    LAS float* nvec = (LAS float*)(img + 3 * CH_IMG + 1024);
    if (IS_ML) nvec[lane] = 0.f;
    const LAS float* nq = nvec + 4 * fq;
#pragma unroll 1
    for (int step = 0; step < 36; ++step) {
        int rowbase, t0, L; bool lat;
        if (step < 4) { const int cc = dir ? 3 - step : step; rowbase = TOKL + b * LC + cc * 64; t0 = cc * 64; L = LC; lat = false; }
        else { const int cc = dir ? 35 - step : step - 4; rowbase = b * LL + cc * 64; t0 = cc * 64; L = LL; lat = true; }
#pragma unroll 1
        for (int i = 0; i < 8; ++i) {
            const int p = pr0 + 8 * i, tl = dir ? 63 - p : p, row = rowbase + tl, tpos = t0 + tl;
            float qv[8], kv[8]; u32x4 vraw;
            if (!IS_ML) {
                const bf16* base = RET + (size_t)row * 1536 + h * 64;
                const u32x4 qr = *(const u32x4*)(base + 8 * cq), kr = *(const u32x4*)(base + 384 + 8 * cq); vraw = *(const u32x4*)(base + 768 + 8 * cq);
                const unsigned qw[4] = {qr.x, qr.y, qr.z, qr.w}, kw[4] = {kr.x, kr.y, kr.z, kr.w};
#pragma unroll
                for (int j = 0; j < 4; ++j) { qv[2 * j] = __uint_as_float(qw[j] << 16); qv[2 * j + 1] = __uint_as_float(qw[j] & 0xffff0000u); kv[2 * j] = __uint_as_float(kw[j] << 16); kv[2 * j + 1] = __uint_as_float(kw[j] & 0xffff0000u); }
                if (lat) {
                    const u32x4 qpr = *(const u32x4*)(base + 8 * (cq ^ 2)), kpr = *(const u32x4*)(base + 384 + 8 * (cq ^ 2));
                    const unsigned qpw[4] = {qpr.x, qpr.y, qpr.z, qpr.w}, kpw[4] = {kpr.x, kpr.y, kpr.z, kpr.w};
                    const int half = cq >> 2, hi = (cq >> 1) & 1, i0 = 8 * (cq & 1);
                    const float* rp = rope + tpos * 64 + half * 32 + i0;
                    const f32x4 c0 = *(const f32x4*)(rp), c1 = *(const f32x4*)(rp + 4), s0 = *(const f32x4*)(rp + 16), s1 = *(const f32x4*)(rp + 20);
                    const float cs[8] = {c0.x, c0.y, c0.z, c0.w, c1.x, c1.y, c1.z, c1.w}, sn[8] = {s0.x, s0.y, s0.z, s0.w, s1.x, s1.y, s1.z, s1.w};
#pragma unroll
                    for (int j = 0; j < 8; ++j) {
                        const float qp = (j & 1) ? __uint_as_float(qpw[j >> 1] & 0xffff0000u) : __uint_as_float(qpw[j >> 1] << 16);
                        const float kp = (j & 1) ? __uint_as_float(kpw[j >> 1] & 0xffff0000u) : __uint_as_float(kpw[j >> 1] << 16);
                        qv[j] = hi ? qp * sn[j] + qv[j] * cs[j] : qv[j] * cs[j] - qp * sn[j];
                        kv[j] = hi ? kp * sn[j] + kv[j] * cs[j] : kv[j] * cs[j] - kp * sn[j];
                    }
                }
#pragma unroll
                for (int j = 0; j < 8; ++j) qv[j] *= 0.125f;
            } else {
                const bf16* base = ML + (size_t)row * 1024 + h * 64 + 8 * cq;
                const u32x4 z4 = (u32x4){0u, 0u, 0u, 0u};
                const float* wq = mlc + h * 64 + 8 * cq; asm volatile("" : "+v"(wq));
                vraw = *(const u32x4*)(base + 512);
#pragma unroll
                for (int qk = 0; qk < 2; ++qk) {
                    const bf16* bb = base + 256 * qk; const float* ww = wq + 256 * qk;
                    const u32x4 r1 = *(const u32x4*)(bb), r0 = tpos > 0 ? *(const u32x4*)(bb - 1024) : z4, r2 = tpos < L - 1 ? *(const u32x4*)(bb + 1024) : z4;
                    const unsigned a0[4] = {r0.x, r0.y, r0.z, r0.w}, a1[4] = {r1.x, r1.y, r1.z, r1.w}, a2[4] = {r2.x, r2.y, r2.z, r2.w};
#pragma unroll
                    for (int j = 0; j < 8; ++j) {
                        const float x0 = (j & 1) ? __uint_as_float(a0[j >> 1] & 0xffff0000u) : __uint_as_float(a0[j >> 1] << 16);
                        const float x1 = (j & 1) ? __uint_as_float(a1[j >> 1] & 0xffff0000u) : __uint_as_float(a1[j >> 1] << 16);
                        const float x2 = (j & 1) ? __uint_as_float(a2[j >> 1] & 0xffff0000u) : __uint_as_float(a2[j >> 1] << 16);
                        const float r = siluf_(ww[j] * x0 + ww[512 + j] * x1 + ww[1024 + j] * x2);
                        if (qk == 0) qv[j] = r; else kv[j] = r * 0.125f;
                    }
                    if (qk == 0) asm volatile("" : "+v"(qv[0]), "+v"(qv[1]), "+v"(qv[2]), "+v"(qv[3]), "+v"(qv[4]), "+v"(qv[5]), "+v"(qv[6]), "+v"(qv[7]) :: "memory");
                }
            }
            u32x4 qo, ko; qo.x = pk2(qv[0], qv[1]); qo.y = pk2(qv[2], qv[3]); qo.z = pk2(qv[4], qv[5]); qo.w = pk2(qv[6], qv[7]);
            ko.x = pk2(kv[0], kv[1]); ko.y = pk2(kv[2], kv[3]); ko.z = pk2(kv[4], kv[5]); ko.w = pk2(kv[6], kv[7]);
            *(LAS u32x4*)(Qi + p * CH_PITCH + 16 * cq) = qo; *(LAS u32x4*)(Ki + p * CH_PITCH + 16 * cq) = ko; *(LAS u32x4*)(Vi + p * CH_PITCH + 16 * cq) = vraw;
        }
        __builtin_amdgcn_sched_barrier(0);
        float f_p, i_p;
        { const int tl = dir ? 63 - lane : lane, row = rowbase + tl;
          if (!IS_ML) { f_p = lgam; i_p = 0.f; }
          else { i_p = MLG[(size_t)row * 16 + dir * 8 + h] + bi_; f_p = log_sigmoid_(MLG[(size_t)row * 16 + dir * 8 + 4 + h] + bf_); } }
        float bsum = f_p;
#pragma unroll
        for (int o = 1; o < 64; o <<= 1) { const float t = __shfl_up(bsum, o); if (lane >= o) bsum += t; }
        LAS float* gv = (LAS float*)(img + 3 * CH_IMG);
        const float b63 = __shfl(bsum, 63);
        const float adec = __expf(b63);
        gv[lane] = bsum; gv[64 + lane] = bsum - i_p; gv[128 + lane] = __expf(bsum); gv[192 + lane] = __expf(b63 - (bsum - i_p));
        asm volatile("s_waitcnt lgkmcnt(0)" ::: "memory");
        const LAS float* gq = gv + 4 * fq;
        const bf16x8 ones = (fr == 0) ? (bf16x8){0x3F80, 0x3F80, 0x3F80, 0x3F80, 0x3F80, 0x3F80, 0x3F80, 0x3F80} : (bf16x8){0, 0, 0, 0, 0, 0, 0, 0};
        const int tr_q = fr >> 2, tr_p = fr & 3;
#pragma unroll 1
        for (int pt = 0; pt < 4; ++pt) {
            f32x4 ST[4];
            bf16x8 qn[2];
#pragma unroll
            for (int kk = 0; kk < 2; ++kk) qn[kk] = *(const LAS bf16x8*)(Qi + (16 * pt + fr) * CH_PITCH + (32 * kk + 8 * fq) * 2);
#pragma unroll
            for (int st = 0; st < 4; ++st) {
                ST[st] = (f32x4){0.f, 0.f, 0.f, 0.f};
                if (st <= pt) {
#pragma unroll
                    for (int kk = 0; kk < 2; ++kk) { const bf16x8 kf = *(const LAS bf16x8*)(Ki + (16 * st + fr) * CH_PITCH + (32 * kk + 8 * fq) * 2); ST[st] = __builtin_amdgcn_mfma_f32_16x16x32_bf16(kf, qn[kk], ST[st], 0, 0, 0); }
                }
            }
            const float bp = gv[16 * pt + fr];
#pragma unroll
            for (int st = 0; st < 4; ++st) {
                if (st <= pt) {
                    const f32x4 bis = *(const LAS f32x4*)(gq + 64 + 16 * st);
#pragma unroll
                    for (int j = 0; j < 4; ++j) { const int sidx = 16 * st + 4 * fq + j; const float w = (sidx <= 16 * pt + fr) ? __expf(bp - bis[j]) : 0.f; ST[st][j] *= w; }
                }
            }
            __builtin_amdgcn_sched_barrier(0);
            f32x4 acc[NET], accd = (f32x4){0.f, 0.f, 0.f, 0.f};
#pragma unroll
            for (int et = 0; et < NET; ++et) acc[et] = (f32x4){0.f, 0.f, 0.f, 0.f};
#pragma unroll
            for (int kk = 0; kk < 2; ++kk) {
                const u32x2 lo = *(const LAS u32x2*)(Qi + (16 * pt + fr) * CH_PITCH + (32 * kk + 4 * fq) * 2), hi = *(const LAS u32x2*)(Qi + (16 * pt + fr) * CH_PITCH + (32 * kk + 16 + 4 * fq) * 2);
                const bf16x8 qs = mk_frag(lo, hi);
#pragma unroll
                for (int et = 0; et < NET; ++et) {
                    u32x4 w; w.x = pk2(C[2 * kk][et].x, C[2 * kk][et].y); w.y = pk2(C[2 * kk][et].z, C[2 * kk][et].w); w.z = pk2(C[2 * kk + 1][et].x, C[2 * kk + 1][et].y); w.w = pk2(C[2 * kk + 1][et].z, C[2 * kk + 1][et].w);
                    acc[et] = __builtin_amdgcn_mfma_f32_16x16x32_bf16(qs, __builtin_bit_cast(bf16x8, w), acc[et], 0, 0, 0);
                }
                if (IS_ML) {
                    const f32x4 n0 = *(const LAS f32x4*)(nq + 32 * kk), n1 = *(const LAS f32x4*)(nq + 32 * kk + 16);
                    u32x4 w; w.x = pk2(n0.x, n0.y); w.y = pk2(n0.z, n0.w); w.z = pk2(n1.x, n1.y); w.w = pk2(n1.z, n1.w);
                    if (fr != 0) w = (u32x4){0u, 0u, 0u, 0u};
                    accd = __builtin_amdgcn_mfma_f32_16x16x32_bf16(qs, __builtin_bit_cast(bf16x8, w), accd, 0, 0, 0);
                }
            }
            { const f32x4 ap = *(const LAS f32x4*)(gq + 128 + 16 * pt);
#pragma unroll
              for (int j = 0; j < 4; ++j) {
#pragma unroll
                for (int et = 0; et < NET; ++et) acc[et][j] *= ap[j];
                accd[j] *= ap[j]; } }
            __builtin_amdgcn_sched_barrier(0);
#pragma unroll
            for (int kk = 0; kk < 2; ++kk) {
                if (2 * kk <= pt) {
                    u32x4 w; w.x = pk2(ST[2 * kk].x, ST[2 * kk].y); w.y = pk2(ST[2 * kk].z, ST[2 * kk].w); w.z = pk2(ST[2 * kk + 1].x, ST[2 * kk + 1].y); w.w = pk2(ST[2 * kk + 1].z, ST[2 * kk + 1].w);
                    const bf16x8 pf = __builtin_bit_cast(bf16x8, w);
                    u32x2 vlo[4], vhi[4];
                    ds_tr16x8(va + (32 * kk + 4 * fq + tr_q) * CH_PITCH + 8 * tr_p, vlo, vhi);
#pragma unroll
                    for (int et = 0; et < 4; ++et) acc[et] = __builtin_amdgcn_mfma_f32_16x16x32_bf16(pf, mk_frag(vlo[et], vhi[et]), acc[et], 0, 0, 0);
                    if (IS_ML) accd = __builtin_amdgcn_mfma_f32_16x16x32_bf16(pf, ones, accd, 0, 0, 0);
                }
            }
            __builtin_amdgcn_sched_barrier(0);
#pragma unroll
            for (int j = 0; j < 4; ++j) {
                const int p = 16 * pt + 4 * fq + j, tl = dir ? 63 - p : p, row = rowbase + tl;
                float inv = 1.f;
                if (IS_ML) { const float den = __shfl(accd[j], lane & 48); inv = 1.f / fmaxf(fabsf(den), 1.f); }
#pragma unroll
                for (int et = 0; et < 4; ++et) {
                    const float o = acc[et][j] * inv;
                    const int cof = (IS_ML ? 384 : 0) + h * 64 + 16 * et + fr;
                    if (dir == 0) Y[(size_t)row * D + 384 + cof] = (bf16)f2bf(o); else OB[(size_t)row * 640 + cof] = (bf16)f2bf(o);
                }
            }
        }
        __builtin_amdgcn_sched_barrier(0);
#pragma unroll
        for (int dt = 0; dt < 4; ++dt)
#pragma unroll
            for (int et = 0; et < NET; ++et) C[dt][et] *= adec;
        f32x4 accn[4];
        if (IS_ML) {
#pragma unroll
            for (int dt = 0; dt < 4; ++dt) { accn[dt] = *(const LAS f32x4*)(nq + 16 * dt) * adec; if (fr != 0) accn[dt] = (f32x4){0.f, 0.f, 0.f, 0.f}; }
        }
#pragma unroll
        for (int kk = 0; kk < 2; ++kk) {
            u32x2 vlo[4], vhi[4], klo[4], khi[4];
            ds_tr16x8(va + (32 * kk + 4 * fq + tr_q) * CH_PITCH + 8 * tr_p, vlo, vhi);
            ds_tr16x8(ka + (32 * kk + 4 * fq + tr_q) * CH_PITCH + 8 * tr_p, klo, khi);
            const f32x4 wl = *(const LAS f32x4*)(gq + 192 + 32 * kk), wh = *(const LAS f32x4*)(gq + 192 + 32 * kk + 16);
#pragma unroll
            for (int dt = 0; dt < 4; ++dt) {
                u32x4 w;
                w.x = pk2(__uint_as_float(klo[dt].x << 16) * wl[0], __uint_as_float(klo[dt].x & 0xffff0000u) * wl[1]);
                w.y = pk2(__uint_as_float(klo[dt].y << 16) * wl[2], __uint_as_float(klo[dt].y & 0xffff0000u) * wl[3]);
                w.z = pk2(__uint_as_float(khi[dt].x << 16) * wh[0], __uint_as_float(khi[dt].x & 0xffff0000u) * wh[1]);
                w.w = pk2(__uint_as_float(khi[dt].y << 16) * wh[2], __uint_as_float(khi[dt].y & 0xffff0000u) * wh[3]);
                const bf16x8 kf = __builtin_bit_cast(bf16x8, w);
#pragma unroll
                for (int et = 0; et < 4; ++et) C[dt][et] = __builtin_amdgcn_mfma_f32_16x16x32_bf16(kf, mk_frag(vlo[et], vhi[et]), C[dt][et], 0, 0, 0);
                if (IS_ML) accn[dt] = __builtin_amdgcn_mfma_f32_16x16x32_bf16(kf, ones, accn[dt], 0, 0, 0);
            }
        }
        if (IS_ML) { if (fr == 0) {
#pragma unroll
            for (int dt = 0; dt < 4; ++dt) *(LAS f32x4*)(nvec + 4 * fq + 16 * dt) = accn[dt]; } }
        asm volatile("s_waitcnt lgkmcnt(0)" ::: "memory");
    }
}

#ifndef FAST_CHAIN
#define FAST_CHAIN 1
#endif
constexpr int NCHWG = 80;
__device__ __forceinline__ void phase_mix(Frame& F, int layer) {
    const bool last = layer == 1;
    const bf16* ftl = WSP(const bf16, WS_FTL) + (size_t)layer * 2 * 384 * 4096;
    if (FAST_CHAIN) {
        if (F.wg < NCHWG) {
            if (F.wave < 4) {
                const int c = F.wg * 4 + F.wave;
                LAS unsigned char* img = F.lds + F.wave * CH_WAVE_LDS;
                if (c < 192) { const int b = c / 12, r = c % 12; chain_fast<false>(F, layer, b, r >> 1, r & 1, img); }
                else { const int i = c - 192; chain_fast<true>(F, layer, i >> 3, (i & 7) >> 1, i & 1, img); }
            }
        } else {
            const int nh = F.G - NCHWG, w = F.wg - NCHWG;
#ifndef FAST_HY
#define FAST_HY 1
#endif
            if (FAST_HY) {
                for (int u = w; u < 384; u += nh) hyena_unit_fast<LL>(F, layer, u, WSP(const bf16, WS_HYTL), ftl, WSP(bf16, WS_YHTL));
                if (!last) for (int u = w; u < 384; u += nh) hyena_unit_fast<LC>(F, layer, u, WSP(const bf16, WS_HYTC), WSP(const bf16, WS_FTC), WSP(bf16, WS_YHTC));
            } else {
                for (int u = w; u < 384; u += nh) hyena_unit_naive<LL>(F, layer, u, WSP(const bf16, WS_HYTL), ftl, WSP(bf16, WS_YHTL));
                if (!last) for (int u = w; u < 384; u += nh) hyena_unit_naive<LC>(F, layer, u, WSP(const bf16, WS_HYTC), WSP(const bf16, WS_FTC), WSP(bf16, WS_YHTC));
            }
        }
    } else {
        for (int u = F.wg; u < 384; u += F.G) hyena_unit_naive<LL>(F, layer, u, WSP(const bf16, WS_HYTL), ftl, WSP(bf16, WS_YHTL));
        if (!last) for (int u = F.wg; u < 384; u += F.G) hyena_unit_naive<LC>(F, layer, u, WSP(const bf16, WS_HYTC), WSP(const bf16, WS_FTC), WSP(bf16, WS_YHTC));
        for (int c = F.wg + F.wave * F.G; c < 320; c += F.G * NWAVES) chain_naive(F, layer, c);
    }
}

__device__ __forceinline__ void phase_combine(Frame& F, int layer) {
    const bool last = layer == 1;
    const int gw = F.wg * NWAVES + F.wave, NGW = F.G * NWAVES, lane = F.lane;
    const int nrows = last ? TOKL : TOK;
    bf16* Y = WSP(bf16, WS_Y); const bf16* OB = WSP(const bf16, WS_OB); const bf16* RET = WSP(const bf16, WS_RET); const bf16* ML = WSP(const bf16, WS_ML);
    for (int row = gw; row < nrows; row += NGW) {
#pragma unroll
        for (int hh = 0; hh < 10; ++hh) {
            const int cof = hh * 64 + lane;
            const float x = bf2f(Y[(size_t)row * D + 384 + cof]) + bf2f(OB[(size_t)row * 640 + cof]);
            const float mu = wave_sum(x) * (1.f / 64.f), xc = x - mu;
            const float var = wave_sum(xc * xc) * (1.f / 64.f);
            const float nrm = xc * rsqrtf(var + 1e-6f);
            float gate;
            if (hh < 6) gate = siluf_(bf2f(RET[(size_t)row * 1536 + 1152 + cof]));
            else gate = sigmoidf_(bf2f(ML[(size_t)row * 1024 + 768 + (cof - 384)]));
            Y[(size_t)row * D + 384 + cof] = (bf16)f2bf(nrm * gate);
        }
    }
    LAS float* scr = (LAS float*)(F.lds + F.wave * 16640);
    const int nitL = NB * 6 * 32, nitC = last ? 0 : NB * 6 * 4;
    for (int it = gw; it < nitL + nitC; it += NGW) {
        const bf16* src; int L, rowbase, b, cb, tb;
        if (it < nitL) { b = it / 192; const int r = it % 192; cb = r / 32; tb = r % 32; L = LL; src = WSP(const bf16, WS_YHTL); rowbase = b * LL; }
        else { const int i2 = it - nitL; b = i2 / 24; const int r = i2 % 24; cb = r / 4; tb = r % 4; L = LC; src = WSP(const bf16, WS_YHTC); rowbase = TOKL + b * LC; }
        for (int cc = 0; cc < 64; ++cc) scr[cc * 65 + lane] = bf2f(src[((size_t)(b * 384 + cb * 64 + cc)) * L + tb * 64 + lane]);
        asm volatile("s_waitcnt lgkmcnt(0)" ::: "memory");
        for (int tt = 0; tt < 64; ++tt) Y[(size_t)(rowbase + tb * 64 + tt) * D + cb * 64 + lane] = (bf16)f2bf(scr[lane * 65 + tt]);
        asm volatile("s_waitcnt lgkmcnt(0)" ::: "memory");
    }
}

__device__ __forceinline__ void phase_norm_router(Frame& F) {
    const int gw = F.wg * NWAVES + F.wave, NGW = F.G * NWAVES, lane = F.lane;
    const float* g = inp(F, I_GFFN) + 1 * D; const float* wr = inp(F, I_ROUTER); const float* br = inp(F, I_ROUTERB);
    unsigned* cnt = WSP(unsigned, WS_CTL) + CW_CNT;
    for (int row = gw; row < TOKL; row += NGW) {
        float keep[16];
        norm_mod_row(xrow_ptr(F, row, false), g, mod_ptr(F, 1, row, 3), mod_ptr(F, 1, row, 4), WSP(bf16, WS_H) + (size_t)row * D, lane, keep);
        float lg[8];
#pragma unroll
        for (int e = 0; e < 8; ++e) lg[e] = 0.f;
#pragma unroll
        for (int j = 0; j < 4; ++j)
#pragma unroll
            for (int i = 0; i < 4; ++i) { const int k = 256 * j + 4 * lane + i; const f32x4 w0 = *(const f32x4*)(wr + k * 8), w1 = *(const f32x4*)(wr + k * 8 + 4); const float x = keep[4 * j + i];
                lg[0] += x * w0.x; lg[1] += x * w0.y; lg[2] += x * w0.z; lg[3] += x * w0.w; lg[4] += x * w1.x; lg[5] += x * w1.y; lg[6] += x * w1.z; lg[7] += x * w1.w; }
#pragma unroll
        for (int e = 0; e < 8; ++e) lg[e] = wave_sum(lg[e]) + br[e];
        int e0 = 0; float v0 = lg[0];
#pragma unroll
        for (int e = 1; e < 8; ++e) if (lg[e] > v0) { v0 = lg[e]; e0 = e; }
        int e1 = -1; float v1 = -3.0e38f;
#pragma unroll
        for (int e = 0; e < 8; ++e) if (e != e0 && lg[e] > v1) { v1 = lg[e]; e1 = e; }
        const float w1 = 1.f / (1.f + __expf(v0 - v1)), w0 = 1.f - w1;
        if (lane == 0) {
            const unsigned p0 = atomicAdd(cnt + e0, 1u), p1 = atomicAdd(cnt + e1, 1u);
            WSP(int, WS_TOPE)[row * 2] = e0; WSP(int, WS_TOPE)[row * 2 + 1] = e1;
            WSP(float, WS_TOPW)[row * 2] = w0; WSP(float, WS_TOPW)[row * 2 + 1] = w1;
            WSP(int, WS_TOPP)[row * 2] = (int)p0; WSP(int, WS_TOPP)[row * 2 + 1] = (int)p1;
        }
    }
}
__device__ __forceinline__ void phase_route_tables(Frame& F) {
    const unsigned* cnt = WSP(const unsigned, WS_CTL) + CW_CNT;
    int off[9]; off[0] = 0;
#pragma unroll
    for (int e = 0; e < 8; ++e) { const int c = (int)__hip_atomic_load(cnt + e, __ATOMIC_RELAXED, __HIP_MEMORY_SCOPE_AGENT); off[e + 1] = off[e] + ((c + 255) >> 8) * 256; }
    const int gt = F.wg * NTHR + F.tid, NGT = F.G * NTHR;
    int* rowidx = WSP(int, WS_ROWIDX); int* slot = WSP(int, WS_SLOT); int* tilee = WSP(int, WS_TILEE);
    for (int i = gt; i < MAXTILES * 256; i += NGT) {
        int e = 0;
#pragma unroll
        for (int q = 1; q < 8; ++q) if (i >= off[q]) e = q;
        const int c = (int)cnt[e];
        if (i >= off[8] || i - off[e] >= c) rowidx[i] = 0;
    }
    for (int i = gt; i < TOKL * 2; i += NGT) {
        const int e = WSP(const int, WS_TOPE)[i], pos = WSP(const int, WS_TOPP)[i];
        int o = 0;
#pragma unroll
        for (int q = 0; q < 8; ++q) if (e == q) o = off[q];
        const int s = o + pos; slot[i] = s; rowidx[s] = i >> 1;
    }
    for (int i = gt; i < MAXTILES + 1; i += NGT) {
        if (i == MAXTILES) tilee[MAXTILES] = off[8] >> 8;
        else { int e = 0;
#pragma unroll
            for (int q = 1; q < 8; ++q) if (i * 256 >= off[q]) e = q;
            tilee[i] = e; }
    }
}

__device__ __forceinline__ void moe_pass_gemm1(Frame& F, int t0, int t1) {
    const int gw = F.wg * NWAVES + F.wave, NGW = F.G * NWAVES;
    const int* tilee = WSP(const int, WS_TILEE); RowsGather R{WSP(const int, WS_ROWIDX)};
    const int nct = NFF1 / 64, nunits = (t1 - t0) * 4 * nct;
    EpiSwiglu E{WSP(bf16, WS_MACT), t0 * 256};
    for (int u = gw; u < nunits; u += NGW) {
        const int rt = u / nct, ct = u % nct, tile = t0 + (rt >> 2);
        const bf16* Bt = WSP(const bf16, WS_MW13) + (size_t)tilee[tile] * NFF1 * D;
        gemm_simple_tile(WSP(const bf16, WS_H), D, Bt, D, D, t0 * 4 + rt, ct, E, R, F.lane);
    }
}
__device__ __forceinline__ void moe_pass_gemm2(Frame& F, int t0, int t1) {
    const int gw = F.wg * NWAVES + F.wave, NGW = F.G * NWAVES;
    const int* tilee = WSP(const int, WS_TILEE);
    const int nct = D / 64, nunits = (t1 - t0) * 4 * nct;
    EpiBf16Out E{WSP(bf16, WS_EOUT), D, t0 * 256};
    for (int u = gw; u < nunits; u += NGW) {
        const int rt = u / nct, ct = u % nct, tile = t0 + (rt >> 2);
        const bf16* Bt = WSP(const bf16, WS_MW2) + (size_t)tilee[tile] * D * DFF;
        gemm_simple_tile(WSP(const bf16, WS_MACT), DFF, Bt, DFF, DFF, rt, ct, E, RowsId(), F.lane);
    }
}
__device__ __forceinline__ void moe_pass_gemm1_fast(Frame& F, int t0, int t1) {
    pg8::OrderMoe S; S.o.init(t1 - t0, NFF1 / 256, F.G, F.wg); S.rowidx = WSP(const int, WS_ROWIDX); S.tilee = WSP(const int, WS_TILEE); S.t0 = t0; S.bstride = (size_t)NFF1 * D; S.gather = true;
    EpiSwiglu E{WSP(bf16, WS_MACT), 0};
    pg8::gemm_phase(F.lds, WSP(const bf16, WS_H), D, WSP(const bf16, WS_MW13), D, D, S, E);
}
__device__ __forceinline__ void moe_pass_gemm2_fast(Frame& F, int t0, int t1) {
    pg8::OrderMoe S; S.o.init(t1 - t0, D / 256, F.G, F.wg); S.rowidx = WSP(const int, WS_ROWIDX); S.tilee = WSP(const int, WS_TILEE); S.t0 = t0; S.bstride = (size_t)D * DFF; S.gather = false;
    EpiBf16Out E{WSP(bf16, WS_EOUT), D, t0 * 256};
    pg8::gemm_phase(F.lds, WSP(const bf16, WS_MACT), DFF, WSP(const bf16, WS_MW2), DFF, DFF, S, E);
}
__device__ __forceinline__ void phase_final(Frame& F) {
    const int gw = F.wg * NWAVES + F.wave, NGW = F.G * NWAVES, lane = F.lane;
    const float* gf = inp(F, I_GFINAL); const bf16* eo = WSP(const bf16, WS_EOUT);
    for (int row = gw; row < TOKL; row += NGW) {
        const int s0 = WSP(const int, WS_SLOT)[row * 2], s1 = WSP(const int, WS_SLOT)[row * 2 + 1];
        const float w0 = WSP(const float, WS_TOPW)[row * 2], w1 = WSP(const float, WS_TOPW)[row * 2 + 1];
        const float* m5 = mod_ptr(F, 1, row, 5);
        float* xr = outp(F) + (size_t)row * D;
        f32x4 v[4]; float s = 0.f;
#pragma unroll
        for (int j = 0; j < 4; ++j) {
            const int c = 256 * j + 4 * lane;
            const f32x4 a = ld_bf16x4(eo + (size_t)s0 * D + c), b = ld_bf16x4(eo + (size_t)s1 * D + c), m = *(const f32x4*)(m5 + c);
            v[j] = *(const f32x4*)(xr + c) + m * (a * w0 + b * w1);
            s += (v[j].x * v[j].x + v[j].y * v[j].y) + (v[j].z * v[j].z + v[j].w * v[j].w);
        }
        const float r = rsqrtf(wave_sum(s) * (1.f / 1024.f) + 1e-6f);
#pragma unroll
        for (int j = 0; j < 4; ++j) { const int c = 256 * j + 4 * lane; const f32x4 g = *(const f32x4*)(gf + c); *(f32x4*)(xr + c) = v[j] * r * g; }
    }
}

__global__ void __launch_bounds__(NTHR, 2) hybrid_fwd(Params prm) {
    extern __shared__ __attribute__((aligned(16))) unsigned char lds_raw[];
    Frame F;
    F.lds = (LAS unsigned char*)lds_raw; F.ws = prm.ws;
    F.tid = threadIdx.x; F.lane = F.tid & 63; F.wave = __builtin_amdgcn_readfirstlane(F.tid >> 6); F.G = gridDim.x; F.wg = blockIdx.x;
    volatile LAS unsigned* MISC = (volatile LAS unsigned*)(F.lds + MISC_OFF);
    if (F.tid < 64) MISC[F.tid] = 0u;
    if (F.tid < 33) { const unsigned long long v = F.tid < 32 ? (unsigned long long)prm.in[F.tid] : (unsigned long long)prm.out; *(LAS unsigned long long*)(F.lds + PTAB_OFF + 8 * F.tid) = v; }
    __syncthreads();
    XcdBarrier bar = xcd_barrier_post(WSP(unsigned, WS_CTL) + CW_BAR, MISC + 8);
#define RELAUNDER() do { { unsigned long long _w = (unsigned long long)F.ws; asm volatile("" : "+s"(_w)); F.ws = (unsigned char*)_w; } \
        { unsigned _t = (unsigned)F.tid; asm volatile("" : "+v"(_t)); F.tid = (int)_t; F.lane = F.tid & 63; F.wave = __builtin_amdgcn_readfirstlane(F.tid >> 6); } \
        { unsigned _g = (unsigned)F.G, _b = (unsigned)F.wg; asm volatile("" : "+s"(_g), "+s"(_b)); F.G = (int)_g; F.wg = (int)_b; } \
        { unsigned _l = (unsigned)(size_t)F.lds; asm volatile("" : "+s"(_l)); F.lds = (LAS unsigned char*)(size_t)_l; } } while (0)
#define GRID_BAR() do { { unsigned long long _b = (unsigned long long)bar.bar; unsigned _x = bar.x; asm volatile("" : "+s"(_b), "+s"(_x)); bar.bar = (unsigned*)_b; bar.x = _x; } xcd_barrier(bar); RELAUNDER(); } while (0)

    phase_p0(F); write_bias(F);
    GRID_BAR();
#pragma unroll 1
    for (int layer = 0; layer < 2; ++layer) {
        const bool last = layer == 1;
        const int rows_all = TOK, rows_out = last ? TOKL : TOK;
        const float* modbase = WSP(const float, WS_MOD) + (size_t)layer * 17 * 6144;
        phase_norm(F, layer, rows_all, !last, 0);
        GRID_BAR();
        { EpiWin E{WSP(const float, WS_BIAS) + layer * NWP, WSP(bf16, WS_HYTL), WSP(bf16, WS_HYTC), WSP(bf16, WS_RET), WSP(bf16, WS_ML), WSP(float, WS_MLG)};
          if (FAST_PLAIN) gemm_fast(F, WSP(const bf16, WS_H), D, WSP(const bf16, WS_WIN), D, D, rows_all, NW1, E);
          else gemm_simple(F, WSP(const bf16, WS_H), D, WSP(const bf16, WS_WIN), D, D, rows_all, NW1, E, RowsId()); }
        GRID_BAR();
        phase_mix(F, layer);
        GRID_BAR();
        phase_combine(F, layer);
        GRID_BAR();
        { EpiGate E{WSP(const float, WS_BIAS) + layer * NWP + NW1, WSP(bf16, WS_GATES)};
          if (FAST_PLAIN) gemm_fast(F, WSP(const bf16, WS_H), D, WSP(const bf16, WS_WIN) + (size_t)NW1 * D, D, D, rows_out, NGATE, E);
          else gemm_simple(F, WSP(const bf16, WS_H), D, WSP(const bf16, WS_WIN) + (size_t)NW1 * D, D, D, rows_out, NGATE, E, RowsId()); }
        GRID_BAR();
        { EpiUp E{WSP(const bf16, WS_GATES), WSP(bf16, WS_H)};
          if (FAST_HORNER) gemm_fast(F, WSP(const bf16, WS_Y), D, WSP(const bf16, WS_WUP), D, D, rows_out, D, E);
          else gemm_simple(F, WSP(const bf16, WS_Y), D, WSP(const bf16, WS_WUP), D, D, rows_out, D, E, RowsId()); }
        GRID_BAR();
        { EpiResid E{last ? outp(F) : inp(F, I_X), last ? WSP(const float, WS_XC) : inp(F, I_CTX), outp(F), WSP(float, WS_XC), modbase, 2};
          if (FAST_PLAIN) gemm_fast(F, WSP(const bf16, WS_H), D, WSP(const bf16, WS_WOUT), D, D, rows_out, D, E);
          else gemm_simple(F, WSP(const bf16, WS_H), D, WSP(const bf16, WS_WOUT), D, D, rows_out, D, E, RowsId()); }
        GRID_BAR();
        if (!last) {
            phase_norm(F, layer, rows_out, false, 3);
            { const int gw = F.wg * NWAVES + F.wave, NGW = F.G * NWAVES; LAS float* scr = (LAS float*)(F.lds + F.wave * 8704);
              conv_weights_ffn(inp(F, I_FW1), inp(F, I_FW3), inp(F, I_FW2), WSP(bf16, WS_W13), WSP(bf16, WS_W2), gw, NGW, scr, F.lane);
              conv_weights_win(F, 1, gw, NGW, scr);
              conv_weights_upout(F, 1, gw, NGW, scr); }
            GRID_BAR();
            { EpiSwiglu E{WSP(bf16, WS_ACT), 0};
              if (FAST_PLAIN) gemm_fast(F, WSP(const bf16, WS_H), D, WSP(const bf16, WS_W13), D, D, rows_out, NFF1, E);
              else gemm_simple(F, WSP(const bf16, WS_H), D, WSP(const bf16, WS_W13), D, D, rows_out, NFF1, E, RowsId()); }
            GRID_BAR();
            { EpiResid E{outp(F), WSP(const float, WS_XC), outp(F), WSP(float, WS_XC), modbase, 5};
              if (FAST_PLAIN) gemm_fast(F, WSP(const bf16, WS_ACT), DFF, WSP(const bf16, WS_W2), DFF, DFF, rows_out, D, E);
              else gemm_simple(F, WSP(const bf16, WS_ACT), DFF, WSP(const bf16, WS_W2), DFF, DFF, rows_out, D, E, RowsId()); }
            GRID_BAR();
        }
    }
    phase_norm_router(F);
    { const int gw = F.wg * NWAVES + F.wave, NGW = F.G * NWAVES; LAS float* scr = (LAS float*)(F.lds + F.wave * 8704);
#pragma unroll 1
      for (int e = 0; e < NE; ++e)
          conv_weights_ffn(inp(F, I_MW1) + (size_t)e * D * DFF, inp(F, I_MW3) + (size_t)e * D * DFF, inp(F, I_MW2) + (size_t)e * DFF * D,
                           WSP(bf16, WS_MW13) + (size_t)e * NFF1 * D, WSP(bf16, WS_MW2) + (size_t)e * D * DFF, gw, NGW, scr, F.lane); }
    GRID_BAR();
    phase_route_tables(F);
    GRID_BAR();
    const int ntiles = __builtin_amdgcn_readfirstlane(WSP(const int, WS_TILEE)[MAXTILES]);
#pragma unroll 1
    for (int p = 0; p < NPASS; ++p) {
        const int t0 = p * PASS_TILES, t1 = min(ntiles, t0 + PASS_TILES);
        if (t0 < t1) { if (FAST_MOE) moe_pass_gemm1_fast(F, t0, t1); else moe_pass_gemm1(F, t0, t1); }
        GRID_BAR();
        if (t0 < t1) { if (FAST_MOE) moe_pass_gemm2_fast(F, t0, t1); else moe_pass_gemm2(F, t0, t1); }
        GRID_BAR();
    }
    phase_final(F);
}

extern "C" void kernel_launch(void* const* d_in, const int* in_sizes, int n_in, void* d_out, int out_size, void* d_ws, size_t ws_size, hipStream_t stream) {
    static int grid = 0;
    if (grid == 0) {
        if (n_in != 32 || out_size != TOKL * D || ws_size < WS_END) { fprintf(stderr, "kernel_launch: unexpected arguments (n_in %d, out %d, ws %zu)\n", n_in, out_size, ws_size); grid = -1; return; }
        int dev = 0, cus = 0;
        if (hipGetDevice(&dev) != hipSuccess || hipDeviceGetAttribute(&cus, hipDeviceAttributeMultiprocessorCount, dev) != hipSuccess) { grid = -1; return; }
        if (hipFuncSetAttribute((const void*)hybrid_fwd, hipFuncAttributeMaxDynamicSharedMemorySize, LDS_BYTES) != hipSuccess) { grid = -1; return; }
        int per_cu = 0;
        (void)hipOccupancyMaxActiveBlocksPerMultiprocessor(&per_cu, (const void*)hybrid_fwd, NTHR, LDS_BYTES);
        (void)hipGetLastError();
        grid = cus;
    }
    if (grid < 0) return;
    (void)hipMemsetAsync((char*)d_ws + WS_CTL, 0, CTL_ZERO_BYTES, stream);
    Params p{};
    for (int i = 0; i < 32; ++i) p.in[i] = (const float*)d_in[i];
    p.out = (float*)d_out; p.ws = (unsigned char*)d_ws;
    hipLaunchKernelGGL(hybrid_fwd, dim3(grid), dim3(NTHR), LDS_BYTES, stream, p);
}
```

```cpp
#include <hip/hip_runtime.h>
#include <stdint.h>
#include <stdio.h>

#define LAS __attribute__((address_space(3)))
typedef unsigned short bf16;
typedef short bf16x8 __attribute__((ext_vector_type(8)));
typedef float f32x4 __attribute__((ext_vector_type(4)));
typedef unsigned u32x4 __attribute__((ext_vector_type(4)));
typedef unsigned u32x2 __attribute__((ext_vector_type(2)));

constexpr int D = 1024, NB = 16, LL = 2048, LC = 256;
constexpr int TOKL = NB * LL, TOKC = NB * LC, TOK = TOKL + TOKC;
constexpr int HYW = 384, RETW = 384, MLW = 256;
constexpr int NIN = 6800, NW1 = 3840, NGATE = 3072, NWP = 6912;
constexpr int DFF = 2816, NFF1 = 5632, NE = 8;
constexpr int NWAVES = 8, NTHR = 512;
constexpr int MAXTILES = 272, PASS_TILES = 64, NPASS = 5;

constexpr size_t MiB = 1u << 20;
constexpr size_t WS_CTL = 0, CTL_ZERO_BYTES = 1 * MiB;
constexpr size_t WS_MOD = 1 * MiB;
constexpr size_t WS_BIAS = 2 * MiB;
constexpr size_t WS_ROPE = 2 * MiB + 256 * 1024;
constexpr size_t WS_TOPE = 3 * MiB;
constexpr size_t WS_TOPW = 3 * MiB + 256 * 1024;
constexpr size_t WS_TOPP = 3 * MiB + 512 * 1024;
constexpr size_t WS_SLOT = 3 * MiB + 768 * 1024;
constexpr size_t WS_ROWIDX = 4 * MiB;
constexpr size_t WS_TILEE = 4 * MiB + 512 * 1024;
constexpr size_t WS_FTL = 5 * MiB;
constexpr size_t WS_FTC = 17 * MiB;
constexpr size_t WS_WIN = 18 * MiB;
constexpr size_t WS_WUP = 32 * MiB;
constexpr size_t WS_WOUT = 34 * MiB;
constexpr size_t WS_XC = 36 * MiB;
constexpr size_t WS_H = 52 * MiB;
constexpr size_t WS_Y = 124 * MiB;
constexpr size_t WS_U = 196 * MiB;
constexpr size_t WS_RET = WS_U;
constexpr size_t WS_ML = WS_U + 108 * MiB;
constexpr size_t WS_MLG = WS_U + 180 * MiB;
constexpr size_t WS_OB = WS_U + 183 * MiB;
constexpr size_t WS_YHTL = WS_U + 228 * MiB;
constexpr size_t WS_YHTC = WS_U + 252 * MiB;
constexpr size_t WS_HYTL = WS_U + 255 * MiB;
constexpr size_t WS_HYTC = WS_U + 327 * MiB;
constexpr size_t WS_END = WS_U + 336 * MiB;
constexpr size_t WS_GATES = WS_U;
constexpr size_t WS_ACT = WS_U;
constexpr size_t WS_W13 = WS_U + 204 * MiB;
constexpr size_t WS_W2 = WS_U + 216 * MiB;
constexpr size_t WS_MW13 = WS_Y;
constexpr size_t WS_MW2 = WS_Y + 88 * MiB;
constexpr size_t WS_MACT = WS_Y + 132 * MiB;
constexpr size_t WS_EOUT = WS_Y + 220 * MiB;
static_assert(WS_EOUT + (size_t)MAXTILES * 256 * 1024 * 2 <= WS_END, "map");
static_assert(WS_GATES + (size_t)TOK * NGATE * 2 <= WS_YHTL, "gates overlay");

constexpr int CW_BAR = 4096;
constexpr int CW_CNT = 16384;

constexpr int LDS_BYTES = 147456;
constexpr int MISC_OFF = 147456 - 256;

__device__ __forceinline__ float bf2f(bf16 b) { return __uint_as_float(((unsigned)b) << 16); }
__device__ __forceinline__ unsigned f2bf(float f) { unsigned u = __float_as_uint(f); return (u + 0x7fffu + ((u >> 16) & 1u)) >> 16; }
__device__ __forceinline__ unsigned pk2(float lo, float hi) { return f2bf(lo) | (f2bf(hi) << 16); }
__device__ __forceinline__ float wave_sum(float v) {
#pragma unroll
    for (int o = 1; o < 64; o <<= 1) v += __shfl_xor(v, o);
    return v;
}
__device__ __forceinline__ float sigmoidf_(float x) { return 1.0f / (1.0f + __expf(-x)); }
__device__ __forceinline__ float siluf_(float x) { return x / (1.0f + __expf(-x)); }

#define XB_TMO      128
#define XB_XCNT(j)  (256  + 64 * (j))
#define XB_XSUB(j)  (1280 + 64 * (j))
#define XB_XGEN(j)  (2304 + 64 * (j))
#define XB_TOP      3328
#define XB_TOPGEN   3392
#define XCD_BAR_WORDS 3456
#define XB_SPIN_CAP (1u << 22)
__device__ __forceinline__ unsigned xb_ld(unsigned* p)              { return __hip_atomic_load(p, __ATOMIC_RELAXED, __HIP_MEMORY_SCOPE_AGENT); }
__device__ __forceinline__ unsigned xb_add(unsigned* p, unsigned v) { return __hip_atomic_fetch_add(p, v, __ATOMIC_RELAXED, __HIP_MEMORY_SCOPE_AGENT); }
__device__ __forceinline__ unsigned xb_xcc_id() { return (unsigned)__builtin_amdgcn_s_getreg((3 << 11) | 20) & 0xFu; }
#define XB_SPIN(cond, bar) do { unsigned _sp = 0; while (cond) { __builtin_amdgcn_s_sleep(1); \
    if ((++_sp & 255u) == 0u) { if (xb_ld(&(bar)[XB_TMO])) break; if (_sp > XB_SPIN_CAP) { atomicAdd(&(bar)[XB_TMO], 1u); break; } } } } while (0)
struct XcdBarrier { unsigned* bar; unsigned x; volatile LAS unsigned* st; };
__device__ __forceinline__ XcdBarrier xcd_barrier_post(unsigned* bar, volatile LAS unsigned* st) {
    XcdBarrier b; b.bar = bar; b.x = xb_xcc_id(); b.st = st;
    if (threadIdx.x == 0) (void)xb_add(&bar[XB_XCNT(b.x)], 1u);
    return b;
}
__device__ __forceinline__ void xcd_barrier_complete(unsigned* bar, unsigned x, unsigned& nloc, unsigned& nx) {
    const unsigned G = gridDim.x * gridDim.y * gridDim.z;
    unsigned sum, cnt, mine, sp = 0u;
    for (;;) {
        sum = 0u; cnt = 0u; mine = 0u;
#pragma unroll 1
        for (unsigned j = 0; j < 16; ++j) { const unsigned c = xb_ld(&bar[XB_XCNT(j)]); sum += c; cnt += (c > 0u) ? 1u : 0u; }
        mine = xb_ld(&bar[XB_XCNT(x)]);
        if (sum == G) break;
        __builtin_amdgcn_s_sleep(1);
        if ((++sp & 255u) == 0u) { if (xb_ld(&bar[XB_TMO])) break; if (sp > XB_SPIN_CAP) { atomicAdd(&bar[XB_TMO], 1u); break; } }
    }
    nloc = mine > 0u ? mine : 1u; nx = cnt > 0u ? cnt : 1u;
}
__device__ __forceinline__ void xcd_barrier(const XcdBarrier& b) {
    asm volatile("s_waitcnt vmcnt(0)" ::: "memory");
    __syncthreads();
    if (threadIdx.x == 0) {
        unsigned* bar = b.bar;
        __builtin_amdgcn_s_waitcnt(0);
        unsigned nloc = b.st[0], nx = b.st[1];
        if (nloc == 0u) { xcd_barrier_complete(bar, b.x, nloc, nx); b.st[0] = nloc; b.st[1] = nx; }
        const unsigned old = xb_add(&bar[XB_XSUB(b.x)], 1u);
        const unsigned gen = old / nloc;
        if (old + 1u == (gen + 1u) * nloc) {
            __builtin_amdgcn_fence(__ATOMIC_RELEASE, "agent");
            asm volatile("s_waitcnt vmcnt(0)" ::: "memory");
            const unsigned og = xb_add(&bar[XB_TOP], 1u);
            const unsigned tg = og / nx;
            if (og + 1u == (tg + 1u) * nx) xb_add(&bar[XB_TOPGEN], 1u);
            else XB_SPIN(xb_ld(&bar[XB_TOPGEN]) == tg, bar);
            __builtin_amdgcn_fence(__ATOMIC_ACQUIRE, "agent");
            xb_add(&bar[XB_XGEN(b.x)], 1u);
            asm volatile("s_waitcnt vmcnt(0)" ::: "memory");
        } else {
            XB_SPIN(xb_ld(&bar[XB_XGEN(b.x)]) == gen, bar);
            __builtin_amdgcn_fence(__ATOMIC_ACQUIRE, "agent");
            asm volatile("s_waitcnt vmcnt(0)" ::: "memory");
        }
    }
    __syncthreads();
}

struct Params { const float* in[32]; float* out; unsigned char* ws; };
enum { I_X = 0, I_C, I_CTX, I_CCTX, I_WMOD, I_BMOD, I_GMIX, I_GFFN, I_WIN, I_BIN, I_HYCONV, I_HYF1, I_HYFB1, I_HYF2, I_HYFB2, I_HYF3, I_HYDECAY,
       I_HYSKIP, I_RETDECAY, I_MLCONV, I_MLGB, I_WUP, I_WOUT, I_FW1, I_FW3, I_FW2, I_ROUTER, I_ROUTERB, I_MW1, I_MW3, I_MW2, I_GFINAL };

struct Frame {
    LAS unsigned char* lds;
    unsigned char* ws;
    int tid, lane, wave, G, wg;
};
#define WSP(T, off) ((T*)(F.ws + (off)))
constexpr int PTAB_OFF = 147456 - 1024;
__device__ __forceinline__ const float* inp(const Frame& F, int i) {
    const LAS unsigned* t = (const LAS unsigned*)(F.lds + PTAB_OFF) + 2 * i;
    const unsigned lo = __builtin_amdgcn_readfirstlane(t[0]), hi = __builtin_amdgcn_readfirstlane(t[1]);
    return (const float*)(((unsigned long long)hi << 32) | lo);
}
__device__ __forceinline__ float* outp(const Frame& F) { return (float*)inp(F, 32); }

__device__ __forceinline__ int row_batch(int row) { return row < TOKL ? (row >> 11) : ((row - TOKL) >> 8); }
__device__ __forceinline__ const float* mod_ptr(const Frame& F, int layer, int row, int which) {
    const int r = row < TOKL ? (row >> 11) : 16;
    return WSP(const float, WS_MOD) + ((size_t)(layer * 17 + r) * 6 + which) * 1024;
}

template <class RowMap>
__device__ __forceinline__ void tr_item(const float* W, int K, int N, bf16* WT, int ldT, RowMap rm, LAS float* scr, int item, int lane) {
    const int nblk = (N + 31) / 32, kb = item / nblk, nb = item % nblk, k0 = 64 * kb, n0 = 32 * nb;
#pragma unroll 8
    for (int i = 0; i < 32; ++i) { const int kk = 2 * i + (lane >> 5); const int n = n0 + (lane & 31); scr[kk * 33 + (lane & 31)] = (n < N) ? W[(size_t)(k0 + kk) * N + n] : 0.f; }
    asm volatile("s_waitcnt lgkmcnt(0)" ::: "memory");
    const int c = lane & 7;
#pragma unroll
    for (int j = 0; j < 4; ++j) { const int nl = (lane >> 3) + 8 * j; const int n = n0 + nl; const LAS float* s = scr + (8 * c) * 33 + nl;
        u32x4 o; o.x = pk2(s[0 * 33], s[1 * 33]); o.y = pk2(s[2 * 33], s[3 * 33]); o.z = pk2(s[4 * 33], s[5 * 33]); o.w = pk2(s[6 * 33], s[7 * 33]);
        if (n < N) *(u32x4*)(WT + (size_t)rm(n) * ldT + k0 + 8 * c) = o; }
    asm volatile("s_waitcnt lgkmcnt(0)" ::: "memory");
}
struct RmId { __device__ __forceinline__ int operator()(int n) const { return n; } };
__device__ __forceinline__ int win_row(int n) {
    if (n < 1152) return n;
    if (n < 2688) return 1280 + (n - 1152);
    if (n < 3712) return 2816 + (n - 2688);
    if (n < 3728) return 1152 + (n - 3712);
    return 3840 + (n - 3728);
}
struct RmWin { __device__ __forceinline__ int operator()(int n) const { return win_row(n); } };
struct RmW1 { __device__ __forceinline__ int operator()(int n) const { return (n >> 4) * 32 + (n & 15); } };
struct RmW3 { __device__ __forceinline__ int operator()(int n) const { return (n >> 4) * 32 + 16 + (n & 15); } };

__device__ __forceinline__ void conv_weights_win(Frame& F, int layer, int gw, int NGW, LAS float* scr) {
    const float* W = inp(F, I_WIN) + (size_t)layer * D * NIN;
    const int items = (D / 64) * ((NIN + 31) / 32);
    for (int it = gw; it < items; it += NGW) tr_item(W, D, NIN, WSP(bf16, WS_WIN), D, RmWin(), scr, it, F.lane);
    bf16* wt = WSP(bf16, WS_WIN);
    for (int i = gw * 64 + F.lane; i < 112 * 1024 / 8; i += NGW * 64) *(u32x4*)(wt + (size_t)1168 * 1024 + (size_t)i * 8) = (u32x4){0u, 0u, 0u, 0u};
}
__device__ __forceinline__ void conv_weights_upout(Frame& F, int layer, int gw, int NGW, LAS float* scr) {
    const int items = (D / 64) * (D / 32);
    for (int it = gw; it < items; it += NGW) tr_item(inp(F, I_WUP) + (size_t)layer * D * D, D, D, WSP(bf16, WS_WUP), D, RmId(), scr, it, F.lane);
    for (int it = gw; it < items; it += NGW) tr_item(inp(F, I_WOUT) + (size_t)layer * D * D, D, D, WSP(bf16, WS_WOUT), D, RmId(), scr, it, F.lane);
}
__device__ __forceinline__ void conv_weights_ffn(const float* w1, const float* w3, const float* w2, bf16* w13t, bf16* w2t, int gw, int NGW, LAS float* scr, int lane) {
    const int i1 = (D / 64) * (DFF / 32), i2 = (DFF / 64) * (D / 32);
    for (int it = gw; it < i1; it += NGW) tr_item(w1, D, DFF, w13t, D, RmW1(), scr, it, lane);
    for (int it = gw; it < i1; it += NGW) tr_item(w3, D, DFF, w13t, D, RmW3(), scr, it, lane);
    for (int it = gw; it < i2; it += NGW) tr_item(w2, DFF, D, w2t, DFF, RmId(), scr, it, lane);
}

__device__ __forceinline__ void filter_item(Frame& F, int layer, int L, bf16* FT  , int pb, int ch, LAS float* tile  ) {
    const float* f1 = inp(F, I_HYF1) + layer * 33 * 64; const float* fb1 = inp(F, I_HYFB1) + layer * 64;
    const float* f2 = inp(F, I_HYF2) + layer * 64 * 64; const float* fb2 = inp(F, I_HYFB2) + layer * 64;
    const float* f3 = inp(F, I_HYF3) + (size_t)layer * 64 * 1536; const float* dec = inp(F, I_HYDECAY) + layer * 1536;
    const int lane = F.lane, n = ch * 64 + lane;
    const float b1 = fb1[lane], b2 = fb2[lane], adec = fabsf(dec[n]);
    for (int pl = 0; pl < 64; ++pl) {
        const int pos = pb * 64 + pl;
        const float t = (float)pos / (float)(L - 1);
        const float w = 6.283185307179586f * (float)pos / (float)L;
        float feat = 0.f;
        if (lane == 0) feat = t;
        else if (lane < 17) { const float band = 1e-4f + (float)(lane - 1) * ((15.0f - 1e-4f) / 15.0f); feat = cosf(w * band); }
        else if (lane < 33) { const float band = 1e-4f + (float)(lane - 17) * ((15.0f - 1e-4f) / 15.0f); feat = -sinf(w * band); }
        float a1 = b1;
        for (int i = 0; i < 33; ++i) a1 += __shfl(feat, i) * f1[i * 64 + lane];
        const float h1 = sinf(a1);
        float a2 = b2;
        for (int i = 0; i < 64; ++i) a2 += __shfl(h1, i) * f2[i * 64 + lane];
        const float h2 = sinf(a2);
        float a3 = 0.f;
        for (int i = 0; i < 64; ++i) a3 += __shfl(h2, i) * f3[i * 1536 + n];
        tile[pl * 65 + lane] = a3 * expf(-t * adec);
    }
    asm volatile("s_waitcnt lgkmcnt(0)" ::: "memory");
    const int pos = pb * 64 + lane;
    for (int cl = 0; cl < 64; ++cl) {
        const int nn = ch * 64 + cl, o = nn / 768, dir = (nn / 384) & 1, c = nn % 384;
        bf16* dst = FT + (size_t)(o * 384 + c) * (2 * L);
        const float v = tile[lane * 65 + cl];
        if (dir == 0) dst[L - pos] = (bf16)f2bf(v);
        else if (pos > 0) dst[L + pos] = (bf16)f2bf(v);
    }
    asm volatile("s_waitcnt lgkmcnt(0)" ::: "memory");
}

__device__ __forceinline__ void phase_p0(Frame& F) {
    const int gw = F.wg * NWAVES + F.wave, NGW = F.G * NWAVES;
    LAS float* sl = (LAS float*)F.lds;
    LAS float* red = (LAS float*)(F.lds + 17 * 4096);
    for (int i = F.tid; i < 17 * 1024; i += NTHR) { const int r = i >> 10, k = i & 1023; const float v = r < 16 ? inp(F, I_C)[r * 1024 + k] : inp(F, I_CCTX)[k]; sl[i] = siluf_(v); }
    __syncthreads();
    for (int item = F.wg; item < 2 * 384; item += F.G) {
        const int layer = item / 384, n0 = (item % 384) * 16, j = F.tid & 15, kp = F.tid >> 4;
        const float* W = inp(F, I_WMOD) + (size_t)layer * D * 6144;
        float acc[17];
#pragma unroll
        for (int r = 0; r < 17; ++r) acc[r] = 0.f;
        for (int k = kp * 32; k < kp * 32 + 32; ++k) { const float w = W[(size_t)k * 6144 + n0 + j];
#pragma unroll
            for (int r = 0; r < 17; ++r) acc[r] += sl[r * 1024 + k] * w; }
#pragma unroll
        for (int r = 0; r < 17; ++r) red[(kp * 17 + r) * 16 + j] = acc[r];
        __syncthreads();
        if (F.tid < 272) { const int r = F.tid >> 4, jj = F.tid & 15; float s = inp(F, I_BMOD)[layer * 6144 + n0 + jj];
            for (int q = 0; q < 32; ++q) s += red[(q * 17 + r) * 16 + jj];
            WSP(float, WS_MOD)[(size_t)(layer * 17 + r) * 6144 + n0 + jj] = s; }
        __syncthreads();
    }
    __syncthreads();
    LAS float* scr = (LAS float*)(F.lds + F.wave * 8704);
    conv_weights_win(F, 0, gw, NGW, scr);
    conv_weights_upout(F, 0, gw, NGW, scr);
    for (int i = gw * 64 + F.lane; i < 2048 * 32; i += NGW * 64) {
        const int t = i >> 5, j = i & 31, half = j >> 4, ii = j & 15;
        const float inv = 1.0f / powf(10000.0f, (float)ii / 16.0f);
        const float ang = (float)(half == 0 ? (t >> 6) : (t & 63)) * inv;
        WSP(float, WS_ROPE)[t * 64 + half * 32 + ii] = cosf(ang);
        WSP(float, WS_ROPE)[t * 64 + half * 32 + 16 + ii] = sinf(ang);
    }
    __syncthreads();
    LAS float* ftile = (LAS float*)(F.lds + F.wave * 16640);
    for (int it = gw; it < 1536 + 96; it += NGW) {
        if (it < 1536) { const int layer = it / 768, r = it % 768; filter_item(F, layer, LL, WSP(bf16, WS_FTL) + (size_t)layer * 2 * 384 * 4096, r / 24, r % 24, ftile); }
        else { const int r = it - 1536; filter_item(F, 0, LC, WSP(bf16, WS_FTC), r / 24, r % 24, ftile); }
    }
}
__device__ __forceinline__ void write_bias(Frame& F) {
    const int gt = (F.wg * NWAVES + F.wave) * 64 + F.lane, NGT = F.G * NTHR;
    for (int i = gt; i < 2 * NWP; i += NGT) {
        const int l = i / NWP, r = i % NWP; float v = 0.f;
        int n = -1;
        if (r < 1152) n = r; else if (r < 1168) n = 3712 + (r - 1152); else if (r < 1280) n = -1; else if (r < 2816) n = 1152 + (r - 1280); else if (r < 3840) n = 2688 + (r - 2816); else n = 3728 + (r - 3840);
        if (n >= 0) v = inp(F, I_BIN)[l * NIN + n];
        WSP(float, WS_BIAS)[i] = v;
    }
}

__device__ __forceinline__ void norm_mod_row(const float* xrow, const float* g, const float* shift, const float* scale, bf16* orow, int lane, float* keep  ) {
    f32x4 v[4]; float s = 0.f;
#pragma unroll
    for (int j = 0; j < 4; ++j) { v[j] = *(const f32x4*)(xrow + 256 * j + 4 * lane); s += (v[j].x * v[j].x + v[j].y * v[j].y) + (v[j].z * v[j].z + v[j].w * v[j].w); }
    const float r = rsqrtf(wave_sum(s) * (1.0f / 1024.0f) + 1e-6f);
#pragma unroll
    for (int j = 0; j < 4; ++j) {
        const f32x4 gg = *(const f32x4*)(g + 256 * j + 4 * lane), sh = *(const f32x4*)(shift + 256 * j + 4 * lane), sc = *(const f32x4*)(scale + 256 * j + 4 * lane);
        f32x4 o;
        o.x = (v[j].x * r * gg.x) * (1.f + sc.x) + sh.x; o.y = (v[j].y * r * gg.y) * (1.f + sc.y) + sh.y;
        o.z = (v[j].z * r * gg.z) * (1.f + sc.z) + sh.z; o.w = (v[j].w * r * gg.w) * (1.f + sc.w) + sh.w;
        if (keep) { keep[4 * j + 0] = o.x; keep[4 * j + 1] = o.y; keep[4 * j + 2] = o.z; keep[4 * j + 3] = o.w; }
        u32x2 w; w.x = pk2(o.x, o.y); w.y = pk2(o.z, o.w);
        *(u32x2*)(orow + 256 * j + 4 * lane) = w;
    }
}
__device__ __forceinline__ const float* xrow_ptr(const Frame& F, int row, bool from_input) {
    if (row < TOKL) return (from_input ? inp(F, I_X) : outp(F)) + (size_t)row * D;
    return (from_input ? inp(F, I_CTX) : WSP(const float, WS_XC)) + (size_t)(row - TOKL) * D;
}
__device__ __forceinline__ void phase_norm(Frame& F, int layer, int nrows, bool from_input, int which) {
    const int gw = F.wg * NWAVES + F.wave, NGW = F.G * NWAVES;
    const float* g = inp(F, which == 0 ? I_GMIX : I_GFFN) + layer * D;
    for (int row = gw; row < nrows; row += NGW)
        norm_mod_row(xrow_ptr(F, row, from_input), g, mod_ptr(F, layer, row, which), mod_ptr(F, layer, row, which + 1), WSP(bf16, WS_H) + (size_t)row * D, F.lane, nullptr);
}

namespace pg8 {
constexpr int BM = 256, BK = 64, HALF = 128, HTB = HALF * BK * 2, STAGE_BYTES = 8 * HTB, NXCD = 8, WGM = 8;
__device__ __forceinline__ int lds_byte(int r, int c) { const int st = (r >> 4) * 2 + (c >> 5), rr = r & 15, cc = c & 31, ob = rr * 64 + cc * 2; return st * 1024 + (ob ^ (((ob >> 9) & 1) << 5)); }
__device__ __forceinline__ void stage_rc(int b, int& R, int& C) { const int st = b / 1024, sb = b % 1024, swz = sb ^ (((sb >> 9) & 1) << 5); R = (st >> 1) * 16 + swz / 64; C = (st & 1) * 32 + (swz % 64) / 2; }
struct Unit { int pm, pn; };
struct OrderPlain {
    static constexpr bool GATHER = false;
    int nM, nN, nwg, G, c;
    __device__ __forceinline__ void init(int nM_, int nN_, int G_, int c_) { nM = nM_; nN = nN_; nwg = nM * nN; G = G_; c = c_; }
    __device__ __forceinline__ bool next(int i, Unit& u) const {
        const long L = (long)i * G + c; if (L >= nwg) return false;
        int wgid = (int)L; { const int q = nwg / NXCD, r = nwg % NXCD, xcd = wgid % NXCD, off = wgid / NXCD; wgid = (xcd < r ? xcd * (q + 1) : r * (q + 1) + (xcd - r) * q) + off; }
        const int nig = WGM * nN, gid = wgid / nig, fm = gid * WGM, gsz = (nM - fm) < WGM ? (nM - fm) : WGM;
        u.pm = fm + ((wgid % nig) % gsz); u.pn = (wgid % nig) / gsz; return true;
    }
    __device__ __forceinline__ int arow(int r) const { return r; }
    __device__ __forceinline__ size_t boff(const Unit&) const { return 0; }
};
struct OrderMoe {
    static constexpr bool GATHER = true;
    OrderPlain o; const int* rowidx; const int* tilee; int t0; size_t bstride; bool gather;
    __device__ __forceinline__ bool next(int i, Unit& u) const { return o.next(i, u); }
    __device__ __forceinline__ int arow(int r) const { return gather ? rowidx[t0 * 256 + r] : r; }
    __device__ __forceinline__ size_t boff(const Unit& u) const { return (size_t)tilee[t0 + u.pm] * bstride; }
};

template <class Epi, class Sched>
__device__ __forceinline__ void gemm_phase(LAS unsigned char* lds, const bf16* A, int lda, const bf16* Bt, int ldb, int K, const Sched& S, const Epi& E) {
    unsigned tid_u = threadIdx.x; asm volatile("" : "+v"(tid_u));
    const int tid = (int)tid_u, wid = __builtin_amdgcn_readfirstlane(tid >> 6), lane = tid & 63, wr = wid >> 2, wc = wid & 3, fr = lane & 15, fq = lane >> 4;
    const int nt = K / BK;
    unsigned voffB[2];
    { int sR[2], sC[2];
#pragma unroll
      for (int i = 0; i < 2; ++i) { stage_rc(tid * 16 + i * 8192, sR[i], sC[i]); voffB[i] = (unsigned)(sR[i] * ldb + sC[i]) * 2u; } }
#define PG8_GATHER_OFFS(pm_) do { unsigned _t = (unsigned)tid; asm volatile("" : "+v"(_t)); _Pragma("unroll") for (int i = 0; i < 2; ++i) { int _R, _C; stage_rc((int)_t * 16 + i * 8192, _R, _C); \
        vc0[i] = (unsigned)((size_t)S.arow((pm_) * BM + _R) * lda + _C) * 2u; vc1[i] = (unsigned)((size_t)S.arow((pm_) * BM + HALF + _R) * lda + _C) * 2u; } } while (0)
    const size_t kstep = (size_t)(BK * 2);
    const size_t hstepB = (size_t)HALF * ldb * 2, tstepB = 2 * hstepB;
    const unsigned ldsw = (unsigned)wid * 1024u;
    const int aoff = lds_byte(wr * 64 + fr, fq * 8), boff = lds_byte(wc * 32 + fr, fq * 8);
#define PG8_SA(b, h) (((b) * 2 + (h)) * HTB)
#define PG8_SB(b, h) ((4 + (b) * 2 + (h)) * HTB)
#define PG8_STAGE2(bufoff, gbase, v0, v1) do { \
        __builtin_amdgcn_global_load_lds((const unsigned*)((const char*)(gbase) + (v0)), (LAS unsigned*)(lds + (bufoff) + ldsw), 16, 0, 0); \
        __builtin_amdgcn_global_load_lds((const unsigned*)((const char*)(gbase) + (v1)), (LAS unsigned*)(lds + (bufoff) + ldsw + 8192), 16, 0, 0); } while (0)
#define PG8_STAGEB(bufoff, gbase) PG8_STAGE2(bufoff, gbase, voffB[0], voffB[1])
#define PG8_LDA(dst, b, h) do { _Pragma("unroll") for (int m = 0; m < 4; ++m) _Pragma("unroll") for (int k = 0; k < 2; ++k) dst[m][k] = *(const LAS bf16x8*)(lds + PG8_SA(b, h) + aoff + m * 2048 + k * 1024); } while (0)
#define PG8_LDB(dst, b, h) do { _Pragma("unroll") for (int n = 0; n < 2; ++n) _Pragma("unroll") for (int k = 0; k < 2; ++k) dst[n][k] = *(const LAS bf16x8*)(lds + PG8_SB(b, h) + boff + n * 2048 + k * 1024); } while (0)
#define PG8_MMA(ai, bj, At, Bt_) do { __builtin_amdgcn_s_setprio(1); _Pragma("unroll") for (int m = 0; m < 4; ++m) _Pragma("unroll") for (int n = 0; n < 2; ++n) _Pragma("unroll") for (int k = 0; k < 2; ++k) \
        acc[ai][bj][m][n] = __builtin_amdgcn_mfma_f32_16x16x32_bf16(Bt_[n][k], At[m][k], acc[ai][bj][m][n], 0, 0, 0); __builtin_amdgcn_s_setprio(0); } while (0)
#define PG8_WAIT_V(n) asm volatile("s_waitcnt vmcnt(" #n ")" ::: "memory")
#define PG8_WAIT_L(n) asm volatile("s_waitcnt lgkmcnt(" #n ")" ::: "memory")
#define PG8_BAR __builtin_amdgcn_s_barrier()
#define PG8_SCHED __builtin_amdgcn_sched_barrier(0)
    Unit cur, nxt; int ui = 0;
    if (!S.next(0, cur)) return;
    f32x4 acc[2][2][4][2];
#pragma unroll
    for (int a = 0; a < 2; ++a)
#pragma unroll
        for (int b = 0; b < 2; ++b)
#pragma unroll
            for (int m = 0; m < 4; ++m)
#pragma unroll
                for (int n = 0; n < 2; ++n) acc[a][b][m][n] = (f32x4){0.f, 0.f, 0.f, 0.f};
    bf16x8 At[4][2], B0[2][2], B1[2][2];
    constexpr bool GA = Sched::GATHER;
    const size_t hstepA = GA ? 0 : (size_t)HALF * lda * 2, tstepA = (size_t)BM * lda * 2;
    unsigned vc0[2], vc1[2];
    if constexpr (GA) { PG8_GATHER_OFFS(cur.pm); }
    else { int sR, sC;
#pragma unroll
        for (int i = 0; i < 2; ++i) { stage_rc(tid * 16 + i * 8192, sR, sC); vc0[i] = (unsigned)(sR * lda + sC) * 2u; vc1[i] = 0u; } }
#define VC0(i) vc0[i]
#define VC1(i) (GA ? vc1[i] : vc0[i])
#define VN0(i) vc0[i]
#define VN1(i) VC1(i)
    const char* cA = GA ? (const char*)A : (const char*)A + (size_t)cur.pm * tstepA;
    const char* cB = (const char*)Bt + S.boff(cur) * 2 + (size_t)cur.pn * tstepB;
    PG8_STAGEB(PG8_SB(0, 0), cB); PG8_STAGE2(PG8_SA(0, 0), cA, VC0(0), VC0(1)); PG8_STAGEB(PG8_SB(0, 1), cB + hstepB); PG8_STAGE2(PG8_SA(0, 1), cA + hstepA, VC1(0), VC1(1));
    if (wr == 1) PG8_BAR;
    PG8_WAIT_V(4); PG8_BAR;
    PG8_STAGEB(PG8_SB(1, 0), cB + kstep); PG8_STAGE2(PG8_SA(1, 0), cA + kstep, VC0(0), VC0(1)); PG8_STAGEB(PG8_SB(1, 1), cB + hstepB + kstep);
    PG8_WAIT_V(6); PG8_BAR;
    for (;;) {
        const bool has_next = S.next(ui + 1, nxt);
        const char* nB = cB; const char* nA = cA;
        if (has_next) {
            nB = (const char*)Bt + S.boff(nxt) * 2 + (size_t)nxt.pn * tstepB;
            if constexpr (!GA) nA = (const char*)A + (size_t)nxt.pm * tstepA;
        }
        for (int t = 0; t < nt; t += 2) {
            const bool last = (t == nt - 2);
            if constexpr (Epi::HORNER) {
                if (t == 6 || t == 12) {
                    asm volatile("" ::: "memory");
                    const int seg = (t == 6) ? 0 : 1;
                    int hpm = cur.pm, hpn = cur.pn; asm volatile("" : "+s"(hpm), "+s"(hpn));
                    unsigned hln = (unsigned)lane; asm volatile("" : "+v"(hln)); const int hfr = (int)(hln & 15u), hfq = (int)(hln >> 4);
#pragma unroll
                    for (int ai = 0; ai < 2; ++ai) {
                        u32x2 ga[4][2][2], gb[4][2][2];
#pragma unroll
                        for (int m = 0; m < 4; ++m)
#pragma unroll
                            for (int bj = 0; bj < 2; ++bj)
#pragma unroll
                                for (int n = 0; n < 2; ++n) {
                                    const int row = hpm * BM + ai * HALF + wr * 64 + m * 16 + hfr, col = hpn * BM + bj * HALF + wc * 32 + n * 16 + 4 * hfq;
                                    ga[m][bj][n] = E.gate(seg, row, col); gb[m][bj][n] = E.gate(seg + 1, row, col);
                                }
                        asm volatile("" : "+v"(ga[0][0][0]), "+v"(ga[0][0][1]), "+v"(ga[0][1][0]), "+v"(ga[0][1][1]), "+v"(ga[1][0][0]), "+v"(ga[1][0][1]), "+v"(ga[1][1][0]), "+v"(ga[1][1][1]),
                                          "+v"(ga[2][0][0]), "+v"(ga[2][0][1]), "+v"(ga[2][1][0]), "+v"(ga[2][1][1]), "+v"(ga[3][0][0]), "+v"(ga[3][0][1]), "+v"(ga[3][1][0]), "+v"(ga[3][1][1]) :: "memory");
                        asm volatile("" : "+v"(gb[0][0][0]), "+v"(gb[0][0][1]), "+v"(gb[0][1][0]), "+v"(gb[0][1][1]), "+v"(gb[1][0][0]), "+v"(gb[1][0][1]), "+v"(gb[1][1][0]), "+v"(gb[1][1][1]),
                                          "+v"(gb[2][0][0]), "+v"(gb[2][0][1]), "+v"(gb[2][1][0]), "+v"(gb[2][1][1]), "+v"(gb[3][0][0]), "+v"(gb[3][0][1]), "+v"(gb[3][1][0]), "+v"(gb[3][1][1]) :: "memory");
#pragma unroll
                        for (int m = 0; m < 4; ++m)
#pragma unroll
                            for (int bj = 0; bj < 2; ++bj)
#pragma unroll
                                for (int n = 0; n < 2; ++n) {
                                    const u32x2 a = ga[m][bj][n], b = gb[m][bj][n];
                                    f32x4& v = acc[ai][bj][m][n];
                                    v.x *= __uint_as_float(a.x << 16) * __builtin_amdgcn_rcpf(__uint_as_float(b.x << 16));
                                    v.y *= __uint_as_float(a.x & 0xffff0000u) * __builtin_amdgcn_rcpf(__uint_as_float(b.x & 0xffff0000u));
                                    v.z *= __uint_as_float(a.y << 16) * __builtin_amdgcn_rcpf(__uint_as_float(b.y << 16));
                                    v.w *= __uint_as_float(a.y & 0xffff0000u) * __builtin_amdgcn_rcpf(__uint_as_float(b.y & 0xffff0000u));
                                }
                    }
                    asm volatile("s_waitcnt vmcnt(0)" ::: "memory");
                }
            }
            const char* a1 = cA + (size_t)(t + 1) * kstep;
            const char* a2 = last ? nA : cA + (size_t)(t + 2) * kstep; const char* b2 = last ? nB : cB + (size_t)(t + 2) * kstep;
            const char* a3 = a2 + kstep; const char* b3 = b2 + kstep;
            PG8_LDB(B0, 0, 0); PG8_SCHED; PG8_LDA(At, 0, 0); PG8_STAGE2(PG8_SA(1, 1), a1 + hstepA, VC1(0), VC1(1));
            if constexpr (GA) { if (last && has_next) { asm volatile("" ::: "memory"); PG8_GATHER_OFFS(nxt.pm); asm volatile("" ::: "memory"); } }
            PG8_WAIT_L(8); PG8_BAR; PG8_WAIT_L(0); PG8_MMA(0, 0, At, B0); PG8_BAR; PG8_SCHED;
            PG8_LDB(B1, 0, 1); PG8_STAGEB(PG8_SB(0, 0), b2);
            PG8_BAR; PG8_WAIT_L(0); PG8_MMA(0, 1, At, B1); PG8_BAR;
            PG8_LDA(At, 0, 1); PG8_STAGE2(PG8_SA(0, 0), a2, VN0(0), VN0(1));
            PG8_BAR; PG8_WAIT_L(0); PG8_MMA(1, 0, At, B0); PG8_BAR; PG8_SCHED;
            PG8_STAGEB(PG8_SB(0, 1), b2 + hstepB);
            PG8_WAIT_V(6); PG8_BAR; PG8_MMA(1, 1, At, B1); PG8_BAR;
            PG8_LDB(B0, 1, 0); PG8_SCHED; PG8_LDA(At, 1, 0); PG8_STAGE2(PG8_SA(0, 1), a2 + hstepA, VN1(0), VN1(1));
            PG8_WAIT_L(8); PG8_BAR; PG8_WAIT_L(0); PG8_MMA(0, 0, At, B0); PG8_BAR; PG8_SCHED;
            PG8_LDB(B1, 1, 1); PG8_STAGEB(PG8_SB(1, 0), b3);
            PG8_BAR; PG8_WAIT_L(0); PG8_MMA(0, 1, At, B1); PG8_BAR;
            PG8_LDA(At, 1, 1); PG8_STAGE2(PG8_SA(1, 0), a3, VN0(0), VN0(1));
            PG8_BAR; PG8_WAIT_L(0); PG8_MMA(1, 0, At, B0); PG8_BAR; PG8_SCHED;
            PG8_STAGEB(PG8_SB(1, 1), b3 + hstepB);
            PG8_WAIT_V(6); PG8_BAR; PG8_MMA(1, 1, At, B1); PG8_BAR;
        }
        {
            int epm = cur.pm, epn = cur.pn; asm volatile("" : "+s"(epm), "+s"(epn));
            unsigned eln = (unsigned)lane; asm volatile("" : "+v"(eln)); const int efr = (int)(eln & 15u), efq = (int)(eln >> 4);
            f32x4 cv[2][2];
#pragma unroll
            for (int bj = 0; bj < 2; ++bj)
#pragma unroll
                for (int n = 0; n < 2; ++n) { if constexpr (Epi::COLVEC) cv[bj][n] = E.colvec(epm * BM, epn * BM + bj * HALF + wc * 32 + n * 16 + 4 * efq); else cv[bj][n] = (f32x4){0.f, 0.f, 0.f, 0.f}; }
            if constexpr (Epi::COLVEC) asm volatile("" : "+v"(cv[0][0]), "+v"(cv[0][1]), "+v"(cv[1][0]), "+v"(cv[1][1]) :: "memory");
#pragma unroll
            for (int ai = 0; ai < 2; ++ai) {
                f32x4 bs[4][2][2];
                if constexpr (Epi::BASE) {
#pragma unroll
                    for (int m = 0; m < 4; ++m)
#pragma unroll
                        for (int bj = 0; bj < 2; ++bj)
#pragma unroll
                            for (int n = 0; n < 2; ++n) bs[m][bj][n] = E.base(epm * BM + ai * HALF + wr * 64 + m * 16 + efr, epn * BM + bj * HALF + wc * 32 + n * 16 + 4 * efq);
                    asm volatile("" : "+v"(bs[0][0][0]), "+v"(bs[0][0][1]), "+v"(bs[0][1][0]), "+v"(bs[0][1][1]), "+v"(bs[1][0][0]), "+v"(bs[1][0][1]), "+v"(bs[1][1][0]), "+v"(bs[1][1][1]),
                                      "+v"(bs[2][0][0]), "+v"(bs[2][0][1]), "+v"(bs[2][1][0]), "+v"(bs[2][1][1]), "+v"(bs[3][0][0]), "+v"(bs[3][0][1]), "+v"(bs[3][1][0]), "+v"(bs[3][1][1]) :: "memory");
                }
#pragma unroll
                for (int m = 0; m < 4; ++m) {
                    const int row = epm * BM + ai * HALF + wr * 64 + m * 16 + efr;
#pragma unroll
                    for (int bj = 0; bj < 2; ++bj) {
                        if constexpr (Epi::PAIR) E.store_pair(row, epn * (BM / 2) + bj * (HALF / 2) + wc * 16 + 4 * efq, acc[ai][bj][m][0], acc[ai][bj][m][1]);
                        else {
#pragma unroll
                            for (int n = 0; n < 2; ++n) { f32x4 bb = (f32x4){0.f, 0.f, 0.f, 0.f}; if constexpr (Epi::BASE) bb = bs[m][bj][n]; E.store(row, epn * BM + bj * HALF + wc * 32 + n * 16 + 4 * efq, acc[ai][bj][m][n], cv[bj][n], bb); }
                        }
                    }
                }
            }
        }
        if (!has_next) break;
#pragma unroll
        for (int a = 0; a < 2; ++a)
#pragma unroll
            for (int b = 0; b < 2; ++b)
#pragma unroll
                for (int m = 0; m < 4; ++m)
#pragma unroll
                    for (int n = 0; n < 2; ++n) acc[a][b][m][n] = (f32x4){0.f, 0.f, 0.f, 0.f};
        cur = nxt; cB = nB; cA = nA; ++ui;
    }
    PG8_WAIT_V(0);
    if (wr == 0) PG8_BAR;
    PG8_BAR;
#undef PG8_GATHER_OFFS
#undef VC0
#undef VC1
#undef VN0
#undef VN1
#undef PG8_SA
#undef PG8_SB
#undef PG8_STAGE2
#undef PG8_STAGEB
#undef PG8_LDA
#undef PG8_LDB
#undef PG8_MMA
#undef PG8_WAIT_V
#undef PG8_WAIT_L
#undef PG8_BAR
#undef PG8_SCHED
}
}

template <class Epi>
__device__ __forceinline__ void gemm_fast(Frame& F, const bf16* A, int lda, const bf16* Bt, int ldb, int K, int M, int N, const Epi& E) {
    pg8::OrderPlain S; S.init(M / 256, N / 256, F.G, F.wg);
    pg8::gemm_phase(F.lds, A, lda, Bt, ldb, K, S, E);
}
#ifndef FAST_PLAIN
#define FAST_PLAIN 1
#endif
#ifndef FAST_HORNER
#define FAST_HORNER 1
#endif
#ifndef FAST_MOE
#define FAST_MOE 1
#endif

__device__ __forceinline__ void st_bf16x4(bf16* p, f32x4 v) { u32x2 w; w.x = pk2(v.x, v.y); w.y = pk2(v.z, v.w); *(u32x2*)p = w; }
__device__ __forceinline__ f32x4 ld_bf16x4(const bf16* p) { const u32x2 w = *(const u32x2*)p; f32x4 v; v.x = __uint_as_float(w.x << 16); v.y = __uint_as_float(w.x & 0xffff0000u); v.z = __uint_as_float(w.y << 16); v.w = __uint_as_float(w.y & 0xffff0000u); return v; }

struct EpiWin {
    static constexpr bool HORNER = false, PAIR = false, COLVEC = true, BASE = false;
    const float* bias; bf16 *hytl, *hytc, *ret, *ml; float* mlg;
    __device__ __forceinline__ f32x4 colvec(int, int col) const { return *(const f32x4*)(bias + col); }
    __device__ __forceinline__ void store(int row, int col, f32x4 v, f32x4 cv, f32x4) const {
        v += cv;
        if (col < 1152) {
            if (row < TOKL) { const int b = row >> 11, t = row & 2047; bf16* d = hytl + ((size_t)(b * 1152 + col)) * 2048 + t;
                d[0] = (bf16)f2bf(v.x); d[2048] = (bf16)f2bf(v.y); d[4096] = (bf16)f2bf(v.z); d[6144] = (bf16)f2bf(v.w); }
            else { const int r = row - TOKL, b = r >> 8, t = r & 255; bf16* d = hytc + ((size_t)(b * 1152 + col)) * 256 + t;
                d[0] = (bf16)f2bf(v.x); d[256] = (bf16)f2bf(v.y); d[512] = (bf16)f2bf(v.z); d[768] = (bf16)f2bf(v.w); }
        } else if (col < 1168) { *(f32x4*)(mlg + (size_t)row * 16 + (col - 1152)) = v; }
        else if (col < 1280) { }
        else if (col < 2816) st_bf16x4(ret + (size_t)row * 1536 + (col - 1280), v);
        else st_bf16x4(ml + (size_t)row * 1024 + (col - 2816), v);
    }
};
struct EpiGate {
    static constexpr bool HORNER = false, PAIR = false, COLVEC = true, BASE = false;
    const float* bias; bf16* gates;
    __device__ __forceinline__ f32x4 colvec(int, int col) const { return *(const f32x4*)(bias + col); }
    __device__ __forceinline__ void store(int row, int col, f32x4 v, f32x4 cv, f32x4) const {
        v += cv;
        f32x4 g; g.x = fmaxf(sigmoidf_(v.x), 1e-20f); g.y = fmaxf(sigmoidf_(v.y), 1e-20f); g.z = fmaxf(sigmoidf_(v.z), 1e-20f); g.w = fmaxf(sigmoidf_(v.w), 1e-20f);
        st_bf16x4(gates + (size_t)row * NGATE + col, g);
    }
};
struct EpiUp {
    static constexpr bool HORNER = true, PAIR = false, COLVEC = false, BASE = true;
    const bf16* gates; bf16* acc_out;
    __device__ __forceinline__ u32x2 gate(int which, int row, int col) const { return *(const u32x2*)(gates + (size_t)row * NGATE + which * 1024 + col); }
    __device__ __forceinline__ f32x4 base(int row, int col) const { return ld_bf16x4(gates + (size_t)row * NGATE + 2048 + col); }
    __device__ __forceinline__ void store(int row, int col, f32x4 v, f32x4, f32x4 g) const { st_bf16x4(acc_out + (size_t)row * D + col, v * g); }
};
struct EpiResid {
    static constexpr bool HORNER = false, PAIR = false, COLVEC = true, BASE = true;
    const float *xin_l, *xin_c; float *xout_l, *xout_c; const float* modbase; int which;
    __device__ __forceinline__ f32x4 colvec(int row0, int col) const { const int r = row0 < TOKL ? (row0 >> 11) : 16; return *(const f32x4*)(modbase + ((size_t)r * 6 + which) * 1024 + col); }
    __device__ __forceinline__ f32x4 base(int row, int col) const { return row < TOKL ? *(const f32x4*)(xin_l + (size_t)row * D + col) : *(const f32x4*)(xin_c + (size_t)(row - TOKL) * D + col); }
    __device__ __forceinline__ void store(int row, int col, f32x4 v, f32x4 m, f32x4 x) const {
        if (row < TOKL) *(f32x4*)(xout_l + (size_t)row * D + col) = x + m * v;
        else *(f32x4*)(xout_c + (size_t)(row - TOKL) * D + col) = x + m * v;
    }
};
struct EpiSwiglu {
    static constexpr bool HORNER = false, PAIR = true, COLVEC = false, BASE = false;
    bf16* act; int row_off;
    __device__ __forceinline__ void store_pair(int row, int col, f32x4 a, f32x4 b) const {
        f32x4 o; o.x = siluf_(a.x) * b.x; o.y = siluf_(a.y) * b.y; o.z = siluf_(a.z) * b.z; o.w = siluf_(a.w) * b.w;
        st_bf16x4(act + (size_t)(row - row_off) * DFF + col, o);
    }
    __device__ __forceinline__ void store(int, int, f32x4, f32x4, f32x4) const {}
};
struct EpiBf16Out {
    static constexpr bool HORNER = false, PAIR = false, COLVEC = false, BASE = false;
    bf16* out; int ld; int row_add;
    __device__ __forceinline__ void store(int row, int col, f32x4 v, f32x4, f32x4) const { st_bf16x4(out + (size_t)(row + row_add) * ld + col, v); }
    __device__ __forceinline__ void store_pair(int, int, f32x4, f32x4) const {}
};

constexpr int ZPITCH_L = (LL + 8) * 2, ZPITCH_C = (LC + 8) * 2;
template <int L>
__device__ __forceinline__ float conv3_at(const bf16* base  , int t, float w0, float w1, float w2) {
    const float a = t > 0 ? bf2f(base[t - 1]) : 0.f, b = bf2f(base[t]), c = t < L - 1 ? bf2f(base[t + 1]) : 0.f;
    return w0 * a + w1 * b + w2 * c;
}
template <int L>
__device__ __forceinline__ void hyena_unit_naive(Frame& F, int layer, int c, const bf16* hyt  , const bf16* ft  , bf16* yht  ) {
    constexpr int ZP = (L + 8) * 2;
    constexpr int PER = L / 32;
    constexpr int SUB = 8;
    LAS unsigned char* zimg0 = F.lds;
    LAS unsigned char* zimg1 = F.lds + 16 * ZP;
    LAS bf16* tf = (LAS bf16*)(F.lds + 32 * ZP);
    const float* cw = inp(F, I_HYCONV) + layer * 3 * 1152;
    const float* skip = inp(F, I_HYSKIP) + layer * 2 * 384;
    __syncthreads();
    {
        const int b = F.tid >> 5, seg = F.tid & 31; const bf16* src = hyt + ((size_t)(b * 1152 + c)) * L;
        const float w0 = cw[c], w1 = cw[1152 + c], w2 = cw[2304 + c];
#pragma unroll 2
        for (int j = 0; j < PER; ++j) { const int t = seg * PER + j; *(LAS bf16*)(zimg0 + b * ZP + t * 2) = (bf16)f2bf(conv3_at<L>(src, t, w0, w1, w2)); }
    }
#pragma unroll 1
    for (int o = 0; o < 2; ++o) {
        LAS unsigned char* zs = o == 0 ? zimg0 : zimg1;
        LAS unsigned char* zd = o == 0 ? zimg1 : zimg0;
        const bf16* fsrc = ft + ((size_t)(o * 384 + c)) * (2 * L);
        for (int i = F.tid; i < 2 * L; i += NTHR) tf[i] = i == 0 ? (bf16)0 : fsrc[i];
        __syncthreads();
        const int b = F.tid & 15, tg = F.tid >> 4;
        const int gcol = (o == 0 ? 384 : 768) + c;
        const bf16* gsrc = hyt + ((size_t)(b * 1152 + gcol)) * L;
        const float w0 = cw[gcol], w1 = cw[1152 + gcol], w2 = cw[2304 + gcol], sk = skip[o * 384 + c];
#pragma unroll 1
        for (int sb = 0; sb < PER / SUB; ++sb) {
            const int t0 = tg * PER + sb * SUB;
            float acc[SUB];
#pragma unroll
            for (int j = 0; j < SUB; ++j) acc[j] = 0.f;
#pragma unroll 1
            for (int s0 = 0; s0 < L; s0 += 8) {
                float z[8];
                { const bf16x8 zz = *(const LAS bf16x8*)(zs + b * ZP + s0 * 2);
#pragma unroll
                  for (int i = 0; i < 8; ++i) z[i] = bf2f((bf16)zz[i]); }
                float win[SUB + 7];
                const int wb = L + s0 - t0 - (SUB - 1);
#pragma unroll
                for (int i = 0; i < SUB + 7; ++i) win[i] = bf2f(tf[wb + i]);
#pragma unroll
                for (int j = 0; j < SUB; ++j)
#pragma unroll
                    for (int i = 0; i < 8; ++i) acc[j] += win[(SUB - 1) - j + i] * z[i];
            }
#pragma unroll
            for (int j = 0; j < SUB; ++j) {
                const int t = t0 + j;
                const float zt = bf2f(*(LAS bf16*)(zs + b * ZP + t * 2));
                const float ov = conv3_at<L>(gsrc, t, w0, w1, w2) * (acc[j] + sk * zt);
                *(LAS bf16*)(zd + b * ZP + t * 2) = (bf16)f2bf(ov);
            }
        }
        __syncthreads();
    }
#pragma unroll 2
    for (int i = F.tid; i < 16 * (L / 8); i += NTHR) {
        const int b = i / (L / 8), ch = i % (L / 8);
        *(u32x4*)(yht + ((size_t)(b * 384 + c)) * L + ch * 8) = *(const LAS u32x4*)(zimg0 + b * ZP + ch * 16);
    }
}

template <int L>
__device__ __forceinline__ void hyena_unit_fast(Frame& F, int layer, int c, const bf16* hyt  , const bf16* ft  , bf16* yht  ) {
    constexpr int ZP = (L + 8) * 2;
    constexpr int PER = L / 32;
    constexpr int I = L / 128;
    constexpr int SPAN = L / 4, NSTEP = L / 32;
    LAS unsigned char* zimg0 = F.lds;
    LAS unsigned char* zimg1 = F.lds + 16 * ZP;
    LAS bf16* tf = (LAS bf16*)(F.lds + 32 * ZP);
    const float* cw = inp(F, I_HYCONV) + layer * 3 * 1152;
    const float* skip = inp(F, I_HYSKIP) + layer * 2 * 384;
    const int lane = F.lane, fr = lane & 15, fq = lane >> 4, w = F.wave;
    __syncthreads();
    {
        const int b = F.tid >> 5, seg = F.tid & 31; const bf16* src = hyt + ((size_t)(b * 1152 + c)) * L;
        const float w0 = cw[c], w1 = cw[1152 + c], w2 = cw[2304 + c];
#pragma unroll 2
        for (int j = 0; j < PER; ++j) { const int t = seg * PER + j; *(LAS bf16*)(zimg0 + b * ZP + t * 2) = (bf16)f2bf(conv3_at<L>(src, t, w0, w1, w2)); }
    }
    const int tbase = SPAN * (w >> 1) + 16 * (w & 1);
    const int flane = L - tbase + 8 * fq - fr;
#pragma unroll 1
    for (int o = 0; o < 2; ++o) {
        LAS unsigned char* zs = o == 0 ? zimg0 : zimg1;
        LAS unsigned char* zd = o == 0 ? zimg1 : zimg0;
        const bf16* fsrc = ft + ((size_t)(o * 384 + c)) * (2 * L);
        for (int i = F.tid; i < 2 * L; i += NTHR) tf[i] = i == 0 ? (bf16)0 : fsrc[i];
        __syncthreads();
        f32x4 acc[I];
#pragma unroll
        for (int i = 0; i < I; ++i) acc[i] = (f32x4){0.f, 0.f, 0.f, 0.f};
        bf16x8 ring[I];
#pragma unroll
        for (int i = 1; i < I; ++i) __builtin_memcpy(&ring[(I - i) % I], (const LAS unsigned char*)tf + 2 * (flane - 32 * i), 16);
        const LAS unsigned char* zrow = zs + fr * ZP + 16 * fq;
#pragma unroll 1
        for (int j0 = 0; j0 < NSTEP; j0 += I) {
#pragma unroll
            for (int jj = 0; jj < I; ++jj) {
                const int j = j0 + jj;
                __builtin_memcpy(&ring[jj], (const LAS unsigned char*)tf + 2 * (flane + 32 * j), 16);
                const bf16x8 zf = *(const LAS bf16x8*)(zrow + 64 * j);
#pragma unroll
                for (int i = 0; i < I; ++i) acc[i] = __builtin_amdgcn_mfma_f32_16x16x32_bf16(ring[(jj - i + I) % I], zf, acc[i], 0, 0, 0);
            }
        }
        const int gcol = (o == 0 ? 384 : 768) + c;
        const bf16* gsrc = hyt + ((size_t)(fr * 1152 + gcol)) * L;
        const float w0 = cw[gcol], w1 = cw[1152 + gcol], w2 = cw[2304 + gcol], sk = skip[o * 384 + c];
        bf16* dst = yht + ((size_t)(fr * 384 + c)) * L;
#pragma unroll
        for (int i = 0; i < I; ++i) {
            asm volatile("" ::: "memory");
            const int t = tbase + 32 * i + 4 * fq;
            const u32x2 zr = *(const LAS u32x2*)(zs + fr * ZP + t * 2);
            const u32x2 gr = *(const u32x2*)(gsrc + t);
            const float gm = t > 0 ? bf2f(gsrc[t - 1]) : 0.f, gp = t + 4 < L ? bf2f(gsrc[t + 4]) : 0.f;
            const float g0 = __uint_as_float(gr.x << 16), g1 = __uint_as_float(gr.x & 0xffff0000u), g2 = __uint_as_float(gr.y << 16), g3 = __uint_as_float(gr.y & 0xffff0000u);
            const float z0 = __uint_as_float(zr.x << 16), z1 = __uint_as_float(zr.x & 0xffff0000u), z2 = __uint_as_float(zr.y << 16), z3 = __uint_as_float(zr.y & 0xffff0000u);
            const float o0 = (w0 * gm + w1 * g0 + w2 * g1) * (acc[i].x + sk * z0), o1 = (w0 * g0 + w1 * g1 + w2 * g2) * (acc[i].y + sk * z1);
            const float o2 = (w0 * g1 + w1 * g2 + w2 * g3) * (acc[i].z + sk * z2), o3 = (w0 * g2 + w1 * g3 + w2 * gp) * (acc[i].w + sk * z3);
            u32x2 ov; ov.x = pk2(o0, o1); ov.y = pk2(o2, o3);
            if (o == 0) *(LAS u32x2*)(zd + fr * ZP + t * 2) = ov;
            else *(u32x2*)(dst + t) = ov;
        }
        __syncthreads();
    }
}

__device__ __forceinline__ void chain_naive(Frame& F, int layer, int chain) {
    const int lane = F.lane;
    const bool is_ret = chain < 192;
    int b, h, dir;
    if (is_ret) { b = chain / 12; const int r = chain % 12; h = r >> 1; dir = r & 1; }
    else { const int i = chain - 192; b = i >> 3; h = (i & 7) >> 1; dir = i & 1; }
    const bf16* RET = WSP(const bf16, WS_RET); const bf16* ML = WSP(const bf16, WS_ML); const float* MLG = WSP(const float, WS_MLG);
    const float* rope = WSP(const float, WS_ROPE);
    bf16* Y = WSP(bf16, WS_Y); bf16* OB = WSP(bf16, WS_OB);
    float gam = 0.f;
    if (is_ret) gam = sigmoidf_(inp(F, I_RETDECAY)[layer * 12 + dir * 6 + h]);
    const float* mlc = inp(F, I_MLCONV) + layer * 3 * 512;
    const float bi = is_ret ? 0.f : inp(F, I_MLGB)[layer * 16 + dir * 8 + h], bfg = is_ret ? 0.f : inp(F, I_MLGB)[layer * 16 + dir * 8 + 4 + h];
    const float qw0 = mlc[h * 64 + lane], qw1 = mlc[512 + h * 64 + lane], qw2 = mlc[1024 + h * 64 + lane];
    const float kw0 = mlc[256 + h * 64 + lane], kw1 = mlc[512 + 256 + h * 64 + lane], kw2 = mlc[1024 + 256 + h * 64 + lane];
    float S[64];
#pragma unroll
    for (int d = 0; d < 64; ++d) S[d] = 0.f;
    float nv = 0.f;
    for (int step = 0; step < LC + LL; ++step) {
        int row, tpos, L; bool lat;
        if (step < LC) { tpos = dir ? (LC - 1 - step) : step; row = TOKL + b * LC + tpos; L = LC; lat = false; }
        else { const int s2 = step - LC; tpos = dir ? (LL - 1 - s2) : s2; row = b * LL + tpos; L = LL; lat = true; }
        float q, k, v, Fm, Im;
        if (is_ret) {
            const bf16* base = RET + (size_t)row * 1536;
            float qs = bf2f(base[h * 64 + lane]), ks = bf2f(base[384 + h * 64 + lane]);
            v = bf2f(base[768 + h * 64 + lane]);
            if (lat) {
                const float qp = bf2f(base[h * 64 + (lane ^ 16)]), kp = bf2f(base[384 + h * 64 + (lane ^ 16)]);
                const int half = lane >> 5, ii = lane & 15, hi = (lane >> 4) & 1;
                const float cs = rope[tpos * 64 + half * 32 + ii], sn = rope[tpos * 64 + half * 32 + 16 + ii];
                q = hi == 0 ? qs * cs - qp * sn : qp * sn + qs * cs;
                k = hi == 0 ? ks * cs - kp * sn : kp * sn + ks * cs;
            } else { q = qs; k = ks; }
            q *= 0.125f; Fm = gam; Im = 1.f;
        } else {
            const bf16* base = ML + (size_t)row * 1024;
            const float q0 = tpos > 0 ? bf2f(base[-1024 + h * 64 + lane]) : 0.f, q1 = bf2f(base[h * 64 + lane]), q2 = tpos < L - 1 ? bf2f(base[1024 + h * 64 + lane]) : 0.f;
            const float k0 = tpos > 0 ? bf2f(base[-1024 + 256 + h * 64 + lane]) : 0.f, k1 = bf2f(base[256 + h * 64 + lane]), k2 = tpos < L - 1 ? bf2f(base[1024 + 256 + h * 64 + lane]) : 0.f;
            q = siluf_(qw0 * q0 + qw1 * q1 + qw2 * q2);
            k = siluf_(kw0 * k0 + kw1 * k1 + kw2 * k2) * 0.125f;
            v = bf2f(base[512 + h * 64 + lane]);
            const float ig = MLG[(size_t)row * 16 + dir * 8 + h] + bi, fg = MLG[(size_t)row * 16 + dir * 8 + 4 + h] + bfg;
            Fm = sigmoidf_(fg); Im = __expf(ig);
        }
        float num = 0.f;
        const float iv = Im * v;
#pragma unroll
        for (int d = 0; d < 64; ++d) {
            const float kd = __int_as_float(__builtin_amdgcn_readlane(__float_as_int(k), d));
            const float qd = __int_as_float(__builtin_amdgcn_readlane(__float_as_int(q), d));
            S[d] = Fm * S[d] + kd * iv;
            num += qd * S[d];
        }
        float o = num;
        if (!is_ret) { nv = Fm * nv + Im * k; const float den = wave_sum(q * nv); o = num / fmaxf(fabsf(den), 1.f); }
        const int cof = is_ret ? (h * 64 + lane) : (384 + h * 64 + lane);
        if (dir == 0) Y[(size_t)row * D + 384 + cof] = (bf16)f2bf(o);
        else OB[(size_t)row * 640 + cof] = (bf16)f2bf(o);
    }
}

constexpr int CH_PITCH = 144;
constexpr int CH_IMG = 64 * CH_PITCH;
constexpr int CH_WAVE_LDS = 3 * CH_IMG + 1024 + 256;
__device__ __forceinline__ void ds_tr16x8(unsigned addr, u32x2 (&lo)[4], u32x2 (&hi)[4]) {
    asm volatile("ds_read_b64_tr_b16 %0, %8\n\tds_read_b64_tr_b16 %1, %8 offset:32\n\tds_read_b64_tr_b16 %2, %8 offset:64\n\tds_read_b64_tr_b16 %3, %8 offset:96\n\t"
                 "ds_read_b64_tr_b16 %4, %8 offset:2304\n\tds_read_b64_tr_b16 %5, %8 offset:2336\n\tds_read_b64_tr_b16 %6, %8 offset:2368\n\tds_read_b64_tr_b16 %7, %8 offset:2400\n\t"
                 "s_waitcnt lgkmcnt(0)"
                 : "=&v"(lo[0]), "=&v"(lo[1]), "=&v"(lo[2]), "=&v"(lo[3]), "=&v"(hi[0]), "=&v"(hi[1]), "=&v"(hi[2]), "=&v"(hi[3]) : "v"(addr) : "memory");
}
static_assert(16 * CH_PITCH == 2304, "ds_tr16x8 offsets");
__device__ __forceinline__ float log_sigmoid_(float x) { return fminf(x, 0.f) - log1pf(__expf(-fabsf(x))); }
__device__ __forceinline__ bf16x8 mk_frag(u32x2 lo, u32x2 hi) { u32x4 w; w.x = lo.x; w.y = lo.y; w.z = hi.x; w.w = hi.y; return __builtin_bit_cast(bf16x8, w); }

template <bool IS_ML>
__device__ __forceinline__ void chain_fast(Frame& F, int layer, int b, int h, int dir, LAS unsigned char* img) {
    constexpr int NET = 4;
    const int lane = F.lane, fr = lane & 15, fq = lane >> 4;
    LAS unsigned char* Qi = img; LAS unsigned char* Ki = img + CH_IMG; LAS unsigned char* Vi = img + 2 * CH_IMG;
    const unsigned qa = (unsigned)(size_t)Qi, ka = (unsigned)(size_t)Ki, va = (unsigned)(size_t)Vi;
    const bf16* RET = WSP(const bf16, WS_RET); const bf16* ML = WSP(const bf16, WS_ML); const float* MLG = WSP(const float, WS_MLG);
    const float* rope = WSP(const float, WS_ROPE);
    bf16* Y = WSP(bf16, WS_Y); bf16* OB = WSP(bf16, WS_OB);
    float lgam = 0.f, bi_ = 0.f, bf_ = 0.f;
    if (!IS_ML) lgam = log_sigmoid_(inp(F, I_RETDECAY)[layer * 12 + dir * 6 + h]);
    else { bi_ = inp(F, I_MLGB)[layer * 16 + dir * 8 + h]; bf_ = inp(F, I_MLGB)[layer * 16 + dir * 8 + 4 + h]; }
    const float* mlc = inp(F, I_MLCONV) + layer * 3 * 512;
    f32x4 C[4][NET];
#pragma unroll
    for (int dt = 0; dt < 4; ++dt)
#pragma unroll
        for (int et = 0; et < NET; ++et) C[dt][et] = (f32x4){0.f, 0.f, 0.f, 0.f};
    const int cq = lane & 7, pr0 = lane >> 3;
    LAS float* nvec = (LAS float*)(img + 3 * CH_IMG + 1024);
    if (IS_ML) nvec[lane] = 0.f;
    const LAS float* nq = nvec + 4 * fq;
#pragma unroll 1
    for (int step = 0; step < 36; ++step) {
        int rowbase, t0, L; bool lat;
        if (step < 4) { const int cc = dir ? 3 - step : step; rowbase = TOKL + b * LC + cc * 64; t0 = cc * 64; L = LC; lat = false; }
        else { const int cc = dir ? 35 - step : step - 4; rowbase = b * LL + cc * 64; t0 = cc * 64; L = LL; lat = true; }
#pragma unroll 1
        for (int i = 0; i < 8; ++i) {
            const int p = pr0 + 8 * i, tl = dir ? 63 - p : p, row = rowbase + tl, tpos = t0 + tl;
            float qv[8], kv[8]; u32x4 vraw;
            if (!IS_ML) {
                const bf16* base = RET + (size_t)row * 1536 + h * 64;
                const u32x4 qr = *(const u32x4*)(base + 8 * cq), kr = *(const u32x4*)(base + 384 + 8 * cq); vraw = *(const u32x4*)(base + 768 + 8 * cq);
                const unsigned qw[4] = {qr.x, qr.y, qr.z, qr.w}, kw[4] = {kr.x, kr.y, kr.z, kr.w};
#pragma unroll
                for (int j = 0; j < 4; ++j) { qv[2 * j] = __uint_as_float(qw[j] << 16); qv[2 * j + 1] = __uint_as_float(qw[j] & 0xffff0000u); kv[2 * j] = __uint_as_float(kw[j] << 16); kv[2 * j + 1] = __uint_as_float(kw[j] & 0xffff0000u); }
                if (lat) {
                    const u32x4 qpr = *(const u32x4*)(base + 8 * (cq ^ 2)), kpr = *(const u32x4*)(base + 384 + 8 * (cq ^ 2));
                    const unsigned qpw[4] = {qpr.x, qpr.y, qpr.z, qpr.w}, kpw[4] = {kpr.x, kpr.y, kpr.z, kpr.w};
                    const int half = cq >> 2, hi = (cq >> 1) & 1, i0 = 8 * (cq & 1);
                    const float* rp = rope + tpos * 64 + half * 32 + i0;
                    const f32x4 c0 = *(const f32x4*)(rp), c1 = *(const f32x4*)(rp + 4), s0 = *(const f32x4*)(rp + 16), s1 = *(const f32x4*)(rp + 20);
                    const float cs[8] = {c0.x, c0.y, c0.z, c0.w, c1.x, c1.y, c1.z, c1.w}, sn[8] = {s0.x, s0.y, s0.z, s0.w, s1.x, s1.y, s1.z, s1.w};
#pragma unroll
                    for (int j = 0; j < 8; ++j) {
                        const float qp = (j & 1) ? __uint_as_float(qpw[j >> 1] & 0xffff0000u) : __uint_as_float(qpw[j >> 1] << 16);
                        const float kp = (j & 1) ? __uint_as_float(kpw[j >> 1] & 0xffff0000u) : __uint_as_float(kpw[j >> 1] << 16);
                        qv[j] = hi ? qp * sn[j] + qv[j] * cs[j] : qv[j] * cs[j] - qp * sn[j];
                        kv[j] = hi ? kp * sn[j] + kv[j] * cs[j] : kv[j] * cs[j] - kp * sn[j];
                    }
                }
#pragma unroll
                for (int j = 0; j < 8; ++j) qv[j] *= 0.125f;
            } else {
                const bf16* base = ML + (size_t)row * 1024 + h * 64 + 8 * cq;
                const u32x4 z4 = (u32x4){0u, 0u, 0u, 0u};
                const float* wq = mlc + h * 64 + 8 * cq; asm volatile("" : "+v"(wq));
                vraw = *(const u32x4*)(base + 512);
#pragma unroll
                for (int qk = 0; qk < 2; ++qk) {
                    const bf16* bb = base + 256 * qk; const float* ww = wq + 256 * qk;
                    const u32x4 r1 = *(const u32x4*)(bb), r0 = tpos > 0 ? *(const u32x4*)(bb - 1024) : z4, r2 = tpos < L - 1 ? *(const u32x4*)(bb + 1024) : z4;
                    const unsigned a0[4] = {r0.x, r0.y, r0.z, r0.w}, a1[4] = {r1.x, r1.y, r1.z, r1.w}, a2[4] = {r2.x, r2.y, r2.z, r2.w};
#pragma unroll
                    for (int j = 0; j < 8; ++j) {
                        const float x0 = (j & 1) ? __uint_as_float(a0[j >> 1] & 0xffff0000u) : __uint_as_float(a0[j >> 1] << 16);
                        const float x1 = (j & 1) ? __uint_as_float(a1[j >> 1] & 0xffff0000u) : __uint_as_float(a1[j >> 1] << 16);
                        const float x2 = (j & 1) ? __uint_as_float(a2[j >> 1] & 0xffff0000u) : __uint_as_float(a2[j >> 1] << 16);
                        const float r = siluf_(ww[j] * x0 + ww[512 + j] * x1 + ww[1024 + j] * x2);
                        if (qk == 0) qv[j] = r; else kv[j] = r * 0.125f;
                    }
                    if (qk == 0) asm volatile("" : "+v"(qv[0]), "+v"(qv[1]), "+v"(qv[2]), "+v"(qv[3]), "+v"(qv[4]), "+v"(qv[5]), "+v"(qv[6]), "+v"(qv[7]) :: "memory");
                }
            }
            u32x4 qo, ko; qo.x = pk2(qv[0], qv[1]); qo.y = pk2(qv[2], qv[3]); qo.z = pk2(qv[4], qv[5]); qo.w = pk2(qv[6], qv[7]);
            ko.x = pk2(kv[0], kv[1]); ko.y = pk2(kv[2], kv[3]); ko.z = pk2(kv[4], kv[5]); ko.w = pk2(kv[6], kv[7]);
            *(LAS u32x4*)(Qi + p * CH_PITCH + 16 * cq) = qo; *(LAS u32x4*)(Ki + p * CH_PITCH + 16 * cq) = ko; *(LAS u32x4*)(Vi + p * CH_PITCH + 16 * cq) = vraw;
        }
        __builtin_amdgcn_sched_barrier(0);
        float f_p, i_p;
        { const int tl = dir ? 63 - lane : lane, row = rowbase + tl;
          if (!IS_ML) { f_p = lgam; i_p = 0.f; }
          else { i_p = MLG[(size_t)row * 16 + dir * 8 + h] + bi_; f_p = log_sigmoid_(MLG[(size_t)row * 16 + dir * 8 + 4 + h] + bf_); } }
        float bsum = f_p;
#pragma unroll
        for (int o = 1; o < 64; o <<= 1) { const float t = __shfl_up(bsum, o); if (lane >= o) bsum += t; }
        LAS float* gv = (LAS float*)(img + 3 * CH_IMG);
        const float b63 = __shfl(bsum, 63);
        const float adec = __expf(b63);
        gv[lane] = bsum; gv[64 + lane] = bsum - i_p; gv[128 + lane] = __expf(bsum); gv[192 + lane] = __expf(b63 - (bsum - i_p));
        asm volatile("s_waitcnt lgkmcnt(0)" ::: "memory");
        const LAS float* gq = gv + 4 * fq;
        const bf16x8 ones = (fr == 0) ? (bf16x8){0x3F80, 0x3F80, 0x3F80, 0x3F80, 0x3F80, 0x3F80, 0x3F80, 0x3F80} : (bf16x8){0, 0, 0, 0, 0, 0, 0, 0};
        const int tr_q = fr >> 2, tr_p = fr & 3;
#pragma unroll 1
        for (int pt = 0; pt < 4; ++pt) {
            f32x4 ST[4];
            bf16x8 qn[2];
#pragma unroll
            for (int kk = 0; kk < 2; ++kk) qn[kk] = *(const LAS bf16x8*)(Qi + (16 * pt + fr) * CH_PITCH + (32 * kk + 8 * fq) * 2);
#pragma unroll
            for (int st = 0; st < 4; ++st) {
                ST[st] = (f32x4){0.f, 0.f, 0.f, 0.f};
                if (st <= pt) {
#pragma unroll
                    for (int kk = 0; kk < 2; ++kk) { const bf16x8 kf = *(const LAS bf16x8*)(Ki + (16 * st + fr) * CH_PITCH + (32 * kk + 8 * fq) * 2); ST[st] = __builtin_amdgcn_mfma_f32_16x16x32_bf16(kf, qn[kk], ST[st], 0, 0, 0); }
                }
            }
            const float bp = gv[16 * pt + fr];
#pragma unroll
            for (int st = 0; st < 4; ++st) {
                if (st <= pt) {
                    const f32x4 bis = *(const LAS f32x4*)(gq + 64 + 16 * st);
#pragma unroll
                    for (int j = 0; j < 4; ++j) { const int sidx = 16 * st + 4 * fq + j; const float w = (sidx <= 16 * pt + fr) ? __expf(bp - bis[j]) : 0.f; ST[st][j] *= w; }
                }
            }
            __builtin_amdgcn_sched_barrier(0);
            f32x4 acc[NET], accd = (f32x4){0.f, 0.f, 0.f, 0.f};
#pragma unroll
            for (int et = 0; et < NET; ++et) acc[et] = (f32x4){0.f, 0.f, 0.f, 0.f};
#pragma unroll
            for (int kk = 0; kk < 2; ++kk) {
                const u32x2 lo = *(const LAS u32x2*)(Qi + (16 * pt + fr) * CH_PITCH + (32 * kk + 4 * fq) * 2), hi = *(const LAS u32x2*)(Qi + (16 * pt + fr) * CH_PITCH + (32 * kk + 16 + 4 * fq) * 2);
                const bf16x8 qs = mk_frag(lo, hi);
#pragma unroll
                for (int et = 0; et < NET; ++et) {
                    u32x4 w; w.x = pk2(C[2 * kk][et].x, C[2 * kk][et].y); w.y = pk2(C[2 * kk][et].z, C[2 * kk][et].w); w.z = pk2(C[2 * kk + 1][et].x, C[2 * kk + 1][et].y); w.w = pk2(C[2 * kk + 1][et].z, C[2 * kk + 1][et].w);
                    acc[et] = __builtin_amdgcn_mfma_f32_16x16x32_bf16(qs, __builtin_bit_cast(bf16x8, w), acc[et], 0, 0, 0);
                }
                if (IS_ML) {
                    const f32x4 n0 = *(const LAS f32x4*)(nq + 32 * kk), n1 = *(const LAS f32x4*)(nq + 32 * kk + 16);
                    u32x4 w; w.x = pk2(n0.x, n0.y); w.y = pk2(n0.z, n0.w); w.z = pk2(n1.x, n1.y); w.w = pk2(n1.z, n1.w);
                    if (fr != 0) w = (u32x4){0u, 0u, 0u, 0u};
                    accd = __builtin_amdgcn_mfma_f32_16x16x32_bf16(qs, __builtin_bit_cast(bf16x8, w), accd, 0, 0, 0);
                }
            }
            { const f32x4 ap = *(const LAS f32x4*)(gq + 128 + 16 * pt);
#pragma unroll
              for (int j = 0; j < 4; ++j) {
#pragma unroll
                for (int et = 0; et < NET; ++et) acc[et][j] *= ap[j];
                accd[j] *= ap[j]; } }
            __builtin_amdgcn_sched_barrier(0);
#pragma unroll
            for (int kk = 0; kk < 2; ++kk) {
                if (2 * kk <= pt) {
                    u32x4 w; w.x = pk2(ST[2 * kk].x, ST[2 * kk].y); w.y = pk2(ST[2 * kk].z, ST[2 * kk].w); w.z = pk2(ST[2 * kk + 1].x, ST[2 * kk + 1].y); w.w = pk2(ST[2 * kk + 1].z, ST[2 * kk + 1].w);
                    const bf16x8 pf = __builtin_bit_cast(bf16x8, w);
                    u32x2 vlo[4], vhi[4];
                    ds_tr16x8(va + (32 * kk + 4 * fq + tr_q) * CH_PITCH + 8 * tr_p, vlo, vhi);
#pragma unroll
                    for (int et = 0; et < 4; ++et) acc[et] = __builtin_amdgcn_mfma_f32_16x16x32_bf16(pf, mk_frag(vlo[et], vhi[et]), acc[et], 0, 0, 0);
                    if (IS_ML) accd = __builtin_amdgcn_mfma_f32_16x16x32_bf16(pf, ones, accd, 0, 0, 0);
                }
            }
            __builtin_amdgcn_sched_barrier(0);
#pragma unroll
            for (int j = 0; j < 4; ++j) {
                const int p = 16 * pt + 4 * fq + j, tl = dir ? 63 - p : p, row = rowbase + tl;
                float inv = 1.f;
                if (IS_ML) { const float den = __shfl(accd[j], lane & 48); inv = 1.f / fmaxf(fabsf(den), 1.f); }
#pragma unroll
                for (int et = 0; et < 4; ++et) {
                    const float o = acc[et][j] * inv;
                    const int cof = (IS_ML ? 384 : 0) + h * 64 + 16 * et + fr;
                    if (dir == 0) Y[(size_t)row * D + 384 + cof] = (bf16)f2bf(o); else OB[(size_t)row * 640 + cof] = (bf16)f2bf(o);
                }
            }
        }
        __builtin_amdgcn_sched_barrier(0);
#pragma unroll
        for (int dt = 0; dt < 4; ++dt)
#pragma unroll
            for (int et = 0; et < NET; ++et) C[dt][et] *= adec;
        f32x4 accn[4];
        if (IS_ML) {
#pragma unroll
            for (int dt = 0; dt < 4; ++dt) { accn[dt] = *(const LAS f32x4*)(nq + 16 * dt) * adec; if (fr != 0) accn[dt] = (f32x4){0.f, 0.f, 0.f, 0.f}; }
        }
#pragma unroll
        for (int kk = 0; kk < 2; ++kk) {
            u32x2 vlo[4], vhi[4], klo[4], khi[4];
            ds_tr16x8(va + (32 * kk + 4 * fq + tr_q) * CH_PITCH + 8 * tr_p, vlo, vhi);
            ds_tr16x8(ka + (32 * kk + 4 * fq + tr_q) * CH_PITCH + 8 * tr_p, klo, khi);
            const f32x4 wl = *(const LAS f32x4*)(gq + 192 + 32 * kk), wh = *(const LAS f32x4*)(gq + 192 + 32 * kk + 16);
#pragma unroll
            for (int dt = 0; dt < 4; ++dt) {
                u32x4 w;
                w.x = pk2(__uint_as_float(klo[dt].x << 16) * wl[0], __uint_as_float(klo[dt].x & 0xffff0000u) * wl[1]);
                w.y = pk2(__uint_as_float(klo[dt].y << 16) * wl[2], __uint_as_float(klo[dt].y & 0xffff0000u) * wl[3]);
                w.z = pk2(__uint_as_float(khi[dt].x << 16) * wh[0], __uint_as_float(khi[dt].x & 0xffff0000u) * wh[1]);
                w.w = pk2(__uint_as_float(khi[dt].y << 16) * wh[2], __uint_as_float(khi[dt].y & 0xffff0000u) * wh[3]);
                const bf16x8 kf = __builtin_bit_cast(bf16x8, w);
#pragma unroll
                for (int et = 0; et < 4; ++et) C[dt][et] = __builtin_amdgcn_mfma_f32_16x16x32_bf16(kf, mk_frag(vlo[et], vhi[et]), C[dt][et], 0, 0, 0);
                if (IS_ML) accn[dt] = __builtin_amdgcn_mfma_f32_16x16x32_bf16(kf, ones, accn[dt], 0, 0, 0);
            }
        }
        if (IS_ML) { if (fr == 0) {
#pragma unroll
            for (int dt = 0; dt < 4; ++dt) *(LAS f32x4*)(nvec + 4 * fq + 16 * dt) = accn[dt]; } }
        asm volatile("s_waitcnt lgkmcnt(0)" ::: "memory");
    }
}

#ifndef FAST_CHAIN
#define FAST_CHAIN 1
#endif
constexpr int NCHWG = 80;
__device__ __forceinline__ void phase_mix(Frame& F, int layer) {
    const bool last = layer == 1;
    const bf16* ftl = WSP(const bf16, WS_FTL) + (size_t)layer * 2 * 384 * 4096;
    if (FAST_CHAIN) {
        if (F.wg < NCHWG) {
            if (F.wave < 4) {
                const int c = F.wg * 4 + F.wave;
                LAS unsigned char* img = F.lds + F.wave * CH_WAVE_LDS;
                if (c < 192) { const int b = c / 12, r = c % 12; chain_fast<false>(F, layer, b, r >> 1, r & 1, img); }
                else { const int i = c - 192; chain_fast<true>(F, layer, i >> 3, (i & 7) >> 1, i & 1, img); }
            }
        } else {
            const int nh = F.G - NCHWG, w = F.wg - NCHWG;
#ifndef FAST_HY
#define FAST_HY 1
#endif
            if (FAST_HY) {
                for (int u = w; u < 384; u += nh) hyena_unit_fast<LL>(F, layer, u, WSP(const bf16, WS_HYTL), ftl, WSP(bf16, WS_YHTL));
                if (!last) for (int u = w; u < 384; u += nh) hyena_unit_fast<LC>(F, layer, u, WSP(const bf16, WS_HYTC), WSP(const bf16, WS_FTC), WSP(bf16, WS_YHTC));
            } else {
                for (int u = w; u < 384; u += nh) hyena_unit_naive<LL>(F, layer, u, WSP(const bf16, WS_HYTL), ftl, WSP(bf16, WS_YHTL));
                if (!last) for (int u = w; u < 384; u += nh) hyena_unit_naive<LC>(F, layer, u, WSP(const bf16, WS_HYTC), WSP(const bf16, WS_FTC), WSP(bf16, WS_YHTC));
            }
        }
    } else {
        for (int u = F.wg; u < 384; u += F.G) hyena_unit_naive<LL>(F, layer, u, WSP(const bf16, WS_HYTL), ftl, WSP(bf16, WS_YHTL));
        if (!last) for (int u = F.wg; u < 384; u += F.G) hyena_unit_naive<LC>(F, layer, u, WSP(const bf16, WS_HYTC), WSP(const bf16, WS_FTC), WSP(bf16, WS_YHTC));
        for (int c = F.wg + F.wave * F.G; c < 320; c += F.G * NWAVES) chain_naive(F, layer, c);
    }
}

__device__ __forceinline__ void phase_combine(Frame& F, int layer) {
    const bool last = layer == 1;
    const int gw = F.wg * NWAVES + F.wave, NGW = F.G * NWAVES, lane = F.lane;
    const int nrows = last ? TOKL : TOK;
    bf16* Y = WSP(bf16, WS_Y); const bf16* OB = WSP(const bf16, WS_OB); const bf16* RET = WSP(const bf16, WS_RET); const bf16* ML = WSP(const bf16, WS_ML);
    for (int row = gw; row < nrows; row += NGW) {
#pragma unroll
        for (int hh = 0; hh < 10; ++hh) {
            const int cof = hh * 64 + lane;
            const float x = bf2f(Y[(size_t)row * D + 384 + cof]) + bf2f(OB[(size_t)row * 640 + cof]);
            const float mu = wave_sum(x) * (1.f / 64.f), xc = x - mu;
            const float var = wave_sum(xc * xc) * (1.f / 64.f);
            const float nrm = xc * rsqrtf(var + 1e-6f);
            float gate;
            if (hh < 6) gate = siluf_(bf2f(RET[(size_t)row * 1536 + 1152 + cof]));
            else gate = sigmoidf_(bf2f(ML[(size_t)row * 1024 + 768 + (cof - 384)]));
            Y[(size_t)row * D + 384 + cof] = (bf16)f2bf(nrm * gate);
        }
    }
    LAS float* scr = (LAS float*)(F.lds + F.wave * 16640);
    const int nitL = NB * 6 * 32, nitC = last ? 0 : NB * 6 * 4;
    for (int it = gw; it < nitL + nitC; it += NGW) {
        const bf16* src; int L, rowbase, b, cb, tb;
        if (it < nitL) { b = it / 192; const int r = it % 192; cb = r / 32; tb = r % 32; L = LL; src = WSP(const bf16, WS_YHTL); rowbase = b * LL; }
        else { const int i2 = it - nitL; b = i2 / 24; const int r = i2 % 24; cb = r / 4; tb = r % 4; L = LC; src = WSP(const bf16, WS_YHTC); rowbase = TOKL + b * LC; }
        for (int cc = 0; cc < 64; ++cc) scr[cc * 65 + lane] = bf2f(src[((size_t)(b * 384 + cb * 64 + cc)) * L + tb * 64 + lane]);
        asm volatile("s_waitcnt lgkmcnt(0)" ::: "memory");
        for (int tt = 0; tt < 64; ++tt) Y[(size_t)(rowbase + tb * 64 + tt) * D + cb * 64 + lane] = (bf16)f2bf(scr[lane * 65 + tt]);
        asm volatile("s_waitcnt lgkmcnt(0)" ::: "memory");
    }
}

__device__ __forceinline__ void phase_norm_router(Frame& F) {
    const int gw = F.wg * NWAVES + F.wave, NGW = F.G * NWAVES, lane = F.lane;
    const float* g = inp(F, I_GFFN) + 1 * D; const float* wr = inp(F, I_ROUTER); const float* br = inp(F, I_ROUTERB);
    unsigned* cnt = WSP(unsigned, WS_CTL) + CW_CNT;
    for (int row = gw; row < TOKL; row += NGW) {
        float keep[16];
        norm_mod_row(xrow_ptr(F, row, false), g, mod_ptr(F, 1, row, 3), mod_ptr(F, 1, row, 4), WSP(bf16, WS_H) + (size_t)row * D, lane, keep);
        float lg[8];
#pragma unroll
        for (int e = 0; e < 8; ++e) lg[e] = 0.f;
#pragma unroll
        for (int j = 0; j < 4; ++j)
#pragma unroll
            for (int i = 0; i < 4; ++i) { const int k = 256 * j + 4 * lane + i; const f32x4 w0 = *(const f32x4*)(wr + k * 8), w1 = *(const f32x4*)(wr + k * 8 + 4); const float x = keep[4 * j + i];
                lg[0] += x * w0.x; lg[1] += x * w0.y; lg[2] += x * w0.z; lg[3] += x * w0.w; lg[4] += x * w1.x; lg[5] += x * w1.y; lg[6] += x * w1.z; lg[7] += x * w1.w; }
#pragma unroll
        for (int e = 0; e < 8; ++e) lg[e] = wave_sum(lg[e]) + br[e];
        int e0 = 0; float v0 = lg[0];
#pragma unroll
        for (int e = 1; e < 8; ++e) if (lg[e] > v0) { v0 = lg[e]; e0 = e; }
        int e1 = -1; float v1 = -3.0e38f;
#pragma unroll
        for (int e = 0; e < 8; ++e) if (e != e0 && lg[e] > v1) { v1 = lg[e]; e1 = e; }
        const float w1 = 1.f / (1.f + __expf(v0 - v1)), w0 = 1.f - w1;
        if (lane == 0) {
            const unsigned p0 = atomicAdd(cnt + e0, 1u), p1 = atomicAdd(cnt + e1, 1u);
            WSP(int, WS_TOPE)[row * 2] = e0; WSP(int, WS_TOPE)[row * 2 + 1] = e1;
            WSP(float, WS_TOPW)[row * 2] = w0; WSP(float, WS_TOPW)[row * 2 + 1] = w1;
            WSP(int, WS_TOPP)[row * 2] = (int)p0; WSP(int, WS_TOPP)[row * 2 + 1] = (int)p1;
        }
    }
}
__device__ __forceinline__ void phase_route_tables(Frame& F) {
    const unsigned* cnt = WSP(const unsigned, WS_CTL) + CW_CNT;
    int off[9]; off[0] = 0;
#pragma unroll
    for (int e = 0; e < 8; ++e) { const int c = (int)__hip_atomic_load(cnt + e, __ATOMIC_RELAXED, __HIP_MEMORY_SCOPE_AGENT); off[e + 1] = off[e] + ((c + 255) >> 8) * 256; }
    const int gt = F.wg * NTHR + F.tid, NGT = F.G * NTHR;
    int* rowidx = WSP(int, WS_ROWIDX); int* slot = WSP(int, WS_SLOT); int* tilee = WSP(int, WS_TILEE);
    for (int i = gt; i < MAXTILES * 256; i += NGT) {
        int e = 0;
#pragma unroll
        for (int q = 1; q < 8; ++q) if (i >= off[q]) e = q;
        const int c = (int)cnt[e];
        if (i >= off[8] || i - off[e] >= c) rowidx[i] = 0;
    }
    for (int i = gt; i < TOKL * 2; i += NGT) {
        const int e = WSP(const int, WS_TOPE)[i], pos = WSP(const int, WS_TOPP)[i];
        int o = 0;
#pragma unroll
        for (int q = 0; q < 8; ++q) if (e == q) o = off[q];
        const int s = o + pos; slot[i] = s; rowidx[s] = i >> 1;
    }
    for (int i = gt; i < MAXTILES + 1; i += NGT) {
        if (i == MAXTILES) tilee[MAXTILES] = off[8] >> 8;
        else { int e = 0;
#pragma unroll
            for (int q = 1; q < 8; ++q) if (i * 256 >= off[q]) e = q;
            tilee[i] = e; }
    }
}

__device__ __forceinline__ void moe_pass_gemm1_fast(Frame& F, int t0, int t1) {
    pg8::OrderMoe S; S.o.init(t1 - t0, NFF1 / 256, F.G, F.wg); S.rowidx = WSP(const int, WS_ROWIDX); S.tilee = WSP(const int, WS_TILEE); S.t0 = t0; S.bstride = (size_t)NFF1 * D; S.gather = true;
    EpiSwiglu E{WSP(bf16, WS_MACT), 0};
    pg8::gemm_phase(F.lds, WSP(const bf16, WS_H), D, WSP(const bf16, WS_MW13), D, D, S, E);
}
__device__ __forceinline__ void moe_pass_gemm2_fast(Frame& F, int t0, int t1) {
    pg8::OrderMoe S; S.o.init(t1 - t0, D / 256, F.G, F.wg); S.rowidx = WSP(const int, WS_ROWIDX); S.tilee = WSP(const int, WS_TILEE); S.t0 = t0; S.bstride = (size_t)D * DFF; S.gather = false;
    EpiBf16Out E{WSP(bf16, WS_EOUT), D, t0 * 256};
    pg8::gemm_phase(F.lds, WSP(const bf16, WS_MACT), DFF, WSP(const bf16, WS_MW2), DFF, DFF, S, E);
}
__device__ __forceinline__ void phase_final(Frame& F) {
    const int gw = F.wg * NWAVES + F.wave, NGW = F.G * NWAVES, lane = F.lane;
    const float* gf = inp(F, I_GFINAL); const bf16* eo = WSP(const bf16, WS_EOUT);
    for (int row = gw; row < TOKL; row += NGW) {
        const int s0 = WSP(const int, WS_SLOT)[row * 2], s1 = WSP(const int, WS_SLOT)[row * 2 + 1];
        const float w0 = WSP(const float, WS_TOPW)[row * 2], w1 = WSP(const float, WS_TOPW)[row * 2 + 1];
        const float* m5 = mod_ptr(F, 1, row, 5);
        float* xr = outp(F) + (size_t)row * D;
        f32x4 v[4]; float s = 0.f;
#pragma unroll
        for (int j = 0; j < 4; ++j) {
            const int c = 256 * j + 4 * lane;
            const f32x4 a = ld_bf16x4(eo + (size_t)s0 * D + c), b = ld_bf16x4(eo + (size_t)s1 * D + c), m = *(const f32x4*)(m5 + c);
            v[j] = *(const f32x4*)(xr + c) + m * (a * w0 + b * w1);
            s += (v[j].x * v[j].x + v[j].y * v[j].y) + (v[j].z * v[j].z + v[j].w * v[j].w);
        }
        const float r = rsqrtf(wave_sum(s) * (1.f / 1024.f) + 1e-6f);
#pragma unroll
        for (int j = 0; j < 4; ++j) { const int c = 256 * j + 4 * lane; const f32x4 g = *(const f32x4*)(gf + c); *(f32x4*)(xr + c) = v[j] * r * g; }
    }
}

#ifndef REP_WIN
#define REP_WIN 1
#endif
#ifndef REP_MIX
#define REP_MIX 1
#endif
#ifndef REP_GATE
#define REP_GATE 1
#endif
#ifndef REP_UP
#define REP_UP 1
#endif
#ifndef REP_FFN1
#define REP_FFN1 1
#endif
#ifndef REP_MOE
#define REP_MOE 1
#endif
#ifndef REP_NORM
#define REP_NORM 1
#endif
#ifndef REP_P0
#define REP_P0 1
#endif
__global__ void __launch_bounds__(NTHR, 2) hybrid_fwd(Params prm) {
    extern __shared__ __attribute__((aligned(16))) unsigned char lds_raw[];
    Frame F;
    F.lds = (LAS unsigned char*)lds_raw; F.ws = prm.ws;
    F.tid = threadIdx.x; F.lane = F.tid & 63; F.wave = __builtin_amdgcn_readfirstlane(F.tid >> 6); F.G = gridDim.x; F.wg = blockIdx.x;
    volatile LAS unsigned* MISC = (volatile LAS unsigned*)(F.lds + MISC_OFF);
    if (F.tid < 64) MISC[F.tid] = 0u;
    if (F.tid < 33) { const unsigned long long v = F.tid < 32 ? (unsigned long long)prm.in[F.tid] : (unsigned long long)prm.out; *(LAS unsigned long long*)(F.lds + PTAB_OFF + 8 * F.tid) = v; }
    __syncthreads();
    XcdBarrier bar = xcd_barrier_post(WSP(unsigned, WS_CTL) + CW_BAR, MISC + 8);
#define RELAUNDER() do { { unsigned long long _w = (unsigned long long)F.ws; asm volatile("" : "+s"(_w)); F.ws = (unsigned char*)_w; } \
        { unsigned _t = (unsigned)F.tid; asm volatile("" : "+v"(_t)); F.tid = (int)_t; F.lane = F.tid & 63; F.wave = __builtin_amdgcn_readfirstlane(F.tid >> 6); } \
        { unsigned _g = (unsigned)F.G, _b = (unsigned)F.wg; asm volatile("" : "+s"(_g), "+s"(_b)); F.G = (int)_g; F.wg = (int)_b; } \
        { unsigned _l = (unsigned)(size_t)F.lds; asm volatile("" : "+s"(_l)); F.lds = (LAS unsigned char*)(size_t)_l; } } while (0)
#define GRID_BAR() do { { unsigned long long _b = (unsigned long long)bar.bar; unsigned _x = bar.x; asm volatile("" : "+s"(_b), "+s"(_x)); bar.bar = (unsigned*)_b; bar.x = _x; } xcd_barrier(bar); RELAUNDER(); } while (0)

    for (int rp = 0; rp < REP_P0; ++rp) { phase_p0(F); write_bias(F);
    GRID_BAR(); }
#pragma unroll 1
    for (int layer = 0; layer < 2; ++layer) {
        const bool last = layer == 1;
        const int rows_all = TOK, rows_out = last ? TOKL : TOK;
        const float* modbase = WSP(const float, WS_MOD) + (size_t)layer * 17 * 6144;
        for (int rp = 0; rp < REP_NORM; ++rp) { phase_norm(F, layer, rows_all, !last, 0);
        GRID_BAR(); }
        for (int rp = 0; rp < REP_WIN; ++rp) {
        { EpiWin E{WSP(const float, WS_BIAS) + layer * NWP, WSP(bf16, WS_HYTL), WSP(bf16, WS_HYTC), WSP(bf16, WS_RET), WSP(bf16, WS_ML), WSP(float, WS_MLG)};
          gemm_fast(F, WSP(const bf16, WS_H), D, WSP(const bf16, WS_WIN), D, D, rows_all, NW1, E); }
        GRID_BAR(); }
        for (int rp = 0; rp < REP_MIX; ++rp) { phase_mix(F, layer);
        GRID_BAR(); }
        phase_combine(F, layer);
        GRID_BAR();
        for (int rp = 0; rp < REP_GATE; ++rp) {
        { EpiGate E{WSP(const float, WS_BIAS) + layer * NWP + NW1, WSP(bf16, WS_GATES)};
          gemm_fast(F, WSP(const bf16, WS_H), D, WSP(const bf16, WS_WIN) + (size_t)NW1 * D, D, D, rows_out, NGATE, E); }
        GRID_BAR(); }
        for (int rp = 0; rp < REP_UP; ++rp) {
        { EpiUp E{WSP(const bf16, WS_GATES), WSP(bf16, WS_H)};
          gemm_fast(F, WSP(const bf16, WS_Y), D, WSP(const bf16, WS_WUP), D, D, rows_out, D, E); }
        GRID_BAR(); }
        { EpiResid E{last ? outp(F) : inp(F, I_X), last ? WSP(const float, WS_XC) : inp(F, I_CTX), outp(F), WSP(float, WS_XC), modbase, 2};
          gemm_fast(F, WSP(const bf16, WS_H), D, WSP(const bf16, WS_WOUT), D, D, rows_out, D, E); }
        GRID_BAR();
        if (!last) {
            phase_norm(F, layer, rows_out, false, 3);
            { const int gw = F.wg * NWAVES + F.wave, NGW = F.G * NWAVES; LAS float* scr = (LAS float*)(F.lds + F.wave * 8704);
              conv_weights_ffn(inp(F, I_FW1), inp(F, I_FW3), inp(F, I_FW2), WSP(bf16, WS_W13), WSP(bf16, WS_W2), gw, NGW, scr, F.lane);
              conv_weights_win(F, 1, gw, NGW, scr);
              conv_weights_upout(F, 1, gw, NGW, scr); }
            GRID_BAR();
            for (int rp = 0; rp < REP_FFN1; ++rp) {
            { EpiSwiglu E{WSP(bf16, WS_ACT), 0};
              gemm_fast(F, WSP(const bf16, WS_H), D, WSP(const bf16, WS_W13), D, D, rows_out, NFF1, E); }
            GRID_BAR(); }
            { EpiResid E{outp(F), WSP(const float, WS_XC), outp(F), WSP(float, WS_XC), modbase, 5};
              gemm_fast(F, WSP(const bf16, WS_ACT), DFF, WSP(const bf16, WS_W2), DFF, DFF, rows_out, D, E); }
            GRID_BAR();
        }
    }
    phase_norm_router(F);
    { const int gw = F.wg * NWAVES + F.wave, NGW = F.G * NWAVES; LAS float* scr = (LAS float*)(F.lds + F.wave * 8704);
#pragma unroll 1
      for (int e = 0; e < NE; ++e)
          conv_weights_ffn(inp(F, I_MW1) + (size_t)e * D * DFF, inp(F, I_MW3) + (size_t)e * D * DFF, inp(F, I_MW2) + (size_t)e * DFF * D,
                           WSP(bf16, WS_MW13) + (size_t)e * NFF1 * D, WSP(bf16, WS_MW2) + (size_t)e * D * DFF, gw, NGW, scr, F.lane); }
    GRID_BAR();
    phase_route_tables(F);
    GRID_BAR();
    const int ntiles = __builtin_amdgcn_readfirstlane(WSP(const int, WS_TILEE)[MAXTILES]);
#pragma unroll 1
    for (int p = 0; p < NPASS; ++p) {
        const int t0 = p * PASS_TILES, t1 = min(ntiles, t0 + PASS_TILES);
        for (int rp = 0; rp < REP_MOE; ++rp) {
        if (t0 < t1) moe_pass_gemm1_fast(F, t0, t1);
        GRID_BAR();
        if (t0 < t1) moe_pass_gemm2_fast(F, t0, t1);
        GRID_BAR(); }
    }
    phase_final(F);
}

extern "C" void kernel_launch(void* const* d_in, const int* in_sizes, int n_in, void* d_out, int out_size, void* d_ws, size_t ws_size, hipStream_t stream) {
    static int grid = 0;
    if (grid == 0) {
        if (n_in != 32 || out_size != TOKL * D || ws_size < WS_END) { fprintf(stderr, "kernel_launch: unexpected arguments (n_in %d, out %d, ws %zu)\n", n_in, out_size, ws_size); grid = -1; return; }
        int dev = 0, cus = 0;
        if (hipGetDevice(&dev) != hipSuccess || hipDeviceGetAttribute(&cus, hipDeviceAttributeMultiprocessorCount, dev) != hipSuccess) { grid = -1; return; }
        if (hipFuncSetAttribute((const void*)hybrid_fwd, hipFuncAttributeMaxDynamicSharedMemorySize, LDS_BYTES) != hipSuccess) { grid = -1; return; }
        int per_cu = 0;
        (void)hipOccupancyMaxActiveBlocksPerMultiprocessor(&per_cu, (const void*)hybrid_fwd, NTHR, LDS_BYTES);
        (void)hipGetLastError();
        grid = cus;
    }
    if (grid < 0) return;
    (void)hipMemsetAsync((char*)d_ws + WS_CTL, 0, CTL_ZERO_BYTES, stream);
    Params p{};
    for (int i = 0; i < 32; ++i) p.in[i] = (const float*)d_in[i];
    p.out = (float*)d_out; p.ws = (unsigned char*)d_ws;
    hipLaunchKernelGGL(hybrid_fwd, dim3(grid), dim3(NTHR), LDS_BYTES, stream, p);
}
```

```cpp
#include <hip/hip_runtime.h>
#include <stdint.h>
#include <stdio.h>

#define LAS __attribute__((address_space(3)))
typedef unsigned short bf16;
typedef short bf16x8 __attribute__((ext_vector_type(8)));
typedef float f32x4 __attribute__((ext_vector_type(4)));
typedef unsigned u32x4 __attribute__((ext_vector_type(4)));
typedef unsigned u32x2 __attribute__((ext_vector_type(2)));

constexpr int D = 1024, NB = 16, LL = 2048, LC = 256;
constexpr int TOKL = NB * LL, TOKC = NB * LC, TOK = TOKL + TOKC;
constexpr int HYW = 384, RETW = 384, MLW = 256;
constexpr int NIN = 6800, NW1 = 3840, NGATE = 3072, NWP = 6912;
constexpr int DFF = 2816, NFF1 = 5632, NE = 8;
constexpr int NWAVES = 8, NTHR = 512;
constexpr int MAXTILES = 272, PASS_TILES = 64, NPASS = 5;

constexpr size_t MiB = 1u << 20;
constexpr size_t WS_CTL = 0, CTL_ZERO_BYTES = 1 * MiB;
constexpr size_t WS_MOD = 1 * MiB;
constexpr size_t WS_BIAS = 2 * MiB;
constexpr size_t WS_ROPE = 2 * MiB + 256 * 1024;
constexpr size_t WS_TOPE = 3 * MiB;
constexpr size_t WS_TOPW = 3 * MiB + 256 * 1024;
constexpr size_t WS_TOPP = 3 * MiB + 512 * 1024;
constexpr size_t WS_SLOT = 3 * MiB + 768 * 1024;
constexpr size_t WS_ROWIDX = 4 * MiB;
constexpr size_t WS_TILEE = 4 * MiB + 512 * 1024;
constexpr size_t WS_FTL = 5 * MiB;
constexpr size_t WS_FTC = 17 * MiB;
constexpr size_t WS_WIN = 18 * MiB;
constexpr size_t WS_WUP = 32 * MiB;
constexpr size_t WS_WOUT = 34 * MiB;
constexpr size_t WS_XC = 36 * MiB;
constexpr size_t WS_H = 52 * MiB;
constexpr size_t WS_Y = 124 * MiB;
constexpr size_t WS_U = 196 * MiB;
constexpr size_t WS_RET = WS_U;
constexpr size_t WS_ML = WS_U + 108 * MiB;
constexpr size_t WS_MLG = WS_U + 180 * MiB;
constexpr size_t WS_OB = WS_U + 183 * MiB;
constexpr size_t WS_YHTL = WS_U + 228 * MiB;
constexpr size_t WS_YHTC = WS_U + 252 * MiB;
constexpr size_t WS_HYTL = WS_U + 255 * MiB;
constexpr size_t WS_HYTC = WS_U + 327 * MiB;
constexpr size_t WS_END = WS_U + 336 * MiB;
constexpr size_t WS_GATES = WS_U;
constexpr size_t WS_ACT = WS_U;
constexpr size_t WS_W13 = WS_U + 204 * MiB;
constexpr size_t WS_W2 = WS_U + 216 * MiB;
constexpr size_t WS_MW13 = WS_Y;
constexpr size_t WS_MW2 = WS_Y + 88 * MiB;
constexpr size_t WS_MACT = WS_Y + 132 * MiB;
constexpr size_t WS_EOUT = WS_Y + 220 * MiB;
static_assert(WS_EOUT + (size_t)MAXTILES * 256 * 1024 * 2 <= WS_END, "map");
static_assert(WS_GATES + (size_t)TOK * NGATE * 2 <= WS_YHTL, "gates overlay");

constexpr int CW_BAR = 4096;
constexpr int CW_CNT = 16384;

constexpr int LDS_BYTES = 147456;
constexpr int MISC_OFF = 147456 - 256;

__device__ __forceinline__ float bf2f(bf16 b) { return __uint_as_float(((unsigned)b) << 16); }
__device__ __forceinline__ unsigned f2bf(float f) { unsigned u = __float_as_uint(f); return (u + 0x7fffu + ((u >> 16) & 1u)) >> 16; }
__device__ __forceinline__ unsigned pk2(float lo, float hi) { return f2bf(lo) | (f2bf(hi) << 16); }
__device__ __forceinline__ float wave_sum(float v) {
#pragma unroll
    for (int o = 1; o < 64; o <<= 1) v += __shfl_xor(v, o);
    return v;
}
__device__ __forceinline__ float sigmoidf_(float x) { return 1.0f / (1.0f + __expf(-x)); }
__device__ __forceinline__ float siluf_(float x) { return x / (1.0f + __expf(-x)); }

#define XB_TMO      128
#define XB_XCNT(j)  (256  + 64 * (j))
#define XB_XSUB(j)  (1280 + 64 * (j))
#define XB_XGEN(j)  (2304 + 64 * (j))
#define XB_TOP      3328
#define XB_TOPGEN   3392
#define XCD_BAR_WORDS 3456
#define XB_SPIN_CAP (1u << 22)
__device__ __forceinline__ unsigned xb_ld(unsigned* p)              { return __hip_atomic_load(p, __ATOMIC_RELAXED, __HIP_MEMORY_SCOPE_AGENT); }
__device__ __forceinline__ unsigned xb_add(unsigned* p, unsigned v) { return __hip_atomic_fetch_add(p, v, __ATOMIC_RELAXED, __HIP_MEMORY_SCOPE_AGENT); }
__device__ __forceinline__ unsigned xb_xcc_id() { return (unsigned)__builtin_amdgcn_s_getreg((3 << 11) | 20) & 0xFu; }
#define XB_SPIN(cond, bar) do { unsigned _sp = 0; while (cond) { __builtin_amdgcn_s_sleep(1); \
    if ((++_sp & 255u) == 0u) { if (xb_ld(&(bar)[XB_TMO])) break; if (_sp > XB_SPIN_CAP) { atomicAdd(&(bar)[XB_TMO], 1u); break; } } } } while (0)
struct XcdBarrier { unsigned* bar; unsigned x; volatile LAS unsigned* st; };
__device__ __forceinline__ XcdBarrier xcd_barrier_post(unsigned* bar, volatile LAS unsigned* st) {
    XcdBarrier b; b.bar = bar; b.x = xb_xcc_id(); b.st = st;
    if (threadIdx.x == 0) (void)xb_add(&bar[XB_XCNT(b.x)], 1u);
    return b;
}
__device__ __forceinline__ void xcd_barrier_complete(unsigned* bar, unsigned x, unsigned& nloc, unsigned& nx) {
    const unsigned G = gridDim.x * gridDim.y * gridDim.z;
    unsigned sum, cnt, mine, sp = 0u;
    for (;;) {
        sum = 0u; cnt = 0u; mine = 0u;
#pragma unroll 1
        for (unsigned j = 0; j < 16; ++j) { const unsigned c = xb_ld(&bar[XB_XCNT(j)]); sum += c; cnt += (c > 0u) ? 1u : 0u; }
        mine = xb_ld(&bar[XB_XCNT(x)]);
        if (sum == G) break;
        __builtin_amdgcn_s_sleep(1);
        if ((++sp & 255u) == 0u) { if (xb_ld(&bar[XB_TMO])) break; if (sp > XB_SPIN_CAP) { atomicAdd(&bar[XB_TMO], 1u); break; } }
    }
    nloc = mine > 0u ? mine : 1u; nx = cnt > 0u ? cnt : 1u;
}
__device__ __forceinline__ void xcd_barrier(const XcdBarrier& b) {
    asm volatile("s_waitcnt vmcnt(0)" ::: "memory");
    __syncthreads();
    if (threadIdx.x == 0) {
        unsigned* bar = b.bar;
        __builtin_amdgcn_s_waitcnt(0);
        unsigned nloc = b.st[0], nx = b.st[1];
        if (nloc == 0u) { xcd_barrier_complete(bar, b.x, nloc, nx); b.st[0] = nloc; b.st[1] = nx; }
        const unsigned old = xb_add(&bar[XB_XSUB(b.x)], 1u);
        const unsigned gen = old / nloc;
        if (old + 1u == (gen + 1u) * nloc) {
            __builtin_amdgcn_fence(__ATOMIC_RELEASE, "agent");
            asm volatile("s_waitcnt vmcnt(0)" ::: "memory");
            const unsigned og = xb_add(&bar[XB_TOP], 1u);
            const unsigned tg = og / nx;
            if (og + 1u == (tg + 1u) * nx) xb_add(&bar[XB_TOPGEN], 1u);
            else XB_SPIN(xb_ld(&bar[XB_TOPGEN]) == tg, bar);
            __builtin_amdgcn_fence(__ATOMIC_ACQUIRE, "agent");
            xb_add(&bar[XB_XGEN(b.x)], 1u);
            asm volatile("s_waitcnt vmcnt(0)" ::: "memory");
        } else {
            XB_SPIN(xb_ld(&bar[XB_XGEN(b.x)]) == gen, bar);
            __builtin_amdgcn_fence(__ATOMIC_ACQUIRE, "agent");
            asm volatile("s_waitcnt vmcnt(0)" ::: "memory");
        }
    }
    __syncthreads();
}

struct Params { const float* in[32]; float* out; unsigned char* ws; };
enum { I_X = 0, I_C, I_CTX, I_CCTX, I_WMOD, I_BMOD, I_GMIX, I_GFFN, I_WIN, I_BIN, I_HYCONV, I_HYF1, I_HYFB1, I_HYF2, I_HYFB2, I_HYF3, I_HYDECAY,
       I_HYSKIP, I_RETDECAY, I_MLCONV, I_MLGB, I_WUP, I_WOUT, I_FW1, I_FW3, I_FW2, I_ROUTER, I_ROUTERB, I_MW1, I_MW3, I_MW2, I_GFINAL };

struct Frame {
    LAS unsigned char* lds;
    unsigned char* ws;
    int tid, lane, wave, G, wg;
};
#define WSP(T, off) ((T*)(F.ws + (off)))
constexpr int PTAB_OFF = 147456 - 1024;
__device__ __forceinline__ const float* inp(const Frame& F, int i) {
    const LAS unsigned* t = (const LAS unsigned*)(F.lds + PTAB_OFF) + 2 * i;
    const unsigned lo = __builtin_amdgcn_readfirstlane(t[0]), hi = __builtin_amdgcn_readfirstlane(t[1]);
    return (const float*)(((unsigned long long)hi << 32) | lo);
}
__device__ __forceinline__ float* outp(const Frame& F) { return (float*)inp(F, 32); }

__device__ __forceinline__ int row_batch(int row) { return row < TOKL ? (row >> 11) : ((row - TOKL) >> 8); }
__device__ __forceinline__ const float* mod_ptr(const Frame& F, int layer, int row, int which) {
    const int r = row < TOKL ? (row >> 11) : 16;
    return WSP(const float, WS_MOD) + ((size_t)(layer * 17 + r) * 6 + which) * 1024;
}

template <class RowMap>
__device__ __forceinline__ void tr_item(const float* W, int K, int N, bf16* WT, int ldT, RowMap rm, LAS float* scr, int item, int lane) {
    const int nblk = (N + 31) / 32, kb = item / nblk, nb = item % nblk, k0 = 64 * kb, n0 = 32 * nb;
#pragma unroll 8
    for (int i = 0; i < 32; ++i) { const int kk = 2 * i + (lane >> 5); const int n = n0 + (lane & 31); scr[kk * 33 + (lane & 31)] = (n < N) ? W[(size_t)(k0 + kk) * N + n] : 0.f; }
    asm volatile("s_waitcnt lgkmcnt(0)" ::: "memory");
    const int c = lane & 7;
#pragma unroll
    for (int j = 0; j < 4; ++j) { const int nl = (lane >> 3) + 8 * j; const int n = n0 + nl; const LAS float* s = scr + (8 * c) * 33 + nl;
        u32x4 o; o.x = pk2(s[0 * 33], s[1 * 33]); o.y = pk2(s[2 * 33], s[3 * 33]); o.z = pk2(s[4 * 33], s[5 * 33]); o.w = pk2(s[6 * 33], s[7 * 33]);
        if (n < N) *(u32x4*)(WT + (size_t)rm(n) * ldT + k0 + 8 * c) = o; }
    asm volatile("s_waitcnt lgkmcnt(0)" ::: "memory");
}
struct RmId { __device__ __forceinline__ int operator()(int n) const { return n; } };
__device__ __forceinline__ int win_row(int n) {
    if (n < 1152) return n;
    if (n < 2688) return 1280 + (n - 1152);
    if (n < 3712) return 2816 + (n - 2688);
    if (n < 3728) return 1152 + (n - 3712);
    return 3840 + (n - 3728);
}
struct RmWin { __device__ __forceinline__ int operator()(int n) const { return win_row(n); } };
struct RmW1 { __device__ __forceinline__ int operator()(int n) const { return (n >> 4) * 32 + (n & 15); } };
struct RmW3 { __device__ __forceinline__ int operator()(int n) const { return (n >> 4) * 32 + 16 + (n & 15); } };

__device__ __forceinline__ void conv_weights_win(Frame& F, int layer, int gw, int NGW, LAS float* scr) {
    const float* W = inp(F, I_WIN) + (size_t)layer * D * NIN;
    const int items = (D / 64) * ((NIN + 31) / 32);
    for (int it = gw; it < items; it += NGW) tr_item(W, D, NIN, WSP(bf16, WS_WIN), D, RmWin(), scr, it, F.lane);
    bf16* wt = WSP(bf16, WS_WIN);
    for (int i = gw * 64 + F.lane; i < 112 * 1024 / 8; i += NGW * 64) *(u32x4*)(wt + (size_t)1168 * 1024 + (size_t)i * 8) = (u32x4){0u, 0u, 0u, 0u};
}
__device__ __forceinline__ void conv_weights_upout(Frame& F, int layer, int gw, int NGW, LAS float* scr) {
    const int items = (D / 64) * (D / 32);
    for (int it = gw; it < items; it += NGW) tr_item(inp(F, I_WUP) + (size_t)layer * D * D, D, D, WSP(bf16, WS_WUP), D, RmId(), scr, it, F.lane);
    for (int it = gw; it < items; it += NGW) tr_item(inp(F, I_WOUT) + (size_t)layer * D * D, D, D, WSP(bf16, WS_WOUT), D, RmId(), scr, it, F.lane);
}
__device__ __forceinline__ void conv_weights_ffn(const float* w1, const float* w3, const float* w2, bf16* w13t, bf16* w2t, int gw, int NGW, LAS float* scr, int lane) {
    const int i1 = (D / 64) * (DFF / 32), i2 = (DFF / 64) * (D / 32);
    for (int it = gw; it < i1; it += NGW) tr_item(w1, D, DFF, w13t, D, RmW1(), scr, it, lane);
    for (int it = gw; it < i1; it += NGW) tr_item(w3, D, DFF, w13t, D, RmW3(), scr, it, lane);
    for (int it = gw; it < i2; it += NGW) tr_item(w2, DFF, D, w2t, DFF, RmId(), scr, it, lane);
}

__device__ __forceinline__ void filter_item(Frame& F, int layer, int L, bf16* FT  , int pb, int ch, LAS float* tile  ) {
    const float* f1 = inp(F, I_HYF1) + layer * 33 * 64; const float* fb1 = inp(F, I_HYFB1) + layer * 64;
    const float* f2 = inp(F, I_HYF2) + layer * 64 * 64; const float* fb2 = inp(F, I_HYFB2) + layer * 64;
    const float* f3 = inp(F, I_HYF3) + (size_t)layer * 64 * 1536; const float* dec = inp(F, I_HYDECAY) + layer * 1536;
    const int lane = F.lane, n = ch * 64 + lane;
    const float b1 = fb1[lane], b2 = fb2[lane], adec = fabsf(dec[n]);
    for (int pl = 0; pl < 64; ++pl) {
        const int pos = pb * 64 + pl;
        const float t = (float)pos / (float)(L - 1);
        const float w = 6.283185307179586f * (float)pos / (float)L;
        float feat = 0.f;
        if (lane == 0) feat = t;
        else if (lane < 17) { const float band = 1e-4f + (float)(lane - 1) * ((15.0f - 1e-4f) / 15.0f); feat = cosf(w * band); }
        else if (lane < 33) { const float band = 1e-4f + (float)(lane - 17) * ((15.0f - 1e-4f) / 15.0f); feat = -sinf(w * band); }
        float a1 = b1;
        for (int i = 0; i < 33; ++i) a1 += __shfl(feat, i) * f1[i * 64 + lane];
        const float h1 = sinf(a1);
        float a2 = b2;
        for (int i = 0; i < 64; ++i) a2 += __shfl(h1, i) * f2[i * 64 + lane];
        const float h2 = sinf(a2);
        float a3 = 0.f;
        for (int i = 0; i < 64; ++i) a3 += __shfl(h2, i) * f3[i * 1536 + n];
        tile[pl * 65 + lane] = a3 * expf(-t * adec);
    }
    asm volatile("s_waitcnt lgkmcnt(0)" ::: "memory");
    const int pos = pb * 64 + lane;
    for (int cl = 0; cl < 64; ++cl) {
        const int nn = ch * 64 + cl, o = nn / 768, dir = (nn / 384) & 1, c = nn % 384;
        bf16* dst = FT + (size_t)(o * 384 + c) * (2 * L);
        const float v = tile[lane * 65 + cl];
        if (dir == 0) dst[L - pos] = (bf16)f2bf(v);
        else if (pos > 0) dst[L + pos] = (bf16)f2bf(v);
    }
    asm volatile("s_waitcnt lgkmcnt(0)" ::: "memory");
}

__device__ __forceinline__ void phase_p0(Frame& F) {
    const int gw = F.wg * NWAVES + F.wave, NGW = F.G * NWAVES;
    LAS float* sl = (LAS float*)F.lds;
    LAS float* red = (LAS float*)(F.lds + 17 * 4096);
    for (int i = F.tid; i < 17 * 1024; i += NTHR) { const int r = i >> 10, k = i & 1023; const float v = r < 16 ? inp(F, I_C)[r * 1024 + k] : inp(F, I_CCTX)[k]; sl[i] = siluf_(v); }
    __syncthreads();
    for (int item = F.wg; item < 2 * 384; item += F.G) {
        const int layer = item / 384, n0 = (item % 384) * 16, j = F.tid & 15, kp = F.tid >> 4;
        const float* W = inp(F, I_WMOD) + (size_t)layer * D * 6144;
        float acc[17];
#pragma unroll
        for (int r = 0; r < 17; ++r) acc[r] = 0.f;
        for (int k = kp * 32; k < kp * 32 + 32; ++k) { const float w = W[(size_t)k * 6144 + n0 + j];
#pragma unroll
            for (int r = 0; r < 17; ++r) acc[r] += sl[r * 1024 + k] * w; }
#pragma unroll
        for (int r = 0; r < 17; ++r) red[(kp * 17 + r) * 16 + j] = acc[r];
        __syncthreads();
        if (F.tid < 272) { const int r = F.tid >> 4, jj = F.tid & 15; float s = inp(F, I_BMOD)[layer * 6144 + n0 + jj];
            for (int q = 0; q < 32; ++q) s += red[(q * 17 + r) * 16 + jj];
            WSP(float, WS_MOD)[(size_t)(layer * 17 + r) * 6144 + n0 + jj] = s; }
        __syncthreads();
    }
    __syncthreads();
    LAS float* scr = (LAS float*)(F.lds + F.wave * 8704);
    conv_weights_win(F, 0, gw, NGW, scr);
    conv_weights_upout(F, 0, gw, NGW, scr);
    for (int i = gw * 64 + F.lane; i < 2048 * 32; i += NGW * 64) {
        const int t = i >> 5, j = i & 31, half = j >> 4, ii = j & 15;
        const float inv = 1.0f / powf(10000.0f, (float)ii / 16.0f);
        const float ang = (float)(half == 0 ? (t >> 6) : (t & 63)) * inv;
        WSP(float, WS_ROPE)[t * 64 + half * 32 + ii] = cosf(ang);
        WSP(float, WS_ROPE)[t * 64 + half * 32 + 16 + ii] = sinf(ang);
    }
    __syncthreads();
    LAS float* ftile = (LAS float*)(F.lds + F.wave * 16640);
    for (int it = gw; it < 1536 + 96; it += NGW) {
        if (it < 1536) { const int layer = it / 768, r = it % 768; filter_item(F, layer, LL, WSP(bf16, WS_FTL) + (size_t)layer * 2 * 384 * 4096, r / 24, r % 24, ftile); }
        else { const int r = it - 1536; filter_item(F, 0, LC, WSP(bf16, WS_FTC), r / 24, r % 24, ftile); }
    }
}
__device__ __forceinline__ void write_bias(Frame& F) {
    const int gt = (F.wg * NWAVES + F.wave) * 64 + F.lane, NGT = F.G * NTHR;
    for (int i = gt; i < 2 * NWP; i += NGT) {
        const int l = i / NWP, r = i % NWP; float v = 0.f;
        int n = -1;
        if (r < 1152) n = r; else if (r < 1168) n = 3712 + (r - 1152); else if (r < 1280) n = -1; else if (r < 2816) n = 1152 + (r - 1280); else if (r < 3840) n = 2688 + (r - 2816); else n = 3728 + (r - 3840);
        if (n >= 0) v = inp(F, I_BIN)[l * NIN + n];
        WSP(float, WS_BIAS)[i] = v;
    }
}

__device__ __forceinline__ void norm_mod_row(const float* xrow, const float* g, const float* shift, const float* scale, bf16* orow, int lane, float* keep  ) {
    f32x4 v[4]; float s = 0.f;
#pragma unroll
    for (int j = 0; j < 4; ++j) { v[j] = *(const f32x4*)(xrow + 256 * j + 4 * lane); s += (v[j].x * v[j].x + v[j].y * v[j].y) + (v[j].z * v[j].z + v[j].w * v[j].w); }
    const float r = rsqrtf(wave_sum(s) * (1.0f / 1024.0f) + 1e-6f);
#pragma unroll
    for (int j = 0; j < 4; ++j) {
        const f32x4 gg = *(const f32x4*)(g + 256 * j + 4 * lane), sh = *(const f32x4*)(shift + 256 * j + 4 * lane), sc = *(const f32x4*)(scale + 256 * j + 4 * lane);
        f32x4 o;
        o.x = (v[j].x * r * gg.x) * (1.f + sc.x) + sh.x; o.y = (v[j].y * r * gg.y) * (1.f + sc.y) + sh.y;
        o.z = (v[j].z * r * gg.z) * (1.f + sc.z) + sh.z; o.w = (v[j].w * r * gg.w) * (1.f + sc.w) + sh.w;
        if (keep) { keep[4 * j + 0] = o.x; keep[4 * j + 1] = o.y; keep[4 * j + 2] = o.z; keep[4 * j + 3] = o.w; }
        u32x2 w; w.x = pk2(o.x, o.y); w.y = pk2(o.z, o.w);
        *(u32x2*)(orow + 256 * j + 4 * lane) = w;
    }
}
__device__ __forceinline__ const float* xrow_ptr(const Frame& F, int row, bool from_input) {
    if (row < TOKL) return (from_input ? inp(F, I_X) : outp(F)) + (size_t)row * D;
    return (from_input ? inp(F, I_CTX) : WSP(const float, WS_XC)) + (size_t)(row - TOKL) * D;
}
__device__ __forceinline__ void phase_norm(Frame& F, int layer, int nrows, bool from_input, int which) {
    const int gw = F.wg * NWAVES + F.wave, NGW = F.G * NWAVES;
    const float* g = inp(F, which == 0 ? I_GMIX : I_GFFN) + layer * D;
    for (int row = gw; row < nrows; row += NGW)
        norm_mod_row(xrow_ptr(F, row, from_input), g, mod_ptr(F, layer, row, which), mod_ptr(F, layer, row, which + 1), WSP(bf16, WS_H) + (size_t)row * D, F.lane, nullptr);
}

namespace pg8 {
constexpr int BM = 256, BK = 64, HALF = 128, HTB = HALF * BK * 2, STAGE_BYTES = 8 * HTB, NXCD = 8, WGM = 8;
__device__ __forceinline__ int lds_byte(int r, int c) { const int st = (r >> 4) * 2 + (c >> 5), rr = r & 15, cc = c & 31, ob = rr * 64 + cc * 2; return st * 1024 + (ob ^ (((ob >> 9) & 1) << 5)); }
__device__ __forceinline__ void stage_rc(int b, int& R, int& C) { const int st = b / 1024, sb = b % 1024, swz = sb ^ (((sb >> 9) & 1) << 5); R = (st >> 1) * 16 + swz / 64; C = (st & 1) * 32 + (swz % 64) / 2; }
struct Unit { int pm, pn; };
struct OrderPlain {
    static constexpr bool GATHER = false;
    int nM, nN, nwg, G, c;
    __device__ __forceinline__ void init(int nM_, int nN_, int G_, int c_) { nM = nM_; nN = nN_; nwg = nM * nN; G = G_; c = c_; }
    __device__ __forceinline__ bool next(int i, Unit& u) const {
        const long L = (long)i * G + c; if (L >= nwg) return false;
        int wgid = (int)L; { const int q = nwg / NXCD, r = nwg % NXCD, xcd = wgid % NXCD, off = wgid / NXCD; wgid = (xcd < r ? xcd * (q + 1) : r * (q + 1) + (xcd - r) * q) + off; }
        const int nig = WGM * nN, gid = wgid / nig, fm = gid * WGM, gsz = (nM - fm) < WGM ? (nM - fm) : WGM;
        u.pm = fm + ((wgid % nig) % gsz); u.pn = (wgid % nig) / gsz; return true;
    }
    __device__ __forceinline__ int arow(int r) const { return r; }
    __device__ __forceinline__ size_t boff(const Unit&) const { return 0; }
};
struct OrderMoe {
    static constexpr bool GATHER = true;
    OrderPlain o; const int* rowidx; const int* tilee; int t0; size_t bstride; bool gather;
    __device__ __forceinline__ bool next(int i, Unit& u) const { return o.next(i, u); }
    __device__ __forceinline__ int arow(int r) const { return gather ? rowidx[t0 * 256 + r] : r; }
    __device__ __forceinline__ size_t boff(const Unit& u) const { return (size_t)tilee[t0 + u.pm] * bstride; }
};

template <class Epi, class Sched>
__device__ __forceinline__ void gemm_phase(LAS unsigned char* lds, const bf16* A, int lda, const bf16* Bt, int ldb, int K, const Sched& S, const Epi& E) {
    unsigned tid_u = threadIdx.x; asm volatile("" : "+v"(tid_u));
    const int tid = (int)tid_u, wid = __builtin_amdgcn_readfirstlane(tid >> 6), lane = tid & 63, wr = wid >> 2, wc = wid & 3, fr = lane & 15, fq = lane >> 4;
    const int nt = K / BK;
    unsigned voffB[2];
    { int sR[2], sC[2];
#pragma unroll
      for (int i = 0; i < 2; ++i) { stage_rc(tid * 16 + i * 8192, sR[i], sC[i]); voffB[i] = (unsigned)(sR[i] * ldb + sC[i]) * 2u; } }
#define PG8_GATHER_OFFS(pm_) do { unsigned _t = (unsigned)tid; asm volatile("" : "+v"(_t)); _Pragma("unroll") for (int i = 0; i < 2; ++i) { int _R, _C; stage_rc((int)_t * 16 + i * 8192, _R, _C); \
        vc0[i] = (unsigned)((size_t)S.arow((pm_) * BM + _R) * lda + _C) * 2u; vc1[i] = (unsigned)((size_t)S.arow((pm_) * BM + HALF + _R) * lda + _C) * 2u; } } while (0)
    const size_t kstep = (size_t)(BK * 2);
    const size_t hstepB = (size_t)HALF * ldb * 2, tstepB = 2 * hstepB;
    const unsigned ldsw = (unsigned)wid * 1024u;
    const int aoff = lds_byte(wr * 64 + fr, fq * 8), boff = lds_byte(wc * 32 + fr, fq * 8);
#define PG8_SA(b, h) (((b) * 2 + (h)) * HTB)
#define PG8_SB(b, h) ((4 + (b) * 2 + (h)) * HTB)
#define PG8_STAGE2(bufoff, gbase, v0, v1) do { \
        __builtin_amdgcn_global_load_lds((const unsigned*)((const char*)(gbase) + (v0)), (LAS unsigned*)(lds + (bufoff) + ldsw), 16, 0, 0); \
        __builtin_amdgcn_global_load_lds((const unsigned*)((const char*)(gbase) + (v1)), (LAS unsigned*)(lds + (bufoff) + ldsw + 8192), 16, 0, 0); } while (0)
#define PG8_STAGEB(bufoff, gbase) PG8_STAGE2(bufoff, gbase, voffB[0], voffB[1])
#define PG8_LDA(dst, b, h) do { _Pragma("unroll") for (int m = 0; m < 4; ++m) _Pragma("unroll") for (int k = 0; k < 2; ++k) dst[m][k] = *(const LAS bf16x8*)(lds + PG8_SA(b, h) + aoff + m * 2048 + k * 1024); } while (0)
#define PG8_LDB(dst, b, h) do { _Pragma("unroll") for (int n = 0; n < 2; ++n) _Pragma("unroll") for (int k = 0; k < 2; ++k) dst[n][k] = *(const LAS bf16x8*)(lds + PG8_SB(b, h) + boff + n * 2048 + k * 1024); } while (0)
#define PG8_MMA(ai, bj, At, Bt_) do { __builtin_amdgcn_s_setprio(1); _Pragma("unroll") for (int m = 0; m < 4; ++m) _Pragma("unroll") for (int n = 0; n < 2; ++n) _Pragma("unroll") for (int k = 0; k < 2; ++k) \
        acc[ai][bj][m][n] = __builtin_amdgcn_mfma_f32_16x16x32_bf16(Bt_[n][k], At[m][k], acc[ai][bj][m][n], 0, 0, 0); __builtin_amdgcn_s_setprio(0); } while (0)
#define PG8_WAIT_V(n) asm volatile("s_waitcnt vmcnt(" #n ")" ::: "memory")
#define PG8_WAIT_L(n) asm volatile("s_waitcnt lgkmcnt(" #n ")" ::: "memory")
#define PG8_BAR __builtin_amdgcn_s_barrier()
#define PG8_SCHED __builtin_amdgcn_sched_barrier(0)
    Unit cur, nxt; int ui = 0;
    if (!S.next(0, cur)) return;
    f32x4 acc[2][2][4][2];
#pragma unroll
    for (int a = 0; a < 2; ++a)
#pragma unroll
        for (int b = 0; b < 2; ++b)
#pragma unroll
            for (int m = 0; m < 4; ++m)
#pragma unroll
                for (int n = 0; n < 2; ++n) acc[a][b][m][n] = (f32x4){0.f, 0.f, 0.f, 0.f};
    bf16x8 At[4][2], B0[2][2], B1[2][2];
    constexpr bool GA = Sched::GATHER;
    const size_t hstepA = GA ? 0 : (size_t)HALF * lda * 2, tstepA = (size_t)BM * lda * 2;
    unsigned vc0[2], vc1[2];
    if constexpr (GA) { PG8_GATHER_OFFS(cur.pm); }
    else { int sR, sC;
#pragma unroll
        for (int i = 0; i < 2; ++i) { stage_rc(tid * 16 + i * 8192, sR, sC); vc0[i] = (unsigned)(sR * lda + sC) * 2u; vc1[i] = 0u; } }
#define VC0(i) vc0[i]
#define VC1(i) (GA ? vc1[i] : vc0[i])
#define VN0(i) vc0[i]
#define VN1(i) VC1(i)
    const char* cA = GA ? (const char*)A : (const char*)A + (size_t)cur.pm * tstepA;
    const char* cB = (const char*)Bt + S.boff(cur) * 2 + (size_t)cur.pn * tstepB;
    PG8_STAGEB(PG8_SB(0, 0), cB); PG8_STAGE2(PG8_SA(0, 0), cA, VC0(0), VC0(1)); PG8_STAGEB(PG8_SB(0, 1), cB + hstepB); PG8_STAGE2(PG8_SA(0, 1), cA + hstepA, VC1(0), VC1(1));
    if (wr == 1) PG8_BAR;
    PG8_WAIT_V(4); PG8_BAR;
    PG8_STAGEB(PG8_SB(1, 0), cB + kstep); PG8_STAGE2(PG8_SA(1, 0), cA + kstep, VC0(0), VC0(1)); PG8_STAGEB(PG8_SB(1, 1), cB + hstepB + kstep);
    PG8_WAIT_V(6); PG8_BAR;
    for (;;) {
        const bool has_next = S.next(ui + 1, nxt);
        const char* nB = cB; const char* nA = cA;
        if (has_next) {
            nB = (const char*)Bt + S.boff(nxt) * 2 + (size_t)nxt.pn * tstepB;
            if constexpr (!GA) nA = (const char*)A + (size_t)nxt.pm * tstepA;
        }
        for (int t = 0; t < nt; t += 2) {
            const bool last = (t == nt - 2);
            if constexpr (Epi::HORNER) {
                if (t == 6 || t == 12) {
                    asm volatile("" ::: "memory");
                    const int seg = (t == 6) ? 0 : 1;
                    int hpm = cur.pm, hpn = cur.pn; asm volatile("" : "+s"(hpm), "+s"(hpn));
                    unsigned hln = (unsigned)lane; asm volatile("" : "+v"(hln)); const int hfr = (int)(hln & 15u), hfq = (int)(hln >> 4);
#pragma unroll
                    for (int ai = 0; ai < 2; ++ai) {
                        u32x2 ga[4][2][2], gb[4][2][2];
#pragma unroll
                        for (int m = 0; m < 4; ++m)
#pragma unroll
                            for (int bj = 0; bj < 2; ++bj)
#pragma unroll
                                for (int n = 0; n < 2; ++n) {
                                    const int row = hpm * BM + ai * HALF + wr * 64 + m * 16 + hfr, col = hpn * BM + bj * HALF + wc * 32 + n * 16 + 4 * hfq;
                                    ga[m][bj][n] = E.gate(seg, row, col); gb[m][bj][n] = E.gate(seg + 1, row, col);
                                }
                        asm volatile("" : "+v"(ga[0][0][0]), "+v"(ga[0][0][1]), "+v"(ga[0][1][0]), "+v"(ga[0][1][1]), "+v"(ga[1][0][0]), "+v"(ga[1][0][1]), "+v"(ga[1][1][0]), "+v"(ga[1][1][1]),
                                          "+v"(ga[2][0][0]), "+v"(ga[2][0][1]), "+v"(ga[2][1][0]), "+v"(ga[2][1][1]), "+v"(ga[3][0][0]), "+v"(ga[3][0][1]), "+v"(ga[3][1][0]), "+v"(ga[3][1][1]) :: "memory");
                        asm volatile("" : "+v"(gb[0][0][0]), "+v"(gb[0][0][1]), "+v"(gb[0][1][0]), "+v"(gb[0][1][1]), "+v"(gb[1][0][0]), "+v"(gb[1][0][1]), "+v"(gb[1][1][0]), "+v"(gb[1][1][1]),
                                          "+v"(gb[2][0][0]), "+v"(gb[2][0][1]), "+v"(gb[2][1][0]), "+v"(gb[2][1][1]), "+v"(gb[3][0][0]), "+v"(gb[3][0][1]), "+v"(gb[3][1][0]), "+v"(gb[3][1][1]) :: "memory");
#pragma unroll
                        for (int m = 0; m < 4; ++m)
#pragma unroll
                            for (int bj = 0; bj < 2; ++bj)
#pragma unroll
                                for (int n = 0; n < 2; ++n) {
                                    const u32x2 a = ga[m][bj][n], b = gb[m][bj][n];
                                    f32x4& v = acc[ai][bj][m][n];
                                    v.x *= __uint_as_float(a.x << 16) * __builtin_amdgcn_rcpf(__uint_as_float(b.x << 16));
                                    v.y *= __uint_as_float(a.x & 0xffff0000u) * __builtin_amdgcn_rcpf(__uint_as_float(b.x & 0xffff0000u));
                                    v.z *= __uint_as_float(a.y << 16) * __builtin_amdgcn_rcpf(__uint_as_float(b.y << 16));
                                    v.w *= __uint_as_float(a.y & 0xffff0000u) * __builtin_amdgcn_rcpf(__uint_as_float(b.y & 0xffff0000u));
                                }
                    }
                    asm volatile("s_waitcnt vmcnt(0)" ::: "memory");
                }
            }
            const char* a1 = cA + (size_t)(t + 1) * kstep;
            const char* a2 = last ? nA : cA + (size_t)(t + 2) * kstep; const char* b2 = last ? nB : cB + (size_t)(t + 2) * kstep;
            const char* a3 = a2 + kstep; const char* b3 = b2 + kstep;
            PG8_LDB(B0, 0, 0); PG8_SCHED; PG8_LDA(At, 0, 0); PG8_STAGE2(PG8_SA(1, 1), a1 + hstepA, VC1(0), VC1(1));
            if constexpr (GA) { if (last && has_next) { asm volatile("" ::: "memory"); PG8_GATHER_OFFS(nxt.pm); asm volatile("" ::: "memory"); } }
            PG8_WAIT_L(8); PG8_BAR; PG8_WAIT_L(0); PG8_MMA(0, 0, At, B0); PG8_BAR; PG8_SCHED;
            PG8_LDB(B1, 0, 1); PG8_STAGEB(PG8_SB(0, 0), b2);
            PG8_BAR; PG8_WAIT_L(0); PG8_MMA(0, 1, At, B1); PG8_BAR;
            PG8_LDA(At, 0, 1); PG8_STAGE2(PG8_SA(0, 0), a2, VN0(0), VN0(1));
            PG8_BAR; PG8_WAIT_L(0); PG8_MMA(1, 0, At, B0); PG8_BAR; PG8_SCHED;
            PG8_STAGEB(PG8_SB(0, 1), b2 + hstepB);
            PG8_WAIT_V(6); PG8_BAR; PG8_MMA(1, 1, At, B1); PG8_BAR;
            PG8_LDB(B0, 1, 0); PG8_SCHED; PG8_LDA(At, 1, 0); PG8_STAGE2(PG8_SA(0, 1), a2 + hstepA, VN1(0), VN1(1));
            PG8_WAIT_L(8); PG8_BAR; PG8_WAIT_L(0); PG8_MMA(0, 0, At, B0); PG8_BAR; PG8_SCHED;
            PG8_LDB(B1, 1, 1); PG8_STAGEB(PG8_SB(1, 0), b3);
            PG8_BAR; PG8_WAIT_L(0); PG8_MMA(0, 1, At, B1); PG8_BAR;
            PG8_LDA(At, 1, 1); PG8_STAGE2(PG8_SA(1, 0), a3, VN0(0), VN0(1));
            PG8_BAR; PG8_WAIT_L(0); PG8_MMA(1, 0, At, B0); PG8_BAR; PG8_SCHED;
            PG8_STAGEB(PG8_SB(1, 1), b3 + hstepB);
            PG8_WAIT_V(6); PG8_BAR; PG8_MMA(1, 1, At, B1); PG8_BAR;
        }
        {
            int epm = cur.pm, epn = cur.pn; asm volatile("" : "+s"(epm), "+s"(epn));
            unsigned eln = (unsigned)lane; asm volatile("" : "+v"(eln)); const int efr = (int)(eln & 15u), efq = (int)(eln >> 4);
            f32x4 cv[2][2];
#pragma unroll
            for (int bj = 0; bj < 2; ++bj)
#pragma unroll
                for (int n = 0; n < 2; ++n) { if constexpr (Epi::COLVEC) cv[bj][n] = E.colvec(epm * BM, epn * BM + bj * HALF + wc * 32 + n * 16 + 4 * efq); else cv[bj][n] = (f32x4){0.f, 0.f, 0.f, 0.f}; }
            if constexpr (Epi::COLVEC) asm volatile("" : "+v"(cv[0][0]), "+v"(cv[0][1]), "+v"(cv[1][0]), "+v"(cv[1][1]) :: "memory");
#pragma unroll
            for (int ai = 0; ai < 2; ++ai) {
                f32x4 bs[4][2][2];
                if constexpr (Epi::BASE) {
#pragma unroll
                    for (int m = 0; m < 4; ++m)
#pragma unroll
                        for (int bj = 0; bj < 2; ++bj)
#pragma unroll
                            for (int n = 0; n < 2; ++n) bs[m][bj][n] = E.base(epm * BM + ai * HALF + wr * 64 + m * 16 + efr, epn * BM + bj * HALF + wc * 32 + n * 16 + 4 * efq);
                    asm volatile("" : "+v"(bs[0][0][0]), "+v"(bs[0][0][1]), "+v"(bs[0][1][0]), "+v"(bs[0][1][1]), "+v"(bs[1][0][0]), "+v"(bs[1][0][1]), "+v"(bs[1][1][0]), "+v"(bs[1][1][1]),
                                      "+v"(bs[2][0][0]), "+v"(bs[2][0][1]), "+v"(bs[2][1][0]), "+v"(bs[2][1][1]), "+v"(bs[3][0][0]), "+v"(bs[3][0][1]), "+v"(bs[3][1][0]), "+v"(bs[3][1][1]) :: "memory");
                }
#pragma unroll
                for (int m = 0; m < 4; ++m) {
                    const int row = epm * BM + ai * HALF + wr * 64 + m * 16 + efr;
#pragma unroll
                    for (int bj = 0; bj < 2; ++bj) {
                        if constexpr (Epi::PAIR) E.store_pair(row, epn * (BM / 2) + bj * (HALF / 2) + wc * 16 + 4 * efq, acc[ai][bj][m][0], acc[ai][bj][m][1]);
                        else {
#pragma unroll
                            for (int n = 0; n < 2; ++n) { f32x4 bb = (f32x4){0.f, 0.f, 0.f, 0.f}; if constexpr (Epi::BASE) bb = bs[m][bj][n]; E.store(row, epn * BM + bj * HALF + wc * 32 + n * 16 + 4 * efq, acc[ai][bj][m][n], cv[bj][n], bb); }
                        }
                    }
                }
            }
        }
        if (!has_next) break;
#pragma unroll
        for (int a = 0; a < 2; ++a)
#pragma unroll
            for (int b = 0; b < 2; ++b)
#pragma unroll
                for (int m = 0; m < 4; ++m)
#pragma unroll
                    for (int n = 0; n < 2; ++n) acc[a][b][m][n] = (f32x4){0.f, 0.f, 0.f, 0.f};
        cur = nxt; cB = nB; cA = nA; ++ui;
    }
    PG8_WAIT_V(0);
    if (wr == 0) PG8_BAR;
    PG8_BAR;
#undef PG8_GATHER_OFFS
#undef VC0
#undef VC1
#undef VN0
#undef VN1
#undef PG8_SA
#undef PG8_SB
#undef PG8_STAGE2
#undef PG8_STAGEB
#undef PG8_LDA
#undef PG8_LDB
#undef PG8_MMA
#undef PG8_WAIT_V
#undef PG8_WAIT_L
#undef PG8_BAR
#undef PG8_SCHED
}
}

template <class Epi>
__device__ __forceinline__ void gemm_fast(Frame& F, const bf16* A, int lda, const bf16* Bt, int ldb, int K, int M, int N, const Epi& E) {
    pg8::OrderPlain S; S.init(M / 256, N / 256, F.G, F.wg);
    pg8::gemm_phase(F.lds, A, lda, Bt, ldb, K, S, E);
}
#ifndef FAST_PLAIN
#define FAST_PLAIN 1
#endif
#ifndef FAST_HORNER
#define FAST_HORNER 1
#endif
#ifndef FAST_MOE
#define FAST_MOE 1
#endif

__device__ __forceinline__ void st_bf16x4(bf16* p, f32x4 v) { u32x2 w; w.x = pk2(v.x, v.y); w.y = pk2(v.z, v.w); *(u32x2*)p = w; }
__device__ __forceinline__ f32x4 ld_bf16x4(const bf16* p) { const u32x2 w = *(const u32x2*)p; f32x4 v; v.x = __uint_as_float(w.x << 16); v.y = __uint_as_float(w.x & 0xffff0000u); v.z = __uint_as_float(w.y << 16); v.w = __uint_as_float(w.y & 0xffff0000u); return v; }

struct EpiWin {
    static constexpr bool HORNER = false, PAIR = false, COLVEC = true, BASE = false;
    const float* bias; bf16 *hytl, *hytc, *ret, *ml; float* mlg;
    __device__ __forceinline__ f32x4 colvec(int, int col) const { return *(const f32x4*)(bias + col); }
    __device__ __forceinline__ void store(int row, int col, f32x4 v, f32x4 cv, f32x4) const {
        v += cv;
        if (col < 1152) {
            if (row < TOKL) { const int b = row >> 11, t = row & 2047; bf16* d = hytl + ((size_t)(b * 1152 + col)) * 2048 + t;
                d[0] = (bf16)f2bf(v.x); d[2048] = (bf16)f2bf(v.y); d[4096] = (bf16)f2bf(v.z); d[6144] = (bf16)f2bf(v.w); }
            else { const int r = row - TOKL, b = r >> 8, t = r & 255; bf16* d = hytc + ((size_t)(b * 1152 + col)) * 256 + t;
                d[0] = (bf16)f2bf(v.x); d[256] = (bf16)f2bf(v.y); d[512] = (bf16)f2bf(v.z); d[768] = (bf16)f2bf(v.w); }
        } else if (col < 1168) { *(f32x4*)(mlg + (size_t)row * 16 + (col - 1152)) = v; }
        else if (col < 1280) { }
        else if (col < 2816) st_bf16x4(ret + (size_t)row * 1536 + (col - 1280), v);
        else st_bf16x4(ml + (size_t)row * 1024 + (col - 2816), v);
    }
};
struct EpiGate {
    static constexpr bool HORNER = false, PAIR = false, COLVEC = true, BASE = false;
    const float* bias; bf16* gates;
    __device__ __forceinline__ f32x4 colvec(int, int col) const { return *(const f32x4*)(bias + col); }
    __device__ __forceinline__ void store(int row, int col, f32x4 v, f32x4 cv, f32x4) const {
        v += cv;
        f32x4 g; g.x = fmaxf(sigmoidf_(v.x), 1e-20f); g.y = fmaxf(sigmoidf_(v.y), 1e-20f); g.z = fmaxf(sigmoidf_(v.z), 1e-20f); g.w = fmaxf(sigmoidf_(v.w), 1e-20f);
        st_bf16x4(gates + (size_t)row * NGATE + col, g);
    }
};
struct EpiUp {
    static constexpr bool HORNER = true, PAIR = false, COLVEC = false, BASE = true;
    const bf16* gates; bf16* acc_out;
    __device__ __forceinline__ u32x2 gate(int which, int row, int col) const { return *(const u32x2*)(gates + (size_t)row * NGATE + which * 1024 + col); }
    __device__ __forceinline__ f32x4 base(int row, int col) const { return ld_bf16x4(gates + (size_t)row * NGATE + 2048 + col); }
    __device__ __forceinline__ void store(int row, int col, f32x4 v, f32x4, f32x4 g) const { st_bf16x4(acc_out + (size_t)row * D + col, v * g); }
};
struct EpiResid {
    static constexpr bool HORNER = false, PAIR = false, COLVEC = true, BASE = true;
    const float *xin_l, *xin_c; float *xout_l, *xout_c; const float* modbase; int which;
    __device__ __forceinline__ f32x4 colvec(int row0, int col) const { const int r = row0 < TOKL ? (row0 >> 11) : 16; return *(const f32x4*)(modbase + ((size_t)r * 6 + which) * 1024 + col); }
    __device__ __forceinline__ f32x4 base(int row, int col) const { return row < TOKL ? *(const f32x4*)(xin_l + (size_t)row * D + col) : *(const f32x4*)(xin_c + (size_t)(row - TOKL) * D + col); }
    __device__ __forceinline__ void store(int row, int col, f32x4 v, f32x4 m, f32x4 x) const {
        if (row < TOKL) *(f32x4*)(xout_l + (size_t)row * D + col) = x + m * v;
        else *(f32x4*)(xout_c + (size_t)(row - TOKL) * D + col) = x + m * v;
    }
};
struct EpiSwiglu {
    static constexpr bool HORNER = false, PAIR = true, COLVEC = false, BASE = false;
    bf16* act; int row_off;
    __device__ __forceinline__ void store_pair(int row, int col, f32x4 a, f32x4 b) const {
        f32x4 o; o.x = siluf_(a.x) * b.x; o.y = siluf_(a.y) * b.y; o.z = siluf_(a.z) * b.z; o.w = siluf_(a.w) * b.w;
        st_bf16x4(act + (size_t)(row - row_off) * DFF + col, o);
    }
    __device__ __forceinline__ void store(int, int, f32x4, f32x4, f32x4) const {}
};
struct EpiBf16Out {
    static constexpr bool HORNER = false, PAIR = false, COLVEC = false, BASE = false;
    bf16* out; int ld; int row_add;
    __device__ __forceinline__ void store(int row, int col, f32x4 v, f32x4, f32x4) const { st_bf16x4(out + (size_t)(row + row_add) * ld + col, v); }
    __device__ __forceinline__ void store_pair(int, int, f32x4, f32x4) const {}
};

constexpr int ZPITCH_L = (LL + 8) * 2, ZPITCH_C = (LC + 8) * 2;
template <int L>
__device__ __forceinline__ float conv3_at(const bf16* base  , int t, float w0, float w1, float w2) {
    const float a = t > 0 ? bf2f(base[t - 1]) : 0.f, b = bf2f(base[t]), c = t < L - 1 ? bf2f(base[t + 1]) : 0.f;
    return w0 * a + w1 * b + w2 * c;
}
template <int L>
__device__ __forceinline__ void hyena_unit_naive(Frame& F, int layer, int c, const bf16* hyt  , const bf16* ft  , bf16* yht  ) {
    constexpr int ZP = (L + 8) * 2;
    constexpr int PER = L / 32;
    constexpr int SUB = 8;
    LAS unsigned char* zimg0 = F.lds;
    LAS unsigned char* zimg1 = F.lds + 16 * ZP;
    LAS bf16* tf = (LAS bf16*)(F.lds + 32 * ZP);
    const float* cw = inp(F, I_HYCONV) + layer * 3 * 1152;
    const float* skip = inp(F, I_HYSKIP) + layer * 2 * 384;
    __syncthreads();
    {
        const int b = F.tid >> 5, seg = F.tid & 31; const bf16* src = hyt + ((size_t)(b * 1152 + c)) * L;
        const float w0 = cw[c], w1 = cw[1152 + c], w2 = cw[2304 + c];
#pragma unroll 2
        for (int j = 0; j < PER; ++j) { const int t = seg * PER + j; *(LAS bf16*)(zimg0 + b * ZP + t * 2) = (bf16)f2bf(conv3_at<L>(src, t, w0, w1, w2)); }
    }
#pragma unroll 1
    for (int o = 0; o < 2; ++o) {
        LAS unsigned char* zs = o == 0 ? zimg0 : zimg1;
        LAS unsigned char* zd = o == 0 ? zimg1 : zimg0;
        const bf16* fsrc = ft + ((size_t)(o * 384 + c)) * (2 * L);
        for (int i = F.tid; i < 2 * L; i += NTHR) tf[i] = i == 0 ? (bf16)0 : fsrc[i];
        __syncthreads();
        const int b = F.tid & 15, tg = F.tid >> 4;
        const int gcol = (o == 0 ? 384 : 768) + c;
        const bf16* gsrc = hyt + ((size_t)(b * 1152 + gcol)) * L;
        const float w0 = cw[gcol], w1 = cw[1152 + gcol], w2 = cw[2304 + gcol], sk = skip[o * 384 + c];
#pragma unroll 1
        for (int sb = 0; sb < PER / SUB; ++sb) {
            const int t0 = tg * PER + sb * SUB;
            float acc[SUB];
#pragma unroll
            for (int j = 0; j < SUB; ++j) acc[j] = 0.f;
#pragma unroll 1
            for (int s0 = 0; s0 < L; s0 += 8) {
                float z[8];
                { const bf16x8 zz = *(const LAS bf16x8*)(zs + b * ZP + s0 * 2);
#pragma unroll
                  for (int i = 0; i < 8; ++i) z[i] = bf2f((bf16)zz[i]); }
                float win[SUB + 7];
                const int wb = L + s0 - t0 - (SUB - 1);
#pragma unroll
                for (int i = 0; i < SUB + 7; ++i) win[i] = bf2f(tf[wb + i]);
#pragma unroll
                for (int j = 0; j < SUB; ++j)
#pragma unroll
                    for (int i = 0; i < 8; ++i) acc[j] += win[(SUB - 1) - j + i] * z[i];
            }
#pragma unroll
            for (int j = 0; j < SUB; ++j) {
                const int t = t0 + j;
                const float zt = bf2f(*(LAS bf16*)(zs + b * ZP + t * 2));
                const float ov = conv3_at<L>(gsrc, t, w0, w1, w2) * (acc[j] + sk * zt);
                *(LAS bf16*)(zd + b * ZP + t * 2) = (bf16)f2bf(ov);
            }
        }
        __syncthreads();
    }
#pragma unroll 2
    for (int i = F.tid; i < 16 * (L / 8); i += NTHR) {
        const int b = i / (L / 8), ch = i % (L / 8);
        *(u32x4*)(yht + ((size_t)(b * 384 + c)) * L + ch * 8) = *(const LAS u32x4*)(zimg0 + b * ZP + ch * 16);
    }
}

template <int L>
__device__ __forceinline__ void hyena_unit_fast(Frame& F, int layer, int c, const bf16* hyt  , const bf16* ft  , bf16* yht  ) {
    constexpr int ZP = (L + 8) * 2;
    constexpr int PER = L / 32;
    constexpr int I = L / 128;
    constexpr int SPAN = L / 4, NSTEP = L / 32;
    LAS unsigned char* zimg0 = F.lds;
    LAS unsigned char* zimg1 = F.lds + 16 * ZP;
    LAS bf16* tf = (LAS bf16*)(F.lds + 32 * ZP);
    const float* cw = inp(F, I_HYCONV) + layer * 3 * 1152;
    const float* skip = inp(F, I_HYSKIP) + layer * 2 * 384;
    const int lane = F.lane, fr = lane & 15, fq = lane >> 4, w = F.wave;
    __syncthreads();
    {
        const int b = F.tid >> 5, sg = F.tid & 31, t0 = sg * PER; const bf16* src = hyt + ((size_t)(b * 1152 + c)) * L + t0;
        const float w0 = cw[c], w1 = cw[1152 + c], w2 = cw[2304 + c];
        u32x4 raw[PER / 8];
#pragma unroll
        for (int j = 0; j < PER / 8; ++j) raw[j] = *(const u32x4*)(src + 8 * j);
        float prev = t0 > 0 ? bf2f(src[-1]) : 0.f;
        const float nextv = t0 + PER < L ? bf2f(src[PER]) : 0.f;
#pragma unroll
        for (int j = 0; j < PER / 8; ++j) {
            const unsigned wv[4] = {raw[j].x, raw[j].y, raw[j].z, raw[j].w};
            float x[10]; x[0] = prev;
#pragma unroll
            for (int q = 0; q < 4; ++q) { x[1 + 2 * q] = __uint_as_float(wv[q] << 16); x[2 + 2 * q] = __uint_as_float(wv[q] & 0xffff0000u); }
            if (j + 1 < PER / 8) x[9] = __uint_as_float(raw[(j + 1 < PER / 8) ? j + 1 : j].x << 16); else x[9] = nextv;
            u32x4 o;
            o.x = pk2(w0 * x[0] + w1 * x[1] + w2 * x[2], w0 * x[1] + w1 * x[2] + w2 * x[3]); o.y = pk2(w0 * x[2] + w1 * x[3] + w2 * x[4], w0 * x[3] + w1 * x[4] + w2 * x[5]);
            o.z = pk2(w0 * x[4] + w1 * x[5] + w2 * x[6], w0 * x[5] + w1 * x[6] + w2 * x[7]); o.w = pk2(w0 * x[6] + w1 * x[7] + w2 * x[8], w0 * x[7] + w1 * x[8] + w2 * x[9]);
            *(LAS u32x4*)(zimg0 + b * ZP + (t0 + 8 * j) * 2) = o;
            prev = x[8];
        }
    }
    const int tbase = SPAN * (w >> 1) + 16 * (w & 1);
    const int flane = L - tbase + 8 * fq - fr;
#pragma unroll 1
    for (int o = 0; o < 2; ++o) {
        LAS unsigned char* zs = o == 0 ? zimg0 : zimg1;
        LAS unsigned char* zd = o == 0 ? zimg1 : zimg0;
        const bf16* fsrc = ft + ((size_t)(o * 384 + c)) * (2 * L);
        for (int i = F.tid; i < 2 * L; i += NTHR) tf[i] = i == 0 ? (bf16)0 : fsrc[i];
        __syncthreads();
        f32x4 acc[I];
#pragma unroll
        for (int i = 0; i < I; ++i) acc[i] = (f32x4){0.f, 0.f, 0.f, 0.f};
        bf16x8 ring[I];
#pragma unroll
        for (int i = 1; i < I; ++i) __builtin_memcpy(&ring[(I - i) % I], (const LAS unsigned char*)tf + 2 * (flane - 32 * i), 16);
        const LAS unsigned char* zrow = zs + fr * ZP + 16 * fq;
#pragma unroll 1
        for (int j0 = 0; j0 < NSTEP; j0 += I) {
#pragma unroll
            for (int jj = 0; jj < I; ++jj) {
                const int j = j0 + jj;
                __builtin_memcpy(&ring[jj], (const LAS unsigned char*)tf + 2 * (flane + 32 * j), 16);
                const bf16x8 zf = *(const LAS bf16x8*)(zrow + 64 * j);
#pragma unroll
                for (int i = 0; i < I; ++i) acc[i] = __builtin_amdgcn_mfma_f32_16x16x32_bf16(ring[(jj - i + I) % I], zf, acc[i], 0, 0, 0);
            }
        }
        const int gcol = (o == 0 ? 384 : 768) + c;
        const bf16* gsrc = hyt + ((size_t)(fr * 1152 + gcol)) * L;
        const float w0 = cw[gcol], w1 = cw[1152 + gcol], w2 = cw[2304 + gcol], sk = skip[o * 384 + c];
        bf16* dst = yht + ((size_t)(fr * 384 + c)) * L;
        u32x2 grv[I]; unsigned short gmv[I], gpv[I];
#pragma unroll
        for (int i = 0; i < I; ++i) {
            const int t = tbase + 32 * i + 4 * fq;
            grv[i] = *(const u32x2*)(gsrc + t); gmv[i] = t > 0 ? gsrc[t - 1] : (unsigned short)0; gpv[i] = t + 4 < L ? gsrc[t + 4] : (unsigned short)0;
        }
#pragma unroll
        for (int i = 0; i < I; ++i) {
            const int t = tbase + 32 * i + 4 * fq;
            const u32x2 zr = *(const LAS u32x2*)(zs + fr * ZP + t * 2);
            const u32x2 gr = grv[i];
            const float gm = bf2f(gmv[i]), gp = bf2f(gpv[i]);
            const float g0 = __uint_as_float(gr.x << 16), g1 = __uint_as_float(gr.x & 0xffff0000u), g2 = __uint_as_float(gr.y << 16), g3 = __uint_as_float(gr.y & 0xffff0000u);
            const float z0 = __uint_as_float(zr.x << 16), z1 = __uint_as_float(zr.x & 0xffff0000u), z2 = __uint_as_float(zr.y << 16), z3 = __uint_as_float(zr.y & 0xffff0000u);
            const float o0 = (w0 * gm + w1 * g0 + w2 * g1) * (acc[i].x + sk * z0), o1 = (w0 * g0 + w1 * g1 + w2 * g2) * (acc[i].y + sk * z1);
            const float o2 = (w0 * g1 + w1 * g2 + w2 * g3) * (acc[i].z + sk * z2), o3 = (w0 * g2 + w1 * g3 + w2 * gp) * (acc[i].w + sk * z3);
            u32x2 ov; ov.x = pk2(o0, o1); ov.y = pk2(o2, o3);
            if (o == 0) *(LAS u32x2*)(zd + fr * ZP + t * 2) = ov;
            else *(u32x2*)(dst + t) = ov;
        }
        __syncthreads();
    }
}

__device__ __forceinline__ void chain_naive(Frame& F, int layer, int chain) {
    const int lane = F.lane;
    const bool is_ret = chain < 192;
    int b, h, dir;
    if (is_ret) { b = chain / 12; const int r = chain % 12; h = r >> 1; dir = r & 1; }
    else { const int i = chain - 192; b = i >> 3; h = (i & 7) >> 1; dir = i & 1; }
    const bf16* RET = WSP(const bf16, WS_RET); const bf16* ML = WSP(const bf16, WS_ML); const float* MLG = WSP(const float, WS_MLG);
    const float* rope = WSP(const float, WS_ROPE);
    bf16* Y = WSP(bf16, WS_Y); bf16* OB = WSP(bf16, WS_OB);
    float gam = 0.f;
    if (is_ret) gam = sigmoidf_(inp(F, I_RETDECAY)[layer * 12 + dir * 6 + h]);
    const float* mlc = inp(F, I_MLCONV) + layer * 3 * 512;
    const float bi = is_ret ? 0.f : inp(F, I_MLGB)[layer * 16 + dir * 8 + h], bfg = is_ret ? 0.f : inp(F, I_MLGB)[layer * 16 + dir * 8 + 4 + h];
    const float qw0 = mlc[h * 64 + lane], qw1 = mlc[512 + h * 64 + lane], qw2 = mlc[1024 + h * 64 + lane];
    const float kw0 = mlc[256 + h * 64 + lane], kw1 = mlc[512 + 256 + h * 64 + lane], kw2 = mlc[1024 + 256 + h * 64 + lane];
    float S[64];
#pragma unroll
    for (int d = 0; d < 64; ++d) S[d] = 0.f;
    float nv = 0.f;
    for (int step = 0; step < LC + LL; ++step) {
        int row, tpos, L; bool lat;
        if (step < LC) { tpos = dir ? (LC - 1 - step) : step; row = TOKL + b * LC + tpos; L = LC; lat = false; }
        else { const int s2 = step - LC; tpos = dir ? (LL - 1 - s2) : s2; row = b * LL + tpos; L = LL; lat = true; }
        float q, k, v, Fm, Im;
        if (is_ret) {
            const bf16* base = RET + (size_t)row * 1536;
            float qs = bf2f(base[h * 64 + lane]), ks = bf2f(base[384 + h * 64 + lane]);
            v = bf2f(base[768 + h * 64 + lane]);
            if (lat) {
                const float qp = bf2f(base[h * 64 + (lane ^ 16)]), kp = bf2f(base[384 + h * 64 + (lane ^ 16)]);
                const int half = lane >> 5, ii = lane & 15, hi = (lane >> 4) & 1;
                const float cs = rope[tpos * 64 + half * 32 + ii], sn = rope[tpos * 64 + half * 32 + 16 + ii];
                q = hi == 0 ? qs * cs - qp * sn : qp * sn + qs * cs;
                k = hi == 0 ? ks * cs - kp * sn : kp * sn + ks * cs;
            } else { q = qs; k = ks; }
            q *= 0.125f; Fm = gam; Im = 1.f;
        } else {
            const bf16* base = ML + (size_t)row * 1024;
            const float q0 = tpos > 0 ? bf2f(base[-1024 + h * 64 + lane]) : 0.f, q1 = bf2f(base[h * 64 + lane]), q2 = tpos < L - 1 ? bf2f(base[1024 + h * 64 + lane]) : 0.f;
            const float k0 = tpos > 0 ? bf2f(base[-1024 + 256 + h * 64 + lane]) : 0.f, k1 = bf2f(base[256 + h * 64 + lane]), k2 = tpos < L - 1 ? bf2f(base[1024 + 256 + h * 64 + lane]) : 0.f;
            q = siluf_(qw0 * q0 + qw1 * q1 + qw2 * q2);
            k = siluf_(kw0 * k0 + kw1 * k1 + kw2 * k2) * 0.125f;
            v = bf2f(base[512 + h * 64 + lane]);
            const float ig = MLG[(size_t)row * 16 + dir * 8 + h] + bi, fg = MLG[(size_t)row * 16 + dir * 8 + 4 + h] + bfg;
            Fm = sigmoidf_(fg); Im = __expf(ig);
        }
        float num = 0.f;
        const float iv = Im * v;
#pragma unroll
        for (int d = 0; d < 64; ++d) {
            const float kd = __int_as_float(__builtin_amdgcn_readlane(__float_as_int(k), d));
            const float qd = __int_as_float(__builtin_amdgcn_readlane(__float_as_int(q), d));
            S[d] = Fm * S[d] + kd * iv;
            num += qd * S[d];
        }
        float o = num;
        if (!is_ret) { nv = Fm * nv + Im * k; const float den = wave_sum(q * nv); o = num / fmaxf(fabsf(den), 1.f); }
        const int cof = is_ret ? (h * 64 + lane) : (384 + h * 64 + lane);
        if (dir == 0) Y[(size_t)row * D + 384 + cof] = (bf16)f2bf(o);
        else OB[(size_t)row * 640 + cof] = (bf16)f2bf(o);
    }
}

constexpr int CH_PITCH = 144;
constexpr int CH_IMG = 64 * CH_PITCH;
constexpr int CH_WAVE_LDS = 3 * CH_IMG + 1024 + 512;
__device__ __forceinline__ void ds_tr16x8(unsigned addr, u32x2 (&lo)[4], u32x2 (&hi)[4]) {
    asm volatile("ds_read_b64_tr_b16 %0, %8\n\tds_read_b64_tr_b16 %1, %8 offset:32\n\tds_read_b64_tr_b16 %2, %8 offset:64\n\tds_read_b64_tr_b16 %3, %8 offset:96\n\t"
                 "ds_read_b64_tr_b16 %4, %8 offset:2304\n\tds_read_b64_tr_b16 %5, %8 offset:2336\n\tds_read_b64_tr_b16 %6, %8 offset:2368\n\tds_read_b64_tr_b16 %7, %8 offset:2400\n\t"
                 "s_waitcnt lgkmcnt(0)"
                 : "=&v"(lo[0]), "=&v"(lo[1]), "=&v"(lo[2]), "=&v"(lo[3]), "=&v"(hi[0]), "=&v"(hi[1]), "=&v"(hi[2]), "=&v"(hi[3]) : "v"(addr) : "memory");
}
static_assert(16 * CH_PITCH == 2304, "ds_tr16x8 offsets");
__device__ __forceinline__ void ds_tr16x4(unsigned addr, u32x2 (&lo)[2], u32x2 (&hi)[2]) {
    asm volatile("ds_read_b64_tr_b16 %0, %4\n\tds_read_b64_tr_b16 %1, %4 offset:32\n\tds_read_b64_tr_b16 %2, %4 offset:2304\n\tds_read_b64_tr_b16 %3, %4 offset:2336\n\ts_waitcnt lgkmcnt(0)"
                 : "=&v"(lo[0]), "=&v"(lo[1]), "=&v"(hi[0]), "=&v"(hi[1]) : "v"(addr) : "memory");
}
__device__ __forceinline__ float log_sigmoid_(float x) { return fminf(x, 0.f) - log1pf(__expf(-fabsf(x))); }
__device__ __forceinline__ bf16x8 mk_frag(u32x2 lo, u32x2 hi) { u32x4 w; w.x = lo.x; w.y = lo.y; w.z = hi.x; w.w = hi.y; return __builtin_bit_cast(bf16x8, w); }

template <bool IS_ML>
__device__ __forceinline__ void chain_fast(Frame& F, int layer, int b, int h, int dir, LAS unsigned char* img, int hf) {
    constexpr int NET = 2;
    const int lane = F.lane, fr = lane & 15, fq = lane >> 4;
    LAS unsigned char* Qi = img; LAS unsigned char* Ki = img + CH_IMG; LAS unsigned char* Vi = img + 2 * CH_IMG;
    const unsigned qa = (unsigned)(size_t)Qi, ka = (unsigned)(size_t)Ki, va = (unsigned)(size_t)Vi;
    const bf16* RET = WSP(const bf16, WS_RET); const bf16* ML = WSP(const bf16, WS_ML); const float* MLG = WSP(const float, WS_MLG);
    const float* rope = WSP(const float, WS_ROPE);
    bf16* Y = WSP(bf16, WS_Y); bf16* OB = WSP(bf16, WS_OB);
    float lgam = 0.f, bi_ = 0.f, bf_ = 0.f;
    if (!IS_ML) lgam = log_sigmoid_(inp(F, I_RETDECAY)[layer * 12 + dir * 6 + h]);
    else { bi_ = inp(F, I_MLGB)[layer * 16 + dir * 8 + h]; bf_ = inp(F, I_MLGB)[layer * 16 + dir * 8 + 4 + h]; }
    const float* mlc = inp(F, I_MLCONV) + layer * 3 * 512;
    f32x4 C[4][NET];
#pragma unroll
    for (int dt = 0; dt < 4; ++dt)
#pragma unroll
        for (int et = 0; et < NET; ++et) C[dt][et] = (f32x4){0.f, 0.f, 0.f, 0.f};
    const int cq = lane & 7, pr0 = lane >> 3;
    LAS float* nvec = (LAS float*)(img + 3 * CH_IMG + 1024 + 256 * hf);
    if (IS_ML) nvec[lane] = 0.f;
    const LAS float* nq = nvec + 4 * fq;
#pragma unroll 1
    for (int step = 0; step < 36; ++step) {
        int rowbase, t0, L; bool lat;
        if (step < 4) { const int cc = dir ? 3 - step : step; rowbase = TOKL + b * LC + cc * 64; t0 = cc * 64; L = LC; lat = false; }
        else { const int cc = dir ? 35 - step : step - 4; rowbase = b * LL + cc * 64; t0 = cc * 64; L = LL; lat = true; }
#pragma unroll
        for (int i4 = 0; i4 < 4; ++i4) {
            const int i = 4 * hf + i4;
            const int p = pr0 + 8 * i, tl = dir ? 63 - p : p, row = rowbase + tl, tpos = t0 + tl;
            float qv[8], kv[8]; u32x4 vraw;
            if (!IS_ML) {
                const bf16* base = RET + (size_t)row * 1536 + h * 64;
                const u32x4 qr = *(const u32x4*)(base + 8 * cq), kr = *(const u32x4*)(base + 384 + 8 * cq); vraw = *(const u32x4*)(base + 768 + 8 * cq);
                const unsigned qw[4] = {qr.x, qr.y, qr.z, qr.w}, kw[4] = {kr.x, kr.y, kr.z, kr.w};
#pragma unroll
                for (int j = 0; j < 4; ++j) { qv[2 * j] = __uint_as_float(qw[j] << 16); qv[2 * j + 1] = __uint_as_float(qw[j] & 0xffff0000u); kv[2 * j] = __uint_as_float(kw[j] << 16); kv[2 * j + 1] = __uint_as_float(kw[j] & 0xffff0000u); }
                if (lat) {
                    const u32x4 qpr = *(const u32x4*)(base + 8 * (cq ^ 2)), kpr = *(const u32x4*)(base + 384 + 8 * (cq ^ 2));
                    const unsigned qpw[4] = {qpr.x, qpr.y, qpr.z, qpr.w}, kpw[4] = {kpr.x, kpr.y, kpr.z, kpr.w};
                    const int half = cq >> 2, hi = (cq >> 1) & 1, i0 = 8 * (cq & 1);
                    const float* rp = rope + tpos * 64 + half * 32 + i0;
                    const f32x4 c0 = *(const f32x4*)(rp), c1 = *(const f32x4*)(rp + 4), s0 = *(const f32x4*)(rp + 16), s1 = *(const f32x4*)(rp + 20);
                    const float cs[8] = {c0.x, c0.y, c0.z, c0.w, c1.x, c1.y, c1.z, c1.w}, sn[8] = {s0.x, s0.y, s0.z, s0.w, s1.x, s1.y, s1.z, s1.w};
#pragma unroll
                    for (int j = 0; j < 8; ++j) {
                        const float qp = (j & 1) ? __uint_as_float(qpw[j >> 1] & 0xffff0000u) : __uint_as_float(qpw[j >> 1] << 16);
                        const float kp = (j & 1) ? __uint_as_float(kpw[j >> 1] & 0xffff0000u) : __uint_as_float(kpw[j >> 1] << 16);
                        qv[j] = hi ? qp * sn[j] + qv[j] * cs[j] : qv[j] * cs[j] - qp * sn[j];
                        kv[j] = hi ? kp * sn[j] + kv[j] * cs[j] : kv[j] * cs[j] - kp * sn[j];
                    }
                }
#pragma unroll
                for (int j = 0; j < 8; ++j) qv[j] *= 0.125f;
            } else {
                const bf16* base = ML + (size_t)row * 1024 + h * 64 + 8 * cq;
                const u32x4 z4 = (u32x4){0u, 0u, 0u, 0u};
                const float* wq = mlc + h * 64 + 8 * cq; asm volatile("" : "+v"(wq));
                vraw = *(const u32x4*)(base + 512);
#pragma unroll
                for (int qk = 0; qk < 2; ++qk) {
                    const bf16* bb = base + 256 * qk; const float* ww = wq + 256 * qk;
                    const u32x4 r1 = *(const u32x4*)(bb), r0 = tpos > 0 ? *(const u32x4*)(bb - 1024) : z4, r2 = tpos < L - 1 ? *(const u32x4*)(bb + 1024) : z4;
                    const unsigned a0[4] = {r0.x, r0.y, r0.z, r0.w}, a1[4] = {r1.x, r1.y, r1.z, r1.w}, a2[4] = {r2.x, r2.y, r2.z, r2.w};
#pragma unroll
                    for (int j = 0; j < 8; ++j) {
                        const float x0 = (j & 1) ? __uint_as_float(a0[j >> 1] & 0xffff0000u) : __uint_as_float(a0[j >> 1] << 16);
                        const float x1 = (j & 1) ? __uint_as_float(a1[j >> 1] & 0xffff0000u) : __uint_as_float(a1[j >> 1] << 16);
                        const float x2 = (j & 1) ? __uint_as_float(a2[j >> 1] & 0xffff0000u) : __uint_as_float(a2[j >> 1] << 16);
                        const float r = siluf_(ww[j] * x0 + ww[512 + j] * x1 + ww[1024 + j] * x2);
                        if (qk == 0) qv[j] = r; else kv[j] = r * 0.125f;
                    }
                    if (qk == 0) asm volatile("" : "+v"(qv[0]), "+v"(qv[1]), "+v"(qv[2]), "+v"(qv[3]), "+v"(qv[4]), "+v"(qv[5]), "+v"(qv[6]), "+v"(qv[7]) :: "memory");
                }
            }
            u32x4 qo, ko; qo.x = pk2(qv[0], qv[1]); qo.y = pk2(qv[2], qv[3]); qo.z = pk2(qv[4], qv[5]); qo.w = pk2(qv[6], qv[7]);
            ko.x = pk2(kv[0], kv[1]); ko.y = pk2(kv[2], kv[3]); ko.z = pk2(kv[4], kv[5]); ko.w = pk2(kv[6], kv[7]);
            *(LAS u32x4*)(Qi + p * CH_PITCH + 16 * cq) = qo; *(LAS u32x4*)(Ki + p * CH_PITCH + 16 * cq) = ko; *(LAS u32x4*)(Vi + p * CH_PITCH + 16 * cq) = vraw;
        }
        __builtin_amdgcn_sched_barrier(0);
        float f_p, i_p;
        { const int tl = dir ? 63 - lane : lane, row = rowbase + tl;
          if (!IS_ML) { f_p = lgam; i_p = 0.f; }
          else { i_p = MLG[(size_t)row * 16 + dir * 8 + h] + bi_; f_p = log_sigmoid_(MLG[(size_t)row * 16 + dir * 8 + 4 + h] + bf_); } }
        float bsum = f_p;
#pragma unroll
        for (int o = 1; o < 64; o <<= 1) { const float t = __shfl_up(bsum, o); if (lane >= o) bsum += t; }
        LAS float* gv = (LAS float*)(img + 3 * CH_IMG);
        const float b63 = __shfl(bsum, 63);
        const float adec = __expf(b63);
        if (hf == 0) { gv[lane] = bsum; gv[64 + lane] = bsum - i_p; gv[128 + lane] = __expf(bsum); gv[192 + lane] = __expf(b63 - (bsum - i_p)); }
        asm volatile("s_waitcnt lgkmcnt(0)" ::: "memory");
        __syncthreads();
        const LAS float* gq = gv + 4 * fq;
        const bf16x8 ones = (fr == 0) ? (bf16x8){0x3F80, 0x3F80, 0x3F80, 0x3F80, 0x3F80, 0x3F80, 0x3F80, 0x3F80} : (bf16x8){0, 0, 0, 0, 0, 0, 0, 0};
        const int tr_q = fr >> 2, tr_p = fr & 3;
#pragma unroll 1
        for (int pt = 0; pt < 4; ++pt) {
            f32x4 ST[4];
            bf16x8 qn[2];
#pragma unroll
            for (int kk = 0; kk < 2; ++kk) qn[kk] = *(const LAS bf16x8*)(Qi + (16 * pt + fr) * CH_PITCH + (32 * kk + 8 * fq) * 2);
#pragma unroll
            for (int st = 0; st < 4; ++st) {
                ST[st] = (f32x4){0.f, 0.f, 0.f, 0.f};
                if (st <= pt) {
#pragma unroll
                    for (int kk = 0; kk < 2; ++kk) { const bf16x8 kf = *(const LAS bf16x8*)(Ki + (16 * st + fr) * CH_PITCH + (32 * kk + 8 * fq) * 2); ST[st] = __builtin_amdgcn_mfma_f32_16x16x32_bf16(kf, qn[kk], ST[st], 0, 0, 0); }
                }
            }
            const float bp = gv[16 * pt + fr];
#pragma unroll
            for (int st = 0; st < 4; ++st) {
                if (st <= pt) {
                    const f32x4 bis = *(const LAS f32x4*)(gq + 64 + 16 * st);
#pragma unroll
                    for (int j = 0; j < 4; ++j) { const int sidx = 16 * st + 4 * fq + j; const float w = (sidx <= 16 * pt + fr) ? __expf(bp - bis[j]) : 0.f; ST[st][j] *= w; }
                }
            }
            __builtin_amdgcn_sched_barrier(0);
            f32x4 acc[NET], accd = (f32x4){0.f, 0.f, 0.f, 0.f};
#pragma unroll
            for (int et = 0; et < NET; ++et) acc[et] = (f32x4){0.f, 0.f, 0.f, 0.f};
#pragma unroll
            for (int kk = 0; kk < 2; ++kk) {
                const u32x2 lo = *(const LAS u32x2*)(Qi + (16 * pt + fr) * CH_PITCH + (32 * kk + 4 * fq) * 2), hi = *(const LAS u32x2*)(Qi + (16 * pt + fr) * CH_PITCH + (32 * kk + 16 + 4 * fq) * 2);
                const bf16x8 qs = mk_frag(lo, hi);
#pragma unroll
                for (int et = 0; et < NET; ++et) {
                    u32x4 w; w.x = pk2(C[2 * kk][et].x, C[2 * kk][et].y); w.y = pk2(C[2 * kk][et].z, C[2 * kk][et].w); w.z = pk2(C[2 * kk + 1][et].x, C[2 * kk + 1][et].y); w.w = pk2(C[2 * kk + 1][et].z, C[2 * kk + 1][et].w);
                    acc[et] = __builtin_amdgcn_mfma_f32_16x16x32_bf16(qs, __builtin_bit_cast(bf16x8, w), acc[et], 0, 0, 0);
                }
                if (IS_ML) {
                    const f32x4 n0 = *(const LAS f32x4*)(nq + 32 * kk), n1 = *(const LAS f32x4*)(nq + 32 * kk + 16);
                    u32x4 w; w.x = pk2(n0.x, n0.y); w.y = pk2(n0.z, n0.w); w.z = pk2(n1.x, n1.y); w.w = pk2(n1.z, n1.w);
                    if (fr != 0) w = (u32x4){0u, 0u, 0u, 0u};
                    accd = __builtin_amdgcn_mfma_f32_16x16x32_bf16(qs, __builtin_bit_cast(bf16x8, w), accd, 0, 0, 0);
                }
            }
            { const f32x4 ap = *(const LAS f32x4*)(gq + 128 + 16 * pt);
#pragma unroll
              for (int j = 0; j < 4; ++j) {
#pragma unroll
                for (int et = 0; et < NET; ++et) acc[et][j] *= ap[j];
                accd[j] *= ap[j]; } }
            __builtin_amdgcn_sched_barrier(0);
#pragma unroll
            for (int kk = 0; kk < 2; ++kk) {
                if (2 * kk <= pt) {
                    u32x4 w; w.x = pk2(ST[2 * kk].x, ST[2 * kk].y); w.y = pk2(ST[2 * kk].z, ST[2 * kk].w); w.z = pk2(ST[2 * kk + 1].x, ST[2 * kk + 1].y); w.w = pk2(ST[2 * kk + 1].z, ST[2 * kk + 1].w);
                    const bf16x8 pf = __builtin_bit_cast(bf16x8, w);
                    u32x2 vlo[2], vhi[2];
                    ds_tr16x4(va + (32 * kk + 4 * fq + tr_q) * CH_PITCH + 8 * tr_p + 64 * hf, vlo, vhi);
#pragma unroll
                    for (int et = 0; et < NET; ++et) acc[et] = __builtin_amdgcn_mfma_f32_16x16x32_bf16(pf, mk_frag(vlo[et], vhi[et]), acc[et], 0, 0, 0);
                    if (IS_ML) accd = __builtin_amdgcn_mfma_f32_16x16x32_bf16(pf, ones, accd, 0, 0, 0);
                }
            }
            __builtin_amdgcn_sched_barrier(0);
#pragma unroll
            for (int j = 0; j < 4; ++j) {
                const int p = 16 * pt + 4 * fq + j, tl = dir ? 63 - p : p, row = rowbase + tl;
                float inv = 1.f;
                if (IS_ML) { const float den = __shfl(accd[j], lane & 48); inv = 1.f / fmaxf(fabsf(den), 1.f); }
#pragma unroll
                for (int et = 0; et < NET; ++et) {
                    const float o = acc[et][j] * inv;
                    const int cof = (IS_ML ? 384 : 0) + h * 64 + 32 * hf + 16 * et + fr;
                    if (dir == 0) Y[(size_t)row * D + 384 + cof] = (bf16)f2bf(o); else OB[(size_t)row * 640 + cof] = (bf16)f2bf(o);
                }
            }
        }
        __builtin_amdgcn_sched_barrier(0);
#pragma unroll
        for (int dt = 0; dt < 4; ++dt)
#pragma unroll
            for (int et = 0; et < NET; ++et) C[dt][et] *= adec;
        f32x4 accn[4];
        if (IS_ML) {
#pragma unroll
            for (int dt = 0; dt < 4; ++dt) { accn[dt] = *(const LAS f32x4*)(nq + 16 * dt) * adec; if (fr != 0) accn[dt] = (f32x4){0.f, 0.f, 0.f, 0.f}; }
        }
#pragma unroll
        for (int kk = 0; kk < 2; ++kk) {
            u32x2 vlo[2], vhi[2], klo[4], khi[4];
            ds_tr16x4(va + (32 * kk + 4 * fq + tr_q) * CH_PITCH + 8 * tr_p + 64 * hf, vlo, vhi);
            ds_tr16x8(ka + (32 * kk + 4 * fq + tr_q) * CH_PITCH + 8 * tr_p, klo, khi);
            const f32x4 wl = *(const LAS f32x4*)(gq + 192 + 32 * kk), wh = *(const LAS f32x4*)(gq + 192 + 32 * kk + 16);
#pragma unroll
            for (int dt = 0; dt < 4; ++dt) {
                u32x4 w;
                w.x = pk2(__uint_as_float(klo[dt].x << 16) * wl[0], __uint_as_float(klo[dt].x & 0xffff0000u) * wl[1]);
                w.y = pk2(__uint_as_float(klo[dt].y << 16) * wl[2], __uint_as_float(klo[dt].y & 0xffff0000u) * wl[3]);
                w.z = pk2(__uint_as_float(khi[dt].x << 16) * wh[0], __uint_as_float(khi[dt].x & 0xffff0000u) * wh[1]);
                w.w = pk2(__uint_as_float(khi[dt].y << 16) * wh[2], __uint_as_float(khi[dt].y & 0xffff0000u) * wh[3]);
                const bf16x8 kf = __builtin_bit_cast(bf16x8, w);
#pragma unroll
                for (int et = 0; et < NET; ++et) C[dt][et] = __builtin_amdgcn_mfma_f32_16x16x32_bf16(kf, mk_frag(vlo[et], vhi[et]), C[dt][et], 0, 0, 0);
                if (IS_ML) accn[dt] = __builtin_amdgcn_mfma_f32_16x16x32_bf16(kf, ones, accn[dt], 0, 0, 0);
            }
        }
        if (IS_ML) { if (fr == 0) {
#pragma unroll
            for (int dt = 0; dt < 4; ++dt) *(LAS f32x4*)(nvec + 4 * fq + 16 * dt) = accn[dt]; } }
        asm volatile("s_waitcnt lgkmcnt(0)" ::: "memory");
        __syncthreads();
    }
}

#ifndef FAST_CHAIN
#define FAST_CHAIN 1
#endif
constexpr int NCHWG = 80;
__device__ __forceinline__ void phase_mix(Frame& F, int layer) {
    const bool last = layer == 1;
    const bf16* ftl = WSP(const bf16, WS_FTL) + (size_t)layer * 2 * 384 * 4096;
    if (FAST_CHAIN) {
        if (F.wg < NCHWG) {
            {
                const int cl = F.wave >> 1, hf = F.wave & 1, c = F.wg * 4 + cl;
                LAS unsigned char* img = F.lds + cl * CH_WAVE_LDS;
                if (c < 192) { const int b = c / 12, r = c % 12; chain_fast<false>(F, layer, b, r >> 1, r & 1, img, hf); }
                else { const int i = c - 192; chain_fast<true>(F, layer, i >> 3, (i & 7) >> 1, i & 1, img, hf); }
            }
        } else {
            const int nh = F.G - NCHWG, w = F.wg - NCHWG;
#ifndef FAST_HY
#define FAST_HY 1
#endif
            if (FAST_HY) {
                for (int u = w; u < 384; u += nh) hyena_unit_fast<LL>(F, layer, u, WSP(const bf16, WS_HYTL), ftl, WSP(bf16, WS_YHTL));
                if (!last) for (int u = w; u < 384; u += nh) hyena_unit_fast<LC>(F, layer, u, WSP(const bf16, WS_HYTC), WSP(const bf16, WS_FTC), WSP(bf16, WS_YHTC));
            } else {
                for (int u = w; u < 384; u += nh) hyena_unit_naive<LL>(F, layer, u, WSP(const bf16, WS_HYTL), ftl, WSP(bf16, WS_YHTL));
                if (!last) for (int u = w; u < 384; u += nh) hyena_unit_naive<LC>(F, layer, u, WSP(const bf16, WS_HYTC), WSP(const bf16, WS_FTC), WSP(bf16, WS_YHTC));
            }
        }
    } else {
        for (int u = F.wg; u < 384; u += F.G) hyena_unit_naive<LL>(F, layer, u, WSP(const bf16, WS_HYTL), ftl, WSP(bf16, WS_YHTL));
        if (!last) for (int u = F.wg; u < 384; u += F.G) hyena_unit_naive<LC>(F, layer, u, WSP(const bf16, WS_HYTC), WSP(const bf16, WS_FTC), WSP(bf16, WS_YHTC));
        for (int c = F.wg + F.wave * F.G; c < 320; c += F.G * NWAVES) chain_naive(F, layer, c);
    }
}

__device__ __forceinline__ void phase_combine(Frame& F, int layer) {
    const bool last = layer == 1;
    const int gw = F.wg * NWAVES + F.wave, NGW = F.G * NWAVES, lane = F.lane;
    const int nrows = last ? TOKL : TOK;
    bf16* Y = WSP(bf16, WS_Y); const bf16* OB = WSP(const bf16, WS_OB); const bf16* RET = WSP(const bf16, WS_RET); const bf16* ML = WSP(const bf16, WS_ML);
    for (int row = gw; row < nrows; row += NGW) {
#pragma unroll
        for (int hh = 0; hh < 10; ++hh) {
            const int cof = hh * 64 + lane;
            const float x = bf2f(Y[(size_t)row * D + 384 + cof]) + bf2f(OB[(size_t)row * 640 + cof]);
            const float mu = wave_sum(x) * (1.f / 64.f), xc = x - mu;
            const float var = wave_sum(xc * xc) * (1.f / 64.f);
            const float nrm = xc * rsqrtf(var + 1e-6f);
            float gate;
            if (hh < 6) gate = siluf_(bf2f(RET[(size_t)row * 1536 + 1152 + cof]));
            else gate = sigmoidf_(bf2f(ML[(size_t)row * 1024 + 768 + (cof - 384)]));
            Y[(size_t)row * D + 384 + cof] = (bf16)f2bf(nrm * gate);
        }
    }
    LAS float* scr = (LAS float*)(F.lds + F.wave * 16640);
    const int nitL = NB * 6 * 32, nitC = last ? 0 : NB * 6 * 4;
    for (int it = gw; it < nitL + nitC; it += NGW) {
        const bf16* src; int L, rowbase, b, cb, tb;
        if (it < nitL) { b = it / 192; const int r = it % 192; cb = r / 32; tb = r % 32; L = LL; src = WSP(const bf16, WS_YHTL); rowbase = b * LL; }
        else { const int i2 = it - nitL; b = i2 / 24; const int r = i2 % 24; cb = r / 4; tb = r % 4; L = LC; src = WSP(const bf16, WS_YHTC); rowbase = TOKL + b * LC; }
        for (int cc = 0; cc < 64; ++cc) scr[cc * 65 + lane] = bf2f(src[((size_t)(b * 384 + cb * 64 + cc)) * L + tb * 64 + lane]);
        asm volatile("s_waitcnt lgkmcnt(0)" ::: "memory");
        for (int tt = 0; tt < 64; ++tt) Y[(size_t)(rowbase + tb * 64 + tt) * D + cb * 64 + lane] = (bf16)f2bf(scr[lane * 65 + tt]);
        asm volatile("s_waitcnt lgkmcnt(0)" ::: "memory");
    }
}

__device__ __forceinline__ void phase_norm_router(Frame& F) {
    const int gw = F.wg * NWAVES + F.wave, NGW = F.G * NWAVES, lane = F.lane;
    const float* g = inp(F, I_GFFN) + 1 * D; const float* wr = inp(F, I_ROUTER); const float* br = inp(F, I_ROUTERB);
    unsigned* cnt = WSP(unsigned, WS_CTL) + CW_CNT;
    for (int row = gw; row < TOKL; row += NGW) {
        float keep[16];
        norm_mod_row(xrow_ptr(F, row, false), g, mod_ptr(F, 1, row, 3), mod_ptr(F, 1, row, 4), WSP(bf16, WS_H) + (size_t)row * D, lane, keep);
        float lg[8];
#pragma unroll
        for (int e = 0; e < 8; ++e) lg[e] = 0.f;
#pragma unroll
        for (int j = 0; j < 4; ++j)
#pragma unroll
            for (int i = 0; i < 4; ++i) { const int k = 256 * j + 4 * lane + i; const f32x4 w0 = *(const f32x4*)(wr + k * 8), w1 = *(const f32x4*)(wr + k * 8 + 4); const float x = keep[4 * j + i];
                lg[0] += x * w0.x; lg[1] += x * w0.y; lg[2] += x * w0.z; lg[3] += x * w0.w; lg[4] += x * w1.x; lg[5] += x * w1.y; lg[6] += x * w1.z; lg[7] += x * w1.w; }
#pragma unroll
        for (int e = 0; e < 8; ++e) lg[e] = wave_sum(lg[e]) + br[e];
        int e0 = 0; float v0 = lg[0];
#pragma unroll
        for (int e = 1; e < 8; ++e) if (lg[e] > v0) { v0 = lg[e]; e0 = e; }
        int e1 = -1; float v1 = -3.0e38f;
#pragma unroll
        for (int e = 0; e < 8; ++e) if (e != e0 && lg[e] > v1) { v1 = lg[e]; e1 = e; }
        const float w1 = 1.f / (1.f + __expf(v0 - v1)), w0 = 1.f - w1;
        if (lane == 0) {
            const unsigned p0 = atomicAdd(cnt + e0, 1u), p1 = atomicAdd(cnt + e1, 1u);
            WSP(int, WS_TOPE)[row * 2] = e0; WSP(int, WS_TOPE)[row * 2 + 1] = e1;
            WSP(float, WS_TOPW)[row * 2] = w0; WSP(float, WS_TOPW)[row * 2 + 1] = w1;
            WSP(int, WS_TOPP)[row * 2] = (int)p0; WSP(int, WS_TOPP)[row * 2 + 1] = (int)p1;
        }
    }
}
__device__ __forceinline__ void phase_route_tables(Frame& F) {
    const unsigned* cnt = WSP(const unsigned, WS_CTL) + CW_CNT;
    int off[9]; off[0] = 0;
#pragma unroll
    for (int e = 0; e < 8; ++e) { const int c = (int)__hip_atomic_load(cnt + e, __ATOMIC_RELAXED, __HIP_MEMORY_SCOPE_AGENT); off[e + 1] = off[e] + ((c + 255) >> 8) * 256; }
    const int gt = F.wg * NTHR + F.tid, NGT = F.G * NTHR;
    int* rowidx = WSP(int, WS_ROWIDX); int* slot = WSP(int, WS_SLOT); int* tilee = WSP(int, WS_TILEE);
    for (int i = gt; i < MAXTILES * 256; i += NGT) {
        int e = 0;
#pragma unroll
        for (int q = 1; q < 8; ++q) if (i >= off[q]) e = q;
        const int c = (int)cnt[e];
        if (i >= off[8] || i - off[e] >= c) rowidx[i] = 0;
    }
    for (int i = gt; i < TOKL * 2; i += NGT) {
        const int e = WSP(const int, WS_TOPE)[i], pos = WSP(const int, WS_TOPP)[i];
        int o = 0;
#pragma unroll
        for (int q = 0; q < 8; ++q) if (e == q) o = off[q];
        const int s = o + pos; slot[i] = s; rowidx[s] = i >> 1;
    }
    for (int i = gt; i < MAXTILES + 1; i += NGT) {
        if (i == MAXTILES) tilee[MAXTILES] = off[8] >> 8;
        else { int e = 0;
#pragma unroll
            for (int q = 1; q < 8; ++q) if (i * 256 >= off[q]) e = q;
            tilee[i] = e; }
    }
}

__device__ __forceinline__ void moe_pass_gemm1_fast(Frame& F, int t0, int t1) {
    pg8::OrderMoe S; S.o.init(t1 - t0, NFF1 / 256, F.G, F.wg); S.rowidx = WSP(const int, WS_ROWIDX); S.tilee = WSP(const int, WS_TILEE); S.t0 = t0; S.bstride = (size_t)NFF1 * D; S.gather = true;
    EpiSwiglu E{WSP(bf16, WS_MACT), 0};
    pg8::gemm_phase(F.lds, WSP(const bf16, WS_H), D, WSP(const bf16, WS_MW13), D, D, S, E);
}
__device__ __forceinline__ void moe_pass_gemm2_fast(Frame& F, int t0, int t1) {
    pg8::OrderMoe S; S.o.init(t1 - t0, D / 256, F.G, F.wg); S.rowidx = WSP(const int, WS_ROWIDX); S.tilee = WSP(const int, WS_TILEE); S.t0 = t0; S.bstride = (size_t)D * DFF; S.gather = false;
    EpiBf16Out E{WSP(bf16, WS_EOUT), D, t0 * 256};
    pg8::gemm_phase(F.lds, WSP(const bf16, WS_MACT), DFF, WSP(const bf16, WS_MW2), DFF, DFF, S, E);
}
__device__ __forceinline__ void phase_final(Frame& F) {
    const int gw = F.wg * NWAVES + F.wave, NGW = F.G * NWAVES, lane = F.lane;
    const float* gf = inp(F, I_GFINAL); const bf16* eo = WSP(const bf16, WS_EOUT);
    for (int row = gw; row < TOKL; row += NGW) {
        const int s0 = WSP(const int, WS_SLOT)[row * 2], s1 = WSP(const int, WS_SLOT)[row * 2 + 1];
        const float w0 = WSP(const float, WS_TOPW)[row * 2], w1 = WSP(const float, WS_TOPW)[row * 2 + 1];
        const float* m5 = mod_ptr(F, 1, row, 5);
        float* xr = outp(F) + (size_t)row * D;
        f32x4 v[4]; float s = 0.f;
#pragma unroll
        for (int j = 0; j < 4; ++j) {
            const int c = 256 * j + 4 * lane;
            const f32x4 a = ld_bf16x4(eo + (size_t)s0 * D + c), b = ld_bf16x4(eo + (size_t)s1 * D + c), m = *(const f32x4*)(m5 + c);
            v[j] = *(const f32x4*)(xr + c) + m * (a * w0 + b * w1);
            s += (v[j].x * v[j].x + v[j].y * v[j].y) + (v[j].z * v[j].z + v[j].w * v[j].w);
        }
        const float r = rsqrtf(wave_sum(s) * (1.f / 1024.f) + 1e-6f);
#pragma unroll
        for (int j = 0; j < 4; ++j) { const int c = 256 * j + 4 * lane; const f32x4 g = *(const f32x4*)(gf + c); *(f32x4*)(xr + c) = v[j] * r * g; }
    }
}

#ifndef REP_WIN
#define REP_WIN 1
#endif
#ifndef REP_MIX
#define REP_MIX 1
#endif
#ifndef REP_GATE
#define REP_GATE 1
#endif
#ifndef REP_UP
#define REP_UP 1
#endif
#ifndef REP_FFN1
#define REP_FFN1 1
#endif
#ifndef REP_MOE
#define REP_MOE 1
#endif
#ifndef REP_NORM
#define REP_NORM 1
#endif
#ifndef REP_P0
#define REP_P0 1
#endif
__global__ void __launch_bounds__(NTHR, 2) hybrid_fwd(Params prm) {
    extern __shared__ __attribute__((aligned(16))) unsigned char lds_raw[];
    Frame F;
    F.lds = (LAS unsigned char*)lds_raw; F.ws = prm.ws;
    F.tid = threadIdx.x; F.lane = F.tid & 63; F.wave = __builtin_amdgcn_readfirstlane(F.tid >> 6); F.G = gridDim.x; F.wg = blockIdx.x;
    volatile LAS unsigned* MISC = (volatile LAS unsigned*)(F.lds + MISC_OFF);
    if (F.tid < 64) MISC[F.tid] = 0u;
    if (F.tid < 33) { const unsigned long long v = F.tid < 32 ? (unsigned long long)prm.in[F.tid] : (unsigned long long)prm.out; *(LAS unsigned long long*)(F.lds + PTAB_OFF + 8 * F.tid) = v; }
    __syncthreads();
    XcdBarrier bar = xcd_barrier_post(WSP(unsigned, WS_CTL) + CW_BAR, MISC + 8);
#define RELAUNDER() do { { unsigned long long _w = (unsigned long long)F.ws; asm volatile("" : "+s"(_w)); F.ws = (unsigned char*)_w; } \
        { unsigned _t = (unsigned)F.tid; asm volatile("" : "+v"(_t)); F.tid = (int)_t; F.lane = F.tid & 63; F.wave = __builtin_amdgcn_readfirstlane(F.tid >> 6); } \
        { unsigned _g = (unsigned)F.G, _b = (unsigned)F.wg; asm volatile("" : "+s"(_g), "+s"(_b)); F.G = (int)_g; F.wg = (int)_b; } \
        { unsigned _l = (unsigned)(size_t)F.lds; asm volatile("" : "+s"(_l)); F.lds = (LAS unsigned char*)(size_t)_l; } } while (0)
#define GRID_BAR() do { { unsigned long long _b = (unsigned long long)bar.bar; unsigned _x = bar.x; asm volatile("" : "+s"(_b), "+s"(_x)); bar.bar = (unsigned*)_b; bar.x = _x; } xcd_barrier(bar); RELAUNDER(); } while (0)

    for (int rp = 0; rp < REP_P0; ++rp) { phase_p0(F); write_bias(F);
    GRID_BAR(); }
#pragma unroll 1
    for (int layer = 0; layer < 2; ++layer) {
        const bool last = layer == 1;
        const int rows_all = TOK, rows_out = last ? TOKL : TOK;
        const float* modbase = WSP(const float, WS_MOD) + (size_t)layer * 17 * 6144;
        for (int rp = 0; rp < REP_NORM; ++rp) { phase_norm(F, layer, rows_all, !last, 0);
        GRID_BAR(); }
        for (int rp = 0; rp < REP_WIN; ++rp) {
        { EpiWin E{WSP(const float, WS_BIAS) + layer * NWP, WSP(bf16, WS_HYTL), WSP(bf16, WS_HYTC), WSP(bf16, WS_RET), WSP(bf16, WS_ML), WSP(float, WS_MLG)};
          gemm_fast(F, WSP(const bf16, WS_H), D, WSP(const bf16, WS_WIN), D, D, rows_all, NW1, E); }
        GRID_BAR(); }
        for (int rp = 0; rp < REP_MIX; ++rp) { phase_mix(F, layer);
        GRID_BAR(); }
        phase_combine(F, layer);
        GRID_BAR();
        for (int rp = 0; rp < REP_GATE; ++rp) {
        { EpiGate E{WSP(const float, WS_BIAS) + layer * NWP + NW1, WSP(bf16, WS_GATES)};
          gemm_fast(F, WSP(const bf16, WS_H), D, WSP(const bf16, WS_WIN) + (size_t)NW1 * D, D, D, rows_out, NGATE, E); }
        GRID_BAR(); }
        for (int rp = 0; rp < REP_UP; ++rp) {
        { EpiUp E{WSP(const bf16, WS_GATES), WSP(bf16, WS_H)};
          gemm_fast(F, WSP(const bf16, WS_Y), D, WSP(const bf16, WS_WUP), D, D, rows_out, D, E); }
        GRID_BAR(); }
        { EpiResid E{last ? outp(F) : inp(F, I_X), last ? WSP(const float, WS_XC) : inp(F, I_CTX), outp(F), WSP(float, WS_XC), modbase, 2};
          gemm_fast(F, WSP(const bf16, WS_H), D, WSP(const bf16, WS_WOUT), D, D, rows_out, D, E); }
        GRID_BAR();
        if (!last) {
            phase_norm(F, layer, rows_out, false, 3);
            { const int gw = F.wg * NWAVES + F.wave, NGW = F.G * NWAVES; LAS float* scr = (LAS float*)(F.lds + F.wave * 8704);
              conv_weights_ffn(inp(F, I_FW1), inp(F, I_FW3), inp(F, I_FW2), WSP(bf16, WS_W13), WSP(bf16, WS_W2), gw, NGW, scr, F.lane);
              conv_weights_win(F, 1, gw, NGW, scr);
              conv_weights_upout(F, 1, gw, NGW, scr); }
            GRID_BAR();
            for (int rp = 0; rp < REP_FFN1; ++rp) {
            { EpiSwiglu E{WSP(bf16, WS_ACT), 0};
              gemm_fast(F, WSP(const bf16, WS_H), D, WSP(const bf16, WS_W13), D, D, rows_out, NFF1, E); }
            GRID_BAR(); }
            { EpiResid E{outp(F), WSP(const float, WS_XC), outp(F), WSP(float, WS_XC), modbase, 5};
              gemm_fast(F, WSP(const bf16, WS_ACT), DFF, WSP(const bf16, WS_W2), DFF, DFF, rows_out, D, E); }
            GRID_BAR();
        }
    }
    phase_norm_router(F);
    { const int gw = F.wg * NWAVES + F.wave, NGW = F.G * NWAVES; LAS float* scr = (LAS float*)(F.lds + F.wave * 8704);
#pragma unroll 1
      for (int e = 0; e < NE; ++e)
          conv_weights_ffn(inp(F, I_MW1) + (size_t)e * D * DFF, inp(F, I_MW3) + (size_t)e * D * DFF, inp(F, I_MW2) + (size_t)e * DFF * D,
                           WSP(bf16, WS_MW13) + (size_t)e * NFF1 * D, WSP(bf16, WS_MW2) + (size_t)e * D * DFF, gw, NGW, scr, F.lane); }
    GRID_BAR();
    phase_route_tables(F);
    GRID_BAR();
    const int ntiles = __builtin_amdgcn_readfirstlane(WSP(const int, WS_TILEE)[MAXTILES]);
#pragma unroll 1
    for (int p = 0; p < NPASS; ++p) {
        const int t0 = p * PASS_TILES, t1 = min(ntiles, t0 + PASS_TILES);
        for (int rp = 0; rp < REP_MOE; ++rp) {
        if (t0 < t1) moe_pass_gemm1_fast(F, t0, t1);
        GRID_BAR();
        if (t0 < t1) moe_pass_gemm2_fast(F, t0, t1);
        GRID_BAR(); }
    }
    phase_final(F);
}

extern "C" void kernel_launch(void* const* d_in, const int* in_sizes, int n_in, void* d_out, int out_size, void* d_ws, size_t ws_size, hipStream_t stream) {
    static int grid = 0;
    if (grid == 0) {
        if (n_in != 32 || out_size != TOKL * D || ws_size < WS_END) { fprintf(stderr, "kernel_launch: unexpected arguments (n_in %d, out %d, ws %zu)\n", n_in, out_size, ws_size); grid = -1; return; }
        int dev = 0, cus = 0;
        if (hipGetDevice(&dev) != hipSuccess || hipDeviceGetAttribute(&cus, hipDeviceAttributeMultiprocessorCount, dev) != hipSuccess) { grid = -1; return; }
        if (hipFuncSetAttribute((const void*)hybrid_fwd, hipFuncAttributeMaxDynamicSharedMemorySize, LDS_BYTES) != hipSuccess) { grid = -1; return; }
        int per_cu = 0;
        (void)hipOccupancyMaxActiveBlocksPerMultiprocessor(&per_cu, (const void*)hybrid_fwd, NTHR, LDS_BYTES);
        (void)hipGetLastError();
        grid = cus;
    }
    if (grid < 0) return;
    (void)hipMemsetAsync((char*)d_ws + WS_CTL, 0, CTL_ZERO_BYTES, stream);
    Params p{};
    for (int i = 0; i < 32; ++i) p.in[i] = (const float*)d_in[i];
    p.out = (float*)d_out; p.ws = (unsigned char*)d_ws;
    hipLaunchKernelGGL(hybrid_fwd, dim3(grid), dim3(NTHR), LDS_BYTES, stream, p);
}
```

```cpp
#include <hip/hip_runtime.h>
#include <stdint.h>
#include <stdio.h>

#define LAS __attribute__((address_space(3)))
typedef unsigned short bf16;
typedef short bf16x8 __attribute__((ext_vector_type(8)));
typedef float f32x4 __attribute__((ext_vector_type(4)));
typedef unsigned u32x4 __attribute__((ext_vector_type(4)));
typedef unsigned u32x2 __attribute__((ext_vector_type(2)));

constexpr int D = 1024, NB = 16, LL = 2048, LC = 256;
constexpr int TOKL = NB * LL, TOKC = NB * LC, TOK = TOKL + TOKC;
constexpr int HYW = 384, RETW = 384, MLW = 256;
constexpr int NIN = 6800, NW1 = 3840, NGATE = 3072, NWP = 6912;
constexpr int DFF = 2816, NFF1 = 5632, NE = 8;
constexpr int NWAVES = 8, NTHR = 512;
constexpr int MAXTILES = 272, PASS_TILES = 64, NPASS = 5;

constexpr size_t MiB = 1u << 20;
constexpr size_t WS_CTL = 0, CTL_ZERO_BYTES = 1 * MiB;
constexpr size_t WS_MOD = 1 * MiB;
constexpr size_t WS_BIAS = 2 * MiB;
constexpr size_t WS_ROPE = 2 * MiB + 256 * 1024;
constexpr size_t WS_TOPE = 3 * MiB;
constexpr size_t WS_TOPW = 3 * MiB + 256 * 1024;
constexpr size_t WS_TOPP = 3 * MiB + 512 * 1024;
constexpr size_t WS_SLOT = 3 * MiB + 768 * 1024;
constexpr size_t WS_ROWIDX = 4 * MiB;
constexpr size_t WS_TILEE = 4 * MiB + 512 * 1024;
constexpr size_t WS_FTL = 5 * MiB;
constexpr size_t WS_FTC = 17 * MiB;
constexpr size_t WS_WIN = 18 * MiB;
constexpr size_t WS_WUP = 32 * MiB;
constexpr size_t WS_WOUT = 34 * MiB;
constexpr size_t WS_XC = 36 * MiB;
constexpr size_t WS_H = 52 * MiB;
constexpr size_t WS_Y = 124 * MiB;
constexpr size_t WS_U = 196 * MiB;
constexpr size_t WS_RET = WS_U;
constexpr size_t WS_ML = WS_U + 108 * MiB;
constexpr size_t WS_MLG = WS_U + 180 * MiB;
constexpr size_t WS_OB = WS_U + 183 * MiB;
constexpr size_t WS_YHTL = WS_U + 228 * MiB;
constexpr size_t WS_YHTC = WS_U + 252 * MiB;
constexpr size_t WS_HYTL = WS_U + 255 * MiB;
constexpr size_t WS_HYTC = WS_U + 327 * MiB;
constexpr size_t WS_END = WS_U + 336 * MiB;
constexpr size_t WS_GATES = WS_U;
constexpr size_t WS_ACT = WS_U;
constexpr size_t WS_W13 = WS_U + 204 * MiB;
constexpr size_t WS_W2 = WS_U + 216 * MiB;
constexpr size_t WS_MW13 = WS_Y;
constexpr size_t WS_MW2 = WS_Y + 88 * MiB;
constexpr size_t WS_MACT = WS_Y + 132 * MiB;
constexpr size_t WS_EOUT = WS_Y + 220 * MiB;
static_assert(WS_EOUT + (size_t)MAXTILES * 256 * 1024 * 2 <= WS_END, "map");
static_assert(WS_GATES + (size_t)TOK * NGATE * 2 <= WS_YHTL, "gates overlay");

constexpr int CW_BAR = 4096;
constexpr int CW_CNT = 16384;

constexpr int LDS_BYTES = 147456;
constexpr int MISC_OFF = 147456 - 256;

__device__ __forceinline__ float bf2f(bf16 b) { return __uint_as_float(((unsigned)b) << 16); }
__device__ __forceinline__ unsigned f2bf(float f) { unsigned u = __float_as_uint(f); return (u + 0x7fffu + ((u >> 16) & 1u)) >> 16; }
__device__ __forceinline__ unsigned pk2(float lo, float hi) { return f2bf(lo) | (f2bf(hi) << 16); }
__device__ __forceinline__ float wave_sum(float v) {
#pragma unroll
    for (int o = 1; o < 64; o <<= 1) v += __shfl_xor(v, o);
    return v;
}
__device__ __forceinline__ float sigmoidf_(float x) { return 1.0f / (1.0f + __expf(-x)); }
__device__ __forceinline__ float siluf_(float x) { return x / (1.0f + __expf(-x)); }

#define XB_TMO      128
#define XB_XCNT(j)  (256  + 64 * (j))
#define XB_XSUB(j)  (1280 + 64 * (j))
#define XB_XGEN(j)  (2304 + 64 * (j))
#define XB_TOP      3328
#define XB_TOPGEN   3392
#define XCD_BAR_WORDS 3456
#define XB_SPIN_CAP (1u << 22)
__device__ __forceinline__ unsigned xb_ld(unsigned* p)              { return __hip_atomic_load(p, __ATOMIC_RELAXED, __HIP_MEMORY_SCOPE_AGENT); }
__device__ __forceinline__ unsigned xb_add(unsigned* p, unsigned v) { return __hip_atomic_fetch_add(p, v, __ATOMIC_RELAXED, __HIP_MEMORY_SCOPE_AGENT); }
__device__ __forceinline__ unsigned xb_xcc_id() { return (unsigned)__builtin_amdgcn_s_getreg((3 << 11) | 20) & 0xFu; }
#define XB_SPIN(cond, bar) do { unsigned _sp = 0; while (cond) { __builtin_amdgcn_s_sleep(1); \
    if ((++_sp & 255u) == 0u) { if (xb_ld(&(bar)[XB_TMO])) break; if (_sp > XB_SPIN_CAP) { atomicAdd(&(bar)[XB_TMO], 1u); break; } } } } while (0)
struct XcdBarrier { unsigned* bar; unsigned x; volatile LAS unsigned* st; };
__device__ __forceinline__ XcdBarrier xcd_barrier_post(unsigned* bar, volatile LAS unsigned* st) {
    XcdBarrier b; b.bar = bar; b.x = xb_xcc_id(); b.st = st;
    if (threadIdx.x == 0) (void)xb_add(&bar[XB_XCNT(b.x)], 1u);
    return b;
}
__device__ __forceinline__ void xcd_barrier_complete(unsigned* bar, unsigned x, unsigned& nloc, unsigned& nx) {
    const unsigned G = gridDim.x * gridDim.y * gridDim.z;
    unsigned sum, cnt, mine, sp = 0u;
    for (;;) {
        sum = 0u; cnt = 0u; mine = 0u;
#pragma unroll 1
        for (unsigned j = 0; j < 16; ++j) { const unsigned c = xb_ld(&bar[XB_XCNT(j)]); sum += c; cnt += (c > 0u) ? 1u : 0u; }
        mine = xb_ld(&bar[XB_XCNT(x)]);
        if (sum == G) break;
        __builtin_amdgcn_s_sleep(1);
        if ((++sp & 255u) == 0u) { if (xb_ld(&bar[XB_TMO])) break; if (sp > XB_SPIN_CAP) { atomicAdd(&bar[XB_TMO], 1u); break; } }
    }
    nloc = mine > 0u ? mine : 1u; nx = cnt > 0u ? cnt : 1u;
}
__device__ __forceinline__ void xcd_barrier(const XcdBarrier& b) {
    asm volatile("s_waitcnt vmcnt(0)" ::: "memory");
    __syncthreads();
    if (threadIdx.x == 0) {
        unsigned* bar = b.bar;
        __builtin_amdgcn_s_waitcnt(0);
        unsigned nloc = b.st[0], nx = b.st[1];
        if (nloc == 0u) { xcd_barrier_complete(bar, b.x, nloc, nx); b.st[0] = nloc; b.st[1] = nx; }
        const unsigned old = xb_add(&bar[XB_XSUB(b.x)], 1u);
        const unsigned gen = old / nloc;
        if (old + 1u == (gen + 1u) * nloc) {
            __builtin_amdgcn_fence(__ATOMIC_RELEASE, "agent");
            asm volatile("s_waitcnt vmcnt(0)" ::: "memory");
            const unsigned og = xb_add(&bar[XB_TOP], 1u);
            const unsigned tg = og / nx;
            if (og + 1u == (tg + 1u) * nx) xb_add(&bar[XB_TOPGEN], 1u);
            else XB_SPIN(xb_ld(&bar[XB_TOPGEN]) == tg, bar);
            __builtin_amdgcn_fence(__ATOMIC_ACQUIRE, "agent");
            xb_add(&bar[XB_XGEN(b.x)], 1u);
            asm volatile("s_waitcnt vmcnt(0)" ::: "memory");
        } else {
            XB_SPIN(xb_ld(&bar[XB_XGEN(b.x)]) == gen, bar);
            __builtin_amdgcn_fence(__ATOMIC_ACQUIRE, "agent");
            asm volatile("s_waitcnt vmcnt(0)" ::: "memory");
        }
    }
    __syncthreads();
}

struct Params { const float* in[32]; float* out; unsigned char* ws; };
enum { I_X = 0, I_C, I_CTX, I_CCTX, I_WMOD, I_BMOD, I_GMIX, I_GFFN, I_WIN, I_BIN, I_HYCONV, I_HYF1, I_HYFB1, I_HYF2, I_HYFB2, I_HYF3, I_HYDECAY,
       I_HYSKIP, I_RETDECAY, I_MLCONV, I_MLGB, I_WUP, I_WOUT, I_FW1, I_FW3, I_FW2, I_ROUTER, I_ROUTERB, I_MW1, I_MW3, I_MW2, I_GFINAL };

struct Frame {
    LAS unsigned char* lds;
    unsigned char* ws;
    int tid, lane, wave, G, wg;
};
#define WSP(T, off) ((T*)(F.ws + (off)))
constexpr int PTAB_OFF = 147456 - 1024;
__device__ __forceinline__ const float* inp(const Frame& F, int i) {
    const LAS unsigned* t = (const LAS unsigned*)(F.lds + PTAB_OFF) + 2 * i;
    const unsigned lo = __builtin_amdgcn_readfirstlane(t[0]), hi = __builtin_amdgcn_readfirstlane(t[1]);
    return (const float*)(((unsigned long long)hi << 32) | lo);
}
__device__ __forceinline__ float* outp(const Frame& F) { return (float*)inp(F, 32); }

__device__ __forceinline__ int row_batch(int row) { return row < TOKL ? (row >> 11) : ((row - TOKL) >> 8); }
__device__ __forceinline__ const float* mod_ptr(const Frame& F, int layer, int row, int which) {
    const int r = row < TOKL ? (row >> 11) : 16;
    return WSP(const float, WS_MOD) + ((size_t)(layer * 17 + r) * 6 + which) * 1024;
}

template <class RowMap>
__device__ __forceinline__ void tr_item(const float* W, int K, int N, bf16* WT, int ldT, RowMap rm, LAS float* scr, int item, int lane) {
    const int nblk = (N + 31) / 32, kb = item / nblk, nb = item % nblk, k0 = 64 * kb, n0 = 32 * nb;
#pragma unroll 8
    for (int i = 0; i < 32; ++i) { const int kk = 2 * i + (lane >> 5); const int n = n0 + (lane & 31); scr[kk * 33 + (lane & 31)] = (n < N) ? W[(size_t)(k0 + kk) * N + n] : 0.f; }
    asm volatile("s_waitcnt lgkmcnt(0)" ::: "memory");
    const int c = lane & 7;
#pragma unroll
    for (int j = 0; j < 4; ++j) { const int nl = (lane >> 3) + 8 * j; const int n = n0 + nl; const LAS float* s = scr + (8 * c) * 33 + nl;
        u32x4 o; o.x = pk2(s[0 * 33], s[1 * 33]); o.y = pk2(s[2 * 33], s[3 * 33]); o.z = pk2(s[4 * 33], s[5 * 33]); o.w = pk2(s[6 * 33], s[7 * 33]);
        if (n < N) *(u32x4*)(WT + (size_t)rm(n) * ldT + k0 + 8 * c) = o; }
    asm volatile("s_waitcnt lgkmcnt(0)" ::: "memory");
}
struct RmId { __device__ __forceinline__ int operator()(int n) const { return n; } };
__device__ __forceinline__ int win_row(int n) {
    if (n < 1152) return n;
    if (n < 2688) return 1280 + (n - 1152);
    if (n < 3712) return 2816 + (n - 2688);
    if (n < 3728) return 1152 + (n - 3712);
    return 3840 + (n - 3728);
}
struct RmWin { __device__ __forceinline__ int operator()(int n) const { return win_row(n); } };
struct RmW1 { __device__ __forceinline__ int operator()(int n) const { return (n >> 4) * 32 + (n & 15); } };
struct RmW3 { __device__ __forceinline__ int operator()(int n) const { return (n >> 4) * 32 + 16 + (n & 15); } };

__device__ __forceinline__ void conv_weights_win(Frame& F, int layer, int gw, int NGW, LAS float* scr) {
    const float* W = inp(F, I_WIN) + (size_t)layer * D * NIN;
    const int items = (D / 64) * ((NIN + 31) / 32);
    for (int it = gw; it < items; it += NGW) tr_item(W, D, NIN, WSP(bf16, WS_WIN), D, RmWin(), scr, it, F.lane);
    bf16* wt = WSP(bf16, WS_WIN);
    for (int i = gw * 64 + F.lane; i < 112 * 1024 / 8; i += NGW * 64) *(u32x4*)(wt + (size_t)1168 * 1024 + (size_t)i * 8) = (u32x4){0u, 0u, 0u, 0u};
}
__device__ __forceinline__ void conv_weights_upout(Frame& F, int layer, int gw, int NGW, LAS float* scr) {
    const int items = (D / 64) * (D / 32);
    for (int it = gw; it < items; it += NGW) tr_item(inp(F, I_WUP) + (size_t)layer * D * D, D, D, WSP(bf16, WS_WUP), D, RmId(), scr, it, F.lane);
    for (int it = gw; it < items; it += NGW) tr_item(inp(F, I_WOUT) + (size_t)layer * D * D, D, D, WSP(bf16, WS_WOUT), D, RmId(), scr, it, F.lane);
}
__device__ __forceinline__ void conv_weights_ffn(const float* w1, const float* w3, const float* w2, bf16* w13t, bf16* w2t, int gw, int NGW, LAS float* scr, int lane) {
    const int i1 = (D / 64) * (DFF / 32), i2 = (DFF / 64) * (D / 32);
    for (int it = gw; it < i1; it += NGW) tr_item(w1, D, DFF, w13t, D, RmW1(), scr, it, lane);
    for (int it = gw; it < i1; it += NGW) tr_item(w3, D, DFF, w13t, D, RmW3(), scr, it, lane);
    for (int it = gw; it < i2; it += NGW) tr_item(w2, DFF, D, w2t, DFF, RmId(), scr, it, lane);
}

__device__ __forceinline__ void filter_item(Frame& F, int layer, int L, bf16* FT  , int pb, int ch, LAS float* tile  ) {
    const float* f1 = inp(F, I_HYF1) + layer * 33 * 64; const float* fb1 = inp(F, I_HYFB1) + layer * 64;
    const float* f2 = inp(F, I_HYF2) + layer * 64 * 64; const float* fb2 = inp(F, I_HYFB2) + layer * 64;
    const float* f3 = inp(F, I_HYF3) + (size_t)layer * 64 * 1536; const float* dec = inp(F, I_HYDECAY) + layer * 1536;
    const int lane = F.lane, n = ch * 64 + lane;
    const float b1 = fb1[lane], b2 = fb2[lane], adec = fabsf(dec[n]);
    for (int pl = 0; pl < 64; ++pl) {
        const int pos = pb * 64 + pl;
        const float t = (float)pos / (float)(L - 1);
        const float w = 6.283185307179586f * (float)pos / (float)L;
        float feat = 0.f;
        if (lane == 0) feat = t;
        else if (lane < 17) { const float band = 1e-4f + (float)(lane - 1) * ((15.0f - 1e-4f) / 15.0f); feat = cosf(w * band); }
        else if (lane < 33) { const float band = 1e-4f + (float)(lane - 17) * ((15.0f - 1e-4f) / 15.0f); feat = -sinf(w * band); }
        float a1 = b1;
        for (int i = 0; i < 33; ++i) a1 += __shfl(feat, i) * f1[i * 64 + lane];
        const float h1 = sinf(a1);
        float a2 = b2;
        for (int i = 0; i < 64; ++i) a2 += __shfl(h1, i) * f2[i * 64 + lane];
        const float h2 = sinf(a2);
        float a3 = 0.f;
        for (int i = 0; i < 64; ++i) a3 += __shfl(h2, i) * f3[i * 1536 + n];
        tile[pl * 65 + lane] = a3 * expf(-t * adec);
    }
    asm volatile("s_waitcnt lgkmcnt(0)" ::: "memory");
    const int pos = pb * 64 + lane;
    for (int cl = 0; cl < 64; ++cl) {
        const int nn = ch * 64 + cl, o = nn / 768, dir = (nn / 384) & 1, c = nn % 384;
        bf16* dst = FT + (size_t)(o * 384 + c) * (2 * L);
        const float v = tile[lane * 65 + cl];
        if (dir == 0) dst[L - pos] = (bf16)f2bf(v);
        else if (pos > 0) dst[L + pos] = (bf16)f2bf(v);
    }
    asm volatile("s_waitcnt lgkmcnt(0)" ::: "memory");
}

__device__ __forceinline__ void phase_p0(Frame& F) {
    const int gw = F.wg * NWAVES + F.wave, NGW = F.G * NWAVES;
    LAS float* sl = (LAS float*)F.lds;
    LAS float* red = (LAS float*)(F.lds + 17 * 4096);
    for (int i = F.tid; i < 17 * 1024; i += NTHR) { const int r = i >> 10, k = i & 1023; const float v = r < 16 ? inp(F, I_C)[r * 1024 + k] : inp(F, I_CCTX)[k]; sl[i] = siluf_(v); }
    __syncthreads();
    for (int item = F.wg; item < 2 * 384; item += F.G) {
        const int layer = item / 384, n0 = (item % 384) * 16, j = F.tid & 15, kp = F.tid >> 4;
        const float* W = inp(F, I_WMOD) + (size_t)layer * D * 6144;
        float acc[17];
#pragma unroll
        for (int r = 0; r < 17; ++r) acc[r] = 0.f;
        for (int k = kp * 32; k < kp * 32 + 32; ++k) { const float w = W[(size_t)k * 6144 + n0 + j];
#pragma unroll
            for (int r = 0; r < 17; ++r) acc[r] += sl[r * 1024 + k] * w; }
#pragma unroll
        for (int r = 0; r < 17; ++r) red[(kp * 17 + r) * 16 + j] = acc[r];
        __syncthreads();
        if (F.tid < 272) { const int r = F.tid >> 4, jj = F.tid & 15; float s = inp(F, I_BMOD)[layer * 6144 + n0 + jj];
            for (int q = 0; q < 32; ++q) s += red[(q * 17 + r) * 16 + jj];
            WSP(float, WS_MOD)[(size_t)(layer * 17 + r) * 6144 + n0 + jj] = s; }
        __syncthreads();
    }
    __syncthreads();
    LAS float* scr = (LAS float*)(F.lds + F.wave * 8704);
    conv_weights_win(F, 0, gw, NGW, scr);
    conv_weights_upout(F, 0, gw, NGW, scr);
    for (int i = gw * 64 + F.lane; i < 2048 * 32; i += NGW * 64) {
        const int t = i >> 5, j = i & 31, half = j >> 4, ii = j & 15;
        const float inv = 1.0f / powf(10000.0f, (float)ii / 16.0f);
        const float ang = (float)(half == 0 ? (t >> 6) : (t & 63)) * inv;
        WSP(float, WS_ROPE)[t * 64 + half * 32 + ii] = cosf(ang);
        WSP(float, WS_ROPE)[t * 64 + half * 32 + 16 + ii] = sinf(ang);
    }
    __syncthreads();
    LAS float* ftile = (LAS float*)(F.lds + F.wave * 16640);
    for (int it = gw; it < 1536 + 96; it += NGW) {
        if (it < 1536) { const int layer = it / 768, r = it % 768; filter_item(F, layer, LL, WSP(bf16, WS_FTL) + (size_t)layer * 2 * 384 * 4096, r / 24, r % 24, ftile); }
        else { const int r = it - 1536; filter_item(F, 0, LC, WSP(bf16, WS_FTC), r / 24, r % 24, ftile); }
    }
}
__device__ __forceinline__ void write_bias(Frame& F) {
    const int gt = (F.wg * NWAVES + F.wave) * 64 + F.lane, NGT = F.G * NTHR;
    for (int i = gt; i < 2 * NWP; i += NGT) {
        const int l = i / NWP, r = i % NWP; float v = 0.f;
        int n = -1;
        if (r < 1152) n = r; else if (r < 1168) n = 3712 + (r - 1152); else if (r < 1280) n = -1; else if (r < 2816) n = 1152 + (r - 1280); else if (r < 3840) n = 2688 + (r - 2816); else n = 3728 + (r - 3840);
        if (n >= 0) v = inp(F, I_BIN)[l * NIN + n];
        WSP(float, WS_BIAS)[i] = v;
    }
}

__device__ __forceinline__ void norm_mod_row(const float* xrow, const float* g, const float* shift, const float* scale, bf16* orow, int lane, float* keep  ) {
    f32x4 v[4]; float s = 0.f;
#pragma unroll
    for (int j = 0; j < 4; ++j) { v[j] = *(const f32x4*)(xrow + 256 * j + 4 * lane); s += (v[j].x * v[j].x + v[j].y * v[j].y) + (v[j].z * v[j].z + v[j].w * v[j].w); }
    const float r = rsqrtf(wave_sum(s) * (1.0f / 1024.0f) + 1e-6f);
#pragma unroll
    for (int j = 0; j < 4; ++j) {
        const f32x4 gg = *(const f32x4*)(g + 256 * j + 4 * lane), sh = *(const f32x4*)(shift + 256 * j + 4 * lane), sc = *(const f32x4*)(scale + 256 * j + 4 * lane);
        f32x4 o;
        o.x = (v[j].x * r * gg.x) * (1.f + sc.x) + sh.x; o.y = (v[j].y * r * gg.y) * (1.f + sc.y) + sh.y;
        o.z = (v[j].z * r * gg.z) * (1.f + sc.z) + sh.z; o.w = (v[j].w * r * gg.w) * (1.f + sc.w) + sh.w;
        if (keep) { keep[4 * j + 0] = o.x; keep[4 * j + 1] = o.y; keep[4 * j + 2] = o.z; keep[4 * j + 3] = o.w; }
        u32x2 w; w.x = pk2(o.x, o.y); w.y = pk2(o.z, o.w);
        *(u32x2*)(orow + 256 * j + 4 * lane) = w;
    }
}
__device__ __forceinline__ const float* xrow_ptr(const Frame& F, int row, bool from_input) {
    if (row < TOKL) return (from_input ? inp(F, I_X) : outp(F)) + (size_t)row * D;
    return (from_input ? inp(F, I_CTX) : WSP(const float, WS_XC)) + (size_t)(row - TOKL) * D;
}
__device__ __forceinline__ void phase_norm(Frame& F, int layer, int nrows, bool from_input, int which) {
    const int gw = F.wg * NWAVES + F.wave, NGW = F.G * NWAVES;
    const float* g = inp(F, which == 0 ? I_GMIX : I_GFFN) + layer * D;
    for (int row = gw; row < nrows; row += NGW)
        norm_mod_row(xrow_ptr(F, row, from_input), g, mod_ptr(F, layer, row, which), mod_ptr(F, layer, row, which + 1), WSP(bf16, WS_H) + (size_t)row * D, F.lane, nullptr);
}

namespace pg8 {
constexpr int BM = 256, BK = 64, HALF = 128, HTB = HALF * BK * 2, STAGE_BYTES = 8 * HTB, NXCD = 8, WGM = 8;
__device__ __forceinline__ int lds_byte(int r, int c) { const int st = (r >> 4) * 2 + (c >> 5), rr = r & 15, cc = c & 31, ob = rr * 64 + cc * 2; return st * 1024 + (ob ^ (((ob >> 9) & 1) << 5)); }
__device__ __forceinline__ void stage_rc(int b, int& R, int& C) { const int st = b / 1024, sb = b % 1024, swz = sb ^ (((sb >> 9) & 1) << 5); R = (st >> 1) * 16 + swz / 64; C = (st & 1) * 32 + (swz % 64) / 2; }
struct Unit { int pm, pn; };
struct OrderPlain {
    static constexpr bool GATHER = false;
    int nM, nN, nwg, G, c;
    __device__ __forceinline__ void init(int nM_, int nN_, int G_, int c_) { nM = nM_; nN = nN_; nwg = nM * nN; G = G_; c = c_; }
    __device__ __forceinline__ bool next(int i, Unit& u) const {
        const long L = (long)i * G + c; if (L >= nwg) return false;
        int wgid = (int)L; { const int q = nwg / NXCD, r = nwg % NXCD, xcd = wgid % NXCD, off = wgid / NXCD; wgid = (xcd < r ? xcd * (q + 1) : r * (q + 1) + (xcd - r) * q) + off; }
        const int nig = WGM * nN, gid = wgid / nig, fm = gid * WGM, gsz = (nM - fm) < WGM ? (nM - fm) : WGM;
        u.pm = fm + ((wgid % nig) % gsz); u.pn = (wgid % nig) / gsz; return true;
    }
    __device__ __forceinline__ int arow(int r) const { return r; }
    __device__ __forceinline__ size_t boff(const Unit&) const { return 0; }
};
struct OrderMoe {
    static constexpr bool GATHER = true;
    OrderPlain o; const int* rowidx; const int* tilee; int t0; size_t bstride; bool gather;
    __device__ __forceinline__ bool next(int i, Unit& u) const { return o.next(i, u); }
    __device__ __forceinline__ int arow(int r) const { return gather ? rowidx[t0 * 256 + r] : r; }
    __device__ __forceinline__ size_t boff(const Unit& u) const { return (size_t)tilee[t0 + u.pm] * bstride; }
};

template <class Epi, class Sched>
__device__ __forceinline__ void gemm_phase(LAS unsigned char* lds, const bf16* A, int lda, const bf16* Bt, int ldb, int K, const Sched& S, const Epi& E) {
    unsigned tid_u = threadIdx.x; asm volatile("" : "+v"(tid_u));
    const int tid = (int)tid_u, wid = __builtin_amdgcn_readfirstlane(tid >> 6), lane = tid & 63, wr = wid >> 2, wc = wid & 3, fr = lane & 15, fq = lane >> 4;
    const int nt = K / BK;
    unsigned voffB[2];
    { int sR[2], sC[2];
#pragma unroll
      for (int i = 0; i < 2; ++i) { stage_rc(tid * 16 + i * 8192, sR[i], sC[i]); voffB[i] = (unsigned)(sR[i] * ldb + sC[i]) * 2u; } }
#define PG8_GATHER_OFFS(pm_) do { unsigned _t = (unsigned)tid; asm volatile("" : "+v"(_t)); _Pragma("unroll") for (int i = 0; i < 2; ++i) { int _R, _C; stage_rc((int)_t * 16 + i * 8192, _R, _C); \
        vc0[i] = (unsigned)((size_t)S.arow((pm_) * BM + _R) * lda + _C) * 2u; vc1[i] = (unsigned)((size_t)S.arow((pm_) * BM + HALF + _R) * lda + _C) * 2u; } } while (0)
    const size_t kstep = (size_t)(BK * 2);
    const size_t hstepB = (size_t)HALF * ldb * 2, tstepB = 2 * hstepB;
    const unsigned ldsw = (unsigned)wid * 1024u;
    const int aoff = lds_byte(wr * 64 + fr, fq * 8), boff = lds_byte(wc * 32 + fr, fq * 8);
#define PG8_SA(b, h) (((b) * 2 + (h)) * HTB)
#define PG8_SB(b, h) ((4 + (b) * 2 + (h)) * HTB)
#define PG8_STAGE2(bufoff, gbase, v0, v1) do { \
        __builtin_amdgcn_global_load_lds((const unsigned*)((const char*)(gbase) + (v0)), (LAS unsigned*)(lds + (bufoff) + ldsw), 16, 0, 0); \
        __builtin_amdgcn_global_load_lds((const unsigned*)((const char*)(gbase) + (v1)), (LAS unsigned*)(lds + (bufoff) + ldsw + 8192), 16, 0, 0); } while (0)
#define PG8_STAGEB(bufoff, gbase) PG8_STAGE2(bufoff, gbase, voffB[0], voffB[1])
#define PG8_LDA(dst, b, h) do { _Pragma("unroll") for (int m = 0; m < 4; ++m) _Pragma("unroll") for (int k = 0; k < 2; ++k) dst[m][k] = *(const LAS bf16x8*)(lds + PG8_SA(b, h) + aoff + m * 2048 + k * 1024); } while (0)
#define PG8_LDB(dst, b, h) do { _Pragma("unroll") for (int n = 0; n < 2; ++n) _Pragma("unroll") for (int k = 0; k < 2; ++k) dst[n][k] = *(const LAS bf16x8*)(lds + PG8_SB(b, h) + boff + n * 2048 + k * 1024); } while (0)
#define PG8_MMA(ai, bj, At, Bt_) do { __builtin_amdgcn_s_setprio(1); _Pragma("unroll") for (int m = 0; m < 4; ++m) _Pragma("unroll") for (int n = 0; n < 2; ++n) _Pragma("unroll") for (int k = 0; k < 2; ++k) \
        acc[ai][bj][m][n] = __builtin_amdgcn_mfma_f32_16x16x32_bf16(Bt_[n][k], At[m][k], acc[ai][bj][m][n], 0, 0, 0); __builtin_amdgcn_s_setprio(0); } while (0)
#define PG8_WAIT_V(n) asm volatile("s_waitcnt vmcnt(" #n ")" ::: "memory")
#define PG8_WAIT_L(n) asm volatile("s_waitcnt lgkmcnt(" #n ")" ::: "memory")
#define PG8_BAR __builtin_amdgcn_s_barrier()
#define PG8_SCHED __builtin_amdgcn_sched_barrier(0)
    Unit cur, nxt; int ui = 0;
    if (!S.next(0, cur)) return;
    f32x4 acc[2][2][4][2];
#pragma unroll
    for (int a = 0; a < 2; ++a)
#pragma unroll
        for (int b = 0; b < 2; ++b)
#pragma unroll
            for (int m = 0; m < 4; ++m)
#pragma unroll
                for (int n = 0; n < 2; ++n) acc[a][b][m][n] = (f32x4){0.f, 0.f, 0.f, 0.f};
    bf16x8 At[4][2], B0[2][2], B1[2][2];
    constexpr bool GA = Sched::GATHER;
    const size_t hstepA = GA ? 0 : (size_t)HALF * lda * 2, tstepA = (size_t)BM * lda * 2;
    unsigned vc0[2], vc1[2];
    if constexpr (GA) { PG8_GATHER_OFFS(cur.pm); }
    else { int sR, sC;
#pragma unroll
        for (int i = 0; i < 2; ++i) { stage_rc(tid * 16 + i * 8192, sR, sC); vc0[i] = (unsigned)(sR * lda + sC) * 2u; vc1[i] = 0u; } }
#define VC0(i) vc0[i]
#define VC1(i) (GA ? vc1[i] : vc0[i])
#define VN0(i) vc0[i]
#define VN1(i) VC1(i)
    const char* cA = GA ? (const char*)A : (const char*)A + (size_t)cur.pm * tstepA;
    const char* cB = (const char*)Bt + S.boff(cur) * 2 + (size_t)cur.pn * tstepB;
    PG8_STAGEB(PG8_SB(0, 0), cB); PG8_STAGE2(PG8_SA(0, 0), cA, VC0(0), VC0(1)); PG8_STAGEB(PG8_SB(0, 1), cB + hstepB); PG8_STAGE2(PG8_SA(0, 1), cA + hstepA, VC1(0), VC1(1));
    if (wr == 1) PG8_BAR;
    PG8_WAIT_V(4); PG8_BAR;
    PG8_STAGEB(PG8_SB(1, 0), cB + kstep); PG8_STAGE2(PG8_SA(1, 0), cA + kstep, VC0(0), VC0(1)); PG8_STAGEB(PG8_SB(1, 1), cB + hstepB + kstep);
    PG8_WAIT_V(6); PG8_BAR;
    for (;;) {
        const bool has_next = S.next(ui + 1, nxt);
        const char* nB = cB; const char* nA = cA;
        if (has_next) {
            nB = (const char*)Bt + S.boff(nxt) * 2 + (size_t)nxt.pn * tstepB;
            if constexpr (!GA) nA = (const char*)A + (size_t)nxt.pm * tstepA;
        }
        for (int t = 0; t < nt; t += 2) {
            const bool last = (t == nt - 2);
            if constexpr (Epi::HORNER) {
                if (t == 6 || t == 12) {
                    asm volatile("" ::: "memory");
                    const int seg = (t == 6) ? 0 : 1;
                    int hpm = cur.pm, hpn = cur.pn; asm volatile("" : "+s"(hpm), "+s"(hpn));
                    unsigned hln = (unsigned)lane; asm volatile("" : "+v"(hln)); const int hfr = (int)(hln & 15u), hfq = (int)(hln >> 4);
#pragma unroll
                    for (int ai = 0; ai < 2; ++ai) {
                        u32x2 ga[4][2][2], gb[4][2][2];
#pragma unroll
                        for (int m = 0; m < 4; ++m)
#pragma unroll
                            for (int bj = 0; bj < 2; ++bj)
#pragma unroll
                                for (int n = 0; n < 2; ++n) {
                                    const int row = hpm * BM + ai * HALF + wr * 64 + m * 16 + hfr, col = hpn * BM + bj * HALF + wc * 32 + n * 16 + 4 * hfq;
                                    ga[m][bj][n] = E.gate(seg, row, col); gb[m][bj][n] = E.gate(seg + 1, row, col);
                                }
                        asm volatile("" : "+v"(ga[0][0][0]), "+v"(ga[0][0][1]), "+v"(ga[0][1][0]), "+v"(ga[0][1][1]), "+v"(ga[1][0][0]), "+v"(ga[1][0][1]), "+v"(ga[1][1][0]), "+v"(ga[1][1][1]),
                                          "+v"(ga[2][0][0]), "+v"(ga[2][0][1]), "+v"(ga[2][1][0]), "+v"(ga[2][1][1]), "+v"(ga[3][0][0]), "+v"(ga[3][0][1]), "+v"(ga[3][1][0]), "+v"(ga[3][1][1]) :: "memory");
                        asm volatile("" : "+v"(gb[0][0][0]), "+v"(gb[0][0][1]), "+v"(gb[0][1][0]), "+v"(gb[0][1][1]), "+v"(gb[1][0][0]), "+v"(gb[1][0][1]), "+v"(gb[1][1][0]), "+v"(gb[1][1][1]),
                                          "+v"(gb[2][0][0]), "+v"(gb[2][0][1]), "+v"(gb[2][1][0]), "+v"(gb[2][1][1]), "+v"(gb[3][0][0]), "+v"(gb[3][0][1]), "+v"(gb[3][1][0]), "+v"(gb[3][1][1]) :: "memory");
#pragma unroll
                        for (int m = 0; m < 4; ++m)
#pragma unroll
                            for (int bj = 0; bj < 2; ++bj)
#pragma unroll
                                for (int n = 0; n < 2; ++n) {
                                    const u32x2 a = ga[m][bj][n], b = gb[m][bj][n];
                                    f32x4& v = acc[ai][bj][m][n];
                                    v.x *= __uint_as_float(a.x << 16) * __builtin_amdgcn_rcpf(__uint_as_float(b.x << 16));
                                    v.y *= __uint_as_float(a.x & 0xffff0000u) * __builtin_amdgcn_rcpf(__uint_as_float(b.x & 0xffff0000u));
                                    v.z *= __uint_as_float(a.y << 16) * __builtin_amdgcn_rcpf(__uint_as_float(b.y << 16));
                                    v.w *= __uint_as_float(a.y & 0xffff0000u) * __builtin_amdgcn_rcpf(__uint_as_float(b.y & 0xffff0000u));
                                }
                    }
                    asm volatile("s_waitcnt vmcnt(0)" ::: "memory");
                }
            }
            const char* a1 = cA + (size_t)(t + 1) * kstep;
            const char* a2 = last ? nA : cA + (size_t)(t + 2) * kstep; const char* b2 = last ? nB : cB + (size_t)(t + 2) * kstep;
            const char* a3 = a2 + kstep; const char* b3 = b2 + kstep;
            PG8_LDB(B0, 0, 0); PG8_SCHED; PG8_LDA(At, 0, 0); PG8_STAGE2(PG8_SA(1, 1), a1 + hstepA, VC1(0), VC1(1));
            if constexpr (GA) { if (last && has_next) { asm volatile("" ::: "memory"); PG8_GATHER_OFFS(nxt.pm); asm volatile("" ::: "memory"); } }
            PG8_WAIT_L(8); PG8_BAR; PG8_WAIT_L(0); PG8_MMA(0, 0, At, B0); PG8_BAR; PG8_SCHED;
            PG8_LDB(B1, 0, 1); PG8_STAGEB(PG8_SB(0, 0), b2);
            PG8_BAR; PG8_WAIT_L(0); PG8_MMA(0, 1, At, B1); PG8_BAR;
            PG8_LDA(At, 0, 1); PG8_STAGE2(PG8_SA(0, 0), a2, VN0(0), VN0(1));
            PG8_BAR; PG8_WAIT_L(0); PG8_MMA(1, 0, At, B0); PG8_BAR; PG8_SCHED;
            PG8_STAGEB(PG8_SB(0, 1), b2 + hstepB);
            PG8_WAIT_V(6); PG8_BAR; PG8_MMA(1, 1, At, B1); PG8_BAR;
            PG8_LDB(B0, 1, 0); PG8_SCHED; PG8_LDA(At, 1, 0); PG8_STAGE2(PG8_SA(0, 1), a2 + hstepA, VN1(0), VN1(1));
            PG8_WAIT_L(8); PG8_BAR; PG8_WAIT_L(0); PG8_MMA(0, 0, At, B0); PG8_BAR; PG8_SCHED;
            PG8_LDB(B1, 1, 1); PG8_STAGEB(PG8_SB(1, 0), b3);
            PG8_BAR; PG8_WAIT_L(0); PG8_MMA(0, 1, At, B1); PG8_BAR;
            PG8_LDA(At, 1, 1); PG8_STAGE2(PG8_SA(1, 0), a3, VN0(0), VN0(1));
            PG8_BAR; PG8_WAIT_L(0); PG8_MMA(1, 0, At, B0); PG8_BAR; PG8_SCHED;
            PG8_STAGEB(PG8_SB(1, 1), b3 + hstepB);
            PG8_WAIT_V(6); PG8_BAR; PG8_MMA(1, 1, At, B1); PG8_BAR;
        }
        {
            int epm = cur.pm, epn = cur.pn; asm volatile("" : "+s"(epm), "+s"(epn));
            unsigned eln = (unsigned)lane; asm volatile("" : "+v"(eln)); const int efr = (int)(eln & 15u), efq = (int)(eln >> 4);
            f32x4 cv[2][2];
#pragma unroll
            for (int bj = 0; bj < 2; ++bj)
#pragma unroll
                for (int n = 0; n < 2; ++n) { if constexpr (Epi::COLVEC) cv[bj][n] = E.colvec(epm * BM, epn * BM + bj * HALF + wc * 32 + n * 16 + 4 * efq); else cv[bj][n] = (f32x4){0.f, 0.f, 0.f, 0.f}; }
            if constexpr (Epi::COLVEC) asm volatile("" : "+v"(cv[0][0]), "+v"(cv[0][1]), "+v"(cv[1][0]), "+v"(cv[1][1]) :: "memory");
#pragma unroll
            for (int ai = 0; ai < 2; ++ai) {
                f32x4 bs[4][2][2];
                if constexpr (Epi::BASE) {
#pragma unroll
                    for (int m = 0; m < 4; ++m)
#pragma unroll
                        for (int bj = 0; bj < 2; ++bj)
#pragma unroll
                            for (int n = 0; n < 2; ++n) bs[m][bj][n] = E.base(epm * BM + ai * HALF + wr * 64 + m * 16 + efr, epn * BM + bj * HALF + wc * 32 + n * 16 + 4 * efq);
                    asm volatile("" : "+v"(bs[0][0][0]), "+v"(bs[0][0][1]), "+v"(bs[0][1][0]), "+v"(bs[0][1][1]), "+v"(bs[1][0][0]), "+v"(bs[1][0][1]), "+v"(bs[1][1][0]), "+v"(bs[1][1][1]),
                                      "+v"(bs[2][0][0]), "+v"(bs[2][0][1]), "+v"(bs[2][1][0]), "+v"(bs[2][1][1]), "+v"(bs[3][0][0]), "+v"(bs[3][0][1]), "+v"(bs[3][1][0]), "+v"(bs[3][1][1]) :: "memory");
                }
#pragma unroll
                for (int m = 0; m < 4; ++m) {
                    const int row = epm * BM + ai * HALF + wr * 64 + m * 16 + efr;
#pragma unroll
                    for (int bj = 0; bj < 2; ++bj) {
                        if constexpr (Epi::PAIR) E.store_pair(row, epn * (BM / 2) + bj * (HALF / 2) + wc * 16 + 4 * efq, acc[ai][bj][m][0], acc[ai][bj][m][1]);
                        else {
#pragma unroll
                            for (int n = 0; n < 2; ++n) { f32x4 bb = (f32x4){0.f, 0.f, 0.f, 0.f}; if constexpr (Epi::BASE) bb = bs[m][bj][n]; E.store(row, epn * BM + bj * HALF + wc * 32 + n * 16 + 4 * efq, acc[ai][bj][m][n], cv[bj][n], bb); }
                        }
                    }
                }
            }
        }
        if (!has_next) break;
#pragma unroll
        for (int a = 0; a < 2; ++a)
#pragma unroll
            for (int b = 0; b < 2; ++b)
#pragma unroll
                for (int m = 0; m < 4; ++m)
#pragma unroll
                    for (int n = 0; n < 2; ++n) acc[a][b][m][n] = (f32x4){0.f, 0.f, 0.f, 0.f};
        cur = nxt; cB = nB; cA = nA; ++ui;
    }
    PG8_WAIT_V(0);
    if (wr == 0) PG8_BAR;
    PG8_BAR;
#undef PG8_GATHER_OFFS
#undef VC0
#undef VC1
#undef VN0
#undef VN1
#undef PG8_SA
#undef PG8_SB
#undef PG8_STAGE2
#undef PG8_STAGEB
#undef PG8_LDA
#undef PG8_LDB
#undef PG8_MMA
#undef PG8_WAIT_V
#undef PG8_WAIT_L
#undef PG8_BAR
#undef PG8_SCHED
}
}

template <class Epi>
__device__ __forceinline__ void gemm_fast(Frame& F, const bf16* A, int lda, const bf16* Bt, int ldb, int K, int M, int N, const Epi& E) {
    pg8::OrderPlain S; S.init(M / 256, N / 256, F.G, F.wg);
    pg8::gemm_phase(F.lds, A, lda, Bt, ldb, K, S, E);
}
#ifndef FAST_PLAIN
#define FAST_PLAIN 1
#endif
#ifndef FAST_HORNER
#define FAST_HORNER 1
#endif
#ifndef FAST_MOE
#define FAST_MOE 1
#endif

__device__ __forceinline__ void st_bf16x4(bf16* p, f32x4 v) { u32x2 w; w.x = pk2(v.x, v.y); w.y = pk2(v.z, v.w); *(u32x2*)p = w; }
__device__ __forceinline__ f32x4 ld_bf16x4(const bf16* p) { const u32x2 w = *(const u32x2*)p; f32x4 v; v.x = __uint_as_float(w.x << 16); v.y = __uint_as_float(w.x & 0xffff0000u); v.z = __uint_as_float(w.y << 16); v.w = __uint_as_float(w.y & 0xffff0000u); return v; }

struct EpiWin {
    static constexpr bool HORNER = false, PAIR = false, COLVEC = true, BASE = false;
    const float* bias; bf16 *hytl, *hytc, *ret, *ml; float* mlg;
    __device__ __forceinline__ f32x4 colvec(int, int col) const { return *(const f32x4*)(bias + col); }
    __device__ __forceinline__ void store(int row, int col, f32x4 v, f32x4 cv, f32x4) const {
        v += cv;
        if (col < 1152) {
            if (row < TOKL) { const int b = row >> 11, t = row & 2047; bf16* d = hytl + ((size_t)(b * 1152 + col)) * 2048 + t;
                d[0] = (bf16)f2bf(v.x); d[2048] = (bf16)f2bf(v.y); d[4096] = (bf16)f2bf(v.z); d[6144] = (bf16)f2bf(v.w); }
            else { const int r = row - TOKL, b = r >> 8, t = r & 255; bf16* d = hytc + ((size_t)(b * 1152 + col)) * 256 + t;
                d[0] = (bf16)f2bf(v.x); d[256] = (bf16)f2bf(v.y); d[512] = (bf16)f2bf(v.z); d[768] = (bf16)f2bf(v.w); }
        } else if (col < 1168) { *(f32x4*)(mlg + (size_t)row * 16 + (col - 1152)) = v; }
        else if (col < 1280) { }
        else if (col < 2816) st_bf16x4(ret + (size_t)row * 1536 + (col - 1280), v);
        else st_bf16x4(ml + (size_t)row * 1024 + (col - 2816), v);
    }
};
struct EpiGate {
    static constexpr bool HORNER = false, PAIR = false, COLVEC = true, BASE = false;
    const float* bias; bf16* gates;
    __device__ __forceinline__ f32x4 colvec(int, int col) const { return *(const f32x4*)(bias + col); }
    __device__ __forceinline__ void store(int row, int col, f32x4 v, f32x4 cv, f32x4) const {
        v += cv;
        f32x4 g; g.x = fmaxf(sigmoidf_(v.x), 1e-20f); g.y = fmaxf(sigmoidf_(v.y), 1e-20f); g.z = fmaxf(sigmoidf_(v.z), 1e-20f); g.w = fmaxf(sigmoidf_(v.w), 1e-20f);
        st_bf16x4(gates + (size_t)row * NGATE + col, g);
    }
};
struct EpiUp {
    static constexpr bool HORNER = true, PAIR = false, COLVEC = false, BASE = true;
    const bf16* gates; bf16* acc_out;
    __device__ __forceinline__ u32x2 gate(int which, int row, int col) const { return *(const u32x2*)(gates + (size_t)row * NGATE + which * 1024 + col); }
    __device__ __forceinline__ f32x4 base(int row, int col) const { return ld_bf16x4(gates + (size_t)row * NGATE + 2048 + col); }
    __device__ __forceinline__ void store(int row, int col, f32x4 v, f32x4, f32x4 g) const { st_bf16x4(acc_out + (size_t)row * D + col, v * g); }
};
struct EpiResid {
    static constexpr bool HORNER = false, PAIR = false, COLVEC = true, BASE = true;
    const float *xin_l, *xin_c; float *xout_l, *xout_c; const float* modbase; int which;
    __device__ __forceinline__ f32x4 colvec(int row0, int col) const { const int r = row0 < TOKL ? (row0 >> 11) : 16; return *(const f32x4*)(modbase + ((size_t)r * 6 + which) * 1024 + col); }
    __device__ __forceinline__ f32x4 base(int row, int col) const { return row < TOKL ? *(const f32x4*)(xin_l + (size_t)row * D + col) : *(const f32x4*)(xin_c + (size_t)(row - TOKL) * D + col); }
    __device__ __forceinline__ void store(int row, int col, f32x4 v, f32x4 m, f32x4 x) const {
        if (row < TOKL) *(f32x4*)(xout_l + (size_t)row * D + col) = x + m * v;
        else *(f32x4*)(xout_c + (size_t)(row - TOKL) * D + col) = x + m * v;
    }
};
struct EpiSwiglu {
    static constexpr bool HORNER = false, PAIR = true, COLVEC = false, BASE = false;
    bf16* act; int row_off;
    __device__ __forceinline__ void store_pair(int row, int col, f32x4 a, f32x4 b) const {
        f32x4 o; o.x = siluf_(a.x) * b.x; o.y = siluf_(a.y) * b.y; o.z = siluf_(a.z) * b.z; o.w = siluf_(a.w) * b.w;
        st_bf16x4(act + (size_t)(row - row_off) * DFF + col, o);
    }
    __device__ __forceinline__ void store(int, int, f32x4, f32x4, f32x4) const {}
};
struct EpiBf16Out {
    static constexpr bool HORNER = false, PAIR = false, COLVEC = false, BASE = false;
    bf16* out; int ld; int row_add;
    __device__ __forceinline__ void store(int row, int col, f32x4 v, f32x4, f32x4) const { st_bf16x4(out + (size_t)(row + row_add) * ld + col, v); }
    __device__ __forceinline__ void store_pair(int, int, f32x4, f32x4) const {}
};

constexpr int ZPITCH_L = (LL + 8) * 2, ZPITCH_C = (LC + 8) * 2;
template <int L>
__device__ __forceinline__ float conv3_at(const bf16* base  , int t, float w0, float w1, float w2) {
    const float a = t > 0 ? bf2f(base[t - 1]) : 0.f, b = bf2f(base[t]), c = t < L - 1 ? bf2f(base[t + 1]) : 0.f;
    return w0 * a + w1 * b + w2 * c;
}
template <int L>
__device__ __forceinline__ void hyena_unit_naive(Frame& F, int layer, int c, const bf16* hyt  , const bf16* ft  , bf16* yht  ) {
    constexpr int ZP = (L + 8) * 2;
    constexpr int PER = L / 32;
    constexpr int SUB = 8;
    LAS unsigned char* zimg0 = F.lds;
    LAS unsigned char* zimg1 = F.lds + 16 * ZP;
    LAS bf16* tf = (LAS bf16*)(F.lds + 32 * ZP);
    const float* cw = inp(F, I_HYCONV) + layer * 3 * 1152;
    const float* skip = inp(F, I_HYSKIP) + layer * 2 * 384;
    __syncthreads();
    {
        const int b = F.tid >> 5, seg = F.tid & 31; const bf16* src = hyt + ((size_t)(b * 1152 + c)) * L;
        const float w0 = cw[c], w1 = cw[1152 + c], w2 = cw[2304 + c];
#pragma unroll 2
        for (int j = 0; j < PER; ++j) { const int t = seg * PER + j; *(LAS bf16*)(zimg0 + b * ZP + t * 2) = (bf16)f2bf(conv3_at<L>(src, t, w0, w1, w2)); }
    }
#pragma unroll 1
    for (int o = 0; o < 2; ++o) {
        LAS unsigned char* zs = o == 0 ? zimg0 : zimg1;
        LAS unsigned char* zd = o == 0 ? zimg1 : zimg0;
        const bf16* fsrc = ft + ((size_t)(o * 384 + c)) * (2 * L);
        for (int i = F.tid; i < 2 * L; i += NTHR) tf[i] = i == 0 ? (bf16)0 : fsrc[i];
        __syncthreads();
        const int b = F.tid & 15, tg = F.tid >> 4;
        const int gcol = (o == 0 ? 384 : 768) + c;
        const bf16* gsrc = hyt + ((size_t)(b * 1152 + gcol)) * L;
        const float w0 = cw[gcol], w1 = cw[1152 + gcol], w2 = cw[2304 + gcol], sk = skip[o * 384 + c];
#pragma unroll 1
        for (int sb = 0; sb < PER / SUB; ++sb) {
            const int t0 = tg * PER + sb * SUB;
            float acc[SUB];
#pragma unroll
            for (int j = 0; j < SUB; ++j) acc[j] = 0.f;
#pragma unroll 1
            for (int s0 = 0; s0 < L; s0 += 8) {
                float z[8];
                { const bf16x8 zz = *(const LAS bf16x8*)(zs + b * ZP + s0 * 2);
#pragma unroll
                  for (int i = 0; i < 8; ++i) z[i] = bf2f((bf16)zz[i]); }
                float win[SUB + 7];
                const int wb = L + s0 - t0 - (SUB - 1);
#pragma unroll
                for (int i = 0; i < SUB + 7; ++i) win[i] = bf2f(tf[wb + i]);
#pragma unroll
                for (int j = 0; j < SUB; ++j)
#pragma unroll
                    for (int i = 0; i < 8; ++i) acc[j] += win[(SUB - 1) - j + i] * z[i];
            }
#pragma unroll
            for (int j = 0; j < SUB; ++j) {
                const int t = t0 + j;
                const float zt = bf2f(*(LAS bf16*)(zs + b * ZP + t * 2));
                const float ov = conv3_at<L>(gsrc, t, w0, w1, w2) * (acc[j] + sk * zt);
                *(LAS bf16*)(zd + b * ZP + t * 2) = (bf16)f2bf(ov);
            }
        }
        __syncthreads();
    }
#pragma unroll 2
    for (int i = F.tid; i < 16 * (L / 8); i += NTHR) {
        const int b = i / (L / 8), ch = i % (L / 8);
        *(u32x4*)(yht + ((size_t)(b * 384 + c)) * L + ch * 8) = *(const LAS u32x4*)(zimg0 + b * ZP + ch * 16);
    }
}

template <int L>
__device__ __forceinline__ void hyena_unit_fast(Frame& F, int layer, int c, const bf16* hyt  , const bf16* ft  , bf16* yht  ) {
    constexpr int ZP = (L + 8) * 2;
    constexpr int PER = L / 32;
    constexpr int I = L / 128;
    constexpr int SPAN = L / 4, NSTEP = L / 32;
    LAS unsigned char* zimg0 = F.lds;
    LAS unsigned char* zimg1 = F.lds + 16 * ZP;
    LAS bf16* tf = (LAS bf16*)(F.lds + 32 * ZP);
    const float* cw = inp(F, I_HYCONV) + layer * 3 * 1152;
    const float* skip = inp(F, I_HYSKIP) + layer * 2 * 384;
    const int lane = F.lane, fr = lane & 15, fq = lane >> 4, w = F.wave;
    __syncthreads();
    {
        const int b = F.tid >> 5, sg = F.tid & 31, t0 = sg * PER; const bf16* src = hyt + ((size_t)(b * 1152 + c)) * L + t0;
        const float w0 = cw[c], w1 = cw[1152 + c], w2 = cw[2304 + c];
        u32x4 raw[PER / 8];
#pragma unroll
        for (int j = 0; j < PER / 8; ++j) raw[j] = *(const u32x4*)(src + 8 * j);
        float prev = t0 > 0 ? bf2f(src[-1]) : 0.f;
        const float nextv = t0 + PER < L ? bf2f(src[PER]) : 0.f;
#pragma unroll
        for (int j = 0; j < PER / 8; ++j) {
            const unsigned wv[4] = {raw[j].x, raw[j].y, raw[j].z, raw[j].w};
            float x[10]; x[0] = prev;
#pragma unroll
            for (int q = 0; q < 4; ++q) { x[1 + 2 * q] = __uint_as_float(wv[q] << 16); x[2 + 2 * q] = __uint_as_float(wv[q] & 0xffff0000u); }
            if (j + 1 < PER / 8) x[9] = __uint_as_float(raw[(j + 1 < PER / 8) ? j + 1 : j].x << 16); else x[9] = nextv;
            u32x4 o;
            o.x = pk2(w0 * x[0] + w1 * x[1] + w2 * x[2], w0 * x[1] + w1 * x[2] + w2 * x[3]); o.y = pk2(w0 * x[2] + w1 * x[3] + w2 * x[4], w0 * x[3] + w1 * x[4] + w2 * x[5]);
            o.z = pk2(w0 * x[4] + w1 * x[5] + w2 * x[6], w0 * x[5] + w1 * x[6] + w2 * x[7]); o.w = pk2(w0 * x[6] + w1 * x[7] + w2 * x[8], w0 * x[7] + w1 * x[8] + w2 * x[9]);
            *(LAS u32x4*)(zimg0 + b * ZP + (t0 + 8 * j) * 2) = o;
            prev = x[8];
        }
    }
    const int tbase = SPAN * (w >> 1) + 16 * (w & 1);
    const int flane = L - tbase + 8 * fq - fr;
#pragma unroll 1
    for (int o = 0; o < 2; ++o) {
        LAS unsigned char* zs = o == 0 ? zimg0 : zimg1;
        LAS unsigned char* zd = o == 0 ? zimg1 : zimg0;
        const bf16* fsrc = ft + ((size_t)(o * 384 + c)) * (2 * L);
        for (int i = F.tid; i < 2 * L; i += NTHR) tf[i] = i == 0 ? (bf16)0 : fsrc[i];
        __syncthreads();
        f32x4 acc[I];
#pragma unroll
        for (int i = 0; i < I; ++i) acc[i] = (f32x4){0.f, 0.f, 0.f, 0.f};
        bf16x8 ring[I];
#pragma unroll
        for (int i = 1; i < I; ++i) __builtin_memcpy(&ring[(I - i) % I], (const LAS unsigned char*)tf + 2 * (flane - 32 * i), 16);
        const LAS unsigned char* zrow = zs + fr * ZP + 16 * fq;
#pragma unroll 1
        for (int j0 = 0; j0 < NSTEP; j0 += I) {
#pragma unroll
            for (int jj = 0; jj < I; ++jj) {
                const int j = j0 + jj;
                __builtin_memcpy(&ring[jj], (const LAS unsigned char*)tf + 2 * (flane + 32 * j), 16);
                const bf16x8 zf = *(const LAS bf16x8*)(zrow + 64 * j);
#pragma unroll
                for (int i = 0; i < I; ++i) acc[i] = __builtin_amdgcn_mfma_f32_16x16x32_bf16(ring[(jj - i + I) % I], zf, acc[i], 0, 0, 0);
            }
        }
        const int gcol = (o == 0 ? 384 : 768) + c;
        const bf16* gsrc = hyt + ((size_t)(fr * 1152 + gcol)) * L;
        const float w0 = cw[gcol], w1 = cw[1152 + gcol], w2 = cw[2304 + gcol], sk = skip[o * 384 + c];
        bf16* dst = yht + ((size_t)(fr * 384 + c)) * L;
        u32x2 grv[I]; unsigned short gmv[I], gpv[I];
#pragma unroll
        for (int i = 0; i < I; ++i) {
            const int t = tbase + 32 * i + 4 * fq;
            grv[i] = *(const u32x2*)(gsrc + t); gmv[i] = t > 0 ? gsrc[t - 1] : (unsigned short)0; gpv[i] = t + 4 < L ? gsrc[t + 4] : (unsigned short)0;
        }
#pragma unroll
        for (int i = 0; i < I; ++i) {
            const int t = tbase + 32 * i + 4 * fq;
            const u32x2 zr = *(const LAS u32x2*)(zs + fr * ZP + t * 2);
            const u32x2 gr = grv[i];
            const float gm = bf2f(gmv[i]), gp = bf2f(gpv[i]);
            const float g0 = __uint_as_float(gr.x << 16), g1 = __uint_as_float(gr.x & 0xffff0000u), g2 = __uint_as_float(gr.y << 16), g3 = __uint_as_float(gr.y & 0xffff0000u);
            const float z0 = __uint_as_float(zr.x << 16), z1 = __uint_as_float(zr.x & 0xffff0000u), z2 = __uint_as_float(zr.y << 16), z3 = __uint_as_float(zr.y & 0xffff0000u);
            const float o0 = (w0 * gm + w1 * g0 + w2 * g1) * (acc[i].x + sk * z0), o1 = (w0 * g0 + w1 * g1 + w2 * g2) * (acc[i].y + sk * z1);
            const float o2 = (w0 * g1 + w1 * g2 + w2 * g3) * (acc[i].z + sk * z2), o3 = (w0 * g2 + w1 * g3 + w2 * gp) * (acc[i].w + sk * z3);
            u32x2 ov; ov.x = pk2(o0, o1); ov.y = pk2(o2, o3);
            if (o == 0) *(LAS u32x2*)(zd + fr * ZP + t * 2) = ov;
            else *(u32x2*)(dst + t) = ov;
        }
        __syncthreads();
    }
}

__device__ __forceinline__ void chain_naive(Frame& F, int layer, int chain) {
    const int lane = F.lane;
    const bool is_ret = chain < 192;
    int b, h, dir;
    if (is_ret) { b = chain / 12; const int r = chain % 12; h = r >> 1; dir = r & 1; }
    else { const int i = chain - 192; b = i >> 3; h = (i & 7) >> 1; dir = i & 1; }
    const bf16* RET = WSP(const bf16, WS_RET); const bf16* ML = WSP(const bf16, WS_ML); const float* MLG = WSP(const float, WS_MLG);
    const float* rope = WSP(const float, WS_ROPE);
    bf16* Y = WSP(bf16, WS_Y); bf16* OB = WSP(bf16, WS_OB);
    float gam = 0.f;
    if (is_ret) gam = sigmoidf_(inp(F, I_RETDECAY)[layer * 12 + dir * 6 + h]);
    const float* mlc = inp(F, I_MLCONV) + layer * 3 * 512;
    const float bi = is_ret ? 0.f : inp(F, I_MLGB)[layer * 16 + dir * 8 + h], bfg = is_ret ? 0.f : inp(F, I_MLGB)[layer * 16 + dir * 8 + 4 + h];
    const float qw0 = mlc[h * 64 + lane], qw1 = mlc[512 + h * 64 + lane], qw2 = mlc[1024 + h * 64 + lane];
    const float kw0 = mlc[256 + h * 64 + lane], kw1 = mlc[512 + 256 + h * 64 + lane], kw2 = mlc[1024 + 256 + h * 64 + lane];
    float S[64];
#pragma unroll
    for (int d = 0; d < 64; ++d) S[d] = 0.f;
    float nv = 0.f;
    for (int step = 0; step < LC + LL; ++step) {
        int row, tpos, L; bool lat;
        if (step < LC) { tpos = dir ? (LC - 1 - step) : step; row = TOKL + b * LC + tpos; L = LC; lat = false; }
        else { const int s2 = step - LC; tpos = dir ? (LL - 1 - s2) : s2; row = b * LL + tpos; L = LL; lat = true; }
        float q, k, v, Fm, Im;
        if (is_ret) {
            const bf16* base = RET + (size_t)row * 1536;
            float qs = bf2f(base[h * 64 + lane]), ks = bf2f(base[384 + h * 64 + lane]);
            v = bf2f(base[768 + h * 64 + lane]);
            if (lat) {
                const float qp = bf2f(base[h * 64 + (lane ^ 16)]), kp = bf2f(base[384 + h * 64 + (lane ^ 16)]);
                const int half = lane >> 5, ii = lane & 15, hi = (lane >> 4) & 1;
                const float cs = rope[tpos * 64 + half * 32 + ii], sn = rope[tpos * 64 + half * 32 + 16 + ii];
                q = hi == 0 ? qs * cs - qp * sn : qp * sn + qs * cs;
                k = hi == 0 ? ks * cs - kp * sn : kp * sn + ks * cs;
            } else { q = qs; k = ks; }
            q *= 0.125f; Fm = gam; Im = 1.f;
        } else {
            const bf16* base = ML + (size_t)row * 1024;
            const float q0 = tpos > 0 ? bf2f(base[-1024 + h * 64 + lane]) : 0.f, q1 = bf2f(base[h * 64 + lane]), q2 = tpos < L - 1 ? bf2f(base[1024 + h * 64 + lane]) : 0.f;
            const float k0 = tpos > 0 ? bf2f(base[-1024 + 256 + h * 64 + lane]) : 0.f, k1 = bf2f(base[256 + h * 64 + lane]), k2 = tpos < L - 1 ? bf2f(base[1024 + 256 + h * 64 + lane]) : 0.f;
            q = siluf_(qw0 * q0 + qw1 * q1 + qw2 * q2);
            k = siluf_(kw0 * k0 + kw1 * k1 + kw2 * k2) * 0.125f;
            v = bf2f(base[512 + h * 64 + lane]);
            const float ig = MLG[(size_t)row * 16 + dir * 8 + h] + bi, fg = MLG[(size_t)row * 16 + dir * 8 + 4 + h] + bfg;
            Fm = sigmoidf_(fg); Im = __expf(ig);
        }
        float num = 0.f;
        const float iv = Im * v;
#pragma unroll
        for (int d = 0; d < 64; ++d) {
            const float kd = __int_as_float(__builtin_amdgcn_readlane(__float_as_int(k), d));
            const float qd = __int_as_float(__builtin_amdgcn_readlane(__float_as_int(q), d));
            S[d] = Fm * S[d] + kd * iv;
            num += qd * S[d];
        }
        float o = num;
        if (!is_ret) { nv = Fm * nv + Im * k; const float den = wave_sum(q * nv); o = num / fmaxf(fabsf(den), 1.f); }
        const int cof = is_ret ? (h * 64 + lane) : (384 + h * 64 + lane);
        if (dir == 0) Y[(size_t)row * D + 384 + cof] = (bf16)f2bf(o);
        else OB[(size_t)row * 640 + cof] = (bf16)f2bf(o);
    }
}

constexpr int CH_PITCH = 144;
constexpr int CH_IMG = 64 * CH_PITCH;
constexpr int CH_WAVE_LDS = 3 * CH_IMG + 1024 + 512;
__device__ __forceinline__ void ds_tr16x8(unsigned addr, u32x2 (&lo)[4], u32x2 (&hi)[4]) {
    asm volatile("ds_read_b64_tr_b16 %0, %8\n\tds_read_b64_tr_b16 %1, %8 offset:32\n\tds_read_b64_tr_b16 %2, %8 offset:64\n\tds_read_b64_tr_b16 %3, %8 offset:96\n\t"
                 "ds_read_b64_tr_b16 %4, %8 offset:2304\n\tds_read_b64_tr_b16 %5, %8 offset:2336\n\tds_read_b64_tr_b16 %6, %8 offset:2368\n\tds_read_b64_tr_b16 %7, %8 offset:2400\n\t"
                 "s_waitcnt lgkmcnt(0)"
                 : "=&v"(lo[0]), "=&v"(lo[1]), "=&v"(lo[2]), "=&v"(lo[3]), "=&v"(hi[0]), "=&v"(hi[1]), "=&v"(hi[2]), "=&v"(hi[3]) : "v"(addr) : "memory");
}
static_assert(16 * CH_PITCH == 2304, "ds_tr16x8 offsets");
__device__ __forceinline__ void ds_tr16x4(unsigned addr, u32x2 (&lo)[2], u32x2 (&hi)[2]) {
    asm volatile("ds_read_b64_tr_b16 %0, %4\n\tds_read_b64_tr_b16 %1, %4 offset:32\n\tds_read_b64_tr_b16 %2, %4 offset:2304\n\tds_read_b64_tr_b16 %3, %4 offset:2336\n\ts_waitcnt lgkmcnt(0)"
                 : "=&v"(lo[0]), "=&v"(lo[1]), "=&v"(hi[0]), "=&v"(hi[1]) : "v"(addr) : "memory");
}
__device__ __forceinline__ float log_sigmoid_(float x) { return fminf(x, 0.f) - log1pf(__expf(-fabsf(x))); }
__device__ __forceinline__ bf16x8 mk_frag(u32x2 lo, u32x2 hi) { u32x4 w; w.x = lo.x; w.y = lo.y; w.z = hi.x; w.w = hi.y; return __builtin_bit_cast(bf16x8, w); }

template <bool IS_ML>
__device__ __forceinline__ void chain_fast(Frame& F, int layer, int b, int h, int dir, LAS unsigned char* img, int hf) {
    constexpr int NET = 2;
    const int lane = F.lane, fr = lane & 15, fq = lane >> 4;
    LAS unsigned char* Qi = img; LAS unsigned char* Ki = img + CH_IMG; LAS unsigned char* Vi = img + 2 * CH_IMG;
    const unsigned qa = (unsigned)(size_t)Qi, ka = (unsigned)(size_t)Ki, va = (unsigned)(size_t)Vi;
    const bf16* RET = WSP(const bf16, WS_RET); const bf16* ML = WSP(const bf16, WS_ML); const float* MLG = WSP(const float, WS_MLG);
    const float* rope = WSP(const float, WS_ROPE);
    bf16* Y = WSP(bf16, WS_Y); bf16* OB = WSP(bf16, WS_OB);
    float lgam = 0.f, bi_ = 0.f, bf_ = 0.f;
    if (!IS_ML) lgam = log_sigmoid_(inp(F, I_RETDECAY)[layer * 12 + dir * 6 + h]);
    else { bi_ = inp(F, I_MLGB)[layer * 16 + dir * 8 + h]; bf_ = inp(F, I_MLGB)[layer * 16 + dir * 8 + 4 + h]; }
    const float* mlc = inp(F, I_MLCONV) + layer * 3 * 512;
    f32x4 C[4][NET];
#pragma unroll
    for (int dt = 0; dt < 4; ++dt)
#pragma unroll
        for (int et = 0; et < NET; ++et) C[dt][et] = (f32x4){0.f, 0.f, 0.f, 0.f};
    const int cq = lane & 7, pr0 = lane >> 3;
    LAS float* nvec = (LAS float*)(img + 3 * CH_IMG + 1024 + 256 * hf);
    if (IS_ML) nvec[lane] = 0.f;
    const LAS float* nq = nvec + 4 * fq;
#pragma unroll 1
    for (int step = 0; step < 36; ++step) {
        int rowbase, t0, L; bool lat;
        if (step < 4) { const int cc = dir ? 3 - step : step; rowbase = TOKL + b * LC + cc * 64; t0 = cc * 64; L = LC; lat = false; }
        else { const int cc = dir ? 35 - step : step - 4; rowbase = b * LL + cc * 64; t0 = cc * 64; L = LL; lat = true; }
        if constexpr (!IS_ML) {
#pragma unroll
        for (int i4 = 0; i4 < 4; ++i4) {
            const int i = 4 * hf + i4;
            const int p = pr0 + 8 * i, tl = dir ? 63 - p : p, row = rowbase + tl, tpos = t0 + tl;
            float qv[8], kv[8]; u32x4 vraw;
            {
                const bf16* base = RET + (size_t)row * 1536 + h * 64;
                const u32x4 qr = *(const u32x4*)(base + 8 * cq), kr = *(const u32x4*)(base + 384 + 8 * cq); vraw = *(const u32x4*)(base + 768 + 8 * cq);
                const unsigned qw[4] = {qr.x, qr.y, qr.z, qr.w}, kw[4] = {kr.x, kr.y, kr.z, kr.w};
#pragma unroll
                for (int j = 0; j < 4; ++j) { qv[2 * j] = __uint_as_float(qw[j] << 16); qv[2 * j + 1] = __uint_as_float(qw[j] & 0xffff0000u); kv[2 * j] = __uint_as_float(kw[j] << 16); kv[2 * j + 1] = __uint_as_float(kw[j] & 0xffff0000u); }
                if (lat) {
                    const u32x4 qpr = *(const u32x4*)(base + 8 * (cq ^ 2)), kpr = *(const u32x4*)(base + 384 + 8 * (cq ^ 2));
                    const unsigned qpw[4] = {qpr.x, qpr.y, qpr.z, qpr.w}, kpw[4] = {kpr.x, kpr.y, kpr.z, kpr.w};
                    const int half = cq >> 2, hi = (cq >> 1) & 1, i0 = 8 * (cq & 1);
                    const float* rp = rope + tpos * 64 + half * 32 + i0;
                    const f32x4 c0 = *(const f32x4*)(rp), c1 = *(const f32x4*)(rp + 4), s0 = *(const f32x4*)(rp + 16), s1 = *(const f32x4*)(rp + 20);
                    const float cs[8] = {c0.x, c0.y, c0.z, c0.w, c1.x, c1.y, c1.z, c1.w}, sn[8] = {s0.x, s0.y, s0.z, s0.w, s1.x, s1.y, s1.z, s1.w};
#pragma unroll
                    for (int j = 0; j < 8; ++j) {
                        const float qp = (j & 1) ? __uint_as_float(qpw[j >> 1] & 0xffff0000u) : __uint_as_float(qpw[j >> 1] << 16);
                        const float kp = (j & 1) ? __uint_as_float(kpw[j >> 1] & 0xffff0000u) : __uint_as_float(kpw[j >> 1] << 16);
                        qv[j] = hi ? qp * sn[j] + qv[j] * cs[j] : qv[j] * cs[j] - qp * sn[j];
                        kv[j] = hi ? kp * sn[j] + kv[j] * cs[j] : kv[j] * cs[j] - kp * sn[j];
                    }
                }
#pragma unroll
                for (int j = 0; j < 8; ++j) qv[j] *= 0.125f;
            }
            u32x4 qo, ko; qo.x = pk2(qv[0], qv[1]); qo.y = pk2(qv[2], qv[3]); qo.z = pk2(qv[4], qv[5]); qo.w = pk2(qv[6], qv[7]);
            ko.x = pk2(kv[0], kv[1]); ko.y = pk2(kv[2], kv[3]); ko.z = pk2(kv[4], kv[5]); ko.w = pk2(kv[6], kv[7]);
            *(LAS u32x4*)(Qi + p * CH_PITCH + 16 * cq) = qo; *(LAS u32x4*)(Ki + p * CH_PITCH + 16 * cq) = ko; *(LAS u32x4*)(Vi + p * CH_PITCH + 16 * cq) = vraw;
        }
        } else {
            const float* wq = mlc + h * 64 + 8 * cq;
#pragma unroll
            for (int qk = 0; qk < 2; ++qk) {
                u32x4 r0[4], r1[4], r2[4], vr[4];
                f32x4 wt[3][2];
#pragma unroll
                for (int tp = 0; tp < 3; ++tp) { wt[tp][0] = *(const f32x4*)(wq + 256 * qk + 512 * tp); wt[tp][1] = *(const f32x4*)(wq + 256 * qk + 512 * tp + 4); }
#pragma unroll
                for (int i4 = 0; i4 < 4; ++i4) {
                    const int p = pr0 + 8 * (4 * hf + i4), tl = dir ? 63 - p : p, row = rowbase + tl, tpos = t0 + tl;
                    const bf16* bb = ML + (size_t)row * 1024 + h * 64 + 8 * cq + 256 * qk;
                    const u32x4 z4 = (u32x4){0u, 0u, 0u, 0u};
                    r1[i4] = *(const u32x4*)(bb); r0[i4] = tpos > 0 ? *(const u32x4*)(bb - 1024) : z4; r2[i4] = tpos < L - 1 ? *(const u32x4*)(bb + 1024) : z4;
                    if (qk == 1) vr[i4] = *(const u32x4*)(bb + 256);
                }
#pragma unroll
                for (int i4 = 0; i4 < 4; ++i4) {
                    const int p = pr0 + 8 * (4 * hf + i4);
                    const unsigned a0[4] = {r0[i4].x, r0[i4].y, r0[i4].z, r0[i4].w}, a1[4] = {r1[i4].x, r1[i4].y, r1[i4].z, r1[i4].w}, a2[4] = {r2[i4].x, r2[i4].y, r2[i4].z, r2[i4].w};
                    float ov[8];
#pragma unroll
                    for (int j = 0; j < 8; ++j) {
                        const float x0 = (j & 1) ? __uint_as_float(a0[j >> 1] & 0xffff0000u) : __uint_as_float(a0[j >> 1] << 16);
                        const float x1 = (j & 1) ? __uint_as_float(a1[j >> 1] & 0xffff0000u) : __uint_as_float(a1[j >> 1] << 16);
                        const float x2 = (j & 1) ? __uint_as_float(a2[j >> 1] & 0xffff0000u) : __uint_as_float(a2[j >> 1] << 16);
                        const float r = siluf_(wt[0][j >> 2][j & 3] * x0 + wt[1][j >> 2][j & 3] * x1 + wt[2][j >> 2][j & 3] * x2);
                        ov[j] = qk == 0 ? r : r * 0.125f;
                    }
                    u32x4 o; o.x = pk2(ov[0], ov[1]); o.y = pk2(ov[2], ov[3]); o.z = pk2(ov[4], ov[5]); o.w = pk2(ov[6], ov[7]);
                    if (qk == 0) *(LAS u32x4*)(Qi + p * CH_PITCH + 16 * cq) = o;
                    else { *(LAS u32x4*)(Ki + p * CH_PITCH + 16 * cq) = o; *(LAS u32x4*)(Vi + p * CH_PITCH + 16 * cq) = vr[i4]; }
                }
                asm volatile("" ::: "memory");
            }
        }
        __builtin_amdgcn_sched_barrier(0);
        float f_p, i_p;
        { const int tl = dir ? 63 - lane : lane, row = rowbase + tl;
          if (!IS_ML) { f_p = lgam; i_p = 0.f; }
          else { i_p = MLG[(size_t)row * 16 + dir * 8 + h] + bi_; f_p = log_sigmoid_(MLG[(size_t)row * 16 + dir * 8 + 4 + h] + bf_); } }
        float bsum = f_p;
#pragma unroll
        for (int o = 1; o < 64; o <<= 1) { const float t = __shfl_up(bsum, o); if (lane >= o) bsum += t; }
        LAS float* gv = (LAS float*)(img + 3 * CH_IMG);
        const float b63 = __shfl(bsum, 63);
        const float adec = __expf(b63);
        if (hf == 0) { gv[lane] = bsum; gv[64 + lane] = bsum - i_p; gv[128 + lane] = __expf(bsum); gv[192 + lane] = __expf(b63 - (bsum - i_p)); }
        asm volatile("s_waitcnt lgkmcnt(0)" ::: "memory");
        __syncthreads();
        const LAS float* gq = gv + 4 * fq;
        const bf16x8 ones = (fr == 0) ? (bf16x8){0x3F80, 0x3F80, 0x3F80, 0x3F80, 0x3F80, 0x3F80, 0x3F80, 0x3F80} : (bf16x8){0, 0, 0, 0, 0, 0, 0, 0};
        const int tr_q = fr >> 2, tr_p = fr & 3;
#pragma unroll 1
        for (int pt = 0; pt < 4; ++pt) {
            f32x4 ST[4];
            bf16x8 qn[2];
#pragma unroll
            for (int kk = 0; kk < 2; ++kk) qn[kk] = *(const LAS bf16x8*)(Qi + (16 * pt + fr) * CH_PITCH + (32 * kk + 8 * fq) * 2);
#pragma unroll
            for (int st = 0; st < 4; ++st) {
                ST[st] = (f32x4){0.f, 0.f, 0.f, 0.f};
                if (st <= pt) {
#pragma unroll
                    for (int kk = 0; kk < 2; ++kk) { const bf16x8 kf = *(const LAS bf16x8*)(Ki + (16 * st + fr) * CH_PITCH + (32 * kk + 8 * fq) * 2); ST[st] = __builtin_amdgcn_mfma_f32_16x16x32_bf16(kf, qn[kk], ST[st], 0, 0, 0); }
                }
            }
            const float bp = gv[16 * pt + fr];
#pragma unroll
            for (int st = 0; st < 4; ++st) {
                if (st <= pt) {
                    const f32x4 bis = *(const LAS f32x4*)(gq + 64 + 16 * st);
#pragma unroll
                    for (int j = 0; j < 4; ++j) { const int sidx = 16 * st + 4 * fq + j; const float w = (sidx <= 16 * pt + fr) ? __expf(bp - bis[j]) : 0.f; ST[st][j] *= w; }
                }
            }
            __builtin_amdgcn_sched_barrier(0);
            f32x4 acc[NET], accd = (f32x4){0.f, 0.f, 0.f, 0.f};
#pragma unroll
            for (int et = 0; et < NET; ++et) acc[et] = (f32x4){0.f, 0.f, 0.f, 0.f};
#pragma unroll
            for (int kk = 0; kk < 2; ++kk) {
                const u32x2 lo = *(const LAS u32x2*)(Qi + (16 * pt + fr) * CH_PITCH + (32 * kk + 4 * fq) * 2), hi = *(const LAS u32x2*)(Qi + (16 * pt + fr) * CH_PITCH + (32 * kk + 16 + 4 * fq) * 2);
                const bf16x8 qs = mk_frag(lo, hi);
#pragma unroll
                for (int et = 0; et < NET; ++et) {
                    u32x4 w; w.x = pk2(C[2 * kk][et].x, C[2 * kk][et].y); w.y = pk2(C[2 * kk][et].z, C[2 * kk][et].w); w.z = pk2(C[2 * kk + 1][et].x, C[2 * kk + 1][et].y); w.w = pk2(C[2 * kk + 1][et].z, C[2 * kk + 1][et].w);
                    acc[et] = __builtin_amdgcn_mfma_f32_16x16x32_bf16(qs, __builtin_bit_cast(bf16x8, w), acc[et], 0, 0, 0);
                }
                if (IS_ML) {
                    const f32x4 n0 = *(const LAS f32x4*)(nq + 32 * kk), n1 = *(const LAS f32x4*)(nq + 32 * kk + 16);
                    u32x4 w; w.x = pk2(n0.x, n0.y); w.y = pk2(n0.z, n0.w); w.z = pk2(n1.x, n1.y); w.w = pk2(n1.z, n1.w);
                    if (fr != 0) w = (u32x4){0u, 0u, 0u, 0u};
                    accd = __builtin_amdgcn_mfma_f32_16x16x32_bf16(qs, __builtin_bit_cast(bf16x8, w), accd, 0, 0, 0);
                }
            }
            { const f32x4 ap = *(const LAS f32x4*)(gq + 128 + 16 * pt);
#pragma unroll
              for (int j = 0; j < 4; ++j) {
#pragma unroll
                for (int et = 0; et < NET; ++et) acc[et][j] *= ap[j];
                accd[j] *= ap[j]; } }
            __builtin_amdgcn_sched_barrier(0);
#pragma unroll
            for (int kk = 0; kk < 2; ++kk) {
                if (2 * kk <= pt) {
                    u32x4 w; w.x = pk2(ST[2 * kk].x, ST[2 * kk].y); w.y = pk2(ST[2 * kk].z, ST[2 * kk].w); w.z = pk2(ST[2 * kk + 1].x, ST[2 * kk + 1].y); w.w = pk2(ST[2 * kk + 1].z, ST[2 * kk + 1].w);
                    const bf16x8 pf = __builtin_bit_cast(bf16x8, w);
                    u32x2 vlo[2], vhi[2];
                    ds_tr16x4(va + (32 * kk + 4 * fq + tr_q) * CH_PITCH + 8 * tr_p + 64 * hf, vlo, vhi);
#pragma unroll
                    for (int et = 0; et < NET; ++et) acc[et] = __builtin_amdgcn_mfma_f32_16x16x32_bf16(pf, mk_frag(vlo[et], vhi[et]), acc[et], 0, 0, 0);
                    if (IS_ML) accd = __builtin_amdgcn_mfma_f32_16x16x32_bf16(pf, ones, accd, 0, 0, 0);
                }
            }
            __builtin_amdgcn_sched_barrier(0);
#pragma unroll
            for (int j = 0; j < 4; ++j) {
                const int p = 16 * pt + 4 * fq + j, tl = dir ? 63 - p : p, row = rowbase + tl;
                float inv = 1.f;
                if (IS_ML) { const float den = __shfl(accd[j], lane & 48); inv = 1.f / fmaxf(fabsf(den), 1.f); }
#pragma unroll
                for (int et = 0; et < NET; ++et) {
                    const float o = acc[et][j] * inv;
                    const int cof = (IS_ML ? 384 : 0) + h * 64 + 32 * hf + 16 * et + fr;
                    if (dir == 0) Y[(size_t)row * D + 384 + cof] = (bf16)f2bf(o); else OB[(size_t)row * 640 + cof] = (bf16)f2bf(o);
                }
            }
        }
        __builtin_amdgcn_sched_barrier(0);
#pragma unroll
        for (int dt = 0; dt < 4; ++dt)
#pragma unroll
            for (int et = 0; et < NET; ++et) C[dt][et] *= adec;
        f32x4 accn[4];
        if (IS_ML) {
#pragma unroll
            for (int dt = 0; dt < 4; ++dt) { accn[dt] = *(const LAS f32x4*)(nq + 16 * dt) * adec; if (fr != 0) accn[dt] = (f32x4){0.f, 0.f, 0.f, 0.f}; }
        }
#pragma unroll
        for (int kk = 0; kk < 2; ++kk) {
            u32x2 vlo[2], vhi[2], klo[4], khi[4];
            ds_tr16x4(va + (32 * kk + 4 * fq + tr_q) * CH_PITCH + 8 * tr_p + 64 * hf, vlo, vhi);
            ds_tr16x8(ka + (32 * kk + 4 * fq + tr_q) * CH_PITCH + 8 * tr_p, klo, khi);
            const f32x4 wl = *(const LAS f32x4*)(gq + 192 + 32 * kk), wh = *(const LAS f32x4*)(gq + 192 + 32 * kk + 16);
#pragma unroll
            for (int dt = 0; dt < 4; ++dt) {
                u32x4 w;
                w.x = pk2(__uint_as_float(klo[dt].x << 16) * wl[0], __uint_as_float(klo[dt].x & 0xffff0000u) * wl[1]);
                w.y = pk2(__uint_as_float(klo[dt].y << 16) * wl[2], __uint_as_float(klo[dt].y & 0xffff0000u) * wl[3]);
                w.z = pk2(__uint_as_float(khi[dt].x << 16) * wh[0], __uint_as_float(khi[dt].x & 0xffff0000u) * wh[1]);
                w.w = pk2(__uint_as_float(khi[dt].y << 16) * wh[2], __uint_as_float(khi[dt].y & 0xffff0000u) * wh[3]);
                const bf16x8 kf = __builtin_bit_cast(bf16x8, w);
#pragma unroll
                for (int et = 0; et < NET; ++et) C[dt][et] = __builtin_amdgcn_mfma_f32_16x16x32_bf16(kf, mk_frag(vlo[et], vhi[et]), C[dt][et], 0, 0, 0);
                if (IS_ML) accn[dt] = __builtin_amdgcn_mfma_f32_16x16x32_bf16(kf, ones, accn[dt], 0, 0, 0);
            }
        }
        if (IS_ML) { if (fr == 0) {
#pragma unroll
            for (int dt = 0; dt < 4; ++dt) *(LAS f32x4*)(nvec + 4 * fq + 16 * dt) = accn[dt]; } }
        asm volatile("s_waitcnt lgkmcnt(0)" ::: "memory");
        __syncthreads();
    }
}

#ifndef FAST_CHAIN
#define FAST_CHAIN 1
#endif
constexpr int NCHWG = 80;
__device__ __forceinline__ void phase_mix(Frame& F, int layer) {
    const bool last = layer == 1;
    const bf16* ftl = WSP(const bf16, WS_FTL) + (size_t)layer * 2 * 384 * 4096;
    if (FAST_CHAIN) {
        if (F.wg < NCHWG) {
            {
                const int cl = F.wave >> 1, hf = F.wave & 1, c = F.wg * 4 + cl;
                LAS unsigned char* img = F.lds + cl * CH_WAVE_LDS;
                if (c < 192) { const int b = c / 12, r = c % 12; chain_fast<false>(F, layer, b, r >> 1, r & 1, img, hf); }
                else { const int i = c - 192; chain_fast<true>(F, layer, i >> 3, (i & 7) >> 1, i & 1, img, hf); }
            }
        } else {
            const int nh = F.G - NCHWG, w = F.wg - NCHWG;
#ifndef FAST_HY
#define FAST_HY 1
#endif
            if (FAST_HY) {
                for (int u = w; u < 384; u += nh) hyena_unit_fast<LL>(F, layer, u, WSP(const bf16, WS_HYTL), ftl, WSP(bf16, WS_YHTL));
                if (!last) for (int u = w; u < 384; u += nh) hyena_unit_fast<LC>(F, layer, u, WSP(const bf16, WS_HYTC), WSP(const bf16, WS_FTC), WSP(bf16, WS_YHTC));
            } else {
                for (int u = w; u < 384; u += nh) hyena_unit_naive<LL>(F, layer, u, WSP(const bf16, WS_HYTL), ftl, WSP(bf16, WS_YHTL));
                if (!last) for (int u = w; u < 384; u += nh) hyena_unit_naive<LC>(F, layer, u, WSP(const bf16, WS_HYTC), WSP(const bf16, WS_FTC), WSP(bf16, WS_YHTC));
            }
        }
    } else {
        for (int u = F.wg; u < 384; u += F.G) hyena_unit_naive<LL>(F, layer, u, WSP(const bf16, WS_HYTL), ftl, WSP(bf16, WS_YHTL));
        if (!last) for (int u = F.wg; u < 384; u += F.G) hyena_unit_naive<LC>(F, layer, u, WSP(const bf16, WS_HYTC), WSP(const bf16, WS_FTC), WSP(bf16, WS_YHTC));
        for (int c = F.wg + F.wave * F.G; c < 320; c += F.G * NWAVES) chain_naive(F, layer, c);
    }
}

__device__ __forceinline__ void phase_combine(Frame& F, int layer) {
    const bool last = layer == 1;
    const int gw = F.wg * NWAVES + F.wave, NGW = F.G * NWAVES, lane = F.lane;
    const int nrows = last ? TOKL : TOK;
    bf16* Y = WSP(bf16, WS_Y); const bf16* OB = WSP(const bf16, WS_OB); const bf16* RET = WSP(const bf16, WS_RET); const bf16* ML = WSP(const bf16, WS_ML);
    for (int row = gw; row < nrows; row += NGW) {
#pragma unroll
        for (int hh = 0; hh < 10; ++hh) {
            const int cof = hh * 64 + lane;
            const float x = bf2f(Y[(size_t)row * D + 384 + cof]) + bf2f(OB[(size_t)row * 640 + cof]);
            const float mu = wave_sum(x) * (1.f / 64.f), xc = x - mu;
            const float var = wave_sum(xc * xc) * (1.f / 64.f);
            const float nrm = xc * rsqrtf(var + 1e-6f);
            float gate;
            if (hh < 6) gate = siluf_(bf2f(RET[(size_t)row * 1536 + 1152 + cof]));
            else gate = sigmoidf_(bf2f(ML[(size_t)row * 1024 + 768 + (cof - 384)]));
            Y[(size_t)row * D + 384 + cof] = (bf16)f2bf(nrm * gate);
        }
    }
    LAS float* scr = (LAS float*)(F.lds + F.wave * 16640);
    const int nitL = NB * 6 * 32, nitC = last ? 0 : NB * 6 * 4;
    for (int it = gw; it < nitL + nitC; it += NGW) {
        const bf16* src; int L, rowbase, b, cb, tb;
        if (it < nitL) { b = it / 192; const int r = it % 192; cb = r / 32; tb = r % 32; L = LL; src = WSP(const bf16, WS_YHTL); rowbase = b * LL; }
        else { const int i2 = it - nitL; b = i2 / 24; const int r = i2 % 24; cb = r / 4; tb = r % 4; L = LC; src = WSP(const bf16, WS_YHTC); rowbase = TOKL + b * LC; }
        for (int cc = 0; cc < 64; ++cc) scr[cc * 65 + lane] = bf2f(src[((size_t)(b * 384 + cb * 64 + cc)) * L + tb * 64 + lane]);
        asm volatile("s_waitcnt lgkmcnt(0)" ::: "memory");
        for (int tt = 0; tt < 64; ++tt) Y[(size_t)(rowbase + tb * 64 + tt) * D + cb * 64 + lane] = (bf16)f2bf(scr[lane * 65 + tt]);
        asm volatile("s_waitcnt lgkmcnt(0)" ::: "memory");
    }
}

__device__ __forceinline__ void phase_norm_router(Frame& F) {
    const int gw = F.wg * NWAVES + F.wave, NGW = F.G * NWAVES, lane = F.lane;
    const float* g = inp(F, I_GFFN) + 1 * D; const float* wr = inp(F, I_ROUTER); const float* br = inp(F, I_ROUTERB);
    unsigned* cnt = WSP(unsigned, WS_CTL) + CW_CNT;
    for (int row = gw; row < TOKL; row += NGW) {
        float keep[16];
        norm_mod_row(xrow_ptr(F, row, false), g, mod_ptr(F, 1, row, 3), mod_ptr(F, 1, row, 4), WSP(bf16, WS_H) + (size_t)row * D, lane, keep);
        float lg[8];
#pragma unroll
        for (int e = 0; e < 8; ++e) lg[e] = 0.f;
#pragma unroll
        for (int j = 0; j < 4; ++j)
#pragma unroll
            for (int i = 0; i < 4; ++i) { const int k = 256 * j + 4 * lane + i; const f32x4 w0 = *(const f32x4*)(wr + k * 8), w1 = *(const f32x4*)(wr + k * 8 + 4); const float x = keep[4 * j + i];
                lg[0] += x * w0.x; lg[1] += x * w0.y; lg[2] += x * w0.z; lg[3] += x * w0.w; lg[4] += x * w1.x; lg[5] += x * w1.y; lg[6] += x * w1.z; lg[7] += x * w1.w; }
#pragma unroll
        for (int e = 0; e < 8; ++e) lg[e] = wave_sum(lg[e]) + br[e];
        int e0 = 0; float v0 = lg[0];
#pragma unroll
        for (int e = 1; e < 8; ++e) if (lg[e] > v0) { v0 = lg[e]; e0 = e; }
        int e1 = -1; float v1 = -3.0e38f;
#pragma unroll
        for (int e = 0; e < 8; ++e) if (e != e0 && lg[e] > v1) { v1 = lg[e]; e1 = e; }
        const float w1 = 1.f / (1.f + __expf(v0 - v1)), w0 = 1.f - w1;
        if (lane == 0) {
            const unsigned p0 = atomicAdd(cnt + e0, 1u), p1 = atomicAdd(cnt + e1, 1u);
            WSP(int, WS_TOPE)[row * 2] = e0; WSP(int, WS_TOPE)[row * 2 + 1] = e1;
            WSP(float, WS_TOPW)[row * 2] = w0; WSP(float, WS_TOPW)[row * 2 + 1] = w1;
            WSP(int, WS_TOPP)[row * 2] = (int)p0; WSP(int, WS_TOPP)[row * 2 + 1] = (int)p1;
        }
    }
}
__device__ __forceinline__ void phase_route_tables(Frame& F) {
    const unsigned* cnt = WSP(const unsigned, WS_CTL) + CW_CNT;
    int off[9]; off[0] = 0;
#pragma unroll
    for (int e = 0; e < 8; ++e) { const int c = (int)__hip_atomic_load(cnt + e, __ATOMIC_RELAXED, __HIP_MEMORY_SCOPE_AGENT); off[e + 1] = off[e] + ((c + 255) >> 8) * 256; }
    const int gt = F.wg * NTHR + F.tid, NGT = F.G * NTHR;
    int* rowidx = WSP(int, WS_ROWIDX); int* slot = WSP(int, WS_SLOT); int* tilee = WSP(int, WS_TILEE);
    for (int i = gt; i < MAXTILES * 256; i += NGT) {
        int e = 0;
#pragma unroll
        for (int q = 1; q < 8; ++q) if (i >= off[q]) e = q;
        const int c = (int)cnt[e];
        if (i >= off[8] || i - off[e] >= c) rowidx[i] = 0;
    }
    for (int i = gt; i < TOKL * 2; i += NGT) {
        const int e = WSP(const int, WS_TOPE)[i], pos = WSP(const int, WS_TOPP)[i];
        int o = 0;
#pragma unroll
        for (int q = 0; q < 8; ++q) if (e == q) o = off[q];
        const int s = o + pos; slot[i] = s; rowidx[s] = i >> 1;
    }
    for (int i = gt; i < MAXTILES + 1; i += NGT) {
        if (i == MAXTILES) tilee[MAXTILES] = off[8] >> 8;
        else { int e = 0;
#pragma unroll
            for (int q = 1; q < 8; ++q) if (i * 256 >= off[q]) e = q;
            tilee[i] = e; }
    }
}

__device__ __forceinline__ void moe_pass_gemm1_fast(Frame& F, int t0, int t1) {
    pg8::OrderMoe S; S.o.init(t1 - t0, NFF1 / 256, F.G, F.wg); S.rowidx = WSP(const int, WS_ROWIDX); S.tilee = WSP(const int, WS_TILEE); S.t0 = t0; S.bstride = (size_t)NFF1 * D; S.gather = true;
    EpiSwiglu E{WSP(bf16, WS_MACT), 0};
    pg8::gemm_phase(F.lds, WSP(const bf16, WS_H), D, WSP(const bf16, WS_MW13), D, D, S, E);
}
__device__ __forceinline__ void moe_pass_gemm2_fast(Frame& F, int t0, int t1) {
    pg8::OrderMoe S; S.o.init(t1 - t0, D / 256, F.G, F.wg); S.rowidx = WSP(const int, WS_ROWIDX); S.tilee = WSP(const int, WS_TILEE); S.t0 = t0; S.bstride = (size_t)D * DFF; S.gather = false;
    EpiBf16Out E{WSP(bf16, WS_EOUT), D, t0 * 256};
    pg8::gemm_phase(F.lds, WSP(const bf16, WS_MACT), DFF, WSP(const bf16, WS_MW2), DFF, DFF, S, E);
}
__device__ __forceinline__ void phase_final(Frame& F) {
    const int gw = F.wg * NWAVES + F.wave, NGW = F.G * NWAVES, lane = F.lane;
    const float* gf = inp(F, I_GFINAL); const bf16* eo = WSP(const bf16, WS_EOUT);
    for (int row = gw; row < TOKL; row += NGW) {
        const int s0 = WSP(const int, WS_SLOT)[row * 2], s1 = WSP(const int, WS_SLOT)[row * 2 + 1];
        const float w0 = WSP(const float, WS_TOPW)[row * 2], w1 = WSP(const float, WS_TOPW)[row * 2 + 1];
        const float* m5 = mod_ptr(F, 1, row, 5);
        float* xr = outp(F) + (size_t)row * D;
        f32x4 v[4]; float s = 0.f;
#pragma unroll
        for (int j = 0; j < 4; ++j) {
            const int c = 256 * j + 4 * lane;
            const f32x4 a = ld_bf16x4(eo + (size_t)s0 * D + c), b = ld_bf16x4(eo + (size_t)s1 * D + c), m = *(const f32x4*)(m5 + c);
            v[j] = *(const f32x4*)(xr + c) + m * (a * w0 + b * w1);
            s += (v[j].x * v[j].x + v[j].y * v[j].y) + (v[j].z * v[j].z + v[j].w * v[j].w);
        }
        const float r = rsqrtf(wave_sum(s) * (1.f / 1024.f) + 1e-6f);
#pragma unroll
        for (int j = 0; j < 4; ++j) { const int c = 256 * j + 4 * lane; const f32x4 g = *(const f32x4*)(gf + c); *(f32x4*)(xr + c) = v[j] * r * g; }
    }
}

#ifndef REP_WIN
#define REP_WIN 1
#endif
#ifndef REP_MIX
#define REP_MIX 1
#endif
#ifndef REP_GATE
#define REP_GATE 1
#endif
#ifndef REP_UP
#define REP_UP 1
#endif
#ifndef REP_FFN1
#define REP_FFN1 1
#endif
#ifndef REP_MOE
#define REP_MOE 1
#endif
#ifndef REP_NORM
#define REP_NORM 1
#endif
#ifndef REP_P0
#define REP_P0 1
#endif
__global__ void __launch_bounds__(NTHR, 2) hybrid_fwd(Params prm) {
    extern __shared__ __attribute__((aligned(16))) unsigned char lds_raw[];
    Frame F;
    F.lds = (LAS unsigned char*)lds_raw; F.ws = prm.ws;
    F.tid = threadIdx.x; F.lane = F.tid & 63; F.wave = __builtin_amdgcn_readfirstlane(F.tid >> 6); F.G = gridDim.x; F.wg = blockIdx.x;
    volatile LAS unsigned* MISC = (volatile LAS unsigned*)(F.lds + MISC_OFF);
    if (F.tid < 64) MISC[F.tid] = 0u;
    if (F.tid < 33) { const unsigned long long v = F.tid < 32 ? (unsigned long long)prm.in[F.tid] : (unsigned long long)prm.out; *(LAS unsigned long long*)(F.lds + PTAB_OFF + 8 * F.tid) = v; }
    __syncthreads();
    XcdBarrier bar = xcd_barrier_post(WSP(unsigned, WS_CTL) + CW_BAR, MISC + 8);
#define RELAUNDER() do { { unsigned long long _w = (unsigned long long)F.ws; asm volatile("" : "+s"(_w)); F.ws = (unsigned char*)_w; } \
        { unsigned _t = (unsigned)F.tid; asm volatile("" : "+v"(_t)); F.tid = (int)_t; F.lane = F.tid & 63; F.wave = __builtin_amdgcn_readfirstlane(F.tid >> 6); } \
        { unsigned _g = (unsigned)F.G, _b = (unsigned)F.wg; asm volatile("" : "+s"(_g), "+s"(_b)); F.G = (int)_g; F.wg = (int)_b; } \
        { unsigned _l = (unsigned)(size_t)F.lds; asm volatile("" : "+s"(_l)); F.lds = (LAS unsigned char*)(size_t)_l; } } while (0)
#define GRID_BAR() do { { unsigned long long _b = (unsigned long long)bar.bar; unsigned _x = bar.x; asm volatile("" : "+s"(_b), "+s"(_x)); bar.bar = (unsigned*)_b; bar.x = _x; } xcd_barrier(bar); RELAUNDER(); } while (0)

    for (int rp = 0; rp < REP_P0; ++rp) { phase_p0(F); write_bias(F);
    GRID_BAR(); }
#pragma unroll 1
    for (int layer = 0; layer < 2; ++layer) {
        const bool last = layer == 1;
        const int rows_all = TOK, rows_out = last ? TOKL : TOK;
        const float* modbase = WSP(const float, WS_MOD) + (size_t)layer * 17 * 6144;
        for (int rp = 0; rp < REP_NORM; ++rp) { phase_norm(F, layer, rows_all, !last, 0);
        GRID_BAR(); }
        for (int rp = 0; rp < REP_WIN; ++rp) {
        { EpiWin E{WSP(const float, WS_BIAS) + layer * NWP, WSP(bf16, WS_HYTL), WSP(bf16, WS_HYTC), WSP(bf16, WS_RET), WSP(bf16, WS_ML), WSP(float, WS_MLG)};
          gemm_fast(F, WSP(const bf16, WS_H), D, WSP(const bf16, WS_WIN), D, D, rows_all, NW1, E); }
        GRID_BAR(); }
        for (int rp = 0; rp < REP_MIX; ++rp) { phase_mix(F, layer);
        GRID_BAR(); }
        phase_combine(F, layer);
        GRID_BAR();
        for (int rp = 0; rp < REP_GATE; ++rp) {
        { EpiGate E{WSP(const float, WS_BIAS) + layer * NWP + NW1, WSP(bf16, WS_GATES)};
          gemm_fast(F, WSP(const bf16, WS_H), D, WSP(const bf16, WS_WIN) + (size_t)NW1 * D, D, D, rows_out, NGATE, E); }
        GRID_BAR(); }
        for (int rp = 0; rp < REP_UP; ++rp) {
        { EpiUp E{WSP(const bf16, WS_GATES), WSP(bf16, WS_H)};
          gemm_fast(F, WSP(const bf16, WS_Y), D, WSP(const bf16, WS_WUP), D, D, rows_out, D, E); }
        GRID_BAR(); }
        { EpiResid E{last ? outp(F) : inp(F, I_X), last ? WSP(const float, WS_XC) : inp(F, I_CTX), outp(F), WSP(float, WS_XC), modbase, 2};
          gemm_fast(F, WSP(const bf16, WS_H), D, WSP(const bf16, WS_WOUT), D, D, rows_out, D, E); }
        GRID_BAR();
        if (!last) {
            phase_norm(F, layer, rows_out, false, 3);
            { const int gw = F.wg * NWAVES + F.wave, NGW = F.G * NWAVES; LAS float* scr = (LAS float*)(F.lds + F.wave * 8704);
              conv_weights_ffn(inp(F, I_FW1), inp(F, I_FW3), inp(F, I_FW2), WSP(bf16, WS_W13), WSP(bf16, WS_W2), gw, NGW, scr, F.lane);
              conv_weights_win(F, 1, gw, NGW, scr);
              conv_weights_upout(F, 1, gw, NGW, scr); }
            GRID_BAR();
            for (int rp = 0; rp < REP_FFN1; ++rp) {
            { EpiSwiglu E{WSP(bf16, WS_ACT), 0};
              gemm_fast(F, WSP(const bf16, WS_H), D, WSP(const bf16, WS_W13), D, D, rows_out, NFF1, E); }
            GRID_BAR(); }
            { EpiResid E{outp(F), WSP(const float, WS_XC), outp(F), WSP(float, WS_XC), modbase, 5};
              gemm_fast(F, WSP(const bf16, WS_ACT), DFF, WSP(const bf16, WS_W2), DFF, DFF, rows_out, D, E); }
            GRID_BAR();
        }
    }
    phase_norm_router(F);
    { const int gw = F.wg * NWAVES + F.wave, NGW = F.G * NWAVES; LAS float* scr = (LAS float*)(F.lds + F.wave * 8704);
#pragma unroll 1
      for (int e = 0; e < NE; ++e)
          conv_weights_ffn(inp(F, I_MW1) + (size_t)e * D * DFF, inp(F, I_MW3) + (size_t)e * D * DFF, inp(F, I_MW2) + (size_t)e * DFF * D,
                           WSP(bf16, WS_MW13) + (size_t)e * NFF1 * D, WSP(bf16, WS_MW2) + (size_t)e * D * DFF, gw, NGW, scr, F.lane); }
    GRID_BAR();
    phase_route_tables(F);
    GRID_BAR();
    const int ntiles = __builtin_amdgcn_readfirstlane(WSP(const int, WS_TILEE)[MAXTILES]);
#pragma unroll 1
    for (int p = 0; p < NPASS; ++p) {
        const int t0 = p * PASS_TILES, t1 = min(ntiles, t0 + PASS_TILES);
        for (int rp = 0; rp < REP_MOE; ++rp) {
        if (t0 < t1) moe_pass_gemm1_fast(F, t0, t1);
        GRID_BAR();
        if (t0 < t1) moe_pass_gemm2_fast(F, t0, t1);
        GRID_BAR(); }
    }
    phase_final(F);
}

extern "C" void kernel_launch(void* const* d_in, const int* in_sizes, int n_in, void* d_out, int out_size, void* d_ws, size_t ws_size, hipStream_t stream) {
    static int grid = 0;
    if (grid == 0) {
        if (n_in != 32 || out_size != TOKL * D || ws_size < WS_END) { fprintf(stderr, "kernel_launch: unexpected arguments (n_in %d, out %d, ws %zu)\n", n_in, out_size, ws_size); grid = -1; return; }
        int dev = 0, cus = 0;
        if (hipGetDevice(&dev) != hipSuccess || hipDeviceGetAttribute(&cus, hipDeviceAttributeMultiprocessorCount, dev) != hipSuccess) { grid = -1; return; }
        if (hipFuncSetAttribute((const void*)hybrid_fwd, hipFuncAttributeMaxDynamicSharedMemorySize, LDS_BYTES) != hipSuccess) { grid = -1; return; }
        int per_cu = 0;
        (void)hipOccupancyMaxActiveBlocksPerMultiprocessor(&per_cu, (const void*)hybrid_fwd, NTHR, LDS_BYTES);
        (void)hipGetLastError();
        grid = cus;
    }
    if (grid < 0) return;
    (void)hipMemsetAsync((char*)d_ws + WS_CTL, 0, CTL_ZERO_BYTES, stream);
    Params p{};
    for (int i = 0; i < 32; ++i) p.in[i] = (const float*)d_in[i];
    p.out = (float*)d_out; p.ws = (unsigned char*)d_ws;
    hipLaunchKernelGGL(hybrid_fwd, dim3(grid), dim3(NTHR), LDS_BYTES, stream, p);
}
```

```cpp
#include <hip/hip_runtime.h>
#include <stdint.h>
#include <stdio.h>

#define LAS __attribute__((address_space(3)))
#define GAS __attribute__((address_space(1)))
typedef unsigned short bf16;
typedef short bf16x8 __attribute__((ext_vector_type(8)));
typedef float f32x4 __attribute__((ext_vector_type(4)));
typedef unsigned u32x4 __attribute__((ext_vector_type(4)));
typedef unsigned u32x2 __attribute__((ext_vector_type(2)));

constexpr int D = 1024, NB = 16, LL = 2048, LC = 256;
constexpr int TOKL = NB * LL, TOKC = NB * LC, TOK = TOKL + TOKC;
constexpr int HYW = 384, RETW = 384, MLW = 256;
constexpr int NIN = 6800, NW1 = 3840, NGATE = 3072, NWP = 6912;
constexpr int DFF = 2816, NFF1 = 5632, NE = 8;
constexpr int NWAVES = 8, NTHR = 512;
constexpr int MAXTILES = 272, PASS_TILES = 64, NPASS = 5;

constexpr size_t MiB = 1u << 20;
constexpr size_t WS_CTL = 0, CTL_ZERO_BYTES = 1 * MiB;
constexpr size_t WS_MOD = 1 * MiB;
constexpr size_t WS_BIAS = 2 * MiB;
constexpr size_t WS_ROPE = 2 * MiB + 256 * 1024;
constexpr size_t WS_TOPE = 3 * MiB;
constexpr size_t WS_TOPW = 3 * MiB + 256 * 1024;
constexpr size_t WS_TOPP = 3 * MiB + 512 * 1024;
constexpr size_t WS_SLOT = 3 * MiB + 768 * 1024;
constexpr size_t WS_ROWIDX = 4 * MiB;
constexpr size_t WS_TILEE = 4 * MiB + 512 * 1024;
constexpr size_t WS_FTL = 5 * MiB;
constexpr size_t WS_FTC = 17 * MiB;
constexpr size_t WS_WIN = 18 * MiB;
constexpr size_t WS_WUP = 32 * MiB;
constexpr size_t WS_WOUT = 34 * MiB;
constexpr size_t WS_XC = 36 * MiB;
constexpr size_t WS_H = 52 * MiB;
constexpr size_t WS_Y = 124 * MiB;
constexpr size_t WS_U = 196 * MiB;
constexpr size_t WS_RET = WS_U;
constexpr size_t WS_ML = WS_U + 108 * MiB;
constexpr size_t WS_MLG = WS_U + 180 * MiB;
constexpr size_t WS_OB = WS_U + 183 * MiB;
constexpr size_t WS_YHTL = WS_U + 228 * MiB;
constexpr size_t WS_YHTC = WS_U + 252 * MiB;
constexpr size_t WS_HYTL = WS_U + 255 * MiB;
constexpr size_t WS_HYTC = WS_U + 327 * MiB;
constexpr size_t WS_END = WS_U + 336 * MiB;
constexpr size_t WS_GATES = WS_U;
constexpr size_t WS_ACT = WS_U;
constexpr size_t WS_W13 = WS_U + 204 * MiB;
constexpr size_t WS_W2 = WS_U + 216 * MiB;
constexpr size_t WS_MW13 = WS_Y;
constexpr size_t WS_MW2 = WS_Y + 88 * MiB;
constexpr size_t WS_MACT = WS_Y + 132 * MiB;
constexpr size_t WS_EOUT = WS_Y + 220 * MiB;
static_assert(WS_EOUT + (size_t)MAXTILES * 256 * 1024 * 2 <= WS_END, "map");
static_assert(WS_GATES + (size_t)TOK * NGATE * 2 <= WS_YHTL, "gates overlay");

constexpr int CW_BAR = 4096;
constexpr int CW_CNT = 16384;

constexpr int LDS_BYTES = 147456;
constexpr int MISC_OFF = 147456 - 256;

__device__ __forceinline__ float bf2f(bf16 b) { return __uint_as_float(((unsigned)b) << 16); }
__device__ __forceinline__ unsigned f2bf(float f) { unsigned u = __float_as_uint(f); return (u + 0x7fffu + ((u >> 16) & 1u)) >> 16; }
__device__ __forceinline__ unsigned pk2(float lo, float hi) { return f2bf(lo) | (f2bf(hi) << 16); }
__device__ __forceinline__ float wave_sum(float v) {
#pragma unroll
    for (int o = 1; o < 64; o <<= 1) v += __shfl_xor(v, o);
    return v;
}
__device__ __forceinline__ float sigmoidf_(float x) { return 1.0f / (1.0f + __expf(-x)); }
__device__ __forceinline__ float siluf_(float x) { return x / (1.0f + __expf(-x)); }

#define XB_TMO      128
#define XB_XCNT(j)  (256  + 64 * (j))
#define XB_XSUB(j)  (1280 + 64 * (j))
#define XB_XGEN(j)  (2304 + 64 * (j))
#define XB_TOP      3328
#define XB_TOPGEN   3392
#define XCD_BAR_WORDS 3456
#define XB_SPIN_CAP (1u << 22)
__device__ __forceinline__ unsigned xb_ld(GAS unsigned* p)              { return __hip_atomic_load(p, __ATOMIC_RELAXED, __HIP_MEMORY_SCOPE_AGENT); }
__device__ __forceinline__ unsigned xb_add(GAS unsigned* p, unsigned v) { return __hip_atomic_fetch_add(p, v, __ATOMIC_RELAXED, __HIP_MEMORY_SCOPE_AGENT); }
__device__ __forceinline__ unsigned xb_xcc_id() { return (unsigned)__builtin_amdgcn_s_getreg((3 << 11) | 20) & 0xFu; }
#define XB_SPIN(cond, bar) do { unsigned _sp = 0; while (cond) { __builtin_amdgcn_s_sleep(1); \
    if ((++_sp & 255u) == 0u) { if (xb_ld(&(bar)[XB_TMO])) break; if (_sp > XB_SPIN_CAP) { (void)__hip_atomic_fetch_add(&(bar)[XB_TMO], 1u, __ATOMIC_RELAXED, __HIP_MEMORY_SCOPE_AGENT); break; } } } } while (0)
struct XcdBarrier { GAS unsigned* bar; unsigned x; volatile LAS unsigned* st; };
__device__ __forceinline__ XcdBarrier xcd_barrier_post(GAS unsigned* bar, volatile LAS unsigned* st) {
    XcdBarrier b; b.bar = bar; b.x = xb_xcc_id(); b.st = st;
    if (threadIdx.x == 0) (void)xb_add(&bar[XB_XCNT(b.x)], 1u);
    return b;
}
__device__ __forceinline__ void xcd_barrier_complete(GAS unsigned* bar, unsigned x, unsigned& nloc, unsigned& nx) {
    const unsigned G = gridDim.x * gridDim.y * gridDim.z;
    unsigned sum, cnt, mine, sp = 0u;
    for (;;) {
        sum = 0u; cnt = 0u; mine = 0u;
#pragma unroll 1
        for (unsigned j = 0; j < 16; ++j) { const unsigned c = xb_ld(&bar[XB_XCNT(j)]); sum += c; cnt += (c > 0u) ? 1u : 0u; }
        mine = xb_ld(&bar[XB_XCNT(x)]);
        if (sum == G) break;
        __builtin_amdgcn_s_sleep(1);
        if ((++sp & 255u) == 0u) { if (xb_ld(&bar[XB_TMO])) break; if (sp > XB_SPIN_CAP) { (void)__hip_atomic_fetch_add(&bar[XB_TMO], 1u, __ATOMIC_RELAXED, __HIP_MEMORY_SCOPE_AGENT); break; } }
    }
    nloc = mine > 0u ? mine : 1u; nx = cnt > 0u ? cnt : 1u;
}
__device__ __forceinline__ void xcd_barrier(const XcdBarrier& b) {
    asm volatile("s_waitcnt vmcnt(0)" ::: "memory");
    __syncthreads();
    if (threadIdx.x == 0) {
        GAS unsigned* bar = b.bar;
        __builtin_amdgcn_s_waitcnt(0);
        unsigned nloc = b.st[0], nx = b.st[1];
        if (nloc == 0u) { xcd_barrier_complete(bar, b.x, nloc, nx); b.st[0] = nloc; b.st[1] = nx; }
        const unsigned old = xb_add(&bar[XB_XSUB(b.x)], 1u);
        const unsigned gen = old / nloc;
        if (old + 1u == (gen + 1u) * nloc) {
            __builtin_amdgcn_fence(__ATOMIC_RELEASE, "agent");
            asm volatile("s_waitcnt vmcnt(0)" ::: "memory");
            const unsigned og = xb_add(&bar[XB_TOP], 1u);
            const unsigned tg = og / nx;
            if (og + 1u == (tg + 1u) * nx) xb_add(&bar[XB_TOPGEN], 1u);
            else XB_SPIN(xb_ld(&bar[XB_TOPGEN]) == tg, bar);
            __builtin_amdgcn_fence(__ATOMIC_ACQUIRE, "agent");
            xb_add(&bar[XB_XGEN(b.x)], 1u);
            asm volatile("s_waitcnt vmcnt(0)" ::: "memory");
        } else {
            XB_SPIN(xb_ld(&bar[XB_XGEN(b.x)]) == gen, bar);
            __builtin_amdgcn_fence(__ATOMIC_ACQUIRE, "agent");
            asm volatile("s_waitcnt vmcnt(0)" ::: "memory");
        }
    }
    __syncthreads();
}

struct Params { const float* in[32]; float* out; unsigned char* ws; };
enum { I_X = 0, I_C, I_CTX, I_CCTX, I_WMOD, I_BMOD, I_GMIX, I_GFFN, I_WIN, I_BIN, I_HYCONV, I_HYF1, I_HYFB1, I_HYF2, I_HYFB2, I_HYF3, I_HYDECAY,
       I_HYSKIP, I_RETDECAY, I_MLCONV, I_MLGB, I_WUP, I_WOUT, I_FW1, I_FW3, I_FW2, I_ROUTER, I_ROUTERB, I_MW1, I_MW3, I_MW2, I_GFINAL };

struct Frame {
    LAS unsigned char* lds;
    GAS unsigned char* ws;
    int tid, lane, wave, G, wg;
};
#define WSP(T, off) ((GAS T*)(F.ws + (off)))
constexpr int PTAB_OFF = 147456 - 1024;
__device__ __forceinline__ const GAS float* inp(const Frame& F, int i) {
    const LAS unsigned* t = (const LAS unsigned*)(F.lds + PTAB_OFF) + 2 * i;
    const unsigned lo = __builtin_amdgcn_readfirstlane(t[0]), hi = __builtin_amdgcn_readfirstlane(t[1]);
    return (const GAS float*)(((unsigned long long)hi << 32) | lo);
}
__device__ __forceinline__ GAS float* outp(const Frame& F) { return (GAS float*)inp(F, 32); }

__device__ __forceinline__ int row_batch(int row) { return row < TOKL ? (row >> 11) : ((row - TOKL) >> 8); }
__device__ __forceinline__ const GAS float* mod_ptr(const Frame& F, int layer, int row, int which) {
    const int r = row < TOKL ? (row >> 11) : 16;
    return WSP(const float, WS_MOD) + ((size_t)(layer * 17 + r) * 6 + which) * 1024;
}

template <class RowMap>
__device__ __forceinline__ void tr_item(const GAS float* W, int K, int N, GAS bf16* WT, int ldT, RowMap rm, LAS float* scr, int item, int lane) {
    const int nblk = (N + 31) / 32, kb = item / nblk, nb = item % nblk, k0 = 64 * kb, n0 = 32 * nb;
#pragma unroll 8
    for (int i = 0; i < 32; ++i) { const int kk = 2 * i + (lane >> 5); const int n = n0 + (lane & 31); scr[kk * 33 + (lane & 31)] = (n < N) ? W[(size_t)(k0 + kk) * N + n] : 0.f; }
    asm volatile("s_waitcnt lgkmcnt(0)" ::: "memory");
    const int c = lane & 7;
#pragma unroll
    for (int j = 0; j < 4; ++j) { const int nl = (lane >> 3) + 8 * j; const int n = n0 + nl; const LAS float* s = scr + (8 * c) * 33 + nl;
        u32x4 o; o.x = pk2(s[0 * 33], s[1 * 33]); o.y = pk2(s[2 * 33], s[3 * 33]); o.z = pk2(s[4 * 33], s[5 * 33]); o.w = pk2(s[6 * 33], s[7 * 33]);
        if (n < N) *(GAS u32x4*)(WT + (size_t)rm(n) * ldT + k0 + 8 * c) = o; }
    asm volatile("s_waitcnt lgkmcnt(0)" ::: "memory");
}
struct RmId { __device__ __forceinline__ int operator()(int n) const { return n; } };
__device__ __forceinline__ int win_row(int n) {
    if (n < 1152) return n;
    if (n < 2688) return 1280 + (n - 1152);
    if (n < 3712) return 2816 + (n - 2688);
    if (n < 3728) return 1152 + (n - 3712);
    return 3840 + (n - 3728);
}
struct RmWin { __device__ __forceinline__ int operator()(int n) const { return win_row(n); } };
struct RmW1 { __device__ __forceinline__ int operator()(int n) const { return (n >> 4) * 32 + (n & 15); } };
struct RmW3 { __device__ __forceinline__ int operator()(int n) const { return (n >> 4) * 32 + 16 + (n & 15); } };

__device__ __forceinline__ void conv_weights_win(Frame& F, int layer, int gw, int NGW, LAS float* scr) {
    const GAS float* W = inp(F, I_WIN) + (size_t)layer * D * NIN;
    const int items = (D / 64) * ((NIN + 31) / 32);
    for (int it = gw; it < items; it += NGW) tr_item(W, D, NIN, WSP(bf16, WS_WIN), D, RmWin(), scr, it, F.lane);
    GAS bf16* wt = WSP(bf16, WS_WIN);
    for (int i = gw * 64 + F.lane; i < 112 * 1024 / 8; i += NGW * 64) *(GAS u32x4*)(wt + (size_t)1168 * 1024 + (size_t)i * 8) = (u32x4){0u, 0u, 0u, 0u};
}
__device__ __forceinline__ void conv_weights_upout(Frame& F, int layer, int gw, int NGW, LAS float* scr) {
    const int items = (D / 64) * (D / 32);
    for (int it = gw; it < items; it += NGW) tr_item(inp(F, I_WUP) + (size_t)layer * D * D, D, D, WSP(bf16, WS_WUP), D, RmId(), scr, it, F.lane);
    for (int it = gw; it < items; it += NGW) tr_item(inp(F, I_WOUT) + (size_t)layer * D * D, D, D, WSP(bf16, WS_WOUT), D, RmId(), scr, it, F.lane);
}
__device__ __forceinline__ void conv_weights_ffn(const GAS float* w1, const GAS float* w3, const GAS float* w2, GAS bf16* w13t, GAS bf16* w2t, int gw, int NGW, LAS float* scr, int lane) {
    const int i1 = (D / 64) * (DFF / 32), i2 = (DFF / 64) * (D / 32);
    for (int it = gw; it < i1; it += NGW) tr_item(w1, D, DFF, w13t, D, RmW1(), scr, it, lane);
    for (int it = gw; it < i1; it += NGW) tr_item(w3, D, DFF, w13t, D, RmW3(), scr, it, lane);
    for (int it = gw; it < i2; it += NGW) tr_item(w2, DFF, D, w2t, DFF, RmId(), scr, it, lane);
}

__device__ __forceinline__ void filter_item(Frame& F, int layer, int L, GAS bf16* FT  , int pb, int ch, LAS float* tile  ) {
    const GAS float* f1 = inp(F, I_HYF1) + layer * 33 * 64; const GAS float* fb1 = inp(F, I_HYFB1) + layer * 64;
    const GAS float* f2 = inp(F, I_HYF2) + layer * 64 * 64; const GAS float* fb2 = inp(F, I_HYFB2) + layer * 64;
    const GAS float* f3 = inp(F, I_HYF3) + (size_t)layer * 64 * 1536; const GAS float* dec = inp(F, I_HYDECAY) + layer * 1536;
    const int lane = F.lane, n = ch * 64 + lane;
    const float b1 = fb1[lane], b2 = fb2[lane], adec = fabsf(dec[n]);
    for (int pl = 0; pl < 64; ++pl) {
        const int pos = pb * 64 + pl;
        const float t = (float)pos / (float)(L - 1);
        const float w = 6.283185307179586f * (float)pos / (float)L;
        float feat = 0.f;
        if (lane == 0) feat = t;
        else if (lane < 17) { const float band = 1e-4f + (float)(lane - 1) * ((15.0f - 1e-4f) / 15.0f); feat = cosf(w * band); }
        else if (lane < 33) { const float band = 1e-4f + (float)(lane - 17) * ((15.0f - 1e-4f) / 15.0f); feat = -sinf(w * band); }
        float a1 = b1;
        for (int i = 0; i < 33; ++i) a1 += __shfl(feat, i) * f1[i * 64 + lane];
        const float h1 = sinf(a1);
        float a2 = b2;
        for (int i = 0; i < 64; ++i) a2 += __shfl(h1, i) * f2[i * 64 + lane];
        const float h2 = sinf(a2);
        float a3 = 0.f;
        for (int i = 0; i < 64; ++i) a3 += __shfl(h2, i) * f3[i * 1536 + n];
        tile[pl * 65 + lane] = a3 * expf(-t * adec);
    }
    asm volatile("s_waitcnt lgkmcnt(0)" ::: "memory");
    const int pos = pb * 64 + lane;
    for (int cl = 0; cl < 64; ++cl) {
        const int nn = ch * 64 + cl, o = nn / 768, dir = (nn / 384) & 1, c = nn % 384;
        GAS bf16* dst = FT + (size_t)(o * 384 + c) * (2 * L);
        const float v = tile[lane * 65 + cl];
        if (dir == 0) dst[L - pos] = (bf16)f2bf(v);
        else if (pos > 0) dst[L + pos] = (bf16)f2bf(v);
    }
    asm volatile("s_waitcnt lgkmcnt(0)" ::: "memory");
}

__device__ __forceinline__ void phase_p0(Frame& F) {
    const int gw = F.wg * NWAVES + F.wave, NGW = F.G * NWAVES;
    LAS float* sl = (LAS float*)F.lds;
    LAS float* red = (LAS float*)(F.lds + 17 * 4096);
    for (int i = F.tid; i < 17 * 1024; i += NTHR) { const int r = i >> 10, k = i & 1023; const float v = r < 16 ? inp(F, I_C)[r * 1024 + k] : inp(F, I_CCTX)[k]; sl[i] = siluf_(v); }
    __syncthreads();
    for (int item = F.wg; item < 2 * 384; item += F.G) {
        const int layer = item / 384, n0 = (item % 384) * 16, j = F.tid & 15, kp = F.tid >> 4;
        const GAS float* W = inp(F, I_WMOD) + (size_t)layer * D * 6144;
        float acc[17];
#pragma unroll
        for (int r = 0; r < 17; ++r) acc[r] = 0.f;
        for (int k = kp * 32; k < kp * 32 + 32; ++k) { const float w = W[(size_t)k * 6144 + n0 + j];
#pragma unroll
            for (int r = 0; r < 17; ++r) acc[r] += sl[r * 1024 + k] * w; }
#pragma unroll
        for (int r = 0; r < 17; ++r) red[(kp * 17 + r) * 16 + j] = acc[r];
        __syncthreads();
        if (F.tid < 272) { const int r = F.tid >> 4, jj = F.tid & 15; float s = inp(F, I_BMOD)[layer * 6144 + n0 + jj];
            for (int q = 0; q < 32; ++q) s += red[(q * 17 + r) * 16 + jj];
            WSP(float, WS_MOD)[(size_t)(layer * 17 + r) * 6144 + n0 + jj] = s; }
        __syncthreads();
    }
    __syncthreads();
    LAS float* scr = (LAS float*)(F.lds + F.wave * 8704);
    conv_weights_win(F, 0, gw, NGW, scr);
    conv_weights_upout(F, 0, gw, NGW, scr);
    for (int i = gw * 64 + F.lane; i < 2048 * 32; i += NGW * 64) {
        const int t = i >> 5, j = i & 31, half = j >> 4, ii = j & 15;
        const float inv = 1.0f / powf(10000.0f, (float)ii / 16.0f);
        const float ang = (float)(half == 0 ? (t >> 6) : (t & 63)) * inv;
        WSP(float, WS_ROPE)[t * 64 + half * 32 + ii] = cosf(ang);
        WSP(float, WS_ROPE)[t * 64 + half * 32 + 16 + ii] = sinf(ang);
    }
    __syncthreads();
    LAS float* ftile = (LAS float*)(F.lds + F.wave * 16640);
    for (int it = gw; it < 1536 + 96; it += NGW) {
        if (it < 1536) { const int layer = it / 768, r = it % 768; filter_item(F, layer, LL, WSP(bf16, WS_FTL) + (size_t)layer * 2 * 384 * 4096, r / 24, r % 24, ftile); }
        else { const int r = it - 1536; filter_item(F, 0, LC, WSP(bf16, WS_FTC), r / 24, r % 24, ftile); }
    }
}
__device__ __forceinline__ void write_bias(Frame& F) {
    const int gt = (F.wg * NWAVES + F.wave) * 64 + F.lane, NGT = F.G * NTHR;
    for (int i = gt; i < 2 * NWP; i += NGT) {
        const int l = i / NWP, r = i % NWP; float v = 0.f;
        int n = -1;
        if (r < 1152) n = r; else if (r < 1168) n = 3712 + (r - 1152); else if (r < 1280) n = -1; else if (r < 2816) n = 1152 + (r - 1280); else if (r < 3840) n = 2688 + (r - 2816); else n = 3728 + (r - 3840);
        if (n >= 0) v = inp(F, I_BIN)[l * NIN + n];
        WSP(float, WS_BIAS)[i] = v;
    }
}

__device__ __forceinline__ void norm_mod_row(const GAS float* xrow, const GAS float* g, const GAS float* shift, const GAS float* scale, GAS bf16* orow, int lane, float* keep  ) {
    f32x4 v[4]; float s = 0.f;
#pragma unroll
    for (int j = 0; j < 4; ++j) { v[j] = *(const GAS f32x4*)(xrow + 256 * j + 4 * lane); s += (v[j].x * v[j].x + v[j].y * v[j].y) + (v[j].z * v[j].z + v[j].w * v[j].w); }
    const float r = rsqrtf(wave_sum(s) * (1.0f / 1024.0f) + 1e-6f);
#pragma unroll
    for (int j = 0; j < 4; ++j) {
        const f32x4 gg = *(const GAS f32x4*)(g + 256 * j + 4 * lane), sh = *(const GAS f32x4*)(shift + 256 * j + 4 * lane), sc = *(const GAS f32x4*)(scale + 256 * j + 4 * lane);
        f32x4 o;
        o.x = (v[j].x * r * gg.x) * (1.f + sc.x) + sh.x; o.y = (v[j].y * r * gg.y) * (1.f + sc.y) + sh.y;
        o.z = (v[j].z * r * gg.z) * (1.f + sc.z) + sh.z; o.w = (v[j].w * r * gg.w) * (1.f + sc.w) + sh.w;
        if (keep) { keep[4 * j + 0] = o.x; keep[4 * j + 1] = o.y; keep[4 * j + 2] = o.z; keep[4 * j + 3] = o.w; }
        u32x2 w; w.x = pk2(o.x, o.y); w.y = pk2(o.z, o.w);
        *(GAS u32x2*)(orow + 256 * j + 4 * lane) = w;
    }
}
__device__ __forceinline__ const GAS float* xrow_ptr(const Frame& F, int row, bool from_input) {
    if (row < TOKL) return (from_input ? inp(F, I_X) : outp(F)) + (size_t)row * D;
    return (from_input ? inp(F, I_CTX) : WSP(const float, WS_XC)) + (size_t)(row - TOKL) * D;
}
__device__ __forceinline__ void phase_norm(Frame& F, int layer, int nrows, bool from_input, int which) {
    const int gw = F.wg * NWAVES + F.wave, NGW = F.G * NWAVES;
    const GAS float* g = inp(F, which == 0 ? I_GMIX : I_GFFN) + layer * D;
    for (int row = gw; row < nrows; row += NGW)
        norm_mod_row(xrow_ptr(F, row, from_input), g, mod_ptr(F, layer, row, which), mod_ptr(F, layer, row, which + 1), WSP(bf16, WS_H) + (size_t)row * D, F.lane, nullptr);
}

namespace pg8 {
constexpr int BM = 256, BK = 64, HALF = 128, HTB = HALF * BK * 2, STAGE_BYTES = 8 * HTB, NXCD = 8, WGM = 8;
__device__ __forceinline__ int lds_byte(int r, int c) { const int st = (r >> 4) * 2 + (c >> 5), rr = r & 15, cc = c & 31, ob = rr * 64 + cc * 2; return st * 1024 + (ob ^ (((ob >> 9) & 1) << 5)); }
__device__ __forceinline__ void stage_rc(int b, int& R, int& C) { const int st = b / 1024, sb = b % 1024, swz = sb ^ (((sb >> 9) & 1) << 5); R = (st >> 1) * 16 + swz / 64; C = (st & 1) * 32 + (swz % 64) / 2; }
struct Unit { int pm, pn; };
struct OrderPlain {
    static constexpr bool GATHER = false;
    int nM, nN, nwg, G, c;
    __device__ __forceinline__ void init(int nM_, int nN_, int G_, int c_) { nM = nM_; nN = nN_; nwg = nM * nN; G = G_; c = c_; }
    __device__ __forceinline__ bool next(int i, Unit& u) const {
        const long L = (long)i * G + c; if (L >= nwg) return false;
        int wgid = (int)L; { const int q = nwg / NXCD, r = nwg % NXCD, xcd = wgid % NXCD, off = wgid / NXCD; wgid = (xcd < r ? xcd * (q + 1) : r * (q + 1) + (xcd - r) * q) + off; }
        const int nig = WGM * nN, gid = wgid / nig, fm = gid * WGM, gsz = (nM - fm) < WGM ? (nM - fm) : WGM;
        u.pm = fm + ((wgid % nig) % gsz); u.pn = (wgid % nig) / gsz; return true;
    }
    __device__ __forceinline__ int arow(int r) const { return r; }
    __device__ __forceinline__ size_t boff(const Unit&) const { return 0; }
};
struct OrderMoe {
    static constexpr bool GATHER = true;
    OrderPlain o; const GAS int* rowidx; const GAS int* tilee; int t0; size_t bstride; bool gather;
    __device__ __forceinline__ bool next(int i, Unit& u) const { return o.next(i, u); }
    __device__ __forceinline__ int arow(int r) const { return gather ? rowidx[t0 * 256 + r] : r; }
    __device__ __forceinline__ size_t boff(const Unit& u) const { return (size_t)tilee[t0 + u.pm] * bstride; }
};

template <class Epi, class Sched>
__device__ __forceinline__ void gemm_phase(LAS unsigned char* lds, const GAS bf16* A, int lda, const GAS bf16* Bt, int ldb, int K, const Sched& S, const Epi& E) {
    unsigned tid_u = threadIdx.x; asm volatile("" : "+v"(tid_u));
    const int tid = (int)tid_u, wid = __builtin_amdgcn_readfirstlane(tid >> 6), lane = tid & 63, wr = wid >> 2, wc = wid & 3, fr = lane & 15, fq = lane >> 4;
    const int nt = K / BK;
    unsigned voffB[2];
    { int sR[2], sC[2];
#pragma unroll
      for (int i = 0; i < 2; ++i) { stage_rc(tid * 16 + i * 8192, sR[i], sC[i]); voffB[i] = (unsigned)(sR[i] * ldb + sC[i]) * 2u; } }
#define PG8_GATHER_OFFS(pm_) do { unsigned _t = (unsigned)tid; asm volatile("" : "+v"(_t)); _Pragma("unroll") for (int i = 0; i < 2; ++i) { int _R, _C; stage_rc((int)_t * 16 + i * 8192, _R, _C); \
        vc0[i] = (unsigned)((size_t)S.arow((pm_) * BM + _R) * lda + _C) * 2u; vc1[i] = (unsigned)((size_t)S.arow((pm_) * BM + HALF + _R) * lda + _C) * 2u; } } while (0)
    const size_t kstep = (size_t)(BK * 2);
    const size_t hstepB = (size_t)HALF * ldb * 2, tstepB = 2 * hstepB;
    const unsigned ldsw = (unsigned)wid * 1024u;
    const int aoff = lds_byte(wr * 64 + fr, fq * 8), boff = lds_byte(wc * 32 + fr, fq * 8);
#define PG8_SA(b, h) (((b) * 2 + (h)) * HTB)
#define PG8_SB(b, h) ((4 + (b) * 2 + (h)) * HTB)
#define PG8_STAGE2(bufoff, gbase, v0, v1) do { \
        __builtin_amdgcn_global_load_lds((const GAS unsigned*)((const GAS char*)(gbase) + (v0)), (LAS unsigned*)(lds + (bufoff) + ldsw), 16, 0, 0); \
        __builtin_amdgcn_global_load_lds((const GAS unsigned*)((const GAS char*)(gbase) + (v1)), (LAS unsigned*)(lds + (bufoff) + ldsw + 8192), 16, 0, 0); } while (0)
#define PG8_STAGEB(bufoff, gbase) PG8_STAGE2(bufoff, gbase, voffB[0], voffB[1])
#define PG8_LDA(dst, b, h) do { _Pragma("unroll") for (int m = 0; m < 4; ++m) _Pragma("unroll") for (int k = 0; k < 2; ++k) dst[m][k] = *(const LAS bf16x8*)(lds + PG8_SA(b, h) + aoff + m * 2048 + k * 1024); } while (0)
#define PG8_LDB(dst, b, h) do { _Pragma("unroll") for (int n = 0; n < 2; ++n) _Pragma("unroll") for (int k = 0; k < 2; ++k) dst[n][k] = *(const LAS bf16x8*)(lds + PG8_SB(b, h) + boff + n * 2048 + k * 1024); } while (0)
#define PG8_MMA(ai, bj, At, Bt_) do { __builtin_amdgcn_s_setprio(1); _Pragma("unroll") for (int m = 0; m < 4; ++m) _Pragma("unroll") for (int n = 0; n < 2; ++n) _Pragma("unroll") for (int k = 0; k < 2; ++k) \
        acc[ai][bj][m][n] = __builtin_amdgcn_mfma_f32_16x16x32_bf16(Bt_[n][k], At[m][k], acc[ai][bj][m][n], 0, 0, 0); __builtin_amdgcn_s_setprio(0); } while (0)
#define PG8_WAIT_V(n) asm volatile("s_waitcnt vmcnt(" #n ")" ::: "memory")
#define PG8_WAIT_L(n) asm volatile("s_waitcnt lgkmcnt(" #n ")" ::: "memory")
#define PG8_BAR __builtin_amdgcn_s_barrier()
#define PG8_SCHED __builtin_amdgcn_sched_barrier(0)
    Unit cur, nxt; int ui = 0;
    if (!S.next(0, cur)) return;
    f32x4 acc[2][2][4][2];
#pragma unroll
    for (int a = 0; a < 2; ++a)
#pragma unroll
        for (int b = 0; b < 2; ++b)
#pragma unroll
            for (int m = 0; m < 4; ++m)
#pragma unroll
                for (int n = 0; n < 2; ++n) { float zf; asm volatile("v_mov_b32 %0, 0" : "=v"(zf)); acc[a][b][m][n] = (f32x4){zf, zf, zf, zf}; }
    bf16x8 At[4][2], B0[2][2], B1[2][2];
    constexpr bool GA = Sched::GATHER;
    const size_t hstepA = GA ? 0 : (size_t)HALF * lda * 2, tstepA = (size_t)BM * lda * 2;
    unsigned vc0[2], vc1[2];
    if constexpr (GA) { PG8_GATHER_OFFS(cur.pm); }
    else { int sR, sC;
#pragma unroll
        for (int i = 0; i < 2; ++i) { stage_rc(tid * 16 + i * 8192, sR, sC); vc0[i] = (unsigned)(sR * lda + sC) * 2u; vc1[i] = 0u; } }
#define VC0(i) vc0[i]
#define VC1(i) (GA ? vc1[i] : vc0[i])
#define VN0(i) vc0[i]
#define VN1(i) VC1(i)
    const GAS char* cA = GA ? (const GAS char*)A : (const GAS char*)A + (size_t)cur.pm * tstepA;
    const GAS char* cB = (const GAS char*)Bt + S.boff(cur) * 2 + (size_t)cur.pn * tstepB;
    PG8_STAGEB(PG8_SB(0, 0), cB); PG8_STAGE2(PG8_SA(0, 0), cA, VC0(0), VC0(1)); PG8_STAGEB(PG8_SB(0, 1), cB + hstepB); PG8_STAGE2(PG8_SA(0, 1), cA + hstepA, VC1(0), VC1(1));
    if (wr == 1) PG8_BAR;
    PG8_WAIT_V(4); PG8_BAR;
    PG8_STAGEB(PG8_SB(1, 0), cB + kstep); PG8_STAGE2(PG8_SA(1, 0), cA + kstep, VC0(0), VC0(1)); PG8_STAGEB(PG8_SB(1, 1), cB + hstepB + kstep);
    PG8_WAIT_V(6); PG8_BAR;
    for (;;) {
        const bool has_next = S.next(ui + 1, nxt);
        const GAS char* nB = cB; const GAS char* nA = cA;
        if (has_next) {
            nB = (const GAS char*)Bt + S.boff(nxt) * 2 + (size_t)nxt.pn * tstepB;
            if constexpr (!GA) nA = (const GAS char*)A + (size_t)nxt.pm * tstepA;
        }
        for (int t = 0; t < nt; t += 2) {
            const bool last = (t == nt - 2);
            if constexpr (Epi::HORNER) {
                if (t == 6 || t == 12) {
                    asm volatile("" ::: "memory");
                    const int seg = (t == 6) ? 0 : 1;
                    int hpm = cur.pm, hpn = cur.pn; asm volatile("" : "+s"(hpm), "+s"(hpn));
                    unsigned hln = (unsigned)lane; asm volatile("" : "+v"(hln)); const int hfr = (int)(hln & 15u), hfq = (int)(hln >> 4);
#pragma unroll
                    for (int ai = 0; ai < 2; ++ai) {
                        u32x2 ga[4][2][2], gb[4][2][2];
#pragma unroll
                        for (int m = 0; m < 4; ++m)
#pragma unroll
                            for (int bj = 0; bj < 2; ++bj)
#pragma unroll
                                for (int n = 0; n < 2; ++n) {
                                    const int row = hpm * BM + ai * HALF + wr * 64 + m * 16 + hfr, col = hpn * BM + bj * HALF + wc * 32 + n * 16 + 4 * hfq;
                                    ga[m][bj][n] = E.gate(seg, row, col); gb[m][bj][n] = E.gate(seg + 1, row, col);
                                }
                        asm volatile("" : "+v"(ga[0][0][0]), "+v"(ga[0][0][1]), "+v"(ga[0][1][0]), "+v"(ga[0][1][1]), "+v"(ga[1][0][0]), "+v"(ga[1][0][1]), "+v"(ga[1][1][0]), "+v"(ga[1][1][1]),
                                          "+v"(ga[2][0][0]), "+v"(ga[2][0][1]), "+v"(ga[2][1][0]), "+v"(ga[2][1][1]), "+v"(ga[3][0][0]), "+v"(ga[3][0][1]), "+v"(ga[3][1][0]), "+v"(ga[3][1][1]) :: "memory");
                        asm volatile("" : "+v"(gb[0][0][0]), "+v"(gb[0][0][1]), "+v"(gb[0][1][0]), "+v"(gb[0][1][1]), "+v"(gb[1][0][0]), "+v"(gb[1][0][1]), "+v"(gb[1][1][0]), "+v"(gb[1][1][1]),
                                          "+v"(gb[2][0][0]), "+v"(gb[2][0][1]), "+v"(gb[2][1][0]), "+v"(gb[2][1][1]), "+v"(gb[3][0][0]), "+v"(gb[3][0][1]), "+v"(gb[3][1][0]), "+v"(gb[3][1][1]) :: "memory");
#pragma unroll
                        for (int m = 0; m < 4; ++m)
#pragma unroll
                            for (int bj = 0; bj < 2; ++bj)
#pragma unroll
                                for (int n = 0; n < 2; ++n) {
                                    const u32x2 a = ga[m][bj][n], b = gb[m][bj][n];
                                    f32x4& v = acc[ai][bj][m][n];
                                    v.x *= __uint_as_float(a.x << 16) * __builtin_amdgcn_rcpf(__uint_as_float(b.x << 16));
                                    v.y *= __uint_as_float(a.x & 0xffff0000u) * __builtin_amdgcn_rcpf(__uint_as_float(b.x & 0xffff0000u));
                                    v.z *= __uint_as_float(a.y << 16) * __builtin_amdgcn_rcpf(__uint_as_float(b.y << 16));
                                    v.w *= __uint_as_float(a.y & 0xffff0000u) * __builtin_amdgcn_rcpf(__uint_as_float(b.y & 0xffff0000u));
                                }
                    }
                    asm volatile("s_waitcnt vmcnt(0)" ::: "memory");
                }
            }
            const GAS char* a1 = cA + (size_t)(t + 1) * kstep;
            const GAS char* a2 = last ? nA : cA + (size_t)(t + 2) * kstep; const GAS char* b2 = last ? nB : cB + (size_t)(t + 2) * kstep;
            const GAS char* a3 = a2 + kstep; const GAS char* b3 = b2 + kstep;
            PG8_LDB(B0, 0, 0); PG8_SCHED; PG8_LDA(At, 0, 0); PG8_STAGE2(PG8_SA(1, 1), a1 + hstepA, VC1(0), VC1(1));
            if constexpr (GA) { if (last && has_next) { asm volatile("" ::: "memory"); PG8_GATHER_OFFS(nxt.pm); asm volatile("" ::: "memory"); } }
            PG8_WAIT_L(8); PG8_BAR; PG8_WAIT_L(0); PG8_MMA(0, 0, At, B0); PG8_BAR; PG8_SCHED;
            PG8_LDB(B1, 0, 1); PG8_STAGEB(PG8_SB(0, 0), b2);
            PG8_BAR; PG8_WAIT_L(0); PG8_MMA(0, 1, At, B1); PG8_BAR;
            PG8_LDA(At, 0, 1); PG8_STAGE2(PG8_SA(0, 0), a2, VN0(0), VN0(1));
            PG8_BAR; PG8_WAIT_L(0); PG8_MMA(1, 0, At, B0); PG8_BAR; PG8_SCHED;
            PG8_STAGEB(PG8_SB(0, 1), b2 + hstepB);
            PG8_WAIT_V(6); PG8_BAR; PG8_MMA(1, 1, At, B1); PG8_BAR;
            PG8_LDB(B0, 1, 0); PG8_SCHED; PG8_LDA(At, 1, 0); PG8_STAGE2(PG8_SA(0, 1), a2 + hstepA, VN1(0), VN1(1));
            PG8_WAIT_L(8); PG8_BAR; PG8_WAIT_L(0); PG8_MMA(0, 0, At, B0); PG8_BAR; PG8_SCHED;
            PG8_LDB(B1, 1, 1); PG8_STAGEB(PG8_SB(1, 0), b3);
            PG8_BAR; PG8_WAIT_L(0); PG8_MMA(0, 1, At, B1); PG8_BAR;
            PG8_LDA(At, 1, 1); PG8_STAGE2(PG8_SA(1, 0), a3, VN0(0), VN0(1));
            PG8_BAR; PG8_WAIT_L(0); PG8_MMA(1, 0, At, B0); PG8_BAR; PG8_SCHED;
            PG8_STAGEB(PG8_SB(1, 1), b3 + hstepB);
            PG8_WAIT_V(6); PG8_BAR; PG8_MMA(1, 1, At, B1); PG8_BAR;
        }
        {
            int epm = cur.pm, epn = cur.pn; asm volatile("" : "+s"(epm), "+s"(epn));
            unsigned eln = (unsigned)lane; asm volatile("" : "+v"(eln)); const int efr = (int)(eln & 15u), efq = (int)(eln >> 4);
            f32x4 cv[2][2];
#pragma unroll
            for (int bj = 0; bj < 2; ++bj)
#pragma unroll
                for (int n = 0; n < 2; ++n) { if constexpr (Epi::COLVEC) cv[bj][n] = E.colvec(epm * BM, epn * BM + bj * HALF + wc * 32 + n * 16 + 4 * efq); else cv[bj][n] = (f32x4){0.f, 0.f, 0.f, 0.f}; }
            if constexpr (Epi::COLVEC) asm volatile("" : "+v"(cv[0][0]), "+v"(cv[0][1]), "+v"(cv[1][0]), "+v"(cv[1][1]) :: "memory");
#pragma unroll
            for (int ai = 0; ai < 2; ++ai) {
                f32x4 bs[4][2][2];
                if constexpr (Epi::BASE) {
#pragma unroll
                    for (int m = 0; m < 4; ++m)
#pragma unroll
                        for (int bj = 0; bj < 2; ++bj)
#pragma unroll
                            for (int n = 0; n < 2; ++n) bs[m][bj][n] = E.base(epm * BM + ai * HALF + wr * 64 + m * 16 + efr, epn * BM + bj * HALF + wc * 32 + n * 16 + 4 * efq);
                    asm volatile("" : "+v"(bs[0][0][0]), "+v"(bs[0][0][1]), "+v"(bs[0][1][0]), "+v"(bs[0][1][1]), "+v"(bs[1][0][0]), "+v"(bs[1][0][1]), "+v"(bs[1][1][0]), "+v"(bs[1][1][1]),
                                      "+v"(bs[2][0][0]), "+v"(bs[2][0][1]), "+v"(bs[2][1][0]), "+v"(bs[2][1][1]), "+v"(bs[3][0][0]), "+v"(bs[3][0][1]), "+v"(bs[3][1][0]), "+v"(bs[3][1][1]) :: "memory");
                }
#pragma unroll
                for (int m = 0; m < 4; ++m) {
                    const int row = epm * BM + ai * HALF + wr * 64 + m * 16 + efr;
#pragma unroll
                    for (int bj = 0; bj < 2; ++bj) {
                        if constexpr (Epi::PAIR) E.store_pair(row, epn * (BM / 2) + bj * (HALF / 2) + wc * 16 + 4 * efq, acc[ai][bj][m][0], acc[ai][bj][m][1]);
                        else {
#pragma unroll
                            for (int n = 0; n < 2; ++n) { f32x4 bb = (f32x4){0.f, 0.f, 0.f, 0.f}; if constexpr (Epi::BASE) bb = bs[m][bj][n]; E.store(row, epn * BM + bj * HALF + wc * 32 + n * 16 + 4 * efq, acc[ai][bj][m][n], cv[bj][n], bb); }
                        }
                    }
                }
            }
        }
        if (!has_next) break;
#pragma unroll
        for (int a = 0; a < 2; ++a)
#pragma unroll
            for (int b = 0; b < 2; ++b)
#pragma unroll
                for (int m = 0; m < 4; ++m)
#pragma unroll
                    for (int n = 0; n < 2; ++n) { float zf; asm volatile("v_mov_b32 %0, 0" : "=v"(zf)); acc[a][b][m][n] = (f32x4){zf, zf, zf, zf}; }
        cur = nxt; cB = nB; cA = nA; ++ui;
    }
    PG8_WAIT_V(0);
    if (wr == 0) PG8_BAR;
    PG8_BAR;
#undef PG8_GATHER_OFFS
#undef VC0
#undef VC1
#undef VN0
#undef VN1
#undef PG8_SA
#undef PG8_SB
#undef PG8_STAGE2
#undef PG8_STAGEB
#undef PG8_LDA
#undef PG8_LDB
#undef PG8_MMA
#undef PG8_WAIT_V
#undef PG8_WAIT_L
#undef PG8_BAR
#undef PG8_SCHED
}
}

template <class Epi>
__device__ __forceinline__ void gemm_fast(Frame& F, const GAS bf16* A, int lda, const GAS bf16* Bt, int ldb, int K, int M, int N, const Epi& E) {
    pg8::OrderPlain S; S.init(M / 256, N / 256, F.G, F.wg);
    pg8::gemm_phase(F.lds, A, lda, Bt, ldb, K, S, E);
}
#ifndef FAST_PLAIN
#define FAST_PLAIN 1
#endif
#ifndef FAST_HORNER
#define FAST_HORNER 1
#endif
#ifndef FAST_MOE
#define FAST_MOE 1
#endif

__device__ __forceinline__ void st_bf16x4(GAS bf16* p, f32x4 v) { u32x2 w; w.x = pk2(v.x, v.y); w.y = pk2(v.z, v.w); *(GAS u32x2*)p = w; }
__device__ __forceinline__ f32x4 ld_bf16x4(const GAS bf16* p) { const u32x2 w = *(const GAS u32x2*)p; f32x4 v; v.x = __uint_as_float(w.x << 16); v.y = __uint_as_float(w.x & 0xffff0000u); v.z = __uint_as_float(w.y << 16); v.w = __uint_as_float(w.y & 0xffff0000u); return v; }

struct EpiWin {
    static constexpr bool HORNER = false, PAIR = false, COLVEC = true, BASE = false;
    const GAS float* bias; GAS bf16 *hytl, *hytc, *ret, *ml; GAS float* mlg;
    __device__ __forceinline__ f32x4 colvec(int, int col) const { return *(const GAS f32x4*)(bias + col); }
    __device__ __forceinline__ void store(int row, int col, f32x4 v, f32x4 cv, f32x4) const {
        v += cv;
        if (col < 1152) {
            if (row < TOKL) { const int b = row >> 11, t = row & 2047; GAS bf16* d = hytl + ((size_t)(b * 1152 + col)) * 2048 + t;
                d[0] = (bf16)f2bf(v.x); d[2048] = (bf16)f2bf(v.y); d[4096] = (bf16)f2bf(v.z); d[6144] = (bf16)f2bf(v.w); }
            else { const int r = row - TOKL, b = r >> 8, t = r & 255; GAS bf16* d = hytc + ((size_t)(b * 1152 + col)) * 256 + t;
                d[0] = (bf16)f2bf(v.x); d[256] = (bf16)f2bf(v.y); d[512] = (bf16)f2bf(v.z); d[768] = (bf16)f2bf(v.w); }
        } else if (col < 1168) { *(GAS f32x4*)(mlg + (size_t)row * 16 + (col - 1152)) = v; }
        else if (col < 1280) { }
        else if (col < 2816) st_bf16x4(ret + (size_t)row * 1536 + (col - 1280), v);
        else st_bf16x4(ml + (size_t)row * 1024 + (col - 2816), v);
    }
};
struct EpiGate {
    static constexpr bool HORNER = false, PAIR = false, COLVEC = true, BASE = false;
    const GAS float* bias; GAS bf16* gates;
    __device__ __forceinline__ f32x4 colvec(int, int col) const { return *(const GAS f32x4*)(bias + col); }
    __device__ __forceinline__ void store(int row, int col, f32x4 v, f32x4 cv, f32x4) const {
        v += cv;
        f32x4 g; g.x = fmaxf(sigmoidf_(v.x), 1e-20f); g.y = fmaxf(sigmoidf_(v.y), 1e-20f); g.z = fmaxf(sigmoidf_(v.z), 1e-20f); g.w = fmaxf(sigmoidf_(v.w), 1e-20f);
        st_bf16x4(gates + (size_t)row * NGATE + col, g);
    }
};
struct EpiUp {
    static constexpr bool HORNER = true, PAIR = false, COLVEC = false, BASE = true;
    const GAS bf16* gates; GAS bf16* acc_out;
    __device__ __forceinline__ u32x2 gate(int which, int row, int col) const { return *(const GAS u32x2*)(gates + (size_t)row * NGATE + which * 1024 + col); }
    __device__ __forceinline__ f32x4 base(int row, int col) const { return ld_bf16x4(gates + (size_t)row * NGATE + 2048 + col); }
    __device__ __forceinline__ void store(int row, int col, f32x4 v, f32x4, f32x4 g) const { st_bf16x4(acc_out + (size_t)row * D + col, v * g); }
};
struct EpiResid {
    static constexpr bool HORNER = false, PAIR = false, COLVEC = true, BASE = true;
    const GAS float *xin_l, *xin_c; GAS float *xout_l, *xout_c; const GAS float* modbase; int which;
    __device__ __forceinline__ f32x4 colvec(int row0, int col) const { const int r = row0 < TOKL ? (row0 >> 11) : 16; return *(const GAS f32x4*)(modbase + ((size_t)r * 6 + which) * 1024 + col); }
    __device__ __forceinline__ f32x4 base(int row, int col) const { return row < TOKL ? *(const GAS f32x4*)(xin_l + (size_t)row * D + col) : *(const GAS f32x4*)(xin_c + (size_t)(row - TOKL) * D + col); }
    __device__ __forceinline__ void store(int row, int col, f32x4 v, f32x4 m, f32x4 x) const {
        if (row < TOKL) *(GAS f32x4*)(xout_l + (size_t)row * D + col) = x + m * v;
        else *(GAS f32x4*)(xout_c + (size_t)(row - TOKL) * D + col) = x + m * v;
    }
};
struct EpiSwiglu {
    static constexpr bool HORNER = false, PAIR = true, COLVEC = false, BASE = false;
    GAS bf16* act; int row_off;
    __device__ __forceinline__ void store_pair(int row, int col, f32x4 a, f32x4 b) const {
        f32x4 o; o.x = siluf_(a.x) * b.x; o.y = siluf_(a.y) * b.y; o.z = siluf_(a.z) * b.z; o.w = siluf_(a.w) * b.w;
        st_bf16x4(act + (size_t)(row - row_off) * DFF + col, o);
    }
    __device__ __forceinline__ void store(int, int, f32x4, f32x4, f32x4) const {}
};
struct EpiBf16Out {
    static constexpr bool HORNER = false, PAIR = false, COLVEC = false, BASE = false;
    GAS bf16* out; int ld; int row_add;
    __device__ __forceinline__ void store(int row, int col, f32x4 v, f32x4, f32x4) const { st_bf16x4(out + (size_t)(row + row_add) * ld + col, v); }
    __device__ __forceinline__ void store_pair(int, int, f32x4, f32x4) const {}
};

constexpr int ZPITCH_L = (LL + 8) * 2, ZPITCH_C = (LC + 8) * 2;
template <int L>
__device__ __forceinline__ float conv3_at(const GAS bf16* base  , int t, float w0, float w1, float w2) {
    const float a = t > 0 ? bf2f(base[t - 1]) : 0.f, b = bf2f(base[t]), c = t < L - 1 ? bf2f(base[t + 1]) : 0.f;
    return w0 * a + w1 * b + w2 * c;
}
template <int L>
__device__ __forceinline__ void hyena_unit_naive(Frame& F, int layer, int c, const GAS bf16* hyt  , const GAS bf16* ft  , GAS bf16* yht  ) {
    constexpr int ZP = (L + 8) * 2;
    constexpr int PER = L / 32;
    constexpr int SUB = 8;
    LAS unsigned char* zimg0 = F.lds;
    LAS unsigned char* zimg1 = F.lds + 16 * ZP;
    LAS bf16* tf = (LAS bf16*)(F.lds + 32 * ZP);
    const GAS float* cw = inp(F, I_HYCONV) + layer * 3 * 1152;
    const GAS float* skip = inp(F, I_HYSKIP) + layer * 2 * 384;
    __syncthreads();
    {
        const int b = F.tid >> 5, seg = F.tid & 31; const GAS bf16* src = hyt + ((size_t)(b * 1152 + c)) * L;
        const float w0 = cw[c], w1 = cw[1152 + c], w2 = cw[2304 + c];
#pragma unroll 2
        for (int j = 0; j < PER; ++j) { const int t = seg * PER + j; *(LAS bf16*)(zimg0 + b * ZP + t * 2) = (bf16)f2bf(conv3_at<L>(src, t, w0, w1, w2)); }
    }
#pragma unroll 1
    for (int o = 0; o < 2; ++o) {
        LAS unsigned char* zs = o == 0 ? zimg0 : zimg1;
        LAS unsigned char* zd = o == 0 ? zimg1 : zimg0;
        const GAS bf16* fsrc = ft + ((size_t)(o * 384 + c)) * (2 * L);
        for (int i = F.tid; i < 2 * L; i += NTHR) tf[i] = i == 0 ? (bf16)0 : fsrc[i];
        __syncthreads();
        const int b = F.tid & 15, tg = F.tid >> 4;
        const int gcol = (o == 0 ? 384 : 768) + c;
        const GAS bf16* gsrc = hyt + ((size_t)(b * 1152 + gcol)) * L;
        const float w0 = cw[gcol], w1 = cw[1152 + gcol], w2 = cw[2304 + gcol], sk = skip[o * 384 + c];
#pragma unroll 1
        for (int sb = 0; sb < PER / SUB; ++sb) {
            const int t0 = tg * PER + sb * SUB;
            float acc[SUB];
#pragma unroll
            for (int j = 0; j < SUB; ++j) acc[j] = 0.f;
#pragma unroll 1
            for (int s0 = 0; s0 < L; s0 += 8) {
                float z[8];
                { const bf16x8 zz = *(const LAS bf16x8*)(zs + b * ZP + s0 * 2);
#pragma unroll
                  for (int i = 0; i < 8; ++i) z[i] = bf2f((bf16)zz[i]); }
                float win[SUB + 7];
                const int wb = L + s0 - t0 - (SUB - 1);
#pragma unroll
                for (int i = 0; i < SUB + 7; ++i) win[i] = bf2f(tf[wb + i]);
#pragma unroll
                for (int j = 0; j < SUB; ++j)
#pragma unroll
                    for (int i = 0; i < 8; ++i) acc[j] += win[(SUB - 1) - j + i] * z[i];
            }
#pragma unroll
            for (int j = 0; j < SUB; ++j) {
                const int t = t0 + j;
                const float zt = bf2f(*(LAS bf16*)(zs + b * ZP + t * 2));
                const float ov = conv3_at<L>(gsrc, t, w0, w1, w2) * (acc[j] + sk * zt);
                *(LAS bf16*)(zd + b * ZP + t * 2) = (bf16)f2bf(ov);
            }
        }
        __syncthreads();
    }
#pragma unroll 2
    for (int i = F.tid; i < 16 * (L / 8); i += NTHR) {
        const int b = i / (L / 8), ch = i % (L / 8);
        *(GAS u32x4*)(yht + ((size_t)(b * 384 + c)) * L + ch * 8) = *(const LAS u32x4*)(zimg0 + b * ZP + ch * 16);
    }
}

template <int L>
__device__ __forceinline__ void hyena_unit_fast(Frame& F, int layer, int c, const GAS bf16* hyt  , const GAS bf16* ft  , GAS bf16* yht  ) {
    constexpr int ZP = (L + 8) * 2;
    constexpr int PER = L / 32;
    constexpr int I = L / 128;
    constexpr int SPAN = L / 4, NSTEP = L / 32;
    LAS unsigned char* zimg0 = F.lds;
    LAS unsigned char* zimg1 = F.lds + 16 * ZP;
    LAS bf16* tf = (LAS bf16*)(F.lds + 32 * ZP);
    const GAS float* cw = inp(F, I_HYCONV) + layer * 3 * 1152;
    const GAS float* skip = inp(F, I_HYSKIP) + layer * 2 * 384;
    const int lane = F.lane, fr = lane & 15, fq = lane >> 4, w = F.wave;
    __syncthreads();
    {
        const int b = F.tid >> 5, sg = F.tid & 31, t0 = sg * PER; const GAS bf16* src = hyt + ((size_t)(b * 1152 + c)) * L + t0;
        const float w0 = cw[c], w1 = cw[1152 + c], w2 = cw[2304 + c];
        u32x4 raw[PER / 8];
#pragma unroll
        for (int j = 0; j < PER / 8; ++j) raw[j] = *(const GAS u32x4*)(src + 8 * j);
        float prev = t0 > 0 ? bf2f(src[-1]) : 0.f;
        const float nextv = t0 + PER < L ? bf2f(src[PER]) : 0.f;
#pragma unroll
        for (int j = 0; j < PER / 8; ++j) {
            const unsigned wv[4] = {raw[j].x, raw[j].y, raw[j].z, raw[j].w};
            float x[10]; x[0] = prev;
#pragma unroll
            for (int q = 0; q < 4; ++q) { x[1 + 2 * q] = __uint_as_float(wv[q] << 16); x[2 + 2 * q] = __uint_as_float(wv[q] & 0xffff0000u); }
            if (j + 1 < PER / 8) x[9] = __uint_as_float(raw[(j + 1 < PER / 8) ? j + 1 : j].x << 16); else x[9] = nextv;
            u32x4 o;
            o.x = pk2(w0 * x[0] + w1 * x[1] + w2 * x[2], w0 * x[1] + w1 * x[2] + w2 * x[3]); o.y = pk2(w0 * x[2] + w1 * x[3] + w2 * x[4], w0 * x[3] + w1 * x[4] + w2 * x[5]);
            o.z = pk2(w0 * x[4] + w1 * x[5] + w2 * x[6], w0 * x[5] + w1 * x[6] + w2 * x[7]); o.w = pk2(w0 * x[6] + w1 * x[7] + w2 * x[8], w0 * x[7] + w1 * x[8] + w2 * x[9]);
            *(LAS u32x4*)(zimg0 + b * ZP + (t0 + 8 * j) * 2) = o;
            prev = x[8];
        }
    }
    const int tbase = SPAN * (w >> 1) + 16 * (w & 1);
    const int flane = L - tbase + 8 * fq - fr;
#pragma unroll 1
    for (int o = 0; o < 2; ++o) {
        LAS unsigned char* zs = o == 0 ? zimg0 : zimg1;
        LAS unsigned char* zd = o == 0 ? zimg1 : zimg0;
        const GAS bf16* fsrc = ft + ((size_t)(o * 384 + c)) * (2 * L);
        for (int i = F.tid; i < 2 * L; i += NTHR) tf[i] = i == 0 ? (bf16)0 : fsrc[i];
        __syncthreads();
        f32x4 acc[I];
#pragma unroll
        for (int i = 0; i < I; ++i) acc[i] = (f32x4){0.f, 0.f, 0.f, 0.f};
        bf16x8 ring[I];
#pragma unroll
        for (int i = 1; i < I; ++i) __builtin_memcpy(&ring[(I - i) % I], (const LAS unsigned char*)tf + 2 * (flane - 32 * i), 16);
        const LAS unsigned char* zrow = zs + fr * ZP + 16 * fq;
#pragma unroll 1
        for (int j0 = 0; j0 < NSTEP; j0 += I) {
#pragma unroll
            for (int jj = 0; jj < I; ++jj) {
                const int j = j0 + jj;
                __builtin_memcpy(&ring[jj], (const LAS unsigned char*)tf + 2 * (flane + 32 * j), 16);
                const bf16x8 zf = *(const LAS bf16x8*)(zrow + 64 * j);
#pragma unroll
                for (int i = 0; i < I; ++i) acc[i] = __builtin_amdgcn_mfma_f32_16x16x32_bf16(ring[(jj - i + I) % I], zf, acc[i], 0, 0, 0);
            }
        }
        const int gcol = (o == 0 ? 384 : 768) + c;
        const GAS bf16* gsrc = hyt + ((size_t)(fr * 1152 + gcol)) * L;
        const float w0 = cw[gcol], w1 = cw[1152 + gcol], w2 = cw[2304 + gcol], sk = skip[o * 384 + c];
        GAS bf16* dst = yht + ((size_t)(fr * 384 + c)) * L;
        u32x2 grv[I]; unsigned short gmv[I], gpv[I];
#pragma unroll
        for (int i = 0; i < I; ++i) {
            const int t = tbase + 32 * i + 4 * fq;
            grv[i] = *(const GAS u32x2*)(gsrc + t); gmv[i] = t > 0 ? gsrc[t - 1] : (unsigned short)0; gpv[i] = t + 4 < L ? gsrc[t + 4] : (unsigned short)0;
        }
#pragma unroll
        for (int i = 0; i < I; ++i) {
            const int t = tbase + 32 * i + 4 * fq;
            const u32x2 zr = *(const LAS u32x2*)(zs + fr * ZP + t * 2);
            const u32x2 gr = grv[i];
            const float gm = bf2f(gmv[i]), gp = bf2f(gpv[i]);
            const float g0 = __uint_as_float(gr.x << 16), g1 = __uint_as_float(gr.x & 0xffff0000u), g2 = __uint_as_float(gr.y << 16), g3 = __uint_as_float(gr.y & 0xffff0000u);
            const float z0 = __uint_as_float(zr.x << 16), z1 = __uint_as_float(zr.x & 0xffff0000u), z2 = __uint_as_float(zr.y << 16), z3 = __uint_as_float(zr.y & 0xffff0000u);
            const float o0 = (w0 * gm + w1 * g0 + w2 * g1) * (acc[i].x + sk * z0), o1 = (w0 * g0 + w1 * g1 + w2 * g2) * (acc[i].y + sk * z1);
            const float o2 = (w0 * g1 + w1 * g2 + w2 * g3) * (acc[i].z + sk * z2), o3 = (w0 * g2 + w1 * g3 + w2 * gp) * (acc[i].w + sk * z3);
            u32x2 ov; ov.x = pk2(o0, o1); ov.y = pk2(o2, o3);
            if (o == 0) *(LAS u32x2*)(zd + fr * ZP + t * 2) = ov;
            else *(GAS u32x2*)(dst + t) = ov;
        }
        __syncthreads();
    }
}

__device__ __forceinline__ void chain_naive(Frame& F, int layer, int chain) {
    const int lane = F.lane;
    const bool is_ret = chain < 192;
    int b, h, dir;
    if (is_ret) { b = chain / 12; const int r = chain % 12; h = r >> 1; dir = r & 1; }
    else { const int i = chain - 192; b = i >> 3; h = (i & 7) >> 1; dir = i & 1; }
    const GAS bf16* RET = WSP(const bf16, WS_RET); const GAS bf16* ML = WSP(const bf16, WS_ML); const GAS float* MLG = WSP(const float, WS_MLG);
    const GAS float* rope = WSP(const float, WS_ROPE);
    GAS bf16* Y = WSP(bf16, WS_Y); GAS bf16* OB = WSP(bf16, WS_OB);
    float gam = 0.f;
    if (is_ret) gam = sigmoidf_(inp(F, I_RETDECAY)[layer * 12 + dir * 6 + h]);
    const GAS float* mlc = inp(F, I_MLCONV) + layer * 3 * 512;
    const float bi = is_ret ? 0.f : inp(F, I_MLGB)[layer * 16 + dir * 8 + h], bfg = is_ret ? 0.f : inp(F, I_MLGB)[layer * 16 + dir * 8 + 4 + h];
    const float qw0 = mlc[h * 64 + lane], qw1 = mlc[512 + h * 64 + lane], qw2 = mlc[1024 + h * 64 + lane];
    const float kw0 = mlc[256 + h * 64 + lane], kw1 = mlc[512 + 256 + h * 64 + lane], kw2 = mlc[1024 + 256 + h * 64 + lane];
    float S[64];
#pragma unroll
    for (int d = 0; d < 64; ++d) S[d] = 0.f;
    float nv = 0.f;
    for (int step = 0; step < LC + LL; ++step) {
        int row, tpos, L; bool lat;
        if (step < LC) { tpos = dir ? (LC - 1 - step) : step; row = TOKL + b * LC + tpos; L = LC; lat = false; }
        else { const int s2 = step - LC; tpos = dir ? (LL - 1 - s2) : s2; row = b * LL + tpos; L = LL; lat = true; }
        float q, k, v, Fm, Im;
        if (is_ret) {
            const GAS bf16* base = RET + (size_t)row * 1536;
            float qs = bf2f(base[h * 64 + lane]), ks = bf2f(base[384 + h * 64 + lane]);
            v = bf2f(base[768 + h * 64 + lane]);
            if (lat) {
                const float qp = bf2f(base[h * 64 + (lane ^ 16)]), kp = bf2f(base[384 + h * 64 + (lane ^ 16)]);
                const int half = lane >> 5, ii = lane & 15, hi = (lane >> 4) & 1;
                const float cs = rope[tpos * 64 + half * 32 + ii], sn = rope[tpos * 64 + half * 32 + 16 + ii];
                q = hi == 0 ? qs * cs - qp * sn : qp * sn + qs * cs;
                k = hi == 0 ? ks * cs - kp * sn : kp * sn + ks * cs;
            } else { q = qs; k = ks; }
            q *= 0.125f; Fm = gam; Im = 1.f;
        } else {
            const GAS bf16* base = ML + (size_t)row * 1024;
            const float q0 = tpos > 0 ? bf2f(base[-1024 + h * 64 + lane]) : 0.f, q1 = bf2f(base[h * 64 + lane]), q2 = tpos < L - 1 ? bf2f(base[1024 + h * 64 + lane]) : 0.f;
            const float k0 = tpos > 0 ? bf2f(base[-1024 + 256 + h * 64 + lane]) : 0.f, k1 = bf2f(base[256 + h * 64 + lane]), k2 = tpos < L - 1 ? bf2f(base[1024 + 256 + h * 64 + lane]) : 0.f;
            q = siluf_(qw0 * q0 + qw1 * q1 + qw2 * q2);
            k = siluf_(kw0 * k0 + kw1 * k1 + kw2 * k2) * 0.125f;
            v = bf2f(base[512 + h * 64 + lane]);
            const float ig = MLG[(size_t)row * 16 + dir * 8 + h] + bi, fg = MLG[(size_t)row * 16 + dir * 8 + 4 + h] + bfg;
            Fm = sigmoidf_(fg); Im = __expf(ig);
        }
        float num = 0.f;
        const float iv = Im * v;
#pragma unroll
        for (int d = 0; d < 64; ++d) {
            const float kd = __int_as_float(__builtin_amdgcn_readlane(__float_as_int(k), d));
            const float qd = __int_as_float(__builtin_amdgcn_readlane(__float_as_int(q), d));
            S[d] = Fm * S[d] + kd * iv;
            num += qd * S[d];
        }
        float o = num;
        if (!is_ret) { nv = Fm * nv + Im * k; const float den = wave_sum(q * nv); o = num / fmaxf(fabsf(den), 1.f); }
        const int cof = is_ret ? (h * 64 + lane) : (384 + h * 64 + lane);
        if (dir == 0) Y[(size_t)row * D + 384 + cof] = (bf16)f2bf(o);
        else OB[(size_t)row * 640 + cof] = (bf16)f2bf(o);
    }
}

constexpr int CH_PITCH = 144;
constexpr int CH_IMG = 64 * CH_PITCH;
constexpr int CH_WAVE_LDS = 3 * CH_IMG + 1024 + 512;
__device__ __forceinline__ void ds_tr16x8(unsigned addr, u32x2 (&lo)[4], u32x2 (&hi)[4]) {
    asm volatile("ds_read_b64_tr_b16 %0, %8\n\tds_read_b64_tr_b16 %1, %8 offset:32\n\tds_read_b64_tr_b16 %2, %8 offset:64\n\tds_read_b64_tr_b16 %3, %8 offset:96\n\t"
                 "ds_read_b64_tr_b16 %4, %8 offset:2304\n\tds_read_b64_tr_b16 %5, %8 offset:2336\n\tds_read_b64_tr_b16 %6, %8 offset:2368\n\tds_read_b64_tr_b16 %7, %8 offset:2400\n\t"
                 "s_waitcnt lgkmcnt(0)"
                 : "=&v"(lo[0]), "=&v"(lo[1]), "=&v"(lo[2]), "=&v"(lo[3]), "=&v"(hi[0]), "=&v"(hi[1]), "=&v"(hi[2]), "=&v"(hi[3]) : "v"(addr) : "memory");
}
static_assert(16 * CH_PITCH == 2304, "ds_tr16x8 offsets");
__device__ __forceinline__ void ds_tr16x4(unsigned addr, u32x2 (&lo)[2], u32x2 (&hi)[2]) {
    asm volatile("ds_read_b64_tr_b16 %0, %4\n\tds_read_b64_tr_b16 %1, %4 offset:32\n\tds_read_b64_tr_b16 %2, %4 offset:2304\n\tds_read_b64_tr_b16 %3, %4 offset:2336\n\ts_waitcnt lgkmcnt(0)"
                 : "=&v"(lo[0]), "=&v"(lo[1]), "=&v"(hi[0]), "=&v"(hi[1]) : "v"(addr) : "memory");
}
__device__ __forceinline__ float log_sigmoid_(float x) { return fminf(x, 0.f) - log1pf(__expf(-fabsf(x))); }
__device__ __forceinline__ bf16x8 mk_frag(u32x2 lo, u32x2 hi) { u32x4 w; w.x = lo.x; w.y = lo.y; w.z = hi.x; w.w = hi.y; return __builtin_bit_cast(bf16x8, w); }

template <bool IS_ML>
__device__ __forceinline__ void chain_fast(Frame& F, int layer, int b, int h, int dir, LAS unsigned char* img, int hf) {
    constexpr int NET = 2;
    const int lane = F.lane, fr = lane & 15, fq = lane >> 4;
    LAS unsigned char* Qi = img; LAS unsigned char* Ki = img + CH_IMG; LAS unsigned char* Vi = img + 2 * CH_IMG;
    const unsigned qa = (unsigned)(size_t)Qi, ka = (unsigned)(size_t)Ki, va = (unsigned)(size_t)Vi;
    const GAS bf16* RET = WSP(const bf16, WS_RET); const GAS bf16* ML = WSP(const bf16, WS_ML); const GAS float* MLG = WSP(const float, WS_MLG);
    const GAS float* rope = WSP(const float, WS_ROPE);
    GAS bf16* Y = WSP(bf16, WS_Y); GAS bf16* OB = WSP(bf16, WS_OB);
    float lgam = 0.f, bi_ = 0.f, bf_ = 0.f;
    if (!IS_ML) lgam = log_sigmoid_(inp(F, I_RETDECAY)[layer * 12 + dir * 6 + h]);
    else { bi_ = inp(F, I_MLGB)[layer * 16 + dir * 8 + h]; bf_ = inp(F, I_MLGB)[layer * 16 + dir * 8 + 4 + h]; }
    const GAS float* mlc = inp(F, I_MLCONV) + layer * 3 * 512;
    f32x4 C[4][NET];
#pragma unroll
    for (int dt = 0; dt < 4; ++dt)
#pragma unroll
        for (int et = 0; et < NET; ++et) C[dt][et] = (f32x4){0.f, 0.f, 0.f, 0.f};
    const int cq = lane & 7, pr0 = lane >> 3;
    LAS float* nvec = (LAS float*)(img + 3 * CH_IMG + 1024 + 256 * hf);
    if (IS_ML) nvec[lane] = 0.f;
    const LAS float* nq = nvec + 4 * fq;
#ifndef REP_CH
#define REP_CH 1
#endif
#pragma unroll 1
    for (int step_ = 0; step_ < 36 * REP_CH; ++step_) {
        const int step = step_ % 36;
        if (REP_CH > 1 && step == 0) {
            if (IS_ML) nvec[lane] = 0.f;
#pragma unroll
            for (int dt = 0; dt < 4; ++dt)
#pragma unroll
                for (int et = 0; et < NET; ++et) C[dt][et] = (f32x4){0.f, 0.f, 0.f, 0.f};
        }
        int rowbase, t0, L; bool lat;
        if (step < 4) { const int cc = dir ? 3 - step : step; rowbase = TOKL + b * LC + cc * 64; t0 = cc * 64; L = LC; lat = false; }
        else { const int cc = dir ? 35 - step : step - 4; rowbase = b * LL + cc * 64; t0 = cc * 64; L = LL; lat = true; }
        if constexpr (!IS_ML) {
#pragma unroll
        for (int i4 = 0; i4 < 4; ++i4) {
            const int i = 4 * hf + i4;
            const int p = pr0 + 8 * i, tl = dir ? 63 - p : p, row = rowbase + tl, tpos = t0 + tl;
            float qv[8], kv[8]; u32x4 vraw;
            {
                const GAS bf16* base = RET + (size_t)row * 1536 + h * 64;
                const u32x4 qr = *(const GAS u32x4*)(base + 8 * cq), kr = *(const GAS u32x4*)(base + 384 + 8 * cq); vraw = *(const GAS u32x4*)(base + 768 + 8 * cq);
                const unsigned qw[4] = {qr.x, qr.y, qr.z, qr.w}, kw[4] = {kr.x, kr.y, kr.z, kr.w};
#pragma unroll
                for (int j = 0; j < 4; ++j) { qv[2 * j] = __uint_as_float(qw[j] << 16); qv[2 * j + 1] = __uint_as_float(qw[j] & 0xffff0000u); kv[2 * j] = __uint_as_float(kw[j] << 16); kv[2 * j + 1] = __uint_as_float(kw[j] & 0xffff0000u); }
                if (lat) {
                    const u32x4 qpr = *(const GAS u32x4*)(base + 8 * (cq ^ 2)), kpr = *(const GAS u32x4*)(base + 384 + 8 * (cq ^ 2));
                    const unsigned qpw[4] = {qpr.x, qpr.y, qpr.z, qpr.w}, kpw[4] = {kpr.x, kpr.y, kpr.z, kpr.w};
                    const int half = cq >> 2, hi = (cq >> 1) & 1, i0 = 8 * (cq & 1);
                    const GAS float* rp = rope + tpos * 64 + half * 32 + i0;
                    const f32x4 c0 = *(const GAS f32x4*)(rp), c1 = *(const GAS f32x4*)(rp + 4), s0 = *(const GAS f32x4*)(rp + 16), s1 = *(const GAS f32x4*)(rp + 20);
                    const float cs[8] = {c0.x, c0.y, c0.z, c0.w, c1.x, c1.y, c1.z, c1.w}, sn[8] = {s0.x, s0.y, s0.z, s0.w, s1.x, s1.y, s1.z, s1.w};
#pragma unroll
                    for (int j = 0; j < 8; ++j) {
                        const float qp = (j & 1) ? __uint_as_float(qpw[j >> 1] & 0xffff0000u) : __uint_as_float(qpw[j >> 1] << 16);
                        const float kp = (j & 1) ? __uint_as_float(kpw[j >> 1] & 0xffff0000u) : __uint_as_float(kpw[j >> 1] << 16);
                        qv[j] = hi ? qp * sn[j] + qv[j] * cs[j] : qv[j] * cs[j] - qp * sn[j];
                        kv[j] = hi ? kp * sn[j] + kv[j] * cs[j] : kv[j] * cs[j] - kp * sn[j];
                    }
                }
#pragma unroll
                for (int j = 0; j < 8; ++j) qv[j] *= 0.125f;
            }
            u32x4 qo, ko; qo.x = pk2(qv[0], qv[1]); qo.y = pk2(qv[2], qv[3]); qo.z = pk2(qv[4], qv[5]); qo.w = pk2(qv[6], qv[7]);
            ko.x = pk2(kv[0], kv[1]); ko.y = pk2(kv[2], kv[3]); ko.z = pk2(kv[4], kv[5]); ko.w = pk2(kv[6], kv[7]);
            *(LAS u32x4*)(Qi + p * CH_PITCH + 16 * cq) = qo; *(LAS u32x4*)(Ki + p * CH_PITCH + 16 * cq) = ko; *(LAS u32x4*)(Vi + p * CH_PITCH + 16 * cq) = vraw;
        }
        } else {
            const GAS float* wq = mlc + h * 64 + 8 * cq;
#pragma unroll
            for (int qk = 0; qk < 2; ++qk) {
                u32x4 r0[4], r1[4], r2[4], vr[4];
                f32x4 wt[3][2];
#pragma unroll
                for (int tp = 0; tp < 3; ++tp) { wt[tp][0] = *(const GAS f32x4*)(wq + 256 * qk + 512 * tp); wt[tp][1] = *(const GAS f32x4*)(wq + 256 * qk + 512 * tp + 4); }
#pragma unroll
                for (int i4 = 0; i4 < 4; ++i4) {
                    const int p = pr0 + 8 * (4 * hf + i4), tl = dir ? 63 - p : p, row = rowbase + tl, tpos = t0 + tl;
                    const GAS bf16* bb = ML + (size_t)row * 1024 + h * 64 + 8 * cq + 256 * qk;
                    const u32x4 z4 = (u32x4){0u, 0u, 0u, 0u};
                    r1[i4] = *(const GAS u32x4*)(bb); r0[i4] = tpos > 0 ? *(const GAS u32x4*)(bb - 1024) : z4; r2[i4] = tpos < L - 1 ? *(const GAS u32x4*)(bb + 1024) : z4;
                    if (qk == 1) vr[i4] = *(const GAS u32x4*)(bb + 256);
                }
#pragma unroll
                for (int i4 = 0; i4 < 4; ++i4) {
                    const int p = pr0 + 8 * (4 * hf + i4);
                    const unsigned a0[4] = {r0[i4].x, r0[i4].y, r0[i4].z, r0[i4].w}, a1[4] = {r1[i4].x, r1[i4].y, r1[i4].z, r1[i4].w}, a2[4] = {r2[i4].x, r2[i4].y, r2[i4].z, r2[i4].w};
                    float ov[8];
#pragma unroll
                    for (int j = 0; j < 8; ++j) {
                        const float x0 = (j & 1) ? __uint_as_float(a0[j >> 1] & 0xffff0000u) : __uint_as_float(a0[j >> 1] << 16);
                        const float x1 = (j & 1) ? __uint_as_float(a1[j >> 1] & 0xffff0000u) : __uint_as_float(a1[j >> 1] << 16);
                        const float x2 = (j & 1) ? __uint_as_float(a2[j >> 1] & 0xffff0000u) : __uint_as_float(a2[j >> 1] << 16);
                        const float r = siluf_(wt[0][j >> 2][j & 3] * x0 + wt[1][j >> 2][j & 3] * x1 + wt[2][j >> 2][j & 3] * x2);
                        ov[j] = qk == 0 ? r : r * 0.125f;
                    }
                    u32x4 o; o.x = pk2(ov[0], ov[1]); o.y = pk2(ov[2], ov[3]); o.z = pk2(ov[4], ov[5]); o.w = pk2(ov[6], ov[7]);
                    if (qk == 0) *(LAS u32x4*)(Qi + p * CH_PITCH + 16 * cq) = o;
                    else { *(LAS u32x4*)(Ki + p * CH_PITCH + 16 * cq) = o; *(LAS u32x4*)(Vi + p * CH_PITCH + 16 * cq) = vr[i4]; }
                }
                asm volatile("" ::: "memory");
            }
        }
        __builtin_amdgcn_sched_barrier(0);
        float f_p, i_p;
        { const int tl = dir ? 63 - lane : lane, row = rowbase + tl;
          if (!IS_ML) { f_p = lgam; i_p = 0.f; }
          else { i_p = MLG[(size_t)row * 16 + dir * 8 + h] + bi_; f_p = log_sigmoid_(MLG[(size_t)row * 16 + dir * 8 + 4 + h] + bf_); } }
        float bsum = f_p;
#pragma unroll
        for (int o = 1; o < 64; o <<= 1) { const float t = __shfl_up(bsum, o); if (lane >= o) bsum += t; }
        LAS float* gv = (LAS float*)(img + 3 * CH_IMG);
        const float b63 = __shfl(bsum, 63);
        const float adec = __expf(b63);
        if (hf == 0) { gv[lane] = bsum; gv[64 + lane] = bsum - i_p; gv[128 + lane] = __expf(bsum); gv[192 + lane] = __expf(b63 - (bsum - i_p)); }
        asm volatile("s_waitcnt lgkmcnt(0)" ::: "memory");
        __syncthreads();
        const LAS float* gq = gv + 4 * fq;
        const bf16x8 ones = (fr == 0) ? (bf16x8){0x3F80, 0x3F80, 0x3F80, 0x3F80, 0x3F80, 0x3F80, 0x3F80, 0x3F80} : (bf16x8){0, 0, 0, 0, 0, 0, 0, 0};
        const int tr_q = fr >> 2, tr_p = fr & 3;
#pragma unroll 1
        for (int pt = 0; pt < 4; ++pt) {
            f32x4 ST[4];
            bf16x8 qn[2];
#pragma unroll
            for (int kk = 0; kk < 2; ++kk) qn[kk] = *(const LAS bf16x8*)(Qi + (16 * pt + fr) * CH_PITCH + (32 * kk + 8 * fq) * 2);
#pragma unroll
            for (int st = 0; st < 4; ++st) {
                ST[st] = (f32x4){0.f, 0.f, 0.f, 0.f};
                if (st <= pt) {
#pragma unroll
                    for (int kk = 0; kk < 2; ++kk) { const bf16x8 kf = *(const LAS bf16x8*)(Ki + (16 * st + fr) * CH_PITCH + (32 * kk + 8 * fq) * 2); ST[st] = __builtin_amdgcn_mfma_f32_16x16x32_bf16(kf, qn[kk], ST[st], 0, 0, 0); }
                }
            }
            const float bp = gv[16 * pt + fr];
#pragma unroll
            for (int st = 0; st < 4; ++st) {
                if (st <= pt) {
                    const f32x4 bis = *(const LAS f32x4*)(gq + 64 + 16 * st);
#pragma unroll
                    for (int j = 0; j < 4; ++j) { const int sidx = 16 * st + 4 * fq + j; const float w = (sidx <= 16 * pt + fr) ? __expf(bp - bis[j]) : 0.f; ST[st][j] *= w; }
                }
            }
            __builtin_amdgcn_sched_barrier(0);
            f32x4 acc[NET], accd = (f32x4){0.f, 0.f, 0.f, 0.f};
#pragma unroll
            for (int et = 0; et < NET; ++et) acc[et] = (f32x4){0.f, 0.f, 0.f, 0.f};
#pragma unroll
            for (int kk = 0; kk < 2; ++kk) {
                const u32x2 lo = *(const LAS u32x2*)(Qi + (16 * pt + fr) * CH_PITCH + (32 * kk + 4 * fq) * 2), hi = *(const LAS u32x2*)(Qi + (16 * pt + fr) * CH_PITCH + (32 * kk + 16 + 4 * fq) * 2);
                const bf16x8 qs = mk_frag(lo, hi);
#pragma unroll
                for (int et = 0; et < NET; ++et) {
                    u32x4 w; w.x = pk2(C[2 * kk][et].x, C[2 * kk][et].y); w.y = pk2(C[2 * kk][et].z, C[2 * kk][et].w); w.z = pk2(C[2 * kk + 1][et].x, C[2 * kk + 1][et].y); w.w = pk2(C[2 * kk + 1][et].z, C[2 * kk + 1][et].w);
                    acc[et] = __builtin_amdgcn_mfma_f32_16x16x32_bf16(qs, __builtin_bit_cast(bf16x8, w), acc[et], 0, 0, 0);
                }
                if (IS_ML) {
                    const f32x4 n0 = *(const LAS f32x4*)(nq + 32 * kk), n1 = *(const LAS f32x4*)(nq + 32 * kk + 16);
                    u32x4 w; w.x = pk2(n0.x, n0.y); w.y = pk2(n0.z, n0.w); w.z = pk2(n1.x, n1.y); w.w = pk2(n1.z, n1.w);
                    if (fr != 0) w = (u32x4){0u, 0u, 0u, 0u};
                    accd = __builtin_amdgcn_mfma_f32_16x16x32_bf16(qs, __builtin_bit_cast(bf16x8, w), accd, 0, 0, 0);
                }
            }
            { const f32x4 ap = *(const LAS f32x4*)(gq + 128 + 16 * pt);
#pragma unroll
              for (int j = 0; j < 4; ++j) {
#pragma unroll
                for (int et = 0; et < NET; ++et) acc[et][j] *= ap[j];
                accd[j] *= ap[j]; } }
            __builtin_amdgcn_sched_barrier(0);
#pragma unroll
            for (int kk = 0; kk < 2; ++kk) {
                if (2 * kk <= pt) {
                    u32x4 w; w.x = pk2(ST[2 * kk].x, ST[2 * kk].y); w.y = pk2(ST[2 * kk].z, ST[2 * kk].w); w.z = pk2(ST[2 * kk + 1].x, ST[2 * kk + 1].y); w.w = pk2(ST[2 * kk + 1].z, ST[2 * kk + 1].w);
                    const bf16x8 pf = __builtin_bit_cast(bf16x8, w);
                    u32x2 vlo[2], vhi[2];
                    ds_tr16x4(va + (32 * kk + 4 * fq + tr_q) * CH_PITCH + 8 * tr_p + 64 * hf, vlo, vhi);
#pragma unroll
                    for (int et = 0; et < NET; ++et) acc[et] = __builtin_amdgcn_mfma_f32_16x16x32_bf16(pf, mk_frag(vlo[et], vhi[et]), acc[et], 0, 0, 0);
                    if (IS_ML) accd = __builtin_amdgcn_mfma_f32_16x16x32_bf16(pf, ones, accd, 0, 0, 0);
                }
            }
            __builtin_amdgcn_sched_barrier(0);
#pragma unroll
            for (int j = 0; j < 4; ++j) {
                const int p = 16 * pt + 4 * fq + j, tl = dir ? 63 - p : p, row = rowbase + tl;
                float inv = 1.f;
                if (IS_ML) { const float den = __shfl(accd[j], lane & 48); inv = 1.f / fmaxf(fabsf(den), 1.f); }
#pragma unroll
                for (int et = 0; et < NET; ++et) {
                    const float o = acc[et][j] * inv;
                    const int cof = (IS_ML ? 384 : 0) + h * 64 + 32 * hf + 16 * et + fr;
                    if (dir == 0) Y[(size_t)row * D + 384 + cof] = (bf16)f2bf(o); else OB[(size_t)row * 640 + cof] = (bf16)f2bf(o);
                }
            }
        }
        __builtin_amdgcn_sched_barrier(0);
#pragma unroll
        for (int dt = 0; dt < 4; ++dt)
#pragma unroll
            for (int et = 0; et < NET; ++et) C[dt][et] *= adec;
        f32x4 accn[4];
        if (IS_ML) {
#pragma unroll
            for (int dt = 0; dt < 4; ++dt) { accn[dt] = *(const LAS f32x4*)(nq + 16 * dt) * adec; if (fr != 0) accn[dt] = (f32x4){0.f, 0.f, 0.f, 0.f}; }
        }
#pragma unroll
        for (int kk = 0; kk < 2; ++kk) {
            u32x2 vlo[2], vhi[2], klo[4], khi[4];
            ds_tr16x4(va + (32 * kk + 4 * fq + tr_q) * CH_PITCH + 8 * tr_p + 64 * hf, vlo, vhi);
            ds_tr16x8(ka + (32 * kk + 4 * fq + tr_q) * CH_PITCH + 8 * tr_p, klo, khi);
            const f32x4 wl = *(const LAS f32x4*)(gq + 192 + 32 * kk), wh = *(const LAS f32x4*)(gq + 192 + 32 * kk + 16);
#pragma unroll
            for (int dt = 0; dt < 4; ++dt) {
                u32x4 w;
                w.x = pk2(__uint_as_float(klo[dt].x << 16) * wl[0], __uint_as_float(klo[dt].x & 0xffff0000u) * wl[1]);
                w.y = pk2(__uint_as_float(klo[dt].y << 16) * wl[2], __uint_as_float(klo[dt].y & 0xffff0000u) * wl[3]);
                w.z = pk2(__uint_as_float(khi[dt].x << 16) * wh[0], __uint_as_float(khi[dt].x & 0xffff0000u) * wh[1]);
                w.w = pk2(__uint_as_float(khi[dt].y << 16) * wh[2], __uint_as_float(khi[dt].y & 0xffff0000u) * wh[3]);
                const bf16x8 kf = __builtin_bit_cast(bf16x8, w);
#pragma unroll
                for (int et = 0; et < NET; ++et) C[dt][et] = __builtin_amdgcn_mfma_f32_16x16x32_bf16(kf, mk_frag(vlo[et], vhi[et]), C[dt][et], 0, 0, 0);
                if (IS_ML) accn[dt] = __builtin_amdgcn_mfma_f32_16x16x32_bf16(kf, ones, accn[dt], 0, 0, 0);
            }
        }
        if (IS_ML) { if (fr == 0) {
#pragma unroll
            for (int dt = 0; dt < 4; ++dt) *(LAS f32x4*)(nvec + 4 * fq + 16 * dt) = accn[dt]; } }
        asm volatile("s_waitcnt lgkmcnt(0)" ::: "memory");
        __syncthreads();
    }
}

#ifndef FAST_CHAIN
#define FAST_CHAIN 1
#endif
constexpr int NCHWG = 80;
__device__ __forceinline__ void phase_mix(Frame& F, int layer) {
    const bool last = layer == 1;
    const GAS bf16* ftl = WSP(const bf16, WS_FTL) + (size_t)layer * 2 * 384 * 4096;
    if (FAST_CHAIN) {
        if (F.wg < NCHWG) {
            {
                const int cl = F.wave >> 1, hf = F.wave & 1, c = F.wg * 4 + cl;
                LAS unsigned char* img = F.lds + cl * CH_WAVE_LDS;
                {
                if (c < 192) { const int b = c / 12, r = c % 12; chain_fast<false>(F, layer, b, r >> 1, r & 1, img, hf); }
                else { const int i = c - 192; chain_fast<true>(F, layer, i >> 3, (i & 7) >> 1, i & 1, img, hf); }
                }
            }
        } else {
            const int nh = F.G - NCHWG, w = F.wg - NCHWG;
#ifndef FAST_HY
#define FAST_HY 1
#endif
            if (FAST_HY) {
#ifndef REP_HY
#define REP_HY 1
#endif
#pragma unroll 1
                for (int rp = 0; rp < REP_HY; ++rp)
                for (int u = w; u < 384; u += nh) hyena_unit_fast<LL>(F, layer, u, WSP(const bf16, WS_HYTL), ftl, WSP(bf16, WS_YHTL));
                if (!last) for (int u = w; u < 384; u += nh) hyena_unit_fast<LC>(F, layer, u, WSP(const bf16, WS_HYTC), WSP(const bf16, WS_FTC), WSP(bf16, WS_YHTC));
            } else {
                for (int u = w; u < 384; u += nh) hyena_unit_naive<LL>(F, layer, u, WSP(const bf16, WS_HYTL), ftl, WSP(bf16, WS_YHTL));
                if (!last) for (int u = w; u < 384; u += nh) hyena_unit_naive<LC>(F, layer, u, WSP(const bf16, WS_HYTC), WSP(const bf16, WS_FTC), WSP(bf16, WS_YHTC));
            }
        }
    } else {
        for (int u = F.wg; u < 384; u += F.G) hyena_unit_naive<LL>(F, layer, u, WSP(const bf16, WS_HYTL), ftl, WSP(bf16, WS_YHTL));
        if (!last) for (int u = F.wg; u < 384; u += F.G) hyena_unit_naive<LC>(F, layer, u, WSP(const bf16, WS_HYTC), WSP(const bf16, WS_FTC), WSP(bf16, WS_YHTC));
        for (int c = F.wg + F.wave * F.G; c < 320; c += F.G * NWAVES) chain_naive(F, layer, c);
    }
}

__device__ __forceinline__ void phase_combine(Frame& F, int layer) {
    const bool last = layer == 1;
    const int gw = F.wg * NWAVES + F.wave, NGW = F.G * NWAVES, lane = F.lane;
    const int nrows = last ? TOKL : TOK;
    GAS bf16* Y = WSP(bf16, WS_Y); const GAS bf16* OB = WSP(const bf16, WS_OB); const GAS bf16* RET = WSP(const bf16, WS_RET); const GAS bf16* ML = WSP(const bf16, WS_ML);
    for (int row = gw; row < nrows; row += NGW) {
#pragma unroll
        for (int hh = 0; hh < 10; ++hh) {
            const int cof = hh * 64 + lane;
            const float x = bf2f(Y[(size_t)row * D + 384 + cof]) + bf2f(OB[(size_t)row * 640 + cof]);
            const float mu = wave_sum(x) * (1.f / 64.f), xc = x - mu;
            const float var = wave_sum(xc * xc) * (1.f / 64.f);
            const float nrm = xc * rsqrtf(var + 1e-6f);
            float gate;
            if (hh < 6) gate = siluf_(bf2f(RET[(size_t)row * 1536 + 1152 + cof]));
            else gate = sigmoidf_(bf2f(ML[(size_t)row * 1024 + 768 + (cof - 384)]));
            Y[(size_t)row * D + 384 + cof] = (bf16)f2bf(nrm * gate);
        }
    }
    LAS float* scr = (LAS float*)(F.lds + F.wave * 16640);
    const int nitL = NB * 6 * 32, nitC = last ? 0 : NB * 6 * 4;
    for (int it = gw; it < nitL + nitC; it += NGW) {
        const GAS bf16* src; int L, rowbase, b, cb, tb;
        if (it < nitL) { b = it / 192; const int r = it % 192; cb = r / 32; tb = r % 32; L = LL; src = WSP(const bf16, WS_YHTL); rowbase = b * LL; }
        else { const int i2 = it - nitL; b = i2 / 24; const int r = i2 % 24; cb = r / 4; tb = r % 4; L = LC; src = WSP(const bf16, WS_YHTC); rowbase = TOKL + b * LC; }
        for (int cc = 0; cc < 64; ++cc) scr[cc * 65 + lane] = bf2f(src[((size_t)(b * 384 + cb * 64 + cc)) * L + tb * 64 + lane]);
        asm volatile("s_waitcnt lgkmcnt(0)" ::: "memory");
        for (int tt = 0; tt < 64; ++tt) Y[(size_t)(rowbase + tb * 64 + tt) * D + cb * 64 + lane] = (bf16)f2bf(scr[lane * 65 + tt]);
        asm volatile("s_waitcnt lgkmcnt(0)" ::: "memory");
    }
}

__device__ __forceinline__ void phase_norm_router(Frame& F) {
    const int gw = F.wg * NWAVES + F.wave, NGW = F.G * NWAVES, lane = F.lane;
    const GAS float* g = inp(F, I_GFFN) + 1 * D; const GAS float* wr = inp(F, I_ROUTER); const GAS float* br = inp(F, I_ROUTERB);
    GAS unsigned* cnt = WSP(unsigned, WS_CTL) + CW_CNT;
    for (int row = gw; row < TOKL; row += NGW) {
        float keep[16];
        norm_mod_row(xrow_ptr(F, row, false), g, mod_ptr(F, 1, row, 3), mod_ptr(F, 1, row, 4), WSP(bf16, WS_H) + (size_t)row * D, lane, keep);
        float lg[8];
#pragma unroll
        for (int e = 0; e < 8; ++e) lg[e] = 0.f;
#pragma unroll
        for (int j = 0; j < 4; ++j)
#pragma unroll
            for (int i = 0; i < 4; ++i) { const int k = 256 * j + 4 * lane + i; const f32x4 w0 = *(const GAS f32x4*)(wr + k * 8), w1 = *(const GAS f32x4*)(wr + k * 8 + 4); const float x = keep[4 * j + i];
                lg[0] += x * w0.x; lg[1] += x * w0.y; lg[2] += x * w0.z; lg[3] += x * w0.w; lg[4] += x * w1.x; lg[5] += x * w1.y; lg[6] += x * w1.z; lg[7] += x * w1.w; }
#pragma unroll
        for (int e = 0; e < 8; ++e) lg[e] = wave_sum(lg[e]) + br[e];
        int e0 = 0; float v0 = lg[0];
#pragma unroll
        for (int e = 1; e < 8; ++e) if (lg[e] > v0) { v0 = lg[e]; e0 = e; }
        int e1 = -1; float v1 = -3.0e38f;
#pragma unroll
        for (int e = 0; e < 8; ++e) if (e != e0 && lg[e] > v1) { v1 = lg[e]; e1 = e; }
        const float w1 = 1.f / (1.f + __expf(v0 - v1)), w0 = 1.f - w1;
        if (lane == 0) {
            const unsigned p0 = __hip_atomic_fetch_add(cnt + e0, 1u, __ATOMIC_RELAXED, __HIP_MEMORY_SCOPE_AGENT), p1 = __hip_atomic_fetch_add(cnt + e1, 1u, __ATOMIC_RELAXED, __HIP_MEMORY_SCOPE_AGENT);
            WSP(int, WS_TOPE)[row * 2] = e0; WSP(int, WS_TOPE)[row * 2 + 1] = e1;
            WSP(float, WS_TOPW)[row * 2] = w0; WSP(float, WS_TOPW)[row * 2 + 1] = w1;
            WSP(int, WS_TOPP)[row * 2] = (int)p0; WSP(int, WS_TOPP)[row * 2 + 1] = (int)p1;
        }
    }
}
__device__ __forceinline__ void phase_route_tables(Frame& F) {
    const GAS unsigned* cnt = WSP(const unsigned, WS_CTL) + CW_CNT;
    int off[9]; off[0] = 0;
#pragma unroll
    for (int e = 0; e < 8; ++e) { const int c = (int)__hip_atomic_load(cnt + e, __ATOMIC_RELAXED, __HIP_MEMORY_SCOPE_AGENT); off[e + 1] = off[e] + ((c + 255) >> 8) * 256; }
    const int gt = F.wg * NTHR + F.tid, NGT = F.G * NTHR;
    GAS int* rowidx = WSP(int, WS_ROWIDX); GAS int* slot = WSP(int, WS_SLOT); GAS int* tilee = WSP(int, WS_TILEE);
    for (int i = gt; i < MAXTILES * 256; i += NGT) {
        int e = 0;
#pragma unroll
        for (int q = 1; q < 8; ++q) if (i >= off[q]) e = q;
        const int c = (int)cnt[e];
        if (i >= off[8] || i - off[e] >= c) rowidx[i] = 0;
    }
    for (int i = gt; i < TOKL * 2; i += NGT) {
        const int e = WSP(const int, WS_TOPE)[i], pos = WSP(const int, WS_TOPP)[i];
        int o = 0;
#pragma unroll
        for (int q = 0; q < 8; ++q) if (e == q) o = off[q];
        const int s = o + pos; slot[i] = s; rowidx[s] = i >> 1;
    }
    for (int i = gt; i < MAXTILES + 1; i += NGT) {
        if (i == MAXTILES) tilee[MAXTILES] = off[8] >> 8;
        else { int e = 0;
#pragma unroll
            for (int q = 1; q < 8; ++q) if (i * 256 >= off[q]) e = q;
            tilee[i] = e; }
    }
}

__device__ __forceinline__ void moe_pass_gemm1_fast(Frame& F, int t0, int t1) {
    pg8::OrderMoe S; S.o.init(t1 - t0, NFF1 / 256, F.G, F.wg); S.rowidx = WSP(const int, WS_ROWIDX); S.tilee = WSP(const int, WS_TILEE); S.t0 = t0; S.bstride = (size_t)NFF1 * D; S.gather = true;
    EpiSwiglu E{WSP(bf16, WS_MACT), 0};
    pg8::gemm_phase(F.lds, WSP(const bf16, WS_H), D, WSP(const bf16, WS_MW13), D, D, S, E);
}
__device__ __forceinline__ void moe_pass_gemm2_fast(Frame& F, int t0, int t1) {
    pg8::OrderMoe S; S.o.init(t1 - t0, D / 256, F.G, F.wg); S.rowidx = WSP(const int, WS_ROWIDX); S.tilee = WSP(const int, WS_TILEE); S.t0 = t0; S.bstride = (size_t)D * DFF; S.gather = false;
    EpiBf16Out E{WSP(bf16, WS_EOUT), D, t0 * 256};
    pg8::gemm_phase(F.lds, WSP(const bf16, WS_MACT), DFF, WSP(const bf16, WS_MW2), DFF, DFF, S, E);
}
__device__ __forceinline__ void phase_final(Frame& F) {
    const int gw = F.wg * NWAVES + F.wave, NGW = F.G * NWAVES, lane = F.lane;
    const GAS float* gf = inp(F, I_GFINAL); const GAS bf16* eo = WSP(const bf16, WS_EOUT);
    for (int row = gw; row < TOKL; row += NGW) {
        const int s0 = WSP(const int, WS_SLOT)[row * 2], s1 = WSP(const int, WS_SLOT)[row * 2 + 1];
        const float w0 = WSP(const float, WS_TOPW)[row * 2], w1 = WSP(const float, WS_TOPW)[row * 2 + 1];
        const GAS float* m5 = mod_ptr(F, 1, row, 5);
        GAS float* xr = outp(F) + (size_t)row * D;
        f32x4 v[4]; float s = 0.f;
#pragma unroll
        for (int j = 0; j < 4; ++j) {
            const int c = 256 * j + 4 * lane;
            const f32x4 a = ld_bf16x4(eo + (size_t)s0 * D + c), b = ld_bf16x4(eo + (size_t)s1 * D + c), m = *(const GAS f32x4*)(m5 + c);
            v[j] = *(const GAS f32x4*)(xr + c) + m * (a * w0 + b * w1);
            s += (v[j].x * v[j].x + v[j].y * v[j].y) + (v[j].z * v[j].z + v[j].w * v[j].w);
        }
        const float r = rsqrtf(wave_sum(s) * (1.f / 1024.f) + 1e-6f);
#pragma unroll
        for (int j = 0; j < 4; ++j) { const int c = 256 * j + 4 * lane; const f32x4 g = *(const GAS f32x4*)(gf + c); *(GAS f32x4*)(xr + c) = v[j] * r * g; }
    }
}

#ifndef REP_WIN
#define REP_WIN 1
#endif
#ifndef REP_MIX
#define REP_MIX 1
#endif
#ifndef REP_GATE
#define REP_GATE 1
#endif
#ifndef REP_UP
#define REP_UP 1
#endif
#ifndef REP_FFN1
#define REP_FFN1 1
#endif
#ifndef REP_MOE
#define REP_MOE 1
#endif
#ifndef REP_NORM
#define REP_NORM 1
#endif
#ifndef REP_P0
#define REP_P0 1
#endif
__global__ void __launch_bounds__(NTHR, 2) hybrid_fwd(Params prm) {
    extern __shared__ __attribute__((aligned(16))) unsigned char lds_raw[];
    Frame F;
    F.lds = (LAS unsigned char*)lds_raw; F.ws = (GAS unsigned char*)prm.ws;
    F.tid = threadIdx.x; F.lane = F.tid & 63; F.wave = __builtin_amdgcn_readfirstlane(F.tid >> 6); F.G = gridDim.x; F.wg = blockIdx.x;
    volatile LAS unsigned* MISC = (volatile LAS unsigned*)(F.lds + MISC_OFF);
    if (F.tid < 64) MISC[F.tid] = 0u;
    if (F.tid < 33) { const unsigned long long v = F.tid < 32 ? (unsigned long long)prm.in[F.tid] : (unsigned long long)prm.out; *(LAS unsigned long long*)(F.lds + PTAB_OFF + 8 * F.tid) = v; }
    __syncthreads();
    XcdBarrier bar = xcd_barrier_post(WSP(unsigned, WS_CTL) + CW_BAR, MISC + 8);
#define RELAUNDER() do { { unsigned long long _w = (unsigned long long)F.ws; asm volatile("" : "+s"(_w)); F.ws = (GAS unsigned char*)_w; } \
        { unsigned _t = (unsigned)F.tid; asm volatile("" : "+v"(_t)); F.tid = (int)_t; F.lane = F.tid & 63; F.wave = __builtin_amdgcn_readfirstlane(F.tid >> 6); } \
        { unsigned _g = (unsigned)F.G, _b = (unsigned)F.wg; asm volatile("" : "+s"(_g), "+s"(_b)); F.G = (int)_g; F.wg = (int)_b; } \
        { unsigned _l = (unsigned)(size_t)F.lds; asm volatile("" : "+s"(_l)); F.lds = (LAS unsigned char*)(size_t)_l; } } while (0)
#define GRID_BAR() do { { unsigned long long _b = (unsigned long long)bar.bar; unsigned _x = bar.x; asm volatile("" : "+s"(_b), "+s"(_x)); bar.bar = (GAS unsigned*)_b; bar.x = _x; } xcd_barrier(bar); RELAUNDER(); } while (0)

    for (int rp = 0; rp < REP_P0; ++rp) { phase_p0(F); write_bias(F);
    GRID_BAR(); }
#pragma unroll 1
    for (int layer = 0; layer < 2; ++layer) {
        const bool last = layer == 1;
        const int rows_all = TOK, rows_out = last ? TOKL : TOK;
        const GAS float* modbase = WSP(const float, WS_MOD) + (size_t)layer * 17 * 6144;
        for (int rp = 0; rp < REP_NORM; ++rp) { phase_norm(F, layer, rows_all, !last, 0);
        GRID_BAR(); }
        for (int rp = 0; rp < REP_WIN; ++rp) {
        { EpiWin E{WSP(const float, WS_BIAS) + layer * NWP, WSP(bf16, WS_HYTL), WSP(bf16, WS_HYTC), WSP(bf16, WS_RET), WSP(bf16, WS_ML), WSP(float, WS_MLG)};
          gemm_fast(F, WSP(const bf16, WS_H), D, WSP(const bf16, WS_WIN), D, D, rows_all, NW1, E); }
        GRID_BAR(); }
        for (int rp = 0; rp < REP_MIX; ++rp) { phase_mix(F, layer);
        GRID_BAR(); }
        phase_combine(F, layer);
        GRID_BAR();
        for (int rp = 0; rp < REP_GATE; ++rp) {
        { EpiGate E{WSP(const float, WS_BIAS) + layer * NWP + NW1, WSP(bf16, WS_GATES)};
          gemm_fast(F, WSP(const bf16, WS_H), D, WSP(const bf16, WS_WIN) + (size_t)NW1 * D, D, D, rows_out, NGATE, E); }
        GRID_BAR(); }
        for (int rp = 0; rp < REP_UP; ++rp) {
        { EpiUp E{WSP(const bf16, WS_GATES), WSP(bf16, WS_H)};
          gemm_fast(F, WSP(const bf16, WS_Y), D, WSP(const bf16, WS_WUP), D, D, rows_out, D, E); }
        GRID_BAR(); }
        { EpiResid E{last ? outp(F) : inp(F, I_X), last ? WSP(const float, WS_XC) : inp(F, I_CTX), outp(F), WSP(float, WS_XC), modbase, 2};
          gemm_fast(F, WSP(const bf16, WS_H), D, WSP(const bf16, WS_WOUT), D, D, rows_out, D, E); }
        GRID_BAR();
        if (!last) {
            phase_norm(F, layer, rows_out, false, 3);
            { const int gw = F.wg * NWAVES + F.wave, NGW = F.G * NWAVES; LAS float* scr = (LAS float*)(F.lds + F.wave * 8704);
              conv_weights_ffn(inp(F, I_FW1), inp(F, I_FW3), inp(F, I_FW2), WSP(bf16, WS_W13), WSP(bf16, WS_W2), gw, NGW, scr, F.lane);
              conv_weights_win(F, 1, gw, NGW, scr);
              conv_weights_upout(F, 1, gw, NGW, scr); }
            GRID_BAR();
            for (int rp = 0; rp < REP_FFN1; ++rp) {
            { EpiSwiglu E{WSP(bf16, WS_ACT), 0};
              gemm_fast(F, WSP(const bf16, WS_H), D, WSP(const bf16, WS_W13), D, D, rows_out, NFF1, E); }
            GRID_BAR(); }
            { EpiResid E{outp(F), WSP(const float, WS_XC), outp(F), WSP(float, WS_XC), modbase, 5};
              gemm_fast(F, WSP(const bf16, WS_ACT), DFF, WSP(const bf16, WS_W2), DFF, DFF, rows_out, D, E); }
            GRID_BAR();
        }
    }
    phase_norm_router(F);
    { const int gw = F.wg * NWAVES + F.wave, NGW = F.G * NWAVES; LAS float* scr = (LAS float*)(F.lds + F.wave * 8704);
#pragma unroll 1
      for (int e = 0; e < NE; ++e)
          conv_weights_ffn(inp(F, I_MW1) + (size_t)e * D * DFF, inp(F, I_MW3) + (size_t)e * D * DFF, inp(F, I_MW2) + (size_t)e * DFF * D,
                           WSP(bf16, WS_MW13) + (size_t)e * NFF1 * D, WSP(bf16, WS_MW2) + (size_t)e * D * DFF, gw, NGW, scr, F.lane); }
    GRID_BAR();
    phase_route_tables(F);
    GRID_BAR();
    const int ntiles = __builtin_amdgcn_readfirstlane(WSP(const int, WS_TILEE)[MAXTILES]);
#pragma unroll 1
    for (int p = 0; p < NPASS; ++p) {
        const int t0 = p * PASS_TILES, t1 = min(ntiles, t0 + PASS_TILES);
        for (int rp = 0; rp < REP_MOE; ++rp) {
        if (t0 < t1) moe_pass_gemm1_fast(F, t0, t1);
        GRID_BAR();
        if (t0 < t1) moe_pass_gemm2_fast(F, t0, t1);
        GRID_BAR(); }
    }
    phase_final(F);
}

extern "C" void kernel_launch(void* const* d_in, const int* in_sizes, int n_in, void* d_out, int out_size, void* d_ws, size_t ws_size, hipStream_t stream) {
    static int grid = 0;
    if (grid == 0) {
        if (n_in != 32 || out_size != TOKL * D || ws_size < WS_END) { fprintf(stderr, "kernel_launch: unexpected arguments (n_in %d, out %d, ws %zu)\n", n_in, out_size, ws_size); grid = -1; return; }
        int dev = 0, cus = 0;
        if (hipGetDevice(&dev) != hipSuccess || hipDeviceGetAttribute(&cus, hipDeviceAttributeMultiprocessorCount, dev) != hipSuccess) { grid = -1; return; }
        if (hipFuncSetAttribute((const void*)hybrid_fwd, hipFuncAttributeMaxDynamicSharedMemorySize, LDS_BYTES) != hipSuccess) { grid = -1; return; }
        int per_cu = 0;
        (void)hipOccupancyMaxActiveBlocksPerMultiprocessor(&per_cu, (const void*)hybrid_fwd, NTHR, LDS_BYTES);
        (void)hipGetLastError();
        grid = cus;
    }
    if (grid < 0) return;
    (void)hipMemsetAsync((char*)d_ws + WS_CTL, 0, CTL_ZERO_BYTES, stream);
    Params p{};
    for (int i = 0; i < 32; ++i) p.in[i] = (const float*)d_in[i];
    p.out = (float*)d_out; p.ws = (unsigned char*)d_ws;
    hipLaunchKernelGGL(hybrid_fwd, dim3(grid), dim3(NTHR), LDS_BYTES, stream, p);
}
```

```cpp
#include <hip/hip_runtime.h>
#include <stdint.h>
#include <stdio.h>

#define LAS __attribute__((address_space(3)))
#define GAS __attribute__((address_space(1)))
typedef unsigned short bf16;
typedef short bf16x8 __attribute__((ext_vector_type(8)));
typedef float f32x4 __attribute__((ext_vector_type(4)));
typedef unsigned u32x4 __attribute__((ext_vector_type(4)));
typedef unsigned u32x2 __attribute__((ext_vector_type(2)));

constexpr int D = 1024, NB = 16, LL = 2048, LC = 256;
constexpr int TOKL = NB * LL, TOKC = NB * LC, TOK = TOKL + TOKC;
constexpr int HYW = 384, RETW = 384, MLW = 256;
constexpr int NIN = 6800, NW1 = 3840, NGATE = 3072, NWP = 6912;
constexpr int DFF = 2816, NFF1 = 5632, NE = 8;
constexpr int NWAVES = 8, NTHR = 512;
constexpr int MAXTILES = 272, PASS_TILES = 64, NPASS = 5;

constexpr size_t MiB = 1u << 20;
constexpr size_t WS_CTL = 0, CTL_ZERO_BYTES = 1 * MiB;
constexpr size_t WS_MOD = 1 * MiB;
constexpr size_t WS_BIAS = 2 * MiB;
constexpr size_t WS_ROPE = 2 * MiB + 256 * 1024;
constexpr size_t WS_TOPE = 3 * MiB;
constexpr size_t WS_TOPW = 3 * MiB + 256 * 1024;
constexpr size_t WS_TOPP = 3 * MiB + 512 * 1024;
constexpr size_t WS_SLOT = 3 * MiB + 768 * 1024;
constexpr size_t WS_ROWIDX = 4 * MiB;
constexpr size_t WS_TILEE = 4 * MiB + 512 * 1024;
constexpr size_t WS_FTL = 5 * MiB;
constexpr size_t WS_FTC = 17 * MiB;
constexpr size_t WS_WIN = 18 * MiB;
constexpr size_t WS_WUP = 32 * MiB;
constexpr size_t WS_WOUT = 34 * MiB;
constexpr size_t WS_XC = 36 * MiB;
constexpr size_t WS_H = 52 * MiB;
constexpr size_t WS_Y = 124 * MiB;
constexpr size_t WS_U = 196 * MiB;
constexpr size_t WS_RET = WS_U;
constexpr size_t WS_ML = WS_U + 108 * MiB;
constexpr size_t WS_MLG = WS_U + 180 * MiB;
constexpr size_t WS_OB = WS_U + 183 * MiB;
constexpr size_t WS_YHTL = WS_U + 228 * MiB;
constexpr size_t WS_YHTC = WS_U + 252 * MiB;
constexpr size_t WS_HYTL = WS_U + 255 * MiB;
constexpr size_t WS_HYTC = WS_U + 327 * MiB;
constexpr size_t WS_END = WS_U + 336 * MiB;
constexpr size_t WS_GATES = WS_U;
constexpr size_t WS_ACT = WS_U;
constexpr size_t WS_W13 = WS_U + 204 * MiB;
constexpr size_t WS_W2 = WS_U + 216 * MiB;
constexpr size_t WS_MW13 = WS_Y;
constexpr size_t WS_MW2 = WS_Y + 88 * MiB;
constexpr size_t WS_MACT = WS_Y + 132 * MiB;
constexpr size_t WS_EOUT = WS_Y + 220 * MiB;
static_assert(WS_EOUT + (size_t)MAXTILES * 256 * 1024 * 2 <= WS_END, "map");
static_assert(WS_GATES + (size_t)TOK * NGATE * 2 <= WS_YHTL, "gates overlay");

constexpr int CW_BAR = 4096;
constexpr int CW_CNT = 16384;

constexpr int LDS_BYTES = 147456;
constexpr int MISC_OFF = 147456 - 256;

__device__ __forceinline__ float bf2f(bf16 b) { return __uint_as_float(((unsigned)b) << 16); }
typedef __bf16 bf2v_ __attribute__((ext_vector_type(2)));
typedef float f2v_ __attribute__((ext_vector_type(2)));
__device__ __forceinline__ unsigned pk2(float lo, float hi) { const f2v_ f = {lo, hi}; return __builtin_bit_cast(unsigned, __builtin_convertvector(f, bf2v_)); }
__device__ __forceinline__ unsigned f2bf(float f) { return pk2(f, 0.f) & 0xffffu; }
__device__ __forceinline__ float wave_sum(float v) {
#pragma unroll
    for (int o = 1; o < 64; o <<= 1) v += __shfl_xor(v, o);
    return v;
}
__device__ __forceinline__ float sigmoidf_(float x) { return __builtin_amdgcn_rcpf(1.0f + __expf(-x)); }
__device__ __forceinline__ float siluf_(float x) { return x * __builtin_amdgcn_rcpf(1.0f + __expf(-x)); }

#define XB_TMO      128
#define XB_XCNT(j)  (256  + 64 * (j))
#define XB_XSUB(j)  (1280 + 64 * (j))
#define XB_XGEN(j)  (2304 + 64 * (j))
#define XB_TOP      3328
#define XB_TOPGEN   3392
#define XCD_BAR_WORDS 3456
#define XB_SPIN_CAP (1u << 22)
__device__ __forceinline__ unsigned xb_ld(GAS unsigned* p)              { return __hip_atomic_load(p, __ATOMIC_RELAXED, __HIP_MEMORY_SCOPE_AGENT); }
__device__ __forceinline__ unsigned xb_add(GAS unsigned* p, unsigned v) { return __hip_atomic_fetch_add(p, v, __ATOMIC_RELAXED, __HIP_MEMORY_SCOPE_AGENT); }
__device__ __forceinline__ unsigned xb_xcc_id() { return (unsigned)__builtin_amdgcn_s_getreg((3 << 11) | 20) & 0xFu; }
#define XB_SPIN(cond, bar) do { unsigned _sp = 0; while (cond) { __builtin_amdgcn_s_sleep(1); \
    if ((++_sp & 255u) == 0u) { if (xb_ld(&(bar)[XB_TMO])) break; if (_sp > XB_SPIN_CAP) { (void)__hip_atomic_fetch_add(&(bar)[XB_TMO], 1u, __ATOMIC_RELAXED, __HIP_MEMORY_SCOPE_AGENT); break; } } } } while (0)
struct XcdBarrier { GAS unsigned* bar; unsigned x; volatile LAS unsigned* st; };
__device__ __forceinline__ XcdBarrier xcd_barrier_post(GAS unsigned* bar, volatile LAS unsigned* st) {
    XcdBarrier b; b.bar = bar; b.x = xb_xcc_id(); b.st = st;
    if (threadIdx.x == 0) (void)xb_add(&bar[XB_XCNT(b.x)], 1u);
    return b;
}
__device__ __forceinline__ void xcd_barrier_complete(GAS unsigned* bar, unsigned x, unsigned& nloc, unsigned& nx) {
    const unsigned G = gridDim.x * gridDim.y * gridDim.z;
    unsigned sum, cnt, mine, sp = 0u;
    for (;;) {
        sum = 0u; cnt = 0u; mine = 0u;
#pragma unroll 1
        for (unsigned j = 0; j < 16; ++j) { const unsigned c = xb_ld(&bar[XB_XCNT(j)]); sum += c; cnt += (c > 0u) ? 1u : 0u; }
        mine = xb_ld(&bar[XB_XCNT(x)]);
        if (sum == G) break;
        __builtin_amdgcn_s_sleep(1);
        if ((++sp & 255u) == 0u) { if (xb_ld(&bar[XB_TMO])) break; if (sp > XB_SPIN_CAP) { (void)__hip_atomic_fetch_add(&bar[XB_TMO], 1u, __ATOMIC_RELAXED, __HIP_MEMORY_SCOPE_AGENT); break; } }
    }
    nloc = mine > 0u ? mine : 1u; nx = cnt > 0u ? cnt : 1u;
}
__device__ __forceinline__ void xcd_barrier(const XcdBarrier& b) {
    asm volatile("s_waitcnt vmcnt(0)" ::: "memory");
    __syncthreads();
    if (threadIdx.x == 0) {
        GAS unsigned* bar = b.bar;
        __builtin_amdgcn_s_waitcnt(0);
        unsigned nloc = b.st[0], nx = b.st[1];
        if (nloc == 0u) { xcd_barrier_complete(bar, b.x, nloc, nx); b.st[0] = nloc; b.st[1] = nx; }
        const unsigned old = xb_add(&bar[XB_XSUB(b.x)], 1u);
        const unsigned gen = old / nloc;
        if (old + 1u == (gen + 1u) * nloc) {
            __builtin_amdgcn_fence(__ATOMIC_RELEASE, "agent");
            asm volatile("s_waitcnt vmcnt(0)" ::: "memory");
            const unsigned og = xb_add(&bar[XB_TOP], 1u);
            const unsigned tg = og / nx;
            if (og + 1u == (tg + 1u) * nx) xb_add(&bar[XB_TOPGEN], 1u);
            else XB_SPIN(xb_ld(&bar[XB_TOPGEN]) == tg, bar);
            __builtin_amdgcn_fence(__ATOMIC_ACQUIRE, "agent");
            xb_add(&bar[XB_XGEN(b.x)], 1u);
            asm volatile("s_waitcnt vmcnt(0)" ::: "memory");
        } else {
            XB_SPIN(xb_ld(&bar[XB_XGEN(b.x)]) == gen, bar);
            __builtin_amdgcn_fence(__ATOMIC_ACQUIRE, "agent");
            asm volatile("s_waitcnt vmcnt(0)" ::: "memory");
        }
    }
    __syncthreads();
}

struct Params { const float* in[32]; float* out; unsigned char* ws; };
enum { I_X = 0, I_C, I_CTX, I_CCTX, I_WMOD, I_BMOD, I_GMIX, I_GFFN, I_WIN, I_BIN, I_HYCONV, I_HYF1, I_HYFB1, I_HYF2, I_HYFB2, I_HYF3, I_HYDECAY,
       I_HYSKIP, I_RETDECAY, I_MLCONV, I_MLGB, I_WUP, I_WOUT, I_FW1, I_FW3, I_FW2, I_ROUTER, I_ROUTERB, I_MW1, I_MW3, I_MW2, I_GFINAL };

struct Frame {
    LAS unsigned char* lds;
    GAS unsigned char* ws;
    int tid, lane, wave, G, wg;
};
#define WSP(T, off) ((GAS T*)(F.ws + (off)))
constexpr int PTAB_OFF = 147456 - 1024;
__device__ __forceinline__ const GAS float* inp(const Frame& F, int i) {
    const LAS unsigned* t = (const LAS unsigned*)(F.lds + PTAB_OFF) + 2 * i;
    const unsigned lo = __builtin_amdgcn_readfirstlane(t[0]), hi = __builtin_amdgcn_readfirstlane(t[1]);
    return (const GAS float*)(((unsigned long long)hi << 32) | lo);
}
__device__ __forceinline__ GAS float* outp(const Frame& F) { return (GAS float*)inp(F, 32); }

__device__ __forceinline__ int row_batch(int row) { return row < TOKL ? (row >> 11) : ((row - TOKL) >> 8); }
__device__ __forceinline__ const GAS float* mod_ptr(const Frame& F, int layer, int row, int which) {
    const int r = row < TOKL ? (row >> 11) : 16;
    return WSP(const float, WS_MOD) + ((size_t)(layer * 17 + r) * 6 + which) * 1024;
}

template <class RowMap>
__device__ __forceinline__ void tr_item(const GAS float* W, int K, int N, GAS bf16* WT, int ldT, RowMap rm, LAS float* scr, int item, int lane) {
    const int nblk = (N + 31) / 32, kb = item / nblk, nb = item % nblk, k0 = 64 * kb, n0 = 32 * nb;
#pragma unroll 8
    for (int i = 0; i < 32; ++i) { const int kk = 2 * i + (lane >> 5); const int n = n0 + (lane & 31); scr[kk * 33 + (lane & 31)] = (n < N) ? W[(size_t)(k0 + kk) * N + n] : 0.f; }
    asm volatile("s_waitcnt lgkmcnt(0)" ::: "memory");
    const int c = lane & 7;
#pragma unroll
    for (int j = 0; j < 4; ++j) { const int nl = (lane >> 3) + 8 * j; const int n = n0 + nl; const LAS float* s = scr + (8 * c) * 33 + nl;
        u32x4 o; o.x = pk2(s[0 * 33], s[1 * 33]); o.y = pk2(s[2 * 33], s[3 * 33]); o.z = pk2(s[4 * 33], s[5 * 33]); o.w = pk2(s[6 * 33], s[7 * 33]);
        if (n < N) *(GAS u32x4*)(WT + (size_t)rm(n) * ldT + k0 + 8 * c) = o; }
    asm volatile("s_waitcnt lgkmcnt(0)" ::: "memory");
}
struct RmId { __device__ __forceinline__ int operator()(int n) const { return n; } };
__device__ __forceinline__ int win_row(int n) {
    if (n < 1152) return n;
    if (n < 2688) return 1280 + (n - 1152);
    if (n < 3712) return 2816 + (n - 2688);
    if (n < 3728) return 1152 + (n - 3712);
    return 3840 + (n - 3728);
}
struct RmWin { __device__ __forceinline__ int operator()(int n) const { return win_row(n); } };
struct RmW1 { __device__ __forceinline__ int operator()(int n) const { return (n >> 4) * 32 + (n & 15); } };
struct RmW3 { __device__ __forceinline__ int operator()(int n) const { return (n >> 4) * 32 + 16 + (n & 15); } };

__device__ __forceinline__ void conv_weights_win(Frame& F, int layer, int gw, int NGW, LAS float* scr) {
    const GAS float* W = inp(F, I_WIN) + (size_t)layer * D * NIN;
    const int items = (D / 64) * ((NIN + 31) / 32);
    for (int it = gw; it < items; it += NGW) tr_item(W, D, NIN, WSP(bf16, WS_WIN), D, RmWin(), scr, it, F.lane);
    GAS bf16* wt = WSP(bf16, WS_WIN);
    for (int i = gw * 64 + F.lane; i < 112 * 1024 / 8; i += NGW * 64) *(GAS u32x4*)(wt + (size_t)1168 * 1024 + (size_t)i * 8) = (u32x4){0u, 0u, 0u, 0u};
}
__device__ __forceinline__ void conv_weights_upout(Frame& F, int layer, int gw, int NGW, LAS float* scr) {
    const int items = (D / 64) * (D / 32);
    for (int it = gw; it < items; it += NGW) tr_item(inp(F, I_WUP) + (size_t)layer * D * D, D, D, WSP(bf16, WS_WUP), D, RmId(), scr, it, F.lane);
    for (int it = gw; it < items; it += NGW) tr_item(inp(F, I_WOUT) + (size_t)layer * D * D, D, D, WSP(bf16, WS_WOUT), D, RmId(), scr, it, F.lane);
}
__device__ __forceinline__ void conv_weights_ffn(const GAS float* w1, const GAS float* w3, const GAS float* w2, GAS bf16* w13t, GAS bf16* w2t, int gw, int NGW, LAS float* scr, int lane) {
    const int i1 = (D / 64) * (DFF / 32), i2 = (DFF / 64) * (D / 32);
    for (int it = gw; it < i1; it += NGW) tr_item(w1, D, DFF, w13t, D, RmW1(), scr, it, lane);
    for (int it = gw; it < i1; it += NGW) tr_item(w3, D, DFF, w13t, D, RmW3(), scr, it, lane);
    for (int it = gw; it < i2; it += NGW) tr_item(w2, DFF, D, w2t, DFF, RmId(), scr, it, lane);
}

__device__ __forceinline__ void filter_item(Frame& F, int layer, int L, GAS bf16* FT  , int pb, int ch, LAS float* tile  ) {
    const GAS float* f1 = inp(F, I_HYF1) + layer * 33 * 64; const GAS float* fb1 = inp(F, I_HYFB1) + layer * 64;
    const GAS float* f2 = inp(F, I_HYF2) + layer * 64 * 64; const GAS float* fb2 = inp(F, I_HYFB2) + layer * 64;
    const GAS float* f3 = inp(F, I_HYF3) + (size_t)layer * 64 * 1536; const GAS float* dec = inp(F, I_HYDECAY) + layer * 1536;
    const int lane = F.lane, n = ch * 64 + lane;
    const float b1 = fb1[lane], b2 = fb2[lane], adec = fabsf(dec[n]);
    for (int pl = 0; pl < 64; ++pl) {
        const int pos = pb * 64 + pl;
        const float t = (float)pos / (float)(L - 1);
        const float w = 6.283185307179586f * (float)pos / (float)L;
        float feat = 0.f;
        if (lane == 0) feat = t;
        else if (lane < 17) { const float band = 1e-4f + (float)(lane - 1) * ((15.0f - 1e-4f) / 15.0f); feat = cosf(w * band); }
        else if (lane < 33) { const float band = 1e-4f + (float)(lane - 17) * ((15.0f - 1e-4f) / 15.0f); feat = -sinf(w * band); }
        float a1 = b1;
        for (int i = 0; i < 33; ++i) a1 += __shfl(feat, i) * f1[i * 64 + lane];
        const float h1 = sinf(a1);
        float a2 = b2;
        for (int i = 0; i < 64; ++i) a2 += __shfl(h1, i) * f2[i * 64 + lane];
        const float h2 = sinf(a2);
        float a3 = 0.f;
        for (int i = 0; i < 64; ++i) a3 += __shfl(h2, i) * f3[i * 1536 + n];
        tile[pl * 65 + lane] = a3 * expf(-t * adec);
    }
    asm volatile("s_waitcnt lgkmcnt(0)" ::: "memory");
    const int pos = pb * 64 + lane;
    for (int cl = 0; cl < 64; ++cl) {
        const int nn = ch * 64 + cl, o = nn / 768, dir = (nn / 384) & 1, c = nn % 384;
        GAS bf16* dst = FT + (size_t)(o * 384 + c) * (2 * L);
        const float v = tile[lane * 65 + cl];
        if (dir == 0) dst[L - pos] = (bf16)f2bf(v);
        else if (pos > 0) dst[L + pos] = (bf16)f2bf(v);
    }
    asm volatile("s_waitcnt lgkmcnt(0)" ::: "memory");
}

__device__ __forceinline__ void phase_p0(Frame& F) {
    const int gw = F.wg * NWAVES + F.wave, NGW = F.G * NWAVES;
    LAS float* sl = (LAS float*)F.lds;
    LAS float* red = (LAS float*)(F.lds + 17 * 4096);
    for (int i = F.tid; i < 17 * 1024; i += NTHR) { const int r = i >> 10, k = i & 1023; const float v = r < 16 ? inp(F, I_C)[r * 1024 + k] : inp(F, I_CCTX)[k]; sl[i] = siluf_(v); }
    __syncthreads();
    for (int item = F.wg; item < 2 * 384; item += F.G) {
        const int layer = item / 384, n0 = (item % 384) * 16, j = F.tid & 15, kp = F.tid >> 4;
        const GAS float* W = inp(F, I_WMOD) + (size_t)layer * D * 6144;
        float acc[17];
#pragma unroll
        for (int r = 0; r < 17; ++r) acc[r] = 0.f;
        for (int k = kp * 32; k < kp * 32 + 32; ++k) { const float w = W[(size_t)k * 6144 + n0 + j];
#pragma unroll
            for (int r = 0; r < 17; ++r) acc[r] += sl[r * 1024 + k] * w; }
#pragma unroll
        for (int r = 0; r < 17; ++r) red[(kp * 17 + r) * 16 + j] = acc[r];
        __syncthreads();
        if (F.tid < 272) { const int r = F.tid >> 4, jj = F.tid & 15; float s = inp(F, I_BMOD)[layer * 6144 + n0 + jj];
            for (int q = 0; q < 32; ++q) s += red[(q * 17 + r) * 16 + jj];
            WSP(float, WS_MOD)[(size_t)(layer * 17 + r) * 6144 + n0 + jj] = s; }
        __syncthreads();
    }
    __syncthreads();
    LAS float* scr = (LAS float*)(F.lds + F.wave * 8704);
    conv_weights_win(F, 0, gw, NGW, scr);
    conv_weights_upout(F, 0, gw, NGW, scr);
    for (int i = gw * 64 + F.lane; i < 2048 * 32; i += NGW * 64) {
        const int t = i >> 5, j = i & 31, half = j >> 4, ii = j & 15;
        const float inv = 1.0f / powf(10000.0f, (float)ii / 16.0f);
        const float ang = (float)(half == 0 ? (t >> 6) : (t & 63)) * inv;
        WSP(float, WS_ROPE)[t * 64 + half * 32 + ii] = cosf(ang);
        WSP(float, WS_ROPE)[t * 64 + half * 32 + 16 + ii] = sinf(ang);
    }
    __syncthreads();
    LAS float* ftile = (LAS float*)(F.lds + F.wave * 16640);
    for (int it = gw; it < 1536 + 96; it += NGW) {
        if (it < 1536) { const int layer = it / 768, r = it % 768; filter_item(F, layer, LL, WSP(bf16, WS_FTL) + (size_t)layer * 2 * 384 * 4096, r / 24, r % 24, ftile); }
        else { const int r = it - 1536; filter_item(F, 0, LC, WSP(bf16, WS_FTC), r / 24, r % 24, ftile); }
    }
}
__device__ __forceinline__ void write_bias(Frame& F) {
    const int gt = (F.wg * NWAVES + F.wave) * 64 + F.lane, NGT = F.G * NTHR;
    for (int i = gt; i < 2 * NWP; i += NGT) {
        const int l = i / NWP, r = i % NWP; float v = 0.f;
        int n = -1;
        if (r < 1152) n = r; else if (r < 1168) n = 3712 + (r - 1152); else if (r < 1280) n = -1; else if (r < 2816) n = 1152 + (r - 1280); else if (r < 3840) n = 2688 + (r - 2816); else n = 3728 + (r - 3840);
        if (n >= 0) v = inp(F, I_BIN)[l * NIN + n];
        WSP(float, WS_BIAS)[i] = v;
    }
}

__device__ __forceinline__ void norm_mod_row(const GAS float* xrow, const GAS float* g, const GAS float* shift, const GAS float* scale, GAS bf16* orow, int lane, float* keep  ) {
    f32x4 v[4]; float s = 0.f;
#pragma unroll
    for (int j = 0; j < 4; ++j) { v[j] = *(const GAS f32x4*)(xrow + 256 * j + 4 * lane); s += (v[j].x * v[j].x + v[j].y * v[j].y) + (v[j].z * v[j].z + v[j].w * v[j].w); }
    const float r = rsqrtf(wave_sum(s) * (1.0f / 1024.0f) + 1e-6f);
#pragma unroll
    for (int j = 0; j < 4; ++j) {
        const f32x4 gg = *(const GAS f32x4*)(g + 256 * j + 4 * lane), sh = *(const GAS f32x4*)(shift + 256 * j + 4 * lane), sc = *(const GAS f32x4*)(scale + 256 * j + 4 * lane);
        f32x4 o;
        o.x = (v[j].x * r * gg.x) * (1.f + sc.x) + sh.x; o.y = (v[j].y * r * gg.y) * (1.f + sc.y) + sh.y;
        o.z = (v[j].z * r * gg.z) * (1.f + sc.z) + sh.z; o.w = (v[j].w * r * gg.w) * (1.f + sc.w) + sh.w;
        if (keep) { keep[4 * j + 0] = o.x; keep[4 * j + 1] = o.y; keep[4 * j + 2] = o.z; keep[4 * j + 3] = o.w; }
        u32x2 w; w.x = pk2(o.x, o.y); w.y = pk2(o.z, o.w);
        *(GAS u32x2*)(orow + 256 * j + 4 * lane) = w;
    }
}
__device__ __forceinline__ const GAS float* xrow_ptr(const Frame& F, int row, bool from_input) {
    if (row < TOKL) return (from_input ? inp(F, I_X) : outp(F)) + (size_t)row * D;
    return (from_input ? inp(F, I_CTX) : WSP(const float, WS_XC)) + (size_t)(row - TOKL) * D;
}
__device__ __forceinline__ void phase_norm(Frame& F, int layer, int nrows, bool from_input, int which) {
    const int gw = F.wg * NWAVES + F.wave, NGW = F.G * NWAVES;
    const GAS float* g = inp(F, which == 0 ? I_GMIX : I_GFFN) + layer * D;
    for (int row = gw; row < nrows; row += NGW)
        norm_mod_row(xrow_ptr(F, row, from_input), g, mod_ptr(F, layer, row, which), mod_ptr(F, layer, row, which + 1), WSP(bf16, WS_H) + (size_t)row * D, F.lane, nullptr);
}

namespace pg8 {
constexpr int BM = 256, BK = 64, HALF = 128, HTB = HALF * BK * 2, STAGE_BYTES = 8 * HTB, NXCD = 8, WGM = 8;
__device__ __forceinline__ int lds_byte(int r, int c) { const int st = (r >> 4) * 2 + (c >> 5), rr = r & 15, cc = c & 31, ob = rr * 64 + cc * 2; return st * 1024 + (ob ^ (((ob >> 9) & 1) << 5)); }
__device__ __forceinline__ void stage_rc(int b, int& R, int& C) { const int st = b / 1024, sb = b % 1024, swz = sb ^ (((sb >> 9) & 1) << 5); R = (st >> 1) * 16 + swz / 64; C = (st & 1) * 32 + (swz % 64) / 2; }
struct Unit { int pm, pn; };
struct OrderPlain {
    static constexpr bool GATHER = false;
    int nM, nN, nwg, G, c;
    __device__ __forceinline__ void init(int nM_, int nN_, int G_, int c_) { nM = nM_; nN = nN_; nwg = nM * nN; G = G_; c = c_; }
    __device__ __forceinline__ bool next(int i, Unit& u) const {
        const long L = (long)i * G + c; if (L >= nwg) return false;
        int wgid = (int)L; { const int q = nwg / NXCD, r = nwg % NXCD, xcd = wgid % NXCD, off = wgid / NXCD; wgid = (xcd < r ? xcd * (q + 1) : r * (q + 1) + (xcd - r) * q) + off; }
        const int nig = WGM * nN, gid = wgid / nig, fm = gid * WGM, gsz = (nM - fm) < WGM ? (nM - fm) : WGM;
        u.pm = fm + ((wgid % nig) % gsz); u.pn = (wgid % nig) / gsz; return true;
    }
    __device__ __forceinline__ int arow(int r) const { return r; }
    __device__ __forceinline__ size_t boff(const Unit&) const { return 0; }
};
struct OrderMoe {
    static constexpr bool GATHER = true;
    OrderPlain o; const GAS int* rowidx; const GAS int* tilee; int t0; size_t bstride; bool gather;
    __device__ __forceinline__ bool next(int i, Unit& u) const { return o.next(i, u); }
    __device__ __forceinline__ int arow(int r) const { return gather ? rowidx[t0 * 256 + r] : r; }
    __device__ __forceinline__ size_t boff(const Unit& u) const { return (size_t)tilee[t0 + u.pm] * bstride; }
};

template <class Epi, class Sched>
__device__ __forceinline__ void gemm_phase(LAS unsigned char* lds, const GAS bf16* A, int lda, const GAS bf16* Bt, int ldb, int K, const Sched& S, const Epi& E) {
    unsigned tid_u = threadIdx.x; asm volatile("" : "+v"(tid_u));
    const int tid = (int)tid_u, wid = __builtin_amdgcn_readfirstlane(tid >> 6), lane = tid & 63, wr = wid >> 2, wc = wid & 3, fr = lane & 15, fq = lane >> 4;
    const int nt = K / BK;
    unsigned voffB[2];
    { int sR[2], sC[2];
#pragma unroll
      for (int i = 0; i < 2; ++i) { stage_rc(tid * 16 + i * 8192, sR[i], sC[i]); voffB[i] = (unsigned)(sR[i] * ldb + sC[i]) * 2u; } }
#define PG8_GATHER_OFFS(pm_) do { unsigned _t = (unsigned)tid; asm volatile("" : "+v"(_t)); _Pragma("unroll") for (int i = 0; i < 2; ++i) { int _R, _C; stage_rc((int)_t * 16 + i * 8192, _R, _C); \
        vc0[i] = (unsigned)((size_t)S.arow((pm_) * BM + _R) * lda + _C) * 2u; vc1[i] = (unsigned)((size_t)S.arow((pm_) * BM + HALF + _R) * lda + _C) * 2u; } } while (0)
    const size_t kstep = (size_t)(BK * 2);
    const size_t hstepB = (size_t)HALF * ldb * 2, tstepB = 2 * hstepB;
    const unsigned ldsw = (unsigned)wid * 1024u;
    const int aoff = lds_byte(wr * 64 + fr, fq * 8), boff = lds_byte(wc * 32 + fr, fq * 8);
#define PG8_SA(b, h) (((b) * 2 + (h)) * HTB)
#define PG8_SB(b, h) ((4 + (b) * 2 + (h)) * HTB)
#define PG8_STAGE2(bufoff, gbase, v0, v1) do { \
        __builtin_amdgcn_global_load_lds((const GAS unsigned*)((const GAS char*)(gbase) + (v0)), (LAS unsigned*)(lds + (bufoff) + ldsw), 16, 0, 0); \
        __builtin_amdgcn_global_load_lds((const GAS unsigned*)((const GAS char*)(gbase) + (v1)), (LAS unsigned*)(lds + (bufoff) + ldsw + 8192), 16, 0, 0); } while (0)
#define PG8_STAGEB(bufoff, gbase) PG8_STAGE2(bufoff, gbase, voffB[0], voffB[1])
#define PG8_LDA(dst, b, h) do { _Pragma("unroll") for (int m = 0; m < 4; ++m) _Pragma("unroll") for (int k = 0; k < 2; ++k) dst[m][k] = *(const LAS bf16x8*)(lds + PG8_SA(b, h) + aoff + m * 2048 + k * 1024); } while (0)
#define PG8_LDB(dst, b, h) do { _Pragma("unroll") for (int n = 0; n < 2; ++n) _Pragma("unroll") for (int k = 0; k < 2; ++k) dst[n][k] = *(const LAS bf16x8*)(lds + PG8_SB(b, h) + boff + n * 2048 + k * 1024); } while (0)
#define PG8_MMA(ai, bj, At, Bt_) do { __builtin_amdgcn_s_setprio(1); _Pragma("unroll") for (int m = 0; m < 4; ++m) _Pragma("unroll") for (int n = 0; n < 2; ++n) _Pragma("unroll") for (int k = 0; k < 2; ++k) \
        acc[ai][bj][m][n] = __builtin_amdgcn_mfma_f32_16x16x32_bf16(Bt_[n][k], At[m][k], acc[ai][bj][m][n], 0, 0, 0); __builtin_amdgcn_s_setprio(0); } while (0)
#define PG8_WAIT_V(n) asm volatile("s_waitcnt vmcnt(" #n ")" ::: "memory")
#define PG8_WAIT_L(n) asm volatile("s_waitcnt lgkmcnt(" #n ")" ::: "memory")
#define PG8_BAR __builtin_amdgcn_s_barrier()
#define PG8_SCHED __builtin_amdgcn_sched_barrier(0)
    Unit cur, nxt; int ui = 0;
    if (!S.next(0, cur)) return;
    f32x4 acc[2][2][4][2];
#pragma unroll
    for (int a = 0; a < 2; ++a)
#pragma unroll
        for (int b = 0; b < 2; ++b)
#pragma unroll
            for (int m = 0; m < 4; ++m)
#pragma unroll
                for (int n = 0; n < 2; ++n) { float zf; asm volatile("v_mov_b32 %0, 0" : "=v"(zf)); acc[a][b][m][n] = (f32x4){zf, zf, zf, zf}; }
    bf16x8 At[4][2], B0[2][2], B1[2][2];
    constexpr bool GA = Sched::GATHER;
    const size_t hstepA = GA ? 0 : (size_t)HALF * lda * 2, tstepA = (size_t)BM * lda * 2;
    unsigned vc0[2], vc1[2];
    if constexpr (GA) { PG8_GATHER_OFFS(cur.pm); }
    else { int sR, sC;
#pragma unroll
        for (int i = 0; i < 2; ++i) { stage_rc(tid * 16 + i * 8192, sR, sC); vc0[i] = (unsigned)(sR * lda + sC) * 2u; vc1[i] = 0u; } }
#define VC0(i) vc0[i]
#define VC1(i) (GA ? vc1[i] : vc0[i])
#define VN0(i) vc0[i]
#define VN1(i) VC1(i)
    const GAS char* cA = GA ? (const GAS char*)A : (const GAS char*)A + (size_t)cur.pm * tstepA;
    const GAS char* cB = (const GAS char*)Bt + S.boff(cur) * 2 + (size_t)cur.pn * tstepB;
    PG8_STAGEB(PG8_SB(0, 0), cB); PG8_STAGE2(PG8_SA(0, 0), cA, VC0(0), VC0(1)); PG8_STAGEB(PG8_SB(0, 1), cB + hstepB); PG8_STAGE2(PG8_SA(0, 1), cA + hstepA, VC1(0), VC1(1));
    if (wr == 1) PG8_BAR;
    PG8_WAIT_V(4); PG8_BAR;
    PG8_STAGEB(PG8_SB(1, 0), cB + kstep); PG8_STAGE2(PG8_SA(1, 0), cA + kstep, VC0(0), VC0(1)); PG8_STAGEB(PG8_SB(1, 1), cB + hstepB + kstep);
    PG8_WAIT_V(6); PG8_BAR;
    for (;;) {
        const bool has_next = S.next(ui + 1, nxt);
        const GAS char* nB = cB; const GAS char* nA = cA;
        if (has_next) {
            nB = (const GAS char*)Bt + S.boff(nxt) * 2 + (size_t)nxt.pn * tstepB;
            if constexpr (!GA) nA = (const GAS char*)A + (size_t)nxt.pm * tstepA;
        }
        for (int t = 0; t < nt; t += 2) {
            const bool last = (t == nt - 2);
            if constexpr (Epi::HORNER) {
                if (t == 6 || t == 12) {
                    asm volatile("" ::: "memory");
                    const int seg = (t == 6) ? 0 : 1;
                    int hpm = cur.pm, hpn = cur.pn; asm volatile("" : "+s"(hpm), "+s"(hpn));
                    unsigned hln = (unsigned)lane; asm volatile("" : "+v"(hln)); const int hfr = (int)(hln & 15u), hfq = (int)(hln >> 4);
#pragma unroll
                    for (int ai = 0; ai < 2; ++ai) {
                        u32x2 ga[4][2][2], gb[4][2][2];
#pragma unroll
                        for (int m = 0; m < 4; ++m)
#pragma unroll
                            for (int bj = 0; bj < 2; ++bj)
#pragma unroll
                                for (int n = 0; n < 2; ++n) {
                                    const int row = hpm * BM + ai * HALF + wr * 64 + m * 16 + hfr, col = hpn * BM + bj * HALF + wc * 32 + n * 16 + 4 * hfq;
                                    ga[m][bj][n] = E.gate(seg, row, col); gb[m][bj][n] = E.gate(seg + 1, row, col);
                                }
                        asm volatile("" : "+v"(ga[0][0][0]), "+v"(ga[0][0][1]), "+v"(ga[0][1][0]), "+v"(ga[0][1][1]), "+v"(ga[1][0][0]), "+v"(ga[1][0][1]), "+v"(ga[1][1][0]), "+v"(ga[1][1][1]),
                                          "+v"(ga[2][0][0]), "+v"(ga[2][0][1]), "+v"(ga[2][1][0]), "+v"(ga[2][1][1]), "+v"(ga[3][0][0]), "+v"(ga[3][0][1]), "+v"(ga[3][1][0]), "+v"(ga[3][1][1]) :: "memory");
                        asm volatile("" : "+v"(gb[0][0][0]), "+v"(gb[0][0][1]), "+v"(gb[0][1][0]), "+v"(gb[0][1][1]), "+v"(gb[1][0][0]), "+v"(gb[1][0][1]), "+v"(gb[1][1][0]), "+v"(gb[1][1][1]),
                                          "+v"(gb[2][0][0]), "+v"(gb[2][0][1]), "+v"(gb[2][1][0]), "+v"(gb[2][1][1]), "+v"(gb[3][0][0]), "+v"(gb[3][0][1]), "+v"(gb[3][1][0]), "+v"(gb[3][1][1]) :: "memory");
#pragma unroll
                        for (int m = 0; m < 4; ++m)
#pragma unroll
                            for (int bj = 0; bj < 2; ++bj)
#pragma unroll
                                for (int n = 0; n < 2; ++n) {
                                    const u32x2 a = ga[m][bj][n], b = gb[m][bj][n];
                                    f32x4& v = acc[ai][bj][m][n];
                                    v.x *= __uint_as_float(a.x << 16) * __builtin_amdgcn_rcpf(__uint_as_float(b.x << 16));
                                    v.y *= __uint_as_float(a.x & 0xffff0000u) * __builtin_amdgcn_rcpf(__uint_as_float(b.x & 0xffff0000u));
                                    v.z *= __uint_as_float(a.y << 16) * __builtin_amdgcn_rcpf(__uint_as_float(b.y << 16));
                                    v.w *= __uint_as_float(a.y & 0xffff0000u) * __builtin_amdgcn_rcpf(__uint_as_float(b.y & 0xffff0000u));
                                }
                    }
                    asm volatile("s_waitcnt vmcnt(0)" ::: "memory");
                }
            }
            const GAS char* a1 = cA + (size_t)(t + 1) * kstep;
            const GAS char* a2 = last ? nA : cA + (size_t)(t + 2) * kstep; const GAS char* b2 = last ? nB : cB + (size_t)(t + 2) * kstep;
            const GAS char* a3 = a2 + kstep; const GAS char* b3 = b2 + kstep;
            PG8_LDB(B0, 0, 0); PG8_SCHED; PG8_LDA(At, 0, 0); PG8_STAGE2(PG8_SA(1, 1), a1 + hstepA, VC1(0), VC1(1));
            if constexpr (GA) { if (last && has_next) { asm volatile("" ::: "memory"); PG8_GATHER_OFFS(nxt.pm); asm volatile("" ::: "memory"); } }
            PG8_WAIT_L(8); PG8_BAR; PG8_WAIT_L(0); PG8_MMA(0, 0, At, B0); PG8_BAR; PG8_SCHED;
            PG8_LDB(B1, 0, 1); PG8_STAGEB(PG8_SB(0, 0), b2);
            PG8_BAR; PG8_WAIT_L(0); PG8_MMA(0, 1, At, B1); PG8_BAR;
            PG8_LDA(At, 0, 1); PG8_STAGE2(PG8_SA(0, 0), a2, VN0(0), VN0(1));
            PG8_BAR; PG8_WAIT_L(0); PG8_MMA(1, 0, At, B0); PG8_BAR; PG8_SCHED;
            PG8_STAGEB(PG8_SB(0, 1), b2 + hstepB);
            PG8_WAIT_V(6); PG8_BAR; PG8_MMA(1, 1, At, B1); PG8_BAR;
            PG8_LDB(B0, 1, 0); PG8_SCHED; PG8_LDA(At, 1, 0); PG8_STAGE2(PG8_SA(0, 1), a2 + hstepA, VN1(0), VN1(1));
            PG8_WAIT_L(8); PG8_BAR; PG8_WAIT_L(0); PG8_MMA(0, 0, At, B0); PG8_BAR; PG8_SCHED;
            PG8_LDB(B1, 1, 1); PG8_STAGEB(PG8_SB(1, 0), b3);
            PG8_BAR; PG8_WAIT_L(0); PG8_MMA(0, 1, At, B1); PG8_BAR;
            PG8_LDA(At, 1, 1); PG8_STAGE2(PG8_SA(1, 0), a3, VN0(0), VN0(1));
            PG8_BAR; PG8_WAIT_L(0); PG8_MMA(1, 0, At, B0); PG8_BAR; PG8_SCHED;
            PG8_STAGEB(PG8_SB(1, 1), b3 + hstepB);
            PG8_WAIT_V(6); PG8_BAR; PG8_MMA(1, 1, At, B1); PG8_BAR;
        }
        {
            int epm = cur.pm, epn = cur.pn; asm volatile("" : "+s"(epm), "+s"(epn));
            unsigned eln = (unsigned)lane; asm volatile("" : "+v"(eln)); const int efr = (int)(eln & 15u), efq = (int)(eln >> 4);
            f32x4 cv[2][2];
#pragma unroll
            for (int bj = 0; bj < 2; ++bj)
#pragma unroll
                for (int n = 0; n < 2; ++n) { if constexpr (Epi::COLVEC) cv[bj][n] = E.colvec(epm * BM, epn * BM + bj * HALF + wc * 32 + n * 16 + 4 * efq); else cv[bj][n] = (f32x4){0.f, 0.f, 0.f, 0.f}; }
            if constexpr (Epi::COLVEC) asm volatile("" : "+v"(cv[0][0]), "+v"(cv[0][1]), "+v"(cv[1][0]), "+v"(cv[1][1]) :: "memory");
#pragma unroll
            for (int ai = 0; ai < 2; ++ai) {
                f32x4 bs[4][2][2];
                if constexpr (Epi::BASE) {
#pragma unroll
                    for (int m = 0; m < 4; ++m)
#pragma unroll
                        for (int bj = 0; bj < 2; ++bj)
#pragma unroll
                            for (int n = 0; n < 2; ++n) bs[m][bj][n] = E.base(epm * BM + ai * HALF + wr * 64 + m * 16 + efr, epn * BM + bj * HALF + wc * 32 + n * 16 + 4 * efq);
                    asm volatile("" : "+v"(bs[0][0][0]), "+v"(bs[0][0][1]), "+v"(bs[0][1][0]), "+v"(bs[0][1][1]), "+v"(bs[1][0][0]), "+v"(bs[1][0][1]), "+v"(bs[1][1][0]), "+v"(bs[1][1][1]),
                                      "+v"(bs[2][0][0]), "+v"(bs[2][0][1]), "+v"(bs[2][1][0]), "+v"(bs[2][1][1]), "+v"(bs[3][0][0]), "+v"(bs[3][0][1]), "+v"(bs[3][1][0]), "+v"(bs[3][1][1]) :: "memory");
                }
#pragma unroll
                for (int m = 0; m < 4; ++m) {
                    const int row = epm * BM + ai * HALF + wr * 64 + m * 16 + efr;
#pragma unroll
                    for (int bj = 0; bj < 2; ++bj) {
                        if constexpr (Epi::PAIR) E.store_pair(row, epn * (BM / 2) + bj * (HALF / 2) + wc * 16 + 4 * efq, acc[ai][bj][m][0], acc[ai][bj][m][1]);
                        else {
#pragma unroll
                            for (int n = 0; n < 2; ++n) { f32x4 bb = (f32x4){0.f, 0.f, 0.f, 0.f}; if constexpr (Epi::BASE) bb = bs[m][bj][n]; E.store(row, epn * BM + bj * HALF + wc * 32 + n * 16 + 4 * efq, acc[ai][bj][m][n], cv[bj][n], bb); }
                        }
                    }
                }
            }
        }
        if (!has_next) break;
#pragma unroll
        for (int a = 0; a < 2; ++a)
#pragma unroll
            for (int b = 0; b < 2; ++b)
#pragma unroll
                for (int m = 0; m < 4; ++m)
#pragma unroll
                    for (int n = 0; n < 2; ++n) { float zf; asm volatile("v_mov_b32 %0, 0" : "=v"(zf)); acc[a][b][m][n] = (f32x4){zf, zf, zf, zf}; }
        cur = nxt; cB = nB; cA = nA; ++ui;
    }
    PG8_WAIT_V(0);
    if (wr == 0) PG8_BAR;
    PG8_BAR;
#undef PG8_GATHER_OFFS
#undef VC0
#undef VC1
#undef VN0
#undef VN1
#undef PG8_SA
#undef PG8_SB
#undef PG8_STAGE2
#undef PG8_STAGEB
#undef PG8_LDA
#undef PG8_LDB
#undef PG8_MMA
#undef PG8_WAIT_V
#undef PG8_WAIT_L
#undef PG8_BAR
#undef PG8_SCHED
}
}

template <class Epi>
__device__ __forceinline__ void gemm_fast(Frame& F, const GAS bf16* A, int lda, const GAS bf16* Bt, int ldb, int K, int M, int N, const Epi& E) {
    pg8::OrderPlain S; S.init(M / 256, N / 256, F.G, F.wg);
    pg8::gemm_phase(F.lds, A, lda, Bt, ldb, K, S, E);
}
#ifndef FAST_PLAIN
#define FAST_PLAIN 1
#endif
#ifndef FAST_HORNER
#define FAST_HORNER 1
#endif
#ifndef FAST_MOE
#define FAST_MOE 1
#endif

__device__ __forceinline__ void st_bf16x4(GAS bf16* p, f32x4 v) { u32x2 w; w.x = pk2(v.x, v.y); w.y = pk2(v.z, v.w); *(GAS u32x2*)p = w; }
__device__ __forceinline__ f32x4 ld_bf16x4(const GAS bf16* p) { const u32x2 w = *(const GAS u32x2*)p; f32x4 v; v.x = __uint_as_float(w.x << 16); v.y = __uint_as_float(w.x & 0xffff0000u); v.z = __uint_as_float(w.y << 16); v.w = __uint_as_float(w.y & 0xffff0000u); return v; }

struct EpiWin {
    static constexpr bool HORNER = false, PAIR = false, COLVEC = true, BASE = false;
    const GAS float* bias; GAS bf16 *hytl, *hytc, *ret, *ml; GAS float* mlg;
    __device__ __forceinline__ f32x4 colvec(int, int col) const { return *(const GAS f32x4*)(bias + col); }
    __device__ __forceinline__ void store(int row, int col, f32x4 v, f32x4 cv, f32x4) const {
        v += cv;
        if (col < 1152) {
            if (row < TOKL) { const int b = row >> 11, t = row & 2047; GAS bf16* d = hytl + ((size_t)(b * 1152 + col)) * 2048 + t;
                d[0] = (bf16)f2bf(v.x); d[2048] = (bf16)f2bf(v.y); d[4096] = (bf16)f2bf(v.z); d[6144] = (bf16)f2bf(v.w); }
            else { const int r = row - TOKL, b = r >> 8, t = r & 255; GAS bf16* d = hytc + ((size_t)(b * 1152 + col)) * 256 + t;
                d[0] = (bf16)f2bf(v.x); d[256] = (bf16)f2bf(v.y); d[512] = (bf16)f2bf(v.z); d[768] = (bf16)f2bf(v.w); }
        } else if (col < 1168) { *(GAS f32x4*)(mlg + (size_t)row * 16 + (col - 1152)) = v; }
        else if (col < 1280) { }
        else if (col < 2816) st_bf16x4(ret + (size_t)row * 1536 + (col - 1280), v);
        else st_bf16x4(ml + (size_t)row * 1024 + (col - 2816), v);
    }
};
struct EpiGate {
    static constexpr bool HORNER = false, PAIR = false, COLVEC = true, BASE = false;
    const GAS float* bias; GAS bf16* gates;
    __device__ __forceinline__ f32x4 colvec(int, int col) const { return *(const GAS f32x4*)(bias + col); }
    __device__ __forceinline__ void store(int row, int col, f32x4 v, f32x4 cv, f32x4) const {
        v += cv;
        f32x4 g; g.x = fmaxf(sigmoidf_(v.x), 1e-20f); g.y = fmaxf(sigmoidf_(v.y), 1e-20f); g.z = fmaxf(sigmoidf_(v.z), 1e-20f); g.w = fmaxf(sigmoidf_(v.w), 1e-20f);
        st_bf16x4(gates + (size_t)row * NGATE + col, g);
    }
};
struct EpiUp {
    static constexpr bool HORNER = true, PAIR = false, COLVEC = false, BASE = true;
    const GAS bf16* gates; GAS bf16* acc_out;
    __device__ __forceinline__ u32x2 gate(int which, int row, int col) const { return *(const GAS u32x2*)(gates + (size_t)row * NGATE + which * 1024 + col); }
    __device__ __forceinline__ f32x4 base(int row, int col) const { return ld_bf16x4(gates + (size_t)row * NGATE + 2048 + col); }
    __device__ __forceinline__ void store(int row, int col, f32x4 v, f32x4, f32x4 g) const { st_bf16x4(acc_out + (size_t)row * D + col, v * g); }
};
struct EpiResid {
    static constexpr bool HORNER = false, PAIR = false, COLVEC = true, BASE = true;
    const GAS float *xin_l, *xin_c; GAS float *xout_l, *xout_c; const GAS float* modbase; int which;
    __device__ __forceinline__ f32x4 colvec(int row0, int col) const { const int r = row0 < TOKL ? (row0 >> 11) : 16; return *(const GAS f32x4*)(modbase + ((size_t)r * 6 + which) * 1024 + col); }
    __device__ __forceinline__ f32x4 base(int row, int col) const { return row < TOKL ? *(const GAS f32x4*)(xin_l + (size_t)row * D + col) : *(const GAS f32x4*)(xin_c + (size_t)(row - TOKL) * D + col); }
    __device__ __forceinline__ void store(int row, int col, f32x4 v, f32x4 m, f32x4 x) const {
        if (row < TOKL) *(GAS f32x4*)(xout_l + (size_t)row * D + col) = x + m * v;
        else *(GAS f32x4*)(xout_c + (size_t)(row - TOKL) * D + col) = x + m * v;
    }
};
struct EpiSwiglu {
    static constexpr bool HORNER = false, PAIR = true, COLVEC = false, BASE = false;
    GAS bf16* act; int row_off;
    __device__ __forceinline__ void store_pair(int row, int col, f32x4 a, f32x4 b) const {
        f32x4 o; o.x = siluf_(a.x) * b.x; o.y = siluf_(a.y) * b.y; o.z = siluf_(a.z) * b.z; o.w = siluf_(a.w) * b.w;
        st_bf16x4(act + (size_t)(row - row_off) * DFF + col, o);
    }
    __device__ __forceinline__ void store(int, int, f32x4, f32x4, f32x4) const {}
};
struct EpiBf16Out {
    static constexpr bool HORNER = false, PAIR = false, COLVEC = false, BASE = false;
    GAS bf16* out; int ld; int row_add;
    __device__ __forceinline__ void store(int row, int col, f32x4 v, f32x4, f32x4) const { st_bf16x4(out + (size_t)(row + row_add) * ld + col, v); }
    __device__ __forceinline__ void store_pair(int, int, f32x4, f32x4) const {}
};

constexpr int ZPITCH_L = (LL + 8) * 2, ZPITCH_C = (LC + 8) * 2;
template <int L>
__device__ __forceinline__ float conv3_at(const GAS bf16* base  , int t, float w0, float w1, float w2) {
    const float a = t > 0 ? bf2f(base[t - 1]) : 0.f, b = bf2f(base[t]), c = t < L - 1 ? bf2f(base[t + 1]) : 0.f;
    return w0 * a + w1 * b + w2 * c;
}
template <int L>
__device__ __forceinline__ void hyena_unit_naive(Frame& F, int layer, int c, const GAS bf16* hyt  , const GAS bf16* ft  , GAS bf16* yht  ) {
    constexpr int ZP = (L + 8) * 2;
    constexpr int PER = L / 32;
    constexpr int SUB = 8;
    LAS unsigned char* zimg0 = F.lds;
    LAS unsigned char* zimg1 = F.lds + 16 * ZP;
    LAS bf16* tf = (LAS bf16*)(F.lds + 32 * ZP);
    const GAS float* cw = inp(F, I_HYCONV) + layer * 3 * 1152;
    const GAS float* skip = inp(F, I_HYSKIP) + layer * 2 * 384;
    __syncthreads();
    {
        const int b = F.tid >> 5, seg = F.tid & 31; const GAS bf16* src = hyt + ((size_t)(b * 1152 + c)) * L;
        const float w0 = cw[c], w1 = cw[1152 + c], w2 = cw[2304 + c];
#pragma unroll 2
        for (int j = 0; j < PER; ++j) { const int t = seg * PER + j; *(LAS bf16*)(zimg0 + b * ZP + t * 2) = (bf16)f2bf(conv3_at<L>(src, t, w0, w1, w2)); }
    }
#pragma unroll 1
    for (int o = 0; o < 2; ++o) {
        LAS unsigned char* zs = o == 0 ? zimg0 : zimg1;
        LAS unsigned char* zd = o == 0 ? zimg1 : zimg0;
        const GAS bf16* fsrc = ft + ((size_t)(o * 384 + c)) * (2 * L);
        for (int i = F.tid; i < 2 * L; i += NTHR) tf[i] = i == 0 ? (bf16)0 : fsrc[i];
        __syncthreads();
        const int b = F.tid & 15, tg = F.tid >> 4;
        const int gcol = (o == 0 ? 384 : 768) + c;
        const GAS bf16* gsrc = hyt + ((size_t)(b * 1152 + gcol)) * L;
        const float w0 = cw[gcol], w1 = cw[1152 + gcol], w2 = cw[2304 + gcol], sk = skip[o * 384 + c];
#pragma unroll 1
        for (int sb = 0; sb < PER / SUB; ++sb) {
            const int t0 = tg * PER + sb * SUB;
            float acc[SUB];
#pragma unroll
            for (int j = 0; j < SUB; ++j) acc[j] = 0.f;
#pragma unroll 1
            for (int s0 = 0; s0 < L; s0 += 8) {
                float z[8];
                { const bf16x8 zz = *(const LAS bf16x8*)(zs + b * ZP + s0 * 2);
#pragma unroll
                  for (int i = 0; i < 8; ++i) z[i] = bf2f((bf16)zz[i]); }
                float win[SUB + 7];
                const int wb = L + s0 - t0 - (SUB - 1);
#pragma unroll
                for (int i = 0; i < SUB + 7; ++i) win[i] = bf2f(tf[wb + i]);
#pragma unroll
                for (int j = 0; j < SUB; ++j)
#pragma unroll
                    for (int i = 0; i < 8; ++i) acc[j] += win[(SUB - 1) - j + i] * z[i];
            }
#pragma unroll
            for (int j = 0; j < SUB; ++j) {
                const int t = t0 + j;
                const float zt = bf2f(*(LAS bf16*)(zs + b * ZP + t * 2));
                const float ov = conv3_at<L>(gsrc, t, w0, w1, w2) * (acc[j] + sk * zt);
                *(LAS bf16*)(zd + b * ZP + t * 2) = (bf16)f2bf(ov);
            }
        }
        __syncthreads();
    }
#pragma unroll 2
    for (int i = F.tid; i < 16 * (L / 8); i += NTHR) {
        const int b = i / (L / 8), ch = i % (L / 8);
        *(GAS u32x4*)(yht + ((size_t)(b * 384 + c)) * L + ch * 8) = *(const LAS u32x4*)(zimg0 + b * ZP + ch * 16);
    }
}

template <int L>
__device__ __forceinline__ void hyena_unit_fast(Frame& F, int layer, int c, const GAS bf16* hyt  , const GAS bf16* ft  , GAS bf16* yht  ) {
    constexpr int ZP = (L + 8) * 2;
    constexpr int PER = L / 32;
    constexpr int I = L / 128;
    constexpr int SPAN = L / 4, NSTEP = L / 32;
    LAS unsigned char* zimg0 = F.lds;
    LAS unsigned char* zimg1 = F.lds + 16 * ZP;
    LAS bf16* tf = (LAS bf16*)(F.lds + 32 * ZP);
    const GAS float* cw = inp(F, I_HYCONV) + layer * 3 * 1152;
    const GAS float* skip = inp(F, I_HYSKIP) + layer * 2 * 384;
    const int lane = F.lane, fr = lane & 15, fq = lane >> 4, w = F.wave;
    __syncthreads();
    {
        const int b = F.tid >> 5, sg = F.tid & 31, t0 = sg * PER; const GAS bf16* src = hyt + ((size_t)(b * 1152 + c)) * L + t0;
        const float w0 = cw[c], w1 = cw[1152 + c], w2 = cw[2304 + c];
        u32x4 raw[PER / 8];
#pragma unroll
        for (int j = 0; j < PER / 8; ++j) raw[j] = *(const GAS u32x4*)(src + 8 * j);
        float prev = t0 > 0 ? bf2f(src[-1]) : 0.f;
        const float nextv = t0 + PER < L ? bf2f(src[PER]) : 0.f;
#pragma unroll
        for (int j = 0; j < PER / 8; ++j) {
            const unsigned wv[4] = {raw[j].x, raw[j].y, raw[j].z, raw[j].w};
            float x[10]; x[0] = prev;
#pragma unroll
            for (int q = 0; q < 4; ++q) { x[1 + 2 * q] = __uint_as_float(wv[q] << 16); x[2 + 2 * q] = __uint_as_float(wv[q] & 0xffff0000u); }
            if (j + 1 < PER / 8) x[9] = __uint_as_float(raw[(j + 1 < PER / 8) ? j + 1 : j].x << 16); else x[9] = nextv;
            u32x4 o;
            o.x = pk2(w0 * x[0] + w1 * x[1] + w2 * x[2], w0 * x[1] + w1 * x[2] + w2 * x[3]); o.y = pk2(w0 * x[2] + w1 * x[3] + w2 * x[4], w0 * x[3] + w1 * x[4] + w2 * x[5]);
            o.z = pk2(w0 * x[4] + w1 * x[5] + w2 * x[6], w0 * x[5] + w1 * x[6] + w2 * x[7]); o.w = pk2(w0 * x[6] + w1 * x[7] + w2 * x[8], w0 * x[7] + w1 * x[8] + w2 * x[9]);
            *(LAS u32x4*)(zimg0 + b * ZP + (t0 + 8 * j) * 2) = o;
            prev = x[8];
        }
    }
    const int tbase = SPAN * (w >> 1) + 16 * (w & 1);
    const int flane = L - tbase + 8 * fq - fr;
#pragma unroll 1
    for (int o = 0; o < 2; ++o) {
        LAS unsigned char* zs = o == 0 ? zimg0 : zimg1;
        LAS unsigned char* zd = o == 0 ? zimg1 : zimg0;
        const GAS bf16* fsrc = ft + ((size_t)(o * 384 + c)) * (2 * L);
        for (int i = F.tid; i < 2 * L; i += NTHR) tf[i] = i == 0 ? (bf16)0 : fsrc[i];
        __syncthreads();
        f32x4 acc[I];
#pragma unroll
        for (int i = 0; i < I; ++i) acc[i] = (f32x4){0.f, 0.f, 0.f, 0.f};
        bf16x8 ring[I];
#pragma unroll
        for (int i = 1; i < I; ++i) __builtin_memcpy(&ring[(I - i) % I], (const LAS unsigned char*)tf + 2 * (flane - 32 * i), 16);
        const LAS unsigned char* zrow = zs + fr * ZP + 16 * fq;
#pragma unroll 1
        for (int j0 = 0; j0 < NSTEP; j0 += I) {
#pragma unroll
            for (int jj = 0; jj < I; ++jj) {
                const int j = j0 + jj;
                __builtin_memcpy(&ring[jj], (const LAS unsigned char*)tf + 2 * (flane + 32 * j), 16);
                const bf16x8 zf = *(const LAS bf16x8*)(zrow + 64 * j);
#pragma unroll
                for (int i = 0; i < I; ++i) acc[i] = __builtin_amdgcn_mfma_f32_16x16x32_bf16(ring[(jj - i + I) % I], zf, acc[i], 0, 0, 0);
            }
        }
        const int gcol = (o == 0 ? 384 : 768) + c;
        const GAS bf16* gsrc = hyt + ((size_t)(fr * 1152 + gcol)) * L;
        const float w0 = cw[gcol], w1 = cw[1152 + gcol], w2 = cw[2304 + gcol], sk = skip[o * 384 + c];
        GAS bf16* dst = yht + ((size_t)(fr * 384 + c)) * L;
        u32x2 grv[I]; unsigned short gmv[I], gpv[I];
#pragma unroll
        for (int i = 0; i < I; ++i) {
            const int t = tbase + 32 * i + 4 * fq;
            grv[i] = *(const GAS u32x2*)(gsrc + t); gmv[i] = t > 0 ? gsrc[t - 1] : (unsigned short)0; gpv[i] = t + 4 < L ? gsrc[t + 4] : (unsigned short)0;
        }
#pragma unroll
        for (int i = 0; i < I; ++i) {
            const int t = tbase + 32 * i + 4 * fq;
            const u32x2 zr = *(const LAS u32x2*)(zs + fr * ZP + t * 2);
            const u32x2 gr = grv[i];
            const float gm = bf2f(gmv[i]), gp = bf2f(gpv[i]);
            const float g0 = __uint_as_float(gr.x << 16), g1 = __uint_as_float(gr.x & 0xffff0000u), g2 = __uint_as_float(gr.y << 16), g3 = __uint_as_float(gr.y & 0xffff0000u);
            const float z0 = __uint_as_float(zr.x << 16), z1 = __uint_as_float(zr.x & 0xffff0000u), z2 = __uint_as_float(zr.y << 16), z3 = __uint_as_float(zr.y & 0xffff0000u);
            const float o0 = (w0 * gm + w1 * g0 + w2 * g1) * (acc[i].x + sk * z0), o1 = (w0 * g0 + w1 * g1 + w2 * g2) * (acc[i].y + sk * z1);
            const float o2 = (w0 * g1 + w1 * g2 + w2 * g3) * (acc[i].z + sk * z2), o3 = (w0 * g2 + w1 * g3 + w2 * gp) * (acc[i].w + sk * z3);
            u32x2 ov; ov.x = pk2(o0, o1); ov.y = pk2(o2, o3);
            if (o == 0) *(LAS u32x2*)(zd + fr * ZP + t * 2) = ov;
            else *(GAS u32x2*)(dst + t) = ov;
        }
        __syncthreads();
    }
}

__device__ __forceinline__ void chain_naive(Frame& F, int layer, int chain) {
    const int lane = F.lane;
    const bool is_ret = chain < 192;
    int b, h, dir;
    if (is_ret) { b = chain / 12; const int r = chain % 12; h = r >> 1; dir = r & 1; }
    else { const int i = chain - 192; b = i >> 3; h = (i & 7) >> 1; dir = i & 1; }
    const GAS bf16* RET = WSP(const bf16, WS_RET); const GAS bf16* ML = WSP(const bf16, WS_ML); const GAS float* MLG = WSP(const float, WS_MLG);
    const GAS float* rope = WSP(const float, WS_ROPE);
    GAS bf16* Y = WSP(bf16, WS_Y); GAS bf16* OB = WSP(bf16, WS_OB);
    float gam = 0.f;
    if (is_ret) gam = sigmoidf_(inp(F, I_RETDECAY)[layer * 12 + dir * 6 + h]);
    const GAS float* mlc = inp(F, I_MLCONV) + layer * 3 * 512;
    const float bi = is_ret ? 0.f : inp(F, I_MLGB)[layer * 16 + dir * 8 + h], bfg = is_ret ? 0.f : inp(F, I_MLGB)[layer * 16 + dir * 8 + 4 + h];
    const float qw0 = mlc[h * 64 + lane], qw1 = mlc[512 + h * 64 + lane], qw2 = mlc[1024 + h * 64 + lane];
    const float kw0 = mlc[256 + h * 64 + lane], kw1 = mlc[512 + 256 + h * 64 + lane], kw2 = mlc[1024 + 256 + h * 64 + lane];
    float S[64];
#pragma unroll
    for (int d = 0; d < 64; ++d) S[d] = 0.f;
    float nv = 0.f;
    for (int step = 0; step < LC + LL; ++step) {
        int row, tpos, L; bool lat;
        if (step < LC) { tpos = dir ? (LC - 1 - step) : step; row = TOKL + b * LC + tpos; L = LC; lat = false; }
        else { const int s2 = step - LC; tpos = dir ? (LL - 1 - s2) : s2; row = b * LL + tpos; L = LL; lat = true; }
        float q, k, v, Fm, Im;
        if (is_ret) {
            const GAS bf16* base = RET + (size_t)row * 1536;
            float qs = bf2f(base[h * 64 + lane]), ks = bf2f(base[384 + h * 64 + lane]);
            v = bf2f(base[768 + h * 64 + lane]);
            if (lat) {
                const float qp = bf2f(base[h * 64 + (lane ^ 16)]), kp = bf2f(base[384 + h * 64 + (lane ^ 16)]);
                const int half = lane >> 5, ii = lane & 15, hi = (lane >> 4) & 1;
                const float cs = rope[tpos * 64 + half * 32 + ii], sn = rope[tpos * 64 + half * 32 + 16 + ii];
                q = hi == 0 ? qs * cs - qp * sn : qp * sn + qs * cs;
                k = hi == 0 ? ks * cs - kp * sn : kp * sn + ks * cs;
            } else { q = qs; k = ks; }
            q *= 0.125f; Fm = gam; Im = 1.f;
        } else {
            const GAS bf16* base = ML + (size_t)row * 1024;
            const float q0 = tpos > 0 ? bf2f(base[-1024 + h * 64 + lane]) : 0.f, q1 = bf2f(base[h * 64 + lane]), q2 = tpos < L - 1 ? bf2f(base[1024 + h * 64 + lane]) : 0.f;
            const float k0 = tpos > 0 ? bf2f(base[-1024 + 256 + h * 64 + lane]) : 0.f, k1 = bf2f(base[256 + h * 64 + lane]), k2 = tpos < L - 1 ? bf2f(base[1024 + 256 + h * 64 + lane]) : 0.f;
            q = siluf_(qw0 * q0 + qw1 * q1 + qw2 * q2);
            k = siluf_(kw0 * k0 + kw1 * k1 + kw2 * k2) * 0.125f;
            v = bf2f(base[512 + h * 64 + lane]);
            const float ig = MLG[(size_t)row * 16 + dir * 8 + h] + bi, fg = MLG[(size_t)row * 16 + dir * 8 + 4 + h] + bfg;
            Fm = sigmoidf_(fg); Im = __expf(ig);
        }
        float num = 0.f;
        const float iv = Im * v;
#pragma unroll
        for (int d = 0; d < 64; ++d) {
            const float kd = __int_as_float(__builtin_amdgcn_readlane(__float_as_int(k), d));
            const float qd = __int_as_float(__builtin_amdgcn_readlane(__float_as_int(q), d));
            S[d] = Fm * S[d] + kd * iv;
            num += qd * S[d];
        }
        float o = num;
        if (!is_ret) { nv = Fm * nv + Im * k; const float den = wave_sum(q * nv); o = num / fmaxf(fabsf(den), 1.f); }
        const int cof = is_ret ? (h * 64 + lane) : (384 + h * 64 + lane);
        if (dir == 0) Y[(size_t)row * D + 384 + cof] = (bf16)f2bf(o);
        else OB[(size_t)row * 640 + cof] = (bf16)f2bf(o);
    }
}

constexpr int CH_PITCH = 144;
constexpr int CH_IMG = 64 * CH_PITCH;
constexpr int CH_WAVE_LDS = 3 * CH_IMG + 1024 + 512;
__device__ __forceinline__ void ds_tr16x8(unsigned addr, u32x2 (&lo)[4], u32x2 (&hi)[4]) {
    asm volatile("ds_read_b64_tr_b16 %0, %8\n\tds_read_b64_tr_b16 %1, %8 offset:32\n\tds_read_b64_tr_b16 %2, %8 offset:64\n\tds_read_b64_tr_b16 %3, %8 offset:96\n\t"
                 "ds_read_b64_tr_b16 %4, %8 offset:2304\n\tds_read_b64_tr_b16 %5, %8 offset:2336\n\tds_read_b64_tr_b16 %6, %8 offset:2368\n\tds_read_b64_tr_b16 %7, %8 offset:2400\n\t"
                 "s_waitcnt lgkmcnt(0)"
                 : "=&v"(lo[0]), "=&v"(lo[1]), "=&v"(lo[2]), "=&v"(lo[3]), "=&v"(hi[0]), "=&v"(hi[1]), "=&v"(hi[2]), "=&v"(hi[3]) : "v"(addr) : "memory");
}
static_assert(16 * CH_PITCH == 2304, "ds_tr16x8 offsets");
__device__ __forceinline__ void ds_tr16x4(unsigned addr, u32x2 (&lo)[2], u32x2 (&hi)[2]) {
    asm volatile("ds_read_b64_tr_b16 %0, %4\n\tds_read_b64_tr_b16 %1, %4 offset:32\n\tds_read_b64_tr_b16 %2, %4 offset:2304\n\tds_read_b64_tr_b16 %3, %4 offset:2336\n\ts_waitcnt lgkmcnt(0)"
                 : "=&v"(lo[0]), "=&v"(lo[1]), "=&v"(hi[0]), "=&v"(hi[1]) : "v"(addr) : "memory");
}
__device__ __forceinline__ float log_sigmoid_(float x) { return fminf(x, 0.f) - log1pf(__expf(-fabsf(x))); }
__device__ __forceinline__ bf16x8 mk_frag(u32x2 lo, u32x2 hi) { u32x4 w; w.x = lo.x; w.y = lo.y; w.z = hi.x; w.w = hi.y; return __builtin_bit_cast(bf16x8, w); }

template <bool IS_ML>
__device__ __forceinline__ void chain_fast(Frame& F, int layer, int b, int h, int dir, LAS unsigned char* img, int hf) {
    constexpr int NET = 2;
    const int lane = F.lane, fr = lane & 15, fq = lane >> 4;
    LAS unsigned char* Qi = img; LAS unsigned char* Ki = img + CH_IMG; LAS unsigned char* Vi = img + 2 * CH_IMG;
    const unsigned qa = (unsigned)(size_t)Qi, ka = (unsigned)(size_t)Ki, va = (unsigned)(size_t)Vi;
    const GAS bf16* RET = WSP(const bf16, WS_RET); const GAS bf16* ML = WSP(const bf16, WS_ML); const GAS float* MLG = WSP(const float, WS_MLG);
    const GAS float* rope = WSP(const float, WS_ROPE);
    GAS bf16* Y = WSP(bf16, WS_Y); GAS bf16* OB = WSP(bf16, WS_OB);
    float lgam = 0.f, bi_ = 0.f, bf_ = 0.f;
    if (!IS_ML) lgam = log_sigmoid_(inp(F, I_RETDECAY)[layer * 12 + dir * 6 + h]);
    else { bi_ = inp(F, I_MLGB)[layer * 16 + dir * 8 + h]; bf_ = inp(F, I_MLGB)[layer * 16 + dir * 8 + 4 + h]; }
    const GAS float* mlc = inp(F, I_MLCONV) + layer * 3 * 512;
    f32x4 C[4][NET];
#pragma unroll
    for (int dt = 0; dt < 4; ++dt)
#pragma unroll
        for (int et = 0; et < NET; ++et) C[dt][et] = (f32x4){0.f, 0.f, 0.f, 0.f};
    const int cq = lane & 7, pr0 = lane >> 3;
    LAS float* nvec = (LAS float*)(img + 3 * CH_IMG + 1024 + 256 * hf);
    if (IS_ML) nvec[lane] = 0.f;
    const LAS float* nq = nvec + 4 * fq;
#ifndef REP_CH
#define REP_CH 1
#endif
#pragma unroll 1
    for (int step_ = 0; step_ < 36 * REP_CH; ++step_) {
        const int step = step_ % 36;
        if (REP_CH > 1 && step == 0) {
            if (IS_ML) nvec[lane] = 0.f;
#pragma unroll
            for (int dt = 0; dt < 4; ++dt)
#pragma unroll
                for (int et = 0; et < NET; ++et) C[dt][et] = (f32x4){0.f, 0.f, 0.f, 0.f};
        }
        int rowbase, t0, L; bool lat;
        if (step < 4) { const int cc = dir ? 3 - step : step; rowbase = TOKL + b * LC + cc * 64; t0 = cc * 64; L = LC; lat = false; }
        else { const int cc = dir ? 35 - step : step - 4; rowbase = b * LL + cc * 64; t0 = cc * 64; L = LL; lat = true; }
        if constexpr (!IS_ML) {
#pragma unroll
        for (int i4 = 0; i4 < 4; ++i4) {
            const int i = 4 * hf + i4;
            const int p = pr0 + 8 * i, tl = dir ? 63 - p : p, row = rowbase + tl, tpos = t0 + tl;
            float qv[8], kv[8]; u32x4 vraw;
            {
                const GAS bf16* base = RET + (size_t)row * 1536 + h * 64;
                const u32x4 qr = *(const GAS u32x4*)(base + 8 * cq), kr = *(const GAS u32x4*)(base + 384 + 8 * cq); vraw = *(const GAS u32x4*)(base + 768 + 8 * cq);
                const unsigned qw[4] = {qr.x, qr.y, qr.z, qr.w}, kw[4] = {kr.x, kr.y, kr.z, kr.w};
#pragma unroll
                for (int j = 0; j < 4; ++j) { qv[2 * j] = __uint_as_float(qw[j] << 16); qv[2 * j + 1] = __uint_as_float(qw[j] & 0xffff0000u); kv[2 * j] = __uint_as_float(kw[j] << 16); kv[2 * j + 1] = __uint_as_float(kw[j] & 0xffff0000u); }
                if (lat) {
                    const u32x4 qpr = *(const GAS u32x4*)(base + 8 * (cq ^ 2)), kpr = *(const GAS u32x4*)(base + 384 + 8 * (cq ^ 2));
                    const unsigned qpw[4] = {qpr.x, qpr.y, qpr.z, qpr.w}, kpw[4] = {kpr.x, kpr.y, kpr.z, kpr.w};
                    const int half = cq >> 2, hi = (cq >> 1) & 1, i0 = 8 * (cq & 1);
                    const GAS float* rp = rope + tpos * 64 + half * 32 + i0;
                    const f32x4 c0 = *(const GAS f32x4*)(rp), c1 = *(const GAS f32x4*)(rp + 4), s0 = *(const GAS f32x4*)(rp + 16), s1 = *(const GAS f32x4*)(rp + 20);
                    const float cs[8] = {c0.x, c0.y, c0.z, c0.w, c1.x, c1.y, c1.z, c1.w}, sn[8] = {s0.x, s0.y, s0.z, s0.w, s1.x, s1.y, s1.z, s1.w};
#pragma unroll
                    for (int j = 0; j < 8; ++j) {
                        const float qp = (j & 1) ? __uint_as_float(qpw[j >> 1] & 0xffff0000u) : __uint_as_float(qpw[j >> 1] << 16);
                        const float kp = (j & 1) ? __uint_as_float(kpw[j >> 1] & 0xffff0000u) : __uint_as_float(kpw[j >> 1] << 16);
                        qv[j] = hi ? qp * sn[j] + qv[j] * cs[j] : qv[j] * cs[j] - qp * sn[j];
                        kv[j] = hi ? kp * sn[j] + kv[j] * cs[j] : kv[j] * cs[j] - kp * sn[j];
                    }
                }
#pragma unroll
                for (int j = 0; j < 8; ++j) qv[j] *= 0.125f;
            }
            u32x4 qo, ko; qo.x = pk2(qv[0], qv[1]); qo.y = pk2(qv[2], qv[3]); qo.z = pk2(qv[4], qv[5]); qo.w = pk2(qv[6], qv[7]);
            ko.x = pk2(kv[0], kv[1]); ko.y = pk2(kv[2], kv[3]); ko.z = pk2(kv[4], kv[5]); ko.w = pk2(kv[6], kv[7]);
            *(LAS u32x4*)(Qi + p * CH_PITCH + 16 * cq) = qo; *(LAS u32x4*)(Ki + p * CH_PITCH + 16 * cq) = ko; *(LAS u32x4*)(Vi + p * CH_PITCH + 16 * cq) = vraw;
        }
        } else {
            const GAS float* wq = mlc + h * 64 + 8 * cq;
#pragma unroll
            for (int qk = 0; qk < 2; ++qk) {
                u32x4 r0[4], r1[4], r2[4], vr[4];
                f32x4 wt[3][2];
#pragma unroll
                for (int tp = 0; tp < 3; ++tp) { wt[tp][0] = *(const GAS f32x4*)(wq + 256 * qk + 512 * tp); wt[tp][1] = *(const GAS f32x4*)(wq + 256 * qk + 512 * tp + 4); }
#pragma unroll
                for (int i4 = 0; i4 < 4; ++i4) {
                    const int p = pr0 + 8 * (4 * hf + i4), tl = dir ? 63 - p : p, row = rowbase + tl, tpos = t0 + tl;
                    const GAS bf16* bb = ML + (size_t)row * 1024 + h * 64 + 8 * cq + 256 * qk;
                    const u32x4 z4 = (u32x4){0u, 0u, 0u, 0u};
                    r1[i4] = *(const GAS u32x4*)(bb); r0[i4] = tpos > 0 ? *(const GAS u32x4*)(bb - 1024) : z4; r2[i4] = tpos < L - 1 ? *(const GAS u32x4*)(bb + 1024) : z4;
                    if (qk == 1) vr[i4] = *(const GAS u32x4*)(bb + 256);
                }
#pragma unroll
                for (int i4 = 0; i4 < 4; ++i4) {
                    const int p = pr0 + 8 * (4 * hf + i4);
                    const unsigned a0[4] = {r0[i4].x, r0[i4].y, r0[i4].z, r0[i4].w}, a1[4] = {r1[i4].x, r1[i4].y, r1[i4].z, r1[i4].w}, a2[4] = {r2[i4].x, r2[i4].y, r2[i4].z, r2[i4].w};
                    float ov[8];
#pragma unroll
                    for (int j = 0; j < 8; ++j) {
                        const float x0 = (j & 1) ? __uint_as_float(a0[j >> 1] & 0xffff0000u) : __uint_as_float(a0[j >> 1] << 16);
                        const float x1 = (j & 1) ? __uint_as_float(a1[j >> 1] & 0xffff0000u) : __uint_as_float(a1[j >> 1] << 16);
                        const float x2 = (j & 1) ? __uint_as_float(a2[j >> 1] & 0xffff0000u) : __uint_as_float(a2[j >> 1] << 16);
                        const float r = siluf_(wt[0][j >> 2][j & 3] * x0 + wt[1][j >> 2][j & 3] * x1 + wt[2][j >> 2][j & 3] * x2);
                        ov[j] = qk == 0 ? r : r * 0.125f;
                    }
                    u32x4 o; o.x = pk2(ov[0], ov[1]); o.y = pk2(ov[2], ov[3]); o.z = pk2(ov[4], ov[5]); o.w = pk2(ov[6], ov[7]);
                    if (qk == 0) *(LAS u32x4*)(Qi + p * CH_PITCH + 16 * cq) = o;
                    else { *(LAS u32x4*)(Ki + p * CH_PITCH + 16 * cq) = o; *(LAS u32x4*)(Vi + p * CH_PITCH + 16 * cq) = vr[i4]; }
                }
                asm volatile("" ::: "memory");
            }
        }
        __builtin_amdgcn_sched_barrier(0);
        float f_p, i_p;
        { const int tl = dir ? 63 - lane : lane, row = rowbase + tl;
          if (!IS_ML) { f_p = lgam; i_p = 0.f; }
          else { i_p = MLG[(size_t)row * 16 + dir * 8 + h] + bi_; f_p = log_sigmoid_(MLG[(size_t)row * 16 + dir * 8 + 4 + h] + bf_); } }
        float bsum = f_p;
#pragma unroll
        for (int o = 1; o < 64; o <<= 1) { const float t = __shfl_up(bsum, o); if (lane >= o) bsum += t; }
        LAS float* gv = (LAS float*)(img + 3 * CH_IMG);
        const float b63 = __shfl(bsum, 63);
        const float adec = __expf(b63);
        if (hf == 0) { gv[lane] = bsum; gv[64 + lane] = bsum - i_p; gv[128 + lane] = __expf(bsum); gv[192 + lane] = __expf(b63 - (bsum - i_p)); }
        asm volatile("s_waitcnt lgkmcnt(0)" ::: "memory");
        __syncthreads();
        const LAS float* gq = gv + 4 * fq;
        const bf16x8 ones = (fr == 0) ? (bf16x8){0x3F80, 0x3F80, 0x3F80, 0x3F80, 0x3F80, 0x3F80, 0x3F80, 0x3F80} : (bf16x8){0, 0, 0, 0, 0, 0, 0, 0};
        const int tr_q = fr >> 2, tr_p = fr & 3;
#pragma unroll 1
        for (int pt = 0; pt < 4; ++pt) {
            f32x4 ST[4];
            bf16x8 qn[2];
#pragma unroll
            for (int kk = 0; kk < 2; ++kk) qn[kk] = *(const LAS bf16x8*)(Qi + (16 * pt + fr) * CH_PITCH + (32 * kk + 8 * fq) * 2);
#pragma unroll
            for (int st = 0; st < 4; ++st) {
                ST[st] = (f32x4){0.f, 0.f, 0.f, 0.f};
                if (st <= pt) {
#pragma unroll
                    for (int kk = 0; kk < 2; ++kk) { const bf16x8 kf = *(const LAS bf16x8*)(Ki + (16 * st + fr) * CH_PITCH + (32 * kk + 8 * fq) * 2); ST[st] = __builtin_amdgcn_mfma_f32_16x16x32_bf16(kf, qn[kk], ST[st], 0, 0, 0); }
                }
            }
            const float bp = gv[16 * pt + fr];
#pragma unroll
            for (int st = 0; st < 4; ++st) {
                if (st <= pt) {
                    const f32x4 bis = *(const LAS f32x4*)(gq + 64 + 16 * st);
#pragma unroll
                    for (int j = 0; j < 4; ++j) { const int sidx = 16 * st + 4 * fq + j; const float w = (sidx <= 16 * pt + fr) ? __expf(bp - bis[j]) : 0.f; ST[st][j] *= w; }
                }
            }
            __builtin_amdgcn_sched_barrier(0);
            f32x4 acc[NET], accd = (f32x4){0.f, 0.f, 0.f, 0.f};
#pragma unroll
            for (int et = 0; et < NET; ++et) acc[et] = (f32x4){0.f, 0.f, 0.f, 0.f};
#pragma unroll
            for (int kk = 0; kk < 2; ++kk) {
                const u32x2 lo = *(const LAS u32x2*)(Qi + (16 * pt + fr) * CH_PITCH + (32 * kk + 4 * fq) * 2), hi = *(const LAS u32x2*)(Qi + (16 * pt + fr) * CH_PITCH + (32 * kk + 16 + 4 * fq) * 2);
                const bf16x8 qs = mk_frag(lo, hi);
#pragma unroll
                for (int et = 0; et < NET; ++et) {
                    u32x4 w; w.x = pk2(C[2 * kk][et].x, C[2 * kk][et].y); w.y = pk2(C[2 * kk][et].z, C[2 * kk][et].w); w.z = pk2(C[2 * kk + 1][et].x, C[2 * kk + 1][et].y); w.w = pk2(C[2 * kk + 1][et].z, C[2 * kk + 1][et].w);
                    acc[et] = __builtin_amdgcn_mfma_f32_16x16x32_bf16(qs, __builtin_bit_cast(bf16x8, w), acc[et], 0, 0, 0);
                }
                if (IS_ML) {
                    const f32x4 n0 = *(const LAS f32x4*)(nq + 32 * kk), n1 = *(const LAS f32x4*)(nq + 32 * kk + 16);
                    u32x4 w; w.x = pk2(n0.x, n0.y); w.y = pk2(n0.z, n0.w); w.z = pk2(n1.x, n1.y); w.w = pk2(n1.z, n1.w);
                    if (fr != 0) w = (u32x4){0u, 0u, 0u, 0u};
                    accd = __builtin_amdgcn_mfma_f32_16x16x32_bf16(qs, __builtin_bit_cast(bf16x8, w), accd, 0, 0, 0);
                }
            }
            { const f32x4 ap = *(const LAS f32x4*)(gq + 128 + 16 * pt);
#pragma unroll
              for (int j = 0; j < 4; ++j) {
#pragma unroll
                for (int et = 0; et < NET; ++et) acc[et][j] *= ap[j];
                accd[j] *= ap[j]; } }
            __builtin_amdgcn_sched_barrier(0);
#pragma unroll
            for (int kk = 0; kk < 2; ++kk) {
                if (2 * kk <= pt) {
                    u32x4 w; w.x = pk2(ST[2 * kk].x, ST[2 * kk].y); w.y = pk2(ST[2 * kk].z, ST[2 * kk].w); w.z = pk2(ST[2 * kk + 1].x, ST[2 * kk + 1].y); w.w = pk2(ST[2 * kk + 1].z, ST[2 * kk + 1].w);
                    const bf16x8 pf = __builtin_bit_cast(bf16x8, w);
                    u32x2 vlo[2], vhi[2];
                    ds_tr16x4(va + (32 * kk + 4 * fq + tr_q) * CH_PITCH + 8 * tr_p + 64 * hf, vlo, vhi);
#pragma unroll
                    for (int et = 0; et < NET; ++et) acc[et] = __builtin_amdgcn_mfma_f32_16x16x32_bf16(pf, mk_frag(vlo[et], vhi[et]), acc[et], 0, 0, 0);
                    if (IS_ML) accd = __builtin_amdgcn_mfma_f32_16x16x32_bf16(pf, ones, accd, 0, 0, 0);
                }
            }
            __builtin_amdgcn_sched_barrier(0);
#pragma unroll
            for (int j = 0; j < 4; ++j) {
                const int p = 16 * pt + 4 * fq + j, tl = dir ? 63 - p : p, row = rowbase + tl;
                float inv = 1.f;
                if (IS_ML) { const float den = __shfl(accd[j], lane & 48); inv = __builtin_amdgcn_rcpf(fmaxf(fabsf(den), 1.f)); }
                const int cof = (IS_ML ? 384 : 0) + h * 64 + 32 * hf + fr;
                const unsigned boff = dir == 0 ? (unsigned)(row * D + 384 + cof) * 2u : (unsigned)(row * 640 + cof) * 2u;
                GAS char* ob = dir == 0 ? (GAS char*)Y : (GAS char*)OB;
#pragma unroll
                for (int et = 0; et < NET; ++et) *(GAS bf16*)(ob + boff + 32 * et) = (bf16)f2bf(acc[et][j] * inv);
            }
        }
        __builtin_amdgcn_sched_barrier(0);
#pragma unroll
        for (int dt = 0; dt < 4; ++dt)
#pragma unroll
            for (int et = 0; et < NET; ++et) C[dt][et] *= adec;
        f32x4 accn[4];
        if (IS_ML) {
#pragma unroll
            for (int dt = 0; dt < 4; ++dt) { accn[dt] = *(const LAS f32x4*)(nq + 16 * dt) * adec; if (fr != 0) accn[dt] = (f32x4){0.f, 0.f, 0.f, 0.f}; }
        }
#pragma unroll
        for (int kk = 0; kk < 2; ++kk) {
            u32x2 vlo[2], vhi[2], klo[4], khi[4];
            ds_tr16x4(va + (32 * kk + 4 * fq + tr_q) * CH_PITCH + 8 * tr_p + 64 * hf, vlo, vhi);
            ds_tr16x8(ka + (32 * kk + 4 * fq + tr_q) * CH_PITCH + 8 * tr_p, klo, khi);
            const f32x4 wl = *(const LAS f32x4*)(gq + 192 + 32 * kk), wh = *(const LAS f32x4*)(gq + 192 + 32 * kk + 16);
#pragma unroll
            for (int dt = 0; dt < 4; ++dt) {
                u32x4 w;
                w.x = pk2(__uint_as_float(klo[dt].x << 16) * wl[0], __uint_as_float(klo[dt].x & 0xffff0000u) * wl[1]);
                w.y = pk2(__uint_as_float(klo[dt].y << 16) * wl[2], __uint_as_float(klo[dt].y & 0xffff0000u) * wl[3]);
                w.z = pk2(__uint_as_float(khi[dt].x << 16) * wh[0], __uint_as_float(khi[dt].x & 0xffff0000u) * wh[1]);
                w.w = pk2(__uint_as_float(khi[dt].y << 16) * wh[2], __uint_as_float(khi[dt].y & 0xffff0000u) * wh[3]);
                const bf16x8 kf = __builtin_bit_cast(bf16x8, w);
#pragma unroll
                for (int et = 0; et < NET; ++et) C[dt][et] = __builtin_amdgcn_mfma_f32_16x16x32_bf16(kf, mk_frag(vlo[et], vhi[et]), C[dt][et], 0, 0, 0);
                if (IS_ML) accn[dt] = __builtin_amdgcn_mfma_f32_16x16x32_bf16(kf, ones, accn[dt], 0, 0, 0);
            }
        }
        if (IS_ML) { if (fr == 0) {
#pragma unroll
            for (int dt = 0; dt < 4; ++dt) *(LAS f32x4*)(nvec + 4 * fq + 16 * dt) = accn[dt]; } }
        asm volatile("s_waitcnt lgkmcnt(0)" ::: "memory");
        __syncthreads();
    }
}

#ifndef FAST_CHAIN
#define FAST_CHAIN 1
#endif
constexpr int NCHWG = 80;
__device__ __forceinline__ void phase_mix(Frame& F, int layer) {
    const bool last = layer == 1;
    const GAS bf16* ftl = WSP(const bf16, WS_FTL) + (size_t)layer * 2 * 384 * 4096;
    if (FAST_CHAIN) {
        if (F.wg < NCHWG) {
            {
                const int cl = F.wave >> 1, hf = F.wave & 1, c = F.wg * 4 + cl;
                LAS unsigned char* img = F.lds + cl * CH_WAVE_LDS;
                {
                if (c < 192) { const int b = c / 12, r = c % 12; chain_fast<false>(F, layer, b, r >> 1, r & 1, img, hf); }
                else { const int i = c - 192; chain_fast<true>(F, layer, i >> 3, (i & 7) >> 1, i & 1, img, hf); }
                }
            }
        } else {
            const int nh = F.G - NCHWG, w = F.wg - NCHWG;
#ifndef FAST_HY
#define FAST_HY 1
#endif
            if (FAST_HY) {
#ifndef REP_HY
#define REP_HY 1
#endif
#pragma unroll 1
                for (int rp = 0; rp < REP_HY; ++rp)
                for (int u = w; u < 384; u += nh) hyena_unit_fast<LL>(F, layer, u, WSP(const bf16, WS_HYTL), ftl, WSP(bf16, WS_YHTL));
                if (!last) for (int u = w; u < 384; u += nh) hyena_unit_fast<LC>(F, layer, u, WSP(const bf16, WS_HYTC), WSP(const bf16, WS_FTC), WSP(bf16, WS_YHTC));
            } else {
                for (int u = w; u < 384; u += nh) hyena_unit_naive<LL>(F, layer, u, WSP(const bf16, WS_HYTL), ftl, WSP(bf16, WS_YHTL));
                if (!last) for (int u = w; u < 384; u += nh) hyena_unit_naive<LC>(F, layer, u, WSP(const bf16, WS_HYTC), WSP(const bf16, WS_FTC), WSP(bf16, WS_YHTC));
            }
        }
    } else {
        for (int u = F.wg; u < 384; u += F.G) hyena_unit_naive<LL>(F, layer, u, WSP(const bf16, WS_HYTL), ftl, WSP(bf16, WS_YHTL));
        if (!last) for (int u = F.wg; u < 384; u += F.G) hyena_unit_naive<LC>(F, layer, u, WSP(const bf16, WS_HYTC), WSP(const bf16, WS_FTC), WSP(bf16, WS_YHTC));
        for (int c = F.wg + F.wave * F.G; c < 320; c += F.G * NWAVES) chain_naive(F, layer, c);
    }
}

__device__ __forceinline__ void phase_combine(Frame& F, int layer) {
    const bool last = layer == 1;
    const int gw = F.wg * NWAVES + F.wave, NGW = F.G * NWAVES, lane = F.lane;
    const int nrows = last ? TOKL : TOK;
    GAS bf16* Y = WSP(bf16, WS_Y); const GAS bf16* OB = WSP(const bf16, WS_OB); const GAS bf16* RET = WSP(const bf16, WS_RET); const GAS bf16* ML = WSP(const bf16, WS_ML);
    for (int row = gw; row < nrows; row += NGW) {
#pragma unroll
        for (int hh = 0; hh < 10; ++hh) {
            const int cof = hh * 64 + lane;
            const float x = bf2f(Y[(size_t)row * D + 384 + cof]) + bf2f(OB[(size_t)row * 640 + cof]);
            const float mu = wave_sum(x) * (1.f / 64.f), xc = x - mu;
            const float var = wave_sum(xc * xc) * (1.f / 64.f);
            const float nrm = xc * rsqrtf(var + 1e-6f);
            float gate;
            if (hh < 6) gate = siluf_(bf2f(RET[(size_t)row * 1536 + 1152 + cof]));
            else gate = sigmoidf_(bf2f(ML[(size_t)row * 1024 + 768 + (cof - 384)]));
            Y[(size_t)row * D + 384 + cof] = (bf16)f2bf(nrm * gate);
        }
    }
    LAS float* scr = (LAS float*)(F.lds + F.wave * 16640);
    const int nitL = NB * 6 * 32, nitC = last ? 0 : NB * 6 * 4;
    for (int it = gw; it < nitL + nitC; it += NGW) {
        const GAS bf16* src; int L, rowbase, b, cb, tb;
        if (it < nitL) { b = it / 192; const int r = it % 192; cb = r / 32; tb = r % 32; L = LL; src = WSP(const bf16, WS_YHTL); rowbase = b * LL; }
        else { const int i2 = it - nitL; b = i2 / 24; const int r = i2 % 24; cb = r / 4; tb = r % 4; L = LC; src = WSP(const bf16, WS_YHTC); rowbase = TOKL + b * LC; }
        for (int cc = 0; cc < 64; ++cc) scr[cc * 65 + lane] = bf2f(src[((size_t)(b * 384 + cb * 64 + cc)) * L + tb * 64 + lane]);
        asm volatile("s_waitcnt lgkmcnt(0)" ::: "memory");
        for (int tt = 0; tt < 64; ++tt) Y[(size_t)(rowbase + tb * 64 + tt) * D + cb * 64 + lane] = (bf16)f2bf(scr[lane * 65 + tt]);
        asm volatile("s_waitcnt lgkmcnt(0)" ::: "memory");
    }
}

__device__ __forceinline__ void phase_norm_router(Frame& F) {
    const int gw = F.wg * NWAVES + F.wave, NGW = F.G * NWAVES, lane = F.lane;
    const GAS float* g = inp(F, I_GFFN) + 1 * D; const GAS float* wr = inp(F, I_ROUTER); const GAS float* br = inp(F, I_ROUTERB);
    GAS unsigned* cnt = WSP(unsigned, WS_CTL) + CW_CNT;
    for (int row = gw; row < TOKL; row += NGW) {
        float keep[16];
        norm_mod_row(xrow_ptr(F, row, false), g, mod_ptr(F, 1, row, 3), mod_ptr(F, 1, row, 4), WSP(bf16, WS_H) + (size_t)row * D, lane, keep);
        float lg[8];
#pragma unroll
        for (int e = 0; e < 8; ++e) lg[e] = 0.f;
#pragma unroll
        for (int j = 0; j < 4; ++j)
#pragma unroll
            for (int i = 0; i < 4; ++i) { const int k = 256 * j + 4 * lane + i; const f32x4 w0 = *(const GAS f32x4*)(wr + k * 8), w1 = *(const GAS f32x4*)(wr + k * 8 + 4); const float x = keep[4 * j + i];
                lg[0] += x * w0.x; lg[1] += x * w0.y; lg[2] += x * w0.z; lg[3] += x * w0.w; lg[4] += x * w1.x; lg[5] += x * w1.y; lg[6] += x * w1.z; lg[7] += x * w1.w; }
#pragma unroll
        for (int e = 0; e < 8; ++e) lg[e] = wave_sum(lg[e]) + br[e];
        int e0 = 0; float v0 = lg[0];
#pragma unroll
        for (int e = 1; e < 8; ++e) if (lg[e] > v0) { v0 = lg[e]; e0 = e; }
        int e1 = -1; float v1 = -3.0e38f;
#pragma unroll
        for (int e = 0; e < 8; ++e) if (e != e0 && lg[e] > v1) { v1 = lg[e]; e1 = e; }
        const float w1 = 1.f / (1.f + __expf(v0 - v1)), w0 = 1.f - w1;
        if (lane == 0) {
            const unsigned p0 = __hip_atomic_fetch_add(cnt + e0, 1u, __ATOMIC_RELAXED, __HIP_MEMORY_SCOPE_AGENT), p1 = __hip_atomic_fetch_add(cnt + e1, 1u, __ATOMIC_RELAXED, __HIP_MEMORY_SCOPE_AGENT);
            WSP(int, WS_TOPE)[row * 2] = e0; WSP(int, WS_TOPE)[row * 2 + 1] = e1;
            WSP(float, WS_TOPW)[row * 2] = w0; WSP(float, WS_TOPW)[row * 2 + 1] = w1;
            WSP(int, WS_TOPP)[row * 2] = (int)p0; WSP(int, WS_TOPP)[row * 2 + 1] = (int)p1;
        }
    }
}
__device__ __forceinline__ void phase_route_tables(Frame& F) {
    const GAS unsigned* cnt = WSP(const unsigned, WS_CTL) + CW_CNT;
    int off[9]; off[0] = 0;
#pragma unroll
    for (int e = 0; e < 8; ++e) { const int c = (int)__hip_atomic_load(cnt + e, __ATOMIC_RELAXED, __HIP_MEMORY_SCOPE_AGENT); off[e + 1] = off[e] + ((c + 255) >> 8) * 256; }
    const int gt = F.wg * NTHR + F.tid, NGT = F.G * NTHR;
    GAS int* rowidx = WSP(int, WS_ROWIDX); GAS int* slot = WSP(int, WS_SLOT); GAS int* tilee = WSP(int, WS_TILEE);
    for (int i = gt; i < MAXTILES * 256; i += NGT) {
        int e = 0;
#pragma unroll
        for (int q = 1; q < 8; ++q) if (i >= off[q]) e = q;
        const int c = (int)cnt[e];
        if (i >= off[8] || i - off[e] >= c) rowidx[i] = 0;
    }
    for (int i = gt; i < TOKL * 2; i += NGT) {
        const int e = WSP(const int, WS_TOPE)[i], pos = WSP(const int, WS_TOPP)[i];
        int o = 0;
#pragma unroll
        for (int q = 0; q < 8; ++q) if (e == q) o = off[q];
        const int s = o + pos; slot[i] = s; rowidx[s] = i >> 1;
    }
    for (int i = gt; i < MAXTILES + 1; i += NGT) {
        if (i == MAXTILES) tilee[MAXTILES] = off[8] >> 8;
        else { int e = 0;
#pragma unroll
            for (int q = 1; q < 8; ++q) if (i * 256 >= off[q]) e = q;
            tilee[i] = e; }
    }
}

__device__ __forceinline__ void moe_pass_gemm1_fast(Frame& F, int t0, int t1) {
    pg8::OrderMoe S; S.o.init(t1 - t0, NFF1 / 256, F.G, F.wg); S.rowidx = WSP(const int, WS_ROWIDX); S.tilee = WSP(const int, WS_TILEE); S.t0 = t0; S.bstride = (size_t)NFF1 * D; S.gather = true;
    EpiSwiglu E{WSP(bf16, WS_MACT), 0};
    pg8::gemm_phase(F.lds, WSP(const bf16, WS_H), D, WSP(const bf16, WS_MW13), D, D, S, E);
}
__device__ __forceinline__ void moe_pass_gemm2_fast(Frame& F, int t0, int t1) {
    pg8::OrderMoe S; S.o.init(t1 - t0, D / 256, F.G, F.wg); S.rowidx = WSP(const int, WS_ROWIDX); S.tilee = WSP(const int, WS_TILEE); S.t0 = t0; S.bstride = (size_t)D * DFF; S.gather = false;
    EpiBf16Out E{WSP(bf16, WS_EOUT), D, t0 * 256};
    pg8::gemm_phase(F.lds, WSP(const bf16, WS_MACT), DFF, WSP(const bf16, WS_MW2), DFF, DFF, S, E);
}
__device__ __forceinline__ void phase_final(Frame& F) {
    const int gw = F.wg * NWAVES + F.wave, NGW = F.G * NWAVES, lane = F.lane;
    const GAS float* gf = inp(F, I_GFINAL); const GAS bf16* eo = WSP(const bf16, WS_EOUT);
    for (int row = gw; row < TOKL; row += NGW) {
        const int s0 = WSP(const int, WS_SLOT)[row * 2], s1 = WSP(const int, WS_SLOT)[row * 2 + 1];
        const float w0 = WSP(const float, WS_TOPW)[row * 2], w1 = WSP(const float, WS_TOPW)[row * 2 + 1];
        const GAS float* m5 = mod_ptr(F, 1, row, 5);
        GAS float* xr = outp(F) + (size_t)row * D;
        f32x4 v[4]; float s = 0.f;
#pragma unroll
        for (int j = 0; j < 4; ++j) {
            const int c = 256 * j + 4 * lane;
            const f32x4 a = ld_bf16x4(eo + (size_t)s0 * D + c), b = ld_bf16x4(eo + (size_t)s1 * D + c), m = *(const GAS f32x4*)(m5 + c);
            v[j] = *(const GAS f32x4*)(xr + c) + m * (a * w0 + b * w1);
            s += (v[j].x * v[j].x + v[j].y * v[j].y) + (v[j].z * v[j].z + v[j].w * v[j].w);
        }
        const float r = rsqrtf(wave_sum(s) * (1.f / 1024.f) + 1e-6f);
#pragma unroll
        for (int j = 0; j < 4; ++j) { const int c = 256 * j + 4 * lane; const f32x4 g = *(const GAS f32x4*)(gf + c); *(GAS f32x4*)(xr + c) = v[j] * r * g; }
    }
}

#ifndef REP_WIN
#define REP_WIN 1
#endif
#ifndef REP_MIX
#define REP_MIX 1
#endif
#ifndef REP_GATE
#define REP_GATE 1
#endif
#ifndef REP_UP
#define REP_UP 1
#endif
#ifndef REP_FFN1
#define REP_FFN1 1
#endif
#ifndef REP_MOE
#define REP_MOE 1
#endif
#ifndef REP_NORM
#define REP_NORM 1
#endif
#ifndef REP_P0
#define REP_P0 1
#endif
__global__ void __launch_bounds__(NTHR, 2) hybrid_fwd(Params prm) {
    extern __shared__ __attribute__((aligned(16))) unsigned char lds_raw[];
    Frame F;
    F.lds = (LAS unsigned char*)lds_raw; F.ws = (GAS unsigned char*)prm.ws;
    F.tid = threadIdx.x; F.lane = F.tid & 63; F.wave = __builtin_amdgcn_readfirstlane(F.tid >> 6); F.G = gridDim.x; F.wg = blockIdx.x;
    volatile LAS unsigned* MISC = (volatile LAS unsigned*)(F.lds + MISC_OFF);
    if (F.tid < 64) MISC[F.tid] = 0u;
    if (F.tid < 33) { const unsigned long long v = F.tid < 32 ? (unsigned long long)prm.in[F.tid] : (unsigned long long)prm.out; *(LAS unsigned long long*)(F.lds + PTAB_OFF + 8 * F.tid) = v; }
    __syncthreads();
    XcdBarrier bar = xcd_barrier_post(WSP(unsigned, WS_CTL) + CW_BAR, MISC + 8);
#define RELAUNDER() do { { unsigned long long _w = (unsigned long long)F.ws; asm volatile("" : "+s"(_w)); F.ws = (GAS unsigned char*)_w; } \
        { unsigned _t = (unsigned)F.tid; asm volatile("" : "+v"(_t)); F.tid = (int)_t; F.lane = F.tid & 63; F.wave = __builtin_amdgcn_readfirstlane(F.tid >> 6); } \
        { unsigned _g = (unsigned)F.G, _b = (unsigned)F.wg; asm volatile("" : "+s"(_g), "+s"(_b)); F.G = (int)_g; F.wg = (int)_b; } \
        { unsigned _l = (unsigned)(size_t)F.lds; asm volatile("" : "+s"(_l)); F.lds = (LAS unsigned char*)(size_t)_l; } } while (0)
#define GRID_BAR() do { { unsigned long long _b = (unsigned long long)bar.bar; unsigned _x = bar.x; asm volatile("" : "+s"(_b), "+s"(_x)); bar.bar = (GAS unsigned*)_b; bar.x = _x; } xcd_barrier(bar); RELAUNDER(); } while (0)

    for (int rp = 0; rp < REP_P0; ++rp) { phase_p0(F); write_bias(F);
    GRID_BAR(); }
#pragma unroll 1
    for (int layer = 0; layer < 2; ++layer) {
        const bool last = layer == 1;
        const int rows_all = TOK, rows_out = last ? TOKL : TOK;
        const GAS float* modbase = WSP(const float, WS_MOD) + (size_t)layer * 17 * 6144;
        for (int rp = 0; rp < REP_NORM; ++rp) { phase_norm(F, layer, rows_all, !last, 0);
        GRID_BAR(); }
        for (int rp = 0; rp < REP_WIN; ++rp) {
        { EpiWin E{WSP(const float, WS_BIAS) + layer * NWP, WSP(bf16, WS_HYTL), WSP(bf16, WS_HYTC), WSP(bf16, WS_RET), WSP(bf16, WS_ML), WSP(float, WS_MLG)};
          gemm_fast(F, WSP(const bf16, WS_H), D, WSP(const bf16, WS_WIN), D, D, rows_all, NW1, E); }
        GRID_BAR(); }
        for (int rp = 0; rp < REP_MIX; ++rp) { phase_mix(F, layer);
        GRID_BAR(); }
        phase_combine(F, layer);
        GRID_BAR();
        for (int rp = 0; rp < REP_GATE; ++rp) {
        { EpiGate E{WSP(const float, WS_BIAS) + layer * NWP + NW1, WSP(bf16, WS_GATES)};
          gemm_fast(F, WSP(const bf16, WS_H), D, WSP(const bf16, WS_WIN) + (size_t)NW1 * D, D, D, rows_out, NGATE, E); }
        GRID_BAR(); }
        for (int rp = 0; rp < REP_UP; ++rp) {
        { EpiUp E{WSP(const bf16, WS_GATES), WSP(bf16, WS_H)};
          gemm_fast(F, WSP(const bf16, WS_Y), D, WSP(const bf16, WS_WUP), D, D, rows_out, D, E); }
        GRID_BAR(); }
        { EpiResid E{last ? outp(F) : inp(F, I_X), last ? WSP(const float, WS_XC) : inp(F, I_CTX), outp(F), WSP(float, WS_XC), modbase, 2};
          gemm_fast(F, WSP(const bf16, WS_H), D, WSP(const bf16, WS_WOUT), D, D, rows_out, D, E); }
        GRID_BAR();
        if (!last) {
            phase_norm(F, layer, rows_out, false, 3);
            { const int gw = F.wg * NWAVES + F.wave, NGW = F.G * NWAVES; LAS float* scr = (LAS float*)(F.lds + F.wave * 8704);
              conv_weights_ffn(inp(F, I_FW1), inp(F, I_FW3), inp(F, I_FW2), WSP(bf16, WS_W13), WSP(bf16, WS_W2), gw, NGW, scr, F.lane);
              conv_weights_win(F, 1, gw, NGW, scr);
              conv_weights_upout(F, 1, gw, NGW, scr); }
            GRID_BAR();
            for (int rp = 0; rp < REP_FFN1; ++rp) {
            { EpiSwiglu E{WSP(bf16, WS_ACT), 0};
              gemm_fast(F, WSP(const bf16, WS_H), D, WSP(const bf16, WS_W13), D, D, rows_out, NFF1, E); }
            GRID_BAR(); }
            { EpiResid E{outp(F), WSP(const float, WS_XC), outp(F), WSP(float, WS_XC), modbase, 5};
              gemm_fast(F, WSP(const bf16, WS_ACT), DFF, WSP(const bf16, WS_W2), DFF, DFF, rows_out, D, E); }
            GRID_BAR();
        }
    }
    phase_norm_router(F);
    { const int gw = F.wg * NWAVES + F.wave, NGW = F.G * NWAVES; LAS float* scr = (LAS float*)(F.lds + F.wave * 8704);
#pragma unroll 1
      for (int e = 0; e < NE; ++e)
          conv_weights_ffn(inp(F, I_MW1) + (size_t)e * D * DFF, inp(F, I_MW3) + (size_t)e * D * DFF, inp(F, I_MW2) + (size_t)e * DFF * D,
                           WSP(bf16, WS_MW13) + (size_t)e * NFF1 * D, WSP(bf16, WS_MW2) + (size_t)e * D * DFF, gw, NGW, scr, F.lane); }
    GRID_BAR();
    phase_route_tables(F);
    GRID_BAR();
    const int ntiles = __builtin_amdgcn_readfirstlane(WSP(const int, WS_TILEE)[MAXTILES]);
#pragma unroll 1
    for (int p = 0; p < NPASS; ++p) {
        const int t0 = p * PASS_TILES, t1 = min(ntiles, t0 + PASS_TILES);
        for (int rp = 0; rp < REP_MOE; ++rp) {
        if (t0 < t1) moe_pass_gemm1_fast(F, t0, t1);
        GRID_BAR();
        if (t0 < t1) moe_pass_gemm2_fast(F, t0, t1);
        GRID_BAR(); }
    }
    phase_final(F);
}

extern "C" void kernel_launch(void* const* d_in, const int* in_sizes, int n_in, void* d_out, int out_size, void* d_ws, size_t ws_size, hipStream_t stream) {
    static int grid = 0;
    if (grid == 0) {
        if (n_in != 32 || out_size != TOKL * D || ws_size < WS_END) { fprintf(stderr, "kernel_launch: unexpected arguments (n_in %d, out %d, ws %zu)\n", n_in, out_size, ws_size); grid = -1; return; }
        int dev = 0, cus = 0;
        if (hipGetDevice(&dev) != hipSuccess || hipDeviceGetAttribute(&cus, hipDeviceAttributeMultiprocessorCount, dev) != hipSuccess) { grid = -1; return; }
        if (hipFuncSetAttribute((const void*)hybrid_fwd, hipFuncAttributeMaxDynamicSharedMemorySize, LDS_BYTES) != hipSuccess) { grid = -1; return; }
        int per_cu = 0;
        (void)hipOccupancyMaxActiveBlocksPerMultiprocessor(&per_cu, (const void*)hybrid_fwd, NTHR, LDS_BYTES);
        (void)hipGetLastError();
        grid = cus;
    }
    if (grid < 0) return;
    (void)hipMemsetAsync((char*)d_ws + WS_CTL, 0, CTL_ZERO_BYTES, stream);
    Params p{};
    for (int i = 0; i < 32; ++i) p.in[i] = (const float*)d_in[i];
    p.out = (float*)d_out; p.ws = (unsigned char*)d_ws;
    hipLaunchKernelGGL(hybrid_fwd, dim3(grid), dim3(NTHR), LDS_BYTES, stream, p);
}
```

```cpp
#include <hip/hip_runtime.h>
#include <stdint.h>
#include <stdio.h>

#define LAS __attribute__((address_space(3)))
#define GAS __attribute__((address_space(1)))
typedef unsigned short bf16;
typedef short bf16x8 __attribute__((ext_vector_type(8)));
typedef float f32x4 __attribute__((ext_vector_type(4)));
typedef unsigned u32x4 __attribute__((ext_vector_type(4)));
typedef unsigned u32x2 __attribute__((ext_vector_type(2)));

constexpr int D = 1024, NB = 16, LL = 2048, LC = 256;
constexpr int TOKL = NB * LL, TOKC = NB * LC, TOK = TOKL + TOKC;
constexpr int HYW = 384, RETW = 384, MLW = 256;
constexpr int NIN = 6800, NW1 = 3840, NGATE = 3072, NWP = 6912;
constexpr int DFF = 2816, NFF1 = 5632, NE = 8;
constexpr int NWAVES = 8, NTHR = 512;
constexpr int MAXTILES = 272, PASS_TILES = 64, NPASS = 5;

constexpr size_t MiB = 1u << 20;
constexpr size_t WS_CTL = 0, CTL_ZERO_BYTES = 1 * MiB;
constexpr size_t WS_MOD = 1 * MiB;
constexpr size_t WS_BIAS = 2 * MiB;
constexpr size_t WS_ROPE = 2 * MiB + 256 * 1024;
constexpr size_t WS_TOPE = 3 * MiB;
constexpr size_t WS_TOPW = 3 * MiB + 256 * 1024;
constexpr size_t WS_TOPP = 3 * MiB + 512 * 1024;
constexpr size_t WS_SLOT = 3 * MiB + 768 * 1024;
constexpr size_t WS_ROWIDX = 4 * MiB;
constexpr size_t WS_TILEE = 4 * MiB + 512 * 1024;
constexpr size_t WS_FTL = 5 * MiB;
constexpr size_t WS_FTC = 17 * MiB;
constexpr size_t WS_WIN = 18 * MiB;
constexpr size_t WS_WUP = 32 * MiB;
constexpr size_t WS_WOUT = 34 * MiB;
constexpr size_t WS_XC = 36 * MiB;
constexpr size_t WS_H = 52 * MiB;
constexpr size_t WS_Y = 124 * MiB;
constexpr size_t WS_U = 196 * MiB;
constexpr size_t WS_RET = WS_U;
constexpr size_t WS_ML = WS_U + 108 * MiB;
constexpr size_t WS_MLG = WS_U + 180 * MiB;
constexpr size_t WS_OB = WS_U + 183 * MiB;
constexpr size_t WS_YHTL = WS_U + 228 * MiB;
constexpr size_t WS_YHTC = WS_U + 252 * MiB;
constexpr size_t WS_HYTL = WS_U + 255 * MiB;
constexpr size_t WS_HYTC = WS_U + 327 * MiB;
constexpr size_t WS_END = WS_U + 336 * MiB;
constexpr size_t WS_GATES = WS_U;
constexpr size_t WS_ACT = WS_U;
constexpr size_t WS_W13 = WS_U + 204 * MiB;
constexpr size_t WS_W2 = WS_U + 216 * MiB;
constexpr size_t WS_MW13 = WS_Y;
constexpr size_t WS_MW2 = WS_Y + 88 * MiB;
constexpr size_t WS_MACT = WS_Y + 132 * MiB;
constexpr size_t WS_EOUT = WS_Y + 220 * MiB;
static_assert(WS_EOUT + (size_t)MAXTILES * 256 * 1024 * 2 <= WS_END, "map");
static_assert(WS_GATES + (size_t)TOK * NGATE * 2 <= WS_YHTL, "gates overlay");

constexpr int CW_BAR = 4096;
constexpr int CW_CNT = 16384;

constexpr int LDS_BYTES = 147456;
constexpr int MISC_OFF = 147456 - 256;

__device__ __forceinline__ float bf2f(bf16 b) { return __uint_as_float(((unsigned)b) << 16); }
typedef __bf16 bf2v_ __attribute__((ext_vector_type(2)));
typedef float f2v_ __attribute__((ext_vector_type(2)));
__device__ __forceinline__ unsigned pk2(float lo, float hi) { const f2v_ f = {lo, hi}; return __builtin_bit_cast(unsigned, __builtin_convertvector(f, bf2v_)); }
__device__ __forceinline__ unsigned f2bf(float f) { return pk2(f, 0.f) & 0xffffu; }
__device__ __forceinline__ float dpp_f(float v, int) { return v; }
#define DPP_ADD(v, ctrl) (v) += __int_as_float(__builtin_amdgcn_update_dpp(0, __float_as_int(v), (ctrl), 0xf, 0xf, true))
__device__ __forceinline__ float wave_sum(float v) {
    DPP_ADD(v, 0xB1);
    DPP_ADD(v, 0x4E);
    DPP_ADD(v, 0x141);
    DPP_ADD(v, 0x140);
    return __int_as_float(__builtin_amdgcn_readlane(__float_as_int(v), 0)) + __int_as_float(__builtin_amdgcn_readlane(__float_as_int(v), 16))
         + __int_as_float(__builtin_amdgcn_readlane(__float_as_int(v), 32)) + __int_as_float(__builtin_amdgcn_readlane(__float_as_int(v), 48));
}
__device__ __forceinline__ float lane_read(float v, int src_lane) { return __int_as_float(__builtin_amdgcn_ds_bpermute(src_lane << 2, __float_as_int(v))); }
__device__ __forceinline__ float sigmoidf_(float x) { return __builtin_amdgcn_rcpf(1.0f + __expf(-x)); }
__device__ __forceinline__ float siluf_(float x) { return x * __builtin_amdgcn_rcpf(1.0f + __expf(-x)); }

#define XB_TMO      128
#define XB_XCNT(j)  (256  + 64 * (j))
#define XB_XSUB(j)  (1280 + 64 * (j))
#define XB_XGEN(j)  (2304 + 64 * (j))
#define XB_TOP      3328
#define XB_TOPGEN   3392
#define XCD_BAR_WORDS 3456
#define XB_SPIN_CAP (1u << 22)
__device__ __forceinline__ unsigned xb_ld(GAS unsigned* p)              { return __hip_atomic_load(p, __ATOMIC_RELAXED, __HIP_MEMORY_SCOPE_AGENT); }
__device__ __forceinline__ unsigned xb_add(GAS unsigned* p, unsigned v) { return __hip_atomic_fetch_add(p, v, __ATOMIC_RELAXED, __HIP_MEMORY_SCOPE_AGENT); }
__device__ __forceinline__ unsigned xb_xcc_id() { return (unsigned)__builtin_amdgcn_s_getreg((3 << 11) | 20) & 0xFu; }
#define XB_SPIN(cond, bar) do { unsigned _sp = 0; while (cond) { __builtin_amdgcn_s_sleep(1); \
    if ((++_sp & 255u) == 0u) { if (xb_ld(&(bar)[XB_TMO])) break; if (_sp > XB_SPIN_CAP) { (void)__hip_atomic_fetch_add(&(bar)[XB_TMO], 1u, __ATOMIC_RELAXED, __HIP_MEMORY_SCOPE_AGENT); break; } } } } while (0)
struct XcdBarrier { GAS unsigned* bar; unsigned x; volatile LAS unsigned* st; };
__device__ __forceinline__ XcdBarrier xcd_barrier_post(GAS unsigned* bar, volatile LAS unsigned* st) {
    XcdBarrier b; b.bar = bar; b.x = xb_xcc_id(); b.st = st;
    if (threadIdx.x == 0) (void)xb_add(&bar[XB_XCNT(b.x)], 1u);
    return b;
}
__device__ __forceinline__ void xcd_barrier_complete(GAS unsigned* bar, unsigned x, unsigned& nloc, unsigned& nx) {
    const unsigned G = gridDim.x * gridDim.y * gridDim.z;
    unsigned sum, cnt, mine, sp = 0u;
    for (;;) {
        sum = 0u; cnt = 0u; mine = 0u;
#pragma unroll 1
        for (unsigned j = 0; j < 16; ++j) { const unsigned c = xb_ld(&bar[XB_XCNT(j)]); sum += c; cnt += (c > 0u) ? 1u : 0u; }
        mine = xb_ld(&bar[XB_XCNT(x)]);
        if (sum == G) break;
        __builtin_amdgcn_s_sleep(1);
        if ((++sp & 255u) == 0u) { if (xb_ld(&bar[XB_TMO])) break; if (sp > XB_SPIN_CAP) { (void)__hip_atomic_fetch_add(&bar[XB_TMO], 1u, __ATOMIC_RELAXED, __HIP_MEMORY_SCOPE_AGENT); break; } }
    }
    nloc = mine > 0u ? mine : 1u; nx = cnt > 0u ? cnt : 1u;
}
__device__ __forceinline__ void xcd_barrier(const XcdBarrier& b) {
    asm volatile("s_waitcnt vmcnt(0)" ::: "memory");
    __syncthreads();
    if (threadIdx.x == 0) {
        GAS unsigned* bar = b.bar;
        __builtin_amdgcn_s_waitcnt(0);
        unsigned nloc = b.st[0], nx = b.st[1];
        if (nloc == 0u) { xcd_barrier_complete(bar, b.x, nloc, nx); b.st[0] = nloc; b.st[1] = nx; }
        const unsigned old = xb_add(&bar[XB_XSUB(b.x)], 1u);
        const unsigned gen = old / nloc;
        if (old + 1u == (gen + 1u) * nloc) {
            __builtin_amdgcn_fence(__ATOMIC_RELEASE, "agent");
            asm volatile("s_waitcnt vmcnt(0)" ::: "memory");
            const unsigned og = xb_add(&bar[XB_TOP], 1u);
            const unsigned tg = og / nx;
            if (og + 1u == (tg + 1u) * nx) xb_add(&bar[XB_TOPGEN], 1u);
            else XB_SPIN(xb_ld(&bar[XB_TOPGEN]) == tg, bar);
            __builtin_amdgcn_fence(__ATOMIC_ACQUIRE, "agent");
            xb_add(&bar[XB_XGEN(b.x)], 1u);
            asm volatile("s_waitcnt vmcnt(0)" ::: "memory");
        } else {
            XB_SPIN(xb_ld(&bar[XB_XGEN(b.x)]) == gen, bar);
            __builtin_amdgcn_fence(__ATOMIC_ACQUIRE, "agent");
            asm volatile("s_waitcnt vmcnt(0)" ::: "memory");
        }
    }
    __syncthreads();
}

struct Params { const float* in[32]; float* out; unsigned char* ws; };
enum { I_X = 0, I_C, I_CTX, I_CCTX, I_WMOD, I_BMOD, I_GMIX, I_GFFN, I_WIN, I_BIN, I_HYCONV, I_HYF1, I_HYFB1, I_HYF2, I_HYFB2, I_HYF3, I_HYDECAY,
       I_HYSKIP, I_RETDECAY, I_MLCONV, I_MLGB, I_WUP, I_WOUT, I_FW1, I_FW3, I_FW2, I_ROUTER, I_ROUTERB, I_MW1, I_MW3, I_MW2, I_GFINAL };

struct Frame {
    LAS unsigned char* lds;
    GAS unsigned char* ws;
    int tid, lane, wave, G, wg;
};
#define WSP(T, off) ((GAS T*)(F.ws + (off)))
constexpr int PTAB_OFF = 147456 - 1024;
__device__ __forceinline__ const GAS float* inp(const Frame& F, int i) {
    const LAS unsigned* t = (const LAS unsigned*)(F.lds + PTAB_OFF) + 2 * i;
    const unsigned lo = __builtin_amdgcn_readfirstlane(t[0]), hi = __builtin_amdgcn_readfirstlane(t[1]);
    return (const GAS float*)(((unsigned long long)hi << 32) | lo);
}
__device__ __forceinline__ GAS float* outp(const Frame& F) { return (GAS float*)inp(F, 32); }

__device__ __forceinline__ int row_batch(int row) { return row < TOKL ? (row >> 11) : ((row - TOKL) >> 8); }
__device__ __forceinline__ const GAS float* mod_ptr(const Frame& F, int layer, int row, int which) {
    const int r = row < TOKL ? (row >> 11) : 16;
    return WSP(const float, WS_MOD) + ((size_t)(layer * 17 + r) * 6 + which) * 1024;
}

template <class RowMap>
__device__ __forceinline__ void tr_item(const GAS float* W, int K, int N, GAS bf16* WT, int ldT, RowMap rm, LAS float* scr, int item, int lane) {
    const int nblk = (N + 31) / 32, kb = item / nblk, nb = item % nblk, k0 = 64 * kb, n0 = 32 * nb;
#pragma unroll 8
    for (int i = 0; i < 32; ++i) { const int kk = 2 * i + (lane >> 5); const int n = n0 + (lane & 31); scr[kk * 33 + (lane & 31)] = (n < N) ? W[(size_t)(k0 + kk) * N + n] : 0.f; }
    asm volatile("s_waitcnt lgkmcnt(0)" ::: "memory");
    const int c = lane & 7;
#pragma unroll
    for (int j = 0; j < 4; ++j) { const int nl = (lane >> 3) + 8 * j; const int n = n0 + nl; const LAS float* s = scr + (8 * c) * 33 + nl;
        u32x4 o; o.x = pk2(s[0 * 33], s[1 * 33]); o.y = pk2(s[2 * 33], s[3 * 33]); o.z = pk2(s[4 * 33], s[5 * 33]); o.w = pk2(s[6 * 33], s[7 * 33]);
        if (n < N) *(GAS u32x4*)(WT + (size_t)rm(n) * ldT + k0 + 8 * c) = o; }
    asm volatile("s_waitcnt lgkmcnt(0)" ::: "memory");
}
struct RmId { __device__ __forceinline__ int operator()(int n) const { return n; } };
__device__ __forceinline__ int win_row(int n) {
    if (n < 1152) return n;
    if (n < 2688) return 1280 + (n - 1152);
    if (n < 3712) return 2816 + (n - 2688);
    if (n < 3728) return 1152 + (n - 3712);
    return 3840 + (n - 3728);
}
struct RmWin { __device__ __forceinline__ int operator()(int n) const { return win_row(n); } };
struct RmW1 { __device__ __forceinline__ int operator()(int n) const { return (n >> 4) * 32 + (n & 15); } };
struct RmW3 { __device__ __forceinline__ int operator()(int n) const { return (n >> 4) * 32 + 16 + (n & 15); } };

__device__ __forceinline__ void conv_weights_win(Frame& F, int layer, int gw, int NGW, LAS float* scr) {
    const GAS float* W = inp(F, I_WIN) + (size_t)layer * D * NIN;
    const int items = (D / 64) * ((NIN + 31) / 32);
    for (int it = gw; it < items; it += NGW) tr_item(W, D, NIN, WSP(bf16, WS_WIN), D, RmWin(), scr, it, F.lane);
    GAS bf16* wt = WSP(bf16, WS_WIN);
    unsigned zz; asm volatile("v_mov_b32 %0, 0" : "=v"(zz));
    for (int i = gw * 64 + F.lane; i < 112 * 1024 / 8; i += NGW * 64) *(GAS u32x4*)(wt + (size_t)1168 * 1024 + (size_t)i * 8) = (u32x4){zz, zz, zz, zz};
}
__device__ __forceinline__ void conv_weights_upout(Frame& F, int layer, int gw, int NGW, LAS float* scr) {
    const int items = (D / 64) * (D / 32);
    for (int it = gw; it < items; it += NGW) tr_item(inp(F, I_WUP) + (size_t)layer * D * D, D, D, WSP(bf16, WS_WUP), D, RmId(), scr, it, F.lane);
    for (int it = gw; it < items; it += NGW) tr_item(inp(F, I_WOUT) + (size_t)layer * D * D, D, D, WSP(bf16, WS_WOUT), D, RmId(), scr, it, F.lane);
}
__device__ __forceinline__ void conv_weights_ffn(const GAS float* w1, const GAS float* w3, const GAS float* w2, GAS bf16* w13t, GAS bf16* w2t, int gw, int NGW, LAS float* scr, int lane) {
    const int i1 = (D / 64) * (DFF / 32), i2 = (DFF / 64) * (D / 32);
    for (int it = gw; it < i1; it += NGW) tr_item(w1, D, DFF, w13t, D, RmW1(), scr, it, lane);
    for (int it = gw; it < i1; it += NGW) tr_item(w3, D, DFF, w13t, D, RmW3(), scr, it, lane);
    for (int it = gw; it < i2; it += NGW) tr_item(w2, DFF, D, w2t, DFF, RmId(), scr, it, lane);
}

__device__ __forceinline__ void filter_item(Frame& F, int layer, int L, GAS bf16* FT  , int pb, int ch, LAS float* tile  ) {
    const GAS float* f1 = inp(F, I_HYF1) + layer * 33 * 64; const GAS float* fb1 = inp(F, I_HYFB1) + layer * 64;
    const GAS float* f2 = inp(F, I_HYF2) + layer * 64 * 64; const GAS float* fb2 = inp(F, I_HYFB2) + layer * 64;
    const GAS float* f3 = inp(F, I_HYF3) + (size_t)layer * 64 * 1536; const GAS float* dec = inp(F, I_HYDECAY) + layer * 1536;
    const int lane = F.lane, n = ch * 64 + lane;
    const float b1 = fb1[lane], b2 = fb2[lane], adec = fabsf(dec[n]);
    for (int pl = 0; pl < 64; ++pl) {
        const int pos = pb * 64 + pl;
        const float t = (float)pos / (float)(L - 1);
        const float w = 6.283185307179586f * (float)pos / (float)L;
        float feat = 0.f;
        if (lane == 0) feat = t;
        else if (lane < 17) { const float band = 1e-4f + (float)(lane - 1) * ((15.0f - 1e-4f) / 15.0f); feat = cosf(w * band); }
        else if (lane < 33) { const float band = 1e-4f + (float)(lane - 17) * ((15.0f - 1e-4f) / 15.0f); feat = -sinf(w * band); }
        float a1 = b1;
        for (int i = 0; i < 33; ++i) a1 += __int_as_float(__builtin_amdgcn_readlane(__float_as_int(feat), i)) * f1[i * 64 + lane];
        const float h1 = sinf(a1);
        float a2 = b2;
        for (int i = 0; i < 64; ++i) a2 += __int_as_float(__builtin_amdgcn_readlane(__float_as_int(h1), i)) * f2[i * 64 + lane];
        const float h2 = sinf(a2);
        float a3 = 0.f;
        for (int i = 0; i < 64; ++i) a3 += __int_as_float(__builtin_amdgcn_readlane(__float_as_int(h2), i)) * f3[i * 1536 + n];
        tile[pl * 65 + lane] = a3 * expf(-t * adec);
    }
    asm volatile("s_waitcnt lgkmcnt(0)" ::: "memory");
    const int pos = pb * 64 + lane;
    for (int cl = 0; cl < 64; ++cl) {
        const int nn = ch * 64 + cl, o = nn / 768, dir = (nn / 384) & 1, c = nn % 384;
        GAS bf16* dst = FT + (size_t)(o * 384 + c) * (2 * L);
        const float v = tile[lane * 65 + cl];
        if (dir == 0) dst[L - pos] = (bf16)f2bf(v);
        else if (pos > 0) dst[L + pos] = (bf16)f2bf(v);
    }
    asm volatile("s_waitcnt lgkmcnt(0)" ::: "memory");
}

__device__ __forceinline__ void phase_p0(Frame& F) {
    const int gw = F.wg * NWAVES + F.wave, NGW = F.G * NWAVES;
    LAS float* sl = (LAS float*)F.lds;
    LAS float* red = (LAS float*)(F.lds + 17 * 4096);
    for (int i = F.tid; i < 17 * 1024; i += NTHR) { const int r = i >> 10, k = i & 1023; const float v = r < 16 ? inp(F, I_C)[r * 1024 + k] : inp(F, I_CCTX)[k]; sl[i] = siluf_(v); }
    __syncthreads();
    for (int item = F.wg; item < 2 * 384; item += F.G) {
        const int layer = item / 384, n0 = (item % 384) * 16, j = F.tid & 15, kp = F.tid >> 4;
        const GAS float* W = inp(F, I_WMOD) + (size_t)layer * D * 6144;
        float acc[17];
#pragma unroll
        for (int r = 0; r < 17; ++r) acc[r] = 0.f;
        for (int k = kp * 32; k < kp * 32 + 32; ++k) { const float w = W[(size_t)k * 6144 + n0 + j];
#pragma unroll
            for (int r = 0; r < 17; ++r) acc[r] += sl[r * 1024 + k] * w; }
#pragma unroll
        for (int r = 0; r < 17; ++r) red[(kp * 17 + r) * 16 + j] = acc[r];
        __syncthreads();
        if (F.tid < 272) { const int r = F.tid >> 4, jj = F.tid & 15; float s = inp(F, I_BMOD)[layer * 6144 + n0 + jj];
            for (int q = 0; q < 32; ++q) s += red[(q * 17 + r) * 16 + jj];
            WSP(float, WS_MOD)[(size_t)(layer * 17 + r) * 6144 + n0 + jj] = s; }
        __syncthreads();
    }
    __syncthreads();
    LAS float* scr = (LAS float*)(F.lds + F.wave * 8704);
    conv_weights_win(F, 0, gw, NGW, scr);
    conv_weights_upout(F, 0, gw, NGW, scr);
    for (int i = gw * 64 + F.lane; i < 2048 * 32; i += NGW * 64) {
        const int t = i >> 5, j = i & 31, half = j >> 4, ii = j & 15;
        const float inv = 1.0f / powf(10000.0f, (float)ii / 16.0f);
        const float ang = (float)(half == 0 ? (t >> 6) : (t & 63)) * inv;
        WSP(float, WS_ROPE)[t * 64 + half * 32 + ii] = cosf(ang);
        WSP(float, WS_ROPE)[t * 64 + half * 32 + 16 + ii] = sinf(ang);
    }
    __syncthreads();
    LAS float* ftile = (LAS float*)(F.lds + F.wave * 16640);
    for (int it = gw; it < 1536 + 96; it += NGW) {
        if (it < 1536) { const int layer = it / 768, r = it % 768; filter_item(F, layer, LL, WSP(bf16, WS_FTL) + (size_t)layer * 2 * 384 * 4096, r / 24, r % 24, ftile); }
        else { const int r = it - 1536; filter_item(F, 0, LC, WSP(bf16, WS_FTC), r / 24, r % 24, ftile); }
    }
}
__device__ __forceinline__ void write_bias(Frame& F) {
    const int gt = (F.wg * NWAVES + F.wave) * 64 + F.lane, NGT = F.G * NTHR;
    for (int i = gt; i < 2 * NWP; i += NGT) {
        const int l = i / NWP, r = i % NWP; float v = 0.f;
        int n = -1;
        if (r < 1152) n = r; else if (r < 1168) n = 3712 + (r - 1152); else if (r < 1280) n = -1; else if (r < 2816) n = 1152 + (r - 1280); else if (r < 3840) n = 2688 + (r - 2816); else n = 3728 + (r - 3840);
        if (n >= 0) v = inp(F, I_BIN)[l * NIN + n];
        WSP(float, WS_BIAS)[i] = v;
    }
}

__device__ __forceinline__ void norm_mod_row(const GAS float* xrow, const GAS float* g, const GAS float* shift, const GAS float* scale, GAS bf16* orow, int lane, float* keep  ) {
    f32x4 v[4]; float s = 0.f;
#pragma unroll
    for (int j = 0; j < 4; ++j) { v[j] = *(const GAS f32x4*)(xrow + 256 * j + 4 * lane); s += (v[j].x * v[j].x + v[j].y * v[j].y) + (v[j].z * v[j].z + v[j].w * v[j].w); }
    const float r = rsqrtf(wave_sum(s) * (1.0f / 1024.0f) + 1e-6f);
#pragma unroll
    for (int j = 0; j < 4; ++j) {
        const f32x4 gg = *(const GAS f32x4*)(g + 256 * j + 4 * lane), sh = *(const GAS f32x4*)(shift + 256 * j + 4 * lane), sc = *(const GAS f32x4*)(scale + 256 * j + 4 * lane);
        f32x4 o;
        o.x = (v[j].x * r * gg.x) * (1.f + sc.x) + sh.x; o.y = (v[j].y * r * gg.y) * (1.f + sc.y) + sh.y;
        o.z = (v[j].z * r * gg.z) * (1.f + sc.z) + sh.z; o.w = (v[j].w * r * gg.w) * (1.f + sc.w) + sh.w;
        if (keep) { keep[4 * j + 0] = o.x; keep[4 * j + 1] = o.y; keep[4 * j + 2] = o.z; keep[4 * j + 3] = o.w; }
        u32x2 w; w.x = pk2(o.x, o.y); w.y = pk2(o.z, o.w);
        *(GAS u32x2*)(orow + 256 * j + 4 * lane) = w;
    }
}
__device__ __forceinline__ const GAS float* xrow_ptr(const Frame& F, int row, bool from_input) {
    if (row < TOKL) return (from_input ? inp(F, I_X) : outp(F)) + (size_t)row * D;
    return (from_input ? inp(F, I_CTX) : WSP(const float, WS_XC)) + (size_t)(row - TOKL) * D;
}
__device__ __forceinline__ void phase_norm(Frame& F, int layer, int nrows, bool from_input, int which) {
    const int gw = F.wg * NWAVES + F.wave, NGW = F.G * NWAVES;
    const GAS float* g = inp(F, which == 0 ? I_GMIX : I_GFFN) + layer * D;
    for (int row = gw; row < nrows; row += NGW)
        norm_mod_row(xrow_ptr(F, row, from_input), g, mod_ptr(F, layer, row, which), mod_ptr(F, layer, row, which + 1), WSP(bf16, WS_H) + (size_t)row * D, F.lane, nullptr);
}

namespace pg8 {
constexpr int BM = 256, BK = 64, HALF = 128, HTB = HALF * BK * 2, STAGE_BYTES = 8 * HTB, NXCD = 8, WGM = 8;
__device__ __forceinline__ int lds_byte(int r, int c) { const int st = (r >> 4) * 2 + (c >> 5), rr = r & 15, cc = c & 31, ob = rr * 64 + cc * 2; return st * 1024 + (ob ^ (((ob >> 9) & 1) << 5)); }
__device__ __forceinline__ void stage_rc(int b, int& R, int& C) { const int st = b / 1024, sb = b % 1024, swz = sb ^ (((sb >> 9) & 1) << 5); R = (st >> 1) * 16 + swz / 64; C = (st & 1) * 32 + (swz % 64) / 2; }
struct Unit { int pm, pn; };
struct OrderPlain {
    static constexpr bool GATHER = false;
    int nM, nN, nwg, G, c;
    __device__ __forceinline__ void init(int nM_, int nN_, int G_, int c_) { nM = nM_; nN = nN_; nwg = nM * nN; G = G_; c = c_; }
    __device__ __forceinline__ bool next(int i, Unit& u) const {
        const long L = (long)i * G + c; if (L >= nwg) return false;
        int wgid = (int)L; { const int q = nwg / NXCD, r = nwg % NXCD, xcd = wgid % NXCD, off = wgid / NXCD; wgid = (xcd < r ? xcd * (q + 1) : r * (q + 1) + (xcd - r) * q) + off; }
        const int nig = WGM * nN, gid = wgid / nig, fm = gid * WGM, gsz = (nM - fm) < WGM ? (nM - fm) : WGM;
        u.pm = fm + ((wgid % nig) % gsz); u.pn = (wgid % nig) / gsz; return true;
    }
    __device__ __forceinline__ int arow(int r) const { return r; }
    __device__ __forceinline__ size_t boff(const Unit&) const { return 0; }
};
struct OrderMoe {
    static constexpr bool GATHER = true;
    OrderPlain o; const GAS int* rowidx; const GAS int* tilee; int t0; size_t bstride; bool gather;
    __device__ __forceinline__ bool next(int i, Unit& u) const { return o.next(i, u); }
    __device__ __forceinline__ int arow(int r) const { return gather ? rowidx[t0 * 256 + r] : r; }
    __device__ __forceinline__ size_t boff(const Unit& u) const { return (size_t)tilee[t0 + u.pm] * bstride; }
};

template <class Epi, class Sched>
__device__ __forceinline__ void gemm_phase(LAS unsigned char* lds, int tid_in, const GAS bf16* A, int lda, const GAS bf16* Bt, int ldb, int K, const Sched& S, const Epi& E) {
    unsigned tid_u = (unsigned)tid_in; asm volatile("" : "+v"(tid_u));
    const int tid = (int)tid_u, wid = __builtin_amdgcn_readfirstlane(tid >> 6), lane = tid & 63, wr = wid >> 2, wc = wid & 3, fr = lane & 15, fq = lane >> 4;
    const int nt = K / BK;
    unsigned voffB[2];
    { int sR[2], sC[2];
#pragma unroll
      for (int i = 0; i < 2; ++i) { stage_rc(tid * 16 + i * 8192, sR[i], sC[i]); voffB[i] = (unsigned)(sR[i] * ldb + sC[i]) * 2u; } }
#define PG8_GATHER_OFFS(pm_) do { unsigned _t = (unsigned)tid; asm volatile("" : "+v"(_t)); _Pragma("unroll") for (int i = 0; i < 2; ++i) { int _R, _C; stage_rc((int)_t * 16 + i * 8192, _R, _C); \
        vc0[i] = (unsigned)((size_t)S.arow((pm_) * BM + _R) * lda + _C) * 2u; vc1[i] = (unsigned)((size_t)S.arow((pm_) * BM + HALF + _R) * lda + _C) * 2u; } } while (0)
    const size_t kstep = (size_t)(BK * 2);
    const size_t hstepB = (size_t)HALF * ldb * 2, tstepB = 2 * hstepB;
    const unsigned ldsw = (unsigned)wid * 1024u;
    const int aoff = lds_byte(wr * 64 + fr, fq * 8), boff = lds_byte(wc * 32 + fr, fq * 8);
#define PG8_SA(b, h) (((b) * 2 + (h)) * HTB)
#define PG8_SB(b, h) ((4 + (b) * 2 + (h)) * HTB)
#define PG8_STAGE2(bufoff, gbase, v0, v1) do { \
        __builtin_amdgcn_global_load_lds((const GAS unsigned*)((const GAS char*)(gbase) + (v0)), (LAS unsigned*)(lds + (bufoff) + ldsw), 16, 0, 0); \
        __builtin_amdgcn_global_load_lds((const GAS unsigned*)((const GAS char*)(gbase) + (v1)), (LAS unsigned*)(lds + (bufoff) + ldsw + 8192), 16, 0, 0); } while (0)
#define PG8_STAGEB(bufoff, gbase) PG8_STAGE2(bufoff, gbase, voffB[0], voffB[1])
#define PG8_LDA(dst, b, h) do { _Pragma("unroll") for (int m = 0; m < 4; ++m) _Pragma("unroll") for (int k = 0; k < 2; ++k) dst[m][k] = *(const LAS bf16x8*)(lds + PG8_SA(b, h) + aoff + m * 2048 + k * 1024); } while (0)
#define PG8_LDB(dst, b, h) do { _Pragma("unroll") for (int n = 0; n < 2; ++n) _Pragma("unroll") for (int k = 0; k < 2; ++k) dst[n][k] = *(const LAS bf16x8*)(lds + PG8_SB(b, h) + boff + n * 2048 + k * 1024); } while (0)
#define PG8_MMA(ai, bj, At, Bt_) do { __builtin_amdgcn_s_setprio(1); _Pragma("unroll") for (int m = 0; m < 4; ++m) _Pragma("unroll") for (int n = 0; n < 2; ++n) _Pragma("unroll") for (int k = 0; k < 2; ++k) \
        acc[ai][bj][m][n] = __builtin_amdgcn_mfma_f32_16x16x32_bf16(Bt_[n][k], At[m][k], acc[ai][bj][m][n], 0, 0, 0); __builtin_amdgcn_s_setprio(0); } while (0)
#define PG8_WAIT_V(n) asm volatile("s_waitcnt vmcnt(" #n ")" ::: "memory")
#define PG8_WAIT_L(n) asm volatile("s_waitcnt lgkmcnt(" #n ")" ::: "memory")
#define PG8_BAR __builtin_amdgcn_s_barrier()
#define PG8_SCHED __builtin_amdgcn_sched_barrier(0)
    Unit cur, nxt; int ui = 0;
    if (!S.next(0, cur)) return;
    f32x4 acc[2][2][4][2];
#pragma unroll
    for (int a = 0; a < 2; ++a)
#pragma unroll
        for (int b = 0; b < 2; ++b)
#pragma unroll
            for (int m = 0; m < 4; ++m)
#pragma unroll
                for (int n = 0; n < 2; ++n) { float zf; asm volatile("v_mov_b32 %0, 0" : "=v"(zf)); acc[a][b][m][n] = (f32x4){zf, zf, zf, zf}; }
    bf16x8 At[4][2], B0[2][2], B1[2][2];
    constexpr bool GA = Sched::GATHER;
    const size_t hstepA = GA ? 0 : (size_t)HALF * lda * 2, tstepA = (size_t)BM * lda * 2;
    unsigned vc0[2], vc1[2];
    if constexpr (GA) { PG8_GATHER_OFFS(cur.pm); }
    else { int sR, sC;
#pragma unroll
        for (int i = 0; i < 2; ++i) { stage_rc(tid * 16 + i * 8192, sR, sC); vc0[i] = (unsigned)(sR * lda + sC) * 2u; vc1[i] = 0u; } }
#define VC0(i) vc0[i]
#define VC1(i) (GA ? vc1[i] : vc0[i])
#define VN0(i) vc0[i]
#define VN1(i) VC1(i)
    const GAS char* cA = GA ? (const GAS char*)A : (const GAS char*)A + (size_t)cur.pm * tstepA;
    const GAS char* cB = (const GAS char*)Bt + S.boff(cur) * 2 + (size_t)cur.pn * tstepB;
    PG8_STAGEB(PG8_SB(0, 0), cB); PG8_STAGE2(PG8_SA(0, 0), cA, VC0(0), VC0(1)); PG8_STAGEB(PG8_SB(0, 1), cB + hstepB); PG8_STAGE2(PG8_SA(0, 1), cA + hstepA, VC1(0), VC1(1));
    if (wr == 1) PG8_BAR;
    PG8_WAIT_V(4); PG8_BAR;
    PG8_STAGEB(PG8_SB(1, 0), cB + kstep); PG8_STAGE2(PG8_SA(1, 0), cA + kstep, VC0(0), VC0(1)); PG8_STAGEB(PG8_SB(1, 1), cB + hstepB + kstep);
    PG8_WAIT_V(6); PG8_BAR;
    for (;;) {
        const bool has_next = S.next(ui + 1, nxt);
        const GAS char* nB = cB; const GAS char* nA = cA;
        if (has_next) {
            nB = (const GAS char*)Bt + S.boff(nxt) * 2 + (size_t)nxt.pn * tstepB;
            if constexpr (!GA) nA = (const GAS char*)A + (size_t)nxt.pm * tstepA;
        }
        for (int t = 0; t < nt; t += 2) {
            const bool last = (t == nt - 2);
            if constexpr (Epi::HORNER) {
                if (t == 6 || t == 12) {
                    asm volatile("" ::: "memory");
                    const int seg = (t == 6) ? 0 : 1;
                    int hpm = cur.pm, hpn = cur.pn; asm volatile("" : "+s"(hpm), "+s"(hpn));
                    unsigned hln = (unsigned)lane; asm volatile("" : "+v"(hln)); const int hfr = (int)(hln & 15u), hfq = (int)(hln >> 4);
#pragma unroll
                    for (int ai = 0; ai < 2; ++ai) {
                        u32x2 ga[4][2][2], gb[4][2][2];
#pragma unroll
                        for (int m = 0; m < 4; ++m)
#pragma unroll
                            for (int bj = 0; bj < 2; ++bj)
#pragma unroll
                                for (int n = 0; n < 2; ++n) {
                                    const int row = hpm * BM + ai * HALF + wr * 64 + m * 16 + hfr, col = hpn * BM + bj * HALF + wc * 32 + n * 16 + 4 * hfq;
                                    ga[m][bj][n] = E.gate(seg, row, col); gb[m][bj][n] = E.gate(seg + 1, row, col);
                                }
                        asm volatile("" : "+v"(ga[0][0][0]), "+v"(ga[0][0][1]), "+v"(ga[0][1][0]), "+v"(ga[0][1][1]), "+v"(ga[1][0][0]), "+v"(ga[1][0][1]), "+v"(ga[1][1][0]), "+v"(ga[1][1][1]),
                                          "+v"(ga[2][0][0]), "+v"(ga[2][0][1]), "+v"(ga[2][1][0]), "+v"(ga[2][1][1]), "+v"(ga[3][0][0]), "+v"(ga[3][0][1]), "+v"(ga[3][1][0]), "+v"(ga[3][1][1]) :: "memory");
                        asm volatile("" : "+v"(gb[0][0][0]), "+v"(gb[0][0][1]), "+v"(gb[0][1][0]), "+v"(gb[0][1][1]), "+v"(gb[1][0][0]), "+v"(gb[1][0][1]), "+v"(gb[1][1][0]), "+v"(gb[1][1][1]),
                                          "+v"(gb[2][0][0]), "+v"(gb[2][0][1]), "+v"(gb[2][1][0]), "+v"(gb[2][1][1]), "+v"(gb[3][0][0]), "+v"(gb[3][0][1]), "+v"(gb[3][1][0]), "+v"(gb[3][1][1]) :: "memory");
#pragma unroll
                        for (int m = 0; m < 4; ++m)
#pragma unroll
                            for (int bj = 0; bj < 2; ++bj)
#pragma unroll
                                for (int n = 0; n < 2; ++n) {
                                    const u32x2 a = ga[m][bj][n], b = gb[m][bj][n];
                                    f32x4& v = acc[ai][bj][m][n];
                                    v.x *= __uint_as_float(a.x << 16) * __builtin_amdgcn_rcpf(__uint_as_float(b.x << 16));
                                    v.y *= __uint_as_float(a.x & 0xffff0000u) * __builtin_amdgcn_rcpf(__uint_as_float(b.x & 0xffff0000u));
                                    v.z *= __uint_as_float(a.y << 16) * __builtin_amdgcn_rcpf(__uint_as_float(b.y << 16));
                                    v.w *= __uint_as_float(a.y & 0xffff0000u) * __builtin_amdgcn_rcpf(__uint_as_float(b.y & 0xffff0000u));
                                }
                    }
                    asm volatile("s_waitcnt vmcnt(0)" ::: "memory");
                }
            }
            const GAS char* a1 = cA + (size_t)(t + 1) * kstep;
            const GAS char* a2 = last ? nA : cA + (size_t)(t + 2) * kstep; const GAS char* b2 = last ? nB : cB + (size_t)(t + 2) * kstep;
            const GAS char* a3 = a2 + kstep; const GAS char* b3 = b2 + kstep;
            PG8_LDB(B0, 0, 0); PG8_SCHED; PG8_LDA(At, 0, 0); PG8_STAGE2(PG8_SA(1, 1), a1 + hstepA, VC1(0), VC1(1));
            if constexpr (GA) { if (last && has_next) { asm volatile("" ::: "memory"); PG8_GATHER_OFFS(nxt.pm); asm volatile("" ::: "memory"); } }
            PG8_WAIT_L(8); PG8_BAR; PG8_WAIT_L(0); PG8_MMA(0, 0, At, B0); PG8_BAR; PG8_SCHED;
            PG8_LDB(B1, 0, 1); PG8_STAGEB(PG8_SB(0, 0), b2);
            PG8_BAR; PG8_WAIT_L(0); PG8_MMA(0, 1, At, B1); PG8_BAR;
            PG8_LDA(At, 0, 1); PG8_STAGE2(PG8_SA(0, 0), a2, VN0(0), VN0(1));
            PG8_BAR; PG8_WAIT_L(0); PG8_MMA(1, 0, At, B0); PG8_BAR; PG8_SCHED;
            PG8_STAGEB(PG8_SB(0, 1), b2 + hstepB);
            PG8_WAIT_V(6); PG8_BAR; PG8_MMA(1, 1, At, B1); PG8_BAR;
            PG8_LDB(B0, 1, 0); PG8_SCHED; PG8_LDA(At, 1, 0); PG8_STAGE2(PG8_SA(0, 1), a2 + hstepA, VN1(0), VN1(1));
            PG8_WAIT_L(8); PG8_BAR; PG8_WAIT_L(0); PG8_MMA(0, 0, At, B0); PG8_BAR; PG8_SCHED;
            PG8_LDB(B1, 1, 1); PG8_STAGEB(PG8_SB(1, 0), b3);
            PG8_BAR; PG8_WAIT_L(0); PG8_MMA(0, 1, At, B1); PG8_BAR;
            PG8_LDA(At, 1, 1); PG8_STAGE2(PG8_SA(1, 0), a3, VN0(0), VN0(1));
            PG8_BAR; PG8_WAIT_L(0); PG8_MMA(1, 0, At, B0); PG8_BAR; PG8_SCHED;
            PG8_STAGEB(PG8_SB(1, 1), b3 + hstepB);
            PG8_WAIT_V(6); PG8_BAR; PG8_MMA(1, 1, At, B1); PG8_BAR;
        }
        {
            int epm = cur.pm, epn = cur.pn; asm volatile("" : "+s"(epm), "+s"(epn));
            unsigned eln = (unsigned)lane; asm volatile("" : "+v"(eln)); const int efr = (int)(eln & 15u), efq = (int)(eln >> 4);
            f32x4 cv[2][2];
#pragma unroll
            for (int bj = 0; bj < 2; ++bj)
#pragma unroll
                for (int n = 0; n < 2; ++n) { if constexpr (Epi::COLVEC) cv[bj][n] = E.colvec(epm * BM, epn * BM + bj * HALF + wc * 32 + n * 16 + 4 * efq); else cv[bj][n] = (f32x4){0.f, 0.f, 0.f, 0.f}; }
            if constexpr (Epi::COLVEC) asm volatile("" : "+v"(cv[0][0]), "+v"(cv[0][1]), "+v"(cv[1][0]), "+v"(cv[1][1]) :: "memory");
#pragma unroll
            for (int ai = 0; ai < 2; ++ai) {
                f32x4 bs[4][2][2];
                if constexpr (Epi::BASE) {
#pragma unroll
                    for (int m = 0; m < 4; ++m)
#pragma unroll
                        for (int bj = 0; bj < 2; ++bj)
#pragma unroll
                            for (int n = 0; n < 2; ++n) bs[m][bj][n] = E.base(epm * BM + ai * HALF + wr * 64 + m * 16 + efr, epn * BM + bj * HALF + wc * 32 + n * 16 + 4 * efq);
                    asm volatile("" : "+v"(bs[0][0][0]), "+v"(bs[0][0][1]), "+v"(bs[0][1][0]), "+v"(bs[0][1][1]), "+v"(bs[1][0][0]), "+v"(bs[1][0][1]), "+v"(bs[1][1][0]), "+v"(bs[1][1][1]),
                                      "+v"(bs[2][0][0]), "+v"(bs[2][0][1]), "+v"(bs[2][1][0]), "+v"(bs[2][1][1]), "+v"(bs[3][0][0]), "+v"(bs[3][0][1]), "+v"(bs[3][1][0]), "+v"(bs[3][1][1]) :: "memory");
                }
#pragma unroll
                for (int m = 0; m < 4; ++m) {
                    const int row = epm * BM + ai * HALF + wr * 64 + m * 16 + efr;
#pragma unroll
                    for (int bj = 0; bj < 2; ++bj) {
                        if constexpr (Epi::PAIR) E.store_pair(row, epn * (BM / 2) + bj * (HALF / 2) + wc * 16 + 4 * efq, acc[ai][bj][m][0], acc[ai][bj][m][1]);
                        else {
#pragma unroll
                            for (int n = 0; n < 2; ++n) { f32x4 bb = (f32x4){0.f, 0.f, 0.f, 0.f}; if constexpr (Epi::BASE) bb = bs[m][bj][n]; E.store(row, epn * BM + bj * HALF + wc * 32 + n * 16 + 4 * efq, acc[ai][bj][m][n], cv[bj][n], bb); }
                        }
                    }
                }
            }
        }
        if (!has_next) break;
#pragma unroll
        for (int a = 0; a < 2; ++a)
#pragma unroll
            for (int b = 0; b < 2; ++b)
#pragma unroll
                for (int m = 0; m < 4; ++m)
#pragma unroll
                    for (int n = 0; n < 2; ++n) { float zf; asm volatile("v_mov_b32 %0, 0" : "=v"(zf)); acc[a][b][m][n] = (f32x4){zf, zf, zf, zf}; }
        cur = nxt; cB = nB; cA = nA; ++ui;
    }
    PG8_WAIT_V(0);
    if (wr == 0) PG8_BAR;
    PG8_BAR;
#undef PG8_GATHER_OFFS
#undef VC0
#undef VC1
#undef VN0
#undef VN1
#undef PG8_SA
#undef PG8_SB
#undef PG8_STAGE2
#undef PG8_STAGEB
#undef PG8_LDA
#undef PG8_LDB
#undef PG8_MMA
#undef PG8_WAIT_V
#undef PG8_WAIT_L
#undef PG8_BAR
#undef PG8_SCHED
}
}

template <class Epi>
__device__ __forceinline__ void gemm_fast(Frame& F, const GAS bf16* A, int lda, const GAS bf16* Bt, int ldb, int K, int M, int N, const Epi& E) {
    pg8::OrderPlain S; S.init(M / 256, N / 256, F.G, F.wg);
    pg8::gemm_phase(F.lds, F.tid, A, lda, Bt, ldb, K, S, E);
}
#ifndef FAST_PLAIN
#define FAST_PLAIN 1
#endif
#ifndef FAST_HORNER
#define FAST_HORNER 1
#endif
#ifndef FAST_MOE
#define FAST_MOE 1
#endif

__device__ __forceinline__ void st_bf16x4(GAS bf16* p, f32x4 v) { u32x2 w; w.x = pk2(v.x, v.y); w.y = pk2(v.z, v.w); *(GAS u32x2*)p = w; }
__device__ __forceinline__ f32x4 ld_bf16x4(const GAS bf16* p) { const u32x2 w = *(const GAS u32x2*)p; f32x4 v; v.x = __uint_as_float(w.x << 16); v.y = __uint_as_float(w.x & 0xffff0000u); v.z = __uint_as_float(w.y << 16); v.w = __uint_as_float(w.y & 0xffff0000u); return v; }

struct EpiWin {
    static constexpr bool HORNER = false, PAIR = false, COLVEC = true, BASE = false;
    const GAS float* bias; GAS bf16 *hytl, *hytc, *ret, *ml; GAS float* mlg;
    __device__ __forceinline__ f32x4 colvec(int, int col) const { return *(const GAS f32x4*)(bias + col); }
    __device__ __forceinline__ void store(int row, int col, f32x4 v, f32x4 cv, f32x4) const {
        v += cv;
        if (col < 1152) {
            if (row < TOKL) { const int b = row >> 11, t = row & 2047; GAS bf16* d = hytl + ((size_t)(b * 1152 + col)) * 2048 + t;
                d[0] = (bf16)f2bf(v.x); d[2048] = (bf16)f2bf(v.y); d[4096] = (bf16)f2bf(v.z); d[6144] = (bf16)f2bf(v.w); }
            else { const int r = row - TOKL, b = r >> 8, t = r & 255; GAS bf16* d = hytc + ((size_t)(b * 1152 + col)) * 256 + t;
                d[0] = (bf16)f2bf(v.x); d[256] = (bf16)f2bf(v.y); d[512] = (bf16)f2bf(v.z); d[768] = (bf16)f2bf(v.w); }
        } else if (col < 1168) { *(GAS f32x4*)(mlg + (size_t)row * 16 + (col - 1152)) = v; }
        else if (col < 1280) { }
        else if (col < 2816) st_bf16x4(ret + (size_t)row * 1536 + (col - 1280), v);
        else st_bf16x4(ml + (size_t)row * 1024 + (col - 2816), v);
    }
};
struct EpiGate {
    static constexpr bool HORNER = false, PAIR = false, COLVEC = true, BASE = false;
    const GAS float* bias; GAS bf16* gates;
    __device__ __forceinline__ f32x4 colvec(int, int col) const { return *(const GAS f32x4*)(bias + col); }
    __device__ __forceinline__ void store(int row, int col, f32x4 v, f32x4 cv, f32x4) const {
        v += cv;
        f32x4 g; g.x = fmaxf(sigmoidf_(v.x), 1e-20f); g.y = fmaxf(sigmoidf_(v.y), 1e-20f); g.z = fmaxf(sigmoidf_(v.z), 1e-20f); g.w = fmaxf(sigmoidf_(v.w), 1e-20f);
        st_bf16x4(gates + (size_t)row * NGATE + col, g);
    }
};
struct EpiUp {
    static constexpr bool HORNER = true, PAIR = false, COLVEC = false, BASE = true;
    const GAS bf16* gates; GAS bf16* acc_out;
    __device__ __forceinline__ u32x2 gate(int which, int row, int col) const { return *(const GAS u32x2*)(gates + (size_t)row * NGATE + which * 1024 + col); }
    __device__ __forceinline__ f32x4 base(int row, int col) const { return ld_bf16x4(gates + (size_t)row * NGATE + 2048 + col); }
    __device__ __forceinline__ void store(int row, int col, f32x4 v, f32x4, f32x4 g) const { st_bf16x4(acc_out + (size_t)row * D + col, v * g); }
};
struct EpiResid {
    static constexpr bool HORNER = false, PAIR = false, COLVEC = true, BASE = true;
    const GAS float *xin_l, *xin_c; GAS float *xout_l, *xout_c; const GAS float* modbase; int which;
    __device__ __forceinline__ f32x4 colvec(int row0, int col) const { const int r = row0 < TOKL ? (row0 >> 11) : 16; return *(const GAS f32x4*)(modbase + ((size_t)r * 6 + which) * 1024 + col); }
    __device__ __forceinline__ f32x4 base(int row, int col) const { return row < TOKL ? *(const GAS f32x4*)(xin_l + (size_t)row * D + col) : *(const GAS f32x4*)(xin_c + (size_t)(row - TOKL) * D + col); }
    __device__ __forceinline__ void store(int row, int col, f32x4 v, f32x4 m, f32x4 x) const {
        if (row < TOKL) *(GAS f32x4*)(xout_l + (size_t)row * D + col) = x + m * v;
        else *(GAS f32x4*)(xout_c + (size_t)(row - TOKL) * D + col) = x + m * v;
    }
};
struct EpiSwiglu {
    static constexpr bool HORNER = false, PAIR = true, COLVEC = false, BASE = false;
    GAS bf16* act; int row_off;
    __device__ __forceinline__ void store_pair(int row, int col, f32x4 a, f32x4 b) const {
        f32x4 o; o.x = siluf_(a.x) * b.x; o.y = siluf_(a.y) * b.y; o.z = siluf_(a.z) * b.z; o.w = siluf_(a.w) * b.w;
        st_bf16x4(act + (size_t)(row - row_off) * DFF + col, o);
    }
    __device__ __forceinline__ void store(int, int, f32x4, f32x4, f32x4) const {}
};
struct EpiBf16Out {
    static constexpr bool HORNER = false, PAIR = false, COLVEC = false, BASE = false;
    GAS bf16* out; int ld; int row_add;
    __device__ __forceinline__ void store(int row, int col, f32x4 v, f32x4, f32x4) const { st_bf16x4(out + (size_t)(row + row_add) * ld + col, v); }
    __device__ __forceinline__ void store_pair(int, int, f32x4, f32x4) const {}
};

constexpr int ZPITCH_L = (LL + 8) * 2, ZPITCH_C = (LC + 8) * 2;
template <int L>
__device__ __forceinline__ float conv3_at(const GAS bf16* base  , int t, float w0, float w1, float w2) {
    const float a = t > 0 ? bf2f(base[t - 1]) : 0.f, b = bf2f(base[t]), c = t < L - 1 ? bf2f(base[t + 1]) : 0.f;
    return w0 * a + w1 * b + w2 * c;
}
template <int L>
__device__ __forceinline__ void hyena_unit_naive(Frame& F, int layer, int c, const GAS bf16* hyt  , const GAS bf16* ft  , GAS bf16* yht  ) {
    constexpr int ZP = (L + 8) * 2;
    constexpr int PER = L / 32;
    constexpr int SUB = 8;
    LAS unsigned char* zimg0 = F.lds;
    LAS unsigned char* zimg1 = F.lds + 16 * ZP;
    LAS bf16* tf = (LAS bf16*)(F.lds + 32 * ZP);
    const GAS float* cw = inp(F, I_HYCONV) + layer * 3 * 1152;
    const GAS float* skip = inp(F, I_HYSKIP) + layer * 2 * 384;
    __syncthreads();
    {
        const int b = F.tid >> 5, seg = F.tid & 31; const GAS bf16* src = hyt + ((size_t)(b * 1152 + c)) * L;
        const float w0 = cw[c], w1 = cw[1152 + c], w2 = cw[2304 + c];
#pragma unroll 2
        for (int j = 0; j < PER; ++j) { const int t = seg * PER + j; *(LAS bf16*)(zimg0 + b * ZP + t * 2) = (bf16)f2bf(conv3_at<L>(src, t, w0, w1, w2)); }
    }
#pragma unroll 1
    for (int o = 0; o < 2; ++o) {
        LAS unsigned char* zs = o == 0 ? zimg0 : zimg1;
        LAS unsigned char* zd = o == 0 ? zimg1 : zimg0;
        const GAS bf16* fsrc = ft + ((size_t)(o * 384 + c)) * (2 * L);
        for (int i = F.tid; i < 2 * L; i += NTHR) tf[i] = i == 0 ? (bf16)0 : fsrc[i];
        __syncthreads();
        const int b = F.tid & 15, tg = F.tid >> 4;
        const int gcol = (o == 0 ? 384 : 768) + c;
        const GAS bf16* gsrc = hyt + ((size_t)(b * 1152 + gcol)) * L;
        const float w0 = cw[gcol], w1 = cw[1152 + gcol], w2 = cw[2304 + gcol], sk = skip[o * 384 + c];
#pragma unroll 1
        for (int sb = 0; sb < PER / SUB; ++sb) {
            const int t0 = tg * PER + sb * SUB;
            float acc[SUB];
#pragma unroll
            for (int j = 0; j < SUB; ++j) acc[j] = 0.f;
#pragma unroll 1
            for (int s0 = 0; s0 < L; s0 += 8) {
                float z[8];
                { const bf16x8 zz = *(const LAS bf16x8*)(zs + b * ZP + s0 * 2);
#pragma unroll
                  for (int i = 0; i < 8; ++i) z[i] = bf2f((bf16)zz[i]); }
                float win[SUB + 7];
                const int wb = L + s0 - t0 - (SUB - 1);
#pragma unroll
                for (int i = 0; i < SUB + 7; ++i) win[i] = bf2f(tf[wb + i]);
#pragma unroll
                for (int j = 0; j < SUB; ++j)
#pragma unroll
                    for (int i = 0; i < 8; ++i) acc[j] += win[(SUB - 1) - j + i] * z[i];
            }
#pragma unroll
            for (int j = 0; j < SUB; ++j) {
                const int t = t0 + j;
                const float zt = bf2f(*(LAS bf16*)(zs + b * ZP + t * 2));
                const float ov = conv3_at<L>(gsrc, t, w0, w1, w2) * (acc[j] + sk * zt);
                *(LAS bf16*)(zd + b * ZP + t * 2) = (bf16)f2bf(ov);
            }
        }
        __syncthreads();
    }
#pragma unroll 2
    for (int i = F.tid; i < 16 * (L / 8); i += NTHR) {
        const int b = i / (L / 8), ch = i % (L / 8);
        *(GAS u32x4*)(yht + ((size_t)(b * 384 + c)) * L + ch * 8) = *(const LAS u32x4*)(zimg0 + b * ZP + ch * 16);
    }
}

template <int L>
__device__ __forceinline__ void hyena_unit_fast(Frame& F, int layer, int c, const GAS bf16* hyt  , const GAS bf16* ft  , GAS bf16* yht  ) {
    constexpr int ZP = (L + 8) * 2;
    constexpr int PER = L / 32;
    constexpr int I = L / 128;
    constexpr int SPAN = L / 4, NSTEP = L / 32;
    constexpr int CP = (2 * L + 8) * 2;
    LAS unsigned char* zimg = F.lds;
    LAS unsigned char* cpy = F.lds + 16 * ZP;
    const GAS float* cw = inp(F, I_HYCONV) + layer * 3 * 1152;
    const GAS float* skip = inp(F, I_HYSKIP) + layer * 2 * 384;
    const int lane = F.lane, fr = lane & 15, fq = lane >> 4, w = F.wave;
    { unsigned long long a_ = (unsigned long long)hyt, b_ = (unsigned long long)yht; asm volatile("" : "+s"(a_), "+s"(b_)); hyt = (const GAS bf16*)a_; yht = (GAS bf16*)b_; }
    __syncthreads();
    {
        const int b = F.tid >> 5, sg = F.tid & 31, t0 = sg * PER; const GAS bf16* src = hyt + ((size_t)(b * 1152 + c)) * L + t0;
        const float w0 = cw[c], w1 = cw[1152 + c], w2 = cw[2304 + c];
        u32x4 raw[PER / 8];
#pragma unroll
        for (int j = 0; j < PER / 8; ++j) raw[j] = *(const GAS u32x4*)(src + 8 * j);
        float prev = t0 > 0 ? bf2f(src[-1]) : 0.f;
        const float nextv = t0 + PER < L ? bf2f(src[PER]) : 0.f;
#pragma unroll
        for (int j = 0; j < PER / 8; ++j) {
            const unsigned wv[4] = {raw[j].x, raw[j].y, raw[j].z, raw[j].w};
            float x[10]; x[0] = prev;
#pragma unroll
            for (int q = 0; q < 4; ++q) { x[1 + 2 * q] = __uint_as_float(wv[q] << 16); x[2 + 2 * q] = __uint_as_float(wv[q] & 0xffff0000u); }
            if (j + 1 < PER / 8) x[9] = __uint_as_float(raw[(j + 1 < PER / 8) ? j + 1 : j].x << 16); else x[9] = nextv;
            u32x4 o;
            o.x = pk2(w0 * x[0] + w1 * x[1] + w2 * x[2], w0 * x[1] + w1 * x[2] + w2 * x[3]); o.y = pk2(w0 * x[2] + w1 * x[3] + w2 * x[4], w0 * x[3] + w1 * x[4] + w2 * x[5]);
            o.z = pk2(w0 * x[4] + w1 * x[5] + w2 * x[6], w0 * x[5] + w1 * x[6] + w2 * x[7]); o.w = pk2(w0 * x[6] + w1 * x[7] + w2 * x[8], w0 * x[7] + w1 * x[8] + w2 * x[9]);
            *(LAS u32x4*)(zimg + b * ZP + (t0 + 8 * j) * 2) = o;
            prev = x[8];
        }
    }
    const int tbase = SPAN * (w >> 1) + 16 * (w & 1);
    const int flane = L - tbase + 8 * fq - fr;
    const int msh = fr & 7;
    const LAS unsigned char* fbase = cpy + msh * CP + 2 * (flane + msh);
#pragma unroll 1
    for (int o = 0; o < 2; ++o) {
        const GAS bf16* fsrc = ft + ((size_t)(o * 384 + c)) * (2 * L);
        for (int i = F.tid; i < CP / 16; i += NTHR) { u32x4 v = (u32x4){0u, 0u, 0u, 0u}; if (i < 2 * L / 8) v = *(const GAS u32x4*)(fsrc + 8 * i); if (i == 0) v.x &= 0xffff0000u; *(LAS u32x4*)(cpy + 16 * i) = v; }
        __syncthreads();
        for (int task = F.tid; task < 7 * (CP / 16); task += NTHR) {
            const int m = 1 + task / (CP / 16), x8 = task % (CP / 16);
            unsigned short e[8];
#pragma unroll
            for (int i = 0; i < 8; ++i) { const int idx = 8 * x8 - m + i; e[i] = idx >= 0 ? *(const LAS unsigned short*)(cpy + 2 * idx) : (unsigned short)0; }
            u32x4 v; v.x = e[0] | ((unsigned)e[1] << 16); v.y = e[2] | ((unsigned)e[3] << 16); v.z = e[4] | ((unsigned)e[5] << 16); v.w = e[6] | ((unsigned)e[7] << 16);
            *(LAS u32x4*)(cpy + m * CP + 16 * x8) = v;
        }
        __syncthreads();
        f32x4 acc[I];
#pragma unroll
        for (int i = 0; i < I; ++i) acc[i] = (f32x4){0.f, 0.f, 0.f, 0.f};
        bf16x8 ring[I];
#pragma unroll
        for (int i = 1; i < I; ++i) ring[(I - i) % I] = *(const LAS bf16x8*)(fbase - 64 * i);
        bf16x8 nf = *(const LAS bf16x8*)(fbase);
        const LAS unsigned char* zrow = zimg + fr * ZP + 16 * fq;
#pragma unroll 1
        for (int j0 = 0; j0 < NSTEP; j0 += I) {
#pragma unroll
            for (int jj = 0; jj < I; ++jj) {
                const int j = j0 + jj;
                ring[jj] = nf;
                if (j + 1 < NSTEP) nf = *(const LAS bf16x8*)(fbase + 64 * (j + 1));
                const bf16x8 zf = *(const LAS bf16x8*)(zrow + 64 * j);
#pragma unroll
                for (int i = 0; i < I; ++i) acc[i] = __builtin_amdgcn_mfma_f32_16x16x32_bf16(ring[(jj - i + I) % I], zf, acc[i], 0, 0, 0);
            }
        }
        const int gcol = (o == 0 ? 384 : 768) + c;
        const GAS bf16* gsrc = hyt + ((size_t)(fr * 1152 + gcol)) * L;
        const float w0 = cw[gcol], w1 = cw[1152 + gcol], w2 = cw[2304 + gcol], sk = skip[o * 384 + c];
        GAS bf16* dst = yht + ((size_t)(fr * 384 + c)) * L;
        constexpr int GI = I < 8 ? I : 8;
#pragma unroll
        for (int i0 = 0; i0 < I; i0 += GI) {
            u32x2 grv[GI]; unsigned short gmv[GI], gpv[GI];
#pragma unroll
            for (int ii = 0; ii < GI; ++ii) {
                const int t = tbase + 32 * (i0 + ii) + 4 * fq;
                grv[ii] = *(const GAS u32x2*)(gsrc + t); gmv[ii] = t > 0 ? gsrc[t - 1] : (unsigned short)0; gpv[ii] = t + 4 < L ? gsrc[t + 4] : (unsigned short)0;
            }
            asm volatile("" ::: "memory");
#pragma unroll
            for (int ii = 0; ii < GI; ++ii) {
                const int i = i0 + ii;
                const int t = tbase + 32 * i + 4 * fq;
                const u32x2 zr = *(const LAS u32x2*)(zimg + fr * ZP + t * 2);
                const u32x2 gr = grv[ii];
                const float gm = bf2f(gmv[ii]), gp = bf2f(gpv[ii]);
                const float g0 = __uint_as_float(gr.x << 16), g1 = __uint_as_float(gr.x & 0xffff0000u), g2 = __uint_as_float(gr.y << 16), g3 = __uint_as_float(gr.y & 0xffff0000u);
                const float z0 = __uint_as_float(zr.x << 16), z1 = __uint_as_float(zr.x & 0xffff0000u), z2 = __uint_as_float(zr.y << 16), z3 = __uint_as_float(zr.y & 0xffff0000u);
                const float o0 = (w0 * gm + w1 * g0 + w2 * g1) * (acc[i].x + sk * z0), o1 = (w0 * g0 + w1 * g1 + w2 * g2) * (acc[i].y + sk * z1);
                const float o2 = (w0 * g1 + w1 * g2 + w2 * g3) * (acc[i].z + sk * z2), o3 = (w0 * g2 + w1 * g3 + w2 * gp) * (acc[i].w + sk * z3);
                acc[i] = (f32x4){o0, o1, o2, o3};
            }
        }
        __syncthreads();
#pragma unroll
        for (int i = 0; i < I; ++i) {
            const int t = tbase + 32 * i + 4 * fq;
            u32x2 ov; ov.x = pk2(acc[i].x, acc[i].y); ov.y = pk2(acc[i].z, acc[i].w);
            if (o == 0) *(LAS u32x2*)(zimg + fr * ZP + t * 2) = ov;
            else *(GAS u32x2*)(dst + t) = ov;
        }
    }
}

__device__ __forceinline__ void chain_naive(Frame& F, int layer, int chain) {
    const int lane = F.lane;
    const bool is_ret = chain < 192;
    int b, h, dir;
    if (is_ret) { b = chain / 12; const int r = chain % 12; h = r >> 1; dir = r & 1; }
    else { const int i = chain - 192; b = i >> 3; h = (i & 7) >> 1; dir = i & 1; }
    const GAS bf16* RET = WSP(const bf16, WS_RET); const GAS bf16* ML = WSP(const bf16, WS_ML); const GAS float* MLG = WSP(const float, WS_MLG);
    const GAS float* rope = WSP(const float, WS_ROPE);
    GAS bf16* Y = WSP(bf16, WS_Y); GAS bf16* OB = WSP(bf16, WS_OB);
    float gam = 0.f;
    if (is_ret) gam = sigmoidf_(inp(F, I_RETDECAY)[layer * 12 + dir * 6 + h]);
    const GAS float* mlc = inp(F, I_MLCONV) + layer * 3 * 512;
    const float bi = is_ret ? 0.f : inp(F, I_MLGB)[layer * 16 + dir * 8 + h], bfg = is_ret ? 0.f : inp(F, I_MLGB)[layer * 16 + dir * 8 + 4 + h];
    const float qw0 = mlc[h * 64 + lane], qw1 = mlc[512 + h * 64 + lane], qw2 = mlc[1024 + h * 64 + lane];
    const float kw0 = mlc[256 + h * 64 + lane], kw1 = mlc[512 + 256 + h * 64 + lane], kw2 = mlc[1024 + 256 + h * 64 + lane];
    float S[64];
#pragma unroll
    for (int d = 0; d < 64; ++d) S[d] = 0.f;
    float nv = 0.f;
    for (int step = 0; step < LC + LL; ++step) {
        int row, tpos, L; bool lat;
        if (step < LC) { tpos = dir ? (LC - 1 - step) : step; row = TOKL + b * LC + tpos; L = LC; lat = false; }
        else { const int s2 = step - LC; tpos = dir ? (LL - 1 - s2) : s2; row = b * LL + tpos; L = LL; lat = true; }
        float q, k, v, Fm, Im;
        if (is_ret) {
            const GAS bf16* base = RET + (size_t)row * 1536;
            float qs = bf2f(base[h * 64 + lane]), ks = bf2f(base[384 + h * 64 + lane]);
            v = bf2f(base[768 + h * 64 + lane]);
            if (lat) {
                const float qp = bf2f(base[h * 64 + (lane ^ 16)]), kp = bf2f(base[384 + h * 64 + (lane ^ 16)]);
                const int half = lane >> 5, ii = lane & 15, hi = (lane >> 4) & 1;
                const float cs = rope[tpos * 64 + half * 32 + ii], sn = rope[tpos * 64 + half * 32 + 16 + ii];
                q = hi == 0 ? qs * cs - qp * sn : qp * sn + qs * cs;
                k = hi == 0 ? ks * cs - kp * sn : kp * sn + ks * cs;
            } else { q = qs; k = ks; }
            q *= 0.125f; Fm = gam; Im = 1.f;
        } else {
            const GAS bf16* base = ML + (size_t)row * 1024;
            const float q0 = tpos > 0 ? bf2f(base[-1024 + h * 64 + lane]) : 0.f, q1 = bf2f(base[h * 64 + lane]), q2 = tpos < L - 1 ? bf2f(base[1024 + h * 64 + lane]) : 0.f;
            const float k0 = tpos > 0 ? bf2f(base[-1024 + 256 + h * 64 + lane]) : 0.f, k1 = bf2f(base[256 + h * 64 + lane]), k2 = tpos < L - 1 ? bf2f(base[1024 + 256 + h * 64 + lane]) : 0.f;
            q = siluf_(qw0 * q0 + qw1 * q1 + qw2 * q2);
            k = siluf_(kw0 * k0 + kw1 * k1 + kw2 * k2) * 0.125f;
            v = bf2f(base[512 + h * 64 + lane]);
            const float ig = MLG[(size_t)row * 16 + dir * 8 + h] + bi, fg = MLG[(size_t)row * 16 + dir * 8 + 4 + h] + bfg;
            Fm = sigmoidf_(fg); Im = __expf(ig);
        }
        float num = 0.f;
        const float iv = Im * v;
#pragma unroll
        for (int d = 0; d < 64; ++d) {
            const float kd = __int_as_float(__builtin_amdgcn_readlane(__float_as_int(k), d));
            const float qd = __int_as_float(__builtin_amdgcn_readlane(__float_as_int(q), d));
            S[d] = Fm * S[d] + kd * iv;
            num += qd * S[d];
        }
        float o = num;
        if (!is_ret) { nv = Fm * nv + Im * k; const float den = wave_sum(q * nv); o = num / fmaxf(fabsf(den), 1.f); }
        const int cof = is_ret ? (h * 64 + lane) : (384 + h * 64 + lane);
        if (dir == 0) Y[(size_t)row * D + 384 + cof] = (bf16)f2bf(o);
        else OB[(size_t)row * 640 + cof] = (bf16)f2bf(o);
    }
}

constexpr int CH_PITCH = 144;
constexpr int CH_IMG = 64 * CH_PITCH;
constexpr int CH_WAVE_LDS = 3 * CH_IMG + 1024 + 512;
__device__ __forceinline__ void ds_tr16x8(unsigned addr, u32x2 (&lo)[4], u32x2 (&hi)[4]) {
    asm volatile("ds_read_b64_tr_b16 %0, %8\n\tds_read_b64_tr_b16 %1, %8 offset:32\n\tds_read_b64_tr_b16 %2, %8 offset:64\n\tds_read_b64_tr_b16 %3, %8 offset:96\n\t"
                 "ds_read_b64_tr_b16 %4, %8 offset:2304\n\tds_read_b64_tr_b16 %5, %8 offset:2336\n\tds_read_b64_tr_b16 %6, %8 offset:2368\n\tds_read_b64_tr_b16 %7, %8 offset:2400\n\t"
                 "s_waitcnt lgkmcnt(0)"
                 : "=&v"(lo[0]), "=&v"(lo[1]), "=&v"(lo[2]), "=&v"(lo[3]), "=&v"(hi[0]), "=&v"(hi[1]), "=&v"(hi[2]), "=&v"(hi[3]) : "v"(addr) : "memory");
}
static_assert(16 * CH_PITCH == 2304, "ds_tr16x8 offsets");
__device__ __forceinline__ void ds_tr16x4(unsigned addr, u32x2 (&lo)[2], u32x2 (&hi)[2]) {
    asm volatile("ds_read_b64_tr_b16 %0, %4\n\tds_read_b64_tr_b16 %1, %4 offset:32\n\tds_read_b64_tr_b16 %2, %4 offset:2304\n\tds_read_b64_tr_b16 %3, %4 offset:2336\n\ts_waitcnt lgkmcnt(0)"
                 : "=&v"(lo[0]), "=&v"(lo[1]), "=&v"(hi[0]), "=&v"(hi[1]) : "v"(addr) : "memory");
}
__device__ __forceinline__ float log_sigmoid_(float x) { return fminf(x, 0.f) - log1pf(__expf(-fabsf(x))); }
__device__ __forceinline__ bf16x8 mk_frag(u32x2 lo, u32x2 hi) { u32x4 w; w.x = lo.x; w.y = lo.y; w.z = hi.x; w.w = hi.y; return __builtin_bit_cast(bf16x8, w); }

template <bool IS_ML>
__device__ __forceinline__ void chain_fast(Frame& F, int layer, int b, int h, int dir, LAS unsigned char* img, int hf) {
    constexpr int NET = 2;
    const int lane = F.lane, fr = lane & 15, fq = lane >> 4;
    LAS unsigned char* Qi = img; LAS unsigned char* Ki = img + CH_IMG; LAS unsigned char* Vi = img + 2 * CH_IMG;
    const unsigned qa = (unsigned)(size_t)Qi, ka = (unsigned)(size_t)Ki, va = (unsigned)(size_t)Vi;
    const GAS bf16* RET = WSP(const bf16, WS_RET); const GAS bf16* ML = WSP(const bf16, WS_ML); const GAS float* MLG = WSP(const float, WS_MLG);
    const GAS float* rope = WSP(const float, WS_ROPE);
    GAS bf16* Y = WSP(bf16, WS_Y); GAS bf16* OB = WSP(bf16, WS_OB);
    float lgam = 0.f, bi_ = 0.f, bf_ = 0.f;
    if (!IS_ML) lgam = log_sigmoid_(inp(F, I_RETDECAY)[layer * 12 + dir * 6 + h]);
    else { bi_ = inp(F, I_MLGB)[layer * 16 + dir * 8 + h]; bf_ = inp(F, I_MLGB)[layer * 16 + dir * 8 + 4 + h]; }
    const GAS float* mlc = inp(F, I_MLCONV) + layer * 3 * 512;
    f32x4 C[4][NET];
#pragma unroll
    for (int dt = 0; dt < 4; ++dt)
#pragma unroll
        for (int et = 0; et < NET; ++et) C[dt][et] = (f32x4){0.f, 0.f, 0.f, 0.f};
    const int cq = lane & 7, pr0 = lane >> 3;
    LAS float* nvec = (LAS float*)(img + 3 * CH_IMG + 1024 + 256 * hf);
    if (IS_ML) nvec[lane] = 0.f;
    const LAS float* nq = nvec + 4 * fq;
#ifndef REP_CH
#define REP_CH 1
#endif
#pragma unroll 1
    for (int step_ = 0; step_ < 36 * REP_CH; ++step_) {
        const int step = step_ % 36;
        if (REP_CH > 1 && step == 0) {
            if (IS_ML) nvec[lane] = 0.f;
#pragma unroll
            for (int dt = 0; dt < 4; ++dt)
#pragma unroll
                for (int et = 0; et < NET; ++et) C[dt][et] = (f32x4){0.f, 0.f, 0.f, 0.f};
        }
        int rowbase, t0, L; bool lat;
        if (step < 4) { const int cc = dir ? 3 - step : step; rowbase = TOKL + b * LC + cc * 64; t0 = cc * 64; L = LC; lat = false; }
        else { const int cc = dir ? 35 - step : step - 4; rowbase = b * LL + cc * 64; t0 = cc * 64; L = LL; lat = true; }
        float g_i = 0.f, g_f = 0.f;
        if (IS_ML) { const int tlg = dir ? 63 - lane : lane; const GAS float* gp = MLG + (size_t)(rowbase + tlg) * 16 + dir * 8 + h; g_i = gp[0]; g_f = gp[4]; }
        if constexpr (!IS_ML) {
#pragma unroll
        for (int i4 = 0; i4 < 4; ++i4) {
            const int i = 4 * hf + i4;
            const int p = pr0 + 8 * i, tl = dir ? 63 - p : p, row = rowbase + tl, tpos = t0 + tl;
            float qv[8], kv[8]; u32x4 vraw;
            {
                const GAS bf16* base = RET + (size_t)row * 1536 + h * 64;
                const u32x4 qr = *(const GAS u32x4*)(base + 8 * cq), kr = *(const GAS u32x4*)(base + 384 + 8 * cq); vraw = *(const GAS u32x4*)(base + 768 + 8 * cq);
                const unsigned qw[4] = {qr.x, qr.y, qr.z, qr.w}, kw[4] = {kr.x, kr.y, kr.z, kr.w};
#pragma unroll
                for (int j = 0; j < 4; ++j) { qv[2 * j] = __uint_as_float(qw[j] << 16); qv[2 * j + 1] = __uint_as_float(qw[j] & 0xffff0000u); kv[2 * j] = __uint_as_float(kw[j] << 16); kv[2 * j + 1] = __uint_as_float(kw[j] & 0xffff0000u); }
                if (lat) {
                    const u32x4 qpr = *(const GAS u32x4*)(base + 8 * (cq ^ 2)), kpr = *(const GAS u32x4*)(base + 384 + 8 * (cq ^ 2));
                    const unsigned qpw[4] = {qpr.x, qpr.y, qpr.z, qpr.w}, kpw[4] = {kpr.x, kpr.y, kpr.z, kpr.w};
                    const int half = cq >> 2, hi = (cq >> 1) & 1, i0 = 8 * (cq & 1);
                    const GAS float* rp = rope + tpos * 64 + half * 32 + i0;
                    const f32x4 c0 = *(const GAS f32x4*)(rp), c1 = *(const GAS f32x4*)(rp + 4), s0 = *(const GAS f32x4*)(rp + 16), s1 = *(const GAS f32x4*)(rp + 20);
                    const float cs[8] = {c0.x, c0.y, c0.z, c0.w, c1.x, c1.y, c1.z, c1.w}, sn[8] = {s0.x, s0.y, s0.z, s0.w, s1.x, s1.y, s1.z, s1.w};
#pragma unroll
                    for (int j = 0; j < 8; ++j) {
                        const float qp = (j & 1) ? __uint_as_float(qpw[j >> 1] & 0xffff0000u) : __uint_as_float(qpw[j >> 1] << 16);
                        const float kp = (j & 1) ? __uint_as_float(kpw[j >> 1] & 0xffff0000u) : __uint_as_float(kpw[j >> 1] << 16);
                        qv[j] = hi ? qp * sn[j] + qv[j] * cs[j] : qv[j] * cs[j] - qp * sn[j];
                        kv[j] = hi ? kp * sn[j] + kv[j] * cs[j] : kv[j] * cs[j] - kp * sn[j];
                    }
                }
#pragma unroll
                for (int j = 0; j < 8; ++j) qv[j] *= 0.125f;
            }
            u32x4 qo, ko; qo.x = pk2(qv[0], qv[1]); qo.y = pk2(qv[2], qv[3]); qo.z = pk2(qv[4], qv[5]); qo.w = pk2(qv[6], qv[7]);
            ko.x = pk2(kv[0], kv[1]); ko.y = pk2(kv[2], kv[3]); ko.z = pk2(kv[4], kv[5]); ko.w = pk2(kv[6], kv[7]);
            *(LAS u32x4*)(Qi + p * CH_PITCH + 16 * cq) = qo; *(LAS u32x4*)(Ki + p * CH_PITCH + 16 * cq) = ko; *(LAS u32x4*)(Vi + p * CH_PITCH + 16 * cq) = vraw;
        }
        } else {
            const GAS float* wq = mlc + h * 64 + 8 * cq;
#pragma unroll
            for (int qk = 0; qk < 2; ++qk) {
                u32x4 r0[4], r1[4], r2[4], vr[4];
                f32x4 wt[3][2];
#pragma unroll
                for (int tp = 0; tp < 3; ++tp) { wt[tp][0] = *(const GAS f32x4*)(wq + 256 * qk + 512 * tp); wt[tp][1] = *(const GAS f32x4*)(wq + 256 * qk + 512 * tp + 4); }
#pragma unroll
                for (int i4 = 0; i4 < 4; ++i4) {
                    const int p = pr0 + 8 * (4 * hf + i4), tl = dir ? 63 - p : p, row = rowbase + tl, tpos = t0 + tl;
                    const GAS bf16* bb = ML + (size_t)row * 1024 + h * 64 + 8 * cq + 256 * qk;
                    const u32x4 z4 = (u32x4){0u, 0u, 0u, 0u};
                    r1[i4] = *(const GAS u32x4*)(bb); r0[i4] = tpos > 0 ? *(const GAS u32x4*)(bb - 1024) : z4; r2[i4] = tpos < L - 1 ? *(const GAS u32x4*)(bb + 1024) : z4;
                    if (qk == 1) vr[i4] = *(const GAS u32x4*)(bb + 256);
                }
#pragma unroll
                for (int i4 = 0; i4 < 4; ++i4) {
                    const int p = pr0 + 8 * (4 * hf + i4);
                    const unsigned a0[4] = {r0[i4].x, r0[i4].y, r0[i4].z, r0[i4].w}, a1[4] = {r1[i4].x, r1[i4].y, r1[i4].z, r1[i4].w}, a2[4] = {r2[i4].x, r2[i4].y, r2[i4].z, r2[i4].w};
                    float ov[8];
#pragma unroll
                    for (int j = 0; j < 8; ++j) {
                        const float x0 = (j & 1) ? __uint_as_float(a0[j >> 1] & 0xffff0000u) : __uint_as_float(a0[j >> 1] << 16);
                        const float x1 = (j & 1) ? __uint_as_float(a1[j >> 1] & 0xffff0000u) : __uint_as_float(a1[j >> 1] << 16);
                        const float x2 = (j & 1) ? __uint_as_float(a2[j >> 1] & 0xffff0000u) : __uint_as_float(a2[j >> 1] << 16);
                        const float r = siluf_(wt[0][j >> 2][j & 3] * x0 + wt[1][j >> 2][j & 3] * x1 + wt[2][j >> 2][j & 3] * x2);
                        ov[j] = qk == 0 ? r : r * 0.125f;
                    }
                    u32x4 o; o.x = pk2(ov[0], ov[1]); o.y = pk2(ov[2], ov[3]); o.z = pk2(ov[4], ov[5]); o.w = pk2(ov[6], ov[7]);
                    if (qk == 0) *(LAS u32x4*)(Qi + p * CH_PITCH + 16 * cq) = o;
                    else { *(LAS u32x4*)(Ki + p * CH_PITCH + 16 * cq) = o; *(LAS u32x4*)(Vi + p * CH_PITCH + 16 * cq) = vr[i4]; }
                }
                asm volatile("" ::: "memory");
            }
        }
        __builtin_amdgcn_sched_barrier(0);
        float f_p, i_p;
        if (!IS_ML) { f_p = lgam; i_p = 0.f; }
        else { i_p = g_i + bi_; f_p = log_sigmoid_(g_f + bf_); }
        float bsum = f_p;
#pragma unroll
        for (int o = 1; o < 64; o <<= 1) { const float t = lane_read(bsum, lane >= o ? lane - o : lane); if (lane >= o) bsum += t; }
        LAS float* gv = (LAS float*)(img + 3 * CH_IMG);
        const float b63 = __int_as_float(__builtin_amdgcn_readlane(__float_as_int(bsum), 63));
        const float adec = __expf(b63);
        if (hf == 0) { gv[lane] = bsum; gv[64 + lane] = bsum - i_p; gv[128 + lane] = __expf(bsum); gv[192 + lane] = __expf(b63 - (bsum - i_p)); }
        asm volatile("s_waitcnt lgkmcnt(0)" ::: "memory");
        __syncthreads();
        const LAS float* gq = gv + 4 * fq;
        const bf16x8 ones = (fr == 0) ? (bf16x8){0x3F80, 0x3F80, 0x3F80, 0x3F80, 0x3F80, 0x3F80, 0x3F80, 0x3F80} : (bf16x8){0, 0, 0, 0, 0, 0, 0, 0};
        const int tr_q = fr >> 2, tr_p = fr & 3;
#pragma unroll 1
        for (int pt = 0; pt < 4; ++pt) {
            f32x4 ST[4];
            bf16x8 qn[2];
#pragma unroll
            for (int kk = 0; kk < 2; ++kk) qn[kk] = *(const LAS bf16x8*)(Qi + (16 * pt + fr) * CH_PITCH + (32 * kk + 8 * fq) * 2);
#pragma unroll
            for (int st = 0; st < 4; ++st) {
                ST[st] = (f32x4){0.f, 0.f, 0.f, 0.f};
                if (st <= pt) {
#pragma unroll
                    for (int kk = 0; kk < 2; ++kk) { const bf16x8 kf = *(const LAS bf16x8*)(Ki + (16 * st + fr) * CH_PITCH + (32 * kk + 8 * fq) * 2); ST[st] = __builtin_amdgcn_mfma_f32_16x16x32_bf16(kf, qn[kk], ST[st], 0, 0, 0); }
                }
            }
            const float bp = gv[16 * pt + fr];
#pragma unroll
            for (int st = 0; st < 4; ++st) {
                if (st <= pt) {
                    const f32x4 bis = *(const LAS f32x4*)(gq + 64 + 16 * st);
#pragma unroll
                    for (int j = 0; j < 4; ++j) { const int sidx = 16 * st + 4 * fq + j; const float w = (sidx <= 16 * pt + fr) ? __expf(bp - bis[j]) : 0.f; ST[st][j] *= w; }
                }
            }
            __builtin_amdgcn_sched_barrier(0);
            f32x4 acc[NET], accd = (f32x4){0.f, 0.f, 0.f, 0.f};
#pragma unroll
            for (int et = 0; et < NET; ++et) acc[et] = (f32x4){0.f, 0.f, 0.f, 0.f};
#pragma unroll
            for (int kk = 0; kk < 2; ++kk) {
                const u32x2 lo = *(const LAS u32x2*)(Qi + (16 * pt + fr) * CH_PITCH + (32 * kk + 4 * fq) * 2), hi = *(const LAS u32x2*)(Qi + (16 * pt + fr) * CH_PITCH + (32 * kk + 16 + 4 * fq) * 2);
                const bf16x8 qs = mk_frag(lo, hi);
#pragma unroll
                for (int et = 0; et < NET; ++et) {
                    u32x4 w; w.x = pk2(C[2 * kk][et].x, C[2 * kk][et].y); w.y = pk2(C[2 * kk][et].z, C[2 * kk][et].w); w.z = pk2(C[2 * kk + 1][et].x, C[2 * kk + 1][et].y); w.w = pk2(C[2 * kk + 1][et].z, C[2 * kk + 1][et].w);
                    acc[et] = __builtin_amdgcn_mfma_f32_16x16x32_bf16(qs, __builtin_bit_cast(bf16x8, w), acc[et], 0, 0, 0);
                }
                if (IS_ML) {
                    const f32x4 n0 = *(const LAS f32x4*)(nq + 32 * kk), n1 = *(const LAS f32x4*)(nq + 32 * kk + 16);
                    u32x4 w; w.x = pk2(n0.x, n0.y); w.y = pk2(n0.z, n0.w); w.z = pk2(n1.x, n1.y); w.w = pk2(n1.z, n1.w);
                    if (fr != 0) w = (u32x4){0u, 0u, 0u, 0u};
                    accd = __builtin_amdgcn_mfma_f32_16x16x32_bf16(qs, __builtin_bit_cast(bf16x8, w), accd, 0, 0, 0);
                }
            }
            { const f32x4 ap = *(const LAS f32x4*)(gq + 128 + 16 * pt);
#pragma unroll
              for (int j = 0; j < 4; ++j) {
#pragma unroll
                for (int et = 0; et < NET; ++et) acc[et][j] *= ap[j];
                accd[j] *= ap[j]; } }
            __builtin_amdgcn_sched_barrier(0);
#pragma unroll
            for (int kk = 0; kk < 2; ++kk) {
                if (2 * kk <= pt) {
                    u32x4 w; w.x = pk2(ST[2 * kk].x, ST[2 * kk].y); w.y = pk2(ST[2 * kk].z, ST[2 * kk].w); w.z = pk2(ST[2 * kk + 1].x, ST[2 * kk + 1].y); w.w = pk2(ST[2 * kk + 1].z, ST[2 * kk + 1].w);
                    const bf16x8 pf = __builtin_bit_cast(bf16x8, w);
                    u32x2 vlo[2], vhi[2];
                    ds_tr16x4(va + (32 * kk + 4 * fq + tr_q) * CH_PITCH + 8 * tr_p + 64 * hf, vlo, vhi);
#pragma unroll
                    for (int et = 0; et < NET; ++et) acc[et] = __builtin_amdgcn_mfma_f32_16x16x32_bf16(pf, mk_frag(vlo[et], vhi[et]), acc[et], 0, 0, 0);
                    if (IS_ML) accd = __builtin_amdgcn_mfma_f32_16x16x32_bf16(pf, ones, accd, 0, 0, 0);
                }
            }
            __builtin_amdgcn_sched_barrier(0);
#pragma unroll
            for (int j = 0; j < 4; ++j) {
                const int p = 16 * pt + 4 * fq + j, tl = dir ? 63 - p : p, row = rowbase + tl;
                float inv = 1.f;
                if (IS_ML) { const float den = lane_read(accd[j], lane & 48); inv = __builtin_amdgcn_rcpf(fmaxf(fabsf(den), 1.f)); }
                const int cof = (IS_ML ? 384 : 0) + h * 64 + 32 * hf + fr;
                const unsigned boff = dir == 0 ? (unsigned)(row * D + 384 + cof) * 2u : (unsigned)(row * 640 + cof) * 2u;
                GAS char* ob = dir == 0 ? (GAS char*)Y : (GAS char*)OB;
#pragma unroll
                for (int et = 0; et < NET; ++et) *(GAS bf16*)(ob + boff + 32 * et) = (bf16)f2bf(acc[et][j] * inv);
            }
        }
        __builtin_amdgcn_sched_barrier(0);
#pragma unroll
        for (int dt = 0; dt < 4; ++dt)
#pragma unroll
            for (int et = 0; et < NET; ++et) C[dt][et] *= adec;
        f32x4 accn[4];
        if (IS_ML) {
#pragma unroll
            for (int dt = 0; dt < 4; ++dt) { accn[dt] = *(const LAS f32x4*)(nq + 16 * dt) * adec; if (fr != 0) accn[dt] = (f32x4){0.f, 0.f, 0.f, 0.f}; }
        }
#pragma unroll
        for (int kk = 0; kk < 2; ++kk) {
            u32x2 vlo[2], vhi[2], klo[4], khi[4];
            ds_tr16x4(va + (32 * kk + 4 * fq + tr_q) * CH_PITCH + 8 * tr_p + 64 * hf, vlo, vhi);
            ds_tr16x8(ka + (32 * kk + 4 * fq + tr_q) * CH_PITCH + 8 * tr_p, klo, khi);
            const f32x4 wl = *(const LAS f32x4*)(gq + 192 + 32 * kk), wh = *(const LAS f32x4*)(gq + 192 + 32 * kk + 16);
#pragma unroll
            for (int dt = 0; dt < 4; ++dt) {
                u32x4 w;
                w.x = pk2(__uint_as_float(klo[dt].x << 16) * wl[0], __uint_as_float(klo[dt].x & 0xffff0000u) * wl[1]);
                w.y = pk2(__uint_as_float(klo[dt].y << 16) * wl[2], __uint_as_float(klo[dt].y & 0xffff0000u) * wl[3]);
                w.z = pk2(__uint_as_float(khi[dt].x << 16) * wh[0], __uint_as_float(khi[dt].x & 0xffff0000u) * wh[1]);
                w.w = pk2(__uint_as_float(khi[dt].y << 16) * wh[2], __uint_as_float(khi[dt].y & 0xffff0000u) * wh[3]);
                const bf16x8 kf = __builtin_bit_cast(bf16x8, w);
#pragma unroll
                for (int et = 0; et < NET; ++et) C[dt][et] = __builtin_amdgcn_mfma_f32_16x16x32_bf16(kf, mk_frag(vlo[et], vhi[et]), C[dt][et], 0, 0, 0);
                if (IS_ML) accn[dt] = __builtin_amdgcn_mfma_f32_16x16x32_bf16(kf, ones, accn[dt], 0, 0, 0);
            }
        }
        if (IS_ML) { if (fr == 0) {
#pragma unroll
            for (int dt = 0; dt < 4; ++dt) *(LAS f32x4*)(nvec + 4 * fq + 16 * dt) = accn[dt]; } }
        asm volatile("s_waitcnt lgkmcnt(0)" ::: "memory");
        __syncthreads();
    }
}

#ifndef FAST_CHAIN
#define FAST_CHAIN 1
#endif
constexpr int NCHWG = 80;
__device__ __forceinline__ void phase_mix(Frame& F, int layer) {
    const bool last = layer == 1;
    const GAS bf16* ftl = WSP(const bf16, WS_FTL) + (size_t)layer * 2 * 384 * 4096;
    if (FAST_CHAIN) {
        if (F.wg < NCHWG) {
            {
                const int cl = F.wave >> 1, hf = F.wave & 1, c = F.wg * 4 + cl;
                LAS unsigned char* img = F.lds + cl * CH_WAVE_LDS;
                {
                if (c < 192) { const int b = c / 12, r = c % 12; chain_fast<false>(F, layer, b, r >> 1, r & 1, img, hf); }
                else { const int i = c - 192; chain_fast<true>(F, layer, i >> 3, (i & 7) >> 1, i & 1, img, hf); }
                }
            }
        } else {
            const int nh = F.G - NCHWG, w = F.wg - NCHWG;
#ifndef FAST_HY
#define FAST_HY 1
#endif
            if (FAST_HY) {
#ifndef REP_HY
#define REP_HY 1
#endif
#pragma unroll 1
                for (int rp = 0; rp < REP_HY; ++rp)
                for (int u = w; u < 384; u += nh) hyena_unit_fast<LL>(F, layer, u, WSP(const bf16, WS_HYTL), ftl, WSP(bf16, WS_YHTL));
                if (!last) for (int u = w; u < 384; u += nh) hyena_unit_fast<LC>(F, layer, u, WSP(const bf16, WS_HYTC), WSP(const bf16, WS_FTC), WSP(bf16, WS_YHTC));
            } else {
                for (int u = w; u < 384; u += nh) hyena_unit_naive<LL>(F, layer, u, WSP(const bf16, WS_HYTL), ftl, WSP(bf16, WS_YHTL));
                if (!last) for (int u = w; u < 384; u += nh) hyena_unit_naive<LC>(F, layer, u, WSP(const bf16, WS_HYTC), WSP(const bf16, WS_FTC), WSP(bf16, WS_YHTC));
            }
        }
    } else {
        for (int u = F.wg; u < 384; u += F.G) hyena_unit_naive<LL>(F, layer, u, WSP(const bf16, WS_HYTL), ftl, WSP(bf16, WS_YHTL));
        if (!last) for (int u = F.wg; u < 384; u += F.G) hyena_unit_naive<LC>(F, layer, u, WSP(const bf16, WS_HYTC), WSP(const bf16, WS_FTC), WSP(bf16, WS_YHTC));
        for (int c = F.wg + F.wave * F.G; c < 320; c += F.G * NWAVES) chain_naive(F, layer, c);
    }
}

__device__ __forceinline__ void phase_combine(Frame& F, int layer) {
    const bool last = layer == 1;
    const int gw = F.wg * NWAVES + F.wave, NGW = F.G * NWAVES, lane = F.lane;
    const int nrows = last ? TOKL : TOK;
    GAS bf16* Y = WSP(bf16, WS_Y); const GAS bf16* OB = WSP(const bf16, WS_OB); const GAS bf16* RET = WSP(const bf16, WS_RET); const GAS bf16* ML = WSP(const bf16, WS_ML);
    for (int row = gw; row < nrows; row += NGW) {
#pragma unroll
        for (int hh = 0; hh < 10; ++hh) {
            const int cof = hh * 64 + lane;
            const float x = bf2f(Y[(size_t)row * D + 384 + cof]) + bf2f(OB[(size_t)row * 640 + cof]);
            const float mu = wave_sum(x) * (1.f / 64.f), xc = x - mu;
            const float var = wave_sum(xc * xc) * (1.f / 64.f);
            const float nrm = xc * rsqrtf(var + 1e-6f);
            float gate;
            if (hh < 6) gate = siluf_(bf2f(RET[(size_t)row * 1536 + 1152 + cof]));
            else gate = sigmoidf_(bf2f(ML[(size_t)row * 1024 + 768 + (cof - 384)]));
            Y[(size_t)row * D + 384 + cof] = (bf16)f2bf(nrm * gate);
        }
    }
    LAS float* scr = (LAS float*)(F.lds + F.wave * 16640);
    const int nitL = NB * 6 * 32, nitC = last ? 0 : NB * 6 * 4;
    for (int it = gw; it < nitL + nitC; it += NGW) {
        const GAS bf16* src; int L, rowbase, b, cb, tb;
        if (it < nitL) { b = it / 192; const int r = it % 192; cb = r / 32; tb = r % 32; L = LL; src = WSP(const bf16, WS_YHTL); rowbase = b * LL; }
        else { const int i2 = it - nitL; b = i2 / 24; const int r = i2 % 24; cb = r / 4; tb = r % 4; L = LC; src = WSP(const bf16, WS_YHTC); rowbase = TOKL + b * LC; }
        for (int cc = 0; cc < 64; ++cc) scr[cc * 65 + lane] = bf2f(src[((size_t)(b * 384 + cb * 64 + cc)) * L + tb * 64 + lane]);
        asm volatile("s_waitcnt lgkmcnt(0)" ::: "memory");
        for (int tt = 0; tt < 64; ++tt) Y[(size_t)(rowbase + tb * 64 + tt) * D + cb * 64 + lane] = (bf16)f2bf(scr[lane * 65 + tt]);
        asm volatile("s_waitcnt lgkmcnt(0)" ::: "memory");
    }
}

__device__ __forceinline__ void phase_norm_router(Frame& F) {
    const int gw = F.wg * NWAVES + F.wave, NGW = F.G * NWAVES, lane = F.lane;
    const GAS float* g = inp(F, I_GFFN) + 1 * D; const GAS float* wr = inp(F, I_ROUTER); const GAS float* br = inp(F, I_ROUTERB);
    GAS unsigned* cnt = WSP(unsigned, WS_CTL) + CW_CNT;
    for (int row = gw; row < TOKL; row += NGW) {
        float keep[16];
        norm_mod_row(xrow_ptr(F, row, false), g, mod_ptr(F, 1, row, 3), mod_ptr(F, 1, row, 4), WSP(bf16, WS_H) + (size_t)row * D, lane, keep);
        float lg[8];
#pragma unroll
        for (int e = 0; e < 8; ++e) lg[e] = 0.f;
#pragma unroll
        for (int j = 0; j < 4; ++j)
#pragma unroll
            for (int i = 0; i < 4; ++i) { const int k = 256 * j + 4 * lane + i; const f32x4 w0 = *(const GAS f32x4*)(wr + k * 8), w1 = *(const GAS f32x4*)(wr + k * 8 + 4); const float x = keep[4 * j + i];
                lg[0] += x * w0.x; lg[1] += x * w0.y; lg[2] += x * w0.z; lg[3] += x * w0.w; lg[4] += x * w1.x; lg[5] += x * w1.y; lg[6] += x * w1.z; lg[7] += x * w1.w; }
#pragma unroll
        for (int e = 0; e < 8; ++e) lg[e] = wave_sum(lg[e]) + br[e];
        int e0 = 0; float v0 = lg[0];
#pragma unroll
        for (int e = 1; e < 8; ++e) if (lg[e] > v0) { v0 = lg[e]; e0 = e; }
        int e1 = -1; float v1 = -3.0e38f;
#pragma unroll
        for (int e = 0; e < 8; ++e) if (e != e0 && lg[e] > v1) { v1 = lg[e]; e1 = e; }
        const float w1 = 1.f / (1.f + __expf(v0 - v1)), w0 = 1.f - w1;
        if (lane == 0) {
            const unsigned p0 = __hip_atomic_fetch_add(cnt + e0, 1u, __ATOMIC_RELAXED, __HIP_MEMORY_SCOPE_AGENT), p1 = __hip_atomic_fetch_add(cnt + e1, 1u, __ATOMIC_RELAXED, __HIP_MEMORY_SCOPE_AGENT);
            WSP(int, WS_TOPE)[row * 2] = e0; WSP(int, WS_TOPE)[row * 2 + 1] = e1;
            WSP(float, WS_TOPW)[row * 2] = w0; WSP(float, WS_TOPW)[row * 2 + 1] = w1;
            WSP(int, WS_TOPP)[row * 2] = (int)p0; WSP(int, WS_TOPP)[row * 2 + 1] = (int)p1;
        }
    }
}
__device__ __forceinline__ void phase_route_tables(Frame& F) {
    const GAS unsigned* cnt = WSP(const unsigned, WS_CTL) + CW_CNT;
    int off[9]; off[0] = 0;
#pragma unroll
    for (int e = 0; e < 8; ++e) { const int c = (int)__hip_atomic_load(cnt + e, __ATOMIC_RELAXED, __HIP_MEMORY_SCOPE_AGENT); off[e + 1] = off[e] + ((c + 255) >> 8) * 256; }
    const int gt = F.wg * NTHR + F.tid, NGT = F.G * NTHR;
    GAS int* rowidx = WSP(int, WS_ROWIDX); GAS int* slot = WSP(int, WS_SLOT); GAS int* tilee = WSP(int, WS_TILEE);
    for (int i = gt; i < MAXTILES * 256; i += NGT) {
        int e = 0;
#pragma unroll
        for (int q = 1; q < 8; ++q) if (i >= off[q]) e = q;
        const int c = (int)cnt[e];
        if (i >= off[8] || i - off[e] >= c) rowidx[i] = 0;
    }
    for (int i = gt; i < TOKL * 2; i += NGT) {
        const int e = WSP(const int, WS_TOPE)[i], pos = WSP(const int, WS_TOPP)[i];
        int o = 0;
#pragma unroll
        for (int q = 0; q < 8; ++q) if (e == q) o = off[q];
        const int s = o + pos; slot[i] = s; rowidx[s] = i >> 1;
    }
    for (int i = gt; i < MAXTILES + 1; i += NGT) {
        if (i == MAXTILES) tilee[MAXTILES] = off[8] >> 8;
        else { int e = 0;
#pragma unroll
            for (int q = 1; q < 8; ++q) if (i * 256 >= off[q]) e = q;
            tilee[i] = e; }
    }
}

__device__ __forceinline__ void moe_pass_gemm1_fast(Frame& F, int t0, int t1) {
    pg8::OrderMoe S; S.o.init(t1 - t0, NFF1 / 256, F.G, F.wg); S.rowidx = WSP(const int, WS_ROWIDX); S.tilee = WSP(const int, WS_TILEE); S.t0 = t0; S.bstride = (size_t)NFF1 * D; S.gather = true;
    EpiSwiglu E{WSP(bf16, WS_MACT), 0};
    pg8::gemm_phase(F.lds, F.tid, WSP(const bf16, WS_H), D, WSP(const bf16, WS_MW13), D, D, S, E);
}
__device__ __forceinline__ void moe_pass_gemm2_fast(Frame& F, int t0, int t1) {
    pg8::OrderMoe S; S.o.init(t1 - t0, D / 256, F.G, F.wg); S.rowidx = WSP(const int, WS_ROWIDX); S.tilee = WSP(const int, WS_TILEE); S.t0 = t0; S.bstride = (size_t)D * DFF; S.gather = false;
    EpiBf16Out E{WSP(bf16, WS_EOUT), D, t0 * 256};
    pg8::gemm_phase(F.lds, F.tid, WSP(const bf16, WS_MACT), DFF, WSP(const bf16, WS_MW2), DFF, DFF, S, E);
}
__device__ __forceinline__ void phase_final(Frame& F) {
    const int gw = F.wg * NWAVES + F.wave, NGW = F.G * NWAVES, lane = F.lane;
    const GAS float* gf = inp(F, I_GFINAL); const GAS bf16* eo = WSP(const bf16, WS_EOUT);
    for (int row = gw; row < TOKL; row += NGW) {
        const int s0 = WSP(const int, WS_SLOT)[row * 2], s1 = WSP(const int, WS_SLOT)[row * 2 + 1];
        const float w0 = WSP(const float, WS_TOPW)[row * 2], w1 = WSP(const float, WS_TOPW)[row * 2 + 1];
        const GAS float* m5 = mod_ptr(F, 1, row, 5);
        GAS float* xr = outp(F) + (size_t)row * D;
        f32x4 v[4]; float s = 0.f;
#pragma unroll
        for (int j = 0; j < 4; ++j) {
            const int c = 256 * j + 4 * lane;
            const f32x4 a = ld_bf16x4(eo + (size_t)s0 * D + c), b = ld_bf16x4(eo + (size_t)s1 * D + c), m = *(const GAS f32x4*)(m5 + c);
            v[j] = *(const GAS f32x4*)(xr + c) + m * (a * w0 + b * w1);
            s += (v[j].x * v[j].x + v[j].y * v[j].y) + (v[j].z * v[j].z + v[j].w * v[j].w);
        }
        const float r = rsqrtf(wave_sum(s) * (1.f / 1024.f) + 1e-6f);
#pragma unroll
        for (int j = 0; j < 4; ++j) { const int c = 256 * j + 4 * lane; const f32x4 g = *(const GAS f32x4*)(gf + c); *(GAS f32x4*)(xr + c) = v[j] * r * g; }
    }
}

#ifndef REP_WIN
#define REP_WIN 1
#endif
#ifndef REP_MIX
#define REP_MIX 1
#endif
#ifndef REP_GATE
#define REP_GATE 1
#endif
#ifndef REP_UP
#define REP_UP 1
#endif
#ifndef REP_FFN1
#define REP_FFN1 1
#endif
#ifndef REP_MOE
#define REP_MOE 1
#endif
#ifndef REP_NORM
#define REP_NORM 1
#endif
#ifndef REP_P0
#define REP_P0 1
#endif
__global__ void __launch_bounds__(NTHR, 2) hybrid_fwd(Params prm) {
    extern __shared__ __attribute__((aligned(16))) unsigned char lds_raw[];
    Frame F;
    F.lds = (LAS unsigned char*)lds_raw; F.ws = (GAS unsigned char*)prm.ws;
    F.tid = threadIdx.x; F.lane = F.tid & 63; F.wave = __builtin_amdgcn_readfirstlane(F.tid >> 6); F.G = gridDim.x; F.wg = blockIdx.x;
    volatile LAS unsigned* MISC = (volatile LAS unsigned*)(F.lds + MISC_OFF);
    if (F.tid < 64) MISC[F.tid] = 0u;
    if (F.tid < 33) { const unsigned long long v = F.tid < 32 ? (unsigned long long)prm.in[F.tid] : (unsigned long long)prm.out; *(LAS unsigned long long*)(F.lds + PTAB_OFF + 8 * F.tid) = v; }
    __syncthreads();
    XcdBarrier bar = xcd_barrier_post(WSP(unsigned, WS_CTL) + CW_BAR, MISC + 8);
#define RELAUNDER() do { { unsigned long long _w = (unsigned long long)F.ws; asm volatile("" : "+s"(_w)); F.ws = (GAS unsigned char*)_w; } \
        { unsigned _t = (unsigned)F.tid; asm volatile("" : "+v"(_t)); F.tid = (int)_t; F.lane = F.tid & 63; F.wave = __builtin_amdgcn_readfirstlane(F.tid >> 6); } \
        { unsigned _g = (unsigned)F.G, _b = (unsigned)F.wg; asm volatile("" : "+s"(_g), "+s"(_b)); F.G = (int)_g; F.wg = (int)_b; } \
        { unsigned _l = (unsigned)(size_t)F.lds; asm volatile("" : "+s"(_l)); F.lds = (LAS unsigned char*)(size_t)_l; } } while (0)
#define GRID_BAR() do { { unsigned long long _b = (unsigned long long)bar.bar; unsigned _x = bar.x; asm volatile("" : "+s"(_b), "+s"(_x)); bar.bar = (GAS unsigned*)_b; bar.x = _x; } xcd_barrier(bar); RELAUNDER(); } while (0)

    for (int rp = 0; rp < REP_P0; ++rp) { phase_p0(F); write_bias(F);
    GRID_BAR(); }
#pragma unroll 1
    for (int layer_ = 0; layer_ < 2; ++layer_) {
        int layer = layer_;
#define last (layer == 1)
#define rows_all TOK
#define rows_out (last ? TOKL : TOK)
#define modbase (WSP(const float, WS_MOD) + (size_t)layer * 17 * 6144)
#define LAYER_LAUNDER() asm volatile("" : "+s"(layer))
        for (int rp = 0; rp < REP_NORM; ++rp) { phase_norm(F, layer, rows_all, !last, 0);
        { GRID_BAR(); LAYER_LAUNDER(); } }
        for (int rp = 0; rp < REP_WIN; ++rp) {
        { EpiWin E{WSP(const float, WS_BIAS) + layer * NWP, WSP(bf16, WS_HYTL), WSP(bf16, WS_HYTC), WSP(bf16, WS_RET), WSP(bf16, WS_ML), WSP(float, WS_MLG)};
          gemm_fast(F, WSP(const bf16, WS_H), D, WSP(const bf16, WS_WIN), D, D, rows_all, NW1, E); }
        { GRID_BAR(); LAYER_LAUNDER(); } }
        for (int rp = 0; rp < REP_MIX; ++rp) { phase_mix(F, layer);
        { GRID_BAR(); LAYER_LAUNDER(); } }
        phase_combine(F, layer);
        { GRID_BAR(); LAYER_LAUNDER(); }
        for (int rp = 0; rp < REP_GATE; ++rp) {
        { EpiGate E{WSP(const float, WS_BIAS) + layer * NWP + NW1, WSP(bf16, WS_GATES)};
          gemm_fast(F, WSP(const bf16, WS_H), D, WSP(const bf16, WS_WIN) + (size_t)NW1 * D, D, D, rows_out, NGATE, E); }
        { GRID_BAR(); LAYER_LAUNDER(); } }
        for (int rp = 0; rp < REP_UP; ++rp) {
        { EpiUp E{WSP(const bf16, WS_GATES), WSP(bf16, WS_H)};
          gemm_fast(F, WSP(const bf16, WS_Y), D, WSP(const bf16, WS_WUP), D, D, rows_out, D, E); }
        { GRID_BAR(); LAYER_LAUNDER(); } }
        { EpiResid E{last ? outp(F) : inp(F, I_X), last ? WSP(const float, WS_XC) : inp(F, I_CTX), outp(F), WSP(float, WS_XC), modbase, 2};
          gemm_fast(F, WSP(const bf16, WS_H), D, WSP(const bf16, WS_WOUT), D, D, rows_out, D, E); }
        { GRID_BAR(); LAYER_LAUNDER(); }
        if (!last) {
            phase_norm(F, layer, rows_out, false, 3);
            { const int gw = F.wg * NWAVES + F.wave, NGW = F.G * NWAVES; LAS float* scr = (LAS float*)(F.lds + F.wave * 8704);
              conv_weights_ffn(inp(F, I_FW1), inp(F, I_FW3), inp(F, I_FW2), WSP(bf16, WS_W13), WSP(bf16, WS_W2), gw, NGW, scr, F.lane);
              conv_weights_win(F, 1, gw, NGW, scr);
              conv_weights_upout(F, 1, gw, NGW, scr); }
            { GRID_BAR(); LAYER_LAUNDER(); }
            for (int rp = 0; rp < REP_FFN1; ++rp) {
            { EpiSwiglu E{WSP(bf16, WS_ACT), 0};
              gemm_fast(F, WSP(const bf16, WS_H), D, WSP(const bf16, WS_W13), D, D, rows_out, NFF1, E); }
            { GRID_BAR(); LAYER_LAUNDER(); } }
            { EpiResid E{outp(F), WSP(const float, WS_XC), outp(F), WSP(float, WS_XC), modbase, 5};
              gemm_fast(F, WSP(const bf16, WS_ACT), DFF, WSP(const bf16, WS_W2), DFF, DFF, rows_out, D, E); }
            { GRID_BAR(); LAYER_LAUNDER(); }
        }
    }
#undef LAYER_LAUNDER
#undef last
#undef rows_all
#undef rows_out
#undef modbase
    phase_norm_router(F);
    { const int gw = F.wg * NWAVES + F.wave, NGW = F.G * NWAVES; LAS float* scr = (LAS float*)(F.lds + F.wave * 8704);
#pragma unroll 1
      for (int e = 0; e < NE; ++e)
          conv_weights_ffn(inp(F, I_MW1) + (size_t)e * D * DFF, inp(F, I_MW3) + (size_t)e * D * DFF, inp(F, I_MW2) + (size_t)e * DFF * D,
                           WSP(bf16, WS_MW13) + (size_t)e * NFF1 * D, WSP(bf16, WS_MW2) + (size_t)e * D * DFF, gw, NGW, scr, F.lane); }
    GRID_BAR();
    phase_route_tables(F);
    GRID_BAR();
    const int ntiles = __builtin_amdgcn_readfirstlane(WSP(const int, WS_TILEE)[MAXTILES]);
#pragma unroll 1
    for (int p = 0; p < NPASS; ++p) {
        const int t0 = p * PASS_TILES, t1 = min(ntiles, t0 + PASS_TILES);
        for (int rp = 0; rp < REP_MOE; ++rp) {
        if (t0 < t1) moe_pass_gemm1_fast(F, t0, t1);
        GRID_BAR();
        if (t0 < t1) moe_pass_gemm2_fast(F, t0, t1);
        GRID_BAR(); }
    }
    phase_final(F);
}

extern "C" void kernel_launch(void* const* d_in, const int* in_sizes, int n_in, void* d_out, int out_size, void* d_ws, size_t ws_size, hipStream_t stream) {
    static int grid = 0;
    if (grid == 0) {
        if (n_in != 32 || out_size != TOKL * D || ws_size < WS_END) { fprintf(stderr, "kernel_launch: unexpected arguments (n_in %d, out %d, ws %zu)\n", n_in, out_size, ws_size); grid = -1; return; }
        int dev = 0, cus = 0;
        if (hipGetDevice(&dev) != hipSuccess || hipDeviceGetAttribute(&cus, hipDeviceAttributeMultiprocessorCount, dev) != hipSuccess) { grid = -1; return; }
        if (hipFuncSetAttribute((const void*)hybrid_fwd, hipFuncAttributeMaxDynamicSharedMemorySize, LDS_BYTES) != hipSuccess) { grid = -1; return; }
        int per_cu = 0;
        (void)hipOccupancyMaxActiveBlocksPerMultiprocessor(&per_cu, (const void*)hybrid_fwd, NTHR, LDS_BYTES);
        (void)hipGetLastError();
        grid = cus;
    }
    if (grid < 0) return;
    (void)hipMemsetAsync((char*)d_ws + WS_CTL, 0, CTL_ZERO_BYTES, stream);
    Params p{};
    for (int i = 0; i < 32; ++i) p.in[i] = (const float*)d_in[i];
    p.out = (float*)d_out; p.ws = (unsigned char*)d_ws;
    hipLaunchKernelGGL(hybrid_fwd, dim3(grid), dim3(NTHR), LDS_BYTES, stream, p);
}
```

```cpp
#include <hip/hip_runtime.h>
#include <stdint.h>
#include <stdio.h>

#define LAS __attribute__((address_space(3)))
#define GAS __attribute__((address_space(1)))
typedef unsigned short bf16;
typedef short bf16x8 __attribute__((ext_vector_type(8)));
typedef float f32x4 __attribute__((ext_vector_type(4)));
typedef unsigned u32x4 __attribute__((ext_vector_type(4)));
typedef unsigned u32x2 __attribute__((ext_vector_type(2)));

constexpr int D = 1024, NB = 16, LL = 2048, LC = 256;
constexpr int TOKL = NB * LL, TOKC = NB * LC, TOK = TOKL + TOKC;
constexpr int HYW = 384, RETW = 384, MLW = 256;
constexpr int NIN = 6800, NW1 = 3840, NGATE = 3072, NWP = 6912;
constexpr int DFF = 2816, NFF1 = 5632, NE = 8;
constexpr int NWAVES = 8, NTHR = 512;
constexpr int MAXTILES = 272, PASS_TILES = 64, NPASS = 5;

constexpr size_t MiB = 1u << 20;
constexpr size_t WS_CTL = 0, CTL_ZERO_BYTES = 1 * MiB;
constexpr size_t WS_MOD = 1 * MiB;
constexpr size_t WS_BIAS = 2 * MiB;
constexpr size_t WS_ROPE = 2 * MiB + 256 * 1024;
constexpr size_t WS_TOPE = 3 * MiB;
constexpr size_t WS_TOPW = 3 * MiB + 256 * 1024;
constexpr size_t WS_TOPP = 3 * MiB + 512 * 1024;
constexpr size_t WS_SLOT = 3 * MiB + 768 * 1024;
constexpr size_t WS_ROWIDX = 4 * MiB;
constexpr size_t WS_TILEE = 4 * MiB + 512 * 1024;
constexpr size_t WS_FTL = 5 * MiB;
constexpr size_t WS_FTC = 17 * MiB;
constexpr size_t WS_WIN = 18 * MiB;
constexpr size_t WS_WUP = 32 * MiB;
constexpr size_t WS_WOUT = 34 * MiB;
constexpr size_t WS_XC = 36 * MiB;
constexpr size_t WS_H = 52 * MiB;
constexpr size_t WS_Y = 124 * MiB;
constexpr size_t WS_U = 196 * MiB;
constexpr size_t WS_RET = WS_U;
constexpr size_t WS_ML = WS_U + 108 * MiB;
constexpr size_t WS_MLG = WS_U + 180 * MiB;
constexpr size_t WS_OB = WS_U + 183 * MiB;
constexpr size_t WS_YHTL = WS_U + 228 * MiB;
constexpr size_t WS_YHTC = WS_U + 252 * MiB;
constexpr size_t WS_HYTL = WS_U + 255 * MiB;
constexpr size_t WS_HYTC = WS_U + 327 * MiB;
constexpr size_t WS_END = WS_U + 336 * MiB;
constexpr size_t WS_GATES = WS_U;
constexpr size_t WS_ACT = WS_U;
constexpr size_t WS_W13 = WS_U + 204 * MiB;
constexpr size_t WS_W2 = WS_U + 216 * MiB;
constexpr size_t WS_MW13 = WS_Y;
constexpr size_t WS_MW2 = WS_Y + 88 * MiB;
constexpr size_t WS_MACT = WS_Y + 132 * MiB;
constexpr size_t WS_EOUT = WS_Y + 220 * MiB;
static_assert(WS_EOUT + (size_t)MAXTILES * 256 * 1024 * 2 <= WS_END, "map");
static_assert(WS_GATES + (size_t)TOK * NGATE * 2 <= WS_YHTL, "gates overlay");

constexpr int CW_BAR = 4096;
constexpr int CW_CNT = 16384;

constexpr int LDS_BYTES = 147456;
constexpr int MISC_OFF = 147456 - 256;

__device__ __forceinline__ float bf2f(bf16 b) { return __uint_as_float(((unsigned)b) << 16); }
typedef __bf16 bf2v_ __attribute__((ext_vector_type(2)));
typedef float f2v_ __attribute__((ext_vector_type(2)));
__device__ __forceinline__ unsigned pk2(float lo, float hi) { const f2v_ f = {lo, hi}; return __builtin_bit_cast(unsigned, __builtin_convertvector(f, bf2v_)); }
__device__ __forceinline__ unsigned f2bf(float f) { return pk2(f, 0.f) & 0xffffu; }
__device__ __forceinline__ float dpp_f(float v, int) { return v; }
#define DPP_ADD(v, ctrl) (v) += __int_as_float(__builtin_amdgcn_update_dpp(0, __float_as_int(v), (ctrl), 0xf, 0xf, true))
__device__ __forceinline__ float wave_sum(float v) {
    DPP_ADD(v, 0xB1);
    DPP_ADD(v, 0x4E);
    DPP_ADD(v, 0x141);
    DPP_ADD(v, 0x140);
    return __int_as_float(__builtin_amdgcn_readlane(__float_as_int(v), 0)) + __int_as_float(__builtin_amdgcn_readlane(__float_as_int(v), 16))
         + __int_as_float(__builtin_amdgcn_readlane(__float_as_int(v), 32)) + __int_as_float(__builtin_amdgcn_readlane(__float_as_int(v), 48));
}
__device__ __forceinline__ float lane_read(float v, int src_lane) { return __int_as_float(__builtin_amdgcn_ds_bpermute(src_lane << 2, __float_as_int(v))); }
__device__ __forceinline__ float sigmoidf_(float x) { return __builtin_amdgcn_rcpf(1.0f + __expf(-x)); }
__device__ __forceinline__ float siluf_(float x) { return x * __builtin_amdgcn_rcpf(1.0f + __expf(-x)); }

#define XB_TMO      128
#define XB_XCNT(j)  (256  + 64 * (j))
#define XB_XSUB(j)  (1280 + 64 * (j))
#define XB_XGEN(j)  (2304 + 64 * (j))
#define XB_TOP      3328
#define XB_TOPGEN   3392
#define XCD_BAR_WORDS 3456
#define XB_SPIN_CAP (1u << 22)
__device__ __forceinline__ unsigned xb_ld(GAS unsigned* p)              { return __hip_atomic_load(p, __ATOMIC_RELAXED, __HIP_MEMORY_SCOPE_AGENT); }
__device__ __forceinline__ unsigned xb_add(GAS unsigned* p, unsigned v) { return __hip_atomic_fetch_add(p, v, __ATOMIC_RELAXED, __HIP_MEMORY_SCOPE_AGENT); }
__device__ __forceinline__ unsigned xb_xcc_id() { return (unsigned)__builtin_amdgcn_s_getreg((3 << 11) | 20) & 0xFu; }
#define XB_SPIN(cond, bar) do { unsigned _sp = 0; while (cond) { __builtin_amdgcn_s_sleep(1); \
    if ((++_sp & 255u) == 0u) { if (xb_ld(&(bar)[XB_TMO])) break; if (_sp > XB_SPIN_CAP) { (void)__hip_atomic_fetch_add(&(bar)[XB_TMO], 1u, __ATOMIC_RELAXED, __HIP_MEMORY_SCOPE_AGENT); break; } } } } while (0)
struct XcdBarrier { GAS unsigned* bar; unsigned x; volatile LAS unsigned* st; };
__device__ __forceinline__ XcdBarrier xcd_barrier_post(GAS unsigned* bar, volatile LAS unsigned* st) {
    XcdBarrier b; b.bar = bar; b.x = xb_xcc_id(); b.st = st;
    if (threadIdx.x == 0) (void)xb_add(&bar[XB_XCNT(b.x)], 1u);
    return b;
}
__device__ __forceinline__ void xcd_barrier_complete(GAS unsigned* bar, unsigned x, unsigned& nloc, unsigned& nx) {
    const unsigned G = gridDim.x * gridDim.y * gridDim.z;
    unsigned sum, cnt, mine, sp = 0u;
    for (;;) {
        sum = 0u; cnt = 0u; mine = 0u;
#pragma unroll 1
        for (unsigned j = 0; j < 16; ++j) { const unsigned c = xb_ld(&bar[XB_XCNT(j)]); sum += c; cnt += (c > 0u) ? 1u : 0u; }
        mine = xb_ld(&bar[XB_XCNT(x)]);
        if (sum == G) break;
        __builtin_amdgcn_s_sleep(1);
        if ((++sp & 255u) == 0u) { if (xb_ld(&bar[XB_TMO])) break; if (sp > XB_SPIN_CAP) { (void)__hip_atomic_fetch_add(&bar[XB_TMO], 1u, __ATOMIC_RELAXED, __HIP_MEMORY_SCOPE_AGENT); break; } }
    }
    nloc = mine > 0u ? mine : 1u; nx = cnt > 0u ? cnt : 1u;
}
__device__ __forceinline__ void xcd_barrier(const XcdBarrier& b) {
    asm volatile("s_waitcnt vmcnt(0)" ::: "memory");
    __syncthreads();
    if (threadIdx.x == 0) {
        GAS unsigned* bar = b.bar;
        __builtin_amdgcn_s_waitcnt(0);
        unsigned nloc = b.st[0], nx = b.st[1];
        if (nloc == 0u) { xcd_barrier_complete(bar, b.x, nloc, nx); b.st[0] = nloc; b.st[1] = nx; }
        const unsigned old = xb_add(&bar[XB_XSUB(b.x)], 1u);
        const unsigned gen = old / nloc;
        if (old + 1u == (gen + 1u) * nloc) {
            __builtin_amdgcn_fence(__ATOMIC_RELEASE, "agent");
            asm volatile("s_waitcnt vmcnt(0)" ::: "memory");
            const unsigned og = xb_add(&bar[XB_TOP], 1u);
            const unsigned tg = og / nx;
            if (og + 1u == (tg + 1u) * nx) xb_add(&bar[XB_TOPGEN], 1u);
            else XB_SPIN(xb_ld(&bar[XB_TOPGEN]) == tg, bar);
            __builtin_amdgcn_fence(__ATOMIC_ACQUIRE, "agent");
            xb_add(&bar[XB_XGEN(b.x)], 1u);
            asm volatile("s_waitcnt vmcnt(0)" ::: "memory");
        } else {
            XB_SPIN(xb_ld(&bar[XB_XGEN(b.x)]) == gen, bar);
            __builtin_amdgcn_fence(__ATOMIC_ACQUIRE, "agent");
            asm volatile("s_waitcnt vmcnt(0)" ::: "memory");
        }
    }
    __syncthreads();
}

struct Params { const float* in[32]; float* out; unsigned char* ws; };
enum { I_X = 0, I_C, I_CTX, I_CCTX, I_WMOD, I_BMOD, I_GMIX, I_GFFN, I_WIN, I_BIN, I_HYCONV, I_HYF1, I_HYFB1, I_HYF2, I_HYFB2, I_HYF3, I_HYDECAY,
       I_HYSKIP, I_RETDECAY, I_MLCONV, I_MLGB, I_WUP, I_WOUT, I_FW1, I_FW3, I_FW2, I_ROUTER, I_ROUTERB, I_MW1, I_MW3, I_MW2, I_GFINAL };

struct Frame {
    LAS unsigned char* lds;
    GAS unsigned char* ws;
    int tid, lane, wave, G, wg;
};
#define WSP(T, off) ((GAS T*)(F.ws + (off)))
constexpr int PTAB_OFF = 147456 - 1024;
__device__ __forceinline__ const GAS float* inp(const Frame& F, int i) {
    const LAS unsigned* t = (const LAS unsigned*)(F.lds + PTAB_OFF) + 2 * i;
    const unsigned lo = __builtin_amdgcn_readfirstlane(t[0]), hi = __builtin_amdgcn_readfirstlane(t[1]);
    return (const GAS float*)(((unsigned long long)hi << 32) | lo);
}
__device__ __forceinline__ GAS float* outp(const Frame& F) { return (GAS float*)inp(F, 32); }

__device__ __forceinline__ int row_batch(int row) { return row < TOKL ? (row >> 11) : ((row - TOKL) >> 8); }
__device__ __forceinline__ const GAS float* mod_ptr(const Frame& F, int layer, int row, int which) {
    const int r = row < TOKL ? (row >> 11) : 16;
    return WSP(const float, WS_MOD) + ((size_t)(layer * 17 + r) * 6 + which) * 1024;
}

template <class RowMap>
__device__ __forceinline__ void tr_item(const GAS float* W, int K, int N, GAS bf16* WT, int ldT, RowMap rm, LAS float* scr, int item, int lane) {
    const int nblk = (N + 31) / 32, kb = item / nblk, nb = item % nblk, k0 = 64 * kb, n0 = 32 * nb;
#pragma unroll 8
    for (int i = 0; i < 32; ++i) { const int kk = 2 * i + (lane >> 5); const int n = n0 + (lane & 31); scr[kk * 33 + (lane & 31)] = (n < N) ? W[(size_t)(k0 + kk) * N + n] : 0.f; }
    asm volatile("s_waitcnt lgkmcnt(0)" ::: "memory");
    const int c = lane & 7;
#pragma unroll
    for (int j = 0; j < 4; ++j) { const int nl = (lane >> 3) + 8 * j; const int n = n0 + nl; const LAS float* s = scr + (8 * c) * 33 + nl;
        u32x4 o; o.x = pk2(s[0 * 33], s[1 * 33]); o.y = pk2(s[2 * 33], s[3 * 33]); o.z = pk2(s[4 * 33], s[5 * 33]); o.w = pk2(s[6 * 33], s[7 * 33]);
        if (n < N) *(GAS u32x4*)(WT + (size_t)rm(n) * ldT + k0 + 8 * c) = o; }
    asm volatile("s_waitcnt lgkmcnt(0)" ::: "memory");
}
struct RmId { __device__ __forceinline__ int operator()(int n) const { return n; } };
__device__ __forceinline__ int win_row(int n) {
    if (n < 1152) return n;
    if (n < 2688) return 1280 + (n - 1152);
    if (n < 3712) return 2816 + (n - 2688);
    if (n < 3728) return 1152 + (n - 3712);
    return 3840 + (n - 3728);
}
struct RmWin { __device__ __forceinline__ int operator()(int n) const { return win_row(n); } };
struct RmW1 { __device__ __forceinline__ int operator()(int n) const { return (n >> 4) * 32 + (n & 15); } };
struct RmW3 { __device__ __forceinline__ int operator()(int n) const { return (n >> 4) * 32 + 16 + (n & 15); } };

__device__ __forceinline__ void conv_weights_win(Frame& F, int layer, int gw, int NGW, LAS float* scr) {
    const GAS float* W = inp(F, I_WIN) + (size_t)layer * D * NIN;
    const int items = (D / 64) * ((NIN + 31) / 32);
    for (int it = gw; it < items; it += NGW) tr_item(W, D, NIN, WSP(bf16, WS_WIN), D, RmWin(), scr, it, F.lane);
    GAS bf16* wt = WSP(bf16, WS_WIN);
    unsigned zz; asm volatile("v_mov_b32 %0, 0" : "=v"(zz));
    for (int i = gw * 64 + F.lane; i < 112 * 1024 / 8; i += NGW * 64) *(GAS u32x4*)(wt + (size_t)1168 * 1024 + (size_t)i * 8) = (u32x4){zz, zz, zz, zz};
}
__device__ __forceinline__ void conv_weights_upout(Frame& F, int layer, int gw, int NGW, LAS float* scr) {
    const int items = (D / 64) * (D / 32);
    for (int it = gw; it < items; it += NGW) tr_item(inp(F, I_WUP) + (size_t)layer * D * D, D, D, WSP(bf16, WS_WUP), D, RmId(), scr, it, F.lane);
    for (int it = gw; it < items; it += NGW) tr_item(inp(F, I_WOUT) + (size_t)layer * D * D, D, D, WSP(bf16, WS_WOUT), D, RmId(), scr, it, F.lane);
}
__device__ __forceinline__ void conv_weights_ffn(const GAS float* w1, const GAS float* w3, const GAS float* w2, GAS bf16* w13t, GAS bf16* w2t, int gw, int NGW, LAS float* scr, int lane) {
    const int i1 = (D / 64) * (DFF / 32), i2 = (DFF / 64) * (D / 32);
    for (int it = gw; it < i1; it += NGW) tr_item(w1, D, DFF, w13t, D, RmW1(), scr, it, lane);
    for (int it = gw; it < i1; it += NGW) tr_item(w3, D, DFF, w13t, D, RmW3(), scr, it, lane);
    for (int it = gw; it < i2; it += NGW) tr_item(w2, DFF, D, w2t, DFF, RmId(), scr, it, lane);
}

__device__ __forceinline__ void filter_item(Frame& F, int layer, int L, GAS bf16* FT  , int pb, int ch, LAS float* tile  ) {
    const GAS float* f1 = inp(F, I_HYF1) + layer * 33 * 64; const GAS float* fb1 = inp(F, I_HYFB1) + layer * 64;
    const GAS float* f2 = inp(F, I_HYF2) + layer * 64 * 64; const GAS float* fb2 = inp(F, I_HYFB2) + layer * 64;
    const GAS float* f3 = inp(F, I_HYF3) + (size_t)layer * 64 * 1536; const GAS float* dec = inp(F, I_HYDECAY) + layer * 1536;
    const int lane = F.lane, n = ch * 64 + lane;
    const float b1 = fb1[lane], b2 = fb2[lane], adec = fabsf(dec[n]);
    for (int pl = 0; pl < 64; ++pl) {
        const int pos = pb * 64 + pl;
        const float t = (float)pos / (float)(L - 1);
        const float w = 6.283185307179586f * (float)pos / (float)L;
        float feat = 0.f;
        if (lane == 0) feat = t;
        else if (lane < 17) { const float band = 1e-4f + (float)(lane - 1) * ((15.0f - 1e-4f) / 15.0f); feat = cosf(w * band); }
        else if (lane < 33) { const float band = 1e-4f + (float)(lane - 17) * ((15.0f - 1e-4f) / 15.0f); feat = -sinf(w * band); }
        float a1 = b1;
        for (int i = 0; i < 33; ++i) a1 += __int_as_float(__builtin_amdgcn_readlane(__float_as_int(feat), i)) * f1[i * 64 + lane];
        const float h1 = sinf(a1);
        float a2 = b2;
        for (int i = 0; i < 64; ++i) a2 += __int_as_float(__builtin_amdgcn_readlane(__float_as_int(h1), i)) * f2[i * 64 + lane];
        const float h2 = sinf(a2);
        float a3 = 0.f;
        for (int i = 0; i < 64; ++i) a3 += __int_as_float(__builtin_amdgcn_readlane(__float_as_int(h2), i)) * f3[i * 1536 + n];
        tile[pl * 65 + lane] = a3 * expf(-t * adec);
    }
    asm volatile("s_waitcnt lgkmcnt(0)" ::: "memory");
    const int pos = pb * 64 + lane;
    for (int cl = 0; cl < 64; ++cl) {
        const int nn = ch * 64 + cl, o = nn / 768, dir = (nn / 384) & 1, c = nn % 384;
        GAS bf16* dst = FT + (size_t)(o * 384 + c) * (2 * L);
        const float v = tile[lane * 65 + cl];
        if (dir == 0) dst[L - pos] = (bf16)f2bf(v);
        else if (pos > 0) dst[L + pos] = (bf16)f2bf(v);
    }
    asm volatile("s_waitcnt lgkmcnt(0)" ::: "memory");
}

__device__ __forceinline__ void phase_p0(Frame& F) {
    const int gw = F.wg * NWAVES + F.wave, NGW = F.G * NWAVES;
    LAS float* sl = (LAS float*)F.lds;
    LAS float* red = (LAS float*)(F.lds + 17 * 4096);
    for (int i = F.tid; i < 17 * 1024; i += NTHR) { const int r = i >> 10, k = i & 1023; const float v = r < 16 ? inp(F, I_C)[r * 1024 + k] : inp(F, I_CCTX)[k]; sl[i] = siluf_(v); }
    __syncthreads();
    for (int item = F.wg; item < 2 * 384; item += F.G) {
        const int layer = item / 384, n0 = (item % 384) * 16, j = F.tid & 15, kp = F.tid >> 4;
        const GAS float* W = inp(F, I_WMOD) + (size_t)layer * D * 6144;
        float acc[17];
#pragma unroll
        for (int r = 0; r < 17; ++r) acc[r] = 0.f;
        for (int k = kp * 32; k < kp * 32 + 32; ++k) { const float w = W[(size_t)k * 6144 + n0 + j];
#pragma unroll
            for (int r = 0; r < 17; ++r) acc[r] += sl[r * 1024 + k] * w; }
#pragma unroll
        for (int r = 0; r < 17; ++r) red[(kp * 17 + r) * 16 + j] = acc[r];
        __syncthreads();
        if (F.tid < 272) { const int r = F.tid >> 4, jj = F.tid & 15; float s = inp(F, I_BMOD)[layer * 6144 + n0 + jj];
            for (int q = 0; q < 32; ++q) s += red[(q * 17 + r) * 16 + jj];
            WSP(float, WS_MOD)[(size_t)(layer * 17 + r) * 6144 + n0 + jj] = s; }
        __syncthreads();
    }
    __syncthreads();
    LAS float* scr = (LAS float*)(F.lds + F.wave * 8704);
    conv_weights_win(F, 0, gw, NGW, scr);
    conv_weights_upout(F, 0, gw, NGW, scr);
    for (int i = gw * 64 + F.lane; i < 2048 * 32; i += NGW * 64) {
        const int t = i >> 5, j = i & 31, half = j >> 4, ii = j & 15;
        const float inv = 1.0f / powf(10000.0f, (float)ii / 16.0f);
        const float ang = (float)(half == 0 ? (t >> 6) : (t & 63)) * inv;
        WSP(float, WS_ROPE)[t * 64 + half * 32 + ii] = cosf(ang);
        WSP(float, WS_ROPE)[t * 64 + half * 32 + 16 + ii] = sinf(ang);
    }
    __syncthreads();
    LAS float* ftile = (LAS float*)(F.lds + F.wave * 16640);
    for (int it = gw; it < 1536 + 96; it += NGW) {
        if (it < 1536) { const int layer = it / 768, r = it % 768; filter_item(F, layer, LL, WSP(bf16, WS_FTL) + (size_t)layer * 2 * 384 * 4096, r / 24, r % 24, ftile); }
        else { const int r = it - 1536; filter_item(F, 0, LC, WSP(bf16, WS_FTC), r / 24, r % 24, ftile); }
    }
}
__device__ __forceinline__ void write_bias(Frame& F) {
    const int gt = (F.wg * NWAVES + F.wave) * 64 + F.lane, NGT = F.G * NTHR;
    for (int i = gt; i < 2 * NWP; i += NGT) {
        const int l = i / NWP, r = i % NWP; float v = 0.f;
        int n = -1;
        if (r < 1152) n = r; else if (r < 1168) n = 3712 + (r - 1152); else if (r < 1280) n = -1; else if (r < 2816) n = 1152 + (r - 1280); else if (r < 3840) n = 2688 + (r - 2816); else n = 3728 + (r - 3840);
        if (n >= 0) v = inp(F, I_BIN)[l * NIN + n];
        WSP(float, WS_BIAS)[i] = v;
    }
}

__device__ __forceinline__ void norm_mod_row(const GAS float* xrow, const GAS float* g, const GAS float* shift, const GAS float* scale, GAS bf16* orow, int lane, float* keep  ) {
    f32x4 v[4]; float s = 0.f;
#pragma unroll
    for (int j = 0; j < 4; ++j) { v[j] = *(const GAS f32x4*)(xrow + 256 * j + 4 * lane); s += (v[j].x * v[j].x + v[j].y * v[j].y) + (v[j].z * v[j].z + v[j].w * v[j].w); }
    const float r = rsqrtf(wave_sum(s) * (1.0f / 1024.0f) + 1e-6f);
#pragma unroll
    for (int j = 0; j < 4; ++j) {
        const f32x4 gg = *(const GAS f32x4*)(g + 256 * j + 4 * lane), sh = *(const GAS f32x4*)(shift + 256 * j + 4 * lane), sc = *(const GAS f32x4*)(scale + 256 * j + 4 * lane);
        f32x4 o;
        o.x = (v[j].x * r * gg.x) * (1.f + sc.x) + sh.x; o.y = (v[j].y * r * gg.y) * (1.f + sc.y) + sh.y;
        o.z = (v[j].z * r * gg.z) * (1.f + sc.z) + sh.z; o.w = (v[j].w * r * gg.w) * (1.f + sc.w) + sh.w;
        if (keep) { keep[4 * j + 0] = o.x; keep[4 * j + 1] = o.y; keep[4 * j + 2] = o.z; keep[4 * j + 3] = o.w; }
        u32x2 w; w.x = pk2(o.x, o.y); w.y = pk2(o.z, o.w);
        *(GAS u32x2*)(orow + 256 * j + 4 * lane) = w;
    }
}
__device__ __forceinline__ const GAS float* xrow_ptr(const Frame& F, int row, bool from_input) {
    if (row < TOKL) return (from_input ? inp(F, I_X) : outp(F)) + (size_t)row * D;
    return (from_input ? inp(F, I_CTX) : WSP(const float, WS_XC)) + (size_t)(row - TOKL) * D;
}
__device__ __forceinline__ void phase_norm(Frame& F, int layer, int nrows, bool from_input, int which) {
    const int gw = F.wg * NWAVES + F.wave, NGW = F.G * NWAVES;
    const GAS float* g = inp(F, which == 0 ? I_GMIX : I_GFFN) + layer * D;
    for (int row = gw; row < nrows; row += NGW)
        norm_mod_row(xrow_ptr(F, row, from_input), g, mod_ptr(F, layer, row, which), mod_ptr(F, layer, row, which + 1), WSP(bf16, WS_H) + (size_t)row * D, F.lane, nullptr);
}

namespace pg8 {
constexpr int BM = 256, BK = 64, HALF = 128, HTB = HALF * BK * 2, STAGE_BYTES = 8 * HTB, NXCD = 8, WGM = 8;
__device__ __forceinline__ int lds_byte(int r, int c) { const int st = (r >> 4) * 2 + (c >> 5), rr = r & 15, cc = c & 31, ob = rr * 64 + cc * 2; return st * 1024 + (ob ^ (((ob >> 9) & 1) << 5)); }
__device__ __forceinline__ void stage_rc(int b, int& R, int& C) { const int st = b / 1024, sb = b % 1024, swz = sb ^ (((sb >> 9) & 1) << 5); R = (st >> 1) * 16 + swz / 64; C = (st & 1) * 32 + (swz % 64) / 2; }
struct Unit { int pm, pn; };
struct OrderPlain {
    static constexpr bool GATHER = false;
    int nM, nN, nwg, G, c;
    __device__ __forceinline__ void init(int nM_, int nN_, int G_, int c_) { nM = nM_; nN = nN_; nwg = nM * nN; G = G_; c = c_; }
    __device__ __forceinline__ bool next(int i, Unit& u) const {
        const long L = (long)i * G + c; if (L >= nwg) return false;
        int wgid = (int)L; { const int q = nwg / NXCD, r = nwg % NXCD, xcd = wgid % NXCD, off = wgid / NXCD; wgid = (xcd < r ? xcd * (q + 1) : r * (q + 1) + (xcd - r) * q) + off; }
        const int nig = WGM * nN, gid = wgid / nig, fm = gid * WGM, gsz = (nM - fm) < WGM ? (nM - fm) : WGM;
        u.pm = fm + ((wgid % nig) % gsz); u.pn = (wgid % nig) / gsz; return true;
    }
    __device__ __forceinline__ int arow(int r) const { return r; }
    __device__ __forceinline__ size_t boff(const Unit&) const { return 0; }
};
struct OrderMoe {
    static constexpr bool GATHER = true;
    OrderPlain o; const GAS int* rowidx; const GAS int* tilee; int t0; size_t bstride; bool gather;
    __device__ __forceinline__ bool next(int i, Unit& u) const { return o.next(i, u); }
    __device__ __forceinline__ int arow(int r) const { return gather ? rowidx[t0 * 256 + r] : r; }
    __device__ __forceinline__ size_t boff(const Unit& u) const { return (size_t)tilee[t0 + u.pm] * bstride; }
};

template <class Epi, class Sched>
__device__ __forceinline__ void gemm_phase(LAS unsigned char* lds, int tid_in, const GAS bf16* A, int lda, const GAS bf16* Bt, int ldb, int K, const Sched& S, const Epi& E) {
    unsigned tid_u = (unsigned)tid_in; asm volatile("" : "+v"(tid_u));
    const int tid = (int)tid_u, wid = __builtin_amdgcn_readfirstlane(tid >> 6), lane = tid & 63, wr = wid >> 2, wc = wid & 3, fr = lane & 15, fq = lane >> 4;
    const int nt = K / BK;
    unsigned voffB[2];
    { int sR[2], sC[2];
#pragma unroll
      for (int i = 0; i < 2; ++i) { stage_rc(tid * 16 + i * 8192, sR[i], sC[i]); voffB[i] = (unsigned)(sR[i] * ldb + sC[i]) * 2u; } }
#define PG8_GATHER_OFFS(pm_) do { unsigned _t = (unsigned)tid; asm volatile("" : "+v"(_t)); _Pragma("unroll") for (int i = 0; i < 2; ++i) { int _R, _C; stage_rc((int)_t * 16 + i * 8192, _R, _C); \
        vc0[i] = (unsigned)((size_t)S.arow((pm_) * BM + _R) * lda + _C) * 2u; vc1[i] = (unsigned)((size_t)S.arow((pm_) * BM + HALF + _R) * lda + _C) * 2u; } } while (0)
    const size_t kstep = (size_t)(BK * 2);
    const size_t hstepB = (size_t)HALF * ldb * 2, tstepB = 2 * hstepB;
    const unsigned ldsw = (unsigned)wid * 1024u;
    const int aoff = lds_byte(wr * 64 + fr, fq * 8), boff = lds_byte(wc * 32 + fr, fq * 8);
#define PG8_SA(b, h) (((b) * 2 + (h)) * HTB)
#define PG8_SB(b, h) ((4 + (b) * 2 + (h)) * HTB)
#define PG8_STAGE2(bufoff, gbase, v0, v1) do { \
        __builtin_amdgcn_global_load_lds((const GAS unsigned*)((const GAS char*)(gbase) + (v0)), (LAS unsigned*)(lds + (bufoff) + ldsw), 16, 0, 0); \
        __builtin_amdgcn_global_load_lds((const GAS unsigned*)((const GAS char*)(gbase) + (v1)), (LAS unsigned*)(lds + (bufoff) + ldsw + 8192), 16, 0, 0); } while (0)
#define PG8_STAGEB(bufoff, gbase) PG8_STAGE2(bufoff, gbase, voffB[0], voffB[1])
#define PG8_LDA(dst, b, h) do { _Pragma("unroll") for (int m = 0; m < 4; ++m) _Pragma("unroll") for (int k = 0; k < 2; ++k) dst[m][k] = *(const LAS bf16x8*)(lds + PG8_SA(b, h) + aoff + m * 2048 + k * 1024); } while (0)
#define PG8_LDB(dst, b, h) do { _Pragma("unroll") for (int n = 0; n < 2; ++n) _Pragma("unroll") for (int k = 0; k < 2; ++k) dst[n][k] = *(const LAS bf16x8*)(lds + PG8_SB(b, h) + boff + n * 2048 + k * 1024); } while (0)
#define PG8_MMA(ai, bj, At, Bt_) do { __builtin_amdgcn_s_setprio(1); _Pragma("unroll") for (int m = 0; m < 4; ++m) _Pragma("unroll") for (int n = 0; n < 2; ++n) _Pragma("unroll") for (int k = 0; k < 2; ++k) \
        acc[ai][bj][m][n] = __builtin_amdgcn_mfma_f32_16x16x32_bf16(Bt_[n][k], At[m][k], acc[ai][bj][m][n], 0, 0, 0); __builtin_amdgcn_s_setprio(0); } while (0)
#define PG8_WAIT_V(n) asm volatile("s_waitcnt vmcnt(" #n ")" ::: "memory")
#define PG8_WAIT_L(n) asm volatile("s_waitcnt lgkmcnt(" #n ")" ::: "memory")
#define PG8_BAR __builtin_amdgcn_s_barrier()
#define PG8_SCHED __builtin_amdgcn_sched_barrier(0)
    Unit cur, nxt; int ui = 0;
    if (!S.next(0, cur)) return;
    f32x4 acc[2][2][4][2];
#pragma unroll
    for (int a = 0; a < 2; ++a)
#pragma unroll
        for (int b = 0; b < 2; ++b)
#pragma unroll
            for (int m = 0; m < 4; ++m)
#pragma unroll
                for (int n = 0; n < 2; ++n) { float zf; asm volatile("v_mov_b32 %0, 0" : "=v"(zf)); acc[a][b][m][n] = (f32x4){zf, zf, zf, zf}; }
    bf16x8 At[4][2], B0[2][2], B1[2][2];
    constexpr bool GA = Sched::GATHER;
    const size_t hstepA = GA ? 0 : (size_t)HALF * lda * 2, tstepA = (size_t)BM * lda * 2;
    unsigned vc0[2], vc1[2];
    if constexpr (GA) { PG8_GATHER_OFFS(cur.pm); }
    else { int sR, sC;
#pragma unroll
        for (int i = 0; i < 2; ++i) { stage_rc(tid * 16 + i * 8192, sR, sC); vc0[i] = (unsigned)(sR * lda + sC) * 2u; vc1[i] = 0u; } }
#define VC0(i) vc0[i]
#define VC1(i) (GA ? vc1[i] : vc0[i])
#define VN0(i) vc0[i]
#define VN1(i) VC1(i)
    const GAS char* cA = GA ? (const GAS char*)A : (const GAS char*)A + (size_t)cur.pm * tstepA;
    const GAS char* cB = (const GAS char*)Bt + S.boff(cur) * 2 + (size_t)cur.pn * tstepB;
    PG8_STAGEB(PG8_SB(0, 0), cB); PG8_STAGE2(PG8_SA(0, 0), cA, VC0(0), VC0(1)); PG8_STAGEB(PG8_SB(0, 1), cB + hstepB); PG8_STAGE2(PG8_SA(0, 1), cA + hstepA, VC1(0), VC1(1));
    if (wr == 1) PG8_BAR;
    PG8_WAIT_V(4); PG8_BAR;
    PG8_STAGEB(PG8_SB(1, 0), cB + kstep); PG8_STAGE2(PG8_SA(1, 0), cA + kstep, VC0(0), VC0(1)); PG8_STAGEB(PG8_SB(1, 1), cB + hstepB + kstep);
    PG8_WAIT_V(6); PG8_BAR;
    for (;;) {
        const bool has_next = S.next(ui + 1, nxt);
        const GAS char* nB = cB; const GAS char* nA = cA;
        if (has_next) {
            nB = (const GAS char*)Bt + S.boff(nxt) * 2 + (size_t)nxt.pn * tstepB;
            if constexpr (!GA) nA = (const GAS char*)A + (size_t)nxt.pm * tstepA;
        }
        for (int t = 0; t < nt; t += 2) {
            const bool last = (t == nt - 2);
            if constexpr (Epi::HORNER) {
                if (t == 6 || t == 12) {
                    asm volatile("" ::: "memory");
                    const int seg = (t == 6) ? 0 : 1;
                    int hpm = cur.pm, hpn = cur.pn; asm volatile("" : "+s"(hpm), "+s"(hpn));
                    unsigned hln = (unsigned)lane; asm volatile("" : "+v"(hln)); const int hfr = (int)(hln & 15u), hfq = (int)(hln >> 4);
#pragma unroll
                    for (int ai = 0; ai < 2; ++ai) {
                        u32x2 ga[4][2][2], gb[4][2][2];
#pragma unroll
                        for (int m = 0; m < 4; ++m)
#pragma unroll
                            for (int bj = 0; bj < 2; ++bj)
#pragma unroll
                                for (int n = 0; n < 2; ++n) {
                                    const int row = hpm * BM + ai * HALF + wr * 64 + m * 16 + hfr, col = hpn * BM + bj * HALF + wc * 32 + n * 16 + 4 * hfq;
                                    ga[m][bj][n] = E.gate(seg, row, col); gb[m][bj][n] = E.gate(seg + 1, row, col);
                                }
                        asm volatile("" : "+v"(ga[0][0][0]), "+v"(ga[0][0][1]), "+v"(ga[0][1][0]), "+v"(ga[0][1][1]), "+v"(ga[1][0][0]), "+v"(ga[1][0][1]), "+v"(ga[1][1][0]), "+v"(ga[1][1][1]),
                                          "+v"(ga[2][0][0]), "+v"(ga[2][0][1]), "+v"(ga[2][1][0]), "+v"(ga[2][1][1]), "+v"(ga[3][0][0]), "+v"(ga[3][0][1]), "+v"(ga[3][1][0]), "+v"(ga[3][1][1]) :: "memory");
                        asm volatile("" : "+v"(gb[0][0][0]), "+v"(gb[0][0][1]), "+v"(gb[0][1][0]), "+v"(gb[0][1][1]), "+v"(gb[1][0][0]), "+v"(gb[1][0][1]), "+v"(gb[1][1][0]), "+v"(gb[1][1][1]),
                                          "+v"(gb[2][0][0]), "+v"(gb[2][0][1]), "+v"(gb[2][1][0]), "+v"(gb[2][1][1]), "+v"(gb[3][0][0]), "+v"(gb[3][0][1]), "+v"(gb[3][1][0]), "+v"(gb[3][1][1]) :: "memory");
#pragma unroll
                        for (int m = 0; m < 4; ++m)
#pragma unroll
                            for (int bj = 0; bj < 2; ++bj)
#pragma unroll
                                for (int n = 0; n < 2; ++n) {
                                    const u32x2 a = ga[m][bj][n], b = gb[m][bj][n];
                                    f32x4& v = acc[ai][bj][m][n];
                                    v.x *= __uint_as_float(a.x << 16) * __builtin_amdgcn_rcpf(__uint_as_float(b.x << 16));
                                    v.y *= __uint_as_float(a.x & 0xffff0000u) * __builtin_amdgcn_rcpf(__uint_as_float(b.x & 0xffff0000u));
                                    v.z *= __uint_as_float(a.y << 16) * __builtin_amdgcn_rcpf(__uint_as_float(b.y << 16));
                                    v.w *= __uint_as_float(a.y & 0xffff0000u) * __builtin_amdgcn_rcpf(__uint_as_float(b.y & 0xffff0000u));
                                }
                    }
                    asm volatile("s_waitcnt vmcnt(0)" ::: "memory");
                }
            }
            const GAS char* a1 = cA + (size_t)(t + 1) * kstep;
            const GAS char* a2 = last ? nA : cA + (size_t)(t + 2) * kstep; const GAS char* b2 = last ? nB : cB + (size_t)(t + 2) * kstep;
            const GAS char* a3 = a2 + kstep; const GAS char* b3 = b2 + kstep;
            PG8_LDB(B0, 0, 0); PG8_SCHED; PG8_LDA(At, 0, 0); PG8_STAGE2(PG8_SA(1, 1), a1 + hstepA, VC1(0), VC1(1));
            if constexpr (GA) { if (last && has_next) { asm volatile("" ::: "memory"); PG8_GATHER_OFFS(nxt.pm); asm volatile("" ::: "memory"); } }
            PG8_WAIT_L(8); PG8_BAR; PG8_WAIT_L(0); PG8_MMA(0, 0, At, B0); PG8_BAR; PG8_SCHED;
            PG8_LDB(B1, 0, 1); PG8_STAGEB(PG8_SB(0, 0), b2);
            PG8_BAR; PG8_WAIT_L(0); PG8_MMA(0, 1, At, B1); PG8_BAR;
            PG8_LDA(At, 0, 1); PG8_STAGE2(PG8_SA(0, 0), a2, VN0(0), VN0(1));
            PG8_BAR; PG8_WAIT_L(0); PG8_MMA(1, 0, At, B0); PG8_BAR; PG8_SCHED;
            PG8_STAGEB(PG8_SB(0, 1), b2 + hstepB);
            PG8_WAIT_V(6); PG8_BAR; PG8_MMA(1, 1, At, B1); PG8_BAR;
            PG8_LDB(B0, 1, 0); PG8_SCHED; PG8_LDA(At, 1, 0); PG8_STAGE2(PG8_SA(0, 1), a2 + hstepA, VN1(0), VN1(1));
            PG8_WAIT_L(8); PG8_BAR; PG8_WAIT_L(0); PG8_MMA(0, 0, At, B0); PG8_BAR; PG8_SCHED;
            PG8_LDB(B1, 1, 1); PG8_STAGEB(PG8_SB(1, 0), b3);
            PG8_BAR; PG8_WAIT_L(0); PG8_MMA(0, 1, At, B1); PG8_BAR;
            PG8_LDA(At, 1, 1); PG8_STAGE2(PG8_SA(1, 0), a3, VN0(0), VN0(1));
            PG8_BAR; PG8_WAIT_L(0); PG8_MMA(1, 0, At, B0); PG8_BAR; PG8_SCHED;
            PG8_STAGEB(PG8_SB(1, 1), b3 + hstepB);
            PG8_WAIT_V(6); PG8_BAR; PG8_MMA(1, 1, At, B1); PG8_BAR;
        }
        {
            int epm = cur.pm, epn = cur.pn; asm volatile("" : "+s"(epm), "+s"(epn));
            unsigned eln = (unsigned)lane; asm volatile("" : "+v"(eln)); const int efr = (int)(eln & 15u), efq = (int)(eln >> 4);
            f32x4 cv[2][2];
#pragma unroll
            for (int bj = 0; bj < 2; ++bj)
#pragma unroll
                for (int n = 0; n < 2; ++n) { if constexpr (Epi::COLVEC) cv[bj][n] = E.colvec(epm * BM, epn * BM + bj * HALF + wc * 32 + n * 16 + 4 * efq); else cv[bj][n] = (f32x4){0.f, 0.f, 0.f, 0.f}; }
            if constexpr (Epi::COLVEC) asm volatile("" : "+v"(cv[0][0]), "+v"(cv[0][1]), "+v"(cv[1][0]), "+v"(cv[1][1]) :: "memory");
#pragma unroll
            for (int ai = 0; ai < 2; ++ai) {
                f32x4 bs[4][2][2];
                if constexpr (Epi::BASE) {
#pragma unroll
                    for (int m = 0; m < 4; ++m)
#pragma unroll
                        for (int bj = 0; bj < 2; ++bj)
#pragma unroll
                            for (int n = 0; n < 2; ++n) bs[m][bj][n] = E.base(epm * BM + ai * HALF + wr * 64 + m * 16 + efr, epn * BM + bj * HALF + wc * 32 + n * 16 + 4 * efq);
                    asm volatile("" : "+v"(bs[0][0][0]), "+v"(bs[0][0][1]), "+v"(bs[0][1][0]), "+v"(bs[0][1][1]), "+v"(bs[1][0][0]), "+v"(bs[1][0][1]), "+v"(bs[1][1][0]), "+v"(bs[1][1][1]),
                                      "+v"(bs[2][0][0]), "+v"(bs[2][0][1]), "+v"(bs[2][1][0]), "+v"(bs[2][1][1]), "+v"(bs[3][0][0]), "+v"(bs[3][0][1]), "+v"(bs[3][1][0]), "+v"(bs[3][1][1]) :: "memory");
                }
#pragma unroll
                for (int m = 0; m < 4; ++m) {
                    const int row = epm * BM + ai * HALF + wr * 64 + m * 16 + efr;
#pragma unroll
                    for (int bj = 0; bj < 2; ++bj) {
                        if constexpr (Epi::PAIR) E.store_pair(row, epn * (BM / 2) + bj * (HALF / 2) + wc * 16 + 4 * efq, acc[ai][bj][m][0], acc[ai][bj][m][1]);
                        else {
#pragma unroll
                            for (int n = 0; n < 2; ++n) { f32x4 bb = (f32x4){0.f, 0.f, 0.f, 0.f}; if constexpr (Epi::BASE) bb = bs[m][bj][n]; E.store(row, epn * BM + bj * HALF + wc * 32 + n * 16 + 4 * efq, acc[ai][bj][m][n], cv[bj][n], bb); }
                        }
                    }
                }
            }
        }
        if (!has_next) break;
#pragma unroll
        for (int a = 0; a < 2; ++a)
#pragma unroll
            for (int b = 0; b < 2; ++b)
#pragma unroll
                for (int m = 0; m < 4; ++m)
#pragma unroll
                    for (int n = 0; n < 2; ++n) { float zf; asm volatile("v_mov_b32 %0, 0" : "=v"(zf)); acc[a][b][m][n] = (f32x4){zf, zf, zf, zf}; }
        cur = nxt; cB = nB; cA = nA; ++ui;
    }
    PG8_WAIT_V(0);
    if (wr == 0) PG8_BAR;
    PG8_BAR;
#undef PG8_GATHER_OFFS
#undef VC0
#undef VC1
#undef VN0
#undef VN1
#undef PG8_SA
#undef PG8_SB
#undef PG8_STAGE2
#undef PG8_STAGEB
#undef PG8_LDA
#undef PG8_LDB
#undef PG8_MMA
#undef PG8_WAIT_V
#undef PG8_WAIT_L
#undef PG8_BAR
#undef PG8_SCHED
}
}

template <class Epi>
__device__ __forceinline__ void gemm_fast(Frame& F, const GAS bf16* A, int lda, const GAS bf16* Bt, int ldb, int K, int M, int N, const Epi& E) {
    pg8::OrderPlain S; S.init(M / 256, N / 256, F.G, F.wg);
    pg8::gemm_phase(F.lds, F.tid, A, lda, Bt, ldb, K, S, E);
}
#ifndef FAST_PLAIN
#define FAST_PLAIN 1
#endif
#ifndef FAST_HORNER
#define FAST_HORNER 1
#endif
#ifndef FAST_MOE
#define FAST_MOE 1
#endif

__device__ __forceinline__ void st_bf16x4(GAS bf16* p, f32x4 v) { u32x2 w; w.x = pk2(v.x, v.y); w.y = pk2(v.z, v.w); *(GAS u32x2*)p = w; }
__device__ __forceinline__ f32x4 ld_bf16x4(const GAS bf16* p) { const u32x2 w = *(const GAS u32x2*)p; f32x4 v; v.x = __uint_as_float(w.x << 16); v.y = __uint_as_float(w.x & 0xffff0000u); v.z = __uint_as_float(w.y << 16); v.w = __uint_as_float(w.y & 0xffff0000u); return v; }

struct EpiWin {
    static constexpr bool HORNER = false, PAIR = false, COLVEC = true, BASE = false;
    const GAS float* bias; GAS bf16 *hytl, *hytc, *ret, *ml; GAS float* mlg;
    __device__ __forceinline__ f32x4 colvec(int, int col) const { return *(const GAS f32x4*)(bias + col); }
    __device__ __forceinline__ void store(int row, int col, f32x4 v, f32x4 cv, f32x4) const {
        v += cv;
        if (col < 1152) {
            if (row < TOKL) { const int b = row >> 11, t = row & 2047; GAS bf16* d = hytl + ((size_t)(b * 1152 + col)) * 2048 + t;
                d[0] = (bf16)f2bf(v.x); d[2048] = (bf16)f2bf(v.y); d[4096] = (bf16)f2bf(v.z); d[6144] = (bf16)f2bf(v.w); }
            else { const int r = row - TOKL, b = r >> 8, t = r & 255; GAS bf16* d = hytc + ((size_t)(b * 1152 + col)) * 256 + t;
                d[0] = (bf16)f2bf(v.x); d[256] = (bf16)f2bf(v.y); d[512] = (bf16)f2bf(v.z); d[768] = (bf16)f2bf(v.w); }
        } else if (col < 1168) { *(GAS f32x4*)(mlg + (size_t)row * 16 + (col - 1152)) = v; }
        else if (col < 1280) { }
        else if (col < 2816) st_bf16x4(ret + (size_t)row * 1536 + (col - 1280), v);
        else st_bf16x4(ml + (size_t)row * 1024 + (col - 2816), v);
    }
};
struct EpiGate {
    static constexpr bool HORNER = false, PAIR = false, COLVEC = true, BASE = false;
    const GAS float* bias; GAS bf16* gates;
    __device__ __forceinline__ f32x4 colvec(int, int col) const { return *(const GAS f32x4*)(bias + col); }
    __device__ __forceinline__ void store(int row, int col, f32x4 v, f32x4 cv, f32x4) const {
        v += cv;
        f32x4 g; g.x = fmaxf(sigmoidf_(v.x), 1e-20f); g.y = fmaxf(sigmoidf_(v.y), 1e-20f); g.z = fmaxf(sigmoidf_(v.z), 1e-20f); g.w = fmaxf(sigmoidf_(v.w), 1e-20f);
        st_bf16x4(gates + (size_t)row * NGATE + col, g);
    }
};
struct EpiUp {
    static constexpr bool HORNER = true, PAIR = false, COLVEC = false, BASE = true;
    const GAS bf16* gates; GAS bf16* acc_out;
    __device__ __forceinline__ u32x2 gate(int which, int row, int col) const { return *(const GAS u32x2*)(gates + (size_t)row * NGATE + which * 1024 + col); }
    __device__ __forceinline__ f32x4 base(int row, int col) const { return ld_bf16x4(gates + (size_t)row * NGATE + 2048 + col); }
    __device__ __forceinline__ void store(int row, int col, f32x4 v, f32x4, f32x4 g) const { st_bf16x4(acc_out + (size_t)row * D + col, v * g); }
};
struct EpiResid {
    static constexpr bool HORNER = false, PAIR = false, COLVEC = true, BASE = true;
    const GAS float *xin_l, *xin_c; GAS float *xout_l, *xout_c; const GAS float* modbase; int which;
    __device__ __forceinline__ f32x4 colvec(int row0, int col) const { const int r = row0 < TOKL ? (row0 >> 11) : 16; return *(const GAS f32x4*)(modbase + ((size_t)r * 6 + which) * 1024 + col); }
    __device__ __forceinline__ f32x4 base(int row, int col) const { return row < TOKL ? *(const GAS f32x4*)(xin_l + (size_t)row * D + col) : *(const GAS f32x4*)(xin_c + (size_t)(row - TOKL) * D + col); }
    __device__ __forceinline__ void store(int row, int col, f32x4 v, f32x4 m, f32x4 x) const {
        if (row < TOKL) *(GAS f32x4*)(xout_l + (size_t)row * D + col) = x + m * v;
        else *(GAS f32x4*)(xout_c + (size_t)(row - TOKL) * D + col) = x + m * v;
    }
};
struct EpiSwiglu {
    static constexpr bool HORNER = false, PAIR = true, COLVEC = false, BASE = false;
    GAS bf16* act; int row_off;
    __device__ __forceinline__ void store_pair(int row, int col, f32x4 a, f32x4 b) const {
        f32x4 o; o.x = siluf_(a.x) * b.x; o.y = siluf_(a.y) * b.y; o.z = siluf_(a.z) * b.z; o.w = siluf_(a.w) * b.w;
        st_bf16x4(act + (size_t)(row - row_off) * DFF + col, o);
    }
    __device__ __forceinline__ void store(int, int, f32x4, f32x4, f32x4) const {}
};
struct EpiBf16Out {
    static constexpr bool HORNER = false, PAIR = false, COLVEC = false, BASE = false;
    GAS bf16* out; int ld; int row_add;
    __device__ __forceinline__ void store(int row, int col, f32x4 v, f32x4, f32x4) const { st_bf16x4(out + (size_t)(row + row_add) * ld + col, v); }
    __device__ __forceinline__ void store_pair(int, int, f32x4, f32x4) const {}
};

constexpr int ZPITCH_L = (LL + 8) * 2, ZPITCH_C = (LC + 8) * 2;
template <int L>
__device__ __forceinline__ float conv3_at(const GAS bf16* base  , int t, float w0, float w1, float w2) {
    const float a = t > 0 ? bf2f(base[t - 1]) : 0.f, b = bf2f(base[t]), c = t < L - 1 ? bf2f(base[t + 1]) : 0.f;
    return w0 * a + w1 * b + w2 * c;
}
template <int L>
__device__ __forceinline__ void hyena_unit_naive(Frame& F, int layer, int c, const GAS bf16* hyt  , const GAS bf16* ft  , GAS bf16* yht  ) {
    constexpr int ZP = (L + 8) * 2;
    constexpr int PER = L / 32;
    constexpr int SUB = 8;
    LAS unsigned char* zimg0 = F.lds;
    LAS unsigned char* zimg1 = F.lds + 16 * ZP;
    LAS bf16* tf = (LAS bf16*)(F.lds + 32 * ZP);
    const GAS float* cw = inp(F, I_HYCONV) + layer * 3 * 1152;
    const GAS float* skip = inp(F, I_HYSKIP) + layer * 2 * 384;
    __syncthreads();
    {
        const int b = F.tid >> 5, seg = F.tid & 31; const GAS bf16* src = hyt + ((size_t)(b * 1152 + c)) * L;
        const float w0 = cw[c], w1 = cw[1152 + c], w2 = cw[2304 + c];
#pragma unroll 2
        for (int j = 0; j < PER; ++j) { const int t = seg * PER + j; *(LAS bf16*)(zimg0 + b * ZP + t * 2) = (bf16)f2bf(conv3_at<L>(src, t, w0, w1, w2)); }
    }
#pragma unroll 1
    for (int o = 0; o < 2; ++o) {
        LAS unsigned char* zs = o == 0 ? zimg0 : zimg1;
        LAS unsigned char* zd = o == 0 ? zimg1 : zimg0;
        const GAS bf16* fsrc = ft + ((size_t)(o * 384 + c)) * (2 * L);
        for (int i = F.tid; i < 2 * L; i += NTHR) tf[i] = i == 0 ? (bf16)0 : fsrc[i];
        __syncthreads();
        const int b = F.tid & 15, tg = F.tid >> 4;
        const int gcol = (o == 0 ? 384 : 768) + c;
        const GAS bf16* gsrc = hyt + ((size_t)(b * 1152 + gcol)) * L;
        const float w0 = cw[gcol], w1 = cw[1152 + gcol], w2 = cw[2304 + gcol], sk = skip[o * 384 + c];
#pragma unroll 1
        for (int sb = 0; sb < PER / SUB; ++sb) {
            const int t0 = tg * PER + sb * SUB;
            float acc[SUB];
#pragma unroll
            for (int j = 0; j < SUB; ++j) acc[j] = 0.f;
#pragma unroll 1
            for (int s0 = 0; s0 < L; s0 += 8) {
                float z[8];
                { const bf16x8 zz = *(const LAS bf16x8*)(zs + b * ZP + s0 * 2);
#pragma unroll
                  for (int i = 0; i < 8; ++i) z[i] = bf2f((bf16)zz[i]); }
                float win[SUB + 7];
                const int wb = L + s0 - t0 - (SUB - 1);
#pragma unroll
                for (int i = 0; i < SUB + 7; ++i) win[i] = bf2f(tf[wb + i]);
#pragma unroll
                for (int j = 0; j < SUB; ++j)
#pragma unroll
                    for (int i = 0; i < 8; ++i) acc[j] += win[(SUB - 1) - j + i] * z[i];
            }
#pragma unroll
            for (int j = 0; j < SUB; ++j) {
                const int t = t0 + j;
                const float zt = bf2f(*(LAS bf16*)(zs + b * ZP + t * 2));
                const float ov = conv3_at<L>(gsrc, t, w0, w1, w2) * (acc[j] + sk * zt);
                *(LAS bf16*)(zd + b * ZP + t * 2) = (bf16)f2bf(ov);
            }
        }
        __syncthreads();
    }
#pragma unroll 2
    for (int i = F.tid; i < 16 * (L / 8); i += NTHR) {
        const int b = i / (L / 8), ch = i % (L / 8);
        *(GAS u32x4*)(yht + ((size_t)(b * 384 + c)) * L + ch * 8) = *(const LAS u32x4*)(zimg0 + b * ZP + ch * 16);
    }
}

template <int L>
__device__ __forceinline__ void hyena_unit_fast(Frame& F, int layer, int c, const GAS bf16* hyt  , const GAS bf16* ft  , GAS bf16* yht  ) {
    constexpr int ZP = (L + 8) * 2;
    constexpr int PER = L / 32;
    constexpr int I = L / 128;
    constexpr int SPAN = L / 4, NSTEP = L / 32;
    constexpr int CP = (2 * L + 8) * 2;
    LAS unsigned char* zimg = F.lds;
    LAS unsigned char* cpy = F.lds + 16 * ZP;
    const GAS float* cw = inp(F, I_HYCONV) + layer * 3 * 1152;
    const GAS float* skip = inp(F, I_HYSKIP) + layer * 2 * 384;
    const int lane = F.lane, fr = lane & 15, fq = lane >> 4, w = F.wave;
    { unsigned long long a_ = (unsigned long long)hyt, b_ = (unsigned long long)yht; asm volatile("" : "+s"(a_), "+s"(b_)); hyt = (const GAS bf16*)a_; yht = (GAS bf16*)b_; }
    __syncthreads();
    {
        const int b = F.tid >> 5, sg = F.tid & 31, t0 = sg * PER; const GAS bf16* src = hyt + ((size_t)(b * 1152 + c)) * L + t0;
        const float w0 = cw[c], w1 = cw[1152 + c], w2 = cw[2304 + c];
        u32x4 raw[PER / 8];
#pragma unroll
        for (int j = 0; j < PER / 8; ++j) raw[j] = *(const GAS u32x4*)(src + 8 * j);
        float prev = t0 > 0 ? bf2f(src[-1]) : 0.f;
        const float nextv = t0 + PER < L ? bf2f(src[PER]) : 0.f;
#pragma unroll
        for (int j = 0; j < PER / 8; ++j) {
            const unsigned wv[4] = {raw[j].x, raw[j].y, raw[j].z, raw[j].w};
            float x[10]; x[0] = prev;
#pragma unroll
            for (int q = 0; q < 4; ++q) { x[1 + 2 * q] = __uint_as_float(wv[q] << 16); x[2 + 2 * q] = __uint_as_float(wv[q] & 0xffff0000u); }
            if (j + 1 < PER / 8) x[9] = __uint_as_float(raw[(j + 1 < PER / 8) ? j + 1 : j].x << 16); else x[9] = nextv;
            u32x4 o;
            o.x = pk2(w0 * x[0] + w1 * x[1] + w2 * x[2], w0 * x[1] + w1 * x[2] + w2 * x[3]); o.y = pk2(w0 * x[2] + w1 * x[3] + w2 * x[4], w0 * x[3] + w1 * x[4] + w2 * x[5]);
            o.z = pk2(w0 * x[4] + w1 * x[5] + w2 * x[6], w0 * x[5] + w1 * x[6] + w2 * x[7]); o.w = pk2(w0 * x[6] + w1 * x[7] + w2 * x[8], w0 * x[7] + w1 * x[8] + w2 * x[9]);
            *(LAS u32x4*)(zimg + b * ZP + (t0 + 8 * j) * 2) = o;
            prev = x[8];
        }
    }
    const int tbase = SPAN * (w >> 1) + 16 * (w & 1);
    const int flane = L - tbase + 8 * fq - fr;
    const int msh = fr & 7;
    const LAS unsigned char* fbase = cpy + msh * CP + 2 * (flane + msh);
#pragma unroll 1
    for (int o = 0; o < 2; ++o) {
        const GAS bf16* fsrc = ft + ((size_t)(o * 384 + c)) * (2 * L);
        for (int i = F.tid; i < CP / 16; i += NTHR) { u32x4 v = (u32x4){0u, 0u, 0u, 0u}; if (i < 2 * L / 8) v = *(const GAS u32x4*)(fsrc + 8 * i); if (i == 0) v.x &= 0xffff0000u; *(LAS u32x4*)(cpy + 16 * i) = v; }
        __syncthreads();
        for (int task = F.tid; task < 7 * (CP / 16); task += NTHR) {
            const int m = 1 + task / (CP / 16), x8 = task % (CP / 16);
            unsigned short e[8];
#pragma unroll
            for (int i = 0; i < 8; ++i) { const int idx = 8 * x8 - m + i; e[i] = idx >= 0 ? *(const LAS unsigned short*)(cpy + 2 * idx) : (unsigned short)0; }
            u32x4 v; v.x = e[0] | ((unsigned)e[1] << 16); v.y = e[2] | ((unsigned)e[3] << 16); v.z = e[4] | ((unsigned)e[5] << 16); v.w = e[6] | ((unsigned)e[7] << 16);
            *(LAS u32x4*)(cpy + m * CP + 16 * x8) = v;
        }
        __syncthreads();
        f32x4 acc[I];
#pragma unroll
        for (int i = 0; i < I; ++i) acc[i] = (f32x4){0.f, 0.f, 0.f, 0.f};
        bf16x8 ring[I];
#pragma unroll
        for (int i = 1; i < I; ++i) ring[(I - i) % I] = *(const LAS bf16x8*)(fbase - 64 * i);
        bf16x8 nf = *(const LAS bf16x8*)(fbase);
        const LAS unsigned char* zrow = zimg + fr * ZP + 16 * fq;
#pragma unroll 1
        for (int j0 = 0; j0 < NSTEP; j0 += I) {
#pragma unroll
            for (int jj = 0; jj < I; ++jj) {
                const int j = j0 + jj;
                ring[jj] = nf;
                if (j + 1 < NSTEP) nf = *(const LAS bf16x8*)(fbase + 64 * (j + 1));
                const bf16x8 zf = *(const LAS bf16x8*)(zrow + 64 * j);
#pragma unroll
                for (int i = 0; i < I; ++i) acc[i] = __builtin_amdgcn_mfma_f32_16x16x32_bf16(ring[(jj - i + I) % I], zf, acc[i], 0, 0, 0);
            }
        }
        const int gcol = (o == 0 ? 384 : 768) + c;
        const GAS bf16* gsrc = hyt + ((size_t)(fr * 1152 + gcol)) * L;
        const float w0 = cw[gcol], w1 = cw[1152 + gcol], w2 = cw[2304 + gcol], sk = skip[o * 384 + c];
        GAS bf16* dst = yht + ((size_t)(fr * 384 + c)) * L;
        constexpr int GI = I < 8 ? I : 8;
#pragma unroll
        for (int i0 = 0; i0 < I; i0 += GI) {
            u32x2 grv[GI]; unsigned short gmv[GI], gpv[GI];
#pragma unroll
            for (int ii = 0; ii < GI; ++ii) {
                const int t = tbase + 32 * (i0 + ii) + 4 * fq;
                grv[ii] = *(const GAS u32x2*)(gsrc + t); gmv[ii] = t > 0 ? gsrc[t - 1] : (unsigned short)0; gpv[ii] = t + 4 < L ? gsrc[t + 4] : (unsigned short)0;
            }
            asm volatile("" ::: "memory");
#pragma unroll
            for (int ii = 0; ii < GI; ++ii) {
                const int i = i0 + ii;
                const int t = tbase + 32 * i + 4 * fq;
                const u32x2 zr = *(const LAS u32x2*)(zimg + fr * ZP + t * 2);
                const u32x2 gr = grv[ii];
                const float gm = bf2f(gmv[ii]), gp = bf2f(gpv[ii]);
                const float g0 = __uint_as_float(gr.x << 16), g1 = __uint_as_float(gr.x & 0xffff0000u), g2 = __uint_as_float(gr.y << 16), g3 = __uint_as_float(gr.y & 0xffff0000u);
                const float z0 = __uint_as_float(zr.x << 16), z1 = __uint_as_float(zr.x & 0xffff0000u), z2 = __uint_as_float(zr.y << 16), z3 = __uint_as_float(zr.y & 0xffff0000u);
                const float o0 = (w0 * gm + w1 * g0 + w2 * g1) * (acc[i].x + sk * z0), o1 = (w0 * g0 + w1 * g1 + w2 * g2) * (acc[i].y + sk * z1);
                const float o2 = (w0 * g1 + w1 * g2 + w2 * g3) * (acc[i].z + sk * z2), o3 = (w0 * g2 + w1 * g3 + w2 * gp) * (acc[i].w + sk * z3);
                acc[i] = (f32x4){o0, o1, o2, o3};
            }
        }
        __syncthreads();
#pragma unroll
        for (int i = 0; i < I; ++i) {
            const int t = tbase + 32 * i + 4 * fq;
            u32x2 ov; ov.x = pk2(acc[i].x, acc[i].y); ov.y = pk2(acc[i].z, acc[i].w);
            if (o == 0) *(LAS u32x2*)(zimg + fr * ZP + t * 2) = ov;
            else *(GAS u32x2*)(dst + t) = ov;
        }
    }
}

__device__ __forceinline__ void chain_naive(Frame& F, int layer, int chain) {
    const int lane = F.lane;
    const bool is_ret = chain < 192;
    int b, h, dir;
    if (is_ret) { b = chain / 12; const int r = chain % 12; h = r >> 1; dir = r & 1; }
    else { const int i = chain - 192; b = i >> 3; h = (i & 7) >> 1; dir = i & 1; }
    const GAS bf16* RET = WSP(const bf16, WS_RET); const GAS bf16* ML = WSP(const bf16, WS_ML); const GAS float* MLG = WSP(const float, WS_MLG);
    const GAS float* rope = WSP(const float, WS_ROPE);
    GAS bf16* Y = WSP(bf16, WS_Y); GAS bf16* OB = WSP(bf16, WS_OB);
    float gam = 0.f;
    if (is_ret) gam = sigmoidf_(inp(F, I_RETDECAY)[layer * 12 + dir * 6 + h]);
    const GAS float* mlc = inp(F, I_MLCONV) + layer * 3 * 512;
    const float bi = is_ret ? 0.f : inp(F, I_MLGB)[layer * 16 + dir * 8 + h], bfg = is_ret ? 0.f : inp(F, I_MLGB)[layer * 16 + dir * 8 + 4 + h];
    const float qw0 = mlc[h * 64 + lane], qw1 = mlc[512 + h * 64 + lane], qw2 = mlc[1024 + h * 64 + lane];
    const float kw0 = mlc[256 + h * 64 + lane], kw1 = mlc[512 + 256 + h * 64 + lane], kw2 = mlc[1024 + 256 + h * 64 + lane];
    float S[64];
#pragma unroll
    for (int d = 0; d < 64; ++d) S[d] = 0.f;
    float nv = 0.f;
    for (int step = 0; step < LC + LL; ++step) {
        int row, tpos, L; bool lat;
        if (step < LC) { tpos = dir ? (LC - 1 - step) : step; row = TOKL + b * LC + tpos; L = LC; lat = false; }
        else { const int s2 = step - LC; tpos = dir ? (LL - 1 - s2) : s2; row = b * LL + tpos; L = LL; lat = true; }
        float q, k, v, Fm, Im;
        if (is_ret) {
            const GAS bf16* base = RET + (size_t)row * 1536;
            float qs = bf2f(base[h * 64 + lane]), ks = bf2f(base[384 + h * 64 + lane]);
            v = bf2f(base[768 + h * 64 + lane]);
            if (lat) {
                const float qp = bf2f(base[h * 64 + (lane ^ 16)]), kp = bf2f(base[384 + h * 64 + (lane ^ 16)]);
                const int half = lane >> 5, ii = lane & 15, hi = (lane >> 4) & 1;
                const float cs = rope[tpos * 64 + half * 32 + ii], sn = rope[tpos * 64 + half * 32 + 16 + ii];
                q = hi == 0 ? qs * cs - qp * sn : qp * sn + qs * cs;
                k = hi == 0 ? ks * cs - kp * sn : kp * sn + ks * cs;
            } else { q = qs; k = ks; }
            q *= 0.125f; Fm = gam; Im = 1.f;
        } else {
            const GAS bf16* base = ML + (size_t)row * 1024;
            const float q0 = tpos > 0 ? bf2f(base[-1024 + h * 64 + lane]) : 0.f, q1 = bf2f(base[h * 64 + lane]), q2 = tpos < L - 1 ? bf2f(base[1024 + h * 64 + lane]) : 0.f;
            const float k0 = tpos > 0 ? bf2f(base[-1024 + 256 + h * 64 + lane]) : 0.f, k1 = bf2f(base[256 + h * 64 + lane]), k2 = tpos < L - 1 ? bf2f(base[1024 + 256 + h * 64 + lane]) : 0.f;
            q = siluf_(qw0 * q0 + qw1 * q1 + qw2 * q2);
            k = siluf_(kw0 * k0 + kw1 * k1 + kw2 * k2) * 0.125f;
            v = bf2f(base[512 + h * 64 + lane]);
            const float ig = MLG[(size_t)row * 16 + dir * 8 + h] + bi, fg = MLG[(size_t)row * 16 + dir * 8 + 4 + h] + bfg;
            Fm = sigmoidf_(fg); Im = __expf(ig);
        }
        float num = 0.f;
        const float iv = Im * v;
#pragma unroll
        for (int d = 0; d < 64; ++d) {
            const float kd = __int_as_float(__builtin_amdgcn_readlane(__float_as_int(k), d));
            const float qd = __int_as_float(__builtin_amdgcn_readlane(__float_as_int(q), d));
            S[d] = Fm * S[d] + kd * iv;
            num += qd * S[d];
        }
        float o = num;
        if (!is_ret) { nv = Fm * nv + Im * k; const float den = wave_sum(q * nv); o = num / fmaxf(fabsf(den), 1.f); }
        const int cof = is_ret ? (h * 64 + lane) : (384 + h * 64 + lane);
        if (dir == 0) Y[(size_t)row * D + 384 + cof] = (bf16)f2bf(o);
        else OB[(size_t)row * 640 + cof] = (bf16)f2bf(o);
    }
}

#ifndef REP_CH
#define REP_CH 1
#endif
constexpr int CH_PITCH = 144;
constexpr int CH_IMG = 64 * CH_PITCH;
constexpr int CH_WAVE_LDS = 3 * CH_IMG + 1024 + 512;
__device__ __forceinline__ void ds_tr16x8(unsigned addr, u32x2 (&lo)[4], u32x2 (&hi)[4]) {
    asm volatile("ds_read_b64_tr_b16 %0, %8\n\tds_read_b64_tr_b16 %1, %8 offset:32\n\tds_read_b64_tr_b16 %2, %8 offset:64\n\tds_read_b64_tr_b16 %3, %8 offset:96\n\t"
                 "ds_read_b64_tr_b16 %4, %8 offset:2304\n\tds_read_b64_tr_b16 %5, %8 offset:2336\n\tds_read_b64_tr_b16 %6, %8 offset:2368\n\tds_read_b64_tr_b16 %7, %8 offset:2400\n\t"
                 "s_waitcnt lgkmcnt(0)"
                 : "=&v"(lo[0]), "=&v"(lo[1]), "=&v"(lo[2]), "=&v"(lo[3]), "=&v"(hi[0]), "=&v"(hi[1]), "=&v"(hi[2]), "=&v"(hi[3]) : "v"(addr) : "memory");
}
static_assert(16 * CH_PITCH == 2304, "ds_tr16x8 offsets");
__device__ __forceinline__ void ds_tr16x4(unsigned addr, u32x2 (&lo)[2], u32x2 (&hi)[2]) {
    asm volatile("ds_read_b64_tr_b16 %0, %4\n\tds_read_b64_tr_b16 %1, %4 offset:32\n\tds_read_b64_tr_b16 %2, %4 offset:2304\n\tds_read_b64_tr_b16 %3, %4 offset:2336\n\ts_waitcnt lgkmcnt(0)"
                 : "=&v"(lo[0]), "=&v"(lo[1]), "=&v"(hi[0]), "=&v"(hi[1]) : "v"(addr) : "memory");
}
__device__ __forceinline__ float log_sigmoid_(float x) { return fminf(x, 0.f) - log1pf(__expf(-fabsf(x))); }
__device__ __forceinline__ bf16x8 mk_frag(u32x2 lo, u32x2 hi) { u32x4 w; w.x = lo.x; w.y = lo.y; w.z = hi.x; w.w = hi.y; return __builtin_bit_cast(bf16x8, w); }

template <bool IS_ML>
__device__ __forceinline__ void chain_fast(Frame& F, int layer, int b, int h, int dir, LAS unsigned char* img, int hf) {
    constexpr int NET = 2;
    const int lane = F.lane, fr = lane & 15, fq = lane >> 4;
    LAS unsigned char* Qi = img; LAS unsigned char* Ki = img + CH_IMG; LAS unsigned char* Vi = img + 2 * CH_IMG;
    const unsigned qa = (unsigned)(size_t)Qi, ka = (unsigned)(size_t)Ki, va = (unsigned)(size_t)Vi;
    const GAS bf16* RET = WSP(const bf16, WS_RET); const GAS bf16* ML = WSP(const bf16, WS_ML); const GAS float* MLG = WSP(const float, WS_MLG);
    const GAS float* rope = WSP(const float, WS_ROPE);
    GAS bf16* Y = WSP(bf16, WS_Y); GAS bf16* OB = WSP(bf16, WS_OB);
    float lgam = 0.f, bi_ = 0.f, bf_ = 0.f;
    if (!IS_ML) lgam = log_sigmoid_(inp(F, I_RETDECAY)[layer * 12 + dir * 6 + h]);
    else { bi_ = inp(F, I_MLGB)[layer * 16 + dir * 8 + h]; bf_ = inp(F, I_MLGB)[layer * 16 + dir * 8 + 4 + h]; }
    const GAS float* mlc = inp(F, I_MLCONV) + layer * 3 * 512;
    f32x4 C[4][NET];
#pragma unroll
    for (int dt = 0; dt < 4; ++dt)
#pragma unroll
        for (int et = 0; et < NET; ++et) C[dt][et] = (f32x4){0.f, 0.f, 0.f, 0.f};
    const int cq = lane & 7, pr0 = lane >> 3;
    LAS float* nvec = (LAS float*)(img + 3 * CH_IMG + 1024 + 256 * hf);
    if (IS_ML) nvec[lane] = 0.f;
    const LAS float* nq = nvec + 4 * fq;
#pragma unroll 1
    for (int step_ = 0; step_ < 36 * REP_CH; ++step_) {
        const int step = step_ % 36;
        if (REP_CH > 1 && step == 0) {
            if (IS_ML) nvec[lane] = 0.f;
#pragma unroll
            for (int dt = 0; dt < 4; ++dt)
#pragma unroll
                for (int et = 0; et < NET; ++et) C[dt][et] = (f32x4){0.f, 0.f, 0.f, 0.f};
        }
        int rowbase, t0, L; bool lat;
        if (step < 4) { const int cc = dir ? 3 - step : step; rowbase = TOKL + b * LC + cc * 64; t0 = cc * 64; L = LC; lat = false; }
        else { const int cc = dir ? 35 - step : step - 4; rowbase = b * LL + cc * 64; t0 = cc * 64; L = LL; lat = true; }
        float g_i = 0.f, g_f = 0.f;
        if (IS_ML) { const int tlg = dir ? 63 - lane : lane; const GAS float* gp = MLG + (size_t)(rowbase + tlg) * 16 + dir * 8 + h; g_i = gp[0]; g_f = gp[4]; }
        if constexpr (!IS_ML) {
#pragma unroll
        for (int i4 = 0; i4 < 4; ++i4) {
            const int i = 4 * hf + i4;
            const int p = pr0 + 8 * i, tl = dir ? 63 - p : p, row = rowbase + tl, tpos = t0 + tl;
            float qv[8], kv[8]; u32x4 vraw;
            {
                const GAS bf16* base = RET + (size_t)row * 1536 + h * 64;
                const u32x4 qr = *(const GAS u32x4*)(base + 8 * cq), kr = *(const GAS u32x4*)(base + 384 + 8 * cq); vraw = *(const GAS u32x4*)(base + 768 + 8 * cq);
                const unsigned qw[4] = {qr.x, qr.y, qr.z, qr.w}, kw[4] = {kr.x, kr.y, kr.z, kr.w};
#pragma unroll
                for (int j = 0; j < 4; ++j) { qv[2 * j] = __uint_as_float(qw[j] << 16); qv[2 * j + 1] = __uint_as_float(qw[j] & 0xffff0000u); kv[2 * j] = __uint_as_float(kw[j] << 16); kv[2 * j + 1] = __uint_as_float(kw[j] & 0xffff0000u); }
                if (lat) {
                    const u32x4 qpr = *(const GAS u32x4*)(base + 8 * (cq ^ 2)), kpr = *(const GAS u32x4*)(base + 384 + 8 * (cq ^ 2));
                    const unsigned qpw[4] = {qpr.x, qpr.y, qpr.z, qpr.w}, kpw[4] = {kpr.x, kpr.y, kpr.z, kpr.w};
                    const int half = cq >> 2, hi = (cq >> 1) & 1, i0 = 8 * (cq & 1);
                    const GAS float* rp = rope + tpos * 64 + half * 32 + i0;
                    const f32x4 c0 = *(const GAS f32x4*)(rp), c1 = *(const GAS f32x4*)(rp + 4), s0 = *(const GAS f32x4*)(rp + 16), s1 = *(const GAS f32x4*)(rp + 20);
                    const float cs[8] = {c0.x, c0.y, c0.z, c0.w, c1.x, c1.y, c1.z, c1.w}, sn[8] = {s0.x, s0.y, s0.z, s0.w, s1.x, s1.y, s1.z, s1.w};
#pragma unroll
                    for (int j = 0; j < 8; ++j) {
                        const float qp = (j & 1) ? __uint_as_float(qpw[j >> 1] & 0xffff0000u) : __uint_as_float(qpw[j >> 1] << 16);
                        const float kp = (j & 1) ? __uint_as_float(kpw[j >> 1] & 0xffff0000u) : __uint_as_float(kpw[j >> 1] << 16);
                        qv[j] = hi ? qp * sn[j] + qv[j] * cs[j] : qv[j] * cs[j] - qp * sn[j];
                        kv[j] = hi ? kp * sn[j] + kv[j] * cs[j] : kv[j] * cs[j] - kp * sn[j];
                    }
                }
#pragma unroll
                for (int j = 0; j < 8; ++j) qv[j] *= 0.125f;
            }
            u32x4 qo, ko; qo.x = pk2(qv[0], qv[1]); qo.y = pk2(qv[2], qv[3]); qo.z = pk2(qv[4], qv[5]); qo.w = pk2(qv[6], qv[7]);
            ko.x = pk2(kv[0], kv[1]); ko.y = pk2(kv[2], kv[3]); ko.z = pk2(kv[4], kv[5]); ko.w = pk2(kv[6], kv[7]);
            *(LAS u32x4*)(Qi + p * CH_PITCH + 16 * cq) = qo; *(LAS u32x4*)(Ki + p * CH_PITCH + 16 * cq) = ko; *(LAS u32x4*)(Vi + p * CH_PITCH + 16 * cq) = vraw;
        }
        } else {
            const GAS float* wq = mlc + h * 64 + 8 * cq;
#pragma unroll
            for (int qk = 0; qk < 2; ++qk) {
                u32x4 r0[4], r1[4], r2[4], vr[4];
                f32x4 wt[3][2];
#pragma unroll
                for (int tp = 0; tp < 3; ++tp) { wt[tp][0] = *(const GAS f32x4*)(wq + 256 * qk + 512 * tp); wt[tp][1] = *(const GAS f32x4*)(wq + 256 * qk + 512 * tp + 4); }
#pragma unroll
                for (int i4 = 0; i4 < 4; ++i4) {
                    const int p = pr0 + 8 * (4 * hf + i4), tl = dir ? 63 - p : p, row = rowbase + tl, tpos = t0 + tl;
                    const GAS bf16* bb = ML + (size_t)row * 1024 + h * 64 + 8 * cq + 256 * qk;
                    const u32x4 z4 = (u32x4){0u, 0u, 0u, 0u};
                    r1[i4] = *(const GAS u32x4*)(bb); r0[i4] = tpos > 0 ? *(const GAS u32x4*)(bb - 1024) : z4; r2[i4] = tpos < L - 1 ? *(const GAS u32x4*)(bb + 1024) : z4;
                    if (qk == 1) vr[i4] = *(const GAS u32x4*)(bb + 256);
                }
#pragma unroll
                for (int i4 = 0; i4 < 4; ++i4) {
                    const int p = pr0 + 8 * (4 * hf + i4);
                    const unsigned a0[4] = {r0[i4].x, r0[i4].y, r0[i4].z, r0[i4].w}, a1[4] = {r1[i4].x, r1[i4].y, r1[i4].z, r1[i4].w}, a2[4] = {r2[i4].x, r2[i4].y, r2[i4].z, r2[i4].w};
                    float ov[8];
#pragma unroll
                    for (int j = 0; j < 8; ++j) {
                        const float x0 = (j & 1) ? __uint_as_float(a0[j >> 1] & 0xffff0000u) : __uint_as_float(a0[j >> 1] << 16);
                        const float x1 = (j & 1) ? __uint_as_float(a1[j >> 1] & 0xffff0000u) : __uint_as_float(a1[j >> 1] << 16);
                        const float x2 = (j & 1) ? __uint_as_float(a2[j >> 1] & 0xffff0000u) : __uint_as_float(a2[j >> 1] << 16);
                        const float r = siluf_(wt[0][j >> 2][j & 3] * x0 + wt[1][j >> 2][j & 3] * x1 + wt[2][j >> 2][j & 3] * x2);
                        ov[j] = qk == 0 ? r : r * 0.125f;
                    }
                    u32x4 o; o.x = pk2(ov[0], ov[1]); o.y = pk2(ov[2], ov[3]); o.z = pk2(ov[4], ov[5]); o.w = pk2(ov[6], ov[7]);
                    if (qk == 0) *(LAS u32x4*)(Qi + p * CH_PITCH + 16 * cq) = o;
                    else { *(LAS u32x4*)(Ki + p * CH_PITCH + 16 * cq) = o; *(LAS u32x4*)(Vi + p * CH_PITCH + 16 * cq) = vr[i4]; }
                }
                asm volatile("" ::: "memory");
            }
        }
        __builtin_amdgcn_sched_barrier(0);
        float f_p, i_p;
        if (!IS_ML) { f_p = lgam; i_p = 0.f; }
        else { i_p = g_i + bi_; f_p = log_sigmoid_(g_f + bf_); }
        float bsum = f_p;
#pragma unroll
        for (int o = 1; o < 64; o <<= 1) { const float t = lane_read(bsum, lane >= o ? lane - o : lane); if (lane >= o) bsum += t; }
        LAS float* gv = (LAS float*)(img + 3 * CH_IMG);
        const float b63 = __int_as_float(__builtin_amdgcn_readlane(__float_as_int(bsum), 63));
        const float adec = __expf(b63);
        if (hf == 0) { gv[lane] = bsum; gv[64 + lane] = bsum - i_p; gv[128 + lane] = __expf(bsum); gv[192 + lane] = __expf(b63 - (bsum - i_p)); }
        asm volatile("s_waitcnt lgkmcnt(0)" ::: "memory");
        __syncthreads();
        const LAS float* gq = gv + 4 * fq;
        const bf16x8 ones = (fr == 0) ? (bf16x8){0x3F80, 0x3F80, 0x3F80, 0x3F80, 0x3F80, 0x3F80, 0x3F80, 0x3F80} : (bf16x8){0, 0, 0, 0, 0, 0, 0, 0};
        const int tr_q = fr >> 2, tr_p = fr & 3;
#pragma unroll 1
        for (int pt = 0; pt < 4; ++pt) {
            f32x4 ST[4];
            bf16x8 qn[2];
#pragma unroll
            for (int kk = 0; kk < 2; ++kk) qn[kk] = *(const LAS bf16x8*)(Qi + (16 * pt + fr) * CH_PITCH + (32 * kk + 8 * fq) * 2);
#pragma unroll
            for (int st = 0; st < 4; ++st) {
                ST[st] = (f32x4){0.f, 0.f, 0.f, 0.f};
                if (st <= pt) {
#pragma unroll
                    for (int kk = 0; kk < 2; ++kk) { const bf16x8 kf = *(const LAS bf16x8*)(Ki + (16 * st + fr) * CH_PITCH + (32 * kk + 8 * fq) * 2); ST[st] = __builtin_amdgcn_mfma_f32_16x16x32_bf16(kf, qn[kk], ST[st], 0, 0, 0); }
                }
            }
            const float bp = gv[16 * pt + fr];
#pragma unroll
            for (int st = 0; st < 4; ++st) {
                if (st <= pt) {
                    const f32x4 bis = *(const LAS f32x4*)(gq + 64 + 16 * st);
#pragma unroll
                    for (int j = 0; j < 4; ++j) { const int sidx = 16 * st + 4 * fq + j; const float w = (sidx <= 16 * pt + fr) ? __expf(bp - bis[j]) : 0.f; ST[st][j] *= w; }
                }
            }
            __builtin_amdgcn_sched_barrier(0);
            f32x4 acc[NET], accd = (f32x4){0.f, 0.f, 0.f, 0.f};
#pragma unroll
            for (int et = 0; et < NET; ++et) acc[et] = (f32x4){0.f, 0.f, 0.f, 0.f};
#pragma unroll
            for (int kk = 0; kk < 2; ++kk) {
                const u32x2 lo = *(const LAS u32x2*)(Qi + (16 * pt + fr) * CH_PITCH + (32 * kk + 4 * fq) * 2), hi = *(const LAS u32x2*)(Qi + (16 * pt + fr) * CH_PITCH + (32 * kk + 16 + 4 * fq) * 2);
                const bf16x8 qs = mk_frag(lo, hi);
#pragma unroll
                for (int et = 0; et < NET; ++et) {
                    u32x4 w; w.x = pk2(C[2 * kk][et].x, C[2 * kk][et].y); w.y = pk2(C[2 * kk][et].z, C[2 * kk][et].w); w.z = pk2(C[2 * kk + 1][et].x, C[2 * kk + 1][et].y); w.w = pk2(C[2 * kk + 1][et].z, C[2 * kk + 1][et].w);
                    acc[et] = __builtin_amdgcn_mfma_f32_16x16x32_bf16(qs, __builtin_bit_cast(bf16x8, w), acc[et], 0, 0, 0);
                }
                if (IS_ML) {
                    const f32x4 n0 = *(const LAS f32x4*)(nq + 32 * kk), n1 = *(const LAS f32x4*)(nq + 32 * kk + 16);
                    u32x4 w; w.x = pk2(n0.x, n0.y); w.y = pk2(n0.z, n0.w); w.z = pk2(n1.x, n1.y); w.w = pk2(n1.z, n1.w);
                    if (fr != 0) w = (u32x4){0u, 0u, 0u, 0u};
                    accd = __builtin_amdgcn_mfma_f32_16x16x32_bf16(qs, __builtin_bit_cast(bf16x8, w), accd, 0, 0, 0);
                }
            }
            { const f32x4 ap = *(const LAS f32x4*)(gq + 128 + 16 * pt);
#pragma unroll
              for (int j = 0; j < 4; ++j) {
#pragma unroll
                for (int et = 0; et < NET; ++et) acc[et][j] *= ap[j];
                accd[j] *= ap[j]; } }
            __builtin_amdgcn_sched_barrier(0);
#pragma unroll
            for (int kk = 0; kk < 2; ++kk) {
                if (2 * kk <= pt) {
                    u32x4 w; w.x = pk2(ST[2 * kk].x, ST[2 * kk].y); w.y = pk2(ST[2 * kk].z, ST[2 * kk].w); w.z = pk2(ST[2 * kk + 1].x, ST[2 * kk + 1].y); w.w = pk2(ST[2 * kk + 1].z, ST[2 * kk + 1].w);
                    const bf16x8 pf = __builtin_bit_cast(bf16x8, w);
                    u32x2 vlo[2], vhi[2];
                    ds_tr16x4(va + (32 * kk + 4 * fq + tr_q) * CH_PITCH + 8 * tr_p + 64 * hf, vlo, vhi);
#pragma unroll
                    for (int et = 0; et < NET; ++et) acc[et] = __builtin_amdgcn_mfma_f32_16x16x32_bf16(pf, mk_frag(vlo[et], vhi[et]), acc[et], 0, 0, 0);
                    if (IS_ML) accd = __builtin_amdgcn_mfma_f32_16x16x32_bf16(pf, ones, accd, 0, 0, 0);
                }
            }
            __builtin_amdgcn_sched_barrier(0);
#pragma unroll
            for (int j = 0; j < 4; ++j) {
                const int p = 16 * pt + 4 * fq + j, tl = dir ? 63 - p : p, row = rowbase + tl;
                float inv = 1.f;
                if (IS_ML) { const float den = lane_read(accd[j], lane & 48); inv = __builtin_amdgcn_rcpf(fmaxf(fabsf(den), 1.f)); }
                const int cof = (IS_ML ? 384 : 0) + h * 64 + 32 * hf + fr;
                const unsigned boff = dir == 0 ? (unsigned)(row * D + 384 + cof) * 2u : (unsigned)(row * 640 + cof) * 2u;
                GAS char* ob = dir == 0 ? (GAS char*)Y : (GAS char*)OB;
#pragma unroll
                for (int et = 0; et < NET; ++et) *(GAS bf16*)(ob + boff + 32 * et) = (bf16)f2bf(acc[et][j] * inv);
            }
        }
        __builtin_amdgcn_sched_barrier(0);
#pragma unroll
        for (int dt = 0; dt < 4; ++dt)
#pragma unroll
            for (int et = 0; et < NET; ++et) C[dt][et] *= adec;
        f32x4 accn[4];
        if (IS_ML) {
#pragma unroll
            for (int dt = 0; dt < 4; ++dt) { accn[dt] = *(const LAS f32x4*)(nq + 16 * dt) * adec; if (fr != 0) accn[dt] = (f32x4){0.f, 0.f, 0.f, 0.f}; }
        }
#pragma unroll
        for (int kk = 0; kk < 2; ++kk) {
            u32x2 vlo[2], vhi[2], klo[4], khi[4];
            ds_tr16x4(va + (32 * kk + 4 * fq + tr_q) * CH_PITCH + 8 * tr_p + 64 * hf, vlo, vhi);
            ds_tr16x8(ka + (32 * kk + 4 * fq + tr_q) * CH_PITCH + 8 * tr_p, klo, khi);
            const f32x4 wl = *(const LAS f32x4*)(gq + 192 + 32 * kk), wh = *(const LAS f32x4*)(gq + 192 + 32 * kk + 16);
#pragma unroll
            for (int dt = 0; dt < 4; ++dt) {
                u32x4 w;
                w.x = pk2(__uint_as_float(klo[dt].x << 16) * wl[0], __uint_as_float(klo[dt].x & 0xffff0000u) * wl[1]);
                w.y = pk2(__uint_as_float(klo[dt].y << 16) * wl[2], __uint_as_float(klo[dt].y & 0xffff0000u) * wl[3]);
                w.z = pk2(__uint_as_float(khi[dt].x << 16) * wh[0], __uint_as_float(khi[dt].x & 0xffff0000u) * wh[1]);
                w.w = pk2(__uint_as_float(khi[dt].y << 16) * wh[2], __uint_as_float(khi[dt].y & 0xffff0000u) * wh[3]);
                const bf16x8 kf = __builtin_bit_cast(bf16x8, w);
#pragma unroll
                for (int et = 0; et < NET; ++et) C[dt][et] = __builtin_amdgcn_mfma_f32_16x16x32_bf16(kf, mk_frag(vlo[et], vhi[et]), C[dt][et], 0, 0, 0);
                if (IS_ML) accn[dt] = __builtin_amdgcn_mfma_f32_16x16x32_bf16(kf, ones, accn[dt], 0, 0, 0);
            }
        }
        if (IS_ML) { if (fr == 0) {
#pragma unroll
            for (int dt = 0; dt < 4; ++dt) *(LAS f32x4*)(nvec + 4 * fq + 16 * dt) = accn[dt]; } }
        asm volatile("s_waitcnt lgkmcnt(0)" ::: "memory");
        __syncthreads();
    }
}

#ifndef FAST_CHAIN
#define FAST_CHAIN 1
#endif
constexpr int NCHWG = 160;
__device__ __forceinline__ void phase_mix(Frame& F, int layer) {
    const bool last = layer == 1;
    const GAS bf16* ftl = WSP(const bf16, WS_FTL) + (size_t)layer * 2 * 384 * 4096;
    if (FAST_CHAIN) {
        if (F.wg < NCHWG) {
            if (F.wave >= 4) {
#pragma unroll 1
                for (int i = 0; i < 72 * REP_CH; ++i) __syncthreads();
            } else {
                const int cl = F.wave >> 1, hf = F.wave & 1, c = F.wg * 2 + cl;
                LAS unsigned char* img = F.lds + cl * CH_WAVE_LDS;
                {
                if (c < 192) { const int b = c / 12, r = c % 12; chain_fast<false>(F, layer, b, r >> 1, r & 1, img, hf); }
                else { const int i = c - 192; chain_fast<true>(F, layer, i >> 3, (i & 7) >> 1, i & 1, img, hf); }
                }
            }
        } else {
            const int nh = F.G - NCHWG, w = F.wg - NCHWG;
#ifndef FAST_HY
#define FAST_HY 1
#endif
            if (FAST_HY) {
#ifndef REP_HY
#define REP_HY 1
#endif
#pragma unroll 1
                for (int rp = 0; rp < REP_HY; ++rp)
                for (int u = w; u < 384; u += nh) hyena_unit_fast<LL>(F, layer, u, WSP(const bf16, WS_HYTL), ftl, WSP(bf16, WS_YHTL));
                if (!last) for (int u = w; u < 384; u += nh) hyena_unit_fast<LC>(F, layer, u, WSP(const bf16, WS_HYTC), WSP(const bf16, WS_FTC), WSP(bf16, WS_YHTC));
            } else {
                for (int u = w; u < 384; u += nh) hyena_unit_naive<LL>(F, layer, u, WSP(const bf16, WS_HYTL), ftl, WSP(bf16, WS_YHTL));
                if (!last) for (int u = w; u < 384; u += nh) hyena_unit_naive<LC>(F, layer, u, WSP(const bf16, WS_HYTC), WSP(const bf16, WS_FTC), WSP(bf16, WS_YHTC));
            }
        }
    } else {
        for (int u = F.wg; u < 384; u += F.G) hyena_unit_naive<LL>(F, layer, u, WSP(const bf16, WS_HYTL), ftl, WSP(bf16, WS_YHTL));
        if (!last) for (int u = F.wg; u < 384; u += F.G) hyena_unit_naive<LC>(F, layer, u, WSP(const bf16, WS_HYTC), WSP(const bf16, WS_FTC), WSP(bf16, WS_YHTC));
        for (int c = F.wg + F.wave * F.G; c < 320; c += F.G * NWAVES) chain_naive(F, layer, c);
    }
}

__device__ __forceinline__ void phase_combine(Frame& F, int layer) {
    const bool last = layer == 1;
    const int gw = F.wg * NWAVES + F.wave, NGW = F.G * NWAVES, lane = F.lane;
    const int nrows = last ? TOKL : TOK;
    GAS bf16* Y = WSP(bf16, WS_Y); const GAS bf16* OB = WSP(const bf16, WS_OB); const GAS bf16* RET = WSP(const bf16, WS_RET); const GAS bf16* ML = WSP(const bf16, WS_ML);
    for (int row = gw; row < nrows; row += NGW) {
#pragma unroll
        for (int hh = 0; hh < 10; ++hh) {
            const int cof = hh * 64 + lane;
            const float x = bf2f(Y[(size_t)row * D + 384 + cof]) + bf2f(OB[(size_t)row * 640 + cof]);
            const float mu = wave_sum(x) * (1.f / 64.f), xc = x - mu;
            const float var = wave_sum(xc * xc) * (1.f / 64.f);
            const float nrm = xc * rsqrtf(var + 1e-6f);
            float gate;
            if (hh < 6) gate = siluf_(bf2f(RET[(size_t)row * 1536 + 1152 + cof]));
            else gate = sigmoidf_(bf2f(ML[(size_t)row * 1024 + 768 + (cof - 384)]));
            Y[(size_t)row * D + 384 + cof] = (bf16)f2bf(nrm * gate);
        }
    }
    LAS float* scr = (LAS float*)(F.lds + F.wave * 16640);
    const int nitL = NB * 6 * 32, nitC = last ? 0 : NB * 6 * 4;
    for (int it = gw; it < nitL + nitC; it += NGW) {
        const GAS bf16* src; int L, rowbase, b, cb, tb;
        if (it < nitL) { b = it / 192; const int r = it % 192; cb = r / 32; tb = r % 32; L = LL; src = WSP(const bf16, WS_YHTL); rowbase = b * LL; }
        else { const int i2 = it - nitL; b = i2 / 24; const int r = i2 % 24; cb = r / 4; tb = r % 4; L = LC; src = WSP(const bf16, WS_YHTC); rowbase = TOKL + b * LC; }
        for (int cc = 0; cc < 64; ++cc) scr[cc * 65 + lane] = bf2f(src[((size_t)(b * 384 + cb * 64 + cc)) * L + tb * 64 + lane]);
        asm volatile("s_waitcnt lgkmcnt(0)" ::: "memory");
        for (int tt = 0; tt < 64; ++tt) Y[(size_t)(rowbase + tb * 64 + tt) * D + cb * 64 + lane] = (bf16)f2bf(scr[lane * 65 + tt]);
        asm volatile("s_waitcnt lgkmcnt(0)" ::: "memory");
    }
}

__device__ __forceinline__ void phase_norm_router(Frame& F) {
    const int gw = F.wg * NWAVES + F.wave, NGW = F.G * NWAVES, lane = F.lane;
    const GAS float* g = inp(F, I_GFFN) + 1 * D; const GAS float* wr = inp(F, I_ROUTER); const GAS float* br = inp(F, I_ROUTERB);
    GAS unsigned* cnt = WSP(unsigned, WS_CTL) + CW_CNT;
    for (int row = gw; row < TOKL; row += NGW) {
        float keep[16];
        norm_mod_row(xrow_ptr(F, row, false), g, mod_ptr(F, 1, row, 3), mod_ptr(F, 1, row, 4), WSP(bf16, WS_H) + (size_t)row * D, lane, keep);
        float lg[8];
#pragma unroll
        for (int e = 0; e < 8; ++e) lg[e] = 0.f;
#pragma unroll
        for (int j = 0; j < 4; ++j)
#pragma unroll
            for (int i = 0; i < 4; ++i) { const int k = 256 * j + 4 * lane + i; const f32x4 w0 = *(const GAS f32x4*)(wr + k * 8), w1 = *(const GAS f32x4*)(wr + k * 8 + 4); const float x = keep[4 * j + i];
                lg[0] += x * w0.x; lg[1] += x * w0.y; lg[2] += x * w0.z; lg[3] += x * w0.w; lg[4] += x * w1.x; lg[5] += x * w1.y; lg[6] += x * w1.z; lg[7] += x * w1.w; }
#pragma unroll
        for (int e = 0; e < 8; ++e) lg[e] = wave_sum(lg[e]) + br[e];
        int e0 = 0; float v0 = lg[0];
#pragma unroll
        for (int e = 1; e < 8; ++e) if (lg[e] > v0) { v0 = lg[e]; e0 = e; }
        int e1 = -1; float v1 = -3.0e38f;
#pragma unroll
        for (int e = 0; e < 8; ++e) if (e != e0 && lg[e] > v1) { v1 = lg[e]; e1 = e; }
        const float w1 = 1.f / (1.f + __expf(v0 - v1)), w0 = 1.f - w1;
        if (lane == 0) {
            const unsigned p0 = __hip_atomic_fetch_add(cnt + e0, 1u, __ATOMIC_RELAXED, __HIP_MEMORY_SCOPE_AGENT), p1 = __hip_atomic_fetch_add(cnt + e1, 1u, __ATOMIC_RELAXED, __HIP_MEMORY_SCOPE_AGENT);
            WSP(int, WS_TOPE)[row * 2] = e0; WSP(int, WS_TOPE)[row * 2 + 1] = e1;
            WSP(float, WS_TOPW)[row * 2] = w0; WSP(float, WS_TOPW)[row * 2 + 1] = w1;
            WSP(int, WS_TOPP)[row * 2] = (int)p0; WSP(int, WS_TOPP)[row * 2 + 1] = (int)p1;
        }
    }
}
__device__ __forceinline__ void phase_route_tables(Frame& F) {
    const GAS unsigned* cnt = WSP(const unsigned, WS_CTL) + CW_CNT;
    int off[9]; off[0] = 0;
#pragma unroll
    for (int e = 0; e < 8; ++e) { const int c = (int)__hip_atomic_load(cnt + e, __ATOMIC_RELAXED, __HIP_MEMORY_SCOPE_AGENT); off[e + 1] = off[e] + ((c + 255) >> 8) * 256; }
    const int gt = F.wg * NTHR + F.tid, NGT = F.G * NTHR;
    GAS int* rowidx = WSP(int, WS_ROWIDX); GAS int* slot = WSP(int, WS_SLOT); GAS int* tilee = WSP(int, WS_TILEE);
    for (int i = gt; i < MAXTILES * 256; i += NGT) {
        int e = 0;
#pragma unroll
        for (int q = 1; q < 8; ++q) if (i >= off[q]) e = q;
        const int c = (int)cnt[e];
        if (i >= off[8] || i - off[e] >= c) rowidx[i] = 0;
    }
    for (int i = gt; i < TOKL * 2; i += NGT) {
        const int e = WSP(const int, WS_TOPE)[i], pos = WSP(const int, WS_TOPP)[i];
        int o = 0;
#pragma unroll
        for (int q = 0; q < 8; ++q) if (e == q) o = off[q];
        const int s = o + pos; slot[i] = s; rowidx[s] = i >> 1;
    }
    for (int i = gt; i < MAXTILES + 1; i += NGT) {
        if (i == MAXTILES) tilee[MAXTILES] = off[8] >> 8;
        else { int e = 0;
#pragma unroll
            for (int q = 1; q < 8; ++q) if (i * 256 >= off[q]) e = q;
            tilee[i] = e; }
    }
}

__device__ __forceinline__ void moe_pass_gemm1_fast(Frame& F, int t0, int t1) {
    pg8::OrderMoe S; S.o.init(t1 - t0, NFF1 / 256, F.G, F.wg); S.rowidx = WSP(const int, WS_ROWIDX); S.tilee = WSP(const int, WS_TILEE); S.t0 = t0; S.bstride = (size_t)NFF1 * D; S.gather = true;
    EpiSwiglu E{WSP(bf16, WS_MACT), 0};
    pg8::gemm_phase(F.lds, F.tid, WSP(const bf16, WS_H), D, WSP(const bf16, WS_MW13), D, D, S, E);
}
__device__ __forceinline__ void moe_pass_gemm2_fast(Frame& F, int t0, int t1) {
    pg8::OrderMoe S; S.o.init(t1 - t0, D / 256, F.G, F.wg); S.rowidx = WSP(const int, WS_ROWIDX); S.tilee = WSP(const int, WS_TILEE); S.t0 = t0; S.bstride = (size_t)D * DFF; S.gather = false;
    EpiBf16Out E{WSP(bf16, WS_EOUT), D, t0 * 256};
    pg8::gemm_phase(F.lds, F.tid, WSP(const bf16, WS_MACT), DFF, WSP(const bf16, WS_MW2), DFF, DFF, S, E);
}
__device__ __forceinline__ void phase_final(Frame& F) {
    const int gw = F.wg * NWAVES + F.wave, NGW = F.G * NWAVES, lane = F.lane;
    const GAS float* gf = inp(F, I_GFINAL); const GAS bf16* eo = WSP(const bf16, WS_EOUT);
    for (int row = gw; row < TOKL; row += NGW) {
        const int s0 = WSP(const int, WS_SLOT)[row * 2], s1 = WSP(const int, WS_SLOT)[row * 2 + 1];
        const float w0 = WSP(const float, WS_TOPW)[row * 2], w1 = WSP(const float, WS_TOPW)[row * 2 + 1];
        const GAS float* m5 = mod_ptr(F, 1, row, 5);
        GAS float* xr = outp(F) + (size_t)row * D;
        f32x4 v[4]; float s = 0.f;
#pragma unroll
        for (int j = 0; j < 4; ++j) {
            const int c = 256 * j + 4 * lane;
            const f32x4 a = ld_bf16x4(eo + (size_t)s0 * D + c), b = ld_bf16x4(eo + (size_t)s1 * D + c), m = *(const GAS f32x4*)(m5 + c);
            v[j] = *(const GAS f32x4*)(xr + c) + m * (a * w0 + b * w1);
            s += (v[j].x * v[j].x + v[j].y * v[j].y) + (v[j].z * v[j].z + v[j].w * v[j].w);
        }
        const float r = rsqrtf(wave_sum(s) * (1.f / 1024.f) + 1e-6f);
#pragma unroll
        for (int j = 0; j < 4; ++j) { const int c = 256 * j + 4 * lane; const f32x4 g = *(const GAS f32x4*)(gf + c); *(GAS f32x4*)(xr + c) = v[j] * r * g; }
    }
}

#ifndef REP_WIN
#define REP_WIN 1
#endif
#ifndef REP_MIX
#define REP_MIX 1
#endif
#ifndef REP_GATE
#define REP_GATE 1
#endif
#ifndef REP_UP
#define REP_UP 1
#endif
#ifndef REP_FFN1
#define REP_FFN1 1
#endif
#ifndef REP_MOE
#define REP_MOE 1
#endif
#ifndef REP_NORM
#define REP_NORM 1
#endif
#ifndef REP_P0
#define REP_P0 1
#endif
__global__ void __launch_bounds__(NTHR, 2) hybrid_fwd(Params prm) {
    extern __shared__ __attribute__((aligned(16))) unsigned char lds_raw[];
    Frame F;
    F.lds = (LAS unsigned char*)lds_raw; F.ws = (GAS unsigned char*)prm.ws;
    F.tid = threadIdx.x; F.lane = F.tid & 63; F.wave = __builtin_amdgcn_readfirstlane(F.tid >> 6); F.G = gridDim.x; F.wg = blockIdx.x;
    volatile LAS unsigned* MISC = (volatile LAS unsigned*)(F.lds + MISC_OFF);
    if (F.tid < 64) MISC[F.tid] = 0u;
    if (F.tid < 33) { const unsigned long long v = F.tid < 32 ? (unsigned long long)prm.in[F.tid] : (unsigned long long)prm.out; *(LAS unsigned long long*)(F.lds + PTAB_OFF + 8 * F.tid) = v; }
    __syncthreads();
    XcdBarrier bar = xcd_barrier_post(WSP(unsigned, WS_CTL) + CW_BAR, MISC + 8);
#define RELAUNDER() do { { unsigned long long _w = (unsigned long long)F.ws; asm volatile("" : "+s"(_w)); F.ws = (GAS unsigned char*)_w; } \
        { unsigned _t = (unsigned)F.tid; asm volatile("" : "+v"(_t)); F.tid = (int)_t; F.lane = F.tid & 63; F.wave = __builtin_amdgcn_readfirstlane(F.tid >> 6); } \
        { unsigned _g = (unsigned)F.G, _b = (unsigned)F.wg; asm volatile("" : "+s"(_g), "+s"(_b)); F.G = (int)_g; F.wg = (int)_b; } \
        { unsigned _l = (unsigned)(size_t)F.lds; asm volatile("" : "+s"(_l)); F.lds = (LAS unsigned char*)(size_t)_l; } } while (0)
#define GRID_BAR() do { { unsigned long long _b = (unsigned long long)bar.bar; unsigned _x = bar.x; asm volatile("" : "+s"(_b), "+s"(_x)); bar.bar = (GAS unsigned*)_b; bar.x = _x; } xcd_barrier(bar); RELAUNDER(); } while (0)

    for (int rp = 0; rp < REP_P0; ++rp) { phase_p0(F); write_bias(F);
    GRID_BAR(); }
#pragma unroll 1
    for (int layer_ = 0; layer_ < 2; ++layer_) {
        int layer = layer_;
#define last (layer == 1)
#define rows_all TOK
#define rows_out (last ? TOKL : TOK)
#define modbase (WSP(const float, WS_MOD) + (size_t)layer * 17 * 6144)
#define LAYER_LAUNDER() asm volatile("" : "+s"(layer))
        for (int rp = 0; rp < REP_NORM; ++rp) { phase_norm(F, layer, rows_all, !last, 0);
        { GRID_BAR(); LAYER_LAUNDER(); } }
        for (int rp = 0; rp < REP_WIN; ++rp) {
        { EpiWin E{WSP(const float, WS_BIAS) + layer * NWP, WSP(bf16, WS_HYTL), WSP(bf16, WS_HYTC), WSP(bf16, WS_RET), WSP(bf16, WS_ML), WSP(float, WS_MLG)};
          gemm_fast(F, WSP(const bf16, WS_H), D, WSP(const bf16, WS_WIN), D, D, rows_all, NW1, E); }
        { GRID_BAR(); LAYER_LAUNDER(); } }
        for (int rp = 0; rp < REP_MIX; ++rp) { phase_mix(F, layer);
        { GRID_BAR(); LAYER_LAUNDER(); } }
        phase_combine(F, layer);
        { GRID_BAR(); LAYER_LAUNDER(); }
        for (int rp = 0; rp < REP_GATE; ++rp) {
        { EpiGate E{WSP(const float, WS_BIAS) + layer * NWP + NW1, WSP(bf16, WS_GATES)};
          gemm_fast(F, WSP(const bf16, WS_H), D, WSP(const bf16, WS_WIN) + (size_t)NW1 * D, D, D, rows_out, NGATE, E); }
        { GRID_BAR(); LAYER_LAUNDER(); } }
        for (int rp = 0; rp < REP_UP; ++rp) {
        { EpiUp E{WSP(const bf16, WS_GATES), WSP(bf16, WS_H)};
          gemm_fast(F, WSP(const bf16, WS_Y), D, WSP(const bf16, WS_WUP), D, D, rows_out, D, E); }
        { GRID_BAR(); LAYER_LAUNDER(); } }
        { EpiResid E{last ? outp(F) : inp(F, I_X), last ? WSP(const float, WS_XC) : inp(F, I_CTX), outp(F), WSP(float, WS_XC), modbase, 2};
          gemm_fast(F, WSP(const bf16, WS_H), D, WSP(const bf16, WS_WOUT), D, D, rows_out, D, E); }
        { GRID_BAR(); LAYER_LAUNDER(); }
        if (!last) {
            phase_norm(F, layer, rows_out, false, 3);
            { const int gw = F.wg * NWAVES + F.wave, NGW = F.G * NWAVES; LAS float* scr = (LAS float*)(F.lds + F.wave * 8704);
              conv_weights_ffn(inp(F, I_FW1), inp(F, I_FW3), inp(F, I_FW2), WSP(bf16, WS_W13), WSP(bf16, WS_W2), gw, NGW, scr, F.lane);
              conv_weights_win(F, 1, gw, NGW, scr);
              conv_weights_upout(F, 1, gw, NGW, scr); }
            { GRID_BAR(); LAYER_LAUNDER(); }
            for (int rp = 0; rp < REP_FFN1; ++rp) {
            { EpiSwiglu E{WSP(bf16, WS_ACT), 0};
              gemm_fast(F, WSP(const bf16, WS_H), D, WSP(const bf16, WS_W13), D, D, rows_out, NFF1, E); }
            { GRID_BAR(); LAYER_LAUNDER(); } }
            { EpiResid E{outp(F), WSP(const float, WS_XC), outp(F), WSP(float, WS_XC), modbase, 5};
              gemm_fast(F, WSP(const bf16, WS_ACT), DFF, WSP(const bf16, WS_W2), DFF, DFF, rows_out, D, E); }
            { GRID_BAR(); LAYER_LAUNDER(); }
        }
    }
#undef LAYER_LAUNDER
#undef last
#undef rows_all
#undef rows_out
#undef modbase
    phase_norm_router(F);
    { const int gw = F.wg * NWAVES + F.wave, NGW = F.G * NWAVES; LAS float* scr = (LAS float*)(F.lds + F.wave * 8704);
#pragma unroll 1
      for (int e = 0; e < NE; ++e)
          conv_weights_ffn(inp(F, I_MW1) + (size_t)e * D * DFF, inp(F, I_MW3) + (size_t)e * D * DFF, inp(F, I_MW2) + (size_t)e * DFF * D,
                           WSP(bf16, WS_MW13) + (size_t)e * NFF1 * D, WSP(bf16, WS_MW2) + (size_t)e * D * DFF, gw, NGW, scr, F.lane); }
    GRID_BAR();
    phase_route_tables(F);
    GRID_BAR();
    const int ntiles = __builtin_amdgcn_readfirstlane(WSP(const int, WS_TILEE)[MAXTILES]);
#pragma unroll 1
    for (int p = 0; p < NPASS; ++p) {
        const int t0 = p * PASS_TILES, t1 = min(ntiles, t0 + PASS_TILES);
        for (int rp = 0; rp < REP_MOE; ++rp) {
        if (t0 < t1) moe_pass_gemm1_fast(F, t0, t1);
        GRID_BAR();
        if (t0 < t1) moe_pass_gemm2_fast(F, t0, t1);
        GRID_BAR(); }
    }
    phase_final(F);
}

extern "C" void kernel_launch(void* const* d_in, const int* in_sizes, int n_in, void* d_out, int out_size, void* d_ws, size_t ws_size, hipStream_t stream) {
    static int grid = 0;
    if (grid == 0) {
        if (n_in != 32 || out_size != TOKL * D || ws_size < WS_END) { fprintf(stderr, "kernel_launch: unexpected arguments (n_in %d, out %d, ws %zu)\n", n_in, out_size, ws_size); grid = -1; return; }
        int dev = 0, cus = 0;
        if (hipGetDevice(&dev) != hipSuccess || hipDeviceGetAttribute(&cus, hipDeviceAttributeMultiprocessorCount, dev) != hipSuccess) { grid = -1; return; }
        if (hipFuncSetAttribute((const void*)hybrid_fwd, hipFuncAttributeMaxDynamicSharedMemorySize, LDS_BYTES) != hipSuccess) { grid = -1; return; }
        int per_cu = 0;
        (void)hipOccupancyMaxActiveBlocksPerMultiprocessor(&per_cu, (const void*)hybrid_fwd, NTHR, LDS_BYTES);
        (void)hipGetLastError();
        grid = cus;
    }
    if (grid < 0) return;
    (void)hipMemsetAsync((char*)d_ws + WS_CTL, 0, CTL_ZERO_BYTES, stream);
    Params p{};
    for (int i = 0; i < 32; ++i) p.in[i] = (const float*)d_in[i];
    p.out = (float*)d_out; p.ws = (unsigned char*)d_ws;
    hipLaunchKernelGGL(hybrid_fwd, dim3(grid), dim3(NTHR), LDS_BYTES, stream, p);
}
```

```cpp
#include <hip/hip_runtime.h>
#include <stdint.h>
#include <stdio.h>

#define LAS __attribute__((address_space(3)))
#define GAS __attribute__((address_space(1)))
typedef unsigned short bf16;
typedef short bf16x8 __attribute__((ext_vector_type(8)));
typedef float f32x4 __attribute__((ext_vector_type(4)));
typedef unsigned u32x4 __attribute__((ext_vector_type(4)));
typedef unsigned u32x2 __attribute__((ext_vector_type(2)));

constexpr int D = 1024, NB = 16, LL = 2048, LC = 256;
constexpr int TOKL = NB * LL, TOKC = NB * LC, TOK = TOKL + TOKC;
constexpr int HYW = 384, RETW = 384, MLW = 256;
constexpr int NIN = 6800, NW1 = 3840, NGATE = 3072, NWP = 6912;
constexpr int DFF = 2816, NFF1 = 5632, NE = 8;
constexpr int NWAVES = 8, NTHR = 512;
constexpr int MAXTILES = 272, PASS_TILES = 64, NPASS = 5;

constexpr size_t MiB = 1u << 20;
constexpr size_t WS_CTL = 0, CTL_ZERO_BYTES = 1 * MiB;
constexpr size_t WS_MOD = 1 * MiB;
constexpr size_t WS_BIAS = 2 * MiB;
constexpr size_t WS_ROPE = 2 * MiB + 256 * 1024;
constexpr size_t WS_TOPE = 3 * MiB;
constexpr size_t WS_TOPW = 3 * MiB + 256 * 1024;
constexpr size_t WS_TOPP = 3 * MiB + 512 * 1024;
constexpr size_t WS_SLOT = 3 * MiB + 768 * 1024;
constexpr size_t WS_ROWIDX = 4 * MiB;
constexpr size_t WS_TILEE = 4 * MiB + 512 * 1024;
constexpr size_t WS_FTL = 5 * MiB;
constexpr size_t WS_FTC = 17 * MiB;
constexpr size_t WS_WIN = 18 * MiB;
constexpr size_t WS_WUP = 32 * MiB;
constexpr size_t WS_WOUT = 34 * MiB;
constexpr size_t WS_XC = 36 * MiB;
constexpr size_t WS_H = 52 * MiB;
constexpr size_t WS_Y = 124 * MiB;
constexpr size_t WS_U = 196 * MiB;
constexpr size_t WS_RET = WS_U;
constexpr size_t WS_ML = WS_U + 108 * MiB;
constexpr size_t WS_MLG = WS_U + 180 * MiB;
constexpr size_t WS_OB = WS_U + 183 * MiB;
constexpr size_t WS_YHTL = WS_U + 228 * MiB;
constexpr size_t WS_YHTC = WS_U + 252 * MiB;
constexpr size_t WS_HYTL = WS_U + 255 * MiB;
constexpr size_t WS_HYTC = WS_U + 327 * MiB;
constexpr size_t WS_END = WS_U + 336 * MiB;
constexpr size_t WS_GATES = WS_U;
constexpr size_t WS_ACT = WS_U;
constexpr size_t WS_W13 = WS_U + 204 * MiB;
constexpr size_t WS_W2 = WS_U + 216 * MiB;
constexpr size_t WS_MW13 = WS_Y;
constexpr size_t WS_MW2 = WS_Y + 88 * MiB;
constexpr size_t WS_MACT = WS_Y + 132 * MiB;
constexpr size_t WS_EOUT = WS_Y + 220 * MiB;
static_assert(WS_EOUT + (size_t)MAXTILES * 256 * 1024 * 2 <= WS_END, "map");
static_assert(WS_GATES + (size_t)TOK * NGATE * 2 <= WS_YHTL, "gates overlay");

constexpr int CW_BAR = 4096;
constexpr int CW_CNT = 16384;

constexpr int LDS_BYTES = 147456;
constexpr int MISC_OFF = 147456 - 256;

__device__ __forceinline__ float bf2f(bf16 b) { return __uint_as_float(((unsigned)b) << 16); }
typedef __bf16 bf2v_ __attribute__((ext_vector_type(2)));
typedef float f2v_ __attribute__((ext_vector_type(2)));
__device__ __forceinline__ unsigned pk2(float lo, float hi) { const f2v_ f = {lo, hi}; return __builtin_bit_cast(unsigned, __builtin_convertvector(f, bf2v_)); }
__device__ __forceinline__ unsigned f2bf(float f) { return pk2(f, 0.f) & 0xffffu; }
__device__ __forceinline__ float dpp_f(float v, int) { return v; }
#define DPP_ADD(v, ctrl) (v) += __int_as_float(__builtin_amdgcn_update_dpp(0, __float_as_int(v), (ctrl), 0xf, 0xf, true))
__device__ __forceinline__ float wave_sum(float v) {
    DPP_ADD(v, 0xB1);
    DPP_ADD(v, 0x4E);
    DPP_ADD(v, 0x141);
    DPP_ADD(v, 0x140);
    return __int_as_float(__builtin_amdgcn_readlane(__float_as_int(v), 0)) + __int_as_float(__builtin_amdgcn_readlane(__float_as_int(v), 16))
         + __int_as_float(__builtin_amdgcn_readlane(__float_as_int(v), 32)) + __int_as_float(__builtin_amdgcn_readlane(__float_as_int(v), 48));
}
__device__ __forceinline__ float lane_read(float v, int src_lane) { return __int_as_float(__builtin_amdgcn_ds_bpermute(src_lane << 2, __float_as_int(v))); }
__device__ __forceinline__ float sigmoidf_(float x) { return __builtin_amdgcn_rcpf(1.0f + __expf(-x)); }
__device__ __forceinline__ float siluf_(float x) { return x * __builtin_amdgcn_rcpf(1.0f + __expf(-x)); }

#define XB_TMO      128
#define XB_XCNT(j)  (256  + 64 * (j))
#define XB_XSUB(j)  (1280 + 64 * (j))
#define XB_XGEN(j)  (2304 + 64 * (j))
#define XB_TOP      3328
#define XB_TOPGEN   3392
#define XCD_BAR_WORDS 3456
#define XB_SPIN_CAP (1u << 22)
__device__ __forceinline__ unsigned xb_ld(GAS unsigned* p)              { return __hip_atomic_load(p, __ATOMIC_RELAXED, __HIP_MEMORY_SCOPE_AGENT); }
__device__ __forceinline__ unsigned xb_add(GAS unsigned* p, unsigned v) { return __hip_atomic_fetch_add(p, v, __ATOMIC_RELAXED, __HIP_MEMORY_SCOPE_AGENT); }
__device__ __forceinline__ unsigned xb_xcc_id() { return (unsigned)__builtin_amdgcn_s_getreg((3 << 11) | 20) & 0xFu; }
#define XB_SPIN(cond, bar) do { unsigned _sp = 0; while (cond) { __builtin_amdgcn_s_sleep(1); \
    if ((++_sp & 255u) == 0u) { if (xb_ld(&(bar)[XB_TMO])) break; if (_sp > XB_SPIN_CAP) { (void)__hip_atomic_fetch_add(&(bar)[XB_TMO], 1u, __ATOMIC_RELAXED, __HIP_MEMORY_SCOPE_AGENT); break; } } } } while (0)
struct XcdBarrier { GAS unsigned* bar; unsigned x; volatile LAS unsigned* st; };
__device__ __forceinline__ XcdBarrier xcd_barrier_post(GAS unsigned* bar, volatile LAS unsigned* st) {
    XcdBarrier b; b.bar = bar; b.x = xb_xcc_id(); b.st = st;
    if (threadIdx.x == 0) (void)xb_add(&bar[XB_XCNT(b.x)], 1u);
    return b;
}
__device__ __forceinline__ void xcd_barrier_complete(GAS unsigned* bar, unsigned x, unsigned& nloc, unsigned& nx) {
    const unsigned G = gridDim.x * gridDim.y * gridDim.z;
    unsigned sum, cnt, mine, sp = 0u;
    for (;;) {
        sum = 0u; cnt = 0u; mine = 0u;
#pragma unroll 1
        for (unsigned j = 0; j < 16; ++j) { const unsigned c = xb_ld(&bar[XB_XCNT(j)]); sum += c; cnt += (c > 0u) ? 1u : 0u; }
        mine = xb_ld(&bar[XB_XCNT(x)]);
        if (sum == G) break;
        __builtin_amdgcn_s_sleep(1);
        if ((++sp & 255u) == 0u) { if (xb_ld(&bar[XB_TMO])) break; if (sp > XB_SPIN_CAP) { (void)__hip_atomic_fetch_add(&bar[XB_TMO], 1u, __ATOMIC_RELAXED, __HIP_MEMORY_SCOPE_AGENT); break; } }
    }
    nloc = mine > 0u ? mine : 1u; nx = cnt > 0u ? cnt : 1u;
}
__device__ __forceinline__ void xcd_barrier(const XcdBarrier& b) {
    asm volatile("s_waitcnt vmcnt(0)" ::: "memory");
    __syncthreads();
    if (threadIdx.x == 0) {
        GAS unsigned* bar = b.bar;
        __builtin_amdgcn_s_waitcnt(0);
        unsigned nloc = b.st[0], nx = b.st[1];
        if (nloc == 0u) { xcd_barrier_complete(bar, b.x, nloc, nx); b.st[0] = nloc; b.st[1] = nx; }
        const unsigned old = xb_add(&bar[XB_XSUB(b.x)], 1u);
        const unsigned gen = old / nloc;
        if (old + 1u == (gen + 1u) * nloc) {
            __builtin_amdgcn_fence(__ATOMIC_RELEASE, "agent");
            asm volatile("s_waitcnt vmcnt(0)" ::: "memory");
            const unsigned og = xb_add(&bar[XB_TOP], 1u);
            const unsigned tg = og / nx;
            if (og + 1u == (tg + 1u) * nx) xb_add(&bar[XB_TOPGEN], 1u);
            else XB_SPIN(xb_ld(&bar[XB_TOPGEN]) == tg, bar);
            __builtin_amdgcn_fence(__ATOMIC_ACQUIRE, "agent");
            xb_add(&bar[XB_XGEN(b.x)], 1u);
            asm volatile("s_waitcnt vmcnt(0)" ::: "memory");
        } else {
            XB_SPIN(xb_ld(&bar[XB_XGEN(b.x)]) == gen, bar);
            __builtin_amdgcn_fence(__ATOMIC_ACQUIRE, "agent");
            asm volatile("s_waitcnt vmcnt(0)" ::: "memory");
        }
    }
    __syncthreads();
}

struct Params { const float* in[32]; float* out; unsigned char* ws; };
enum { I_X = 0, I_C, I_CTX, I_CCTX, I_WMOD, I_BMOD, I_GMIX, I_GFFN, I_WIN, I_BIN, I_HYCONV, I_HYF1, I_HYFB1, I_HYF2, I_HYFB2, I_HYF3, I_HYDECAY,
       I_HYSKIP, I_RETDECAY, I_MLCONV, I_MLGB, I_WUP, I_WOUT, I_FW1, I_FW3, I_FW2, I_ROUTER, I_ROUTERB, I_MW1, I_MW3, I_MW2, I_GFINAL };

struct Frame {
    LAS unsigned char* lds;
    GAS unsigned char* ws;
    int tid, lane, wave, G, wg;
};
#define WSP(T, off) ((GAS T*)(F.ws + (off)))
constexpr int PTAB_OFF = 147456 - 1024;
__device__ __forceinline__ const GAS float* inp(const Frame& F, int i) {
    const LAS unsigned* t = (const LAS unsigned*)(F.lds + PTAB_OFF) + 2 * i;
    const unsigned lo = __builtin_amdgcn_readfirstlane(t[0]), hi = __builtin_amdgcn_readfirstlane(t[1]);
    return (const GAS float*)(((unsigned long long)hi << 32) | lo);
}
__device__ __forceinline__ GAS float* outp(const Frame& F) { return (GAS float*)inp(F, 32); }

__device__ __forceinline__ int row_batch(int row) { return row < TOKL ? (row >> 11) : ((row - TOKL) >> 8); }
__device__ __forceinline__ const GAS float* mod_ptr(const Frame& F, int layer, int row, int which) {
    const int r = row < TOKL ? (row >> 11) : 16;
    return WSP(const float, WS_MOD) + ((size_t)(layer * 17 + r) * 6 + which) * 1024;
}

template <class RowMap>
__device__ __forceinline__ void tr_item(const GAS float* W, int K, int N, GAS bf16* WT, int ldT, RowMap rm, LAS float* scr, int item, int lane) {
    const int nblk = (N + 31) / 32, kb = item / nblk, nb = item % nblk, k0 = 64 * kb, n0 = 32 * nb;
#pragma unroll 8
    for (int i = 0; i < 32; ++i) { const int kk = 2 * i + (lane >> 5); const int n = n0 + (lane & 31); scr[kk * 33 + (lane & 31)] = (n < N) ? W[(size_t)(k0 + kk) * N + n] : 0.f; }
    asm volatile("s_waitcnt lgkmcnt(0)" ::: "memory");
    const int c = lane & 7;
#pragma unroll
    for (int j = 0; j < 4; ++j) { const int nl = (lane >> 3) + 8 * j; const int n = n0 + nl; const LAS float* s = scr + (8 * c) * 33 + nl;
        u32x4 o; o.x = pk2(s[0 * 33], s[1 * 33]); o.y = pk2(s[2 * 33], s[3 * 33]); o.z = pk2(s[4 * 33], s[5 * 33]); o.w = pk2(s[6 * 33], s[7 * 33]);
        if (n < N) *(GAS u32x4*)(WT + (size_t)rm(n) * ldT + k0 + 8 * c) = o; }
    asm volatile("s_waitcnt lgkmcnt(0)" ::: "memory");
}
struct RmId { __device__ __forceinline__ int operator()(int n) const { return n; } };
__device__ __forceinline__ int win_row(int n) {
    if (n < 1152) return n;
    if (n < 2688) return 1280 + (n - 1152);
    if (n < 3712) return 2816 + (n - 2688);
    if (n < 3728) return 1152 + (n - 3712);
    return 3840 + (n - 3728);
}
struct RmWin { __device__ __forceinline__ int operator()(int n) const { return win_row(n); } };
struct RmW1 { __device__ __forceinline__ int operator()(int n) const { return (n >> 4) * 32 + (n & 15); } };
struct RmW3 { __device__ __forceinline__ int operator()(int n) const { return (n >> 4) * 32 + 16 + (n & 15); } };

__device__ __forceinline__ void conv_weights_win(Frame& F, int layer, int gw, int NGW, LAS float* scr) {
    const GAS float* W = inp(F, I_WIN) + (size_t)layer * D * NIN;
    const int items = (D / 64) * ((NIN + 31) / 32);
    for (int it = gw; it < items; it += NGW) tr_item(W, D, NIN, WSP(bf16, WS_WIN), D, RmWin(), scr, it, F.lane);
    GAS bf16* wt = WSP(bf16, WS_WIN);
    unsigned zz; asm volatile("v_mov_b32 %0, 0" : "=v"(zz));
    for (int i = gw * 64 + F.lane; i < 112 * 1024 / 8; i += NGW * 64) *(GAS u32x4*)(wt + (size_t)1168 * 1024 + (size_t)i * 8) = (u32x4){zz, zz, zz, zz};
}
__device__ __forceinline__ void conv_weights_upout(Frame& F, int layer, int gw, int NGW, LAS float* scr) {
    const int items = (D / 64) * (D / 32);
    for (int it = gw; it < items; it += NGW) tr_item(inp(F, I_WUP) + (size_t)layer * D * D, D, D, WSP(bf16, WS_WUP), D, RmId(), scr, it, F.lane);
    for (int it = gw; it < items; it += NGW) tr_item(inp(F, I_WOUT) + (size_t)layer * D * D, D, D, WSP(bf16, WS_WOUT), D, RmId(), scr, it, F.lane);
}
__device__ __forceinline__ void conv_weights_ffn(const GAS float* w1, const GAS float* w3, const GAS float* w2, GAS bf16* w13t, GAS bf16* w2t, int gw, int NGW, LAS float* scr, int lane) {
    const int i1 = (D / 64) * (DFF / 32), i2 = (DFF / 64) * (D / 32);
    for (int it = gw; it < i1; it += NGW) tr_item(w1, D, DFF, w13t, D, RmW1(), scr, it, lane);
    for (int it = gw; it < i1; it += NGW) tr_item(w3, D, DFF, w13t, D, RmW3(), scr, it, lane);
    for (int it = gw; it < i2; it += NGW) tr_item(w2, DFF, D, w2t, DFF, RmId(), scr, it, lane);
}

constexpr size_t WS_HID2 = WS_XC;
__device__ __forceinline__ void filter_hidden_item(Frame& F, int item) {
    const int p0 = item * 8, sel = p0 < 2048 ? 0 : (p0 < 4096 ? 1 : 2), layer = sel == 1 ? 1 : 0, L = sel == 2 ? LC : LL, pbase = sel == 0 ? 0 : (sel == 1 ? 2048 : 4096);
    const GAS float* f1 = inp(F, I_HYF1) + layer * 33 * 64; const GAS float* fb1 = inp(F, I_HYFB1) + layer * 64;
    const GAS float* f2 = inp(F, I_HYF2) + layer * 64 * 64; const GAS float* fb2 = inp(F, I_HYFB2) + layer * 64;
    const int lane = F.lane;
    const float b1 = fb1[lane], b2 = fb2[lane];
    for (int pl = 0; pl < 8; ++pl) {
        const int pos = p0 + pl - pbase;
        const float t = (float)pos / (float)(L - 1);
        const float w = 6.283185307179586f * (float)pos / (float)L;
        float feat = 0.f;
        if (lane == 0) feat = t;
        else if (lane < 17) { const float band = 1e-4f + (float)(lane - 1) * ((15.0f - 1e-4f) / 15.0f); feat = cosf(w * band); }
        else if (lane < 33) { const float band = 1e-4f + (float)(lane - 17) * ((15.0f - 1e-4f) / 15.0f); feat = -sinf(w * band); }
        float a1 = b1;
        for (int i = 0; i < 33; ++i) a1 += __int_as_float(__builtin_amdgcn_readlane(__float_as_int(feat), i)) * f1[i * 64 + lane];
        const float h1 = sinf(a1);
        float a2 = b2;
        for (int i = 0; i < 64; ++i) a2 += __int_as_float(__builtin_amdgcn_readlane(__float_as_int(h1), i)) * f2[i * 64 + lane];
        WSP(float, WS_HID2)[(size_t)(p0 + pl) * 64 + lane] = sinf(a2);
    }
}
__device__ __forceinline__ void filter_out_item(Frame& F, int item) {
    int sel, r;
    if (item < 768) { sel = 0; r = item; } else if (item < 1536) { sel = 1; r = item - 768; } else { sel = 2; r = item - 1536; }
    const int layer = sel == 1 ? 1 : 0, L = sel == 2 ? LC : LL, pb = r / 24, ch = r % 24, pbase = sel == 0 ? 0 : (sel == 1 ? 2048 : 4096);
    GAS bf16* FT = sel == 2 ? WSP(bf16, WS_FTC) : WSP(bf16, WS_FTL) + (size_t)layer * 2 * 384 * 4096;
    const GAS float* f3 = inp(F, I_HYF3) + (size_t)layer * 64 * 1536; const GAS float* dec = inp(F, I_HYDECAY) + layer * 1536;
    const int lane = F.lane, fr = lane & 15, fq = lane >> 4;
    const GAS float* hid = WSP(const float, WS_HID2) + (size_t)(pbase + pb * 64) * 64;
    f32x4 acc[4][4];
#pragma unroll
    for (int mt = 0; mt < 4; ++mt)
#pragma unroll
        for (int nt = 0; nt < 4; ++nt) acc[mt][nt] = (f32x4){0.f, 0.f, 0.f, 0.f};
#pragma unroll 4
    for (int ks = 0; ks < 16; ++ks) {
        float a[4], bb[4];
#pragma unroll
        for (int mt = 0; mt < 4; ++mt) a[mt] = hid[(16 * mt + fr) * 64 + 4 * ks + fq];
#pragma unroll
        for (int nt = 0; nt < 4; ++nt) bb[nt] = f3[(size_t)(4 * ks + fq) * 1536 + ch * 64 + 16 * nt + fr];
#pragma unroll
        for (int mt = 0; mt < 4; ++mt)
#pragma unroll
            for (int nt = 0; nt < 4; ++nt) acc[mt][nt] = __builtin_amdgcn_mfma_f32_16x16x4f32(a[mt], bb[nt], acc[mt][nt], 0, 0, 0);
    }
#pragma unroll
    for (int nt = 0; nt < 4; ++nt) {
        const int nn = ch * 64 + 16 * nt + fr, o = nn / 768, dir = (nn / 384) & 1, c = nn % 384;
        const float adec = fabsf(dec[nn]);
        GAS bf16* dst = FT + (size_t)(o * 384 + c) * (2 * L);
#pragma unroll
        for (int mt = 0; mt < 4; ++mt)
#pragma unroll
            for (int j = 0; j < 4; ++j) {
                const int pos = pb * 64 + 16 * mt + 4 * fq + j;
                const float t = (float)pos / (float)(L - 1);
                const float v = acc[mt][nt][j] * expf(-t * adec);
                if (dir == 0) dst[L - pos] = (bf16)f2bf(v);
                else if (pos > 0) dst[L + pos] = (bf16)f2bf(v);
            }
    }
}

__device__ __forceinline__ void phase_p0(Frame& F) {
    const int gw = F.wg * NWAVES + F.wave, NGW = F.G * NWAVES;
    LAS float* sl = (LAS float*)F.lds;
    LAS float* red = (LAS float*)(F.lds + 17 * 4096);
    for (int i = F.tid; i < 17 * 1024; i += NTHR) { const int r = i >> 10, k = i & 1023; const float v = r < 16 ? inp(F, I_C)[r * 1024 + k] : inp(F, I_CCTX)[k]; sl[i] = siluf_(v); }
    __syncthreads();
    for (int item = F.wg; item < 2 * 384; item += F.G) {
        const int layer = item / 384, n0 = (item % 384) * 16, j = F.tid & 15, kp = F.tid >> 4;
        const GAS float* W = inp(F, I_WMOD) + (size_t)layer * D * 6144;
        float acc[17];
#pragma unroll
        for (int r = 0; r < 17; ++r) acc[r] = 0.f;
        for (int k = kp * 32; k < kp * 32 + 32; ++k) { const float w = W[(size_t)k * 6144 + n0 + j];
#pragma unroll
            for (int r = 0; r < 17; ++r) acc[r] += sl[r * 1024 + k] * w; }
#pragma unroll
        for (int r = 0; r < 17; ++r) red[(kp * 17 + r) * 16 + j] = acc[r];
        __syncthreads();
        if (F.tid < 272) { const int r = F.tid >> 4, jj = F.tid & 15; float s = inp(F, I_BMOD)[layer * 6144 + n0 + jj];
            for (int q = 0; q < 32; ++q) s += red[(q * 17 + r) * 16 + jj];
            WSP(float, WS_MOD)[(size_t)(layer * 17 + r) * 6144 + n0 + jj] = s; }
        __syncthreads();
    }
    __syncthreads();
    LAS float* scr = (LAS float*)(F.lds + F.wave * 8704);
    conv_weights_win(F, 0, gw, NGW, scr);
    conv_weights_upout(F, 0, gw, NGW, scr);
    for (int i = gw * 64 + F.lane; i < 2048 * 32; i += NGW * 64) {
        const int t = i >> 5, j = i & 31, half = j >> 4, ii = j & 15;
        const float inv = 1.0f / powf(10000.0f, (float)ii / 16.0f);
        const float ang = (float)(half == 0 ? (t >> 6) : (t & 63)) * inv;
        WSP(float, WS_ROPE)[t * 64 + half * 32 + ii] = cosf(ang);
        WSP(float, WS_ROPE)[t * 64 + half * 32 + 16 + ii] = sinf(ang);
    }
    for (int it = gw; it < 4352 / 8; it += NGW) filter_hidden_item(F, it);
}
__device__ __forceinline__ void write_bias(Frame& F) {
    const int gt = (F.wg * NWAVES + F.wave) * 64 + F.lane, NGT = F.G * NTHR;
    for (int i = gt; i < 2 * NWP; i += NGT) {
        const int l = i / NWP, r = i % NWP; float v = 0.f;
        int n = -1;
        if (r < 1152) n = r; else if (r < 1168) n = 3712 + (r - 1152); else if (r < 1280) n = -1; else if (r < 2816) n = 1152 + (r - 1280); else if (r < 3840) n = 2688 + (r - 2816); else n = 3728 + (r - 3840);
        if (n >= 0) v = inp(F, I_BIN)[l * NIN + n];
        WSP(float, WS_BIAS)[i] = v;
    }
}

__device__ __forceinline__ void norm_mod_row(const GAS float* xrow, const GAS float* g, const GAS float* shift, const GAS float* scale, GAS bf16* orow, int lane, float* keep  ) {
    f32x4 v[4]; float s = 0.f;
#pragma unroll
    for (int j = 0; j < 4; ++j) { v[j] = *(const GAS f32x4*)(xrow + 256 * j + 4 * lane); s += (v[j].x * v[j].x + v[j].y * v[j].y) + (v[j].z * v[j].z + v[j].w * v[j].w); }
    const float r = rsqrtf(wave_sum(s) * (1.0f / 1024.0f) + 1e-6f);
#pragma unroll
    for (int j = 0; j < 4; ++j) {
        const f32x4 gg = *(const GAS f32x4*)(g + 256 * j + 4 * lane), sh = *(const GAS f32x4*)(shift + 256 * j + 4 * lane), sc = *(const GAS f32x4*)(scale + 256 * j + 4 * lane);
        f32x4 o;
        o.x = (v[j].x * r * gg.x) * (1.f + sc.x) + sh.x; o.y = (v[j].y * r * gg.y) * (1.f + sc.y) + sh.y;
        o.z = (v[j].z * r * gg.z) * (1.f + sc.z) + sh.z; o.w = (v[j].w * r * gg.w) * (1.f + sc.w) + sh.w;
        if (keep) { keep[4 * j + 0] = o.x; keep[4 * j + 1] = o.y; keep[4 * j + 2] = o.z; keep[4 * j + 3] = o.w; }
        u32x2 w; w.x = pk2(o.x, o.y); w.y = pk2(o.z, o.w);
        *(GAS u32x2*)(orow + 256 * j + 4 * lane) = w;
    }
}
__device__ __forceinline__ const GAS float* xrow_ptr(const Frame& F, int row, bool from_input) {
    if (row < TOKL) return (from_input ? inp(F, I_X) : outp(F)) + (size_t)row * D;
    return (from_input ? inp(F, I_CTX) : WSP(const float, WS_XC)) + (size_t)(row - TOKL) * D;
}
__device__ __forceinline__ void phase_norm(Frame& F, int layer, int nrows, bool from_input, int which) {
    const int gw = F.wg * NWAVES + F.wave, NGW = F.G * NWAVES;
    const GAS float* g = inp(F, which == 0 ? I_GMIX : I_GFFN) + layer * D;
    for (int row = gw; row < nrows; row += NGW)
        norm_mod_row(xrow_ptr(F, row, from_input), g, mod_ptr(F, layer, row, which), mod_ptr(F, layer, row, which + 1), WSP(bf16, WS_H) + (size_t)row * D, F.lane, nullptr);
}

namespace pg8 {
constexpr int BM = 256, BK = 64, HALF = 128, HTB = HALF * BK * 2, STAGE_BYTES = 8 * HTB, NXCD = 8, WGM = 8;
__device__ __forceinline__ int lds_byte(int r, int c) { const int st = (r >> 4) * 2 + (c >> 5), rr = r & 15, cc = c & 31, ob = rr * 64 + cc * 2; return st * 1024 + (ob ^ (((ob >> 9) & 1) << 5)); }
__device__ __forceinline__ void stage_rc(int b, int& R, int& C) { const int st = b / 1024, sb = b % 1024, swz = sb ^ (((sb >> 9) & 1) << 5); R = (st >> 1) * 16 + swz / 64; C = (st & 1) * 32 + (swz % 64) / 2; }
struct Unit { int pm, pn; };
struct OrderPlain {
    static constexpr bool GATHER = false;
    int nM, nN, nwg, G, c;
    __device__ __forceinline__ void init(int nM_, int nN_, int G_, int c_) { nM = nM_; nN = nN_; nwg = nM * nN; G = G_; c = c_; }
    __device__ __forceinline__ bool next(int i, Unit& u) const {
        const long L = (long)i * G + c; if (L >= nwg) return false;
        int wgid = (int)L; { const int q = nwg / NXCD, r = nwg % NXCD, xcd = wgid % NXCD, off = wgid / NXCD; wgid = (xcd < r ? xcd * (q + 1) : r * (q + 1) + (xcd - r) * q) + off; }
        const int nig = WGM * nN, gid = wgid / nig, fm = gid * WGM, gsz = (nM - fm) < WGM ? (nM - fm) : WGM;
        u.pm = fm + ((wgid % nig) % gsz); u.pn = (wgid % nig) / gsz; return true;
    }
    __device__ __forceinline__ int arow(int r) const { return r; }
    __device__ __forceinline__ size_t boff(const Unit&) const { return 0; }
};
struct OrderMoe {
    static constexpr bool GATHER = true;
    OrderPlain o; const GAS int* rowidx; const GAS int* tilee; int t0; size_t bstride; bool gather;
    __device__ __forceinline__ bool next(int i, Unit& u) const { return o.next(i, u); }
    __device__ __forceinline__ int arow(int r) const { return gather ? rowidx[t0 * 256 + r] : r; }
    __device__ __forceinline__ size_t boff(const Unit& u) const { return (size_t)tilee[t0 + u.pm] * bstride; }
};

template <class Epi, class Sched>
__device__ __forceinline__ void gemm_phase(LAS unsigned char* lds, int tid_in, const GAS bf16* A, int lda, const GAS bf16* Bt, int ldb, int K, const Sched& S, const Epi& E) {
    unsigned tid_u = (unsigned)tid_in; asm volatile("" : "+v"(tid_u));
    const int tid = (int)tid_u, wid = __builtin_amdgcn_readfirstlane(tid >> 6), lane = tid & 63, wr = wid >> 2, wc = wid & 3, fr = lane & 15, fq = lane >> 4;
    const int nt = K / BK;
    unsigned voffB[2];
    { int sR[2], sC[2];
#pragma unroll
      for (int i = 0; i < 2; ++i) { stage_rc(tid * 16 + i * 8192, sR[i], sC[i]); voffB[i] = (unsigned)(sR[i] * ldb + sC[i]) * 2u; } }
#define PG8_GATHER_OFFS(pm_) do { unsigned _t = (unsigned)tid; asm volatile("" : "+v"(_t)); _Pragma("unroll") for (int i = 0; i < 2; ++i) { int _R, _C; stage_rc((int)_t * 16 + i * 8192, _R, _C); \
        vc0[i] = (unsigned)((size_t)S.arow((pm_) * BM + _R) * lda + _C) * 2u; vc1[i] = (unsigned)((size_t)S.arow((pm_) * BM + HALF + _R) * lda + _C) * 2u; } } while (0)
    const size_t kstep = (size_t)(BK * 2);
    const size_t hstepB = (size_t)HALF * ldb * 2, tstepB = 2 * hstepB;
    const unsigned ldsw = (unsigned)wid * 1024u;
    const int aoff = lds_byte(wr * 64 + fr, fq * 8), boff = lds_byte(wc * 32 + fr, fq * 8);
#define PG8_SA(b, h) (((b) * 2 + (h)) * HTB)
#define PG8_SB(b, h) ((4 + (b) * 2 + (h)) * HTB)
#define PG8_STAGE2(bufoff, gbase, v0, v1) do { \
        __builtin_amdgcn_global_load_lds((const GAS unsigned*)((const GAS char*)(gbase) + (v0)), (LAS unsigned*)(lds + (bufoff) + ldsw), 16, 0, 0); \
        __builtin_amdgcn_global_load_lds((const GAS unsigned*)((const GAS char*)(gbase) + (v1)), (LAS unsigned*)(lds + (bufoff) + ldsw + 8192), 16, 0, 0); } while (0)
#define PG8_STAGEB(bufoff, gbase) PG8_STAGE2(bufoff, gbase, voffB[0], voffB[1])
#define PG8_LDA(dst, b, h) do { _Pragma("unroll") for (int m = 0; m < 4; ++m) _Pragma("unroll") for (int k = 0; k < 2; ++k) dst[m][k] = *(const LAS bf16x8*)(lds + PG8_SA(b, h) + aoff + m * 2048 + k * 1024); } while (0)
#define PG8_LDB(dst, b, h) do { _Pragma("unroll") for (int n = 0; n < 2; ++n) _Pragma("unroll") for (int k = 0; k < 2; ++k) dst[n][k] = *(const LAS bf16x8*)(lds + PG8_SB(b, h) + boff + n * 2048 + k * 1024); } while (0)
#define PG8_MMA(ai, bj, At, Bt_) do { __builtin_amdgcn_s_setprio(1); _Pragma("unroll") for (int m = 0; m < 4; ++m) _Pragma("unroll") for (int n = 0; n < 2; ++n) _Pragma("unroll") for (int k = 0; k < 2; ++k) \
        acc[ai][bj][m][n] = __builtin_amdgcn_mfma_f32_16x16x32_bf16(Bt_[n][k], At[m][k], acc[ai][bj][m][n], 0, 0, 0); __builtin_amdgcn_s_setprio(0); } while (0)
#define PG8_WAIT_V(n) asm volatile("s_waitcnt vmcnt(" #n ")" ::: "memory")
#define PG8_WAIT_L(n) asm volatile("s_waitcnt lgkmcnt(" #n ")" ::: "memory")
#define PG8_BAR __builtin_amdgcn_s_barrier()
#define PG8_SCHED __builtin_amdgcn_sched_barrier(0)
    Unit cur, nxt; int ui = 0;
    if (!S.next(0, cur)) return;
    f32x4 acc[2][2][4][2];
#pragma unroll
    for (int a = 0; a < 2; ++a)
#pragma unroll
        for (int b = 0; b < 2; ++b)
#pragma unroll
            for (int m = 0; m < 4; ++m)
#pragma unroll
                for (int n = 0; n < 2; ++n) { float zf; asm volatile("v_mov_b32 %0, 0" : "=v"(zf)); acc[a][b][m][n] = (f32x4){zf, zf, zf, zf}; }
    bf16x8 At[4][2], B0[2][2], B1[2][2];
    constexpr bool GA = Sched::GATHER;
    const size_t hstepA = GA ? 0 : (size_t)HALF * lda * 2, tstepA = (size_t)BM * lda * 2;
    unsigned vc0[2], vc1[2];
    if constexpr (GA) { PG8_GATHER_OFFS(cur.pm); }
    else { int sR, sC;
#pragma unroll
        for (int i = 0; i < 2; ++i) { stage_rc(tid * 16 + i * 8192, sR, sC); vc0[i] = (unsigned)(sR * lda + sC) * 2u; vc1[i] = 0u; } }
#define VC0(i) vc0[i]
#define VC1(i) (GA ? vc1[i] : vc0[i])
#define VN0(i) vc0[i]
#define VN1(i) VC1(i)
    const GAS char* cA = GA ? (const GAS char*)A : (const GAS char*)A + (size_t)cur.pm * tstepA;
    const GAS char* cB = (const GAS char*)Bt + S.boff(cur) * 2 + (size_t)cur.pn * tstepB;
    PG8_STAGEB(PG8_SB(0, 0), cB); PG8_STAGE2(PG8_SA(0, 0), cA, VC0(0), VC0(1)); PG8_STAGEB(PG8_SB(0, 1), cB + hstepB); PG8_STAGE2(PG8_SA(0, 1), cA + hstepA, VC1(0), VC1(1));
    if (wr == 1) PG8_BAR;
    PG8_WAIT_V(4); PG8_BAR;
    PG8_STAGEB(PG8_SB(1, 0), cB + kstep); PG8_STAGE2(PG8_SA(1, 0), cA + kstep, VC0(0), VC0(1)); PG8_STAGEB(PG8_SB(1, 1), cB + hstepB + kstep);
    PG8_WAIT_V(6); PG8_BAR;
    for (;;) {
        const bool has_next = S.next(ui + 1, nxt);
        const GAS char* nB = cB; const GAS char* nA = cA;
        if (has_next) {
            nB = (const GAS char*)Bt + S.boff(nxt) * 2 + (size_t)nxt.pn * tstepB;
            if constexpr (!GA) nA = (const GAS char*)A + (size_t)nxt.pm * tstepA;
        }
        for (int t = 0; t < nt; t += 2) {
            const bool last = (t == nt - 2);
            if constexpr (Epi::HORNER) {
                if (t == 6 || t == 12) {
                    asm volatile("" ::: "memory");
                    const int seg = (t == 6) ? 0 : 1;
                    int hpm = cur.pm, hpn = cur.pn; asm volatile("" : "+s"(hpm), "+s"(hpn));
                    unsigned hln = (unsigned)lane; asm volatile("" : "+v"(hln)); const int hfr = (int)(hln & 15u), hfq = (int)(hln >> 4);
#pragma unroll
                    for (int ai = 0; ai < 2; ++ai) {
                        u32x2 ga[4][2][2], gb[4][2][2];
#pragma unroll
                        for (int m = 0; m < 4; ++m)
#pragma unroll
                            for (int bj = 0; bj < 2; ++bj)
#pragma unroll
                                for (int n = 0; n < 2; ++n) {
                                    const int row = hpm * BM + ai * HALF + wr * 64 + m * 16 + hfr, col = hpn * BM + bj * HALF + wc * 32 + n * 16 + 4 * hfq;
                                    ga[m][bj][n] = E.gate(seg, row, col); gb[m][bj][n] = E.gate(seg + 1, row, col);
                                }
                        asm volatile("" : "+v"(ga[0][0][0]), "+v"(ga[0][0][1]), "+v"(ga[0][1][0]), "+v"(ga[0][1][1]), "+v"(ga[1][0][0]), "+v"(ga[1][0][1]), "+v"(ga[1][1][0]), "+v"(ga[1][1][1]),
                                          "+v"(ga[2][0][0]), "+v"(ga[2][0][1]), "+v"(ga[2][1][0]), "+v"(ga[2][1][1]), "+v"(ga[3][0][0]), "+v"(ga[3][0][1]), "+v"(ga[3][1][0]), "+v"(ga[3][1][1]) :: "memory");
                        asm volatile("" : "+v"(gb[0][0][0]), "+v"(gb[0][0][1]), "+v"(gb[0][1][0]), "+v"(gb[0][1][1]), "+v"(gb[1][0][0]), "+v"(gb[1][0][1]), "+v"(gb[1][1][0]), "+v"(gb[1][1][1]),
                                          "+v"(gb[2][0][0]), "+v"(gb[2][0][1]), "+v"(gb[2][1][0]), "+v"(gb[2][1][1]), "+v"(gb[3][0][0]), "+v"(gb[3][0][1]), "+v"(gb[3][1][0]), "+v"(gb[3][1][1]) :: "memory");
#pragma unroll
                        for (int m = 0; m < 4; ++m)
#pragma unroll
                            for (int bj = 0; bj < 2; ++bj)
#pragma unroll
                                for (int n = 0; n < 2; ++n) {
                                    const u32x2 a = ga[m][bj][n], b = gb[m][bj][n];
                                    f32x4& v = acc[ai][bj][m][n];
                                    v.x *= __uint_as_float(a.x << 16) * __builtin_amdgcn_rcpf(__uint_as_float(b.x << 16));
                                    v.y *= __uint_as_float(a.x & 0xffff0000u) * __builtin_amdgcn_rcpf(__uint_as_float(b.x & 0xffff0000u));
                                    v.z *= __uint_as_float(a.y << 16) * __builtin_amdgcn_rcpf(__uint_as_float(b.y << 16));
                                    v.w *= __uint_as_float(a.y & 0xffff0000u) * __builtin_amdgcn_rcpf(__uint_as_float(b.y & 0xffff0000u));
                                }
                    }
                    asm volatile("s_waitcnt vmcnt(0)" ::: "memory");
                }
            }
            const GAS char* a1 = cA + (size_t)(t + 1) * kstep;
            const GAS char* a2 = last ? nA : cA + (size_t)(t + 2) * kstep; const GAS char* b2 = last ? nB : cB + (size_t)(t + 2) * kstep;
            const GAS char* a3 = a2 + kstep; const GAS char* b3 = b2 + kstep;
            PG8_LDB(B0, 0, 0); PG8_SCHED; PG8_LDA(At, 0, 0); PG8_STAGE2(PG8_SA(1, 1), a1 + hstepA, VC1(0), VC1(1));
            if constexpr (GA) { if (last && has_next) { asm volatile("" ::: "memory"); PG8_GATHER_OFFS(nxt.pm); asm volatile("" ::: "memory"); } }
            PG8_WAIT_L(8); PG8_BAR; PG8_WAIT_L(0); PG8_MMA(0, 0, At, B0); PG8_BAR; PG8_SCHED;
            PG8_LDB(B1, 0, 1); PG8_STAGEB(PG8_SB(0, 0), b2);
            PG8_BAR; PG8_WAIT_L(0); PG8_MMA(0, 1, At, B1); PG8_BAR;
            PG8_LDA(At, 0, 1); PG8_STAGE2(PG8_SA(0, 0), a2, VN0(0), VN0(1));
            PG8_BAR; PG8_WAIT_L(0); PG8_MMA(1, 0, At, B0); PG8_BAR; PG8_SCHED;
            PG8_STAGEB(PG8_SB(0, 1), b2 + hstepB);
            PG8_WAIT_V(6); PG8_BAR; PG8_MMA(1, 1, At, B1); PG8_BAR;
            PG8_LDB(B0, 1, 0); PG8_SCHED; PG8_LDA(At, 1, 0); PG8_STAGE2(PG8_SA(0, 1), a2 + hstepA, VN1(0), VN1(1));
            PG8_WAIT_L(8); PG8_BAR; PG8_WAIT_L(0); PG8_MMA(0, 0, At, B0); PG8_BAR; PG8_SCHED;
            PG8_LDB(B1, 1, 1); PG8_STAGEB(PG8_SB(1, 0), b3);
            PG8_BAR; PG8_WAIT_L(0); PG8_MMA(0, 1, At, B1); PG8_BAR;
            PG8_LDA(At, 1, 1); PG8_STAGE2(PG8_SA(1, 0), a3, VN0(0), VN0(1));
            PG8_BAR; PG8_WAIT_L(0); PG8_MMA(1, 0, At, B0); PG8_BAR; PG8_SCHED;
            PG8_STAGEB(PG8_SB(1, 1), b3 + hstepB);
            PG8_WAIT_V(6); PG8_BAR; PG8_MMA(1, 1, At, B1); PG8_BAR;
        }
        {
            int epm = cur.pm, epn = cur.pn; asm volatile("" : "+s"(epm), "+s"(epn));
            unsigned eln = (unsigned)lane; asm volatile("" : "+v"(eln)); const int efr = (int)(eln & 15u), efq = (int)(eln >> 4);
            f32x4 cv[2][2];
#pragma unroll
            for (int bj = 0; bj < 2; ++bj)
#pragma unroll
                for (int n = 0; n < 2; ++n) { if constexpr (Epi::COLVEC) cv[bj][n] = E.colvec(epm * BM, epn * BM + bj * HALF + wc * 32 + n * 16 + 4 * efq); else cv[bj][n] = (f32x4){0.f, 0.f, 0.f, 0.f}; }
            if constexpr (Epi::COLVEC) asm volatile("" : "+v"(cv[0][0]), "+v"(cv[0][1]), "+v"(cv[1][0]), "+v"(cv[1][1]) :: "memory");
#pragma unroll
            for (int ai = 0; ai < 2; ++ai) {
                f32x4 bs[4][2][2];
                if constexpr (Epi::BASE) {
#pragma unroll
                    for (int m = 0; m < 4; ++m)
#pragma unroll
                        for (int bj = 0; bj < 2; ++bj)
#pragma unroll
                            for (int n = 0; n < 2; ++n) bs[m][bj][n] = E.base(epm * BM + ai * HALF + wr * 64 + m * 16 + efr, epn * BM + bj * HALF + wc * 32 + n * 16 + 4 * efq);
                    asm volatile("" : "+v"(bs[0][0][0]), "+v"(bs[0][0][1]), "+v"(bs[0][1][0]), "+v"(bs[0][1][1]), "+v"(bs[1][0][0]), "+v"(bs[1][0][1]), "+v"(bs[1][1][0]), "+v"(bs[1][1][1]),
                                      "+v"(bs[2][0][0]), "+v"(bs[2][0][1]), "+v"(bs[2][1][0]), "+v"(bs[2][1][1]), "+v"(bs[3][0][0]), "+v"(bs[3][0][1]), "+v"(bs[3][1][0]), "+v"(bs[3][1][1]) :: "memory");
                }
#pragma unroll
                for (int m = 0; m < 4; ++m) {
                    const int row = epm * BM + ai * HALF + wr * 64 + m * 16 + efr;
#pragma unroll
                    for (int bj = 0; bj < 2; ++bj) {
                        if constexpr (Epi::PAIR) E.store_pair(row, epn * (BM / 2) + bj * (HALF / 2) + wc * 16 + 4 * efq, acc[ai][bj][m][0], acc[ai][bj][m][1]);
                        else {
#pragma unroll
                            for (int n = 0; n < 2; ++n) { f32x4 bb = (f32x4){0.f, 0.f, 0.f, 0.f}; if constexpr (Epi::BASE) bb = bs[m][bj][n]; E.store(row, epn * BM + bj * HALF + wc * 32 + n * 16 + 4 * efq, acc[ai][bj][m][n], cv[bj][n], bb); }
                        }
                    }
                }
            }
        }
        if (!has_next) break;
#pragma unroll
        for (int a = 0; a < 2; ++a)
#pragma unroll
            for (int b = 0; b < 2; ++b)
#pragma unroll
                for (int m = 0; m < 4; ++m)
#pragma unroll
                    for (int n = 0; n < 2; ++n) { float zf; asm volatile("v_mov_b32 %0, 0" : "=v"(zf)); acc[a][b][m][n] = (f32x4){zf, zf, zf, zf}; }
        cur = nxt; cB = nB; cA = nA; ++ui;
    }
    PG8_WAIT_V(0);
    if (wr == 0) PG8_BAR;
    PG8_BAR;
#undef PG8_GATHER_OFFS
#undef VC0
#undef VC1
#undef VN0
#undef VN1
#undef PG8_SA
#undef PG8_SB
#undef PG8_STAGE2
#undef PG8_STAGEB
#undef PG8_LDA
#undef PG8_LDB
#undef PG8_MMA
#undef PG8_WAIT_V
#undef PG8_WAIT_L
#undef PG8_BAR
#undef PG8_SCHED
}
}

template <class Epi>
__device__ __forceinline__ void gemm_fast(Frame& F, const GAS bf16* A, int lda, const GAS bf16* Bt, int ldb, int K, int M, int N, const Epi& E) {
    pg8::OrderPlain S; S.init(M / 256, N / 256, F.G, F.wg);
    pg8::gemm_phase(F.lds, F.tid, A, lda, Bt, ldb, K, S, E);
}
#ifndef FAST_PLAIN
#define FAST_PLAIN 1
#endif
#ifndef FAST_HORNER
#define FAST_HORNER 1
#endif
#ifndef FAST_MOE
#define FAST_MOE 1
#endif

__device__ __forceinline__ void st_bf16x4(GAS bf16* p, f32x4 v) { u32x2 w; w.x = pk2(v.x, v.y); w.y = pk2(v.z, v.w); *(GAS u32x2*)p = w; }
__device__ __forceinline__ f32x4 ld_bf16x4(const GAS bf16* p) { const u32x2 w = *(const GAS u32x2*)p; f32x4 v; v.x = __uint_as_float(w.x << 16); v.y = __uint_as_float(w.x & 0xffff0000u); v.z = __uint_as_float(w.y << 16); v.w = __uint_as_float(w.y & 0xffff0000u); return v; }

struct EpiWin {
    static constexpr bool HORNER = false, PAIR = false, COLVEC = true, BASE = false;
    const GAS float* bias; GAS bf16 *hytl, *hytc, *ret, *ml; GAS float* mlg;
    __device__ __forceinline__ f32x4 colvec(int, int col) const { return *(const GAS f32x4*)(bias + col); }
    __device__ __forceinline__ void store(int row, int col, f32x4 v, f32x4 cv, f32x4) const {
        v += cv;
        if (col < 1152) {
            if (row < TOKL) { const int b = row >> 11, t = row & 2047; GAS bf16* d = hytl + ((size_t)(b * 1152 + col)) * 2048 + t;
                d[0] = (bf16)f2bf(v.x); d[2048] = (bf16)f2bf(v.y); d[4096] = (bf16)f2bf(v.z); d[6144] = (bf16)f2bf(v.w); }
            else { const int r = row - TOKL, b = r >> 8, t = r & 255; GAS bf16* d = hytc + ((size_t)(b * 1152 + col)) * 256 + t;
                d[0] = (bf16)f2bf(v.x); d[256] = (bf16)f2bf(v.y); d[512] = (bf16)f2bf(v.z); d[768] = (bf16)f2bf(v.w); }
        } else if (col < 1168) { *(GAS f32x4*)(mlg + (size_t)row * 16 + (col - 1152)) = v; }
        else if (col < 1280) { }
        else if (col < 2816) st_bf16x4(ret + (size_t)row * 1536 + (col - 1280), v);
        else st_bf16x4(ml + (size_t)row * 1024 + (col - 2816), v);
    }
};
struct EpiGate {
    static constexpr bool HORNER = false, PAIR = false, COLVEC = true, BASE = false;
    const GAS float* bias; GAS bf16* gates;
    __device__ __forceinline__ f32x4 colvec(int, int col) const { return *(const GAS f32x4*)(bias + col); }
    __device__ __forceinline__ void store(int row, int col, f32x4 v, f32x4 cv, f32x4) const {
        v += cv;
        f32x4 g; g.x = fmaxf(sigmoidf_(v.x), 1e-20f); g.y = fmaxf(sigmoidf_(v.y), 1e-20f); g.z = fmaxf(sigmoidf_(v.z), 1e-20f); g.w = fmaxf(sigmoidf_(v.w), 1e-20f);
        st_bf16x4(gates + (size_t)row * NGATE + col, g);
    }
};
struct EpiUp {
    static constexpr bool HORNER = true, PAIR = false, COLVEC = false, BASE = true;
    const GAS bf16* gates; GAS bf16* acc_out;
    __device__ __forceinline__ u32x2 gate(int which, int row, int col) const { return *(const GAS u32x2*)(gates + (size_t)row * NGATE + which * 1024 + col); }
    __device__ __forceinline__ f32x4 base(int row, int col) const { return ld_bf16x4(gates + (size_t)row * NGATE + 2048 + col); }
    __device__ __forceinline__ void store(int row, int col, f32x4 v, f32x4, f32x4 g) const { st_bf16x4(acc_out + (size_t)row * D + col, v * g); }
};
struct EpiResid {
    static constexpr bool HORNER = false, PAIR = false, COLVEC = true, BASE = true;
    const GAS float *xin_l, *xin_c; GAS float *xout_l, *xout_c; const GAS float* modbase; int which;
    __device__ __forceinline__ f32x4 colvec(int row0, int col) const { const int r = row0 < TOKL ? (row0 >> 11) : 16; return *(const GAS f32x4*)(modbase + ((size_t)r * 6 + which) * 1024 + col); }
    __device__ __forceinline__ f32x4 base(int row, int col) const { return row < TOKL ? *(const GAS f32x4*)(xin_l + (size_t)row * D + col) : *(const GAS f32x4*)(xin_c + (size_t)(row - TOKL) * D + col); }
    __device__ __forceinline__ void store(int row, int col, f32x4 v, f32x4 m, f32x4 x) const {
        if (row < TOKL) *(GAS f32x4*)(xout_l + (size_t)row * D + col) = x + m * v;
        else *(GAS f32x4*)(xout_c + (size_t)(row - TOKL) * D + col) = x + m * v;
    }
};
struct EpiSwiglu {
    static constexpr bool HORNER = false, PAIR = true, COLVEC = false, BASE = false;
    GAS bf16* act; int row_off;
    __device__ __forceinline__ void store_pair(int row, int col, f32x4 a, f32x4 b) const {
        f32x4 o; o.x = siluf_(a.x) * b.x; o.y = siluf_(a.y) * b.y; o.z = siluf_(a.z) * b.z; o.w = siluf_(a.w) * b.w;
        st_bf16x4(act + (size_t)(row - row_off) * DFF + col, o);
    }
    __device__ __forceinline__ void store(int, int, f32x4, f32x4, f32x4) const {}
};
struct EpiBf16Out {
    static constexpr bool HORNER = false, PAIR = false, COLVEC = false, BASE = false;
    GAS bf16* out; int ld; int row_add;
    __device__ __forceinline__ void store(int row, int col, f32x4 v, f32x4, f32x4) const { st_bf16x4(out + (size_t)(row + row_add) * ld + col, v); }
    __device__ __forceinline__ void store_pair(int, int, f32x4, f32x4) const {}
};

constexpr int ZPITCH_L = (LL + 8) * 2, ZPITCH_C = (LC + 8) * 2;
template <int L>
__device__ __forceinline__ float conv3_at(const GAS bf16* base  , int t, float w0, float w1, float w2) {
    const float a = t > 0 ? bf2f(base[t - 1]) : 0.f, b = bf2f(base[t]), c = t < L - 1 ? bf2f(base[t + 1]) : 0.f;
    return w0 * a + w1 * b + w2 * c;
}
template <int L>
__device__ __forceinline__ void hyena_unit_naive(Frame& F, int layer, int c, const GAS bf16* hyt  , const GAS bf16* ft  , GAS bf16* yht  ) {
    constexpr int ZP = (L + 8) * 2;
    constexpr int PER = L / 32;
    constexpr int SUB = 8;
    LAS unsigned char* zimg0 = F.lds;
    LAS unsigned char* zimg1 = F.lds + 16 * ZP;
    LAS bf16* tf = (LAS bf16*)(F.lds + 32 * ZP);
    const GAS float* cw = inp(F, I_HYCONV) + layer * 3 * 1152;
    const GAS float* skip = inp(F, I_HYSKIP) + layer * 2 * 384;
    __syncthreads();
    {
        const int b = F.tid >> 5, seg = F.tid & 31; const GAS bf16* src = hyt + ((size_t)(b * 1152 + c)) * L;
        const float w0 = cw[c], w1 = cw[1152 + c], w2 = cw[2304 + c];
#pragma unroll 2
        for (int j = 0; j < PER; ++j) { const int t = seg * PER + j; *(LAS bf16*)(zimg0 + b * ZP + t * 2) = (bf16)f2bf(conv3_at<L>(src, t, w0, w1, w2)); }
    }
#pragma unroll 1
    for (int o = 0; o < 2; ++o) {
        LAS unsigned char* zs = o == 0 ? zimg0 : zimg1;
        LAS unsigned char* zd = o == 0 ? zimg1 : zimg0;
        const GAS bf16* fsrc = ft + ((size_t)(o * 384 + c)) * (2 * L);
        for (int i = F.tid; i < 2 * L; i += NTHR) tf[i] = i == 0 ? (bf16)0 : fsrc[i];
        __syncthreads();
        const int b = F.tid & 15, tg = F.tid >> 4;
        const int gcol = (o == 0 ? 384 : 768) + c;
        const GAS bf16* gsrc = hyt + ((size_t)(b * 1152 + gcol)) * L;
        const float w0 = cw[gcol], w1 = cw[1152 + gcol], w2 = cw[2304 + gcol], sk = skip[o * 384 + c];
#pragma unroll 1
        for (int sb = 0; sb < PER / SUB; ++sb) {
            const int t0 = tg * PER + sb * SUB;
            float acc[SUB];
#pragma unroll
            for (int j = 0; j < SUB; ++j) acc[j] = 0.f;
#pragma unroll 1
            for (int s0 = 0; s0 < L; s0 += 8) {
                float z[8];
                { const bf16x8 zz = *(const LAS bf16x8*)(zs + b * ZP + s0 * 2);
#pragma unroll
                  for (int i = 0; i < 8; ++i) z[i] = bf2f((bf16)zz[i]); }
                float win[SUB + 7];
                const int wb = L + s0 - t0 - (SUB - 1);
#pragma unroll
                for (int i = 0; i < SUB + 7; ++i) win[i] = bf2f(tf[wb + i]);
#pragma unroll
                for (int j = 0; j < SUB; ++j)
#pragma unroll
                    for (int i = 0; i < 8; ++i) acc[j] += win[(SUB - 1) - j + i] * z[i];
            }
#pragma unroll
            for (int j = 0; j < SUB; ++j) {
                const int t = t0 + j;
                const float zt = bf2f(*(LAS bf16*)(zs + b * ZP + t * 2));
                const float ov = conv3_at<L>(gsrc, t, w0, w1, w2) * (acc[j] + sk * zt);
                *(LAS bf16*)(zd + b * ZP + t * 2) = (bf16)f2bf(ov);
            }
        }
        __syncthreads();
    }
#pragma unroll 2
    for (int i = F.tid; i < 16 * (L / 8); i += NTHR) {
        const int b = i / (L / 8), ch = i % (L / 8);
        *(GAS u32x4*)(yht + ((size_t)(b * 384 + c)) * L + ch * 8) = *(const LAS u32x4*)(zimg0 + b * ZP + ch * 16);
    }
}

template <int L>
__device__ __forceinline__ void hyena_unit_fast(Frame& F, int layer, int c, const GAS bf16* hyt  , const GAS bf16* ft  , GAS bf16* yht  ) {
    constexpr int ZP = (L + 8) * 2;
    constexpr int PER = L / 32;
    constexpr int I = L / 128;
    constexpr int SPAN = L / 4, NSTEP = L / 32;
    constexpr int CP = (2 * L + 8) * 2;
    LAS unsigned char* zimg = F.lds;
    LAS unsigned char* cpy = F.lds + 16 * ZP;
    const GAS float* cw = inp(F, I_HYCONV) + layer * 3 * 1152;
    const GAS float* skip = inp(F, I_HYSKIP) + layer * 2 * 384;
    const int lane = F.lane, fr = lane & 15, fq = lane >> 4, w = F.wave;
    { unsigned long long a_ = (unsigned long long)hyt, b_ = (unsigned long long)yht; asm volatile("" : "+s"(a_), "+s"(b_)); hyt = (const GAS bf16*)a_; yht = (GAS bf16*)b_; }
    __syncthreads();
    {
        const int b = F.tid >> 5, sg = F.tid & 31, t0 = sg * PER; const GAS bf16* src = hyt + ((size_t)(b * 1152 + c)) * L + t0;
        const float w0 = cw[c], w1 = cw[1152 + c], w2 = cw[2304 + c];
        u32x4 raw[PER / 8];
#pragma unroll
        for (int j = 0; j < PER / 8; ++j) raw[j] = *(const GAS u32x4*)(src + 8 * j);
        float prev = t0 > 0 ? bf2f(src[-1]) : 0.f;
        const float nextv = t0 + PER < L ? bf2f(src[PER]) : 0.f;
#pragma unroll
        for (int j = 0; j < PER / 8; ++j) {
            const unsigned wv[4] = {raw[j].x, raw[j].y, raw[j].z, raw[j].w};
            float x[10]; x[0] = prev;
#pragma unroll
            for (int q = 0; q < 4; ++q) { x[1 + 2 * q] = __uint_as_float(wv[q] << 16); x[2 + 2 * q] = __uint_as_float(wv[q] & 0xffff0000u); }
            if (j + 1 < PER / 8) x[9] = __uint_as_float(raw[(j + 1 < PER / 8) ? j + 1 : j].x << 16); else x[9] = nextv;
            u32x4 o;
            o.x = pk2(w0 * x[0] + w1 * x[1] + w2 * x[2], w0 * x[1] + w1 * x[2] + w2 * x[3]); o.y = pk2(w0 * x[2] + w1 * x[3] + w2 * x[4], w0 * x[3] + w1 * x[4] + w2 * x[5]);
            o.z = pk2(w0 * x[4] + w1 * x[5] + w2 * x[6], w0 * x[5] + w1 * x[6] + w2 * x[7]); o.w = pk2(w0 * x[6] + w1 * x[7] + w2 * x[8], w0 * x[7] + w1 * x[8] + w2 * x[9]);
            *(LAS u32x4*)(zimg + b * ZP + (t0 + 8 * j) * 2) = o;
            prev = x[8];
        }
    }
    const int tbase = SPAN * (w >> 1) + 16 * (w & 1);
    const int flane = L - tbase + 8 * fq - fr;
    const int msh = fr & 7;
    const LAS unsigned char* fbase = cpy + msh * CP + 2 * (flane + msh);
#pragma unroll 1
    for (int o = 0; o < 2; ++o) {
        const GAS bf16* fsrc = ft + ((size_t)(o * 384 + c)) * (2 * L);
        for (int i = F.tid; i < CP / 16; i += NTHR) { u32x4 v = (u32x4){0u, 0u, 0u, 0u}; if (i < 2 * L / 8) v = *(const GAS u32x4*)(fsrc + 8 * i); if (i == 0) v.x &= 0xffff0000u; *(LAS u32x4*)(cpy + 16 * i) = v; }
        __syncthreads();
        for (int task = F.tid; task < 7 * (CP / 16); task += NTHR) {
            const int m = 1 + task / (CP / 16), x8 = task % (CP / 16);
            unsigned short e[8];
#pragma unroll
            for (int i = 0; i < 8; ++i) { const int idx = 8 * x8 - m + i; e[i] = idx >= 0 ? *(const LAS unsigned short*)(cpy + 2 * idx) : (unsigned short)0; }
            u32x4 v; v.x = e[0] | ((unsigned)e[1] << 16); v.y = e[2] | ((unsigned)e[3] << 16); v.z = e[4] | ((unsigned)e[5] << 16); v.w = e[6] | ((unsigned)e[7] << 16);
            *(LAS u32x4*)(cpy + m * CP + 16 * x8) = v;
        }
        __syncthreads();
        f32x4 acc[I];
#pragma unroll
        for (int i = 0; i < I; ++i) acc[i] = (f32x4){0.f, 0.f, 0.f, 0.f};
        bf16x8 ring[I];
#pragma unroll
        for (int i = 1; i < I; ++i) ring[(I - i) % I] = *(const LAS bf16x8*)(fbase - 64 * i);
        bf16x8 nf = *(const LAS bf16x8*)(fbase);
        const LAS unsigned char* zrow = zimg + fr * ZP + 16 * fq;
#pragma unroll 1
        for (int j0 = 0; j0 < NSTEP; j0 += I) {
#pragma unroll
            for (int jj = 0; jj < I; ++jj) {
                const int j = j0 + jj;
                ring[jj] = nf;
                if (j + 1 < NSTEP) nf = *(const LAS bf16x8*)(fbase + 64 * (j + 1));
                const bf16x8 zf = *(const LAS bf16x8*)(zrow + 64 * j);
#pragma unroll
                for (int i = 0; i < I; ++i) acc[i] = __builtin_amdgcn_mfma_f32_16x16x32_bf16(ring[(jj - i + I) % I], zf, acc[i], 0, 0, 0);
            }
        }
        unsigned el_ = (unsigned)lane; asm volatile("" : "+v"(el_)); const int efr = (int)(el_ & 15u), efq = (int)(el_ >> 4);
        const int etb = SPAN * (w >> 1) + 16 * (w & 1);
        const int gcol = (o == 0 ? 384 : 768) + c;
        const GAS bf16* gsrc = hyt + ((size_t)(efr * 1152 + gcol)) * L;
        const float w0 = cw[gcol], w1 = cw[1152 + gcol], w2 = cw[2304 + gcol], sk = skip[o * 384 + c];
        GAS bf16* dst = yht + ((size_t)(efr * 384 + c)) * L;
        constexpr int GI = I < 8 ? I : 8;
#pragma unroll
        for (int i0 = 0; i0 < I; i0 += GI) {
            u32x2 grv[GI]; unsigned short gmv[GI], gpv[GI];
#pragma unroll
            for (int ii = 0; ii < GI; ++ii) {
                const int t = etb + 32 * (i0 + ii) + 4 * efq;
                grv[ii] = *(const GAS u32x2*)(gsrc + t); gmv[ii] = t > 0 ? gsrc[t - 1] : (unsigned short)0; gpv[ii] = t + 4 < L ? gsrc[t + 4] : (unsigned short)0;
            }
            asm volatile("" ::: "memory");
#pragma unroll
            for (int ii = 0; ii < GI; ++ii) {
                const int i = i0 + ii;
                const int t = etb + 32 * i + 4 * efq;
                const u32x2 zr = *(const LAS u32x2*)(zimg + efr * ZP + t * 2);
                const u32x2 gr = grv[ii];
                const float gm = bf2f(gmv[ii]), gp = bf2f(gpv[ii]);
                const float g0 = __uint_as_float(gr.x << 16), g1 = __uint_as_float(gr.x & 0xffff0000u), g2 = __uint_as_float(gr.y << 16), g3 = __uint_as_float(gr.y & 0xffff0000u);
                const float z0 = __uint_as_float(zr.x << 16), z1 = __uint_as_float(zr.x & 0xffff0000u), z2 = __uint_as_float(zr.y << 16), z3 = __uint_as_float(zr.y & 0xffff0000u);
                const float o0 = (w0 * gm + w1 * g0 + w2 * g1) * (acc[i].x + sk * z0), o1 = (w0 * g0 + w1 * g1 + w2 * g2) * (acc[i].y + sk * z1);
                const float o2 = (w0 * g1 + w1 * g2 + w2 * g3) * (acc[i].z + sk * z2), o3 = (w0 * g2 + w1 * g3 + w2 * gp) * (acc[i].w + sk * z3);
                acc[i] = (f32x4){o0, o1, o2, o3};
            }
        }
        __syncthreads();
#pragma unroll
        for (int i = 0; i < I; ++i) {
            const int t = etb + 32 * i + 4 * efq;
            u32x2 ov; ov.x = pk2(acc[i].x, acc[i].y); ov.y = pk2(acc[i].z, acc[i].w);
            if (o == 0) *(LAS u32x2*)(zimg + efr * ZP + t * 2) = ov;
            else *(GAS u32x2*)(dst + t) = ov;
        }
    }
}

__device__ __forceinline__ void chain_naive(Frame& F, int layer, int chain) {
    const int lane = F.lane;
    const bool is_ret = chain < 192;
    int b, h, dir;
    if (is_ret) { b = chain / 12; const int r = chain % 12; h = r >> 1; dir = r & 1; }
    else { const int i = chain - 192; b = i >> 3; h = (i & 7) >> 1; dir = i & 1; }
    const GAS bf16* RET = WSP(const bf16, WS_RET); const GAS bf16* ML = WSP(const bf16, WS_ML); const GAS float* MLG = WSP(const float, WS_MLG);
    const GAS float* rope = WSP(const float, WS_ROPE);
    GAS bf16* Y = WSP(bf16, WS_Y); GAS bf16* OB = WSP(bf16, WS_OB);
    float gam = 0.f;
    if (is_ret) gam = sigmoidf_(inp(F, I_RETDECAY)[layer * 12 + dir * 6 + h]);
    const GAS float* mlc = inp(F, I_MLCONV) + layer * 3 * 512;
    const float bi = is_ret ? 0.f : inp(F, I_MLGB)[layer * 16 + dir * 8 + h], bfg = is_ret ? 0.f : inp(F, I_MLGB)[layer * 16 + dir * 8 + 4 + h];
    const float qw0 = mlc[h * 64 + lane], qw1 = mlc[512 + h * 64 + lane], qw2 = mlc[1024 + h * 64 + lane];
    const float kw0 = mlc[256 + h * 64 + lane], kw1 = mlc[512 + 256 + h * 64 + lane], kw2 = mlc[1024 + 256 + h * 64 + lane];
    float S[64];
#pragma unroll
    for (int d = 0; d < 64; ++d) S[d] = 0.f;
    float nv = 0.f;
    for (int step = 0; step < LC + LL; ++step) {
        int row, tpos, L; bool lat;
        if (step < LC) { tpos = dir ? (LC - 1 - step) : step; row = TOKL + b * LC + tpos; L = LC; lat = false; }
        else { const int s2 = step - LC; tpos = dir ? (LL - 1 - s2) : s2; row = b * LL + tpos; L = LL; lat = true; }
        float q, k, v, Fm, Im;
        if (is_ret) {
            const GAS bf16* base = RET + (size_t)row * 1536;
            float qs = bf2f(base[h * 64 + lane]), ks = bf2f(base[384 + h * 64 + lane]);
            v = bf2f(base[768 + h * 64 + lane]);
            if (lat) {
                const float qp = bf2f(base[h * 64 + (lane ^ 16)]), kp = bf2f(base[384 + h * 64 + (lane ^ 16)]);
                const int half = lane >> 5, ii = lane & 15, hi = (lane >> 4) & 1;
                const float cs = rope[tpos * 64 + half * 32 + ii], sn = rope[tpos * 64 + half * 32 + 16 + ii];
                q = hi == 0 ? qs * cs - qp * sn : qp * sn + qs * cs;
                k = hi == 0 ? ks * cs - kp * sn : kp * sn + ks * cs;
            } else { q = qs; k = ks; }
            q *= 0.125f; Fm = gam; Im = 1.f;
        } else {
            const GAS bf16* base = ML + (size_t)row * 1024;
            const float q0 = tpos > 0 ? bf2f(base[-1024 + h * 64 + lane]) : 0.f, q1 = bf2f(base[h * 64 + lane]), q2 = tpos < L - 1 ? bf2f(base[1024 + h * 64 + lane]) : 0.f;
            const float k0 = tpos > 0 ? bf2f(base[-1024 + 256 + h * 64 + lane]) : 0.f, k1 = bf2f(base[256 + h * 64 + lane]), k2 = tpos < L - 1 ? bf2f(base[1024 + 256 + h * 64 + lane]) : 0.f;
            q = siluf_(qw0 * q0 + qw1 * q1 + qw2 * q2);
            k = siluf_(kw0 * k0 + kw1 * k1 + kw2 * k2) * 0.125f;
            v = bf2f(base[512 + h * 64 + lane]);
            const float ig = MLG[(size_t)row * 16 + dir * 8 + h] + bi, fg = MLG[(size_t)row * 16 + dir * 8 + 4 + h] + bfg;
            Fm = sigmoidf_(fg); Im = __expf(ig);
        }
        float num = 0.f;
        const float iv = Im * v;
#pragma unroll
        for (int d = 0; d < 64; ++d) {
            const float kd = __int_as_float(__builtin_amdgcn_readlane(__float_as_int(k), d));
            const float qd = __int_as_float(__builtin_amdgcn_readlane(__float_as_int(q), d));
            S[d] = Fm * S[d] + kd * iv;
            num += qd * S[d];
        }
        float o = num;
        if (!is_ret) { nv = Fm * nv + Im * k; const float den = wave_sum(q * nv); o = num / fmaxf(fabsf(den), 1.f); }
        const int cof = is_ret ? (h * 64 + lane) : (384 + h * 64 + lane);
        if (dir == 0) Y[(size_t)row * D + 384 + cof] = (bf16)f2bf(o);
        else OB[(size_t)row * 640 + cof] = (bf16)f2bf(o);
    }
}

#ifndef REP_CH
#define REP_CH 1
#endif
constexpr int CH_PITCH = 144;
constexpr int CH_IMG = 64 * CH_PITCH;
constexpr int CH_WAVE_LDS = 3 * CH_IMG + 1024 + 512;
__device__ __forceinline__ void ds_tr16x8(unsigned addr, u32x2 (&lo)[4], u32x2 (&hi)[4]) {
    asm volatile("ds_read_b64_tr_b16 %0, %8\n\tds_read_b64_tr_b16 %1, %8 offset:32\n\tds_read_b64_tr_b16 %2, %8 offset:64\n\tds_read_b64_tr_b16 %3, %8 offset:96\n\t"
                 "ds_read_b64_tr_b16 %4, %8 offset:2304\n\tds_read_b64_tr_b16 %5, %8 offset:2336\n\tds_read_b64_tr_b16 %6, %8 offset:2368\n\tds_read_b64_tr_b16 %7, %8 offset:2400\n\t"
                 "s_waitcnt lgkmcnt(0)"
                 : "=&v"(lo[0]), "=&v"(lo[1]), "=&v"(lo[2]), "=&v"(lo[3]), "=&v"(hi[0]), "=&v"(hi[1]), "=&v"(hi[2]), "=&v"(hi[3]) : "v"(addr) : "memory");
}
static_assert(16 * CH_PITCH == 2304, "ds_tr16x8 offsets");
__device__ __forceinline__ void ds_tr16x4(unsigned addr, u32x2 (&lo)[2], u32x2 (&hi)[2]) {
    asm volatile("ds_read_b64_tr_b16 %0, %4\n\tds_read_b64_tr_b16 %1, %4 offset:32\n\tds_read_b64_tr_b16 %2, %4 offset:2304\n\tds_read_b64_tr_b16 %3, %4 offset:2336\n\ts_waitcnt lgkmcnt(0)"
                 : "=&v"(lo[0]), "=&v"(lo[1]), "=&v"(hi[0]), "=&v"(hi[1]) : "v"(addr) : "memory");
}
__device__ __forceinline__ float log_sigmoid_(float x) { return fminf(x, 0.f) - log1pf(__expf(-fabsf(x))); }
__device__ __forceinline__ bf16x8 mk_frag(u32x2 lo, u32x2 hi) { u32x4 w; w.x = lo.x; w.y = lo.y; w.z = hi.x; w.w = hi.y; return __builtin_bit_cast(bf16x8, w); }

template <bool IS_ML>
__device__ __forceinline__ void chain_fast(Frame& F, int layer, int b, int h, int dir, LAS unsigned char* img, int hf) {
    constexpr int NET = 2;
    const int lane = F.lane, fr = lane & 15, fq = lane >> 4;
    LAS unsigned char* Qi = img; LAS unsigned char* Ki = img + CH_IMG; LAS unsigned char* Vi = img + 2 * CH_IMG;
    const unsigned qa = (unsigned)(size_t)Qi, ka = (unsigned)(size_t)Ki, va = (unsigned)(size_t)Vi;
    const GAS bf16* RET = WSP(const bf16, WS_RET); const GAS bf16* ML = WSP(const bf16, WS_ML); const GAS float* MLG = WSP(const float, WS_MLG);
    const GAS float* rope = WSP(const float, WS_ROPE);
    GAS bf16* Y = WSP(bf16, WS_Y); GAS bf16* OB = WSP(bf16, WS_OB);
    float lgam = 0.f, bi_ = 0.f, bf_ = 0.f;
    if (!IS_ML) lgam = log_sigmoid_(inp(F, I_RETDECAY)[layer * 12 + dir * 6 + h]);
    else { bi_ = inp(F, I_MLGB)[layer * 16 + dir * 8 + h]; bf_ = inp(F, I_MLGB)[layer * 16 + dir * 8 + 4 + h]; }
    const GAS float* mlc = inp(F, I_MLCONV) + layer * 3 * 512;
    f32x4 C[4][NET];
#pragma unroll
    for (int dt = 0; dt < 4; ++dt)
#pragma unroll
        for (int et = 0; et < NET; ++et) C[dt][et] = (f32x4){0.f, 0.f, 0.f, 0.f};
    const int cq = lane & 7, pr0 = lane >> 3;
    LAS float* nvec = (LAS float*)(img + 3 * CH_IMG + 1024 + 256 * hf);
    if (IS_ML) nvec[lane] = 0.f;
    const LAS float* nq = nvec + 4 * fq;
#pragma unroll 1
    for (int step_ = 0; step_ < 36 * REP_CH; ++step_) {
        const int step = step_ % 36;
        if (REP_CH > 1 && step == 0) {
            if (IS_ML) nvec[lane] = 0.f;
#pragma unroll
            for (int dt = 0; dt < 4; ++dt)
#pragma unroll
                for (int et = 0; et < NET; ++et) C[dt][et] = (f32x4){0.f, 0.f, 0.f, 0.f};
        }
        int rowbase, t0, L; bool lat;
        if (step < 4) { const int cc = dir ? 3 - step : step; rowbase = TOKL + b * LC + cc * 64; t0 = cc * 64; L = LC; lat = false; }
        else { const int cc = dir ? 35 - step : step - 4; rowbase = b * LL + cc * 64; t0 = cc * 64; L = LL; lat = true; }
        float g_i = 0.f, g_f = 0.f;
        if (IS_ML) { const int tlg = dir ? 63 - lane : lane; const GAS float* gp = MLG + (size_t)(rowbase + tlg) * 16 + dir * 8 + h; g_i = gp[0]; g_f = gp[4]; }
        if constexpr (!IS_ML) {
#pragma unroll
        for (int i4 = 0; i4 < 4; ++i4) {
            const int i = 4 * hf + i4;
            const int p = pr0 + 8 * i, tl = dir ? 63 - p : p, row = rowbase + tl, tpos = t0 + tl;
            float qv[8], kv[8]; u32x4 vraw;
            {
                const GAS bf16* base = RET + (size_t)row * 1536 + h * 64;
                const u32x4 qr = *(const GAS u32x4*)(base + 8 * cq), kr = *(const GAS u32x4*)(base + 384 + 8 * cq); vraw = *(const GAS u32x4*)(base + 768 + 8 * cq);
                const unsigned qw[4] = {qr.x, qr.y, qr.z, qr.w}, kw[4] = {kr.x, kr.y, kr.z, kr.w};
#pragma unroll
                for (int j = 0; j < 4; ++j) { qv[2 * j] = __uint_as_float(qw[j] << 16); qv[2 * j + 1] = __uint_as_float(qw[j] & 0xffff0000u); kv[2 * j] = __uint_as_float(kw[j] << 16); kv[2 * j + 1] = __uint_as_float(kw[j] & 0xffff0000u); }
                if (lat) {
                    const u32x4 qpr = *(const GAS u32x4*)(base + 8 * (cq ^ 2)), kpr = *(const GAS u32x4*)(base + 384 + 8 * (cq ^ 2));
                    const unsigned qpw[4] = {qpr.x, qpr.y, qpr.z, qpr.w}, kpw[4] = {kpr.x, kpr.y, kpr.z, kpr.w};
                    const int half = cq >> 2, hi = (cq >> 1) & 1, i0 = 8 * (cq & 1);
                    const GAS float* rp = rope + tpos * 64 + half * 32 + i0;
                    const f32x4 c0 = *(const GAS f32x4*)(rp), c1 = *(const GAS f32x4*)(rp + 4), s0 = *(const GAS f32x4*)(rp + 16), s1 = *(const GAS f32x4*)(rp + 20);
                    const float cs[8] = {c0.x, c0.y, c0.z, c0.w, c1.x, c1.y, c1.z, c1.w}, sn[8] = {s0.x, s0.y, s0.z, s0.w, s1.x, s1.y, s1.z, s1.w};
#pragma unroll
                    for (int j = 0; j < 8; ++j) {
                        const float qp = (j & 1) ? __uint_as_float(qpw[j >> 1] & 0xffff0000u) : __uint_as_float(qpw[j >> 1] << 16);
                        const float kp = (j & 1) ? __uint_as_float(kpw[j >> 1] & 0xffff0000u) : __uint_as_float(kpw[j >> 1] << 16);
                        qv[j] = hi ? qp * sn[j] + qv[j] * cs[j] : qv[j] * cs[j] - qp * sn[j];
                        kv[j] = hi ? kp * sn[j] + kv[j] * cs[j] : kv[j] * cs[j] - kp * sn[j];
                    }
                }
#pragma unroll
                for (int j = 0; j < 8; ++j) qv[j] *= 0.125f;
            }
            u32x4 qo, ko; qo.x = pk2(qv[0], qv[1]); qo.y = pk2(qv[2], qv[3]); qo.z = pk2(qv[4], qv[5]); qo.w = pk2(qv[6], qv[7]);
            ko.x = pk2(kv[0], kv[1]); ko.y = pk2(kv[2], kv[3]); ko.z = pk2(kv[4], kv[5]); ko.w = pk2(kv[6], kv[7]);
            *(LAS u32x4*)(Qi + p * CH_PITCH + 16 * cq) = qo; *(LAS u32x4*)(Ki + p * CH_PITCH + 16 * cq) = ko; *(LAS u32x4*)(Vi + p * CH_PITCH + 16 * cq) = vraw;
        }
        } else {
            const GAS float* wq = mlc + h * 64 + 8 * cq;
#pragma unroll
            for (int qk = 0; qk < 2; ++qk) {
                u32x4 r0[4], r1[4], r2[4], vr[4];
                f32x4 wt[3][2];
#pragma unroll
                for (int tp = 0; tp < 3; ++tp) { wt[tp][0] = *(const GAS f32x4*)(wq + 256 * qk + 512 * tp); wt[tp][1] = *(const GAS f32x4*)(wq + 256 * qk + 512 * tp + 4); }
#pragma unroll
                for (int i4 = 0; i4 < 4; ++i4) {
                    const int p = pr0 + 8 * (4 * hf + i4), tl = dir ? 63 - p : p, row = rowbase + tl, tpos = t0 + tl;
                    const GAS bf16* bb = ML + (size_t)row * 1024 + h * 64 + 8 * cq + 256 * qk;
                    const u32x4 z4 = (u32x4){0u, 0u, 0u, 0u};
                    r1[i4] = *(const GAS u32x4*)(bb); r0[i4] = tpos > 0 ? *(const GAS u32x4*)(bb - 1024) : z4; r2[i4] = tpos < L - 1 ? *(const GAS u32x4*)(bb + 1024) : z4;
                    if (qk == 1) vr[i4] = *(const GAS u32x4*)(bb + 256);
                }
#pragma unroll
                for (int i4 = 0; i4 < 4; ++i4) {
                    const int p = pr0 + 8 * (4 * hf + i4);
                    const unsigned a0[4] = {r0[i4].x, r0[i4].y, r0[i4].z, r0[i4].w}, a1[4] = {r1[i4].x, r1[i4].y, r1[i4].z, r1[i4].w}, a2[4] = {r2[i4].x, r2[i4].y, r2[i4].z, r2[i4].w};
                    float ov[8];
#pragma unroll
                    for (int j = 0; j < 8; ++j) {
                        const float x0 = (j & 1) ? __uint_as_float(a0[j >> 1] & 0xffff0000u) : __uint_as_float(a0[j >> 1] << 16);
                        const float x1 = (j & 1) ? __uint_as_float(a1[j >> 1] & 0xffff0000u) : __uint_as_float(a1[j >> 1] << 16);
                        const float x2 = (j & 1) ? __uint_as_float(a2[j >> 1] & 0xffff0000u) : __uint_as_float(a2[j >> 1] << 16);
                        const float r = siluf_(wt[0][j >> 2][j & 3] * x0 + wt[1][j >> 2][j & 3] * x1 + wt[2][j >> 2][j & 3] * x2);
                        ov[j] = qk == 0 ? r : r * 0.125f;
                    }
                    u32x4 o; o.x = pk2(ov[0], ov[1]); o.y = pk2(ov[2], ov[3]); o.z = pk2(ov[4], ov[5]); o.w = pk2(ov[6], ov[7]);
                    if (qk == 0) *(LAS u32x4*)(Qi + p * CH_PITCH + 16 * cq) = o;
                    else { *(LAS u32x4*)(Ki + p * CH_PITCH + 16 * cq) = o; *(LAS u32x4*)(Vi + p * CH_PITCH + 16 * cq) = vr[i4]; }
                }
                asm volatile("" ::: "memory");
            }
        }
        __builtin_amdgcn_sched_barrier(0);
        float f_p, i_p;
        if (!IS_ML) { f_p = lgam; i_p = 0.f; }
        else { i_p = g_i + bi_; f_p = log_sigmoid_(g_f + bf_); }
        float bsum = f_p;
#pragma unroll
        for (int o = 1; o < 64; o <<= 1) { const float t = lane_read(bsum, lane >= o ? lane - o : lane); if (lane >= o) bsum += t; }
        LAS float* gv = (LAS float*)(img + 3 * CH_IMG);
        const float b63 = __int_as_float(__builtin_amdgcn_readlane(__float_as_int(bsum), 63));
        const float adec = __expf(b63);
        if (hf == 0) { gv[lane] = bsum; gv[64 + lane] = bsum - i_p; gv[128 + lane] = __expf(bsum); gv[192 + lane] = __expf(b63 - (bsum - i_p)); }
        asm volatile("s_waitcnt lgkmcnt(0)" ::: "memory");
        __syncthreads();
        const LAS float* gq = gv + 4 * fq;
        const bf16x8 ones = (fr == 0) ? (bf16x8){0x3F80, 0x3F80, 0x3F80, 0x3F80, 0x3F80, 0x3F80, 0x3F80, 0x3F80} : (bf16x8){0, 0, 0, 0, 0, 0, 0, 0};
        const int tr_q = fr >> 2, tr_p = fr & 3;
#pragma unroll 1
        for (int pt = 0; pt < 4; ++pt) {
            f32x4 ST[4];
            bf16x8 qn[2];
#pragma unroll
            for (int kk = 0; kk < 2; ++kk) qn[kk] = *(const LAS bf16x8*)(Qi + (16 * pt + fr) * CH_PITCH + (32 * kk + 8 * fq) * 2);
#pragma unroll
            for (int st = 0; st < 4; ++st) {
                ST[st] = (f32x4){0.f, 0.f, 0.f, 0.f};
                if (st <= pt) {
#pragma unroll
                    for (int kk = 0; kk < 2; ++kk) { const bf16x8 kf = *(const LAS bf16x8*)(Ki + (16 * st + fr) * CH_PITCH + (32 * kk + 8 * fq) * 2); ST[st] = __builtin_amdgcn_mfma_f32_16x16x32_bf16(kf, qn[kk], ST[st], 0, 0, 0); }
                }
            }
            const float bp = gv[16 * pt + fr];
#pragma unroll
            for (int st = 0; st < 4; ++st) {
                if (st <= pt) {
                    const f32x4 bis = *(const LAS f32x4*)(gq + 64 + 16 * st);
#pragma unroll
                    for (int j = 0; j < 4; ++j) { const int sidx = 16 * st + 4 * fq + j; const float w = (sidx <= 16 * pt + fr) ? __expf(bp - bis[j]) : 0.f; ST[st][j] *= w; }
                }
            }
            __builtin_amdgcn_sched_barrier(0);
            f32x4 acc[NET], accd = (f32x4){0.f, 0.f, 0.f, 0.f};
#pragma unroll
            for (int et = 0; et < NET; ++et) acc[et] = (f32x4){0.f, 0.f, 0.f, 0.f};
#pragma unroll
            for (int kk = 0; kk < 2; ++kk) {
                const u32x2 lo = *(const LAS u32x2*)(Qi + (16 * pt + fr) * CH_PITCH + (32 * kk + 4 * fq) * 2), hi = *(const LAS u32x2*)(Qi + (16 * pt + fr) * CH_PITCH + (32 * kk + 16 + 4 * fq) * 2);
                const bf16x8 qs = mk_frag(lo, hi);
#pragma unroll
                for (int et = 0; et < NET; ++et) {
                    u32x4 w; w.x = pk2(C[2 * kk][et].x, C[2 * kk][et].y); w.y = pk2(C[2 * kk][et].z, C[2 * kk][et].w); w.z = pk2(C[2 * kk + 1][et].x, C[2 * kk + 1][et].y); w.w = pk2(C[2 * kk + 1][et].z, C[2 * kk + 1][et].w);
                    acc[et] = __builtin_amdgcn_mfma_f32_16x16x32_bf16(qs, __builtin_bit_cast(bf16x8, w), acc[et], 0, 0, 0);
                }
                if (IS_ML) {
                    const f32x4 n0 = *(const LAS f32x4*)(nq + 32 * kk), n1 = *(const LAS f32x4*)(nq + 32 * kk + 16);
                    u32x4 w; w.x = pk2(n0.x, n0.y); w.y = pk2(n0.z, n0.w); w.z = pk2(n1.x, n1.y); w.w = pk2(n1.z, n1.w);
                    if (fr != 0) w = (u32x4){0u, 0u, 0u, 0u};
                    accd = __builtin_amdgcn_mfma_f32_16x16x32_bf16(qs, __builtin_bit_cast(bf16x8, w), accd, 0, 0, 0);
                }
            }
            { const f32x4 ap = *(const LAS f32x4*)(gq + 128 + 16 * pt);
#pragma unroll
              for (int j = 0; j < 4; ++j) {
#pragma unroll
                for (int et = 0; et < NET; ++et) acc[et][j] *= ap[j];
                accd[j] *= ap[j]; } }
            __builtin_amdgcn_sched_barrier(0);
#pragma unroll
            for (int kk = 0; kk < 2; ++kk) {
                if (2 * kk <= pt) {
                    u32x4 w; w.x = pk2(ST[2 * kk].x, ST[2 * kk].y); w.y = pk2(ST[2 * kk].z, ST[2 * kk].w); w.z = pk2(ST[2 * kk + 1].x, ST[2 * kk + 1].y); w.w = pk2(ST[2 * kk + 1].z, ST[2 * kk + 1].w);
                    const bf16x8 pf = __builtin_bit_cast(bf16x8, w);
                    u32x2 vlo[2], vhi[2];
                    ds_tr16x4(va + (32 * kk + 4 * fq + tr_q) * CH_PITCH + 8 * tr_p + 64 * hf, vlo, vhi);
#pragma unroll
                    for (int et = 0; et < NET; ++et) acc[et] = __builtin_amdgcn_mfma_f32_16x16x32_bf16(pf, mk_frag(vlo[et], vhi[et]), acc[et], 0, 0, 0);
                    if (IS_ML) accd = __builtin_amdgcn_mfma_f32_16x16x32_bf16(pf, ones, accd, 0, 0, 0);
                }
            }
            __builtin_amdgcn_sched_barrier(0);
#pragma unroll
            for (int j = 0; j < 4; ++j) {
                const int p = 16 * pt + 4 * fq + j, tl = dir ? 63 - p : p, row = rowbase + tl;
                float inv = 1.f;
                if (IS_ML) { const float den = lane_read(accd[j], lane & 48); inv = __builtin_amdgcn_rcpf(fmaxf(fabsf(den), 1.f)); }
                const int cof = (IS_ML ? 384 : 0) + h * 64 + 32 * hf + fr;
                const unsigned boff = dir == 0 ? (unsigned)(row * D + 384 + cof) * 2u : (unsigned)(row * 640 + cof) * 2u;
                GAS char* ob = dir == 0 ? (GAS char*)Y : (GAS char*)OB;
#pragma unroll
                for (int et = 0; et < NET; ++et) *(GAS bf16*)(ob + boff + 32 * et) = (bf16)f2bf(acc[et][j] * inv);
            }
        }
        __builtin_amdgcn_sched_barrier(0);
#pragma unroll
        for (int dt = 0; dt < 4; ++dt)
#pragma unroll
            for (int et = 0; et < NET; ++et) C[dt][et] *= adec;
        f32x4 accn[4];
        if (IS_ML) {
#pragma unroll
            for (int dt = 0; dt < 4; ++dt) { accn[dt] = *(const LAS f32x4*)(nq + 16 * dt) * adec; if (fr != 0) accn[dt] = (f32x4){0.f, 0.f, 0.f, 0.f}; }
        }
#pragma unroll
        for (int kk = 0; kk < 2; ++kk) {
            u32x2 vlo[2], vhi[2], klo[4], khi[4];
            ds_tr16x4(va + (32 * kk + 4 * fq + tr_q) * CH_PITCH + 8 * tr_p + 64 * hf, vlo, vhi);
            ds_tr16x8(ka + (32 * kk + 4 * fq + tr_q) * CH_PITCH + 8 * tr_p, klo, khi);
            const f32x4 wl = *(const LAS f32x4*)(gq + 192 + 32 * kk), wh = *(const LAS f32x4*)(gq + 192 + 32 * kk + 16);
#pragma unroll
            for (int dt = 0; dt < 4; ++dt) {
                u32x4 w;
                w.x = pk2(__uint_as_float(klo[dt].x << 16) * wl[0], __uint_as_float(klo[dt].x & 0xffff0000u) * wl[1]);
                w.y = pk2(__uint_as_float(klo[dt].y << 16) * wl[2], __uint_as_float(klo[dt].y & 0xffff0000u) * wl[3]);
                w.z = pk2(__uint_as_float(khi[dt].x << 16) * wh[0], __uint_as_float(khi[dt].x & 0xffff0000u) * wh[1]);
                w.w = pk2(__uint_as_float(khi[dt].y << 16) * wh[2], __uint_as_float(khi[dt].y & 0xffff0000u) * wh[3]);
                const bf16x8 kf = __builtin_bit_cast(bf16x8, w);
#pragma unroll
                for (int et = 0; et < NET; ++et) C[dt][et] = __builtin_amdgcn_mfma_f32_16x16x32_bf16(kf, mk_frag(vlo[et], vhi[et]), C[dt][et], 0, 0, 0);
                if (IS_ML) accn[dt] = __builtin_amdgcn_mfma_f32_16x16x32_bf16(kf, ones, accn[dt], 0, 0, 0);
            }
        }
        if (IS_ML) { if (fr == 0) {
#pragma unroll
            for (int dt = 0; dt < 4; ++dt) *(LAS f32x4*)(nvec + 4 * fq + 16 * dt) = accn[dt]; } }
        asm volatile("s_waitcnt lgkmcnt(0)" ::: "memory");
        __syncthreads();
    }
}

#ifndef FAST_CHAIN
#define FAST_CHAIN 1
#endif
constexpr int NCHWG = 160;
__device__ __forceinline__ void phase_mix(Frame& F, int layer) {
    const bool last = layer == 1;
    const GAS bf16* ftl = WSP(const bf16, WS_FTL) + (size_t)layer * 2 * 384 * 4096;
    if (FAST_CHAIN) {
        if (F.wg < NCHWG) {
            if (F.wave >= 4) {
#pragma unroll 1
                for (int i = 0; i < 72 * REP_CH; ++i) __syncthreads();
            } else {
                const int cl = F.wave >> 1, hf = F.wave & 1, c = F.wg * 2 + cl;
                LAS unsigned char* img = F.lds + cl * CH_WAVE_LDS;
                {
                if (c < 192) { const int b = c / 12, r = c % 12; chain_fast<false>(F, layer, b, r >> 1, r & 1, img, hf); }
                else { const int i = c - 192; chain_fast<true>(F, layer, i >> 3, (i & 7) >> 1, i & 1, img, hf); }
                }
            }
        } else {
            const int nh = F.G - NCHWG, w = F.wg - NCHWG;
#ifndef FAST_HY
#define FAST_HY 1
#endif
            if (FAST_HY) {
#ifndef REP_HY
#define REP_HY 1
#endif
#pragma unroll 1
                for (int rp = 0; rp < REP_HY; ++rp)
                for (int u = w; u < 384; u += nh) hyena_unit_fast<LL>(F, layer, u, WSP(const bf16, WS_HYTL), ftl, WSP(bf16, WS_YHTL));
                if (!last) for (int u = w; u < 384; u += nh) hyena_unit_fast<LC>(F, layer, u, WSP(const bf16, WS_HYTC), WSP(const bf16, WS_FTC), WSP(bf16, WS_YHTC));
            } else {
                for (int u = w; u < 384; u += nh) hyena_unit_naive<LL>(F, layer, u, WSP(const bf16, WS_HYTL), ftl, WSP(bf16, WS_YHTL));
                if (!last) for (int u = w; u < 384; u += nh) hyena_unit_naive<LC>(F, layer, u, WSP(const bf16, WS_HYTC), WSP(const bf16, WS_FTC), WSP(bf16, WS_YHTC));
            }
        }
    } else {
        for (int u = F.wg; u < 384; u += F.G) hyena_unit_naive<LL>(F, layer, u, WSP(const bf16, WS_HYTL), ftl, WSP(bf16, WS_YHTL));
        if (!last) for (int u = F.wg; u < 384; u += F.G) hyena_unit_naive<LC>(F, layer, u, WSP(const bf16, WS_HYTC), WSP(const bf16, WS_FTC), WSP(bf16, WS_YHTC));
        for (int c = F.wg + F.wave * F.G; c < 320; c += F.G * NWAVES) chain_naive(F, layer, c);
    }
}

__device__ __forceinline__ void phase_combine(Frame& F, int layer) {
    const bool last = layer == 1;
    const int gw = F.wg * NWAVES + F.wave, NGW = F.G * NWAVES, lane = F.lane;
    const int nrows = last ? TOKL : TOK;
    GAS bf16* Y = WSP(bf16, WS_Y); const GAS bf16* OB = WSP(const bf16, WS_OB); const GAS bf16* RET = WSP(const bf16, WS_RET); const GAS bf16* ML = WSP(const bf16, WS_ML);
    for (int row = gw; row < nrows; row += NGW) {
#pragma unroll
        for (int hh = 0; hh < 10; ++hh) {
            const int cof = hh * 64 + lane;
            const float x = bf2f(Y[(size_t)row * D + 384 + cof]) + bf2f(OB[(size_t)row * 640 + cof]);
            const float mu = wave_sum(x) * (1.f / 64.f), xc = x - mu;
            const float var = wave_sum(xc * xc) * (1.f / 64.f);
            const float nrm = xc * rsqrtf(var + 1e-6f);
            float gate;
            if (hh < 6) gate = siluf_(bf2f(RET[(size_t)row * 1536 + 1152 + cof]));
            else gate = sigmoidf_(bf2f(ML[(size_t)row * 1024 + 768 + (cof - 384)]));
            Y[(size_t)row * D + 384 + cof] = (bf16)f2bf(nrm * gate);
        }
    }
    LAS float* scr = (LAS float*)(F.lds + F.wave * 16640);
    const int nitL = NB * 6 * 32, nitC = last ? 0 : NB * 6 * 4;
    for (int it = gw; it < nitL + nitC; it += NGW) {
        const GAS bf16* src; int L, rowbase, b, cb, tb;
        if (it < nitL) { b = it / 192; const int r = it % 192; cb = r / 32; tb = r % 32; L = LL; src = WSP(const bf16, WS_YHTL); rowbase = b * LL; }
        else { const int i2 = it - nitL; b = i2 / 24; const int r = i2 % 24; cb = r / 4; tb = r % 4; L = LC; src = WSP(const bf16, WS_YHTC); rowbase = TOKL + b * LC; }
        for (int cc = 0; cc < 64; ++cc) scr[cc * 65 + lane] = bf2f(src[((size_t)(b * 384 + cb * 64 + cc)) * L + tb * 64 + lane]);
        asm volatile("s_waitcnt lgkmcnt(0)" ::: "memory");
        for (int tt = 0; tt < 64; ++tt) Y[(size_t)(rowbase + tb * 64 + tt) * D + cb * 64 + lane] = (bf16)f2bf(scr[lane * 65 + tt]);
        asm volatile("s_waitcnt lgkmcnt(0)" ::: "memory");
    }
}

__device__ __forceinline__ void phase_norm_router(Frame& F) {
    const int gw = F.wg * NWAVES + F.wave, NGW = F.G * NWAVES, lane = F.lane;
    const GAS float* g = inp(F, I_GFFN) + 1 * D; const GAS float* wr = inp(F, I_ROUTER); const GAS float* br = inp(F, I_ROUTERB);
    GAS unsigned* cnt = WSP(unsigned, WS_CTL) + CW_CNT;
    for (int row = gw; row < TOKL; row += NGW) {
        float keep[16];
        norm_mod_row(xrow_ptr(F, row, false), g, mod_ptr(F, 1, row, 3), mod_ptr(F, 1, row, 4), WSP(bf16, WS_H) + (size_t)row * D, lane, keep);
        float lg[8];
#pragma unroll
        for (int e = 0; e < 8; ++e) lg[e] = 0.f;
#pragma unroll
        for (int j = 0; j < 4; ++j)
#pragma unroll
            for (int i = 0; i < 4; ++i) { const int k = 256 * j + 4 * lane + i; const f32x4 w0 = *(const GAS f32x4*)(wr + k * 8), w1 = *(const GAS f32x4*)(wr + k * 8 + 4); const float x = keep[4 * j + i];
                lg[0] += x * w0.x; lg[1] += x * w0.y; lg[2] += x * w0.z; lg[3] += x * w0.w; lg[4] += x * w1.x; lg[5] += x * w1.y; lg[6] += x * w1.z; lg[7] += x * w1.w; }
#pragma unroll
        for (int e = 0; e < 8; ++e) lg[e] = wave_sum(lg[e]) + br[e];
        int e0 = 0; float v0 = lg[0];
#pragma unroll
        for (int e = 1; e < 8; ++e) if (lg[e] > v0) { v0 = lg[e]; e0 = e; }
        int e1 = -1; float v1 = -3.0e38f;
#pragma unroll
        for (int e = 0; e < 8; ++e) if (e != e0 && lg[e] > v1) { v1 = lg[e]; e1 = e; }
        const float w1 = 1.f / (1.f + __expf(v0 - v1)), w0 = 1.f - w1;
        if (lane == 0) {
            const unsigned p0 = __hip_atomic_fetch_add(cnt + e0, 1u, __ATOMIC_RELAXED, __HIP_MEMORY_SCOPE_AGENT), p1 = __hip_atomic_fetch_add(cnt + e1, 1u, __ATOMIC_RELAXED, __HIP_MEMORY_SCOPE_AGENT);
            WSP(int, WS_TOPE)[row * 2] = e0; WSP(int, WS_TOPE)[row * 2 + 1] = e1;
            WSP(float, WS_TOPW)[row * 2] = w0; WSP(float, WS_TOPW)[row * 2 + 1] = w1;
            WSP(int, WS_TOPP)[row * 2] = (int)p0; WSP(int, WS_TOPP)[row * 2 + 1] = (int)p1;
        }
    }
}
__device__ __forceinline__ void phase_route_tables(Frame& F) {
    const GAS unsigned* cnt = WSP(const unsigned, WS_CTL) + CW_CNT;
    int off[9]; off[0] = 0;
#pragma unroll
    for (int e = 0; e < 8; ++e) { const int c = (int)__hip_atomic_load(cnt + e, __ATOMIC_RELAXED, __HIP_MEMORY_SCOPE_AGENT); off[e + 1] = off[e] + ((c + 255) >> 8) * 256; }
    const int gt = F.wg * NTHR + F.tid, NGT = F.G * NTHR;
    GAS int* rowidx = WSP(int, WS_ROWIDX); GAS int* slot = WSP(int, WS_SLOT); GAS int* tilee = WSP(int, WS_TILEE);
    for (int i = gt; i < MAXTILES * 256; i += NGT) {
        int e = 0;
#pragma unroll
        for (int q = 1; q < 8; ++q) if (i >= off[q]) e = q;
        const int c = (int)cnt[e];
        if (i >= off[8] || i - off[e] >= c) rowidx[i] = 0;
    }
    for (int i = gt; i < TOKL * 2; i += NGT) {
        const int e = WSP(const int, WS_TOPE)[i], pos = WSP(const int, WS_TOPP)[i];
        int o = 0;
#pragma unroll
        for (int q = 0; q < 8; ++q) if (e == q) o = off[q];
        const int s = o + pos; slot[i] = s; rowidx[s] = i >> 1;
    }
    for (int i = gt; i < MAXTILES + 1; i += NGT) {
        if (i == MAXTILES) tilee[MAXTILES] = off[8] >> 8;
        else { int e = 0;
#pragma unroll
            for (int q = 1; q < 8; ++q) if (i * 256 >= off[q]) e = q;
            tilee[i] = e; }
    }
}

__device__ __forceinline__ void moe_pass_gemm1_fast(Frame& F, int t0, int t1) {
    pg8::OrderMoe S; S.o.init(t1 - t0, NFF1 / 256, F.G, F.wg); S.rowidx = WSP(const int, WS_ROWIDX); S.tilee = WSP(const int, WS_TILEE); S.t0 = t0; S.bstride = (size_t)NFF1 * D; S.gather = true;
    EpiSwiglu E{WSP(bf16, WS_MACT), 0};
    pg8::gemm_phase(F.lds, F.tid, WSP(const bf16, WS_H), D, WSP(const bf16, WS_MW13), D, D, S, E);
}
__device__ __forceinline__ void moe_pass_gemm2_fast(Frame& F, int t0, int t1) {
    pg8::OrderMoe S; S.o.init(t1 - t0, D / 256, F.G, F.wg); S.rowidx = WSP(const int, WS_ROWIDX); S.tilee = WSP(const int, WS_TILEE); S.t0 = t0; S.bstride = (size_t)D * DFF; S.gather = false;
    EpiBf16Out E{WSP(bf16, WS_EOUT), D, t0 * 256};
    pg8::gemm_phase(F.lds, F.tid, WSP(const bf16, WS_MACT), DFF, WSP(const bf16, WS_MW2), DFF, DFF, S, E);
}
__device__ __forceinline__ void phase_final(Frame& F) {
    const int gw = F.wg * NWAVES + F.wave, NGW = F.G * NWAVES, lane = F.lane;
    const GAS float* gf = inp(F, I_GFINAL); const GAS bf16* eo = WSP(const bf16, WS_EOUT);
    for (int row = gw; row < TOKL; row += NGW) {
        const int s0 = WSP(const int, WS_SLOT)[row * 2], s1 = WSP(const int, WS_SLOT)[row * 2 + 1];
        const float w0 = WSP(const float, WS_TOPW)[row * 2], w1 = WSP(const float, WS_TOPW)[row * 2 + 1];
        const GAS float* m5 = mod_ptr(F, 1, row, 5);
        GAS float* xr = outp(F) + (size_t)row * D;
        f32x4 v[4]; float s = 0.f;
#pragma unroll
        for (int j = 0; j < 4; ++j) {
            const int c = 256 * j + 4 * lane;
            const f32x4 a = ld_bf16x4(eo + (size_t)s0 * D + c), b = ld_bf16x4(eo + (size_t)s1 * D + c), m = *(const GAS f32x4*)(m5 + c);
            v[j] = *(const GAS f32x4*)(xr + c) + m * (a * w0 + b * w1);
            s += (v[j].x * v[j].x + v[j].y * v[j].y) + (v[j].z * v[j].z + v[j].w * v[j].w);
        }
        const float r = rsqrtf(wave_sum(s) * (1.f / 1024.f) + 1e-6f);
#pragma unroll
        for (int j = 0; j < 4; ++j) { const int c = 256 * j + 4 * lane; const f32x4 g = *(const GAS f32x4*)(gf + c); *(GAS f32x4*)(xr + c) = v[j] * r * g; }
    }
}

#ifndef REP_WIN
#define REP_WIN 1
#endif
#ifndef REP_MIX
#define REP_MIX 1
#endif
#ifndef REP_GATE
#define REP_GATE 1
#endif
#ifndef REP_UP
#define REP_UP 1
#endif
#ifndef REP_FFN1
#define REP_FFN1 1
#endif
#ifndef REP_MOE
#define REP_MOE 1
#endif
#ifndef REP_NORM
#define REP_NORM 1
#endif
#ifndef REP_P0
#define REP_P0 1
#endif
__global__ void __launch_bounds__(NTHR, 2) hybrid_fwd(Params prm) {
    extern __shared__ __attribute__((aligned(16))) unsigned char lds_raw[];
    Frame F;
    F.lds = (LAS unsigned char*)lds_raw; F.ws = (GAS unsigned char*)prm.ws;
    F.tid = threadIdx.x; F.lane = F.tid & 63; F.wave = __builtin_amdgcn_readfirstlane(F.tid >> 6); F.G = gridDim.x; F.wg = blockIdx.x;
    volatile LAS unsigned* MISC = (volatile LAS unsigned*)(F.lds + MISC_OFF);
    if (F.tid < 64) MISC[F.tid] = 0u;
    if (F.tid < 33) { const unsigned long long v = F.tid < 32 ? (unsigned long long)prm.in[F.tid] : (unsigned long long)prm.out; *(LAS unsigned long long*)(F.lds + PTAB_OFF + 8 * F.tid) = v; }
    __syncthreads();
    XcdBarrier bar = xcd_barrier_post(WSP(unsigned, WS_CTL) + CW_BAR, MISC + 8);
#define RELAUNDER() do { { unsigned long long _w = (unsigned long long)F.ws; asm volatile("" : "+s"(_w)); F.ws = (GAS unsigned char*)_w; } \
        { unsigned _t = (unsigned)F.tid; asm volatile("" : "+v"(_t)); F.tid = (int)_t; F.lane = F.tid & 63; F.wave = __builtin_amdgcn_readfirstlane(F.tid >> 6); } \
        { unsigned _g = (unsigned)F.G, _b = (unsigned)F.wg; asm volatile("" : "+s"(_g), "+s"(_b)); F.G = (int)_g; F.wg = (int)_b; } \
        { unsigned _l = (unsigned)(size_t)F.lds; asm volatile("" : "+s"(_l)); F.lds = (LAS unsigned char*)(size_t)_l; } } while (0)
#define GRID_BAR() do { { unsigned long long _b = (unsigned long long)bar.bar; unsigned _x = bar.x; asm volatile("" : "+s"(_b), "+s"(_x)); bar.bar = (GAS unsigned*)_b; bar.x = _x; } xcd_barrier(bar); RELAUNDER(); } while (0)

    for (int rp = 0; rp < REP_P0; ++rp) { phase_p0(F); write_bias(F);
    GRID_BAR(); }
#pragma unroll 1
    for (int layer_ = 0; layer_ < 2; ++layer_) {
        int layer = layer_;
#define last (layer == 1)
#define rows_all TOK
#define rows_out (last ? TOKL : TOK)
#define modbase (WSP(const float, WS_MOD) + (size_t)layer * 17 * 6144)
#define LAYER_LAUNDER() asm volatile("" : "+s"(layer))
        for (int rp = 0; rp < REP_NORM; ++rp) { phase_norm(F, layer, rows_all, !last, 0);
        if (layer == 0) { const int gw = F.wg * NWAVES + F.wave, NGW = F.G * NWAVES;
            for (int it = gw; it < 1536 + 96; it += NGW) filter_out_item(F, it); }
        { GRID_BAR(); LAYER_LAUNDER(); } }
        for (int rp = 0; rp < REP_WIN; ++rp) {
        { EpiWin E{WSP(const float, WS_BIAS) + layer * NWP, WSP(bf16, WS_HYTL), WSP(bf16, WS_HYTC), WSP(bf16, WS_RET), WSP(bf16, WS_ML), WSP(float, WS_MLG)};
          gemm_fast(F, WSP(const bf16, WS_H), D, WSP(const bf16, WS_WIN), D, D, rows_all, NW1, E); }
        { GRID_BAR(); LAYER_LAUNDER(); } }
        for (int rp = 0; rp < REP_MIX; ++rp) { phase_mix(F, layer);
        { GRID_BAR(); LAYER_LAUNDER(); } }
        phase_combine(F, layer);
        { GRID_BAR(); LAYER_LAUNDER(); }
        for (int rp = 0; rp < REP_GATE; ++rp) {
        { EpiGate E{WSP(const float, WS_BIAS) + layer * NWP + NW1, WSP(bf16, WS_GATES)};
          gemm_fast(F, WSP(const bf16, WS_H), D, WSP(const bf16, WS_WIN) + (size_t)NW1 * D, D, D, rows_out, NGATE, E); }
        { GRID_BAR(); LAYER_LAUNDER(); } }
        for (int rp = 0; rp < REP_UP; ++rp) {
        { EpiUp E{WSP(const bf16, WS_GATES), WSP(bf16, WS_H)};
          gemm_fast(F, WSP(const bf16, WS_Y), D, WSP(const bf16, WS_WUP), D, D, rows_out, D, E); }
        { GRID_BAR(); LAYER_LAUNDER(); } }
        { EpiResid E{last ? outp(F) : inp(F, I_X), last ? WSP(const float, WS_XC) : inp(F, I_CTX), outp(F), WSP(float, WS_XC), modbase, 2};
          gemm_fast(F, WSP(const bf16, WS_H), D, WSP(const bf16, WS_WOUT), D, D, rows_out, D, E); }
        { GRID_BAR(); LAYER_LAUNDER(); }
        if (!last) {
            phase_norm(F, layer, rows_out, false, 3);
            { const int gw = F.wg * NWAVES + F.wave, NGW = F.G * NWAVES; LAS float* scr = (LAS float*)(F.lds + F.wave * 8704);
              conv_weights_ffn(inp(F, I_FW1), inp(F, I_FW3), inp(F, I_FW2), WSP(bf16, WS_W13), WSP(bf16, WS_W2), gw, NGW, scr, F.lane);
              conv_weights_win(F, 1, gw, NGW, scr);
              conv_weights_upout(F, 1, gw, NGW, scr); }
            { GRID_BAR(); LAYER_LAUNDER(); }
            for (int rp = 0; rp < REP_FFN1; ++rp) {
            { EpiSwiglu E{WSP(bf16, WS_ACT), 0};
              gemm_fast(F, WSP(const bf16, WS_H), D, WSP(const bf16, WS_W13), D, D, rows_out, NFF1, E); }
            { GRID_BAR(); LAYER_LAUNDER(); } }
            { EpiResid E{outp(F), WSP(const float, WS_XC), outp(F), WSP(float, WS_XC), modbase, 5};
              gemm_fast(F, WSP(const bf16, WS_ACT), DFF, WSP(const bf16, WS_W2), DFF, DFF, rows_out, D, E); }
            { GRID_BAR(); LAYER_LAUNDER(); }
        }
    }
#undef LAYER_LAUNDER
#undef last
#undef rows_all
#undef rows_out
#undef modbase
    phase_norm_router(F);
    { const int gw = F.wg * NWAVES + F.wave, NGW = F.G * NWAVES; LAS float* scr = (LAS float*)(F.lds + F.wave * 8704);
#pragma unroll 1
      for (int e = 0; e < NE; ++e)
          conv_weights_ffn(inp(F, I_MW1) + (size_t)e * D * DFF, inp(F, I_MW3) + (size_t)e * D * DFF, inp(F, I_MW2) + (size_t)e * DFF * D,
                           WSP(bf16, WS_MW13) + (size_t)e * NFF1 * D, WSP(bf16, WS_MW2) + (size_t)e * D * DFF, gw, NGW, scr, F.lane); }
    GRID_BAR();
    phase_route_tables(F);
    GRID_BAR();
    const int ntiles = __builtin_amdgcn_readfirstlane(WSP(const int, WS_TILEE)[MAXTILES]);
#pragma unroll 1
    for (int p = 0; p < NPASS; ++p) {
        const int t0 = p * PASS_TILES, t1 = min(ntiles, t0 + PASS_TILES);
        for (int rp = 0; rp < REP_MOE; ++rp) {
        if (t0 < t1) moe_pass_gemm1_fast(F, t0, t1);
        GRID_BAR();
        if (t0 < t1) moe_pass_gemm2_fast(F, t0, t1);
        GRID_BAR(); }
    }
    phase_final(F);
}

extern "C" void kernel_launch(void* const* d_in, const int* in_sizes, int n_in, void* d_out, int out_size, void* d_ws, size_t ws_size, hipStream_t stream) {
    static int grid = 0;
    if (grid == 0) {
        if (n_in != 32 || out_size != TOKL * D || ws_size < WS_END) { fprintf(stderr, "kernel_launch: unexpected arguments (n_in %d, out %d, ws %zu)\n", n_in, out_size, ws_size); grid = -1; return; }
        int dev = 0, cus = 0;
        if (hipGetDevice(&dev) != hipSuccess || hipDeviceGetAttribute(&cus, hipDeviceAttributeMultiprocessorCount, dev) != hipSuccess) { grid = -1; return; }
        if (hipFuncSetAttribute((const void*)hybrid_fwd, hipFuncAttributeMaxDynamicSharedMemorySize, LDS_BYTES) != hipSuccess) { grid = -1; return; }
        int per_cu = 0;
        (void)hipOccupancyMaxActiveBlocksPerMultiprocessor(&per_cu, (const void*)hybrid_fwd, NTHR, LDS_BYTES);
        (void)hipGetLastError();
        grid = cus;
    }
    if (grid < 0) return;
    (void)hipMemsetAsync((char*)d_ws + WS_CTL, 0, CTL_ZERO_BYTES, stream);
    Params p{};
    for (int i = 0; i < 32; ++i) p.in[i] = (const float*)d_in[i];
    p.out = (float*)d_out; p.ws = (unsigned char*)d_ws;
    hipLaunchKernelGGL(hybrid_fwd, dim3(grid), dim3(NTHR), LDS_BYTES, stream, p);
}
```

```cpp
#include <hip/hip_runtime.h>
#include <stdint.h>
#include <stdio.h>

#define LAS __attribute__((address_space(3)))
#define GAS __attribute__((address_space(1)))
typedef unsigned short bf16;
typedef short bf16x8 __attribute__((ext_vector_type(8)));
typedef float f32x4 __attribute__((ext_vector_type(4)));
typedef unsigned u32x4 __attribute__((ext_vector_type(4)));
typedef unsigned u32x2 __attribute__((ext_vector_type(2)));

constexpr int D = 1024, NB = 16, LL = 2048, LC = 256;
constexpr int TOKL = NB * LL, TOKC = NB * LC, TOK = TOKL + TOKC;
constexpr int HYW = 384, RETW = 384, MLW = 256;
constexpr int NIN = 6800, NW1 = 3840, NGATE = 3072, NWP = 6912;
constexpr int DFF = 2816, NFF1 = 5632, NE = 8;
constexpr int NWAVES = 8, NTHR = 512;
constexpr int MAXTILES = 272, PASS_TILES = 64, NPASS = 5;

constexpr size_t MiB = 1u << 20;
constexpr size_t WS_CTL = 0, CTL_ZERO_BYTES = 1 * MiB;
constexpr size_t WS_MOD = 1 * MiB;
constexpr size_t WS_BIAS = 2 * MiB;
constexpr size_t WS_ROPE = 2 * MiB + 256 * 1024;
constexpr size_t WS_TOPE = 3 * MiB;
constexpr size_t WS_TOPW = 3 * MiB + 256 * 1024;
constexpr size_t WS_TOPP = 3 * MiB + 512 * 1024;
constexpr size_t WS_SLOT = 3 * MiB + 768 * 1024;
constexpr size_t WS_ROWIDX = 4 * MiB;
constexpr size_t WS_TILEE = 4 * MiB + 512 * 1024;
constexpr size_t WS_FTL = 5 * MiB;
constexpr size_t WS_FTC = 17 * MiB;
constexpr size_t WS_WIN = 18 * MiB;
constexpr size_t WS_WUP = 32 * MiB;
constexpr size_t WS_WOUT = 34 * MiB;
constexpr size_t WS_XC = 36 * MiB;
constexpr size_t WS_H = 52 * MiB;
constexpr size_t WS_Y = 124 * MiB;
constexpr size_t WS_U = 196 * MiB;
constexpr size_t WS_RET = WS_U;
constexpr size_t WS_ML = WS_U + 108 * MiB;
constexpr size_t WS_MLG = WS_U + 180 * MiB;
constexpr size_t WS_OB = WS_U + 183 * MiB;
constexpr size_t WS_YHTL = WS_U + 228 * MiB;
constexpr size_t WS_YHTC = WS_U + 252 * MiB;
constexpr size_t WS_HYTL = WS_U + 255 * MiB;
constexpr size_t WS_HYTC = WS_U + 327 * MiB;
constexpr size_t WS_END = WS_U + 336 * MiB;
constexpr size_t WS_GATES = WS_U;
constexpr size_t WS_ACT = WS_U;
constexpr size_t WS_W13 = WS_U + 204 * MiB;
constexpr size_t WS_W2 = WS_U + 216 * MiB;
constexpr size_t WS_MW13 = WS_Y;
constexpr size_t WS_MW2 = WS_Y + 88 * MiB;
constexpr size_t WS_MACT = WS_Y + 132 * MiB;
constexpr size_t WS_EOUT = WS_Y + 220 * MiB;
static_assert(WS_EOUT + (size_t)MAXTILES * 256 * 1024 * 2 <= WS_END, "map");
static_assert(WS_GATES + (size_t)TOK * NGATE * 2 <= WS_YHTL, "gates overlay");

constexpr int CW_BAR = 4096;
constexpr int CW_CNT = 16384;

constexpr int LDS_BYTES = 147456;
constexpr int MISC_OFF = 147456 - 256;

__device__ __forceinline__ float bf2f(bf16 b) { return __uint_as_float(((unsigned)b) << 16); }
typedef __bf16 bf2v_ __attribute__((ext_vector_type(2)));
typedef float f2v_ __attribute__((ext_vector_type(2)));
__device__ __forceinline__ unsigned pk2(float lo, float hi) { const f2v_ f = {lo, hi}; return __builtin_bit_cast(unsigned, __builtin_convertvector(f, bf2v_)); }
__device__ __forceinline__ unsigned f2bf(float f) { return pk2(f, 0.f) & 0xffffu; }
__device__ __forceinline__ float dpp_f(float v, int) { return v; }
#define DPP_ADD(v, ctrl) (v) += __int_as_float(__builtin_amdgcn_update_dpp(0, __float_as_int(v), (ctrl), 0xf, 0xf, true))
__device__ __forceinline__ float wave_sum(float v) {
    DPP_ADD(v, 0xB1);
    DPP_ADD(v, 0x4E);
    DPP_ADD(v, 0x141);
    DPP_ADD(v, 0x140);
    return __int_as_float(__builtin_amdgcn_readlane(__float_as_int(v), 0)) + __int_as_float(__builtin_amdgcn_readlane(__float_as_int(v), 16))
         + __int_as_float(__builtin_amdgcn_readlane(__float_as_int(v), 32)) + __int_as_float(__builtin_amdgcn_readlane(__float_as_int(v), 48));
}
__device__ __forceinline__ float lane_read(float v, int src_lane) { return __int_as_float(__builtin_amdgcn_ds_bpermute(src_lane << 2, __float_as_int(v))); }
__device__ __forceinline__ float sigmoidf_(float x) { return __builtin_amdgcn_rcpf(1.0f + __expf(-x)); }
__device__ __forceinline__ float siluf_(float x) { return x * __builtin_amdgcn_rcpf(1.0f + __expf(-x)); }

#define XB_TMO      128
#define XB_XCNT(j)  (256  + 64 * (j))
#define XB_XSUB(j)  (1280 + 64 * (j))
#define XB_XGEN(j)  (2304 + 64 * (j))
#define XB_TOP      3328
#define XB_TOPGEN   3392
#define XCD_BAR_WORDS 3456
#define XB_SPIN_CAP (1u << 22)
__device__ __forceinline__ unsigned xb_ld(GAS unsigned* p)              { return __hip_atomic_load(p, __ATOMIC_RELAXED, __HIP_MEMORY_SCOPE_AGENT); }
__device__ __forceinline__ unsigned xb_add(GAS unsigned* p, unsigned v) { return __hip_atomic_fetch_add(p, v, __ATOMIC_RELAXED, __HIP_MEMORY_SCOPE_AGENT); }
__device__ __forceinline__ unsigned xb_xcc_id() { return (unsigned)__builtin_amdgcn_s_getreg((3 << 11) | 20) & 0xFu; }
#define XB_SPIN(cond, bar) do { unsigned _sp = 0; while (cond) { __builtin_amdgcn_s_sleep(1); \
    if ((++_sp & 255u) == 0u) { if (xb_ld(&(bar)[XB_TMO])) break; if (_sp > XB_SPIN_CAP) { (void)__hip_atomic_fetch_add(&(bar)[XB_TMO], 1u, __ATOMIC_RELAXED, __HIP_MEMORY_SCOPE_AGENT); break; } } } } while (0)
struct XcdBarrier { GAS unsigned* bar; unsigned x; volatile LAS unsigned* st; };
__device__ __forceinline__ XcdBarrier xcd_barrier_post(GAS unsigned* bar, volatile LAS unsigned* st) {
    XcdBarrier b; b.bar = bar; b.x = xb_xcc_id(); b.st = st;
    if (threadIdx.x == 0) (void)xb_add(&bar[XB_XCNT(b.x)], 1u);
    return b;
}
__device__ __forceinline__ void xcd_barrier_complete(GAS unsigned* bar, unsigned x, unsigned& nloc, unsigned& nx) {
    const unsigned G = gridDim.x * gridDim.y * gridDim.z;
    unsigned sum, cnt, mine, sp = 0u;
    for (;;) {
        sum = 0u; cnt = 0u; mine = 0u;
#pragma unroll 1
        for (unsigned j = 0; j < 16; ++j) { const unsigned c = xb_ld(&bar[XB_XCNT(j)]); sum += c; cnt += (c > 0u) ? 1u : 0u; }
        mine = xb_ld(&bar[XB_XCNT(x)]);
        if (sum == G) break;
        __builtin_amdgcn_s_sleep(1);
        if ((++sp & 255u) == 0u) { if (xb_ld(&bar[XB_TMO])) break; if (sp > XB_SPIN_CAP) { (void)__hip_atomic_fetch_add(&bar[XB_TMO], 1u, __ATOMIC_RELAXED, __HIP_MEMORY_SCOPE_AGENT); break; } }
    }
    nloc = mine > 0u ? mine : 1u; nx = cnt > 0u ? cnt : 1u;
}
__device__ __forceinline__ void xcd_barrier(const XcdBarrier& b) {
    asm volatile("s_waitcnt vmcnt(0)" ::: "memory");
    __syncthreads();
    if (threadIdx.x == 0) {
        GAS unsigned* bar = b.bar;
        __builtin_amdgcn_s_waitcnt(0);
        unsigned nloc = b.st[0], nx = b.st[1];
        if (nloc == 0u) { xcd_barrier_complete(bar, b.x, nloc, nx); b.st[0] = nloc; b.st[1] = nx; }
        const unsigned old = xb_add(&bar[XB_XSUB(b.x)], 1u);
        const unsigned gen = old / nloc;
        if (old + 1u == (gen + 1u) * nloc) {
            __builtin_amdgcn_fence(__ATOMIC_RELEASE, "agent");
            asm volatile("s_waitcnt vmcnt(0)" ::: "memory");
            const unsigned og = xb_add(&bar[XB_TOP], 1u);
            const unsigned tg = og / nx;
            if (og + 1u == (tg + 1u) * nx) xb_add(&bar[XB_TOPGEN], 1u);
            else XB_SPIN(xb_ld(&bar[XB_TOPGEN]) == tg, bar);
            __builtin_amdgcn_fence(__ATOMIC_ACQUIRE, "agent");
            xb_add(&bar[XB_XGEN(b.x)], 1u);
            asm volatile("s_waitcnt vmcnt(0)" ::: "memory");
        } else {
            XB_SPIN(xb_ld(&bar[XB_XGEN(b.x)]) == gen, bar);
            __builtin_amdgcn_fence(__ATOMIC_ACQUIRE, "agent");
            asm volatile("s_waitcnt vmcnt(0)" ::: "memory");
        }
    }
    __syncthreads();
}

struct Params { const float* in[32]; float* out; unsigned char* ws; };
enum { I_X = 0, I_C, I_CTX, I_CCTX, I_WMOD, I_BMOD, I_GMIX, I_GFFN, I_WIN, I_BIN, I_HYCONV, I_HYF1, I_HYFB1, I_HYF2, I_HYFB2, I_HYF3, I_HYDECAY,
       I_HYSKIP, I_RETDECAY, I_MLCONV, I_MLGB, I_WUP, I_WOUT, I_FW1, I_FW3, I_FW2, I_ROUTER, I_ROUTERB, I_MW1, I_MW3, I_MW2, I_GFINAL };

struct Frame {
    LAS unsigned char* lds;
    GAS unsigned char* ws;
    int tid, lane, wave, G, wg;
};
#define WSP(T, off) ((GAS T*)(F.ws + (off)))
constexpr int PTAB_OFF = 147456 - 1024;
__device__ __forceinline__ const GAS float* inp(const Frame& F, int i) {
    const LAS unsigned* t = (const LAS unsigned*)(F.lds + PTAB_OFF) + 2 * i;
    const unsigned lo = __builtin_amdgcn_readfirstlane(t[0]), hi = __builtin_amdgcn_readfirstlane(t[1]);
    return (const GAS float*)(((unsigned long long)hi << 32) | lo);
}
__device__ __forceinline__ GAS float* outp(const Frame& F) { return (GAS float*)inp(F, 32); }

__device__ __forceinline__ int row_batch(int row) { return row < TOKL ? (row >> 11) : ((row - TOKL) >> 8); }
__device__ __forceinline__ const GAS float* mod_ptr(const Frame& F, int layer, int row, int which) {
    const int r = row < TOKL ? (row >> 11) : 16;
    return WSP(const float, WS_MOD) + ((size_t)(layer * 17 + r) * 6 + which) * 1024;
}

template <class RowMap>
__device__ __forceinline__ void tr_item(const GAS float* W, int K, int N, GAS bf16* WT, int ldT, RowMap rm, LAS float* scr, int item, int lane) {
    const int nblk = (N + 31) / 32, kb = item / nblk, nb = item % nblk, k0 = 64 * kb, n0 = 32 * nb;
    { float tv[32];
#pragma unroll
      for (int i = 0; i < 32; ++i) { const int kk = 2 * i + (lane >> 5); const int n = n0 + (lane & 31); tv[i] = (n < N) ? W[(size_t)(k0 + kk) * N + n] : 0.f; }
#pragma unroll
      for (int i = 0; i < 32; ++i) { const int kk = 2 * i + (lane >> 5); scr[kk * 33 + (lane & 31)] = tv[i]; } }
    asm volatile("s_waitcnt lgkmcnt(0)" ::: "memory");
    const int c = lane & 7;
#pragma unroll
    for (int j = 0; j < 4; ++j) { const int nl = (lane >> 3) + 8 * j; const int n = n0 + nl; const LAS float* s = scr + (8 * c) * 33 + nl;
        u32x4 o; o.x = pk2(s[0 * 33], s[1 * 33]); o.y = pk2(s[2 * 33], s[3 * 33]); o.z = pk2(s[4 * 33], s[5 * 33]); o.w = pk2(s[6 * 33], s[7 * 33]);
        if (n < N) *(GAS u32x4*)(WT + (size_t)rm(n) * ldT + k0 + 8 * c) = o; }
    asm volatile("s_waitcnt lgkmcnt(0)" ::: "memory");
}
struct RmId { __device__ __forceinline__ int operator()(int n) const { return n; } };
__device__ __forceinline__ int win_row(int n) {
    if (n < 1152) return n;
    if (n < 2688) return 1280 + (n - 1152);
    if (n < 3712) return 2816 + (n - 2688);
    if (n < 3728) return 1152 + (n - 3712);
    return 3840 + (n - 3728);
}
struct RmWin { __device__ __forceinline__ int operator()(int n) const { return win_row(n); } };
struct RmW1 { __device__ __forceinline__ int operator()(int n) const { return (n >> 4) * 32 + (n & 15); } };
struct RmW3 { __device__ __forceinline__ int operator()(int n) const { return (n >> 4) * 32 + 16 + (n & 15); } };

__device__ __forceinline__ void conv_weights_win(Frame& F, int layer, int gw, int NGW, LAS float* scr) {
    const GAS float* W = inp(F, I_WIN) + (size_t)layer * D * NIN;
    const int items = (D / 64) * ((NIN + 31) / 32);
    for (int it = gw; it < items; it += NGW) tr_item(W, D, NIN, WSP(bf16, WS_WIN), D, RmWin(), scr, it, F.lane);
    GAS bf16* wt = WSP(bf16, WS_WIN);
    unsigned zz; asm volatile("v_mov_b32 %0, 0" : "=v"(zz));
    for (int i = gw * 64 + F.lane; i < 112 * 1024 / 8; i += NGW * 64) *(GAS u32x4*)(wt + (size_t)1168 * 1024 + (size_t)i * 8) = (u32x4){zz, zz, zz, zz};
}
__device__ __forceinline__ void conv_weights_upout(Frame& F, int layer, int gw, int NGW, LAS float* scr) {
    const int items = (D / 64) * (D / 32);
    for (int it = gw; it < items; it += NGW) tr_item(inp(F, I_WUP) + (size_t)layer * D * D, D, D, WSP(bf16, WS_WUP), D, RmId(), scr, it, F.lane);
    for (int it = gw; it < items; it += NGW) tr_item(inp(F, I_WOUT) + (size_t)layer * D * D, D, D, WSP(bf16, WS_WOUT), D, RmId(), scr, it, F.lane);
}
__device__ __forceinline__ void conv_weights_ffn(const GAS float* w1, const GAS float* w3, const GAS float* w2, GAS bf16* w13t, GAS bf16* w2t, int gw, int NGW, LAS float* scr, int lane) {
    const int i1 = (D / 64) * (DFF / 32), i2 = (DFF / 64) * (D / 32);
    for (int it = gw; it < i1; it += NGW) tr_item(w1, D, DFF, w13t, D, RmW1(), scr, it, lane);
    for (int it = gw; it < i1; it += NGW) tr_item(w3, D, DFF, w13t, D, RmW3(), scr, it, lane);
    for (int it = gw; it < i2; it += NGW) tr_item(w2, DFF, D, w2t, DFF, RmId(), scr, it, lane);
}

constexpr size_t WS_HID2 = WS_XC;
__device__ __forceinline__ void filter_hidden_item(Frame& F, int item) {
    const int p0 = item * 8, sel = p0 < 2048 ? 0 : (p0 < 4096 ? 1 : 2), layer = sel == 1 ? 1 : 0, L = sel == 2 ? LC : LL, pbase = sel == 0 ? 0 : (sel == 1 ? 2048 : 4096);
    const GAS float* f1 = inp(F, I_HYF1) + layer * 33 * 64; const GAS float* fb1 = inp(F, I_HYFB1) + layer * 64;
    const GAS float* f2 = inp(F, I_HYF2) + layer * 64 * 64; const GAS float* fb2 = inp(F, I_HYFB2) + layer * 64;
    const int lane = F.lane;
    const float b1 = fb1[lane], b2 = fb2[lane];
    for (int pl = 0; pl < 8; ++pl) {
        const int pos = p0 + pl - pbase;
        const float t = (float)pos / (float)(L - 1);
        const float w = 6.283185307179586f * (float)pos / (float)L;
        float feat = 0.f;
        if (lane == 0) feat = t;
        else if (lane < 17) { const float band = 1e-4f + (float)(lane - 1) * ((15.0f - 1e-4f) / 15.0f); feat = cosf(w * band); }
        else if (lane < 33) { const float band = 1e-4f + (float)(lane - 17) * ((15.0f - 1e-4f) / 15.0f); feat = -sinf(w * band); }
        float a1 = b1;
        for (int i = 0; i < 33; ++i) a1 += __int_as_float(__builtin_amdgcn_readlane(__float_as_int(feat), i)) * f1[i * 64 + lane];
        const float h1 = sinf(a1);
        float a2 = b2;
        for (int i = 0; i < 64; ++i) a2 += __int_as_float(__builtin_amdgcn_readlane(__float_as_int(h1), i)) * f2[i * 64 + lane];
        WSP(float, WS_HID2)[(size_t)(p0 + pl) * 64 + lane] = sinf(a2);
    }
}
__device__ __forceinline__ void filter_out_item(Frame& F, int item) {
    int sel, r;
    if (item < 768) { sel = 0; r = item; } else if (item < 1536) { sel = 1; r = item - 768; } else { sel = 2; r = item - 1536; }
    const int layer = sel == 1 ? 1 : 0, L = sel == 2 ? LC : LL, pb = r / 24, ch = r % 24, pbase = sel == 0 ? 0 : (sel == 1 ? 2048 : 4096);
    GAS bf16* FT = sel == 2 ? WSP(bf16, WS_FTC) : WSP(bf16, WS_FTL) + (size_t)layer * 2 * 384 * 4096;
    const GAS float* f3 = inp(F, I_HYF3) + (size_t)layer * 64 * 1536; const GAS float* dec = inp(F, I_HYDECAY) + layer * 1536;
    const int lane = F.lane, fr = lane & 15, fq = lane >> 4;
    const GAS float* hid = WSP(const float, WS_HID2) + (size_t)(pbase + pb * 64) * 64;
    f32x4 acc[4][4];
#pragma unroll
    for (int mt = 0; mt < 4; ++mt)
#pragma unroll
        for (int nt = 0; nt < 4; ++nt) acc[mt][nt] = (f32x4){0.f, 0.f, 0.f, 0.f};
#pragma unroll 4
    for (int ks = 0; ks < 16; ++ks) {
        float a[4], bb[4];
#pragma unroll
        for (int mt = 0; mt < 4; ++mt) a[mt] = hid[(16 * mt + fr) * 64 + 4 * ks + fq];
#pragma unroll
        for (int nt = 0; nt < 4; ++nt) bb[nt] = f3[(size_t)(4 * ks + fq) * 1536 + ch * 64 + 16 * nt + fr];
#pragma unroll
        for (int mt = 0; mt < 4; ++mt)
#pragma unroll
            for (int nt = 0; nt < 4; ++nt) acc[mt][nt] = __builtin_amdgcn_mfma_f32_16x16x4f32(a[mt], bb[nt], acc[mt][nt], 0, 0, 0);
    }
#pragma unroll
    for (int nt = 0; nt < 4; ++nt) {
        const int nn = ch * 64 + 16 * nt + fr, o = nn / 768, dir = (nn / 384) & 1, c = nn % 384;
        const float adec = fabsf(dec[nn]);
        GAS bf16* dst = FT + (size_t)(o * 384 + c) * (2 * L);
#pragma unroll
        for (int mt = 0; mt < 4; ++mt)
#pragma unroll
            for (int j = 0; j < 4; ++j) {
                const int pos = pb * 64 + 16 * mt + 4 * fq + j;
                const float t = (float)pos / (float)(L - 1);
                const float v = acc[mt][nt][j] * expf(-t * adec);
                if (dir == 0) dst[L - pos] = (bf16)f2bf(v);
                else if (pos > 0) dst[L + pos] = (bf16)f2bf(v);
            }
    }
}

__device__ __forceinline__ void phase_p0(Frame& F) {
    const int gw = F.wg * NWAVES + F.wave, NGW = F.G * NWAVES;
    LAS float* sl = (LAS float*)F.lds;
    LAS float* red = (LAS float*)(F.lds + 17 * 4096);
    for (int i = F.tid; i < 17 * 1024; i += NTHR) { const int r = i >> 10, k = i & 1023; const float v = r < 16 ? inp(F, I_C)[r * 1024 + k] : inp(F, I_CCTX)[k]; sl[i] = siluf_(v); }
    __syncthreads();
    for (int item = F.wg; item < 2 * 384; item += F.G) {
        const int layer = item / 384, n0 = (item % 384) * 16, j = F.tid & 15, kp = F.tid >> 4;
        const GAS float* W = inp(F, I_WMOD) + (size_t)layer * D * 6144;
        float acc[17];
#pragma unroll
        for (int r = 0; r < 17; ++r) acc[r] = 0.f;
        for (int k = kp * 32; k < kp * 32 + 32; ++k) { const float w = W[(size_t)k * 6144 + n0 + j];
#pragma unroll
            for (int r = 0; r < 17; ++r) acc[r] += sl[r * 1024 + k] * w; }
#pragma unroll
        for (int r = 0; r < 17; ++r) red[(kp * 17 + r) * 16 + j] = acc[r];
        __syncthreads();
        if (F.tid < 272) { const int r = F.tid >> 4, jj = F.tid & 15; float s = inp(F, I_BMOD)[layer * 6144 + n0 + jj];
            for (int q = 0; q < 32; ++q) s += red[(q * 17 + r) * 16 + jj];
            WSP(float, WS_MOD)[(size_t)(layer * 17 + r) * 6144 + n0 + jj] = s; }
        __syncthreads();
    }
    __syncthreads();
    LAS float* scr = (LAS float*)(F.lds + F.wave * 8704);
    conv_weights_win(F, 0, gw, NGW, scr);
    conv_weights_upout(F, 0, gw, NGW, scr);
    for (int i = gw * 64 + F.lane; i < 2048 * 32; i += NGW * 64) {
        const int t = i >> 5, j = i & 31, half = j >> 4, ii = j & 15;
        const float inv = 1.0f / powf(10000.0f, (float)ii / 16.0f);
        const float ang = (float)(half == 0 ? (t >> 6) : (t & 63)) * inv;
        WSP(float, WS_ROPE)[t * 64 + half * 32 + ii] = cosf(ang);
        WSP(float, WS_ROPE)[t * 64 + half * 32 + 16 + ii] = sinf(ang);
    }
    for (int it = gw; it < 4352 / 8; it += NGW) filter_hidden_item(F, it);
}
__device__ __forceinline__ void write_bias(Frame& F) {
    const int gt = (F.wg * NWAVES + F.wave) * 64 + F.lane, NGT = F.G * NTHR;
    for (int i = gt; i < 2 * NWP; i += NGT) {
        const int l = i / NWP, r = i % NWP; float v = 0.f;
        int n = -1;
        if (r < 1152) n = r; else if (r < 1168) n = 3712 + (r - 1152); else if (r < 1280) n = -1; else if (r < 2816) n = 1152 + (r - 1280); else if (r < 3840) n = 2688 + (r - 2816); else n = 3728 + (r - 3840);
        if (n >= 0) v = inp(F, I_BIN)[l * NIN + n];
        WSP(float, WS_BIAS)[i] = v;
    }
}

__device__ __forceinline__ void norm_mod_row(const GAS float* xrow, const GAS float* g, const GAS float* shift, const GAS float* scale, GAS bf16* orow, int lane, float* keep  ) {
    f32x4 v[4]; float s = 0.f;
#pragma unroll
    for (int j = 0; j < 4; ++j) { v[j] = *(const GAS f32x4*)(xrow + 256 * j + 4 * lane); s += (v[j].x * v[j].x + v[j].y * v[j].y) + (v[j].z * v[j].z + v[j].w * v[j].w); }
    const float r = rsqrtf(wave_sum(s) * (1.0f / 1024.0f) + 1e-6f);
#pragma unroll
    for (int j = 0; j < 4; ++j) {
        const f32x4 gg = *(const GAS f32x4*)(g + 256 * j + 4 * lane), sh = *(const GAS f32x4*)(shift + 256 * j + 4 * lane), sc = *(const GAS f32x4*)(scale + 256 * j + 4 * lane);
        f32x4 o;
        o.x = (v[j].x * r * gg.x) * (1.f + sc.x) + sh.x; o.y = (v[j].y * r * gg.y) * (1.f + sc.y) + sh.y;
        o.z = (v[j].z * r * gg.z) * (1.f + sc.z) + sh.z; o.w = (v[j].w * r * gg.w) * (1.f + sc.w) + sh.w;
        if (keep) { keep[4 * j + 0] = o.x; keep[4 * j + 1] = o.y; keep[4 * j + 2] = o.z; keep[4 * j + 3] = o.w; }
        u32x2 w; w.x = pk2(o.x, o.y); w.y = pk2(o.z, o.w);
        *(GAS u32x2*)(orow + 256 * j + 4 * lane) = w;
    }
}
__device__ __forceinline__ const GAS float* xrow_ptr(const Frame& F, int row, bool from_input) {
    if (row < TOKL) return (from_input ? inp(F, I_X) : outp(F)) + (size_t)row * D;
    return (from_input ? inp(F, I_CTX) : WSP(const float, WS_XC)) + (size_t)(row - TOKL) * D;
}
__device__ __forceinline__ void phase_norm(Frame& F, int layer, int nrows, bool from_input, int which) {
    const int gw = F.wg * NWAVES + F.wave, NGW = F.G * NWAVES;
    const GAS float* g = inp(F, which == 0 ? I_GMIX : I_GFFN) + layer * D;
    for (int row = gw; row < nrows; row += NGW)
        norm_mod_row(xrow_ptr(F, row, from_input), g, mod_ptr(F, layer, row, which), mod_ptr(F, layer, row, which + 1), WSP(bf16, WS_H) + (size_t)row * D, F.lane, nullptr);
}

namespace pg8 {
constexpr int BM = 256, BK = 64, HALF = 128, HTB = HALF * BK * 2, STAGE_BYTES = 8 * HTB, NXCD = 8, WGM = 8;
__device__ __forceinline__ int lds_byte(int r, int c) { const int st = (r >> 4) * 2 + (c >> 5), rr = r & 15, cc = c & 31, ob = rr * 64 + cc * 2; return st * 1024 + (ob ^ (((ob >> 9) & 1) << 5)); }
__device__ __forceinline__ void stage_rc(int b, int& R, int& C) { const int st = b / 1024, sb = b % 1024, swz = sb ^ (((sb >> 9) & 1) << 5); R = (st >> 1) * 16 + swz / 64; C = (st & 1) * 32 + (swz % 64) / 2; }
struct Unit { int pm, pn; };
struct OrderPlain {
    static constexpr bool GATHER = false;
    int nM, nN, nwg, G, c;
    __device__ __forceinline__ void init(int nM_, int nN_, int G_, int c_) { nM = nM_; nN = nN_; nwg = nM * nN; G = G_; c = c_; }
    __device__ __forceinline__ bool next(int i, Unit& u) const {
        const long L = (long)i * G + c; if (L >= nwg) return false;
        int wgid = (int)L; { const int q = nwg / NXCD, r = nwg % NXCD, xcd = wgid % NXCD, off = wgid / NXCD; wgid = (xcd < r ? xcd * (q + 1) : r * (q + 1) + (xcd - r) * q) + off; }
        const int nig = WGM * nN, gid = wgid / nig, fm = gid * WGM, gsz = (nM - fm) < WGM ? (nM - fm) : WGM;
        u.pm = fm + ((wgid % nig) % gsz); u.pn = (wgid % nig) / gsz; return true;
    }
    __device__ __forceinline__ int arow(int r) const { return r; }
    __device__ __forceinline__ size_t boff(const Unit&) const { return 0; }
};
struct OrderMoe {
    static constexpr bool GATHER = true;
    OrderPlain o; const GAS int* rowidx; const GAS int* tilee; int t0; size_t bstride; bool gather;
    __device__ __forceinline__ bool next(int i, Unit& u) const { return o.next(i, u); }
    __device__ __forceinline__ int arow(int r) const { return gather ? rowidx[t0 * 256 + r] : r; }
    __device__ __forceinline__ size_t boff(const Unit& u) const { return (size_t)tilee[t0 + u.pm] * bstride; }
};

template <class Epi, class Sched>
__device__ __forceinline__ void gemm_phase(LAS unsigned char* lds, int tid_in, const GAS bf16* A, int lda, const GAS bf16* Bt, int ldb, int K, const Sched& S, const Epi& E) {
    unsigned tid_u = (unsigned)tid_in; asm volatile("" : "+v"(tid_u));
    const int tid = (int)tid_u, wid = __builtin_amdgcn_readfirstlane(tid >> 6), lane = tid & 63, wr = wid >> 2, wc = wid & 3, fr = lane & 15, fq = lane >> 4;
    const int nt = K / BK;
    unsigned voffB[2];
    { int sR[2], sC[2];
#pragma unroll
      for (int i = 0; i < 2; ++i) { stage_rc(tid * 16 + i * 8192, sR[i], sC[i]); voffB[i] = (unsigned)(sR[i] * ldb + sC[i]) * 2u; } }
#define PG8_GATHER_OFFS(pm_) do { unsigned _t = (unsigned)tid; asm volatile("" : "+v"(_t)); _Pragma("unroll") for (int i = 0; i < 2; ++i) { int _R, _C; stage_rc((int)_t * 16 + i * 8192, _R, _C); \
        vc0[i] = (unsigned)((size_t)S.arow((pm_) * BM + _R) * lda + _C) * 2u; vc1[i] = (unsigned)((size_t)S.arow((pm_) * BM + HALF + _R) * lda + _C) * 2u; } } while (0)
    const size_t kstep = (size_t)(BK * 2);
    const size_t hstepB = (size_t)HALF * ldb * 2, tstepB = 2 * hstepB;
    const unsigned ldsw = (unsigned)wid * 1024u;
    const int aoff = lds_byte(wr * 64 + fr, fq * 8), boff = lds_byte(wc * 32 + fr, fq * 8);
#define PG8_SA(b, h) (((b) * 2 + (h)) * HTB)
#define PG8_SB(b, h) ((4 + (b) * 2 + (h)) * HTB)
#define PG8_STAGE2(bufoff, gbase, v0, v1) do { \
        __builtin_amdgcn_global_load_lds((const GAS unsigned*)((const GAS char*)(gbase) + (v0)), (LAS unsigned*)(lds + (bufoff) + ldsw), 16, 0, 0); \
        __builtin_amdgcn_global_load_lds((const GAS unsigned*)((const GAS char*)(gbase) + (v1)), (LAS unsigned*)(lds + (bufoff) + ldsw + 8192), 16, 0, 0); } while (0)
#define PG8_STAGEB(bufoff, gbase) PG8_STAGE2(bufoff, gbase, voffB[0], voffB[1])
#define PG8_LDA(dst, b, h) do { _Pragma("unroll") for (int m = 0; m < 4; ++m) _Pragma("unroll") for (int k = 0; k < 2; ++k) dst[m][k] = *(const LAS bf16x8*)(lds + PG8_SA(b, h) + aoff + m * 2048 + k * 1024); } while (0)
#define PG8_LDB(dst, b, h) do { _Pragma("unroll") for (int n = 0; n < 2; ++n) _Pragma("unroll") for (int k = 0; k < 2; ++k) dst[n][k] = *(const LAS bf16x8*)(lds + PG8_SB(b, h) + boff + n * 2048 + k * 1024); } while (0)
#define PG8_MMA(ai, bj, At, Bt_) do { __builtin_amdgcn_s_setprio(1); _Pragma("unroll") for (int m = 0; m < 4; ++m) _Pragma("unroll") for (int n = 0; n < 2; ++n) _Pragma("unroll") for (int k = 0; k < 2; ++k) \
        acc[ai][bj][m][n] = __builtin_amdgcn_mfma_f32_16x16x32_bf16(Bt_[n][k], At[m][k], acc[ai][bj][m][n], 0, 0, 0); __builtin_amdgcn_s_setprio(0); } while (0)
#define PG8_WAIT_V(n) asm volatile("s_waitcnt vmcnt(" #n ")" ::: "memory")
#define PG8_WAIT_L(n) asm volatile("s_waitcnt lgkmcnt(" #n ")" ::: "memory")
#define PG8_BAR __builtin_amdgcn_s_barrier()
#define PG8_SCHED __builtin_amdgcn_sched_barrier(0)
    Unit cur, nxt; int ui = 0;
    if (!S.next(0, cur)) return;
    f32x4 acc[2][2][4][2];
#pragma unroll
    for (int a = 0; a < 2; ++a)
#pragma unroll
        for (int b = 0; b < 2; ++b)
#pragma unroll
            for (int m = 0; m < 4; ++m)
#pragma unroll
                for (int n = 0; n < 2; ++n) { float zf; asm volatile("v_mov_b32 %0, 0" : "=v"(zf)); acc[a][b][m][n] = (f32x4){zf, zf, zf, zf}; }
    bf16x8 At[4][2], B0[2][2], B1[2][2];
    constexpr bool GA = Sched::GATHER;
    const size_t hstepA = GA ? 0 : (size_t)HALF * lda * 2, tstepA = (size_t)BM * lda * 2;
    unsigned vc0[2], vc1[2];
    if constexpr (GA) { PG8_GATHER_OFFS(cur.pm); }
    else { int sR, sC;
#pragma unroll
        for (int i = 0; i < 2; ++i) { stage_rc(tid * 16 + i * 8192, sR, sC); vc0[i] = (unsigned)(sR * lda + sC) * 2u; vc1[i] = 0u; } }
#define VC0(i) vc0[i]
#define VC1(i) (GA ? vc1[i] : vc0[i])
#define VN0(i) vc0[i]
#define VN1(i) VC1(i)
    const GAS char* cA = GA ? (const GAS char*)A : (const GAS char*)A + (size_t)cur.pm * tstepA;
    const GAS char* cB = (const GAS char*)Bt + S.boff(cur) * 2 + (size_t)cur.pn * tstepB;
    PG8_STAGEB(PG8_SB(0, 0), cB); PG8_STAGE2(PG8_SA(0, 0), cA, VC0(0), VC0(1)); PG8_STAGEB(PG8_SB(0, 1), cB + hstepB); PG8_STAGE2(PG8_SA(0, 1), cA + hstepA, VC1(0), VC1(1));
    if (wr == 1) PG8_BAR;
    PG8_WAIT_V(4); PG8_BAR;
    PG8_STAGEB(PG8_SB(1, 0), cB + kstep); PG8_STAGE2(PG8_SA(1, 0), cA + kstep, VC0(0), VC0(1)); PG8_STAGEB(PG8_SB(1, 1), cB + hstepB + kstep);
    PG8_WAIT_V(6); PG8_BAR;
    for (;;) {
        const bool has_next = S.next(ui + 1, nxt);
        const GAS char* nB = cB; const GAS char* nA = cA;
        if (has_next) {
            nB = (const GAS char*)Bt + S.boff(nxt) * 2 + (size_t)nxt.pn * tstepB;
            if constexpr (!GA) nA = (const GAS char*)A + (size_t)nxt.pm * tstepA;
        }
        for (int t = 0; t < nt; t += 2) {
            const bool last = (t == nt - 2);
            if constexpr (Epi::HORNER) {
                if (t == 6 || t == 12) {
                    asm volatile("" ::: "memory");
                    const int seg = (t == 6) ? 0 : 1;
                    int hpm = cur.pm, hpn = cur.pn; asm volatile("" : "+s"(hpm), "+s"(hpn));
                    unsigned hln = (unsigned)lane; asm volatile("" : "+v"(hln)); const int hfr = (int)(hln & 15u), hfq = (int)(hln >> 4);
#pragma unroll
                    for (int ai = 0; ai < 2; ++ai) {
                        u32x2 ga[4][2][2], gb[4][2][2];
#pragma unroll
                        for (int m = 0; m < 4; ++m)
#pragma unroll
                            for (int bj = 0; bj < 2; ++bj)
#pragma unroll
                                for (int n = 0; n < 2; ++n) {
                                    const int row = hpm * BM + ai * HALF + wr * 64 + m * 16 + hfr, col = hpn * BM + bj * HALF + wc * 32 + n * 16 + 4 * hfq;
                                    ga[m][bj][n] = E.gate(seg, row, col); gb[m][bj][n] = E.gate(seg + 1, row, col);
                                }
                        asm volatile("" : "+v"(ga[0][0][0]), "+v"(ga[0][0][1]), "+v"(ga[0][1][0]), "+v"(ga[0][1][1]), "+v"(ga[1][0][0]), "+v"(ga[1][0][1]), "+v"(ga[1][1][0]), "+v"(ga[1][1][1]),
                                          "+v"(ga[2][0][0]), "+v"(ga[2][0][1]), "+v"(ga[2][1][0]), "+v"(ga[2][1][1]), "+v"(ga[3][0][0]), "+v"(ga[3][0][1]), "+v"(ga[3][1][0]), "+v"(ga[3][1][1]) :: "memory");
                        asm volatile("" : "+v"(gb[0][0][0]), "+v"(gb[0][0][1]), "+v"(gb[0][1][0]), "+v"(gb[0][1][1]), "+v"(gb[1][0][0]), "+v"(gb[1][0][1]), "+v"(gb[1][1][0]), "+v"(gb[1][1][1]),
                                          "+v"(gb[2][0][0]), "+v"(gb[2][0][1]), "+v"(gb[2][1][0]), "+v"(gb[2][1][1]), "+v"(gb[3][0][0]), "+v"(gb[3][0][1]), "+v"(gb[3][1][0]), "+v"(gb[3][1][1]) :: "memory");
#pragma unroll
                        for (int m = 0; m < 4; ++m)
#pragma unroll
                            for (int bj = 0; bj < 2; ++bj)
#pragma unroll
                                for (int n = 0; n < 2; ++n) {
                                    const u32x2 a = ga[m][bj][n], b = gb[m][bj][n];
                                    f32x4& v = acc[ai][bj][m][n];
                                    v.x *= __uint_as_float(a.x << 16) * __builtin_amdgcn_rcpf(__uint_as_float(b.x << 16));
                                    v.y *= __uint_as_float(a.x & 0xffff0000u) * __builtin_amdgcn_rcpf(__uint_as_float(b.x & 0xffff0000u));
                                    v.z *= __uint_as_float(a.y << 16) * __builtin_amdgcn_rcpf(__uint_as_float(b.y << 16));
                                    v.w *= __uint_as_float(a.y & 0xffff0000u) * __builtin_amdgcn_rcpf(__uint_as_float(b.y & 0xffff0000u));
                                }
                    }
                    asm volatile("s_waitcnt vmcnt(0)" ::: "memory");
                }
            }
            const GAS char* a1 = cA + (size_t)(t + 1) * kstep;
            const GAS char* a2 = last ? nA : cA + (size_t)(t + 2) * kstep; const GAS char* b2 = last ? nB : cB + (size_t)(t + 2) * kstep;
            const GAS char* a3 = a2 + kstep; const GAS char* b3 = b2 + kstep;
            PG8_LDB(B0, 0, 0); PG8_SCHED; PG8_LDA(At, 0, 0); PG8_STAGE2(PG8_SA(1, 1), a1 + hstepA, VC1(0), VC1(1));
            if constexpr (GA) { if (last && has_next) { asm volatile("" ::: "memory"); PG8_GATHER_OFFS(nxt.pm); asm volatile("" ::: "memory"); } }
            PG8_WAIT_L(8); PG8_BAR; PG8_WAIT_L(0); PG8_MMA(0, 0, At, B0); PG8_BAR; PG8_SCHED;
            PG8_LDB(B1, 0, 1); PG8_STAGEB(PG8_SB(0, 0), b2);
            PG8_BAR; PG8_WAIT_L(0); PG8_MMA(0, 1, At, B1); PG8_BAR;
            PG8_LDA(At, 0, 1); PG8_STAGE2(PG8_SA(0, 0), a2, VN0(0), VN0(1));
            PG8_BAR; PG8_WAIT_L(0); PG8_MMA(1, 0, At, B0); PG8_BAR; PG8_SCHED;
            PG8_STAGEB(PG8_SB(0, 1), b2 + hstepB);
            PG8_WAIT_V(6); PG8_BAR; PG8_MMA(1, 1, At, B1); PG8_BAR;
            PG8_LDB(B0, 1, 0); PG8_SCHED; PG8_LDA(At, 1, 0); PG8_STAGE2(PG8_SA(0, 1), a2 + hstepA, VN1(0), VN1(1));
            PG8_WAIT_L(8); PG8_BAR; PG8_WAIT_L(0); PG8_MMA(0, 0, At, B0); PG8_BAR; PG8_SCHED;
            PG8_LDB(B1, 1, 1); PG8_STAGEB(PG8_SB(1, 0), b3);
            PG8_BAR; PG8_WAIT_L(0); PG8_MMA(0, 1, At, B1); PG8_BAR;
            PG8_LDA(At, 1, 1); PG8_STAGE2(PG8_SA(1, 0), a3, VN0(0), VN0(1));
            PG8_BAR; PG8_WAIT_L(0); PG8_MMA(1, 0, At, B0); PG8_BAR; PG8_SCHED;
            PG8_STAGEB(PG8_SB(1, 1), b3 + hstepB);
            PG8_WAIT_V(6); PG8_BAR; PG8_MMA(1, 1, At, B1); PG8_BAR;
        }
        {
            int epm = cur.pm, epn = cur.pn; asm volatile("" : "+s"(epm), "+s"(epn));
            unsigned eln = (unsigned)lane; asm volatile("" : "+v"(eln)); const int efr = (int)(eln & 15u), efq = (int)(eln >> 4);
            f32x4 cv[2][2];
#pragma unroll
            for (int bj = 0; bj < 2; ++bj)
#pragma unroll
                for (int n = 0; n < 2; ++n) { if constexpr (Epi::COLVEC) cv[bj][n] = E.colvec(epm * BM, epn * BM + bj * HALF + wc * 32 + n * 16 + 4 * efq); else cv[bj][n] = (f32x4){0.f, 0.f, 0.f, 0.f}; }
            if constexpr (Epi::COLVEC) asm volatile("" : "+v"(cv[0][0]), "+v"(cv[0][1]), "+v"(cv[1][0]), "+v"(cv[1][1]) :: "memory");
#pragma unroll
            for (int ai = 0; ai < 2; ++ai) {
                f32x4 bs[4][2][2];
                if constexpr (Epi::BASE) {
#pragma unroll
                    for (int m = 0; m < 4; ++m)
#pragma unroll
                        for (int bj = 0; bj < 2; ++bj)
#pragma unroll
                            for (int n = 0; n < 2; ++n) bs[m][bj][n] = E.base(epm * BM + ai * HALF + wr * 64 + m * 16 + efr, epn * BM + bj * HALF + wc * 32 + n * 16 + 4 * efq);
                    asm volatile("" : "+v"(bs[0][0][0]), "+v"(bs[0][0][1]), "+v"(bs[0][1][0]), "+v"(bs[0][1][1]), "+v"(bs[1][0][0]), "+v"(bs[1][0][1]), "+v"(bs[1][1][0]), "+v"(bs[1][1][1]),
                                      "+v"(bs[2][0][0]), "+v"(bs[2][0][1]), "+v"(bs[2][1][0]), "+v"(bs[2][1][1]), "+v"(bs[3][0][0]), "+v"(bs[3][0][1]), "+v"(bs[3][1][0]), "+v"(bs[3][1][1]) :: "memory");
                }
#pragma unroll
                for (int m = 0; m < 4; ++m) {
                    const int row = epm * BM + ai * HALF + wr * 64 + m * 16 + efr;
#pragma unroll
                    for (int bj = 0; bj < 2; ++bj) {
                        if constexpr (Epi::PAIR) E.store_pair(row, epn * (BM / 2) + bj * (HALF / 2) + wc * 16 + 4 * efq, acc[ai][bj][m][0], acc[ai][bj][m][1]);
                        else {
#pragma unroll
                            for (int n = 0; n < 2; ++n) { f32x4 bb = (f32x4){0.f, 0.f, 0.f, 0.f}; if constexpr (Epi::BASE) bb = bs[m][bj][n]; E.store(row, epn * BM + bj * HALF + wc * 32 + n * 16 + 4 * efq, acc[ai][bj][m][n], cv[bj][n], bb); }
                        }
                    }
                }
            }
        }
        if (!has_next) break;
#pragma unroll
        for (int a = 0; a < 2; ++a)
#pragma unroll
            for (int b = 0; b < 2; ++b)
#pragma unroll
                for (int m = 0; m < 4; ++m)
#pragma unroll
                    for (int n = 0; n < 2; ++n) { float zf; asm volatile("v_mov_b32 %0, 0" : "=v"(zf)); acc[a][b][m][n] = (f32x4){zf, zf, zf, zf}; }
        cur = nxt; cB = nB; cA = nA; ++ui;
    }
    PG8_WAIT_V(0);
    if (wr == 0) PG8_BAR;
    PG8_BAR;
#undef PG8_GATHER_OFFS
#undef VC0
#undef VC1
#undef VN0
#undef VN1
#undef PG8_SA
#undef PG8_SB
#undef PG8_STAGE2
#undef PG8_STAGEB
#undef PG8_LDA
#undef PG8_LDB
#undef PG8_MMA
#undef PG8_WAIT_V
#undef PG8_WAIT_L
#undef PG8_BAR
#undef PG8_SCHED
}
}

template <class Epi>
__device__ __forceinline__ void gemm_fast(Frame& F, const GAS bf16* A, int lda, const GAS bf16* Bt, int ldb, int K, int M, int N, const Epi& E) {
    pg8::OrderPlain S; S.init(M / 256, N / 256, F.G, F.wg);
    pg8::gemm_phase(F.lds, F.tid, A, lda, Bt, ldb, K, S, E);
}
#ifndef FAST_PLAIN
#define FAST_PLAIN 1
#endif
#ifndef FAST_HORNER
#define FAST_HORNER 1
#endif
#ifndef FAST_MOE
#define FAST_MOE 1
#endif

__device__ __forceinline__ void st_bf16x4(GAS bf16* p, f32x4 v) { u32x2 w; w.x = pk2(v.x, v.y); w.y = pk2(v.z, v.w); *(GAS u32x2*)p = w; }
__device__ __forceinline__ f32x4 ld_bf16x4(const GAS bf16* p) { const u32x2 w = *(const GAS u32x2*)p; f32x4 v; v.x = __uint_as_float(w.x << 16); v.y = __uint_as_float(w.x & 0xffff0000u); v.z = __uint_as_float(w.y << 16); v.w = __uint_as_float(w.y & 0xffff0000u); return v; }

struct EpiWin {
    static constexpr bool HORNER = false, PAIR = false, COLVEC = true, BASE = false;
    const GAS float* bias; GAS bf16 *hytl, *hytc, *ret, *ml; GAS float* mlg;
    __device__ __forceinline__ f32x4 colvec(int, int col) const { return *(const GAS f32x4*)(bias + col); }
    __device__ __forceinline__ void store(int row, int col, f32x4 v, f32x4 cv, f32x4) const {
        v += cv;
        if (col < 1152) {
            if (row < TOKL) { const int b = row >> 11, t = row & 2047; GAS bf16* d = hytl + ((size_t)(b * 1152 + col)) * 2048 + t;
                d[0] = (bf16)f2bf(v.x); d[2048] = (bf16)f2bf(v.y); d[4096] = (bf16)f2bf(v.z); d[6144] = (bf16)f2bf(v.w); }
            else { const int r = row - TOKL, b = r >> 8, t = r & 255; GAS bf16* d = hytc + ((size_t)(b * 1152 + col)) * 256 + t;
                d[0] = (bf16)f2bf(v.x); d[256] = (bf16)f2bf(v.y); d[512] = (bf16)f2bf(v.z); d[768] = (bf16)f2bf(v.w); }
        } else if (col < 1168) { *(GAS f32x4*)(mlg + (size_t)row * 16 + (col - 1152)) = v; }
        else if (col < 1280) { }
        else if (col < 2816) st_bf16x4(ret + (size_t)row * 1536 + (col - 1280), v);
        else st_bf16x4(ml + (size_t)row * 1024 + (col - 2816), v);
    }
};
struct EpiGate {
    static constexpr bool HORNER = false, PAIR = false, COLVEC = true, BASE = false;
    const GAS float* bias; GAS bf16* gates;
    __device__ __forceinline__ f32x4 colvec(int, int col) const { return *(const GAS f32x4*)(bias + col); }
    __device__ __forceinline__ void store(int row, int col, f32x4 v, f32x4 cv, f32x4) const {
        v += cv;
        f32x4 g; g.x = fmaxf(sigmoidf_(v.x), 1e-20f); g.y = fmaxf(sigmoidf_(v.y), 1e-20f); g.z = fmaxf(sigmoidf_(v.z), 1e-20f); g.w = fmaxf(sigmoidf_(v.w), 1e-20f);
        st_bf16x4(gates + (size_t)row * NGATE + col, g);
    }
};
struct EpiUp {
    static constexpr bool HORNER = true, PAIR = false, COLVEC = false, BASE = true;
    const GAS bf16* gates; GAS bf16* acc_out;
    __device__ __forceinline__ u32x2 gate(int which, int row, int col) const { return *(const GAS u32x2*)(gates + (size_t)row * NGATE + which * 1024 + col); }
    __device__ __forceinline__ f32x4 base(int row, int col) const { return ld_bf16x4(gates + (size_t)row * NGATE + 2048 + col); }
    __device__ __forceinline__ void store(int row, int col, f32x4 v, f32x4, f32x4 g) const { st_bf16x4(acc_out + (size_t)row * D + col, v * g); }
};
struct EpiResid {
    static constexpr bool HORNER = false, PAIR = false, COLVEC = true, BASE = true;
    const GAS float *xin_l, *xin_c; GAS float *xout_l, *xout_c; const GAS float* modbase; int which;
    __device__ __forceinline__ f32x4 colvec(int row0, int col) const { const int r = row0 < TOKL ? (row0 >> 11) : 16; return *(const GAS f32x4*)(modbase + ((size_t)r * 6 + which) * 1024 + col); }
    __device__ __forceinline__ f32x4 base(int row, int col) const { return row < TOKL ? *(const GAS f32x4*)(xin_l + (size_t)row * D + col) : *(const GAS f32x4*)(xin_c + (size_t)(row - TOKL) * D + col); }
    __device__ __forceinline__ void store(int row, int col, f32x4 v, f32x4 m, f32x4 x) const {
        if (row < TOKL) *(GAS f32x4*)(xout_l + (size_t)row * D + col) = x + m * v;
        else *(GAS f32x4*)(xout_c + (size_t)(row - TOKL) * D + col) = x + m * v;
    }
};
struct EpiSwiglu {
    static constexpr bool HORNER = false, PAIR = true, COLVEC = false, BASE = false;
    GAS bf16* act; int row_off;
    __device__ __forceinline__ void store_pair(int row, int col, f32x4 a, f32x4 b) const {
        f32x4 o; o.x = siluf_(a.x) * b.x; o.y = siluf_(a.y) * b.y; o.z = siluf_(a.z) * b.z; o.w = siluf_(a.w) * b.w;
        st_bf16x4(act + (size_t)(row - row_off) * DFF + col, o);
    }
    __device__ __forceinline__ void store(int, int, f32x4, f32x4, f32x4) const {}
};
struct EpiBf16Out {
    static constexpr bool HORNER = false, PAIR = false, COLVEC = false, BASE = false;
    GAS bf16* out; int ld; int row_add;
    __device__ __forceinline__ void store(int row, int col, f32x4 v, f32x4, f32x4) const { st_bf16x4(out + (size_t)(row + row_add) * ld + col, v); }
    __device__ __forceinline__ void store_pair(int, int, f32x4, f32x4) const {}
};

constexpr int ZPITCH_L = (LL + 8) * 2, ZPITCH_C = (LC + 8) * 2;
template <int L>
__device__ __forceinline__ float conv3_at(const GAS bf16* base  , int t, float w0, float w1, float w2) {
    const float a = t > 0 ? bf2f(base[t - 1]) : 0.f, b = bf2f(base[t]), c = t < L - 1 ? bf2f(base[t + 1]) : 0.f;
    return w0 * a + w1 * b + w2 * c;
}
template <int L>
__device__ __forceinline__ void hyena_unit_naive(Frame& F, int layer, int c, const GAS bf16* hyt  , const GAS bf16* ft  , GAS bf16* yht  ) {
    constexpr int ZP = (L + 8) * 2;
    constexpr int PER = L / 32;
    constexpr int SUB = 8;
    LAS unsigned char* zimg0 = F.lds;
    LAS unsigned char* zimg1 = F.lds + 16 * ZP;
    LAS bf16* tf = (LAS bf16*)(F.lds + 32 * ZP);
    const GAS float* cw = inp(F, I_HYCONV) + layer * 3 * 1152;
    const GAS float* skip = inp(F, I_HYSKIP) + layer * 2 * 384;
    __syncthreads();
    {
        const int b = F.tid >> 5, seg = F.tid & 31; const GAS bf16* src = hyt + ((size_t)(b * 1152 + c)) * L;
        const float w0 = cw[c], w1 = cw[1152 + c], w2 = cw[2304 + c];
#pragma unroll 2
        for (int j = 0; j < PER; ++j) { const int t = seg * PER + j; *(LAS bf16*)(zimg0 + b * ZP + t * 2) = (bf16)f2bf(conv3_at<L>(src, t, w0, w1, w2)); }
    }
#pragma unroll 1
    for (int o = 0; o < 2; ++o) {
        LAS unsigned char* zs = o == 0 ? zimg0 : zimg1;
        LAS unsigned char* zd = o == 0 ? zimg1 : zimg0;
        const GAS bf16* fsrc = ft + ((size_t)(o * 384 + c)) * (2 * L);
        for (int i = F.tid; i < 2 * L; i += NTHR) tf[i] = i == 0 ? (bf16)0 : fsrc[i];
        __syncthreads();
        const int b = F.tid & 15, tg = F.tid >> 4;
        const int gcol = (o == 0 ? 384 : 768) + c;
        const GAS bf16* gsrc = hyt + ((size_t)(b * 1152 + gcol)) * L;
        const float w0 = cw[gcol], w1 = cw[1152 + gcol], w2 = cw[2304 + gcol], sk = skip[o * 384 + c];
#pragma unroll 1
        for (int sb = 0; sb < PER / SUB; ++sb) {
            const int t0 = tg * PER + sb * SUB;
            float acc[SUB];
#pragma unroll
            for (int j = 0; j < SUB; ++j) acc[j] = 0.f;
#pragma unroll 1
            for (int s0 = 0; s0 < L; s0 += 8) {
                float z[8];
                { const bf16x8 zz = *(const LAS bf16x8*)(zs + b * ZP + s0 * 2);
#pragma unroll
                  for (int i = 0; i < 8; ++i) z[i] = bf2f((bf16)zz[i]); }
                float win[SUB + 7];
                const int wb = L + s0 - t0 - (SUB - 1);
#pragma unroll
                for (int i = 0; i < SUB + 7; ++i) win[i] = bf2f(tf[wb + i]);
#pragma unroll
                for (int j = 0; j < SUB; ++j)
#pragma unroll
                    for (int i = 0; i < 8; ++i) acc[j] += win[(SUB - 1) - j + i] * z[i];
            }
#pragma unroll
            for (int j = 0; j < SUB; ++j) {
                const int t = t0 + j;
                const float zt = bf2f(*(LAS bf16*)(zs + b * ZP + t * 2));
                const float ov = conv3_at<L>(gsrc, t, w0, w1, w2) * (acc[j] + sk * zt);
                *(LAS bf16*)(zd + b * ZP + t * 2) = (bf16)f2bf(ov);
            }
        }
        __syncthreads();
    }
#pragma unroll 2
    for (int i = F.tid; i < 16 * (L / 8); i += NTHR) {
        const int b = i / (L / 8), ch = i % (L / 8);
        *(GAS u32x4*)(yht + ((size_t)(b * 384 + c)) * L + ch * 8) = *(const LAS u32x4*)(zimg0 + b * ZP + ch * 16);
    }
}

template <int L>
__device__ __forceinline__ void hyena_unit_fast(Frame& F, int layer, int c, const GAS bf16* hyt  , const GAS bf16* ft  , GAS bf16* yht  ) {
    constexpr int ZP = (L + 8) * 2;
    constexpr int PER = L / 32;
    constexpr int I = L / 128;
    constexpr int SPAN = L / 4, NSTEP = L / 32;
    constexpr int CP = (2 * L + 8) * 2;
    LAS unsigned char* zimg = F.lds;
    LAS unsigned char* cpy = F.lds + 16 * ZP;
    const GAS float* cw = inp(F, I_HYCONV) + layer * 3 * 1152;
    const GAS float* skip = inp(F, I_HYSKIP) + layer * 2 * 384;
    const int lane = F.lane, fr = lane & 15, fq = lane >> 4, w = F.wave;
    { unsigned long long a_ = (unsigned long long)hyt, b_ = (unsigned long long)yht; asm volatile("" : "+s"(a_), "+s"(b_)); hyt = (const GAS bf16*)a_; yht = (GAS bf16*)b_; }
    __syncthreads();
    {
        const int b = F.tid >> 5, sg = F.tid & 31, t0 = sg * PER; const GAS bf16* src = hyt + ((size_t)(b * 1152 + c)) * L + t0;
        const float w0 = cw[c], w1 = cw[1152 + c], w2 = cw[2304 + c];
        u32x4 raw[PER / 8];
#pragma unroll
        for (int j = 0; j < PER / 8; ++j) raw[j] = *(const GAS u32x4*)(src + 8 * j);
        float prev = t0 > 0 ? bf2f(src[-1]) : 0.f;
        const float nextv = t0 + PER < L ? bf2f(src[PER]) : 0.f;
#pragma unroll
        for (int j = 0; j < PER / 8; ++j) {
            const unsigned wv[4] = {raw[j].x, raw[j].y, raw[j].z, raw[j].w};
            float x[10]; x[0] = prev;
#pragma unroll
            for (int q = 0; q < 4; ++q) { x[1 + 2 * q] = __uint_as_float(wv[q] << 16); x[2 + 2 * q] = __uint_as_float(wv[q] & 0xffff0000u); }
            if (j + 1 < PER / 8) x[9] = __uint_as_float(raw[(j + 1 < PER / 8) ? j + 1 : j].x << 16); else x[9] = nextv;
            u32x4 o;
            o.x = pk2(w0 * x[0] + w1 * x[1] + w2 * x[2], w0 * x[1] + w1 * x[2] + w2 * x[3]); o.y = pk2(w0 * x[2] + w1 * x[3] + w2 * x[4], w0 * x[3] + w1 * x[4] + w2 * x[5]);
            o.z = pk2(w0 * x[4] + w1 * x[5] + w2 * x[6], w0 * x[5] + w1 * x[6] + w2 * x[7]); o.w = pk2(w0 * x[6] + w1 * x[7] + w2 * x[8], w0 * x[7] + w1 * x[8] + w2 * x[9]);
            *(LAS u32x4*)(zimg + b * ZP + (t0 + 8 * j) * 2) = o;
            prev = x[8];
        }
    }
    const int tbase = SPAN * (w >> 1) + 16 * (w & 1);
    const int flane = L - tbase + 8 * fq - fr;
    const int msh = fr & 7;
    const LAS unsigned char* fbase = cpy + msh * CP + 2 * (flane + msh);
#pragma unroll 1
    for (int o = 0; o < 2; ++o) {
        const GAS bf16* fsrc = ft + ((size_t)(o * 384 + c)) * (2 * L);
        for (int i = F.tid; i < CP / 16; i += NTHR) { u32x4 v = (u32x4){0u, 0u, 0u, 0u}; if (i < 2 * L / 8) v = *(const GAS u32x4*)(fsrc + 8 * i); if (i == 0) v.x &= 0xffff0000u; *(LAS u32x4*)(cpy + 16 * i) = v; }
        __syncthreads();
        for (int task = F.tid; task < 7 * (CP / 16); task += NTHR) {
            const int m = 1 + task / (CP / 16), x8 = task % (CP / 16);
            unsigned short e[8];
#pragma unroll
            for (int i = 0; i < 8; ++i) { const int idx = 8 * x8 - m + i; e[i] = idx >= 0 ? *(const LAS unsigned short*)(cpy + 2 * idx) : (unsigned short)0; }
            u32x4 v; v.x = e[0] | ((unsigned)e[1] << 16); v.y = e[2] | ((unsigned)e[3] << 16); v.z = e[4] | ((unsigned)e[5] << 16); v.w = e[6] | ((unsigned)e[7] << 16);
            *(LAS u32x4*)(cpy + m * CP + 16 * x8) = v;
        }
        __syncthreads();
        f32x4 acc[I];
#pragma unroll
        for (int i = 0; i < I; ++i) acc[i] = (f32x4){0.f, 0.f, 0.f, 0.f};
        bf16x8 ring[I];
#pragma unroll
        for (int i = 1; i < I; ++i) ring[(I - i) % I] = *(const LAS bf16x8*)(fbase - 64 * i);
        bf16x8 nf = *(const LAS bf16x8*)(fbase);
        const LAS unsigned char* zrow = zimg + fr * ZP + 16 * fq;
#pragma unroll 1
        for (int j0 = 0; j0 < NSTEP; j0 += I) {
#pragma unroll
            for (int jj = 0; jj < I; ++jj) {
                const int j = j0 + jj;
                ring[jj] = nf;
                if (j + 1 < NSTEP) nf = *(const LAS bf16x8*)(fbase + 64 * (j + 1));
                const bf16x8 zf = *(const LAS bf16x8*)(zrow + 64 * j);
#pragma unroll
                for (int i = 0; i < I; ++i) acc[i] = __builtin_amdgcn_mfma_f32_16x16x32_bf16(ring[(jj - i + I) % I], zf, acc[i], 0, 0, 0);
            }
        }
        unsigned el_ = (unsigned)lane; asm volatile("" : "+v"(el_)); const int efr = (int)(el_ & 15u), efq = (int)(el_ >> 4);
        const int etb = SPAN * (w >> 1) + 16 * (w & 1);
        const int gcol = (o == 0 ? 384 : 768) + c;
        const GAS bf16* gsrc = hyt + ((size_t)(efr * 1152 + gcol)) * L;
        const float w0 = cw[gcol], w1 = cw[1152 + gcol], w2 = cw[2304 + gcol], sk = skip[o * 384 + c];
        GAS bf16* dst = yht + ((size_t)(efr * 384 + c)) * L;
        constexpr int GI = I < 8 ? I : 8;
#pragma unroll
        for (int i0 = 0; i0 < I; i0 += GI) {
            u32x2 grv[GI]; unsigned short gmv[GI], gpv[GI];
#pragma unroll
            for (int ii = 0; ii < GI; ++ii) {
                const int t = etb + 32 * (i0 + ii) + 4 * efq;
                grv[ii] = *(const GAS u32x2*)(gsrc + t); gmv[ii] = t > 0 ? gsrc[t - 1] : (unsigned short)0; gpv[ii] = t + 4 < L ? gsrc[t + 4] : (unsigned short)0;
            }
            asm volatile("" ::: "memory");
#pragma unroll
            for (int ii = 0; ii < GI; ++ii) {
                const int i = i0 + ii;
                const int t = etb + 32 * i + 4 * efq;
                const u32x2 zr = *(const LAS u32x2*)(zimg + efr * ZP + t * 2);
                const u32x2 gr = grv[ii];
                const float gm = bf2f(gmv[ii]), gp = bf2f(gpv[ii]);
                const float g0 = __uint_as_float(gr.x << 16), g1 = __uint_as_float(gr.x & 0xffff0000u), g2 = __uint_as_float(gr.y << 16), g3 = __uint_as_float(gr.y & 0xffff0000u);
                const float z0 = __uint_as_float(zr.x << 16), z1 = __uint_as_float(zr.x & 0xffff0000u), z2 = __uint_as_float(zr.y << 16), z3 = __uint_as_float(zr.y & 0xffff0000u);
                const float o0 = (w0 * gm + w1 * g0 + w2 * g1) * (acc[i].x + sk * z0), o1 = (w0 * g0 + w1 * g1 + w2 * g2) * (acc[i].y + sk * z1);
                const float o2 = (w0 * g1 + w1 * g2 + w2 * g3) * (acc[i].z + sk * z2), o3 = (w0 * g2 + w1 * g3 + w2 * gp) * (acc[i].w + sk * z3);
                acc[i] = (f32x4){o0, o1, o2, o3};
            }
        }
        __syncthreads();
#pragma unroll
        for (int i = 0; i < I; ++i) {
            const int t = etb + 32 * i + 4 * efq;
            u32x2 ov; ov.x = pk2(acc[i].x, acc[i].y); ov.y = pk2(acc[i].z, acc[i].w);
            if (o == 0) *(LAS u32x2*)(zimg + efr * ZP + t * 2) = ov;
            else *(GAS u32x2*)(dst + t) = ov;
        }
    }
}

__device__ __forceinline__ void chain_naive(Frame& F, int layer, int chain) {
    const int lane = F.lane;
    const bool is_ret = chain < 192;
    int b, h, dir;
    if (is_ret) { b = chain / 12; const int r = chain % 12; h = r >> 1; dir = r & 1; }
    else { const int i = chain - 192; b = i >> 3; h = (i & 7) >> 1; dir = i & 1; }
    const GAS bf16* RET = WSP(const bf16, WS_RET); const GAS bf16* ML = WSP(const bf16, WS_ML); const GAS float* MLG = WSP(const float, WS_MLG);
    const GAS float* rope = WSP(const float, WS_ROPE);
    GAS bf16* Y = WSP(bf16, WS_Y); GAS bf16* OB = WSP(bf16, WS_OB);
    float gam = 0.f;
    if (is_ret) gam = sigmoidf_(inp(F, I_RETDECAY)[layer * 12 + dir * 6 + h]);
    const GAS float* mlc = inp(F, I_MLCONV) + layer * 3 * 512;
    const float bi = is_ret ? 0.f : inp(F, I_MLGB)[layer * 16 + dir * 8 + h], bfg = is_ret ? 0.f : inp(F, I_MLGB)[layer * 16 + dir * 8 + 4 + h];
    const float qw0 = mlc[h * 64 + lane], qw1 = mlc[512 + h * 64 + lane], qw2 = mlc[1024 + h * 64 + lane];
    const float kw0 = mlc[256 + h * 64 + lane], kw1 = mlc[512 + 256 + h * 64 + lane], kw2 = mlc[1024 + 256 + h * 64 + lane];
    float S[64];
#pragma unroll
    for (int d = 0; d < 64; ++d) S[d] = 0.f;
    float nv = 0.f;
    for (int step = 0; step < LC + LL; ++step) {
        int row, tpos, L; bool lat;
        if (step < LC) { tpos = dir ? (LC - 1 - step) : step; row = TOKL + b * LC + tpos; L = LC; lat = false; }
        else { const int s2 = step - LC; tpos = dir ? (LL - 1 - s2) : s2; row = b * LL + tpos; L = LL; lat = true; }
        float q, k, v, Fm, Im;
        if (is_ret) {
            const GAS bf16* base = RET + (size_t)row * 1536;
            float qs = bf2f(base[h * 64 + lane]), ks = bf2f(base[384 + h * 64 + lane]);
            v = bf2f(base[768 + h * 64 + lane]);
            if (lat) {
                const float qp = bf2f(base[h * 64 + (lane ^ 16)]), kp = bf2f(base[384 + h * 64 + (lane ^ 16)]);
                const int half = lane >> 5, ii = lane & 15, hi = (lane >> 4) & 1;
                const float cs = rope[tpos * 64 + half * 32 + ii], sn = rope[tpos * 64 + half * 32 + 16 + ii];
                q = hi == 0 ? qs * cs - qp * sn : qp * sn + qs * cs;
                k = hi == 0 ? ks * cs - kp * sn : kp * sn + ks * cs;
            } else { q = qs; k = ks; }
            q *= 0.125f; Fm = gam; Im = 1.f;
        } else {
            const GAS bf16* base = ML + (size_t)row * 1024;
            const float q0 = tpos > 0 ? bf2f(base[-1024 + h * 64 + lane]) : 0.f, q1 = bf2f(base[h * 64 + lane]), q2 = tpos < L - 1 ? bf2f(base[1024 + h * 64 + lane]) : 0.f;
            const float k0 = tpos > 0 ? bf2f(base[-1024 + 256 + h * 64 + lane]) : 0.f, k1 = bf2f(base[256 + h * 64 + lane]), k2 = tpos < L - 1 ? bf2f(base[1024 + 256 + h * 64 + lane]) : 0.f;
            q = siluf_(qw0 * q0 + qw1 * q1 + qw2 * q2);
            k = siluf_(kw0 * k0 + kw1 * k1 + kw2 * k2) * 0.125f;
            v = bf2f(base[512 + h * 64 + lane]);
            const float ig = MLG[(size_t)row * 16 + dir * 8 + h] + bi, fg = MLG[(size_t)row * 16 + dir * 8 + 4 + h] + bfg;
            Fm = sigmoidf_(fg); Im = __expf(ig);
        }
        float num = 0.f;
        const float iv = Im * v;
#pragma unroll
        for (int d = 0; d < 64; ++d) {
            const float kd = __int_as_float(__builtin_amdgcn_readlane(__float_as_int(k), d));
            const float qd = __int_as_float(__builtin_amdgcn_readlane(__float_as_int(q), d));
            S[d] = Fm * S[d] + kd * iv;
            num += qd * S[d];
        }
        float o = num;
        if (!is_ret) { nv = Fm * nv + Im * k; const float den = wave_sum(q * nv); o = num / fmaxf(fabsf(den), 1.f); }
        const int cof = is_ret ? (h * 64 + lane) : (384 + h * 64 + lane);
        if (dir == 0) Y[(size_t)row * D + 384 + cof] = (bf16)f2bf(o);
        else OB[(size_t)row * 640 + cof] = (bf16)f2bf(o);
    }
}

#ifndef REP_CH
#define REP_CH 1
#endif
constexpr int CH_PITCH = 144;
constexpr int CH_IMG = 64 * CH_PITCH;
constexpr int CH_WAVE_LDS = 3 * CH_IMG + 1024 + 512;
__device__ __forceinline__ void ds_tr16x8(unsigned addr, u32x2 (&lo)[4], u32x2 (&hi)[4]) {
    asm volatile("ds_read_b64_tr_b16 %0, %8\n\tds_read_b64_tr_b16 %1, %8 offset:32\n\tds_read_b64_tr_b16 %2, %8 offset:64\n\tds_read_b64_tr_b16 %3, %8 offset:96\n\t"
                 "ds_read_b64_tr_b16 %4, %8 offset:2304\n\tds_read_b64_tr_b16 %5, %8 offset:2336\n\tds_read_b64_tr_b16 %6, %8 offset:2368\n\tds_read_b64_tr_b16 %7, %8 offset:2400\n\t"
                 "s_waitcnt lgkmcnt(0)"
                 : "=&v"(lo[0]), "=&v"(lo[1]), "=&v"(lo[2]), "=&v"(lo[3]), "=&v"(hi[0]), "=&v"(hi[1]), "=&v"(hi[2]), "=&v"(hi[3]) : "v"(addr) : "memory");
}
static_assert(16 * CH_PITCH == 2304, "ds_tr16x8 offsets");
__device__ __forceinline__ void ds_tr16x4(unsigned addr, u32x2 (&lo)[2], u32x2 (&hi)[2]) {
    asm volatile("ds_read_b64_tr_b16 %0, %4\n\tds_read_b64_tr_b16 %1, %4 offset:32\n\tds_read_b64_tr_b16 %2, %4 offset:2304\n\tds_read_b64_tr_b16 %3, %4 offset:2336\n\ts_waitcnt lgkmcnt(0)"
                 : "=&v"(lo[0]), "=&v"(lo[1]), "=&v"(hi[0]), "=&v"(hi[1]) : "v"(addr) : "memory");
}
__device__ __forceinline__ float log_sigmoid_(float x) { return fminf(x, 0.f) - log1pf(__expf(-fabsf(x))); }
__device__ __forceinline__ bf16x8 mk_frag(u32x2 lo, u32x2 hi) { u32x4 w; w.x = lo.x; w.y = lo.y; w.z = hi.x; w.w = hi.y; return __builtin_bit_cast(bf16x8, w); }

template <bool IS_ML>
__device__ __forceinline__ void chain_fast(Frame& F, int layer, int b, int h, int dir, LAS unsigned char* img, int hf) {
    constexpr int NET = 2;
    const int lane = F.lane, fr = lane & 15, fq = lane >> 4;
    LAS unsigned char* Qi = img; LAS unsigned char* Ki = img + CH_IMG; LAS unsigned char* Vi = img + 2 * CH_IMG;
    const unsigned qa = (unsigned)(size_t)Qi, ka = (unsigned)(size_t)Ki, va = (unsigned)(size_t)Vi;
    const GAS bf16* RET = WSP(const bf16, WS_RET); const GAS bf16* ML = WSP(const bf16, WS_ML); const GAS float* MLG = WSP(const float, WS_MLG);
    const GAS float* rope = WSP(const float, WS_ROPE);
    GAS bf16* Y = WSP(bf16, WS_Y); GAS bf16* OB = WSP(bf16, WS_OB);
    float lgam = 0.f, bi_ = 0.f, bf_ = 0.f;
    if (!IS_ML) lgam = log_sigmoid_(inp(F, I_RETDECAY)[layer * 12 + dir * 6 + h]);
    else { bi_ = inp(F, I_MLGB)[layer * 16 + dir * 8 + h]; bf_ = inp(F, I_MLGB)[layer * 16 + dir * 8 + 4 + h]; }
    const GAS float* mlc = inp(F, I_MLCONV) + layer * 3 * 512;
    f32x4 C[4][NET];
#pragma unroll
    for (int dt = 0; dt < 4; ++dt)
#pragma unroll
        for (int et = 0; et < NET; ++et) C[dt][et] = (f32x4){0.f, 0.f, 0.f, 0.f};
    const int cq = lane & 7, pr0 = lane >> 3;
    LAS float* nvec = (LAS float*)(img + 3 * CH_IMG + 1024 + 256 * hf);
    if (IS_ML) nvec[lane] = 0.f;
    const LAS float* nq = nvec + 4 * fq;
#pragma unroll 1
    for (int step_ = 0; step_ < 36 * REP_CH; ++step_) {
        const int step = step_ % 36;
        if (REP_CH > 1 && step == 0) {
            if (IS_ML) nvec[lane] = 0.f;
#pragma unroll
            for (int dt = 0; dt < 4; ++dt)
#pragma unroll
                for (int et = 0; et < NET; ++et) C[dt][et] = (f32x4){0.f, 0.f, 0.f, 0.f};
        }
        int rowbase, t0, L; bool lat;
        if (step < 4) { const int cc = dir ? 3 - step : step; rowbase = TOKL + b * LC + cc * 64; t0 = cc * 64; L = LC; lat = false; }
        else { const int cc = dir ? 35 - step : step - 4; rowbase = b * LL + cc * 64; t0 = cc * 64; L = LL; lat = true; }
        float g_i = 0.f, g_f = 0.f;
        if (IS_ML) { const int tlg = dir ? 63 - lane : lane; const GAS float* gp = MLG + (size_t)(rowbase + tlg) * 16 + dir * 8 + h; g_i = gp[0]; g_f = gp[4]; }
        if constexpr (!IS_ML) {
#pragma unroll
        for (int i4 = 0; i4 < 4; ++i4) {
            const int i = 4 * hf + i4;
            const int p = pr0 + 8 * i, tl = dir ? 63 - p : p, row = rowbase + tl, tpos = t0 + tl;
            float qv[8], kv[8]; u32x4 vraw;
            {
                const GAS bf16* base = RET + (size_t)row * 1536 + h * 64;
                const u32x4 qr = *(const GAS u32x4*)(base + 8 * cq), kr = *(const GAS u32x4*)(base + 384 + 8 * cq); vraw = *(const GAS u32x4*)(base + 768 + 8 * cq);
                const unsigned qw[4] = {qr.x, qr.y, qr.z, qr.w}, kw[4] = {kr.x, kr.y, kr.z, kr.w};
#pragma unroll
                for (int j = 0; j < 4; ++j) { qv[2 * j] = __uint_as_float(qw[j] << 16); qv[2 * j + 1] = __uint_as_float(qw[j] & 0xffff0000u); kv[2 * j] = __uint_as_float(kw[j] << 16); kv[2 * j + 1] = __uint_as_float(kw[j] & 0xffff0000u); }
                if (lat) {
                    const u32x4 qpr = *(const GAS u32x4*)(base + 8 * (cq ^ 2)), kpr = *(const GAS u32x4*)(base + 384 + 8 * (cq ^ 2));
                    const unsigned qpw[4] = {qpr.x, qpr.y, qpr.z, qpr.w}, kpw[4] = {kpr.x, kpr.y, kpr.z, kpr.w};
                    const int half = cq >> 2, hi = (cq >> 1) & 1, i0 = 8 * (cq & 1);
                    const GAS float* rp = rope + tpos * 64 + half * 32 + i0;
                    const f32x4 c0 = *(const GAS f32x4*)(rp), c1 = *(const GAS f32x4*)(rp + 4), s0 = *(const GAS f32x4*)(rp + 16), s1 = *(const GAS f32x4*)(rp + 20);
                    const float cs[8] = {c0.x, c0.y, c0.z, c0.w, c1.x, c1.y, c1.z, c1.w}, sn[8] = {s0.x, s0.y, s0.z, s0.w, s1.x, s1.y, s1.z, s1.w};
#pragma unroll
                    for (int j = 0; j < 8; ++j) {
                        const float qp = (j & 1) ? __uint_as_float(qpw[j >> 1] & 0xffff0000u) : __uint_as_float(qpw[j >> 1] << 16);
                        const float kp = (j & 1) ? __uint_as_float(kpw[j >> 1] & 0xffff0000u) : __uint_as_float(kpw[j >> 1] << 16);
                        qv[j] = hi ? qp * sn[j] + qv[j] * cs[j] : qv[j] * cs[j] - qp * sn[j];
                        kv[j] = hi ? kp * sn[j] + kv[j] * cs[j] : kv[j] * cs[j] - kp * sn[j];
                    }
                }
#pragma unroll
                for (int j = 0; j < 8; ++j) qv[j] *= 0.125f;
            }
            u32x4 qo, ko; qo.x = pk2(qv[0], qv[1]); qo.y = pk2(qv[2], qv[3]); qo.z = pk2(qv[4], qv[5]); qo.w = pk2(qv[6], qv[7]);
            ko.x = pk2(kv[0], kv[1]); ko.y = pk2(kv[2], kv[3]); ko.z = pk2(kv[4], kv[5]); ko.w = pk2(kv[6], kv[7]);
            *(LAS u32x4*)(Qi + p * CH_PITCH + 16 * cq) = qo; *(LAS u32x4*)(Ki + p * CH_PITCH + 16 * cq) = ko; *(LAS u32x4*)(Vi + p * CH_PITCH + 16 * cq) = vraw;
        }
        } else {
            const GAS float* wq = mlc + h * 64 + 8 * cq;
#pragma unroll
            for (int qk = 0; qk < 2; ++qk) {
                u32x4 r0[4], r1[4], r2[4], vr[4];
                f32x4 wt[3][2];
#pragma unroll
                for (int tp = 0; tp < 3; ++tp) { wt[tp][0] = *(const GAS f32x4*)(wq + 256 * qk + 512 * tp); wt[tp][1] = *(const GAS f32x4*)(wq + 256 * qk + 512 * tp + 4); }
#pragma unroll
                for (int i4 = 0; i4 < 4; ++i4) {
                    const int p = pr0 + 8 * (4 * hf + i4), tl = dir ? 63 - p : p, row = rowbase + tl, tpos = t0 + tl;
                    const GAS bf16* bb = ML + (size_t)row * 1024 + h * 64 + 8 * cq + 256 * qk;
                    const u32x4 z4 = (u32x4){0u, 0u, 0u, 0u};
                    r1[i4] = *(const GAS u32x4*)(bb); r0[i4] = tpos > 0 ? *(const GAS u32x4*)(bb - 1024) : z4; r2[i4] = tpos < L - 1 ? *(const GAS u32x4*)(bb + 1024) : z4;
                    if (qk == 1) vr[i4] = *(const GAS u32x4*)(bb + 256);
                }
#pragma unroll
                for (int i4 = 0; i4 < 4; ++i4) {
                    const int p = pr0 + 8 * (4 * hf + i4);
                    const unsigned a0[4] = {r0[i4].x, r0[i4].y, r0[i4].z, r0[i4].w}, a1[4] = {r1[i4].x, r1[i4].y, r1[i4].z, r1[i4].w}, a2[4] = {r2[i4].x, r2[i4].y, r2[i4].z, r2[i4].w};
                    float ov[8];
#pragma unroll
                    for (int j = 0; j < 8; ++j) {
                        const float x0 = (j & 1) ? __uint_as_float(a0[j >> 1] & 0xffff0000u) : __uint_as_float(a0[j >> 1] << 16);
                        const float x1 = (j & 1) ? __uint_as_float(a1[j >> 1] & 0xffff0000u) : __uint_as_float(a1[j >> 1] << 16);
                        const float x2 = (j & 1) ? __uint_as_float(a2[j >> 1] & 0xffff0000u) : __uint_as_float(a2[j >> 1] << 16);
                        const float r = siluf_(wt[0][j >> 2][j & 3] * x0 + wt[1][j >> 2][j & 3] * x1 + wt[2][j >> 2][j & 3] * x2);
                        ov[j] = qk == 0 ? r : r * 0.125f;
                    }
                    u32x4 o; o.x = pk2(ov[0], ov[1]); o.y = pk2(ov[2], ov[3]); o.z = pk2(ov[4], ov[5]); o.w = pk2(ov[6], ov[7]);
                    if (qk == 0) *(LAS u32x4*)(Qi + p * CH_PITCH + 16 * cq) = o;
                    else { *(LAS u32x4*)(Ki + p * CH_PITCH + 16 * cq) = o; *(LAS u32x4*)(Vi + p * CH_PITCH + 16 * cq) = vr[i4]; }
                }
                asm volatile("" ::: "memory");
            }
        }
        __builtin_amdgcn_sched_barrier(0);
        float f_p, i_p;
        if (!IS_ML) { f_p = lgam; i_p = 0.f; }
        else { i_p = g_i + bi_; f_p = log_sigmoid_(g_f + bf_); }
        float bsum = f_p;
#pragma unroll
        for (int o = 1; o < 64; o <<= 1) { const float t = lane_read(bsum, lane >= o ? lane - o : lane); if (lane >= o) bsum += t; }
        LAS float* gv = (LAS float*)(img + 3 * CH_IMG);
        const float b63 = __int_as_float(__builtin_amdgcn_readlane(__float_as_int(bsum), 63));
        const float adec = __expf(b63);
        if (hf == 0) { gv[lane] = bsum; gv[64 + lane] = bsum - i_p; gv[128 + lane] = __expf(bsum); gv[192 + lane] = __expf(b63 - (bsum - i_p)); }
        asm volatile("s_waitcnt lgkmcnt(0)" ::: "memory");
        __syncthreads();
        const LAS float* gq = gv + 4 * fq;
        const bf16x8 ones = (fr == 0) ? (bf16x8){0x3F80, 0x3F80, 0x3F80, 0x3F80, 0x3F80, 0x3F80, 0x3F80, 0x3F80} : (bf16x8){0, 0, 0, 0, 0, 0, 0, 0};
        const int tr_q = fr >> 2, tr_p = fr & 3;
#pragma unroll 1
        for (int pt = 0; pt < 4; ++pt) {
            f32x4 ST[4];
            bf16x8 qn[2];
#pragma unroll
            for (int kk = 0; kk < 2; ++kk) qn[kk] = *(const LAS bf16x8*)(Qi + (16 * pt + fr) * CH_PITCH + (32 * kk + 8 * fq) * 2);
#pragma unroll
            for (int st = 0; st < 4; ++st) {
                ST[st] = (f32x4){0.f, 0.f, 0.f, 0.f};
                if (st <= pt) {
#pragma unroll
                    for (int kk = 0; kk < 2; ++kk) { const bf16x8 kf = *(const LAS bf16x8*)(Ki + (16 * st + fr) * CH_PITCH + (32 * kk + 8 * fq) * 2); ST[st] = __builtin_amdgcn_mfma_f32_16x16x32_bf16(kf, qn[kk], ST[st], 0, 0, 0); }
                }
            }
            const float bp = gv[16 * pt + fr];
#pragma unroll
            for (int st = 0; st < 4; ++st) {
                if (st <= pt) {
                    const f32x4 bis = *(const LAS f32x4*)(gq + 64 + 16 * st);
#pragma unroll
                    for (int j = 0; j < 4; ++j) { const int sidx = 16 * st + 4 * fq + j; const float w = (sidx <= 16 * pt + fr) ? __expf(bp - bis[j]) : 0.f; ST[st][j] *= w; }
                }
            }
            __builtin_amdgcn_sched_barrier(0);
            f32x4 acc[NET], accd = (f32x4){0.f, 0.f, 0.f, 0.f};
#pragma unroll
            for (int et = 0; et < NET; ++et) acc[et] = (f32x4){0.f, 0.f, 0.f, 0.f};
#pragma unroll
            for (int kk = 0; kk < 2; ++kk) {
                const u32x2 lo = *(const LAS u32x2*)(Qi + (16 * pt + fr) * CH_PITCH + (32 * kk + 4 * fq) * 2), hi = *(const LAS u32x2*)(Qi + (16 * pt + fr) * CH_PITCH + (32 * kk + 16 + 4 * fq) * 2);
                const bf16x8 qs = mk_frag(lo, hi);
#pragma unroll
                for (int et = 0; et < NET; ++et) {
                    u32x4 w; w.x = pk2(C[2 * kk][et].x, C[2 * kk][et].y); w.y = pk2(C[2 * kk][et].z, C[2 * kk][et].w); w.z = pk2(C[2 * kk + 1][et].x, C[2 * kk + 1][et].y); w.w = pk2(C[2 * kk + 1][et].z, C[2 * kk + 1][et].w);
                    acc[et] = __builtin_amdgcn_mfma_f32_16x16x32_bf16(qs, __builtin_bit_cast(bf16x8, w), acc[et], 0, 0, 0);
                }
                if (IS_ML) {
                    const f32x4 n0 = *(const LAS f32x4*)(nq + 32 * kk), n1 = *(const LAS f32x4*)(nq + 32 * kk + 16);
                    u32x4 w; w.x = pk2(n0.x, n0.y); w.y = pk2(n0.z, n0.w); w.z = pk2(n1.x, n1.y); w.w = pk2(n1.z, n1.w);
                    if (fr != 0) w = (u32x4){0u, 0u, 0u, 0u};
                    accd = __builtin_amdgcn_mfma_f32_16x16x32_bf16(qs, __builtin_bit_cast(bf16x8, w), accd, 0, 0, 0);
                }
            }
            { const f32x4 ap = *(const LAS f32x4*)(gq + 128 + 16 * pt);
#pragma unroll
              for (int j = 0; j < 4; ++j) {
#pragma unroll
                for (int et = 0; et < NET; ++et) acc[et][j] *= ap[j];
                accd[j] *= ap[j]; } }
            __builtin_amdgcn_sched_barrier(0);
#pragma unroll
            for (int kk = 0; kk < 2; ++kk) {
                if (2 * kk <= pt) {
                    u32x4 w; w.x = pk2(ST[2 * kk].x, ST[2 * kk].y); w.y = pk2(ST[2 * kk].z, ST[2 * kk].w); w.z = pk2(ST[2 * kk + 1].x, ST[2 * kk + 1].y); w.w = pk2(ST[2 * kk + 1].z, ST[2 * kk + 1].w);
                    const bf16x8 pf = __builtin_bit_cast(bf16x8, w);
                    u32x2 vlo[2], vhi[2];
                    ds_tr16x4(va + (32 * kk + 4 * fq + tr_q) * CH_PITCH + 8 * tr_p + 64 * hf, vlo, vhi);
#pragma unroll
                    for (int et = 0; et < NET; ++et) acc[et] = __builtin_amdgcn_mfma_f32_16x16x32_bf16(pf, mk_frag(vlo[et], vhi[et]), acc[et], 0, 0, 0);
                    if (IS_ML) accd = __builtin_amdgcn_mfma_f32_16x16x32_bf16(pf, ones, accd, 0, 0, 0);
                }
            }
            __builtin_amdgcn_sched_barrier(0);
#pragma unroll
            for (int j = 0; j < 4; ++j) {
                const int p = 16 * pt + 4 * fq + j, tl = dir ? 63 - p : p, row = rowbase + tl;
                float inv = 1.f;
                if (IS_ML) { const float den = lane_read(accd[j], lane & 48); inv = __builtin_amdgcn_rcpf(fmaxf(fabsf(den), 1.f)); }
                const int cof = (IS_ML ? 384 : 0) + h * 64 + 32 * hf + fr;
                const unsigned boff = dir == 0 ? (unsigned)(row * D + 384 + cof) * 2u : (unsigned)(row * 640 + cof) * 2u;
                GAS char* ob = dir == 0 ? (GAS char*)Y : (GAS char*)OB;
#pragma unroll
                for (int et = 0; et < NET; ++et) *(GAS bf16*)(ob + boff + 32 * et) = (bf16)f2bf(acc[et][j] * inv);
            }
        }
        __builtin_amdgcn_sched_barrier(0);
#pragma unroll
        for (int dt = 0; dt < 4; ++dt)
#pragma unroll
            for (int et = 0; et < NET; ++et) C[dt][et] *= adec;
        f32x4 accn[4];
        if (IS_ML) {
#pragma unroll
            for (int dt = 0; dt < 4; ++dt) { accn[dt] = *(const LAS f32x4*)(nq + 16 * dt) * adec; if (fr != 0) accn[dt] = (f32x4){0.f, 0.f, 0.f, 0.f}; }
        }
#pragma unroll
        for (int kk = 0; kk < 2; ++kk) {
            u32x2 vlo[2], vhi[2], klo[4], khi[4];
            ds_tr16x4(va + (32 * kk + 4 * fq + tr_q) * CH_PITCH + 8 * tr_p + 64 * hf, vlo, vhi);
            ds_tr16x8(ka + (32 * kk + 4 * fq + tr_q) * CH_PITCH + 8 * tr_p, klo, khi);
            const f32x4 wl = *(const LAS f32x4*)(gq + 192 + 32 * kk), wh = *(const LAS f32x4*)(gq + 192 + 32 * kk + 16);
#pragma unroll
            for (int dt = 0; dt < 4; ++dt) {
                u32x4 w;
                w.x = pk2(__uint_as_float(klo[dt].x << 16) * wl[0], __uint_as_float(klo[dt].x & 0xffff0000u) * wl[1]);
                w.y = pk2(__uint_as_float(klo[dt].y << 16) * wl[2], __uint_as_float(klo[dt].y & 0xffff0000u) * wl[3]);
                w.z = pk2(__uint_as_float(khi[dt].x << 16) * wh[0], __uint_as_float(khi[dt].x & 0xffff0000u) * wh[1]);
                w.w = pk2(__uint_as_float(khi[dt].y << 16) * wh[2], __uint_as_float(khi[dt].y & 0xffff0000u) * wh[3]);
                const bf16x8 kf = __builtin_bit_cast(bf16x8, w);
#pragma unroll
                for (int et = 0; et < NET; ++et) C[dt][et] = __builtin_amdgcn_mfma_f32_16x16x32_bf16(kf, mk_frag(vlo[et], vhi[et]), C[dt][et], 0, 0, 0);
                if (IS_ML) accn[dt] = __builtin_amdgcn_mfma_f32_16x16x32_bf16(kf, ones, accn[dt], 0, 0, 0);
            }
        }
        if (IS_ML) { if (fr == 0) {
#pragma unroll
            for (int dt = 0; dt < 4; ++dt) *(LAS f32x4*)(nvec + 4 * fq + 16 * dt) = accn[dt]; } }
        asm volatile("s_waitcnt lgkmcnt(0)" ::: "memory");
        __syncthreads();
    }
}

#ifndef FAST_CHAIN
#define FAST_CHAIN 1
#endif
constexpr int NCHWG = 160;
__device__ __forceinline__ void phase_mix(Frame& F, int layer) {
    const bool last = layer == 1;
    const GAS bf16* ftl = WSP(const bf16, WS_FTL) + (size_t)layer * 2 * 384 * 4096;
    if (FAST_CHAIN) {
        if (F.wg < NCHWG) {
            if (F.wave >= 4) {
#pragma unroll 1
                for (int i = 0; i < 72 * REP_CH; ++i) __syncthreads();
            } else {
                const int cl = F.wave >> 1, hf = F.wave & 1, c = F.wg * 2 + cl;
                LAS unsigned char* img = F.lds + cl * CH_WAVE_LDS;
                {
                if (c < 192) { const int b = c / 12, r = c % 12; chain_fast<false>(F, layer, b, r >> 1, r & 1, img, hf); }
                else { const int i = c - 192; chain_fast<true>(F, layer, i >> 3, (i & 7) >> 1, i & 1, img, hf); }
                }
            }
        } else {
            const int nh = F.G - NCHWG, w = F.wg - NCHWG;
#ifndef FAST_HY
#define FAST_HY 1
#endif
            if (FAST_HY) {
#ifndef REP_HY
#define REP_HY 1
#endif
#pragma unroll 1
                for (int rp = 0; rp < REP_HY; ++rp)
                for (int u = w; u < 384; u += nh) hyena_unit_fast<LL>(F, layer, u, WSP(const bf16, WS_HYTL), ftl, WSP(bf16, WS_YHTL));
                if (!last) for (int u = w; u < 384; u += nh) hyena_unit_fast<LC>(F, layer, u, WSP(const bf16, WS_HYTC), WSP(const bf16, WS_FTC), WSP(bf16, WS_YHTC));
            } else {
                for (int u = w; u < 384; u += nh) hyena_unit_naive<LL>(F, layer, u, WSP(const bf16, WS_HYTL), ftl, WSP(bf16, WS_YHTL));
                if (!last) for (int u = w; u < 384; u += nh) hyena_unit_naive<LC>(F, layer, u, WSP(const bf16, WS_HYTC), WSP(const bf16, WS_FTC), WSP(bf16, WS_YHTC));
            }
        }
    } else {
        for (int u = F.wg; u < 384; u += F.G) hyena_unit_naive<LL>(F, layer, u, WSP(const bf16, WS_HYTL), ftl, WSP(bf16, WS_YHTL));
        if (!last) for (int u = F.wg; u < 384; u += F.G) hyena_unit_naive<LC>(F, layer, u, WSP(const bf16, WS_HYTC), WSP(const bf16, WS_FTC), WSP(bf16, WS_YHTC));
        for (int c = F.wg + F.wave * F.G; c < 320; c += F.G * NWAVES) chain_naive(F, layer, c);
    }
}

__device__ __forceinline__ void phase_combine(Frame& F, int layer) {
    const bool last = layer == 1;
    const int gw = F.wg * NWAVES + F.wave, NGW = F.G * NWAVES, lane = F.lane;
    const int nrows = last ? TOKL : TOK;
    GAS bf16* Y = WSP(bf16, WS_Y); const GAS bf16* OB = WSP(const bf16, WS_OB); const GAS bf16* RET = WSP(const bf16, WS_RET); const GAS bf16* ML = WSP(const bf16, WS_ML);
    for (int row = gw; row < nrows; row += NGW) {
#pragma unroll
        for (int hh = 0; hh < 10; ++hh) {
            const int cof = hh * 64 + lane;
            const float x = bf2f(Y[(size_t)row * D + 384 + cof]) + bf2f(OB[(size_t)row * 640 + cof]);
            const float mu = wave_sum(x) * (1.f / 64.f), xc = x - mu;
            const float var = wave_sum(xc * xc) * (1.f / 64.f);
            const float nrm = xc * rsqrtf(var + 1e-6f);
            float gate;
            if (hh < 6) gate = siluf_(bf2f(RET[(size_t)row * 1536 + 1152 + cof]));
            else gate = sigmoidf_(bf2f(ML[(size_t)row * 1024 + 768 + (cof - 384)]));
            Y[(size_t)row * D + 384 + cof] = (bf16)f2bf(nrm * gate);
        }
    }
    LAS unsigned char* scr = F.lds + F.wave * 8704;
    const int nitL = NB * 6 * 32, nitC = last ? 0 : NB * 6 * 4;
    for (int it = gw; it < nitL + nitC; it += NGW) {
        const GAS bf16* src; int L, rowbase, b, cb, tb;
        if (it < nitL) { b = it / 192; const int r = it % 192; cb = r / 32; tb = r % 32; L = LL; src = WSP(const bf16, WS_YHTL); rowbase = b * LL; }
        else { const int i2 = it - nitL; b = i2 / 24; const int r = i2 % 24; cb = r / 4; tb = r % 4; L = LC; src = WSP(const bf16, WS_YHTC); rowbase = TOKL + b * LC; }
        u32x4 v[8];
#pragma unroll
        for (int i = 0; i < 8; ++i) { const int cc = (lane >> 3) + 8 * i; v[i] = *(const GAS u32x4*)(src + ((size_t)(b * 384 + cb * 64 + cc)) * L + tb * 64 + 8 * (lane & 7)); }
#pragma unroll
        for (int i = 0; i < 8; ++i) { const int cc = (lane >> 3) + 8 * i; *(LAS u32x4*)(scr + cc * 136 + 16 * (lane & 7)) = v[i]; }
        asm volatile("s_waitcnt lgkmcnt(0)" ::: "memory");
#pragma unroll
        for (int i = 0; i < 8; ++i) {
            const int tt = (lane >> 3) + 8 * i, c8 = 8 * (lane & 7);
            unsigned short e[8];
#pragma unroll
            for (int j = 0; j < 8; ++j) e[j] = *(const LAS unsigned short*)(scr + (c8 + j) * 136 + tt * 2);
            u32x4 o; o.x = e[0] | ((unsigned)e[1] << 16); o.y = e[2] | ((unsigned)e[3] << 16); o.z = e[4] | ((unsigned)e[5] << 16); o.w = e[6] | ((unsigned)e[7] << 16);
            *(GAS u32x4*)(Y + (size_t)(rowbase + tb * 64 + tt) * D + cb * 64 + c8) = o;
        }
        asm volatile("s_waitcnt lgkmcnt(0)" ::: "memory");
    }
}

__device__ __forceinline__ void phase_norm_router(Frame& F) {
    const int gw = F.wg * NWAVES + F.wave, NGW = F.G * NWAVES, lane = F.lane;
    const GAS float* g = inp(F, I_GFFN) + 1 * D; const GAS float* wr = inp(F, I_ROUTER); const GAS float* br = inp(F, I_ROUTERB);
    GAS unsigned* cnt = WSP(unsigned, WS_CTL) + CW_CNT;
    for (int row = gw; row < TOKL; row += NGW) {
        float keep[16];
        norm_mod_row(xrow_ptr(F, row, false), g, mod_ptr(F, 1, row, 3), mod_ptr(F, 1, row, 4), WSP(bf16, WS_H) + (size_t)row * D, lane, keep);
        float lg[8];
#pragma unroll
        for (int e = 0; e < 8; ++e) lg[e] = 0.f;
#pragma unroll
        for (int j = 0; j < 4; ++j)
#pragma unroll
            for (int i = 0; i < 4; ++i) { const int k = 256 * j + 4 * lane + i; const f32x4 w0 = *(const GAS f32x4*)(wr + k * 8), w1 = *(const GAS f32x4*)(wr + k * 8 + 4); const float x = keep[4 * j + i];
                lg[0] += x * w0.x; lg[1] += x * w0.y; lg[2] += x * w0.z; lg[3] += x * w0.w; lg[4] += x * w1.x; lg[5] += x * w1.y; lg[6] += x * w1.z; lg[7] += x * w1.w; }
#pragma unroll
        for (int e = 0; e < 8; ++e) lg[e] = wave_sum(lg[e]) + br[e];
        int e0 = 0; float v0 = lg[0];
#pragma unroll
        for (int e = 1; e < 8; ++e) if (lg[e] > v0) { v0 = lg[e]; e0 = e; }
        int e1 = -1; float v1 = -3.0e38f;
#pragma unroll
        for (int e = 0; e < 8; ++e) if (e != e0 && lg[e] > v1) { v1 = lg[e]; e1 = e; }
        const float w1 = 1.f / (1.f + __expf(v0 - v1)), w0 = 1.f - w1;
        if (lane == 0) {
            const unsigned p0 = __hip_atomic_fetch_add(cnt + e0, 1u, __ATOMIC_RELAXED, __HIP_MEMORY_SCOPE_AGENT), p1 = __hip_atomic_fetch_add(cnt + e1, 1u, __ATOMIC_RELAXED, __HIP_MEMORY_SCOPE_AGENT);
            WSP(int, WS_TOPE)[row * 2] = e0; WSP(int, WS_TOPE)[row * 2 + 1] = e1;
            WSP(float, WS_TOPW)[row * 2] = w0; WSP(float, WS_TOPW)[row * 2 + 1] = w1;
            WSP(int, WS_TOPP)[row * 2] = (int)p0; WSP(int, WS_TOPP)[row * 2 + 1] = (int)p1;
        }
    }
}
__device__ __forceinline__ void phase_route_tables(Frame& F) {
    const GAS unsigned* cnt = WSP(const unsigned, WS_CTL) + CW_CNT;
    int off[9]; off[0] = 0;
#pragma unroll
    for (int e = 0; e < 8; ++e) { const int c = (int)__hip_atomic_load(cnt + e, __ATOMIC_RELAXED, __HIP_MEMORY_SCOPE_AGENT); off[e + 1] = off[e] + ((c + 255) >> 8) * 256; }
    const int gt = F.wg * NTHR + F.tid, NGT = F.G * NTHR;
    GAS int* rowidx = WSP(int, WS_ROWIDX); GAS int* slot = WSP(int, WS_SLOT); GAS int* tilee = WSP(int, WS_TILEE);
    for (int i = gt; i < MAXTILES * 256; i += NGT) {
        int e = 0;
#pragma unroll
        for (int q = 1; q < 8; ++q) if (i >= off[q]) e = q;
        const int c = (int)cnt[e];
        if (i >= off[8] || i - off[e] >= c) rowidx[i] = 0;
    }
    for (int i = gt; i < TOKL * 2; i += NGT) {
        const int e = WSP(const int, WS_TOPE)[i], pos = WSP(const int, WS_TOPP)[i];
        int o = 0;
#pragma unroll
        for (int q = 0; q < 8; ++q) if (e == q) o = off[q];
        const int s = o + pos; slot[i] = s; rowidx[s] = i >> 1;
    }
    for (int i = gt; i < MAXTILES + 1; i += NGT) {
        if (i == MAXTILES) tilee[MAXTILES] = off[8] >> 8;
        else { int e = 0;
#pragma unroll
            for (int q = 1; q < 8; ++q) if (i * 256 >= off[q]) e = q;
            tilee[i] = e; }
    }
}

__device__ __forceinline__ void moe_pass_gemm1_fast(Frame& F, int t0, int t1) {
    pg8::OrderMoe S; S.o.init(t1 - t0, NFF1 / 256, F.G, F.wg); S.rowidx = WSP(const int, WS_ROWIDX); S.tilee = WSP(const int, WS_TILEE); S.t0 = t0; S.bstride = (size_t)NFF1 * D; S.gather = true;
    EpiSwiglu E{WSP(bf16, WS_MACT), 0};
    pg8::gemm_phase(F.lds, F.tid, WSP(const bf16, WS_H), D, WSP(const bf16, WS_MW13), D, D, S, E);
}
__device__ __forceinline__ void moe_pass_gemm2_fast(Frame& F, int t0, int t1) {
    pg8::OrderMoe S; S.o.init(t1 - t0, D / 256, F.G, F.wg); S.rowidx = WSP(const int, WS_ROWIDX); S.tilee = WSP(const int, WS_TILEE); S.t0 = t0; S.bstride = (size_t)D * DFF; S.gather = false;
    EpiBf16Out E{WSP(bf16, WS_EOUT), D, t0 * 256};
    pg8::gemm_phase(F.lds, F.tid, WSP(const bf16, WS_MACT), DFF, WSP(const bf16, WS_MW2), DFF, DFF, S, E);
}
__device__ __forceinline__ void phase_final(Frame& F) {
    const int gw = F.wg * NWAVES + F.wave, NGW = F.G * NWAVES, lane = F.lane;
    const GAS float* gf = inp(F, I_GFINAL); const GAS bf16* eo = WSP(const bf16, WS_EOUT);
    for (int row = gw; row < TOKL; row += NGW) {
        const int s0 = WSP(const int, WS_SLOT)[row * 2], s1 = WSP(const int, WS_SLOT)[row * 2 + 1];
        const float w0 = WSP(const float, WS_TOPW)[row * 2], w1 = WSP(const float, WS_TOPW)[row * 2 + 1];
        const GAS float* m5 = mod_ptr(F, 1, row, 5);
        GAS float* xr = outp(F) + (size_t)row * D;
        f32x4 v[4]; float s = 0.f;
#pragma unroll
        for (int j = 0; j < 4; ++j) {
            const int c = 256 * j + 4 * lane;
            const f32x4 a = ld_bf16x4(eo + (size_t)s0 * D + c), b = ld_bf16x4(eo + (size_t)s1 * D + c), m = *(const GAS f32x4*)(m5 + c);
            v[j] = *(const GAS f32x4*)(xr + c) + m * (a * w0 + b * w1);
            s += (v[j].x * v[j].x + v[j].y * v[j].y) + (v[j].z * v[j].z + v[j].w * v[j].w);
        }
        const float r = rsqrtf(wave_sum(s) * (1.f / 1024.f) + 1e-6f);
#pragma unroll
        for (int j = 0; j < 4; ++j) { const int c = 256 * j + 4 * lane; const f32x4 g = *(const GAS f32x4*)(gf + c); *(GAS f32x4*)(xr + c) = v[j] * r * g; }
    }
}

#ifndef REP_WIN
#define REP_WIN 1
#endif
#ifndef REP_MIX
#define REP_MIX 1
#endif
#ifndef REP_GATE
#define REP_GATE 1
#endif
#ifndef REP_UP
#define REP_UP 1
#endif
#ifndef REP_FFN1
#define REP_FFN1 1
#endif
#ifndef REP_MOE
#define REP_MOE 1
#endif
#ifndef REP_NORM
#define REP_NORM 1
#endif
#ifndef REP_P0
#define REP_P0 1
#endif
__global__ void __launch_bounds__(NTHR, 2) hybrid_fwd(Params prm) {
    extern __shared__ __attribute__((aligned(16))) unsigned char lds_raw[];
    Frame F;
    F.lds = (LAS unsigned char*)lds_raw; F.ws = (GAS unsigned char*)prm.ws;
    F.tid = threadIdx.x; F.lane = F.tid & 63; F.wave = __builtin_amdgcn_readfirstlane(F.tid >> 6); F.G = gridDim.x; F.wg = blockIdx.x;
    volatile LAS unsigned* MISC = (volatile LAS unsigned*)(F.lds + MISC_OFF);
    if (F.tid < 64) MISC[F.tid] = 0u;
    if (F.tid < 33) { const unsigned long long v = F.tid < 32 ? (unsigned long long)prm.in[F.tid] : (unsigned long long)prm.out; *(LAS unsigned long long*)(F.lds + PTAB_OFF + 8 * F.tid) = v; }
    __syncthreads();
    XcdBarrier bar = xcd_barrier_post(WSP(unsigned, WS_CTL) + CW_BAR, MISC + 8);
#define RELAUNDER() do { { unsigned long long _w = (unsigned long long)F.ws; asm volatile("" : "+s"(_w)); F.ws = (GAS unsigned char*)_w; } \
        { unsigned _t = (unsigned)F.tid; asm volatile("" : "+v"(_t)); F.tid = (int)_t; F.lane = F.tid & 63; F.wave = __builtin_amdgcn_readfirstlane(F.tid >> 6); } \
        { unsigned _g = (unsigned)F.G, _b = (unsigned)F.wg; asm volatile("" : "+s"(_g), "+s"(_b)); F.G = (int)_g; F.wg = (int)_b; } \
        { unsigned _l = (unsigned)(size_t)F.lds; asm volatile("" : "+s"(_l)); F.lds = (LAS unsigned char*)(size_t)_l; } } while (0)
#define GRID_BAR() do { { unsigned long long _b = (unsigned long long)bar.bar; unsigned _x = bar.x; asm volatile("" : "+s"(_b), "+s"(_x)); bar.bar = (GAS unsigned*)_b; bar.x = _x; } xcd_barrier(bar); RELAUNDER(); } while (0)

    for (int rp = 0; rp < REP_P0; ++rp) { phase_p0(F); write_bias(F);
    GRID_BAR(); }
#pragma unroll 1
    for (int layer_ = 0; layer_ < 2; ++layer_) {
        int layer = layer_;
#define last (layer == 1)
#define rows_all TOK
#define rows_out (last ? TOKL : TOK)
#define modbase (WSP(const float, WS_MOD) + (size_t)layer * 17 * 6144)
#define LAYER_LAUNDER() asm volatile("" : "+s"(layer))
        for (int rp = 0; rp < REP_NORM; ++rp) { phase_norm(F, layer, rows_all, !last, 0);
        if (layer == 0) { const int gw = F.wg * NWAVES + F.wave, NGW = F.G * NWAVES;
            for (int it = gw; it < 1536 + 96; it += NGW) filter_out_item(F, it); }
        { GRID_BAR(); LAYER_LAUNDER(); } }
        for (int rp = 0; rp < REP_WIN; ++rp) {
        { EpiWin E{WSP(const float, WS_BIAS) + layer * NWP, WSP(bf16, WS_HYTL), WSP(bf16, WS_HYTC), WSP(bf16, WS_RET), WSP(bf16, WS_ML), WSP(float, WS_MLG)};
          gemm_fast(F, WSP(const bf16, WS_H), D, WSP(const bf16, WS_WIN), D, D, rows_all, NW1, E); }
        { GRID_BAR(); LAYER_LAUNDER(); } }
        for (int rp = 0; rp < REP_MIX; ++rp) { phase_mix(F, layer);
        { GRID_BAR(); LAYER_LAUNDER(); } }
        phase_combine(F, layer);
        { GRID_BAR(); LAYER_LAUNDER(); }
        for (int rp = 0; rp < REP_GATE; ++rp) {
        { EpiGate E{WSP(const float, WS_BIAS) + layer * NWP + NW1, WSP(bf16, WS_GATES)};
          gemm_fast(F, WSP(const bf16, WS_H), D, WSP(const bf16, WS_WIN) + (size_t)NW1 * D, D, D, rows_out, NGATE, E); }
        { GRID_BAR(); LAYER_LAUNDER(); } }
        for (int rp = 0; rp < REP_UP; ++rp) {
        { EpiUp E{WSP(const bf16, WS_GATES), WSP(bf16, WS_H)};
          gemm_fast(F, WSP(const bf16, WS_Y), D, WSP(const bf16, WS_WUP), D, D, rows_out, D, E); }
        { GRID_BAR(); LAYER_LAUNDER(); } }
        { EpiResid E{last ? outp(F) : inp(F, I_X), last ? WSP(const float, WS_XC) : inp(F, I_CTX), outp(F), WSP(float, WS_XC), modbase, 2};
          gemm_fast(F, WSP(const bf16, WS_H), D, WSP(const bf16, WS_WOUT), D, D, rows_out, D, E); }
        { GRID_BAR(); LAYER_LAUNDER(); }
        if (!last) {
            phase_norm(F, layer, rows_out, false, 3);
            { const int gw = F.wg * NWAVES + F.wave, NGW = F.G * NWAVES; LAS float* scr = (LAS float*)(F.lds + F.wave * 8704);
              conv_weights_ffn(inp(F, I_FW1), inp(F, I_FW3), inp(F, I_FW2), WSP(bf16, WS_W13), WSP(bf16, WS_W2), gw, NGW, scr, F.lane);
              conv_weights_win(F, 1, gw, NGW, scr);
              conv_weights_upout(F, 1, gw, NGW, scr); }
            { GRID_BAR(); LAYER_LAUNDER(); }
            for (int rp = 0; rp < REP_FFN1; ++rp) {
            { EpiSwiglu E{WSP(bf16, WS_ACT), 0};
              gemm_fast(F, WSP(const bf16, WS_H), D, WSP(const bf16, WS_W13), D, D, rows_out, NFF1, E); }
            { GRID_BAR(); LAYER_LAUNDER(); } }
            { EpiResid E{outp(F), WSP(const float, WS_XC), outp(F), WSP(float, WS_XC), modbase, 5};
              gemm_fast(F, WSP(const bf16, WS_ACT), DFF, WSP(const bf16, WS_W2), DFF, DFF, rows_out, D, E); }
            { GRID_BAR(); LAYER_LAUNDER(); }
        }
    }
#undef LAYER_LAUNDER
#undef last
#undef rows_all
#undef rows_out
#undef modbase
    phase_norm_router(F);
    { const int gw = F.wg * NWAVES + F.wave, NGW = F.G * NWAVES; LAS float* scr = (LAS float*)(F.lds + F.wave * 8704);
#pragma unroll 1
      for (int e = 0; e < NE; ++e)
          conv_weights_ffn(inp(F, I_MW1) + (size_t)e * D * DFF, inp(F, I_MW3) + (size_t)e * D * DFF, inp(F, I_MW2) + (size_t)e * DFF * D,
                           WSP(bf16, WS_MW13) + (size_t)e * NFF1 * D, WSP(bf16, WS_MW2) + (size_t)e * D * DFF, gw, NGW, scr, F.lane); }
    GRID_BAR();
    phase_route_tables(F);
    GRID_BAR();
    const int ntiles = __builtin_amdgcn_readfirstlane(WSP(const int, WS_TILEE)[MAXTILES]);
#pragma unroll 1
    for (int p = 0; p < NPASS; ++p) {
        const int t0 = p * PASS_TILES, t1 = min(ntiles, t0 + PASS_TILES);
        for (int rp = 0; rp < REP_MOE; ++rp) {
        if (t0 < t1) moe_pass_gemm1_fast(F, t0, t1);
        GRID_BAR();
        if (t0 < t1) moe_pass_gemm2_fast(F, t0, t1);
        GRID_BAR(); }
    }
    phase_final(F);
}

extern "C" void kernel_launch(void* const* d_in, const int* in_sizes, int n_in, void* d_out, int out_size, void* d_ws, size_t ws_size, hipStream_t stream) {
    static int grid = 0;
    if (grid == 0) {
        if (n_in != 32 || out_size != TOKL * D || ws_size < WS_END) { fprintf(stderr, "kernel_launch: unexpected arguments (n_in %d, out %d, ws %zu)\n", n_in, out_size, ws_size); grid = -1; return; }
        int dev = 0, cus = 0;
        if (hipGetDevice(&dev) != hipSuccess || hipDeviceGetAttribute(&cus, hipDeviceAttributeMultiprocessorCount, dev) != hipSuccess) { grid = -1; return; }
        if (hipFuncSetAttribute((const void*)hybrid_fwd, hipFuncAttributeMaxDynamicSharedMemorySize, LDS_BYTES) != hipSuccess) { grid = -1; return; }
        int per_cu = 0;
        (void)hipOccupancyMaxActiveBlocksPerMultiprocessor(&per_cu, (const void*)hybrid_fwd, NTHR, LDS_BYTES);
        (void)hipGetLastError();
        grid = cus;
    }
    if (grid < 0) return;
    (void)hipMemsetAsync((char*)d_ws + WS_CTL, 0, CTL_ZERO_BYTES, stream);
    Params p{};
    for (int i = 0; i < 32; ++i) p.in[i] = (const float*)d_in[i];
    p.out = (float*)d_out; p.ws = (unsigned char*)d_ws;
    hipLaunchKernelGGL(hybrid_fwd, dim3(grid), dim3(NTHR), LDS_BYTES, stream, p);
}
```

```cpp
#include <hip/hip_runtime.h>
#include <stdint.h>
#include <stdio.h>

#define LAS __attribute__((address_space(3)))
#define GAS __attribute__((address_space(1)))
typedef unsigned short bf16;
typedef short bf16x8 __attribute__((ext_vector_type(8)));
typedef float f32x4 __attribute__((ext_vector_type(4)));
typedef unsigned u32x4 __attribute__((ext_vector_type(4)));
typedef unsigned u32x2 __attribute__((ext_vector_type(2)));

constexpr int D = 1024, NB = 16, LL = 2048, LC = 256;
constexpr int TOKL = NB * LL, TOKC = NB * LC, TOK = TOKL + TOKC;
constexpr int HYW = 384, RETW = 384, MLW = 256;
constexpr int NIN = 6800, NW1 = 3840, NGATE = 3072, NWP = 6912;
constexpr int DFF = 2816, NFF1 = 5632, NE = 8;
constexpr int NWAVES = 8, NTHR = 512;
constexpr int MAXTILES = 272, PASS_TILES = 64, NPASS = 5;

constexpr size_t MiB = 1u << 20;
constexpr size_t WS_CTL = 0, CTL_ZERO_BYTES = 1 * MiB;
constexpr size_t WS_MOD = 1 * MiB;
constexpr size_t WS_BIAS = 2 * MiB;
constexpr size_t WS_ROPE = 2 * MiB + 256 * 1024;
constexpr size_t WS_TOPE = 3 * MiB;
constexpr size_t WS_TOPW = 3 * MiB + 256 * 1024;
constexpr size_t WS_TOPP = 3 * MiB + 512 * 1024;
constexpr size_t WS_SLOT = 3 * MiB + 768 * 1024;
constexpr size_t WS_ROWIDX = 4 * MiB;
constexpr size_t WS_TILEE = 4 * MiB + 512 * 1024;
constexpr size_t WS_FTL = 5 * MiB;
constexpr size_t WS_FTC = 17 * MiB;
constexpr size_t WS_WIN = 18 * MiB;
constexpr size_t WS_WUP = 32 * MiB;
constexpr size_t WS_WOUT = 34 * MiB;
constexpr size_t WS_XC = 36 * MiB;
constexpr size_t WS_H = 52 * MiB;
constexpr size_t WS_Y = 124 * MiB;
constexpr size_t WS_U = 196 * MiB;
constexpr size_t WS_RET = WS_U;
constexpr size_t WS_ML = WS_U + 108 * MiB;
constexpr size_t WS_MLG = WS_U + 180 * MiB;
constexpr size_t WS_OB = WS_U + 183 * MiB;
constexpr size_t WS_YHTL = WS_U + 228 * MiB;
constexpr size_t WS_YHTC = WS_U + 252 * MiB;
constexpr size_t WS_HYTL = WS_U + 255 * MiB;
constexpr size_t WS_HYTC = WS_U + 327 * MiB;
constexpr size_t WS_END = WS_U + 336 * MiB;
constexpr size_t WS_GATES = WS_U;
constexpr size_t WS_ACT = WS_U;
constexpr size_t WS_W13 = WS_U + 204 * MiB;
constexpr size_t WS_W2 = WS_U + 216 * MiB;
constexpr size_t WS_MW13 = WS_Y;
constexpr size_t WS_MW2 = WS_Y + 88 * MiB;
constexpr size_t WS_MACT = WS_Y + 132 * MiB;
constexpr size_t WS_EOUT = WS_Y + 220 * MiB;
static_assert(WS_EOUT + (size_t)MAXTILES * 256 * 1024 * 2 <= WS_END, "map");
static_assert(WS_GATES + (size_t)TOK * NGATE * 2 <= WS_YHTL, "gates overlay");

constexpr int CW_BAR = 4096;
constexpr int CW_CNT = 16384;

constexpr int LDS_BYTES = 147456;
constexpr int MISC_OFF = 147456 - 256;

__device__ __forceinline__ float bf2f(bf16 b) { return __uint_as_float(((unsigned)b) << 16); }
typedef __bf16 bf2v_ __attribute__((ext_vector_type(2)));
typedef float f2v_ __attribute__((ext_vector_type(2)));
__device__ __forceinline__ unsigned pk2(float lo, float hi) { const f2v_ f = {lo, hi}; return __builtin_bit_cast(unsigned, __builtin_convertvector(f, bf2v_)); }
__device__ __forceinline__ unsigned f2bf(float f) { return pk2(f, 0.f) & 0xffffu; }
__device__ __forceinline__ float dpp_f(float v, int) { return v; }
#define DPP_ADD(v, ctrl) (v) += __int_as_float(__builtin_amdgcn_update_dpp(0, __float_as_int(v), (ctrl), 0xf, 0xf, true))
__device__ __forceinline__ float wave_sum(float v) {
    DPP_ADD(v, 0xB1);
    DPP_ADD(v, 0x4E);
    DPP_ADD(v, 0x141);
    DPP_ADD(v, 0x140);
    return __int_as_float(__builtin_amdgcn_readlane(__float_as_int(v), 0)) + __int_as_float(__builtin_amdgcn_readlane(__float_as_int(v), 16))
         + __int_as_float(__builtin_amdgcn_readlane(__float_as_int(v), 32)) + __int_as_float(__builtin_amdgcn_readlane(__float_as_int(v), 48));
}
__device__ __forceinline__ float lane_read(float v, int src_lane) { return __int_as_float(__builtin_amdgcn_ds_bpermute(src_lane << 2, __float_as_int(v))); }
__device__ __forceinline__ float sigmoidf_(float x) { return __builtin_amdgcn_rcpf(1.0f + __expf(-x)); }
__device__ __forceinline__ float siluf_(float x) { return x * __builtin_amdgcn_rcpf(1.0f + __expf(-x)); }

#define XB_TMO      128
#define XB_XCNT(j)  (256  + 64 * (j))
#define XB_XSUB(j)  (1280 + 64 * (j))
#define XB_XGEN(j)  (2304 + 64 * (j))
#define XB_TOP      3328
#define XB_TOPGEN   3392
#define XCD_BAR_WORDS 3456
#define XB_SPIN_CAP (1u << 22)
__device__ __forceinline__ unsigned xb_ld(GAS unsigned* p)              { return __hip_atomic_load(p, __ATOMIC_RELAXED, __HIP_MEMORY_SCOPE_AGENT); }
__device__ __forceinline__ unsigned xb_add(GAS unsigned* p, unsigned v) { return __hip_atomic_fetch_add(p, v, __ATOMIC_RELAXED, __HIP_MEMORY_SCOPE_AGENT); }
__device__ __forceinline__ unsigned xb_xcc_id() { return (unsigned)__builtin_amdgcn_s_getreg((3 << 11) | 20) & 0xFu; }
#define XB_SPIN(cond, bar) do { unsigned _sp = 0; while (cond) { __builtin_amdgcn_s_sleep(1); \
    if ((++_sp & 255u) == 0u) { if (xb_ld(&(bar)[XB_TMO])) break; if (_sp > XB_SPIN_CAP) { (void)__hip_atomic_fetch_add(&(bar)[XB_TMO], 1u, __ATOMIC_RELAXED, __HIP_MEMORY_SCOPE_AGENT); break; } } } } while (0)
struct XcdBarrier { GAS unsigned* bar; unsigned x; volatile LAS unsigned* st; };
__device__ __forceinline__ XcdBarrier xcd_barrier_post(GAS unsigned* bar, volatile LAS unsigned* st) {
    XcdBarrier b; b.bar = bar; b.x = xb_xcc_id(); b.st = st;
    if (threadIdx.x == 0) (void)xb_add(&bar[XB_XCNT(b.x)], 1u);
    return b;
}
__device__ __forceinline__ void xcd_barrier_complete(GAS unsigned* bar, unsigned x, unsigned& nloc, unsigned& nx) {
    const unsigned G = gridDim.x * gridDim.y * gridDim.z;
    unsigned sum, cnt, mine, sp = 0u;
    for (;;) {
        sum = 0u; cnt = 0u; mine = 0u;
#pragma unroll 1
        for (unsigned j = 0; j < 16; ++j) { const unsigned c = xb_ld(&bar[XB_XCNT(j)]); sum += c; cnt += (c > 0u) ? 1u : 0u; }
        mine = xb_ld(&bar[XB_XCNT(x)]);
        if (sum == G) break;
        __builtin_amdgcn_s_sleep(1);
        if ((++sp & 255u) == 0u) { if (xb_ld(&bar[XB_TMO])) break; if (sp > XB_SPIN_CAP) { (void)__hip_atomic_fetch_add(&bar[XB_TMO], 1u, __ATOMIC_RELAXED, __HIP_MEMORY_SCOPE_AGENT); break; } }
    }
    nloc = mine > 0u ? mine : 1u; nx = cnt > 0u ? cnt : 1u;
}
__device__ __forceinline__ void xcd_barrier(const XcdBarrier& b) {
    asm volatile("s_waitcnt vmcnt(0)" ::: "memory");
    __syncthreads();
    if (threadIdx.x == 0) {
        GAS unsigned* bar = b.bar;
        __builtin_amdgcn_s_waitcnt(0);
        unsigned nloc = b.st[0], nx = b.st[1];
        if (nloc == 0u) { xcd_barrier_complete(bar, b.x, nloc, nx); b.st[0] = nloc; b.st[1] = nx; }
        const unsigned old = xb_add(&bar[XB_XSUB(b.x)], 1u);
        const unsigned gen = old / nloc;
        if (old + 1u == (gen + 1u) * nloc) {
            __builtin_amdgcn_fence(__ATOMIC_RELEASE, "agent");
            asm volatile("s_waitcnt vmcnt(0)" ::: "memory");
            const unsigned og = xb_add(&bar[XB_TOP], 1u);
            const unsigned tg = og / nx;
            if (og + 1u == (tg + 1u) * nx) xb_add(&bar[XB_TOPGEN], 1u);
            else XB_SPIN(xb_ld(&bar[XB_TOPGEN]) == tg, bar);
            __builtin_amdgcn_fence(__ATOMIC_ACQUIRE, "agent");
            xb_add(&bar[XB_XGEN(b.x)], 1u);
            asm volatile("s_waitcnt vmcnt(0)" ::: "memory");
        } else {
            XB_SPIN(xb_ld(&bar[XB_XGEN(b.x)]) == gen, bar);
            __builtin_amdgcn_fence(__ATOMIC_ACQUIRE, "agent");
            asm volatile("s_waitcnt vmcnt(0)" ::: "memory");
        }
    }
    __syncthreads();
}

struct Params { const float* in[32]; float* out; unsigned char* ws; };
enum { I_X = 0, I_C, I_CTX, I_CCTX, I_WMOD, I_BMOD, I_GMIX, I_GFFN, I_WIN, I_BIN, I_HYCONV, I_HYF1, I_HYFB1, I_HYF2, I_HYFB2, I_HYF3, I_HYDECAY,
       I_HYSKIP, I_RETDECAY, I_MLCONV, I_MLGB, I_WUP, I_WOUT, I_FW1, I_FW3, I_FW2, I_ROUTER, I_ROUTERB, I_MW1, I_MW3, I_MW2, I_GFINAL };

struct Frame {
    LAS unsigned char* lds;
    GAS unsigned char* ws;
    int tid, lane, wave, G, wg;
};
#define WSP(T, off) ((GAS T*)(F.ws + (off)))
constexpr int PTAB_OFF = 147456 - 1024;
__device__ __forceinline__ const GAS float* inp(const Frame& F, int i) {
    const LAS unsigned* t = (const LAS unsigned*)(F.lds + PTAB_OFF) + 2 * i;
    const unsigned lo = __builtin_amdgcn_readfirstlane(t[0]), hi = __builtin_amdgcn_readfirstlane(t[1]);
    return (const GAS float*)(((unsigned long long)hi << 32) | lo);
}
__device__ __forceinline__ GAS float* outp(const Frame& F) { return (GAS float*)inp(F, 32); }

__device__ __forceinline__ int row_batch(int row) { return row < TOKL ? (row >> 11) : ((row - TOKL) >> 8); }
__device__ __forceinline__ const GAS float* mod_ptr(const Frame& F, int layer, int row, int which) {
    const int r = row < TOKL ? (row >> 11) : 16;
    return WSP(const float, WS_MOD) + ((size_t)(layer * 17 + r) * 6 + which) * 1024;
}

template <class RowMap>
__device__ __forceinline__ void tr_item(const GAS float* W, int K, int N, GAS bf16* WT, int ldT, RowMap rm, LAS float* scr, int item, int lane) {
    const int nblk = (N + 31) / 32, kb = item / nblk, nb = item % nblk, k0 = 64 * kb, n0 = 32 * nb;
    { float tv[32];
#pragma unroll
      for (int i = 0; i < 32; ++i) { const int kk = 2 * i + (lane >> 5); const int n = n0 + (lane & 31); tv[i] = (n < N) ? W[(size_t)(k0 + kk) * N + n] : 0.f; }
#pragma unroll
      for (int i = 0; i < 32; ++i) { const int kk = 2 * i + (lane >> 5); scr[kk * 33 + (lane & 31)] = tv[i]; } }
    asm volatile("s_waitcnt lgkmcnt(0)" ::: "memory");
    const int c = lane & 7;
#pragma unroll
    for (int j = 0; j < 4; ++j) { const int nl = (lane >> 3) + 8 * j; const int n = n0 + nl; const LAS float* s = scr + (8 * c) * 33 + nl;
        u32x4 o; o.x = pk2(s[0 * 33], s[1 * 33]); o.y = pk2(s[2 * 33], s[3 * 33]); o.z = pk2(s[4 * 33], s[5 * 33]); o.w = pk2(s[6 * 33], s[7 * 33]);
        if (n < N) *(GAS u32x4*)(WT + (size_t)rm(n) * ldT + k0 + 8 * c) = o; }
    asm volatile("s_waitcnt lgkmcnt(0)" ::: "memory");
}
struct RmId { __device__ __forceinline__ int operator()(int n) const { return n; } };
__device__ __forceinline__ int win_row(int n) {
    if (n < 1152) return n;
    if (n < 2688) return 1280 + (n - 1152);
    if (n < 3712) return 2816 + (n - 2688);
    if (n < 3728) return 1152 + (n - 3712);
    return 3840 + (n - 3728);
}
struct RmWin { __device__ __forceinline__ int operator()(int n) const { return win_row(n); } };
struct RmW1 { __device__ __forceinline__ int operator()(int n) const { return (n >> 4) * 32 + (n & 15); } };
struct RmW3 { __device__ __forceinline__ int operator()(int n) const { return (n >> 4) * 32 + 16 + (n & 15); } };

__device__ __forceinline__ void conv_weights_win(Frame& F, int layer, int gw, int NGW, LAS float* scr) {
    const GAS float* W = inp(F, I_WIN) + (size_t)layer * D * NIN;
    const int items = (D / 64) * ((NIN + 31) / 32);
    for (int it = gw; it < items; it += NGW) tr_item(W, D, NIN, WSP(bf16, WS_WIN), D, RmWin(), scr, it, F.lane);
    GAS bf16* wt = WSP(bf16, WS_WIN);
    unsigned zz; asm volatile("v_mov_b32 %0, 0" : "=v"(zz));
    for (int i = gw * 64 + F.lane; i < 112 * 1024 / 8; i += NGW * 64) *(GAS u32x4*)(wt + (size_t)1168 * 1024 + (size_t)i * 8) = (u32x4){zz, zz, zz, zz};
}
__device__ __forceinline__ void conv_weights_upout(Frame& F, int layer, int gw, int NGW, LAS float* scr) {
    const int items = (D / 64) * (D / 32);
    for (int it = gw; it < items; it += NGW) tr_item(inp(F, I_WUP) + (size_t)layer * D * D, D, D, WSP(bf16, WS_WUP), D, RmId(), scr, it, F.lane);
    for (int it = gw; it < items; it += NGW) tr_item(inp(F, I_WOUT) + (size_t)layer * D * D, D, D, WSP(bf16, WS_WOUT), D, RmId(), scr, it, F.lane);
}
__device__ __forceinline__ void conv_weights_ffn(const GAS float* w1, const GAS float* w3, const GAS float* w2, GAS bf16* w13t, GAS bf16* w2t, int gw, int NGW, LAS float* scr, int lane) {
    const int i1 = (D / 64) * (DFF / 32), i2 = (DFF / 64) * (D / 32);
    for (int it = gw; it < i1; it += NGW) tr_item(w1, D, DFF, w13t, D, RmW1(), scr, it, lane);
    for (int it = gw; it < i1; it += NGW) tr_item(w3, D, DFF, w13t, D, RmW3(), scr, it, lane);
    for (int it = gw; it < i2; it += NGW) tr_item(w2, DFF, D, w2t, DFF, RmId(), scr, it, lane);
}

constexpr size_t WS_HID2 = WS_XC;
__device__ __forceinline__ void filter_hidden_item(Frame& F, int item) {
    const int p0 = item * 8, sel = p0 < 2048 ? 0 : (p0 < 4096 ? 1 : 2), layer = sel == 1 ? 1 : 0, L = sel == 2 ? LC : LL, pbase = sel == 0 ? 0 : (sel == 1 ? 2048 : 4096);
    const GAS float* f1 = inp(F, I_HYF1) + layer * 33 * 64; const GAS float* fb1 = inp(F, I_HYFB1) + layer * 64;
    const GAS float* f2 = inp(F, I_HYF2) + layer * 64 * 64; const GAS float* fb2 = inp(F, I_HYFB2) + layer * 64;
    const int lane = F.lane;
    const float b1 = fb1[lane], b2 = fb2[lane];
    for (int pl = 0; pl < 8; ++pl) {
        const int pos = p0 + pl - pbase;
        const float t = (float)pos / (float)(L - 1);
        const float w = 6.283185307179586f * (float)pos / (float)L;
        float feat = 0.f;
        if (lane == 0) feat = t;
        else if (lane < 17) { const float band = 1e-4f + (float)(lane - 1) * ((15.0f - 1e-4f) / 15.0f); feat = cosf(w * band); }
        else if (lane < 33) { const float band = 1e-4f + (float)(lane - 17) * ((15.0f - 1e-4f) / 15.0f); feat = -sinf(w * band); }
        float a1 = b1;
        for (int i = 0; i < 33; ++i) a1 += __int_as_float(__builtin_amdgcn_readlane(__float_as_int(feat), i)) * f1[i * 64 + lane];
        const float h1 = sinf(a1);
        float a2 = b2;
        for (int i = 0; i < 64; ++i) a2 += __int_as_float(__builtin_amdgcn_readlane(__float_as_int(h1), i)) * f2[i * 64 + lane];
        WSP(float, WS_HID2)[(size_t)(p0 + pl) * 64 + lane] = sinf(a2);
    }
}
__device__ __forceinline__ void filter_out_item(Frame& F, int item) {
    int sel, r;
    if (item < 768) { sel = 0; r = item; } else if (item < 1536) { sel = 1; r = item - 768; } else { sel = 2; r = item - 1536; }
    const int layer = sel == 1 ? 1 : 0, L = sel == 2 ? LC : LL, pb = r / 24, ch = r % 24, pbase = sel == 0 ? 0 : (sel == 1 ? 2048 : 4096);
    GAS bf16* FT = sel == 2 ? WSP(bf16, WS_FTC) : WSP(bf16, WS_FTL) + (size_t)layer * 2 * 384 * 4096;
    const GAS float* f3 = inp(F, I_HYF3) + (size_t)layer * 64 * 1536; const GAS float* dec = inp(F, I_HYDECAY) + layer * 1536;
    const int lane = F.lane, fr = lane & 15, fq = lane >> 4;
    const GAS float* hid = WSP(const float, WS_HID2) + (size_t)(pbase + pb * 64) * 64;
    f32x4 acc[4][4];
#pragma unroll
    for (int mt = 0; mt < 4; ++mt)
#pragma unroll
        for (int nt = 0; nt < 4; ++nt) acc[mt][nt] = (f32x4){0.f, 0.f, 0.f, 0.f};
#pragma unroll 4
    for (int ks = 0; ks < 16; ++ks) {
        float a[4], bb[4];
#pragma unroll
        for (int mt = 0; mt < 4; ++mt) a[mt] = hid[(16 * mt + fr) * 64 + 4 * ks + fq];
#pragma unroll
        for (int nt = 0; nt < 4; ++nt) bb[nt] = f3[(size_t)(4 * ks + fq) * 1536 + ch * 64 + 16 * nt + fr];
#pragma unroll
        for (int mt = 0; mt < 4; ++mt)
#pragma unroll
            for (int nt = 0; nt < 4; ++nt) acc[mt][nt] = __builtin_amdgcn_mfma_f32_16x16x4f32(a[mt], bb[nt], acc[mt][nt], 0, 0, 0);
    }
#pragma unroll
    for (int nt = 0; nt < 4; ++nt) {
        const int nn = ch * 64 + 16 * nt + fr, o = nn / 768, dir = (nn / 384) & 1, c = nn % 384;
        const float adec = fabsf(dec[nn]);
        GAS bf16* dst = FT + (size_t)(o * 384 + c) * (2 * L);
#pragma unroll
        for (int mt = 0; mt < 4; ++mt)
#pragma unroll
            for (int j = 0; j < 4; ++j) {
                const int pos = pb * 64 + 16 * mt + 4 * fq + j;
                const float t = (float)pos / (float)(L - 1);
                const float v = acc[mt][nt][j] * expf(-t * adec);
                if (dir == 0) dst[L - pos] = (bf16)f2bf(v);
                else if (pos > 0) dst[L + pos] = (bf16)f2bf(v);
            }
    }
}

__device__ __forceinline__ void phase_p0(Frame& F) {
    const int gw = F.wg * NWAVES + F.wave, NGW = F.G * NWAVES;
    LAS float* sl = (LAS float*)F.lds;
    LAS float* red = (LAS float*)(F.lds + 17 * 4096);
    for (int i = F.tid; i < 17 * 1024; i += NTHR) { const int r = i >> 10, k = i & 1023; const float v = r < 16 ? inp(F, I_C)[r * 1024 + k] : inp(F, I_CCTX)[k]; sl[i] = siluf_(v); }
    __syncthreads();
    for (int item = F.wg; item < 2 * 384; item += F.G) {
        const int layer = item / 384, n0 = (item % 384) * 16, j = F.tid & 15, kp = F.tid >> 4;
        const GAS float* W = inp(F, I_WMOD) + (size_t)layer * D * 6144;
        float acc[17];
#pragma unroll
        for (int r = 0; r < 17; ++r) acc[r] = 0.f;
        for (int k = kp * 32; k < kp * 32 + 32; ++k) { const float w = W[(size_t)k * 6144 + n0 + j];
#pragma unroll
            for (int r = 0; r < 17; ++r) acc[r] += sl[r * 1024 + k] * w; }
#pragma unroll
        for (int r = 0; r < 17; ++r) red[(kp * 17 + r) * 16 + j] = acc[r];
        __syncthreads();
        if (F.tid < 272) { const int r = F.tid >> 4, jj = F.tid & 15; float s = inp(F, I_BMOD)[layer * 6144 + n0 + jj];
            for (int q = 0; q < 32; ++q) s += red[(q * 17 + r) * 16 + jj];
            WSP(float, WS_MOD)[(size_t)(layer * 17 + r) * 6144 + n0 + jj] = s; }
        __syncthreads();
    }
    __syncthreads();
    LAS float* scr = (LAS float*)(F.lds + F.wave * 8704);
    conv_weights_win(F, 0, gw, NGW, scr);
    conv_weights_upout(F, 0, gw, NGW, scr);
    for (int i = gw * 64 + F.lane; i < 2048 * 32; i += NGW * 64) {
        const int t = i >> 5, j = i & 31, half = j >> 4, ii = j & 15;
        const float inv = 1.0f / powf(10000.0f, (float)ii / 16.0f);
        const float ang = (float)(half == 0 ? (t >> 6) : (t & 63)) * inv;
        WSP(float, WS_ROPE)[t * 64 + half * 32 + ii] = cosf(ang);
        WSP(float, WS_ROPE)[t * 64 + half * 32 + 16 + ii] = sinf(ang);
    }
    for (int it = gw; it < 4352 / 8; it += NGW) filter_hidden_item(F, it);
}
__device__ __forceinline__ void write_bias(Frame& F) {
    const int gt = (F.wg * NWAVES + F.wave) * 64 + F.lane, NGT = F.G * NTHR;
    for (int i = gt; i < 2 * NWP; i += NGT) {
        const int l = i / NWP, r = i % NWP; float v = 0.f;
        int n = -1;
        if (r < 1152) n = r; else if (r < 1168) n = 3712 + (r - 1152); else if (r < 1280) n = -1; else if (r < 2816) n = 1152 + (r - 1280); else if (r < 3840) n = 2688 + (r - 2816); else n = 3728 + (r - 3840);
        if (n >= 0) v = inp(F, I_BIN)[l * NIN + n];
        WSP(float, WS_BIAS)[i] = v;
    }
}

__device__ __forceinline__ void norm_mod_row(const GAS float* xrow, const GAS float* g, const GAS float* shift, const GAS float* scale, GAS bf16* orow, int lane, float* keep  ) {
    f32x4 v[4]; float s = 0.f;
#pragma unroll
    for (int j = 0; j < 4; ++j) { v[j] = *(const GAS f32x4*)(xrow + 256 * j + 4 * lane); s += (v[j].x * v[j].x + v[j].y * v[j].y) + (v[j].z * v[j].z + v[j].w * v[j].w); }
    const float r = rsqrtf(wave_sum(s) * (1.0f / 1024.0f) + 1e-6f);
#pragma unroll
    for (int j = 0; j < 4; ++j) {
        const f32x4 gg = *(const GAS f32x4*)(g + 256 * j + 4 * lane), sh = *(const GAS f32x4*)(shift + 256 * j + 4 * lane), sc = *(const GAS f32x4*)(scale + 256 * j + 4 * lane);
        f32x4 o;
        o.x = (v[j].x * r * gg.x) * (1.f + sc.x) + sh.x; o.y = (v[j].y * r * gg.y) * (1.f + sc.y) + sh.y;
        o.z = (v[j].z * r * gg.z) * (1.f + sc.z) + sh.z; o.w = (v[j].w * r * gg.w) * (1.f + sc.w) + sh.w;
        if (keep) { keep[4 * j + 0] = o.x; keep[4 * j + 1] = o.y; keep[4 * j + 2] = o.z; keep[4 * j + 3] = o.w; }
        u32x2 w; w.x = pk2(o.x, o.y); w.y = pk2(o.z, o.w);
        *(GAS u32x2*)(orow + 256 * j + 4 * lane) = w;
    }
}
__device__ __forceinline__ const GAS float* xrow_ptr(const Frame& F, int row, bool from_input) {
    if (row < TOKL) return (from_input ? inp(F, I_X) : outp(F)) + (size_t)row * D;
    return (from_input ? inp(F, I_CTX) : WSP(const float, WS_XC)) + (size_t)(row - TOKL) * D;
}
__device__ __forceinline__ void phase_norm(Frame& F, int layer, int nrows, bool from_input, int which) {
    const int gw = F.wg * NWAVES + F.wave, NGW = F.G * NWAVES;
    const GAS float* g = inp(F, which == 0 ? I_GMIX : I_GFFN) + layer * D;
#pragma unroll 2
    for (int row = gw; row < nrows; row += NGW)
        norm_mod_row(xrow_ptr(F, row, from_input), g, mod_ptr(F, layer, row, which), mod_ptr(F, layer, row, which + 1), WSP(bf16, WS_H) + (size_t)row * D, F.lane, nullptr);
}

namespace pg8 {
constexpr int BM = 256, BK = 64, HALF = 128, HTB = HALF * BK * 2, STAGE_BYTES = 8 * HTB, NXCD = 8, WGM = 8;
__device__ __forceinline__ int lds_byte(int r, int c) { const int st = (r >> 4) * 2 + (c >> 5), rr = r & 15, cc = c & 31, ob = rr * 64 + cc * 2; return st * 1024 + (ob ^ (((ob >> 9) & 1) << 5)); }
__device__ __forceinline__ void stage_rc(int b, int& R, int& C) { const int st = b / 1024, sb = b % 1024, swz = sb ^ (((sb >> 9) & 1) << 5); R = (st >> 1) * 16 + swz / 64; C = (st & 1) * 32 + (swz % 64) / 2; }
struct Unit { int pm, pn; };
struct OrderPlain {
    static constexpr bool GATHER = false;
    int nM, nN, nwg, G, c;
    __device__ __forceinline__ void init(int nM_, int nN_, int G_, int c_) { nM = nM_; nN = nN_; nwg = nM * nN; G = G_; c = c_; }
    __device__ __forceinline__ bool next(int i, Unit& u) const {
        const long L = (long)i * G + c; if (L >= nwg) return false;
        int wgid = (int)L; { const int q = nwg / NXCD, r = nwg % NXCD, xcd = wgid % NXCD, off = wgid / NXCD; wgid = (xcd < r ? xcd * (q + 1) : r * (q + 1) + (xcd - r) * q) + off; }
        const int nig = WGM * nN, gid = wgid / nig, fm = gid * WGM, gsz = (nM - fm) < WGM ? (nM - fm) : WGM;
        u.pm = fm + ((wgid % nig) % gsz); u.pn = (wgid % nig) / gsz; return true;
    }
    __device__ __forceinline__ int arow(int r) const { return r; }
    __device__ __forceinline__ size_t boff(const Unit&) const { return 0; }
};
struct OrderMoe {
    static constexpr bool GATHER = true;
    OrderPlain o; const GAS int* rowidx; const GAS int* tilee; int t0; size_t bstride; bool gather;
    __device__ __forceinline__ bool next(int i, Unit& u) const { return o.next(i, u); }
    __device__ __forceinline__ int arow(int r) const { return gather ? rowidx[t0 * 256 + r] : r; }
    __device__ __forceinline__ size_t boff(const Unit& u) const { return (size_t)tilee[t0 + u.pm] * bstride; }
};

template <class Epi, class Sched>
__device__ __forceinline__ void gemm_phase(LAS unsigned char* lds, int tid_in, const GAS bf16* A, int lda, const GAS bf16* Bt, int ldb, int K, const Sched& S, const Epi& E) {
    unsigned tid_u = (unsigned)tid_in; asm volatile("" : "+v"(tid_u));
    const int tid = (int)tid_u, wid = __builtin_amdgcn_readfirstlane(tid >> 6), lane = tid & 63, wr = wid >> 2, wc = wid & 3, fr = lane & 15, fq = lane >> 4;
    const int nt = K / BK;
    unsigned voffB[2];
    { int sR[2], sC[2];
#pragma unroll
      for (int i = 0; i < 2; ++i) { stage_rc(tid * 16 + i * 8192, sR[i], sC[i]);
        const int rho = sR[i] & 31, Rb = Epi::PERM ? ((sR[i] & ~31) + 8 * ((rho & 15) >> 2) + 4 * (rho >> 4) + (rho & 3)) : sR[i];
        voffB[i] = (unsigned)(Rb * ldb + sC[i]) * 2u; } }
#define PG8_GATHER_OFFS(pm_) do { unsigned _t = (unsigned)tid; asm volatile("" : "+v"(_t)); _Pragma("unroll") for (int i = 0; i < 2; ++i) { int _R, _C; stage_rc((int)_t * 16 + i * 8192, _R, _C); \
        vc0[i] = (unsigned)((size_t)S.arow((pm_) * BM + _R) * lda + _C) * 2u; vc1[i] = (unsigned)((size_t)S.arow((pm_) * BM + HALF + _R) * lda + _C) * 2u; } } while (0)
    const size_t kstep = (size_t)(BK * 2);
    const size_t hstepB = (size_t)HALF * ldb * 2, tstepB = 2 * hstepB;
    const unsigned ldsw = (unsigned)wid * 1024u;
    const int aoff = lds_byte(wr * 64 + fr, fq * 8), boff = lds_byte(wc * 32 + fr, fq * 8);
#define PG8_SA(b, h) (((b) * 2 + (h)) * HTB)
#define PG8_SB(b, h) ((4 + (b) * 2 + (h)) * HTB)
#define PG8_STAGE2(bufoff, gbase, v0, v1) do { \
        __builtin_amdgcn_global_load_lds((const GAS unsigned*)((const GAS char*)(gbase) + (v0)), (LAS unsigned*)(lds + (bufoff) + ldsw), 16, 0, 0); \
        __builtin_amdgcn_global_load_lds((const GAS unsigned*)((const GAS char*)(gbase) + (v1)), (LAS unsigned*)(lds + (bufoff) + ldsw + 8192), 16, 0, 0); } while (0)
#define PG8_STAGEB(bufoff, gbase) PG8_STAGE2(bufoff, gbase, voffB[0], voffB[1])
#define PG8_LDA(dst, b, h) do { _Pragma("unroll") for (int m = 0; m < 4; ++m) _Pragma("unroll") for (int k = 0; k < 2; ++k) dst[m][k] = *(const LAS bf16x8*)(lds + PG8_SA(b, h) + aoff + m * 2048 + k * 1024); } while (0)
#define PG8_LDB(dst, b, h) do { _Pragma("unroll") for (int n = 0; n < 2; ++n) _Pragma("unroll") for (int k = 0; k < 2; ++k) dst[n][k] = *(const LAS bf16x8*)(lds + PG8_SB(b, h) + boff + n * 2048 + k * 1024); } while (0)
#define PG8_MMA(ai, bj, At, Bt_) do { __builtin_amdgcn_s_setprio(1); _Pragma("unroll") for (int m = 0; m < 4; ++m) _Pragma("unroll") for (int n = 0; n < 2; ++n) _Pragma("unroll") for (int k = 0; k < 2; ++k) \
        acc[ai][bj][m][n] = __builtin_amdgcn_mfma_f32_16x16x32_bf16(Bt_[n][k], At[m][k], acc[ai][bj][m][n], 0, 0, 0); __builtin_amdgcn_s_setprio(0); } while (0)
#define PG8_WAIT_V(n) asm volatile("s_waitcnt vmcnt(" #n ")" ::: "memory")
#define PG8_WAIT_L(n) asm volatile("s_waitcnt lgkmcnt(" #n ")" ::: "memory")
#define PG8_BAR __builtin_amdgcn_s_barrier()
#define PG8_SCHED __builtin_amdgcn_sched_barrier(0)
    Unit cur, nxt; int ui = 0;
    if (!S.next(0, cur)) return;
    f32x4 acc[2][2][4][2];
#pragma unroll
    for (int a = 0; a < 2; ++a)
#pragma unroll
        for (int b = 0; b < 2; ++b)
#pragma unroll
            for (int m = 0; m < 4; ++m)
#pragma unroll
                for (int n = 0; n < 2; ++n) { float zf; asm volatile("v_mov_b32 %0, 0" : "=v"(zf)); acc[a][b][m][n] = (f32x4){zf, zf, zf, zf}; }
    bf16x8 At[4][2], B0[2][2], B1[2][2];
    constexpr bool GA = Sched::GATHER;
    const size_t hstepA = GA ? 0 : (size_t)HALF * lda * 2, tstepA = (size_t)BM * lda * 2;
    unsigned vc0[2], vc1[2];
    if constexpr (GA) { PG8_GATHER_OFFS(cur.pm); }
    else { int sR, sC;
#pragma unroll
        for (int i = 0; i < 2; ++i) { stage_rc(tid * 16 + i * 8192, sR, sC); vc0[i] = (unsigned)(sR * lda + sC) * 2u; vc1[i] = 0u; } }
#define VC0(i) vc0[i]
#define VC1(i) (GA ? vc1[i] : vc0[i])
#define VN0(i) vc0[i]
#define VN1(i) VC1(i)
    const GAS char* cA = GA ? (const GAS char*)A : (const GAS char*)A + (size_t)cur.pm * tstepA;
    const GAS char* cB = (const GAS char*)Bt + S.boff(cur) * 2 + (size_t)cur.pn * tstepB;
    PG8_STAGEB(PG8_SB(0, 0), cB); PG8_STAGE2(PG8_SA(0, 0), cA, VC0(0), VC0(1)); PG8_STAGEB(PG8_SB(0, 1), cB + hstepB); PG8_STAGE2(PG8_SA(0, 1), cA + hstepA, VC1(0), VC1(1));
    if (wr == 1) PG8_BAR;
    PG8_WAIT_V(4); PG8_BAR;
    PG8_STAGEB(PG8_SB(1, 0), cB + kstep); PG8_STAGE2(PG8_SA(1, 0), cA + kstep, VC0(0), VC0(1)); PG8_STAGEB(PG8_SB(1, 1), cB + hstepB + kstep);
    PG8_WAIT_V(6); PG8_BAR;
    for (;;) {
        const bool has_next = S.next(ui + 1, nxt);
        const GAS char* nB = cB; const GAS char* nA = cA;
        if (has_next) {
            nB = (const GAS char*)Bt + S.boff(nxt) * 2 + (size_t)nxt.pn * tstepB;
            if constexpr (!GA) nA = (const GAS char*)A + (size_t)nxt.pm * tstepA;
        }
        for (int t = 0; t < nt; t += 2) {
            const bool last = (t == nt - 2);
            if constexpr (Epi::HORNER) {
                if (t == 6 || t == 12) {
                    asm volatile("" ::: "memory");
                    const int seg = (t == 6) ? 0 : 1;
                    int hpm = cur.pm, hpn = cur.pn; asm volatile("" : "+s"(hpm), "+s"(hpn));
                    unsigned hln = (unsigned)lane; asm volatile("" : "+v"(hln)); const int hfr = (int)(hln & 15u), hfq = (int)(hln >> 4);
#pragma unroll
                    for (int ai = 0; ai < 2; ++ai) {
                        u32x4 ga[4][2], gb[4][2];
#pragma unroll
                        for (int m = 0; m < 4; ++m)
#pragma unroll
                            for (int bj = 0; bj < 2; ++bj) {
                                const int row = hpm * BM + ai * HALF + wr * 64 + m * 16 + hfr, col = hpn * BM + bj * HALF + wc * 32 + 8 * hfq;
                                ga[m][bj] = E.gate8(seg, row, col); gb[m][bj] = E.gate8(seg + 1, row, col);
                            }
                        asm volatile("" : "+v"(ga[0][0]), "+v"(ga[0][1]), "+v"(ga[1][0]), "+v"(ga[1][1]), "+v"(ga[2][0]), "+v"(ga[2][1]), "+v"(ga[3][0]), "+v"(ga[3][1]),
                                          "+v"(gb[0][0]), "+v"(gb[0][1]), "+v"(gb[1][0]), "+v"(gb[1][1]), "+v"(gb[2][0]), "+v"(gb[2][1]), "+v"(gb[3][0]), "+v"(gb[3][1]) :: "memory");
#pragma unroll
                        for (int m = 0; m < 4; ++m)
#pragma unroll
                            for (int bj = 0; bj < 2; ++bj) {
                                const unsigned aw[4] = {ga[m][bj].x, ga[m][bj].y, ga[m][bj].z, ga[m][bj].w}, bw[4] = {gb[m][bj].x, gb[m][bj].y, gb[m][bj].z, gb[m][bj].w};
#pragma unroll
                                for (int n = 0; n < 2; ++n) {
                                    f32x4& v = acc[ai][bj][m][n];
                                    v.x *= __uint_as_float(aw[2 * n] << 16) * __builtin_amdgcn_rcpf(__uint_as_float(bw[2 * n] << 16));
                                    v.y *= __uint_as_float(aw[2 * n] & 0xffff0000u) * __builtin_amdgcn_rcpf(__uint_as_float(bw[2 * n] & 0xffff0000u));
                                    v.z *= __uint_as_float(aw[2 * n + 1] << 16) * __builtin_amdgcn_rcpf(__uint_as_float(bw[2 * n + 1] << 16));
                                    v.w *= __uint_as_float(aw[2 * n + 1] & 0xffff0000u) * __builtin_amdgcn_rcpf(__uint_as_float(bw[2 * n + 1] & 0xffff0000u));
                                }
                            }
                    }
                    asm volatile("s_waitcnt vmcnt(0)" ::: "memory");
                }
            }
            const GAS char* a1 = cA + (size_t)(t + 1) * kstep;
            const GAS char* a2 = last ? nA : cA + (size_t)(t + 2) * kstep; const GAS char* b2 = last ? nB : cB + (size_t)(t + 2) * kstep;
            const GAS char* a3 = a2 + kstep; const GAS char* b3 = b2 + kstep;
            PG8_LDB(B0, 0, 0); PG8_SCHED; PG8_LDA(At, 0, 0); PG8_STAGE2(PG8_SA(1, 1), a1 + hstepA, VC1(0), VC1(1));
            if constexpr (GA) { if (last && has_next) { asm volatile("" ::: "memory"); PG8_GATHER_OFFS(nxt.pm); asm volatile("" ::: "memory"); } }
            PG8_WAIT_L(8); PG8_BAR; PG8_WAIT_L(0); PG8_MMA(0, 0, At, B0); PG8_BAR; PG8_SCHED;
            PG8_LDB(B1, 0, 1); PG8_STAGEB(PG8_SB(0, 0), b2);
            PG8_BAR; PG8_WAIT_L(0); PG8_MMA(0, 1, At, B1); PG8_BAR;
            PG8_LDA(At, 0, 1); PG8_STAGE2(PG8_SA(0, 0), a2, VN0(0), VN0(1));
            PG8_BAR; PG8_WAIT_L(0); PG8_MMA(1, 0, At, B0); PG8_BAR; PG8_SCHED;
            PG8_STAGEB(PG8_SB(0, 1), b2 + hstepB);
            PG8_WAIT_V(6); PG8_BAR; PG8_MMA(1, 1, At, B1); PG8_BAR;
            PG8_LDB(B0, 1, 0); PG8_SCHED; PG8_LDA(At, 1, 0); PG8_STAGE2(PG8_SA(0, 1), a2 + hstepA, VN1(0), VN1(1));
            PG8_WAIT_L(8); PG8_BAR; PG8_WAIT_L(0); PG8_MMA(0, 0, At, B0); PG8_BAR; PG8_SCHED;
            PG8_LDB(B1, 1, 1); PG8_STAGEB(PG8_SB(1, 0), b3);
            PG8_BAR; PG8_WAIT_L(0); PG8_MMA(0, 1, At, B1); PG8_BAR;
            PG8_LDA(At, 1, 1); PG8_STAGE2(PG8_SA(1, 0), a3, VN0(0), VN0(1));
            PG8_BAR; PG8_WAIT_L(0); PG8_MMA(1, 0, At, B0); PG8_BAR; PG8_SCHED;
            PG8_STAGEB(PG8_SB(1, 1), b3 + hstepB);
            PG8_WAIT_V(6); PG8_BAR; PG8_MMA(1, 1, At, B1); PG8_BAR;
        }
        {
            int epm = cur.pm, epn = cur.pn; asm volatile("" : "+s"(epm), "+s"(epn));
            unsigned eln = (unsigned)lane; asm volatile("" : "+v"(eln)); const int efr = (int)(eln & 15u), efq = (int)(eln >> 4);
            constexpr bool PM = Epi::PERM;
#define PG8_COL(bj, n) (epn * BM + (bj) * HALF + wc * 32 + (PM ? 8 * efq + 4 * (n) : (n) * 16 + 4 * efq))
            f32x4 cv[2][2];
#pragma unroll
            for (int bj = 0; bj < 2; ++bj)
#pragma unroll
                for (int n = 0; n < 2; ++n) { if constexpr (Epi::COLVEC) cv[bj][n] = E.colvec(epm * BM, PG8_COL(bj, n)); else cv[bj][n] = (f32x4){0.f, 0.f, 0.f, 0.f}; }
            if constexpr (Epi::COLVEC) asm volatile("" : "+v"(cv[0][0]), "+v"(cv[0][1]), "+v"(cv[1][0]), "+v"(cv[1][1]) :: "memory");
#pragma unroll
            for (int ai = 0; ai < 2; ++ai) {
                f32x4 bs[4][2][2];
                if constexpr (Epi::BASE) {
#pragma unroll
                    for (int m = 0; m < 4; ++m)
#pragma unroll
                        for (int bj = 0; bj < 2; ++bj) {
                            const int row = epm * BM + ai * HALF + wr * 64 + m * 16 + efr;
                            if constexpr (PM) E.base8(row, PG8_COL(bj, 0), bs[m][bj][0], bs[m][bj][1]);
                            else {
#pragma unroll
                                for (int n = 0; n < 2; ++n) bs[m][bj][n] = E.base(row, PG8_COL(bj, n));
                            }
                        }
                    asm volatile("" : "+v"(bs[0][0][0]), "+v"(bs[0][0][1]), "+v"(bs[0][1][0]), "+v"(bs[0][1][1]), "+v"(bs[1][0][0]), "+v"(bs[1][0][1]), "+v"(bs[1][1][0]), "+v"(bs[1][1][1]),
                                      "+v"(bs[2][0][0]), "+v"(bs[2][0][1]), "+v"(bs[2][1][0]), "+v"(bs[2][1][1]), "+v"(bs[3][0][0]), "+v"(bs[3][0][1]), "+v"(bs[3][1][0]), "+v"(bs[3][1][1]) :: "memory");
                }
#pragma unroll
                for (int m = 0; m < 4; ++m) {
                    const int row = epm * BM + ai * HALF + wr * 64 + m * 16 + efr;
#pragma unroll
                    for (int bj = 0; bj < 2; ++bj) {
                        if constexpr (Epi::PAIR) E.store_pair(row, epn * (BM / 2) + bj * (HALF / 2) + wc * 16 + 4 * efq, acc[ai][bj][m][0], acc[ai][bj][m][1]);
                        else if constexpr (PM) {
                            f32x4 b0 = (f32x4){0.f, 0.f, 0.f, 0.f}, b1 = b0; if constexpr (Epi::BASE) { b0 = bs[m][bj][0]; b1 = bs[m][bj][1]; }
                            E.store8(row, PG8_COL(bj, 0), acc[ai][bj][m][0], acc[ai][bj][m][1], cv[bj][0], cv[bj][1], b0, b1);
                        } else {
#pragma unroll
                            for (int n = 0; n < 2; ++n) { f32x4 bb = (f32x4){0.f, 0.f, 0.f, 0.f}; if constexpr (Epi::BASE) bb = bs[m][bj][n]; E.store(row, PG8_COL(bj, n), acc[ai][bj][m][n], cv[bj][n], bb); }
                        }
                    }
                }
            }
#undef PG8_COL
        }
        if (!has_next) break;
#pragma unroll
        for (int a = 0; a < 2; ++a)
#pragma unroll
            for (int b = 0; b < 2; ++b)
#pragma unroll
                for (int m = 0; m < 4; ++m)
#pragma unroll
                    for (int n = 0; n < 2; ++n) { float zf; asm volatile("v_mov_b32 %0, 0" : "=v"(zf)); acc[a][b][m][n] = (f32x4){zf, zf, zf, zf}; }
        cur = nxt; cB = nB; cA = nA; ++ui;
    }
    PG8_WAIT_V(0);
    if (wr == 0) PG8_BAR;
    PG8_BAR;
#undef PG8_GATHER_OFFS
#undef VC0
#undef VC1
#undef VN0
#undef VN1
#undef PG8_SA
#undef PG8_SB
#undef PG8_STAGE2
#undef PG8_STAGEB
#undef PG8_LDA
#undef PG8_LDB
#undef PG8_MMA
#undef PG8_WAIT_V
#undef PG8_WAIT_L
#undef PG8_BAR
#undef PG8_SCHED
}
}

template <class Epi>
__device__ __forceinline__ void gemm_fast(Frame& F, const GAS bf16* A, int lda, const GAS bf16* Bt, int ldb, int K, int M, int N, const Epi& E) {
    pg8::OrderPlain S; S.init(M / 256, N / 256, F.G, F.wg);
    pg8::gemm_phase(F.lds, F.tid, A, lda, Bt, ldb, K, S, E);
}
#ifndef FAST_PLAIN
#define FAST_PLAIN 1
#endif
#ifndef FAST_HORNER
#define FAST_HORNER 1
#endif
#ifndef FAST_MOE
#define FAST_MOE 1
#endif

__device__ __forceinline__ void st_bf16x4(GAS bf16* p, f32x4 v) { u32x2 w; w.x = pk2(v.x, v.y); w.y = pk2(v.z, v.w); *(GAS u32x2*)p = w; }
__device__ __forceinline__ f32x4 ld_bf16x4(const GAS bf16* p) { const u32x2 w = *(const GAS u32x2*)p; f32x4 v; v.x = __uint_as_float(w.x << 16); v.y = __uint_as_float(w.x & 0xffff0000u); v.z = __uint_as_float(w.y << 16); v.w = __uint_as_float(w.y & 0xffff0000u); return v; }

__device__ __forceinline__ void st_bf16x8(GAS bf16* p, f32x4 a, f32x4 b) { u32x4 w; w.x = pk2(a.x, a.y); w.y = pk2(a.z, a.w); w.z = pk2(b.x, b.y); w.w = pk2(b.z, b.w); *(GAS u32x4*)p = w; }
struct EpiWin {
    static constexpr bool HORNER = false, PAIR = false, COLVEC = true, BASE = false, PERM = true;
    const GAS float* bias; GAS bf16 *hytl, *hytc, *ret, *ml; GAS float* mlg;
    __device__ __forceinline__ f32x4 colvec(int, int col) const { return *(const GAS f32x4*)(bias + col); }
    __device__ __forceinline__ void store8(int row, int col, f32x4 v0, f32x4 v1, f32x4 c0, f32x4 c1, f32x4, f32x4) const {
        v0 += c0; v1 += c1;
        if (col < 1152) {
            const float v[8] = {v0.x, v0.y, v0.z, v0.w, v1.x, v1.y, v1.z, v1.w};
            if (row < TOKL) { const int b = row >> 11, t = row & 2047; GAS bf16* d = hytl + ((size_t)(b * 1152 + col)) * 2048 + t;
#pragma unroll
                for (int j = 0; j < 8; ++j) d[2048 * j] = (bf16)f2bf(v[j]); }
            else { const int r = row - TOKL, b = r >> 8, t = r & 255; GAS bf16* d = hytc + ((size_t)(b * 1152 + col)) * 256 + t;
#pragma unroll
                for (int j = 0; j < 8; ++j) d[256 * j] = (bf16)f2bf(v[j]); }
        } else if (col < 1168) { *(GAS f32x4*)(mlg + (size_t)row * 16 + (col - 1152)) = v0; *(GAS f32x4*)(mlg + (size_t)row * 16 + (col - 1152) + 4) = v1; }
        else if (col < 1280) { }
        else if (col < 2816) st_bf16x8(ret + (size_t)row * 1536 + (col - 1280), v0, v1);
        else st_bf16x8(ml + (size_t)row * 1024 + (col - 2816), v0, v1);
    }
};
struct EpiGate {
    static constexpr bool HORNER = false, PAIR = false, COLVEC = true, BASE = false, PERM = true;
    const GAS float* bias; GAS bf16* gates;
    __device__ __forceinline__ f32x4 colvec(int, int col) const { return *(const GAS f32x4*)(bias + col); }
    __device__ __forceinline__ void store8(int row, int col, f32x4 v0, f32x4 v1, f32x4 c0, f32x4 c1, f32x4, f32x4) const {
        v0 += c0; v1 += c1;
        f32x4 g0, g1;
        g0.x = fmaxf(sigmoidf_(v0.x), 1e-20f); g0.y = fmaxf(sigmoidf_(v0.y), 1e-20f); g0.z = fmaxf(sigmoidf_(v0.z), 1e-20f); g0.w = fmaxf(sigmoidf_(v0.w), 1e-20f);
        g1.x = fmaxf(sigmoidf_(v1.x), 1e-20f); g1.y = fmaxf(sigmoidf_(v1.y), 1e-20f); g1.z = fmaxf(sigmoidf_(v1.z), 1e-20f); g1.w = fmaxf(sigmoidf_(v1.w), 1e-20f);
        st_bf16x8(gates + (size_t)row * NGATE + col, g0, g1);
    }
};
struct EpiUp {
    static constexpr bool HORNER = true, PAIR = false, COLVEC = false, BASE = true, PERM = true;
    const GAS bf16* gates; GAS bf16* acc_out;
    __device__ __forceinline__ u32x4 gate8(int which, int row, int col) const { return *(const GAS u32x4*)(gates + (size_t)row * NGATE + which * 1024 + col); }
    __device__ __forceinline__ void base8(int row, int col, f32x4& b0, f32x4& b1) const {
        const u32x4 w = *(const GAS u32x4*)(gates + (size_t)row * NGATE + 2048 + col);
        b0.x = __uint_as_float(w.x << 16); b0.y = __uint_as_float(w.x & 0xffff0000u); b0.z = __uint_as_float(w.y << 16); b0.w = __uint_as_float(w.y & 0xffff0000u);
        b1.x = __uint_as_float(w.z << 16); b1.y = __uint_as_float(w.z & 0xffff0000u); b1.z = __uint_as_float(w.w << 16); b1.w = __uint_as_float(w.w & 0xffff0000u);
    }
    __device__ __forceinline__ void store8(int row, int col, f32x4 v0, f32x4 v1, f32x4, f32x4, f32x4 g0, f32x4 g1) const { st_bf16x8(acc_out + (size_t)row * D + col, v0 * g0, v1 * g1); }
};
struct EpiResid {
    static constexpr bool HORNER = false, PAIR = false, COLVEC = true, BASE = true, PERM = false;
    const GAS float *xin_l, *xin_c; GAS float *xout_l, *xout_c; const GAS float* modbase; int which;
    __device__ __forceinline__ f32x4 colvec(int row0, int col) const { const int r = row0 < TOKL ? (row0 >> 11) : 16; return *(const GAS f32x4*)(modbase + ((size_t)r * 6 + which) * 1024 + col); }
    __device__ __forceinline__ f32x4 base(int row, int col) const { return row < TOKL ? *(const GAS f32x4*)(xin_l + (size_t)row * D + col) : *(const GAS f32x4*)(xin_c + (size_t)(row - TOKL) * D + col); }
    __device__ __forceinline__ void store(int row, int col, f32x4 v, f32x4 m, f32x4 x) const {
        if (row < TOKL) *(GAS f32x4*)(xout_l + (size_t)row * D + col) = x + m * v;
        else *(GAS f32x4*)(xout_c + (size_t)(row - TOKL) * D + col) = x + m * v;
    }
};
struct EpiSwiglu {
    static constexpr bool HORNER = false, PAIR = true, COLVEC = false, BASE = false, PERM = false;
    GAS bf16* act; int row_off;
    __device__ __forceinline__ void store_pair(int row, int col, f32x4 a, f32x4 b) const {
        f32x4 o; o.x = siluf_(a.x) * b.x; o.y = siluf_(a.y) * b.y; o.z = siluf_(a.z) * b.z; o.w = siluf_(a.w) * b.w;
        st_bf16x4(act + (size_t)(row - row_off) * DFF + col, o);
    }
    __device__ __forceinline__ void store(int, int, f32x4, f32x4, f32x4) const {}
};
struct EpiBf16Out {
    static constexpr bool HORNER = false, PAIR = false, COLVEC = false, BASE = false, PERM = true;
    GAS bf16* out; int ld; int row_add;
    __device__ __forceinline__ void store8(int row, int col, f32x4 v0, f32x4 v1, f32x4, f32x4, f32x4, f32x4) const { st_bf16x8(out + (size_t)(row + row_add) * ld + col, v0, v1); }
};

constexpr int ZPITCH_L = (LL + 8) * 2, ZPITCH_C = (LC + 8) * 2;
template <int L>
__device__ __forceinline__ float conv3_at(const GAS bf16* base  , int t, float w0, float w1, float w2) {
    const float a = t > 0 ? bf2f(base[t - 1]) : 0.f, b = bf2f(base[t]), c = t < L - 1 ? bf2f(base[t + 1]) : 0.f;
    return w0 * a + w1 * b + w2 * c;
}
template <int L>
__device__ __forceinline__ void hyena_unit_naive(Frame& F, int layer, int c, const GAS bf16* hyt  , const GAS bf16* ft  , GAS bf16* yht  ) {
    constexpr int ZP = (L + 8) * 2;
    constexpr int PER = L / 32;
    constexpr int SUB = 8;
    LAS unsigned char* zimg0 = F.lds;
    LAS unsigned char* zimg1 = F.lds + 16 * ZP;
    LAS bf16* tf = (LAS bf16*)(F.lds + 32 * ZP);
    const GAS float* cw = inp(F, I_HYCONV) + layer * 3 * 1152;
    const GAS float* skip = inp(F, I_HYSKIP) + layer * 2 * 384;
    __syncthreads();
    {
        const int b = F.tid >> 5, seg = F.tid & 31; const GAS bf16* src = hyt + ((size_t)(b * 1152 + c)) * L;
        const float w0 = cw[c], w1 = cw[1152 + c], w2 = cw[2304 + c];
#pragma unroll 2
        for (int j = 0; j < PER; ++j) { const int t = seg * PER + j; *(LAS bf16*)(zimg0 + b * ZP + t * 2) = (bf16)f2bf(conv3_at<L>(src, t, w0, w1, w2)); }
    }
#pragma unroll 1
    for (int o = 0; o < 2; ++o) {
        LAS unsigned char* zs = o == 0 ? zimg0 : zimg1;
        LAS unsigned char* zd = o == 0 ? zimg1 : zimg0;
        const GAS bf16* fsrc = ft + ((size_t)(o * 384 + c)) * (2 * L);
        for (int i = F.tid; i < 2 * L; i += NTHR) tf[i] = i == 0 ? (bf16)0 : fsrc[i];
        __syncthreads();
        const int b = F.tid & 15, tg = F.tid >> 4;
        const int gcol = (o == 0 ? 384 : 768) + c;
        const GAS bf16* gsrc = hyt + ((size_t)(b * 1152 + gcol)) * L;
        const float w0 = cw[gcol], w1 = cw[1152 + gcol], w2 = cw[2304 + gcol], sk = skip[o * 384 + c];
#pragma unroll 1
        for (int sb = 0; sb < PER / SUB; ++sb) {
            const int t0 = tg * PER + sb * SUB;
            float acc[SUB];
#pragma unroll
            for (int j = 0; j < SUB; ++j) acc[j] = 0.f;
#pragma unroll 1
            for (int s0 = 0; s0 < L; s0 += 8) {
                float z[8];
                { const bf16x8 zz = *(const LAS bf16x8*)(zs + b * ZP + s0 * 2);
#pragma unroll
                  for (int i = 0; i < 8; ++i) z[i] = bf2f((bf16)zz[i]); }
                float win[SUB + 7];
                const int wb = L + s0 - t0 - (SUB - 1);
#pragma unroll
                for (int i = 0; i < SUB + 7; ++i) win[i] = bf2f(tf[wb + i]);
#pragma unroll
                for (int j = 0; j < SUB; ++j)
#pragma unroll
                    for (int i = 0; i < 8; ++i) acc[j] += win[(SUB - 1) - j + i] * z[i];
            }
#pragma unroll
            for (int j = 0; j < SUB; ++j) {
                const int t = t0 + j;
                const float zt = bf2f(*(LAS bf16*)(zs + b * ZP + t * 2));
                const float ov = conv3_at<L>(gsrc, t, w0, w1, w2) * (acc[j] + sk * zt);
                *(LAS bf16*)(zd + b * ZP + t * 2) = (bf16)f2bf(ov);
            }
        }
        __syncthreads();
    }
#pragma unroll 2
    for (int i = F.tid; i < 16 * (L / 8); i += NTHR) {
        const int b = i / (L / 8), ch = i % (L / 8);
        *(GAS u32x4*)(yht + ((size_t)(b * 384 + c)) * L + ch * 8) = *(const LAS u32x4*)(zimg0 + b * ZP + ch * 16);
    }
}

template <int L>
__device__ __forceinline__ void hyena_unit_fast(Frame& F, int layer, int c, const GAS bf16* hyt  , const GAS bf16* ft  , GAS bf16* yht  ) {
    constexpr int ZP = (L + 8) * 2;
    constexpr int PER = L / 32;
    constexpr int I = L / 128;
    constexpr int SPAN = L / 4, NSTEP = L / 32;
    constexpr int CP = (2 * L + 8) * 2;
    LAS unsigned char* zimg = F.lds;
    LAS unsigned char* cpy = F.lds + 16 * ZP;
    const GAS float* cw = inp(F, I_HYCONV) + layer * 3 * 1152;
    const GAS float* skip = inp(F, I_HYSKIP) + layer * 2 * 384;
    const int lane = F.lane, fr = lane & 15, fq = lane >> 4, w = F.wave;
    { unsigned long long a_ = (unsigned long long)hyt, b_ = (unsigned long long)yht; asm volatile("" : "+s"(a_), "+s"(b_)); hyt = (const GAS bf16*)a_; yht = (GAS bf16*)b_; }
    __syncthreads();
    {
        const int b = F.tid >> 5, sg = F.tid & 31, t0 = sg * PER; const GAS bf16* src = hyt + ((size_t)(b * 1152 + c)) * L + t0;
        const float w0 = cw[c], w1 = cw[1152 + c], w2 = cw[2304 + c];
        u32x4 raw[PER / 8];
#pragma unroll
        for (int j = 0; j < PER / 8; ++j) raw[j] = *(const GAS u32x4*)(src + 8 * j);
        float prev = t0 > 0 ? bf2f(src[-1]) : 0.f;
        const float nextv = t0 + PER < L ? bf2f(src[PER]) : 0.f;
#pragma unroll
        for (int j = 0; j < PER / 8; ++j) {
            const unsigned wv[4] = {raw[j].x, raw[j].y, raw[j].z, raw[j].w};
            float x[10]; x[0] = prev;
#pragma unroll
            for (int q = 0; q < 4; ++q) { x[1 + 2 * q] = __uint_as_float(wv[q] << 16); x[2 + 2 * q] = __uint_as_float(wv[q] & 0xffff0000u); }
            if (j + 1 < PER / 8) x[9] = __uint_as_float(raw[(j + 1 < PER / 8) ? j + 1 : j].x << 16); else x[9] = nextv;
            u32x4 o;
            o.x = pk2(w0 * x[0] + w1 * x[1] + w2 * x[2], w0 * x[1] + w1 * x[2] + w2 * x[3]); o.y = pk2(w0 * x[2] + w1 * x[3] + w2 * x[4], w0 * x[3] + w1 * x[4] + w2 * x[5]);
            o.z = pk2(w0 * x[4] + w1 * x[5] + w2 * x[6], w0 * x[5] + w1 * x[6] + w2 * x[7]); o.w = pk2(w0 * x[6] + w1 * x[7] + w2 * x[8], w0 * x[7] + w1 * x[8] + w2 * x[9]);
            *(LAS u32x4*)(zimg + b * ZP + (t0 + 8 * j) * 2) = o;
            prev = x[8];
        }
    }
    const int tbase = SPAN * (w >> 1) + 16 * (w & 1);
    const int flane = L - tbase + 8 * fq - fr;
    const int msh = fr & 7;
    const LAS unsigned char* fbase = cpy + msh * CP + 2 * (flane + msh);
#pragma unroll 1
    for (int o = 0; o < 2; ++o) {
        const GAS bf16* fsrc = ft + ((size_t)(o * 384 + c)) * (2 * L);
        for (int i = F.tid; i < CP / 16; i += NTHR) { u32x4 v = (u32x4){0u, 0u, 0u, 0u}; if (i < 2 * L / 8) v = *(const GAS u32x4*)(fsrc + 8 * i); if (i == 0) v.x &= 0xffff0000u; *(LAS u32x4*)(cpy + 16 * i) = v; }
        __syncthreads();
        for (int task = F.tid; task < 7 * (CP / 16); task += NTHR) {
            const int m = 1 + task / (CP / 16), x8 = task % (CP / 16);
            unsigned short e[8];
#pragma unroll
            for (int i = 0; i < 8; ++i) { const int idx = 8 * x8 - m + i; e[i] = idx >= 0 ? *(const LAS unsigned short*)(cpy + 2 * idx) : (unsigned short)0; }
            u32x4 v; v.x = e[0] | ((unsigned)e[1] << 16); v.y = e[2] | ((unsigned)e[3] << 16); v.z = e[4] | ((unsigned)e[5] << 16); v.w = e[6] | ((unsigned)e[7] << 16);
            *(LAS u32x4*)(cpy + m * CP + 16 * x8) = v;
        }
        __syncthreads();
        f32x4 acc[I];
#pragma unroll
        for (int i = 0; i < I; ++i) acc[i] = (f32x4){0.f, 0.f, 0.f, 0.f};
        bf16x8 ring[I];
#pragma unroll
        for (int i = 1; i < I; ++i) ring[(I - i) % I] = *(const LAS bf16x8*)(fbase - 64 * i);
        bf16x8 nf = *(const LAS bf16x8*)(fbase);
        const LAS unsigned char* zrow = zimg + fr * ZP + 16 * fq;
#pragma unroll 1
        for (int j0 = 0; j0 < NSTEP; j0 += I) {
#pragma unroll
            for (int jj = 0; jj < I; ++jj) {
                const int j = j0 + jj;
                ring[jj] = nf;
                if (j + 1 < NSTEP) nf = *(const LAS bf16x8*)(fbase + 64 * (j + 1));
                const bf16x8 zf = *(const LAS bf16x8*)(zrow + 64 * j);
#pragma unroll
                for (int i = 0; i < I; ++i) acc[i] = __builtin_amdgcn_mfma_f32_16x16x32_bf16(ring[(jj - i + I) % I], zf, acc[i], 0, 0, 0);
            }
        }
        unsigned el_ = (unsigned)lane; asm volatile("" : "+v"(el_)); const int efr = (int)(el_ & 15u), efq = (int)(el_ >> 4);
        const int etb = SPAN * (w >> 1) + 16 * (w & 1);
        const int gcol = (o == 0 ? 384 : 768) + c;
        const GAS bf16* gsrc = hyt + ((size_t)(efr * 1152 + gcol)) * L;
        const float w0 = cw[gcol], w1 = cw[1152 + gcol], w2 = cw[2304 + gcol], sk = skip[o * 384 + c];
        GAS bf16* dst = yht + ((size_t)(efr * 384 + c)) * L;
        constexpr int GI = I < 8 ? I : 8;
#pragma unroll
        for (int i0 = 0; i0 < I; i0 += GI) {
            u32x2 grv[GI]; unsigned short gmv[GI], gpv[GI];
#pragma unroll
            for (int ii = 0; ii < GI; ++ii) {
                const int t = etb + 32 * (i0 + ii) + 4 * efq;
                grv[ii] = *(const GAS u32x2*)(gsrc + t); gmv[ii] = t > 0 ? gsrc[t - 1] : (unsigned short)0; gpv[ii] = t + 4 < L ? gsrc[t + 4] : (unsigned short)0;
            }
            asm volatile("" ::: "memory");
#pragma unroll
            for (int ii = 0; ii < GI; ++ii) {
                const int i = i0 + ii;
                const int t = etb + 32 * i + 4 * efq;
                const u32x2 zr = *(const LAS u32x2*)(zimg + efr * ZP + t * 2);
                const u32x2 gr = grv[ii];
                const float gm = bf2f(gmv[ii]), gp = bf2f(gpv[ii]);
                const float g0 = __uint_as_float(gr.x << 16), g1 = __uint_as_float(gr.x & 0xffff0000u), g2 = __uint_as_float(gr.y << 16), g3 = __uint_as_float(gr.y & 0xffff0000u);
                const float z0 = __uint_as_float(zr.x << 16), z1 = __uint_as_float(zr.x & 0xffff0000u), z2 = __uint_as_float(zr.y << 16), z3 = __uint_as_float(zr.y & 0xffff0000u);
                const float o0 = (w0 * gm + w1 * g0 + w2 * g1) * (acc[i].x + sk * z0), o1 = (w0 * g0 + w1 * g1 + w2 * g2) * (acc[i].y + sk * z1);
                const float o2 = (w0 * g1 + w1 * g2 + w2 * g3) * (acc[i].z + sk * z2), o3 = (w0 * g2 + w1 * g3 + w2 * gp) * (acc[i].w + sk * z3);
                acc[i] = (f32x4){o0, o1, o2, o3};
            }
        }
        __syncthreads();
#pragma unroll
        for (int i = 0; i < I; ++i) {
            const int t = etb + 32 * i + 4 * efq;
            u32x2 ov; ov.x = pk2(acc[i].x, acc[i].y); ov.y = pk2(acc[i].z, acc[i].w);
            if (o == 0) *(LAS u32x2*)(zimg + efr * ZP + t * 2) = ov;
            else *(GAS u32x2*)(dst + t) = ov;
        }
    }
}

__device__ __forceinline__ void chain_naive(Frame& F, int layer, int chain) {
    const int lane = F.lane;
    const bool is_ret = chain < 192;
    int b, h, dir;
    if (is_ret) { b = chain / 12; const int r = chain % 12; h = r >> 1; dir = r & 1; }
    else { const int i = chain - 192; b = i >> 3; h = (i & 7) >> 1; dir = i & 1; }
    const GAS bf16* RET = WSP(const bf16, WS_RET); const GAS bf16* ML = WSP(const bf16, WS_ML); const GAS float* MLG = WSP(const float, WS_MLG);
    const GAS float* rope = WSP(const float, WS_ROPE);
    GAS bf16* Y = WSP(bf16, WS_Y); GAS bf16* OB = WSP(bf16, WS_OB);
    float gam = 0.f;
    if (is_ret) gam = sigmoidf_(inp(F, I_RETDECAY)[layer * 12 + dir * 6 + h]);
    const GAS float* mlc = inp(F, I_MLCONV) + layer * 3 * 512;
    const float bi = is_ret ? 0.f : inp(F, I_MLGB)[layer * 16 + dir * 8 + h], bfg = is_ret ? 0.f : inp(F, I_MLGB)[layer * 16 + dir * 8 + 4 + h];
    const float qw0 = mlc[h * 64 + lane], qw1 = mlc[512 + h * 64 + lane], qw2 = mlc[1024 + h * 64 + lane];
    const float kw0 = mlc[256 + h * 64 + lane], kw1 = mlc[512 + 256 + h * 64 + lane], kw2 = mlc[1024 + 256 + h * 64 + lane];
    float S[64];
#pragma unroll
    for (int d = 0; d < 64; ++d) S[d] = 0.f;
    float nv = 0.f;
    for (int step = 0; step < LC + LL; ++step) {
        int row, tpos, L; bool lat;
        if (step < LC) { tpos = dir ? (LC - 1 - step) : step; row = TOKL + b * LC + tpos; L = LC; lat = false; }
        else { const int s2 = step - LC; tpos = dir ? (LL - 1 - s2) : s2; row = b * LL + tpos; L = LL; lat = true; }
        float q, k, v, Fm, Im;
        if (is_ret) {
            const GAS bf16* base = RET + (size_t)row * 1536;
            float qs = bf2f(base[h * 64 + lane]), ks = bf2f(base[384 + h * 64 + lane]);
            v = bf2f(base[768 + h * 64 + lane]);
            if (lat) {
                const float qp = bf2f(base[h * 64 + (lane ^ 16)]), kp = bf2f(base[384 + h * 64 + (lane ^ 16)]);
                const int half = lane >> 5, ii = lane & 15, hi = (lane >> 4) & 1;
                const float cs = rope[tpos * 64 + half * 32 + ii], sn = rope[tpos * 64 + half * 32 + 16 + ii];
                q = hi == 0 ? qs * cs - qp * sn : qp * sn + qs * cs;
                k = hi == 0 ? ks * cs - kp * sn : kp * sn + ks * cs;
            } else { q = qs; k = ks; }
            q *= 0.125f; Fm = gam; Im = 1.f;
        } else {
            const GAS bf16* base = ML + (size_t)row * 1024;
            const float q0 = tpos > 0 ? bf2f(base[-1024 + h * 64 + lane]) : 0.f, q1 = bf2f(base[h * 64 + lane]), q2 = tpos < L - 1 ? bf2f(base[1024 + h * 64 + lane]) : 0.f;
            const float k0 = tpos > 0 ? bf2f(base[-1024 + 256 + h * 64 + lane]) : 0.f, k1 = bf2f(base[256 + h * 64 + lane]), k2 = tpos < L - 1 ? bf2f(base[1024 + 256 + h * 64 + lane]) : 0.f;
            q = siluf_(qw0 * q0 + qw1 * q1 + qw2 * q2);
            k = siluf_(kw0 * k0 + kw1 * k1 + kw2 * k2) * 0.125f;
            v = bf2f(base[512 + h * 64 + lane]);
            const float ig = MLG[(size_t)row * 16 + dir * 8 + h] + bi, fg = MLG[(size_t)row * 16 + dir * 8 + 4 + h] + bfg;
            Fm = sigmoidf_(fg); Im = __expf(ig);
        }
        float num = 0.f;
        const float iv = Im * v;
#pragma unroll
        for (int d = 0; d < 64; ++d) {
            const float kd = __int_as_float(__builtin_amdgcn_readlane(__float_as_int(k), d));
            const float qd = __int_as_float(__builtin_amdgcn_readlane(__float_as_int(q), d));
            S[d] = Fm * S[d] + kd * iv;
            num += qd * S[d];
        }
        float o = num;
        if (!is_ret) { nv = Fm * nv + Im * k; const float den = wave_sum(q * nv); o = num / fmaxf(fabsf(den), 1.f); }
        const int cof = is_ret ? (h * 64 + lane) : (384 + h * 64 + lane);
        if (dir == 0) Y[(size_t)row * D + 384 + cof] = (bf16)f2bf(o);
        else OB[(size_t)row * 640 + cof] = (bf16)f2bf(o);
    }
}

#ifndef REP_CH
#define REP_CH 1
#endif
constexpr int CH_PITCH = 144;
constexpr int CH_IMG = 64 * CH_PITCH;
constexpr int CH_WAVE_LDS = 3 * CH_IMG + 1024 + 512;
__device__ __forceinline__ void ds_tr16x8(unsigned addr, u32x2 (&lo)[4], u32x2 (&hi)[4]) {
    asm volatile("ds_read_b64_tr_b16 %0, %8\n\tds_read_b64_tr_b16 %1, %8 offset:32\n\tds_read_b64_tr_b16 %2, %8 offset:64\n\tds_read_b64_tr_b16 %3, %8 offset:96\n\t"
                 "ds_read_b64_tr_b16 %4, %8 offset:2304\n\tds_read_b64_tr_b16 %5, %8 offset:2336\n\tds_read_b64_tr_b16 %6, %8 offset:2368\n\tds_read_b64_tr_b16 %7, %8 offset:2400\n\t"
                 "s_waitcnt lgkmcnt(0)"
                 : "=&v"(lo[0]), "=&v"(lo[1]), "=&v"(lo[2]), "=&v"(lo[3]), "=&v"(hi[0]), "=&v"(hi[1]), "=&v"(hi[2]), "=&v"(hi[3]) : "v"(addr) : "memory");
}
static_assert(16 * CH_PITCH == 2304, "ds_tr16x8 offsets");
__device__ __forceinline__ void ds_tr16x4(unsigned addr, u32x2 (&lo)[2], u32x2 (&hi)[2]) {
    asm volatile("ds_read_b64_tr_b16 %0, %4\n\tds_read_b64_tr_b16 %1, %4 offset:32\n\tds_read_b64_tr_b16 %2, %4 offset:2304\n\tds_read_b64_tr_b16 %3, %4 offset:2336\n\ts_waitcnt lgkmcnt(0)"
                 : "=&v"(lo[0]), "=&v"(lo[1]), "=&v"(hi[0]), "=&v"(hi[1]) : "v"(addr) : "memory");
}
__device__ __forceinline__ float log_sigmoid_(float x) { return fminf(x, 0.f) - log1pf(__expf(-fabsf(x))); }
__device__ __forceinline__ bf16x8 mk_frag(u32x2 lo, u32x2 hi) { u32x4 w; w.x = lo.x; w.y = lo.y; w.z = hi.x; w.w = hi.y; return __builtin_bit_cast(bf16x8, w); }

template <bool IS_ML>
__device__ __forceinline__ void chain_fast(Frame& F, int layer, int b, int h, int dir, LAS unsigned char* img, int hf) {
    constexpr int NET = 2;
    const int lane = F.lane, fr = lane & 15, fq = lane >> 4;
    LAS unsigned char* Qi = img; LAS unsigned char* Ki = img + CH_IMG; LAS unsigned char* Vi = img + 2 * CH_IMG;
    const unsigned qa = (unsigned)(size_t)Qi, ka = (unsigned)(size_t)Ki, va = (unsigned)(size_t)Vi;
    const GAS bf16* RET = WSP(const bf16, WS_RET); const GAS bf16* ML = WSP(const bf16, WS_ML); const GAS float* MLG = WSP(const float, WS_MLG);
    const GAS float* rope = WSP(const float, WS_ROPE);
    GAS bf16* Y = WSP(bf16, WS_Y); GAS bf16* OB = WSP(bf16, WS_OB);
    float lgam = 0.f, bi_ = 0.f, bf_ = 0.f;
    if (!IS_ML) lgam = log_sigmoid_(inp(F, I_RETDECAY)[layer * 12 + dir * 6 + h]);
    else { bi_ = inp(F, I_MLGB)[layer * 16 + dir * 8 + h]; bf_ = inp(F, I_MLGB)[layer * 16 + dir * 8 + 4 + h]; }
    const GAS float* mlc = inp(F, I_MLCONV) + layer * 3 * 512;
    f32x4 C[4][NET];
#pragma unroll
    for (int dt = 0; dt < 4; ++dt)
#pragma unroll
        for (int et = 0; et < NET; ++et) C[dt][et] = (f32x4){0.f, 0.f, 0.f, 0.f};
    const int cq = lane & 7, pr0 = lane >> 3;
    LAS float* nvec = (LAS float*)(img + 3 * CH_IMG + 1024 + 256 * hf);
    if (IS_ML) nvec[lane] = 0.f;
    const LAS float* nq = nvec + 4 * fq;
#pragma unroll 1
    for (int step_ = 0; step_ < 36 * REP_CH; ++step_) {
        const int step = step_ % 36;
        if (REP_CH > 1 && step == 0) {
            if (IS_ML) nvec[lane] = 0.f;
#pragma unroll
            for (int dt = 0; dt < 4; ++dt)
#pragma unroll
                for (int et = 0; et < NET; ++et) C[dt][et] = (f32x4){0.f, 0.f, 0.f, 0.f};
        }
        int rowbase, t0, L; bool lat;
        if (step < 4) { const int cc = dir ? 3 - step : step; rowbase = TOKL + b * LC + cc * 64; t0 = cc * 64; L = LC; lat = false; }
        else { const int cc = dir ? 35 - step : step - 4; rowbase = b * LL + cc * 64; t0 = cc * 64; L = LL; lat = true; }
        float g_i = 0.f, g_f = 0.f;
        if (IS_ML) { const int tlg = dir ? 63 - lane : lane; const GAS float* gp = MLG + (size_t)(rowbase + tlg) * 16 + dir * 8 + h; g_i = gp[0]; g_f = gp[4]; }
        if constexpr (!IS_ML) {
#pragma unroll
        for (int i4 = 0; i4 < 4; ++i4) {
            const int i = 4 * hf + i4;
            const int p = pr0 + 8 * i, tl = dir ? 63 - p : p, row = rowbase + tl, tpos = t0 + tl;
            float qv[8], kv[8]; u32x4 vraw;
            {
                const GAS bf16* base = RET + (size_t)row * 1536 + h * 64;
                const u32x4 qr = *(const GAS u32x4*)(base + 8 * cq), kr = *(const GAS u32x4*)(base + 384 + 8 * cq); vraw = *(const GAS u32x4*)(base + 768 + 8 * cq);
                const unsigned qw[4] = {qr.x, qr.y, qr.z, qr.w}, kw[4] = {kr.x, kr.y, kr.z, kr.w};
#pragma unroll
                for (int j = 0; j < 4; ++j) { qv[2 * j] = __uint_as_float(qw[j] << 16); qv[2 * j + 1] = __uint_as_float(qw[j] & 0xffff0000u); kv[2 * j] = __uint_as_float(kw[j] << 16); kv[2 * j + 1] = __uint_as_float(kw[j] & 0xffff0000u); }
                if (lat) {
                    const u32x4 qpr = *(const GAS u32x4*)(base + 8 * (cq ^ 2)), kpr = *(const GAS u32x4*)(base + 384 + 8 * (cq ^ 2));
                    const unsigned qpw[4] = {qpr.x, qpr.y, qpr.z, qpr.w}, kpw[4] = {kpr.x, kpr.y, kpr.z, kpr.w};
                    const int half = cq >> 2, hi = (cq >> 1) & 1, i0 = 8 * (cq & 1);
                    const GAS float* rp = rope + tpos * 64 + half * 32 + i0;
                    const f32x4 c0 = *(const GAS f32x4*)(rp), c1 = *(const GAS f32x4*)(rp + 4), s0 = *(const GAS f32x4*)(rp + 16), s1 = *(const GAS f32x4*)(rp + 20);
                    const float cs[8] = {c0.x, c0.y, c0.z, c0.w, c1.x, c1.y, c1.z, c1.w}, sn[8] = {s0.x, s0.y, s0.z, s0.w, s1.x, s1.y, s1.z, s1.w};
#pragma unroll
                    for (int j = 0; j < 8; ++j) {
                        const float qp = (j & 1) ? __uint_as_float(qpw[j >> 1] & 0xffff0000u) : __uint_as_float(qpw[j >> 1] << 16);
                        const float kp = (j & 1) ? __uint_as_float(kpw[j >> 1] & 0xffff0000u) : __uint_as_float(kpw[j >> 1] << 16);
                        qv[j] = hi ? qp * sn[j] + qv[j] * cs[j] : qv[j] * cs[j] - qp * sn[j];
                        kv[j] = hi ? kp * sn[j] + kv[j] * cs[j] : kv[j] * cs[j] - kp * sn[j];
                    }
                }
#pragma unroll
                for (int j = 0; j < 8; ++j) qv[j] *= 0.125f;
            }
            u32x4 qo, ko; qo.x = pk2(qv[0], qv[1]); qo.y = pk2(qv[2], qv[3]); qo.z = pk2(qv[4], qv[5]); qo.w = pk2(qv[6], qv[7]);
            ko.x = pk2(kv[0], kv[1]); ko.y = pk2(kv[2], kv[3]); ko.z = pk2(kv[4], kv[5]); ko.w = pk2(kv[6], kv[7]);
            *(LAS u32x4*)(Qi + p * CH_PITCH + 16 * cq) = qo; *(LAS u32x4*)(Ki + p * CH_PITCH + 16 * cq) = ko; *(LAS u32x4*)(Vi + p * CH_PITCH + 16 * cq) = vraw;
        }
        } else {
            const GAS float* wq = mlc + h * 64 + 8 * cq;
            u32x4 rr[2][3][4], vr[4];
#pragma unroll
            for (int i4 = 0; i4 < 4; ++i4) {
                const int p = pr0 + 8 * (4 * hf + i4), tl = dir ? 63 - p : p, row = rowbase + tl, tpos = t0 + tl;
                const GAS bf16* bb = ML + (size_t)row * 1024 + h * 64 + 8 * cq;
                const u32x4 z4 = (u32x4){0u, 0u, 0u, 0u};
#pragma unroll
                for (int qk = 0; qk < 2; ++qk) {
                    rr[qk][1][i4] = *(const GAS u32x4*)(bb + 256 * qk);
                    rr[qk][0][i4] = tpos > 0 ? *(const GAS u32x4*)(bb + 256 * qk - 1024) : z4;
                    rr[qk][2][i4] = tpos < L - 1 ? *(const GAS u32x4*)(bb + 256 * qk + 1024) : z4;
                }
                vr[i4] = *(const GAS u32x4*)(bb + 512);
            }
#pragma unroll
            for (int qk = 0; qk < 2; ++qk) {
                f32x4 wt[3][2];
#pragma unroll
                for (int tp = 0; tp < 3; ++tp) { wt[tp][0] = *(const GAS f32x4*)(wq + 256 * qk + 512 * tp); wt[tp][1] = *(const GAS f32x4*)(wq + 256 * qk + 512 * tp + 4); }
#pragma unroll
                for (int i4 = 0; i4 < 4; ++i4) {
                    const int p = pr0 + 8 * (4 * hf + i4);
                    const unsigned a0[4] = {rr[qk][0][i4].x, rr[qk][0][i4].y, rr[qk][0][i4].z, rr[qk][0][i4].w}, a1[4] = {rr[qk][1][i4].x, rr[qk][1][i4].y, rr[qk][1][i4].z, rr[qk][1][i4].w},
                                   a2[4] = {rr[qk][2][i4].x, rr[qk][2][i4].y, rr[qk][2][i4].z, rr[qk][2][i4].w};
                    float ov[8];
#pragma unroll
                    for (int j = 0; j < 8; ++j) {
                        const float x0 = (j & 1) ? __uint_as_float(a0[j >> 1] & 0xffff0000u) : __uint_as_float(a0[j >> 1] << 16);
                        const float x1 = (j & 1) ? __uint_as_float(a1[j >> 1] & 0xffff0000u) : __uint_as_float(a1[j >> 1] << 16);
                        const float x2 = (j & 1) ? __uint_as_float(a2[j >> 1] & 0xffff0000u) : __uint_as_float(a2[j >> 1] << 16);
                        const float r = siluf_(wt[0][j >> 2][j & 3] * x0 + wt[1][j >> 2][j & 3] * x1 + wt[2][j >> 2][j & 3] * x2);
                        ov[j] = qk == 0 ? r : r * 0.125f;
                    }
                    u32x4 o; o.x = pk2(ov[0], ov[1]); o.y = pk2(ov[2], ov[3]); o.z = pk2(ov[4], ov[5]); o.w = pk2(ov[6], ov[7]);
                    if (qk == 0) *(LAS u32x4*)(Qi + p * CH_PITCH + 16 * cq) = o;
                    else { *(LAS u32x4*)(Ki + p * CH_PITCH + 16 * cq) = o; *(LAS u32x4*)(Vi + p * CH_PITCH + 16 * cq) = vr[i4]; }
                }
            }
        }
        __builtin_amdgcn_sched_barrier(0);
        float f_p, i_p;
        if (!IS_ML) { f_p = lgam; i_p = 0.f; }
        else { i_p = g_i + bi_; f_p = log_sigmoid_(g_f + bf_); }
        float bsum = f_p;
#pragma unroll
        for (int o = 1; o < 64; o <<= 1) { const float t = lane_read(bsum, lane >= o ? lane - o : lane); if (lane >= o) bsum += t; }
        LAS float* gv = (LAS float*)(img + 3 * CH_IMG);
        const float b63 = __int_as_float(__builtin_amdgcn_readlane(__float_as_int(bsum), 63));
        const float adec = __expf(b63);
        if (hf == 0) { gv[lane] = bsum; gv[64 + lane] = bsum - i_p; gv[128 + lane] = __expf(bsum); gv[192 + lane] = __expf(b63 - (bsum - i_p)); }
        asm volatile("s_waitcnt lgkmcnt(0)" ::: "memory");
        __syncthreads();
        const LAS float* gq = gv + 4 * fq;
        const bf16x8 ones = (fr == 0) ? (bf16x8){0x3F80, 0x3F80, 0x3F80, 0x3F80, 0x3F80, 0x3F80, 0x3F80, 0x3F80} : (bf16x8){0, 0, 0, 0, 0, 0, 0, 0};
        const int tr_q = fr >> 2, tr_p = fr & 3;
#pragma unroll 1
        for (int pt = 0; pt < 4; ++pt) {
            f32x4 ST[4];
            bf16x8 qn[2];
#pragma unroll
            for (int kk = 0; kk < 2; ++kk) qn[kk] = *(const LAS bf16x8*)(Qi + (16 * pt + fr) * CH_PITCH + (32 * kk + 8 * fq) * 2);
#pragma unroll
            for (int st = 0; st < 4; ++st) {
                ST[st] = (f32x4){0.f, 0.f, 0.f, 0.f};
                if (st <= pt) {
#pragma unroll
                    for (int kk = 0; kk < 2; ++kk) { const bf16x8 kf = *(const LAS bf16x8*)(Ki + (16 * st + fr) * CH_PITCH + (32 * kk + 8 * fq) * 2); ST[st] = __builtin_amdgcn_mfma_f32_16x16x32_bf16(kf, qn[kk], ST[st], 0, 0, 0); }
                }
            }
            const float bp = gv[16 * pt + fr];
#pragma unroll
            for (int st = 0; st < 4; ++st) {
                if (st <= pt) {
                    const f32x4 bis = *(const LAS f32x4*)(gq + 64 + 16 * st);
#pragma unroll
                    for (int j = 0; j < 4; ++j) { const int sidx = 16 * st + 4 * fq + j; const float w = (sidx <= 16 * pt + fr) ? __expf(bp - bis[j]) : 0.f; ST[st][j] *= w; }
                }
            }
            __builtin_amdgcn_sched_barrier(0);
            f32x4 acc[NET], accd = (f32x4){0.f, 0.f, 0.f, 0.f};
#pragma unroll
            for (int et = 0; et < NET; ++et) acc[et] = (f32x4){0.f, 0.f, 0.f, 0.f};
#pragma unroll
            for (int kk = 0; kk < 2; ++kk) {
                const u32x2 lo = *(const LAS u32x2*)(Qi + (16 * pt + fr) * CH_PITCH + (32 * kk + 4 * fq) * 2), hi = *(const LAS u32x2*)(Qi + (16 * pt + fr) * CH_PITCH + (32 * kk + 16 + 4 * fq) * 2);
                const bf16x8 qs = mk_frag(lo, hi);
#pragma unroll
                for (int et = 0; et < NET; ++et) {
                    u32x4 w; w.x = pk2(C[2 * kk][et].x, C[2 * kk][et].y); w.y = pk2(C[2 * kk][et].z, C[2 * kk][et].w); w.z = pk2(C[2 * kk + 1][et].x, C[2 * kk + 1][et].y); w.w = pk2(C[2 * kk + 1][et].z, C[2 * kk + 1][et].w);
                    acc[et] = __builtin_amdgcn_mfma_f32_16x16x32_bf16(qs, __builtin_bit_cast(bf16x8, w), acc[et], 0, 0, 0);
                }
                if (IS_ML) {
                    const f32x4 n0 = *(const LAS f32x4*)(nq + 32 * kk), n1 = *(const LAS f32x4*)(nq + 32 * kk + 16);
                    u32x4 w; w.x = pk2(n0.x, n0.y); w.y = pk2(n0.z, n0.w); w.z = pk2(n1.x, n1.y); w.w = pk2(n1.z, n1.w);
                    if (fr != 0) w = (u32x4){0u, 0u, 0u, 0u};
                    accd = __builtin_amdgcn_mfma_f32_16x16x32_bf16(qs, __builtin_bit_cast(bf16x8, w), accd, 0, 0, 0);
                }
            }
            { const f32x4 ap = *(const LAS f32x4*)(gq + 128 + 16 * pt);
#pragma unroll
              for (int j = 0; j < 4; ++j) {
#pragma unroll
                for (int et = 0; et < NET; ++et) acc[et][j] *= ap[j];
                accd[j] *= ap[j]; } }
            __builtin_amdgcn_sched_barrier(0);
#pragma unroll
            for (int kk = 0; kk < 2; ++kk) {
                if (2 * kk <= pt) {
                    u32x4 w; w.x = pk2(ST[2 * kk].x, ST[2 * kk].y); w.y = pk2(ST[2 * kk].z, ST[2 * kk].w); w.z = pk2(ST[2 * kk + 1].x, ST[2 * kk + 1].y); w.w = pk2(ST[2 * kk + 1].z, ST[2 * kk + 1].w);
                    const bf16x8 pf = __builtin_bit_cast(bf16x8, w);
                    u32x2 vlo[2], vhi[2];
                    ds_tr16x4(va + (32 * kk + 4 * fq + tr_q) * CH_PITCH + 8 * tr_p + 64 * hf, vlo, vhi);
#pragma unroll
                    for (int et = 0; et < NET; ++et) acc[et] = __builtin_amdgcn_mfma_f32_16x16x32_bf16(pf, mk_frag(vlo[et], vhi[et]), acc[et], 0, 0, 0);
                    if (IS_ML) accd = __builtin_amdgcn_mfma_f32_16x16x32_bf16(pf, ones, accd, 0, 0, 0);
                }
            }
            __builtin_amdgcn_sched_barrier(0);
#pragma unroll
            for (int j = 0; j < 4; ++j) {
                const int p = 16 * pt + 4 * fq + j, tl = dir ? 63 - p : p, row = rowbase + tl;
                float inv = 1.f;
                if (IS_ML) { const float den = lane_read(accd[j], lane & 48); inv = __builtin_amdgcn_rcpf(fmaxf(fabsf(den), 1.f)); }
                const int cof = (IS_ML ? 384 : 0) + h * 64 + 32 * hf + fr;
                const unsigned boff = dir == 0 ? (unsigned)(row * D + 384 + cof) * 2u : (unsigned)(row * 640 + cof) * 2u;
                GAS char* ob = dir == 0 ? (GAS char*)Y : (GAS char*)OB;
#pragma unroll
                for (int et = 0; et < NET; ++et) *(GAS bf16*)(ob + boff + 32 * et) = (bf16)f2bf(acc[et][j] * inv);
            }
        }
        __builtin_amdgcn_sched_barrier(0);
#pragma unroll
        for (int dt = 0; dt < 4; ++dt)
#pragma unroll
            for (int et = 0; et < NET; ++et) C[dt][et] *= adec;
        f32x4 accn[4];
        if (IS_ML) {
#pragma unroll
            for (int dt = 0; dt < 4; ++dt) { accn[dt] = *(const LAS f32x4*)(nq + 16 * dt) * adec; if (fr != 0) accn[dt] = (f32x4){0.f, 0.f, 0.f, 0.f}; }
        }
#pragma unroll
        for (int kk = 0; kk < 2; ++kk) {
            u32x2 vlo[2], vhi[2], klo[4], khi[4];
            ds_tr16x4(va + (32 * kk + 4 * fq + tr_q) * CH_PITCH + 8 * tr_p + 64 * hf, vlo, vhi);
            ds_tr16x8(ka + (32 * kk + 4 * fq + tr_q) * CH_PITCH + 8 * tr_p, klo, khi);
            const f32x4 wl = *(const LAS f32x4*)(gq + 192 + 32 * kk), wh = *(const LAS f32x4*)(gq + 192 + 32 * kk + 16);
#pragma unroll
            for (int dt = 0; dt < 4; ++dt) {
                u32x4 w;
                w.x = pk2(__uint_as_float(klo[dt].x << 16) * wl[0], __uint_as_float(klo[dt].x & 0xffff0000u) * wl[1]);
                w.y = pk2(__uint_as_float(klo[dt].y << 16) * wl[2], __uint_as_float(klo[dt].y & 0xffff0000u) * wl[3]);
                w.z = pk2(__uint_as_float(khi[dt].x << 16) * wh[0], __uint_as_float(khi[dt].x & 0xffff0000u) * wh[1]);
                w.w = pk2(__uint_as_float(khi[dt].y << 16) * wh[2], __uint_as_float(khi[dt].y & 0xffff0000u) * wh[3]);
                const bf16x8 kf = __builtin_bit_cast(bf16x8, w);
#pragma unroll
                for (int et = 0; et < NET; ++et) C[dt][et] = __builtin_amdgcn_mfma_f32_16x16x32_bf16(kf, mk_frag(vlo[et], vhi[et]), C[dt][et], 0, 0, 0);
                if (IS_ML) accn[dt] = __builtin_amdgcn_mfma_f32_16x16x32_bf16(kf, ones, accn[dt], 0, 0, 0);
            }
        }
        if (IS_ML) { if (fr == 0) {
#pragma unroll
            for (int dt = 0; dt < 4; ++dt) *(LAS f32x4*)(nvec + 4 * fq + 16 * dt) = accn[dt]; } }
        asm volatile("s_waitcnt lgkmcnt(0)" ::: "memory");
        __syncthreads();
    }
}

#ifndef FAST_CHAIN
#define FAST_CHAIN 1
#endif
constexpr int NCHWG = 160;
__device__ __forceinline__ void phase_mix(Frame& F, int layer) {
    const bool last = layer == 1;
    const GAS bf16* ftl = WSP(const bf16, WS_FTL) + (size_t)layer * 2 * 384 * 4096;
    if (FAST_CHAIN) {
        if (F.wg < NCHWG) {
            if (F.wave >= 4) {
#pragma unroll 1
                for (int i = 0; i < 72 * REP_CH; ++i) __syncthreads();
            } else {
                const int cl = F.wave >> 1, hf = F.wave & 1, c = F.wg * 2 + cl;
                LAS unsigned char* img = F.lds + cl * CH_WAVE_LDS;
                {
                if (c < 192) { const int b = c / 12, r = c % 12; chain_fast<false>(F, layer, b, r >> 1, r & 1, img, hf); }
                else { const int i = c - 192; chain_fast<true>(F, layer, i >> 3, (i & 7) >> 1, i & 1, img, hf); }
                }
            }
        } else {
            const int nh = F.G - NCHWG, w = F.wg - NCHWG;
#ifndef FAST_HY
#define FAST_HY 1
#endif
            if (FAST_HY) {
#ifndef REP_HY
#define REP_HY 1
#endif
#pragma unroll 1
                for (int rp = 0; rp < REP_HY; ++rp)
                for (int u = w; u < 384; u += nh) hyena_unit_fast<LL>(F, layer, u, WSP(const bf16, WS_HYTL), ftl, WSP(bf16, WS_YHTL));
                if (!last) for (int u = w; u < 384; u += nh) hyena_unit_fast<LC>(F, layer, u, WSP(const bf16, WS_HYTC), WSP(const bf16, WS_FTC), WSP(bf16, WS_YHTC));
            } else {
                for (int u = w; u < 384; u += nh) hyena_unit_naive<LL>(F, layer, u, WSP(const bf16, WS_HYTL), ftl, WSP(bf16, WS_YHTL));
                if (!last) for (int u = w; u < 384; u += nh) hyena_unit_naive<LC>(F, layer, u, WSP(const bf16, WS_HYTC), WSP(const bf16, WS_FTC), WSP(bf16, WS_YHTC));
            }
        }
    } else {
        for (int u = F.wg; u < 384; u += F.G) hyena_unit_naive<LL>(F, layer, u, WSP(const bf16, WS_HYTL), ftl, WSP(bf16, WS_YHTL));
        if (!last) for (int u = F.wg; u < 384; u += F.G) hyena_unit_naive<LC>(F, layer, u, WSP(const bf16, WS_HYTC), WSP(const bf16, WS_FTC), WSP(bf16, WS_YHTC));
        for (int c = F.wg + F.wave * F.G; c < 320; c += F.G * NWAVES) chain_naive(F, layer, c);
    }
}

__device__ __forceinline__ void phase_combine(Frame& F, int layer) {
    const bool last = layer == 1;
    const int gw = F.wg * NWAVES + F.wave, NGW = F.G * NWAVES, lane = F.lane;
    const int nrows = last ? TOKL : TOK;
    GAS bf16* Y = WSP(bf16, WS_Y); const GAS bf16* OB = WSP(const bf16, WS_OB); const GAS bf16* RET = WSP(const bf16, WS_RET); const GAS bf16* ML = WSP(const bf16, WS_ML);
#pragma unroll 2
    for (int row = gw; row < nrows; row += NGW) {
#pragma unroll
        for (int hh = 0; hh < 10; ++hh) {
            const int cof = hh * 64 + lane;
            const float x = bf2f(Y[(size_t)row * D + 384 + cof]) + bf2f(OB[(size_t)row * 640 + cof]);
            const float mu = wave_sum(x) * (1.f / 64.f), xc = x - mu;
            const float var = wave_sum(xc * xc) * (1.f / 64.f);
            const float nrm = xc * rsqrtf(var + 1e-6f);
            float gate;
            if (hh < 6) gate = siluf_(bf2f(RET[(size_t)row * 1536 + 1152 + cof]));
            else gate = sigmoidf_(bf2f(ML[(size_t)row * 1024 + 768 + (cof - 384)]));
            Y[(size_t)row * D + 384 + cof] = (bf16)f2bf(nrm * gate);
        }
    }
    LAS unsigned char* scr = F.lds + F.wave * 8704;
    const int nitL = NB * 6 * 32, nitC = last ? 0 : NB * 6 * 4;
    for (int it = gw; it < nitL + nitC; it += NGW) {
        const GAS bf16* src; int L, rowbase, b, cb, tb;
        if (it < nitL) { b = it / 192; const int r = it % 192; cb = r / 32; tb = r % 32; L = LL; src = WSP(const bf16, WS_YHTL); rowbase = b * LL; }
        else { const int i2 = it - nitL; b = i2 / 24; const int r = i2 % 24; cb = r / 4; tb = r % 4; L = LC; src = WSP(const bf16, WS_YHTC); rowbase = TOKL + b * LC; }
        u32x4 v[8];
#pragma unroll
        for (int i = 0; i < 8; ++i) { const int cc = (lane >> 3) + 8 * i; v[i] = *(const GAS u32x4*)(src + ((size_t)(b * 384 + cb * 64 + cc)) * L + tb * 64 + 8 * (lane & 7)); }
#pragma unroll
        for (int i = 0; i < 8; ++i) { const int cc = (lane >> 3) + 8 * i; *(LAS u32x4*)(scr + cc * 136 + 16 * (lane & 7)) = v[i]; }
        asm volatile("s_waitcnt lgkmcnt(0)" ::: "memory");
#pragma unroll
        for (int i = 0; i < 8; ++i) {
            const int tt = (lane >> 3) + 8 * i, c8 = 8 * (lane & 7);
            unsigned short e[8];
#pragma unroll
            for (int j = 0; j < 8; ++j) e[j] = *(const LAS unsigned short*)(scr + (c8 + j) * 136 + tt * 2);
            u32x4 o; o.x = e[0] | ((unsigned)e[1] << 16); o.y = e[2] | ((unsigned)e[3] << 16); o.z = e[4] | ((unsigned)e[5] << 16); o.w = e[6] | ((unsigned)e[7] << 16);
            *(GAS u32x4*)(Y + (size_t)(rowbase + tb * 64 + tt) * D + cb * 64 + c8) = o;
        }
        asm volatile("s_waitcnt lgkmcnt(0)" ::: "memory");
    }
}

__device__ __forceinline__ void phase_norm_router(Frame& F) {
    const int gw = F.wg * NWAVES + F.wave, NGW = F.G * NWAVES, lane = F.lane;
    const GAS float* g = inp(F, I_GFFN) + 1 * D; const GAS float* wr = inp(F, I_ROUTER); const GAS float* br = inp(F, I_ROUTERB);
    GAS unsigned* cnt = WSP(unsigned, WS_CTL) + CW_CNT;
#pragma unroll 2
    for (int row = gw; row < TOKL; row += NGW) {
        float keep[16];
        norm_mod_row(xrow_ptr(F, row, false), g, mod_ptr(F, 1, row, 3), mod_ptr(F, 1, row, 4), WSP(bf16, WS_H) + (size_t)row * D, lane, keep);
        float lg[8];
#pragma unroll
        for (int e = 0; e < 8; ++e) lg[e] = 0.f;
#pragma unroll
        for (int j = 0; j < 4; ++j)
#pragma unroll
            for (int i = 0; i < 4; ++i) { const int k = 256 * j + 4 * lane + i; const f32x4 w0 = *(const GAS f32x4*)(wr + k * 8), w1 = *(const GAS f32x4*)(wr + k * 8 + 4); const float x = keep[4 * j + i];
                lg[0] += x * w0.x; lg[1] += x * w0.y; lg[2] += x * w0.z; lg[3] += x * w0.w; lg[4] += x * w1.x; lg[5] += x * w1.y; lg[6] += x * w1.z; lg[7] += x * w1.w; }
#pragma unroll
        for (int e = 0; e < 8; ++e) lg[e] = wave_sum(lg[e]) + br[e];
        int e0 = 0; float v0 = lg[0];
#pragma unroll
        for (int e = 1; e < 8; ++e) if (lg[e] > v0) { v0 = lg[e]; e0 = e; }
        int e1 = -1; float v1 = -3.0e38f;
#pragma unroll
        for (int e = 0; e < 8; ++e) if (e != e0 && lg[e] > v1) { v1 = lg[e]; e1 = e; }
        const float w1 = 1.f / (1.f + __expf(v0 - v1)), w0 = 1.f - w1;
        if (lane == 0) {
            const unsigned p0 = __hip_atomic_fetch_add(cnt + e0, 1u, __ATOMIC_RELAXED, __HIP_MEMORY_SCOPE_AGENT), p1 = __hip_atomic_fetch_add(cnt + e1, 1u, __ATOMIC_RELAXED, __HIP_MEMORY_SCOPE_AGENT);
            WSP(int, WS_TOPE)[row * 2] = e0; WSP(int, WS_TOPE)[row * 2 + 1] = e1;
            WSP(float, WS_TOPW)[row * 2] = w0; WSP(float, WS_TOPW)[row * 2 + 1] = w1;
            WSP(int, WS_TOPP)[row * 2] = (int)p0; WSP(int, WS_TOPP)[row * 2 + 1] = (int)p1;
        }
    }
}
__device__ __forceinline__ void phase_route_tables(Frame& F) {
    const GAS unsigned* cnt = WSP(const unsigned, WS_CTL) + CW_CNT;
    int off[9]; off[0] = 0;
#pragma unroll
    for (int e = 0; e < 8; ++e) { const int c = (int)__hip_atomic_load(cnt + e, __ATOMIC_RELAXED, __HIP_MEMORY_SCOPE_AGENT); off[e + 1] = off[e] + ((c + 255) >> 8) * 256; }
    const int gt = F.wg * NTHR + F.tid, NGT = F.G * NTHR;
    GAS int* rowidx = WSP(int, WS_ROWIDX); GAS int* slot = WSP(int, WS_SLOT); GAS int* tilee = WSP(int, WS_TILEE);
    for (int i = gt; i < MAXTILES * 256; i += NGT) {
        int e = 0;
#pragma unroll
        for (int q = 1; q < 8; ++q) if (i >= off[q]) e = q;
        const int c = (int)cnt[e];
        if (i >= off[8] || i - off[e] >= c) rowidx[i] = 0;
    }
    for (int i = gt; i < TOKL * 2; i += NGT) {
        const int e = WSP(const int, WS_TOPE)[i], pos = WSP(const int, WS_TOPP)[i];
        int o = 0;
#pragma unroll
        for (int q = 0; q < 8; ++q) if (e == q) o = off[q];
        const int s = o + pos; slot[i] = s; rowidx[s] = i >> 1;
    }
    for (int i = gt; i < MAXTILES + 1; i += NGT) {
        if (i == MAXTILES) tilee[MAXTILES] = off[8] >> 8;
        else { int e = 0;
#pragma unroll
            for (int q = 1; q < 8; ++q) if (i * 256 >= off[q]) e = q;
            tilee[i] = e; }
    }
}

__device__ __forceinline__ void moe_pass_gemm1_fast(Frame& F, int t0, int t1) {
    pg8::OrderMoe S; S.o.init(t1 - t0, NFF1 / 256, F.G, F.wg); S.rowidx = WSP(const int, WS_ROWIDX); S.tilee = WSP(const int, WS_TILEE); S.t0 = t0; S.bstride = (size_t)NFF1 * D; S.gather = true;
    EpiSwiglu E{WSP(bf16, WS_MACT), 0};
    pg8::gemm_phase(F.lds, F.tid, WSP(const bf16, WS_H), D, WSP(const bf16, WS_MW13), D, D, S, E);
}
__device__ __forceinline__ void moe_pass_gemm2_fast(Frame& F, int t0, int t1) {
    pg8::OrderMoe S; S.o.init(t1 - t0, D / 256, F.G, F.wg); S.rowidx = WSP(const int, WS_ROWIDX); S.tilee = WSP(const int, WS_TILEE); S.t0 = t0; S.bstride = (size_t)D * DFF; S.gather = false;
    EpiBf16Out E{WSP(bf16, WS_EOUT), D, t0 * 256};
    pg8::gemm_phase(F.lds, F.tid, WSP(const bf16, WS_MACT), DFF, WSP(const bf16, WS_MW2), DFF, DFF, S, E);
}
__device__ __forceinline__ void phase_final(Frame& F) {
    const int gw = F.wg * NWAVES + F.wave, NGW = F.G * NWAVES, lane = F.lane;
    const GAS float* gf = inp(F, I_GFINAL); const GAS bf16* eo = WSP(const bf16, WS_EOUT);
#pragma unroll 2
    for (int row = gw; row < TOKL; row += NGW) {
        const int s0 = WSP(const int, WS_SLOT)[row * 2], s1 = WSP(const int, WS_SLOT)[row * 2 + 1];
        const float w0 = WSP(const float, WS_TOPW)[row * 2], w1 = WSP(const float, WS_TOPW)[row * 2 + 1];
        const GAS float* m5 = mod_ptr(F, 1, row, 5);
        GAS float* xr = outp(F) + (size_t)row * D;
        f32x4 v[4]; float s = 0.f;
#pragma unroll
        for (int j = 0; j < 4; ++j) {
            const int c = 256 * j + 4 * lane;
            const f32x4 a = ld_bf16x4(eo + (size_t)s0 * D + c), b = ld_bf16x4(eo + (size_t)s1 * D + c), m = *(const GAS f32x4*)(m5 + c);
            v[j] = *(const GAS f32x4*)(xr + c) + m * (a * w0 + b * w1);
            s += (v[j].x * v[j].x + v[j].y * v[j].y) + (v[j].z * v[j].z + v[j].w * v[j].w);
        }
        const float r = rsqrtf(wave_sum(s) * (1.f / 1024.f) + 1e-6f);
#pragma unroll
        for (int j = 0; j < 4; ++j) { const int c = 256 * j + 4 * lane; const f32x4 g = *(const GAS f32x4*)(gf + c); *(GAS f32x4*)(xr + c) = v[j] * r * g; }
    }
}

#ifndef REP_WIN
#define REP_WIN 1
#endif
#ifndef REP_MIX
#define REP_MIX 1
#endif
#ifndef REP_GATE
#define REP_GATE 1
#endif
#ifndef REP_UP
#define REP_UP 1
#endif
#ifndef REP_FFN1
#define REP_FFN1 1
#endif
#ifndef REP_MOE
#define REP_MOE 1
#endif
#ifndef REP_NORM
#define REP_NORM 1
#endif
#ifndef REP_P0
#define REP_P0 1
#endif
__global__ void __launch_bounds__(NTHR, 2) hybrid_fwd(Params prm) {
    extern __shared__ __attribute__((aligned(16))) unsigned char lds_raw[];
    Frame F;
    F.lds = (LAS unsigned char*)lds_raw; F.ws = (GAS unsigned char*)prm.ws;
    F.tid = threadIdx.x; F.lane = F.tid & 63; F.wave = __builtin_amdgcn_readfirstlane(F.tid >> 6); F.G = gridDim.x; F.wg = blockIdx.x;
    volatile LAS unsigned* MISC = (volatile LAS unsigned*)(F.lds + MISC_OFF);
    if (F.tid < 64) MISC[F.tid] = 0u;
    if (F.tid < 33) { const unsigned long long v = F.tid < 32 ? (unsigned long long)prm.in[F.tid] : (unsigned long long)prm.out; *(LAS unsigned long long*)(F.lds + PTAB_OFF + 8 * F.tid) = v; }
    __syncthreads();
    XcdBarrier bar = xcd_barrier_post(WSP(unsigned, WS_CTL) + CW_BAR, MISC + 8);
#define RELAUNDER() do { { unsigned long long _w = (unsigned long long)F.ws; asm volatile("" : "+s"(_w)); F.ws = (GAS unsigned char*)_w; } \
        { unsigned _t = (unsigned)F.tid; asm volatile("" : "+v"(_t)); F.tid = (int)_t; F.lane = F.tid & 63; F.wave = __builtin_amdgcn_readfirstlane(F.tid >> 6); } \
        { unsigned _g = (unsigned)F.G, _b = (unsigned)F.wg; asm volatile("" : "+s"(_g), "+s"(_b)); F.G = (int)_g; F.wg = (int)_b; } \
        { unsigned _l = (unsigned)(size_t)F.lds; asm volatile("" : "+s"(_l)); F.lds = (LAS unsigned char*)(size_t)_l; } } while (0)
#define GRID_BAR() do { { unsigned long long _b = (unsigned long long)bar.bar; unsigned _x = bar.x; asm volatile("" : "+s"(_b), "+s"(_x)); bar.bar = (GAS unsigned*)_b; bar.x = _x; } xcd_barrier(bar); RELAUNDER(); } while (0)

    for (int rp = 0; rp < REP_P0; ++rp) { phase_p0(F); write_bias(F);
    GRID_BAR(); }
#pragma unroll 1
    for (int layer_ = 0; layer_ < 2; ++layer_) {
        int layer = layer_;
#define last (layer == 1)
#define rows_all TOK
#define rows_out (last ? TOKL : TOK)
#define modbase (WSP(const float, WS_MOD) + (size_t)layer * 17 * 6144)
#define LAYER_LAUNDER() asm volatile("" : "+s"(layer))
        for (int rp = 0; rp < REP_NORM; ++rp) { phase_norm(F, layer, rows_all, !last, 0);
        if (layer == 0) { const int gw = F.wg * NWAVES + F.wave, NGW = F.G * NWAVES;
            for (int it = gw; it < 1536 + 96; it += NGW) filter_out_item(F, it); }
        { GRID_BAR(); LAYER_LAUNDER(); } }
        for (int rp = 0; rp < REP_WIN; ++rp) {
        { EpiWin E{WSP(const float, WS_BIAS) + layer * NWP, WSP(bf16, WS_HYTL), WSP(bf16, WS_HYTC), WSP(bf16, WS_RET), WSP(bf16, WS_ML), WSP(float, WS_MLG)};
          gemm_fast(F, WSP(const bf16, WS_H), D, WSP(const bf16, WS_WIN), D, D, rows_all, NW1, E); }
        { GRID_BAR(); LAYER_LAUNDER(); } }
        for (int rp = 0; rp < REP_MIX; ++rp) { phase_mix(F, layer);
        { GRID_BAR(); LAYER_LAUNDER(); } }
        phase_combine(F, layer);
        { GRID_BAR(); LAYER_LAUNDER(); }
        for (int rp = 0; rp < REP_GATE; ++rp) {
        { EpiGate E{WSP(const float, WS_BIAS) + layer * NWP + NW1, WSP(bf16, WS_GATES)};
          gemm_fast(F, WSP(const bf16, WS_H), D, WSP(const bf16, WS_WIN) + (size_t)NW1 * D, D, D, rows_out, NGATE, E); }
        { GRID_BAR(); LAYER_LAUNDER(); } }
        for (int rp = 0; rp < REP_UP; ++rp) {
        { EpiUp E{WSP(const bf16, WS_GATES), WSP(bf16, WS_H)};
          gemm_fast(F, WSP(const bf16, WS_Y), D, WSP(const bf16, WS_WUP), D, D, rows_out, D, E); }
        { GRID_BAR(); LAYER_LAUNDER(); } }
        { EpiResid E{last ? outp(F) : inp(F, I_X), last ? WSP(const float, WS_XC) : inp(F, I_CTX), outp(F), WSP(float, WS_XC), modbase, 2};
          gemm_fast(F, WSP(const bf16, WS_H), D, WSP(const bf16, WS_WOUT), D, D, rows_out, D, E); }
        { GRID_BAR(); LAYER_LAUNDER(); }
        if (!last) {
            phase_norm(F, layer, rows_out, false, 3);
            { const int gw = F.wg * NWAVES + F.wave, NGW = F.G * NWAVES; LAS float* scr = (LAS float*)(F.lds + F.wave * 8704);
              conv_weights_ffn(inp(F, I_FW1), inp(F, I_FW3), inp(F, I_FW2), WSP(bf16, WS_W13), WSP(bf16, WS_W2), gw, NGW, scr, F.lane);
              conv_weights_win(F, 1, gw, NGW, scr);
              conv_weights_upout(F, 1, gw, NGW, scr); }
            { GRID_BAR(); LAYER_LAUNDER(); }
            for (int rp = 0; rp < REP_FFN1; ++rp) {
            { EpiSwiglu E{WSP(bf16, WS_ACT), 0};
              gemm_fast(F, WSP(const bf16, WS_H), D, WSP(const bf16, WS_W13), D, D, rows_out, NFF1, E); }
            { GRID_BAR(); LAYER_LAUNDER(); } }
            { EpiResid E{outp(F), WSP(const float, WS_XC), outp(F), WSP(float, WS_XC), modbase, 5};
              gemm_fast(F, WSP(const bf16, WS_ACT), DFF, WSP(const bf16, WS_W2), DFF, DFF, rows_out, D, E); }
            { GRID_BAR(); LAYER_LAUNDER(); }
        }
    }
#undef LAYER_LAUNDER
#undef last
#undef rows_all
#undef rows_out
#undef modbase
    phase_norm_router(F);
    { const int gw = F.wg * NWAVES + F.wave, NGW = F.G * NWAVES; LAS float* scr = (LAS float*)(F.lds + F.wave * 8704);
#ifndef REP_MCONV
#define REP_MCONV 1
#endif
#pragma unroll 1
      for (int e = 0; e < NE * REP_MCONV; ++e)
          conv_weights_ffn(inp(F, I_MW1) + (size_t)(e % NE) * D * DFF, inp(F, I_MW3) + (size_t)(e % NE) * D * DFF, inp(F, I_MW2) + (size_t)(e % NE) * DFF * D,
                           WSP(bf16, WS_MW13) + (size_t)(e % NE) * NFF1 * D, WSP(bf16, WS_MW2) + (size_t)(e % NE) * D * DFF, gw, NGW, scr, F.lane); }
    GRID_BAR();
    phase_route_tables(F);
    GRID_BAR();
    const int ntiles = __builtin_amdgcn_readfirstlane(WSP(const int, WS_TILEE)[MAXTILES]);
#pragma unroll 1
    for (int p = 0; p < NPASS; ++p) {
        const int t0 = p * PASS_TILES, t1 = min(ntiles, t0 + PASS_TILES);
        for (int rp = 0; rp < REP_MOE; ++rp) {
        if (t0 < t1) moe_pass_gemm1_fast(F, t0, t1);
        GRID_BAR();
        if (t0 < t1) moe_pass_gemm2_fast(F, t0, t1);
        GRID_BAR(); }
    }
#ifndef REP_BAR
#define REP_BAR 0
#endif
    for (int rb = 0; rb < REP_BAR; ++rb) GRID_BAR();
    phase_final(F);
}

extern "C" void kernel_launch(void* const* d_in, const int* in_sizes, int n_in, void* d_out, int out_size, void* d_ws, size_t ws_size, hipStream_t stream) {
    static int grid = 0;
    if (grid == 0) {
        if (n_in != 32 || out_size != TOKL * D || ws_size < WS_END) { fprintf(stderr, "kernel_launch: unexpected arguments (n_in %d, out %d, ws %zu)\n", n_in, out_size, ws_size); grid = -1; return; }
        int dev = 0, cus = 0;
        if (hipGetDevice(&dev) != hipSuccess || hipDeviceGetAttribute(&cus, hipDeviceAttributeMultiprocessorCount, dev) != hipSuccess) { grid = -1; return; }
        if (hipFuncSetAttribute((const void*)hybrid_fwd, hipFuncAttributeMaxDynamicSharedMemorySize, LDS_BYTES) != hipSuccess) { grid = -1; return; }
        int per_cu = 0;
        (void)hipOccupancyMaxActiveBlocksPerMultiprocessor(&per_cu, (const void*)hybrid_fwd, NTHR, LDS_BYTES);
        (void)hipGetLastError();
        grid = cus;
    }
    if (grid < 0) return;
    (void)hipMemsetAsync((char*)d_ws + WS_CTL, 0, CTL_ZERO_BYTES, stream);
    Params p{};
    for (int i = 0; i < 32; ++i) p.in[i] = (const float*)d_in[i];
    p.out = (float*)d_out; p.ws = (unsigned char*)d_ws;
    hipLaunchKernelGGL(hybrid_fwd, dim3(grid), dim3(NTHR), LDS_BYTES, stream, p);
}
```

```cpp
#include <hip/hip_runtime.h>
#include <stdint.h>
#include <stdio.h>

#define LAS __attribute__((address_space(3)))
#define GAS __attribute__((address_space(1)))
typedef unsigned short bf16;
typedef short bf16x8 __attribute__((ext_vector_type(8)));
typedef float f32x4 __attribute__((ext_vector_type(4)));
typedef unsigned u32x4 __attribute__((ext_vector_type(4)));
typedef unsigned u32x2 __attribute__((ext_vector_type(2)));

constexpr int D = 1024, NB = 16, LL = 2048, LC = 256;
constexpr int TOKL = NB * LL, TOKC = NB * LC, TOK = TOKL + TOKC;
constexpr int HYW = 384, RETW = 384, MLW = 256;
constexpr int NIN = 6800, NW1 = 3840, NGATE = 3072, NWP = 6912;
constexpr int DFF = 2816, NFF1 = 5632, NE = 8;
constexpr int NWAVES = 8, NTHR = 512;
constexpr int MAXTILES = 272, PASS_TILES = 58, NPASS = 5;

constexpr size_t MiB = 1u << 20;
constexpr size_t WS_CTL = 0, CTL_ZERO_BYTES = 1 * MiB;
constexpr size_t WS_MOD = 1 * MiB;
constexpr size_t WS_BIAS = 2 * MiB;
constexpr size_t WS_ROPE = 2 * MiB + 256 * 1024;
constexpr size_t WS_TOPE = 3 * MiB;
constexpr size_t WS_TOPW = 3 * MiB + 256 * 1024;
constexpr size_t WS_TOPP = 3 * MiB + 512 * 1024;
constexpr size_t WS_SLOT = 3 * MiB + 768 * 1024;
constexpr size_t WS_ROWIDX = 4 * MiB;
constexpr size_t WS_TILEE = 4 * MiB + 512 * 1024;
constexpr size_t WS_FTL = 5 * MiB;
constexpr size_t WS_FTC = 17 * MiB;
constexpr size_t WS_WIN = 18 * MiB;
constexpr size_t WS_WUP = 32 * MiB;
constexpr size_t WS_WOUT = 34 * MiB;
constexpr size_t WS_XC = 36 * MiB;
constexpr size_t WS_H = 52 * MiB;
constexpr size_t WS_Y = 124 * MiB;
constexpr size_t WS_U = 196 * MiB;
constexpr size_t WS_RET = WS_U;
constexpr size_t WS_ML = WS_U + 108 * MiB;
constexpr size_t WS_MLG = WS_U + 180 * MiB;
constexpr size_t WS_OB = WS_U + 183 * MiB;
constexpr size_t WS_YHTL = WS_U + 228 * MiB;
constexpr size_t WS_YHTC = WS_U + 252 * MiB;
constexpr size_t WS_HYTL = WS_U + 255 * MiB;
constexpr size_t WS_HYTC = WS_U + 327 * MiB;
constexpr size_t WS_END = WS_U + 336 * MiB;
constexpr size_t WS_GATES = WS_U;
constexpr size_t WS_ACT = WS_U;
constexpr size_t WS_W13 = WS_U + 204 * MiB;
constexpr size_t WS_W2 = WS_U + 216 * MiB;
constexpr size_t WS_MW13 = WS_Y;
constexpr size_t WS_MW2 = WS_Y + 88 * MiB;
constexpr size_t WS_MACT = WS_Y + 132 * MiB;
constexpr size_t WS_EOUT = WS_Y + 220 * MiB;
static_assert(WS_EOUT + (size_t)MAXTILES * 256 * 1024 * 2 <= WS_END, "map");
static_assert(WS_GATES + (size_t)TOK * NGATE * 2 <= WS_YHTL, "gates overlay");

constexpr int CW_BAR = 4096;
constexpr int CW_CNT = 16384;

constexpr int LDS_BYTES = 147456;
constexpr int MISC_OFF = 147456 - 256;

__device__ __forceinline__ float bf2f(bf16 b) { return __uint_as_float(((unsigned)b) << 16); }
typedef __bf16 bf2v_ __attribute__((ext_vector_type(2)));
typedef float f2v_ __attribute__((ext_vector_type(2)));
__device__ __forceinline__ unsigned pk2(float lo, float hi) { const f2v_ f = {lo, hi}; return __builtin_bit_cast(unsigned, __builtin_convertvector(f, bf2v_)); }
__device__ __forceinline__ unsigned f2bf(float f) { return pk2(f, 0.f) & 0xffffu; }
__device__ __forceinline__ float dpp_f(float v, int) { return v; }
#define DPP_ADD(v, ctrl) (v) += __int_as_float(__builtin_amdgcn_update_dpp(0, __float_as_int(v), (ctrl), 0xf, 0xf, true))
__device__ __forceinline__ float wave_sum(float v) {
    DPP_ADD(v, 0xB1);
    DPP_ADD(v, 0x4E);
    DPP_ADD(v, 0x141);
    DPP_ADD(v, 0x140);
    return __int_as_float(__builtin_amdgcn_readlane(__float_as_int(v), 0)) + __int_as_float(__builtin_amdgcn_readlane(__float_as_int(v), 16))
         + __int_as_float(__builtin_amdgcn_readlane(__float_as_int(v), 32)) + __int_as_float(__builtin_amdgcn_readlane(__float_as_int(v), 48));
}
__device__ __forceinline__ float lane_read(float v, int src_lane) { return __int_as_float(__builtin_amdgcn_ds_bpermute(src_lane << 2, __float_as_int(v))); }
__device__ __forceinline__ float sigmoidf_(float x) { return __builtin_amdgcn_rcpf(1.0f + __expf(-x)); }
__device__ __forceinline__ float siluf_(float x) { return x * __builtin_amdgcn_rcpf(1.0f + __expf(-x)); }

#define XB_TMO      128
#define XB_XCNT(j)  (256  + 64 * (j))
#define XB_XSUB(j)  (1280 + 64 * (j))
#define XB_XGEN(j)  (2304 + 64 * (j))
#define XB_TOP      3328
#define XB_TOPGEN   3392
#define XCD_BAR_WORDS 3456
#define XB_SPIN_CAP (1u << 22)
__device__ __forceinline__ unsigned xb_ld(GAS unsigned* p)              { return __hip_atomic_load(p, __ATOMIC_RELAXED, __HIP_MEMORY_SCOPE_AGENT); }
__device__ __forceinline__ unsigned xb_add(GAS unsigned* p, unsigned v) { return __hip_atomic_fetch_add(p, v, __ATOMIC_RELAXED, __HIP_MEMORY_SCOPE_AGENT); }
__device__ __forceinline__ unsigned xb_xcc_id() { return (unsigned)__builtin_amdgcn_s_getreg((3 << 11) | 20) & 0xFu; }
#define XB_SPIN(cond, bar) do { unsigned _sp = 0; while (cond) { __builtin_amdgcn_s_sleep(1); \
    if ((++_sp & 255u) == 0u) { if (xb_ld(&(bar)[XB_TMO])) break; if (_sp > XB_SPIN_CAP) { (void)__hip_atomic_fetch_add(&(bar)[XB_TMO], 1u, __ATOMIC_RELAXED, __HIP_MEMORY_SCOPE_AGENT); break; } } } } while (0)
struct XcdBarrier { GAS unsigned* bar; unsigned x; volatile LAS unsigned* st; };
__device__ __forceinline__ XcdBarrier xcd_barrier_post(GAS unsigned* bar, volatile LAS unsigned* st) {
    XcdBarrier b; b.bar = bar; b.x = xb_xcc_id(); b.st = st;
    if (threadIdx.x == 0) (void)xb_add(&bar[XB_XCNT(b.x)], 1u);
    return b;
}
__device__ __forceinline__ void xcd_barrier_complete(GAS unsigned* bar, unsigned x, unsigned& nloc, unsigned& nx) {
    const unsigned G = gridDim.x * gridDim.y * gridDim.z;
    unsigned sum, cnt, mine, sp = 0u;
    for (;;) {
        sum = 0u; cnt = 0u; mine = 0u;
#pragma unroll 1
        for (unsigned j = 0; j < 16; ++j) { const unsigned c = xb_ld(&bar[XB_XCNT(j)]); sum += c; cnt += (c > 0u) ? 1u : 0u; }
        mine = xb_ld(&bar[XB_XCNT(x)]);
        if (sum == G) break;
        __builtin_amdgcn_s_sleep(1);
        if ((++sp & 255u) == 0u) { if (xb_ld(&bar[XB_TMO])) break; if (sp > XB_SPIN_CAP) { (void)__hip_atomic_fetch_add(&bar[XB_TMO], 1u, __ATOMIC_RELAXED, __HIP_MEMORY_SCOPE_AGENT); break; } }
    }
    nloc = mine > 0u ? mine : 1u; nx = cnt > 0u ? cnt : 1u;
}
__device__ __forceinline__ void xcd_barrier(const XcdBarrier& b) {
    asm volatile("s_waitcnt vmcnt(0)" ::: "memory");
    __syncthreads();
    if (threadIdx.x == 0) {
        GAS unsigned* bar = b.bar;
        __builtin_amdgcn_s_waitcnt(0);
        unsigned nloc = b.st[0], nx = b.st[1];
        if (nloc == 0u) { xcd_barrier_complete(bar, b.x, nloc, nx); b.st[0] = nloc; b.st[1] = nx; }
        const unsigned old = xb_add(&bar[XB_XSUB(b.x)], 1u);
        const unsigned gen = old / nloc;
        if (old + 1u == (gen + 1u) * nloc) {
            __builtin_amdgcn_fence(__ATOMIC_RELEASE, "agent");
            asm volatile("s_waitcnt vmcnt(0)" ::: "memory");
            const unsigned og = xb_add(&bar[XB_TOP], 1u);
            const unsigned tg = og / nx;
            if (og + 1u == (tg + 1u) * nx) xb_add(&bar[XB_TOPGEN], 1u);
            else XB_SPIN(xb_ld(&bar[XB_TOPGEN]) == tg, bar);
            __builtin_amdgcn_fence(__ATOMIC_ACQUIRE, "agent");
            xb_add(&bar[XB_XGEN(b.x)], 1u);
            asm volatile("s_waitcnt vmcnt(0)" ::: "memory");
        } else {
            XB_SPIN(xb_ld(&bar[XB_XGEN(b.x)]) == gen, bar);
            __builtin_amdgcn_fence(__ATOMIC_ACQUIRE, "agent");
            asm volatile("s_waitcnt vmcnt(0)" ::: "memory");
        }
    }
    __syncthreads();
}

struct Params { const float* in[32]; float* out; unsigned char* ws; };
enum { I_X = 0, I_C, I_CTX, I_CCTX, I_WMOD, I_BMOD, I_GMIX, I_GFFN, I_WIN, I_BIN, I_HYCONV, I_HYF1, I_HYFB1, I_HYF2, I_HYFB2, I_HYF3, I_HYDECAY,
       I_HYSKIP, I_RETDECAY, I_MLCONV, I_MLGB, I_WUP, I_WOUT, I_FW1, I_FW3, I_FW2, I_ROUTER, I_ROUTERB, I_MW1, I_MW3, I_MW2, I_GFINAL };

struct Frame {
    LAS unsigned char* lds;
    GAS unsigned char* ws;
    int tid, lane, wave, G, wg;
};
#define WSP(T, off) ((GAS T*)(F.ws + (off)))
constexpr int PTAB_OFF = 147456 - 1024;
__device__ __forceinline__ const GAS float* inp(const Frame& F, int i) {
    const LAS unsigned* t = (const LAS unsigned*)(F.lds + PTAB_OFF) + 2 * i;
    const unsigned lo = __builtin_amdgcn_readfirstlane(t[0]), hi = __builtin_amdgcn_readfirstlane(t[1]);
    return (const GAS float*)(((unsigned long long)hi << 32) | lo);
}
__device__ __forceinline__ GAS float* outp(const Frame& F) { return (GAS float*)inp(F, 32); }

__device__ __forceinline__ int row_batch(int row) { return row < TOKL ? (row >> 11) : ((row - TOKL) >> 8); }
__device__ __forceinline__ const GAS float* mod_ptr(const Frame& F, int layer, int row, int which) {
    const int r = row < TOKL ? (row >> 11) : 16;
    return WSP(const float, WS_MOD) + ((size_t)(layer * 17 + r) * 6 + which) * 1024;
}

template <class RowMap>
__device__ __forceinline__ void tr_item(const GAS float* W, int K, int N, GAS bf16* WT, int ldT, RowMap rm, LAS float* scr, int item, int lane) {
    const int nblk = (N + 31) / 32, kb = item / nblk, nb = item % nblk, k0 = 64 * kb, n0 = 32 * nb;
    { float tv[32];
#pragma unroll
      for (int i = 0; i < 32; ++i) { const int kk = 2 * i + (lane >> 5); const int n = n0 + (lane & 31); tv[i] = (n < N) ? W[(size_t)(k0 + kk) * N + n] : 0.f; }
#pragma unroll
      for (int i = 0; i < 32; ++i) { const int kk = 2 * i + (lane >> 5); scr[kk * 33 + (lane & 31)] = tv[i]; } }
    asm volatile("s_waitcnt lgkmcnt(0)" ::: "memory");
    const int c = lane & 7;
#pragma unroll
    for (int j = 0; j < 4; ++j) { const int nl = (lane >> 3) + 8 * j; const int n = n0 + nl; const LAS float* s = scr + (8 * c) * 33 + nl;
        u32x4 o; o.x = pk2(s[0 * 33], s[1 * 33]); o.y = pk2(s[2 * 33], s[3 * 33]); o.z = pk2(s[4 * 33], s[5 * 33]); o.w = pk2(s[6 * 33], s[7 * 33]);
        if (n < N) *(GAS u32x4*)(WT + (size_t)rm(n) * ldT + k0 + 8 * c) = o; }
    asm volatile("s_waitcnt lgkmcnt(0)" ::: "memory");
}
struct RmId { __device__ __forceinline__ int operator()(int n) const { return n; } };
__device__ __forceinline__ int win_row(int n) {
    if (n < 1152) return n;
    if (n < 2688) return 1280 + (n - 1152);
    if (n < 3712) return 2816 + (n - 2688);
    if (n < 3728) return 1152 + (n - 3712);
    return 3840 + (n - 3728);
}
struct RmWin { __device__ __forceinline__ int operator()(int n) const { return win_row(n); } };
struct RmW1 { __device__ __forceinline__ int operator()(int n) const { return (n >> 4) * 32 + (n & 15); } };
struct RmW3 { __device__ __forceinline__ int operator()(int n) const { return (n >> 4) * 32 + 16 + (n & 15); } };

__device__ __forceinline__ void conv_weights_win(Frame& F, int layer, int gw, int NGW, LAS float* scr) {
    const GAS float* W = inp(F, I_WIN) + (size_t)layer * D * NIN;
    const int items = (D / 64) * ((NIN + 31) / 32);
    for (int it = gw; it < items; it += NGW) tr_item(W, D, NIN, WSP(bf16, WS_WIN), D, RmWin(), scr, it, F.lane);
    GAS bf16* wt = WSP(bf16, WS_WIN);
    unsigned zz; asm volatile("v_mov_b32 %0, 0" : "=v"(zz));
    for (int i = gw * 64 + F.lane; i < 112 * 1024 / 8; i += NGW * 64) *(GAS u32x4*)(wt + (size_t)1168 * 1024 + (size_t)i * 8) = (u32x4){zz, zz, zz, zz};
}
__device__ __forceinline__ void conv_weights_upout(Frame& F, int layer, int gw, int NGW, LAS float* scr) {
    const int items = (D / 64) * (D / 32);
    for (int it = gw; it < items; it += NGW) tr_item(inp(F, I_WUP) + (size_t)layer * D * D, D, D, WSP(bf16, WS_WUP), D, RmId(), scr, it, F.lane);
    for (int it = gw; it < items; it += NGW) tr_item(inp(F, I_WOUT) + (size_t)layer * D * D, D, D, WSP(bf16, WS_WOUT), D, RmId(), scr, it, F.lane);
}
__device__ __forceinline__ void conv_weights_ffn(const GAS float* w1, const GAS float* w3, const GAS float* w2, GAS bf16* w13t, GAS bf16* w2t, int gw, int NGW, LAS float* scr, int lane) {
    const int i1 = (D / 64) * (DFF / 32), i2 = (DFF / 64) * (D / 32);
    for (int it = gw; it < i1; it += NGW) tr_item(w1, D, DFF, w13t, D, RmW1(), scr, it, lane);
    for (int it = gw; it < i1; it += NGW) tr_item(w3, D, DFF, w13t, D, RmW3(), scr, it, lane);
    for (int it = gw; it < i2; it += NGW) tr_item(w2, DFF, D, w2t, DFF, RmId(), scr, it, lane);
}

constexpr size_t WS_HID2 = WS_XC;
__device__ __forceinline__ void filter_hidden_item(Frame& F, int item) {
    const int p0 = item * 8, sel = p0 < 2048 ? 0 : (p0 < 4096 ? 1 : 2), layer = sel == 1 ? 1 : 0, L = sel == 2 ? LC : LL, pbase = sel == 0 ? 0 : (sel == 1 ? 2048 : 4096);
    const GAS float* f1 = inp(F, I_HYF1) + layer * 33 * 64; const GAS float* fb1 = inp(F, I_HYFB1) + layer * 64;
    const GAS float* f2 = inp(F, I_HYF2) + layer * 64 * 64; const GAS float* fb2 = inp(F, I_HYFB2) + layer * 64;
    const int lane = F.lane;
    const float b1 = fb1[lane], b2 = fb2[lane];
    for (int pl = 0; pl < 8; ++pl) {
        const int pos = p0 + pl - pbase;
        const float t = (float)pos / (float)(L - 1);
        const float w = 6.283185307179586f * (float)pos / (float)L;
        float feat = 0.f;
        if (lane == 0) feat = t;
        else if (lane < 17) { const float band = 1e-4f + (float)(lane - 1) * ((15.0f - 1e-4f) / 15.0f); feat = cosf(w * band); }
        else if (lane < 33) { const float band = 1e-4f + (float)(lane - 17) * ((15.0f - 1e-4f) / 15.0f); feat = -sinf(w * band); }
        float a1 = b1;
        for (int i = 0; i < 33; ++i) a1 += __int_as_float(__builtin_amdgcn_readlane(__float_as_int(feat), i)) * f1[i * 64 + lane];
        const float h1 = sinf(a1);
        float a2 = b2;
        for (int i = 0; i < 64; ++i) a2 += __int_as_float(__builtin_amdgcn_readlane(__float_as_int(h1), i)) * f2[i * 64 + lane];
        WSP(float, WS_HID2)[(size_t)(p0 + pl) * 64 + lane] = sinf(a2);
    }
}
__device__ __forceinline__ void filter_out_item(Frame& F, int item) {
    int sel, r;
    if (item < 768) { sel = 0; r = item; } else if (item < 1536) { sel = 1; r = item - 768; } else { sel = 2; r = item - 1536; }
    const int layer = sel == 1 ? 1 : 0, L = sel == 2 ? LC : LL, pb = r / 24, ch = r % 24, pbase = sel == 0 ? 0 : (sel == 1 ? 2048 : 4096);
    GAS bf16* FT = sel == 2 ? WSP(bf16, WS_FTC) : WSP(bf16, WS_FTL) + (size_t)layer * 2 * 384 * 4096;
    const GAS float* f3 = inp(F, I_HYF3) + (size_t)layer * 64 * 1536; const GAS float* dec = inp(F, I_HYDECAY) + layer * 1536;
    const int lane = F.lane, fr = lane & 15, fq = lane >> 4;
    const GAS float* hid = WSP(const float, WS_HID2) + (size_t)(pbase + pb * 64) * 64;
    f32x4 acc[4][4];
#pragma unroll
    for (int mt = 0; mt < 4; ++mt)
#pragma unroll
        for (int nt = 0; nt < 4; ++nt) acc[mt][nt] = (f32x4){0.f, 0.f, 0.f, 0.f};
#pragma unroll 4
    for (int ks = 0; ks < 16; ++ks) {
        float a[4], bb[4];
#pragma unroll
        for (int mt = 0; mt < 4; ++mt) a[mt] = hid[(16 * mt + fr) * 64 + 4 * ks + fq];
#pragma unroll
        for (int nt = 0; nt < 4; ++nt) bb[nt] = f3[(size_t)(4 * ks + fq) * 1536 + ch * 64 + 16 * nt + fr];
#pragma unroll
        for (int mt = 0; mt < 4; ++mt)
#pragma unroll
            for (int nt = 0; nt < 4; ++nt) acc[mt][nt] = __builtin_amdgcn_mfma_f32_16x16x4f32(a[mt], bb[nt], acc[mt][nt], 0, 0, 0);
    }
#pragma unroll
    for (int nt = 0; nt < 4; ++nt) {
        const int nn = ch * 64 + 16 * nt + fr, o = nn / 768, dir = (nn / 384) & 1, c = nn % 384;
        const float adec = fabsf(dec[nn]);
        GAS bf16* dst = FT + (size_t)(o * 384 + c) * (2 * L);
#pragma unroll
        for (int mt = 0; mt < 4; ++mt)
#pragma unroll
            for (int j = 0; j < 4; ++j) {
                const int pos = pb * 64 + 16 * mt + 4 * fq + j;
                const float t = (float)pos / (float)(L - 1);
                const float v = acc[mt][nt][j] * expf(-t * adec);
                if (dir == 0) dst[L - pos] = (bf16)f2bf(v);
                else if (pos > 0) dst[L + pos] = (bf16)f2bf(v);
            }
    }
}

__device__ __forceinline__ void phase_p0(Frame& F) {
    const int gw = F.wg * NWAVES + F.wave, NGW = F.G * NWAVES;
    LAS float* sl = (LAS float*)F.lds;
    LAS float* red = (LAS float*)(F.lds + 17 * 4096);
    for (int i = F.tid; i < 17 * 1024; i += NTHR) { const int r = i >> 10, k = i & 1023; const float v = r < 16 ? inp(F, I_C)[r * 1024 + k] : inp(F, I_CCTX)[k]; sl[i] = siluf_(v); }
    __syncthreads();
    for (int item = F.wg; item < 2 * 384; item += F.G) {
        const int layer = item / 384, n0 = (item % 384) * 16, j = F.tid & 15, kp = F.tid >> 4;
        const GAS float* W = inp(F, I_WMOD) + (size_t)layer * D * 6144;
        float acc[17];
#pragma unroll
        for (int r = 0; r < 17; ++r) acc[r] = 0.f;
        for (int k = kp * 32; k < kp * 32 + 32; ++k) { const float w = W[(size_t)k * 6144 + n0 + j];
#pragma unroll
            for (int r = 0; r < 17; ++r) acc[r] += sl[r * 1024 + k] * w; }
#pragma unroll
        for (int r = 0; r < 17; ++r) red[(kp * 17 + r) * 16 + j] = acc[r];
        __syncthreads();
        if (F.tid < 272) { const int r = F.tid >> 4, jj = F.tid & 15; float s = inp(F, I_BMOD)[layer * 6144 + n0 + jj];
            for (int q = 0; q < 32; ++q) s += red[(q * 17 + r) * 16 + jj];
            WSP(float, WS_MOD)[(size_t)(layer * 17 + r) * 6144 + n0 + jj] = s; }
        __syncthreads();
    }
    __syncthreads();
    LAS float* scr = (LAS float*)(F.lds + F.wave * 8704);
    conv_weights_win(F, 0, gw, NGW, scr);
    conv_weights_upout(F, 0, gw, NGW, scr);
    for (int i = gw * 64 + F.lane; i < 2048 * 32; i += NGW * 64) {
        const int t = i >> 5, j = i & 31, half = j >> 4, ii = j & 15;
        const float inv = 1.0f / powf(10000.0f, (float)ii / 16.0f);
        const float ang = (float)(half == 0 ? (t >> 6) : (t & 63)) * inv;
        WSP(float, WS_ROPE)[t * 64 + half * 32 + ii] = cosf(ang);
        WSP(float, WS_ROPE)[t * 64 + half * 32 + 16 + ii] = sinf(ang);
    }
    for (int it = gw; it < 4352 / 8; it += NGW) filter_hidden_item(F, it);
}
__device__ __forceinline__ void write_bias(Frame& F) {
    const int gt = (F.wg * NWAVES + F.wave) * 64 + F.lane, NGT = F.G * NTHR;
    for (int i = gt; i < 2 * NWP; i += NGT) {
        const int l = i / NWP, r = i % NWP; float v = 0.f;
        int n = -1;
        if (r < 1152) n = r; else if (r < 1168) n = 3712 + (r - 1152); else if (r < 1280) n = -1; else if (r < 2816) n = 1152 + (r - 1280); else if (r < 3840) n = 2688 + (r - 2816); else n = 3728 + (r - 3840);
        if (n >= 0) v = inp(F, I_BIN)[l * NIN + n];
        WSP(float, WS_BIAS)[i] = v;
    }
}

__device__ __forceinline__ void norm_mod_row(const GAS float* xrow, const GAS float* g, const GAS float* shift, const GAS float* scale, GAS bf16* orow, int lane, float* keep  ) {
    f32x4 v[4]; float s = 0.f;
#pragma unroll
    for (int j = 0; j < 4; ++j) { v[j] = *(const GAS f32x4*)(xrow + 256 * j + 4 * lane); s += (v[j].x * v[j].x + v[j].y * v[j].y) + (v[j].z * v[j].z + v[j].w * v[j].w); }
    const float r = rsqrtf(wave_sum(s) * (1.0f / 1024.0f) + 1e-6f);
#pragma unroll
    for (int j = 0; j < 4; ++j) {
        const f32x4 gg = *(const GAS f32x4*)(g + 256 * j + 4 * lane), sh = *(const GAS f32x4*)(shift + 256 * j + 4 * lane), sc = *(const GAS f32x4*)(scale + 256 * j + 4 * lane);
        f32x4 o;
        o.x = (v[j].x * r * gg.x) * (1.f + sc.x) + sh.x; o.y = (v[j].y * r * gg.y) * (1.f + sc.y) + sh.y;
        o.z = (v[j].z * r * gg.z) * (1.f + sc.z) + sh.z; o.w = (v[j].w * r * gg.w) * (1.f + sc.w) + sh.w;
        if (keep) { keep[4 * j + 0] = o.x; keep[4 * j + 1] = o.y; keep[4 * j + 2] = o.z; keep[4 * j + 3] = o.w; }
        u32x2 w; w.x = pk2(o.x, o.y); w.y = pk2(o.z, o.w);
        *(GAS u32x2*)(orow + 256 * j + 4 * lane) = w;
    }
}
__device__ __forceinline__ const GAS float* xrow_ptr(const Frame& F, int row, bool from_input) {
    if (row < TOKL) return (from_input ? inp(F, I_X) : outp(F)) + (size_t)row * D;
    return (from_input ? inp(F, I_CTX) : WSP(const float, WS_XC)) + (size_t)(row - TOKL) * D;
}
__device__ __forceinline__ void phase_norm(Frame& F, int layer, int nrows, bool from_input, int which) {
    const int gw = F.wg * NWAVES + F.wave, NGW = F.G * NWAVES;
    const GAS float* g = inp(F, which == 0 ? I_GMIX : I_GFFN) + layer * D;
#pragma unroll 2
    for (int row = gw; row < nrows; row += NGW)
        norm_mod_row(xrow_ptr(F, row, from_input), g, mod_ptr(F, layer, row, which), mod_ptr(F, layer, row, which + 1), WSP(bf16, WS_H) + (size_t)row * D, F.lane, nullptr);
}

namespace pg8 {
constexpr int BM = 256, BK = 64, HALF = 128, HTB = HALF * BK * 2, STAGE_BYTES = 8 * HTB, NXCD = 8, WGM = 8;
__device__ __forceinline__ int lds_byte(int r, int c) { const int st = (r >> 4) * 2 + (c >> 5), rr = r & 15, cc = c & 31, ob = rr * 64 + cc * 2; return st * 1024 + (ob ^ (((ob >> 9) & 1) << 5)); }
__device__ __forceinline__ void stage_rc(int b, int& R, int& C) { const int st = b / 1024, sb = b % 1024, swz = sb ^ (((sb >> 9) & 1) << 5); R = (st >> 1) * 16 + swz / 64; C = (st & 1) * 32 + (swz % 64) / 2; }
struct Unit { int pm, pn; };
struct OrderPlain {
    static constexpr bool GATHER = false;
    int nM, nN, nwg, G, c;
    __device__ __forceinline__ void init(int nM_, int nN_, int G_, int c_) { nM = nM_; nN = nN_; nwg = nM * nN; G = G_; c = c_; }
    __device__ __forceinline__ bool next(int i, Unit& u) const {
        const long L = (long)i * G + c; if (L >= nwg) return false;
        int wgid = (int)L; { const int q = nwg / NXCD, r = nwg % NXCD, xcd = wgid % NXCD, off = wgid / NXCD; wgid = (xcd < r ? xcd * (q + 1) : r * (q + 1) + (xcd - r) * q) + off; }
        const int nig = WGM * nN, gid = wgid / nig, fm = gid * WGM, gsz = (nM - fm) < WGM ? (nM - fm) : WGM;
        u.pm = fm + ((wgid % nig) % gsz); u.pn = (wgid % nig) / gsz; return true;
    }
    __device__ __forceinline__ int arow(int r) const { return r; }
    __device__ __forceinline__ size_t boff(const Unit&) const { return 0; }
};
struct OrderMoe {
    static constexpr bool GATHER = true;
    OrderPlain o; const GAS int* rowidx; const GAS int* tilee; int t0; size_t bstride; bool gather;
    __device__ __forceinline__ bool next(int i, Unit& u) const { return o.next(i, u); }
    __device__ __forceinline__ int arow(int r) const { return gather ? rowidx[t0 * 256 + r] : r; }
    __device__ __forceinline__ size_t boff(const Unit& u) const { return (size_t)tilee[t0 + u.pm] * bstride; }
};

template <class Epi, class Sched>
__device__ __forceinline__ void gemm_phase(LAS unsigned char* lds, int tid_in, const GAS bf16* A, int lda, const GAS bf16* Bt, int ldb, int K, const Sched& S, const Epi& E) {
    unsigned tid_u = (unsigned)tid_in; asm volatile("" : "+v"(tid_u));
    const int tid = (int)tid_u, wid = __builtin_amdgcn_readfirstlane(tid >> 6), lane = tid & 63, wr = wid >> 2, wc = wid & 3, fr = lane & 15, fq = lane >> 4;
    const int nt = K / BK;
    unsigned voffB[2];
    { int sR[2], sC[2];
#pragma unroll
      for (int i = 0; i < 2; ++i) { stage_rc(tid * 16 + i * 8192, sR[i], sC[i]);
        const int rho = sR[i] & 31, Rb = Epi::PERM ? ((sR[i] & ~31) + 8 * ((rho & 15) >> 2) + 4 * (rho >> 4) + (rho & 3)) : sR[i];
        voffB[i] = (unsigned)(Rb * ldb + sC[i]) * 2u; } }
#define PG8_GATHER_OFFS(pm_) do { unsigned _t = (unsigned)tid; asm volatile("" : "+v"(_t)); _Pragma("unroll") for (int i = 0; i < 2; ++i) { int _R, _C; stage_rc((int)_t * 16 + i * 8192, _R, _C); \
        vc0[i] = (unsigned)((size_t)S.arow((pm_) * BM + _R) * lda + _C) * 2u; vc1[i] = (unsigned)((size_t)S.arow((pm_) * BM + HALF + _R) * lda + _C) * 2u; } } while (0)
    const size_t kstep = (size_t)(BK * 2);
    const size_t hstepB = (size_t)HALF * ldb * 2, tstepB = 2 * hstepB;
    const unsigned ldsw = (unsigned)wid * 1024u;
    const int aoff = lds_byte(wr * 64 + fr, fq * 8), boff = lds_byte(wc * 32 + fr, fq * 8);
#define PG8_SA(b, h) (((b) * 2 + (h)) * HTB)
#define PG8_SB(b, h) ((4 + (b) * 2 + (h)) * HTB)
#define PG8_STAGE2(bufoff, gbase, v0, v1) do { \
        __builtin_amdgcn_global_load_lds((const GAS unsigned*)((const GAS char*)(gbase) + (v0)), (LAS unsigned*)(lds + (bufoff) + ldsw), 16, 0, 0); \
        __builtin_amdgcn_global_load_lds((const GAS unsigned*)((const GAS char*)(gbase) + (v1)), (LAS unsigned*)(lds + (bufoff) + ldsw + 8192), 16, 0, 0); } while (0)
#define PG8_STAGEB(bufoff, gbase) PG8_STAGE2(bufoff, gbase, voffB[0], voffB[1])
#define PG8_LDA(dst, b, h) do { _Pragma("unroll") for (int m = 0; m < 4; ++m) _Pragma("unroll") for (int k = 0; k < 2; ++k) dst[m][k] = *(const LAS bf16x8*)(lds + PG8_SA(b, h) + aoff + m * 2048 + k * 1024); } while (0)
#define PG8_LDB(dst, b, h) do { _Pragma("unroll") for (int n = 0; n < 2; ++n) _Pragma("unroll") for (int k = 0; k < 2; ++k) dst[n][k] = *(const LAS bf16x8*)(lds + PG8_SB(b, h) + boff + n * 2048 + k * 1024); } while (0)
#define PG8_MMA(ai, bj, At, Bt_) do { __builtin_amdgcn_s_setprio(1); _Pragma("unroll") for (int m = 0; m < 4; ++m) _Pragma("unroll") for (int n = 0; n < 2; ++n) _Pragma("unroll") for (int k = 0; k < 2; ++k) \
        acc[ai][bj][m][n] = __builtin_amdgcn_mfma_f32_16x16x32_bf16(Bt_[n][k], At[m][k], acc[ai][bj][m][n], 0, 0, 0); __builtin_amdgcn_s_setprio(0); } while (0)
#define PG8_WAIT_V(n) asm volatile("s_waitcnt vmcnt(" #n ")" ::: "memory")
#define PG8_WAIT_L(n) asm volatile("s_waitcnt lgkmcnt(" #n ")" ::: "memory")
#define PG8_BAR __builtin_amdgcn_s_barrier()
#define PG8_SCHED __builtin_amdgcn_sched_barrier(0)
    Unit cur, nxt; int ui = 0;
    if (!S.next(0, cur)) return;
    f32x4 acc[2][2][4][2];
#pragma unroll
    for (int a = 0; a < 2; ++a)
#pragma unroll
        for (int b = 0; b < 2; ++b)
#pragma unroll
            for (int m = 0; m < 4; ++m)
#pragma unroll
                for (int n = 0; n < 2; ++n) { float zf; asm volatile("v_mov_b32 %0, 0" : "=v"(zf)); acc[a][b][m][n] = (f32x4){zf, zf, zf, zf}; }
    bf16x8 At[4][2], B0[2][2], B1[2][2];
    constexpr bool GA = Sched::GATHER;
    const size_t hstepA = GA ? 0 : (size_t)HALF * lda * 2, tstepA = (size_t)BM * lda * 2;
    unsigned vc0[2], vc1[2];
    if constexpr (GA) { PG8_GATHER_OFFS(cur.pm); }
    else { int sR, sC;
#pragma unroll
        for (int i = 0; i < 2; ++i) { stage_rc(tid * 16 + i * 8192, sR, sC); vc0[i] = (unsigned)(sR * lda + sC) * 2u; vc1[i] = 0u; } }
#define VC0(i) vc0[i]
#define VC1(i) (GA ? vc1[i] : vc0[i])
#define VN0(i) vc0[i]
#define VN1(i) VC1(i)
    const GAS char* cA = GA ? (const GAS char*)A : (const GAS char*)A + (size_t)cur.pm * tstepA;
    const GAS char* cB = (const GAS char*)Bt + S.boff(cur) * 2 + (size_t)cur.pn * tstepB;
    PG8_STAGEB(PG8_SB(0, 0), cB); PG8_STAGE2(PG8_SA(0, 0), cA, VC0(0), VC0(1)); PG8_STAGEB(PG8_SB(0, 1), cB + hstepB); PG8_STAGE2(PG8_SA(0, 1), cA + hstepA, VC1(0), VC1(1));
    if (wr == 1) PG8_BAR;
    PG8_WAIT_V(4); PG8_BAR;
    PG8_STAGEB(PG8_SB(1, 0), cB + kstep); PG8_STAGE2(PG8_SA(1, 0), cA + kstep, VC0(0), VC0(1)); PG8_STAGEB(PG8_SB(1, 1), cB + hstepB + kstep);
    PG8_WAIT_V(6); PG8_BAR;
    for (;;) {
        const bool has_next = S.next(ui + 1, nxt);
        const GAS char* nB = cB; const GAS char* nA = cA;
        if (has_next) {
            nB = (const GAS char*)Bt + S.boff(nxt) * 2 + (size_t)nxt.pn * tstepB;
            if constexpr (!GA) nA = (const GAS char*)A + (size_t)nxt.pm * tstepA;
        }
        for (int t = 0; t < nt; t += 2) {
            const bool last = (t == nt - 2);
            if constexpr (Epi::HORNER) {
                if (t == 6 || t == 12) {
                    asm volatile("" ::: "memory");
                    const int seg = (t == 6) ? 0 : 1;
                    int hpm = cur.pm, hpn = cur.pn; asm volatile("" : "+s"(hpm), "+s"(hpn));
                    unsigned hln = (unsigned)lane; asm volatile("" : "+v"(hln)); const int hfr = (int)(hln & 15u), hfq = (int)(hln >> 4);
#pragma unroll
                    for (int ai = 0; ai < 2; ++ai) {
                        u32x4 ga[4][2], gb[4][2];
#pragma unroll
                        for (int m = 0; m < 4; ++m)
#pragma unroll
                            for (int bj = 0; bj < 2; ++bj) {
                                const int row = hpm * BM + ai * HALF + wr * 64 + m * 16 + hfr, col = hpn * BM + bj * HALF + wc * 32 + 8 * hfq;
                                ga[m][bj] = E.gate8(seg, row, col); gb[m][bj] = E.gate8(seg + 1, row, col);
                            }
                        asm volatile("" : "+v"(ga[0][0]), "+v"(ga[0][1]), "+v"(ga[1][0]), "+v"(ga[1][1]), "+v"(ga[2][0]), "+v"(ga[2][1]), "+v"(ga[3][0]), "+v"(ga[3][1]),
                                          "+v"(gb[0][0]), "+v"(gb[0][1]), "+v"(gb[1][0]), "+v"(gb[1][1]), "+v"(gb[2][0]), "+v"(gb[2][1]), "+v"(gb[3][0]), "+v"(gb[3][1]) :: "memory");
#pragma unroll
                        for (int m = 0; m < 4; ++m)
#pragma unroll
                            for (int bj = 0; bj < 2; ++bj) {
                                const unsigned aw[4] = {ga[m][bj].x, ga[m][bj].y, ga[m][bj].z, ga[m][bj].w}, bw[4] = {gb[m][bj].x, gb[m][bj].y, gb[m][bj].z, gb[m][bj].w};
#pragma unroll
                                for (int n = 0; n < 2; ++n) {
                                    f32x4& v = acc[ai][bj][m][n];
                                    v.x *= __uint_as_float(aw[2 * n] << 16) * __builtin_amdgcn_rcpf(__uint_as_float(bw[2 * n] << 16));
                                    v.y *= __uint_as_float(aw[2 * n] & 0xffff0000u) * __builtin_amdgcn_rcpf(__uint_as_float(bw[2 * n] & 0xffff0000u));
                                    v.z *= __uint_as_float(aw[2 * n + 1] << 16) * __builtin_amdgcn_rcpf(__uint_as_float(bw[2 * n + 1] << 16));
                                    v.w *= __uint_as_float(aw[2 * n + 1] & 0xffff0000u) * __builtin_amdgcn_rcpf(__uint_as_float(bw[2 * n + 1] & 0xffff0000u));
                                }
                            }
                    }
                    asm volatile("s_waitcnt vmcnt(0)" ::: "memory");
                }
            }
            const GAS char* a1 = cA + (size_t)(t + 1) * kstep;
            const GAS char* a2 = last ? nA : cA + (size_t)(t + 2) * kstep; const GAS char* b2 = last ? nB : cB + (size_t)(t + 2) * kstep;
            const GAS char* a3 = a2 + kstep; const GAS char* b3 = b2 + kstep;
            PG8_LDB(B0, 0, 0); PG8_SCHED; PG8_LDA(At, 0, 0); PG8_STAGE2(PG8_SA(1, 1), a1 + hstepA, VC1(0), VC1(1));
            if constexpr (GA) { if (last && has_next) { asm volatile("" ::: "memory"); PG8_GATHER_OFFS(nxt.pm); asm volatile("" ::: "memory"); } }
            PG8_WAIT_L(8); PG8_BAR; PG8_WAIT_L(0); PG8_MMA(0, 0, At, B0); PG8_BAR; PG8_SCHED;
            PG8_LDB(B1, 0, 1); PG8_STAGEB(PG8_SB(0, 0), b2);
            PG8_BAR; PG8_WAIT_L(0); PG8_MMA(0, 1, At, B1); PG8_BAR;
            PG8_LDA(At, 0, 1); PG8_STAGE2(PG8_SA(0, 0), a2, VN0(0), VN0(1));
            PG8_BAR; PG8_WAIT_L(0); PG8_MMA(1, 0, At, B0); PG8_BAR; PG8_SCHED;
            PG8_STAGEB(PG8_SB(0, 1), b2 + hstepB);
            PG8_WAIT_V(6); PG8_BAR; PG8_MMA(1, 1, At, B1); PG8_BAR;
            PG8_LDB(B0, 1, 0); PG8_SCHED; PG8_LDA(At, 1, 0); PG8_STAGE2(PG8_SA(0, 1), a2 + hstepA, VN1(0), VN1(1));
            PG8_WAIT_L(8); PG8_BAR; PG8_WAIT_L(0); PG8_MMA(0, 0, At, B0); PG8_BAR; PG8_SCHED;
            PG8_LDB(B1, 1, 1); PG8_STAGEB(PG8_SB(1, 0), b3);
            PG8_BAR; PG8_WAIT_L(0); PG8_MMA(0, 1, At, B1); PG8_BAR;
            PG8_LDA(At, 1, 1); PG8_STAGE2(PG8_SA(1, 0), a3, VN0(0), VN0(1));
            PG8_BAR; PG8_WAIT_L(0); PG8_MMA(1, 0, At, B0); PG8_BAR; PG8_SCHED;
            PG8_STAGEB(PG8_SB(1, 1), b3 + hstepB);
            PG8_WAIT_V(6); PG8_BAR; PG8_MMA(1, 1, At, B1); PG8_BAR;
        }
        {
            int epm = cur.pm, epn = cur.pn; asm volatile("" : "+s"(epm), "+s"(epn));
            unsigned eln = (unsigned)lane; asm volatile("" : "+v"(eln)); const int efr = (int)(eln & 15u), efq = (int)(eln >> 4);
            constexpr bool PM = Epi::PERM;
#define PG8_COL(bj, n) (epn * BM + (bj) * HALF + wc * 32 + (PM ? 8 * efq + 4 * (n) : (n) * 16 + 4 * efq))
            f32x4 cv[2][2];
#pragma unroll
            for (int bj = 0; bj < 2; ++bj)
#pragma unroll
                for (int n = 0; n < 2; ++n) { if constexpr (Epi::COLVEC) cv[bj][n] = E.colvec(epm * BM, PG8_COL(bj, n)); else cv[bj][n] = (f32x4){0.f, 0.f, 0.f, 0.f}; }
            if constexpr (Epi::COLVEC) asm volatile("" : "+v"(cv[0][0]), "+v"(cv[0][1]), "+v"(cv[1][0]), "+v"(cv[1][1]) :: "memory");
#pragma unroll
            for (int ai = 0; ai < 2; ++ai) {
                f32x4 bs[4][2][2];
                if constexpr (Epi::BASE) {
#pragma unroll
                    for (int m = 0; m < 4; ++m)
#pragma unroll
                        for (int bj = 0; bj < 2; ++bj) {
                            const int row = epm * BM + ai * HALF + wr * 64 + m * 16 + efr;
                            if constexpr (PM) E.base8(row, PG8_COL(bj, 0), bs[m][bj][0], bs[m][bj][1]);
                            else {
#pragma unroll
                                for (int n = 0; n < 2; ++n) bs[m][bj][n] = E.base(row, PG8_COL(bj, n));
                            }
                        }
                    asm volatile("" : "+v"(bs[0][0][0]), "+v"(bs[0][0][1]), "+v"(bs[0][1][0]), "+v"(bs[0][1][1]), "+v"(bs[1][0][0]), "+v"(bs[1][0][1]), "+v"(bs[1][1][0]), "+v"(bs[1][1][1]),
                                      "+v"(bs[2][0][0]), "+v"(bs[2][0][1]), "+v"(bs[2][1][0]), "+v"(bs[2][1][1]), "+v"(bs[3][0][0]), "+v"(bs[3][0][1]), "+v"(bs[3][1][0]), "+v"(bs[3][1][1]) :: "memory");
                }
#pragma unroll
                for (int m = 0; m < 4; ++m) {
                    const int row = epm * BM + ai * HALF + wr * 64 + m * 16 + efr;
#pragma unroll
                    for (int bj = 0; bj < 2; ++bj) {
                        if constexpr (Epi::PAIR) E.store_pair(row, epn * (BM / 2) + bj * (HALF / 2) + wc * 16 + 4 * efq, acc[ai][bj][m][0], acc[ai][bj][m][1]);
                        else if constexpr (PM) {
                            f32x4 b0 = (f32x4){0.f, 0.f, 0.f, 0.f}, b1 = b0; if constexpr (Epi::BASE) { b0 = bs[m][bj][0]; b1 = bs[m][bj][1]; }
                            E.store8(row, PG8_COL(bj, 0), acc[ai][bj][m][0], acc[ai][bj][m][1], cv[bj][0], cv[bj][1], b0, b1);
                        } else {
#pragma unroll
                            for (int n = 0; n < 2; ++n) { f32x4 bb = (f32x4){0.f, 0.f, 0.f, 0.f}; if constexpr (Epi::BASE) bb = bs[m][bj][n]; E.store(row, PG8_COL(bj, n), acc[ai][bj][m][n], cv[bj][n], bb); }
                        }
                    }
                }
            }
#undef PG8_COL
        }
        if (!has_next) break;
#pragma unroll
        for (int a = 0; a < 2; ++a)
#pragma unroll
            for (int b = 0; b < 2; ++b)
#pragma unroll
                for (int m = 0; m < 4; ++m)
#pragma unroll
                    for (int n = 0; n < 2; ++n) { float zf; asm volatile("v_mov_b32 %0, 0" : "=v"(zf)); acc[a][b][m][n] = (f32x4){zf, zf, zf, zf}; }
        cur = nxt; cB = nB; cA = nA; ++ui;
    }
    PG8_WAIT_V(0);
    if (wr == 0) PG8_BAR;
    PG8_BAR;
#undef PG8_GATHER_OFFS
#undef VC0
#undef VC1
#undef VN0
#undef VN1
#undef PG8_SA
#undef PG8_SB
#undef PG8_STAGE2
#undef PG8_STAGEB
#undef PG8_LDA
#undef PG8_LDB
#undef PG8_MMA
#undef PG8_WAIT_V
#undef PG8_WAIT_L
#undef PG8_BAR
#undef PG8_SCHED
}
}

template <class Epi>
__device__ __forceinline__ void gemm_fast(Frame& F, const GAS bf16* A, int lda, const GAS bf16* Bt, int ldb, int K, int M, int N, const Epi& E) {
    pg8::OrderPlain S; S.init(M / 256, N / 256, F.G, F.wg);
    pg8::gemm_phase(F.lds, F.tid, A, lda, Bt, ldb, K, S, E);
}
#ifndef FAST_PLAIN
#define FAST_PLAIN 1
#endif
#ifndef FAST_HORNER
#define FAST_HORNER 1
#endif
#ifndef FAST_MOE
#define FAST_MOE 1
#endif

__device__ __forceinline__ void st_bf16x4(GAS bf16* p, f32x4 v) { u32x2 w; w.x = pk2(v.x, v.y); w.y = pk2(v.z, v.w); *(GAS u32x2*)p = w; }
__device__ __forceinline__ f32x4 ld_bf16x4(const GAS bf16* p) { const u32x2 w = *(const GAS u32x2*)p; f32x4 v; v.x = __uint_as_float(w.x << 16); v.y = __uint_as_float(w.x & 0xffff0000u); v.z = __uint_as_float(w.y << 16); v.w = __uint_as_float(w.y & 0xffff0000u); return v; }

__device__ __forceinline__ void st_bf16x8(GAS bf16* p, f32x4 a, f32x4 b) { u32x4 w; w.x = pk2(a.x, a.y); w.y = pk2(a.z, a.w); w.z = pk2(b.x, b.y); w.w = pk2(b.z, b.w); *(GAS u32x4*)p = w; }
struct EpiWin {
    static constexpr bool HORNER = false, PAIR = false, COLVEC = true, BASE = false, PERM = true;
    const GAS float* bias; GAS bf16 *hytl, *hytc, *ret, *ml; GAS float* mlg;
    __device__ __forceinline__ f32x4 colvec(int, int col) const { return *(const GAS f32x4*)(bias + col); }
    __device__ __forceinline__ void store8(int row, int col, f32x4 v0, f32x4 v1, f32x4 c0, f32x4 c1, f32x4, f32x4) const {
        v0 += c0; v1 += c1;
        if (col < 1152) {
            const float v[8] = {v0.x, v0.y, v0.z, v0.w, v1.x, v1.y, v1.z, v1.w};
            if (row < TOKL) { const int b = row >> 11, t = row & 2047; GAS bf16* d = hytl + ((size_t)(b * 1152 + col)) * 2048 + t;
#pragma unroll
                for (int j = 0; j < 8; ++j) d[2048 * j] = (bf16)f2bf(v[j]); }
            else { const int r = row - TOKL, b = r >> 8, t = r & 255; GAS bf16* d = hytc + ((size_t)(b * 1152 + col)) * 256 + t;
#pragma unroll
                for (int j = 0; j < 8; ++j) d[256 * j] = (bf16)f2bf(v[j]); }
        } else if (col < 1168) { *(GAS f32x4*)(mlg + (size_t)row * 16 + (col - 1152)) = v0; *(GAS f32x4*)(mlg + (size_t)row * 16 + (col - 1152) + 4) = v1; }
        else if (col < 1280) { }
        else if (col < 2816) st_bf16x8(ret + (size_t)row * 1536 + (col - 1280), v0, v1);
        else st_bf16x8(ml + (size_t)row * 1024 + (col - 2816), v0, v1);
    }
};
struct EpiGate {
    static constexpr bool HORNER = false, PAIR = false, COLVEC = true, BASE = false, PERM = true;
    const GAS float* bias; GAS bf16* gates;
    __device__ __forceinline__ f32x4 colvec(int, int col) const { return *(const GAS f32x4*)(bias + col); }
    __device__ __forceinline__ void store8(int row, int col, f32x4 v0, f32x4 v1, f32x4 c0, f32x4 c1, f32x4, f32x4) const {
        v0 += c0; v1 += c1;
        f32x4 g0, g1;
        g0.x = fmaxf(sigmoidf_(v0.x), 1e-20f); g0.y = fmaxf(sigmoidf_(v0.y), 1e-20f); g0.z = fmaxf(sigmoidf_(v0.z), 1e-20f); g0.w = fmaxf(sigmoidf_(v0.w), 1e-20f);
        g1.x = fmaxf(sigmoidf_(v1.x), 1e-20f); g1.y = fmaxf(sigmoidf_(v1.y), 1e-20f); g1.z = fmaxf(sigmoidf_(v1.z), 1e-20f); g1.w = fmaxf(sigmoidf_(v1.w), 1e-20f);
        st_bf16x8(gates + (size_t)row * NGATE + col, g0, g1);
    }
};
struct EpiUp {
    static constexpr bool HORNER = true, PAIR = false, COLVEC = false, BASE = true, PERM = true;
    const GAS bf16* gates; GAS bf16* acc_out;
    __device__ __forceinline__ u32x4 gate8(int which, int row, int col) const { return *(const GAS u32x4*)(gates + (size_t)row * NGATE + which * 1024 + col); }
    __device__ __forceinline__ void base8(int row, int col, f32x4& b0, f32x4& b1) const {
        const u32x4 w = *(const GAS u32x4*)(gates + (size_t)row * NGATE + 2048 + col);
        b0.x = __uint_as_float(w.x << 16); b0.y = __uint_as_float(w.x & 0xffff0000u); b0.z = __uint_as_float(w.y << 16); b0.w = __uint_as_float(w.y & 0xffff0000u);
        b1.x = __uint_as_float(w.z << 16); b1.y = __uint_as_float(w.z & 0xffff0000u); b1.z = __uint_as_float(w.w << 16); b1.w = __uint_as_float(w.w & 0xffff0000u);
    }
    __device__ __forceinline__ void store8(int row, int col, f32x4 v0, f32x4 v1, f32x4, f32x4, f32x4 g0, f32x4 g1) const { st_bf16x8(acc_out + (size_t)row * D + col, v0 * g0, v1 * g1); }
};
struct EpiResid {
    static constexpr bool HORNER = false, PAIR = false, COLVEC = true, BASE = true, PERM = false;
    const GAS float *xin_l, *xin_c; GAS float *xout_l, *xout_c; const GAS float* modbase; int which;
    __device__ __forceinline__ f32x4 colvec(int row0, int col) const { const int r = row0 < TOKL ? (row0 >> 11) : 16; return *(const GAS f32x4*)(modbase + ((size_t)r * 6 + which) * 1024 + col); }
    __device__ __forceinline__ f32x4 base(int row, int col) const { return row < TOKL ? *(const GAS f32x4*)(xin_l + (size_t)row * D + col) : *(const GAS f32x4*)(xin_c + (size_t)(row - TOKL) * D + col); }
    __device__ __forceinline__ void store(int row, int col, f32x4 v, f32x4 m, f32x4 x) const {
        if (row < TOKL) *(GAS f32x4*)(xout_l + (size_t)row * D + col) = x + m * v;
        else *(GAS f32x4*)(xout_c + (size_t)(row - TOKL) * D + col) = x + m * v;
    }
};
struct EpiSwiglu {
    static constexpr bool HORNER = false, PAIR = true, COLVEC = false, BASE = false, PERM = false;
    GAS bf16* act; int row_off;
    __device__ __forceinline__ void store_pair(int row, int col, f32x4 a, f32x4 b) const {
        f32x4 o; o.x = siluf_(a.x) * b.x; o.y = siluf_(a.y) * b.y; o.z = siluf_(a.z) * b.z; o.w = siluf_(a.w) * b.w;
        st_bf16x4(act + (size_t)(row - row_off) * DFF + col, o);
    }
    __device__ __forceinline__ void store(int, int, f32x4, f32x4, f32x4) const {}
};
struct EpiBf16Out {
    static constexpr bool HORNER = false, PAIR = false, COLVEC = false, BASE = false, PERM = true;
    GAS bf16* out; int ld; int row_add;
    __device__ __forceinline__ void store8(int row, int col, f32x4 v0, f32x4 v1, f32x4, f32x4, f32x4, f32x4) const { st_bf16x8(out + (size_t)(row + row_add) * ld + col, v0, v1); }
};

constexpr int ZPITCH_L = (LL + 8) * 2, ZPITCH_C = (LC + 8) * 2;
template <int L>
__device__ __forceinline__ float conv3_at(const GAS bf16* base  , int t, float w0, float w1, float w2) {
    const float a = t > 0 ? bf2f(base[t - 1]) : 0.f, b = bf2f(base[t]), c = t < L - 1 ? bf2f(base[t + 1]) : 0.f;
    return w0 * a + w1 * b + w2 * c;
}
template <int L>
__device__ __forceinline__ void hyena_unit_naive(Frame& F, int layer, int c, const GAS bf16* hyt  , const GAS bf16* ft  , GAS bf16* yht  ) {
    constexpr int ZP = (L + 8) * 2;
    constexpr int PER = L / 32;
    constexpr int SUB = 8;
    LAS unsigned char* zimg0 = F.lds;
    LAS unsigned char* zimg1 = F.lds + 16 * ZP;
    LAS bf16* tf = (LAS bf16*)(F.lds + 32 * ZP);
    const GAS float* cw = inp(F, I_HYCONV) + layer * 3 * 1152;
    const GAS float* skip = inp(F, I_HYSKIP) + layer * 2 * 384;
    __syncthreads();
    {
        const int b = F.tid >> 5, seg = F.tid & 31; const GAS bf16* src = hyt + ((size_t)(b * 1152 + c)) * L;
        const float w0 = cw[c], w1 = cw[1152 + c], w2 = cw[2304 + c];
#pragma unroll 2
        for (int j = 0; j < PER; ++j) { const int t = seg * PER + j; *(LAS bf16*)(zimg0 + b * ZP + t * 2) = (bf16)f2bf(conv3_at<L>(src, t, w0, w1, w2)); }
    }
#pragma unroll 1
    for (int o = 0; o < 2; ++o) {
        LAS unsigned char* zs = o == 0 ? zimg0 : zimg1;
        LAS unsigned char* zd = o == 0 ? zimg1 : zimg0;
        const GAS bf16* fsrc = ft + ((size_t)(o * 384 + c)) * (2 * L);
        for (int i = F.tid; i < 2 * L; i += NTHR) tf[i] = i == 0 ? (bf16)0 : fsrc[i];
        __syncthreads();
        const int b = F.tid & 15, tg = F.tid >> 4;
        const int gcol = (o == 0 ? 384 : 768) + c;
        const GAS bf16* gsrc = hyt + ((size_t)(b * 1152 + gcol)) * L;
        const float w0 = cw[gcol], w1 = cw[1152 + gcol], w2 = cw[2304 + gcol], sk = skip[o * 384 + c];
#pragma unroll 1
        for (int sb = 0; sb < PER / SUB; ++sb) {
            const int t0 = tg * PER + sb * SUB;
            float acc[SUB];
#pragma unroll
            for (int j = 0; j < SUB; ++j) acc[j] = 0.f;
#pragma unroll 1
            for (int s0 = 0; s0 < L; s0 += 8) {
                float z[8];
                { const bf16x8 zz = *(const LAS bf16x8*)(zs + b * ZP + s0 * 2);
#pragma unroll
                  for (int i = 0; i < 8; ++i) z[i] = bf2f((bf16)zz[i]); }
                float win[SUB + 7];
                const int wb = L + s0 - t0 - (SUB - 1);
#pragma unroll
                for (int i = 0; i < SUB + 7; ++i) win[i] = bf2f(tf[wb + i]);
#pragma unroll
                for (int j = 0; j < SUB; ++j)
#pragma unroll
                    for (int i = 0; i < 8; ++i) acc[j] += win[(SUB - 1) - j + i] * z[i];
            }
#pragma unroll
            for (int j = 0; j < SUB; ++j) {
                const int t = t0 + j;
                const float zt = bf2f(*(LAS bf16*)(zs + b * ZP + t * 2));
                const float ov = conv3_at<L>(gsrc, t, w0, w1, w2) * (acc[j] + sk * zt);
                *(LAS bf16*)(zd + b * ZP + t * 2) = (bf16)f2bf(ov);
            }
        }
        __syncthreads();
    }
#pragma unroll 2
    for (int i = F.tid; i < 16 * (L / 8); i += NTHR) {
        const int b = i / (L / 8), ch = i % (L / 8);
        *(GAS u32x4*)(yht + ((size_t)(b * 384 + c)) * L + ch * 8) = *(const LAS u32x4*)(zimg0 + b * ZP + ch * 16);
    }
}

template <int L>
__device__ __forceinline__ void hyena_unit_fast(Frame& F, int layer, int c, const GAS bf16* hyt  , const GAS bf16* ft  , GAS bf16* yht  ) {
    constexpr int ZP = (L + 8) * 2;
    constexpr int PER = L / 32;
    constexpr int I = L / 128;
    constexpr int SPAN = L / 4, NSTEP = L / 32;
    constexpr int CP = (2 * L + 8) * 2;
    LAS unsigned char* zimg = F.lds;
    LAS unsigned char* cpy = F.lds + 16 * ZP;
    const GAS float* cw = inp(F, I_HYCONV) + layer * 3 * 1152;
    const GAS float* skip = inp(F, I_HYSKIP) + layer * 2 * 384;
    const int lane = F.lane, fr = lane & 15, fq = lane >> 4, w = F.wave;
    { unsigned long long a_ = (unsigned long long)hyt, b_ = (unsigned long long)yht; asm volatile("" : "+s"(a_), "+s"(b_)); hyt = (const GAS bf16*)a_; yht = (GAS bf16*)b_; }
    __syncthreads();
    {
        const int b = F.tid >> 5, sg = F.tid & 31, t0 = sg * PER; const GAS bf16* src = hyt + ((size_t)(b * 1152 + c)) * L + t0;
        const float w0 = cw[c], w1 = cw[1152 + c], w2 = cw[2304 + c];
        u32x4 raw[PER / 8];
#pragma unroll
        for (int j = 0; j < PER / 8; ++j) raw[j] = *(const GAS u32x4*)(src + 8 * j);
        float prev = t0 > 0 ? bf2f(src[-1]) : 0.f;
        const float nextv = t0 + PER < L ? bf2f(src[PER]) : 0.f;
#pragma unroll
        for (int j = 0; j < PER / 8; ++j) {
            const unsigned wv[4] = {raw[j].x, raw[j].y, raw[j].z, raw[j].w};
            float x[10]; x[0] = prev;
#pragma unroll
            for (int q = 0; q < 4; ++q) { x[1 + 2 * q] = __uint_as_float(wv[q] << 16); x[2 + 2 * q] = __uint_as_float(wv[q] & 0xffff0000u); }
            if (j + 1 < PER / 8) x[9] = __uint_as_float(raw[(j + 1 < PER / 8) ? j + 1 : j].x << 16); else x[9] = nextv;
            u32x4 o;
            o.x = pk2(w0 * x[0] + w1 * x[1] + w2 * x[2], w0 * x[1] + w1 * x[2] + w2 * x[3]); o.y = pk2(w0 * x[2] + w1 * x[3] + w2 * x[4], w0 * x[3] + w1 * x[4] + w2 * x[5]);
            o.z = pk2(w0 * x[4] + w1 * x[5] + w2 * x[6], w0 * x[5] + w1 * x[6] + w2 * x[7]); o.w = pk2(w0 * x[6] + w1 * x[7] + w2 * x[8], w0 * x[7] + w1 * x[8] + w2 * x[9]);
            *(LAS u32x4*)(zimg + b * ZP + (t0 + 8 * j) * 2) = o;
            prev = x[8];
        }
    }
    const int tbase = SPAN * (w >> 1) + 16 * (w & 1);
    const int flane = L - tbase + 8 * fq - fr;
    const int msh = fr & 7;
    const LAS unsigned char* fbase = cpy + msh * CP + 2 * (flane + msh);
#pragma unroll 1
    for (int o = 0; o < 2; ++o) {
        const GAS bf16* fsrc = ft + ((size_t)(o * 384 + c)) * (2 * L);
        for (int i = F.tid; i < CP / 16; i += NTHR) { u32x4 v = (u32x4){0u, 0u, 0u, 0u}; if (i < 2 * L / 8) v = *(const GAS u32x4*)(fsrc + 8 * i); if (i == 0) v.x &= 0xffff0000u; *(LAS u32x4*)(cpy + 16 * i) = v; }
        __syncthreads();
        for (int task = F.tid; task < 7 * (CP / 16); task += NTHR) {
            const int m = 1 + task / (CP / 16), x8 = task % (CP / 16);
            unsigned short e[8];
#pragma unroll
            for (int i = 0; i < 8; ++i) { const int idx = 8 * x8 - m + i; e[i] = idx >= 0 ? *(const LAS unsigned short*)(cpy + 2 * idx) : (unsigned short)0; }
            u32x4 v; v.x = e[0] | ((unsigned)e[1] << 16); v.y = e[2] | ((unsigned)e[3] << 16); v.z = e[4] | ((unsigned)e[5] << 16); v.w = e[6] | ((unsigned)e[7] << 16);
            *(LAS u32x4*)(cpy + m * CP + 16 * x8) = v;
        }
        __syncthreads();
        f32x4 acc[I];
#pragma unroll
        for (int i = 0; i < I; ++i) acc[i] = (f32x4){0.f, 0.f, 0.f, 0.f};
        bf16x8 ring[I];
#pragma unroll
        for (int i = 1; i < I; ++i) ring[(I - i) % I] = *(const LAS bf16x8*)(fbase - 64 * i);
        bf16x8 nf = *(const LAS bf16x8*)(fbase);
        const LAS unsigned char* zrow = zimg + fr * ZP + 16 * fq;
#pragma unroll 1
        for (int j0 = 0; j0 < NSTEP; j0 += I) {
#pragma unroll
            for (int jj = 0; jj < I; ++jj) {
                const int j = j0 + jj;
                ring[jj] = nf;
                if (j + 1 < NSTEP) nf = *(const LAS bf16x8*)(fbase + 64 * (j + 1));
                const bf16x8 zf = *(const LAS bf16x8*)(zrow + 64 * j);
#pragma unroll
                for (int i = 0; i < I; ++i) acc[i] = __builtin_amdgcn_mfma_f32_16x16x32_bf16(ring[(jj - i + I) % I], zf, acc[i], 0, 0, 0);
            }
        }
        unsigned el_ = (unsigned)lane; asm volatile("" : "+v"(el_)); const int efr = (int)(el_ & 15u), efq = (int)(el_ >> 4);
        const int etb = SPAN * (w >> 1) + 16 * (w & 1);
        const int gcol = (o == 0 ? 384 : 768) + c;
        const GAS bf16* gsrc = hyt + ((size_t)(efr * 1152 + gcol)) * L;
        const float w0 = cw[gcol], w1 = cw[1152 + gcol], w2 = cw[2304 + gcol], sk = skip[o * 384 + c];
        GAS bf16* dst = yht + ((size_t)(efr * 384 + c)) * L;
        constexpr int GI = I < 8 ? I : 8;
#pragma unroll
        for (int i0 = 0; i0 < I; i0 += GI) {
            u32x2 grv[GI]; unsigned short gmv[GI], gpv[GI];
#pragma unroll
            for (int ii = 0; ii < GI; ++ii) {
                const int t = etb + 32 * (i0 + ii) + 4 * efq;
                grv[ii] = *(const GAS u32x2*)(gsrc + t); gmv[ii] = t > 0 ? gsrc[t - 1] : (unsigned short)0; gpv[ii] = t + 4 < L ? gsrc[t + 4] : (unsigned short)0;
            }
            asm volatile("" ::: "memory");
#pragma unroll
            for (int ii = 0; ii < GI; ++ii) {
                const int i = i0 + ii;
                const int t = etb + 32 * i + 4 * efq;
                const u32x2 zr = *(const LAS u32x2*)(zimg + efr * ZP + t * 2);
                const u32x2 gr = grv[ii];
                const float gm = bf2f(gmv[ii]), gp = bf2f(gpv[ii]);
                const float g0 = __uint_as_float(gr.x << 16), g1 = __uint_as_float(gr.x & 0xffff0000u), g2 = __uint_as_float(gr.y << 16), g3 = __uint_as_float(gr.y & 0xffff0000u);
                const float z0 = __uint_as_float(zr.x << 16), z1 = __uint_as_float(zr.x & 0xffff0000u), z2 = __uint_as_float(zr.y << 16), z3 = __uint_as_float(zr.y & 0xffff0000u);
                const float o0 = (w0 * gm + w1 * g0 + w2 * g1) * (acc[i].x + sk * z0), o1 = (w0 * g0 + w1 * g1 + w2 * g2) * (acc[i].y + sk * z1);
                const float o2 = (w0 * g1 + w1 * g2 + w2 * g3) * (acc[i].z + sk * z2), o3 = (w0 * g2 + w1 * g3 + w2 * gp) * (acc[i].w + sk * z3);
                acc[i] = (f32x4){o0, o1, o2, o3};
            }
        }
        __syncthreads();
#pragma unroll
        for (int i = 0; i < I; ++i) {
            const int t = etb + 32 * i + 4 * efq;
            u32x2 ov; ov.x = pk2(acc[i].x, acc[i].y); ov.y = pk2(acc[i].z, acc[i].w);
            if (o == 0) *(LAS u32x2*)(zimg + efr * ZP + t * 2) = ov;
            else *(GAS u32x2*)(dst + t) = ov;
        }
    }
}

__device__ __forceinline__ void chain_naive(Frame& F, int layer, int chain) {
    const int lane = F.lane;
    const bool is_ret = chain < 192;
    int b, h, dir;
    if (is_ret) { b = chain / 12; const int r = chain % 12; h = r >> 1; dir = r & 1; }
    else { const int i = chain - 192; b = i >> 3; h = (i & 7) >> 1; dir = i & 1; }
    const GAS bf16* RET = WSP(const bf16, WS_RET); const GAS bf16* ML = WSP(const bf16, WS_ML); const GAS float* MLG = WSP(const float, WS_MLG);
    const GAS float* rope = WSP(const float, WS_ROPE);
    GAS bf16* Y = WSP(bf16, WS_Y); GAS bf16* OB = WSP(bf16, WS_OB);
    float gam = 0.f;
    if (is_ret) gam = sigmoidf_(inp(F, I_RETDECAY)[layer * 12 + dir * 6 + h]);
    const GAS float* mlc = inp(F, I_MLCONV) + layer * 3 * 512;
    const float bi = is_ret ? 0.f : inp(F, I_MLGB)[layer * 16 + dir * 8 + h], bfg = is_ret ? 0.f : inp(F, I_MLGB)[layer * 16 + dir * 8 + 4 + h];
    const float qw0 = mlc[h * 64 + lane], qw1 = mlc[512 + h * 64 + lane], qw2 = mlc[1024 + h * 64 + lane];
    const float kw0 = mlc[256 + h * 64 + lane], kw1 = mlc[512 + 256 + h * 64 + lane], kw2 = mlc[1024 + 256 + h * 64 + lane];
    float S[64];
#pragma unroll
    for (int d = 0; d < 64; ++d) S[d] = 0.f;
    float nv = 0.f;
    for (int step = 0; step < LC + LL; ++step) {
        int row, tpos, L; bool lat;
        if (step < LC) { tpos = dir ? (LC - 1 - step) : step; row = TOKL + b * LC + tpos; L = LC; lat = false; }
        else { const int s2 = step - LC; tpos = dir ? (LL - 1 - s2) : s2; row = b * LL + tpos; L = LL; lat = true; }
        float q, k, v, Fm, Im;
        if (is_ret) {
            const GAS bf16* base = RET + (size_t)row * 1536;
            float qs = bf2f(base[h * 64 + lane]), ks = bf2f(base[384 + h * 64 + lane]);
            v = bf2f(base[768 + h * 64 + lane]);
            if (lat) {
                const float qp = bf2f(base[h * 64 + (lane ^ 16)]), kp = bf2f(base[384 + h * 64 + (lane ^ 16)]);
                const int half = lane >> 5, ii = lane & 15, hi = (lane >> 4) & 1;
                const float cs = rope[tpos * 64 + half * 32 + ii], sn = rope[tpos * 64 + half * 32 + 16 + ii];
                q = hi == 0 ? qs * cs - qp * sn : qp * sn + qs * cs;
                k = hi == 0 ? ks * cs - kp * sn : kp * sn + ks * cs;
            } else { q = qs; k = ks; }
            q *= 0.125f; Fm = gam; Im = 1.f;
        } else {
            const GAS bf16* base = ML + (size_t)row * 1024;
            const float q0 = tpos > 0 ? bf2f(base[-1024 + h * 64 + lane]) : 0.f, q1 = bf2f(base[h * 64 + lane]), q2 = tpos < L - 1 ? bf2f(base[1024 + h * 64 + lane]) : 0.f;
            const float k0 = tpos > 0 ? bf2f(base[-1024 + 256 + h * 64 + lane]) : 0.f, k1 = bf2f(base[256 + h * 64 + lane]), k2 = tpos < L - 1 ? bf2f(base[1024 + 256 + h * 64 + lane]) : 0.f;
            q = siluf_(qw0 * q0 + qw1 * q1 + qw2 * q2);
            k = siluf_(kw0 * k0 + kw1 * k1 + kw2 * k2) * 0.125f;
            v = bf2f(base[512 + h * 64 + lane]);
            const float ig = MLG[(size_t)row * 16 + dir * 8 + h] + bi, fg = MLG[(size_t)row * 16 + dir * 8 + 4 + h] + bfg;
            Fm = sigmoidf_(fg); Im = __expf(ig);
        }
        float num = 0.f;
        const float iv = Im * v;
#pragma unroll
        for (int d = 0; d < 64; ++d) {
            const float kd = __int_as_float(__builtin_amdgcn_readlane(__float_as_int(k), d));
            const float qd = __int_as_float(__builtin_amdgcn_readlane(__float_as_int(q), d));
            S[d] = Fm * S[d] + kd * iv;
            num += qd * S[d];
        }
        float o = num;
        if (!is_ret) { nv = Fm * nv + Im * k; const float den = wave_sum(q * nv); o = num / fmaxf(fabsf(den), 1.f); }
        const int cof = is_ret ? (h * 64 + lane) : (384 + h * 64 + lane);
        if (dir == 0) Y[(size_t)row * D + 384 + cof] = (bf16)f2bf(o);
        else OB[(size_t)row * 640 + cof] = (bf16)f2bf(o);
    }
}

#ifndef REP_CH
#define REP_CH 1
#endif
constexpr int CH_PITCH = 144;
constexpr int CH_IMG = 64 * CH_PITCH;
constexpr int CH_WAVE_LDS = 3 * CH_IMG + 1024 + 512;
__device__ __forceinline__ void ds_tr16x8(unsigned addr, u32x2 (&lo)[4], u32x2 (&hi)[4]) {
    asm volatile("ds_read_b64_tr_b16 %0, %8\n\tds_read_b64_tr_b16 %1, %8 offset:32\n\tds_read_b64_tr_b16 %2, %8 offset:64\n\tds_read_b64_tr_b16 %3, %8 offset:96\n\t"
                 "ds_read_b64_tr_b16 %4, %8 offset:2304\n\tds_read_b64_tr_b16 %5, %8 offset:2336\n\tds_read_b64_tr_b16 %6, %8 offset:2368\n\tds_read_b64_tr_b16 %7, %8 offset:2400\n\t"
                 "s_waitcnt lgkmcnt(0)"
                 : "=&v"(lo[0]), "=&v"(lo[1]), "=&v"(lo[2]), "=&v"(lo[3]), "=&v"(hi[0]), "=&v"(hi[1]), "=&v"(hi[2]), "=&v"(hi[3]) : "v"(addr) : "memory");
}
static_assert(16 * CH_PITCH == 2304, "ds_tr16x8 offsets");
__device__ __forceinline__ void ds_tr16x4(unsigned addr, u32x2 (&lo)[2], u32x2 (&hi)[2]) {
    asm volatile("ds_read_b64_tr_b16 %0, %4\n\tds_read_b64_tr_b16 %1, %4 offset:32\n\tds_read_b64_tr_b16 %2, %4 offset:2304\n\tds_read_b64_tr_b16 %3, %4 offset:2336\n\ts_waitcnt lgkmcnt(0)"
                 : "=&v"(lo[0]), "=&v"(lo[1]), "=&v"(hi[0]), "=&v"(hi[1]) : "v"(addr) : "memory");
}
__device__ __forceinline__ float log_sigmoid_(float x) { return fminf(x, 0.f) - log1pf(__expf(-fabsf(x))); }
__device__ __forceinline__ bf16x8 mk_frag(u32x2 lo, u32x2 hi) { u32x4 w; w.x = lo.x; w.y = lo.y; w.z = hi.x; w.w = hi.y; return __builtin_bit_cast(bf16x8, w); }

template <bool IS_ML>
__device__ __forceinline__ void chain_fast(Frame& F, int layer, int b, int h, int dir, LAS unsigned char* img, int hf) {
    constexpr int NET = 2;
    const int lane = F.lane, fr = lane & 15, fq = lane >> 4;
    LAS unsigned char* Qi = img; LAS unsigned char* Ki = img + CH_IMG; LAS unsigned char* Vi = img + 2 * CH_IMG;
    const unsigned qa = (unsigned)(size_t)Qi, ka = (unsigned)(size_t)Ki, va = (unsigned)(size_t)Vi;
    const GAS bf16* RET = WSP(const bf16, WS_RET); const GAS bf16* ML = WSP(const bf16, WS_ML); const GAS float* MLG = WSP(const float, WS_MLG);
    const GAS float* rope = WSP(const float, WS_ROPE);
    GAS bf16* Y = WSP(bf16, WS_Y); GAS bf16* OB = WSP(bf16, WS_OB);
    float lgam = 0.f, bi_ = 0.f, bf_ = 0.f;
    if (!IS_ML) lgam = log_sigmoid_(inp(F, I_RETDECAY)[layer * 12 + dir * 6 + h]);
    else { bi_ = inp(F, I_MLGB)[layer * 16 + dir * 8 + h]; bf_ = inp(F, I_MLGB)[layer * 16 + dir * 8 + 4 + h]; }
    const GAS float* mlc = inp(F, I_MLCONV) + layer * 3 * 512;
    f32x4 C[4][NET];
#pragma unroll
    for (int dt = 0; dt < 4; ++dt)
#pragma unroll
        for (int et = 0; et < NET; ++et) C[dt][et] = (f32x4){0.f, 0.f, 0.f, 0.f};
    const int cq = lane & 7, pr0 = lane >> 3;
    LAS float* nvec = (LAS float*)(img + 3 * CH_IMG + 1024 + 256 * hf);
    if (IS_ML) nvec[lane] = 0.f;
    const LAS float* nq = nvec + 4 * fq;
#pragma unroll 1
    for (int step_ = 0; step_ < 36 * REP_CH; ++step_) {
        const int step = step_ % 36;
        if (REP_CH > 1 && step == 0) {
            if (IS_ML) nvec[lane] = 0.f;
#pragma unroll
            for (int dt = 0; dt < 4; ++dt)
#pragma unroll
                for (int et = 0; et < NET; ++et) C[dt][et] = (f32x4){0.f, 0.f, 0.f, 0.f};
        }
        int rowbase, t0, L; bool lat;
        if (step < 4) { const int cc = dir ? 3 - step : step; rowbase = TOKL + b * LC + cc * 64; t0 = cc * 64; L = LC; lat = false; }
        else { const int cc = dir ? 35 - step : step - 4; rowbase = b * LL + cc * 64; t0 = cc * 64; L = LL; lat = true; }
        float g_i = 0.f, g_f = 0.f;
        if (IS_ML) { const int tlg = dir ? 63 - lane : lane; const GAS float* gp = MLG + (size_t)(rowbase + tlg) * 16 + dir * 8 + h; g_i = gp[0]; g_f = gp[4]; }
        if constexpr (!IS_ML) {
#pragma unroll
        for (int i4 = 0; i4 < 4; ++i4) {
            const int i = 4 * hf + i4;
            const int p = pr0 + 8 * i, tl = dir ? 63 - p : p, row = rowbase + tl, tpos = t0 + tl;
            float qv[8], kv[8]; u32x4 vraw;
            {
                const GAS bf16* base = RET + (size_t)row * 1536 + h * 64;
                const u32x4 qr = *(const GAS u32x4*)(base + 8 * cq), kr = *(const GAS u32x4*)(base + 384 + 8 * cq); vraw = *(const GAS u32x4*)(base + 768 + 8 * cq);
                const unsigned qw[4] = {qr.x, qr.y, qr.z, qr.w}, kw[4] = {kr.x, kr.y, kr.z, kr.w};
#pragma unroll
                for (int j = 0; j < 4; ++j) { qv[2 * j] = __uint_as_float(qw[j] << 16); qv[2 * j + 1] = __uint_as_float(qw[j] & 0xffff0000u); kv[2 * j] = __uint_as_float(kw[j] << 16); kv[2 * j + 1] = __uint_as_float(kw[j] & 0xffff0000u); }
                if (lat) {
                    const u32x4 qpr = *(const GAS u32x4*)(base + 8 * (cq ^ 2)), kpr = *(const GAS u32x4*)(base + 384 + 8 * (cq ^ 2));
                    const unsigned qpw[4] = {qpr.x, qpr.y, qpr.z, qpr.w}, kpw[4] = {kpr.x, kpr.y, kpr.z, kpr.w};
                    const int half = cq >> 2, hi = (cq >> 1) & 1, i0 = 8 * (cq & 1);
                    const GAS float* rp = rope + tpos * 64 + half * 32 + i0;
                    const f32x4 c0 = *(const GAS f32x4*)(rp), c1 = *(const GAS f32x4*)(rp + 4), s0 = *(const GAS f32x4*)(rp + 16), s1 = *(const GAS f32x4*)(rp + 20);
                    const float cs[8] = {c0.x, c0.y, c0.z, c0.w, c1.x, c1.y, c1.z, c1.w}, sn[8] = {s0.x, s0.y, s0.z, s0.w, s1.x, s1.y, s1.z, s1.w};
#pragma unroll
                    for (int j = 0; j < 8; ++j) {
                        const float qp = (j & 1) ? __uint_as_float(qpw[j >> 1] & 0xffff0000u) : __uint_as_float(qpw[j >> 1] << 16);
                        const float kp = (j & 1) ? __uint_as_float(kpw[j >> 1] & 0xffff0000u) : __uint_as_float(kpw[j >> 1] << 16);
                        qv[j] = hi ? qp * sn[j] + qv[j] * cs[j] : qv[j] * cs[j] - qp * sn[j];
                        kv[j] = hi ? kp * sn[j] + kv[j] * cs[j] : kv[j] * cs[j] - kp * sn[j];
                    }
                }
#pragma unroll
                for (int j = 0; j < 8; ++j) qv[j] *= 0.125f;
            }
            u32x4 qo, ko; qo.x = pk2(qv[0], qv[1]); qo.y = pk2(qv[2], qv[3]); qo.z = pk2(qv[4], qv[5]); qo.w = pk2(qv[6], qv[7]);
            ko.x = pk2(kv[0], kv[1]); ko.y = pk2(kv[2], kv[3]); ko.z = pk2(kv[4], kv[5]); ko.w = pk2(kv[6], kv[7]);
            *(LAS u32x4*)(Qi + p * CH_PITCH + 16 * cq) = qo; *(LAS u32x4*)(Ki + p * CH_PITCH + 16 * cq) = ko; *(LAS u32x4*)(Vi + p * CH_PITCH + 16 * cq) = vraw;
        }
        } else {
            const GAS float* wq = mlc + h * 64 + 8 * cq;
            u32x4 rr[2][3][4], vr[4];
#pragma unroll
            for (int i4 = 0; i4 < 4; ++i4) {
                const int p = pr0 + 8 * (4 * hf + i4), tl = dir ? 63 - p : p, row = rowbase + tl, tpos = t0 + tl;
                const GAS bf16* bb = ML + (size_t)row * 1024 + h * 64 + 8 * cq;
                const u32x4 z4 = (u32x4){0u, 0u, 0u, 0u};
#pragma unroll
                for (int qk = 0; qk < 2; ++qk) {
                    rr[qk][1][i4] = *(const GAS u32x4*)(bb + 256 * qk);
                    rr[qk][0][i4] = tpos > 0 ? *(const GAS u32x4*)(bb + 256 * qk - 1024) : z4;
                    rr[qk][2][i4] = tpos < L - 1 ? *(const GAS u32x4*)(bb + 256 * qk + 1024) : z4;
                }
                vr[i4] = *(const GAS u32x4*)(bb + 512);
            }
#pragma unroll
            for (int qk = 0; qk < 2; ++qk) {
                f32x4 wt[3][2];
#pragma unroll
                for (int tp = 0; tp < 3; ++tp) { wt[tp][0] = *(const GAS f32x4*)(wq + 256 * qk + 512 * tp); wt[tp][1] = *(const GAS f32x4*)(wq + 256 * qk + 512 * tp + 4); }
#pragma unroll
                for (int i4 = 0; i4 < 4; ++i4) {
                    const int p = pr0 + 8 * (4 * hf + i4);
                    const unsigned a0[4] = {rr[qk][0][i4].x, rr[qk][0][i4].y, rr[qk][0][i4].z, rr[qk][0][i4].w}, a1[4] = {rr[qk][1][i4].x, rr[qk][1][i4].y, rr[qk][1][i4].z, rr[qk][1][i4].w},
                                   a2[4] = {rr[qk][2][i4].x, rr[qk][2][i4].y, rr[qk][2][i4].z, rr[qk][2][i4].w};
                    float ov[8];
#pragma unroll
                    for (int j = 0; j < 8; ++j) {
                        const float x0 = (j & 1) ? __uint_as_float(a0[j >> 1] & 0xffff0000u) : __uint_as_float(a0[j >> 1] << 16);
                        const float x1 = (j & 1) ? __uint_as_float(a1[j >> 1] & 0xffff0000u) : __uint_as_float(a1[j >> 1] << 16);
                        const float x2 = (j & 1) ? __uint_as_float(a2[j >> 1] & 0xffff0000u) : __uint_as_float(a2[j >> 1] << 16);
                        const float r = siluf_(wt[0][j >> 2][j & 3] * x0 + wt[1][j >> 2][j & 3] * x1 + wt[2][j >> 2][j & 3] * x2);
                        ov[j] = qk == 0 ? r : r * 0.125f;
                    }
                    u32x4 o; o.x = pk2(ov[0], ov[1]); o.y = pk2(ov[2], ov[3]); o.z = pk2(ov[4], ov[5]); o.w = pk2(ov[6], ov[7]);
                    if (qk == 0) *(LAS u32x4*)(Qi + p * CH_PITCH + 16 * cq) = o;
                    else { *(LAS u32x4*)(Ki + p * CH_PITCH + 16 * cq) = o; *(LAS u32x4*)(Vi + p * CH_PITCH + 16 * cq) = vr[i4]; }
                }
            }
        }
        __builtin_amdgcn_sched_barrier(0);
        float f_p, i_p;
        if (!IS_ML) { f_p = lgam; i_p = 0.f; }
        else { i_p = g_i + bi_; f_p = log_sigmoid_(g_f + bf_); }
        float bsum = f_p;
#pragma unroll
        for (int o = 1; o < 64; o <<= 1) { const float t = lane_read(bsum, lane >= o ? lane - o : lane); if (lane >= o) bsum += t; }
        LAS float* gv = (LAS float*)(img + 3 * CH_IMG);
        const float b63 = __int_as_float(__builtin_amdgcn_readlane(__float_as_int(bsum), 63));
        const float adec = __expf(b63);
        if (hf == 0) { gv[lane] = bsum; gv[64 + lane] = bsum - i_p; gv[128 + lane] = __expf(bsum); gv[192 + lane] = __expf(b63 - (bsum - i_p)); }
        asm volatile("s_waitcnt lgkmcnt(0)" ::: "memory");
        __syncthreads();
        const LAS float* gq = gv + 4 * fq;
        const bf16x8 ones = (fr == 0) ? (bf16x8){0x3F80, 0x3F80, 0x3F80, 0x3F80, 0x3F80, 0x3F80, 0x3F80, 0x3F80} : (bf16x8){0, 0, 0, 0, 0, 0, 0, 0};
        const int tr_q = fr >> 2, tr_p = fr & 3;
#pragma unroll 1
        for (int pt = 0; pt < 4; ++pt) {
            f32x4 ST[4];
            bf16x8 qn[2];
#pragma unroll
            for (int kk = 0; kk < 2; ++kk) qn[kk] = *(const LAS bf16x8*)(Qi + (16 * pt + fr) * CH_PITCH + (32 * kk + 8 * fq) * 2);
#pragma unroll
            for (int st = 0; st < 4; ++st) {
                ST[st] = (f32x4){0.f, 0.f, 0.f, 0.f};
                if (st <= pt) {
#pragma unroll
                    for (int kk = 0; kk < 2; ++kk) { const bf16x8 kf = *(const LAS bf16x8*)(Ki + (16 * st + fr) * CH_PITCH + (32 * kk + 8 * fq) * 2); ST[st] = __builtin_amdgcn_mfma_f32_16x16x32_bf16(kf, qn[kk], ST[st], 0, 0, 0); }
                }
            }
            const float bp = gv[16 * pt + fr];
#pragma unroll
            for (int st = 0; st < 4; ++st) {
                if (st <= pt) {
                    const f32x4 bis = *(const LAS f32x4*)(gq + 64 + 16 * st);
#pragma unroll
                    for (int j = 0; j < 4; ++j) { const int sidx = 16 * st + 4 * fq + j; const float w = (sidx <= 16 * pt + fr) ? __expf(bp - bis[j]) : 0.f; ST[st][j] *= w; }
                }
            }
            __builtin_amdgcn_sched_barrier(0);
            f32x4 acc[NET], accd = (f32x4){0.f, 0.f, 0.f, 0.f};
#pragma unroll
            for (int et = 0; et < NET; ++et) acc[et] = (f32x4){0.f, 0.f, 0.f, 0.f};
#pragma unroll
            for (int kk = 0; kk < 2; ++kk) {
                const u32x2 lo = *(const LAS u32x2*)(Qi + (16 * pt + fr) * CH_PITCH + (32 * kk + 4 * fq) * 2), hi = *(const LAS u32x2*)(Qi + (16 * pt + fr) * CH_PITCH + (32 * kk + 16 + 4 * fq) * 2);
                const bf16x8 qs = mk_frag(lo, hi);
#pragma unroll
                for (int et = 0; et < NET; ++et) {
                    u32x4 w; w.x = pk2(C[2 * kk][et].x, C[2 * kk][et].y); w.y = pk2(C[2 * kk][et].z, C[2 * kk][et].w); w.z = pk2(C[2 * kk + 1][et].x, C[2 * kk + 1][et].y); w.w = pk2(C[2 * kk + 1][et].z, C[2 * kk + 1][et].w);
                    acc[et] = __builtin_amdgcn_mfma_f32_16x16x32_bf16(qs, __builtin_bit_cast(bf16x8, w), acc[et], 0, 0, 0);
                }
                if (IS_ML) {
                    const f32x4 n0 = *(const LAS f32x4*)(nq + 32 * kk), n1 = *(const LAS f32x4*)(nq + 32 * kk + 16);
                    u32x4 w; w.x = pk2(n0.x, n0.y); w.y = pk2(n0.z, n0.w); w.z = pk2(n1.x, n1.y); w.w = pk2(n1.z, n1.w);
                    if (fr != 0) w = (u32x4){0u, 0u, 0u, 0u};
                    accd = __builtin_amdgcn_mfma_f32_16x16x32_bf16(qs, __builtin_bit_cast(bf16x8, w), accd, 0, 0, 0);
                }
            }
            { const f32x4 ap = *(const LAS f32x4*)(gq + 128 + 16 * pt);
#pragma unroll
              for (int j = 0; j < 4; ++j) {
#pragma unroll
                for (int et = 0; et < NET; ++et) acc[et][j] *= ap[j];
                accd[j] *= ap[j]; } }
            __builtin_amdgcn_sched_barrier(0);
#pragma unroll
            for (int kk = 0; kk < 2; ++kk) {
                if (2 * kk <= pt) {
                    u32x4 w; w.x = pk2(ST[2 * kk].x, ST[2 * kk].y); w.y = pk2(ST[2 * kk].z, ST[2 * kk].w); w.z = pk2(ST[2 * kk + 1].x, ST[2 * kk + 1].y); w.w = pk2(ST[2 * kk + 1].z, ST[2 * kk + 1].w);
                    const bf16x8 pf = __builtin_bit_cast(bf16x8, w);
                    u32x2 vlo[2], vhi[2];
                    ds_tr16x4(va + (32 * kk + 4 * fq + tr_q) * CH_PITCH + 8 * tr_p + 64 * hf, vlo, vhi);
#pragma unroll
                    for (int et = 0; et < NET; ++et) acc[et] = __builtin_amdgcn_mfma_f32_16x16x32_bf16(pf, mk_frag(vlo[et], vhi[et]), acc[et], 0, 0, 0);
                    if (IS_ML) accd = __builtin_amdgcn_mfma_f32_16x16x32_bf16(pf, ones, accd, 0, 0, 0);
                }
            }
            __builtin_amdgcn_sched_barrier(0);
#pragma unroll
            for (int j = 0; j < 4; ++j) {
                const int p = 16 * pt + 4 * fq + j, tl = dir ? 63 - p : p, row = rowbase + tl;
                float inv = 1.f;
                if (IS_ML) { const float den = lane_read(accd[j], lane & 48); inv = __builtin_amdgcn_rcpf(fmaxf(fabsf(den), 1.f)); }
                const int cof = (IS_ML ? 384 : 0) + h * 64 + 32 * hf + fr;
                const unsigned boff = dir == 0 ? (unsigned)(row * D + 384 + cof) * 2u : (unsigned)(row * 640 + cof) * 2u;
                GAS char* ob = dir == 0 ? (GAS char*)Y : (GAS char*)OB;
#pragma unroll
                for (int et = 0; et < NET; ++et) *(GAS bf16*)(ob + boff + 32 * et) = (bf16)f2bf(acc[et][j] * inv);
            }
        }
        __builtin_amdgcn_sched_barrier(0);
#pragma unroll
        for (int dt = 0; dt < 4; ++dt)
#pragma unroll
            for (int et = 0; et < NET; ++et) C[dt][et] *= adec;
        f32x4 accn[4];
        if (IS_ML) {
#pragma unroll
            for (int dt = 0; dt < 4; ++dt) { accn[dt] = *(const LAS f32x4*)(nq + 16 * dt) * adec; if (fr != 0) accn[dt] = (f32x4){0.f, 0.f, 0.f, 0.f}; }
        }
#pragma unroll
        for (int kk = 0; kk < 2; ++kk) {
            u32x2 vlo[2], vhi[2], klo[4], khi[4];
            ds_tr16x4(va + (32 * kk + 4 * fq + tr_q) * CH_PITCH + 8 * tr_p + 64 * hf, vlo, vhi);
            ds_tr16x8(ka + (32 * kk + 4 * fq + tr_q) * CH_PITCH + 8 * tr_p, klo, khi);
            const f32x4 wl = *(const LAS f32x4*)(gq + 192 + 32 * kk), wh = *(const LAS f32x4*)(gq + 192 + 32 * kk + 16);
#pragma unroll
            for (int dt = 0; dt < 4; ++dt) {
                u32x4 w;
                w.x = pk2(__uint_as_float(klo[dt].x << 16) * wl[0], __uint_as_float(klo[dt].x & 0xffff0000u) * wl[1]);
                w.y = pk2(__uint_as_float(klo[dt].y << 16) * wl[2], __uint_as_float(klo[dt].y & 0xffff0000u) * wl[3]);
                w.z = pk2(__uint_as_float(khi[dt].x << 16) * wh[0], __uint_as_float(khi[dt].x & 0xffff0000u) * wh[1]);
                w.w = pk2(__uint_as_float(khi[dt].y << 16) * wh[2], __uint_as_float(khi[dt].y & 0xffff0000u) * wh[3]);
                const bf16x8 kf = __builtin_bit_cast(bf16x8, w);
#pragma unroll
                for (int et = 0; et < NET; ++et) C[dt][et] = __builtin_amdgcn_mfma_f32_16x16x32_bf16(kf, mk_frag(vlo[et], vhi[et]), C[dt][et], 0, 0, 0);
                if (IS_ML) accn[dt] = __builtin_amdgcn_mfma_f32_16x16x32_bf16(kf, ones, accn[dt], 0, 0, 0);
            }
        }
        if (IS_ML) { if (fr == 0) {
#pragma unroll
            for (int dt = 0; dt < 4; ++dt) *(LAS f32x4*)(nvec + 4 * fq + 16 * dt) = accn[dt]; } }
        asm volatile("s_waitcnt lgkmcnt(0)" ::: "memory");
        __syncthreads();
    }
}

#ifndef FAST_CHAIN
#define FAST_CHAIN 1
#endif
constexpr int NCHWG = 160;
__device__ __forceinline__ void phase_mix(Frame& F, int layer) {
    const bool last = layer == 1;
    const GAS bf16* ftl = WSP(const bf16, WS_FTL) + (size_t)layer * 2 * 384 * 4096;
    if (FAST_CHAIN) {
        if (F.wg < NCHWG) {
            if (F.wave >= 4) {
#pragma unroll 1
                for (int i = 0; i < 72 * REP_CH; ++i) __syncthreads();
            } else {
                const int cl = F.wave >> 1, hf = F.wave & 1, c = F.wg * 2 + cl;
                LAS unsigned char* img = F.lds + cl * CH_WAVE_LDS;
                {
                if (c < 192) { const int b = c / 12, r = c % 12; chain_fast<false>(F, layer, b, r >> 1, r & 1, img, hf); }
                else { const int i = c - 192; chain_fast<true>(F, layer, i >> 3, (i & 7) >> 1, i & 1, img, hf); }
                }
            }
        } else {
            const int nh = F.G - NCHWG, w = F.wg - NCHWG;
#ifndef FAST_HY
#define FAST_HY 1
#endif
            if (FAST_HY) {
#ifndef REP_HY
#define REP_HY 1
#endif
#pragma unroll 1
                for (int rp = 0; rp < REP_HY; ++rp)
                for (int u = w; u < 384; u += nh) hyena_unit_fast<LL>(F, layer, u, WSP(const bf16, WS_HYTL), ftl, WSP(bf16, WS_YHTL));
                if (!last) for (int u = w; u < 384; u += nh) hyena_unit_fast<LC>(F, layer, u, WSP(const bf16, WS_HYTC), WSP(const bf16, WS_FTC), WSP(bf16, WS_YHTC));
            } else {
                for (int u = w; u < 384; u += nh) hyena_unit_naive<LL>(F, layer, u, WSP(const bf16, WS_HYTL), ftl, WSP(bf16, WS_YHTL));
                if (!last) for (int u = w; u < 384; u += nh) hyena_unit_naive<LC>(F, layer, u, WSP(const bf16, WS_HYTC), WSP(const bf16, WS_FTC), WSP(bf16, WS_YHTC));
            }
        }
    } else {
        for (int u = F.wg; u < 384; u += F.G) hyena_unit_naive<LL>(F, layer, u, WSP(const bf16, WS_HYTL), ftl, WSP(bf16, WS_YHTL));
        if (!last) for (int u = F.wg; u < 384; u += F.G) hyena_unit_naive<LC>(F, layer, u, WSP(const bf16, WS_HYTC), WSP(const bf16, WS_FTC), WSP(bf16, WS_YHTC));
        for (int c = F.wg + F.wave * F.G; c < 320; c += F.G * NWAVES) chain_naive(F, layer, c);
    }
}

__device__ __forceinline__ void phase_combine(Frame& F, int layer) {
    const bool last = layer == 1;
    const int gw = F.wg * NWAVES + F.wave, NGW = F.G * NWAVES, lane = F.lane;
    const int nrows = last ? TOKL : TOK;
    GAS bf16* Y = WSP(bf16, WS_Y); const GAS bf16* OB = WSP(const bf16, WS_OB); const GAS bf16* RET = WSP(const bf16, WS_RET); const GAS bf16* ML = WSP(const bf16, WS_ML);
#pragma unroll 2
    for (int row = gw; row < nrows; row += NGW) {
#pragma unroll
        for (int hh = 0; hh < 10; ++hh) {
            const int cof = hh * 64 + lane;
            const float x = bf2f(Y[(size_t)row * D + 384 + cof]) + bf2f(OB[(size_t)row * 640 + cof]);
            const float mu = wave_sum(x) * (1.f / 64.f), xc = x - mu;
            const float var = wave_sum(xc * xc) * (1.f / 64.f);
            const float nrm = xc * rsqrtf(var + 1e-6f);
            float gate;
            if (hh < 6) gate = siluf_(bf2f(RET[(size_t)row * 1536 + 1152 + cof]));
            else gate = sigmoidf_(bf2f(ML[(size_t)row * 1024 + 768 + (cof - 384)]));
            Y[(size_t)row * D + 384 + cof] = (bf16)f2bf(nrm * gate);
        }
    }
    LAS unsigned char* scr = F.lds + F.wave * 8704;
    const int nitL = NB * 6 * 32, nitC = last ? 0 : NB * 6 * 4;
    for (int it = gw; it < nitL + nitC; it += NGW) {
        const GAS bf16* src; int L, rowbase, b, cb, tb;
        if (it < nitL) { b = it / 192; const int r = it % 192; cb = r / 32; tb = r % 32; L = LL; src = WSP(const bf16, WS_YHTL); rowbase = b * LL; }
        else { const int i2 = it - nitL; b = i2 / 24; const int r = i2 % 24; cb = r / 4; tb = r % 4; L = LC; src = WSP(const bf16, WS_YHTC); rowbase = TOKL + b * LC; }
        u32x4 v[8];
#pragma unroll
        for (int i = 0; i < 8; ++i) { const int cc = (lane >> 3) + 8 * i; v[i] = *(const GAS u32x4*)(src + ((size_t)(b * 384 + cb * 64 + cc)) * L + tb * 64 + 8 * (lane & 7)); }
#pragma unroll
        for (int i = 0; i < 8; ++i) { const int cc = (lane >> 3) + 8 * i; *(LAS u32x4*)(scr + cc * 136 + 16 * (lane & 7)) = v[i]; }
        asm volatile("s_waitcnt lgkmcnt(0)" ::: "memory");
#pragma unroll
        for (int i = 0; i < 8; ++i) {
            const int tt = (lane >> 3) + 8 * i, c8 = 8 * (lane & 7);
            unsigned short e[8];
#pragma unroll
            for (int j = 0; j < 8; ++j) e[j] = *(const LAS unsigned short*)(scr + (c8 + j) * 136 + tt * 2);
            u32x4 o; o.x = e[0] | ((unsigned)e[1] << 16); o.y = e[2] | ((unsigned)e[3] << 16); o.z = e[4] | ((unsigned)e[5] << 16); o.w = e[6] | ((unsigned)e[7] << 16);
            *(GAS u32x4*)(Y + (size_t)(rowbase + tb * 64 + tt) * D + cb * 64 + c8) = o;
        }
        asm volatile("s_waitcnt lgkmcnt(0)" ::: "memory");
    }
}

__device__ __forceinline__ void phase_norm_router(Frame& F) {
    const int gw = F.wg * NWAVES + F.wave, NGW = F.G * NWAVES, lane = F.lane;
    const GAS float* g = inp(F, I_GFFN) + 1 * D; const GAS float* wr = inp(F, I_ROUTER); const GAS float* br = inp(F, I_ROUTERB);
    GAS unsigned* cnt = WSP(unsigned, WS_CTL) + CW_CNT;
#pragma unroll 2
    for (int row = gw; row < TOKL; row += NGW) {
        float keep[16];
        norm_mod_row(xrow_ptr(F, row, false), g, mod_ptr(F, 1, row, 3), mod_ptr(F, 1, row, 4), WSP(bf16, WS_H) + (size_t)row * D, lane, keep);
        float lg[8];
#pragma unroll
        for (int e = 0; e < 8; ++e) lg[e] = 0.f;
#pragma unroll
        for (int j = 0; j < 4; ++j)
#pragma unroll
            for (int i = 0; i < 4; ++i) { const int k = 256 * j + 4 * lane + i; const f32x4 w0 = *(const GAS f32x4*)(wr + k * 8), w1 = *(const GAS f32x4*)(wr + k * 8 + 4); const float x = keep[4 * j + i];
                lg[0] += x * w0.x; lg[1] += x * w0.y; lg[2] += x * w0.z; lg[3] += x * w0.w; lg[4] += x * w1.x; lg[5] += x * w1.y; lg[6] += x * w1.z; lg[7] += x * w1.w; }
#pragma unroll
        for (int e = 0; e < 8; ++e) lg[e] = wave_sum(lg[e]) + br[e];
        int e0 = 0; float v0 = lg[0];
#pragma unroll
        for (int e = 1; e < 8; ++e) if (lg[e] > v0) { v0 = lg[e]; e0 = e; }
        int e1 = -1; float v1 = -3.0e38f;
#pragma unroll
        for (int e = 0; e < 8; ++e) if (e != e0 && lg[e] > v1) { v1 = lg[e]; e1 = e; }
        const float w1 = 1.f / (1.f + __expf(v0 - v1)), w0 = 1.f - w1;
        if (lane == 0) {
            const unsigned p0 = __hip_atomic_fetch_add(cnt + e0, 1u, __ATOMIC_RELAXED, __HIP_MEMORY_SCOPE_AGENT), p1 = __hip_atomic_fetch_add(cnt + e1, 1u, __ATOMIC_RELAXED, __HIP_MEMORY_SCOPE_AGENT);
            WSP(int, WS_TOPE)[row * 2] = e0; WSP(int, WS_TOPE)[row * 2 + 1] = e1;
            WSP(float, WS_TOPW)[row * 2] = w0; WSP(float, WS_TOPW)[row * 2 + 1] = w1;
            WSP(int, WS_TOPP)[row * 2] = (int)p0; WSP(int, WS_TOPP)[row * 2 + 1] = (int)p1;
        }
    }
}
__device__ __forceinline__ void phase_route_tables(Frame& F) {
    const GAS unsigned* cnt = WSP(const unsigned, WS_CTL) + CW_CNT;
    int off[9]; off[0] = 0;
#pragma unroll
    for (int e = 0; e < 8; ++e) { const int c = (int)__hip_atomic_load(cnt + e, __ATOMIC_RELAXED, __HIP_MEMORY_SCOPE_AGENT); off[e + 1] = off[e] + ((c + 255) >> 8) * 256; }
    const int gt = F.wg * NTHR + F.tid, NGT = F.G * NTHR;
    GAS int* rowidx = WSP(int, WS_ROWIDX); GAS int* slot = WSP(int, WS_SLOT); GAS int* tilee = WSP(int, WS_TILEE);
    for (int i = gt; i < MAXTILES * 256; i += NGT) {
        int e = 0;
#pragma unroll
        for (int q = 1; q < 8; ++q) if (i >= off[q]) e = q;
        const int c = (int)cnt[e];
        if (i >= off[8] || i - off[e] >= c) rowidx[i] = 0;
    }
    for (int i = gt; i < TOKL * 2; i += NGT) {
        const int e = WSP(const int, WS_TOPE)[i], pos = WSP(const int, WS_TOPP)[i];
        int o = 0;
#pragma unroll
        for (int q = 0; q < 8; ++q) if (e == q) o = off[q];
        const int s = o + pos; slot[i] = s; rowidx[s] = i >> 1;
    }
    for (int i = gt; i < MAXTILES + 1; i += NGT) {
        if (i == MAXTILES) tilee[MAXTILES] = off[8] >> 8;
        else { int e = 0;
#pragma unroll
            for (int q = 1; q < 8; ++q) if (i * 256 >= off[q]) e = q;
            tilee[i] = e; }
    }
}

__device__ __forceinline__ void moe_pass_gemm1_fast(Frame& F, int t0, int t1) {
    pg8::OrderMoe S; S.o.init(t1 - t0, NFF1 / 256, F.G, F.wg); S.rowidx = WSP(const int, WS_ROWIDX); S.tilee = WSP(const int, WS_TILEE); S.t0 = t0; S.bstride = (size_t)NFF1 * D; S.gather = true;
    EpiSwiglu E{WSP(bf16, WS_MACT), 0};
    pg8::gemm_phase(F.lds, F.tid, WSP(const bf16, WS_H), D, WSP(const bf16, WS_MW13), D, D, S, E);
}
__device__ __forceinline__ void moe_pass_gemm2_fast(Frame& F, int t0, int t1) {
    pg8::OrderMoe S; S.o.init(t1 - t0, D / 256, F.G, F.wg); S.rowidx = WSP(const int, WS_ROWIDX); S.tilee = WSP(const int, WS_TILEE); S.t0 = t0; S.bstride = (size_t)D * DFF; S.gather = false;
    EpiBf16Out E{WSP(bf16, WS_EOUT), D, t0 * 256};
    pg8::gemm_phase(F.lds, F.tid, WSP(const bf16, WS_MACT), DFF, WSP(const bf16, WS_MW2), DFF, DFF, S, E);
}
__device__ __forceinline__ void phase_final(Frame& F) {
    const int gw = F.wg * NWAVES + F.wave, NGW = F.G * NWAVES, lane = F.lane;
    const GAS float* gf = inp(F, I_GFINAL); const GAS bf16* eo = WSP(const bf16, WS_EOUT);
#pragma unroll 2
    for (int row = gw; row < TOKL; row += NGW) {
        const int s0 = WSP(const int, WS_SLOT)[row * 2], s1 = WSP(const int, WS_SLOT)[row * 2 + 1];
        const float w0 = WSP(const float, WS_TOPW)[row * 2], w1 = WSP(const float, WS_TOPW)[row * 2 + 1];
        const GAS float* m5 = mod_ptr(F, 1, row, 5);
        GAS float* xr = outp(F) + (size_t)row * D;
        f32x4 v[4]; float s = 0.f;
#pragma unroll
        for (int j = 0; j < 4; ++j) {
            const int c = 256 * j + 4 * lane;
            const f32x4 a = ld_bf16x4(eo + (size_t)s0 * D + c), b = ld_bf16x4(eo + (size_t)s1 * D + c), m = *(const GAS f32x4*)(m5 + c);
            v[j] = *(const GAS f32x4*)(xr + c) + m * (a * w0 + b * w1);
            s += (v[j].x * v[j].x + v[j].y * v[j].y) + (v[j].z * v[j].z + v[j].w * v[j].w);
        }
        const float r = rsqrtf(wave_sum(s) * (1.f / 1024.f) + 1e-6f);
#pragma unroll
        for (int j = 0; j < 4; ++j) { const int c = 256 * j + 4 * lane; const f32x4 g = *(const GAS f32x4*)(gf + c); *(GAS f32x4*)(xr + c) = v[j] * r * g; }
    }
}

#ifndef REP_WIN
#define REP_WIN 1
#endif
#ifndef REP_MIX
#define REP_MIX 1
#endif
#ifndef REP_GATE
#define REP_GATE 1
#endif
#ifndef REP_UP
#define REP_UP 1
#endif
#ifndef REP_FFN1
#define REP_FFN1 1
#endif
#ifndef REP_MOE
#define REP_MOE 1
#endif
#ifndef REP_NORM
#define REP_NORM 1
#endif
#ifndef REP_P0
#define REP_P0 1
#endif
__global__ void __launch_bounds__(NTHR, 2) hybrid_fwd(Params prm) {
    extern __shared__ __attribute__((aligned(16))) unsigned char lds_raw[];
    Frame F;
    F.lds = (LAS unsigned char*)lds_raw; F.ws = (GAS unsigned char*)prm.ws;
    F.tid = threadIdx.x; F.lane = F.tid & 63; F.wave = __builtin_amdgcn_readfirstlane(F.tid >> 6); F.G = gridDim.x; F.wg = blockIdx.x;
    volatile LAS unsigned* MISC = (volatile LAS unsigned*)(F.lds + MISC_OFF);
    if (F.tid < 64) MISC[F.tid] = 0u;
    if (F.tid < 33) { const unsigned long long v = F.tid < 32 ? (unsigned long long)prm.in[F.tid] : (unsigned long long)prm.out; *(LAS unsigned long long*)(F.lds + PTAB_OFF + 8 * F.tid) = v; }
    __syncthreads();
    XcdBarrier bar = xcd_barrier_post(WSP(unsigned, WS_CTL) + CW_BAR, MISC + 8);
#define RELAUNDER() do { { unsigned long long _w = (unsigned long long)F.ws; asm volatile("" : "+s"(_w)); F.ws = (GAS unsigned char*)_w; } \
        { unsigned _t = (unsigned)F.tid; asm volatile("" : "+v"(_t)); F.tid = (int)_t; F.lane = F.tid & 63; F.wave = __builtin_amdgcn_readfirstlane(F.tid >> 6); } \
        { unsigned _g = (unsigned)F.G, _b = (unsigned)F.wg; asm volatile("" : "+s"(_g), "+s"(_b)); F.G = (int)_g; F.wg = (int)_b; } \
        { unsigned _l = (unsigned)(size_t)F.lds; asm volatile("" : "+s"(_l)); F.lds = (LAS unsigned char*)(size_t)_l; } } while (0)
#define GRID_BAR() do { { unsigned long long _b = (unsigned long long)bar.bar; unsigned _x = bar.x; asm volatile("" : "+s"(_b), "+s"(_x)); bar.bar = (GAS unsigned*)_b; bar.x = _x; } xcd_barrier(bar); RELAUNDER(); } while (0)

    for (int rp = 0; rp < REP_P0; ++rp) { phase_p0(F); write_bias(F);
    GRID_BAR(); }
#pragma unroll 1
    for (int layer_ = 0; layer_ < 2; ++layer_) {
        int layer = layer_;
#define last (layer == 1)
#define rows_all TOK
#define rows_out (last ? TOKL : TOK)
#define modbase (WSP(const float, WS_MOD) + (size_t)layer * 17 * 6144)
#define LAYER_LAUNDER() asm volatile("" : "+s"(layer))
        for (int rp = 0; rp < REP_NORM; ++rp) { phase_norm(F, layer, rows_all, !last, 0);
        if (layer == 0) { const int gw = F.wg * NWAVES + F.wave, NGW = F.G * NWAVES;
            for (int it = gw; it < 1536 + 96; it += NGW) filter_out_item(F, it); }
        { GRID_BAR(); LAYER_LAUNDER(); } }
        for (int rp = 0; rp < REP_WIN; ++rp) {
        { EpiWin E{WSP(const float, WS_BIAS) + layer * NWP, WSP(bf16, WS_HYTL), WSP(bf16, WS_HYTC), WSP(bf16, WS_RET), WSP(bf16, WS_ML), WSP(float, WS_MLG)};
          gemm_fast(F, WSP(const bf16, WS_H), D, WSP(const bf16, WS_WIN), D, D, rows_all, NW1, E); }
        { GRID_BAR(); LAYER_LAUNDER(); } }
        for (int rp = 0; rp < REP_MIX; ++rp) { phase_mix(F, layer);
        { GRID_BAR(); LAYER_LAUNDER(); } }
        phase_combine(F, layer);
        { GRID_BAR(); LAYER_LAUNDER(); }
        for (int rp = 0; rp < REP_GATE; ++rp) {
        { EpiGate E{WSP(const float, WS_BIAS) + layer * NWP + NW1, WSP(bf16, WS_GATES)};
          gemm_fast(F, WSP(const bf16, WS_H), D, WSP(const bf16, WS_WIN) + (size_t)NW1 * D, D, D, rows_out, NGATE, E); }
        { GRID_BAR(); LAYER_LAUNDER(); } }
        for (int rp = 0; rp < REP_UP; ++rp) {
        { EpiUp E{WSP(const bf16, WS_GATES), WSP(bf16, WS_H)};
          gemm_fast(F, WSP(const bf16, WS_Y), D, WSP(const bf16, WS_WUP), D, D, rows_out, D, E); }
        { GRID_BAR(); LAYER_LAUNDER(); } }
        { EpiResid E{last ? outp(F) : inp(F, I_X), last ? WSP(const float, WS_XC) : inp(F, I_CTX), outp(F), WSP(float, WS_XC), modbase, 2};
          gemm_fast(F, WSP(const bf16, WS_H), D, WSP(const bf16, WS_WOUT), D, D, rows_out, D, E); }
        { GRID_BAR(); LAYER_LAUNDER(); }
        if (!last) {
            phase_norm(F, layer, rows_out, false, 3);
            { const int gw = F.wg * NWAVES + F.wave, NGW = F.G * NWAVES; LAS float* scr = (LAS float*)(F.lds + F.wave * 8704);
              conv_weights_ffn(inp(F, I_FW1), inp(F, I_FW3), inp(F, I_FW2), WSP(bf16, WS_W13), WSP(bf16, WS_W2), gw, NGW, scr, F.lane);
              conv_weights_win(F, 1, gw, NGW, scr);
              conv_weights_upout(F, 1, gw, NGW, scr); }
            { GRID_BAR(); LAYER_LAUNDER(); }
            for (int rp = 0; rp < REP_FFN1; ++rp) {
            { EpiSwiglu E{WSP(bf16, WS_ACT), 0};
              gemm_fast(F, WSP(const bf16, WS_H), D, WSP(const bf16, WS_W13), D, D, rows_out, NFF1, E); }
            { GRID_BAR(); LAYER_LAUNDER(); } }
            { EpiResid E{outp(F), WSP(const float, WS_XC), outp(F), WSP(float, WS_XC), modbase, 5};
              gemm_fast(F, WSP(const bf16, WS_ACT), DFF, WSP(const bf16, WS_W2), DFF, DFF, rows_out, D, E); }
            { GRID_BAR(); LAYER_LAUNDER(); }
        }
    }
#undef LAYER_LAUNDER
#undef last
#undef rows_all
#undef rows_out
#undef modbase
    phase_norm_router(F);
    { const int gw = F.wg * NWAVES + F.wave, NGW = F.G * NWAVES; LAS float* scr = (LAS float*)(F.lds + F.wave * 8704);
#ifndef REP_MCONV
#define REP_MCONV 1
#endif
#pragma unroll 1
      for (int e = 0; e < NE * REP_MCONV; ++e)
          conv_weights_ffn(inp(F, I_MW1) + (size_t)(e % NE) * D * DFF, inp(F, I_MW3) + (size_t)(e % NE) * D * DFF, inp(F, I_MW2) + (size_t)(e % NE) * DFF * D,
                           WSP(bf16, WS_MW13) + (size_t)(e % NE) * NFF1 * D, WSP(bf16, WS_MW2) + (size_t)(e % NE) * D * DFF, gw, NGW, scr, F.lane); }
    GRID_BAR();
    phase_route_tables(F);
    GRID_BAR();
    const int ntiles = __builtin_amdgcn_readfirstlane(WSP(const int, WS_TILEE)[MAXTILES]);
#pragma unroll 1
    for (int p = 0; p < NPASS; ++p) {
        const int t0 = p * PASS_TILES, t1 = min(ntiles, t0 + PASS_TILES);
        for (int rp = 0; rp < REP_MOE; ++rp) {
        if (t0 < t1) moe_pass_gemm1_fast(F, t0, t1);
        GRID_BAR();
        if (t0 < t1) moe_pass_gemm2_fast(F, t0, t1);
        GRID_BAR(); }
    }
#ifndef REP_BAR
#define REP_BAR 0
#endif
    for (int rb = 0; rb < REP_BAR; ++rb) GRID_BAR();
    phase_final(F);
}

extern "C" void kernel_launch(void* const* d_in, const int* in_sizes, int n_in, void* d_out, int out_size, void* d_ws, size_t ws_size, hipStream_t stream) {
    static int grid = 0;
    if (grid == 0) {
        if (n_in != 32 || out_size != TOKL * D || ws_size < WS_END) { fprintf(stderr, "kernel_launch: unexpected arguments (n_in %d, out %d, ws %zu)\n", n_in, out_size, ws_size); grid = -1; return; }
        int dev = 0, cus = 0;
        if (hipGetDevice(&dev) != hipSuccess || hipDeviceGetAttribute(&cus, hipDeviceAttributeMultiprocessorCount, dev) != hipSuccess) { grid = -1; return; }
        if (hipFuncSetAttribute((const void*)hybrid_fwd, hipFuncAttributeMaxDynamicSharedMemorySize, LDS_BYTES) != hipSuccess) { grid = -1; return; }
        int per_cu = 0;
        (void)hipOccupancyMaxActiveBlocksPerMultiprocessor(&per_cu, (const void*)hybrid_fwd, NTHR, LDS_BYTES);
        (void)hipGetLastError();
        grid = cus;
    }
    if (grid < 0) return;
    (void)hipMemsetAsync((char*)d_ws + WS_CTL, 0, CTL_ZERO_BYTES, stream);
    Params p{};
    for (int i = 0; i < 32; ++i) p.in[i] = (const float*)d_in[i];
    p.out = (float*)d_out; p.ws = (unsigned char*)d_ws;
    hipLaunchKernelGGL(hybrid_fwd, dim3(grid), dim3(NTHR), LDS_BYTES, stream, p);
}
```

```cpp
#include <hip/hip_runtime.h>
#include <stdint.h>
#include <stdio.h>

#define LAS __attribute__((address_space(3)))
#define GAS __attribute__((address_space(1)))
typedef unsigned short bf16;
typedef short bf16x8 __attribute__((ext_vector_type(8)));
typedef float f32x4 __attribute__((ext_vector_type(4)));
typedef unsigned u32x4 __attribute__((ext_vector_type(4)));
typedef unsigned u32x2 __attribute__((ext_vector_type(2)));

constexpr int D = 1024, NB = 16, LL = 2048, LC = 256;
constexpr int TOKL = NB * LL, TOKC = NB * LC, TOK = TOKL + TOKC;
constexpr int HYW = 384, RETW = 384, MLW = 256;
constexpr int NIN = 6800, NW1 = 3840, NGATE = 3072, NWP = 6912;
constexpr int DFF = 2816, NFF1 = 5632, NE = 8;
constexpr int NWAVES = 8, NTHR = 512;
constexpr int MAXTILES = 272, PASS_TILES = 58, NPASS = 5;

constexpr size_t MiB = 1u << 20;
constexpr size_t WS_CTL = 0, CTL_ZERO_BYTES = 1 * MiB;
constexpr size_t WS_MOD = 1 * MiB;
constexpr size_t WS_BIAS = 2 * MiB;
constexpr size_t WS_ROPE = 2 * MiB + 256 * 1024;
constexpr size_t WS_TOPE = 3 * MiB;
constexpr size_t WS_TOPW = 3 * MiB + 256 * 1024;
constexpr size_t WS_TOPP = 3 * MiB + 512 * 1024;
constexpr size_t WS_SLOT = 3 * MiB + 768 * 1024;
constexpr size_t WS_ROWIDX = 4 * MiB;
constexpr size_t WS_TILEE = 4 * MiB + 512 * 1024;
constexpr size_t WS_FTL = 5 * MiB;
constexpr size_t WS_FTC = 17 * MiB;
constexpr size_t WS_WIN = 18 * MiB;
constexpr size_t WS_WUP = 32 * MiB;
constexpr size_t WS_WOUT = 34 * MiB;
constexpr size_t WS_XC = 36 * MiB;
constexpr size_t WS_H = 52 * MiB;
constexpr size_t WS_Y = 124 * MiB;
constexpr size_t WS_U = 196 * MiB;
constexpr size_t WS_RET = WS_U;
constexpr size_t WS_ML = WS_U + 108 * MiB;
constexpr size_t WS_MLG = WS_U + 180 * MiB;
constexpr size_t WS_OB = WS_U + 183 * MiB;
constexpr size_t WS_YHTL = WS_U + 228 * MiB;
constexpr size_t WS_YHTC = WS_U + 252 * MiB;
constexpr size_t WS_HYTL = WS_U + 255 * MiB;
constexpr size_t WS_HYTC = WS_U + 327 * MiB;
constexpr size_t WS_END = WS_U + 336 * MiB;
constexpr size_t WS_GATES = WS_U;
constexpr size_t WS_ACT = WS_U;
constexpr size_t WS_W13 = WS_U + 204 * MiB;
constexpr size_t WS_W2 = WS_U + 216 * MiB;
constexpr size_t WS_MW13 = WS_Y;
constexpr size_t WS_MW2 = WS_Y + 88 * MiB;
constexpr size_t WS_MACT = WS_Y + 132 * MiB;
constexpr size_t WS_EOUT = WS_Y + 220 * MiB;
static_assert(WS_EOUT + (size_t)MAXTILES * 256 * 1024 * 2 <= WS_END, "map");
static_assert(WS_GATES + (size_t)TOK * NGATE * 2 <= WS_YHTL, "gates overlay");

constexpr int CW_BAR = 4096;
constexpr int CW_CNT = 16384;

constexpr int LDS_BYTES = 147456;
constexpr int MISC_OFF = 147456 - 256;

__device__ __forceinline__ float bf2f(bf16 b) { return __uint_as_float(((unsigned)b) << 16); }
typedef __bf16 bf2v_ __attribute__((ext_vector_type(2)));
typedef float f2v_ __attribute__((ext_vector_type(2)));
__device__ __forceinline__ unsigned pk2(float lo, float hi) { const f2v_ f = {lo, hi}; return __builtin_bit_cast(unsigned, __builtin_convertvector(f, bf2v_)); }
__device__ __forceinline__ unsigned f2bf(float f) { return pk2(f, 0.f) & 0xffffu; }
__device__ __forceinline__ float dpp_f(float v, int) { return v; }
#define DPP_ADD(v, ctrl) (v) += __int_as_float(__builtin_amdgcn_update_dpp(0, __float_as_int(v), (ctrl), 0xf, 0xf, true))
__device__ __forceinline__ float wave_sum(float v) {
    DPP_ADD(v, 0xB1);
    DPP_ADD(v, 0x4E);
    DPP_ADD(v, 0x141);
    DPP_ADD(v, 0x140);
    return __int_as_float(__builtin_amdgcn_readlane(__float_as_int(v), 0)) + __int_as_float(__builtin_amdgcn_readlane(__float_as_int(v), 16))
         + __int_as_float(__builtin_amdgcn_readlane(__float_as_int(v), 32)) + __int_as_float(__builtin_amdgcn_readlane(__float_as_int(v), 48));
}
__device__ __forceinline__ float lane_read(float v, int src_lane) { return __int_as_float(__builtin_amdgcn_ds_bpermute(src_lane << 2, __float_as_int(v))); }
__device__ __forceinline__ float sigmoidf_(float x) { return __builtin_amdgcn_rcpf(1.0f + __expf(-x)); }
__device__ __forceinline__ float siluf_(float x) { return x * __builtin_amdgcn_rcpf(1.0f + __expf(-x)); }

#define XB_TMO      128
#define XB_XCNT(j)  (256  + 64 * (j))
#define XB_XSUB(j)  (1280 + 64 * (j))
#define XB_XGEN(j)  (2304 + 64 * (j))
#define XB_TOP      3328
#define XB_TOPGEN   3392
#define XCD_BAR_WORDS 3456
#define XB_SPIN_CAP (1u << 22)
__device__ __forceinline__ unsigned xb_ld(GAS unsigned* p)              { return __hip_atomic_load(p, __ATOMIC_RELAXED, __HIP_MEMORY_SCOPE_AGENT); }
__device__ __forceinline__ unsigned xb_add(GAS unsigned* p, unsigned v) { return __hip_atomic_fetch_add(p, v, __ATOMIC_RELAXED, __HIP_MEMORY_SCOPE_AGENT); }
__device__ __forceinline__ unsigned xb_xcc_id() { return (unsigned)__builtin_amdgcn_s_getreg((3 << 11) | 20) & 0xFu; }
#define XB_SPIN(cond, bar) do { unsigned _sp = 0; while (cond) { __builtin_amdgcn_s_sleep(1); \
    if ((++_sp & 255u) == 0u) { if (xb_ld(&(bar)[XB_TMO])) break; if (_sp > XB_SPIN_CAP) { (void)__hip_atomic_fetch_add(&(bar)[XB_TMO], 1u, __ATOMIC_RELAXED, __HIP_MEMORY_SCOPE_AGENT); break; } } } } while (0)
struct XcdBarrier { GAS unsigned* bar; unsigned x; volatile LAS unsigned* st; };
__device__ __forceinline__ XcdBarrier xcd_barrier_post(GAS unsigned* bar, volatile LAS unsigned* st) {
    XcdBarrier b; b.bar = bar; b.x = xb_xcc_id(); b.st = st;
    if (threadIdx.x == 0) (void)xb_add(&bar[XB_XCNT(b.x)], 1u);
    return b;
}
__device__ __forceinline__ void xcd_barrier_complete(GAS unsigned* bar, unsigned x, unsigned& nloc, unsigned& nx) {
    const unsigned G = gridDim.x * gridDim.y * gridDim.z;
    unsigned sum, cnt, mine, sp = 0u;
    for (;;) {
        sum = 0u; cnt = 0u; mine = 0u;
#pragma unroll 1
        for (unsigned j = 0; j < 16; ++j) { const unsigned c = xb_ld(&bar[XB_XCNT(j)]); sum += c; cnt += (c > 0u) ? 1u : 0u; }
        mine = xb_ld(&bar[XB_XCNT(x)]);
        if (sum == G) break;
        __builtin_amdgcn_s_sleep(1);
        if ((++sp & 255u) == 0u) { if (xb_ld(&bar[XB_TMO])) break; if (sp > XB_SPIN_CAP) { (void)__hip_atomic_fetch_add(&bar[XB_TMO], 1u, __ATOMIC_RELAXED, __HIP_MEMORY_SCOPE_AGENT); break; } }
    }
    nloc = mine > 0u ? mine : 1u; nx = cnt > 0u ? cnt : 1u;
}
__device__ __forceinline__ void xcd_barrier(const XcdBarrier& b) {
    asm volatile("s_waitcnt vmcnt(0)" ::: "memory");
    __syncthreads();
    if (threadIdx.x == 0) {
        GAS unsigned* bar = b.bar;
        __builtin_amdgcn_s_waitcnt(0);
        unsigned nloc = b.st[0], nx = b.st[1];
        if (nloc == 0u) { xcd_barrier_complete(bar, b.x, nloc, nx); b.st[0] = nloc; b.st[1] = nx; }
        const unsigned old = xb_add(&bar[XB_XSUB(b.x)], 1u);
        const unsigned gen = old / nloc;
        if (old + 1u == (gen + 1u) * nloc) {
            __builtin_amdgcn_fence(__ATOMIC_RELEASE, "agent");
            asm volatile("s_waitcnt vmcnt(0)" ::: "memory");
            const unsigned og = xb_add(&bar[XB_TOP], 1u);
            const unsigned tg = og / nx;
            if (og + 1u == (tg + 1u) * nx) xb_add(&bar[XB_TOPGEN], 1u);
            else XB_SPIN(xb_ld(&bar[XB_TOPGEN]) == tg, bar);
            __builtin_amdgcn_fence(__ATOMIC_ACQUIRE, "agent");
            xb_add(&bar[XB_XGEN(b.x)], 1u);
            asm volatile("s_waitcnt vmcnt(0)" ::: "memory");
        } else {
            XB_SPIN(xb_ld(&bar[XB_XGEN(b.x)]) == gen, bar);
            __builtin_amdgcn_fence(__ATOMIC_ACQUIRE, "agent");
            asm volatile("s_waitcnt vmcnt(0)" ::: "memory");
        }
    }
    __syncthreads();
}

struct Params { const float* in[32]; float* out; unsigned char* ws; };
enum { I_X = 0, I_C, I_CTX, I_CCTX, I_WMOD, I_BMOD, I_GMIX, I_GFFN, I_WIN, I_BIN, I_HYCONV, I_HYF1, I_HYFB1, I_HYF2, I_HYFB2, I_HYF3, I_HYDECAY,
       I_HYSKIP, I_RETDECAY, I_MLCONV, I_MLGB, I_WUP, I_WOUT, I_FW1, I_FW3, I_FW2, I_ROUTER, I_ROUTERB, I_MW1, I_MW3, I_MW2, I_GFINAL };

struct Frame {
    LAS unsigned char* lds;
    GAS unsigned char* ws;
    int tid, lane, wave, G, wg;
};
#define WSP(T, off) ((GAS T*)(F.ws + (off)))
constexpr int PTAB_OFF = 147456 - 1024;
__device__ __forceinline__ const GAS float* inp(const Frame& F, int i) {
    const LAS unsigned* t = (const LAS unsigned*)(F.lds + PTAB_OFF) + 2 * i;
    const unsigned lo = __builtin_amdgcn_readfirstlane(t[0]), hi = __builtin_amdgcn_readfirstlane(t[1]);
    return (const GAS float*)(((unsigned long long)hi << 32) | lo);
}
__device__ __forceinline__ GAS float* outp(const Frame& F) { return (GAS float*)inp(F, 32); }

__device__ __forceinline__ int row_batch(int row) { return row < TOKL ? (row >> 11) : ((row - TOKL) >> 8); }
__device__ __forceinline__ const GAS float* mod_ptr(const Frame& F, int layer, int row, int which) {
    const int r = row < TOKL ? (row >> 11) : 16;
    return WSP(const float, WS_MOD) + ((size_t)(layer * 17 + r) * 6 + which) * 1024;
}

template <class RowMap>
__device__ __forceinline__ void tr_item(const GAS float* W, int K, int N, GAS bf16* WT, int ldT, RowMap rm, LAS float* scr, int item, int lane) {
    const int nblk = (N + 31) / 32, kb = item / nblk, nb = item % nblk, k0 = 64 * kb, n0 = 32 * nb;
    { float tv[32];
#pragma unroll
      for (int i = 0; i < 32; ++i) { const int kk = 2 * i + (lane >> 5); const int n = n0 + (lane & 31); tv[i] = (n < N) ? W[(size_t)(k0 + kk) * N + n] : 0.f; }
#pragma unroll
      for (int i = 0; i < 32; ++i) { const int kk = 2 * i + (lane >> 5); scr[kk * 33 + (lane & 31)] = tv[i]; } }
    asm volatile("s_waitcnt lgkmcnt(0)" ::: "memory");
    const int c = lane & 7;
#pragma unroll
    for (int j = 0; j < 4; ++j) { const int nl = (lane >> 3) + 8 * j; const int n = n0 + nl; const LAS float* s = scr + (8 * c) * 33 + nl;
        u32x4 o; o.x = pk2(s[0 * 33], s[1 * 33]); o.y = pk2(s[2 * 33], s[3 * 33]); o.z = pk2(s[4 * 33], s[5 * 33]); o.w = pk2(s[6 * 33], s[7 * 33]);
        if (n < N) *(GAS u32x4*)(WT + (size_t)rm(n) * ldT + k0 + 8 * c) = o; }
    asm volatile("s_waitcnt lgkmcnt(0)" ::: "memory");
}
struct RmId { __device__ __forceinline__ int operator()(int n) const { return n; } };
__device__ __forceinline__ int win_row(int n) {
    if (n < 1152) return n;
    if (n < 2688) return 1280 + (n - 1152);
    if (n < 3712) return 2816 + (n - 2688);
    if (n < 3728) return 1152 + (n - 3712);
    return 3840 + (n - 3728);
}
struct RmWin { __device__ __forceinline__ int operator()(int n) const { return win_row(n); } };
struct RmW1 { __device__ __forceinline__ int operator()(int n) const { return (n >> 4) * 32 + (n & 15); } };
struct RmW3 { __device__ __forceinline__ int operator()(int n) const { return (n >> 4) * 32 + 16 + (n & 15); } };

__device__ __forceinline__ void conv_weights_win(Frame& F, int layer, int gw, int NGW, LAS float* scr) {
    const GAS float* W = inp(F, I_WIN) + (size_t)layer * D * NIN;
    const int items = (D / 64) * ((NIN + 31) / 32);
    for (int it = gw; it < items; it += NGW) tr_item(W, D, NIN, WSP(bf16, WS_WIN), D, RmWin(), scr, it, F.lane);
    GAS bf16* wt = WSP(bf16, WS_WIN);
    unsigned zz; asm volatile("v_mov_b32 %0, 0" : "=v"(zz));
    for (int i = gw * 64 + F.lane; i < 112 * 1024 / 8; i += NGW * 64) *(GAS u32x4*)(wt + (size_t)1168 * 1024 + (size_t)i * 8) = (u32x4){zz, zz, zz, zz};
}
__device__ __forceinline__ void conv_weights_upout(Frame& F, int layer, int gw, int NGW, LAS float* scr) {
    const int items = (D / 64) * (D / 32);
    for (int it = gw; it < items; it += NGW) tr_item(inp(F, I_WUP) + (size_t)layer * D * D, D, D, WSP(bf16, WS_WUP), D, RmId(), scr, it, F.lane);
    for (int it = gw; it < items; it += NGW) tr_item(inp(F, I_WOUT) + (size_t)layer * D * D, D, D, WSP(bf16, WS_WOUT), D, RmId(), scr, it, F.lane);
}
__device__ __forceinline__ void conv_weights_ffn(const GAS float* w1, const GAS float* w3, const GAS float* w2, GAS bf16* w13t, GAS bf16* w2t, int gw, int NGW, LAS float* scr, int lane) {
    const int i1 = (D / 64) * (DFF / 32), i2 = (DFF / 64) * (D / 32);
    for (int it = gw; it < i1; it += NGW) tr_item(w1, D, DFF, w13t, D, RmW1(), scr, it, lane);
    for (int it = gw; it < i1; it += NGW) tr_item(w3, D, DFF, w13t, D, RmW3(), scr, it, lane);
    for (int it = gw; it < i2; it += NGW) tr_item(w2, DFF, D, w2t, DFF, RmId(), scr, it, lane);
}

constexpr size_t WS_HID2 = WS_XC;
__device__ __forceinline__ void filter_hidden_item(Frame& F, int item) {
    const int p0 = item * 8, sel = p0 < 2048 ? 0 : (p0 < 4096 ? 1 : 2), layer = sel == 1 ? 1 : 0, L = sel == 2 ? LC : LL, pbase = sel == 0 ? 0 : (sel == 1 ? 2048 : 4096);
    const GAS float* f1 = inp(F, I_HYF1) + layer * 33 * 64; const GAS float* fb1 = inp(F, I_HYFB1) + layer * 64;
    const GAS float* f2 = inp(F, I_HYF2) + layer * 64 * 64; const GAS float* fb2 = inp(F, I_HYFB2) + layer * 64;
    const int lane = F.lane;
    const float b1 = fb1[lane], b2 = fb2[lane];
    for (int pl = 0; pl < 8; ++pl) {
        const int pos = p0 + pl - pbase;
        const float t = (float)pos / (float)(L - 1);
        const float w = 6.283185307179586f * (float)pos / (float)L;
        float feat = 0.f;
        if (lane == 0) feat = t;
        else if (lane < 17) { const float band = 1e-4f + (float)(lane - 1) * ((15.0f - 1e-4f) / 15.0f); feat = cosf(w * band); }
        else if (lane < 33) { const float band = 1e-4f + (float)(lane - 17) * ((15.0f - 1e-4f) / 15.0f); feat = -sinf(w * band); }
        float a1 = b1;
        for (int i = 0; i < 33; ++i) a1 += __int_as_float(__builtin_amdgcn_readlane(__float_as_int(feat), i)) * f1[i * 64 + lane];
        const float h1 = sinf(a1);
        float a2 = b2;
        for (int i = 0; i < 64; ++i) a2 += __int_as_float(__builtin_amdgcn_readlane(__float_as_int(h1), i)) * f2[i * 64 + lane];
        WSP(float, WS_HID2)[(size_t)(p0 + pl) * 64 + lane] = sinf(a2);
    }
}
__device__ __forceinline__ void filter_out_item(Frame& F, int item) {
    int sel, r;
    if (item < 768) { sel = 0; r = item; } else if (item < 1536) { sel = 1; r = item - 768; } else { sel = 2; r = item - 1536; }
    const int layer = sel == 1 ? 1 : 0, L = sel == 2 ? LC : LL, pb = r / 24, ch = r % 24, pbase = sel == 0 ? 0 : (sel == 1 ? 2048 : 4096);
    GAS bf16* FT = sel == 2 ? WSP(bf16, WS_FTC) : WSP(bf16, WS_FTL) + (size_t)layer * 2 * 384 * 4096;
    const GAS float* f3 = inp(F, I_HYF3) + (size_t)layer * 64 * 1536; const GAS float* dec = inp(F, I_HYDECAY) + layer * 1536;
    const int lane = F.lane, fr = lane & 15, fq = lane >> 4;
    const GAS float* hid = WSP(const float, WS_HID2) + (size_t)(pbase + pb * 64) * 64;
    f32x4 acc[4][4];
#pragma unroll
    for (int mt = 0; mt < 4; ++mt)
#pragma unroll
        for (int nt = 0; nt < 4; ++nt) acc[mt][nt] = (f32x4){0.f, 0.f, 0.f, 0.f};
#pragma unroll 4
    for (int ks = 0; ks < 16; ++ks) {
        float a[4], bb[4];
#pragma unroll
        for (int mt = 0; mt < 4; ++mt) a[mt] = hid[(16 * mt + fr) * 64 + 4 * ks + fq];
#pragma unroll
        for (int nt = 0; nt < 4; ++nt) bb[nt] = f3[(size_t)(4 * ks + fq) * 1536 + ch * 64 + 16 * nt + fr];
#pragma unroll
        for (int mt = 0; mt < 4; ++mt)
#pragma unroll
            for (int nt = 0; nt < 4; ++nt) acc[mt][nt] = __builtin_amdgcn_mfma_f32_16x16x4f32(a[mt], bb[nt], acc[mt][nt], 0, 0, 0);
    }
#pragma unroll
    for (int nt = 0; nt < 4; ++nt) {
        const int nn = ch * 64 + 16 * nt + fr, o = nn / 768, dir = (nn / 384) & 1, c = nn % 384;
        const float adec = fabsf(dec[nn]);
        GAS bf16* dst = FT + (size_t)(o * 384 + c) * (2 * L);
#pragma unroll
        for (int mt = 0; mt < 4; ++mt)
#pragma unroll
            for (int j = 0; j < 4; ++j) {
                const int pos = pb * 64 + 16 * mt + 4 * fq + j;
                const float t = (float)pos / (float)(L - 1);
                const float v = acc[mt][nt][j] * expf(-t * adec);
                if (dir == 0) dst[L - pos] = (bf16)f2bf(v);
                else if (pos > 0) dst[L + pos] = (bf16)f2bf(v);
            }
    }
}

__device__ __forceinline__ void phase_p0(Frame& F) {
    const int gw = F.wg * NWAVES + F.wave, NGW = F.G * NWAVES;
    LAS float* sl = (LAS float*)F.lds;
    LAS float* red = (LAS float*)(F.lds + 17 * 4096);
    for (int i = F.tid; i < 17 * 1024; i += NTHR) { const int r = i >> 10, k = i & 1023; const float v = r < 16 ? inp(F, I_C)[r * 1024 + k] : inp(F, I_CCTX)[k]; sl[i] = siluf_(v); }
    __syncthreads();
    for (int item = F.wg; item < 2 * 384; item += F.G) {
        const int layer = item / 384, n0 = (item % 384) * 16, j = F.tid & 15, kp = F.tid >> 4;
        const GAS float* W = inp(F, I_WMOD) + (size_t)layer * D * 6144;
        float acc[17];
#pragma unroll
        for (int r = 0; r < 17; ++r) acc[r] = 0.f;
        for (int k = kp * 32; k < kp * 32 + 32; ++k) { const float w = W[(size_t)k * 6144 + n0 + j];
#pragma unroll
            for (int r = 0; r < 17; ++r) acc[r] += sl[r * 1024 + k] * w; }
#pragma unroll
        for (int r = 0; r < 17; ++r) red[(kp * 17 + r) * 16 + j] = acc[r];
        __syncthreads();
        if (F.tid < 272) { const int r = F.tid >> 4, jj = F.tid & 15; float s = inp(F, I_BMOD)[layer * 6144 + n0 + jj];
            for (int q = 0; q < 32; ++q) s += red[(q * 17 + r) * 16 + jj];
            WSP(float, WS_MOD)[(size_t)(layer * 17 + r) * 6144 + n0 + jj] = s; }
        __syncthreads();
    }
    __syncthreads();
    LAS float* scr = (LAS float*)(F.lds + F.wave * 8704);
    conv_weights_win(F, 0, gw, NGW, scr);
    conv_weights_upout(F, 0, gw, NGW, scr);
    for (int i = gw * 64 + F.lane; i < 2048 * 32; i += NGW * 64) {
        const int t = i >> 5, j = i & 31, half = j >> 4, ii = j & 15;
        const float inv = 1.0f / powf(10000.0f, (float)ii / 16.0f);
        const float ang = (float)(half == 0 ? (t >> 6) : (t & 63)) * inv;
        WSP(float, WS_ROPE)[t * 64 + half * 32 + ii] = cosf(ang);
        WSP(float, WS_ROPE)[t * 64 + half * 32 + 16 + ii] = sinf(ang);
    }
    for (int it = gw; it < 4352 / 8; it += NGW) filter_hidden_item(F, it);
}
__device__ __forceinline__ void write_bias(Frame& F) {
    const int gt = (F.wg * NWAVES + F.wave) * 64 + F.lane, NGT = F.G * NTHR;
    for (int i = gt; i < 2 * NWP; i += NGT) {
        const int l = i / NWP, r = i % NWP; float v = 0.f;
        int n = -1;
        if (r < 1152) n = r; else if (r < 1168) n = 3712 + (r - 1152); else if (r < 1280) n = -1; else if (r < 2816) n = 1152 + (r - 1280); else if (r < 3840) n = 2688 + (r - 2816); else n = 3728 + (r - 3840);
        if (n >= 0) v = inp(F, I_BIN)[l * NIN + n];
        WSP(float, WS_BIAS)[i] = v;
    }
}

__device__ __forceinline__ void norm_mod_row(const GAS float* xrow, const GAS float* g, const GAS float* shift, const GAS float* scale, GAS bf16* orow, int lane, float* keep  ) {
    f32x4 v[4]; float s = 0.f;
#pragma unroll
    for (int j = 0; j < 4; ++j) { v[j] = *(const GAS f32x4*)(xrow + 256 * j + 4 * lane); s += (v[j].x * v[j].x + v[j].y * v[j].y) + (v[j].z * v[j].z + v[j].w * v[j].w); }
    const float r = rsqrtf(wave_sum(s) * (1.0f / 1024.0f) + 1e-6f);
#pragma unroll
    for (int j = 0; j < 4; ++j) {
        const f32x4 gg = *(const GAS f32x4*)(g + 256 * j + 4 * lane), sh = *(const GAS f32x4*)(shift + 256 * j + 4 * lane), sc = *(const GAS f32x4*)(scale + 256 * j + 4 * lane);
        f32x4 o;
        o.x = (v[j].x * r * gg.x) * (1.f + sc.x) + sh.x; o.y = (v[j].y * r * gg.y) * (1.f + sc.y) + sh.y;
        o.z = (v[j].z * r * gg.z) * (1.f + sc.z) + sh.z; o.w = (v[j].w * r * gg.w) * (1.f + sc.w) + sh.w;
        if (keep) { keep[4 * j + 0] = o.x; keep[4 * j + 1] = o.y; keep[4 * j + 2] = o.z; keep[4 * j + 3] = o.w; }
        u32x2 w; w.x = pk2(o.x, o.y); w.y = pk2(o.z, o.w);
        *(GAS u32x2*)(orow + 256 * j + 4 * lane) = w;
    }
}
__device__ __forceinline__ const GAS float* xrow_ptr(const Frame& F, int row, bool from_input) {
    if (row < TOKL) return (from_input ? inp(F, I_X) : outp(F)) + (size_t)row * D;
    return (from_input ? inp(F, I_CTX) : WSP(const float, WS_XC)) + (size_t)(row - TOKL) * D;
}
__device__ __forceinline__ void phase_norm(Frame& F, int layer, int nrows, bool from_input, int which) {
    const int gw = F.wg * NWAVES + F.wave, NGW = F.G * NWAVES;
    const GAS float* g = inp(F, which == 0 ? I_GMIX : I_GFFN) + layer * D;
#pragma unroll 2
    for (int row = gw; row < nrows; row += NGW)
        norm_mod_row(xrow_ptr(F, row, from_input), g, mod_ptr(F, layer, row, which), mod_ptr(F, layer, row, which + 1), WSP(bf16, WS_H) + (size_t)row * D, F.lane, nullptr);
}

namespace pg8 {
#ifndef WGM_
#define WGM_ 4
#endif
constexpr int BM = 256, BK = 64, HALF = 128, HTB = HALF * BK * 2, STAGE_BYTES = 8 * HTB, NXCD = 8, WGM = WGM_;
__device__ __forceinline__ int lds_byte(int r, int c) { const int st = (r >> 4) * 2 + (c >> 5), rr = r & 15, cc = c & 31, ob = rr * 64 + cc * 2; return st * 1024 + (ob ^ (((ob >> 9) & 1) << 5)); }
__device__ __forceinline__ void stage_rc(int b, int& R, int& C) { const int st = b / 1024, sb = b % 1024, swz = sb ^ (((sb >> 9) & 1) << 5); R = (st >> 1) * 16 + swz / 64; C = (st & 1) * 32 + (swz % 64) / 2; }
struct Unit { int pm, pn; };
struct OrderPlain {
    static constexpr bool GATHER = false;
    int nM, nN, nwg, G, c;
    __device__ __forceinline__ void init(int nM_, int nN_, int G_, int c_) { nM = nM_; nN = nN_; nwg = nM * nN; G = G_; c = c_; }
    __device__ __forceinline__ bool next(int i, Unit& u) const {
        const long L = (long)i * G + c; if (L >= nwg) return false;
        int wgid = (int)L; { const int q = nwg / NXCD, r = nwg % NXCD, xcd = wgid % NXCD, off = wgid / NXCD; wgid = (xcd < r ? xcd * (q + 1) : r * (q + 1) + (xcd - r) * q) + off; }
        const int nig = WGM * nN, gid = wgid / nig, fm = gid * WGM, gsz = (nM - fm) < WGM ? (nM - fm) : WGM;
        u.pm = fm + ((wgid % nig) % gsz); u.pn = (wgid % nig) / gsz; return true;
    }
    __device__ __forceinline__ int arow(int r) const { return r; }
    __device__ __forceinline__ size_t boff(const Unit&) const { return 0; }
};
struct OrderMoe {
    static constexpr bool GATHER = true;
    OrderPlain o; const GAS int* rowidx; const GAS int* tilee; int t0; size_t bstride; bool gather;
    __device__ __forceinline__ bool next(int i, Unit& u) const { return o.next(i, u); }
    __device__ __forceinline__ int arow(int r) const { return gather ? rowidx[t0 * 256 + r] : r; }
    __device__ __forceinline__ size_t boff(const Unit& u) const { return (size_t)tilee[t0 + u.pm] * bstride; }
};

template <class Epi, class Sched>
__device__ __forceinline__ void gemm_phase(LAS unsigned char* lds, int tid_in, const GAS bf16* A, int lda, const GAS bf16* Bt, int ldb, int K, const Sched& S, const Epi& E) {
    unsigned tid_u = (unsigned)tid_in; asm volatile("" : "+v"(tid_u));
    const int tid = (int)tid_u, wid = __builtin_amdgcn_readfirstlane(tid >> 6), lane = tid & 63, wr = wid >> 2, wc = wid & 3, fr = lane & 15, fq = lane >> 4;
    const int nt = K / BK;
    unsigned voffB[2];
    { int sR[2], sC[2];
#pragma unroll
      for (int i = 0; i < 2; ++i) { stage_rc(tid * 16 + i * 8192, sR[i], sC[i]);
        const int rho = sR[i] & 31, Rb = Epi::PERM ? ((sR[i] & ~31) + 8 * ((rho & 15) >> 2) + 4 * (rho >> 4) + (rho & 3)) : sR[i];
        voffB[i] = (unsigned)(Rb * ldb + sC[i]) * 2u; } }
#define PG8_GATHER_OFFS(pm_) do { unsigned _t = (unsigned)tid; asm volatile("" : "+v"(_t)); _Pragma("unroll") for (int i = 0; i < 2; ++i) { int _R, _C; stage_rc((int)_t * 16 + i * 8192, _R, _C); \
        vc0[i] = (unsigned)((size_t)S.arow((pm_) * BM + _R) * lda + _C) * 2u; vc1[i] = (unsigned)((size_t)S.arow((pm_) * BM + HALF + _R) * lda + _C) * 2u; } } while (0)
    const size_t kstep = (size_t)(BK * 2);
    const size_t hstepB = (size_t)HALF * ldb * 2, tstepB = 2 * hstepB;
    const unsigned ldsw = (unsigned)wid * 1024u;
    const int aoff = lds_byte(wr * 64 + fr, fq * 8), boff = lds_byte(wc * 32 + fr, fq * 8);
#define PG8_SA(b, h) (((b) * 2 + (h)) * HTB)
#define PG8_SB(b, h) ((4 + (b) * 2 + (h)) * HTB)
#define PG8_STAGE2(bufoff, gbase, v0, v1) do { \
        __builtin_amdgcn_global_load_lds((const GAS unsigned*)((const GAS char*)(gbase) + (v0)), (LAS unsigned*)(lds + (bufoff) + ldsw), 16, 0, 0); \
        __builtin_amdgcn_global_load_lds((const GAS unsigned*)((const GAS char*)(gbase) + (v1)), (LAS unsigned*)(lds + (bufoff) + ldsw + 8192), 16, 0, 0); } while (0)
#define PG8_STAGEB(bufoff, gbase) PG8_STAGE2(bufoff, gbase, voffB[0], voffB[1])
#define PG8_LDA(dst, b, h) do { _Pragma("unroll") for (int m = 0; m < 4; ++m) _Pragma("unroll") for (int k = 0; k < 2; ++k) dst[m][k] = *(const LAS bf16x8*)(lds + PG8_SA(b, h) + aoff + m * 2048 + k * 1024); } while (0)
#define PG8_LDB(dst, b, h) do { _Pragma("unroll") for (int n = 0; n < 2; ++n) _Pragma("unroll") for (int k = 0; k < 2; ++k) dst[n][k] = *(const LAS bf16x8*)(lds + PG8_SB(b, h) + boff + n * 2048 + k * 1024); } while (0)
#define PG8_MMA(ai, bj, At, Bt_) do { __builtin_amdgcn_s_setprio(1); _Pragma("unroll") for (int m = 0; m < 4; ++m) _Pragma("unroll") for (int n = 0; n < 2; ++n) _Pragma("unroll") for (int k = 0; k < 2; ++k) \
        acc[ai][bj][m][n] = __builtin_amdgcn_mfma_f32_16x16x32_bf16(Bt_[n][k], At[m][k], acc[ai][bj][m][n], 0, 0, 0); __builtin_amdgcn_s_setprio(0); } while (0)
#define PG8_WAIT_V(n) asm volatile("s_waitcnt vmcnt(" #n ")" ::: "memory")
#define PG8_WAIT_L(n) asm volatile("s_waitcnt lgkmcnt(" #n ")" ::: "memory")
#define PG8_BAR __builtin_amdgcn_s_barrier()
#define PG8_SCHED __builtin_amdgcn_sched_barrier(0)
    Unit cur, nxt; int ui = 0;
    if (!S.next(0, cur)) return;
#ifndef STAGGER
#define STAGGER 0
#endif
    if (STAGGER) { const int grp = (int)(blockIdx.x >> 3) & 3;
        for (int i = 0; i < grp * STAGGER; ++i) __builtin_amdgcn_s_sleep(127); }
    f32x4 acc[2][2][4][2];
#pragma unroll
    for (int a = 0; a < 2; ++a)
#pragma unroll
        for (int b = 0; b < 2; ++b)
#pragma unroll
            for (int m = 0; m < 4; ++m)
#pragma unroll
                for (int n = 0; n < 2; ++n) { float zf; asm volatile("v_mov_b32 %0, 0" : "=v"(zf)); acc[a][b][m][n] = (f32x4){zf, zf, zf, zf}; }
    bf16x8 At[4][2], B0[2][2], B1[2][2];
    constexpr bool GA = Sched::GATHER;
    const size_t hstepA = GA ? 0 : (size_t)HALF * lda * 2, tstepA = (size_t)BM * lda * 2;
    unsigned vc0[2], vc1[2];
    if constexpr (GA) { PG8_GATHER_OFFS(cur.pm); }
    else { int sR, sC;
#pragma unroll
        for (int i = 0; i < 2; ++i) { stage_rc(tid * 16 + i * 8192, sR, sC); vc0[i] = (unsigned)(sR * lda + sC) * 2u; vc1[i] = 0u; } }
#define VC0(i) vc0[i]
#define VC1(i) (GA ? vc1[i] : vc0[i])
#define VN0(i) vc0[i]
#define VN1(i) VC1(i)
    const GAS char* cA = GA ? (const GAS char*)A : (const GAS char*)A + (size_t)cur.pm * tstepA;
    const GAS char* cB = (const GAS char*)Bt + S.boff(cur) * 2 + (size_t)cur.pn * tstepB;
    PG8_STAGEB(PG8_SB(0, 0), cB); PG8_STAGE2(PG8_SA(0, 0), cA, VC0(0), VC0(1)); PG8_STAGEB(PG8_SB(0, 1), cB + hstepB); PG8_STAGE2(PG8_SA(0, 1), cA + hstepA, VC1(0), VC1(1));
    if (wr == 1) PG8_BAR;
    PG8_WAIT_V(4); PG8_BAR;
    PG8_STAGEB(PG8_SB(1, 0), cB + kstep); PG8_STAGE2(PG8_SA(1, 0), cA + kstep, VC0(0), VC0(1)); PG8_STAGEB(PG8_SB(1, 1), cB + hstepB + kstep);
    PG8_WAIT_V(6); PG8_BAR;
    for (;;) {
        const bool has_next = S.next(ui + 1, nxt);
        const GAS char* nB = cB; const GAS char* nA = cA;
        if (has_next) {
            nB = (const GAS char*)Bt + S.boff(nxt) * 2 + (size_t)nxt.pn * tstepB;
            if constexpr (!GA) nA = (const GAS char*)A + (size_t)nxt.pm * tstepA;
        }
        for (int t = 0; t < nt; t += 2) {
            const bool last = (t == nt - 2);
            if constexpr (Epi::HORNER) {
                if (t == 6 || t == 12) {
                    asm volatile("" ::: "memory");
                    const int seg = (t == 6) ? 0 : 1;
                    int hpm = cur.pm, hpn = cur.pn; asm volatile("" : "+s"(hpm), "+s"(hpn));
                    unsigned hln = (unsigned)lane; asm volatile("" : "+v"(hln)); const int hfr = (int)(hln & 15u), hfq = (int)(hln >> 4);
#pragma unroll
                    for (int ai = 0; ai < 2; ++ai) {
                        u32x4 ga[4][2], gb[4][2];
#pragma unroll
                        for (int m = 0; m < 4; ++m)
#pragma unroll
                            for (int bj = 0; bj < 2; ++bj) {
                                const int row = hpm * BM + ai * HALF + wr * 64 + m * 16 + hfr, col = hpn * BM + bj * HALF + wc * 32 + 8 * hfq;
                                ga[m][bj] = E.gate8(seg, row, col); gb[m][bj] = E.gate8(seg + 1, row, col);
                            }
                        asm volatile("" : "+v"(ga[0][0]), "+v"(ga[0][1]), "+v"(ga[1][0]), "+v"(ga[1][1]), "+v"(ga[2][0]), "+v"(ga[2][1]), "+v"(ga[3][0]), "+v"(ga[3][1]),
                                          "+v"(gb[0][0]), "+v"(gb[0][1]), "+v"(gb[1][0]), "+v"(gb[1][1]), "+v"(gb[2][0]), "+v"(gb[2][1]), "+v"(gb[3][0]), "+v"(gb[3][1]) :: "memory");
#pragma unroll
                        for (int m = 0; m < 4; ++m)
#pragma unroll
                            for (int bj = 0; bj < 2; ++bj) {
                                const unsigned aw[4] = {ga[m][bj].x, ga[m][bj].y, ga[m][bj].z, ga[m][bj].w}, bw[4] = {gb[m][bj].x, gb[m][bj].y, gb[m][bj].z, gb[m][bj].w};
#pragma unroll
                                for (int n = 0; n < 2; ++n) {
                                    f32x4& v = acc[ai][bj][m][n];
                                    v.x *= __uint_as_float(aw[2 * n] << 16) * __builtin_amdgcn_rcpf(__uint_as_float(bw[2 * n] << 16));
                                    v.y *= __uint_as_float(aw[2 * n] & 0xffff0000u) * __builtin_amdgcn_rcpf(__uint_as_float(bw[2 * n] & 0xffff0000u));
                                    v.z *= __uint_as_float(aw[2 * n + 1] << 16) * __builtin_amdgcn_rcpf(__uint_as_float(bw[2 * n + 1] << 16));
                                    v.w *= __uint_as_float(aw[2 * n + 1] & 0xffff0000u) * __builtin_amdgcn_rcpf(__uint_as_float(bw[2 * n + 1] & 0xffff0000u));
                                }
                            }
                    }
                    asm volatile("s_waitcnt vmcnt(0)" ::: "memory");
                }
            }
            const GAS char* a1 = cA + (size_t)(t + 1) * kstep;
            const GAS char* a2 = last ? nA : cA + (size_t)(t + 2) * kstep; const GAS char* b2 = last ? nB : cB + (size_t)(t + 2) * kstep;
            const GAS char* a3 = a2 + kstep; const GAS char* b3 = b2 + kstep;
            PG8_LDB(B0, 0, 0); PG8_SCHED; PG8_LDA(At, 0, 0); PG8_STAGE2(PG8_SA(1, 1), a1 + hstepA, VC1(0), VC1(1));
            if constexpr (GA) { if (last && has_next) { asm volatile("" ::: "memory"); PG8_GATHER_OFFS(nxt.pm); asm volatile("" ::: "memory"); } }
            PG8_WAIT_L(8); PG8_BAR; PG8_WAIT_L(0); PG8_MMA(0, 0, At, B0); PG8_BAR; PG8_SCHED;
            PG8_LDB(B1, 0, 1); PG8_STAGEB(PG8_SB(0, 0), b2);
            PG8_BAR; PG8_WAIT_L(0); PG8_MMA(0, 1, At, B1); PG8_BAR;
            PG8_LDA(At, 0, 1); PG8_STAGE2(PG8_SA(0, 0), a2, VN0(0), VN0(1));
            PG8_BAR; PG8_WAIT_L(0); PG8_MMA(1, 0, At, B0); PG8_BAR; PG8_SCHED;
            PG8_STAGEB(PG8_SB(0, 1), b2 + hstepB);
            PG8_WAIT_V(6); PG8_BAR; PG8_MMA(1, 1, At, B1); PG8_BAR;
            PG8_LDB(B0, 1, 0); PG8_SCHED; PG8_LDA(At, 1, 0); PG8_STAGE2(PG8_SA(0, 1), a2 + hstepA, VN1(0), VN1(1));
            PG8_WAIT_L(8); PG8_BAR; PG8_WAIT_L(0); PG8_MMA(0, 0, At, B0); PG8_BAR; PG8_SCHED;
            PG8_LDB(B1, 1, 1); PG8_STAGEB(PG8_SB(1, 0), b3);
            PG8_BAR; PG8_WAIT_L(0); PG8_MMA(0, 1, At, B1); PG8_BAR;
            PG8_LDA(At, 1, 1); PG8_STAGE2(PG8_SA(1, 0), a3, VN0(0), VN0(1));
            PG8_BAR; PG8_WAIT_L(0); PG8_MMA(1, 0, At, B0); PG8_BAR; PG8_SCHED;
            PG8_STAGEB(PG8_SB(1, 1), b3 + hstepB);
            PG8_WAIT_V(6); PG8_BAR; PG8_MMA(1, 1, At, B1); PG8_BAR;
        }
        {
            int epm = cur.pm, epn = cur.pn; asm volatile("" : "+s"(epm), "+s"(epn));
            unsigned eln = (unsigned)lane; asm volatile("" : "+v"(eln)); const int efr = (int)(eln & 15u), efq = (int)(eln >> 4);
            constexpr bool PM = Epi::PERM;
#define PG8_COL(bj, n) (epn * BM + (bj) * HALF + wc * 32 + (PM ? 8 * efq + 4 * (n) : (n) * 16 + 4 * efq))
            f32x4 cv[2][2];
#pragma unroll
            for (int bj = 0; bj < 2; ++bj)
#pragma unroll
                for (int n = 0; n < 2; ++n) { if constexpr (Epi::COLVEC) cv[bj][n] = E.colvec(epm * BM, PG8_COL(bj, n)); else cv[bj][n] = (f32x4){0.f, 0.f, 0.f, 0.f}; }
            if constexpr (Epi::COLVEC) asm volatile("" : "+v"(cv[0][0]), "+v"(cv[0][1]), "+v"(cv[1][0]), "+v"(cv[1][1]) :: "memory");
#pragma unroll
            for (int ai = 0; ai < 2; ++ai) {
                f32x4 bs[4][2][2];
                if constexpr (Epi::BASE) {
#pragma unroll
                    for (int m = 0; m < 4; ++m)
#pragma unroll
                        for (int bj = 0; bj < 2; ++bj) {
                            const int row = epm * BM + ai * HALF + wr * 64 + m * 16 + efr;
                            if constexpr (PM) E.base8(row, PG8_COL(bj, 0), bs[m][bj][0], bs[m][bj][1]);
                            else {
#pragma unroll
                                for (int n = 0; n < 2; ++n) bs[m][bj][n] = E.base(row, PG8_COL(bj, n));
                            }
                        }
                    asm volatile("" : "+v"(bs[0][0][0]), "+v"(bs[0][0][1]), "+v"(bs[0][1][0]), "+v"(bs[0][1][1]), "+v"(bs[1][0][0]), "+v"(bs[1][0][1]), "+v"(bs[1][1][0]), "+v"(bs[1][1][1]),
                                      "+v"(bs[2][0][0]), "+v"(bs[2][0][1]), "+v"(bs[2][1][0]), "+v"(bs[2][1][1]), "+v"(bs[3][0][0]), "+v"(bs[3][0][1]), "+v"(bs[3][1][0]), "+v"(bs[3][1][1]) :: "memory");
                }
#pragma unroll
                for (int m = 0; m < 4; ++m) {
                    const int row = epm * BM + ai * HALF + wr * 64 + m * 16 + efr;
#pragma unroll
                    for (int bj = 0; bj < 2; ++bj) {
                        if constexpr (Epi::PAIR) E.store_pair(row, epn * (BM / 2) + bj * (HALF / 2) + wc * 16 + 4 * efq, acc[ai][bj][m][0], acc[ai][bj][m][1]);
                        else if constexpr (PM) {
                            f32x4 b0 = (f32x4){0.f, 0.f, 0.f, 0.f}, b1 = b0; if constexpr (Epi::BASE) { b0 = bs[m][bj][0]; b1 = bs[m][bj][1]; }
                            E.store8(row, PG8_COL(bj, 0), acc[ai][bj][m][0], acc[ai][bj][m][1], cv[bj][0], cv[bj][1], b0, b1);
                        } else {
#pragma unroll
                            for (int n = 0; n < 2; ++n) { f32x4 bb = (f32x4){0.f, 0.f, 0.f, 0.f}; if constexpr (Epi::BASE) bb = bs[m][bj][n]; E.store(row, PG8_COL(bj, n), acc[ai][bj][m][n], cv[bj][n], bb); }
                        }
                    }
                }
            }
#undef PG8_COL
        }
        if (!has_next) break;
#pragma unroll
        for (int a = 0; a < 2; ++a)
#pragma unroll
            for (int b = 0; b < 2; ++b)
#pragma unroll
                for (int m = 0; m < 4; ++m)
#pragma unroll
                    for (int n = 0; n < 2; ++n) { float zf; asm volatile("v_mov_b32 %0, 0" : "=v"(zf)); acc[a][b][m][n] = (f32x4){zf, zf, zf, zf}; }
        cur = nxt; cB = nB; cA = nA; ++ui;
    }
    PG8_WAIT_V(0);
    if (wr == 0) PG8_BAR;
    PG8_BAR;
#undef PG8_GATHER_OFFS
#undef VC0
#undef VC1
#undef VN0
#undef VN1
#undef PG8_SA
#undef PG8_SB
#undef PG8_STAGE2
#undef PG8_STAGEB
#undef PG8_LDA
#undef PG8_LDB
#undef PG8_MMA
#undef PG8_WAIT_V
#undef PG8_WAIT_L
#undef PG8_BAR
#undef PG8_SCHED
}
}

template <class Epi>
__device__ __forceinline__ void gemm_fast(Frame& F, const GAS bf16* A, int lda, const GAS bf16* Bt, int ldb, int K, int M, int N, const Epi& E) {
    pg8::OrderPlain S; S.init(M / 256, N / 256, F.G, F.wg);
    pg8::gemm_phase(F.lds, F.tid, A, lda, Bt, ldb, K, S, E);
}
#ifndef FAST_PLAIN
#define FAST_PLAIN 1
#endif
#ifndef FAST_HORNER
#define FAST_HORNER 1
#endif
#ifndef FAST_MOE
#define FAST_MOE 1
#endif

__device__ __forceinline__ void st_bf16x4(GAS bf16* p, f32x4 v) { u32x2 w; w.x = pk2(v.x, v.y); w.y = pk2(v.z, v.w); *(GAS u32x2*)p = w; }
__device__ __forceinline__ f32x4 ld_bf16x4(const GAS bf16* p) { const u32x2 w = *(const GAS u32x2*)p; f32x4 v; v.x = __uint_as_float(w.x << 16); v.y = __uint_as_float(w.x & 0xffff0000u); v.z = __uint_as_float(w.y << 16); v.w = __uint_as_float(w.y & 0xffff0000u); return v; }

__device__ __forceinline__ void st_bf16x8(GAS bf16* p, f32x4 a, f32x4 b) { u32x4 w; w.x = pk2(a.x, a.y); w.y = pk2(a.z, a.w); w.z = pk2(b.x, b.y); w.w = pk2(b.z, b.w); *(GAS u32x4*)p = w; }
struct EpiWin {
    static constexpr bool HORNER = false, PAIR = false, COLVEC = true, BASE = false, PERM = true;
    const GAS float* bias; GAS bf16 *hytl, *hytc, *ret, *ml; GAS float* mlg;
    __device__ __forceinline__ f32x4 colvec(int, int col) const { return *(const GAS f32x4*)(bias + col); }
    __device__ __forceinline__ void store8(int row, int col, f32x4 v0, f32x4 v1, f32x4 c0, f32x4 c1, f32x4, f32x4) const {
        v0 += c0; v1 += c1;
        if (col < 1152) {
            const float v[8] = {v0.x, v0.y, v0.z, v0.w, v1.x, v1.y, v1.z, v1.w};
            if (row < TOKL) { const int b = row >> 11, t = row & 2047; GAS bf16* d = hytl + ((size_t)(b * 1152 + col)) * 2048 + t;
#pragma unroll
                for (int j = 0; j < 8; ++j) d[2048 * j] = (bf16)f2bf(v[j]); }
            else { const int r = row - TOKL, b = r >> 8, t = r & 255; GAS bf16* d = hytc + ((size_t)(b * 1152 + col)) * 256 + t;
#pragma unroll
                for (int j = 0; j < 8; ++j) d[256 * j] = (bf16)f2bf(v[j]); }
        } else if (col < 1168) { *(GAS f32x4*)(mlg + (size_t)row * 16 + (col - 1152)) = v0; *(GAS f32x4*)(mlg + (size_t)row * 16 + (col - 1152) + 4) = v1; }
        else if (col < 1280) { }
        else if (col < 2816) st_bf16x8(ret + (size_t)row * 1536 + (col - 1280), v0, v1);
        else st_bf16x8(ml + (size_t)row * 1024 + (col - 2816), v0, v1);
    }
};
struct EpiGate {
    static constexpr bool HORNER = false, PAIR = false, COLVEC = true, BASE = false, PERM = true;
    const GAS float* bias; GAS bf16* gates;
    __device__ __forceinline__ f32x4 colvec(int, int col) const { return *(const GAS f32x4*)(bias + col); }
    __device__ __forceinline__ void store8(int row, int col, f32x4 v0, f32x4 v1, f32x4 c0, f32x4 c1, f32x4, f32x4) const {
        v0 += c0; v1 += c1;
        f32x4 g0, g1;
        g0.x = fmaxf(sigmoidf_(v0.x), 1e-20f); g0.y = fmaxf(sigmoidf_(v0.y), 1e-20f); g0.z = fmaxf(sigmoidf_(v0.z), 1e-20f); g0.w = fmaxf(sigmoidf_(v0.w), 1e-20f);
        g1.x = fmaxf(sigmoidf_(v1.x), 1e-20f); g1.y = fmaxf(sigmoidf_(v1.y), 1e-20f); g1.z = fmaxf(sigmoidf_(v1.z), 1e-20f); g1.w = fmaxf(sigmoidf_(v1.w), 1e-20f);
        st_bf16x8(gates + (size_t)row * NGATE + col, g0, g1);
    }
};
struct EpiUp {
    static constexpr bool HORNER = true, PAIR = false, COLVEC = false, BASE = true, PERM = true;
    const GAS bf16* gates; GAS bf16* acc_out;
    __device__ __forceinline__ u32x4 gate8(int which, int row, int col) const { return *(const GAS u32x4*)(gates + (size_t)row * NGATE + which * 1024 + col); }
    __device__ __forceinline__ void base8(int row, int col, f32x4& b0, f32x4& b1) const {
        const u32x4 w = *(const GAS u32x4*)(gates + (size_t)row * NGATE + 2048 + col);
        b0.x = __uint_as_float(w.x << 16); b0.y = __uint_as_float(w.x & 0xffff0000u); b0.z = __uint_as_float(w.y << 16); b0.w = __uint_as_float(w.y & 0xffff0000u);
        b1.x = __uint_as_float(w.z << 16); b1.y = __uint_as_float(w.z & 0xffff0000u); b1.z = __uint_as_float(w.w << 16); b1.w = __uint_as_float(w.w & 0xffff0000u);
    }
    __device__ __forceinline__ void store8(int row, int col, f32x4 v0, f32x4 v1, f32x4, f32x4, f32x4 g0, f32x4 g1) const { st_bf16x8(acc_out + (size_t)row * D + col, v0 * g0, v1 * g1); }
};
struct EpiResid {
    static constexpr bool HORNER = false, PAIR = false, COLVEC = true, BASE = true, PERM = false;
    const GAS float *xin_l, *xin_c; GAS float *xout_l, *xout_c; const GAS float* modbase; int which; GAS float* dummy;
    __device__ __forceinline__ f32x4 colvec(int row0, int col) const { const int r = row0 < TOKL ? (row0 >> 11) : 16; return *(const GAS f32x4*)(modbase + ((size_t)r * 6 + which) * 1024 + col); }
    __device__ __forceinline__ f32x4 base(int row, int col) const { return row < TOKL ? *(const GAS f32x4*)(xin_l + (size_t)row * D + col) : *(const GAS f32x4*)(xin_c + (size_t)(row - TOKL) * D + col); }
    __device__ __forceinline__ void store(int row, int col, f32x4 v, f32x4 m, f32x4 x) const {
        if (dummy) { *(GAS f32x4*)(dummy + (size_t)(row & 8191) * D + col) = x + m * v; return; }
        if (row < TOKL) *(GAS f32x4*)(xout_l + (size_t)row * D + col) = x + m * v;
        else *(GAS f32x4*)(xout_c + (size_t)(row - TOKL) * D + col) = x + m * v;
    }
};
struct EpiSwiglu {
    static constexpr bool HORNER = false, PAIR = true, COLVEC = false, BASE = false, PERM = false;
    GAS bf16* act; int row_off;
    __device__ __forceinline__ void store_pair(int row, int col, f32x4 a, f32x4 b) const {
        f32x4 o; o.x = siluf_(a.x) * b.x; o.y = siluf_(a.y) * b.y; o.z = siluf_(a.z) * b.z; o.w = siluf_(a.w) * b.w;
        st_bf16x4(act + (size_t)(row - row_off) * DFF + col, o);
    }
    __device__ __forceinline__ void store(int, int, f32x4, f32x4, f32x4) const {}
};
struct EpiBf16Out {
    static constexpr bool HORNER = false, PAIR = false, COLVEC = false, BASE = false, PERM = true;
    GAS bf16* out; int ld; int row_add;
    __device__ __forceinline__ void store8(int row, int col, f32x4 v0, f32x4 v1, f32x4, f32x4, f32x4, f32x4) const { st_bf16x8(out + (size_t)(row + row_add) * ld + col, v0, v1); }
};

constexpr int ZPITCH_L = (LL + 8) * 2, ZPITCH_C = (LC + 8) * 2;
template <int L>
__device__ __forceinline__ float conv3_at(const GAS bf16* base  , int t, float w0, float w1, float w2) {
    const float a = t > 0 ? bf2f(base[t - 1]) : 0.f, b = bf2f(base[t]), c = t < L - 1 ? bf2f(base[t + 1]) : 0.f;
    return w0 * a + w1 * b + w2 * c;
}
template <int L>
__device__ __forceinline__ void hyena_unit_naive(Frame& F, int layer, int c, const GAS bf16* hyt  , const GAS bf16* ft  , GAS bf16* yht  ) {
    constexpr int ZP = (L + 8) * 2;
    constexpr int PER = L / 32;
    constexpr int SUB = 8;
    LAS unsigned char* zimg0 = F.lds;
    LAS unsigned char* zimg1 = F.lds + 16 * ZP;
    LAS bf16* tf = (LAS bf16*)(F.lds + 32 * ZP);
    const GAS float* cw = inp(F, I_HYCONV) + layer * 3 * 1152;
    const GAS float* skip = inp(F, I_HYSKIP) + layer * 2 * 384;
    __syncthreads();
    {
        const int b = F.tid >> 5, seg = F.tid & 31; const GAS bf16* src = hyt + ((size_t)(b * 1152 + c)) * L;
        const float w0 = cw[c], w1 = cw[1152 + c], w2 = cw[2304 + c];
#pragma unroll 2
        for (int j = 0; j < PER; ++j) { const int t = seg * PER + j; *(LAS bf16*)(zimg0 + b * ZP + t * 2) = (bf16)f2bf(conv3_at<L>(src, t, w0, w1, w2)); }
    }
#pragma unroll 1
    for (int o = 0; o < 2; ++o) {
        LAS unsigned char* zs = o == 0 ? zimg0 : zimg1;
        LAS unsigned char* zd = o == 0 ? zimg1 : zimg0;
        const GAS bf16* fsrc = ft + ((size_t)(o * 384 + c)) * (2 * L);
        for (int i = F.tid; i < 2 * L; i += NTHR) tf[i] = i == 0 ? (bf16)0 : fsrc[i];
        __syncthreads();
        const int b = F.tid & 15, tg = F.tid >> 4;
        const int gcol = (o == 0 ? 384 : 768) + c;
        const GAS bf16* gsrc = hyt + ((size_t)(b * 1152 + gcol)) * L;
        const float w0 = cw[gcol], w1 = cw[1152 + gcol], w2 = cw[2304 + gcol], sk = skip[o * 384 + c];
#pragma unroll 1
        for (int sb = 0; sb < PER / SUB; ++sb) {
            const int t0 = tg * PER + sb * SUB;
            float acc[SUB];
#pragma unroll
            for (int j = 0; j < SUB; ++j) acc[j] = 0.f;
#pragma unroll 1
            for (int s0 = 0; s0 < L; s0 += 8) {
                float z[8];
                { const bf16x8 zz = *(const LAS bf16x8*)(zs + b * ZP + s0 * 2);
#pragma unroll
                  for (int i = 0; i < 8; ++i) z[i] = bf2f((bf16)zz[i]); }
                float win[SUB + 7];
                const int wb = L + s0 - t0 - (SUB - 1);
#pragma unroll
                for (int i = 0; i < SUB + 7; ++i) win[i] = bf2f(tf[wb + i]);
#pragma unroll
                for (int j = 0; j < SUB; ++j)
#pragma unroll
                    for (int i = 0; i < 8; ++i) acc[j] += win[(SUB - 1) - j + i] * z[i];
            }
#pragma unroll
            for (int j = 0; j < SUB; ++j) {
                const int t = t0 + j;
                const float zt = bf2f(*(LAS bf16*)(zs + b * ZP + t * 2));
                const float ov = conv3_at<L>(gsrc, t, w0, w1, w2) * (acc[j] + sk * zt);
                *(LAS bf16*)(zd + b * ZP + t * 2) = (bf16)f2bf(ov);
            }
        }
        __syncthreads();
    }
#pragma unroll 2
    for (int i = F.tid; i < 16 * (L / 8); i += NTHR) {
        const int b = i / (L / 8), ch = i % (L / 8);
        *(GAS u32x4*)(yht + ((size_t)(b * 384 + c)) * L + ch * 8) = *(const LAS u32x4*)(zimg0 + b * ZP + ch * 16);
    }
}

template <int L>
__device__ __forceinline__ void hyena_unit_fast(Frame& F, int layer, int c, const GAS bf16* hyt  , const GAS bf16* ft  , GAS bf16* yht  ) {
    constexpr int ZP = (L + 8) * 2;
    constexpr int PER = L / 32;
    constexpr int I = L / 128;
    constexpr int SPAN = L / 4, NSTEP = L / 32;
    constexpr int CP = (2 * L + 8) * 2;
    LAS unsigned char* zimg = F.lds;
    LAS unsigned char* cpy = F.lds + 16 * ZP;
    const GAS float* cw = inp(F, I_HYCONV) + layer * 3 * 1152;
    const GAS float* skip = inp(F, I_HYSKIP) + layer * 2 * 384;
    const int lane = F.lane, fr = lane & 15, fq = lane >> 4, w = F.wave;
    { unsigned long long a_ = (unsigned long long)hyt, b_ = (unsigned long long)yht; asm volatile("" : "+s"(a_), "+s"(b_)); hyt = (const GAS bf16*)a_; yht = (GAS bf16*)b_; }
    __syncthreads();
    {
        const int b = F.tid >> 5, sg = F.tid & 31, t0 = sg * PER; const GAS bf16* src = hyt + ((size_t)(b * 1152 + c)) * L + t0;
        const float w0 = cw[c], w1 = cw[1152 + c], w2 = cw[2304 + c];
        u32x4 raw[PER / 8];
#pragma unroll
        for (int j = 0; j < PER / 8; ++j) raw[j] = *(const GAS u32x4*)(src + 8 * j);
        float prev = t0 > 0 ? bf2f(src[-1]) : 0.f;
        const float nextv = t0 + PER < L ? bf2f(src[PER]) : 0.f;
#pragma unroll
        for (int j = 0; j < PER / 8; ++j) {
            const unsigned wv[4] = {raw[j].x, raw[j].y, raw[j].z, raw[j].w};
            float x[10]; x[0] = prev;
#pragma unroll
            for (int q = 0; q < 4; ++q) { x[1 + 2 * q] = __uint_as_float(wv[q] << 16); x[2 + 2 * q] = __uint_as_float(wv[q] & 0xffff0000u); }
            if (j + 1 < PER / 8) x[9] = __uint_as_float(raw[(j + 1 < PER / 8) ? j + 1 : j].x << 16); else x[9] = nextv;
            u32x4 o;
            o.x = pk2(w0 * x[0] + w1 * x[1] + w2 * x[2], w0 * x[1] + w1 * x[2] + w2 * x[3]); o.y = pk2(w0 * x[2] + w1 * x[3] + w2 * x[4], w0 * x[3] + w1 * x[4] + w2 * x[5]);
            o.z = pk2(w0 * x[4] + w1 * x[5] + w2 * x[6], w0 * x[5] + w1 * x[6] + w2 * x[7]); o.w = pk2(w0 * x[6] + w1 * x[7] + w2 * x[8], w0 * x[7] + w1 * x[8] + w2 * x[9]);
            *(LAS u32x4*)(zimg + b * ZP + (t0 + 8 * j) * 2) = o;
            prev = x[8];
        }
    }
    const int tbase = SPAN * (w >> 1) + 16 * (w & 1);
    const int flane = L - tbase + 8 * fq - fr;
    const int msh = fr & 7;
    const LAS unsigned char* fbase = cpy + msh * CP + 2 * (flane + msh);
#pragma unroll 1
    for (int o = 0; o < 2; ++o) {
        const GAS bf16* fsrc = ft + ((size_t)(o * 384 + c)) * (2 * L);
        for (int i = F.tid; i < CP / 16; i += NTHR) { u32x4 v = (u32x4){0u, 0u, 0u, 0u}; if (i < 2 * L / 8) v = *(const GAS u32x4*)(fsrc + 8 * i); if (i == 0) v.x &= 0xffff0000u; *(LAS u32x4*)(cpy + 16 * i) = v; }
        __syncthreads();
        for (int task = F.tid; task < 7 * (CP / 16); task += NTHR) {
            const int m = 1 + task / (CP / 16), x8 = task % (CP / 16);
            unsigned short e[8];
#pragma unroll
            for (int i = 0; i < 8; ++i) { const int idx = 8 * x8 - m + i; e[i] = idx >= 0 ? *(const LAS unsigned short*)(cpy + 2 * idx) : (unsigned short)0; }
            u32x4 v; v.x = e[0] | ((unsigned)e[1] << 16); v.y = e[2] | ((unsigned)e[3] << 16); v.z = e[4] | ((unsigned)e[5] << 16); v.w = e[6] | ((unsigned)e[7] << 16);
            *(LAS u32x4*)(cpy + m * CP + 16 * x8) = v;
        }
        __syncthreads();
        f32x4 acc[I];
#pragma unroll
        for (int i = 0; i < I; ++i) acc[i] = (f32x4){0.f, 0.f, 0.f, 0.f};
        bf16x8 ring[I];
#pragma unroll
        for (int i = 1; i < I; ++i) ring[(I - i) % I] = *(const LAS bf16x8*)(fbase - 64 * i);
        bf16x8 nf = *(const LAS bf16x8*)(fbase);
        const LAS unsigned char* zrow = zimg + fr * ZP + 16 * fq;
#pragma unroll 1
        for (int j0 = 0; j0 < NSTEP; j0 += I) {
#pragma unroll
            for (int jj = 0; jj < I; ++jj) {
                const int j = j0 + jj;
                ring[jj] = nf;
                if (j + 1 < NSTEP) nf = *(const LAS bf16x8*)(fbase + 64 * (j + 1));
                const bf16x8 zf = *(const LAS bf16x8*)(zrow + 64 * j);
#pragma unroll
                for (int i = 0; i < I; ++i) acc[i] = __builtin_amdgcn_mfma_f32_16x16x32_bf16(ring[(jj - i + I) % I], zf, acc[i], 0, 0, 0);
            }
        }
        unsigned el_ = (unsigned)lane; asm volatile("" : "+v"(el_)); const int efr = (int)(el_ & 15u), efq = (int)(el_ >> 4);
        const int etb = SPAN * (w >> 1) + 16 * (w & 1);
        const int gcol = (o == 0 ? 384 : 768) + c;
        const GAS bf16* gsrc = hyt + ((size_t)(efr * 1152 + gcol)) * L;
        const float w0 = cw[gcol], w1 = cw[1152 + gcol], w2 = cw[2304 + gcol], sk = skip[o * 384 + c];
        GAS bf16* dst = yht + ((size_t)(efr * 384 + c)) * L;
        constexpr int GI = I < 8 ? I : 8;
#pragma unroll
        for (int i0 = 0; i0 < I; i0 += GI) {
            u32x2 grv[GI]; unsigned short gmv[GI], gpv[GI];
#pragma unroll
            for (int ii = 0; ii < GI; ++ii) {
                const int t = etb + 32 * (i0 + ii) + 4 * efq;
                grv[ii] = *(const GAS u32x2*)(gsrc + t); gmv[ii] = t > 0 ? gsrc[t - 1] : (unsigned short)0; gpv[ii] = t + 4 < L ? gsrc[t + 4] : (unsigned short)0;
            }
            asm volatile("" ::: "memory");
#pragma unroll
            for (int ii = 0; ii < GI; ++ii) {
                const int i = i0 + ii;
                const int t = etb + 32 * i + 4 * efq;
                const u32x2 zr = *(const LAS u32x2*)(zimg + efr * ZP + t * 2);
                const u32x2 gr = grv[ii];
                const float gm = bf2f(gmv[ii]), gp = bf2f(gpv[ii]);
                const float g0 = __uint_as_float(gr.x << 16), g1 = __uint_as_float(gr.x & 0xffff0000u), g2 = __uint_as_float(gr.y << 16), g3 = __uint_as_float(gr.y & 0xffff0000u);
                const float z0 = __uint_as_float(zr.x << 16), z1 = __uint_as_float(zr.x & 0xffff0000u), z2 = __uint_as_float(zr.y << 16), z3 = __uint_as_float(zr.y & 0xffff0000u);
                const float o0 = (w0 * gm + w1 * g0 + w2 * g1) * (acc[i].x + sk * z0), o1 = (w0 * g0 + w1 * g1 + w2 * g2) * (acc[i].y + sk * z1);
                const float o2 = (w0 * g1 + w1 * g2 + w2 * g3) * (acc[i].z + sk * z2), o3 = (w0 * g2 + w1 * g3 + w2 * gp) * (acc[i].w + sk * z3);
                acc[i] = (f32x4){o0, o1, o2, o3};
            }
        }
        __syncthreads();
#pragma unroll
        for (int i = 0; i < I; ++i) {
            const int t = etb + 32 * i + 4 * efq;
            u32x2 ov; ov.x = pk2(acc[i].x, acc[i].y); ov.y = pk2(acc[i].z, acc[i].w);
            if (o == 0) *(LAS u32x2*)(zimg + efr * ZP + t * 2) = ov;
            else *(GAS u32x2*)(dst + t) = ov;
        }
    }
}

__device__ __forceinline__ void chain_naive(Frame& F, int layer, int chain) {
    const int lane = F.lane;
    const bool is_ret = chain < 192;
    int b, h, dir;
    if (is_ret) { b = chain / 12; const int r = chain % 12; h = r >> 1; dir = r & 1; }
    else { const int i = chain - 192; b = i >> 3; h = (i & 7) >> 1; dir = i & 1; }
    const GAS bf16* RET = WSP(const bf16, WS_RET); const GAS bf16* ML = WSP(const bf16, WS_ML); const GAS float* MLG = WSP(const float, WS_MLG);
    const GAS float* rope = WSP(const float, WS_ROPE);
    GAS bf16* Y = WSP(bf16, WS_Y); GAS bf16* OB = WSP(bf16, WS_OB);
    float gam = 0.f;
    if (is_ret) gam = sigmoidf_(inp(F, I_RETDECAY)[layer * 12 + dir * 6 + h]);
    const GAS float* mlc = inp(F, I_MLCONV) + layer * 3 * 512;
    const float bi = is_ret ? 0.f : inp(F, I_MLGB)[layer * 16 + dir * 8 + h], bfg = is_ret ? 0.f : inp(F, I_MLGB)[layer * 16 + dir * 8 + 4 + h];
    const float qw0 = mlc[h * 64 + lane], qw1 = mlc[512 + h * 64 + lane], qw2 = mlc[1024 + h * 64 + lane];
    const float kw0 = mlc[256 + h * 64 + lane], kw1 = mlc[512 + 256 + h * 64 + lane], kw2 = mlc[1024 + 256 + h * 64 + lane];
    float S[64];
#pragma unroll
    for (int d = 0; d < 64; ++d) S[d] = 0.f;
    float nv = 0.f;
    for (int step = 0; step < LC + LL; ++step) {
        int row, tpos, L; bool lat;
        if (step < LC) { tpos = dir ? (LC - 1 - step) : step; row = TOKL + b * LC + tpos; L = LC; lat = false; }
        else { const int s2 = step - LC; tpos = dir ? (LL - 1 - s2) : s2; row = b * LL + tpos; L = LL; lat = true; }
        float q, k, v, Fm, Im;
        if (is_ret) {
            const GAS bf16* base = RET + (size_t)row * 1536;
            float qs = bf2f(base[h * 64 + lane]), ks = bf2f(base[384 + h * 64 + lane]);
            v = bf2f(base[768 + h * 64 + lane]);
            if (lat) {
                const float qp = bf2f(base[h * 64 + (lane ^ 16)]), kp = bf2f(base[384 + h * 64 + (lane ^ 16)]);
                const int half = lane >> 5, ii = lane & 15, hi = (lane >> 4) & 1;
                const float cs = rope[tpos * 64 + half * 32 + ii], sn = rope[tpos * 64 + half * 32 + 16 + ii];
                q = hi == 0 ? qs * cs - qp * sn : qp * sn + qs * cs;
                k = hi == 0 ? ks * cs - kp * sn : kp * sn + ks * cs;
            } else { q = qs; k = ks; }
            q *= 0.125f; Fm = gam; Im = 1.f;
        } else {
            const GAS bf16* base = ML + (size_t)row * 1024;
            const float q0 = tpos > 0 ? bf2f(base[-1024 + h * 64 + lane]) : 0.f, q1 = bf2f(base[h * 64 + lane]), q2 = tpos < L - 1 ? bf2f(base[1024 + h * 64 + lane]) : 0.f;
            const float k0 = tpos > 0 ? bf2f(base[-1024 + 256 + h * 64 + lane]) : 0.f, k1 = bf2f(base[256 + h * 64 + lane]), k2 = tpos < L - 1 ? bf2f(base[1024 + 256 + h * 64 + lane]) : 0.f;
            q = siluf_(qw0 * q0 + qw1 * q1 + qw2 * q2);
            k = siluf_(kw0 * k0 + kw1 * k1 + kw2 * k2) * 0.125f;
            v = bf2f(base[512 + h * 64 + lane]);
            const float ig = MLG[(size_t)row * 16 + dir * 8 + h] + bi, fg = MLG[(size_t)row * 16 + dir * 8 + 4 + h] + bfg;
            Fm = sigmoidf_(fg); Im = __expf(ig);
        }
        float num = 0.f;
        const float iv = Im * v;
#pragma unroll
        for (int d = 0; d < 64; ++d) {
            const float kd = __int_as_float(__builtin_amdgcn_readlane(__float_as_int(k), d));
            const float qd = __int_as_float(__builtin_amdgcn_readlane(__float_as_int(q), d));
            S[d] = Fm * S[d] + kd * iv;
            num += qd * S[d];
        }
        float o = num;
        if (!is_ret) { nv = Fm * nv + Im * k; const float den = wave_sum(q * nv); o = num / fmaxf(fabsf(den), 1.f); }
        const int cof = is_ret ? (h * 64 + lane) : (384 + h * 64 + lane);
        if (dir == 0) Y[(size_t)row * D + 384 + cof] = (bf16)f2bf(o);
        else OB[(size_t)row * 640 + cof] = (bf16)f2bf(o);
    }
}

#ifndef REP_CH
#define REP_CH 1
#endif
#ifndef REP_CH_ML
#define REP_CH_ML REP_CH
#endif
#ifndef REP_CH_RET
#define REP_CH_RET REP_CH
#endif
constexpr int CH_PITCH = 144;
constexpr int CH_IMG = 64 * CH_PITCH;
constexpr int CH_WAVE_LDS = 3 * CH_IMG + 1024 + 512;
__device__ __forceinline__ void ds_tr16x8(unsigned addr, u32x2 (&lo)[4], u32x2 (&hi)[4]) {
    asm volatile("ds_read_b64_tr_b16 %0, %8\n\tds_read_b64_tr_b16 %1, %8 offset:32\n\tds_read_b64_tr_b16 %2, %8 offset:64\n\tds_read_b64_tr_b16 %3, %8 offset:96\n\t"
                 "ds_read_b64_tr_b16 %4, %8 offset:2304\n\tds_read_b64_tr_b16 %5, %8 offset:2336\n\tds_read_b64_tr_b16 %6, %8 offset:2368\n\tds_read_b64_tr_b16 %7, %8 offset:2400\n\t"
                 "s_waitcnt lgkmcnt(0)"
                 : "=&v"(lo[0]), "=&v"(lo[1]), "=&v"(lo[2]), "=&v"(lo[3]), "=&v"(hi[0]), "=&v"(hi[1]), "=&v"(hi[2]), "=&v"(hi[3]) : "v"(addr) : "memory");
}
static_assert(16 * CH_PITCH == 2304, "ds_tr16x8 offsets");
__device__ __forceinline__ void ds_tr16x4(unsigned addr, u32x2 (&lo)[2], u32x2 (&hi)[2]) {
    asm volatile("ds_read_b64_tr_b16 %0, %4\n\tds_read_b64_tr_b16 %1, %4 offset:32\n\tds_read_b64_tr_b16 %2, %4 offset:2304\n\tds_read_b64_tr_b16 %3, %4 offset:2336\n\ts_waitcnt lgkmcnt(0)"
                 : "=&v"(lo[0]), "=&v"(lo[1]), "=&v"(hi[0]), "=&v"(hi[1]) : "v"(addr) : "memory");
}
__device__ __forceinline__ float log_sigmoid_(float x) { return fminf(x, 0.f) - log1pf(__expf(-fabsf(x))); }
__device__ __forceinline__ bf16x8 mk_frag(u32x2 lo, u32x2 hi) { u32x4 w; w.x = lo.x; w.y = lo.y; w.z = hi.x; w.w = hi.y; return __builtin_bit_cast(bf16x8, w); }

template <bool IS_ML>
__device__ __forceinline__ void chain_fast(Frame& F, int layer, int b, int h, int dir, LAS unsigned char* img, int hf) {
    constexpr int NET = 2;
    const int lane = F.lane, fr = lane & 15, fq = lane >> 4;
    LAS unsigned char* Qi = img; LAS unsigned char* Ki = img + CH_IMG; LAS unsigned char* Vi = img + 2 * CH_IMG;
    const unsigned qa = (unsigned)(size_t)Qi, ka = (unsigned)(size_t)Ki, va = (unsigned)(size_t)Vi;
    const GAS bf16* RET = WSP(const bf16, WS_RET); const GAS bf16* ML = WSP(const bf16, WS_ML); const GAS float* MLG = WSP(const float, WS_MLG);
    const GAS float* rope = WSP(const float, WS_ROPE);
    GAS bf16* Y = WSP(bf16, WS_Y); GAS bf16* OB = WSP(bf16, WS_OB);
    float lgam = 0.f, bi_ = 0.f, bf_ = 0.f;
    if (!IS_ML) lgam = log_sigmoid_(inp(F, I_RETDECAY)[layer * 12 + dir * 6 + h]);
    else { bi_ = inp(F, I_MLGB)[layer * 16 + dir * 8 + h]; bf_ = inp(F, I_MLGB)[layer * 16 + dir * 8 + 4 + h]; }
    const GAS float* mlc = inp(F, I_MLCONV) + layer * 3 * 512;
    f32x4 C[4][NET];
#pragma unroll
    for (int dt = 0; dt < 4; ++dt)
#pragma unroll
        for (int et = 0; et < NET; ++et) C[dt][et] = (f32x4){0.f, 0.f, 0.f, 0.f};
    const int cq = lane & 7, pr0 = lane >> 3;
    LAS float* nvec = (LAS float*)(img + 3 * CH_IMG + 1024 + 256 * hf);
    if (IS_ML) nvec[lane] = 0.f;
    const LAS float* nq = nvec + 4 * fq;
#pragma unroll 1
    for (int step_ = 0; step_ < 36 * (IS_ML ? REP_CH_ML : REP_CH_RET); ++step_) {
        const int step = step_ % 36;
        if ((IS_ML ? REP_CH_ML : REP_CH_RET) > 1 && step == 0) {
            if (IS_ML) nvec[lane] = 0.f;
#pragma unroll
            for (int dt = 0; dt < 4; ++dt)
#pragma unroll
                for (int et = 0; et < NET; ++et) C[dt][et] = (f32x4){0.f, 0.f, 0.f, 0.f};
        }
        int rowbase, t0, L; bool lat;
        if (step < 4) { const int cc = dir ? 3 - step : step; rowbase = TOKL + b * LC + cc * 64; t0 = cc * 64; L = LC; lat = false; }
        else { const int cc = dir ? 35 - step : step - 4; rowbase = b * LL + cc * 64; t0 = cc * 64; L = LL; lat = true; }
        float g_i = 0.f, g_f = 0.f;
        if (IS_ML) { const int tlg = dir ? 63 - lane : lane; const GAS float* gp = MLG + (size_t)(rowbase + tlg) * 16 + dir * 8 + h; g_i = gp[0]; g_f = gp[4]; }
        if constexpr (!IS_ML) {
#pragma unroll
        for (int i4 = 0; i4 < 4; ++i4) {
            const int i = 4 * hf + i4;
            const int p = pr0 + 8 * i, tl = dir ? 63 - p : p, row = rowbase + tl, tpos = t0 + tl;
            float qv[8], kv[8]; u32x4 vraw;
            {
                const GAS bf16* base = RET + (size_t)row * 1536 + h * 64;
                const u32x4 qr = *(const GAS u32x4*)(base + 8 * cq), kr = *(const GAS u32x4*)(base + 384 + 8 * cq); vraw = *(const GAS u32x4*)(base + 768 + 8 * cq);
                const unsigned qw[4] = {qr.x, qr.y, qr.z, qr.w}, kw[4] = {kr.x, kr.y, kr.z, kr.w};
#pragma unroll
                for (int j = 0; j < 4; ++j) { qv[2 * j] = __uint_as_float(qw[j] << 16); qv[2 * j + 1] = __uint_as_float(qw[j] & 0xffff0000u); kv[2 * j] = __uint_as_float(kw[j] << 16); kv[2 * j + 1] = __uint_as_float(kw[j] & 0xffff0000u); }
                if (lat) {
                    const u32x4 qpr = *(const GAS u32x4*)(base + 8 * (cq ^ 2)), kpr = *(const GAS u32x4*)(base + 384 + 8 * (cq ^ 2));
                    const unsigned qpw[4] = {qpr.x, qpr.y, qpr.z, qpr.w}, kpw[4] = {kpr.x, kpr.y, kpr.z, kpr.w};
                    const int half = cq >> 2, hi = (cq >> 1) & 1, i0 = 8 * (cq & 1);
                    const GAS float* rp = rope + tpos * 64 + half * 32 + i0;
                    const f32x4 c0 = *(const GAS f32x4*)(rp), c1 = *(const GAS f32x4*)(rp + 4), s0 = *(const GAS f32x4*)(rp + 16), s1 = *(const GAS f32x4*)(rp + 20);
                    const float cs[8] = {c0.x, c0.y, c0.z, c0.w, c1.x, c1.y, c1.z, c1.w}, sn[8] = {s0.x, s0.y, s0.z, s0.w, s1.x, s1.y, s1.z, s1.w};
#pragma unroll
                    for (int j = 0; j < 8; ++j) {
                        const float qp = (j & 1) ? __uint_as_float(qpw[j >> 1] & 0xffff0000u) : __uint_as_float(qpw[j >> 1] << 16);
                        const float kp = (j & 1) ? __uint_as_float(kpw[j >> 1] & 0xffff0000u) : __uint_as_float(kpw[j >> 1] << 16);
                        qv[j] = hi ? qp * sn[j] + qv[j] * cs[j] : qv[j] * cs[j] - qp * sn[j];
                        kv[j] = hi ? kp * sn[j] + kv[j] * cs[j] : kv[j] * cs[j] - kp * sn[j];
                    }
                }
#pragma unroll
                for (int j = 0; j < 8; ++j) qv[j] *= 0.125f;
            }
            u32x4 qo, ko; qo.x = pk2(qv[0], qv[1]); qo.y = pk2(qv[2], qv[3]); qo.z = pk2(qv[4], qv[5]); qo.w = pk2(qv[6], qv[7]);
            ko.x = pk2(kv[0], kv[1]); ko.y = pk2(kv[2], kv[3]); ko.z = pk2(kv[4], kv[5]); ko.w = pk2(kv[6], kv[7]);
            *(LAS u32x4*)(Qi + p * CH_PITCH + 16 * cq) = qo; *(LAS u32x4*)(Ki + p * CH_PITCH + 16 * cq) = ko; *(LAS u32x4*)(Vi + p * CH_PITCH + 16 * cq) = vraw;
        }
        } else {
            const GAS float* wq = mlc + h * 64 + 8 * cq;
            u32x4 rr[2][3][4], vr[4];
#pragma unroll
            for (int i4 = 0; i4 < 4; ++i4) {
                const int p = pr0 + 8 * (4 * hf + i4), tl = dir ? 63 - p : p, row = rowbase + tl, tpos = t0 + tl;
                const GAS bf16* bb = ML + (size_t)row * 1024 + h * 64 + 8 * cq;
                const u32x4 z4 = (u32x4){0u, 0u, 0u, 0u};
#pragma unroll
                for (int qk = 0; qk < 2; ++qk) {
                    rr[qk][1][i4] = *(const GAS u32x4*)(bb + 256 * qk);
                    rr[qk][0][i4] = tpos > 0 ? *(const GAS u32x4*)(bb + 256 * qk - 1024) : z4;
                    rr[qk][2][i4] = tpos < L - 1 ? *(const GAS u32x4*)(bb + 256 * qk + 1024) : z4;
                }
                vr[i4] = *(const GAS u32x4*)(bb + 512);
            }
#pragma unroll
            for (int qk = 0; qk < 2; ++qk) {
                f32x4 wt[3][2];
#pragma unroll
                for (int tp = 0; tp < 3; ++tp) { wt[tp][0] = *(const GAS f32x4*)(wq + 256 * qk + 512 * tp); wt[tp][1] = *(const GAS f32x4*)(wq + 256 * qk + 512 * tp + 4); }
#pragma unroll
                for (int i4 = 0; i4 < 4; ++i4) {
                    const int p = pr0 + 8 * (4 * hf + i4);
                    const unsigned a0[4] = {rr[qk][0][i4].x, rr[qk][0][i4].y, rr[qk][0][i4].z, rr[qk][0][i4].w}, a1[4] = {rr[qk][1][i4].x, rr[qk][1][i4].y, rr[qk][1][i4].z, rr[qk][1][i4].w},
                                   a2[4] = {rr[qk][2][i4].x, rr[qk][2][i4].y, rr[qk][2][i4].z, rr[qk][2][i4].w};
                    float ov[8];
#pragma unroll
                    for (int j = 0; j < 8; ++j) {
                        const float x0 = (j & 1) ? __uint_as_float(a0[j >> 1] & 0xffff0000u) : __uint_as_float(a0[j >> 1] << 16);
                        const float x1 = (j & 1) ? __uint_as_float(a1[j >> 1] & 0xffff0000u) : __uint_as_float(a1[j >> 1] << 16);
                        const float x2 = (j & 1) ? __uint_as_float(a2[j >> 1] & 0xffff0000u) : __uint_as_float(a2[j >> 1] << 16);
                        const float r = siluf_(wt[0][j >> 2][j & 3] * x0 + wt[1][j >> 2][j & 3] * x1 + wt[2][j >> 2][j & 3] * x2);
                        ov[j] = qk == 0 ? r : r * 0.125f;
                    }
                    u32x4 o; o.x = pk2(ov[0], ov[1]); o.y = pk2(ov[2], ov[3]); o.z = pk2(ov[4], ov[5]); o.w = pk2(ov[6], ov[7]);
                    if (qk == 0) *(LAS u32x4*)(Qi + p * CH_PITCH + 16 * cq) = o;
                    else { *(LAS u32x4*)(Ki + p * CH_PITCH + 16 * cq) = o; *(LAS u32x4*)(Vi + p * CH_PITCH + 16 * cq) = vr[i4]; }
                }
            }
        }
        __builtin_amdgcn_sched_barrier(0);
        float f_p, i_p;
        if (!IS_ML) { f_p = lgam; i_p = 0.f; }
        else { i_p = g_i + bi_; f_p = log_sigmoid_(g_f + bf_); }
        float bsum = f_p;
#pragma unroll
        for (int o = 1; o < 64; o <<= 1) { const float t = lane_read(bsum, lane >= o ? lane - o : lane); if (lane >= o) bsum += t; }
        LAS float* gv = (LAS float*)(img + 3 * CH_IMG);
        const float b63 = __int_as_float(__builtin_amdgcn_readlane(__float_as_int(bsum), 63));
        const float adec = __expf(b63);
        if (hf == 0) { gv[lane] = bsum; gv[64 + lane] = bsum - i_p; gv[128 + lane] = __expf(bsum); gv[192 + lane] = __expf(b63 - (bsum - i_p)); }
        asm volatile("s_waitcnt lgkmcnt(0)" ::: "memory");
        __syncthreads();
        const LAS float* gq = gv + 4 * fq;
        const bf16x8 ones = (fr == 0) ? (bf16x8){0x3F80, 0x3F80, 0x3F80, 0x3F80, 0x3F80, 0x3F80, 0x3F80, 0x3F80} : (bf16x8){0, 0, 0, 0, 0, 0, 0, 0};
        const int tr_q = fr >> 2, tr_p = fr & 3;
#pragma unroll 1
        for (int pt = 0; pt < 4; ++pt) {
            f32x4 ST[4];
            bf16x8 qn[2];
#pragma unroll
            for (int kk = 0; kk < 2; ++kk) qn[kk] = *(const LAS bf16x8*)(Qi + (16 * pt + fr) * CH_PITCH + (32 * kk + 8 * fq) * 2);
#pragma unroll
            for (int st = 0; st < 4; ++st) {
                ST[st] = (f32x4){0.f, 0.f, 0.f, 0.f};
                if (st <= pt) {
#pragma unroll
                    for (int kk = 0; kk < 2; ++kk) { const bf16x8 kf = *(const LAS bf16x8*)(Ki + (16 * st + fr) * CH_PITCH + (32 * kk + 8 * fq) * 2); ST[st] = __builtin_amdgcn_mfma_f32_16x16x32_bf16(kf, qn[kk], ST[st], 0, 0, 0); }
                }
            }
            const float bp = gv[16 * pt + fr];
#pragma unroll
            for (int st = 0; st < 4; ++st) {
                if (st <= pt) {
                    const f32x4 bis = *(const LAS f32x4*)(gq + 64 + 16 * st);
#pragma unroll
                    for (int j = 0; j < 4; ++j) { const int sidx = 16 * st + 4 * fq + j; const float w = (sidx <= 16 * pt + fr) ? __expf(bp - bis[j]) : 0.f; ST[st][j] *= w; }
                }
            }
            __builtin_amdgcn_sched_barrier(0);
            f32x4 acc[NET], accd = (f32x4){0.f, 0.f, 0.f, 0.f};
#pragma unroll
            for (int et = 0; et < NET; ++et) acc[et] = (f32x4){0.f, 0.f, 0.f, 0.f};
#pragma unroll
            for (int kk = 0; kk < 2; ++kk) {
                const u32x2 lo = *(const LAS u32x2*)(Qi + (16 * pt + fr) * CH_PITCH + (32 * kk + 4 * fq) * 2), hi = *(const LAS u32x2*)(Qi + (16 * pt + fr) * CH_PITCH + (32 * kk + 16 + 4 * fq) * 2);
                const bf16x8 qs = mk_frag(lo, hi);
#pragma unroll
                for (int et = 0; et < NET; ++et) {
                    u32x4 w; w.x = pk2(C[2 * kk][et].x, C[2 * kk][et].y); w.y = pk2(C[2 * kk][et].z, C[2 * kk][et].w); w.z = pk2(C[2 * kk + 1][et].x, C[2 * kk + 1][et].y); w.w = pk2(C[2 * kk + 1][et].z, C[2 * kk + 1][et].w);
                    acc[et] = __builtin_amdgcn_mfma_f32_16x16x32_bf16(qs, __builtin_bit_cast(bf16x8, w), acc[et], 0, 0, 0);
                }
                if (IS_ML) {
                    const f32x4 n0 = *(const LAS f32x4*)(nq + 32 * kk), n1 = *(const LAS f32x4*)(nq + 32 * kk + 16);
                    u32x4 w; w.x = pk2(n0.x, n0.y); w.y = pk2(n0.z, n0.w); w.z = pk2(n1.x, n1.y); w.w = pk2(n1.z, n1.w);
                    if (fr != 0) w = (u32x4){0u, 0u, 0u, 0u};
                    accd = __builtin_amdgcn_mfma_f32_16x16x32_bf16(qs, __builtin_bit_cast(bf16x8, w), accd, 0, 0, 0);
                }
            }
            { const f32x4 ap = *(const LAS f32x4*)(gq + 128 + 16 * pt);
#pragma unroll
              for (int j = 0; j < 4; ++j) {
#pragma unroll
                for (int et = 0; et < NET; ++et) acc[et][j] *= ap[j];
                accd[j] *= ap[j]; } }
            __builtin_amdgcn_sched_barrier(0);
#pragma unroll
            for (int kk = 0; kk < 2; ++kk) {
                if (2 * kk <= pt) {
                    u32x4 w; w.x = pk2(ST[2 * kk].x, ST[2 * kk].y); w.y = pk2(ST[2 * kk].z, ST[2 * kk].w); w.z = pk2(ST[2 * kk + 1].x, ST[2 * kk + 1].y); w.w = pk2(ST[2 * kk + 1].z, ST[2 * kk + 1].w);
                    const bf16x8 pf = __builtin_bit_cast(bf16x8, w);
                    u32x2 vlo[2], vhi[2];
                    ds_tr16x4(va + (32 * kk + 4 * fq + tr_q) * CH_PITCH + 8 * tr_p + 64 * hf, vlo, vhi);
#pragma unroll
                    for (int et = 0; et < NET; ++et) acc[et] = __builtin_amdgcn_mfma_f32_16x16x32_bf16(pf, mk_frag(vlo[et], vhi[et]), acc[et], 0, 0, 0);
                    if (IS_ML) accd = __builtin_amdgcn_mfma_f32_16x16x32_bf16(pf, ones, accd, 0, 0, 0);
                }
            }
            __builtin_amdgcn_sched_barrier(0);
#pragma unroll
            for (int j = 0; j < 4; ++j) {
                const int p = 16 * pt + 4 * fq + j, tl = dir ? 63 - p : p, row = rowbase + tl;
                float inv = 1.f;
                if (IS_ML) { const float den = lane_read(accd[j], lane & 48); inv = __builtin_amdgcn_rcpf(fmaxf(fabsf(den), 1.f)); }
                const int cof = (IS_ML ? 384 : 0) + h * 64 + 32 * hf + fr;
                const unsigned boff = dir == 0 ? (unsigned)(row * D + 384 + cof) * 2u : (unsigned)(row * 640 + cof) * 2u;
                GAS char* ob = dir == 0 ? (GAS char*)Y : (GAS char*)OB;
#pragma unroll
                for (int et = 0; et < NET; ++et) *(GAS bf16*)(ob + boff + 32 * et) = (bf16)f2bf(acc[et][j] * inv);
            }
        }
        __builtin_amdgcn_sched_barrier(0);
#pragma unroll
        for (int dt = 0; dt < 4; ++dt)
#pragma unroll
            for (int et = 0; et < NET; ++et) C[dt][et] *= adec;
        f32x4 accn[4];
        if (IS_ML) {
#pragma unroll
            for (int dt = 0; dt < 4; ++dt) { accn[dt] = *(const LAS f32x4*)(nq + 16 * dt) * adec; if (fr != 0) accn[dt] = (f32x4){0.f, 0.f, 0.f, 0.f}; }
        }
#pragma unroll
        for (int kk = 0; kk < 2; ++kk) {
            u32x2 vlo[2], vhi[2], klo[4], khi[4];
            ds_tr16x4(va + (32 * kk + 4 * fq + tr_q) * CH_PITCH + 8 * tr_p + 64 * hf, vlo, vhi);
            ds_tr16x8(ka + (32 * kk + 4 * fq + tr_q) * CH_PITCH + 8 * tr_p, klo, khi);
            const f32x4 wl = *(const LAS f32x4*)(gq + 192 + 32 * kk), wh = *(const LAS f32x4*)(gq + 192 + 32 * kk + 16);
#pragma unroll
            for (int dt = 0; dt < 4; ++dt) {
                u32x4 w;
                w.x = pk2(__uint_as_float(klo[dt].x << 16) * wl[0], __uint_as_float(klo[dt].x & 0xffff0000u) * wl[1]);
                w.y = pk2(__uint_as_float(klo[dt].y << 16) * wl[2], __uint_as_float(klo[dt].y & 0xffff0000u) * wl[3]);
                w.z = pk2(__uint_as_float(khi[dt].x << 16) * wh[0], __uint_as_float(khi[dt].x & 0xffff0000u) * wh[1]);
                w.w = pk2(__uint_as_float(khi[dt].y << 16) * wh[2], __uint_as_float(khi[dt].y & 0xffff0000u) * wh[3]);
                const bf16x8 kf = __builtin_bit_cast(bf16x8, w);
#pragma unroll
                for (int et = 0; et < NET; ++et) C[dt][et] = __builtin_amdgcn_mfma_f32_16x16x32_bf16(kf, mk_frag(vlo[et], vhi[et]), C[dt][et], 0, 0, 0);
                if (IS_ML) accn[dt] = __builtin_amdgcn_mfma_f32_16x16x32_bf16(kf, ones, accn[dt], 0, 0, 0);
            }
        }
        if (IS_ML) { if (fr == 0) {
#pragma unroll
            for (int dt = 0; dt < 4; ++dt) *(LAS f32x4*)(nvec + 4 * fq + 16 * dt) = accn[dt]; } }
        asm volatile("s_waitcnt lgkmcnt(0)" ::: "memory");
        __syncthreads();
    }
}

#ifndef FAST_CHAIN
#define FAST_CHAIN 1
#endif
constexpr int NCHWG = 160;
__device__ __forceinline__ void phase_mix(Frame& F, int layer) {
    const bool last = layer == 1;
    const GAS bf16* ftl = WSP(const bf16, WS_FTL) + (size_t)layer * 2 * 384 * 4096;
    if (FAST_CHAIN) {
        if (F.wg < NCHWG) {
            if (F.wave >= 4) {
#pragma unroll 1
                for (int i = 0; i < 72 * (F.wg * 2 < 192 ? REP_CH_RET : REP_CH_ML); ++i) __syncthreads();
            } else {
                const int cl = F.wave >> 1, hf = F.wave & 1, c = F.wg * 2 + cl;
                LAS unsigned char* img = F.lds + cl * CH_WAVE_LDS;
                {
                if (c < 192) { const int b = c / 12, r = c % 12; chain_fast<false>(F, layer, b, r >> 1, r & 1, img, hf); }
                else { const int i = c - 192; chain_fast<true>(F, layer, i >> 3, (i & 7) >> 1, i & 1, img, hf); }
                }
            }
        } else {
            const int nh = F.G - NCHWG, w = F.wg - NCHWG;
#ifndef FAST_HY
#define FAST_HY 1
#endif
            if (FAST_HY) {
#ifndef REP_HY
#define REP_HY 1
#endif
#pragma unroll 1
                for (int rp = 0; rp < REP_HY; ++rp)
                for (int u = w; u < 384; u += nh) hyena_unit_fast<LL>(F, layer, u, WSP(const bf16, WS_HYTL), ftl, WSP(bf16, WS_YHTL));
                if (!last) for (int u = w; u < 384; u += nh) hyena_unit_fast<LC>(F, layer, u, WSP(const bf16, WS_HYTC), WSP(const bf16, WS_FTC), WSP(bf16, WS_YHTC));
            } else {
                for (int u = w; u < 384; u += nh) hyena_unit_naive<LL>(F, layer, u, WSP(const bf16, WS_HYTL), ftl, WSP(bf16, WS_YHTL));
                if (!last) for (int u = w; u < 384; u += nh) hyena_unit_naive<LC>(F, layer, u, WSP(const bf16, WS_HYTC), WSP(const bf16, WS_FTC), WSP(bf16, WS_YHTC));
            }
        }
    } else {
        for (int u = F.wg; u < 384; u += F.G) hyena_unit_naive<LL>(F, layer, u, WSP(const bf16, WS_HYTL), ftl, WSP(bf16, WS_YHTL));
        if (!last) for (int u = F.wg; u < 384; u += F.G) hyena_unit_naive<LC>(F, layer, u, WSP(const bf16, WS_HYTC), WSP(const bf16, WS_FTC), WSP(bf16, WS_YHTC));
        for (int c = F.wg + F.wave * F.G; c < 320; c += F.G * NWAVES) chain_naive(F, layer, c);
    }
}

__device__ __forceinline__ void phase_combine(Frame& F, int layer, bool dummy = false) {
    const bool last = layer == 1;
    const int gw = F.wg * NWAVES + F.wave, NGW = F.G * NWAVES, lane = F.lane;
    const int nrows = last ? TOKL : TOK;
    GAS bf16* Y = WSP(bf16, WS_Y); const GAS bf16* OB = WSP(const bf16, WS_OB); const GAS bf16* RET = WSP(const bf16, WS_RET); const GAS bf16* ML = WSP(const bf16, WS_ML);
#pragma unroll 2
    for (int row = gw; row < nrows; row += NGW) {
#pragma unroll
        for (int hh = 0; hh < 10; ++hh) {
            const int cof = hh * 64 + lane;
            const float x = bf2f(Y[(size_t)row * D + 384 + cof]) + bf2f(OB[(size_t)row * 640 + cof]);
            const float mu = wave_sum(x) * (1.f / 64.f), xc = x - mu;
            const float var = wave_sum(xc * xc) * (1.f / 64.f);
            const float nrm = xc * rsqrtf(var + 1e-6f);
            float gate;
            if (hh < 6) gate = siluf_(bf2f(RET[(size_t)row * 1536 + 1152 + cof]));
            else gate = sigmoidf_(bf2f(ML[(size_t)row * 1024 + 768 + (cof - 384)]));
            (dummy ? WSP(bf16, WS_U + 300 * MiB) : Y)[(size_t)(dummy ? (row & 8191) : row) * D + 384 + cof] = (bf16)f2bf(nrm * gate);
        }
    }
    LAS unsigned char* scr = F.lds + F.wave * 8704;
    const int nitL = NB * 6 * 32, nitC = last ? 0 : NB * 6 * 4;
    for (int it = gw; it < nitL + nitC; it += NGW) {
        const GAS bf16* src; int L, rowbase, b, cb, tb;
        if (it < nitL) { b = it / 192; const int r = it % 192; cb = r / 32; tb = r % 32; L = LL; src = WSP(const bf16, WS_YHTL); rowbase = b * LL; }
        else { const int i2 = it - nitL; b = i2 / 24; const int r = i2 % 24; cb = r / 4; tb = r % 4; L = LC; src = WSP(const bf16, WS_YHTC); rowbase = TOKL + b * LC; }
        u32x4 v[8];
#pragma unroll
        for (int i = 0; i < 8; ++i) { const int cc = (lane >> 3) + 8 * i; v[i] = *(const GAS u32x4*)(src + ((size_t)(b * 384 + cb * 64 + cc)) * L + tb * 64 + 8 * (lane & 7)); }
#pragma unroll
        for (int i = 0; i < 8; ++i) { const int cc = (lane >> 3) + 8 * i; *(LAS u32x4*)(scr + cc * 136 + 16 * (lane & 7)) = v[i]; }
        asm volatile("s_waitcnt lgkmcnt(0)" ::: "memory");
#pragma unroll
        for (int i = 0; i < 8; ++i) {
            const int tt = (lane >> 3) + 8 * i, c8 = 8 * (lane & 7);
            unsigned short e[8];
#pragma unroll
            for (int j = 0; j < 8; ++j) e[j] = *(const LAS unsigned short*)(scr + (c8 + j) * 136 + tt * 2);
            u32x4 o; o.x = e[0] | ((unsigned)e[1] << 16); o.y = e[2] | ((unsigned)e[3] << 16); o.z = e[4] | ((unsigned)e[5] << 16); o.w = e[6] | ((unsigned)e[7] << 16);
            *(GAS u32x4*)((dummy ? WSP(bf16, WS_U + 300 * MiB) : Y) + (size_t)(dummy ? ((rowbase + tb * 64 + tt) & 8191) : (rowbase + tb * 64 + tt)) * D + cb * 64 + c8) = o;
        }
        asm volatile("s_waitcnt lgkmcnt(0)" ::: "memory");
    }
}

__device__ __forceinline__ void phase_norm_router(Frame& F) {
    const int gw = F.wg * NWAVES + F.wave, NGW = F.G * NWAVES, lane = F.lane;
    const GAS float* g = inp(F, I_GFFN) + 1 * D; const GAS float* wr = inp(F, I_ROUTER); const GAS float* br = inp(F, I_ROUTERB);
    GAS unsigned* cnt = WSP(unsigned, WS_CTL) + CW_CNT;
#pragma unroll 2
    for (int row = gw; row < TOKL; row += NGW) {
        float keep[16];
        norm_mod_row(xrow_ptr(F, row, false), g, mod_ptr(F, 1, row, 3), mod_ptr(F, 1, row, 4), WSP(bf16, WS_H) + (size_t)row * D, lane, keep);
        float lg[8];
#pragma unroll
        for (int e = 0; e < 8; ++e) lg[e] = 0.f;
#pragma unroll
        for (int j = 0; j < 4; ++j)
#pragma unroll
            for (int i = 0; i < 4; ++i) { const int k = 256 * j + 4 * lane + i; const f32x4 w0 = *(const GAS f32x4*)(wr + k * 8), w1 = *(const GAS f32x4*)(wr + k * 8 + 4); const float x = keep[4 * j + i];
                lg[0] += x * w0.x; lg[1] += x * w0.y; lg[2] += x * w0.z; lg[3] += x * w0.w; lg[4] += x * w1.x; lg[5] += x * w1.y; lg[6] += x * w1.z; lg[7] += x * w1.w; }
#pragma unroll
        for (int e = 0; e < 8; ++e) lg[e] = wave_sum(lg[e]) + br[e];
        int e0 = 0; float v0 = lg[0];
#pragma unroll
        for (int e = 1; e < 8; ++e) if (lg[e] > v0) { v0 = lg[e]; e0 = e; }
        int e1 = -1; float v1 = -3.0e38f;
#pragma unroll
        for (int e = 0; e < 8; ++e) if (e != e0 && lg[e] > v1) { v1 = lg[e]; e1 = e; }
        const float w1 = 1.f / (1.f + __expf(v0 - v1)), w0 = 1.f - w1;
        if (lane == 0) {
            const unsigned p0 = __hip_atomic_fetch_add(cnt + e0, 1u, __ATOMIC_RELAXED, __HIP_MEMORY_SCOPE_AGENT), p1 = __hip_atomic_fetch_add(cnt + e1, 1u, __ATOMIC_RELAXED, __HIP_MEMORY_SCOPE_AGENT);
            WSP(int, WS_TOPE)[row * 2] = e0; WSP(int, WS_TOPE)[row * 2 + 1] = e1;
            WSP(float, WS_TOPW)[row * 2] = w0; WSP(float, WS_TOPW)[row * 2 + 1] = w1;
            WSP(int, WS_TOPP)[row * 2] = (int)p0; WSP(int, WS_TOPP)[row * 2 + 1] = (int)p1;
        }
    }
}
__device__ __forceinline__ void phase_route_tables(Frame& F) {
    const GAS unsigned* cnt = WSP(const unsigned, WS_CTL) + CW_CNT;
    int off[9]; off[0] = 0;
#pragma unroll
    for (int e = 0; e < 8; ++e) { const int c = (int)__hip_atomic_load(cnt + e, __ATOMIC_RELAXED, __HIP_MEMORY_SCOPE_AGENT); off[e + 1] = off[e] + ((c + 255) >> 8) * 256; }
    const int gt = F.wg * NTHR + F.tid, NGT = F.G * NTHR;
    GAS int* rowidx = WSP(int, WS_ROWIDX); GAS int* slot = WSP(int, WS_SLOT); GAS int* tilee = WSP(int, WS_TILEE);
    for (int i = gt; i < MAXTILES * 256; i += NGT) {
        int e = 0;
#pragma unroll
        for (int q = 1; q < 8; ++q) if (i >= off[q]) e = q;
        const int c = (int)cnt[e];
        if (i >= off[8] || i - off[e] >= c) rowidx[i] = 0;
    }
    for (int i = gt; i < TOKL * 2; i += NGT) {
        const int e = WSP(const int, WS_TOPE)[i], pos = WSP(const int, WS_TOPP)[i];
        int o = 0;
#pragma unroll
        for (int q = 0; q < 8; ++q) if (e == q) o = off[q];
        const int s = o + pos; slot[i] = s; rowidx[s] = i >> 1;
    }
    for (int i = gt; i < MAXTILES + 1; i += NGT) {
        if (i == MAXTILES) tilee[MAXTILES] = off[8] >> 8;
        else { int e = 0;
#pragma unroll
            for (int q = 1; q < 8; ++q) if (i * 256 >= off[q]) e = q;
            tilee[i] = e; }
    }
}

__device__ __forceinline__ void moe_pass_gemm1_fast(Frame& F, int t0, int t1) {
    pg8::OrderMoe S; S.o.init(t1 - t0, NFF1 / 256, F.G, F.wg); S.rowidx = WSP(const int, WS_ROWIDX); S.tilee = WSP(const int, WS_TILEE); S.t0 = t0; S.bstride = (size_t)NFF1 * D; S.gather = true;
    EpiSwiglu E{WSP(bf16, WS_MACT), 0};
    pg8::gemm_phase(F.lds, F.tid, WSP(const bf16, WS_H), D, WSP(const bf16, WS_MW13), D, D, S, E);
}
__device__ __forceinline__ void moe_pass_gemm2_fast(Frame& F, int t0, int t1) {
    pg8::OrderMoe S; S.o.init(t1 - t0, D / 256, F.G, F.wg); S.rowidx = WSP(const int, WS_ROWIDX); S.tilee = WSP(const int, WS_TILEE); S.t0 = t0; S.bstride = (size_t)D * DFF; S.gather = false;
    EpiBf16Out E{WSP(bf16, WS_EOUT), D, t0 * 256};
    pg8::gemm_phase(F.lds, F.tid, WSP(const bf16, WS_MACT), DFF, WSP(const bf16, WS_MW2), DFF, DFF, S, E);
}
__device__ __forceinline__ void phase_final(Frame& F, GAS float* dummy = nullptr) {
    const int gw = F.wg * NWAVES + F.wave, NGW = F.G * NWAVES, lane = F.lane;
    const GAS float* gf = inp(F, I_GFINAL); const GAS bf16* eo = WSP(const bf16, WS_EOUT);
#pragma unroll 2
    for (int row = gw; row < TOKL; row += NGW) {
        const int s0 = WSP(const int, WS_SLOT)[row * 2], s1 = WSP(const int, WS_SLOT)[row * 2 + 1];
        const float w0 = WSP(const float, WS_TOPW)[row * 2], w1 = WSP(const float, WS_TOPW)[row * 2 + 1];
        const GAS float* m5 = mod_ptr(F, 1, row, 5);
        GAS float* xr = outp(F) + (size_t)row * D;
        f32x4 v[4]; float s = 0.f;
#pragma unroll
        for (int j = 0; j < 4; ++j) {
            const int c = 256 * j + 4 * lane;
            const f32x4 a = ld_bf16x4(eo + (size_t)s0 * D + c), b = ld_bf16x4(eo + (size_t)s1 * D + c), m = *(const GAS f32x4*)(m5 + c);
            v[j] = *(const GAS f32x4*)(xr + c) + m * (a * w0 + b * w1);
            s += (v[j].x * v[j].x + v[j].y * v[j].y) + (v[j].z * v[j].z + v[j].w * v[j].w);
        }
        const float r = rsqrtf(wave_sum(s) * (1.f / 1024.f) + 1e-6f);
#pragma unroll
        for (int j = 0; j < 4; ++j) { const int c = 256 * j + 4 * lane; const f32x4 g = *(const GAS f32x4*)(gf + c); GAS float* o_ = dummy ? dummy + (size_t)(row & 8191) * D : xr; *(GAS f32x4*)(o_ + c) = v[j] * r * g; }
    }
}

#ifndef REP_WIN
#define REP_WIN 1
#endif
#ifndef REP_MIX
#define REP_MIX 1
#endif
#ifndef REP_GATE
#define REP_GATE 1
#endif
#ifndef REP_UP
#define REP_UP 1
#endif
#ifndef REP_FFN1
#define REP_FFN1 1
#endif
#ifndef REP_MOE
#define REP_MOE 1
#endif
#ifndef REP_NORM
#define REP_NORM 1
#endif
#ifndef REP_P0
#define REP_P0 1
#endif
__global__ void __launch_bounds__(NTHR, 2) hybrid_fwd(Params prm) {
    extern __shared__ __attribute__((aligned(16))) unsigned char lds_raw[];
    Frame F;
    F.lds = (LAS unsigned char*)lds_raw; F.ws = (GAS unsigned char*)prm.ws;
    F.tid = threadIdx.x; F.lane = F.tid & 63; F.wave = __builtin_amdgcn_readfirstlane(F.tid >> 6); F.G = gridDim.x; F.wg = blockIdx.x;
    volatile LAS unsigned* MISC = (volatile LAS unsigned*)(F.lds + MISC_OFF);
    if (F.tid < 64) MISC[F.tid] = 0u;
    if (F.tid < 33) { const unsigned long long v = F.tid < 32 ? (unsigned long long)prm.in[F.tid] : (unsigned long long)prm.out; *(LAS unsigned long long*)(F.lds + PTAB_OFF + 8 * F.tid) = v; }
    __syncthreads();
    XcdBarrier bar = xcd_barrier_post(WSP(unsigned, WS_CTL) + CW_BAR, MISC + 8);
#define RELAUNDER() do { { unsigned long long _w = (unsigned long long)F.ws; asm volatile("" : "+s"(_w)); F.ws = (GAS unsigned char*)_w; } \
        { unsigned _t = (unsigned)F.tid; asm volatile("" : "+v"(_t)); F.tid = (int)_t; F.lane = F.tid & 63; F.wave = __builtin_amdgcn_readfirstlane(F.tid >> 6); } \
        { unsigned _g = (unsigned)F.G, _b = (unsigned)F.wg; asm volatile("" : "+s"(_g), "+s"(_b)); F.G = (int)_g; F.wg = (int)_b; } \
        { unsigned _l = (unsigned)(size_t)F.lds; asm volatile("" : "+s"(_l)); F.lds = (LAS unsigned char*)(size_t)_l; } } while (0)
#define GRID_BAR() do { { unsigned long long _b = (unsigned long long)bar.bar; unsigned _x = bar.x; asm volatile("" : "+s"(_b), "+s"(_x)); bar.bar = (GAS unsigned*)_b; bar.x = _x; } xcd_barrier(bar); RELAUNDER(); } while (0)

    for (int rp = 0; rp < REP_P0; ++rp) { phase_p0(F); write_bias(F);
    GRID_BAR(); }
#pragma unroll 1
    for (int layer_ = 0; layer_ < 2; ++layer_) {
        int layer = layer_;
#define last (layer == 1)
#define rows_all TOK
#define rows_out (last ? TOKL : TOK)
#define modbase (WSP(const float, WS_MOD) + (size_t)layer * 17 * 6144)
#define LAYER_LAUNDER() asm volatile("" : "+s"(layer))
        for (int rp = 0; rp < REP_NORM; ++rp) { phase_norm(F, layer, rows_all, !last, 0);
        if (layer == 0) { const int gw = F.wg * NWAVES + F.wave, NGW = F.G * NWAVES;
            for (int it = gw; it < 1536 + 96; it += NGW) filter_out_item(F, it); }
        { GRID_BAR(); LAYER_LAUNDER(); } }
        for (int rp = 0; rp < REP_WIN; ++rp) {
        { EpiWin E{WSP(const float, WS_BIAS) + layer * NWP, WSP(bf16, WS_HYTL), WSP(bf16, WS_HYTC), WSP(bf16, WS_RET), WSP(bf16, WS_ML), WSP(float, WS_MLG)};
          gemm_fast(F, WSP(const bf16, WS_H), D, WSP(const bf16, WS_WIN), D, D, rows_all, NW1, E); }
        { GRID_BAR(); LAYER_LAUNDER(); } }
        for (int rp = 0; rp < REP_MIX; ++rp) { phase_mix(F, layer);
        { GRID_BAR(); LAYER_LAUNDER(); } }
#ifndef REP_COMB
#define REP_COMB 1
#endif
        for (int rp = REP_COMB - 1; rp > 0; --rp) { phase_combine(F, layer, true); { GRID_BAR(); LAYER_LAUNDER(); } }
        phase_combine(F, layer);
        { GRID_BAR(); LAYER_LAUNDER(); }
        for (int rp = 0; rp < REP_GATE; ++rp) {
        { EpiGate E{WSP(const float, WS_BIAS) + layer * NWP + NW1, WSP(bf16, WS_GATES)};
          gemm_fast(F, WSP(const bf16, WS_H), D, WSP(const bf16, WS_WIN) + (size_t)NW1 * D, D, D, rows_out, NGATE, E); }
        { GRID_BAR(); LAYER_LAUNDER(); } }
        for (int rp = 0; rp < REP_UP; ++rp) {
        { EpiUp E{WSP(const bf16, WS_GATES), WSP(bf16, WS_H)};
          gemm_fast(F, WSP(const bf16, WS_Y), D, WSP(const bf16, WS_WUP), D, D, rows_out, D, E); }
        { GRID_BAR(); LAYER_LAUNDER(); } }
#ifndef REP_OUT
#define REP_OUT 1
#endif
        for (int rp = REP_OUT - 1; rp >= 0; --rp) {
        { EpiResid E{last ? outp(F) : inp(F, I_X), last ? WSP(const float, WS_XC) : inp(F, I_CTX), outp(F), WSP(float, WS_XC), modbase, 2, rp ? WSP(float, WS_U + 300 * MiB) : (GAS float*)nullptr};
          gemm_fast(F, WSP(const bf16, WS_H), D, WSP(const bf16, WS_WOUT), D, D, rows_out, D, E); }
        if (rp) { GRID_BAR(); LAYER_LAUNDER(); } }
        { GRID_BAR(); LAYER_LAUNDER(); }
        if (!last) {
            phase_norm(F, layer, rows_out, false, 3);
            { const int gw = F.wg * NWAVES + F.wave, NGW = F.G * NWAVES; LAS float* scr = (LAS float*)(F.lds + F.wave * 8704);
              conv_weights_ffn(inp(F, I_FW1), inp(F, I_FW3), inp(F, I_FW2), WSP(bf16, WS_W13), WSP(bf16, WS_W2), gw, NGW, scr, F.lane);
              conv_weights_win(F, 1, gw, NGW, scr);
              conv_weights_upout(F, 1, gw, NGW, scr); }
            { GRID_BAR(); LAYER_LAUNDER(); }
            for (int rp = 0; rp < REP_FFN1; ++rp) {
            { EpiSwiglu E{WSP(bf16, WS_ACT), 0};
              gemm_fast(F, WSP(const bf16, WS_H), D, WSP(const bf16, WS_W13), D, D, rows_out, NFF1, E); }
            { GRID_BAR(); LAYER_LAUNDER(); } }
#ifndef REP_FFN2
#define REP_FFN2 1
#endif
            for (int rp = REP_FFN2 - 1; rp >= 0; --rp) {
            { EpiResid E{outp(F), WSP(const float, WS_XC), outp(F), WSP(float, WS_XC), modbase, 5, rp ? WSP(float, WS_U + 300 * MiB) : (GAS float*)nullptr};
              gemm_fast(F, WSP(const bf16, WS_ACT), DFF, WSP(const bf16, WS_W2), DFF, DFF, rows_out, D, E); }
            if (rp) { GRID_BAR(); LAYER_LAUNDER(); } }
            { GRID_BAR(); LAYER_LAUNDER(); }
        }
    }
#undef LAYER_LAUNDER
#undef last
#undef rows_all
#undef rows_out
#undef modbase
    phase_norm_router(F);
    { const int gw = F.wg * NWAVES + F.wave, NGW = F.G * NWAVES; LAS float* scr = (LAS float*)(F.lds + F.wave * 8704);
#ifndef REP_MCONV
#define REP_MCONV 1
#endif
#pragma unroll 1
      for (int e = 0; e < NE * REP_MCONV; ++e)
          conv_weights_ffn(inp(F, I_MW1) + (size_t)(e % NE) * D * DFF, inp(F, I_MW3) + (size_t)(e % NE) * D * DFF, inp(F, I_MW2) + (size_t)(e % NE) * DFF * D,
                           WSP(bf16, WS_MW13) + (size_t)(e % NE) * NFF1 * D, WSP(bf16, WS_MW2) + (size_t)(e % NE) * D * DFF, gw, NGW, scr, F.lane); }
    GRID_BAR();
    phase_route_tables(F);
    GRID_BAR();
    const int ntiles = __builtin_amdgcn_readfirstlane(WSP(const int, WS_TILEE)[MAXTILES]);
#pragma unroll 1
    for (int p = 0; p < NPASS; ++p) {
        const int t0 = p * PASS_TILES, t1 = min(ntiles, t0 + PASS_TILES);
        for (int rp = 0; rp < REP_MOE; ++rp) {
        if (t0 < t1) moe_pass_gemm1_fast(F, t0, t1);
        GRID_BAR();
        if (t0 < t1) moe_pass_gemm2_fast(F, t0, t1);
        GRID_BAR(); }
    }
#ifndef REP_BAR
#define REP_BAR 0
#endif
    for (int rb = 0; rb < REP_BAR; ++rb) GRID_BAR();
#ifndef REP_FINAL
#define REP_FINAL 1
#endif
    for (int rp = REP_FINAL - 1; rp > 0; --rp) { phase_final(F, WSP(float, WS_U + 300 * MiB)); GRID_BAR(); }
    phase_final(F);
}

extern "C" void kernel_launch(void* const* d_in, const int* in_sizes, int n_in, void* d_out, int out_size, void* d_ws, size_t ws_size, hipStream_t stream) {
    static int grid = 0;
    if (grid == 0) {
        if (n_in != 32 || out_size != TOKL * D || ws_size < WS_END) { fprintf(stderr, "kernel_launch: unexpected arguments (n_in %d, out %d, ws %zu)\n", n_in, out_size, ws_size); grid = -1; return; }
        int dev = 0, cus = 0;
        if (hipGetDevice(&dev) != hipSuccess || hipDeviceGetAttribute(&cus, hipDeviceAttributeMultiprocessorCount, dev) != hipSuccess) { grid = -1; return; }
        if (hipFuncSetAttribute((const void*)hybrid_fwd, hipFuncAttributeMaxDynamicSharedMemorySize, LDS_BYTES) != hipSuccess) { grid = -1; return; }
        int per_cu = 0;
        (void)hipOccupancyMaxActiveBlocksPerMultiprocessor(&per_cu, (const void*)hybrid_fwd, NTHR, LDS_BYTES);
        (void)hipGetLastError();
        grid = cus;
    }
    if (grid < 0) return;
    (void)hipMemsetAsync((char*)d_ws + WS_CTL, 0, CTL_ZERO_BYTES, stream);
    Params p{};
    for (int i = 0; i < 32; ++i) p.in[i] = (const float*)d_in[i];
    p.out = (float*)d_out; p.ws = (unsigned char*)d_ws;
    hipLaunchKernelGGL(hybrid_fwd, dim3(grid), dim3(NTHR), LDS_BYTES, stream, p);
}
```

```cpp
#include <hip/hip_runtime.h>
#include <stdint.h>
#include <stdio.h>

#define LAS __attribute__((address_space(3)))
#define GAS __attribute__((address_space(1)))
typedef unsigned short bf16;
typedef short bf16x8 __attribute__((ext_vector_type(8)));
typedef float f32x4 __attribute__((ext_vector_type(4)));
typedef unsigned u32x4 __attribute__((ext_vector_type(4)));
typedef unsigned u32x2 __attribute__((ext_vector_type(2)));

constexpr int D = 1024, NB = 16, LL = 2048, LC = 256;
constexpr int TOKL = NB * LL, TOKC = NB * LC, TOK = TOKL + TOKC;
constexpr int HYW = 384, RETW = 384, MLW = 256;
constexpr int NIN = 6800, NW1 = 3840, NGATE = 3072, NWP = 6912;
constexpr int DFF = 2816, NFF1 = 5632, NE = 8;
constexpr int NWAVES = 8, NTHR = 512;
constexpr int MAXTILES = 272, PASS_TILES = 58, NPASS = 5;

constexpr size_t MiB = 1u << 20;
constexpr size_t WS_CTL = 0, CTL_ZERO_BYTES = 1 * MiB;
constexpr size_t WS_MOD = 1 * MiB;
constexpr size_t WS_BIAS = 2 * MiB;
constexpr size_t WS_ROPE = 2 * MiB + 256 * 1024;
constexpr size_t WS_TOPE = 3 * MiB;
constexpr size_t WS_TOPW = 3 * MiB + 256 * 1024;
constexpr size_t WS_TOPP = 3 * MiB + 512 * 1024;
constexpr size_t WS_SLOT = 3 * MiB + 768 * 1024;
constexpr size_t WS_ROWIDX = 4 * MiB;
constexpr size_t WS_TILEE = 4 * MiB + 512 * 1024;
constexpr size_t WS_FTL = 5 * MiB;
constexpr size_t WS_FTC = 17 * MiB;
constexpr size_t WS_WIN = 18 * MiB;
constexpr size_t WS_WUP = 32 * MiB;
constexpr size_t WS_WOUT = 34 * MiB;
constexpr size_t WS_XC = 36 * MiB;
constexpr size_t WS_H = 52 * MiB;
constexpr size_t WS_Y = 124 * MiB;
constexpr size_t WS_U = 196 * MiB;
constexpr size_t WS_RET = WS_U;
constexpr size_t WS_ML = WS_U + 108 * MiB;
constexpr size_t WS_MLG = WS_U + 180 * MiB;
constexpr size_t WS_OB = WS_U + 183 * MiB;
constexpr size_t WS_YHTL = WS_U + 228 * MiB;
constexpr size_t WS_YHTC = WS_U + 252 * MiB;
constexpr size_t WS_HYTL = WS_U + 255 * MiB;
constexpr size_t WS_HYTC = WS_U + 327 * MiB;
constexpr size_t WS_END = WS_U + 336 * MiB;
constexpr size_t WS_GATES = WS_U;
constexpr size_t WS_ACT = WS_U;
constexpr size_t WS_W13 = WS_U + 204 * MiB;
constexpr size_t WS_W2 = WS_U + 216 * MiB;
constexpr size_t WS_MW13 = WS_Y;
constexpr size_t WS_MW2 = WS_Y + 88 * MiB;
constexpr size_t WS_MACT = WS_Y + 132 * MiB;
constexpr size_t WS_EOUT = WS_Y + 220 * MiB;
static_assert(WS_EOUT + (size_t)MAXTILES * 256 * 1024 * 2 <= WS_END, "map");
static_assert(WS_GATES + (size_t)TOK * NGATE * 2 <= WS_YHTL, "gates overlay");

constexpr int CW_BAR = 4096;
constexpr int CW_CNT = 16384;

constexpr int LDS_BYTES = 147456;
constexpr int MISC_OFF = 147456 - 256;

__device__ __forceinline__ float bf2f(bf16 b) { return __uint_as_float(((unsigned)b) << 16); }
typedef __bf16 bf2v_ __attribute__((ext_vector_type(2)));
typedef float f2v_ __attribute__((ext_vector_type(2)));
__device__ __forceinline__ unsigned pk2(float lo, float hi) { const f2v_ f = {lo, hi}; return __builtin_bit_cast(unsigned, __builtin_convertvector(f, bf2v_)); }
__device__ __forceinline__ unsigned f2bf(float f) { return pk2(f, 0.f) & 0xffffu; }
__device__ __forceinline__ float dpp_f(float v, int) { return v; }
#define DPP_ADD(v, ctrl) (v) += __int_as_float(__builtin_amdgcn_update_dpp(0, __float_as_int(v), (ctrl), 0xf, 0xf, true))
__device__ __forceinline__ float wave_sum(float v) {
    DPP_ADD(v, 0xB1);
    DPP_ADD(v, 0x4E);
    DPP_ADD(v, 0x141);
    DPP_ADD(v, 0x140);
    return __int_as_float(__builtin_amdgcn_readlane(__float_as_int(v), 0)) + __int_as_float(__builtin_amdgcn_readlane(__float_as_int(v), 16))
         + __int_as_float(__builtin_amdgcn_readlane(__float_as_int(v), 32)) + __int_as_float(__builtin_amdgcn_readlane(__float_as_int(v), 48));
}
__device__ __forceinline__ float lane_read(float v, int src_lane) { return __int_as_float(__builtin_amdgcn_ds_bpermute(src_lane << 2, __float_as_int(v))); }
__device__ __forceinline__ float sigmoidf_(float x) { return __builtin_amdgcn_rcpf(1.0f + __expf(-x)); }
__device__ __forceinline__ float siluf_(float x) { return x * __builtin_amdgcn_rcpf(1.0f + __expf(-x)); }

#define XB_TMO      128
#define XB_XCNT(j)  (256  + 64 * (j))
#define XB_XSUB(j)  (1280 + 64 * (j))
#define XB_XGEN(j)  (2304 + 64 * (j))
#define XB_TOP      3328
#define XB_TOPGEN   3392
#define XCD_BAR_WORDS 3456
#define XB_SPIN_CAP (1u << 22)
__device__ __forceinline__ unsigned xb_ld(GAS unsigned* p)              { return __hip_atomic_load(p, __ATOMIC_RELAXED, __HIP_MEMORY_SCOPE_AGENT); }
__device__ __forceinline__ unsigned xb_add(GAS unsigned* p, unsigned v) { return __hip_atomic_fetch_add(p, v, __ATOMIC_RELAXED, __HIP_MEMORY_SCOPE_AGENT); }
__device__ __forceinline__ unsigned xb_xcc_id() { return (unsigned)__builtin_amdgcn_s_getreg((3 << 11) | 20) & 0xFu; }
#define XB_SPIN(cond, bar) do { unsigned _sp = 0; while (cond) { __builtin_amdgcn_s_sleep(1); \
    if ((++_sp & 255u) == 0u) { if (xb_ld(&(bar)[XB_TMO])) break; if (_sp > XB_SPIN_CAP) { (void)__hip_atomic_fetch_add(&(bar)[XB_TMO], 1u, __ATOMIC_RELAXED, __HIP_MEMORY_SCOPE_AGENT); break; } } } } while (0)
struct XcdBarrier { GAS unsigned* bar; unsigned x; volatile LAS unsigned* st; };
__device__ __forceinline__ XcdBarrier xcd_barrier_post(GAS unsigned* bar, volatile LAS unsigned* st) {
    XcdBarrier b; b.bar = bar; b.x = xb_xcc_id(); b.st = st;
    if (threadIdx.x == 0) (void)xb_add(&bar[XB_XCNT(b.x)], 1u);
    return b;
}
__device__ __forceinline__ void xcd_barrier_complete(GAS unsigned* bar, unsigned x, unsigned& nloc, unsigned& nx) {
    const unsigned G = gridDim.x * gridDim.y * gridDim.z;
    unsigned sum, cnt, mine, sp = 0u;
    for (;;) {
        sum = 0u; cnt = 0u; mine = 0u;
#pragma unroll 1
        for (unsigned j = 0; j < 16; ++j) { const unsigned c = xb_ld(&bar[XB_XCNT(j)]); sum += c; cnt += (c > 0u) ? 1u : 0u; }
        mine = xb_ld(&bar[XB_XCNT(x)]);
        if (sum == G) break;
        __builtin_amdgcn_s_sleep(1);
        if ((++sp & 255u) == 0u) { if (xb_ld(&bar[XB_TMO])) break; if (sp > XB_SPIN_CAP) { (void)__hip_atomic_fetch_add(&bar[XB_TMO], 1u, __ATOMIC_RELAXED, __HIP_MEMORY_SCOPE_AGENT); break; } }
    }
    nloc = mine > 0u ? mine : 1u; nx = cnt > 0u ? cnt : 1u;
}
__device__ __forceinline__ void xcd_barrier(const XcdBarrier& b) {
    asm volatile("s_waitcnt vmcnt(0)" ::: "memory");
    __syncthreads();
    if (threadIdx.x == 0) {
        GAS unsigned* bar = b.bar;
        __builtin_amdgcn_s_waitcnt(0);
        unsigned nloc = b.st[0], nx = b.st[1];
        if (nloc == 0u) { xcd_barrier_complete(bar, b.x, nloc, nx); b.st[0] = nloc; b.st[1] = nx; }
        const unsigned old = xb_add(&bar[XB_XSUB(b.x)], 1u);
        const unsigned gen = old / nloc;
        if (old + 1u == (gen + 1u) * nloc) {
            __builtin_amdgcn_fence(__ATOMIC_RELEASE, "agent");
            asm volatile("s_waitcnt vmcnt(0)" ::: "memory");
            const unsigned og = xb_add(&bar[XB_TOP], 1u);
            const unsigned tg = og / nx;
            if (og + 1u == (tg + 1u) * nx) xb_add(&bar[XB_TOPGEN], 1u);
            else XB_SPIN(xb_ld(&bar[XB_TOPGEN]) == tg, bar);
            __builtin_amdgcn_fence(__ATOMIC_ACQUIRE, "agent");
            xb_add(&bar[XB_XGEN(b.x)], 1u);
            asm volatile("s_waitcnt vmcnt(0)" ::: "memory");
        } else {
            XB_SPIN(xb_ld(&bar[XB_XGEN(b.x)]) == gen, bar);
            __builtin_amdgcn_fence(__ATOMIC_ACQUIRE, "agent");
            asm volatile("s_waitcnt vmcnt(0)" ::: "memory");
        }
    }
    __syncthreads();
}

struct Params { const float* in[32]; float* out; unsigned char* ws; };
enum { I_X = 0, I_C, I_CTX, I_CCTX, I_WMOD, I_BMOD, I_GMIX, I_GFFN, I_WIN, I_BIN, I_HYCONV, I_HYF1, I_HYFB1, I_HYF2, I_HYFB2, I_HYF3, I_HYDECAY,
       I_HYSKIP, I_RETDECAY, I_MLCONV, I_MLGB, I_WUP, I_WOUT, I_FW1, I_FW3, I_FW2, I_ROUTER, I_ROUTERB, I_MW1, I_MW3, I_MW2, I_GFINAL };

struct Frame {
    LAS unsigned char* lds;
    GAS unsigned char* ws;
    int tid, lane, wave, G, wg;
};
#define WSP(T, off) ((GAS T*)(F.ws + (off)))
constexpr int PTAB_OFF = 147456 - 1024;
__device__ __forceinline__ const GAS float* inp(const Frame& F, int i) {
    const LAS unsigned* t = (const LAS unsigned*)(F.lds + PTAB_OFF) + 2 * i;
    const unsigned lo = __builtin_amdgcn_readfirstlane(t[0]), hi = __builtin_amdgcn_readfirstlane(t[1]);
    return (const GAS float*)(((unsigned long long)hi << 32) | lo);
}
__device__ __forceinline__ GAS float* outp(const Frame& F) { return (GAS float*)inp(F, 32); }

__device__ __forceinline__ int row_batch(int row) { return row < TOKL ? (row >> 11) : ((row - TOKL) >> 8); }
__device__ __forceinline__ const GAS float* mod_ptr(const Frame& F, int layer, int row, int which) {
    const int r = row < TOKL ? (row >> 11) : 16;
    return WSP(const float, WS_MOD) + ((size_t)(layer * 17 + r) * 6 + which) * 1024;
}

template <class RowMap>
__device__ __forceinline__ void tr_item(const GAS float* W, int K, int N, GAS bf16* WT, int ldT, RowMap rm, LAS float* scr, int item, int lane) {
    const int nblk = (N + 31) / 32, kb = item / nblk, nb = item % nblk, k0 = 64 * kb, n0 = 32 * nb;
    { float tv[32];
#pragma unroll
      for (int i = 0; i < 32; ++i) { const int kk = 2 * i + (lane >> 5); const int n = n0 + (lane & 31); tv[i] = (n < N) ? W[(size_t)(k0 + kk) * N + n] : 0.f; }
#pragma unroll
      for (int i = 0; i < 32; ++i) { const int kk = 2 * i + (lane >> 5); scr[kk * 33 + (lane & 31)] = tv[i]; } }
    asm volatile("s_waitcnt lgkmcnt(0)" ::: "memory");
    const int c = lane & 7;
#pragma unroll
    for (int j = 0; j < 4; ++j) { const int nl = (lane >> 3) + 8 * j; const int n = n0 + nl; const LAS float* s = scr + (8 * c) * 33 + nl;
        u32x4 o; o.x = pk2(s[0 * 33], s[1 * 33]); o.y = pk2(s[2 * 33], s[3 * 33]); o.z = pk2(s[4 * 33], s[5 * 33]); o.w = pk2(s[6 * 33], s[7 * 33]);
        if (n < N) *(GAS u32x4*)(WT + (size_t)rm(n) * ldT + k0 + 8 * c) = o; }
    asm volatile("s_waitcnt lgkmcnt(0)" ::: "memory");
}
struct RmId { __device__ __forceinline__ int operator()(int n) const { return n; } };
__device__ __forceinline__ int win_row(int n) {
    if (n < 1152) return n;
    if (n < 2688) return 1280 + (n - 1152);
    if (n < 3712) return 2816 + (n - 2688);
    if (n < 3728) return 1152 + (n - 3712);
    return 3840 + (n - 3728);
}
struct RmWin { __device__ __forceinline__ int operator()(int n) const { return win_row(n); } };
struct RmW1 { __device__ __forceinline__ int operator()(int n) const { return (n >> 4) * 32 + (n & 15); } };
struct RmW3 { __device__ __forceinline__ int operator()(int n) const { return (n >> 4) * 32 + 16 + (n & 15); } };

__device__ __forceinline__ void conv_weights_win(Frame& F, int layer, int gw, int NGW, LAS float* scr) {
    const GAS float* W = inp(F, I_WIN) + (size_t)layer * D * NIN;
    const int items = (D / 64) * ((NIN + 31) / 32);
    for (int it = gw; it < items; it += NGW) tr_item(W, D, NIN, WSP(bf16, WS_WIN), D, RmWin(), scr, it, F.lane);
    GAS bf16* wt = WSP(bf16, WS_WIN);
    unsigned zz; asm volatile("v_mov_b32 %0, 0" : "=v"(zz));
    for (int i = gw * 64 + F.lane; i < 112 * 1024 / 8; i += NGW * 64) *(GAS u32x4*)(wt + (size_t)1168 * 1024 + (size_t)i * 8) = (u32x4){zz, zz, zz, zz};
}
__device__ __forceinline__ void conv_weights_upout(Frame& F, int layer, int gw, int NGW, LAS float* scr) {
    const int items = (D / 64) * (D / 32);
    for (int it = gw; it < items; it += NGW) tr_item(inp(F, I_WUP) + (size_t)layer * D * D, D, D, WSP(bf16, WS_WUP), D, RmId(), scr, it, F.lane);
    for (int it = gw; it < items; it += NGW) tr_item(inp(F, I_WOUT) + (size_t)layer * D * D, D, D, WSP(bf16, WS_WOUT), D, RmId(), scr, it, F.lane);
}
__device__ __forceinline__ void conv_weights_ffn(const GAS float* w1, const GAS float* w3, const GAS float* w2, GAS bf16* w13t, GAS bf16* w2t, int gw, int NGW, LAS float* scr, int lane) {
    const int i1 = (D / 64) * (DFF / 32), i2 = (DFF / 64) * (D / 32);
    for (int it = gw; it < i1; it += NGW) tr_item(w1, D, DFF, w13t, D, RmW1(), scr, it, lane);
    for (int it = gw; it < i1; it += NGW) tr_item(w3, D, DFF, w13t, D, RmW3(), scr, it, lane);
    for (int it = gw; it < i2; it += NGW) tr_item(w2, DFF, D, w2t, DFF, RmId(), scr, it, lane);
}

constexpr size_t WS_HID2 = WS_XC;
__device__ __forceinline__ void filter_hidden_item(Frame& F, int item) {
    const int p0 = item * 8, sel = p0 < 2048 ? 0 : (p0 < 4096 ? 1 : 2), layer = sel == 1 ? 1 : 0, L = sel == 2 ? LC : LL, pbase = sel == 0 ? 0 : (sel == 1 ? 2048 : 4096);
    const GAS float* f1 = inp(F, I_HYF1) + layer * 33 * 64; const GAS float* fb1 = inp(F, I_HYFB1) + layer * 64;
    const GAS float* f2 = inp(F, I_HYF2) + layer * 64 * 64; const GAS float* fb2 = inp(F, I_HYFB2) + layer * 64;
    const int lane = F.lane;
    const float b1 = fb1[lane], b2 = fb2[lane];
    for (int pl = 0; pl < 8; ++pl) {
        const int pos = p0 + pl - pbase;
        const float t = (float)pos / (float)(L - 1);
        const float w = 6.283185307179586f * (float)pos / (float)L;
        float feat = 0.f;
        if (lane == 0) feat = t;
        else if (lane < 17) { const float band = 1e-4f + (float)(lane - 1) * ((15.0f - 1e-4f) / 15.0f); feat = cosf(w * band); }
        else if (lane < 33) { const float band = 1e-4f + (float)(lane - 17) * ((15.0f - 1e-4f) / 15.0f); feat = -sinf(w * band); }
        float a1 = b1;
        for (int i = 0; i < 33; ++i) a1 += __int_as_float(__builtin_amdgcn_readlane(__float_as_int(feat), i)) * f1[i * 64 + lane];
        const float h1 = sinf(a1);
        float a2 = b2;
        for (int i = 0; i < 64; ++i) a2 += __int_as_float(__builtin_amdgcn_readlane(__float_as_int(h1), i)) * f2[i * 64 + lane];
        WSP(float, WS_HID2)[(size_t)(p0 + pl) * 64 + lane] = sinf(a2);
    }
}
__device__ __forceinline__ void filter_out_item(Frame& F, int item) {
    int sel, r;
    if (item < 768) { sel = 0; r = item; } else if (item < 1536) { sel = 1; r = item - 768; } else { sel = 2; r = item - 1536; }
    const int layer = sel == 1 ? 1 : 0, L = sel == 2 ? LC : LL, pb = r / 24, ch = r % 24, pbase = sel == 0 ? 0 : (sel == 1 ? 2048 : 4096);
    GAS bf16* FT = sel == 2 ? WSP(bf16, WS_FTC) : WSP(bf16, WS_FTL) + (size_t)layer * 2 * 384 * 4096;
    const GAS float* f3 = inp(F, I_HYF3) + (size_t)layer * 64 * 1536; const GAS float* dec = inp(F, I_HYDECAY) + layer * 1536;
    const int lane = F.lane, fr = lane & 15, fq = lane >> 4;
    const GAS float* hid = WSP(const float, WS_HID2) + (size_t)(pbase + pb * 64) * 64;
    f32x4 acc[4][4];
#pragma unroll
    for (int mt = 0; mt < 4; ++mt)
#pragma unroll
        for (int nt = 0; nt < 4; ++nt) acc[mt][nt] = (f32x4){0.f, 0.f, 0.f, 0.f};
#pragma unroll 4
    for (int ks = 0; ks < 16; ++ks) {
        float a[4], bb[4];
#pragma unroll
        for (int mt = 0; mt < 4; ++mt) a[mt] = hid[(16 * mt + fr) * 64 + 4 * ks + fq];
#pragma unroll
        for (int nt = 0; nt < 4; ++nt) bb[nt] = f3[(size_t)(4 * ks + fq) * 1536 + ch * 64 + 16 * nt + fr];
#pragma unroll
        for (int mt = 0; mt < 4; ++mt)
#pragma unroll
            for (int nt = 0; nt < 4; ++nt) acc[mt][nt] = __builtin_amdgcn_mfma_f32_16x16x4f32(a[mt], bb[nt], acc[mt][nt], 0, 0, 0);
    }
#pragma unroll
    for (int nt = 0; nt < 4; ++nt) {
        const int nn = ch * 64 + 16 * nt + fr, o = nn / 768, dir = (nn / 384) & 1, c = nn % 384;
        const float adec = fabsf(dec[nn]);
        GAS bf16* dst = FT + (size_t)(o * 384 + c) * (2 * L);
#pragma unroll
        for (int mt = 0; mt < 4; ++mt)
#pragma unroll
            for (int j = 0; j < 4; ++j) {
                const int pos = pb * 64 + 16 * mt + 4 * fq + j;
                const float t = (float)pos / (float)(L - 1);
                const float v = acc[mt][nt][j] * expf(-t * adec);
                if (dir == 0) dst[L - pos] = (bf16)f2bf(v);
                else if (pos > 0) dst[L + pos] = (bf16)f2bf(v);
            }
    }
}

__device__ __forceinline__ void phase_p0(Frame& F) {
    const int gw = F.wg * NWAVES + F.wave, NGW = F.G * NWAVES;
    LAS float* sl = (LAS float*)F.lds;
    LAS float* red = (LAS float*)(F.lds + 17 * 4096);
    for (int i = F.tid; i < 17 * 1024; i += NTHR) { const int r = i >> 10, k = i & 1023; const float v = r < 16 ? inp(F, I_C)[r * 1024 + k] : inp(F, I_CCTX)[k]; sl[i] = siluf_(v); }
    __syncthreads();
    for (int item = F.wg; item < 2 * 384; item += F.G) {
        const int layer = item / 384, n0 = (item % 384) * 16, j = F.tid & 15, kp = F.tid >> 4;
        const GAS float* W = inp(F, I_WMOD) + (size_t)layer * D * 6144;
        float acc[17];
#pragma unroll
        for (int r = 0; r < 17; ++r) acc[r] = 0.f;
        for (int k = kp * 32; k < kp * 32 + 32; ++k) { const float w = W[(size_t)k * 6144 + n0 + j];
#pragma unroll
            for (int r = 0; r < 17; ++r) acc[r] += sl[r * 1024 + k] * w; }
#pragma unroll
        for (int r = 0; r < 17; ++r) red[(kp * 17 + r) * 16 + j] = acc[r];
        __syncthreads();
        if (F.tid < 272) { const int r = F.tid >> 4, jj = F.tid & 15; float s = inp(F, I_BMOD)[layer * 6144 + n0 + jj];
            for (int q = 0; q < 32; ++q) s += red[(q * 17 + r) * 16 + jj];
            WSP(float, WS_MOD)[(size_t)(layer * 17 + r) * 6144 + n0 + jj] = s; }
        __syncthreads();
    }
    __syncthreads();
    LAS float* scr = (LAS float*)(F.lds + F.wave * 8704);
    conv_weights_win(F, 0, gw, NGW, scr);
    conv_weights_upout(F, 0, gw, NGW, scr);
    for (int i = gw * 64 + F.lane; i < 2048 * 32; i += NGW * 64) {
        const int t = i >> 5, j = i & 31, half = j >> 4, ii = j & 15;
        const float inv = 1.0f / powf(10000.0f, (float)ii / 16.0f);
        const float ang = (float)(half == 0 ? (t >> 6) : (t & 63)) * inv;
        WSP(float, WS_ROPE)[t * 64 + half * 32 + ii] = cosf(ang);
        WSP(float, WS_ROPE)[t * 64 + half * 32 + 16 + ii] = sinf(ang);
    }
    for (int it = gw; it < 4352 / 8; it += NGW) filter_hidden_item(F, it);
}
__device__ __forceinline__ void write_bias(Frame& F) {
    const int gt = (F.wg * NWAVES + F.wave) * 64 + F.lane, NGT = F.G * NTHR;
    for (int i = gt; i < 2 * NWP; i += NGT) {
        const int l = i / NWP, r = i % NWP; float v = 0.f;
        int n = -1;
        if (r < 1152) n = r; else if (r < 1168) n = 3712 + (r - 1152); else if (r < 1280) n = -1; else if (r < 2816) n = 1152 + (r - 1280); else if (r < 3840) n = 2688 + (r - 2816); else n = 3728 + (r - 3840);
        if (n >= 0) v = inp(F, I_BIN)[l * NIN + n];
        WSP(float, WS_BIAS)[i] = v;
    }
}

__device__ __forceinline__ void norm_mod_row(const GAS float* xrow, const GAS float* g, const GAS float* shift, const GAS float* scale, GAS bf16* orow, int lane, float* keep  ) {
    f32x4 v[4]; float s = 0.f;
#pragma unroll
    for (int j = 0; j < 4; ++j) { v[j] = *(const GAS f32x4*)(xrow + 256 * j + 4 * lane); s += (v[j].x * v[j].x + v[j].y * v[j].y) + (v[j].z * v[j].z + v[j].w * v[j].w); }
    const float r = rsqrtf(wave_sum(s) * (1.0f / 1024.0f) + 1e-6f);
#pragma unroll
    for (int j = 0; j < 4; ++j) {
        const f32x4 gg = *(const GAS f32x4*)(g + 256 * j + 4 * lane), sh = *(const GAS f32x4*)(shift + 256 * j + 4 * lane), sc = *(const GAS f32x4*)(scale + 256 * j + 4 * lane);
        f32x4 o;
        o.x = (v[j].x * r * gg.x) * (1.f + sc.x) + sh.x; o.y = (v[j].y * r * gg.y) * (1.f + sc.y) + sh.y;
        o.z = (v[j].z * r * gg.z) * (1.f + sc.z) + sh.z; o.w = (v[j].w * r * gg.w) * (1.f + sc.w) + sh.w;
        if (keep) { keep[4 * j + 0] = o.x; keep[4 * j + 1] = o.y; keep[4 * j + 2] = o.z; keep[4 * j + 3] = o.w; }
        u32x2 w; w.x = pk2(o.x, o.y); w.y = pk2(o.z, o.w);
        *(GAS u32x2*)(orow + 256 * j + 4 * lane) = w;
    }
}
__device__ __forceinline__ const GAS float* xrow_ptr(const Frame& F, int row, bool from_input) {
    if (row < TOKL) return (from_input ? inp(F, I_X) : outp(F)) + (size_t)row * D;
    return (from_input ? inp(F, I_CTX) : WSP(const float, WS_XC)) + (size_t)(row - TOKL) * D;
}
__device__ __forceinline__ void phase_norm(Frame& F, int layer, int nrows, bool from_input, int which) {
    const int gw = F.wg * NWAVES + F.wave, NGW = F.G * NWAVES;
    const GAS float* g = inp(F, which == 0 ? I_GMIX : I_GFFN) + layer * D;
#pragma unroll 2
    for (int row = gw; row < nrows; row += NGW)
        norm_mod_row(xrow_ptr(F, row, from_input), g, mod_ptr(F, layer, row, which), mod_ptr(F, layer, row, which + 1), WSP(bf16, WS_H) + (size_t)row * D, F.lane, nullptr);
}

namespace pg8 {
#ifndef WGM_
#define WGM_ 4
#endif
constexpr int BM = 256, BK = 64, HALF = 128, HTB = HALF * BK * 2, STAGE_BYTES = 8 * HTB, NXCD = 8, WGM = WGM_;
__device__ __forceinline__ int lds_byte(int r, int c) { const int st = (r >> 4) * 2 + (c >> 5), rr = r & 15, cc = c & 31, ob = rr * 64 + cc * 2; return st * 1024 + (ob ^ (((ob >> 9) & 1) << 5)); }
__device__ __forceinline__ void stage_rc(int b, int& R, int& C) { const int st = b / 1024, sb = b % 1024, swz = sb ^ (((sb >> 9) & 1) << 5); R = (st >> 1) * 16 + swz / 64; C = (st & 1) * 32 + (swz % 64) / 2; }
struct Unit { int pm, pn; };
struct OrderPlain {
    static constexpr bool GATHER = false;
    int nM, nN, nwg, G, c;
    __device__ __forceinline__ void init(int nM_, int nN_, int G_, int c_) { nM = nM_; nN = nN_; nwg = nM * nN; G = G_; c = c_; }
    __device__ __forceinline__ bool next(int i, Unit& u) const {
        const long L = (long)i * G + c; if (L >= nwg) return false;
        int wgid = (int)L; { const int q = nwg / NXCD, r = nwg % NXCD, xcd = wgid % NXCD, off = wgid / NXCD; wgid = (xcd < r ? xcd * (q + 1) : r * (q + 1) + (xcd - r) * q) + off; }
        const int nig = WGM * nN, gid = wgid / nig, fm = gid * WGM, gsz = (nM - fm) < WGM ? (nM - fm) : WGM;
        u.pm = fm + ((wgid % nig) % gsz); u.pn = (wgid % nig) / gsz; return true;
    }
    __device__ __forceinline__ int arow(int r) const { return r; }
    __device__ __forceinline__ size_t boff(const Unit&) const { return 0; }
};
struct OrderMoe {
    static constexpr bool GATHER = true;
    OrderPlain o; const GAS int* rowidx; const GAS int* tilee; int t0; size_t bstride; bool gather;
    __device__ __forceinline__ bool next(int i, Unit& u) const { return o.next(i, u); }
    __device__ __forceinline__ int arow(int r) const { return gather ? rowidx[t0 * 256 + r] : r; }
    __device__ __forceinline__ size_t boff(const Unit& u) const { return (size_t)tilee[t0 + u.pm] * bstride; }
};

template <class Epi, class Sched>
__device__ __forceinline__ void gemm_phase(LAS unsigned char* lds, int tid_in, const GAS bf16* A, int lda, const GAS bf16* Bt, int ldb, int K, const Sched& S, const Epi& E) {
    unsigned tid_u = (unsigned)tid_in; asm volatile("" : "+v"(tid_u));
    const int tid = (int)tid_u, wid = __builtin_amdgcn_readfirstlane(tid >> 6), lane = tid & 63, wr = wid >> 2, wc = wid & 3, fr = lane & 15, fq = lane >> 4;
    const int nt = K / BK;
    unsigned voffB[2];
    { int sR[2], sC[2];
#pragma unroll
      for (int i = 0; i < 2; ++i) { stage_rc(tid * 16 + i * 8192, sR[i], sC[i]);
        const int rho = sR[i] & 31, Rb = Epi::PERM ? ((sR[i] & ~31) + 8 * ((rho & 15) >> 2) + 4 * (rho >> 4) + (rho & 3)) : sR[i];
        voffB[i] = (unsigned)(Rb * ldb + sC[i]) * 2u; } }
#define PG8_GATHER_OFFS(pm_) do { unsigned _t = (unsigned)tid; asm volatile("" : "+v"(_t)); _Pragma("unroll") for (int i = 0; i < 2; ++i) { int _R, _C; stage_rc((int)_t * 16 + i * 8192, _R, _C); \
        vc0[i] = (unsigned)((size_t)S.arow((pm_) * BM + _R) * lda + _C) * 2u; vc1[i] = (unsigned)((size_t)S.arow((pm_) * BM + HALF + _R) * lda + _C) * 2u; } } while (0)
    const size_t kstep = (size_t)(BK * 2);
    const size_t hstepB = (size_t)HALF * ldb * 2, tstepB = 2 * hstepB;
    const unsigned ldsw = (unsigned)wid * 1024u;
    const int aoff = lds_byte(wr * 64 + fr, fq * 8), boff = lds_byte(wc * 32 + fr, fq * 8);
#define PG8_SA(b, h) (((b) * 2 + (h)) * HTB)
#define PG8_SB(b, h) ((4 + (b) * 2 + (h)) * HTB)
#define PG8_STAGE2(bufoff, gbase, v0, v1) do { \
        __builtin_amdgcn_global_load_lds((const GAS unsigned*)((const GAS char*)(gbase) + (v0)), (LAS unsigned*)(lds + (bufoff) + ldsw), 16, 0, 0); \
        __builtin_amdgcn_global_load_lds((const GAS unsigned*)((const GAS char*)(gbase) + (v1)), (LAS unsigned*)(lds + (bufoff) + ldsw + 8192), 16, 0, 0); } while (0)
#define PG8_STAGEB(bufoff, gbase) PG8_STAGE2(bufoff, gbase, voffB[0], voffB[1])
#define PG8_LDA(dst, b, h) do { _Pragma("unroll") for (int m = 0; m < 4; ++m) _Pragma("unroll") for (int k = 0; k < 2; ++k) dst[m][k] = *(const LAS bf16x8*)(lds + PG8_SA(b, h) + aoff + m * 2048 + k * 1024); } while (0)
#define PG8_LDB(dst, b, h) do { _Pragma("unroll") for (int n = 0; n < 2; ++n) _Pragma("unroll") for (int k = 0; k < 2; ++k) dst[n][k] = *(const LAS bf16x8*)(lds + PG8_SB(b, h) + boff + n * 2048 + k * 1024); } while (0)
#define PG8_MMA(ai, bj, At, Bt_) do { __builtin_amdgcn_s_setprio(1); _Pragma("unroll") for (int m = 0; m < 4; ++m) _Pragma("unroll") for (int n = 0; n < 2; ++n) _Pragma("unroll") for (int k = 0; k < 2; ++k) \
        acc[ai][bj][m][n] = __builtin_amdgcn_mfma_f32_16x16x32_bf16(Bt_[n][k], At[m][k], acc[ai][bj][m][n], 0, 0, 0); __builtin_amdgcn_s_setprio(0); } while (0)
#define PG8_WAIT_V(n) asm volatile("s_waitcnt vmcnt(" #n ")" ::: "memory")
#define PG8_WAIT_L(n) asm volatile("s_waitcnt lgkmcnt(" #n ")" ::: "memory")
#define PG8_BAR __builtin_amdgcn_s_barrier()
#define PG8_SCHED __builtin_amdgcn_sched_barrier(0)
    Unit cur, nxt; int ui = 0;
    if (!S.next(0, cur)) return;
#ifndef STAGGER
#define STAGGER 0
#endif
    if (STAGGER) { const int grp = (int)(blockIdx.x >> 3) & 3;
        for (int i = 0; i < grp * STAGGER; ++i) __builtin_amdgcn_s_sleep(127); }
    f32x4 acc[2][2][4][2];
#pragma unroll
    for (int a = 0; a < 2; ++a)
#pragma unroll
        for (int b = 0; b < 2; ++b)
#pragma unroll
            for (int m = 0; m < 4; ++m)
#pragma unroll
                for (int n = 0; n < 2; ++n) { float zf; asm volatile("v_mov_b32 %0, 0" : "=v"(zf)); acc[a][b][m][n] = (f32x4){zf, zf, zf, zf}; }
    bf16x8 At[4][2], B0[2][2], B1[2][2];
    constexpr bool GA = Sched::GATHER;
    const size_t hstepA = GA ? 0 : (size_t)HALF * lda * 2, tstepA = (size_t)BM * lda * 2;
    unsigned vc0[2], vc1[2];
    if constexpr (GA) { PG8_GATHER_OFFS(cur.pm); }
    else { int sR, sC;
#pragma unroll
        for (int i = 0; i < 2; ++i) { stage_rc(tid * 16 + i * 8192, sR, sC); vc0[i] = (unsigned)(sR * lda + sC) * 2u; vc1[i] = 0u; } }
#define VC0(i) vc0[i]
#define VC1(i) (GA ? vc1[i] : vc0[i])
#define VN0(i) vc0[i]
#define VN1(i) VC1(i)
    const GAS char* cA = GA ? (const GAS char*)A : (const GAS char*)A + (size_t)cur.pm * tstepA;
    const GAS char* cB = (const GAS char*)Bt + S.boff(cur) * 2 + (size_t)cur.pn * tstepB;
    PG8_STAGEB(PG8_SB(0, 0), cB); PG8_STAGE2(PG8_SA(0, 0), cA, VC0(0), VC0(1)); PG8_STAGEB(PG8_SB(0, 1), cB + hstepB); PG8_STAGE2(PG8_SA(0, 1), cA + hstepA, VC1(0), VC1(1));
    if (wr == 1) PG8_BAR;
    PG8_WAIT_V(4); PG8_BAR;
    PG8_STAGEB(PG8_SB(1, 0), cB + kstep); PG8_STAGE2(PG8_SA(1, 0), cA + kstep, VC0(0), VC0(1)); PG8_STAGEB(PG8_SB(1, 1), cB + hstepB + kstep);
    PG8_WAIT_V(6); PG8_BAR;
    for (;;) {
        const bool has_next = S.next(ui + 1, nxt);
        const GAS char* nB = cB; const GAS char* nA = cA;
        if (has_next) {
            nB = (const GAS char*)Bt + S.boff(nxt) * 2 + (size_t)nxt.pn * tstepB;
            if constexpr (!GA) nA = (const GAS char*)A + (size_t)nxt.pm * tstepA;
        }
        for (int t = 0; t < nt; t += 2) {
            const bool last = (t == nt - 2);
            if constexpr (Epi::HORNER) {
                if (t == 6 || t == 12) {
                    asm volatile("" ::: "memory");
                    const int seg = (t == 6) ? 0 : 1;
                    int hpm = cur.pm, hpn = cur.pn; asm volatile("" : "+s"(hpm), "+s"(hpn));
                    unsigned hln = (unsigned)lane; asm volatile("" : "+v"(hln)); const int hfr = (int)(hln & 15u), hfq = (int)(hln >> 4);
#pragma unroll
                    for (int ai = 0; ai < 2; ++ai) {
                        u32x4 ga[4][2], gb[4][2];
#pragma unroll
                        for (int m = 0; m < 4; ++m)
#pragma unroll
                            for (int bj = 0; bj < 2; ++bj) {
                                const int row = hpm * BM + ai * HALF + wr * 64 + m * 16 + hfr, col = hpn * BM + bj * HALF + wc * 32 + 8 * hfq;
                                ga[m][bj] = E.gate8(seg, row, col); gb[m][bj] = E.gate8(seg + 1, row, col);
                            }
                        asm volatile("" : "+v"(ga[0][0]), "+v"(ga[0][1]), "+v"(ga[1][0]), "+v"(ga[1][1]), "+v"(ga[2][0]), "+v"(ga[2][1]), "+v"(ga[3][0]), "+v"(ga[3][1]),
                                          "+v"(gb[0][0]), "+v"(gb[0][1]), "+v"(gb[1][0]), "+v"(gb[1][1]), "+v"(gb[2][0]), "+v"(gb[2][1]), "+v"(gb[3][0]), "+v"(gb[3][1]) :: "memory");
#pragma unroll
                        for (int m = 0; m < 4; ++m)
#pragma unroll
                            for (int bj = 0; bj < 2; ++bj) {
                                const unsigned aw[4] = {ga[m][bj].x, ga[m][bj].y, ga[m][bj].z, ga[m][bj].w}, bw[4] = {gb[m][bj].x, gb[m][bj].y, gb[m][bj].z, gb[m][bj].w};
#pragma unroll
                                for (int n = 0; n < 2; ++n) {
                                    f32x4& v = acc[ai][bj][m][n];
                                    v.x *= __uint_as_float(aw[2 * n] << 16) * __builtin_amdgcn_rcpf(__uint_as_float(bw[2 * n] << 16));
                                    v.y *= __uint_as_float(aw[2 * n] & 0xffff0000u) * __builtin_amdgcn_rcpf(__uint_as_float(bw[2 * n] & 0xffff0000u));
                                    v.z *= __uint_as_float(aw[2 * n + 1] << 16) * __builtin_amdgcn_rcpf(__uint_as_float(bw[2 * n + 1] << 16));
                                    v.w *= __uint_as_float(aw[2 * n + 1] & 0xffff0000u) * __builtin_amdgcn_rcpf(__uint_as_float(bw[2 * n + 1] & 0xffff0000u));
                                }
                            }
                    }
                    asm volatile("s_waitcnt vmcnt(0)" ::: "memory");
                }
            }
            const GAS char* a1 = cA + (size_t)(t + 1) * kstep;
            const GAS char* a2 = last ? nA : cA + (size_t)(t + 2) * kstep; const GAS char* b2 = last ? nB : cB + (size_t)(t + 2) * kstep;
            const GAS char* a3 = a2 + kstep; const GAS char* b3 = b2 + kstep;
            PG8_LDB(B0, 0, 0); PG8_SCHED; PG8_LDA(At, 0, 0); PG8_STAGE2(PG8_SA(1, 1), a1 + hstepA, VC1(0), VC1(1));
            if constexpr (GA) { if (last && has_next) { asm volatile("" ::: "memory"); PG8_GATHER_OFFS(nxt.pm); asm volatile("" ::: "memory"); } }
            PG8_WAIT_L(8); PG8_BAR; PG8_WAIT_L(0); PG8_MMA(0, 0, At, B0); PG8_BAR; PG8_SCHED;
            PG8_LDB(B1, 0, 1); PG8_STAGEB(PG8_SB(0, 0), b2);
            PG8_BAR; PG8_WAIT_L(0); PG8_MMA(0, 1, At, B1); PG8_BAR;
            PG8_LDA(At, 0, 1); PG8_STAGE2(PG8_SA(0, 0), a2, VN0(0), VN0(1));
            PG8_BAR; PG8_WAIT_L(0); PG8_MMA(1, 0, At, B0); PG8_BAR; PG8_SCHED;
            PG8_STAGEB(PG8_SB(0, 1), b2 + hstepB);
            PG8_WAIT_V(6); PG8_BAR; PG8_MMA(1, 1, At, B1); PG8_BAR;
            PG8_LDB(B0, 1, 0); PG8_SCHED; PG8_LDA(At, 1, 0); PG8_STAGE2(PG8_SA(0, 1), a2 + hstepA, VN1(0), VN1(1));
            PG8_WAIT_L(8); PG8_BAR; PG8_WAIT_L(0); PG8_MMA(0, 0, At, B0); PG8_BAR; PG8_SCHED;
            PG8_LDB(B1, 1, 1); PG8_STAGEB(PG8_SB(1, 0), b3);
            PG8_BAR; PG8_WAIT_L(0); PG8_MMA(0, 1, At, B1); PG8_BAR;
            PG8_LDA(At, 1, 1); PG8_STAGE2(PG8_SA(1, 0), a3, VN0(0), VN0(1));
            PG8_BAR; PG8_WAIT_L(0); PG8_MMA(1, 0, At, B0); PG8_BAR; PG8_SCHED;
            PG8_STAGEB(PG8_SB(1, 1), b3 + hstepB);
            PG8_WAIT_V(6); PG8_BAR; PG8_MMA(1, 1, At, B1); PG8_BAR;
        }
        {
            int epm = cur.pm, epn = cur.pn; asm volatile("" : "+s"(epm), "+s"(epn));
            unsigned eln = (unsigned)lane; asm volatile("" : "+v"(eln)); const int efr = (int)(eln & 15u), efq = (int)(eln >> 4);
            constexpr bool PM = Epi::PERM;
#define PG8_COL(bj, n) (epn * BM + (bj) * HALF + wc * 32 + (PM ? 8 * efq + 4 * (n) : (n) * 16 + 4 * efq))
            f32x4 cv[2][2];
#pragma unroll
            for (int bj = 0; bj < 2; ++bj)
#pragma unroll
                for (int n = 0; n < 2; ++n) { if constexpr (Epi::COLVEC) cv[bj][n] = E.colvec(epm * BM, PG8_COL(bj, n)); else cv[bj][n] = (f32x4){0.f, 0.f, 0.f, 0.f}; }
            if constexpr (Epi::COLVEC) asm volatile("" : "+v"(cv[0][0]), "+v"(cv[0][1]), "+v"(cv[1][0]), "+v"(cv[1][1]) :: "memory");
#pragma unroll
            for (int ai = 0; ai < 2; ++ai) {
                f32x4 bs[4][2][2];
                if constexpr (Epi::BASE) {
#pragma unroll
                    for (int m = 0; m < 4; ++m)
#pragma unroll
                        for (int bj = 0; bj < 2; ++bj) {
                            const int row = epm * BM + ai * HALF + wr * 64 + m * 16 + efr;
                            if constexpr (PM) E.base8(row, PG8_COL(bj, 0), bs[m][bj][0], bs[m][bj][1]);
                            else {
#pragma unroll
                                for (int n = 0; n < 2; ++n) bs[m][bj][n] = E.base(row, PG8_COL(bj, n));
                            }
                        }
                    asm volatile("" : "+v"(bs[0][0][0]), "+v"(bs[0][0][1]), "+v"(bs[0][1][0]), "+v"(bs[0][1][1]), "+v"(bs[1][0][0]), "+v"(bs[1][0][1]), "+v"(bs[1][1][0]), "+v"(bs[1][1][1]),
                                      "+v"(bs[2][0][0]), "+v"(bs[2][0][1]), "+v"(bs[2][1][0]), "+v"(bs[2][1][1]), "+v"(bs[3][0][0]), "+v"(bs[3][0][1]), "+v"(bs[3][1][0]), "+v"(bs[3][1][1]) :: "memory");
                }
#pragma unroll
                for (int m = 0; m < 4; ++m) {
                    const int row = epm * BM + ai * HALF + wr * 64 + m * 16 + efr;
#pragma unroll
                    for (int bj = 0; bj < 2; ++bj) {
                        if constexpr (Epi::PAIR) E.store_pair(row, epn * (BM / 2) + bj * (HALF / 2) + wc * 16 + 4 * efq, acc[ai][bj][m][0], acc[ai][bj][m][1]);
                        else if constexpr (PM) {
                            f32x4 b0 = (f32x4){0.f, 0.f, 0.f, 0.f}, b1 = b0; if constexpr (Epi::BASE) { b0 = bs[m][bj][0]; b1 = bs[m][bj][1]; }
                            E.store8(row, PG8_COL(bj, 0), acc[ai][bj][m][0], acc[ai][bj][m][1], cv[bj][0], cv[bj][1], b0, b1);
                        } else {
#pragma unroll
                            for (int n = 0; n < 2; ++n) { f32x4 bb = (f32x4){0.f, 0.f, 0.f, 0.f}; if constexpr (Epi::BASE) bb = bs[m][bj][n]; E.store(row, PG8_COL(bj, n), acc[ai][bj][m][n], cv[bj][n], bb); }
                        }
                    }
                }
            }
#undef PG8_COL
        }
        if (!has_next) break;
#pragma unroll
        for (int a = 0; a < 2; ++a)
#pragma unroll
            for (int b = 0; b < 2; ++b)
#pragma unroll
                for (int m = 0; m < 4; ++m)
#pragma unroll
                    for (int n = 0; n < 2; ++n) { float zf; asm volatile("v_mov_b32 %0, 0" : "=v"(zf)); acc[a][b][m][n] = (f32x4){zf, zf, zf, zf}; }
        cur = nxt; cB = nB; cA = nA; ++ui;
    }
    PG8_WAIT_V(0);
    if (wr == 0) PG8_BAR;
    PG8_BAR;
#undef PG8_GATHER_OFFS
#undef VC0
#undef VC1
#undef VN0
#undef VN1
#undef PG8_SA
#undef PG8_SB
#undef PG8_STAGE2
#undef PG8_STAGEB
#undef PG8_LDA
#undef PG8_LDB
#undef PG8_MMA
#undef PG8_WAIT_V
#undef PG8_WAIT_L
#undef PG8_BAR
#undef PG8_SCHED
}
}

template <class Epi>
__device__ __forceinline__ void gemm_fast(Frame& F, const GAS bf16* A, int lda, const GAS bf16* Bt, int ldb, int K, int M, int N, const Epi& E) {
    pg8::OrderPlain S; S.init(M / 256, N / 256, F.G, F.wg);
    pg8::gemm_phase(F.lds, F.tid, A, lda, Bt, ldb, K, S, E);
}
#ifndef FAST_PLAIN
#define FAST_PLAIN 1
#endif
#ifndef FAST_HORNER
#define FAST_HORNER 1
#endif
#ifndef FAST_MOE
#define FAST_MOE 1
#endif

__device__ __forceinline__ void st_bf16x4(GAS bf16* p, f32x4 v) { u32x2 w; w.x = pk2(v.x, v.y); w.y = pk2(v.z, v.w); *(GAS u32x2*)p = w; }
__device__ __forceinline__ f32x4 ld_bf16x4(const GAS bf16* p) { const u32x2 w = *(const GAS u32x2*)p; f32x4 v; v.x = __uint_as_float(w.x << 16); v.y = __uint_as_float(w.x & 0xffff0000u); v.z = __uint_as_float(w.y << 16); v.w = __uint_as_float(w.y & 0xffff0000u); return v; }

__device__ __forceinline__ void st_bf16x8(GAS bf16* p, f32x4 a, f32x4 b) { u32x4 w; w.x = pk2(a.x, a.y); w.y = pk2(a.z, a.w); w.z = pk2(b.x, b.y); w.w = pk2(b.z, b.w); *(GAS u32x4*)p = w; }
struct EpiWin {
    static constexpr bool HORNER = false, PAIR = false, COLVEC = true, BASE = false, PERM = true;
    const GAS float* bias; GAS bf16 *hytl, *hytc, *ret, *ml; GAS float* mlg;
    __device__ __forceinline__ f32x4 colvec(int, int col) const { return *(const GAS f32x4*)(bias + col); }
    __device__ __forceinline__ void store8(int row, int col, f32x4 v0, f32x4 v1, f32x4 c0, f32x4 c1, f32x4, f32x4) const {
        v0 += c0; v1 += c1;
        if (col < 1152) {
            const float v[8] = {v0.x, v0.y, v0.z, v0.w, v1.x, v1.y, v1.z, v1.w};
            if (row < TOKL) { const int b = row >> 11, t = row & 2047; GAS bf16* d = hytl + ((size_t)(b * 1152 + col)) * 2048 + t;
#pragma unroll
                for (int j = 0; j < 8; ++j) d[2048 * j] = (bf16)f2bf(v[j]); }
            else { const int r = row - TOKL, b = r >> 8, t = r & 255; GAS bf16* d = hytc + ((size_t)(b * 1152 + col)) * 256 + t;
#pragma unroll
                for (int j = 0; j < 8; ++j) d[256 * j] = (bf16)f2bf(v[j]); }
        } else if (col < 1168) { *(GAS f32x4*)(mlg + (size_t)row * 16 + (col - 1152)) = v0; *(GAS f32x4*)(mlg + (size_t)row * 16 + (col - 1152) + 4) = v1; }
        else if (col < 1280) { }
        else if (col < 2816) st_bf16x8(ret + (size_t)row * 1536 + (col - 1280), v0, v1);
        else st_bf16x8(ml + (size_t)row * 1024 + (col - 2816), v0, v1);
    }
};
struct EpiGate {
    static constexpr bool HORNER = false, PAIR = false, COLVEC = true, BASE = false, PERM = true;
    const GAS float* bias; GAS bf16* gates;
    __device__ __forceinline__ f32x4 colvec(int, int col) const { return *(const GAS f32x4*)(bias + col); }
    __device__ __forceinline__ void store8(int row, int col, f32x4 v0, f32x4 v1, f32x4 c0, f32x4 c1, f32x4, f32x4) const {
        v0 += c0; v1 += c1;
        f32x4 g0, g1;
        g0.x = fmaxf(sigmoidf_(v0.x), 1e-20f); g0.y = fmaxf(sigmoidf_(v0.y), 1e-20f); g0.z = fmaxf(sigmoidf_(v0.z), 1e-20f); g0.w = fmaxf(sigmoidf_(v0.w), 1e-20f);
        g1.x = fmaxf(sigmoidf_(v1.x), 1e-20f); g1.y = fmaxf(sigmoidf_(v1.y), 1e-20f); g1.z = fmaxf(sigmoidf_(v1.z), 1e-20f); g1.w = fmaxf(sigmoidf_(v1.w), 1e-20f);
        st_bf16x8(gates + (size_t)row * NGATE + col, g0, g1);
    }
};
struct EpiUp {
    static constexpr bool HORNER = true, PAIR = false, COLVEC = false, BASE = true, PERM = true;
    const GAS bf16* gates; GAS bf16* acc_out;
    __device__ __forceinline__ u32x4 gate8(int which, int row, int col) const { return *(const GAS u32x4*)(gates + (size_t)row * NGATE + which * 1024 + col); }
    __device__ __forceinline__ void base8(int row, int col, f32x4& b0, f32x4& b1) const {
        const u32x4 w = *(const GAS u32x4*)(gates + (size_t)row * NGATE + 2048 + col);
        b0.x = __uint_as_float(w.x << 16); b0.y = __uint_as_float(w.x & 0xffff0000u); b0.z = __uint_as_float(w.y << 16); b0.w = __uint_as_float(w.y & 0xffff0000u);
        b1.x = __uint_as_float(w.z << 16); b1.y = __uint_as_float(w.z & 0xffff0000u); b1.z = __uint_as_float(w.w << 16); b1.w = __uint_as_float(w.w & 0xffff0000u);
    }
    __device__ __forceinline__ void store8(int row, int col, f32x4 v0, f32x4 v1, f32x4, f32x4, f32x4 g0, f32x4 g1) const { st_bf16x8(acc_out + (size_t)row * D + col, v0 * g0, v1 * g1); }
};
struct EpiResid {
    static constexpr bool HORNER = false, PAIR = false, COLVEC = true, BASE = true, PERM = false;
    const GAS float *xin_l, *xin_c; GAS float *xout_l, *xout_c; const GAS float* modbase; int which; GAS float* dummy;
    __device__ __forceinline__ f32x4 colvec(int row0, int col) const { const int r = row0 < TOKL ? (row0 >> 11) : 16; return *(const GAS f32x4*)(modbase + ((size_t)r * 6 + which) * 1024 + col); }
    __device__ __forceinline__ f32x4 base(int row, int col) const { return row < TOKL ? *(const GAS f32x4*)(xin_l + (size_t)row * D + col) : *(const GAS f32x4*)(xin_c + (size_t)(row - TOKL) * D + col); }
    __device__ __forceinline__ void store(int row, int col, f32x4 v, f32x4 m, f32x4 x) const {
        if (dummy) { *(GAS f32x4*)(dummy + (size_t)(row & 8191) * D + col) = x + m * v; return; }
        if (row < TOKL) *(GAS f32x4*)(xout_l + (size_t)row * D + col) = x + m * v;
        else *(GAS f32x4*)(xout_c + (size_t)(row - TOKL) * D + col) = x + m * v;
    }
};
struct EpiSwiglu {
    static constexpr bool HORNER = false, PAIR = true, COLVEC = false, BASE = false, PERM = false;
    GAS bf16* act; int row_off;
    __device__ __forceinline__ void store_pair(int row, int col, f32x4 a, f32x4 b) const {
        f32x4 o; o.x = siluf_(a.x) * b.x; o.y = siluf_(a.y) * b.y; o.z = siluf_(a.z) * b.z; o.w = siluf_(a.w) * b.w;
        st_bf16x4(act + (size_t)(row - row_off) * DFF + col, o);
    }
    __device__ __forceinline__ void store(int, int, f32x4, f32x4, f32x4) const {}
};
struct EpiBf16Out {
    static constexpr bool HORNER = false, PAIR = false, COLVEC = false, BASE = false, PERM = true;
    GAS bf16* out; int ld; int row_add;
    __device__ __forceinline__ void store8(int row, int col, f32x4 v0, f32x4 v1, f32x4, f32x4, f32x4, f32x4) const { st_bf16x8(out + (size_t)(row + row_add) * ld + col, v0, v1); }
};

constexpr int ZPITCH_L = (LL + 8) * 2, ZPITCH_C = (LC + 8) * 2;
template <int L>
__device__ __forceinline__ float conv3_at(const GAS bf16* base  , int t, float w0, float w1, float w2) {
    const float a = t > 0 ? bf2f(base[t - 1]) : 0.f, b = bf2f(base[t]), c = t < L - 1 ? bf2f(base[t + 1]) : 0.f;
    return w0 * a + w1 * b + w2 * c;
}
template <int L>
__device__ __forceinline__ void hyena_unit_naive(Frame& F, int layer, int c, const GAS bf16* hyt  , const GAS bf16* ft  , GAS bf16* yht  ) {
    constexpr int ZP = (L + 8) * 2;
    constexpr int PER = L / 32;
    constexpr int SUB = 8;
    LAS unsigned char* zimg0 = F.lds;
    LAS unsigned char* zimg1 = F.lds + 16 * ZP;
    LAS bf16* tf = (LAS bf16*)(F.lds + 32 * ZP);
    const GAS float* cw = inp(F, I_HYCONV) + layer * 3 * 1152;
    const GAS float* skip = inp(F, I_HYSKIP) + layer * 2 * 384;
    __syncthreads();
    {
        const int b = F.tid >> 5, seg = F.tid & 31; const GAS bf16* src = hyt + ((size_t)(b * 1152 + c)) * L;
        const float w0 = cw[c], w1 = cw[1152 + c], w2 = cw[2304 + c];
#pragma unroll 2
        for (int j = 0; j < PER; ++j) { const int t = seg * PER + j; *(LAS bf16*)(zimg0 + b * ZP + t * 2) = (bf16)f2bf(conv3_at<L>(src, t, w0, w1, w2)); }
    }
#pragma unroll 1
    for (int o = 0; o < 2; ++o) {
        LAS unsigned char* zs = o == 0 ? zimg0 : zimg1;
        LAS unsigned char* zd = o == 0 ? zimg1 : zimg0;
        const GAS bf16* fsrc = ft + ((size_t)(o * 384 + c)) * (2 * L);
        for (int i = F.tid; i < 2 * L; i += NTHR) tf[i] = i == 0 ? (bf16)0 : fsrc[i];
        __syncthreads();
        const int b = F.tid & 15, tg = F.tid >> 4;
        const int gcol = (o == 0 ? 384 : 768) + c;
        const GAS bf16* gsrc = hyt + ((size_t)(b * 1152 + gcol)) * L;
        const float w0 = cw[gcol], w1 = cw[1152 + gcol], w2 = cw[2304 + gcol], sk = skip[o * 384 + c];
#pragma unroll 1
        for (int sb = 0; sb < PER / SUB; ++sb) {
            const int t0 = tg * PER + sb * SUB;
            float acc[SUB];
#pragma unroll
            for (int j = 0; j < SUB; ++j) acc[j] = 0.f;
#pragma unroll 1
            for (int s0 = 0; s0 < L; s0 += 8) {
                float z[8];
                { const bf16x8 zz = *(const LAS bf16x8*)(zs + b * ZP + s0 * 2);
#pragma unroll
                  for (int i = 0; i < 8; ++i) z[i] = bf2f((bf16)zz[i]); }
                float win[SUB + 7];
                const int wb = L + s0 - t0 - (SUB - 1);
#pragma unroll
                for (int i = 0; i < SUB + 7; ++i) win[i] = bf2f(tf[wb + i]);
#pragma unroll
                for (int j = 0; j < SUB; ++j)
#pragma unroll
                    for (int i = 0; i < 8; ++i) acc[j] += win[(SUB - 1) - j + i] * z[i];
            }
#pragma unroll
            for (int j = 0; j < SUB; ++j) {
                const int t = t0 + j;
                const float zt = bf2f(*(LAS bf16*)(zs + b * ZP + t * 2));
                const float ov = conv3_at<L>(gsrc, t, w0, w1, w2) * (acc[j] + sk * zt);
                *(LAS bf16*)(zd + b * ZP + t * 2) = (bf16)f2bf(ov);
            }
        }
        __syncthreads();
    }
#pragma unroll 2
    for (int i = F.tid; i < 16 * (L / 8); i += NTHR) {
        const int b = i / (L / 8), ch = i % (L / 8);
        *(GAS u32x4*)(yht + ((size_t)(b * 384 + c)) * L + ch * 8) = *(const LAS u32x4*)(zimg0 + b * ZP + ch * 16);
    }
}

template <int L>
__device__ __forceinline__ void hyena_unit_fast(Frame& F, int layer, int c, const GAS bf16* hyt  , const GAS bf16* ft  , GAS bf16* yht  ) {
    constexpr int ZP = (L + 8) * 2;
    constexpr int PER = L / 32;
    constexpr int I = L / 128;
    constexpr int SPAN = L / 4, NSTEP = L / 32;
    constexpr int CP = (2 * L + 8) * 2;
    LAS unsigned char* zimg = F.lds;
    LAS unsigned char* cpy = F.lds + 16 * ZP;
    const GAS float* cw = inp(F, I_HYCONV) + layer * 3 * 1152;
    const GAS float* skip = inp(F, I_HYSKIP) + layer * 2 * 384;
    const int lane = F.lane, fr = lane & 15, fq = lane >> 4, w = F.wave;
    { unsigned long long a_ = (unsigned long long)hyt, b_ = (unsigned long long)yht; asm volatile("" : "+s"(a_), "+s"(b_)); hyt = (const GAS bf16*)a_; yht = (GAS bf16*)b_; }
    __syncthreads();
    {
        const int b = F.tid >> 5, sg = F.tid & 31, t0 = sg * PER; const GAS bf16* src = hyt + ((size_t)(b * 1152 + c)) * L + t0;
        const float w0 = cw[c], w1 = cw[1152 + c], w2 = cw[2304 + c];
        u32x4 raw[PER / 8];
#pragma unroll
        for (int j = 0; j < PER / 8; ++j) raw[j] = *(const GAS u32x4*)(src + 8 * j);
        float prev = t0 > 0 ? bf2f(src[-1]) : 0.f;
        const float nextv = t0 + PER < L ? bf2f(src[PER]) : 0.f;
#pragma unroll
        for (int j = 0; j < PER / 8; ++j) {
            const unsigned wv[4] = {raw[j].x, raw[j].y, raw[j].z, raw[j].w};
            float x[10]; x[0] = prev;
#pragma unroll
            for (int q = 0; q < 4; ++q) { x[1 + 2 * q] = __uint_as_float(wv[q] << 16); x[2 + 2 * q] = __uint_as_float(wv[q] & 0xffff0000u); }
            if (j + 1 < PER / 8) x[9] = __uint_as_float(raw[(j + 1 < PER / 8) ? j + 1 : j].x << 16); else x[9] = nextv;
            u32x4 o;
            o.x = pk2(w0 * x[0] + w1 * x[1] + w2 * x[2], w0 * x[1] + w1 * x[2] + w2 * x[3]); o.y = pk2(w0 * x[2] + w1 * x[3] + w2 * x[4], w0 * x[3] + w1 * x[4] + w2 * x[5]);
            o.z = pk2(w0 * x[4] + w1 * x[5] + w2 * x[6], w0 * x[5] + w1 * x[6] + w2 * x[7]); o.w = pk2(w0 * x[6] + w1 * x[7] + w2 * x[8], w0 * x[7] + w1 * x[8] + w2 * x[9]);
            *(LAS u32x4*)(zimg + b * ZP + (t0 + 8 * j) * 2) = o;
            prev = x[8];
        }
    }
    const int tbase = SPAN * (w >> 1) + 16 * (w & 1);
    const int flane = L - tbase + 8 * fq - fr;
    const int msh = fr & 7;
    const LAS unsigned char* fbase = cpy + msh * CP + 2 * (flane + msh);
#pragma unroll 1
    for (int o = 0; o < 2; ++o) {
        const GAS bf16* fsrc = ft + ((size_t)(o * 384 + c)) * (2 * L);
        for (int i = F.tid; i < CP / 16; i += NTHR) { u32x4 v = (u32x4){0u, 0u, 0u, 0u}; if (i < 2 * L / 8) v = *(const GAS u32x4*)(fsrc + 8 * i); if (i == 0) v.x &= 0xffff0000u; *(LAS u32x4*)(cpy + 16 * i) = v; }
        __syncthreads();
        for (int task = F.tid; task < 7 * (CP / 16); task += NTHR) {
            const int m = 1 + task / (CP / 16), x8 = task % (CP / 16);
            unsigned short e[8];
#pragma unroll
            for (int i = 0; i < 8; ++i) { const int idx = 8 * x8 - m + i; e[i] = idx >= 0 ? *(const LAS unsigned short*)(cpy + 2 * idx) : (unsigned short)0; }
            u32x4 v; v.x = e[0] | ((unsigned)e[1] << 16); v.y = e[2] | ((unsigned)e[3] << 16); v.z = e[4] | ((unsigned)e[5] << 16); v.w = e[6] | ((unsigned)e[7] << 16);
            *(LAS u32x4*)(cpy + m * CP + 16 * x8) = v;
        }
        __syncthreads();
        f32x4 acc[I];
#pragma unroll
        for (int i = 0; i < I; ++i) acc[i] = (f32x4){0.f, 0.f, 0.f, 0.f};
        bf16x8 ring[I];
#pragma unroll
        for (int i = 1; i < I; ++i) ring[(I - i) % I] = *(const LAS bf16x8*)(fbase - 64 * i);
        bf16x8 nf = *(const LAS bf16x8*)(fbase);
        const LAS unsigned char* zrow = zimg + fr * ZP + 16 * fq;
#pragma unroll 1
        for (int j0 = 0; j0 < NSTEP; j0 += I) {
#pragma unroll
            for (int jj = 0; jj < I; ++jj) {
                const int j = j0 + jj;
                ring[jj] = nf;
                if (j + 1 < NSTEP) nf = *(const LAS bf16x8*)(fbase + 64 * (j + 1));
                const bf16x8 zf = *(const LAS bf16x8*)(zrow + 64 * j);
#pragma unroll
                for (int i = 0; i < I; ++i) acc[i] = __builtin_amdgcn_mfma_f32_16x16x32_bf16(ring[(jj - i + I) % I], zf, acc[i], 0, 0, 0);
            }
        }
        unsigned el_ = (unsigned)lane; asm volatile("" : "+v"(el_)); const int efr = (int)(el_ & 15u), efq = (int)(el_ >> 4);
        const int etb = SPAN * (w >> 1) + 16 * (w & 1);
        const int gcol = (o == 0 ? 384 : 768) + c;
        const GAS bf16* gsrc = hyt + ((size_t)(efr * 1152 + gcol)) * L;
        const float w0 = cw[gcol], w1 = cw[1152 + gcol], w2 = cw[2304 + gcol], sk = skip[o * 384 + c];
        GAS bf16* dst = yht + ((size_t)(efr * 384 + c)) * L;
        constexpr int GI = I < 8 ? I : 8;
#pragma unroll
        for (int i0 = 0; i0 < I; i0 += GI) {
            u32x2 grv[GI]; unsigned short gmv[GI], gpv[GI];
#pragma unroll
            for (int ii = 0; ii < GI; ++ii) {
                const int t = etb + 32 * (i0 + ii) + 4 * efq;
                grv[ii] = *(const GAS u32x2*)(gsrc + t); gmv[ii] = t > 0 ? gsrc[t - 1] : (unsigned short)0; gpv[ii] = t + 4 < L ? gsrc[t + 4] : (unsigned short)0;
            }
            asm volatile("" ::: "memory");
#pragma unroll
            for (int ii = 0; ii < GI; ++ii) {
                const int i = i0 + ii;
                const int t = etb + 32 * i + 4 * efq;
                const u32x2 zr = *(const LAS u32x2*)(zimg + efr * ZP + t * 2);
                const u32x2 gr = grv[ii];
                const float gm = bf2f(gmv[ii]), gp = bf2f(gpv[ii]);
                const float g0 = __uint_as_float(gr.x << 16), g1 = __uint_as_float(gr.x & 0xffff0000u), g2 = __uint_as_float(gr.y << 16), g3 = __uint_as_float(gr.y & 0xffff0000u);
                const float z0 = __uint_as_float(zr.x << 16), z1 = __uint_as_float(zr.x & 0xffff0000u), z2 = __uint_as_float(zr.y << 16), z3 = __uint_as_float(zr.y & 0xffff0000u);
                const float o0 = (w0 * gm + w1 * g0 + w2 * g1) * (acc[i].x + sk * z0), o1 = (w0 * g0 + w1 * g1 + w2 * g2) * (acc[i].y + sk * z1);
                const float o2 = (w0 * g1 + w1 * g2 + w2 * g3) * (acc[i].z + sk * z2), o3 = (w0 * g2 + w1 * g3 + w2 * gp) * (acc[i].w + sk * z3);
                acc[i] = (f32x4){o0, o1, o2, o3};
            }
        }
        __syncthreads();
#pragma unroll
        for (int i = 0; i < I; ++i) {
            const int t = etb + 32 * i + 4 * efq;
            u32x2 ov; ov.x = pk2(acc[i].x, acc[i].y); ov.y = pk2(acc[i].z, acc[i].w);
            if (o == 0) *(LAS u32x2*)(zimg + efr * ZP + t * 2) = ov;
            else *(GAS u32x2*)(dst + t) = ov;
        }
    }
}

__device__ __forceinline__ void chain_naive(Frame& F, int layer, int chain) {
    const int lane = F.lane;
    const bool is_ret = chain < 192;
    int b, h, dir;
    if (is_ret) { b = chain / 12; const int r = chain % 12; h = r >> 1; dir = r & 1; }
    else { const int i = chain - 192; b = i >> 3; h = (i & 7) >> 1; dir = i & 1; }
    const GAS bf16* RET = WSP(const bf16, WS_RET); const GAS bf16* ML = WSP(const bf16, WS_ML); const GAS float* MLG = WSP(const float, WS_MLG);
    const GAS float* rope = WSP(const float, WS_ROPE);
    GAS bf16* Y = WSP(bf16, WS_Y); GAS bf16* OB = WSP(bf16, WS_OB);
    float gam = 0.f;
    if (is_ret) gam = sigmoidf_(inp(F, I_RETDECAY)[layer * 12 + dir * 6 + h]);
    const GAS float* mlc = inp(F, I_MLCONV) + layer * 3 * 512;
    const float bi = is_ret ? 0.f : inp(F, I_MLGB)[layer * 16 + dir * 8 + h], bfg = is_ret ? 0.f : inp(F, I_MLGB)[layer * 16 + dir * 8 + 4 + h];
    const float qw0 = mlc[h * 64 + lane], qw1 = mlc[512 + h * 64 + lane], qw2 = mlc[1024 + h * 64 + lane];
    const float kw0 = mlc[256 + h * 64 + lane], kw1 = mlc[512 + 256 + h * 64 + lane], kw2 = mlc[1024 + 256 + h * 64 + lane];
    float S[64];
#pragma unroll
    for (int d = 0; d < 64; ++d) S[d] = 0.f;
    float nv = 0.f;
    for (int step = 0; step < LC + LL; ++step) {
        int row, tpos, L; bool lat;
        if (step < LC) { tpos = dir ? (LC - 1 - step) : step; row = TOKL + b * LC + tpos; L = LC; lat = false; }
        else { const int s2 = step - LC; tpos = dir ? (LL - 1 - s2) : s2; row = b * LL + tpos; L = LL; lat = true; }
        float q, k, v, Fm, Im;
        if (is_ret) {
            const GAS bf16* base = RET + (size_t)row * 1536;
            float qs = bf2f(base[h * 64 + lane]), ks = bf2f(base[384 + h * 64 + lane]);
            v = bf2f(base[768 + h * 64 + lane]);
            if (lat) {
                const float qp = bf2f(base[h * 64 + (lane ^ 16)]), kp = bf2f(base[384 + h * 64 + (lane ^ 16)]);
                const int half = lane >> 5, ii = lane & 15, hi = (lane >> 4) & 1;
                const float cs = rope[tpos * 64 + half * 32 + ii], sn = rope[tpos * 64 + half * 32 + 16 + ii];
                q = hi == 0 ? qs * cs - qp * sn : qp * sn + qs * cs;
                k = hi == 0 ? ks * cs - kp * sn : kp * sn + ks * cs;
            } else { q = qs; k = ks; }
            q *= 0.125f; Fm = gam; Im = 1.f;
        } else {
            const GAS bf16* base = ML + (size_t)row * 1024;
            const float q0 = tpos > 0 ? bf2f(base[-1024 + h * 64 + lane]) : 0.f, q1 = bf2f(base[h * 64 + lane]), q2 = tpos < L - 1 ? bf2f(base[1024 + h * 64 + lane]) : 0.f;
            const float k0 = tpos > 0 ? bf2f(base[-1024 + 256 + h * 64 + lane]) : 0.f, k1 = bf2f(base[256 + h * 64 + lane]), k2 = tpos < L - 1 ? bf2f(base[1024 + 256 + h * 64 + lane]) : 0.f;
            q = siluf_(qw0 * q0 + qw1 * q1 + qw2 * q2);
            k = siluf_(kw0 * k0 + kw1 * k1 + kw2 * k2) * 0.125f;
            v = bf2f(base[512 + h * 64 + lane]);
            const float ig = MLG[(size_t)row * 16 + dir * 8 + h] + bi, fg = MLG[(size_t)row * 16 + dir * 8 + 4 + h] + bfg;
            Fm = sigmoidf_(fg); Im = __expf(ig);
        }
        float num = 0.f;
        const float iv = Im * v;
#pragma unroll
        for (int d = 0; d < 64; ++d) {
            const float kd = __int_as_float(__builtin_amdgcn_readlane(__float_as_int(k), d));
            const float qd = __int_as_float(__builtin_amdgcn_readlane(__float_as_int(q), d));
            S[d] = Fm * S[d] + kd * iv;
            num += qd * S[d];
        }
        float o = num;
        if (!is_ret) { nv = Fm * nv + Im * k; const float den = wave_sum(q * nv); o = num / fmaxf(fabsf(den), 1.f); }
        const int cof = is_ret ? (h * 64 + lane) : (384 + h * 64 + lane);
        if (dir == 0) Y[(size_t)row * D + 384 + cof] = (bf16)f2bf(o);
        else OB[(size_t)row * 640 + cof] = (bf16)f2bf(o);
    }
}

#ifndef REP_CH
#define REP_CH 1
#endif
#ifndef REP_CH_ML
#define REP_CH_ML REP_CH
#endif
#ifndef REP_CH_RET
#define REP_CH_RET REP_CH
#endif
constexpr int CH_PITCH = 144;
constexpr int CH_IMG = 64 * CH_PITCH;
constexpr int CH_WAVE_LDS = 3 * CH_IMG + 1024 + 512;
__device__ __forceinline__ void ds_tr16x8(unsigned addr, u32x2 (&lo)[4], u32x2 (&hi)[4]) {
    asm volatile("ds_read_b64_tr_b16 %0, %8\n\tds_read_b64_tr_b16 %1, %8 offset:32\n\tds_read_b64_tr_b16 %2, %8 offset:64\n\tds_read_b64_tr_b16 %3, %8 offset:96\n\t"
                 "ds_read_b64_tr_b16 %4, %8 offset:2304\n\tds_read_b64_tr_b16 %5, %8 offset:2336\n\tds_read_b64_tr_b16 %6, %8 offset:2368\n\tds_read_b64_tr_b16 %7, %8 offset:2400\n\t"
                 "s_waitcnt lgkmcnt(0)"
                 : "=&v"(lo[0]), "=&v"(lo[1]), "=&v"(lo[2]), "=&v"(lo[3]), "=&v"(hi[0]), "=&v"(hi[1]), "=&v"(hi[2]), "=&v"(hi[3]) : "v"(addr) : "memory");
}
static_assert(16 * CH_PITCH == 2304, "ds_tr16x8 offsets");
__device__ __forceinline__ void ds_tr16x4(unsigned addr, u32x2 (&lo)[2], u32x2 (&hi)[2]) {
    asm volatile("ds_read_b64_tr_b16 %0, %4\n\tds_read_b64_tr_b16 %1, %4 offset:32\n\tds_read_b64_tr_b16 %2, %4 offset:2304\n\tds_read_b64_tr_b16 %3, %4 offset:2336\n\ts_waitcnt lgkmcnt(0)"
                 : "=&v"(lo[0]), "=&v"(lo[1]), "=&v"(hi[0]), "=&v"(hi[1]) : "v"(addr) : "memory");
}
__device__ __forceinline__ float log_sigmoid_(float x) { return fminf(x, 0.f) - log1pf(__expf(-fabsf(x))); }
__device__ __forceinline__ bf16x8 mk_frag(u32x2 lo, u32x2 hi) { u32x4 w; w.x = lo.x; w.y = lo.y; w.z = hi.x; w.w = hi.y; return __builtin_bit_cast(bf16x8, w); }

template <bool IS_ML>
__device__ __forceinline__ void chain_fast(Frame& F, int layer, int b, int h, int dir, LAS unsigned char* img, int hf) {
    constexpr int NET = 2;
    const int lane = F.lane, fr = lane & 15, fq = lane >> 4;
    LAS unsigned char* Qi = img; LAS unsigned char* Ki = img + CH_IMG; LAS unsigned char* Vi = img + 2 * CH_IMG;
    const unsigned qa = (unsigned)(size_t)Qi, ka = (unsigned)(size_t)Ki, va = (unsigned)(size_t)Vi;
    const GAS bf16* RET = WSP(const bf16, WS_RET); const GAS bf16* ML = WSP(const bf16, WS_ML); const GAS float* MLG = WSP(const float, WS_MLG);
    const GAS float* rope = WSP(const float, WS_ROPE);
    GAS bf16* Y = WSP(bf16, WS_Y); GAS bf16* OB = WSP(bf16, WS_OB);
    float lgam = 0.f, bi_ = 0.f, bf_ = 0.f;
    if (!IS_ML) lgam = log_sigmoid_(inp(F, I_RETDECAY)[layer * 12 + dir * 6 + h]);
    else { bi_ = inp(F, I_MLGB)[layer * 16 + dir * 8 + h]; bf_ = inp(F, I_MLGB)[layer * 16 + dir * 8 + 4 + h]; }
    const GAS float* mlc = inp(F, I_MLCONV) + layer * 3 * 512;
    f32x4 C[4][NET];
#pragma unroll
    for (int dt = 0; dt < 4; ++dt)
#pragma unroll
        for (int et = 0; et < NET; ++et) C[dt][et] = (f32x4){0.f, 0.f, 0.f, 0.f};
    const int cq = lane & 7, pr0 = lane >> 3;
    LAS float* nvec = (LAS float*)(img + 3 * CH_IMG + 1024 + 256 * hf);
    if (IS_ML) nvec[lane] = 0.f;
    const LAS float* nq = nvec + 4 * fq;
#pragma unroll 1
    for (int step_ = 0; step_ < 36 * (IS_ML ? REP_CH_ML : REP_CH_RET); ++step_) {
        const int step = step_ % 36;
        if ((IS_ML ? REP_CH_ML : REP_CH_RET) > 1 && step == 0) {
            if (IS_ML) nvec[lane] = 0.f;
#pragma unroll
            for (int dt = 0; dt < 4; ++dt)
#pragma unroll
                for (int et = 0; et < NET; ++et) C[dt][et] = (f32x4){0.f, 0.f, 0.f, 0.f};
        }
        int rowbase, t0, L; bool lat;
        if (step < 4) { const int cc = dir ? 3 - step : step; rowbase = TOKL + b * LC + cc * 64; t0 = cc * 64; L = LC; lat = false; }
        else { const int cc = dir ? 35 - step : step - 4; rowbase = b * LL + cc * 64; t0 = cc * 64; L = LL; lat = true; }
        float g_i = 0.f, g_f = 0.f;
        if (IS_ML) { const int tlg = dir ? 63 - lane : lane; const GAS float* gp = MLG + (size_t)(rowbase + tlg) * 16 + dir * 8 + h; g_i = gp[0]; g_f = gp[4]; }
        if constexpr (!IS_ML) {
#pragma unroll
        for (int i4 = 0; i4 < 4; ++i4) {
            const int i = 4 * hf + i4;
            const int p = pr0 + 8 * i, tl = dir ? 63 - p : p, row = rowbase + tl, tpos = t0 + tl;
            float qv[8], kv[8]; u32x4 vraw;
            {
                const GAS bf16* base = RET + (size_t)row * 1536 + h * 64;
                const u32x4 qr = *(const GAS u32x4*)(base + 8 * cq), kr = *(const GAS u32x4*)(base + 384 + 8 * cq); vraw = *(const GAS u32x4*)(base + 768 + 8 * cq);
                const unsigned qw[4] = {qr.x, qr.y, qr.z, qr.w}, kw[4] = {kr.x, kr.y, kr.z, kr.w};
#pragma unroll
                for (int j = 0; j < 4; ++j) { qv[2 * j] = __uint_as_float(qw[j] << 16); qv[2 * j + 1] = __uint_as_float(qw[j] & 0xffff0000u); kv[2 * j] = __uint_as_float(kw[j] << 16); kv[2 * j + 1] = __uint_as_float(kw[j] & 0xffff0000u); }
                if (lat) {
                    const u32x4 qpr = *(const GAS u32x4*)(base + 8 * (cq ^ 2)), kpr = *(const GAS u32x4*)(base + 384 + 8 * (cq ^ 2));
                    const unsigned qpw[4] = {qpr.x, qpr.y, qpr.z, qpr.w}, kpw[4] = {kpr.x, kpr.y, kpr.z, kpr.w};
                    const int half = cq >> 2, hi = (cq >> 1) & 1, i0 = 8 * (cq & 1);
                    const GAS float* rp = rope + tpos * 64 + half * 32 + i0;
                    const f32x4 c0 = *(const GAS f32x4*)(rp), c1 = *(const GAS f32x4*)(rp + 4), s0 = *(const GAS f32x4*)(rp + 16), s1 = *(const GAS f32x4*)(rp + 20);
                    const float cs[8] = {c0.x, c0.y, c0.z, c0.w, c1.x, c1.y, c1.z, c1.w}, sn[8] = {s0.x, s0.y, s0.z, s0.w, s1.x, s1.y, s1.z, s1.w};
#pragma unroll
                    for (int j = 0; j < 8; ++j) {
                        const float qp = (j & 1) ? __uint_as_float(qpw[j >> 1] & 0xffff0000u) : __uint_as_float(qpw[j >> 1] << 16);
                        const float kp = (j & 1) ? __uint_as_float(kpw[j >> 1] & 0xffff0000u) : __uint_as_float(kpw[j >> 1] << 16);
                        qv[j] = hi ? qp * sn[j] + qv[j] * cs[j] : qv[j] * cs[j] - qp * sn[j];
                        kv[j] = hi ? kp * sn[j] + kv[j] * cs[j] : kv[j] * cs[j] - kp * sn[j];
                    }
                }
#pragma unroll
                for (int j = 0; j < 8; ++j) qv[j] *= 0.125f;
            }
            u32x4 qo, ko; qo.x = pk2(qv[0], qv[1]); qo.y = pk2(qv[2], qv[3]); qo.z = pk2(qv[4], qv[5]); qo.w = pk2(qv[6], qv[7]);
            ko.x = pk2(kv[0], kv[1]); ko.y = pk2(kv[2], kv[3]); ko.z = pk2(kv[4], kv[5]); ko.w = pk2(kv[6], kv[7]);
            *(LAS u32x4*)(Qi + p * CH_PITCH + 16 * cq) = qo; *(LAS u32x4*)(Ki + p * CH_PITCH + 16 * cq) = ko; *(LAS u32x4*)(Vi + p * CH_PITCH + 16 * cq) = vraw;
        }
        } else {
            const GAS float* wq = mlc + h * 64 + 8 * cq;
            u32x4 rr[2][3][4], vr[4];
#pragma unroll
            for (int i4 = 0; i4 < 4; ++i4) {
                const int p = pr0 + 8 * (4 * hf + i4), tl = dir ? 63 - p : p, row = rowbase + tl, tpos = t0 + tl;
                const GAS bf16* bb = ML + (size_t)row * 1024 + h * 64 + 8 * cq;
                const u32x4 z4 = (u32x4){0u, 0u, 0u, 0u};
#pragma unroll
                for (int qk = 0; qk < 2; ++qk) {
                    rr[qk][1][i4] = *(const GAS u32x4*)(bb + 256 * qk);
                    rr[qk][0][i4] = tpos > 0 ? *(const GAS u32x4*)(bb + 256 * qk - 1024) : z4;
                    rr[qk][2][i4] = tpos < L - 1 ? *(const GAS u32x4*)(bb + 256 * qk + 1024) : z4;
                }
                vr[i4] = *(const GAS u32x4*)(bb + 512);
            }
#pragma unroll
            for (int qk = 0; qk < 2; ++qk) {
                f32x4 wt[3][2];
#pragma unroll
                for (int tp = 0; tp < 3; ++tp) { wt[tp][0] = *(const GAS f32x4*)(wq + 256 * qk + 512 * tp); wt[tp][1] = *(const GAS f32x4*)(wq + 256 * qk + 512 * tp + 4); }
#pragma unroll
                for (int i4 = 0; i4 < 4; ++i4) {
                    const int p = pr0 + 8 * (4 * hf + i4);
                    const unsigned a0[4] = {rr[qk][0][i4].x, rr[qk][0][i4].y, rr[qk][0][i4].z, rr[qk][0][i4].w}, a1[4] = {rr[qk][1][i4].x, rr[qk][1][i4].y, rr[qk][1][i4].z, rr[qk][1][i4].w},
                                   a2[4] = {rr[qk][2][i4].x, rr[qk][2][i4].y, rr[qk][2][i4].z, rr[qk][2][i4].w};
                    float ov[8];
#pragma unroll
                    for (int j = 0; j < 8; ++j) {
                        const float x0 = (j & 1) ? __uint_as_float(a0[j >> 1] & 0xffff0000u) : __uint_as_float(a0[j >> 1] << 16);
                        const float x1 = (j & 1) ? __uint_as_float(a1[j >> 1] & 0xffff0000u) : __uint_as_float(a1[j >> 1] << 16);
                        const float x2 = (j & 1) ? __uint_as_float(a2[j >> 1] & 0xffff0000u) : __uint_as_float(a2[j >> 1] << 16);
                        const float r = siluf_(wt[0][j >> 2][j & 3] * x0 + wt[1][j >> 2][j & 3] * x1 + wt[2][j >> 2][j & 3] * x2);
                        ov[j] = qk == 0 ? r : r * 0.125f;
                    }
                    u32x4 o; o.x = pk2(ov[0], ov[1]); o.y = pk2(ov[2], ov[3]); o.z = pk2(ov[4], ov[5]); o.w = pk2(ov[6], ov[7]);
                    if (qk == 0) *(LAS u32x4*)(Qi + p * CH_PITCH + 16 * cq) = o;
                    else { *(LAS u32x4*)(Ki + p * CH_PITCH + 16 * cq) = o; *(LAS u32x4*)(Vi + p * CH_PITCH + 16 * cq) = vr[i4]; }
                }
            }
        }
        __builtin_amdgcn_sched_barrier(0);
        float f_p, i_p;
        if (!IS_ML) { f_p = lgam; i_p = 0.f; }
        else { i_p = g_i + bi_; f_p = log_sigmoid_(g_f + bf_); }
        float bsum = f_p;
#pragma unroll
        for (int o = 1; o < 64; o <<= 1) { const float t = lane_read(bsum, lane >= o ? lane - o : lane); if (lane >= o) bsum += t; }
        LAS float* gv = (LAS float*)(img + 3 * CH_IMG);
        const float b63 = __int_as_float(__builtin_amdgcn_readlane(__float_as_int(bsum), 63));
        const float adec = __expf(b63);
        if (hf == 0) { gv[lane] = bsum; gv[64 + lane] = bsum - i_p; gv[128 + lane] = __expf(bsum); gv[192 + lane] = __expf(b63 - (bsum - i_p)); }
        asm volatile("s_waitcnt lgkmcnt(0)" ::: "memory");
        __syncthreads();
        const LAS float* gq = gv + 4 * fq;
        const bf16x8 ones = (fr == 0) ? (bf16x8){0x3F80, 0x3F80, 0x3F80, 0x3F80, 0x3F80, 0x3F80, 0x3F80, 0x3F80} : (bf16x8){0, 0, 0, 0, 0, 0, 0, 0};
        const int tr_q = fr >> 2, tr_p = fr & 3;
#pragma unroll 1
        for (int pt = 0; pt < 4; ++pt) {
            f32x4 ST[4];
            bf16x8 qn[2];
#pragma unroll
            for (int kk = 0; kk < 2; ++kk) qn[kk] = *(const LAS bf16x8*)(Qi + (16 * pt + fr) * CH_PITCH + (32 * kk + 8 * fq) * 2);
#pragma unroll
            for (int st = 0; st < 4; ++st) {
                ST[st] = (f32x4){0.f, 0.f, 0.f, 0.f};
                if (st <= pt) {
#pragma unroll
                    for (int kk = 0; kk < 2; ++kk) { const bf16x8 kf = *(const LAS bf16x8*)(Ki + (16 * st + fr) * CH_PITCH + (32 * kk + 8 * fq) * 2); ST[st] = __builtin_amdgcn_mfma_f32_16x16x32_bf16(kf, qn[kk], ST[st], 0, 0, 0); }
                }
            }
            const float bp = gv[16 * pt + fr];
#pragma unroll
            for (int st = 0; st < 4; ++st) {
                if (st <= pt) {
                    const f32x4 bis = *(const LAS f32x4*)(gq + 64 + 16 * st);
#pragma unroll
                    for (int j = 0; j < 4; ++j) { const int sidx = 16 * st + 4 * fq + j; const float w = (sidx <= 16 * pt + fr) ? __expf(bp - bis[j]) : 0.f; ST[st][j] *= w; }
                }
            }
            __builtin_amdgcn_sched_barrier(0);
            f32x4 acc[NET], accd = (f32x4){0.f, 0.f, 0.f, 0.f};
#pragma unroll
            for (int et = 0; et < NET; ++et) acc[et] = (f32x4){0.f, 0.f, 0.f, 0.f};
#pragma unroll
            for (int kk = 0; kk < 2; ++kk) {
                const u32x2 lo = *(const LAS u32x2*)(Qi + (16 * pt + fr) * CH_PITCH + (32 * kk + 4 * fq) * 2), hi = *(const LAS u32x2*)(Qi + (16 * pt + fr) * CH_PITCH + (32 * kk + 16 + 4 * fq) * 2);
                const bf16x8 qs = mk_frag(lo, hi);
#pragma unroll
                for (int et = 0; et < NET; ++et) {
                    u32x4 w; w.x = pk2(C[2 * kk][et].x, C[2 * kk][et].y); w.y = pk2(C[2 * kk][et].z, C[2 * kk][et].w); w.z = pk2(C[2 * kk + 1][et].x, C[2 * kk + 1][et].y); w.w = pk2(C[2 * kk + 1][et].z, C[2 * kk + 1][et].w);
                    acc[et] = __builtin_amdgcn_mfma_f32_16x16x32_bf16(qs, __builtin_bit_cast(bf16x8, w), acc[et], 0, 0, 0);
                }
                if (IS_ML) {
                    const f32x4 n0 = *(const LAS f32x4*)(nq + 32 * kk), n1 = *(const LAS f32x4*)(nq + 32 * kk + 16);
                    u32x4 w; w.x = pk2(n0.x, n0.y); w.y = pk2(n0.z, n0.w); w.z = pk2(n1.x, n1.y); w.w = pk2(n1.z, n1.w);
                    if (fr != 0) w = (u32x4){0u, 0u, 0u, 0u};
                    accd = __builtin_amdgcn_mfma_f32_16x16x32_bf16(qs, __builtin_bit_cast(bf16x8, w), accd, 0, 0, 0);
                }
            }
            { const f32x4 ap = *(const LAS f32x4*)(gq + 128 + 16 * pt);
#pragma unroll
              for (int j = 0; j < 4; ++j) {
#pragma unroll
                for (int et = 0; et < NET; ++et) acc[et][j] *= ap[j];
                accd[j] *= ap[j]; } }
            __builtin_amdgcn_sched_barrier(0);
#pragma unroll
            for (int kk = 0; kk < 2; ++kk) {
                if (2 * kk <= pt) {
                    u32x4 w; w.x = pk2(ST[2 * kk].x, ST[2 * kk].y); w.y = pk2(ST[2 * kk].z, ST[2 * kk].w); w.z = pk2(ST[2 * kk + 1].x, ST[2 * kk + 1].y); w.w = pk2(ST[2 * kk + 1].z, ST[2 * kk + 1].w);
                    const bf16x8 pf = __builtin_bit_cast(bf16x8, w);
                    u32x2 vlo[2], vhi[2];
                    ds_tr16x4(va + (32 * kk + 4 * fq + tr_q) * CH_PITCH + 8 * tr_p + 64 * hf, vlo, vhi);
#pragma unroll
                    for (int et = 0; et < NET; ++et) acc[et] = __builtin_amdgcn_mfma_f32_16x16x32_bf16(pf, mk_frag(vlo[et], vhi[et]), acc[et], 0, 0, 0);
                    if (IS_ML) accd = __builtin_amdgcn_mfma_f32_16x16x32_bf16(pf, ones, accd, 0, 0, 0);
                }
            }
            __builtin_amdgcn_sched_barrier(0);
#pragma unroll
            for (int j = 0; j < 4; ++j) {
                const int p = 16 * pt + 4 * fq + j, tl = dir ? 63 - p : p, row = rowbase + tl;
                float inv = 1.f;
                if (IS_ML) { const float den = lane_read(accd[j], lane & 48); inv = __builtin_amdgcn_rcpf(fmaxf(fabsf(den), 1.f)); }
                const int cof = (IS_ML ? 384 : 0) + h * 64 + 32 * hf + fr;
                const unsigned boff = dir == 0 ? (unsigned)(row * D + 384 + cof) * 2u : (unsigned)(row * 640 + cof) * 2u;
                GAS char* ob = dir == 0 ? (GAS char*)Y : (GAS char*)OB;
#pragma unroll
                for (int et = 0; et < NET; ++et) *(GAS bf16*)(ob + boff + 32 * et) = (bf16)f2bf(acc[et][j] * inv);
            }
        }
        __builtin_amdgcn_sched_barrier(0);
#pragma unroll
        for (int dt = 0; dt < 4; ++dt)
#pragma unroll
            for (int et = 0; et < NET; ++et) C[dt][et] *= adec;
        f32x4 accn[4];
        if (IS_ML) {
#pragma unroll
            for (int dt = 0; dt < 4; ++dt) { accn[dt] = *(const LAS f32x4*)(nq + 16 * dt) * adec; if (fr != 0) accn[dt] = (f32x4){0.f, 0.f, 0.f, 0.f}; }
        }
#pragma unroll
        for (int kk = 0; kk < 2; ++kk) {
            u32x2 vlo[2], vhi[2], klo[4], khi[4];
            ds_tr16x4(va + (32 * kk + 4 * fq + tr_q) * CH_PITCH + 8 * tr_p + 64 * hf, vlo, vhi);
            ds_tr16x8(ka + (32 * kk + 4 * fq + tr_q) * CH_PITCH + 8 * tr_p, klo, khi);
            const f32x4 wl = *(const LAS f32x4*)(gq + 192 + 32 * kk), wh = *(const LAS f32x4*)(gq + 192 + 32 * kk + 16);
#pragma unroll
            for (int dt = 0; dt < 4; ++dt) {
                u32x4 w;
                w.x = pk2(__uint_as_float(klo[dt].x << 16) * wl[0], __uint_as_float(klo[dt].x & 0xffff0000u) * wl[1]);
                w.y = pk2(__uint_as_float(klo[dt].y << 16) * wl[2], __uint_as_float(klo[dt].y & 0xffff0000u) * wl[3]);
                w.z = pk2(__uint_as_float(khi[dt].x << 16) * wh[0], __uint_as_float(khi[dt].x & 0xffff0000u) * wh[1]);
                w.w = pk2(__uint_as_float(khi[dt].y << 16) * wh[2], __uint_as_float(khi[dt].y & 0xffff0000u) * wh[3]);
                const bf16x8 kf = __builtin_bit_cast(bf16x8, w);
#pragma unroll
                for (int et = 0; et < NET; ++et) C[dt][et] = __builtin_amdgcn_mfma_f32_16x16x32_bf16(kf, mk_frag(vlo[et], vhi[et]), C[dt][et], 0, 0, 0);
                if (IS_ML) accn[dt] = __builtin_amdgcn_mfma_f32_16x16x32_bf16(kf, ones, accn[dt], 0, 0, 0);
            }
        }
        if (IS_ML) { if (fr == 0) {
#pragma unroll
            for (int dt = 0; dt < 4; ++dt) *(LAS f32x4*)(nvec + 4 * fq + 16 * dt) = accn[dt]; } }
        asm volatile("s_waitcnt lgkmcnt(0)" ::: "memory");
        __syncthreads();
    }
}

#ifndef FAST_CHAIN
#define FAST_CHAIN 1
#endif
constexpr int NCHWG = 160;
__device__ __forceinline__ void phase_mix(Frame& F, int layer) {
    const bool last = layer == 1;
    const GAS bf16* ftl = WSP(const bf16, WS_FTL) + (size_t)layer * 2 * 384 * 4096;
    if (FAST_CHAIN) {
        if (F.wg < NCHWG) {
            if (F.wave >= 4) {
#pragma unroll 1
                for (int i = 0; i < 72 * (F.wg * 2 < 192 ? REP_CH_RET : REP_CH_ML); ++i) __syncthreads();
            } else {
                const int cl = F.wave >> 1, hf = F.wave & 1, c = F.wg * 2 + cl;
                LAS unsigned char* img = F.lds + cl * CH_WAVE_LDS;
                {
                if (c < 192) { const int b = c / 12, r = c % 12; chain_fast<false>(F, layer, b, r >> 1, r & 1, img, hf); }
                else { const int i = c - 192; chain_fast<true>(F, layer, i >> 3, (i & 7) >> 1, i & 1, img, hf); }
                }
            }
        } else {
            const int nh = F.G - NCHWG, w = F.wg - NCHWG;
#ifndef FAST_HY
#define FAST_HY 1
#endif
            if (FAST_HY) {
#ifndef REP_HY
#define REP_HY 1
#endif
#pragma unroll 1
                for (int rp = 0; rp < REP_HY; ++rp)
                for (int u = w; u < 384; u += nh) hyena_unit_fast<LL>(F, layer, u, WSP(const bf16, WS_HYTL), ftl, WSP(bf16, WS_YHTL));
                if (!last) for (int u = w; u < 384; u += nh) hyena_unit_fast<LC>(F, layer, u, WSP(const bf16, WS_HYTC), WSP(const bf16, WS_FTC), WSP(bf16, WS_YHTC));
            } else {
                for (int u = w; u < 384; u += nh) hyena_unit_naive<LL>(F, layer, u, WSP(const bf16, WS_HYTL), ftl, WSP(bf16, WS_YHTL));
                if (!last) for (int u = w; u < 384; u += nh) hyena_unit_naive<LC>(F, layer, u, WSP(const bf16, WS_HYTC), WSP(const bf16, WS_FTC), WSP(bf16, WS_YHTC));
            }
        }
    } else {
        for (int u = F.wg; u < 384; u += F.G) hyena_unit_naive<LL>(F, layer, u, WSP(const bf16, WS_HYTL), ftl, WSP(bf16, WS_YHTL));
        if (!last) for (int u = F.wg; u < 384; u += F.G) hyena_unit_naive<LC>(F, layer, u, WSP(const bf16, WS_HYTC), WSP(const bf16, WS_FTC), WSP(bf16, WS_YHTC));
        for (int c = F.wg + F.wave * F.G; c < 320; c += F.G * NWAVES) chain_naive(F, layer, c);
    }
}

__device__ __forceinline__ void phase_combine(Frame& F, int layer, bool dummy = false) {
    const bool last = layer == 1;
    const int gw = F.wg * NWAVES + F.wave, NGW = F.G * NWAVES, lane = F.lane;
    const int nrows = last ? TOKL : TOK;
    GAS bf16* Y = WSP(bf16, WS_Y); const GAS bf16* OB = WSP(const bf16, WS_OB); const GAS bf16* RET = WSP(const bf16, WS_RET); const GAS bf16* ML = WSP(const bf16, WS_ML);
    const int rsub = lane >> 4, l16 = lane & 15;
    for (int row0 = gw * 4; row0 < nrows; row0 += NGW * 4) {
        const int row = row0 + rsub;
        GAS bf16* yo = dummy ? WSP(bf16, WS_U + 300 * MiB) + (size_t)(row & 8191) * D : Y + (size_t)row * D;
        u32x2 of[10], ob[10], gt[10];
#pragma unroll
        for (int hh = 0; hh < 10; ++hh) {
            const int cof = hh * 64 + 4 * l16;
            of[hh] = *(const GAS u32x2*)(Y + (size_t)row * D + 384 + cof); ob[hh] = *(const GAS u32x2*)(OB + (size_t)row * 640 + cof);
            gt[hh] = hh < 6 ? *(const GAS u32x2*)(RET + (size_t)row * 1536 + 1152 + cof) : *(const GAS u32x2*)(ML + (size_t)row * 1024 + 768 + (cof - 384));
        }
#pragma unroll
        for (int hh = 0; hh < 10; ++hh) {
            float x[4], g[4];
            x[0] = __uint_as_float(of[hh].x << 16) + __uint_as_float(ob[hh].x << 16); x[1] = __uint_as_float(of[hh].x & 0xffff0000u) + __uint_as_float(ob[hh].x & 0xffff0000u);
            x[2] = __uint_as_float(of[hh].y << 16) + __uint_as_float(ob[hh].y << 16); x[3] = __uint_as_float(of[hh].y & 0xffff0000u) + __uint_as_float(ob[hh].y & 0xffff0000u);
            g[0] = __uint_as_float(gt[hh].x << 16); g[1] = __uint_as_float(gt[hh].x & 0xffff0000u); g[2] = __uint_as_float(gt[hh].y << 16); g[3] = __uint_as_float(gt[hh].y & 0xffff0000u);
            float sm = (x[0] + x[1]) + (x[2] + x[3]);
            DPP_ADD(sm, 0xB1); DPP_ADD(sm, 0x4E); DPP_ADD(sm, 0x141); DPP_ADD(sm, 0x140);
            const float mu = sm * (1.f / 64.f);
#pragma unroll
            for (int j = 0; j < 4; ++j) x[j] -= mu;
            float sq = (x[0] * x[0] + x[1] * x[1]) + (x[2] * x[2] + x[3] * x[3]);
            DPP_ADD(sq, 0xB1); DPP_ADD(sq, 0x4E); DPP_ADD(sq, 0x141); DPP_ADD(sq, 0x140);
            const float rs = rsqrtf(sq * (1.f / 64.f) + 1e-6f);
            float o[4];
#pragma unroll
            for (int j = 0; j < 4; ++j) o[j] = x[j] * rs * (hh < 6 ? siluf_(g[j]) : sigmoidf_(g[j]));
            u32x2 w; w.x = pk2(o[0], o[1]); w.y = pk2(o[2], o[3]);
            *(GAS u32x2*)(yo + 384 + hh * 64 + 4 * l16) = w;
        }
    }
    LAS unsigned char* scr = F.lds + F.wave * 8704;
    const int nitL = NB * 6 * 32, nitC = last ? 0 : NB * 6 * 4;
    for (int it = gw; it < nitL + nitC; it += NGW) {
        const GAS bf16* src; int L, rowbase, b, cb, tb;
        if (it < nitL) { b = it / 192; const int r = it % 192; cb = r / 32; tb = r % 32; L = LL; src = WSP(const bf16, WS_YHTL); rowbase = b * LL; }
        else { const int i2 = it - nitL; b = i2 / 24; const int r = i2 % 24; cb = r / 4; tb = r % 4; L = LC; src = WSP(const bf16, WS_YHTC); rowbase = TOKL + b * LC; }
        u32x4 v[8];
#pragma unroll
        for (int i = 0; i < 8; ++i) { const int cc = (lane >> 3) + 8 * i; v[i] = *(const GAS u32x4*)(src + ((size_t)(b * 384 + cb * 64 + cc)) * L + tb * 64 + 8 * (lane & 7)); }
#pragma unroll
        for (int i = 0; i < 8; ++i) { const int cc = (lane >> 3) + 8 * i; *(LAS u32x4*)(scr + cc * 136 + 16 * (lane & 7)) = v[i]; }
        asm volatile("s_waitcnt lgkmcnt(0)" ::: "memory");
#pragma unroll
        for (int i = 0; i < 8; ++i) {
            const int tt = (lane >> 3) + 8 * i, c8 = 8 * (lane & 7);
            unsigned short e[8];
#pragma unroll
            for (int j = 0; j < 8; ++j) e[j] = *(const LAS unsigned short*)(scr + (c8 + j) * 136 + tt * 2);
            u32x4 o; o.x = e[0] | ((unsigned)e[1] << 16); o.y = e[2] | ((unsigned)e[3] << 16); o.z = e[4] | ((unsigned)e[5] << 16); o.w = e[6] | ((unsigned)e[7] << 16);
            *(GAS u32x4*)((dummy ? WSP(bf16, WS_U + 300 * MiB) : Y) + (size_t)(dummy ? ((rowbase + tb * 64 + tt) & 8191) : (rowbase + tb * 64 + tt)) * D + cb * 64 + c8) = o;
        }
        asm volatile("s_waitcnt lgkmcnt(0)" ::: "memory");
    }
}

__device__ __forceinline__ void phase_norm_router(Frame& F) {
    const int gw = F.wg * NWAVES + F.wave, NGW = F.G * NWAVES, lane = F.lane;
    const GAS float* g = inp(F, I_GFFN) + 1 * D; const GAS float* wr = inp(F, I_ROUTER); const GAS float* br = inp(F, I_ROUTERB);
    GAS unsigned* cnt = WSP(unsigned, WS_CTL) + CW_CNT;
#pragma unroll 2
    for (int row = gw; row < TOKL; row += NGW) {
        float keep[16];
        norm_mod_row(xrow_ptr(F, row, false), g, mod_ptr(F, 1, row, 3), mod_ptr(F, 1, row, 4), WSP(bf16, WS_H) + (size_t)row * D, lane, keep);
        float lg[8];
#pragma unroll
        for (int e = 0; e < 8; ++e) lg[e] = 0.f;
#pragma unroll
        for (int j = 0; j < 4; ++j)
#pragma unroll
            for (int i = 0; i < 4; ++i) { const int k = 256 * j + 4 * lane + i; const f32x4 w0 = *(const GAS f32x4*)(wr + k * 8), w1 = *(const GAS f32x4*)(wr + k * 8 + 4); const float x = keep[4 * j + i];
                lg[0] += x * w0.x; lg[1] += x * w0.y; lg[2] += x * w0.z; lg[3] += x * w0.w; lg[4] += x * w1.x; lg[5] += x * w1.y; lg[6] += x * w1.z; lg[7] += x * w1.w; }
#pragma unroll
        for (int e = 0; e < 8; ++e) lg[e] = wave_sum(lg[e]) + br[e];
        int e0 = 0; float v0 = lg[0];
#pragma unroll
        for (int e = 1; e < 8; ++e) if (lg[e] > v0) { v0 = lg[e]; e0 = e; }
        int e1 = -1; float v1 = -3.0e38f;
#pragma unroll
        for (int e = 0; e < 8; ++e) if (e != e0 && lg[e] > v1) { v1 = lg[e]; e1 = e; }
        const float w1 = 1.f / (1.f + __expf(v0 - v1)), w0 = 1.f - w1;
        if (lane == 0) {
            const unsigned p0 = __hip_atomic_fetch_add(cnt + e0, 1u, __ATOMIC_RELAXED, __HIP_MEMORY_SCOPE_AGENT), p1 = __hip_atomic_fetch_add(cnt + e1, 1u, __ATOMIC_RELAXED, __HIP_MEMORY_SCOPE_AGENT);
            WSP(int, WS_TOPE)[row * 2] = e0; WSP(int, WS_TOPE)[row * 2 + 1] = e1;
            WSP(float, WS_TOPW)[row * 2] = w0; WSP(float, WS_TOPW)[row * 2 + 1] = w1;
            WSP(int, WS_TOPP)[row * 2] = (int)p0; WSP(int, WS_TOPP)[row * 2 + 1] = (int)p1;
        }
    }
}
__device__ __forceinline__ void phase_route_tables(Frame& F) {
    const GAS unsigned* cnt = WSP(const unsigned, WS_CTL) + CW_CNT;
    int off[9]; off[0] = 0;
#pragma unroll
    for (int e = 0; e < 8; ++e) { const int c = (int)__hip_atomic_load(cnt + e, __ATOMIC_RELAXED, __HIP_MEMORY_SCOPE_AGENT); off[e + 1] = off[e] + ((c + 255) >> 8) * 256; }
    const int gt = F.wg * NTHR + F.tid, NGT = F.G * NTHR;
    GAS int* rowidx = WSP(int, WS_ROWIDX); GAS int* slot = WSP(int, WS_SLOT); GAS int* tilee = WSP(int, WS_TILEE);
    for (int i = gt; i < MAXTILES * 256; i += NGT) {
        int e = 0;
#pragma unroll
        for (int q = 1; q < 8; ++q) if (i >= off[q]) e = q;
        const int c = (int)cnt[e];
        if (i >= off[8] || i - off[e] >= c) rowidx[i] = 0;
    }
    for (int i = gt; i < TOKL * 2; i += NGT) {
        const int e = WSP(const int, WS_TOPE)[i], pos = WSP(const int, WS_TOPP)[i];
        int o = 0;
#pragma unroll
        for (int q = 0; q < 8; ++q) if (e == q) o = off[q];
        const int s = o + pos; slot[i] = s; rowidx[s] = i >> 1;
    }
    for (int i = gt; i < MAXTILES + 1; i += NGT) {
        if (i == MAXTILES) tilee[MAXTILES] = off[8] >> 8;
        else { int e = 0;
#pragma unroll
            for (int q = 1; q < 8; ++q) if (i * 256 >= off[q]) e = q;
            tilee[i] = e; }
    }
}

__device__ __forceinline__ void moe_pass_gemm1_fast(Frame& F, int t0, int t1) {
    pg8::OrderMoe S; S.o.init(t1 - t0, NFF1 / 256, F.G, F.wg); S.rowidx = WSP(const int, WS_ROWIDX); S.tilee = WSP(const int, WS_TILEE); S.t0 = t0; S.bstride = (size_t)NFF1 * D; S.gather = true;
    EpiSwiglu E{WSP(bf16, WS_MACT), 0};
    pg8::gemm_phase(F.lds, F.tid, WSP(const bf16, WS_H), D, WSP(const bf16, WS_MW13), D, D, S, E);
}
__device__ __forceinline__ void moe_pass_gemm2_fast(Frame& F, int t0, int t1) {
    pg8::OrderMoe S; S.o.init(t1 - t0, D / 256, F.G, F.wg); S.rowidx = WSP(const int, WS_ROWIDX); S.tilee = WSP(const int, WS_TILEE); S.t0 = t0; S.bstride = (size_t)D * DFF; S.gather = false;
    EpiBf16Out E{WSP(bf16, WS_EOUT), D, t0 * 256};
    pg8::gemm_phase(F.lds, F.tid, WSP(const bf16, WS_MACT), DFF, WSP(const bf16, WS_MW2), DFF, DFF, S, E);
}
__device__ __forceinline__ void phase_final(Frame& F, GAS float* dummy = nullptr) {
    const int gw = F.wg * NWAVES + F.wave, NGW = F.G * NWAVES, lane = F.lane;
    const GAS float* gf = inp(F, I_GFINAL); const GAS bf16* eo = WSP(const bf16, WS_EOUT);
#pragma unroll 2
    for (int row = gw; row < TOKL; row += NGW) {
        const int s0 = WSP(const int, WS_SLOT)[row * 2], s1 = WSP(const int, WS_SLOT)[row * 2 + 1];
        const float w0 = WSP(const float, WS_TOPW)[row * 2], w1 = WSP(const float, WS_TOPW)[row * 2 + 1];
        const GAS float* m5 = mod_ptr(F, 1, row, 5);
        GAS float* xr = outp(F) + (size_t)row * D;
        f32x4 v[4]; float s = 0.f;
#pragma unroll
        for (int j = 0; j < 4; ++j) {
            const int c = 256 * j + 4 * lane;
            const f32x4 a = ld_bf16x4(eo + (size_t)s0 * D + c), b = ld_bf16x4(eo + (size_t)s1 * D + c), m = *(const GAS f32x4*)(m5 + c);
            v[j] = *(const GAS f32x4*)(xr + c) + m * (a * w0 + b * w1);
            s += (v[j].x * v[j].x + v[j].y * v[j].y) + (v[j].z * v[j].z + v[j].w * v[j].w);
        }
        const float r = rsqrtf(wave_sum(s) * (1.f / 1024.f) + 1e-6f);
#pragma unroll
        for (int j = 0; j < 4; ++j) { const int c = 256 * j + 4 * lane; const f32x4 g = *(const GAS f32x4*)(gf + c); GAS float* o_ = dummy ? dummy + (size_t)(row & 8191) * D : xr; *(GAS f32x4*)(o_ + c) = v[j] * r * g; }
    }
}

#ifndef REP_WIN
#define REP_WIN 1
#endif
#ifndef REP_MIX
#define REP_MIX 1
#endif
#ifndef REP_GATE
#define REP_GATE 1
#endif
#ifndef REP_UP
#define REP_UP 1
#endif
#ifndef REP_FFN1
#define REP_FFN1 1
#endif
#ifndef REP_MOE
#define REP_MOE 1
#endif
#ifndef REP_NORM
#define REP_NORM 1
#endif
#ifndef REP_P0
#define REP_P0 1
#endif
__global__ void __launch_bounds__(NTHR, 2) hybrid_fwd(Params prm) {
    extern __shared__ __attribute__((aligned(16))) unsigned char lds_raw[];
    Frame F;
    F.lds = (LAS unsigned char*)lds_raw; F.ws = (GAS unsigned char*)prm.ws;
    F.tid = threadIdx.x; F.lane = F.tid & 63; F.wave = __builtin_amdgcn_readfirstlane(F.tid >> 6); F.G = gridDim.x; F.wg = blockIdx.x;
    volatile LAS unsigned* MISC = (volatile LAS unsigned*)(F.lds + MISC_OFF);
    if (F.tid < 64) MISC[F.tid] = 0u;
    if (F.tid < 33) { const unsigned long long v = F.tid < 32 ? (unsigned long long)prm.in[F.tid] : (unsigned long long)prm.out; *(LAS unsigned long long*)(F.lds + PTAB_OFF + 8 * F.tid) = v; }
    __syncthreads();
    XcdBarrier bar = xcd_barrier_post(WSP(unsigned, WS_CTL) + CW_BAR, MISC + 8);
#define RELAUNDER() do { { unsigned long long _w = (unsigned long long)F.ws; asm volatile("" : "+s"(_w)); F.ws = (GAS unsigned char*)_w; } \
        { unsigned _t = (unsigned)F.tid; asm volatile("" : "+v"(_t)); F.tid = (int)_t; F.lane = F.tid & 63; F.wave = __builtin_amdgcn_readfirstlane(F.tid >> 6); } \
        { unsigned _g = (unsigned)F.G, _b = (unsigned)F.wg; asm volatile("" : "+s"(_g), "+s"(_b)); F.G = (int)_g; F.wg = (int)_b; } \
        { unsigned _l = (unsigned)(size_t)F.lds; asm volatile("" : "+s"(_l)); F.lds = (LAS unsigned char*)(size_t)_l; } } while (0)
#define GRID_BAR() do { { unsigned long long _b = (unsigned long long)bar.bar; unsigned _x = bar.x; asm volatile("" : "+s"(_b), "+s"(_x)); bar.bar = (GAS unsigned*)_b; bar.x = _x; } xcd_barrier(bar); RELAUNDER(); } while (0)

    for (int rp = 0; rp < REP_P0; ++rp) { phase_p0(F); write_bias(F);
    GRID_BAR(); }
#pragma unroll 1
    for (int layer_ = 0; layer_ < 2; ++layer_) {
        int layer = layer_;
#define last (layer == 1)
#define rows_all TOK
#define rows_out (last ? TOKL : TOK)
#define modbase (WSP(const float, WS_MOD) + (size_t)layer * 17 * 6144)
#define LAYER_LAUNDER() asm volatile("" : "+s"(layer))
        for (int rp = 0; rp < REP_NORM; ++rp) { phase_norm(F, layer, rows_all, !last, 0);
        if (layer == 0) { const int gw = F.wg * NWAVES + F.wave, NGW = F.G * NWAVES;
            for (int it = gw; it < 1536 + 96; it += NGW) filter_out_item(F, it); }
        { GRID_BAR(); LAYER_LAUNDER(); } }
        for (int rp = 0; rp < REP_WIN; ++rp) {
        { EpiWin E{WSP(const float, WS_BIAS) + layer * NWP, WSP(bf16, WS_HYTL), WSP(bf16, WS_HYTC), WSP(bf16, WS_RET), WSP(bf16, WS_ML), WSP(float, WS_MLG)};
          gemm_fast(F, WSP(const bf16, WS_H), D, WSP(const bf16, WS_WIN), D, D, rows_all, NW1, E); }
        { GRID_BAR(); LAYER_LAUNDER(); } }
        for (int rp = 0; rp < REP_MIX; ++rp) { phase_mix(F, layer);
        { GRID_BAR(); LAYER_LAUNDER(); } }
#ifndef REP_COMB
#define REP_COMB 1
#endif
        for (int rp = REP_COMB - 1; rp > 0; --rp) { phase_combine(F, layer, true); { GRID_BAR(); LAYER_LAUNDER(); } }
        phase_combine(F, layer);
        { GRID_BAR(); LAYER_LAUNDER(); }
        for (int rp = 0; rp < REP_GATE; ++rp) {
        { EpiGate E{WSP(const float, WS_BIAS) + layer * NWP + NW1, WSP(bf16, WS_GATES)};
          gemm_fast(F, WSP(const bf16, WS_H), D, WSP(const bf16, WS_WIN) + (size_t)NW1 * D, D, D, rows_out, NGATE, E); }
        { GRID_BAR(); LAYER_LAUNDER(); } }
        for (int rp = 0; rp < REP_UP; ++rp) {
        { EpiUp E{WSP(const bf16, WS_GATES), WSP(bf16, WS_H)};
          gemm_fast(F, WSP(const bf16, WS_Y), D, WSP(const bf16, WS_WUP), D, D, rows_out, D, E); }
        { GRID_BAR(); LAYER_LAUNDER(); } }
#ifndef REP_OUT
#define REP_OUT 1
#endif
        for (int rp = REP_OUT - 1; rp >= 0; --rp) {
        { EpiResid E{last ? outp(F) : inp(F, I_X), last ? WSP(const float, WS_XC) : inp(F, I_CTX), outp(F), WSP(float, WS_XC), modbase, 2, rp ? WSP(float, WS_U + 300 * MiB) : (GAS float*)nullptr};
          gemm_fast(F, WSP(const bf16, WS_H), D, WSP(const bf16, WS_WOUT), D, D, rows_out, D, E); }
        if (rp) { GRID_BAR(); LAYER_LAUNDER(); } }
        { GRID_BAR(); LAYER_LAUNDER(); }
        if (!last) {
            phase_norm(F, layer, rows_out, false, 3);
            { const int gw = F.wg * NWAVES + F.wave, NGW = F.G * NWAVES; LAS float* scr = (LAS float*)(F.lds + F.wave * 8704);
              conv_weights_ffn(inp(F, I_FW1), inp(F, I_FW3), inp(F, I_FW2), WSP(bf16, WS_W13), WSP(bf16, WS_W2), gw, NGW, scr, F.lane);
              conv_weights_win(F, 1, gw, NGW, scr);
              conv_weights_upout(F, 1, gw, NGW, scr); }
            { GRID_BAR(); LAYER_LAUNDER(); }
            for (int rp = 0; rp < REP_FFN1; ++rp) {
            { EpiSwiglu E{WSP(bf16, WS_ACT), 0};
              gemm_fast(F, WSP(const bf16, WS_H), D, WSP(const bf16, WS_W13), D, D, rows_out, NFF1, E); }
            { GRID_BAR(); LAYER_LAUNDER(); } }
#ifndef REP_FFN2
#define REP_FFN2 1
#endif
            for (int rp = REP_FFN2 - 1; rp >= 0; --rp) {
            { EpiResid E{outp(F), WSP(const float, WS_XC), outp(F), WSP(float, WS_XC), modbase, 5, rp ? WSP(float, WS_U + 300 * MiB) : (GAS float*)nullptr};
              gemm_fast(F, WSP(const bf16, WS_ACT), DFF, WSP(const bf16, WS_W2), DFF, DFF, rows_out, D, E); }
            if (rp) { GRID_BAR(); LAYER_LAUNDER(); } }
            { GRID_BAR(); LAYER_LAUNDER(); }
        }
    }
#undef LAYER_LAUNDER
#undef last
#undef rows_all
#undef rows_out
#undef modbase
    phase_norm_router(F);
    { const int gw = F.wg * NWAVES + F.wave, NGW = F.G * NWAVES; LAS float* scr = (LAS float*)(F.lds + F.wave * 8704);
#ifndef REP_MCONV
#define REP_MCONV 1
#endif
#pragma unroll 1
      for (int e = 0; e < NE * REP_MCONV; ++e)
          conv_weights_ffn(inp(F, I_MW1) + (size_t)(e % NE) * D * DFF, inp(F, I_MW3) + (size_t)(e % NE) * D * DFF, inp(F, I_MW2) + (size_t)(e % NE) * DFF * D,
                           WSP(bf16, WS_MW13) + (size_t)(e % NE) * NFF1 * D, WSP(bf16, WS_MW2) + (size_t)(e % NE) * D * DFF, gw, NGW, scr, F.lane); }
    GRID_BAR();
    phase_route_tables(F);
    GRID_BAR();
    const int ntiles = __builtin_amdgcn_readfirstlane(WSP(const int, WS_TILEE)[MAXTILES]);
#pragma unroll 1
    for (int p = 0; p < NPASS; ++p) {
        const int t0 = p * PASS_TILES, t1 = min(ntiles, t0 + PASS_TILES);
        for (int rp = 0; rp < REP_MOE; ++rp) {
        if (t0 < t1) moe_pass_gemm1_fast(F, t0, t1);
        GRID_BAR();
        if (t0 < t1) moe_pass_gemm2_fast(F, t0, t1);
        GRID_BAR(); }
    }
#ifndef REP_BAR
#define REP_BAR 0
#endif
    for (int rb = 0; rb < REP_BAR; ++rb) GRID_BAR();
#ifndef REP_FINAL
#define REP_FINAL 1
#endif
    for (int rp = REP_FINAL - 1; rp > 0; --rp) { phase_final(F, WSP(float, WS_U + 300 * MiB)); GRID_BAR(); }
    phase_final(F);
}

extern "C" void kernel_launch(void* const* d_in, const int* in_sizes, int n_in, void* d_out, int out_size, void* d_ws, size_t ws_size, hipStream_t stream) {
    static int grid = 0;
    if (grid == 0) {
        if (n_in != 32 || out_size != TOKL * D || ws_size < WS_END) { fprintf(stderr, "kernel_launch: unexpected arguments (n_in %d, out %d, ws %zu)\n", n_in, out_size, ws_size); grid = -1; return; }
        int dev = 0, cus = 0;
        if (hipGetDevice(&dev) != hipSuccess || hipDeviceGetAttribute(&cus, hipDeviceAttributeMultiprocessorCount, dev) != hipSuccess) { grid = -1; return; }
        if (hipFuncSetAttribute((const void*)hybrid_fwd, hipFuncAttributeMaxDynamicSharedMemorySize, LDS_BYTES) != hipSuccess) { grid = -1; return; }
        int per_cu = 0;
        (void)hipOccupancyMaxActiveBlocksPerMultiprocessor(&per_cu, (const void*)hybrid_fwd, NTHR, LDS_BYTES);
        (void)hipGetLastError();
        grid = cus;
    }
    if (grid < 0) return;
    (void)hipMemsetAsync((char*)d_ws + WS_CTL, 0, CTL_ZERO_BYTES, stream);
    Params p{};
    for (int i = 0; i < 32; ++i) p.in[i] = (const float*)d_in[i];
    p.out = (float*)d_out; p.ws = (unsigned char*)d_ws;
    hipLaunchKernelGGL(hybrid_fwd, dim3(grid), dim3(NTHR), LDS_BYTES, stream, p);
}
```

```cpp
#include <hip/hip_runtime.h>
#include <stdint.h>
#include <stdio.h>

#define LAS __attribute__((address_space(3)))
#define GAS __attribute__((address_space(1)))
typedef unsigned short bf16;
typedef short bf16x8 __attribute__((ext_vector_type(8)));
typedef float f32x4 __attribute__((ext_vector_type(4)));
typedef unsigned u32x4 __attribute__((ext_vector_type(4)));
typedef unsigned u32x2 __attribute__((ext_vector_type(2)));

constexpr int D = 1024, NB = 16, LL = 2048, LC = 256;
constexpr int TOKL = NB * LL, TOKC = NB * LC, TOK = TOKL + TOKC;
constexpr int HYW = 384, RETW = 384, MLW = 256;
constexpr int NIN = 6800, NW1 = 3840, NGATE = 3072, NWP = 6912;
constexpr int DFF = 2816, NFF1 = 5632, NE = 8;
constexpr int NWAVES = 8, NTHR = 512;
constexpr int MAXTILES = 272, PASS_TILES = 58, NPASS = 5;

constexpr size_t MiB = 1u << 20;
constexpr size_t WS_CTL = 0, CTL_ZERO_BYTES = 1 * MiB;
constexpr size_t WS_MOD = 1 * MiB;
constexpr size_t WS_BIAS = 2 * MiB;
constexpr size_t WS_ROPE = 2 * MiB + 256 * 1024;
constexpr size_t WS_TOPE = 3 * MiB;
constexpr size_t WS_TOPW = 3 * MiB + 256 * 1024;
constexpr size_t WS_TOPP = 3 * MiB + 512 * 1024;
constexpr size_t WS_SLOT = 3 * MiB + 768 * 1024;
constexpr size_t WS_ROWIDX = 4 * MiB;
constexpr size_t WS_TILEE = 4 * MiB + 512 * 1024;
constexpr size_t WS_FTL = 5 * MiB;
constexpr size_t WS_FTC = 17 * MiB;
constexpr size_t WS_WIN = 18 * MiB;
constexpr size_t WS_WUP = 32 * MiB;
constexpr size_t WS_WOUT = 34 * MiB;
constexpr size_t WS_XC = 36 * MiB;
constexpr size_t WS_H = 52 * MiB;
constexpr size_t WS_Y = 124 * MiB;
constexpr size_t WS_U = 196 * MiB;
constexpr size_t WS_RET = WS_U;
constexpr size_t WS_ML = WS_U + 108 * MiB;
constexpr size_t WS_MLG = WS_U + 180 * MiB;
constexpr size_t WS_OB = WS_U + 183 * MiB;
constexpr size_t WS_YHTL = WS_U + 228 * MiB;
constexpr size_t WS_YHTC = WS_U + 252 * MiB;
constexpr size_t WS_HYTL = WS_U + 255 * MiB;
constexpr size_t WS_HYTC = WS_U + 327 * MiB;
constexpr size_t WS_END = WS_U + 336 * MiB;
constexpr size_t WS_GATES = WS_U;
constexpr size_t WS_ACT = WS_U;
constexpr size_t WS_W13 = WS_U + 204 * MiB;
constexpr size_t WS_W2 = WS_U + 216 * MiB;
constexpr size_t WS_MW13 = WS_Y;
constexpr size_t WS_MW2 = WS_Y + 88 * MiB;
constexpr size_t WS_MACT = WS_Y + 132 * MiB;
constexpr size_t WS_EOUT = WS_Y + 220 * MiB;
static_assert(WS_EOUT + (size_t)MAXTILES * 256 * 1024 * 2 <= WS_END, "map");
static_assert(WS_GATES + (size_t)TOK * NGATE * 2 <= WS_YHTL, "gates overlay");

constexpr int CW_BAR = 4096;
constexpr int CW_CNT = 16384;

constexpr int LDS_BYTES = 147456;
constexpr int MISC_OFF = 147456 - 256;

__device__ __forceinline__ float bf2f(bf16 b) { return __uint_as_float(((unsigned)b) << 16); }
typedef __bf16 bf2v_ __attribute__((ext_vector_type(2)));
typedef float f2v_ __attribute__((ext_vector_type(2)));
__device__ __forceinline__ unsigned pk2(float lo, float hi) { const f2v_ f = {lo, hi}; return __builtin_bit_cast(unsigned, __builtin_convertvector(f, bf2v_)); }
__device__ __forceinline__ unsigned f2bf(float f) { return pk2(f, 0.f) & 0xffffu; }
__device__ __forceinline__ float dpp_f(float v, int) { return v; }
#define DPP_ADD(v, ctrl) (v) += __int_as_float(__builtin_amdgcn_update_dpp(0, __float_as_int(v), (ctrl), 0xf, 0xf, true))
__device__ __forceinline__ float wave_sum(float v) {
    DPP_ADD(v, 0xB1);
    DPP_ADD(v, 0x4E);
    DPP_ADD(v, 0x141);
    DPP_ADD(v, 0x140);
    return __int_as_float(__builtin_amdgcn_readlane(__float_as_int(v), 0)) + __int_as_float(__builtin_amdgcn_readlane(__float_as_int(v), 16))
         + __int_as_float(__builtin_amdgcn_readlane(__float_as_int(v), 32)) + __int_as_float(__builtin_amdgcn_readlane(__float_as_int(v), 48));
}
__device__ __forceinline__ float lane_read(float v, int src_lane) { return __int_as_float(__builtin_amdgcn_ds_bpermute(src_lane << 2, __float_as_int(v))); }
__device__ __forceinline__ float sigmoidf_(float x) { return __builtin_amdgcn_rcpf(1.0f + __expf(-x)); }
__device__ __forceinline__ float siluf_(float x) { return x * __builtin_amdgcn_rcpf(1.0f + __expf(-x)); }

#define XB_TMO      128
#define XB_XCNT(j)  (256  + 64 * (j))
#define XB_XSUB(j)  (1280 + 64 * (j))
#define XB_XGEN(j)  (2304 + 64 * (j))
#define XB_TOP      3328
#define XB_TOPGEN   3392
#define XCD_BAR_WORDS 3456
#define XB_SPIN_CAP (1u << 22)
__device__ __forceinline__ unsigned xb_ld(GAS unsigned* p)              { return __hip_atomic_load(p, __ATOMIC_RELAXED, __HIP_MEMORY_SCOPE_AGENT); }
__device__ __forceinline__ unsigned xb_add(GAS unsigned* p, unsigned v) { return __hip_atomic_fetch_add(p, v, __ATOMIC_RELAXED, __HIP_MEMORY_SCOPE_AGENT); }
__device__ __forceinline__ unsigned xb_xcc_id() { return (unsigned)__builtin_amdgcn_s_getreg((3 << 11) | 20) & 0xFu; }
#define XB_SPIN(cond, bar) do { unsigned _sp = 0; while (cond) { __builtin_amdgcn_s_sleep(1); \
    if ((++_sp & 255u) == 0u) { if (xb_ld(&(bar)[XB_TMO])) break; if (_sp > XB_SPIN_CAP) { (void)__hip_atomic_fetch_add(&(bar)[XB_TMO], 1u, __ATOMIC_RELAXED, __HIP_MEMORY_SCOPE_AGENT); break; } } } } while (0)
struct XcdBarrier { GAS unsigned* bar; unsigned x; volatile LAS unsigned* st; };
__device__ __forceinline__ XcdBarrier xcd_barrier_post(GAS unsigned* bar, volatile LAS unsigned* st) {
    XcdBarrier b; b.bar = bar; b.x = xb_xcc_id(); b.st = st;
    if (threadIdx.x == 0) (void)xb_add(&bar[XB_XCNT(b.x)], 1u);
    return b;
}
__device__ __forceinline__ void xcd_barrier_complete(GAS unsigned* bar, unsigned x, unsigned& nloc, unsigned& nx) {
    const unsigned G = gridDim.x * gridDim.y * gridDim.z;
    unsigned sum, cnt, mine, sp = 0u;
    for (;;) {
        sum = 0u; cnt = 0u; mine = 0u;
#pragma unroll 1
        for (unsigned j = 0; j < 16; ++j) { const unsigned c = xb_ld(&bar[XB_XCNT(j)]); sum += c; cnt += (c > 0u) ? 1u : 0u; }
        mine = xb_ld(&bar[XB_XCNT(x)]);
        if (sum == G) break;
        __builtin_amdgcn_s_sleep(1);
        if ((++sp & 255u) == 0u) { if (xb_ld(&bar[XB_TMO])) break; if (sp > XB_SPIN_CAP) { (void)__hip_atomic_fetch_add(&bar[XB_TMO], 1u, __ATOMIC_RELAXED, __HIP_MEMORY_SCOPE_AGENT); break; } }
    }
    nloc = mine > 0u ? mine : 1u; nx = cnt > 0u ? cnt : 1u;
}
__device__ __forceinline__ void xcd_barrier(const XcdBarrier& b) {
    asm volatile("s_waitcnt vmcnt(0)" ::: "memory");
    __syncthreads();
    if (threadIdx.x == 0) {
        GAS unsigned* bar = b.bar;
        __builtin_amdgcn_s_waitcnt(0);
        unsigned nloc = b.st[0], nx = b.st[1];
        if (nloc == 0u) { xcd_barrier_complete(bar, b.x, nloc, nx); b.st[0] = nloc; b.st[1] = nx; }
        const unsigned old = xb_add(&bar[XB_XSUB(b.x)], 1u);
        const unsigned gen = old / nloc;
        if (old + 1u == (gen + 1u) * nloc) {
            __builtin_amdgcn_fence(__ATOMIC_RELEASE, "agent");
            asm volatile("s_waitcnt vmcnt(0)" ::: "memory");
            const unsigned og = xb_add(&bar[XB_TOP], 1u);
            const unsigned tg = og / nx;
            if (og + 1u == (tg + 1u) * nx) xb_add(&bar[XB_TOPGEN], 1u);
            else XB_SPIN(xb_ld(&bar[XB_TOPGEN]) == tg, bar);
            __builtin_amdgcn_fence(__ATOMIC_ACQUIRE, "agent");
            xb_add(&bar[XB_XGEN(b.x)], 1u);
            asm volatile("s_waitcnt vmcnt(0)" ::: "memory");
        } else {
            XB_SPIN(xb_ld(&bar[XB_XGEN(b.x)]) == gen, bar);
            __builtin_amdgcn_fence(__ATOMIC_ACQUIRE, "agent");
            asm volatile("s_waitcnt vmcnt(0)" ::: "memory");
        }
    }
    __syncthreads();
}

struct Params { const float* in[32]; float* out; unsigned char* ws; };
enum { I_X = 0, I_C, I_CTX, I_CCTX, I_WMOD, I_BMOD, I_GMIX, I_GFFN, I_WIN, I_BIN, I_HYCONV, I_HYF1, I_HYFB1, I_HYF2, I_HYFB2, I_HYF3, I_HYDECAY,
       I_HYSKIP, I_RETDECAY, I_MLCONV, I_MLGB, I_WUP, I_WOUT, I_FW1, I_FW3, I_FW2, I_ROUTER, I_ROUTERB, I_MW1, I_MW3, I_MW2, I_GFINAL };

struct Frame {
    LAS unsigned char* lds;
    GAS unsigned char* ws;
    int tid, lane, wave, G, wg;
};
#define WSP(T, off) ((GAS T*)(F.ws + (off)))
constexpr int PTAB_OFF = 147456 - 1024;
__device__ __forceinline__ const GAS float* inp(const Frame& F, int i) {
    const LAS unsigned* t = (const LAS unsigned*)(F.lds + PTAB_OFF) + 2 * i;
    const unsigned lo = __builtin_amdgcn_readfirstlane(t[0]), hi = __builtin_amdgcn_readfirstlane(t[1]);
    return (const GAS float*)(((unsigned long long)hi << 32) | lo);
}
__device__ __forceinline__ GAS float* outp(const Frame& F) { return (GAS float*)inp(F, 32); }

__device__ __forceinline__ int row_batch(int row) { return row < TOKL ? (row >> 11) : ((row - TOKL) >> 8); }
__device__ __forceinline__ const GAS float* mod_ptr(const Frame& F, int layer, int row, int which) {
    const int r = row < TOKL ? (row >> 11) : 16;
    return WSP(const float, WS_MOD) + ((size_t)(layer * 17 + r) * 6 + which) * 1024;
}

template <class RowMap>
__device__ __forceinline__ void tr_item(const GAS float* W, int K, int N, GAS bf16* WT, int ldT, RowMap rm, LAS float* scr, int item, int lane) {
    const int nblk = (N + 31) / 32, kb = item / nblk, nb = item % nblk, k0 = 64 * kb, n0 = 32 * nb;
    { float tv[32];
#pragma unroll
      for (int i = 0; i < 32; ++i) { const int kk = 2 * i + (lane >> 5); const int n = n0 + (lane & 31); tv[i] = (n < N) ? W[(size_t)(k0 + kk) * N + n] : 0.f; }
#pragma unroll
      for (int i = 0; i < 32; ++i) { const int kk = 2 * i + (lane >> 5); scr[kk * 33 + (lane & 31)] = tv[i]; } }
    asm volatile("s_waitcnt lgkmcnt(0)" ::: "memory");
    const int c = lane & 7;
#pragma unroll
    for (int j = 0; j < 4; ++j) { const int nl = (lane >> 3) + 8 * j; const int n = n0 + nl; const LAS float* s = scr + (8 * c) * 33 + nl;
        u32x4 o; o.x = pk2(s[0 * 33], s[1 * 33]); o.y = pk2(s[2 * 33], s[3 * 33]); o.z = pk2(s[4 * 33], s[5 * 33]); o.w = pk2(s[6 * 33], s[7 * 33]);
        if (n < N) *(GAS u32x4*)(WT + (size_t)rm(n) * ldT + k0 + 8 * c) = o; }
    asm volatile("s_waitcnt lgkmcnt(0)" ::: "memory");
}
struct RmId { __device__ __forceinline__ int operator()(int n) const { return n; } };
__device__ __forceinline__ int win_row(int n) {
    if (n < 1152) return n;
    if (n < 2688) return 1280 + (n - 1152);
    if (n < 3712) return 2816 + (n - 2688);
    if (n < 3728) return 1152 + (n - 3712);
    return 3840 + (n - 3728);
}
struct RmWin { __device__ __forceinline__ int operator()(int n) const { return win_row(n); } };
struct RmW1 { __device__ __forceinline__ int operator()(int n) const { return (n >> 4) * 32 + (n & 15); } };
struct RmW3 { __device__ __forceinline__ int operator()(int n) const { return (n >> 4) * 32 + 16 + (n & 15); } };

__device__ __forceinline__ void conv_weights_win(Frame& F, int layer, int gw, int NGW, LAS float* scr) {
    const GAS float* W = inp(F, I_WIN) + (size_t)layer * D * NIN;
    const int items = (D / 64) * ((NIN + 31) / 32);
    for (int it = gw; it < items; it += NGW) tr_item(W, D, NIN, WSP(bf16, WS_WIN), D, RmWin(), scr, it, F.lane);
    GAS bf16* wt = WSP(bf16, WS_WIN);
    unsigned zz; asm volatile("v_mov_b32 %0, 0" : "=v"(zz));
    for (int i = gw * 64 + F.lane; i < 112 * 1024 / 8; i += NGW * 64) *(GAS u32x4*)(wt + (size_t)1168 * 1024 + (size_t)i * 8) = (u32x4){zz, zz, zz, zz};
}
__device__ __forceinline__ void conv_weights_upout(Frame& F, int layer, int gw, int NGW, LAS float* scr) {
    const int items = (D / 64) * (D / 32);
    for (int it = gw; it < items; it += NGW) tr_item(inp(F, I_WUP) + (size_t)layer * D * D, D, D, WSP(bf16, WS_WUP), D, RmId(), scr, it, F.lane);
    for (int it = gw; it < items; it += NGW) tr_item(inp(F, I_WOUT) + (size_t)layer * D * D, D, D, WSP(bf16, WS_WOUT), D, RmId(), scr, it, F.lane);
}
__device__ __forceinline__ void conv_weights_ffn(const GAS float* w1, const GAS float* w3, const GAS float* w2, GAS bf16* w13t, GAS bf16* w2t, int gw, int NGW, LAS float* scr, int lane) {
    const int i1 = (D / 64) * (DFF / 32), i2 = (DFF / 64) * (D / 32);
    for (int it = gw; it < i1; it += NGW) tr_item(w1, D, DFF, w13t, D, RmW1(), scr, it, lane);
    for (int it = gw; it < i1; it += NGW) tr_item(w3, D, DFF, w13t, D, RmW3(), scr, it, lane);
    for (int it = gw; it < i2; it += NGW) tr_item(w2, DFF, D, w2t, DFF, RmId(), scr, it, lane);
}

constexpr size_t WS_HID2 = WS_XC;
__device__ __forceinline__ void filter_hidden_item(Frame& F, int item) {
    const int p0 = item * 8, sel = p0 < 2048 ? 0 : (p0 < 4096 ? 1 : 2), layer = sel == 1 ? 1 : 0, L = sel == 2 ? LC : LL, pbase = sel == 0 ? 0 : (sel == 1 ? 2048 : 4096);
    const GAS float* f1 = inp(F, I_HYF1) + layer * 33 * 64; const GAS float* fb1 = inp(F, I_HYFB1) + layer * 64;
    const GAS float* f2 = inp(F, I_HYF2) + layer * 64 * 64; const GAS float* fb2 = inp(F, I_HYFB2) + layer * 64;
    const int lane = F.lane;
    const float b1 = fb1[lane], b2 = fb2[lane];
    for (int pl = 0; pl < 8; ++pl) {
        const int pos = p0 + pl - pbase;
        const float t = (float)pos / (float)(L - 1);
        const float w = 6.283185307179586f * (float)pos / (float)L;
        float feat = 0.f;
        if (lane == 0) feat = t;
        else if (lane < 17) { const float band = 1e-4f + (float)(lane - 1) * ((15.0f - 1e-4f) / 15.0f); feat = cosf(w * band); }
        else if (lane < 33) { const float band = 1e-4f + (float)(lane - 17) * ((15.0f - 1e-4f) / 15.0f); feat = -sinf(w * band); }
        float a1 = b1;
        for (int i = 0; i < 33; ++i) a1 += __int_as_float(__builtin_amdgcn_readlane(__float_as_int(feat), i)) * f1[i * 64 + lane];
        const float h1 = sinf(a1);
        float a2 = b2;
        for (int i = 0; i < 64; ++i) a2 += __int_as_float(__builtin_amdgcn_readlane(__float_as_int(h1), i)) * f2[i * 64 + lane];
        WSP(float, WS_HID2)[(size_t)(p0 + pl) * 64 + lane] = sinf(a2);
    }
}
__device__ __forceinline__ void filter_out_item(Frame& F, int item) {
    int sel, r;
    if (item < 768) { sel = 0; r = item; } else if (item < 1536) { sel = 1; r = item - 768; } else { sel = 2; r = item - 1536; }
    const int layer = sel == 1 ? 1 : 0, L = sel == 2 ? LC : LL, pb = r / 24, ch = r % 24, pbase = sel == 0 ? 0 : (sel == 1 ? 2048 : 4096);
    GAS bf16* FT = sel == 2 ? WSP(bf16, WS_FTC) : WSP(bf16, WS_FTL) + (size_t)layer * 2 * 384 * 4096;
    const GAS float* f3 = inp(F, I_HYF3) + (size_t)layer * 64 * 1536; const GAS float* dec = inp(F, I_HYDECAY) + layer * 1536;
    const int lane = F.lane, fr = lane & 15, fq = lane >> 4;
    const GAS float* hid = WSP(const float, WS_HID2) + (size_t)(pbase + pb * 64) * 64;
    f32x4 acc[4][4];
#pragma unroll
    for (int mt = 0; mt < 4; ++mt)
#pragma unroll
        for (int nt = 0; nt < 4; ++nt) acc[mt][nt] = (f32x4){0.f, 0.f, 0.f, 0.f};
#pragma unroll 4
    for (int ks = 0; ks < 16; ++ks) {
        float a[4], bb[4];
#pragma unroll
        for (int mt = 0; mt < 4; ++mt) a[mt] = hid[(16 * mt + fr) * 64 + 4 * ks + fq];
#pragma unroll
        for (int nt = 0; nt < 4; ++nt) bb[nt] = f3[(size_t)(4 * ks + fq) * 1536 + ch * 64 + 16 * nt + fr];
#pragma unroll
        for (int mt = 0; mt < 4; ++mt)
#pragma unroll
            for (int nt = 0; nt < 4; ++nt) acc[mt][nt] = __builtin_amdgcn_mfma_f32_16x16x4f32(a[mt], bb[nt], acc[mt][nt], 0, 0, 0);
    }
#pragma unroll
    for (int nt = 0; nt < 4; ++nt) {
        const int nn = ch * 64 + 16 * nt + fr, o = nn / 768, dir = (nn / 384) & 1, c = nn % 384;
        const float adec = fabsf(dec[nn]);
        GAS bf16* dst = FT + (size_t)(o * 384 + c) * (2 * L);
#pragma unroll
        for (int mt = 0; mt < 4; ++mt)
#pragma unroll
            for (int j = 0; j < 4; ++j) {
                const int pos = pb * 64 + 16 * mt + 4 * fq + j;
                const float t = (float)pos / (float)(L - 1);
                const float v = acc[mt][nt][j] * expf(-t * adec);
                if (dir == 0) dst[L - pos] = (bf16)f2bf(v);
                else if (pos > 0) dst[L + pos] = (bf16)f2bf(v);
            }
    }
}

__device__ __forceinline__ void phase_p0(Frame& F) {
    const int gw = F.wg * NWAVES + F.wave, NGW = F.G * NWAVES;
    LAS float* sl = (LAS float*)F.lds;
    LAS float* red = (LAS float*)(F.lds + 17 * 4096);
    for (int i = F.tid; i < 17 * 1024; i += NTHR) { const int r = i >> 10, k = i & 1023; const float v = r < 16 ? inp(F, I_C)[r * 1024 + k] : inp(F, I_CCTX)[k]; sl[i] = siluf_(v); }
    __syncthreads();
    for (int item = F.wg; item < 2 * 384; item += F.G) {
        const int layer = item / 384, n0 = (item % 384) * 16, j = F.tid & 15, kp = F.tid >> 4;
        const GAS float* W = inp(F, I_WMOD) + (size_t)layer * D * 6144;
        float acc[17];
#pragma unroll
        for (int r = 0; r < 17; ++r) acc[r] = 0.f;
        for (int k = kp * 32; k < kp * 32 + 32; ++k) { const float w = W[(size_t)k * 6144 + n0 + j];
#pragma unroll
            for (int r = 0; r < 17; ++r) acc[r] += sl[r * 1024 + k] * w; }
#pragma unroll
        for (int r = 0; r < 17; ++r) red[(kp * 17 + r) * 16 + j] = acc[r];
        __syncthreads();
        if (F.tid < 272) { const int r = F.tid >> 4, jj = F.tid & 15; float s = inp(F, I_BMOD)[layer * 6144 + n0 + jj];
            for (int q = 0; q < 32; ++q) s += red[(q * 17 + r) * 16 + jj];
            WSP(float, WS_MOD)[(size_t)(layer * 17 + r) * 6144 + n0 + jj] = s; }
        __syncthreads();
    }
    __syncthreads();
    LAS float* scr = (LAS float*)(F.lds + F.wave * 8704);
    conv_weights_win(F, 0, gw, NGW, scr);
    conv_weights_upout(F, 0, gw, NGW, scr);
    for (int i = gw * 64 + F.lane; i < 2048 * 32; i += NGW * 64) {
        const int t = i >> 5, j = i & 31, half = j >> 4, ii = j & 15;
        const float inv = 1.0f / powf(10000.0f, (float)ii / 16.0f);
        const float ang = (float)(half == 0 ? (t >> 6) : (t & 63)) * inv;
        WSP(float, WS_ROPE)[t * 64 + half * 32 + ii] = cosf(ang);
        WSP(float, WS_ROPE)[t * 64 + half * 32 + 16 + ii] = sinf(ang);
    }
    for (int it = gw; it < 4352 / 8; it += NGW) filter_hidden_item(F, it);
}
__device__ __forceinline__ void write_bias(Frame& F) {
    const int gt = (F.wg * NWAVES + F.wave) * 64 + F.lane, NGT = F.G * NTHR;
    for (int i = gt; i < 2 * NWP; i += NGT) {
        const int l = i / NWP, r = i % NWP; float v = 0.f;
        int n = -1;
        if (r < 1152) n = r; else if (r < 1168) n = 3712 + (r - 1152); else if (r < 1280) n = -1; else if (r < 2816) n = 1152 + (r - 1280); else if (r < 3840) n = 2688 + (r - 2816); else n = 3728 + (r - 3840);
        if (n >= 0) v = inp(F, I_BIN)[l * NIN + n];
        WSP(float, WS_BIAS)[i] = v;
    }
}

__device__ __forceinline__ void norm_mod_row(const GAS float* xrow, const GAS float* g, const GAS float* shift, const GAS float* scale, GAS bf16* orow, int lane, float* keep  ) {
    f32x4 v[4]; float s = 0.f;
#pragma unroll
    for (int j = 0; j < 4; ++j) { v[j] = *(const GAS f32x4*)(xrow + 256 * j + 4 * lane); s += (v[j].x * v[j].x + v[j].y * v[j].y) + (v[j].z * v[j].z + v[j].w * v[j].w); }
    const float r = rsqrtf(wave_sum(s) * (1.0f / 1024.0f) + 1e-6f);
#pragma unroll
    for (int j = 0; j < 4; ++j) {
        const f32x4 gg = *(const GAS f32x4*)(g + 256 * j + 4 * lane), sh = *(const GAS f32x4*)(shift + 256 * j + 4 * lane), sc = *(const GAS f32x4*)(scale + 256 * j + 4 * lane);
        f32x4 o;
        o.x = (v[j].x * r * gg.x) * (1.f + sc.x) + sh.x; o.y = (v[j].y * r * gg.y) * (1.f + sc.y) + sh.y;
        o.z = (v[j].z * r * gg.z) * (1.f + sc.z) + sh.z; o.w = (v[j].w * r * gg.w) * (1.f + sc.w) + sh.w;
        if (keep) { keep[4 * j + 0] = o.x; keep[4 * j + 1] = o.y; keep[4 * j + 2] = o.z; keep[4 * j + 3] = o.w; }
        u32x2 w; w.x = pk2(o.x, o.y); w.y = pk2(o.z, o.w);
        *(GAS u32x2*)(orow + 256 * j + 4 * lane) = w;
    }
}
__device__ __forceinline__ const GAS float* xrow_ptr(const Frame& F, int row, bool from_input) {
    if (row < TOKL) return (from_input ? inp(F, I_X) : outp(F)) + (size_t)row * D;
    return (from_input ? inp(F, I_CTX) : WSP(const float, WS_XC)) + (size_t)(row - TOKL) * D;
}
__device__ __forceinline__ void phase_norm(Frame& F, int layer, int nrows, bool from_input, int which) {
    const int gw = F.wg * NWAVES + F.wave, NGW = F.G * NWAVES;
    const GAS float* g = inp(F, which == 0 ? I_GMIX : I_GFFN) + layer * D;
#pragma unroll 2
    for (int row = gw; row < nrows; row += NGW)
        norm_mod_row(xrow_ptr(F, row, from_input), g, mod_ptr(F, layer, row, which), mod_ptr(F, layer, row, which + 1), WSP(bf16, WS_H) + (size_t)row * D, F.lane, nullptr);
}

namespace pg8 {
#ifndef WGM_
#define WGM_ 4
#endif
constexpr int BM = 256, BK = 64, HALF = 128, HTB = HALF * BK * 2, STAGE_BYTES = 8 * HTB, NXCD = 8, WGM = WGM_;
__device__ __forceinline__ int lds_byte(int r, int c) { const int st = (r >> 4) * 2 + (c >> 5), rr = r & 15, cc = c & 31, ob = rr * 64 + cc * 2; return st * 1024 + (ob ^ (((ob >> 9) & 1) << 5)); }
__device__ __forceinline__ void stage_rc(int b, int& R, int& C) { const int st = b / 1024, sb = b % 1024, swz = sb ^ (((sb >> 9) & 1) << 5); R = (st >> 1) * 16 + swz / 64; C = (st & 1) * 32 + (swz % 64) / 2; }
struct Unit { int pm, pn; };
struct OrderPlain {
    static constexpr bool GATHER = false;
    int nM, nN, nwg, G, c;
    __device__ __forceinline__ void init(int nM_, int nN_, int G_, int c_) { nM = nM_; nN = nN_; nwg = nM * nN; G = G_; c = c_; }
    __device__ __forceinline__ bool next(int i, Unit& u) const {
        const long L = (long)i * G + c; if (L >= nwg) return false;
        int wgid = (int)L; { const int q = nwg / NXCD, r = nwg % NXCD, xcd = wgid % NXCD, off = wgid / NXCD; wgid = (xcd < r ? xcd * (q + 1) : r * (q + 1) + (xcd - r) * q) + off; }
        const int nig = WGM * nN, gid = wgid / nig, fm = gid * WGM, gsz = (nM - fm) < WGM ? (nM - fm) : WGM;
        u.pm = fm + ((wgid % nig) % gsz); u.pn = (wgid % nig) / gsz; return true;
    }
    __device__ __forceinline__ int arow(int r) const { return r; }
    __device__ __forceinline__ size_t boff(const Unit&) const { return 0; }
};
struct OrderWinL1 {
    static constexpr bool GATHER = false;
    OrderPlain o; int G, c;
    __device__ __forceinline__ void init(int G_, int c_) { o.init(128, 15, G_, c_); G = G_; c = c_; }
    __device__ __forceinline__ bool next(int i, Unit& u) const {
        const long L = (long)i * G + c;
        if (L < 1920) return o.next(i, u);
        const int r = (int)(L - 1920); if (r >= 112) return false;
        const int q = r % 7; u.pm = 128 + r / 7; u.pn = q == 0 ? 4 : (q <= 4 ? 5 + q : 7 + q);
        return true;
    }
    __device__ __forceinline__ int arow(int r) const { return r; }
    __device__ __forceinline__ size_t boff(const Unit&) const { return 0; }
};
struct OrderMoe {
    static constexpr bool GATHER = true;
    OrderPlain o; const GAS int* rowidx; const GAS int* tilee; int t0; size_t bstride; bool gather;
    __device__ __forceinline__ bool next(int i, Unit& u) const { return o.next(i, u); }
    __device__ __forceinline__ int arow(int r) const { return gather ? rowidx[t0 * 256 + r] : r; }
    __device__ __forceinline__ size_t boff(const Unit& u) const { return (size_t)tilee[t0 + u.pm] * bstride; }
};

template <class Epi, class Sched>
__device__ __forceinline__ void gemm_phase(LAS unsigned char* lds, int tid_in, const GAS bf16* A, int lda, const GAS bf16* Bt, int ldb, int K, const Sched& S, const Epi& E) {
    unsigned tid_u = (unsigned)tid_in; asm volatile("" : "+v"(tid_u));
    const int tid = (int)tid_u, wid = __builtin_amdgcn_readfirstlane(tid >> 6), lane = tid & 63, wr = wid >> 2, wc = wid & 3, fr = lane & 15, fq = lane >> 4;
    const int nt = K / BK;
    unsigned voffB[2];
    { int sR[2], sC[2];
#pragma unroll
      for (int i = 0; i < 2; ++i) { stage_rc(tid * 16 + i * 8192, sR[i], sC[i]);
        const int rho = sR[i] & 31, Rb = Epi::PERM ? ((sR[i] & ~31) + 8 * ((rho & 15) >> 2) + 4 * (rho >> 4) + (rho & 3)) : sR[i];
        voffB[i] = (unsigned)(Rb * ldb + sC[i]) * 2u; } }
#define PG8_GATHER_OFFS(pm_) do { unsigned _t = (unsigned)tid; asm volatile("" : "+v"(_t)); _Pragma("unroll") for (int i = 0; i < 2; ++i) { int _R, _C; stage_rc((int)_t * 16 + i * 8192, _R, _C); \
        vc0[i] = (unsigned)((size_t)S.arow((pm_) * BM + _R) * lda + _C) * 2u; vc1[i] = (unsigned)((size_t)S.arow((pm_) * BM + HALF + _R) * lda + _C) * 2u; } } while (0)
    const size_t kstep = (size_t)(BK * 2);
    const size_t hstepB = (size_t)HALF * ldb * 2, tstepB = 2 * hstepB;
    const unsigned ldsw = (unsigned)wid * 1024u;
    const int aoff = lds_byte(wr * 64 + fr, fq * 8), boff = lds_byte(wc * 32 + fr, fq * 8);
#define PG8_SA(b, h) (((b) * 2 + (h)) * HTB)
#define PG8_SB(b, h) ((4 + (b) * 2 + (h)) * HTB)
#define PG8_STAGE2(bufoff, gbase, v0, v1) do { \
        __builtin_amdgcn_global_load_lds((const GAS unsigned*)((const GAS char*)(gbase) + (v0)), (LAS unsigned*)(lds + (bufoff) + ldsw), 16, 0, 0); \
        __builtin_amdgcn_global_load_lds((const GAS unsigned*)((const GAS char*)(gbase) + (v1)), (LAS unsigned*)(lds + (bufoff) + ldsw + 8192), 16, 0, 0); } while (0)
#define PG8_STAGEB(bufoff, gbase) PG8_STAGE2(bufoff, gbase, voffB[0], voffB[1])
#define PG8_LDA(dst, b, h) do { _Pragma("unroll") for (int m = 0; m < 4; ++m) _Pragma("unroll") for (int k = 0; k < 2; ++k) dst[m][k] = *(const LAS bf16x8*)(lds + PG8_SA(b, h) + aoff + m * 2048 + k * 1024); } while (0)
#define PG8_LDB(dst, b, h) do { _Pragma("unroll") for (int n = 0; n < 2; ++n) _Pragma("unroll") for (int k = 0; k < 2; ++k) dst[n][k] = *(const LAS bf16x8*)(lds + PG8_SB(b, h) + boff + n * 2048 + k * 1024); } while (0)
#define PG8_MMA(ai, bj, At, Bt_) do { __builtin_amdgcn_s_setprio(1); _Pragma("unroll") for (int m = 0; m < 4; ++m) _Pragma("unroll") for (int n = 0; n < 2; ++n) _Pragma("unroll") for (int k = 0; k < 2; ++k) \
        acc[ai][bj][m][n] = __builtin_amdgcn_mfma_f32_16x16x32_bf16(Bt_[n][k], At[m][k], acc[ai][bj][m][n], 0, 0, 0); __builtin_amdgcn_s_setprio(0); } while (0)
#define PG8_WAIT_V(n) asm volatile("s_waitcnt vmcnt(" #n ")" ::: "memory")
#define PG8_WAIT_L(n) asm volatile("s_waitcnt lgkmcnt(" #n ")" ::: "memory")
#define PG8_BAR __builtin_amdgcn_s_barrier()
#define PG8_SCHED __builtin_amdgcn_sched_barrier(0)
    Unit cur, nxt; int ui = 0;
    if (!S.next(0, cur)) return;
#ifndef STAGGER
#define STAGGER 0
#endif
    if (STAGGER) { const int grp = (int)(blockIdx.x >> 3) & 3;
        for (int i = 0; i < grp * STAGGER; ++i) __builtin_amdgcn_s_sleep(127); }
    f32x4 acc[2][2][4][2];
#pragma unroll
    for (int a = 0; a < 2; ++a)
#pragma unroll
        for (int b = 0; b < 2; ++b)
#pragma unroll
            for (int m = 0; m < 4; ++m)
#pragma unroll
                for (int n = 0; n < 2; ++n) { float zf; asm volatile("v_mov_b32 %0, 0" : "=v"(zf)); acc[a][b][m][n] = (f32x4){zf, zf, zf, zf}; }
    bf16x8 At[4][2], B0[2][2], B1[2][2];
    constexpr bool GA = Sched::GATHER;
    const size_t hstepA = GA ? 0 : (size_t)HALF * lda * 2, tstepA = (size_t)BM * lda * 2;
    unsigned vc0[2], vc1[2];
    if constexpr (GA) { PG8_GATHER_OFFS(cur.pm); }
    else { int sR, sC;
#pragma unroll
        for (int i = 0; i < 2; ++i) { stage_rc(tid * 16 + i * 8192, sR, sC); vc0[i] = (unsigned)(sR * lda + sC) * 2u; vc1[i] = 0u; } }
#define VC0(i) vc0[i]
#define VC1(i) (GA ? vc1[i] : vc0[i])
#define VN0(i) vc0[i]
#define VN1(i) VC1(i)
    const GAS char* cA = GA ? (const GAS char*)A : (const GAS char*)A + (size_t)cur.pm * tstepA;
    const GAS char* cB = (const GAS char*)Bt + S.boff(cur) * 2 + (size_t)cur.pn * tstepB;
    PG8_STAGEB(PG8_SB(0, 0), cB); PG8_STAGE2(PG8_SA(0, 0), cA, VC0(0), VC0(1)); PG8_STAGEB(PG8_SB(0, 1), cB + hstepB); PG8_STAGE2(PG8_SA(0, 1), cA + hstepA, VC1(0), VC1(1));
    if (wr == 1) PG8_BAR;
    PG8_WAIT_V(4); PG8_BAR;
    PG8_STAGEB(PG8_SB(1, 0), cB + kstep); PG8_STAGE2(PG8_SA(1, 0), cA + kstep, VC0(0), VC0(1)); PG8_STAGEB(PG8_SB(1, 1), cB + hstepB + kstep);
    PG8_WAIT_V(6); PG8_BAR;
    for (;;) {
        const bool has_next = S.next(ui + 1, nxt);
        const GAS char* nB = cB; const GAS char* nA = cA;
        if (has_next) {
            nB = (const GAS char*)Bt + S.boff(nxt) * 2 + (size_t)nxt.pn * tstepB;
            if constexpr (!GA) nA = (const GAS char*)A + (size_t)nxt.pm * tstepA;
        }
        for (int t = 0; t < nt; t += 2) {
            const bool last = (t == nt - 2);
            if constexpr (Epi::HORNER) {
                if (t == 6 || t == 12) {
                    asm volatile("" ::: "memory");
                    const int seg = (t == 6) ? 0 : 1;
                    int hpm = cur.pm, hpn = cur.pn; asm volatile("" : "+s"(hpm), "+s"(hpn));
                    unsigned hln = (unsigned)lane; asm volatile("" : "+v"(hln)); const int hfr = (int)(hln & 15u), hfq = (int)(hln >> 4);
#pragma unroll
                    for (int ai = 0; ai < 2; ++ai) {
                        u32x4 ga[4][2], gb[4][2];
#pragma unroll
                        for (int m = 0; m < 4; ++m)
#pragma unroll
                            for (int bj = 0; bj < 2; ++bj) {
                                const int row = hpm * BM + ai * HALF + wr * 64 + m * 16 + hfr, col = hpn * BM + bj * HALF + wc * 32 + 8 * hfq;
                                ga[m][bj] = E.gate8(seg, row, col); gb[m][bj] = E.gate8(seg + 1, row, col);
                            }
                        asm volatile("" : "+v"(ga[0][0]), "+v"(ga[0][1]), "+v"(ga[1][0]), "+v"(ga[1][1]), "+v"(ga[2][0]), "+v"(ga[2][1]), "+v"(ga[3][0]), "+v"(ga[3][1]),
                                          "+v"(gb[0][0]), "+v"(gb[0][1]), "+v"(gb[1][0]), "+v"(gb[1][1]), "+v"(gb[2][0]), "+v"(gb[2][1]), "+v"(gb[3][0]), "+v"(gb[3][1]) :: "memory");
#pragma unroll
                        for (int m = 0; m < 4; ++m)
#pragma unroll
                            for (int bj = 0; bj < 2; ++bj) {
                                const unsigned aw[4] = {ga[m][bj].x, ga[m][bj].y, ga[m][bj].z, ga[m][bj].w}, bw[4] = {gb[m][bj].x, gb[m][bj].y, gb[m][bj].z, gb[m][bj].w};
#pragma unroll
                                for (int n = 0; n < 2; ++n) {
                                    f32x4& v = acc[ai][bj][m][n];
                                    v.x *= __uint_as_float(aw[2 * n] << 16) * __builtin_amdgcn_rcpf(__uint_as_float(bw[2 * n] << 16));
                                    v.y *= __uint_as_float(aw[2 * n] & 0xffff0000u) * __builtin_amdgcn_rcpf(__uint_as_float(bw[2 * n] & 0xffff0000u));
                                    v.z *= __uint_as_float(aw[2 * n + 1] << 16) * __builtin_amdgcn_rcpf(__uint_as_float(bw[2 * n + 1] << 16));
                                    v.w *= __uint_as_float(aw[2 * n + 1] & 0xffff0000u) * __builtin_amdgcn_rcpf(__uint_as_float(bw[2 * n + 1] & 0xffff0000u));
                                }
                            }
                    }
                    asm volatile("s_waitcnt vmcnt(0)" ::: "memory");
                }
            }
            const GAS char* a1 = cA + (size_t)(t + 1) * kstep;
            const GAS char* a2 = last ? nA : cA + (size_t)(t + 2) * kstep; const GAS char* b2 = last ? nB : cB + (size_t)(t + 2) * kstep;
            const GAS char* a3 = a2 + kstep; const GAS char* b3 = b2 + kstep;
            PG8_LDB(B0, 0, 0); PG8_SCHED; PG8_LDA(At, 0, 0); PG8_STAGE2(PG8_SA(1, 1), a1 + hstepA, VC1(0), VC1(1));
            if constexpr (GA) { if (last && has_next) { asm volatile("" ::: "memory"); PG8_GATHER_OFFS(nxt.pm); asm volatile("" ::: "memory"); } }
            PG8_WAIT_L(8); PG8_BAR; PG8_WAIT_L(0); PG8_MMA(0, 0, At, B0); PG8_BAR; PG8_SCHED;
            PG8_LDB(B1, 0, 1); PG8_STAGEB(PG8_SB(0, 0), b2);
            PG8_BAR; PG8_WAIT_L(0); PG8_MMA(0, 1, At, B1); PG8_BAR;
            PG8_LDA(At, 0, 1); PG8_STAGE2(PG8_SA(0, 0), a2, VN0(0), VN0(1));
            PG8_BAR; PG8_WAIT_L(0); PG8_MMA(1, 0, At, B0); PG8_BAR; PG8_SCHED;
            PG8_STAGEB(PG8_SB(0, 1), b2 + hstepB);
            PG8_WAIT_V(6); PG8_BAR; PG8_MMA(1, 1, At, B1); PG8_BAR;
            PG8_LDB(B0, 1, 0); PG8_SCHED; PG8_LDA(At, 1, 0); PG8_STAGE2(PG8_SA(0, 1), a2 + hstepA, VN1(0), VN1(1));
            PG8_WAIT_L(8); PG8_BAR; PG8_WAIT_L(0); PG8_MMA(0, 0, At, B0); PG8_BAR; PG8_SCHED;
            PG8_LDB(B1, 1, 1); PG8_STAGEB(PG8_SB(1, 0), b3);
            PG8_BAR; PG8_WAIT_L(0); PG8_MMA(0, 1, At, B1); PG8_BAR;
            PG8_LDA(At, 1, 1); PG8_STAGE2(PG8_SA(1, 0), a3, VN0(0), VN0(1));
            PG8_BAR; PG8_WAIT_L(0); PG8_MMA(1, 0, At, B0); PG8_BAR; PG8_SCHED;
            PG8_STAGEB(PG8_SB(1, 1), b3 + hstepB);
            PG8_WAIT_V(6); PG8_BAR; PG8_MMA(1, 1, At, B1); PG8_BAR;
        }
        {
            int epm = cur.pm, epn = cur.pn; asm volatile("" : "+s"(epm), "+s"(epn));
            unsigned eln = (unsigned)lane; asm volatile("" : "+v"(eln)); const int efr = (int)(eln & 15u), efq = (int)(eln >> 4);
            constexpr bool PM = Epi::PERM;
#define PG8_COL(bj, n) (epn * BM + (bj) * HALF + wc * 32 + (PM ? 8 * efq + 4 * (n) : (n) * 16 + 4 * efq))
            f32x4 cv[2][2];
#pragma unroll
            for (int bj = 0; bj < 2; ++bj)
#pragma unroll
                for (int n = 0; n < 2; ++n) { if constexpr (Epi::COLVEC) cv[bj][n] = E.colvec(epm * BM, PG8_COL(bj, n)); else cv[bj][n] = (f32x4){0.f, 0.f, 0.f, 0.f}; }
            if constexpr (Epi::COLVEC) asm volatile("" : "+v"(cv[0][0]), "+v"(cv[0][1]), "+v"(cv[1][0]), "+v"(cv[1][1]) :: "memory");
#pragma unroll
            for (int ai = 0; ai < 2; ++ai) {
                f32x4 bs[4][2][2];
                if constexpr (Epi::BASE) {
#pragma unroll
                    for (int m = 0; m < 4; ++m)
#pragma unroll
                        for (int bj = 0; bj < 2; ++bj) {
                            const int row = epm * BM + ai * HALF + wr * 64 + m * 16 + efr;
                            if constexpr (PM) E.base8(row, PG8_COL(bj, 0), bs[m][bj][0], bs[m][bj][1]);
                            else {
#pragma unroll
                                for (int n = 0; n < 2; ++n) bs[m][bj][n] = E.base(row, PG8_COL(bj, n));
                            }
                        }
                    asm volatile("" : "+v"(bs[0][0][0]), "+v"(bs[0][0][1]), "+v"(bs[0][1][0]), "+v"(bs[0][1][1]), "+v"(bs[1][0][0]), "+v"(bs[1][0][1]), "+v"(bs[1][1][0]), "+v"(bs[1][1][1]),
                                      "+v"(bs[2][0][0]), "+v"(bs[2][0][1]), "+v"(bs[2][1][0]), "+v"(bs[2][1][1]), "+v"(bs[3][0][0]), "+v"(bs[3][0][1]), "+v"(bs[3][1][0]), "+v"(bs[3][1][1]) :: "memory");
                }
#pragma unroll
                for (int m = 0; m < 4; ++m) {
                    const int row = epm * BM + ai * HALF + wr * 64 + m * 16 + efr;
#pragma unroll
                    for (int bj = 0; bj < 2; ++bj) {
                        if constexpr (Epi::PAIR) E.store_pair(row, epn * (BM / 2) + bj * (HALF / 2) + wc * 16 + 4 * efq, acc[ai][bj][m][0], acc[ai][bj][m][1]);
                        else if constexpr (PM) {
                            f32x4 b0 = (f32x4){0.f, 0.f, 0.f, 0.f}, b1 = b0; if constexpr (Epi::BASE) { b0 = bs[m][bj][0]; b1 = bs[m][bj][1]; }
                            E.store8(row, PG8_COL(bj, 0), acc[ai][bj][m][0], acc[ai][bj][m][1], cv[bj][0], cv[bj][1], b0, b1);
                        } else {
#pragma unroll
                            for (int n = 0; n < 2; ++n) { f32x4 bb = (f32x4){0.f, 0.f, 0.f, 0.f}; if constexpr (Epi::BASE) bb = bs[m][bj][n]; E.store(row, PG8_COL(bj, n), acc[ai][bj][m][n], cv[bj][n], bb); }
                        }
                    }
                }
            }
#undef PG8_COL
        }
        if (!has_next) break;
#pragma unroll
        for (int a = 0; a < 2; ++a)
#pragma unroll
            for (int b = 0; b < 2; ++b)
#pragma unroll
                for (int m = 0; m < 4; ++m)
#pragma unroll
                    for (int n = 0; n < 2; ++n) { float zf; asm volatile("v_mov_b32 %0, 0" : "=v"(zf)); acc[a][b][m][n] = (f32x4){zf, zf, zf, zf}; }
        cur = nxt; cB = nB; cA = nA; ++ui;
    }
    PG8_WAIT_V(0);
    if (wr == 0) PG8_BAR;
    PG8_BAR;
#undef PG8_GATHER_OFFS
#undef VC0
#undef VC1
#undef VN0
#undef VN1
#undef PG8_SA
#undef PG8_SB
#undef PG8_STAGE2
#undef PG8_STAGEB
#undef PG8_LDA
#undef PG8_LDB
#undef PG8_MMA
#undef PG8_WAIT_V
#undef PG8_WAIT_L
#undef PG8_BAR
#undef PG8_SCHED
}
}

template <class Epi>
__device__ __forceinline__ void gemm_fast(Frame& F, const GAS bf16* A, int lda, const GAS bf16* Bt, int ldb, int K, int M, int N, const Epi& E) {
    pg8::OrderPlain S; S.init(M / 256, N / 256, F.G, F.wg);
    pg8::gemm_phase(F.lds, F.tid, A, lda, Bt, ldb, K, S, E);
}
#ifndef FAST_PLAIN
#define FAST_PLAIN 1
#endif
#ifndef FAST_HORNER
#define FAST_HORNER 1
#endif
#ifndef FAST_MOE
#define FAST_MOE 1
#endif

__device__ __forceinline__ void st_bf16x4(GAS bf16* p, f32x4 v) { u32x2 w; w.x = pk2(v.x, v.y); w.y = pk2(v.z, v.w); *(GAS u32x2*)p = w; }
__device__ __forceinline__ f32x4 ld_bf16x4(const GAS bf16* p) { const u32x2 w = *(const GAS u32x2*)p; f32x4 v; v.x = __uint_as_float(w.x << 16); v.y = __uint_as_float(w.x & 0xffff0000u); v.z = __uint_as_float(w.y << 16); v.w = __uint_as_float(w.y & 0xffff0000u); return v; }

__device__ __forceinline__ void st_bf16x8(GAS bf16* p, f32x4 a, f32x4 b) { u32x4 w; w.x = pk2(a.x, a.y); w.y = pk2(a.z, a.w); w.z = pk2(b.x, b.y); w.w = pk2(b.z, b.w); *(GAS u32x4*)p = w; }
struct EpiWin {
    static constexpr bool HORNER = false, PAIR = false, COLVEC = true, BASE = false, PERM = true;
    const GAS float* bias; GAS bf16 *hytl, *hytc, *ret, *ml; GAS float* mlg;
    __device__ __forceinline__ f32x4 colvec(int, int col) const { return *(const GAS f32x4*)(bias + col); }
    __device__ __forceinline__ void store8(int row, int col, f32x4 v0, f32x4 v1, f32x4 c0, f32x4 c1, f32x4, f32x4) const {
        v0 += c0; v1 += c1;
        if (col < 1152) {
            const float v[8] = {v0.x, v0.y, v0.z, v0.w, v1.x, v1.y, v1.z, v1.w};
            if (row < TOKL) { const int b = row >> 11, t = row & 2047; GAS bf16* d = hytl + ((size_t)(b * 1152 + col)) * 2048 + t;
#pragma unroll
                for (int j = 0; j < 8; ++j) d[2048 * j] = (bf16)f2bf(v[j]); }
            else { const int r = row - TOKL, b = r >> 8, t = r & 255; GAS bf16* d = hytc + ((size_t)(b * 1152 + col)) * 256 + t;
#pragma unroll
                for (int j = 0; j < 8; ++j) d[256 * j] = (bf16)f2bf(v[j]); }
        } else if (col < 1168) { *(GAS f32x4*)(mlg + (size_t)row * 16 + (col - 1152)) = v0; *(GAS f32x4*)(mlg + (size_t)row * 16 + (col - 1152) + 4) = v1; }
        else if (col < 1280) { }
        else if (col < 2816) st_bf16x8(ret + (size_t)row * 1536 + (col - 1280), v0, v1);
        else st_bf16x8(ml + (size_t)row * 1024 + (col - 2816), v0, v1);
    }
};
struct EpiGate {
    static constexpr bool HORNER = false, PAIR = false, COLVEC = true, BASE = false, PERM = true;
    const GAS float* bias; GAS bf16* gates;
    __device__ __forceinline__ f32x4 colvec(int, int col) const { return *(const GAS f32x4*)(bias + col); }
    __device__ __forceinline__ void store8(int row, int col, f32x4 v0, f32x4 v1, f32x4 c0, f32x4 c1, f32x4, f32x4) const {
        v0 += c0; v1 += c1;
        f32x4 g0, g1;
        g0.x = fmaxf(sigmoidf_(v0.x), 1e-20f); g0.y = fmaxf(sigmoidf_(v0.y), 1e-20f); g0.z = fmaxf(sigmoidf_(v0.z), 1e-20f); g0.w = fmaxf(sigmoidf_(v0.w), 1e-20f);
        g1.x = fmaxf(sigmoidf_(v1.x), 1e-20f); g1.y = fmaxf(sigmoidf_(v1.y), 1e-20f); g1.z = fmaxf(sigmoidf_(v1.z), 1e-20f); g1.w = fmaxf(sigmoidf_(v1.w), 1e-20f);
        st_bf16x8(gates + (size_t)row * NGATE + col, g0, g1);
    }
};
struct EpiUp {
    static constexpr bool HORNER = true, PAIR = false, COLVEC = false, BASE = true, PERM = true;
    const GAS bf16* gates; GAS bf16* acc_out;
    __device__ __forceinline__ u32x4 gate8(int which, int row, int col) const { return *(const GAS u32x4*)(gates + (size_t)row * NGATE + which * 1024 + col); }
    __device__ __forceinline__ void base8(int row, int col, f32x4& b0, f32x4& b1) const {
        const u32x4 w = *(const GAS u32x4*)(gates + (size_t)row * NGATE + 2048 + col);
        b0.x = __uint_as_float(w.x << 16); b0.y = __uint_as_float(w.x & 0xffff0000u); b0.z = __uint_as_float(w.y << 16); b0.w = __uint_as_float(w.y & 0xffff0000u);
        b1.x = __uint_as_float(w.z << 16); b1.y = __uint_as_float(w.z & 0xffff0000u); b1.z = __uint_as_float(w.w << 16); b1.w = __uint_as_float(w.w & 0xffff0000u);
    }
    __device__ __forceinline__ void store8(int row, int col, f32x4 v0, f32x4 v1, f32x4, f32x4, f32x4 g0, f32x4 g1) const { st_bf16x8(acc_out + (size_t)row * D + col, v0 * g0, v1 * g1); }
};
struct EpiResid {
    static constexpr bool HORNER = false, PAIR = false, COLVEC = true, BASE = true, PERM = false;
    const GAS float *xin_l, *xin_c; GAS float *xout_l, *xout_c; const GAS float* modbase; int which; GAS float* dummy;
    __device__ __forceinline__ f32x4 colvec(int row0, int col) const { const int r = row0 < TOKL ? (row0 >> 11) : 16; return *(const GAS f32x4*)(modbase + ((size_t)r * 6 + which) * 1024 + col); }
    __device__ __forceinline__ f32x4 base(int row, int col) const { return row < TOKL ? *(const GAS f32x4*)(xin_l + (size_t)row * D + col) : *(const GAS f32x4*)(xin_c + (size_t)(row - TOKL) * D + col); }
    __device__ __forceinline__ void store(int row, int col, f32x4 v, f32x4 m, f32x4 x) const {
        if (dummy) { *(GAS f32x4*)(dummy + (size_t)(row & 8191) * D + col) = x + m * v; return; }
        if (row < TOKL) *(GAS f32x4*)(xout_l + (size_t)row * D + col) = x + m * v;
        else *(GAS f32x4*)(xout_c + (size_t)(row - TOKL) * D + col) = x + m * v;
    }
};
struct EpiSwiglu {
    static constexpr bool HORNER = false, PAIR = true, COLVEC = false, BASE = false, PERM = false;
    GAS bf16* act; int row_off;
    __device__ __forceinline__ void store_pair(int row, int col, f32x4 a, f32x4 b) const {
        f32x4 o; o.x = siluf_(a.x) * b.x; o.y = siluf_(a.y) * b.y; o.z = siluf_(a.z) * b.z; o.w = siluf_(a.w) * b.w;
        st_bf16x4(act + (size_t)(row - row_off) * DFF + col, o);
    }
    __device__ __forceinline__ void store(int, int, f32x4, f32x4, f32x4) const {}
};
struct EpiBf16Out {
    static constexpr bool HORNER = false, PAIR = false, COLVEC = false, BASE = false, PERM = true;
    GAS bf16* out; int ld; int row_add;
    __device__ __forceinline__ void store8(int row, int col, f32x4 v0, f32x4 v1, f32x4, f32x4, f32x4, f32x4) const { st_bf16x8(out + (size_t)(row + row_add) * ld + col, v0, v1); }
};

constexpr int ZPITCH_L = (LL + 8) * 2, ZPITCH_C = (LC + 8) * 2;
template <int L>
__device__ __forceinline__ float conv3_at(const GAS bf16* base  , int t, float w0, float w1, float w2) {
    const float a = t > 0 ? bf2f(base[t - 1]) : 0.f, b = bf2f(base[t]), c = t < L - 1 ? bf2f(base[t + 1]) : 0.f;
    return w0 * a + w1 * b + w2 * c;
}
template <int L>
__device__ __forceinline__ void hyena_unit_naive(Frame& F, int layer, int c, const GAS bf16* hyt  , const GAS bf16* ft  , GAS bf16* yht  ) {
    constexpr int ZP = (L + 8) * 2;
    constexpr int PER = L / 32;
    constexpr int SUB = 8;
    LAS unsigned char* zimg0 = F.lds;
    LAS unsigned char* zimg1 = F.lds + 16 * ZP;
    LAS bf16* tf = (LAS bf16*)(F.lds + 32 * ZP);
    const GAS float* cw = inp(F, I_HYCONV) + layer * 3 * 1152;
    const GAS float* skip = inp(F, I_HYSKIP) + layer * 2 * 384;
    __syncthreads();
    {
        const int b = F.tid >> 5, seg = F.tid & 31; const GAS bf16* src = hyt + ((size_t)(b * 1152 + c)) * L;
        const float w0 = cw[c], w1 = cw[1152 + c], w2 = cw[2304 + c];
#pragma unroll 2
        for (int j = 0; j < PER; ++j) { const int t = seg * PER + j; *(LAS bf16*)(zimg0 + b * ZP + t * 2) = (bf16)f2bf(conv3_at<L>(src, t, w0, w1, w2)); }
    }
#pragma unroll 1
    for (int o = 0; o < 2; ++o) {
        LAS unsigned char* zs = o == 0 ? zimg0 : zimg1;
        LAS unsigned char* zd = o == 0 ? zimg1 : zimg0;
        const GAS bf16* fsrc = ft + ((size_t)(o * 384 + c)) * (2 * L);
        for (int i = F.tid; i < 2 * L; i += NTHR) tf[i] = i == 0 ? (bf16)0 : fsrc[i];
        __syncthreads();
        const int b = F.tid & 15, tg = F.tid >> 4;
        const int gcol = (o == 0 ? 384 : 768) + c;
        const GAS bf16* gsrc = hyt + ((size_t)(b * 1152 + gcol)) * L;
        const float w0 = cw[gcol], w1 = cw[1152 + gcol], w2 = cw[2304 + gcol], sk = skip[o * 384 + c];
#pragma unroll 1
        for (int sb = 0; sb < PER / SUB; ++sb) {
            const int t0 = tg * PER + sb * SUB;
            float acc[SUB];
#pragma unroll
            for (int j = 0; j < SUB; ++j) acc[j] = 0.f;
#pragma unroll 1
            for (int s0 = 0; s0 < L; s0 += 8) {
                float z[8];
                { const bf16x8 zz = *(const LAS bf16x8*)(zs + b * ZP + s0 * 2);
#pragma unroll
                  for (int i = 0; i < 8; ++i) z[i] = bf2f((bf16)zz[i]); }
                float win[SUB + 7];
                const int wb = L + s0 - t0 - (SUB - 1);
#pragma unroll
                for (int i = 0; i < SUB + 7; ++i) win[i] = bf2f(tf[wb + i]);
#pragma unroll
                for (int j = 0; j < SUB; ++j)
#pragma unroll
                    for (int i = 0; i < 8; ++i) acc[j] += win[(SUB - 1) - j + i] * z[i];
            }
#pragma unroll
            for (int j = 0; j < SUB; ++j) {
                const int t = t0 + j;
                const float zt = bf2f(*(LAS bf16*)(zs + b * ZP + t * 2));
                const float ov = conv3_at<L>(gsrc, t, w0, w1, w2) * (acc[j] + sk * zt);
                *(LAS bf16*)(zd + b * ZP + t * 2) = (bf16)f2bf(ov);
            }
        }
        __syncthreads();
    }
#pragma unroll 2
    for (int i = F.tid; i < 16 * (L / 8); i += NTHR) {
        const int b = i / (L / 8), ch = i % (L / 8);
        *(GAS u32x4*)(yht + ((size_t)(b * 384 + c)) * L + ch * 8) = *(const LAS u32x4*)(zimg0 + b * ZP + ch * 16);
    }
}

template <int L>
__device__ __forceinline__ void hyena_unit_fast(Frame& F, int layer, int c, const GAS bf16* hyt  , const GAS bf16* ft  , GAS bf16* yht  ) {
    constexpr int ZP = (L + 8) * 2;
    constexpr int PER = L / 32;
    constexpr int I = L / 128;
    constexpr int SPAN = L / 4, NSTEP = L / 32;
    constexpr int CP = (2 * L + 8) * 2;
    LAS unsigned char* zimg = F.lds;
    LAS unsigned char* cpy = F.lds + 16 * ZP;
    const GAS float* cw = inp(F, I_HYCONV) + layer * 3 * 1152;
    const GAS float* skip = inp(F, I_HYSKIP) + layer * 2 * 384;
    const int lane = F.lane, fr = lane & 15, fq = lane >> 4, w = F.wave;
    { unsigned long long a_ = (unsigned long long)hyt, b_ = (unsigned long long)yht; asm volatile("" : "+s"(a_), "+s"(b_)); hyt = (const GAS bf16*)a_; yht = (GAS bf16*)b_; }
    __syncthreads();
    {
        const int b = F.tid >> 5, sg = F.tid & 31, t0 = sg * PER; const GAS bf16* src = hyt + ((size_t)(b * 1152 + c)) * L + t0;
        const float w0 = cw[c], w1 = cw[1152 + c], w2 = cw[2304 + c];
        u32x4 raw[PER / 8];
#pragma unroll
        for (int j = 0; j < PER / 8; ++j) raw[j] = *(const GAS u32x4*)(src + 8 * j);
        float prev = t0 > 0 ? bf2f(src[-1]) : 0.f;
        const float nextv = t0 + PER < L ? bf2f(src[PER]) : 0.f;
#pragma unroll
        for (int j = 0; j < PER / 8; ++j) {
            const unsigned wv[4] = {raw[j].x, raw[j].y, raw[j].z, raw[j].w};
            float x[10]; x[0] = prev;
#pragma unroll
            for (int q = 0; q < 4; ++q) { x[1 + 2 * q] = __uint_as_float(wv[q] << 16); x[2 + 2 * q] = __uint_as_float(wv[q] & 0xffff0000u); }
            if (j + 1 < PER / 8) x[9] = __uint_as_float(raw[(j + 1 < PER / 8) ? j + 1 : j].x << 16); else x[9] = nextv;
            u32x4 o;
            o.x = pk2(w0 * x[0] + w1 * x[1] + w2 * x[2], w0 * x[1] + w1 * x[2] + w2 * x[3]); o.y = pk2(w0 * x[2] + w1 * x[3] + w2 * x[4], w0 * x[3] + w1 * x[4] + w2 * x[5]);
            o.z = pk2(w0 * x[4] + w1 * x[5] + w2 * x[6], w0 * x[5] + w1 * x[6] + w2 * x[7]); o.w = pk2(w0 * x[6] + w1 * x[7] + w2 * x[8], w0 * x[7] + w1 * x[8] + w2 * x[9]);
            *(LAS u32x4*)(zimg + b * ZP + (t0 + 8 * j) * 2) = o;
            prev = x[8];
        }
    }
    const int tbase = SPAN * (w >> 1) + 16 * (w & 1);
    const int flane = L - tbase + 8 * fq - fr;
    const int msh = fr & 7;
    const LAS unsigned char* fbase = cpy + msh * CP + 2 * (flane + msh);
#pragma unroll 1
    for (int o = 0; o < 2; ++o) {
        const GAS bf16* fsrc = ft + ((size_t)(o * 384 + c)) * (2 * L);
        for (int i = F.tid; i < CP / 16; i += NTHR) { u32x4 v = (u32x4){0u, 0u, 0u, 0u}; if (i < 2 * L / 8) v = *(const GAS u32x4*)(fsrc + 8 * i); if (i == 0) v.x &= 0xffff0000u; *(LAS u32x4*)(cpy + 16 * i) = v; }
        __syncthreads();
        for (int task = F.tid; task < 7 * (CP / 16); task += NTHR) {
            const int m = 1 + task / (CP / 16), x8 = task % (CP / 16);
            unsigned short e[8];
#pragma unroll
            for (int i = 0; i < 8; ++i) { const int idx = 8 * x8 - m + i; e[i] = idx >= 0 ? *(const LAS unsigned short*)(cpy + 2 * idx) : (unsigned short)0; }
            u32x4 v; v.x = e[0] | ((unsigned)e[1] << 16); v.y = e[2] | ((unsigned)e[3] << 16); v.z = e[4] | ((unsigned)e[5] << 16); v.w = e[6] | ((unsigned)e[7] << 16);
            *(LAS u32x4*)(cpy + m * CP + 16 * x8) = v;
        }
        __syncthreads();
        f32x4 acc[I];
#pragma unroll
        for (int i = 0; i < I; ++i) acc[i] = (f32x4){0.f, 0.f, 0.f, 0.f};
        bf16x8 ring[I];
#pragma unroll
        for (int i = 1; i < I; ++i) ring[(I - i) % I] = *(const LAS bf16x8*)(fbase - 64 * i);
        bf16x8 nf = *(const LAS bf16x8*)(fbase);
        const LAS unsigned char* zrow = zimg + fr * ZP + 16 * fq;
#pragma unroll 1
        for (int j0 = 0; j0 < NSTEP; j0 += I) {
#pragma unroll
            for (int jj = 0; jj < I; ++jj) {
                const int j = j0 + jj;
                ring[jj] = nf;
                if (j + 1 < NSTEP) nf = *(const LAS bf16x8*)(fbase + 64 * (j + 1));
                const bf16x8 zf = *(const LAS bf16x8*)(zrow + 64 * j);
#pragma unroll
                for (int i = 0; i < I; ++i) acc[i] = __builtin_amdgcn_mfma_f32_16x16x32_bf16(ring[(jj - i + I) % I], zf, acc[i], 0, 0, 0);
            }
        }
        unsigned el_ = (unsigned)lane; asm volatile("" : "+v"(el_)); const int efr = (int)(el_ & 15u), efq = (int)(el_ >> 4);
        const int etb = SPAN * (w >> 1) + 16 * (w & 1);
        const int gcol = (o == 0 ? 384 : 768) + c;
        const GAS bf16* gsrc = hyt + ((size_t)(efr * 1152 + gcol)) * L;
        const float w0 = cw[gcol], w1 = cw[1152 + gcol], w2 = cw[2304 + gcol], sk = skip[o * 384 + c];
        GAS bf16* dst = yht + ((size_t)(efr * 384 + c)) * L;
        constexpr int GI = I < 8 ? I : 8;
#pragma unroll
        for (int i0 = 0; i0 < I; i0 += GI) {
            u32x2 grv[GI]; unsigned short gmv[GI], gpv[GI];
#pragma unroll
            for (int ii = 0; ii < GI; ++ii) {
                const int t = etb + 32 * (i0 + ii) + 4 * efq;
                grv[ii] = *(const GAS u32x2*)(gsrc + t); gmv[ii] = t > 0 ? gsrc[t - 1] : (unsigned short)0; gpv[ii] = t + 4 < L ? gsrc[t + 4] : (unsigned short)0;
            }
            asm volatile("" ::: "memory");
#pragma unroll
            for (int ii = 0; ii < GI; ++ii) {
                const int i = i0 + ii;
                const int t = etb + 32 * i + 4 * efq;
                const u32x2 zr = *(const LAS u32x2*)(zimg + efr * ZP + t * 2);
                const u32x2 gr = grv[ii];
                const float gm = bf2f(gmv[ii]), gp = bf2f(gpv[ii]);
                const float g0 = __uint_as_float(gr.x << 16), g1 = __uint_as_float(gr.x & 0xffff0000u), g2 = __uint_as_float(gr.y << 16), g3 = __uint_as_float(gr.y & 0xffff0000u);
                const float z0 = __uint_as_float(zr.x << 16), z1 = __uint_as_float(zr.x & 0xffff0000u), z2 = __uint_as_float(zr.y << 16), z3 = __uint_as_float(zr.y & 0xffff0000u);
                const float o0 = (w0 * gm + w1 * g0 + w2 * g1) * (acc[i].x + sk * z0), o1 = (w0 * g0 + w1 * g1 + w2 * g2) * (acc[i].y + sk * z1);
                const float o2 = (w0 * g1 + w1 * g2 + w2 * g3) * (acc[i].z + sk * z2), o3 = (w0 * g2 + w1 * g3 + w2 * gp) * (acc[i].w + sk * z3);
                acc[i] = (f32x4){o0, o1, o2, o3};
            }
        }
        __syncthreads();
#pragma unroll
        for (int i = 0; i < I; ++i) {
            const int t = etb + 32 * i + 4 * efq;
            u32x2 ov; ov.x = pk2(acc[i].x, acc[i].y); ov.y = pk2(acc[i].z, acc[i].w);
            if (o == 0) *(LAS u32x2*)(zimg + efr * ZP + t * 2) = ov;
            else *(GAS u32x2*)(dst + t) = ov;
        }
    }
}

__device__ __forceinline__ void chain_naive(Frame& F, int layer, int chain) {
    const int lane = F.lane;
    const bool is_ret = chain < 192;
    int b, h, dir;
    if (is_ret) { b = chain / 12; const int r = chain % 12; h = r >> 1; dir = r & 1; }
    else { const int i = chain - 192; b = i >> 3; h = (i & 7) >> 1; dir = i & 1; }
    const GAS bf16* RET = WSP(const bf16, WS_RET); const GAS bf16* ML = WSP(const bf16, WS_ML); const GAS float* MLG = WSP(const float, WS_MLG);
    const GAS float* rope = WSP(const float, WS_ROPE);
    GAS bf16* Y = WSP(bf16, WS_Y); GAS bf16* OB = WSP(bf16, WS_OB);
    float gam = 0.f;
    if (is_ret) gam = sigmoidf_(inp(F, I_RETDECAY)[layer * 12 + dir * 6 + h]);
    const GAS float* mlc = inp(F, I_MLCONV) + layer * 3 * 512;
    const float bi = is_ret ? 0.f : inp(F, I_MLGB)[layer * 16 + dir * 8 + h], bfg = is_ret ? 0.f : inp(F, I_MLGB)[layer * 16 + dir * 8 + 4 + h];
    const float qw0 = mlc[h * 64 + lane], qw1 = mlc[512 + h * 64 + lane], qw2 = mlc[1024 + h * 64 + lane];
    const float kw0 = mlc[256 + h * 64 + lane], kw1 = mlc[512 + 256 + h * 64 + lane], kw2 = mlc[1024 + 256 + h * 64 + lane];
    float S[64];
#pragma unroll
    for (int d = 0; d < 64; ++d) S[d] = 0.f;
    float nv = 0.f;
    for (int step = 0; step < LC + LL; ++step) {
        int row, tpos, L; bool lat;
        if (step < LC) { tpos = dir ? (LC - 1 - step) : step; row = TOKL + b * LC + tpos; L = LC; lat = false; }
        else { const int s2 = step - LC; tpos = dir ? (LL - 1 - s2) : s2; row = b * LL + tpos; L = LL; lat = true; }
        float q, k, v, Fm, Im;
        if (is_ret) {
            const GAS bf16* base = RET + (size_t)row * 1536;
            float qs = bf2f(base[h * 64 + lane]), ks = bf2f(base[384 + h * 64 + lane]);
            v = bf2f(base[768 + h * 64 + lane]);
            if (lat) {
                const float qp = bf2f(base[h * 64 + (lane ^ 16)]), kp = bf2f(base[384 + h * 64 + (lane ^ 16)]);
                const int half = lane >> 5, ii = lane & 15, hi = (lane >> 4) & 1;
                const float cs = rope[tpos * 64 + half * 32 + ii], sn = rope[tpos * 64 + half * 32 + 16 + ii];
                q = hi == 0 ? qs * cs - qp * sn : qp * sn + qs * cs;
                k = hi == 0 ? ks * cs - kp * sn : kp * sn + ks * cs;
            } else { q = qs; k = ks; }
            q *= 0.125f; Fm = gam; Im = 1.f;
        } else {
            const GAS bf16* base = ML + (size_t)row * 1024;
            const float q0 = tpos > 0 ? bf2f(base[-1024 + h * 64 + lane]) : 0.f, q1 = bf2f(base[h * 64 + lane]), q2 = tpos < L - 1 ? bf2f(base[1024 + h * 64 + lane]) : 0.f;
            const float k0 = tpos > 0 ? bf2f(base[-1024 + 256 + h * 64 + lane]) : 0.f, k1 = bf2f(base[256 + h * 64 + lane]), k2 = tpos < L - 1 ? bf2f(base[1024 + 256 + h * 64 + lane]) : 0.f;
            q = siluf_(qw0 * q0 + qw1 * q1 + qw2 * q2);
            k = siluf_(kw0 * k0 + kw1 * k1 + kw2 * k2) * 0.125f;
            v = bf2f(base[512 + h * 64 + lane]);
            const float ig = MLG[(size_t)row * 16 + dir * 8 + h] + bi, fg = MLG[(size_t)row * 16 + dir * 8 + 4 + h] + bfg;
            Fm = sigmoidf_(fg); Im = __expf(ig);
        }
        float num = 0.f;
        const float iv = Im * v;
#pragma unroll
        for (int d = 0; d < 64; ++d) {
            const float kd = __int_as_float(__builtin_amdgcn_readlane(__float_as_int(k), d));
            const float qd = __int_as_float(__builtin_amdgcn_readlane(__float_as_int(q), d));
            S[d] = Fm * S[d] + kd * iv;
            num += qd * S[d];
        }
        float o = num;
        if (!is_ret) { nv = Fm * nv + Im * k; const float den = wave_sum(q * nv); o = num / fmaxf(fabsf(den), 1.f); }
        const int cof = is_ret ? (h * 64 + lane) : (384 + h * 64 + lane);
        if (dir == 0) Y[(size_t)row * D + 384 + cof] = (bf16)f2bf(o);
        else OB[(size_t)row * 640 + cof] = (bf16)f2bf(o);
    }
}

#ifndef REP_CH
#define REP_CH 1
#endif
#ifndef REP_CH_ML
#define REP_CH_ML REP_CH
#endif
#ifndef REP_CH_RET
#define REP_CH_RET REP_CH
#endif
constexpr int CH_PITCH = 144;
constexpr int CH_IMG = 64 * CH_PITCH;
constexpr int CH_WAVE_LDS = 3 * CH_IMG + 1024 + 512;
__device__ __forceinline__ void ds_tr16x8(unsigned addr, u32x2 (&lo)[4], u32x2 (&hi)[4]) {
    asm volatile("ds_read_b64_tr_b16 %0, %8\n\tds_read_b64_tr_b16 %1, %8 offset:32\n\tds_read_b64_tr_b16 %2, %8 offset:64\n\tds_read_b64_tr_b16 %3, %8 offset:96\n\t"
                 "ds_read_b64_tr_b16 %4, %8 offset:2304\n\tds_read_b64_tr_b16 %5, %8 offset:2336\n\tds_read_b64_tr_b16 %6, %8 offset:2368\n\tds_read_b64_tr_b16 %7, %8 offset:2400\n\t"
                 "s_waitcnt lgkmcnt(0)"
                 : "=&v"(lo[0]), "=&v"(lo[1]), "=&v"(lo[2]), "=&v"(lo[3]), "=&v"(hi[0]), "=&v"(hi[1]), "=&v"(hi[2]), "=&v"(hi[3]) : "v"(addr) : "memory");
}
static_assert(16 * CH_PITCH == 2304, "ds_tr16x8 offsets");
__device__ __forceinline__ void ds_tr16x4(unsigned addr, u32x2 (&lo)[2], u32x2 (&hi)[2]) {
    asm volatile("ds_read_b64_tr_b16 %0, %4\n\tds_read_b64_tr_b16 %1, %4 offset:32\n\tds_read_b64_tr_b16 %2, %4 offset:2304\n\tds_read_b64_tr_b16 %3, %4 offset:2336\n\ts_waitcnt lgkmcnt(0)"
                 : "=&v"(lo[0]), "=&v"(lo[1]), "=&v"(hi[0]), "=&v"(hi[1]) : "v"(addr) : "memory");
}
__device__ __forceinline__ float log_sigmoid_(float x) { return fminf(x, 0.f) - log1pf(__expf(-fabsf(x))); }
__device__ __forceinline__ bf16x8 mk_frag(u32x2 lo, u32x2 hi) { u32x4 w; w.x = lo.x; w.y = lo.y; w.z = hi.x; w.w = hi.y; return __builtin_bit_cast(bf16x8, w); }

template <bool IS_ML>
__device__ __forceinline__ void chain_fast(Frame& F, int layer, int b, int h, int dir, LAS unsigned char* img, int hf) {
    constexpr int NET = 2;
    const int lane = F.lane, fr = lane & 15, fq = lane >> 4;
    LAS unsigned char* Qi = img; LAS unsigned char* Ki = img + CH_IMG; LAS unsigned char* Vi = img + 2 * CH_IMG;
    const unsigned qa = (unsigned)(size_t)Qi, ka = (unsigned)(size_t)Ki, va = (unsigned)(size_t)Vi;
    const GAS bf16* RET = WSP(const bf16, WS_RET); const GAS bf16* ML = WSP(const bf16, WS_ML); const GAS float* MLG = WSP(const float, WS_MLG);
    const GAS float* rope = WSP(const float, WS_ROPE);
    GAS bf16* Y = WSP(bf16, WS_Y); GAS bf16* OB = WSP(bf16, WS_OB);
    float lgam = 0.f, bi_ = 0.f, bf_ = 0.f;
    if (!IS_ML) lgam = log_sigmoid_(inp(F, I_RETDECAY)[layer * 12 + dir * 6 + h]);
    else { bi_ = inp(F, I_MLGB)[layer * 16 + dir * 8 + h]; bf_ = inp(F, I_MLGB)[layer * 16 + dir * 8 + 4 + h]; }
    const GAS float* mlc = inp(F, I_MLCONV) + layer * 3 * 512;
    f32x4 C[4][NET];
#pragma unroll
    for (int dt = 0; dt < 4; ++dt)
#pragma unroll
        for (int et = 0; et < NET; ++et) C[dt][et] = (f32x4){0.f, 0.f, 0.f, 0.f};
    const int cq = lane & 7, pr0 = lane >> 3;
    LAS float* nvec = (LAS float*)(img + 3 * CH_IMG + 1024 + 256 * hf);
    if (IS_ML) nvec[lane] = 0.f;
    const LAS float* nq = nvec + 4 * fq;
#pragma unroll 1
    for (int step_ = 0; step_ < 36 * (IS_ML ? REP_CH_ML : REP_CH_RET); ++step_) {
        const int step = step_ % 36;
        if ((IS_ML ? REP_CH_ML : REP_CH_RET) > 1 && step == 0) {
            if (IS_ML) nvec[lane] = 0.f;
#pragma unroll
            for (int dt = 0; dt < 4; ++dt)
#pragma unroll
                for (int et = 0; et < NET; ++et) C[dt][et] = (f32x4){0.f, 0.f, 0.f, 0.f};
        }
        int rowbase, t0, L; bool lat;
        if (step < 4) { const int cc = dir ? 3 - step : step; rowbase = TOKL + b * LC + cc * 64; t0 = cc * 64; L = LC; lat = false; }
        else { const int cc = dir ? 35 - step : step - 4; rowbase = b * LL + cc * 64; t0 = cc * 64; L = LL; lat = true; }
        float g_i = 0.f, g_f = 0.f;
        if (IS_ML) { const int tlg = dir ? 63 - lane : lane; const GAS float* gp = MLG + (size_t)(rowbase + tlg) * 16 + dir * 8 + h; g_i = gp[0]; g_f = gp[4]; }
        if constexpr (!IS_ML) {
#pragma unroll
        for (int i4 = 0; i4 < 4; ++i4) {
            const int i = 4 * hf + i4;
            const int p = pr0 + 8 * i, tl = dir ? 63 - p : p, row = rowbase + tl, tpos = t0 + tl;
            float qv[8], kv[8]; u32x4 vraw;
            {
                const GAS bf16* base = RET + (size_t)row * 1536 + h * 64;
                const u32x4 qr = *(const GAS u32x4*)(base + 8 * cq), kr = *(const GAS u32x4*)(base + 384 + 8 * cq); vraw = *(const GAS u32x4*)(base + 768 + 8 * cq);
                const unsigned qw[4] = {qr.x, qr.y, qr.z, qr.w}, kw[4] = {kr.x, kr.y, kr.z, kr.w};
#pragma unroll
                for (int j = 0; j < 4; ++j) { qv[2 * j] = __uint_as_float(qw[j] << 16); qv[2 * j + 1] = __uint_as_float(qw[j] & 0xffff0000u); kv[2 * j] = __uint_as_float(kw[j] << 16); kv[2 * j + 1] = __uint_as_float(kw[j] & 0xffff0000u); }
                if (lat) {
                    const u32x4 qpr = *(const GAS u32x4*)(base + 8 * (cq ^ 2)), kpr = *(const GAS u32x4*)(base + 384 + 8 * (cq ^ 2));
                    const unsigned qpw[4] = {qpr.x, qpr.y, qpr.z, qpr.w}, kpw[4] = {kpr.x, kpr.y, kpr.z, kpr.w};
                    const int half = cq >> 2, hi = (cq >> 1) & 1, i0 = 8 * (cq & 1);
                    const GAS float* rp = rope + tpos * 64 + half * 32 + i0;
                    const f32x4 c0 = *(const GAS f32x4*)(rp), c1 = *(const GAS f32x4*)(rp + 4), s0 = *(const GAS f32x4*)(rp + 16), s1 = *(const GAS f32x4*)(rp + 20);
                    const float cs[8] = {c0.x, c0.y, c0.z, c0.w, c1.x, c1.y, c1.z, c1.w}, sn[8] = {s0.x, s0.y, s0.z, s0.w, s1.x, s1.y, s1.z, s1.w};
#pragma unroll
                    for (int j = 0; j < 8; ++j) {
                        const float qp = (j & 1) ? __uint_as_float(qpw[j >> 1] & 0xffff0000u) : __uint_as_float(qpw[j >> 1] << 16);
                        const float kp = (j & 1) ? __uint_as_float(kpw[j >> 1] & 0xffff0000u) : __uint_as_float(kpw[j >> 1] << 16);
                        qv[j] = hi ? qp * sn[j] + qv[j] * cs[j] : qv[j] * cs[j] - qp * sn[j];
                        kv[j] = hi ? kp * sn[j] + kv[j] * cs[j] : kv[j] * cs[j] - kp * sn[j];
                    }
                }
#pragma unroll
                for (int j = 0; j < 8; ++j) qv[j] *= 0.125f;
            }
            u32x4 qo, ko; qo.x = pk2(qv[0], qv[1]); qo.y = pk2(qv[2], qv[3]); qo.z = pk2(qv[4], qv[5]); qo.w = pk2(qv[6], qv[7]);
            ko.x = pk2(kv[0], kv[1]); ko.y = pk2(kv[2], kv[3]); ko.z = pk2(kv[4], kv[5]); ko.w = pk2(kv[6], kv[7]);
            *(LAS u32x4*)(Qi + p * CH_PITCH + 16 * cq) = qo; *(LAS u32x4*)(Ki + p * CH_PITCH + 16 * cq) = ko; *(LAS u32x4*)(Vi + p * CH_PITCH + 16 * cq) = vraw;
        }
        } else {
            const GAS float* wq = mlc + h * 64 + 8 * cq;
            u32x4 rr[2][3][4], vr[4];
#pragma unroll
            for (int i4 = 0; i4 < 4; ++i4) {
                const int p = pr0 + 8 * (4 * hf + i4), tl = dir ? 63 - p : p, row = rowbase + tl, tpos = t0 + tl;
                const GAS bf16* bb = ML + (size_t)row * 1024 + h * 64 + 8 * cq;
                const u32x4 z4 = (u32x4){0u, 0u, 0u, 0u};
#pragma unroll
                for (int qk = 0; qk < 2; ++qk) {
                    rr[qk][1][i4] = *(const GAS u32x4*)(bb + 256 * qk);
                    rr[qk][0][i4] = tpos > 0 ? *(const GAS u32x4*)(bb + 256 * qk - 1024) : z4;
                    rr[qk][2][i4] = tpos < L - 1 ? *(const GAS u32x4*)(bb + 256 * qk + 1024) : z4;
                }
                vr[i4] = *(const GAS u32x4*)(bb + 512);
            }
#pragma unroll
            for (int qk = 0; qk < 2; ++qk) {
                f32x4 wt[3][2];
#pragma unroll
                for (int tp = 0; tp < 3; ++tp) { wt[tp][0] = *(const GAS f32x4*)(wq + 256 * qk + 512 * tp); wt[tp][1] = *(const GAS f32x4*)(wq + 256 * qk + 512 * tp + 4); }
#pragma unroll
                for (int i4 = 0; i4 < 4; ++i4) {
                    const int p = pr0 + 8 * (4 * hf + i4);
                    const unsigned a0[4] = {rr[qk][0][i4].x, rr[qk][0][i4].y, rr[qk][0][i4].z, rr[qk][0][i4].w}, a1[4] = {rr[qk][1][i4].x, rr[qk][1][i4].y, rr[qk][1][i4].z, rr[qk][1][i4].w},
                                   a2[4] = {rr[qk][2][i4].x, rr[qk][2][i4].y, rr[qk][2][i4].z, rr[qk][2][i4].w};
                    float ov[8];
#pragma unroll
                    for (int j = 0; j < 8; ++j) {
                        const float x0 = (j & 1) ? __uint_as_float(a0[j >> 1] & 0xffff0000u) : __uint_as_float(a0[j >> 1] << 16);
                        const float x1 = (j & 1) ? __uint_as_float(a1[j >> 1] & 0xffff0000u) : __uint_as_float(a1[j >> 1] << 16);
                        const float x2 = (j & 1) ? __uint_as_float(a2[j >> 1] & 0xffff0000u) : __uint_as_float(a2[j >> 1] << 16);
                        const float r = siluf_(wt[0][j >> 2][j & 3] * x0 + wt[1][j >> 2][j & 3] * x1 + wt[2][j >> 2][j & 3] * x2);
                        ov[j] = qk == 0 ? r : r * 0.125f;
                    }
                    u32x4 o; o.x = pk2(ov[0], ov[1]); o.y = pk2(ov[2], ov[3]); o.z = pk2(ov[4], ov[5]); o.w = pk2(ov[6], ov[7]);
                    if (qk == 0) *(LAS u32x4*)(Qi + p * CH_PITCH + 16 * cq) = o;
                    else { *(LAS u32x4*)(Ki + p * CH_PITCH + 16 * cq) = o; *(LAS u32x4*)(Vi + p * CH_PITCH + 16 * cq) = vr[i4]; }
                }
            }
        }
        __builtin_amdgcn_sched_barrier(0);
        float f_p, i_p;
        if (!IS_ML) { f_p = lgam; i_p = 0.f; }
        else { i_p = g_i + bi_; f_p = log_sigmoid_(g_f + bf_); }
        float bsum = f_p;
#pragma unroll
        for (int o = 1; o < 64; o <<= 1) { const float t = lane_read(bsum, lane >= o ? lane - o : lane); if (lane >= o) bsum += t; }
        LAS float* gv = (LAS float*)(img + 3 * CH_IMG);
        const float b63 = __int_as_float(__builtin_amdgcn_readlane(__float_as_int(bsum), 63));
        const float adec = __expf(b63);
        if (hf == 0) { gv[lane] = bsum; gv[64 + lane] = bsum - i_p; gv[128 + lane] = __expf(bsum); gv[192 + lane] = __expf(b63 - (bsum - i_p)); }
        asm volatile("s_waitcnt lgkmcnt(0)" ::: "memory");
        __syncthreads();
        const LAS float* gq = gv + 4 * fq;
        const bf16x8 ones = (fr == 0) ? (bf16x8){0x3F80, 0x3F80, 0x3F80, 0x3F80, 0x3F80, 0x3F80, 0x3F80, 0x3F80} : (bf16x8){0, 0, 0, 0, 0, 0, 0, 0};
        const int tr_q = fr >> 2, tr_p = fr & 3;
#pragma unroll 1
        for (int pt = 0; pt < 4; ++pt) {
            f32x4 ST[4];
            bf16x8 qn[2];
#pragma unroll
            for (int kk = 0; kk < 2; ++kk) qn[kk] = *(const LAS bf16x8*)(Qi + (16 * pt + fr) * CH_PITCH + (32 * kk + 8 * fq) * 2);
#pragma unroll
            for (int st = 0; st < 4; ++st) {
                ST[st] = (f32x4){0.f, 0.f, 0.f, 0.f};
                if (st <= pt) {
#pragma unroll
                    for (int kk = 0; kk < 2; ++kk) { const bf16x8 kf = *(const LAS bf16x8*)(Ki + (16 * st + fr) * CH_PITCH + (32 * kk + 8 * fq) * 2); ST[st] = __builtin_amdgcn_mfma_f32_16x16x32_bf16(kf, qn[kk], ST[st], 0, 0, 0); }
                }
            }
            const float bp = gv[16 * pt + fr];
#pragma unroll
            for (int st = 0; st < 4; ++st) {
                if (st <= pt) {
                    const f32x4 bis = *(const LAS f32x4*)(gq + 64 + 16 * st);
#pragma unroll
                    for (int j = 0; j < 4; ++j) { const int sidx = 16 * st + 4 * fq + j; const float w = (sidx <= 16 * pt + fr) ? __expf(bp - bis[j]) : 0.f; ST[st][j] *= w; }
                }
            }
            __builtin_amdgcn_sched_barrier(0);
            f32x4 acc[NET], accd = (f32x4){0.f, 0.f, 0.f, 0.f};
#pragma unroll
            for (int et = 0; et < NET; ++et) acc[et] = (f32x4){0.f, 0.f, 0.f, 0.f};
#pragma unroll
            for (int kk = 0; kk < 2; ++kk) {
                const u32x2 lo = *(const LAS u32x2*)(Qi + (16 * pt + fr) * CH_PITCH + (32 * kk + 4 * fq) * 2), hi = *(const LAS u32x2*)(Qi + (16 * pt + fr) * CH_PITCH + (32 * kk + 16 + 4 * fq) * 2);
                const bf16x8 qs = mk_frag(lo, hi);
#pragma unroll
                for (int et = 0; et < NET; ++et) {
                    u32x4 w; w.x = pk2(C[2 * kk][et].x, C[2 * kk][et].y); w.y = pk2(C[2 * kk][et].z, C[2 * kk][et].w); w.z = pk2(C[2 * kk + 1][et].x, C[2 * kk + 1][et].y); w.w = pk2(C[2 * kk + 1][et].z, C[2 * kk + 1][et].w);
                    acc[et] = __builtin_amdgcn_mfma_f32_16x16x32_bf16(qs, __builtin_bit_cast(bf16x8, w), acc[et], 0, 0, 0);
                }
                if (IS_ML) {
                    const f32x4 n0 = *(const LAS f32x4*)(nq + 32 * kk), n1 = *(const LAS f32x4*)(nq + 32 * kk + 16);
                    u32x4 w; w.x = pk2(n0.x, n0.y); w.y = pk2(n0.z, n0.w); w.z = pk2(n1.x, n1.y); w.w = pk2(n1.z, n1.w);
                    if (fr != 0) w = (u32x4){0u, 0u, 0u, 0u};
                    accd = __builtin_amdgcn_mfma_f32_16x16x32_bf16(qs, __builtin_bit_cast(bf16x8, w), accd, 0, 0, 0);
                }
            }
            { const f32x4 ap = *(const LAS f32x4*)(gq + 128 + 16 * pt);
#pragma unroll
              for (int j = 0; j < 4; ++j) {
#pragma unroll
                for (int et = 0; et < NET; ++et) acc[et][j] *= ap[j];
                accd[j] *= ap[j]; } }
            __builtin_amdgcn_sched_barrier(0);
#pragma unroll
            for (int kk = 0; kk < 2; ++kk) {
                if (2 * kk <= pt) {
                    u32x4 w; w.x = pk2(ST[2 * kk].x, ST[2 * kk].y); w.y = pk2(ST[2 * kk].z, ST[2 * kk].w); w.z = pk2(ST[2 * kk + 1].x, ST[2 * kk + 1].y); w.w = pk2(ST[2 * kk + 1].z, ST[2 * kk + 1].w);
                    const bf16x8 pf = __builtin_bit_cast(bf16x8, w);
                    u32x2 vlo[2], vhi[2];
                    ds_tr16x4(va + (32 * kk + 4 * fq + tr_q) * CH_PITCH + 8 * tr_p + 64 * hf, vlo, vhi);
#pragma unroll
                    for (int et = 0; et < NET; ++et) acc[et] = __builtin_amdgcn_mfma_f32_16x16x32_bf16(pf, mk_frag(vlo[et], vhi[et]), acc[et], 0, 0, 0);
                    if (IS_ML) accd = __builtin_amdgcn_mfma_f32_16x16x32_bf16(pf, ones, accd, 0, 0, 0);
                }
            }
            __builtin_amdgcn_sched_barrier(0);
#pragma unroll
            for (int j = 0; j < 4; ++j) {
                const int p = 16 * pt + 4 * fq + j, tl = dir ? 63 - p : p, row = rowbase + tl;
                float inv = 1.f;
                if (IS_ML) { const float den = lane_read(accd[j], lane & 48); inv = __builtin_amdgcn_rcpf(fmaxf(fabsf(den), 1.f)); }
                const int cof = (IS_ML ? 384 : 0) + h * 64 + 32 * hf + fr;
                const unsigned boff = dir == 0 ? (unsigned)(row * D + 384 + cof) * 2u : (unsigned)(row * 640 + cof) * 2u;
                GAS char* ob = dir == 0 ? (GAS char*)Y : (GAS char*)OB;
#pragma unroll
                for (int et = 0; et < NET; ++et) *(GAS bf16*)(ob + boff + 32 * et) = (bf16)f2bf(acc[et][j] * inv);
            }
        }
        __builtin_amdgcn_sched_barrier(0);
#pragma unroll
        for (int dt = 0; dt < 4; ++dt)
#pragma unroll
            for (int et = 0; et < NET; ++et) C[dt][et] *= adec;
        f32x4 accn[4];
        if (IS_ML) {
#pragma unroll
            for (int dt = 0; dt < 4; ++dt) { accn[dt] = *(const LAS f32x4*)(nq + 16 * dt) * adec; if (fr != 0) accn[dt] = (f32x4){0.f, 0.f, 0.f, 0.f}; }
        }
#pragma unroll
        for (int kk = 0; kk < 2; ++kk) {
            u32x2 vlo[2], vhi[2], klo[4], khi[4];
            ds_tr16x4(va + (32 * kk + 4 * fq + tr_q) * CH_PITCH + 8 * tr_p + 64 * hf, vlo, vhi);
            ds_tr16x8(ka + (32 * kk + 4 * fq + tr_q) * CH_PITCH + 8 * tr_p, klo, khi);
            const f32x4 wl = *(const LAS f32x4*)(gq + 192 + 32 * kk), wh = *(const LAS f32x4*)(gq + 192 + 32 * kk + 16);
#pragma unroll
            for (int dt = 0; dt < 4; ++dt) {
                u32x4 w;
                w.x = pk2(__uint_as_float(klo[dt].x << 16) * wl[0], __uint_as_float(klo[dt].x & 0xffff0000u) * wl[1]);
                w.y = pk2(__uint_as_float(klo[dt].y << 16) * wl[2], __uint_as_float(klo[dt].y & 0xffff0000u) * wl[3]);
                w.z = pk2(__uint_as_float(khi[dt].x << 16) * wh[0], __uint_as_float(khi[dt].x & 0xffff0000u) * wh[1]);
                w.w = pk2(__uint_as_float(khi[dt].y << 16) * wh[2], __uint_as_float(khi[dt].y & 0xffff0000u) * wh[3]);
                const bf16x8 kf = __builtin_bit_cast(bf16x8, w);
#pragma unroll
                for (int et = 0; et < NET; ++et) C[dt][et] = __builtin_amdgcn_mfma_f32_16x16x32_bf16(kf, mk_frag(vlo[et], vhi[et]), C[dt][et], 0, 0, 0);
                if (IS_ML) accn[dt] = __builtin_amdgcn_mfma_f32_16x16x32_bf16(kf, ones, accn[dt], 0, 0, 0);
            }
        }
        if (IS_ML) { if (fr == 0) {
#pragma unroll
            for (int dt = 0; dt < 4; ++dt) *(LAS f32x4*)(nvec + 4 * fq + 16 * dt) = accn[dt]; } }
        asm volatile("s_waitcnt lgkmcnt(0)" ::: "memory");
        __syncthreads();
    }
}

#ifndef FAST_CHAIN
#define FAST_CHAIN 1
#endif
constexpr int NCHWG = 160;
__device__ __forceinline__ void phase_mix(Frame& F, int layer) {
    const bool last = layer == 1;
    const GAS bf16* ftl = WSP(const bf16, WS_FTL) + (size_t)layer * 2 * 384 * 4096;
    if (FAST_CHAIN) {
        if (F.wg < NCHWG) {
            if (F.wave >= 4) {
#pragma unroll 1
                for (int i = 0; i < 72 * (F.wg * 2 < 192 ? REP_CH_RET : REP_CH_ML); ++i) __syncthreads();
            } else {
                const int cl = F.wave >> 1, hf = F.wave & 1, c = F.wg * 2 + cl;
                LAS unsigned char* img = F.lds + cl * CH_WAVE_LDS;
                {
                if (c < 192) { const int b = c / 12, r = c % 12; chain_fast<false>(F, layer, b, r >> 1, r & 1, img, hf); }
                else { const int i = c - 192; chain_fast<true>(F, layer, i >> 3, (i & 7) >> 1, i & 1, img, hf); }
                }
            }
        } else {
            const int nh = F.G - NCHWG, w = F.wg - NCHWG;
#ifndef FAST_HY
#define FAST_HY 1
#endif
            if (FAST_HY) {
#ifndef REP_HY
#define REP_HY 1
#endif
#pragma unroll 1
                for (int rp = 0; rp < REP_HY; ++rp)
                for (int u = w; u < 384; u += nh) hyena_unit_fast<LL>(F, layer, u, WSP(const bf16, WS_HYTL), ftl, WSP(bf16, WS_YHTL));
                if (!last) for (int u = w; u < 384; u += nh) hyena_unit_fast<LC>(F, layer, u, WSP(const bf16, WS_HYTC), WSP(const bf16, WS_FTC), WSP(bf16, WS_YHTC));
            } else {
                for (int u = w; u < 384; u += nh) hyena_unit_naive<LL>(F, layer, u, WSP(const bf16, WS_HYTL), ftl, WSP(bf16, WS_YHTL));
                if (!last) for (int u = w; u < 384; u += nh) hyena_unit_naive<LC>(F, layer, u, WSP(const bf16, WS_HYTC), WSP(const bf16, WS_FTC), WSP(bf16, WS_YHTC));
            }
        }
    } else {
        for (int u = F.wg; u < 384; u += F.G) hyena_unit_naive<LL>(F, layer, u, WSP(const bf16, WS_HYTL), ftl, WSP(bf16, WS_YHTL));
        if (!last) for (int u = F.wg; u < 384; u += F.G) hyena_unit_naive<LC>(F, layer, u, WSP(const bf16, WS_HYTC), WSP(const bf16, WS_FTC), WSP(bf16, WS_YHTC));
        for (int c = F.wg + F.wave * F.G; c < 320; c += F.G * NWAVES) chain_naive(F, layer, c);
    }
}

__device__ __forceinline__ void phase_combine(Frame& F, int layer, bool dummy = false) {
    const bool last = layer == 1;
    const int gw = F.wg * NWAVES + F.wave, NGW = F.G * NWAVES, lane = F.lane;
    const int nrows = last ? TOKL : TOK;
    GAS bf16* Y = WSP(bf16, WS_Y); const GAS bf16* OB = WSP(const bf16, WS_OB); const GAS bf16* RET = WSP(const bf16, WS_RET); const GAS bf16* ML = WSP(const bf16, WS_ML);
    const int rsub = lane >> 4, l16 = lane & 15;
    for (int row0 = gw * 4; row0 < nrows; row0 += NGW * 4) {
        const int row = row0 + rsub;
        GAS bf16* yo = dummy ? WSP(bf16, WS_U + 300 * MiB) + (size_t)(row & 8191) * D : Y + (size_t)row * D;
        u32x2 of[10], ob[10], gt[10];
#pragma unroll
        for (int hh = 0; hh < 10; ++hh) {
            const int cof = hh * 64 + 4 * l16;
            of[hh] = *(const GAS u32x2*)(Y + (size_t)row * D + 384 + cof); ob[hh] = *(const GAS u32x2*)(OB + (size_t)row * 640 + cof);
            gt[hh] = hh < 6 ? *(const GAS u32x2*)(RET + (size_t)row * 1536 + 1152 + cof) : *(const GAS u32x2*)(ML + (size_t)row * 1024 + 768 + (cof - 384));
        }
#pragma unroll
        for (int hh = 0; hh < 10; ++hh) {
            float x[4], g[4];
            x[0] = __uint_as_float(of[hh].x << 16) + __uint_as_float(ob[hh].x << 16); x[1] = __uint_as_float(of[hh].x & 0xffff0000u) + __uint_as_float(ob[hh].x & 0xffff0000u);
            x[2] = __uint_as_float(of[hh].y << 16) + __uint_as_float(ob[hh].y << 16); x[3] = __uint_as_float(of[hh].y & 0xffff0000u) + __uint_as_float(ob[hh].y & 0xffff0000u);
            g[0] = __uint_as_float(gt[hh].x << 16); g[1] = __uint_as_float(gt[hh].x & 0xffff0000u); g[2] = __uint_as_float(gt[hh].y << 16); g[3] = __uint_as_float(gt[hh].y & 0xffff0000u);
            float sm = (x[0] + x[1]) + (x[2] + x[3]);
            DPP_ADD(sm, 0xB1); DPP_ADD(sm, 0x4E); DPP_ADD(sm, 0x141); DPP_ADD(sm, 0x140);
            const float mu = sm * (1.f / 64.f);
#pragma unroll
            for (int j = 0; j < 4; ++j) x[j] -= mu;
            float sq = (x[0] * x[0] + x[1] * x[1]) + (x[2] * x[2] + x[3] * x[3]);
            DPP_ADD(sq, 0xB1); DPP_ADD(sq, 0x4E); DPP_ADD(sq, 0x141); DPP_ADD(sq, 0x140);
            const float rs = rsqrtf(sq * (1.f / 64.f) + 1e-6f);
            float o[4];
#pragma unroll
            for (int j = 0; j < 4; ++j) o[j] = x[j] * rs * (hh < 6 ? siluf_(g[j]) : sigmoidf_(g[j]));
            u32x2 w; w.x = pk2(o[0], o[1]); w.y = pk2(o[2], o[3]);
            *(GAS u32x2*)(yo + 384 + hh * 64 + 4 * l16) = w;
        }
    }
    LAS unsigned char* scr = F.lds + F.wave * 8704;
    const int nitL = NB * 6 * 32, nitC = last ? 0 : NB * 6 * 4;
    for (int it = gw; it < nitL + nitC; it += NGW) {
        const GAS bf16* src; int L, rowbase, b, cb, tb;
        if (it < nitL) { b = it / 192; const int r = it % 192; cb = r / 32; tb = r % 32; L = LL; src = WSP(const bf16, WS_YHTL); rowbase = b * LL; }
        else { const int i2 = it - nitL; b = i2 / 24; const int r = i2 % 24; cb = r / 4; tb = r % 4; L = LC; src = WSP(const bf16, WS_YHTC); rowbase = TOKL + b * LC; }
        u32x4 v[8];
#pragma unroll
        for (int i = 0; i < 8; ++i) { const int cc = (lane >> 3) + 8 * i; v[i] = *(const GAS u32x4*)(src + ((size_t)(b * 384 + cb * 64 + cc)) * L + tb * 64 + 8 * (lane & 7)); }
#pragma unroll
        for (int i = 0; i < 8; ++i) { const int cc = (lane >> 3) + 8 * i; *(LAS u32x4*)(scr + cc * 136 + 16 * (lane & 7)) = v[i]; }
        asm volatile("s_waitcnt lgkmcnt(0)" ::: "memory");
#pragma unroll
        for (int i = 0; i < 8; ++i) {
            const int tt = (lane >> 3) + 8 * i, c8 = 8 * (lane & 7);
            unsigned short e[8];
#pragma unroll
            for (int j = 0; j < 8; ++j) e[j] = *(const LAS unsigned short*)(scr + (c8 + j) * 136 + tt * 2);
            u32x4 o; o.x = e[0] | ((unsigned)e[1] << 16); o.y = e[2] | ((unsigned)e[3] << 16); o.z = e[4] | ((unsigned)e[5] << 16); o.w = e[6] | ((unsigned)e[7] << 16);
            *(GAS u32x4*)((dummy ? WSP(bf16, WS_U + 300 * MiB) : Y) + (size_t)(dummy ? ((rowbase + tb * 64 + tt) & 8191) : (rowbase + tb * 64 + tt)) * D + cb * 64 + c8) = o;
        }
        asm volatile("s_waitcnt lgkmcnt(0)" ::: "memory");
    }
}

__device__ __forceinline__ void phase_norm_router(Frame& F) {
    const int gw = F.wg * NWAVES + F.wave, NGW = F.G * NWAVES, lane = F.lane;
    const GAS float* g = inp(F, I_GFFN) + 1 * D; const GAS float* wr = inp(F, I_ROUTER); const GAS float* br = inp(F, I_ROUTERB);
    GAS unsigned* cnt = WSP(unsigned, WS_CTL) + CW_CNT;
#pragma unroll 2
    for (int row = gw; row < TOKL; row += NGW) {
        float keep[16];
        norm_mod_row(xrow_ptr(F, row, false), g, mod_ptr(F, 1, row, 3), mod_ptr(F, 1, row, 4), WSP(bf16, WS_H) + (size_t)row * D, lane, keep);
        float lg[8];
#pragma unroll
        for (int e = 0; e < 8; ++e) lg[e] = 0.f;
#pragma unroll
        for (int j = 0; j < 4; ++j)
#pragma unroll
            for (int i = 0; i < 4; ++i) { const int k = 256 * j + 4 * lane + i; const f32x4 w0 = *(const GAS f32x4*)(wr + k * 8), w1 = *(const GAS f32x4*)(wr + k * 8 + 4); const float x = keep[4 * j + i];
                lg[0] += x * w0.x; lg[1] += x * w0.y; lg[2] += x * w0.z; lg[3] += x * w0.w; lg[4] += x * w1.x; lg[5] += x * w1.y; lg[6] += x * w1.z; lg[7] += x * w1.w; }
#pragma unroll
        for (int e = 0; e < 8; ++e) lg[e] = wave_sum(lg[e]) + br[e];
        int e0 = 0; float v0 = lg[0];
#pragma unroll
        for (int e = 1; e < 8; ++e) if (lg[e] > v0) { v0 = lg[e]; e0 = e; }
        int e1 = -1; float v1 = -3.0e38f;
#pragma unroll
        for (int e = 0; e < 8; ++e) if (e != e0 && lg[e] > v1) { v1 = lg[e]; e1 = e; }
        const float w1 = 1.f / (1.f + __expf(v0 - v1)), w0 = 1.f - w1;
        if (lane == 0) {
            const unsigned p0 = __hip_atomic_fetch_add(cnt + e0, 1u, __ATOMIC_RELAXED, __HIP_MEMORY_SCOPE_AGENT), p1 = __hip_atomic_fetch_add(cnt + e1, 1u, __ATOMIC_RELAXED, __HIP_MEMORY_SCOPE_AGENT);
            WSP(int, WS_TOPE)[row * 2] = e0; WSP(int, WS_TOPE)[row * 2 + 1] = e1;
            WSP(float, WS_TOPW)[row * 2] = w0; WSP(float, WS_TOPW)[row * 2 + 1] = w1;
            WSP(int, WS_TOPP)[row * 2] = (int)p0; WSP(int, WS_TOPP)[row * 2 + 1] = (int)p1;
        }
    }
}
__device__ __forceinline__ void phase_route_tables(Frame& F) {
    const GAS unsigned* cnt = WSP(const unsigned, WS_CTL) + CW_CNT;
    int off[9]; off[0] = 0;
#pragma unroll
    for (int e = 0; e < 8; ++e) { const int c = (int)__hip_atomic_load(cnt + e, __ATOMIC_RELAXED, __HIP_MEMORY_SCOPE_AGENT); off[e + 1] = off[e] + ((c + 255) >> 8) * 256; }
    const int gt = F.wg * NTHR + F.tid, NGT = F.G * NTHR;
    GAS int* rowidx = WSP(int, WS_ROWIDX); GAS int* slot = WSP(int, WS_SLOT); GAS int* tilee = WSP(int, WS_TILEE);
    for (int i = gt; i < MAXTILES * 256; i += NGT) {
        int e = 0;
#pragma unroll
        for (int q = 1; q < 8; ++q) if (i >= off[q]) e = q;
        const int c = (int)cnt[e];
        if (i >= off[8] || i - off[e] >= c) rowidx[i] = 0;
    }
    for (int i = gt; i < TOKL * 2; i += NGT) {
        const int e = WSP(const int, WS_TOPE)[i], pos = WSP(const int, WS_TOPP)[i];
        int o = 0;
#pragma unroll
        for (int q = 0; q < 8; ++q) if (e == q) o = off[q];
        const int s = o + pos; slot[i] = s; rowidx[s] = i >> 1;
    }
    for (int i = gt; i < MAXTILES + 1; i += NGT) {
        if (i == MAXTILES) tilee[MAXTILES] = off[8] >> 8;
        else { int e = 0;
#pragma unroll
            for (int q = 1; q < 8; ++q) if (i * 256 >= off[q]) e = q;
            tilee[i] = e; }
    }
}

__device__ __forceinline__ void moe_pass_gemm1_fast(Frame& F, int t0, int t1) {
    pg8::OrderMoe S; S.o.init(t1 - t0, NFF1 / 256, F.G, F.wg); S.rowidx = WSP(const int, WS_ROWIDX); S.tilee = WSP(const int, WS_TILEE); S.t0 = t0; S.bstride = (size_t)NFF1 * D; S.gather = true;
    EpiSwiglu E{WSP(bf16, WS_MACT), 0};
    pg8::gemm_phase(F.lds, F.tid, WSP(const bf16, WS_H), D, WSP(const bf16, WS_MW13), D, D, S, E);
}
__device__ __forceinline__ void moe_pass_gemm2_fast(Frame& F, int t0, int t1) {
    pg8::OrderMoe S; S.o.init(t1 - t0, D / 256, F.G, F.wg); S.rowidx = WSP(const int, WS_ROWIDX); S.tilee = WSP(const int, WS_TILEE); S.t0 = t0; S.bstride = (size_t)D * DFF; S.gather = false;
    EpiBf16Out E{WSP(bf16, WS_EOUT), D, t0 * 256};
    pg8::gemm_phase(F.lds, F.tid, WSP(const bf16, WS_MACT), DFF, WSP(const bf16, WS_MW2), DFF, DFF, S, E);
}
__device__ __forceinline__ void phase_final(Frame& F, GAS float* dummy = nullptr) {
    const int gw = F.wg * NWAVES + F.wave, NGW = F.G * NWAVES, lane = F.lane;
    const GAS float* gf = inp(F, I_GFINAL); const GAS bf16* eo = WSP(const bf16, WS_EOUT);
#pragma unroll 2
    for (int row = gw; row < TOKL; row += NGW) {
        const int s0 = WSP(const int, WS_SLOT)[row * 2], s1 = WSP(const int, WS_SLOT)[row * 2 + 1];
        const float w0 = WSP(const float, WS_TOPW)[row * 2], w1 = WSP(const float, WS_TOPW)[row * 2 + 1];
        const GAS float* m5 = mod_ptr(F, 1, row, 5);
        GAS float* xr = outp(F) + (size_t)row * D;
        f32x4 v[4]; float s = 0.f;
#pragma unroll
        for (int j = 0; j < 4; ++j) {
            const int c = 256 * j + 4 * lane;
            const f32x4 a = ld_bf16x4(eo + (size_t)s0 * D + c), b = ld_bf16x4(eo + (size_t)s1 * D + c), m = *(const GAS f32x4*)(m5 + c);
            v[j] = *(const GAS f32x4*)(xr + c) + m * (a * w0 + b * w1);
            s += (v[j].x * v[j].x + v[j].y * v[j].y) + (v[j].z * v[j].z + v[j].w * v[j].w);
        }
        const float r = rsqrtf(wave_sum(s) * (1.f / 1024.f) + 1e-6f);
#pragma unroll
        for (int j = 0; j < 4; ++j) { const int c = 256 * j + 4 * lane; const f32x4 g = *(const GAS f32x4*)(gf + c); GAS float* o_ = dummy ? dummy + (size_t)(row & 8191) * D : xr; *(GAS f32x4*)(o_ + c) = v[j] * r * g; }
    }
}

#ifndef REP_WIN
#define REP_WIN 1
#endif
#ifndef REP_MIX
#define REP_MIX 1
#endif
#ifndef REP_GATE
#define REP_GATE 1
#endif
#ifndef REP_UP
#define REP_UP 1
#endif
#ifndef REP_FFN1
#define REP_FFN1 1
#endif
#ifndef REP_MOE
#define REP_MOE 1
#endif
#ifndef REP_NORM
#define REP_NORM 1
#endif
#ifndef REP_P0
#define REP_P0 1
#endif
__global__ void __launch_bounds__(NTHR, 2) hybrid_fwd(Params prm) {
    extern __shared__ __attribute__((aligned(16))) unsigned char lds_raw[];
    Frame F;
    F.lds = (LAS unsigned char*)lds_raw; F.ws = (GAS unsigned char*)prm.ws;
    F.tid = threadIdx.x; F.lane = F.tid & 63; F.wave = __builtin_amdgcn_readfirstlane(F.tid >> 6); F.G = gridDim.x; F.wg = blockIdx.x;
    volatile LAS unsigned* MISC = (volatile LAS unsigned*)(F.lds + MISC_OFF);
    if (F.tid < 64) MISC[F.tid] = 0u;
    if (F.tid < 33) { const unsigned long long v = F.tid < 32 ? (unsigned long long)prm.in[F.tid] : (unsigned long long)prm.out; *(LAS unsigned long long*)(F.lds + PTAB_OFF + 8 * F.tid) = v; }
    __syncthreads();
    XcdBarrier bar = xcd_barrier_post(WSP(unsigned, WS_CTL) + CW_BAR, MISC + 8);
#define RELAUNDER() do { { unsigned long long _w = (unsigned long long)F.ws; asm volatile("" : "+s"(_w)); F.ws = (GAS unsigned char*)_w; } \
        { unsigned _t = (unsigned)F.tid; asm volatile("" : "+v"(_t)); F.tid = (int)_t; F.lane = F.tid & 63; F.wave = __builtin_amdgcn_readfirstlane(F.tid >> 6); } \
        { unsigned _g = (unsigned)F.G, _b = (unsigned)F.wg; asm volatile("" : "+s"(_g), "+s"(_b)); F.G = (int)_g; F.wg = (int)_b; } \
        { unsigned _l = (unsigned)(size_t)F.lds; asm volatile("" : "+s"(_l)); F.lds = (LAS unsigned char*)(size_t)_l; } } while (0)
#define GRID_BAR() do { { unsigned long long _b = (unsigned long long)bar.bar; unsigned _x = bar.x; asm volatile("" : "+s"(_b), "+s"(_x)); bar.bar = (GAS unsigned*)_b; bar.x = _x; } xcd_barrier(bar); RELAUNDER(); } while (0)

    for (int rp = 0; rp < REP_P0; ++rp) { phase_p0(F); write_bias(F);
    GRID_BAR(); }
#pragma unroll 1
    for (int layer_ = 0; layer_ < 2; ++layer_) {
        int layer = layer_;
#define last (layer == 1)
#define rows_all TOK
#define rows_out (last ? TOKL : TOK)
#define modbase (WSP(const float, WS_MOD) + (size_t)layer * 17 * 6144)
#define LAYER_LAUNDER() asm volatile("" : "+s"(layer))
        for (int rp = 0; rp < REP_NORM; ++rp) { phase_norm(F, layer, rows_all, !last, 0);
        if (layer == 0) { const int gw = F.wg * NWAVES + F.wave, NGW = F.G * NWAVES;
            for (int it = gw; it < 1536 + 96; it += NGW) filter_out_item(F, it); }
        { GRID_BAR(); LAYER_LAUNDER(); } }
        for (int rp = 0; rp < REP_WIN; ++rp) {
        { EpiWin E{WSP(const float, WS_BIAS) + layer * NWP, WSP(bf16, WS_HYTL), WSP(bf16, WS_HYTC), WSP(bf16, WS_RET), WSP(bf16, WS_ML), WSP(float, WS_MLG)};
          if (last) { pg8::OrderWinL1 S; S.init(F.G, F.wg); pg8::gemm_phase(F.lds, F.tid, WSP(const bf16, WS_H), D, WSP(const bf16, WS_WIN), D, D, S, E); }
          else gemm_fast(F, WSP(const bf16, WS_H), D, WSP(const bf16, WS_WIN), D, D, rows_all, NW1, E); }
        { GRID_BAR(); LAYER_LAUNDER(); } }
        for (int rp = 0; rp < REP_MIX; ++rp) { phase_mix(F, layer);
        { GRID_BAR(); LAYER_LAUNDER(); } }
#ifndef REP_COMB
#define REP_COMB 1
#endif
        for (int rp = REP_COMB - 1; rp > 0; --rp) { phase_combine(F, layer, true); { GRID_BAR(); LAYER_LAUNDER(); } }
        phase_combine(F, layer);
        { GRID_BAR(); LAYER_LAUNDER(); }
        for (int rp = 0; rp < REP_GATE; ++rp) {
        { EpiGate E{WSP(const float, WS_BIAS) + layer * NWP + NW1, WSP(bf16, WS_GATES)};
          gemm_fast(F, WSP(const bf16, WS_H), D, WSP(const bf16, WS_WIN) + (size_t)NW1 * D, D, D, rows_out, NGATE, E); }
        { GRID_BAR(); LAYER_LAUNDER(); } }
        for (int rp = 0; rp < REP_UP; ++rp) {
        { EpiUp E{WSP(const bf16, WS_GATES), WSP(bf16, WS_H)};
          gemm_fast(F, WSP(const bf16, WS_Y), D, WSP(const bf16, WS_WUP), D, D, rows_out, D, E); }
        { GRID_BAR(); LAYER_LAUNDER(); } }
#ifndef REP_OUT
#define REP_OUT 1
#endif
        for (int rp = REP_OUT - 1; rp >= 0; --rp) {
        { EpiResid E{last ? outp(F) : inp(F, I_X), last ? WSP(const float, WS_XC) : inp(F, I_CTX), outp(F), WSP(float, WS_XC), modbase, 2, rp ? WSP(float, WS_U + 300 * MiB) : (GAS float*)nullptr};
          gemm_fast(F, WSP(const bf16, WS_H), D, WSP(const bf16, WS_WOUT), D, D, rows_out, D, E); }
        if (rp) { GRID_BAR(); LAYER_LAUNDER(); } }
        { GRID_BAR(); LAYER_LAUNDER(); }
        if (!last) {
            phase_norm(F, layer, rows_out, false, 3);
            { const int gw = F.wg * NWAVES + F.wave, NGW = F.G * NWAVES; LAS float* scr = (LAS float*)(F.lds + F.wave * 8704);
              conv_weights_ffn(inp(F, I_FW1), inp(F, I_FW3), inp(F, I_FW2), WSP(bf16, WS_W13), WSP(bf16, WS_W2), gw, NGW, scr, F.lane);
              conv_weights_win(F, 1, gw, NGW, scr);
              conv_weights_upout(F, 1, gw, NGW, scr); }
            { GRID_BAR(); LAYER_LAUNDER(); }
            for (int rp = 0; rp < REP_FFN1; ++rp) {
            { EpiSwiglu E{WSP(bf16, WS_ACT), 0};
              gemm_fast(F, WSP(const bf16, WS_H), D, WSP(const bf16, WS_W13), D, D, rows_out, NFF1, E); }
            { GRID_BAR(); LAYER_LAUNDER(); } }
#ifndef REP_FFN2
#define REP_FFN2 1
#endif
            for (int rp = REP_FFN2 - 1; rp >= 0; --rp) {
            { EpiResid E{outp(F), WSP(const float, WS_XC), outp(F), WSP(float, WS_XC), modbase, 5, rp ? WSP(float, WS_U + 300 * MiB) : (GAS float*)nullptr};
              gemm_fast(F, WSP(const bf16, WS_ACT), DFF, WSP(const bf16, WS_W2), DFF, DFF, rows_out, D, E); }
            if (rp) { GRID_BAR(); LAYER_LAUNDER(); } }
            { GRID_BAR(); LAYER_LAUNDER(); }
        }
    }
#undef LAYER_LAUNDER
#undef last
#undef rows_all
#undef rows_out
#undef modbase
    phase_norm_router(F);
    { const int gw = F.wg * NWAVES + F.wave, NGW = F.G * NWAVES; LAS float* scr = (LAS float*)(F.lds + F.wave * 8704);
#ifndef REP_MCONV
#define REP_MCONV 1
#endif
#pragma unroll 1
      for (int e = 0; e < NE * REP_MCONV; ++e)
          conv_weights_ffn(inp(F, I_MW1) + (size_t)(e % NE) * D * DFF, inp(F, I_MW3) + (size_t)(e % NE) * D * DFF, inp(F, I_MW2) + (size_t)(e % NE) * DFF * D,
                           WSP(bf16, WS_MW13) + (size_t)(e % NE) * NFF1 * D, WSP(bf16, WS_MW2) + (size_t)(e % NE) * D * DFF, gw, NGW, scr, F.lane); }
    GRID_BAR();
    phase_route_tables(F);
    GRID_BAR();
    const int ntiles = __builtin_amdgcn_readfirstlane(WSP(const int, WS_TILEE)[MAXTILES]);
#pragma unroll 1
    for (int p = 0; p < NPASS; ++p) {
        const int t0 = p * PASS_TILES, t1 = min(ntiles, t0 + PASS_TILES);
        for (int rp = 0; rp < REP_MOE; ++rp) {
        if (t0 < t1) moe_pass_gemm1_fast(F, t0, t1);
        GRID_BAR();
        if (t0 < t1) moe_pass_gemm2_fast(F, t0, t1);
        GRID_BAR(); }
    }
#ifndef REP_BAR
#define REP_BAR 0
#endif
    for (int rb = 0; rb < REP_BAR; ++rb) GRID_BAR();
#ifndef REP_FINAL
#define REP_FINAL 1
#endif
    for (int rp = REP_FINAL - 1; rp > 0; --rp) { phase_final(F, WSP(float, WS_U + 300 * MiB)); GRID_BAR(); }
    phase_final(F);
}

extern "C" void kernel_launch(void* const* d_in, const int* in_sizes, int n_in, void* d_out, int out_size, void* d_ws, size_t ws_size, hipStream_t stream) {
    static int grid = 0;
    if (grid == 0) {
        if (n_in != 32 || out_size != TOKL * D || ws_size < WS_END) { fprintf(stderr, "kernel_launch: unexpected arguments (n_in %d, out %d, ws %zu)\n", n_in, out_size, ws_size); grid = -1; return; }
        int dev = 0, cus = 0;
        if (hipGetDevice(&dev) != hipSuccess || hipDeviceGetAttribute(&cus, hipDeviceAttributeMultiprocessorCount, dev) != hipSuccess) { grid = -1; return; }
        if (hipFuncSetAttribute((const void*)hybrid_fwd, hipFuncAttributeMaxDynamicSharedMemorySize, LDS_BYTES) != hipSuccess) { grid = -1; return; }
        int per_cu = 0;
        (void)hipOccupancyMaxActiveBlocksPerMultiprocessor(&per_cu, (const void*)hybrid_fwd, NTHR, LDS_BYTES);
        (void)hipGetLastError();
        grid = cus;
    }
    if (grid < 0) return;
    (void)hipMemsetAsync((char*)d_ws + WS_CTL, 0, CTL_ZERO_BYTES, stream);
    Params p{};
    for (int i = 0; i < 32; ++i) p.in[i] = (const float*)d_in[i];
    p.out = (float*)d_out; p.ws = (unsigned char*)d_ws;
    hipLaunchKernelGGL(hybrid_fwd, dim3(grid), dim3(NTHR), LDS_BYTES, stream, p);
}
```

```cpp
#include <hip/hip_runtime.h>
#include <stdint.h>
#include <stdio.h>

#define LAS __attribute__((address_space(3)))
#define GAS __attribute__((address_space(1)))
typedef unsigned short bf16;
typedef short bf16x8 __attribute__((ext_vector_type(8)));
typedef float f32x4 __attribute__((ext_vector_type(4)));
typedef unsigned u32x4 __attribute__((ext_vector_type(4)));
typedef unsigned u32x2 __attribute__((ext_vector_type(2)));

constexpr int D = 1024, NB = 16, LL = 2048, LC = 256;
constexpr int TOKL = NB * LL, TOKC = NB * LC, TOK = TOKL + TOKC;
constexpr int HYW = 384, RETW = 384, MLW = 256;
constexpr int NIN = 6800, NW1 = 3840, NGATE = 3072, NWP = 6912;
constexpr int DFF = 2816, NFF1 = 5632, NE = 8;
constexpr int NWAVES = 8, NTHR = 512;
constexpr int MAXTILES = 272, PASS_TILES = 58, NPASS = 5;

constexpr size_t MiB = 1u << 20;
constexpr size_t WS_CTL = 0, CTL_ZERO_BYTES = 1 * MiB;
constexpr size_t WS_MOD = 1 * MiB;
constexpr size_t WS_BIAS = 2 * MiB;
constexpr size_t WS_ROPE = 2 * MiB + 256 * 1024;
constexpr size_t WS_TOPE = 3 * MiB;
constexpr size_t WS_TOPW = 3 * MiB + 256 * 1024;
constexpr size_t WS_TOPP = 3 * MiB + 512 * 1024;
constexpr size_t WS_SLOT = 3 * MiB + 768 * 1024;
constexpr size_t WS_ROWIDX = 4 * MiB;
constexpr size_t WS_TILEE = 4 * MiB + 512 * 1024;
constexpr size_t WS_FTL = 5 * MiB;
constexpr size_t WS_FTC = 17 * MiB;
constexpr size_t WS_WIN = 18 * MiB;
constexpr size_t WS_WUP = 32 * MiB;
constexpr size_t WS_WOUT = 34 * MiB;
constexpr size_t WS_XC = 36 * MiB;
constexpr size_t WS_H = 52 * MiB;
constexpr size_t WS_Y = 124 * MiB;
constexpr size_t WS_U = 196 * MiB;
constexpr size_t WS_RET = WS_U;
constexpr size_t WS_ML = WS_U + 108 * MiB;
constexpr size_t WS_MLG = WS_U + 180 * MiB;
constexpr size_t WS_OB = WS_U + 183 * MiB;
constexpr size_t WS_YHTL = WS_U + 228 * MiB;
constexpr size_t WS_YHTC = WS_U + 252 * MiB;
constexpr size_t WS_HYTL = WS_U + 255 * MiB;
constexpr size_t WS_HYTC = WS_U + 327 * MiB;
constexpr size_t WS_XL2 = WS_U + 284 * MiB;
constexpr size_t WS_END = WS_U + 348 * MiB;
constexpr size_t WS_GATES = WS_U;
constexpr size_t WS_ACT = WS_U;
constexpr size_t WS_W13 = WS_U + 204 * MiB;
constexpr size_t WS_W2 = WS_U + 216 * MiB;
constexpr size_t WS_MW13 = WS_Y;
constexpr size_t WS_MW2 = WS_Y + 88 * MiB;
constexpr size_t WS_MACT = WS_Y + 132 * MiB;
constexpr size_t WS_EOUT = WS_Y + 220 * MiB;
static_assert(WS_EOUT + (size_t)MAXTILES * 256 * 1024 * 2 <= WS_XL2, "map");
static_assert(WS_GATES + (size_t)TOK * NGATE * 2 <= WS_YHTL, "gates overlay");

constexpr int CW_BAR = 4096;
constexpr int CW_CNT = 16384;

constexpr int LDS_BYTES = 147456;
constexpr int MISC_OFF = 147456 - 256;

__device__ __forceinline__ float bf2f(bf16 b) { return __uint_as_float(((unsigned)b) << 16); }
typedef __bf16 bf2v_ __attribute__((ext_vector_type(2)));
typedef float f2v_ __attribute__((ext_vector_type(2)));
__device__ __forceinline__ unsigned pk2(float lo, float hi) { const f2v_ f = {lo, hi}; return __builtin_bit_cast(unsigned, __builtin_convertvector(f, bf2v_)); }
__device__ __forceinline__ unsigned f2bf(float f) { return pk2(f, 0.f) & 0xffffu; }
__device__ __forceinline__ float dpp_f(float v, int) { return v; }
#define DPP_ADD(v, ctrl) (v) += __int_as_float(__builtin_amdgcn_update_dpp(0, __float_as_int(v), (ctrl), 0xf, 0xf, true))
__device__ __forceinline__ float wave_sum(float v) {
    DPP_ADD(v, 0xB1);
    DPP_ADD(v, 0x4E);
    DPP_ADD(v, 0x141);
    DPP_ADD(v, 0x140);
    return __int_as_float(__builtin_amdgcn_readlane(__float_as_int(v), 0)) + __int_as_float(__builtin_amdgcn_readlane(__float_as_int(v), 16))
         + __int_as_float(__builtin_amdgcn_readlane(__float_as_int(v), 32)) + __int_as_float(__builtin_amdgcn_readlane(__float_as_int(v), 48));
}
__device__ __forceinline__ float lane_read(float v, int src_lane) { return __int_as_float(__builtin_amdgcn_ds_bpermute(src_lane << 2, __float_as_int(v))); }
__device__ __forceinline__ float sigmoidf_(float x) { return __builtin_amdgcn_rcpf(1.0f + __expf(-x)); }
__device__ __forceinline__ float siluf_(float x) { return x * __builtin_amdgcn_rcpf(1.0f + __expf(-x)); }

#define XB_TMO      128
#define XB_XCNT(j)  (256  + 64 * (j))
#define XB_XSUB(j)  (1280 + 64 * (j))
#define XB_XGEN(j)  (2304 + 64 * (j))
#define XB_TOP      3328
#define XB_TOPGEN   3392
#define XCD_BAR_WORDS 3456
#define XB_SPIN_CAP (1u << 22)
__device__ __forceinline__ unsigned xb_ld(GAS unsigned* p)              { return __hip_atomic_load(p, __ATOMIC_RELAXED, __HIP_MEMORY_SCOPE_AGENT); }
__device__ __forceinline__ unsigned xb_add(GAS unsigned* p, unsigned v) { return __hip_atomic_fetch_add(p, v, __ATOMIC_RELAXED, __HIP_MEMORY_SCOPE_AGENT); }
__device__ __forceinline__ unsigned xb_xcc_id() { return (unsigned)__builtin_amdgcn_s_getreg((3 << 11) | 20) & 0xFu; }
#ifndef XB_SLEEP
#define XB_SLEEP 0
#endif
#define XB_SPIN(cond, bar) do { unsigned _sp = 0; while (cond) { if (XB_SLEEP) __builtin_amdgcn_s_sleep(1); \
    if ((++_sp & 255u) == 0u) { if (xb_ld(&(bar)[XB_TMO])) break; if (_sp > XB_SPIN_CAP) { (void)__hip_atomic_fetch_add(&(bar)[XB_TMO], 1u, __ATOMIC_RELAXED, __HIP_MEMORY_SCOPE_AGENT); break; } } } } while (0)
struct XcdBarrier { GAS unsigned* bar; unsigned x; volatile LAS unsigned* st; };
__device__ __forceinline__ XcdBarrier xcd_barrier_post(GAS unsigned* bar, volatile LAS unsigned* st) {
    XcdBarrier b; b.bar = bar; b.x = xb_xcc_id(); b.st = st;
    if (threadIdx.x == 0) (void)xb_add(&bar[XB_XCNT(b.x)], 1u);
    return b;
}
__device__ __forceinline__ void xcd_barrier_complete(GAS unsigned* bar, unsigned x, unsigned& nloc, unsigned& nx) {
    const unsigned G = gridDim.x * gridDim.y * gridDim.z;
    unsigned sum, cnt, mine, sp = 0u;
    for (;;) {
        sum = 0u; cnt = 0u; mine = 0u;
#pragma unroll 1
        for (unsigned j = 0; j < 16; ++j) { const unsigned c = xb_ld(&bar[XB_XCNT(j)]); sum += c; cnt += (c > 0u) ? 1u : 0u; }
        mine = xb_ld(&bar[XB_XCNT(x)]);
        if (sum == G) break;
        __builtin_amdgcn_s_sleep(1);
        if ((++sp & 255u) == 0u) { if (xb_ld(&bar[XB_TMO])) break; if (sp > XB_SPIN_CAP) { (void)__hip_atomic_fetch_add(&bar[XB_TMO], 1u, __ATOMIC_RELAXED, __HIP_MEMORY_SCOPE_AGENT); break; } }
    }
    nloc = mine > 0u ? mine : 1u; nx = cnt > 0u ? cnt : 1u;
}
__device__ __forceinline__ void xcd_barrier(const XcdBarrier& b) {
    asm volatile("s_waitcnt vmcnt(0)" ::: "memory");
    __syncthreads();
    if (threadIdx.x == 0) {
        GAS unsigned* bar = b.bar;
        __builtin_amdgcn_s_waitcnt(0);
        unsigned nloc = b.st[0], nx = b.st[1];
        if (nloc == 0u) { xcd_barrier_complete(bar, b.x, nloc, nx); b.st[0] = nloc; b.st[1] = nx; }
        const unsigned old = xb_add(&bar[XB_XSUB(b.x)], 1u);
        const unsigned gen = old / nloc;
        if (old + 1u == (gen + 1u) * nloc) {
            __builtin_amdgcn_fence(__ATOMIC_RELEASE, "agent");
            asm volatile("s_waitcnt vmcnt(0)" ::: "memory");
            const unsigned og = xb_add(&bar[XB_TOP], 1u);
            const unsigned tg = og / nx;
            if (og + 1u == (tg + 1u) * nx) xb_add(&bar[XB_TOPGEN], 1u);
            else XB_SPIN(xb_ld(&bar[XB_TOPGEN]) == tg, bar);
            __builtin_amdgcn_fence(__ATOMIC_ACQUIRE, "agent");
            xb_add(&bar[XB_XGEN(b.x)], 1u);
            asm volatile("s_waitcnt vmcnt(0)" ::: "memory");
        } else {
            XB_SPIN(xb_ld(&bar[XB_XGEN(b.x)]) == gen, bar);
            __builtin_amdgcn_fence(__ATOMIC_ACQUIRE, "agent");
            asm volatile("s_waitcnt vmcnt(0)" ::: "memory");
        }
    }
    __syncthreads();
}

struct Params { const float* in[32]; float* out; unsigned char* ws; };
enum { I_X = 0, I_C, I_CTX, I_CCTX, I_WMOD, I_BMOD, I_GMIX, I_GFFN, I_WIN, I_BIN, I_HYCONV, I_HYF1, I_HYFB1, I_HYF2, I_HYFB2, I_HYF3, I_HYDECAY,
       I_HYSKIP, I_RETDECAY, I_MLCONV, I_MLGB, I_WUP, I_WOUT, I_FW1, I_FW3, I_FW2, I_ROUTER, I_ROUTERB, I_MW1, I_MW3, I_MW2, I_GFINAL };

struct Frame {
    LAS unsigned char* lds;
    GAS unsigned char* ws;
    int tid, lane, wave, G, wg;
};
#define WSP(T, off) ((GAS T*)(F.ws + (off)))
constexpr int PTAB_OFF = 147456 - 1024;
__device__ __forceinline__ const GAS float* inp(const Frame& F, int i) {
    const LAS unsigned* t = (const LAS unsigned*)(F.lds + PTAB_OFF) + 2 * i;
    const unsigned lo = __builtin_amdgcn_readfirstlane(t[0]), hi = __builtin_amdgcn_readfirstlane(t[1]);
    return (const GAS float*)(((unsigned long long)hi << 32) | lo);
}
__device__ __forceinline__ GAS float* outp(const Frame& F) { return (GAS float*)inp(F, 32); }

__device__ __forceinline__ int row_batch(int row) { return row < TOKL ? (row >> 11) : ((row - TOKL) >> 8); }
__device__ __forceinline__ const GAS float* mod_ptr(const Frame& F, int layer, int row, int which) {
    const int r = row < TOKL ? (row >> 11) : 16;
    return WSP(const float, WS_MOD) + ((size_t)(layer * 17 + r) * 6 + which) * 1024;
}

template <class RowMap>
__device__ __forceinline__ void tr_item(const GAS float* W, int K, int N, GAS bf16* WT, int ldT, RowMap rm, LAS float* scr, int item, int lane) {
    const int nblk = (N + 31) / 32, kb = item / nblk, nb = item % nblk, k0 = 64 * kb, n0 = 32 * nb;
    { f32x4 tv[8];
#pragma unroll
      for (int i = 0; i < 8; ++i) { const int kk = 8 * i + (lane >> 3); const int n = n0 + 4 * (lane & 7); tv[i] = (n < N) ? *(const GAS f32x4*)(W + (size_t)(k0 + kk) * N + n) : (f32x4){0.f, 0.f, 0.f, 0.f}; }
#pragma unroll
      for (int i = 0; i < 8; ++i) { const int kk = 8 * i + (lane >> 3); LAS float* d = scr + kk * 33 + 4 * (lane & 7); d[0] = tv[i].x; d[1] = tv[i].y; d[2] = tv[i].z; d[3] = tv[i].w; } }
    asm volatile("s_waitcnt lgkmcnt(0)" ::: "memory");
    const int c = lane & 7;
#pragma unroll
    for (int j = 0; j < 4; ++j) { const int nl = (lane >> 3) + 8 * j; const int n = n0 + nl; const LAS float* s = scr + (8 * c) * 33 + nl;
        u32x4 o; o.x = pk2(s[0 * 33], s[1 * 33]); o.y = pk2(s[2 * 33], s[3 * 33]); o.z = pk2(s[4 * 33], s[5 * 33]); o.w = pk2(s[6 * 33], s[7 * 33]);
        if (n < N) *(GAS u32x4*)(WT + (size_t)rm(n) * ldT + k0 + 8 * c) = o; }
    asm volatile("s_waitcnt lgkmcnt(0)" ::: "memory");
}
struct RmId { __device__ __forceinline__ int operator()(int n) const { return n; } };
__device__ __forceinline__ int win_row(int n) {
    if (n < 1152) return n;
    if (n < 2688) return 1280 + (n - 1152);
    if (n < 3712) return 2816 + (n - 2688);
    if (n < 3728) return 1152 + (n - 3712);
    return 3840 + (n - 3728);
}
struct RmWin { __device__ __forceinline__ int operator()(int n) const { return win_row(n); } };
struct RmW1 { __device__ __forceinline__ int operator()(int n) const { return (n >> 4) * 32 + (n & 15); } };
struct RmW3 { __device__ __forceinline__ int operator()(int n) const { return (n >> 4) * 32 + 16 + (n & 15); } };

__device__ __forceinline__ void conv_weights_win(Frame& F, int layer, int gw, int NGW, LAS float* scr) {
    const GAS float* W = inp(F, I_WIN) + (size_t)layer * D * NIN;
    const int items = (D / 64) * ((NIN + 31) / 32);
    for (int it = gw; it < items; it += NGW) tr_item(W, D, NIN, WSP(bf16, WS_WIN), D, RmWin(), scr, it, F.lane);
    GAS bf16* wt = WSP(bf16, WS_WIN);
    unsigned zz; asm volatile("v_mov_b32 %0, 0" : "=v"(zz));
    for (int i = gw * 64 + F.lane; i < 112 * 1024 / 8; i += NGW * 64) *(GAS u32x4*)(wt + (size_t)1168 * 1024 + (size_t)i * 8) = (u32x4){zz, zz, zz, zz};
}
__device__ __forceinline__ void conv_weights_upout(Frame& F, int layer, int gw, int NGW, LAS float* scr) {
    const int items = (D / 64) * (D / 32);
    for (int it = gw; it < items; it += NGW) tr_item(inp(F, I_WUP) + (size_t)layer * D * D, D, D, WSP(bf16, WS_WUP), D, RmId(), scr, it, F.lane);
    for (int it = gw; it < items; it += NGW) tr_item(inp(F, I_WOUT) + (size_t)layer * D * D, D, D, WSP(bf16, WS_WOUT), D, RmId(), scr, it, F.lane);
}
__device__ __forceinline__ void conv_weights_ffn(const GAS float* w1, const GAS float* w3, const GAS float* w2, GAS bf16* w13t, GAS bf16* w2t, int gw, int NGW, LAS float* scr, int lane) {
    const int i1 = (D / 64) * (DFF / 32), i2 = (DFF / 64) * (D / 32);
    for (int it = gw; it < i1; it += NGW) tr_item(w1, D, DFF, w13t, D, RmW1(), scr, it, lane);
    for (int it = gw; it < i1; it += NGW) tr_item(w3, D, DFF, w13t, D, RmW3(), scr, it, lane);
    for (int it = gw; it < i2; it += NGW) tr_item(w2, DFF, D, w2t, DFF, RmId(), scr, it, lane);
}

constexpr size_t WS_HID2 = WS_XC;
__device__ __forceinline__ void filter_hidden_item(Frame& F, int p) {
    const int sel = p < 2048 ? 0 : (p < 4096 ? 1 : 2), layer = sel == 1 ? 1 : 0, L = sel == 2 ? LC : LL, pbase = sel == 0 ? 0 : (sel == 1 ? 2048 : 4096);
    const GAS float* f1 = inp(F, I_HYF1) + layer * 33 * 64; const GAS float* fb1 = inp(F, I_HYFB1) + layer * 64;
    const GAS float* f2 = inp(F, I_HYF2) + layer * 64 * 64; const GAS float* fb2 = inp(F, I_HYFB2) + layer * 64;
    const int lane = F.lane;
    float w1[33], w2[64];
#pragma unroll
    for (int i = 0; i < 33; ++i) w1[i] = f1[i * 64 + lane];
#pragma unroll
    for (int i = 0; i < 64; ++i) w2[i] = f2[i * 64 + lane];
    const float b1 = fb1[lane], b2 = fb2[lane];
    const int pos = p - pbase;
    const float t = (float)pos / (float)(L - 1);
    const float w = 6.283185307179586f * (float)pos / (float)L;
    float feat = 0.f;
    if (lane == 0) feat = t;
    else if (lane < 17) { const float band = 1e-4f + (float)(lane - 1) * ((15.0f - 1e-4f) / 15.0f); feat = cosf(w * band); }
    else if (lane < 33) { const float band = 1e-4f + (float)(lane - 17) * ((15.0f - 1e-4f) / 15.0f); feat = -sinf(w * band); }
    float a1 = b1;
#pragma unroll
    for (int i = 0; i < 33; ++i) a1 += __int_as_float(__builtin_amdgcn_readlane(__float_as_int(feat), i)) * w1[i];
    const float h1 = sinf(a1);
    float a2 = b2;
#pragma unroll
    for (int i = 0; i < 64; ++i) a2 += __int_as_float(__builtin_amdgcn_readlane(__float_as_int(h1), i)) * w2[i];
    WSP(float, WS_HID2)[(size_t)p * 64 + lane] = sinf(a2);
}
__device__ __forceinline__ void filter_out_item(Frame& F, int item) {
    int sel, r;
    if (item < 768) { sel = 0; r = item; } else if (item < 1536) { sel = 1; r = item - 768; } else { sel = 2; r = item - 1536; }
    const int layer = sel == 1 ? 1 : 0, L = sel == 2 ? LC : LL, pb = r / 24, ch = r % 24, pbase = sel == 0 ? 0 : (sel == 1 ? 2048 : 4096);
    GAS bf16* FT = sel == 2 ? WSP(bf16, WS_FTC) : WSP(bf16, WS_FTL) + (size_t)layer * 2 * 384 * 4096;
    const GAS float* f3 = inp(F, I_HYF3) + (size_t)layer * 64 * 1536; const GAS float* dec = inp(F, I_HYDECAY) + layer * 1536;
    const int lane = F.lane, fr = lane & 15, fq = lane >> 4;
    const GAS float* hid = WSP(const float, WS_HID2) + (size_t)(pbase + pb * 64) * 64;
    f32x4 acc[4][4];
#pragma unroll
    for (int mt = 0; mt < 4; ++mt)
#pragma unroll
        for (int nt = 0; nt < 4; ++nt) acc[mt][nt] = (f32x4){0.f, 0.f, 0.f, 0.f};
#pragma unroll
    for (int ks = 0; ks < 16; ++ks) {
        float a[4], bb[4];
#pragma unroll
        for (int mt = 0; mt < 4; ++mt) a[mt] = hid[(16 * mt + fr) * 64 + 4 * ks + fq];
#pragma unroll
        for (int nt = 0; nt < 4; ++nt) bb[nt] = f3[(size_t)(4 * ks + fq) * 1536 + ch * 64 + 16 * nt + fr];
#pragma unroll
        for (int mt = 0; mt < 4; ++mt)
#pragma unroll
            for (int nt = 0; nt < 4; ++nt) acc[mt][nt] = __builtin_amdgcn_mfma_f32_16x16x4f32(a[mt], bb[nt], acc[mt][nt], 0, 0, 0);
    }
#pragma unroll
    for (int nt = 0; nt < 4; ++nt) {
        const int nn = ch * 64 + 16 * nt + fr, o = nn / 768, dir = (nn / 384) & 1, c = nn % 384;
        const float adec = fabsf(dec[nn]);
        GAS bf16* dst = FT + (size_t)(o * 384 + c) * (2 * L);
#pragma unroll
        for (int mt = 0; mt < 4; ++mt)
#pragma unroll
            for (int j = 0; j < 4; ++j) {
                const int pos = pb * 64 + 16 * mt + 4 * fq + j;
                const float t = (float)pos / (float)(L - 1);
                const float v = acc[mt][nt][j] * __expf(-t * adec);
                if (dir == 0) dst[L - pos] = (bf16)f2bf(v);
                else if (pos > 0) dst[L + pos] = (bf16)f2bf(v);
            }
    }
}

__device__ __forceinline__ void phase_p0(Frame& F) {
    const int gw = F.wg * NWAVES + F.wave, NGW = F.G * NWAVES;
    LAS float* sl = (LAS float*)F.lds;
    LAS float* red = (LAS float*)(F.lds + 17 * 4096);
    for (int i = F.tid; i < 17 * 1024; i += NTHR) { const int r = i >> 10, k = i & 1023; const float v = r < 16 ? inp(F, I_C)[r * 1024 + k] : inp(F, I_CCTX)[k]; sl[i] = siluf_(v); }
    __syncthreads();
    for (int item = F.wg; item < 2 * 384; item += F.G) {
        const int layer = item / 384, n0 = (item % 384) * 16, j = F.tid & 15, kp = F.tid >> 4;
        const GAS float* W = inp(F, I_WMOD) + (size_t)layer * D * 6144;
        float w[32];
#pragma unroll
        for (int i = 0; i < 32; ++i) w[i] = W[(size_t)(kp * 32 + i) * 6144 + n0 + j];
#pragma unroll
        for (int r = 0; r < 17; ++r) { float acc = 0.f;
#pragma unroll
            for (int q = 0; q < 8; ++q) { const f32x4 s4 = *(const LAS f32x4*)(sl + r * 1024 + kp * 32 + 4 * q); acc += (s4.x * w[4 * q] + s4.y * w[4 * q + 1]) + (s4.z * w[4 * q + 2] + s4.w * w[4 * q + 3]); }
            red[(kp * 17 + r) * 16 + j] = acc; }
        __syncthreads();
        if (F.tid < 272) { const int r = F.tid >> 4, jj = F.tid & 15; float s = inp(F, I_BMOD)[layer * 6144 + n0 + jj];
            for (int q = 0; q < 32; ++q) s += red[(q * 17 + r) * 16 + jj];
            WSP(float, WS_MOD)[(size_t)(layer * 17 + r) * 6144 + n0 + jj] = s; }
        __syncthreads();
    }
    __syncthreads();
    LAS float* scr = (LAS float*)(F.lds + F.wave * 8704);
    conv_weights_win(F, 0, gw, NGW, scr);
    conv_weights_upout(F, 0, gw, NGW, scr);
    for (int i = gw * 64 + F.lane; i < 2048 * 32; i += NGW * 64) {
        const int t = i >> 5, j = i & 31, half = j >> 4, ii = j & 15;
        const float inv = 1.0f / powf(10000.0f, (float)ii / 16.0f);
        const float ang = (float)(half == 0 ? (t >> 6) : (t & 63)) * inv;
        WSP(float, WS_ROPE)[t * 64 + half * 32 + ii] = cosf(ang);
        WSP(float, WS_ROPE)[t * 64 + half * 32 + 16 + ii] = sinf(ang);
    }
    for (int it = gw; it < 4352; it += NGW) filter_hidden_item(F, it);
}
__device__ __forceinline__ void write_bias(Frame& F) {
    const int gt = (F.wg * NWAVES + F.wave) * 64 + F.lane, NGT = F.G * NTHR;
    for (int i = gt; i < 2 * NWP; i += NGT) {
        const int l = i / NWP, r = i % NWP; float v = 0.f;
        int n = -1;
        if (r < 1152) n = r; else if (r < 1168) n = 3712 + (r - 1152); else if (r < 1280) n = -1; else if (r < 2816) n = 1152 + (r - 1280); else if (r < 3840) n = 2688 + (r - 2816); else n = 3728 + (r - 3840);
        if (n >= 0) v = inp(F, I_BIN)[l * NIN + n];
        WSP(float, WS_BIAS)[i] = v;
    }
}

template <bool XB> struct XRaw { typedef f32x4 T; };
template <> struct XRaw<true> { typedef u32x2 T; };
template <bool XB>
__device__ __forceinline__ void xrow_issue(const Frame& F, int row, int src, int lane, typename XRaw<XB>::T (&w)[4]) {
    if constexpr (!XB) { const GAS float* xr = row < TOKL ? inp(F, I_X) + (size_t)row * D : inp(F, I_CTX) + (size_t)(row - TOKL) * D;
#pragma unroll
        for (int j = 0; j < 4; ++j) w[j] = *(const GAS f32x4*)(xr + 256 * j + 4 * lane); }
    else { const GAS bf16* xr = src == 2 ? WSP(const bf16, WS_XL2) + (size_t)row * D : (row < TOKL ? (const GAS bf16*)outp(F) + (size_t)row * D : WSP(const bf16, WS_XC) + (size_t)(row - TOKL) * D);
#pragma unroll
        for (int j = 0; j < 4; ++j) w[j] = *(const GAS u32x2*)(xr + 256 * j + 4 * lane); }
}
__device__ __forceinline__ f32x4 xrow_unpack(f32x4 w) { return w; }
__device__ __forceinline__ f32x4 xrow_unpack(u32x2 w) { f32x4 v; v.x = __uint_as_float(w.x << 16); v.y = __uint_as_float(w.x & 0xffff0000u); v.z = __uint_as_float(w.y << 16); v.w = __uint_as_float(w.y & 0xffff0000u); return v; }
template <bool XB>
__device__ __forceinline__ void phase_norm(Frame& F, int layer, int nrows, int which) {
    const int gw = F.wg * NWAVES + F.wave, NGW = F.G * NWAVES, lane = F.lane;
    const GAS float* g = inp(F, which == 0 ? I_GMIX : I_GFFN) + layer * D;
    const int per = (nrows + NGW - 1) / NGW, r0 = gw * per, r1 = min(nrows, r0 + per);
    if (r0 >= r1) return;
    int grp = -1; f32x4 gm[4], sh[4]; typename XRaw<XB>::T ring[4][4];
#pragma unroll
    for (int i = 0; i < 4; ++i) if (r0 + i < r1) xrow_issue<XB>(F, r0 + i, 1, lane, ring[i]);
#pragma unroll 1
    for (int rb = r0; rb < r1; rb += 4) {
#pragma unroll
        for (int i = 0; i < 4; ++i) {
            const int row = rb + i;
            if (row < r1) {
                const int gr = row < TOKL ? (row >> 11) : 16;
                if (gr != grp) { grp = gr; const GAS float* shp = mod_ptr(F, layer, row, which); const GAS float* scp = mod_ptr(F, layer, row, which + 1);
#pragma unroll
                    for (int j = 0; j < 4; ++j) { const f32x4 gg = *(const GAS f32x4*)(g + 256 * j + 4 * lane), sc = *(const GAS f32x4*)(scp + 256 * j + 4 * lane); sh[j] = *(const GAS f32x4*)(shp + 256 * j + 4 * lane);
                        gm[j].x = gg.x * (1.f + sc.x); gm[j].y = gg.y * (1.f + sc.y); gm[j].z = gg.z * (1.f + sc.z); gm[j].w = gg.w * (1.f + sc.w); } }
                f32x4 v[4]; float s = 0.f;
#pragma unroll
                for (int j = 0; j < 4; ++j) { v[j] = xrow_unpack(ring[i][j]); s += (v[j].x * v[j].x + v[j].y * v[j].y) + (v[j].z * v[j].z + v[j].w * v[j].w); }
                if (row + 4 < r1) xrow_issue<XB>(F, row + 4, 1, lane, ring[i]);
                const float r = rsqrtf(wave_sum(s) * (1.0f / 1024.0f) + 1e-6f);
                GAS bf16* orow = WSP(bf16, WS_H) + (size_t)row * D;
#pragma unroll
                for (int j = 0; j < 4; ++j) {
                    f32x4 o; o.x = v[j].x * r * gm[j].x + sh[j].x; o.y = v[j].y * r * gm[j].y + sh[j].y; o.z = v[j].z * r * gm[j].z + sh[j].z; o.w = v[j].w * r * gm[j].w + sh[j].w;
                    u32x2 w; w.x = pk2(o.x, o.y); w.y = pk2(o.z, o.w);
                    *(GAS u32x2*)(orow + 256 * j + 4 * lane) = w;
                }
            }
        }
    }
}

namespace pg8 {
#ifndef WGM_
#define WGM_ 4
#endif
#ifndef PG8_SP2_
#define PG8_SP2_ 1
#endif
#ifndef PG8_ALIGN_
#define PG8_ALIGN_ 1
#endif
constexpr int BM = 256, BK = 64, HALF = 128, HTB = HALF * BK * 2, STAGE_BYTES = 8 * HTB, NXCD = 8, WGM = WGM_;
__device__ __forceinline__ int lds_byte(int r, int c) { const int st = (r >> 4) * 2 + (c >> 5), rr = r & 15, cc = c & 31, ob = rr * 64 + cc * 2; return st * 1024 + (ob ^ (((ob >> 9) & 1) << 5)); }
__device__ __forceinline__ void stage_rc(int b, int& R, int& C) { const int st = b / 1024, sb = b % 1024, swz = sb ^ (((sb >> 9) & 1) << 5); R = (st >> 1) * 16 + swz / 64; C = (st & 1) * 32 + (swz % 64) / 2; }
struct Unit { int pm, pn; };
template <int MR_>
struct OrderPlainT {
    static constexpr bool GATHER = false; static constexpr int MROWS = MR_;
    int nM, nN, nwg, G, c;
    __device__ __forceinline__ void init(int nM_, int nN_, int G_, int c_) { nM = nM_; nN = nN_; nwg = nM * nN; G = G_; c = c_; }
    __device__ __forceinline__ bool next(int i, Unit& u) const {
        const long L = (long)i * G + c; if (L >= nwg) return false;
        int wgid = (int)L; { const int q = nwg / NXCD, r = nwg % NXCD, xcd = wgid % NXCD, off = wgid / NXCD; wgid = (xcd < r ? xcd * (q + 1) : r * (q + 1) + (xcd - r) * q) + off; }
        const int nig = WGM * nN, gid = wgid / nig, fm = gid * WGM, gsz = (nM - fm) < WGM ? (nM - fm) : WGM;
        u.pm = fm + ((wgid % nig) % gsz); u.pn = (wgid % nig) / gsz; return true;
    }
    __device__ __forceinline__ int arow(int r) const { return r; }
    __device__ __forceinline__ size_t boff(const Unit&) const { return 0; }
};
using OrderPlain = OrderPlainT<256>;
struct OrderWinL1 {
    static constexpr bool GATHER = false; static constexpr int MROWS = 256;
    OrderPlain o; int G, c;
    __device__ __forceinline__ void init(int G_, int c_) { o.init(128, 15, G_, c_); G = G_; c = c_; }
    __device__ __forceinline__ bool next(int i, Unit& u) const {
        const long L = (long)i * G + c;
        if (L < 1920) return o.next(i, u);
        const int r = (int)(L - 1920); if (r >= 112) return false;
        const int q = r % 7; u.pm = 128 + r / 7; u.pn = q == 0 ? 4 : (q <= 4 ? 5 + q : 7 + q);
        return true;
    }
    __device__ __forceinline__ int arow(int r) const { return r; }
    __device__ __forceinline__ size_t boff(const Unit&) const { return 0; }
};
struct OrderMoe {
    static constexpr bool GATHER = true; static constexpr int MROWS = 256;
    OrderPlain o; const GAS int* rowidx; const GAS int* tilee; int t0; size_t bstride; bool gather;
    __device__ __forceinline__ bool next(int i, Unit& u) const { return o.next(i, u); }
    __device__ __forceinline__ int arow(int r) const { return gather ? rowidx[t0 * 256 + r] : r; }
    __device__ __forceinline__ size_t boff(const Unit& u) const { return (size_t)tilee[t0 + u.pm] * bstride; }
};

template <class Epi, class Sched>
__device__ __forceinline__ void gemm_phase(LAS unsigned char* lds, int tid_in, const GAS bf16* A, int lda, const GAS bf16* Bt, int ldb, int K, const Sched& S, const Epi& E) {
    unsigned tid_u = (unsigned)tid_in; asm volatile("" : "+v"(tid_u));
    const int tid = (int)tid_u, wid = __builtin_amdgcn_readfirstlane(tid >> 6), lane = tid & 63, wr = wid >> 2, wc = wid & 3, fr = lane & 15, fq = lane >> 4;
    const int nt = K / BK;
    constexpr int MR = Sched::MROWS, HR = MR / 2, WRR = HR / 2, NMF = WRR / 16;
    static_assert(MR == 256 || (MR == 192 && !Sched::GATHER), "unit rows");
    unsigned voffB[2];
    { int sR[2], sC[2];
#pragma unroll
      for (int i = 0; i < 2; ++i) { stage_rc(tid * 16 + i * 8192, sR[i], sC[i]);
        const int rho = sR[i] & 31, Rb = Epi::PERM ? ((sR[i] & ~31) + 8 * ((rho & 15) >> 2) + 4 * (rho >> 4) + (rho & 3)) : sR[i];
        voffB[i] = (unsigned)(Rb * ldb + sC[i]) * 2u; } }
#define PG8_GATHER_OFFS(pm_) do { unsigned _t = (unsigned)tid; asm volatile("" : "+v"(_t)); _Pragma("unroll") for (int i = 0; i < 2; ++i) { int _R, _C; stage_rc((int)_t * 16 + i * 8192, _R, _C); \
        vc0[i] = (unsigned)((size_t)S.arow((pm_) * BM + _R) * lda + _C) * 2u; vc1[i] = (unsigned)((size_t)S.arow((pm_) * BM + HALF + _R) * lda + _C) * 2u; } } while (0)
    const size_t kstep = (size_t)(BK * 2);
    const size_t hstepB = (size_t)HALF * ldb * 2, tstepB = 2 * hstepB;
    const unsigned ldsw = (unsigned)wid * 1024u;
    const int aoff = lds_byte(wr * WRR + fr, fq * 8), boff = lds_byte(wc * 32 + fr, fq * 8);
#define PG8_SA(b, h) (((b) * 2 + (h)) * HTB)
#define PG8_SB(b, h) ((4 + (b) * 2 + (h)) * HTB)
#define PG8_STAGE2(bufoff, gbase, uo, v0, v1) do { \
        __builtin_amdgcn_global_load_lds((const GAS unsigned*)((const GAS char*)(gbase) + (unsigned)((v0) + (unsigned)(uo))), (LAS unsigned*)(lds + (bufoff) + ldsw), 16, 0, 0); \
        __builtin_amdgcn_global_load_lds((const GAS unsigned*)((const GAS char*)(gbase) + (unsigned)((v1) + (unsigned)(uo))), (LAS unsigned*)(lds + (bufoff) + ldsw + 8192), 16, 0, 0); } while (0)
#define PG8_STAGEB(bufoff, gbase, uo) PG8_STAGE2(bufoff, gbase, uo, voffB[0], voffB[1])
#define PG8_LDA(dst, b, h) do { _Pragma("unroll") for (int m = 0; m < NMF; ++m) _Pragma("unroll") for (int k = 0; k < 2; ++k) dst[m][k] = *(const LAS bf16x8*)(lds + PG8_SA(b, h) + aoff + m * 2048 + k * 1024); } while (0)
#define PG8_LDB(dst, b, h) do { _Pragma("unroll") for (int n = 0; n < 2; ++n) _Pragma("unroll") for (int k = 0; k < 2; ++k) dst[n][k] = *(const LAS bf16x8*)(lds + PG8_SB(b, h) + boff + n * 2048 + k * 1024); } while (0)
#define PG8_MMA(ai, bj, At, Bt_) do { __builtin_amdgcn_s_setprio(1); _Pragma("unroll") for (int m = 0; m < NMF; ++m) _Pragma("unroll") for (int n = 0; n < 2; ++n) _Pragma("unroll") for (int k = 0; k < 2; ++k) \
        acc[ai][bj][m][n] = __builtin_amdgcn_mfma_f32_16x16x32_bf16(Bt_[n][k], At[m][k], acc[ai][bj][m][n], 0, 0, 0); __builtin_amdgcn_s_setprio(0); } while (0)
#define PG8_WAIT_V(n) asm volatile("s_waitcnt vmcnt(" #n ")" ::: "memory")
#define PG8_WAIT_L(n) asm volatile("s_waitcnt lgkmcnt(" #n ")" ::: "memory")
#define PG8_BAR __builtin_amdgcn_s_barrier()
#define PG8_SCHED __builtin_amdgcn_sched_barrier(0)
    Unit cur, nxt; int ui = 0;
    if (!S.next(0, cur)) return;
#ifndef STAGGER
#define STAGGER 0
#endif
    if (STAGGER) { const int grp = (int)(blockIdx.x >> 3) & 3;
        for (int i = 0; i < grp * STAGGER; ++i) __builtin_amdgcn_s_sleep(127); }
    f32x4 acc[2][2][4][2];
#pragma unroll
    for (int a = 0; a < 2; ++a)
#pragma unroll
        for (int b = 0; b < 2; ++b)
#pragma unroll
            for (int m = 0; m < NMF; ++m)
#pragma unroll
                for (int n = 0; n < 2; ++n) { float zf; asm volatile("v_mov_b32 %0, 0" : "=v"(zf)); acc[a][b][m][n] = (f32x4){zf, zf, zf, zf}; }
    bf16x8 At[4][2], B0[2][2], B1[2][2];
    constexpr bool GA = Sched::GATHER;
    const size_t hstepA = GA ? 0 : (size_t)HR * lda * 2, tstepA = (size_t)MR * lda * 2;
    unsigned vc0[2], vc1[2];
    if constexpr (GA) { PG8_GATHER_OFFS(cur.pm); }
    else { int sR, sC;
#pragma unroll
        for (int i = 0; i < 2; ++i) { stage_rc(tid * 16 + i * 8192, sR, sC); if (MR == 192 && sR >= HR) { sR = 0; sC = 0; }
            vc0[i] = (unsigned)(sR * lda + sC) * 2u; vc1[i] = 0u; } }
#define VC0(i) vc0[i]
#define VC1(i) (GA ? vc1[i] : vc0[i])
#define VN0(i) vc0[i]
#define VN1(i) VC1(i)
    const GAS char* cA = GA ? (const GAS char*)A : (const GAS char*)A + (size_t)cur.pm * tstepA;
    const GAS char* cB = (const GAS char*)Bt + S.boff(cur) * 2 + (size_t)cur.pn * tstepB;
    constexpr bool SP2 = PG8_SP2_ != 0, ALIGN_EPI = PG8_ALIGN_ != 0;
    const unsigned hsA = (unsigned)hstepA, hsB = (unsigned)hstepB;
    if constexpr (SP2) {
        PG8_STAGEB(PG8_SB(0, 0), cB, 0u); PG8_STAGEB(PG8_SB(0, 1), cB, hsB); PG8_STAGE2(PG8_SA(0, 0), cA, 0u, VC0(0), VC0(1)); PG8_STAGE2(PG8_SA(0, 1), cA, hsA, VC1(0), VC1(1));
        if (wr == 1) PG8_BAR;
        PG8_WAIT_V(2); PG8_BAR;
        PG8_STAGEB(PG8_SB(1, 0), cB, 128u); PG8_STAGE2(PG8_SA(1, 0), cA, 128u, VC0(0), VC0(1)); PG8_STAGEB(PG8_SB(1, 1), cB, hsB + 128u);
        PG8_WAIT_V(6); PG8_BAR;
    } else {
        PG8_STAGEB(PG8_SB(0, 0), cB, 0u); PG8_STAGE2(PG8_SA(0, 0), cA, 0u, VC0(0), VC0(1)); PG8_STAGEB(PG8_SB(0, 1), cB, hsB); PG8_STAGE2(PG8_SA(0, 1), cA, hsA, VC1(0), VC1(1));
        if (wr == 1) PG8_BAR;
        PG8_WAIT_V(4); PG8_BAR;
        PG8_STAGEB(PG8_SB(1, 0), cB, 128u); PG8_STAGE2(PG8_SA(1, 0), cA, 128u, VC0(0), VC0(1)); PG8_STAGEB(PG8_SB(1, 1), cB, hsB + 128u);
        PG8_WAIT_V(6); PG8_BAR;
    }
    for (;;) {
        const bool has_next = S.next(ui + 1, nxt);
        const GAS char* nB = cB; const GAS char* nA = cA;
        if (has_next) {
            nB = (const GAS char*)Bt + S.boff(nxt) * 2 + (size_t)nxt.pn * tstepB;
            if constexpr (!GA) nA = (const GAS char*)A + (size_t)nxt.pm * tstepA;
        }
        for (int t = 0; t < nt; t += 2) {
            const bool last = (t == nt - 2);
            if constexpr (Epi::HORNER) {
                if (t == 6 || t == 12) {
                    asm volatile("" ::: "memory");
                    const int seg = (t == 6) ? 0 : 1;
                    int hpm = cur.pm, hpn = cur.pn; asm volatile("" : "+s"(hpm), "+s"(hpn));
                    unsigned hln = (unsigned)lane; asm volatile("" : "+v"(hln)); const int hfr = (int)(hln & 15u), hfq = (int)(hln >> 4);
#pragma unroll
                    for (int ai = 0; ai < 2; ++ai) {
                        u32x4 ga[4][2], gb[4][2];
#pragma unroll
                        for (int m = 0; m < NMF; ++m)
#pragma unroll
                            for (int bj = 0; bj < 2; ++bj) {
                                const int row = hpm * MR + ai * HR + wr * WRR + m * 16 + hfr, col = hpn * BM + bj * HALF + wc * 32 + 8 * hfq;
                                ga[m][bj] = E.gate8(seg, row, col); gb[m][bj] = E.gate8(seg + 1, row, col);
                            }
                        if constexpr (NMF == 4) asm volatile("" : "+v"(ga[0][0]), "+v"(ga[0][1]), "+v"(ga[1][0]), "+v"(ga[1][1]), "+v"(ga[2][0]), "+v"(ga[2][1]), "+v"(ga[3][0]), "+v"(ga[3][1]),
                                          "+v"(gb[0][0]), "+v"(gb[0][1]), "+v"(gb[1][0]), "+v"(gb[1][1]), "+v"(gb[2][0]), "+v"(gb[2][1]), "+v"(gb[3][0]), "+v"(gb[3][1]) :: "memory");
                        else asm volatile("" : "+v"(ga[0][0]), "+v"(ga[0][1]), "+v"(ga[1][0]), "+v"(ga[1][1]), "+v"(ga[2][0]), "+v"(ga[2][1]),
                                          "+v"(gb[0][0]), "+v"(gb[0][1]), "+v"(gb[1][0]), "+v"(gb[1][1]), "+v"(gb[2][0]), "+v"(gb[2][1]) :: "memory");
#pragma unroll
                        for (int m = 0; m < NMF; ++m)
#pragma unroll
                            for (int bj = 0; bj < 2; ++bj) {
                                const unsigned aw[4] = {ga[m][bj].x, ga[m][bj].y, ga[m][bj].z, ga[m][bj].w}, bw[4] = {gb[m][bj].x, gb[m][bj].y, gb[m][bj].z, gb[m][bj].w};
#pragma unroll
                                for (int n = 0; n < 2; ++n) {
                                    f32x4& v = acc[ai][bj][m][n];
                                    v.x *= __uint_as_float(aw[2 * n] << 16) * __builtin_amdgcn_rcpf(__uint_as_float(bw[2 * n] << 16));
                                    v.y *= __uint_as_float(aw[2 * n] & 0xffff0000u) * __builtin_amdgcn_rcpf(__uint_as_float(bw[2 * n] & 0xffff0000u));
                                    v.z *= __uint_as_float(aw[2 * n + 1] << 16) * __builtin_amdgcn_rcpf(__uint_as_float(bw[2 * n + 1] << 16));
                                    v.w *= __uint_as_float(aw[2 * n + 1] & 0xffff0000u) * __builtin_amdgcn_rcpf(__uint_as_float(bw[2 * n + 1] & 0xffff0000u));
                                }
                            }
                    }
                    asm volatile("s_waitcnt vmcnt(0)" ::: "memory");
                }
            }
            const unsigned k1 = (unsigned)(t + 1) * 128u, k2 = last ? 0u : (unsigned)(t + 2) * 128u, k3 = k2 + 128u;
            const GAS char* pA2 = last ? nA : cA; const GAS char* pB2 = last ? nB : cB;
            if constexpr (SP2) {
            PG8_LDB(B0, 0, 0); PG8_LDB(B1, 0, 1); PG8_SCHED; PG8_LDA(At, 0, 0); PG8_STAGE2(PG8_SA(1, 1), cA, k1 + hsA, VC1(0), VC1(1));
            if constexpr (GA) { if (last && has_next) { asm volatile("" ::: "memory"); PG8_GATHER_OFFS(nxt.pm); asm volatile("" ::: "memory"); } }
            PG8_WAIT_V(8); PG8_WAIT_L(0); PG8_BAR; PG8_MMA(0, 0, At, B0); PG8_MMA(0, 1, At, B1); PG8_BAR; PG8_SCHED;
            PG8_LDA(At, 0, 1); PG8_STAGEB(PG8_SB(0, 0), pB2, k2); PG8_STAGEB(PG8_SB(0, 1), pB2, k2 + hsB); PG8_STAGE2(PG8_SA(0, 0), pA2, k2, VN0(0), VN0(1));
            PG8_WAIT_V(8); PG8_WAIT_L(0); PG8_BAR; PG8_MMA(1, 0, At, B0); PG8_MMA(1, 1, At, B1); PG8_BAR; PG8_SCHED;
            PG8_LDB(B0, 1, 0); PG8_LDB(B1, 1, 1); PG8_SCHED; PG8_LDA(At, 1, 0); PG8_STAGE2(PG8_SA(0, 1), pA2, k2 + hsA, VN1(0), VN1(1));
            PG8_WAIT_V(8); PG8_WAIT_L(0); PG8_BAR; PG8_MMA(0, 0, At, B0); PG8_MMA(0, 1, At, B1); PG8_BAR; PG8_SCHED;
            PG8_LDA(At, 1, 1); PG8_STAGEB(PG8_SB(1, 0), pB2, k3); PG8_STAGEB(PG8_SB(1, 1), pB2, k3 + hsB); PG8_STAGE2(PG8_SA(1, 0), pA2, k3, VN0(0), VN0(1));
            PG8_WAIT_V(8); PG8_WAIT_L(0); PG8_BAR; PG8_MMA(1, 0, At, B0); PG8_MMA(1, 1, At, B1); PG8_BAR; PG8_SCHED;
            } else {
            PG8_LDB(B0, 0, 0); PG8_SCHED; PG8_LDA(At, 0, 0); PG8_STAGE2(PG8_SA(1, 1), cA, k1 + hsA, VC1(0), VC1(1));
            if constexpr (GA) { if (last && has_next) { asm volatile("" ::: "memory"); PG8_GATHER_OFFS(nxt.pm); asm volatile("" ::: "memory"); } }
            PG8_WAIT_L(8); PG8_BAR; PG8_WAIT_L(0); PG8_MMA(0, 0, At, B0); PG8_BAR; PG8_SCHED;
            PG8_LDB(B1, 0, 1); PG8_STAGEB(PG8_SB(0, 0), pB2, k2);
            PG8_BAR; PG8_WAIT_L(0); PG8_MMA(0, 1, At, B1); PG8_BAR;
            PG8_LDA(At, 0, 1); PG8_STAGE2(PG8_SA(0, 0), pA2, k2, VN0(0), VN0(1));
            PG8_BAR; PG8_WAIT_L(0); PG8_MMA(1, 0, At, B0); PG8_BAR; PG8_SCHED;
            PG8_STAGEB(PG8_SB(0, 1), pB2, k2 + hsB);
            PG8_WAIT_V(6); PG8_BAR; PG8_MMA(1, 1, At, B1); PG8_BAR;
            PG8_LDB(B0, 1, 0); PG8_SCHED; PG8_LDA(At, 1, 0); PG8_STAGE2(PG8_SA(0, 1), pA2, k2 + hsA, VN1(0), VN1(1));
            PG8_WAIT_L(8); PG8_BAR; PG8_WAIT_L(0); PG8_MMA(0, 0, At, B0); PG8_BAR; PG8_SCHED;
            PG8_LDB(B1, 1, 1); PG8_STAGEB(PG8_SB(1, 0), pB2, k3);
            PG8_BAR; PG8_WAIT_L(0); PG8_MMA(0, 1, At, B1); PG8_BAR;
            PG8_LDA(At, 1, 1); PG8_STAGE2(PG8_SA(1, 0), pA2, k3, VN0(0), VN0(1));
            PG8_BAR; PG8_WAIT_L(0); PG8_MMA(1, 0, At, B0); PG8_BAR; PG8_SCHED;
            PG8_STAGEB(PG8_SB(1, 1), pB2, k3 + hsB);
            PG8_WAIT_V(6); PG8_BAR; PG8_MMA(1, 1, At, B1); PG8_BAR;
                    }
        }
        if constexpr (ALIGN_EPI) { if (wr == 0) PG8_BAR; }
#ifndef REP_EPI
#define REP_EPI 1
#endif
#pragma unroll 1
        for (int rpe = 0; rpe < ((Epi::COLVEC && Epi::BASE) ? 1 : REP_EPI); ++rpe) {
            int epm = cur.pm, epn = cur.pn; asm volatile("" : "+s"(epm), "+s"(epn));
            unsigned eln = (unsigned)lane; asm volatile("" : "+v"(eln)); const int efr = (int)(eln & 15u), efq = (int)(eln >> 4);
            constexpr bool PM = Epi::PERM;
#define PG8_COL(bj, n) (epn * BM + (bj) * HALF + wc * 32 + (PM ? 8 * efq + 4 * (n) : (n) * 16 + 4 * efq))
            f32x4 cv[2][2];
#pragma unroll
            for (int bj = 0; bj < 2; ++bj)
#pragma unroll
                for (int n = 0; n < 2; ++n) { if constexpr (Epi::COLVEC) cv[bj][n] = E.colvec(epm * MR, PG8_COL(bj, n)); else cv[bj][n] = (f32x4){0.f, 0.f, 0.f, 0.f}; }
            if constexpr (Epi::COLVEC) asm volatile("" : "+v"(cv[0][0]), "+v"(cv[0][1]), "+v"(cv[1][0]), "+v"(cv[1][1]) :: "memory");
            constexpr bool CV2 = Epi::COLVEC && Epi::ROWCV && MR != 256;
            f32x4 cv2[2][2];
            if constexpr (CV2) {
#pragma unroll
                for (int bj = 0; bj < 2; ++bj)
#pragma unroll
                    for (int n = 0; n < 2; ++n) cv2[bj][n] = E.colvec(epm * MR + MR - 1, PG8_COL(bj, n));
                asm volatile("" : "+v"(cv2[0][0]), "+v"(cv2[0][1]), "+v"(cv2[1][0]), "+v"(cv2[1][1]) :: "memory");
            }
#pragma unroll
            for (int ai = 0; ai < 2; ++ai) {
                f32x4 bs[4][2][2];
                if constexpr (Epi::BASE) {
#pragma unroll
                    for (int m = 0; m < NMF; ++m)
#pragma unroll
                        for (int bj = 0; bj < 2; ++bj) {
                            const int row = epm * MR + ai * HR + wr * WRR + m * 16 + efr;
                            if constexpr (PM) E.base8(row, PG8_COL(bj, 0), bs[m][bj][0], bs[m][bj][1]);
                            else {
#pragma unroll
                                for (int n = 0; n < 2; ++n) bs[m][bj][n] = E.base(row, PG8_COL(bj, n));
                            }
                        }
                    if constexpr (NMF == 4) asm volatile("" : "+v"(bs[0][0][0]), "+v"(bs[0][0][1]), "+v"(bs[0][1][0]), "+v"(bs[0][1][1]), "+v"(bs[1][0][0]), "+v"(bs[1][0][1]), "+v"(bs[1][1][0]), "+v"(bs[1][1][1]),
                                      "+v"(bs[2][0][0]), "+v"(bs[2][0][1]), "+v"(bs[2][1][0]), "+v"(bs[2][1][1]), "+v"(bs[3][0][0]), "+v"(bs[3][0][1]), "+v"(bs[3][1][0]), "+v"(bs[3][1][1]) :: "memory");
                    else asm volatile("" : "+v"(bs[0][0][0]), "+v"(bs[0][0][1]), "+v"(bs[0][1][0]), "+v"(bs[0][1][1]), "+v"(bs[1][0][0]), "+v"(bs[1][0][1]), "+v"(bs[1][1][0]), "+v"(bs[1][1][1]),
                                      "+v"(bs[2][0][0]), "+v"(bs[2][0][1]), "+v"(bs[2][1][0]), "+v"(bs[2][1][1]) :: "memory");
                }
#pragma unroll
                for (int m = 0; m < NMF; ++m) {
                    const int row = epm * MR + ai * HR + wr * WRR + m * 16 + efr;
                    bool alt = false; if constexpr (CV2) alt = E.rowgrp(epm * MR + ai * HR + wr * WRR + m * 16) != E.rowgrp(epm * MR);
#pragma unroll
                    for (int bj = 0; bj < 2; ++bj) {
                        if constexpr (Epi::PAIR) E.store_pair(row, epn * (BM / 2) + bj * (HALF / 2) + wc * 16 + 4 * efq, acc[ai][bj][m][0], acc[ai][bj][m][1]);
                        else if constexpr (PM) {
                            f32x4 b0 = (f32x4){0.f, 0.f, 0.f, 0.f}, b1 = b0; if constexpr (Epi::BASE) { b0 = bs[m][bj][0]; b1 = bs[m][bj][1]; }
                            E.store8(row, PG8_COL(bj, 0), acc[ai][bj][m][0], acc[ai][bj][m][1], (CV2 && alt) ? cv2[bj][0] : cv[bj][0], (CV2 && alt) ? cv2[bj][1] : cv[bj][1], b0, b1);
                        } else {
#pragma unroll
                            for (int n = 0; n < 2; ++n) { f32x4 bb = (f32x4){0.f, 0.f, 0.f, 0.f}; if constexpr (Epi::BASE) bb = bs[m][bj][n]; E.store(row, PG8_COL(bj, n), acc[ai][bj][m][n], (CV2 && alt) ? cv2[bj][n] : cv[bj][n], bb); }
                        }
                    }
                }
            }
#undef PG8_COL
        }
        if (!has_next) break;
#pragma unroll
        for (int a = 0; a < 2; ++a)
#pragma unroll
            for (int b = 0; b < 2; ++b)
#pragma unroll
                for (int m = 0; m < NMF; ++m)
#pragma unroll
                    for (int n = 0; n < 2; ++n) { float zf; asm volatile("v_mov_b32 %0, 0" : "=v"(zf)); acc[a][b][m][n] = (f32x4){zf, zf, zf, zf}; }
        cur = nxt; cB = nB; cA = nA; ++ui;
        if constexpr (ALIGN_EPI) { if (wr == 1) PG8_BAR; }
    }
    PG8_WAIT_V(0);
    if constexpr (!ALIGN_EPI) { if (wr == 0) PG8_BAR; }
    PG8_BAR;
#undef PG8_GATHER_OFFS
#undef VC0
#undef VC1
#undef VN0
#undef VN1
#undef PG8_SA
#undef PG8_SB
#undef PG8_STAGE2
#undef PG8_STAGEB
#undef PG8_LDA
#undef PG8_LDB
#undef PG8_MMA
#undef PG8_WAIT_V
#undef PG8_WAIT_L
#undef PG8_BAR
#undef PG8_SCHED
}
}

template <int MR = 256, class Epi>
__device__ __forceinline__ void gemm_fast(Frame& F, const GAS bf16* A, int lda, const GAS bf16* Bt, int ldb, int K, int M, int N, const Epi& E) {
    pg8::OrderPlainT<MR> S; S.init(M / MR, N / 256, F.G, F.wg);
    pg8::gemm_phase(F.lds, F.tid, A, lda, Bt, ldb, K, S, E);
}

__device__ __forceinline__ void st_bf16x4(GAS bf16* p, f32x4 v) { u32x2 w; w.x = pk2(v.x, v.y); w.y = pk2(v.z, v.w); *(GAS u32x2*)p = w; }
__device__ __forceinline__ f32x4 ld_bf16x4(const GAS bf16* p) { const u32x2 w = *(const GAS u32x2*)p; f32x4 v; v.x = __uint_as_float(w.x << 16); v.y = __uint_as_float(w.x & 0xffff0000u); v.z = __uint_as_float(w.y << 16); v.w = __uint_as_float(w.y & 0xffff0000u); return v; }

__device__ __forceinline__ void st_bf16x8(GAS bf16* p, f32x4 a, f32x4 b) { u32x4 w; w.x = pk2(a.x, a.y); w.y = pk2(a.z, a.w); w.z = pk2(b.x, b.y); w.w = pk2(b.z, b.w); *(GAS u32x4*)p = w; }
struct EpiWin {
    static constexpr bool HORNER = false, PAIR = false, COLVEC = true, BASE = false, PERM = true, ROWCV = false;
    const GAS float* bias; GAS bf16 *hytl, *hytc, *ret, *ml; GAS float* mlg;
    __device__ __forceinline__ f32x4 colvec(int, int col) const { return *(const GAS f32x4*)(bias + col); }
    __device__ __forceinline__ void store8(int row, int col, f32x4 v0, f32x4 v1, f32x4 c0, f32x4 c1, f32x4, f32x4) const {
        v0 += c0; v1 += c1;
        if (col < 1152) {
            const float v[8] = {v0.x, v0.y, v0.z, v0.w, v1.x, v1.y, v1.z, v1.w};
            if (row < TOKL) { const int b = row >> 11, t = row & 2047; GAS bf16* d = hytl + ((size_t)(b * 1152 + col)) * 2048 + t;
#pragma unroll
                for (int j = 0; j < 8; ++j) d[2048 * j] = (bf16)f2bf(v[j]); }
            else { const int r = row - TOKL, b = r >> 8, t = r & 255; GAS bf16* d = hytc + ((size_t)(b * 1152 + col)) * 256 + t;
#pragma unroll
                for (int j = 0; j < 8; ++j) d[256 * j] = (bf16)f2bf(v[j]); }
        } else if (col < 1168) { *(GAS f32x4*)(mlg + (size_t)row * 16 + (col - 1152)) = v0; *(GAS f32x4*)(mlg + (size_t)row * 16 + (col - 1152) + 4) = v1; }
        else if (col < 1280) { }
        else if (col < 2816) st_bf16x8(ret + (size_t)row * 1536 + (col - 1280), v0, v1);
        else st_bf16x8(ml + (size_t)row * 1024 + (col - 2816), v0, v1);
    }
};
struct EpiGate {
    static constexpr bool HORNER = false, PAIR = false, COLVEC = true, BASE = false, PERM = true, ROWCV = false;
    const GAS float* bias; GAS bf16* gates;
    __device__ __forceinline__ f32x4 colvec(int, int col) const { return *(const GAS f32x4*)(bias + col); }
    __device__ __forceinline__ void store8(int row, int col, f32x4 v0, f32x4 v1, f32x4 c0, f32x4 c1, f32x4, f32x4) const {
        v0 += c0; v1 += c1;
        f32x4 g0, g1;
        g0.x = fmaxf(sigmoidf_(v0.x), 1e-20f); g0.y = fmaxf(sigmoidf_(v0.y), 1e-20f); g0.z = fmaxf(sigmoidf_(v0.z), 1e-20f); g0.w = fmaxf(sigmoidf_(v0.w), 1e-20f);
        g1.x = fmaxf(sigmoidf_(v1.x), 1e-20f); g1.y = fmaxf(sigmoidf_(v1.y), 1e-20f); g1.z = fmaxf(sigmoidf_(v1.z), 1e-20f); g1.w = fmaxf(sigmoidf_(v1.w), 1e-20f);
        st_bf16x8(gates + (size_t)row * NGATE + col, g0, g1);
    }
};
struct EpiUp {
    static constexpr bool HORNER = true, PAIR = false, COLVEC = false, BASE = true, PERM = true, ROWCV = false;
    const GAS bf16* gates; GAS bf16* acc_out;
    __device__ __forceinline__ u32x4 gate8(int which, int row, int col) const { return *(const GAS u32x4*)(gates + (size_t)row * NGATE + which * 1024 + col); }
    __device__ __forceinline__ void base8(int row, int col, f32x4& b0, f32x4& b1) const {
        const u32x4 w = *(const GAS u32x4*)(gates + (size_t)row * NGATE + 2048 + col);
        b0.x = __uint_as_float(w.x << 16); b0.y = __uint_as_float(w.x & 0xffff0000u); b0.z = __uint_as_float(w.y << 16); b0.w = __uint_as_float(w.y & 0xffff0000u);
        b1.x = __uint_as_float(w.z << 16); b1.y = __uint_as_float(w.z & 0xffff0000u); b1.z = __uint_as_float(w.w << 16); b1.w = __uint_as_float(w.w & 0xffff0000u);
    }
    __device__ __forceinline__ void store8(int row, int col, f32x4 v0, f32x4 v1, f32x4, f32x4, f32x4 g0, f32x4 g1) const { st_bf16x8(acc_out + (size_t)row * D + col, v0 * g0, v1 * g1); }
};
template <bool IN_BF16>
struct EpiResidT {
    static constexpr bool HORNER = false, PAIR = false, COLVEC = true, BASE = true, PERM = true, ROWCV = true;
    const GAS void *xin_l, *xin_c; GAS bf16 *xout_l, *xout_c; const GAS float* modbase; int which;
    __device__ __forceinline__ int rowgrp(int row) const { return row < TOKL ? (row >> 11) : 16; }
    __device__ __forceinline__ f32x4 colvec(int row0, int col) const { const int r = row0 < TOKL ? (row0 >> 11) : 16; return *(const GAS f32x4*)(modbase + ((size_t)r * 6 + which) * 1024 + col); }
    __device__ __forceinline__ void base8(int row, int col, f32x4& b0, f32x4& b1) const {
        const size_t o = row < TOKL ? (size_t)row * D + col : (size_t)(row - TOKL) * D + col;
        if constexpr (IN_BF16) {
            const u32x4 w = *(const GAS u32x4*)((const GAS bf16*)(row < TOKL ? xin_l : xin_c) + o);
            b0.x = __uint_as_float(w.x << 16); b0.y = __uint_as_float(w.x & 0xffff0000u); b0.z = __uint_as_float(w.y << 16); b0.w = __uint_as_float(w.y & 0xffff0000u);
            b1.x = __uint_as_float(w.z << 16); b1.y = __uint_as_float(w.z & 0xffff0000u); b1.z = __uint_as_float(w.w << 16); b1.w = __uint_as_float(w.w & 0xffff0000u);
        } else { const GAS float* p = (const GAS float*)(row < TOKL ? xin_l : xin_c) + o; b0 = *(const GAS f32x4*)p; b1 = *(const GAS f32x4*)(p + 4); }
    }
    __device__ __forceinline__ void store8(int row, int col, f32x4 v0, f32x4 v1, f32x4 c0, f32x4 c1, f32x4 b0, f32x4 b1) const {
        st_bf16x8(row < TOKL ? xout_l + (size_t)row * D + col : xout_c + (size_t)(row - TOKL) * D + col, b0 + c0 * v0, b1 + c1 * v1);
    }
};
struct EpiSwiglu {
    static constexpr bool HORNER = false, PAIR = true, COLVEC = false, BASE = false, PERM = false, ROWCV = false;
    GAS bf16* act; int row_off;
    __device__ __forceinline__ void store_pair(int row, int col, f32x4 a, f32x4 b) const {
        f32x4 o; o.x = siluf_(a.x) * b.x; o.y = siluf_(a.y) * b.y; o.z = siluf_(a.z) * b.z; o.w = siluf_(a.w) * b.w;
        st_bf16x4(act + (size_t)(row - row_off) * DFF + col, o);
    }
    __device__ __forceinline__ void store(int, int, f32x4, f32x4, f32x4) const {}
};
struct EpiBf16Out {
    static constexpr bool HORNER = false, PAIR = false, COLVEC = false, BASE = false, PERM = true, ROWCV = false;
    GAS bf16* out; int ld; int row_add;
    __device__ __forceinline__ void store8(int row, int col, f32x4 v0, f32x4 v1, f32x4, f32x4, f32x4, f32x4) const { st_bf16x8(out + (size_t)(row + row_add) * ld + col, v0, v1); }
};

template <int L>
__device__ __forceinline__ void hyena_unit_fast(Frame& F, int layer, int c, const GAS bf16* hyt  , const GAS bf16* ft  , GAS bf16* yht  ) {
    constexpr int ZP = (L + 8) * 2;
    constexpr int PER = L / 32;
    constexpr int I = L / 128;
    constexpr int SPAN = L / 4, NSTEP = L / 32;
    constexpr int CP = (2 * L + 8) * 2;
    LAS unsigned char* zimg = F.lds;
    LAS unsigned char* cpy = F.lds + 16 * ZP;
    const GAS float* cw = inp(F, I_HYCONV) + layer * 3 * 1152;
    const GAS float* skip = inp(F, I_HYSKIP) + layer * 2 * 384;
    const int lane = F.lane, fr = lane & 15, fq = lane >> 4, w = F.wave;
    { unsigned long long a_ = (unsigned long long)hyt, b_ = (unsigned long long)yht; asm volatile("" : "+s"(a_), "+s"(b_)); hyt = (const GAS bf16*)a_; yht = (GAS bf16*)b_; }
    __syncthreads();
    {
        const int b = F.tid >> 5, sg = F.tid & 31, t0 = sg * PER; const GAS bf16* src = hyt + ((size_t)(b * 1152 + c)) * L + t0;
        const float w0 = cw[c], w1 = cw[1152 + c], w2 = cw[2304 + c];
        u32x4 raw[PER / 8];
#pragma unroll
        for (int j = 0; j < PER / 8; ++j) raw[j] = *(const GAS u32x4*)(src + 8 * j);
        float prev = t0 > 0 ? bf2f(src[-1]) : 0.f;
        const float nextv = t0 + PER < L ? bf2f(src[PER]) : 0.f;
#pragma unroll
        for (int j = 0; j < PER / 8; ++j) {
            const unsigned wv[4] = {raw[j].x, raw[j].y, raw[j].z, raw[j].w};
            float x[10]; x[0] = prev;
#pragma unroll
            for (int q = 0; q < 4; ++q) { x[1 + 2 * q] = __uint_as_float(wv[q] << 16); x[2 + 2 * q] = __uint_as_float(wv[q] & 0xffff0000u); }
            if (j + 1 < PER / 8) x[9] = __uint_as_float(raw[(j + 1 < PER / 8) ? j + 1 : j].x << 16); else x[9] = nextv;
            u32x4 o;
            o.x = pk2(w0 * x[0] + w1 * x[1] + w2 * x[2], w0 * x[1] + w1 * x[2] + w2 * x[3]); o.y = pk2(w0 * x[2] + w1 * x[3] + w2 * x[4], w0 * x[3] + w1 * x[4] + w2 * x[5]);
            o.z = pk2(w0 * x[4] + w1 * x[5] + w2 * x[6], w0 * x[5] + w1 * x[6] + w2 * x[7]); o.w = pk2(w0 * x[6] + w1 * x[7] + w2 * x[8], w0 * x[7] + w1 * x[8] + w2 * x[9]);
            *(LAS u32x4*)(zimg + b * ZP + (t0 + 8 * j) * 2) = o;
            prev = x[8];
        }
    }
    const int tbase = SPAN * (w >> 1) + 16 * (w & 1);
    const int flane = L - tbase + 8 * fq - fr;
    const int msh = fr & 7;
    const LAS unsigned char* fbase = cpy + msh * CP + 2 * (flane + msh);
#pragma unroll 1
    for (int o = 0; o < 2; ++o) {
        const GAS bf16* fsrc = ft + ((size_t)(o * 384 + c)) * (2 * L);
        for (int i = F.tid; i < CP / 16; i += NTHR) { u32x4 v = (u32x4){0u, 0u, 0u, 0u}; if (i < 2 * L / 8) v = *(const GAS u32x4*)(fsrc + 8 * i); if (i == 0) v.x &= 0xffff0000u; *(LAS u32x4*)(cpy + 16 * i) = v; }
        __syncthreads();
        for (int task = F.tid; task < 7 * (CP / 16); task += NTHR) {
            const int m = 1 + task / (CP / 16), x8 = task % (CP / 16);
            unsigned short e[8];
#pragma unroll
            for (int i = 0; i < 8; ++i) { const int idx = 8 * x8 - m + i; e[i] = idx >= 0 ? *(const LAS unsigned short*)(cpy + 2 * idx) : (unsigned short)0; }
            u32x4 v; v.x = e[0] | ((unsigned)e[1] << 16); v.y = e[2] | ((unsigned)e[3] << 16); v.z = e[4] | ((unsigned)e[5] << 16); v.w = e[6] | ((unsigned)e[7] << 16);
            *(LAS u32x4*)(cpy + m * CP + 16 * x8) = v;
        }
        __syncthreads();
        f32x4 acc[I];
#pragma unroll
        for (int i = 0; i < I; ++i) acc[i] = (f32x4){0.f, 0.f, 0.f, 0.f};
        bf16x8 ring[I];
#pragma unroll
        for (int i = 1; i < I; ++i) ring[(I - i) % I] = *(const LAS bf16x8*)(fbase - 64 * i);
        bf16x8 nf = *(const LAS bf16x8*)(fbase);
        const LAS unsigned char* zrow = zimg + fr * ZP + 16 * fq;
#pragma unroll 1
        for (int j0 = 0; j0 < NSTEP; j0 += I) {
#pragma unroll
            for (int jj = 0; jj < I; ++jj) {
                const int j = j0 + jj;
                ring[jj] = nf;
                if (j + 1 < NSTEP) nf = *(const LAS bf16x8*)(fbase + 64 * (j + 1));
                const bf16x8 zf = *(const LAS bf16x8*)(zrow + 64 * j);
#pragma unroll
                for (int i = 0; i < I; ++i) acc[i] = __builtin_amdgcn_mfma_f32_16x16x32_bf16(ring[(jj - i + I) % I], zf, acc[i], 0, 0, 0);
            }
        }
        unsigned el_ = (unsigned)lane; asm volatile("" : "+v"(el_)); const int efr = (int)(el_ & 15u), efq = (int)(el_ >> 4);
        const int etb = SPAN * (w >> 1) + 16 * (w & 1);
        const int gcol = (o == 0 ? 384 : 768) + c;
        const GAS bf16* gsrc = hyt + ((size_t)(efr * 1152 + gcol)) * L;
        const float w0 = cw[gcol], w1 = cw[1152 + gcol], w2 = cw[2304 + gcol], sk = skip[o * 384 + c];
        GAS bf16* dst = yht + ((size_t)(efr * 384 + c)) * L;
        constexpr int GI = I < 8 ? I : 8;
#pragma unroll
        for (int i0 = 0; i0 < I; i0 += GI) {
            u32x2 grv[GI]; unsigned short gmv[GI], gpv[GI];
#pragma unroll
            for (int ii = 0; ii < GI; ++ii) {
                const int t = etb + 32 * (i0 + ii) + 4 * efq;
                grv[ii] = *(const GAS u32x2*)(gsrc + t); gmv[ii] = t > 0 ? gsrc[t - 1] : (unsigned short)0; gpv[ii] = t + 4 < L ? gsrc[t + 4] : (unsigned short)0;
            }
            asm volatile("" ::: "memory");
#pragma unroll
            for (int ii = 0; ii < GI; ++ii) {
                const int i = i0 + ii;
                const int t = etb + 32 * i + 4 * efq;
                const u32x2 zr = *(const LAS u32x2*)(zimg + efr * ZP + t * 2);
                const u32x2 gr = grv[ii];
                const float gm = bf2f(gmv[ii]), gp = bf2f(gpv[ii]);
                const float g0 = __uint_as_float(gr.x << 16), g1 = __uint_as_float(gr.x & 0xffff0000u), g2 = __uint_as_float(gr.y << 16), g3 = __uint_as_float(gr.y & 0xffff0000u);
                const float z0 = __uint_as_float(zr.x << 16), z1 = __uint_as_float(zr.x & 0xffff0000u), z2 = __uint_as_float(zr.y << 16), z3 = __uint_as_float(zr.y & 0xffff0000u);
                const float o0 = (w0 * gm + w1 * g0 + w2 * g1) * (acc[i].x + sk * z0), o1 = (w0 * g0 + w1 * g1 + w2 * g2) * (acc[i].y + sk * z1);
                const float o2 = (w0 * g1 + w1 * g2 + w2 * g3) * (acc[i].z + sk * z2), o3 = (w0 * g2 + w1 * g3 + w2 * gp) * (acc[i].w + sk * z3);
                acc[i] = (f32x4){o0, o1, o2, o3};
            }
        }
        __syncthreads();
#pragma unroll
        for (int i = 0; i < I; ++i) {
            const int t = etb + 32 * i + 4 * efq;
            u32x2 ov; ov.x = pk2(acc[i].x, acc[i].y); ov.y = pk2(acc[i].z, acc[i].w);
            if (o == 0) *(LAS u32x2*)(zimg + efr * ZP + t * 2) = ov;
            else *(GAS u32x2*)(dst + t) = ov;
        }
    }
}

#ifndef REP_CH
#define REP_CH 1
#endif
#ifndef REP_CH_ML
#define REP_CH_ML REP_CH
#endif
#ifndef REP_CH_RET
#define REP_CH_RET REP_CH
#endif
constexpr int CH_PITCH = 144;
constexpr int CH_IMG = 64 * CH_PITCH;
constexpr int CH_WAVE_LDS = 3 * CH_IMG + 1024 + 512;
__device__ __forceinline__ void ds_tr16x8(unsigned addr, u32x2 (&lo)[4], u32x2 (&hi)[4]) {
    asm volatile("ds_read_b64_tr_b16 %0, %8\n\tds_read_b64_tr_b16 %1, %8 offset:32\n\tds_read_b64_tr_b16 %2, %8 offset:64\n\tds_read_b64_tr_b16 %3, %8 offset:96\n\t"
                 "ds_read_b64_tr_b16 %4, %8 offset:2304\n\tds_read_b64_tr_b16 %5, %8 offset:2336\n\tds_read_b64_tr_b16 %6, %8 offset:2368\n\tds_read_b64_tr_b16 %7, %8 offset:2400\n\t"
                 "s_waitcnt lgkmcnt(0)"
                 : "=&v"(lo[0]), "=&v"(lo[1]), "=&v"(lo[2]), "=&v"(lo[3]), "=&v"(hi[0]), "=&v"(hi[1]), "=&v"(hi[2]), "=&v"(hi[3]) : "v"(addr) : "memory");
}
static_assert(16 * CH_PITCH == 2304, "ds_tr16x8 offsets");
__device__ __forceinline__ void ds_tr16x4(unsigned addr, u32x2 (&lo)[2], u32x2 (&hi)[2]) {
    asm volatile("ds_read_b64_tr_b16 %0, %4\n\tds_read_b64_tr_b16 %1, %4 offset:32\n\tds_read_b64_tr_b16 %2, %4 offset:2304\n\tds_read_b64_tr_b16 %3, %4 offset:2336\n\ts_waitcnt lgkmcnt(0)"
                 : "=&v"(lo[0]), "=&v"(lo[1]), "=&v"(hi[0]), "=&v"(hi[1]) : "v"(addr) : "memory");
}
__device__ __forceinline__ float log_sigmoid_(float x) { return fminf(x, 0.f) - log1pf(__expf(-fabsf(x))); }
__device__ __forceinline__ bf16x8 mk_frag(u32x2 lo, u32x2 hi) { u32x4 w; w.x = lo.x; w.y = lo.y; w.z = hi.x; w.w = hi.y; return __builtin_bit_cast(bf16x8, w); }

template <bool IS_ML>
__device__ __forceinline__ void chain_fast(Frame& F, int layer, int b, int h, int dir, LAS unsigned char* img, int hf) {
    constexpr int NET = 2;
    const int lane = F.lane, fr = lane & 15, fq = lane >> 4;
    LAS unsigned char* Qi = img; LAS unsigned char* Ki = img + CH_IMG; LAS unsigned char* Vi = img + 2 * CH_IMG;
    const unsigned qa = (unsigned)(size_t)Qi, ka = (unsigned)(size_t)Ki, va = (unsigned)(size_t)Vi;
    const GAS bf16* RET = WSP(const bf16, WS_RET); const GAS bf16* ML = WSP(const bf16, WS_ML); const GAS float* MLG = WSP(const float, WS_MLG);
    const GAS float* rope = WSP(const float, WS_ROPE);
    GAS bf16* Y = WSP(bf16, WS_Y); GAS bf16* OB = WSP(bf16, WS_OB);
    float lgam = 0.f, bi_ = 0.f, bf_ = 0.f;
    if (!IS_ML) lgam = log_sigmoid_(inp(F, I_RETDECAY)[layer * 12 + dir * 6 + h]);
    else { bi_ = inp(F, I_MLGB)[layer * 16 + dir * 8 + h]; bf_ = inp(F, I_MLGB)[layer * 16 + dir * 8 + 4 + h]; }
    const GAS float* mlc = inp(F, I_MLCONV) + layer * 3 * 512;
    f32x4 C[4][NET];
#pragma unroll
    for (int dt = 0; dt < 4; ++dt)
#pragma unroll
        for (int et = 0; et < NET; ++et) C[dt][et] = (f32x4){0.f, 0.f, 0.f, 0.f};
    const int cq = lane & 7, pr0 = lane >> 3;
    LAS float* nvec = (LAS float*)(img + 3 * CH_IMG + 1024 + 256 * hf);
    if (IS_ML) nvec[lane] = 0.f;
    const LAS float* nq = nvec + 4 * fq;
#pragma unroll 1
    for (int step_ = 0; step_ < 36 * (IS_ML ? REP_CH_ML : REP_CH_RET); ++step_) {
        const int step = step_ % 36;
        if ((IS_ML ? REP_CH_ML : REP_CH_RET) > 1 && step == 0) {
            if (IS_ML) nvec[lane] = 0.f;
#pragma unroll
            for (int dt = 0; dt < 4; ++dt)
#pragma unroll
                for (int et = 0; et < NET; ++et) C[dt][et] = (f32x4){0.f, 0.f, 0.f, 0.f};
        }
        int rowbase, t0, L; bool lat;
        if (step < 4) { const int cc = dir ? 3 - step : step; rowbase = TOKL + b * LC + cc * 64; t0 = cc * 64; L = LC; lat = false; }
        else { const int cc = dir ? 35 - step : step - 4; rowbase = b * LL + cc * 64; t0 = cc * 64; L = LL; lat = true; }
        float g_i = 0.f, g_f = 0.f;
        if (IS_ML) { const int tlg = dir ? 63 - lane : lane; const GAS float* gp = MLG + (size_t)(rowbase + tlg) * 16 + dir * 8 + h; g_i = gp[0]; g_f = gp[4]; }
        if constexpr (!IS_ML) {
#pragma unroll
        for (int i4 = 0; i4 < 4; ++i4) {
            const int i = 4 * hf + i4;
            const int p = pr0 + 8 * i, tl = dir ? 63 - p : p, row = rowbase + tl, tpos = t0 + tl;
            float qv[8], kv[8]; u32x4 vraw;
            {
                const GAS bf16* base = RET + (size_t)row * 1536 + h * 64;
                const u32x4 qr = *(const GAS u32x4*)(base + 8 * cq), kr = *(const GAS u32x4*)(base + 384 + 8 * cq); vraw = *(const GAS u32x4*)(base + 768 + 8 * cq);
                const unsigned qw[4] = {qr.x, qr.y, qr.z, qr.w}, kw[4] = {kr.x, kr.y, kr.z, kr.w};
#pragma unroll
                for (int j = 0; j < 4; ++j) { qv[2 * j] = __uint_as_float(qw[j] << 16); qv[2 * j + 1] = __uint_as_float(qw[j] & 0xffff0000u); kv[2 * j] = __uint_as_float(kw[j] << 16); kv[2 * j + 1] = __uint_as_float(kw[j] & 0xffff0000u); }
                if (lat) {
                    const u32x4 qpr = *(const GAS u32x4*)(base + 8 * (cq ^ 2)), kpr = *(const GAS u32x4*)(base + 384 + 8 * (cq ^ 2));
                    const unsigned qpw[4] = {qpr.x, qpr.y, qpr.z, qpr.w}, kpw[4] = {kpr.x, kpr.y, kpr.z, kpr.w};
                    const int half = cq >> 2, hi = (cq >> 1) & 1, i0 = 8 * (cq & 1);
                    const GAS float* rp = rope + tpos * 64 + half * 32 + i0;
                    const f32x4 c0 = *(const GAS f32x4*)(rp), c1 = *(const GAS f32x4*)(rp + 4), s0 = *(const GAS f32x4*)(rp + 16), s1 = *(const GAS f32x4*)(rp + 20);
                    const float cs[8] = {c0.x, c0.y, c0.z, c0.w, c1.x, c1.y, c1.z, c1.w}, sn[8] = {s0.x, s0.y, s0.z, s0.w, s1.x, s1.y, s1.z, s1.w};
#pragma unroll
                    for (int j = 0; j < 8; ++j) {
                        const float qp = (j & 1) ? __uint_as_float(qpw[j >> 1] & 0xffff0000u) : __uint_as_float(qpw[j >> 1] << 16);
                        const float kp = (j & 1) ? __uint_as_float(kpw[j >> 1] & 0xffff0000u) : __uint_as_float(kpw[j >> 1] << 16);
                        qv[j] = hi ? qp * sn[j] + qv[j] * cs[j] : qv[j] * cs[j] - qp * sn[j];
                        kv[j] = hi ? kp * sn[j] + kv[j] * cs[j] : kv[j] * cs[j] - kp * sn[j];
                    }
                }
#pragma unroll
                for (int j = 0; j < 8; ++j) qv[j] *= 0.125f;
            }
            u32x4 qo, ko; qo.x = pk2(qv[0], qv[1]); qo.y = pk2(qv[2], qv[3]); qo.z = pk2(qv[4], qv[5]); qo.w = pk2(qv[6], qv[7]);
            ko.x = pk2(kv[0], kv[1]); ko.y = pk2(kv[2], kv[3]); ko.z = pk2(kv[4], kv[5]); ko.w = pk2(kv[6], kv[7]);
            *(LAS u32x4*)(Qi + p * CH_PITCH + 16 * cq) = qo; *(LAS u32x4*)(Ki + p * CH_PITCH + 16 * cq) = ko; *(LAS u32x4*)(Vi + p * CH_PITCH + 16 * cq) = vraw;
        }
        } else {
            const GAS float* wq = mlc + h * 64 + 8 * cq;
            u32x4 rr[2][3][4], vr[4];
#pragma unroll
            for (int i4 = 0; i4 < 4; ++i4) {
                const int p = pr0 + 8 * (4 * hf + i4), tl = dir ? 63 - p : p, row = rowbase + tl, tpos = t0 + tl;
                const GAS bf16* bb = ML + (size_t)row * 1024 + h * 64 + 8 * cq;
                const u32x4 z4 = (u32x4){0u, 0u, 0u, 0u};
#pragma unroll
                for (int qk = 0; qk < 2; ++qk) {
                    rr[qk][1][i4] = *(const GAS u32x4*)(bb + 256 * qk);
                    rr[qk][0][i4] = tpos > 0 ? *(const GAS u32x4*)(bb + 256 * qk - 1024) : z4;
                    rr[qk][2][i4] = tpos < L - 1 ? *(const GAS u32x4*)(bb + 256 * qk + 1024) : z4;
                }
                vr[i4] = *(const GAS u32x4*)(bb + 512);
            }
#pragma unroll
            for (int qk = 0; qk < 2; ++qk) {
                f32x4 wt[3][2];
#pragma unroll
                for (int tp = 0; tp < 3; ++tp) { wt[tp][0] = *(const GAS f32x4*)(wq + 256 * qk + 512 * tp); wt[tp][1] = *(const GAS f32x4*)(wq + 256 * qk + 512 * tp + 4); }
#pragma unroll
                for (int i4 = 0; i4 < 4; ++i4) {
                    const int p = pr0 + 8 * (4 * hf + i4);
                    const unsigned a0[4] = {rr[qk][0][i4].x, rr[qk][0][i4].y, rr[qk][0][i4].z, rr[qk][0][i4].w}, a1[4] = {rr[qk][1][i4].x, rr[qk][1][i4].y, rr[qk][1][i4].z, rr[qk][1][i4].w},
                                   a2[4] = {rr[qk][2][i4].x, rr[qk][2][i4].y, rr[qk][2][i4].z, rr[qk][2][i4].w};
                    float ov[8];
#pragma unroll
                    for (int j = 0; j < 8; ++j) {
                        const float x0 = (j & 1) ? __uint_as_float(a0[j >> 1] & 0xffff0000u) : __uint_as_float(a0[j >> 1] << 16);
                        const float x1 = (j & 1) ? __uint_as_float(a1[j >> 1] & 0xffff0000u) : __uint_as_float(a1[j >> 1] << 16);
                        const float x2 = (j & 1) ? __uint_as_float(a2[j >> 1] & 0xffff0000u) : __uint_as_float(a2[j >> 1] << 16);
                        const float r = siluf_(wt[0][j >> 2][j & 3] * x0 + wt[1][j >> 2][j & 3] * x1 + wt[2][j >> 2][j & 3] * x2);
                        ov[j] = qk == 0 ? r : r * 0.125f;
                    }
                    u32x4 o; o.x = pk2(ov[0], ov[1]); o.y = pk2(ov[2], ov[3]); o.z = pk2(ov[4], ov[5]); o.w = pk2(ov[6], ov[7]);
                    if (qk == 0) *(LAS u32x4*)(Qi + p * CH_PITCH + 16 * cq) = o;
                    else { *(LAS u32x4*)(Ki + p * CH_PITCH + 16 * cq) = o; *(LAS u32x4*)(Vi + p * CH_PITCH + 16 * cq) = vr[i4]; }
                }
            }
        }
        __builtin_amdgcn_sched_barrier(0);
        float f_p, i_p;
        if (!IS_ML) { f_p = lgam; i_p = 0.f; }
        else { i_p = g_i + bi_; f_p = log_sigmoid_(g_f + bf_); }
        float bsum = f_p;
#pragma unroll
        for (int o = 1; o < 64; o <<= 1) { const float t = lane_read(bsum, lane >= o ? lane - o : lane); if (lane >= o) bsum += t; }
        LAS float* gv = (LAS float*)(img + 3 * CH_IMG);
        const float b63 = __int_as_float(__builtin_amdgcn_readlane(__float_as_int(bsum), 63));
        const float adec = __expf(b63);
        if (hf == 0) { gv[lane] = bsum; gv[64 + lane] = bsum - i_p; gv[128 + lane] = __expf(bsum); gv[192 + lane] = __expf(b63 - (bsum - i_p)); }
        asm volatile("s_waitcnt lgkmcnt(0)" ::: "memory");
        __syncthreads();
        const LAS float* gq = gv + 4 * fq;
        const bf16x8 ones = (fr == 0) ? (bf16x8){0x3F80, 0x3F80, 0x3F80, 0x3F80, 0x3F80, 0x3F80, 0x3F80, 0x3F80} : (bf16x8){0, 0, 0, 0, 0, 0, 0, 0};
        const int tr_q = fr >> 2, tr_p = fr & 3;
#ifndef PT_UNROLL
#define PT_UNROLL 2
#endif
#pragma unroll PT_UNROLL
        for (int pt = 0; pt < 4; ++pt) {
            f32x4 ST[4];
            bf16x8 qn[2];
#pragma unroll
            for (int kk = 0; kk < 2; ++kk) qn[kk] = *(const LAS bf16x8*)(Qi + (16 * pt + fr) * CH_PITCH + (32 * kk + 8 * fq) * 2);
#pragma unroll
            for (int st = 0; st < 4; ++st) {
                ST[st] = (f32x4){0.f, 0.f, 0.f, 0.f};
                if (st <= pt) {
#pragma unroll
                    for (int kk = 0; kk < 2; ++kk) { const bf16x8 kf = *(const LAS bf16x8*)(Ki + (16 * st + fr) * CH_PITCH + (32 * kk + 8 * fq) * 2); ST[st] = __builtin_amdgcn_mfma_f32_16x16x32_bf16(kf, qn[kk], ST[st], 0, 0, 0); }
                }
            }
            const float bp = gv[16 * pt + fr];
#pragma unroll
            for (int st = 0; st < 4; ++st) {
                if (st <= pt) {
                    const f32x4 bis = *(const LAS f32x4*)(gq + 64 + 16 * st);
#pragma unroll
                    for (int j = 0; j < 4; ++j) { const int sidx = 16 * st + 4 * fq + j; const float w = (sidx <= 16 * pt + fr) ? __expf(bp - bis[j]) : 0.f; ST[st][j] *= w; }
                }
            }
            __builtin_amdgcn_sched_barrier(0);
            f32x4 acc[NET], accd = (f32x4){0.f, 0.f, 0.f, 0.f};
#pragma unroll
            for (int et = 0; et < NET; ++et) acc[et] = (f32x4){0.f, 0.f, 0.f, 0.f};
#pragma unroll
            for (int kk = 0; kk < 2; ++kk) {
                const u32x2 lo = *(const LAS u32x2*)(Qi + (16 * pt + fr) * CH_PITCH + (32 * kk + 4 * fq) * 2), hi = *(const LAS u32x2*)(Qi + (16 * pt + fr) * CH_PITCH + (32 * kk + 16 + 4 * fq) * 2);
                const bf16x8 qs = mk_frag(lo, hi);
#pragma unroll
                for (int et = 0; et < NET; ++et) {
                    u32x4 w; w.x = pk2(C[2 * kk][et].x, C[2 * kk][et].y); w.y = pk2(C[2 * kk][et].z, C[2 * kk][et].w); w.z = pk2(C[2 * kk + 1][et].x, C[2 * kk + 1][et].y); w.w = pk2(C[2 * kk + 1][et].z, C[2 * kk + 1][et].w);
                    acc[et] = __builtin_amdgcn_mfma_f32_16x16x32_bf16(qs, __builtin_bit_cast(bf16x8, w), acc[et], 0, 0, 0);
                }
                if (IS_ML) {
                    const f32x4 n0 = *(const LAS f32x4*)(nq + 32 * kk), n1 = *(const LAS f32x4*)(nq + 32 * kk + 16);
                    u32x4 w; w.x = pk2(n0.x, n0.y); w.y = pk2(n0.z, n0.w); w.z = pk2(n1.x, n1.y); w.w = pk2(n1.z, n1.w);
                    if (fr != 0) w = (u32x4){0u, 0u, 0u, 0u};
                    accd = __builtin_amdgcn_mfma_f32_16x16x32_bf16(qs, __builtin_bit_cast(bf16x8, w), accd, 0, 0, 0);
                }
            }
            { const f32x4 ap = *(const LAS f32x4*)(gq + 128 + 16 * pt);
#pragma unroll
              for (int j = 0; j < 4; ++j) {
#pragma unroll
                for (int et = 0; et < NET; ++et) acc[et][j] *= ap[j];
                accd[j] *= ap[j]; } }
            __builtin_amdgcn_sched_barrier(0);
#pragma unroll
            for (int kk = 0; kk < 2; ++kk) {
                if (2 * kk <= pt) {
                    u32x4 w; w.x = pk2(ST[2 * kk].x, ST[2 * kk].y); w.y = pk2(ST[2 * kk].z, ST[2 * kk].w); w.z = pk2(ST[2 * kk + 1].x, ST[2 * kk + 1].y); w.w = pk2(ST[2 * kk + 1].z, ST[2 * kk + 1].w);
                    const bf16x8 pf = __builtin_bit_cast(bf16x8, w);
                    u32x2 vlo[2], vhi[2];
                    ds_tr16x4(va + (32 * kk + 4 * fq + tr_q) * CH_PITCH + 8 * tr_p + 64 * hf, vlo, vhi);
#pragma unroll
                    for (int et = 0; et < NET; ++et) acc[et] = __builtin_amdgcn_mfma_f32_16x16x32_bf16(pf, mk_frag(vlo[et], vhi[et]), acc[et], 0, 0, 0);
                    if (IS_ML) accd = __builtin_amdgcn_mfma_f32_16x16x32_bf16(pf, ones, accd, 0, 0, 0);
                }
            }
            __builtin_amdgcn_sched_barrier(0);
#pragma unroll
            for (int j = 0; j < 4; ++j) {
                const int p = 16 * pt + 4 * fq + j, tl = dir ? 63 - p : p, row = rowbase + tl;
                float inv = 1.f;
                if (IS_ML) { const float den = lane_read(accd[j], lane & 48); inv = __builtin_amdgcn_rcpf(fmaxf(fabsf(den), 1.f)); }
                const int cof = (IS_ML ? 384 : 0) + h * 64 + 32 * hf + fr;
                const unsigned boff = dir == 0 ? (unsigned)(row * D + 384 + cof) * 2u : (unsigned)(row * 640 + cof) * 2u;
                GAS char* ob = dir == 0 ? (GAS char*)Y : (GAS char*)OB;
#pragma unroll
                for (int et = 0; et < NET; ++et) *(GAS bf16*)(ob + boff + 32 * et) = (bf16)f2bf(acc[et][j] * inv);
            }
        }
        __builtin_amdgcn_sched_barrier(0);
#pragma unroll
        for (int dt = 0; dt < 4; ++dt)
#pragma unroll
            for (int et = 0; et < NET; ++et) C[dt][et] *= adec;
        f32x4 accn[4];
        if (IS_ML) {
#pragma unroll
            for (int dt = 0; dt < 4; ++dt) { accn[dt] = *(const LAS f32x4*)(nq + 16 * dt) * adec; if (fr != 0) accn[dt] = (f32x4){0.f, 0.f, 0.f, 0.f}; }
        }
#pragma unroll
        for (int kk = 0; kk < 2; ++kk) {
            u32x2 vlo[2], vhi[2], klo[4], khi[4];
            ds_tr16x4(va + (32 * kk + 4 * fq + tr_q) * CH_PITCH + 8 * tr_p + 64 * hf, vlo, vhi);
            ds_tr16x8(ka + (32 * kk + 4 * fq + tr_q) * CH_PITCH + 8 * tr_p, klo, khi);
            const f32x4 wl = *(const LAS f32x4*)(gq + 192 + 32 * kk), wh = *(const LAS f32x4*)(gq + 192 + 32 * kk + 16);
#pragma unroll
            for (int dt = 0; dt < 4; ++dt) {
                u32x4 w;
                w.x = pk2(__uint_as_float(klo[dt].x << 16) * wl[0], __uint_as_float(klo[dt].x & 0xffff0000u) * wl[1]);
                w.y = pk2(__uint_as_float(klo[dt].y << 16) * wl[2], __uint_as_float(klo[dt].y & 0xffff0000u) * wl[3]);
                w.z = pk2(__uint_as_float(khi[dt].x << 16) * wh[0], __uint_as_float(khi[dt].x & 0xffff0000u) * wh[1]);
                w.w = pk2(__uint_as_float(khi[dt].y << 16) * wh[2], __uint_as_float(khi[dt].y & 0xffff0000u) * wh[3]);
                const bf16x8 kf = __builtin_bit_cast(bf16x8, w);
#pragma unroll
                for (int et = 0; et < NET; ++et) C[dt][et] = __builtin_amdgcn_mfma_f32_16x16x32_bf16(kf, mk_frag(vlo[et], vhi[et]), C[dt][et], 0, 0, 0);
                if (IS_ML) accn[dt] = __builtin_amdgcn_mfma_f32_16x16x32_bf16(kf, ones, accn[dt], 0, 0, 0);
            }
        }
        if (IS_ML) { if (fr == 0) {
#pragma unroll
            for (int dt = 0; dt < 4; ++dt) *(LAS f32x4*)(nvec + 4 * fq + 16 * dt) = accn[dt]; } }
        asm volatile("s_waitcnt lgkmcnt(0)" ::: "memory");
        __syncthreads();
    }
}

#ifndef REP_HY
#define REP_HY 1
#endif
constexpr int NCHWG = 160;
__device__ __forceinline__ void phase_mix(Frame& F, int layer) {
    const bool last = layer == 1;
    const GAS bf16* ftl = WSP(const bf16, WS_FTL) + (size_t)layer * 2 * 384 * 4096;
    if (F.wg < NCHWG) {
        if (F.wave >= 4) {
#pragma unroll 1
            for (int i = 0; i < 72 * (F.wg * 2 < 192 ? REP_CH_RET : REP_CH_ML); ++i) __syncthreads();
        } else {
            const int cl = F.wave >> 1, hf = F.wave & 1, c = F.wg * 2 + cl;
            LAS unsigned char* img = F.lds + cl * CH_WAVE_LDS;
            if (c < 192) { const int b = c / 12, r = c % 12; chain_fast<false>(F, layer, b, r >> 1, r & 1, img, hf); }
            else { const int i = c - 192; chain_fast<true>(F, layer, i >> 3, (i & 7) >> 1, i & 1, img, hf); }
        }
    } else {
        const int nh = F.G - NCHWG, w = F.wg - NCHWG;
#pragma unroll 1
        for (int rp = 0; rp < REP_HY; ++rp)
            for (int u = w; u < 384; u += nh) hyena_unit_fast<LL>(F, layer, u, WSP(const bf16, WS_HYTL), ftl, WSP(bf16, WS_YHTL));
        if (!last) for (int u = w; u < 384; u += nh) hyena_unit_fast<LC>(F, layer, u, WSP(const bf16, WS_HYTC), WSP(const bf16, WS_FTC), WSP(bf16, WS_YHTC));
    }
}

__device__ __forceinline__ void phase_combine(Frame& F, int layer, bool dummy = false) {
    const bool last = layer == 1;
    const int gw = F.wg * NWAVES + F.wave, NGW = F.G * NWAVES, lane = F.lane;
    const int nrows = last ? TOKL : TOK;
    GAS bf16* Y = WSP(bf16, WS_Y); const GAS bf16* OB = WSP(const bf16, WS_OB); const GAS bf16* RET = WSP(const bf16, WS_RET); const GAS bf16* ML = WSP(const bf16, WS_ML);
    const int rsub = lane >> 4, l16 = lane & 15;
    for (int row0 = gw * 4; row0 < nrows; row0 += NGW * 4) {
        const int row = row0 + rsub;
        GAS bf16* yo = dummy ? WSP(bf16, WS_U + 300 * MiB) + (size_t)(row & 8191) * D : Y + (size_t)row * D;
        u32x2 of[10], ob[10], gt[10];
#pragma unroll
        for (int hh = 0; hh < 10; ++hh) {
            const int cof = hh * 64 + 4 * l16;
            of[hh] = *(const GAS u32x2*)(Y + (size_t)row * D + 384 + cof); ob[hh] = *(const GAS u32x2*)(OB + (size_t)row * 640 + cof);
            gt[hh] = hh < 6 ? *(const GAS u32x2*)(RET + (size_t)row * 1536 + 1152 + cof) : *(const GAS u32x2*)(ML + (size_t)row * 1024 + 768 + (cof - 384));
        }
#pragma unroll
        for (int hh = 0; hh < 10; ++hh) {
            float x[4], g[4];
            x[0] = __uint_as_float(of[hh].x << 16) + __uint_as_float(ob[hh].x << 16); x[1] = __uint_as_float(of[hh].x & 0xffff0000u) + __uint_as_float(ob[hh].x & 0xffff0000u);
            x[2] = __uint_as_float(of[hh].y << 16) + __uint_as_float(ob[hh].y << 16); x[3] = __uint_as_float(of[hh].y & 0xffff0000u) + __uint_as_float(ob[hh].y & 0xffff0000u);
            g[0] = __uint_as_float(gt[hh].x << 16); g[1] = __uint_as_float(gt[hh].x & 0xffff0000u); g[2] = __uint_as_float(gt[hh].y << 16); g[3] = __uint_as_float(gt[hh].y & 0xffff0000u);
            float sm = (x[0] + x[1]) + (x[2] + x[3]);
            DPP_ADD(sm, 0xB1); DPP_ADD(sm, 0x4E); DPP_ADD(sm, 0x141); DPP_ADD(sm, 0x140);
            const float mu = sm * (1.f / 64.f);
#pragma unroll
            for (int j = 0; j < 4; ++j) x[j] -= mu;
            float sq = (x[0] * x[0] + x[1] * x[1]) + (x[2] * x[2] + x[3] * x[3]);
            DPP_ADD(sq, 0xB1); DPP_ADD(sq, 0x4E); DPP_ADD(sq, 0x141); DPP_ADD(sq, 0x140);
            const float rs = rsqrtf(sq * (1.f / 64.f) + 1e-6f);
            float o[4];
#pragma unroll
            for (int j = 0; j < 4; ++j) o[j] = x[j] * rs * (hh < 6 ? siluf_(g[j]) : sigmoidf_(g[j]));
            u32x2 w; w.x = pk2(o[0], o[1]); w.y = pk2(o[2], o[3]);
            *(GAS u32x2*)(yo + 384 + hh * 64 + 4 * l16) = w;
        }
    }
    LAS unsigned char* scr = F.lds + F.wave * 8704;
    const int nitL = NB * 6 * 32, nitC = last ? 0 : NB * 6 * 4;
    for (int it = gw; it < nitL + nitC; it += NGW) {
        const GAS bf16* src; int L, rowbase, b, cb, tb;
        if (it < nitL) { b = it / 192; const int r = it % 192; cb = r / 32; tb = r % 32; L = LL; src = WSP(const bf16, WS_YHTL); rowbase = b * LL; }
        else { const int i2 = it - nitL; b = i2 / 24; const int r = i2 % 24; cb = r / 4; tb = r % 4; L = LC; src = WSP(const bf16, WS_YHTC); rowbase = TOKL + b * LC; }
        u32x4 v[8];
#pragma unroll
        for (int i = 0; i < 8; ++i) { const int cc = (lane >> 3) + 8 * i; v[i] = *(const GAS u32x4*)(src + ((size_t)(b * 384 + cb * 64 + cc)) * L + tb * 64 + 8 * (lane & 7)); }
#pragma unroll
        for (int i = 0; i < 8; ++i) { const int cc = (lane >> 3) + 8 * i; *(LAS u32x4*)(scr + cc * 136 + 16 * (lane & 7)) = v[i]; }
        asm volatile("s_waitcnt lgkmcnt(0)" ::: "memory");
#pragma unroll
        for (int i = 0; i < 8; ++i) {
            const int tt = (lane >> 3) + 8 * i, c8 = 8 * (lane & 7);
            unsigned short e[8];
#pragma unroll
            for (int j = 0; j < 8; ++j) e[j] = *(const LAS unsigned short*)(scr + (c8 + j) * 136 + tt * 2);
            u32x4 o; o.x = e[0] | ((unsigned)e[1] << 16); o.y = e[2] | ((unsigned)e[3] << 16); o.z = e[4] | ((unsigned)e[5] << 16); o.w = e[6] | ((unsigned)e[7] << 16);
            *(GAS u32x4*)((dummy ? WSP(bf16, WS_U + 300 * MiB) : Y) + (size_t)(dummy ? ((rowbase + tb * 64 + tt) & 8191) : (rowbase + tb * 64 + tt)) * D + cb * 64 + c8) = o;
        }
        asm volatile("s_waitcnt lgkmcnt(0)" ::: "memory");
    }
}

__device__ __forceinline__ void phase_norm_router(Frame& F) {
    const int gw = F.wg * NWAVES + F.wave, lane = F.lane;
    const GAS float* g = inp(F, I_GFFN) + 1 * D; const GAS float* wr = inp(F, I_ROUTER); const GAS float* br = inp(F, I_ROUTERB);
    GAS unsigned* cnt = WSP(unsigned, WS_CTL) + CW_CNT;
    const int r0 = gw * 16, r1 = r0 + 16;
    f32x4 gm[4], sh[4], w0r[4][4], w1r[4][4]; u32x2 ring[4][4];
    { const GAS float* shp = mod_ptr(F, 1, r0, 3); const GAS float* scp = mod_ptr(F, 1, r0, 4);
#pragma unroll
      for (int j = 0; j < 4; ++j) { const f32x4 gg = *(const GAS f32x4*)(g + 256 * j + 4 * lane), sc = *(const GAS f32x4*)(scp + 256 * j + 4 * lane); sh[j] = *(const GAS f32x4*)(shp + 256 * j + 4 * lane);
          gm[j].x = gg.x * (1.f + sc.x); gm[j].y = gg.y * (1.f + sc.y); gm[j].z = gg.z * (1.f + sc.z); gm[j].w = gg.w * (1.f + sc.w);
#pragma unroll
          for (int i = 0; i < 4; ++i) { const int k = 256 * j + 4 * lane + i; w0r[j][i] = *(const GAS f32x4*)(wr + k * 8); w1r[j][i] = *(const GAS f32x4*)(wr + k * 8 + 4); } }
#pragma unroll
      for (int i = 0; i < 4; ++i) xrow_issue<true>(F, r0 + i, 2, lane, ring[i]); }
    float brr[8];
#pragma unroll
    for (int e = 0; e < 8; ++e) brr[e] = br[e];
#pragma unroll 1
    for (int rb = r0; rb < r1; rb += 4) {
#pragma unroll
      for (int i = 0; i < 4; ++i) {
        const int row = rb + i;
        f32x4 v[4]; float s = 0.f;
#pragma unroll
        for (int j = 0; j < 4; ++j) { v[j] = xrow_unpack(ring[i][j]); s += (v[j].x * v[j].x + v[j].y * v[j].y) + (v[j].z * v[j].z + v[j].w * v[j].w); }
        if (row + 4 < r1) xrow_issue<true>(F, row + 4, 2, lane, ring[i]);
        const float r = rsqrtf(wave_sum(s) * (1.0f / 1024.0f) + 1e-6f);
        GAS bf16* orow = WSP(bf16, WS_H) + (size_t)row * D;
        float lg[8];
#pragma unroll
        for (int e = 0; e < 8; ++e) lg[e] = 0.f;
#pragma unroll
        for (int j = 0; j < 4; ++j) {
            f32x4 o; o.x = v[j].x * r * gm[j].x + sh[j].x; o.y = v[j].y * r * gm[j].y + sh[j].y; o.z = v[j].z * r * gm[j].z + sh[j].z; o.w = v[j].w * r * gm[j].w + sh[j].w;
            u32x2 w; w.x = pk2(o.x, o.y); w.y = pk2(o.z, o.w);
            *(GAS u32x2*)(orow + 256 * j + 4 * lane) = w;
            const float xo[4] = {o.x, o.y, o.z, o.w};
#pragma unroll
            for (int i = 0; i < 4; ++i) { const float x = xo[i]; const f32x4 w0 = w0r[j][i], w1 = w1r[j][i];
                lg[0] += x * w0.x; lg[1] += x * w0.y; lg[2] += x * w0.z; lg[3] += x * w0.w; lg[4] += x * w1.x; lg[5] += x * w1.y; lg[6] += x * w1.z; lg[7] += x * w1.w; }
        }
#pragma unroll
        for (int e = 0; e < 8; ++e) lg[e] = wave_sum(lg[e]) + brr[e];
        int e0 = 0; float v0 = lg[0];
#pragma unroll
        for (int e = 1; e < 8; ++e) if (lg[e] > v0) { v0 = lg[e]; e0 = e; }
        int e1 = -1; float v1 = -3.0e38f;
#pragma unroll
        for (int e = 0; e < 8; ++e) if (e != e0 && lg[e] > v1) { v1 = lg[e]; e1 = e; }
        const float w1 = 1.f / (1.f + __expf(v0 - v1)), w0 = 1.f - w1;
        if (lane == 0) {
            const unsigned p0 = __hip_atomic_fetch_add(cnt + e0, 1u, __ATOMIC_RELAXED, __HIP_MEMORY_SCOPE_AGENT), p1 = __hip_atomic_fetch_add(cnt + e1, 1u, __ATOMIC_RELAXED, __HIP_MEMORY_SCOPE_AGENT);
            WSP(int, WS_TOPE)[row * 2] = e0; WSP(int, WS_TOPE)[row * 2 + 1] = e1;
            WSP(float, WS_TOPW)[row * 2] = w0; WSP(float, WS_TOPW)[row * 2 + 1] = w1;
            WSP(int, WS_TOPP)[row * 2] = (int)p0; WSP(int, WS_TOPP)[row * 2 + 1] = (int)p1;
        }
      }
    }
}
__device__ __forceinline__ void phase_route_tables(Frame& F) {
    const GAS unsigned* cnt = WSP(const unsigned, WS_CTL) + CW_CNT;
    int off[9]; off[0] = 0;
#pragma unroll
    for (int e = 0; e < 8; ++e) { const int c = (int)__hip_atomic_load(cnt + e, __ATOMIC_RELAXED, __HIP_MEMORY_SCOPE_AGENT); off[e + 1] = off[e] + ((c + 255) >> 8) * 256; }
    const int gt = F.wg * NTHR + F.tid, NGT = F.G * NTHR;
    GAS int* rowidx = WSP(int, WS_ROWIDX); GAS int* slot = WSP(int, WS_SLOT); GAS int* tilee = WSP(int, WS_TILEE);
    for (int i = gt; i < MAXTILES * 256; i += NGT) {
        int e = 0;
#pragma unroll
        for (int q = 1; q < 8; ++q) if (i >= off[q]) e = q;
        const int c = (int)cnt[e];
        if (i >= off[8] || i - off[e] >= c) rowidx[i] = 0;
    }
    for (int i = gt; i < TOKL * 2; i += NGT) {
        const int e = WSP(const int, WS_TOPE)[i], pos = WSP(const int, WS_TOPP)[i];
        int o = 0;
#pragma unroll
        for (int q = 0; q < 8; ++q) if (e == q) o = off[q];
        const int s = o + pos; slot[i] = s; rowidx[s] = i >> 1;
    }
    for (int i = gt; i < MAXTILES + 1; i += NGT) {
        if (i == MAXTILES) tilee[MAXTILES] = off[8] >> 8;
        else { int e = 0;
#pragma unroll
            for (int q = 1; q < 8; ++q) if (i * 256 >= off[q]) e = q;
            tilee[i] = e; }
    }
}

__device__ __forceinline__ void moe_pass_gemm1_fast(Frame& F, int t0, int t1) {
    pg8::OrderMoe S; S.o.init(t1 - t0, NFF1 / 256, F.G, F.wg); S.rowidx = WSP(const int, WS_ROWIDX); S.tilee = WSP(const int, WS_TILEE); S.t0 = t0; S.bstride = (size_t)NFF1 * D; S.gather = true;
    EpiSwiglu E{WSP(bf16, WS_MACT), 0};
    pg8::gemm_phase(F.lds, F.tid, WSP(const bf16, WS_H), D, WSP(const bf16, WS_MW13), D, D, S, E);
}
__device__ __forceinline__ void moe_pass_gemm2_fast(Frame& F, int t0, int t1) {
    pg8::OrderMoe S; S.o.init(t1 - t0, D / 256, F.G, F.wg); S.rowidx = WSP(const int, WS_ROWIDX); S.tilee = WSP(const int, WS_TILEE); S.t0 = t0; S.bstride = (size_t)D * DFF; S.gather = false;
    EpiBf16Out E{WSP(bf16, WS_EOUT), D, t0 * 256};
    pg8::gemm_phase(F.lds, F.tid, WSP(const bf16, WS_MACT), DFF, WSP(const bf16, WS_MW2), DFF, DFF, S, E);
}
__device__ __forceinline__ void phase_final(Frame& F, GAS float* dummy = nullptr) {
    const int gw = F.wg * NWAVES + F.wave, NGW = F.G * NWAVES, lane = F.lane;
    const GAS float* gf = inp(F, I_GFINAL); const GAS bf16* eo = WSP(const bf16, WS_EOUT);
#pragma unroll 2
    for (int row = gw; row < TOKL; row += NGW) {
        const int s0 = WSP(const int, WS_SLOT)[row * 2], s1 = WSP(const int, WS_SLOT)[row * 2 + 1];
        const float w0 = WSP(const float, WS_TOPW)[row * 2], w1 = WSP(const float, WS_TOPW)[row * 2 + 1];
        const GAS float* m5 = mod_ptr(F, 1, row, 5);
        GAS float* xr = outp(F) + (size_t)row * D; const GAS bf16* xb = WSP(const bf16, WS_XL2) + (size_t)row * D;
        f32x4 v[4]; float s = 0.f;
#pragma unroll
        for (int j = 0; j < 4; ++j) {
            const int c = 256 * j + 4 * lane;
            const f32x4 a = ld_bf16x4(eo + (size_t)s0 * D + c), b = ld_bf16x4(eo + (size_t)s1 * D + c), m = *(const GAS f32x4*)(m5 + c);
            v[j] = ld_bf16x4(xb + c) + m * (a * w0 + b * w1);
            s += (v[j].x * v[j].x + v[j].y * v[j].y) + (v[j].z * v[j].z + v[j].w * v[j].w);
        }
        const float r = rsqrtf(wave_sum(s) * (1.f / 1024.f) + 1e-6f);
#pragma unroll
        for (int j = 0; j < 4; ++j) { const int c = 256 * j + 4 * lane; const f32x4 g = *(const GAS f32x4*)(gf + c); GAS float* o_ = dummy ? dummy + (size_t)(row & 8191) * D : xr; *(GAS f32x4*)(o_ + c) = v[j] * r * g; }
    }
}

#ifndef MR_L0
#define MR_L0 192
#endif
#ifndef REP_WIN
#define REP_WIN 1
#endif
#ifndef REP_MIX
#define REP_MIX 1
#endif
#ifndef REP_GATE
#define REP_GATE 1
#endif
#ifndef REP_UP
#define REP_UP 1
#endif
#ifndef REP_FFN1
#define REP_FFN1 1
#endif
#ifndef REP_MOE
#define REP_MOE 1
#endif
#ifndef REP_NORM
#define REP_NORM 1
#endif
#ifndef REP_P0
#define REP_P0 1
#endif
__global__ void __launch_bounds__(NTHR, 2) hybrid_fwd(Params prm) {
    extern __shared__ __attribute__((aligned(16))) unsigned char lds_raw[];
    Frame F;
    F.lds = (LAS unsigned char*)lds_raw; F.ws = (GAS unsigned char*)prm.ws;
    F.tid = threadIdx.x; F.lane = F.tid & 63; F.wave = __builtin_amdgcn_readfirstlane(F.tid >> 6); F.G = gridDim.x; F.wg = blockIdx.x;
    volatile LAS unsigned* MISC = (volatile LAS unsigned*)(F.lds + MISC_OFF);
    if (F.tid < 64) MISC[F.tid] = 0u;
    if (F.tid < 33) { const unsigned long long v = F.tid < 32 ? (unsigned long long)prm.in[F.tid] : (unsigned long long)prm.out; *(LAS unsigned long long*)(F.lds + PTAB_OFF + 8 * F.tid) = v; }
    __syncthreads();
    XcdBarrier bar = xcd_barrier_post(WSP(unsigned, WS_CTL) + CW_BAR, MISC + 8);
#define RELAUNDER() do { { unsigned long long _w = (unsigned long long)F.ws; asm volatile("" : "+s"(_w)); F.ws = (GAS unsigned char*)_w; } \
        { unsigned _t = (unsigned)F.tid; asm volatile("" : "+v"(_t)); F.tid = (int)_t; F.lane = F.tid & 63; F.wave = __builtin_amdgcn_readfirstlane(F.tid >> 6); } \
        { unsigned _g = (unsigned)F.G, _b = (unsigned)F.wg; asm volatile("" : "+s"(_g), "+s"(_b)); F.G = (int)_g; F.wg = (int)_b; } \
        { unsigned _l = (unsigned)(size_t)F.lds; asm volatile("" : "+s"(_l)); F.lds = (LAS unsigned char*)(size_t)_l; } } while (0)
#define GRID_BAR() do { { unsigned long long _b = (unsigned long long)bar.bar; unsigned _x = bar.x; asm volatile("" : "+s"(_b), "+s"(_x)); bar.bar = (GAS unsigned*)_b; bar.x = _x; } xcd_barrier(bar); RELAUNDER(); } while (0)

    for (int rp = 0; rp < REP_P0; ++rp) { phase_p0(F); write_bias(F);
    GRID_BAR(); }
#pragma unroll 1
    for (int layer_ = 0; layer_ < 2; ++layer_) {
        int layer = layer_;
#define last (layer == 1)
#define rows_all TOK
#define rows_out (last ? TOKL : TOK)
#define modbase (WSP(const float, WS_MOD) + (size_t)layer * 17 * 6144)
#define LAYER_LAUNDER() asm volatile("" : "+s"(layer))
        for (int rp = 0; rp < REP_NORM; ++rp) { if (last) phase_norm<true>(F, layer, rows_all, 0); else phase_norm<false>(F, layer, rows_all, 0);
        if (layer == 0) { const int gw = F.wg * NWAVES + F.wave, NGW = F.G * NWAVES;
            for (int it = gw; it < 1536 + 96; it += NGW) filter_out_item(F, it); }
        { GRID_BAR(); LAYER_LAUNDER(); } }
        for (int rp = 0; rp < REP_WIN; ++rp) {
        { EpiWin E{WSP(const float, WS_BIAS) + layer * NWP, WSP(bf16, WS_HYTL), WSP(bf16, WS_HYTC), WSP(bf16, WS_RET), WSP(bf16, WS_ML), WSP(float, WS_MLG)};
          if (last) { pg8::OrderWinL1 S; S.init(F.G, F.wg); pg8::gemm_phase(F.lds, F.tid, WSP(const bf16, WS_H), D, WSP(const bf16, WS_WIN), D, D, S, E); }
          else gemm_fast(F, WSP(const bf16, WS_H), D, WSP(const bf16, WS_WIN), D, D, rows_all, NW1, E); }
        { GRID_BAR(); LAYER_LAUNDER(); } }
        for (int rp = 0; rp < REP_MIX; ++rp) { phase_mix(F, layer);
        { GRID_BAR(); LAYER_LAUNDER(); } }
#ifndef REP_COMB
#define REP_COMB 1
#endif
        for (int rp = REP_COMB - 1; rp > 0; --rp) { phase_combine(F, layer, true); { GRID_BAR(); LAYER_LAUNDER(); } }
        phase_combine(F, layer);
        { GRID_BAR(); LAYER_LAUNDER(); }
        for (int rp = 0; rp < REP_GATE; ++rp) {
        { EpiGate E{WSP(const float, WS_BIAS) + layer * NWP + NW1, WSP(bf16, WS_GATES)};
          gemm_fast(F, WSP(const bf16, WS_H), D, WSP(const bf16, WS_WIN) + (size_t)NW1 * D, D, D, rows_out, NGATE, E); }
        { GRID_BAR(); LAYER_LAUNDER(); } }
        for (int rp = 0; rp < REP_UP; ++rp) {
        { EpiUp E{WSP(const bf16, WS_GATES), WSP(bf16, WS_H)};
          if (last) gemm_fast(F, WSP(const bf16, WS_Y), D, WSP(const bf16, WS_WUP), D, D, TOKL, D, E);
          else gemm_fast<MR_L0>(F, WSP(const bf16, WS_Y), D, WSP(const bf16, WS_WUP), D, D, TOK, D, E); }
        { GRID_BAR(); LAYER_LAUNDER(); } }
#ifndef REP_OUT
#define REP_OUT 1
#endif
        if (last) { EpiResidT<true> E{(const GAS bf16*)outp(F), nullptr, WSP(bf16, WS_XL2), nullptr, modbase, 2};
            gemm_fast(F, WSP(const bf16, WS_H), D, WSP(const bf16, WS_WOUT), D, D, TOKL, D, E); }
        else { EpiResidT<false> E{inp(F, I_X), inp(F, I_CTX), (GAS bf16*)outp(F), WSP(bf16, WS_XC), modbase, 2};
            gemm_fast<MR_L0>(F, WSP(const bf16, WS_H), D, WSP(const bf16, WS_WOUT), D, D, TOK, D, E); }
        { GRID_BAR(); LAYER_LAUNDER(); }
        if (!last) {
            phase_norm<true>(F, layer, rows_out, 3);
            { const int gw = F.wg * NWAVES + F.wave, NGW = F.G * NWAVES; LAS float* scr = (LAS float*)(F.lds + F.wave * 8704);
              conv_weights_ffn(inp(F, I_FW1), inp(F, I_FW3), inp(F, I_FW2), WSP(bf16, WS_W13), WSP(bf16, WS_W2), gw, NGW, scr, F.lane);
              conv_weights_win(F, 1, gw, NGW, scr);
              conv_weights_upout(F, 1, gw, NGW, scr); }
            { GRID_BAR(); LAYER_LAUNDER(); }
            for (int rp = 0; rp < REP_FFN1; ++rp) {
            { EpiSwiglu E{WSP(bf16, WS_ACT), 0};
              gemm_fast(F, WSP(const bf16, WS_H), D, WSP(const bf16, WS_W13), D, D, rows_out, NFF1, E); }
            { GRID_BAR(); LAYER_LAUNDER(); } }
#ifndef REP_FFN2
#define REP_FFN2 1
#endif
            { EpiResidT<true> E{(const GAS bf16*)outp(F), WSP(const bf16, WS_XC), (GAS bf16*)outp(F), WSP(bf16, WS_XC), modbase, 5};
              gemm_fast<MR_L0>(F, WSP(const bf16, WS_ACT), DFF, WSP(const bf16, WS_W2), DFF, DFF, TOK, D, E); }
            { GRID_BAR(); LAYER_LAUNDER(); }
        }
    }
#undef LAYER_LAUNDER
#undef last
#undef rows_all
#undef rows_out
#undef modbase
    phase_norm_router(F);
    { const int gw = F.wg * NWAVES + F.wave, NGW = F.G * NWAVES; LAS float* scr = (LAS float*)(F.lds + F.wave * 8704);
#ifndef REP_MCONV
#define REP_MCONV 1
#endif
#pragma unroll 1
      for (int e = 0; e < NE * REP_MCONV; ++e)
          conv_weights_ffn(inp(F, I_MW1) + (size_t)(e % NE) * D * DFF, inp(F, I_MW3) + (size_t)(e % NE) * D * DFF, inp(F, I_MW2) + (size_t)(e % NE) * DFF * D,
                           WSP(bf16, WS_MW13) + (size_t)(e % NE) * NFF1 * D, WSP(bf16, WS_MW2) + (size_t)(e % NE) * D * DFF, gw, NGW, scr, F.lane); }
    GRID_BAR();
    phase_route_tables(F);
    GRID_BAR();
    const int ntiles = __builtin_amdgcn_readfirstlane(WSP(const int, WS_TILEE)[MAXTILES]);
#pragma unroll 1
    for (int p = 0; p < NPASS; ++p) {
        const int t0 = p * PASS_TILES, t1 = min(ntiles, t0 + PASS_TILES);
        for (int rp = 0; rp < REP_MOE; ++rp) {
        if (t0 < t1) moe_pass_gemm1_fast(F, t0, t1);
        GRID_BAR();
        if (t0 < t1) moe_pass_gemm2_fast(F, t0, t1);
        GRID_BAR(); }
    }
#ifndef REP_BAR
#define REP_BAR 0
#endif
    for (int rb = 0; rb < REP_BAR; ++rb) GRID_BAR();
#ifndef REP_FINAL
#define REP_FINAL 1
#endif
    for (int rp = REP_FINAL - 1; rp > 0; --rp) { phase_final(F, WSP(float, WS_H)); GRID_BAR(); }
    phase_final(F);
}

extern "C" void kernel_launch(void* const* d_in, const int* in_sizes, int n_in, void* d_out, int out_size, void* d_ws, size_t ws_size, hipStream_t stream) {
    static int grid = 0;
    if (grid == 0) {
        if (n_in != 32 || out_size != TOKL * D || ws_size < WS_END) { fprintf(stderr, "kernel_launch: unexpected arguments (n_in %d, out %d, ws %zu)\n", n_in, out_size, ws_size); grid = -1; return; }
        int dev = 0, cus = 0;
        if (hipGetDevice(&dev) != hipSuccess || hipDeviceGetAttribute(&cus, hipDeviceAttributeMultiprocessorCount, dev) != hipSuccess) { grid = -1; return; }
        if (hipFuncSetAttribute((const void*)hybrid_fwd, hipFuncAttributeMaxDynamicSharedMemorySize, LDS_BYTES) != hipSuccess) { grid = -1; return; }
        int per_cu = 0;
        (void)hipOccupancyMaxActiveBlocksPerMultiprocessor(&per_cu, (const void*)hybrid_fwd, NTHR, LDS_BYTES);
        (void)hipGetLastError();
        if (cus < 256) { fprintf(stderr, "kernel_launch: needs 256 compute units (one workgroup each), found %d\n", cus); grid = -1; return; }
        grid = 256;
    }
    if (grid < 0) return;
    (void)hipMemsetAsync((char*)d_ws + WS_CTL, 0, CTL_ZERO_BYTES, stream);
    Params p{};
    for (int i = 0; i < 32; ++i) p.in[i] = (const float*)d_in[i];
    p.out = (float*)d_out; p.ws = (unsigned char*)d_ws;
    hipLaunchKernelGGL(hybrid_fwd, dim3(grid), dim3(NTHR), LDS_BYTES, stream, p);
}
```

```cpp
#include <hip/hip_runtime.h>
#include <stdint.h>
#include <stdio.h>

#define LAS __attribute__((address_space(3)))
#define GAS __attribute__((address_space(1)))
typedef unsigned short bf16;
typedef short bf16x8 __attribute__((ext_vector_type(8)));
typedef float f32x4 __attribute__((ext_vector_type(4)));
typedef unsigned u32x4 __attribute__((ext_vector_type(4)));
typedef unsigned u32x2 __attribute__((ext_vector_type(2)));

constexpr int D = 1024, NB = 16, LL = 2048, LC = 256;
constexpr int TOKL = NB * LL, TOKC = NB * LC, TOK = TOKL + TOKC;
constexpr int HYW = 384, RETW = 384, MLW = 256;
constexpr int NIN = 6800, NW1 = 3840, NGATE = 3072, NWP = 6912;
constexpr int DFF = 2816, NFF1 = 5632, NE = 8;
constexpr int NWAVES = 8, NTHR = 512;
constexpr int MAXTILES = 272, PASS_TILES = 58, NPASS = 5;

constexpr size_t MiB = 1u << 20;
constexpr size_t WS_CTL = 0, CTL_ZERO_BYTES = 1 * MiB;
constexpr size_t WS_MOD = 1 * MiB;
constexpr size_t WS_BIAS = 2 * MiB;
constexpr size_t WS_ROPE = 2 * MiB + 256 * 1024;
constexpr size_t WS_TOPE = 3 * MiB;
constexpr size_t WS_TOPW = 3 * MiB + 256 * 1024;
constexpr size_t WS_TOPP = 3 * MiB + 512 * 1024;
constexpr size_t WS_SLOT = 3 * MiB + 768 * 1024;
constexpr size_t WS_ROWIDX = 4 * MiB;
constexpr size_t WS_TILEE = 4 * MiB + 512 * 1024;
constexpr size_t WS_FTL = 5 * MiB;
constexpr size_t WS_FTC = 17 * MiB;
constexpr size_t WS_WIN = 18 * MiB;
constexpr size_t WS_WUP = 32 * MiB;
constexpr size_t WS_WOUT = 34 * MiB;
constexpr size_t WS_XC = 36 * MiB;
constexpr size_t WS_H = 52 * MiB;
constexpr size_t WS_Y = 124 * MiB;
constexpr size_t WS_U = 196 * MiB;
constexpr size_t WS_RET = WS_U;
constexpr size_t WS_ML = WS_U + 108 * MiB;
constexpr size_t WS_MLG = WS_U + 180 * MiB;
constexpr size_t WS_OB = WS_U + 183 * MiB;
constexpr size_t WS_YHTL = WS_U + 228 * MiB;
constexpr size_t WS_YHTC = WS_U + 252 * MiB;
constexpr size_t WS_HYTL = WS_U + 255 * MiB;
constexpr size_t WS_HYTC = WS_U + 327 * MiB;
constexpr size_t WS_XL2 = WS_U + 284 * MiB;
constexpr size_t WS_END = WS_U + 348 * MiB;
constexpr size_t WS_GATES = WS_U;
constexpr size_t WS_ACT = WS_U;
constexpr size_t WS_W13 = WS_U + 204 * MiB;
constexpr size_t WS_W2 = WS_U + 216 * MiB;
constexpr size_t WS_MW13 = WS_Y;
constexpr size_t WS_MW2 = WS_Y + 88 * MiB;
constexpr size_t WS_MACT = WS_Y + 132 * MiB;
constexpr size_t WS_EOUT = WS_Y + 220 * MiB;
static_assert(WS_EOUT + (size_t)MAXTILES * 256 * 1024 * 2 <= WS_XL2, "map");
static_assert(WS_GATES + (size_t)TOK * NGATE * 2 <= WS_YHTL, "gates overlay");

constexpr int CW_BAR = 4096;
constexpr int CW_CNT = 16384;

constexpr int LDS_BYTES = 147456;
constexpr int MISC_OFF = 147456 - 256;

__device__ __forceinline__ float bf2f(bf16 b) { return __uint_as_float(((unsigned)b) << 16); }
typedef __bf16 bf2v_ __attribute__((ext_vector_type(2)));
typedef float f2v_ __attribute__((ext_vector_type(2)));
__device__ __forceinline__ unsigned pk2(float lo, float hi) { const f2v_ f = {lo, hi}; return __builtin_bit_cast(unsigned, __builtin_convertvector(f, bf2v_)); }
__device__ __forceinline__ unsigned f2bf(float f) { return pk2(f, 0.f) & 0xffffu; }
__device__ __forceinline__ float dpp_f(float v, int) { return v; }
#define DPP_ADD(v, ctrl) (v) += __int_as_float(__builtin_amdgcn_update_dpp(0, __float_as_int(v), (ctrl), 0xf, 0xf, true))
__device__ __forceinline__ float wave_sum(float v) {
    DPP_ADD(v, 0xB1);
    DPP_ADD(v, 0x4E);
    DPP_ADD(v, 0x141);
    DPP_ADD(v, 0x140);
    return __int_as_float(__builtin_amdgcn_readlane(__float_as_int(v), 0)) + __int_as_float(__builtin_amdgcn_readlane(__float_as_int(v), 16))
         + __int_as_float(__builtin_amdgcn_readlane(__float_as_int(v), 32)) + __int_as_float(__builtin_amdgcn_readlane(__float_as_int(v), 48));
}
__device__ __forceinline__ float lane_read(float v, int src_lane) { return __int_as_float(__builtin_amdgcn_ds_bpermute(src_lane << 2, __float_as_int(v))); }
__device__ __forceinline__ float sigmoidf_(float x) { return __builtin_amdgcn_rcpf(1.0f + __expf(-x)); }
__device__ __forceinline__ float siluf_(float x) { return x * __builtin_amdgcn_rcpf(1.0f + __expf(-x)); }

#define XB_TMO      128
#define XB_XCNT(j)  (256  + 64 * (j))
#define XB_XSUB(j)  (1280 + 64 * (j))
#define XB_XGEN(j)  (2304 + 64 * (j))
#define XB_TOP      3328
#define XB_TOPGEN   3392
#define XCD_BAR_WORDS 3456
#define XB_SPIN_CAP (1u << 22)
__device__ __forceinline__ unsigned xb_ld(GAS unsigned* p)              { return __hip_atomic_load(p, __ATOMIC_RELAXED, __HIP_MEMORY_SCOPE_AGENT); }
__device__ __forceinline__ unsigned xb_add(GAS unsigned* p, unsigned v) { return __hip_atomic_fetch_add(p, v, __ATOMIC_RELAXED, __HIP_MEMORY_SCOPE_AGENT); }
__device__ __forceinline__ unsigned xb_xcc_id() { return (unsigned)__builtin_amdgcn_s_getreg((3 << 11) | 20) & 0xFu; }
#ifndef XB_SLEEP
#define XB_SLEEP 0
#endif
#define XB_SPIN(cond, bar) do { unsigned _sp = 0; while (cond) { if (XB_SLEEP) __builtin_amdgcn_s_sleep(1); \
    if ((++_sp & 255u) == 0u) { if (xb_ld(&(bar)[XB_TMO])) break; if (_sp > XB_SPIN_CAP) { (void)__hip_atomic_fetch_add(&(bar)[XB_TMO], 1u, __ATOMIC_RELAXED, __HIP_MEMORY_SCOPE_AGENT); break; } } } } while (0)
struct XcdBarrier { GAS unsigned* bar; unsigned x; volatile LAS unsigned* st; };
__device__ __forceinline__ XcdBarrier xcd_barrier_post(GAS unsigned* bar, volatile LAS unsigned* st) {
    XcdBarrier b; b.bar = bar; b.x = xb_xcc_id(); b.st = st;
    if (threadIdx.x == 0) (void)xb_add(&bar[XB_XCNT(b.x)], 1u);
    return b;
}
__device__ __forceinline__ void xcd_barrier_complete(GAS unsigned* bar, unsigned x, unsigned& nloc, unsigned& nx) {
    const unsigned G = gridDim.x * gridDim.y * gridDim.z;
    unsigned sum, cnt, mine, sp = 0u;
    for (;;) {
        sum = 0u; cnt = 0u; mine = 0u;
#pragma unroll 1
        for (unsigned j = 0; j < 16; ++j) { const unsigned c = xb_ld(&bar[XB_XCNT(j)]); sum += c; cnt += (c > 0u) ? 1u : 0u; }
        mine = xb_ld(&bar[XB_XCNT(x)]);
        if (sum == G) break;
        __builtin_amdgcn_s_sleep(1);
        if ((++sp & 255u) == 0u) { if (xb_ld(&bar[XB_TMO])) break; if (sp > XB_SPIN_CAP) { (void)__hip_atomic_fetch_add(&bar[XB_TMO], 1u, __ATOMIC_RELAXED, __HIP_MEMORY_SCOPE_AGENT); break; } }
    }
    nloc = mine > 0u ? mine : 1u; nx = cnt > 0u ? cnt : 1u;
}
__device__ __forceinline__ void xcd_barrier(const XcdBarrier& b) {
    asm volatile("s_waitcnt vmcnt(0)" ::: "memory");
    __syncthreads();
    if (threadIdx.x == 0) {
        GAS unsigned* bar = b.bar;
        __builtin_amdgcn_s_waitcnt(0);
        unsigned nloc = b.st[0], nx = b.st[1];
        if (nloc == 0u) { xcd_barrier_complete(bar, b.x, nloc, nx); b.st[0] = nloc; b.st[1] = nx; }
        const unsigned old = xb_add(&bar[XB_XSUB(b.x)], 1u);
        const unsigned gen = old / nloc;
        if (old + 1u == (gen + 1u) * nloc) {
            __builtin_amdgcn_fence(__ATOMIC_RELEASE, "agent");
            asm volatile("s_waitcnt vmcnt(0)" ::: "memory");
            const unsigned og = xb_add(&bar[XB_TOP], 1u);
            const unsigned tg = og / nx;
            if (og + 1u == (tg + 1u) * nx) xb_add(&bar[XB_TOPGEN], 1u);
            else XB_SPIN(xb_ld(&bar[XB_TOPGEN]) == tg, bar);
            __builtin_amdgcn_fence(__ATOMIC_ACQUIRE, "agent");
            xb_add(&bar[XB_XGEN(b.x)], 1u);
            asm volatile("s_waitcnt vmcnt(0)" ::: "memory");
        } else {
            XB_SPIN(xb_ld(&bar[XB_XGEN(b.x)]) == gen, bar);
            __builtin_amdgcn_fence(__ATOMIC_ACQUIRE, "agent");
            asm volatile("s_waitcnt vmcnt(0)" ::: "memory");
        }
    }
    __syncthreads();
}

struct Params { const float* in[32]; float* out; unsigned char* ws; };
enum { I_X = 0, I_C, I_CTX, I_CCTX, I_WMOD, I_BMOD, I_GMIX, I_GFFN, I_WIN, I_BIN, I_HYCONV, I_HYF1, I_HYFB1, I_HYF2, I_HYFB2, I_HYF3, I_HYDECAY,
       I_HYSKIP, I_RETDECAY, I_MLCONV, I_MLGB, I_WUP, I_WOUT, I_FW1, I_FW3, I_FW2, I_ROUTER, I_ROUTERB, I_MW1, I_MW3, I_MW2, I_GFINAL };

struct Frame {
    LAS unsigned char* lds;
    GAS unsigned char* ws;
    int tid, lane, wave, G, wg;
};
#define WSP(T, off) ((GAS T*)(F.ws + (off)))
constexpr int PTAB_OFF = 147456 - 1024;
__device__ __forceinline__ const GAS float* inp(const Frame& F, int i) {
    const LAS unsigned* t = (const LAS unsigned*)(F.lds + PTAB_OFF) + 2 * i;
    const unsigned lo = __builtin_amdgcn_readfirstlane(t[0]), hi = __builtin_amdgcn_readfirstlane(t[1]);
    return (const GAS float*)(((unsigned long long)hi << 32) | lo);
}
__device__ __forceinline__ GAS float* outp(const Frame& F) { return (GAS float*)inp(F, 32); }

__device__ __forceinline__ int row_batch(int row) { return row < TOKL ? (row >> 11) : ((row - TOKL) >> 8); }
__device__ __forceinline__ const GAS float* mod_ptr(const Frame& F, int layer, int row, int which) {
    const int r = row < TOKL ? (row >> 11) : 16;
    return WSP(const float, WS_MOD) + ((size_t)(layer * 17 + r) * 6 + which) * 1024;
}

template <class RowMap>
__device__ __forceinline__ void tr_item(const GAS float* W, int K, int N, GAS bf16* WT, int ldT, RowMap rm, LAS float* scr, int item, int lane) {
    const int nblk = (N + 31) / 32, kb = item / nblk, nb = item % nblk, k0 = 64 * kb, n0 = 32 * nb;
    { f32x4 tv[8];
#pragma unroll
      for (int i = 0; i < 8; ++i) { const int kk = 8 * i + (lane >> 3); const int n = n0 + 4 * (lane & 7); tv[i] = (n < N) ? *(const GAS f32x4*)(W + (size_t)(k0 + kk) * N + n) : (f32x4){0.f, 0.f, 0.f, 0.f}; }
#pragma unroll
      for (int i = 0; i < 8; ++i) { const int kk = 8 * i + (lane >> 3); LAS float* d = scr + kk * 33 + 4 * (lane & 7); d[0] = tv[i].x; d[1] = tv[i].y; d[2] = tv[i].z; d[3] = tv[i].w; } }
    asm volatile("s_waitcnt lgkmcnt(0)" ::: "memory");
    const int c = lane & 7;
#pragma unroll
    for (int j = 0; j < 4; ++j) { const int nl = (lane >> 3) + 8 * j; const int n = n0 + nl; const LAS float* s = scr + (8 * c) * 33 + nl;
        u32x4 o; o.x = pk2(s[0 * 33], s[1 * 33]); o.y = pk2(s[2 * 33], s[3 * 33]); o.z = pk2(s[4 * 33], s[5 * 33]); o.w = pk2(s[6 * 33], s[7 * 33]);
        if (n < N) *(GAS u32x4*)(WT + (size_t)rm(n) * ldT + k0 + 8 * c) = o; }
    asm volatile("s_waitcnt lgkmcnt(0)" ::: "memory");
}
struct RmId { __device__ __forceinline__ int operator()(int n) const { return n; } };
__device__ __forceinline__ int win_row(int n) {
    if (n < 1152) return n;
    if (n < 2688) return 1280 + (n - 1152);
    if (n < 3712) return 2816 + (n - 2688);
    if (n < 3728) return 1152 + (n - 3712);
    return 3840 + (n - 3728);
}
struct RmWin { __device__ __forceinline__ int operator()(int n) const { return win_row(n); } };
struct RmW1 { __device__ __forceinline__ int operator()(int n) const { return (n >> 4) * 32 + (n & 15); } };
struct RmW3 { __device__ __forceinline__ int operator()(int n) const { return (n >> 4) * 32 + 16 + (n & 15); } };

__device__ __forceinline__ void conv_weights_win(Frame& F, int layer, int gw, int NGW, LAS float* scr) {
    const GAS float* W = inp(F, I_WIN) + (size_t)layer * D * NIN;
    const int items = (D / 64) * ((NIN + 31) / 32);
    for (int it = gw; it < items; it += NGW) tr_item(W, D, NIN, WSP(bf16, WS_WIN), D, RmWin(), scr, it, F.lane);
    GAS bf16* wt = WSP(bf16, WS_WIN);
    unsigned zz; asm volatile("v_mov_b32 %0, 0" : "=v"(zz));
    for (int i = gw * 64 + F.lane; i < 112 * 1024 / 8; i += NGW * 64) *(GAS u32x4*)(wt + (size_t)1168 * 1024 + (size_t)i * 8) = (u32x4){zz, zz, zz, zz};
}
__device__ __forceinline__ void conv_weights_upout(Frame& F, int layer, int gw, int NGW, LAS float* scr) {
    const int items = (D / 64) * (D / 32);
    for (int it = gw; it < items; it += NGW) tr_item(inp(F, I_WUP) + (size_t)layer * D * D, D, D, WSP(bf16, WS_WUP), D, RmId(), scr, it, F.lane);
    for (int it = gw; it < items; it += NGW) tr_item(inp(F, I_WOUT) + (size_t)layer * D * D, D, D, WSP(bf16, WS_WOUT), D, RmId(), scr, it, F.lane);
}
__device__ __forceinline__ void conv_weights_ffn(const GAS float* w1, const GAS float* w3, const GAS float* w2, GAS bf16* w13t, GAS bf16* w2t, int gw, int NGW, LAS float* scr, int lane) {
    const int i1 = (D / 64) * (DFF / 32), i2 = (DFF / 64) * (D / 32);
    for (int it = gw; it < i1; it += NGW) tr_item(w1, D, DFF, w13t, D, RmW1(), scr, it, lane);
    for (int it = gw; it < i1; it += NGW) tr_item(w3, D, DFF, w13t, D, RmW3(), scr, it, lane);
    for (int it = gw; it < i2; it += NGW) tr_item(w2, DFF, D, w2t, DFF, RmId(), scr, it, lane);
}

constexpr size_t WS_HID2 = WS_XC;
__device__ __forceinline__ void filter_hidden_item(Frame& F, int p) {
    const int sel = p < 2048 ? 0 : (p < 4096 ? 1 : 2), layer = sel == 1 ? 1 : 0, L = sel == 2 ? LC : LL, pbase = sel == 0 ? 0 : (sel == 1 ? 2048 : 4096);
    const GAS float* f1 = inp(F, I_HYF1) + layer * 33 * 64; const GAS float* fb1 = inp(F, I_HYFB1) + layer * 64;
    const GAS float* f2 = inp(F, I_HYF2) + layer * 64 * 64; const GAS float* fb2 = inp(F, I_HYFB2) + layer * 64;
    const int lane = F.lane;
    float w1[33], w2[64];
#pragma unroll
    for (int i = 0; i < 33; ++i) w1[i] = f1[i * 64 + lane];
#pragma unroll
    for (int i = 0; i < 64; ++i) w2[i] = f2[i * 64 + lane];
    const float b1 = fb1[lane], b2 = fb2[lane];
    const int pos = p - pbase;
    const float t = (float)pos / (float)(L - 1);
    const float w = 6.283185307179586f * (float)pos / (float)L;
    float feat = 0.f;
    if (lane == 0) feat = t;
    else if (lane < 17) { const float band = 1e-4f + (float)(lane - 1) * ((15.0f - 1e-4f) / 15.0f); feat = cosf(w * band); }
    else if (lane < 33) { const float band = 1e-4f + (float)(lane - 17) * ((15.0f - 1e-4f) / 15.0f); feat = -sinf(w * band); }
    float a1 = b1;
#pragma unroll
    for (int i = 0; i < 33; ++i) a1 += __int_as_float(__builtin_amdgcn_readlane(__float_as_int(feat), i)) * w1[i];
    const float h1 = sinf(a1);
    float a2 = b2;
#pragma unroll
    for (int i = 0; i < 64; ++i) a2 += __int_as_float(__builtin_amdgcn_readlane(__float_as_int(h1), i)) * w2[i];
    WSP(float, WS_HID2)[(size_t)p * 64 + lane] = sinf(a2);
}
__device__ __forceinline__ void filter_out_item(Frame& F, int item) {
    int sel, r;
    if (item < 768) { sel = 0; r = item; } else if (item < 1536) { sel = 1; r = item - 768; } else { sel = 2; r = item - 1536; }
    const int layer = sel == 1 ? 1 : 0, L = sel == 2 ? LC : LL, pb = r / 24, ch = r % 24, pbase = sel == 0 ? 0 : (sel == 1 ? 2048 : 4096);
    GAS bf16* FT = sel == 2 ? WSP(bf16, WS_FTC) : WSP(bf16, WS_FTL) + (size_t)layer * 2 * 384 * 4096;
    const GAS float* f3 = inp(F, I_HYF3) + (size_t)layer * 64 * 1536; const GAS float* dec = inp(F, I_HYDECAY) + layer * 1536;
    const int lane = F.lane, fr = lane & 15, fq = lane >> 4;
    const GAS float* hid = WSP(const float, WS_HID2) + (size_t)(pbase + pb * 64) * 64;
    f32x4 acc[4][4];
#pragma unroll
    for (int mt = 0; mt < 4; ++mt)
#pragma unroll
        for (int nt = 0; nt < 4; ++nt) acc[mt][nt] = (f32x4){0.f, 0.f, 0.f, 0.f};
#pragma unroll
    for (int ks = 0; ks < 16; ++ks) {
        float a[4], bb[4];
#pragma unroll
        for (int mt = 0; mt < 4; ++mt) a[mt] = hid[(16 * mt + fr) * 64 + 4 * ks + fq];
#pragma unroll
        for (int nt = 0; nt < 4; ++nt) bb[nt] = f3[(size_t)(4 * ks + fq) * 1536 + ch * 64 + 16 * nt + fr];
#pragma unroll
        for (int mt = 0; mt < 4; ++mt)
#pragma unroll
            for (int nt = 0; nt < 4; ++nt) acc[mt][nt] = __builtin_amdgcn_mfma_f32_16x16x4f32(a[mt], bb[nt], acc[mt][nt], 0, 0, 0);
    }
#pragma unroll
    for (int nt = 0; nt < 4; ++nt) {
        const int nn = ch * 64 + 16 * nt + fr, o = nn / 768, dir = (nn / 384) & 1, c = nn % 384;
        const float adec = fabsf(dec[nn]);
        GAS bf16* dst = FT + (size_t)(o * 384 + c) * (2 * L);
#pragma unroll
        for (int mt = 0; mt < 4; ++mt)
#pragma unroll
            for (int j = 0; j < 4; ++j) {
                const int pos = pb * 64 + 16 * mt + 4 * fq + j;
                const float t = (float)pos / (float)(L - 1);
                const float v = acc[mt][nt][j] * __expf(-t * adec);
                if (dir == 0) dst[L - pos] = (bf16)f2bf(v);
                else if (pos > 0) dst[L + pos] = (bf16)f2bf(v);
            }
    }
}

__device__ __forceinline__ void phase_p0(Frame& F) {
    const int gw = F.wg * NWAVES + F.wave, NGW = F.G * NWAVES;
    LAS float* sl = (LAS float*)F.lds;
    LAS float* red = (LAS float*)(F.lds + 17 * 4096);
    { f32x4 tv[9];
#pragma unroll
      for (int q = 0; q < 9; ++q) { const int i4 = F.tid + q * NTHR; if (i4 < 4352) { const int r = i4 >> 8, k4 = i4 & 255; tv[q] = r < 16 ? *(const GAS f32x4*)(inp(F, I_C) + r * 1024 + 4 * k4) : *(const GAS f32x4*)(inp(F, I_CCTX) + 4 * k4); } }
#pragma unroll
      for (int q = 0; q < 9; ++q) { const int i4 = F.tid + q * NTHR; if (i4 < 4352) { f32x4 o; o.x = siluf_(tv[q].x); o.y = siluf_(tv[q].y); o.z = siluf_(tv[q].z); o.w = siluf_(tv[q].w); *(LAS f32x4*)(sl + 4 * i4) = o; } } }
    __syncthreads();
    for (int item = F.wg; item < 2 * 384; item += F.G) {
        const int layer = item / 384, n0 = (item % 384) * 16, j = F.tid & 15, kp = F.tid >> 4;
        const GAS float* W = inp(F, I_WMOD) + (size_t)layer * D * 6144;
        float w[32];
#pragma unroll
        for (int i = 0; i < 32; ++i) w[i] = W[(size_t)(kp * 32 + i) * 6144 + n0 + j];
#pragma unroll
        for (int r = 0; r < 17; ++r) { float acc = 0.f;
#pragma unroll
            for (int q = 0; q < 8; ++q) { const f32x4 s4 = *(const LAS f32x4*)(sl + r * 1024 + kp * 32 + 4 * q); acc += (s4.x * w[4 * q] + s4.y * w[4 * q + 1]) + (s4.z * w[4 * q + 2] + s4.w * w[4 * q + 3]); }
            red[(kp * 17 + r) * 16 + j] = acc; }
        __syncthreads();
        if (F.tid < 272) { const int r = F.tid >> 4, jj = F.tid & 15; float s = inp(F, I_BMOD)[layer * 6144 + n0 + jj];
            for (int q = 0; q < 32; ++q) s += red[(q * 17 + r) * 16 + jj];
            WSP(float, WS_MOD)[(size_t)(layer * 17 + r) * 6144 + n0 + jj] = s; }
        __syncthreads();
    }
    __syncthreads();
    LAS float* scr = (LAS float*)(F.lds + F.wave * 8704);
    conv_weights_win(F, 0, gw, NGW, scr);
    conv_weights_upout(F, 0, gw, NGW, scr);
    for (int i = gw * 64 + F.lane; i < 2048 * 32; i += NGW * 64) {
        const int t = i >> 5, j = i & 31, half = j >> 4, ii = j & 15;
        const float inv = 1.0f / powf(10000.0f, (float)ii / 16.0f);
        const float ang = (float)(half == 0 ? (t >> 6) : (t & 63)) * inv;
        WSP(float, WS_ROPE)[t * 64 + half * 32 + ii] = cosf(ang);
        WSP(float, WS_ROPE)[t * 64 + half * 32 + 16 + ii] = sinf(ang);
    }
    for (int it = gw; it < 4352; it += NGW) filter_hidden_item(F, it);
}
__device__ __forceinline__ void write_bias(Frame& F) {
    const int gt = (F.wg * NWAVES + F.wave) * 64 + F.lane, NGT = F.G * NTHR;
    for (int i = gt; i < 2 * NWP; i += NGT) {
        const int l = i / NWP, r = i % NWP; float v = 0.f;
        int n = -1;
        if (r < 1152) n = r; else if (r < 1168) n = 3712 + (r - 1152); else if (r < 1280) n = -1; else if (r < 2816) n = 1152 + (r - 1280); else if (r < 3840) n = 2688 + (r - 2816); else n = 3728 + (r - 3840);
        if (n >= 0) v = inp(F, I_BIN)[l * NIN + n];
        WSP(float, WS_BIAS)[i] = v;
    }
}

template <bool XB> struct XRaw { typedef f32x4 T; };
template <> struct XRaw<true> { typedef u32x2 T; };
template <bool XB>
__device__ __forceinline__ void xrow_issue(const Frame& F, int row, int src, int lane, typename XRaw<XB>::T (&w)[4]) {
    if constexpr (!XB) { const GAS float* xr = row < TOKL ? inp(F, I_X) + (size_t)row * D : inp(F, I_CTX) + (size_t)(row - TOKL) * D;
#pragma unroll
        for (int j = 0; j < 4; ++j) w[j] = *(const GAS f32x4*)(xr + 256 * j + 4 * lane); }
    else { const GAS bf16* xr = src == 2 ? WSP(const bf16, WS_XL2) + (size_t)row * D : (row < TOKL ? (const GAS bf16*)outp(F) + (size_t)row * D : WSP(const bf16, WS_XC) + (size_t)(row - TOKL) * D);
#pragma unroll
        for (int j = 0; j < 4; ++j) w[j] = *(const GAS u32x2*)(xr + 256 * j + 4 * lane); }
}
__device__ __forceinline__ f32x4 xrow_unpack(f32x4 w) { return w; }
__device__ __forceinline__ f32x4 xrow_unpack(u32x2 w) { f32x4 v; v.x = __uint_as_float(w.x << 16); v.y = __uint_as_float(w.x & 0xffff0000u); v.z = __uint_as_float(w.y << 16); v.w = __uint_as_float(w.y & 0xffff0000u); return v; }
template <bool XB>
__device__ __forceinline__ void phase_norm(Frame& F, int layer, int nrows, int which) {
    const int gw = F.wg * NWAVES + F.wave, NGW = F.G * NWAVES, lane = F.lane;
    const GAS float* g = inp(F, which == 0 ? I_GMIX : I_GFFN) + layer * D;
    const int per = (nrows + NGW - 1) / NGW, r0 = gw * per, r1 = min(nrows, r0 + per);
    if (r0 >= r1) return;
    int grp = -1; f32x4 gm[4], sh[4]; typename XRaw<XB>::T ring[4][4];
#pragma unroll
    for (int i = 0; i < 4; ++i) if (r0 + i < r1) xrow_issue<XB>(F, r0 + i, 1, lane, ring[i]);
#pragma unroll 1
    for (int rb = r0; rb < r1; rb += 4) {
#pragma unroll
        for (int i = 0; i < 4; ++i) {
            const int row = rb + i;
            if (row < r1) {
                const int gr = row < TOKL ? (row >> 11) : 16;
                if (gr != grp) { grp = gr; const GAS float* shp = mod_ptr(F, layer, row, which); const GAS float* scp = mod_ptr(F, layer, row, which + 1);
#pragma unroll
                    for (int j = 0; j < 4; ++j) { const f32x4 gg = *(const GAS f32x4*)(g + 256 * j + 4 * lane), sc = *(const GAS f32x4*)(scp + 256 * j + 4 * lane); sh[j] = *(const GAS f32x4*)(shp + 256 * j + 4 * lane);
                        gm[j].x = gg.x * (1.f + sc.x); gm[j].y = gg.y * (1.f + sc.y); gm[j].z = gg.z * (1.f + sc.z); gm[j].w = gg.w * (1.f + sc.w); } }
                f32x4 v[4]; float s = 0.f;
#pragma unroll
                for (int j = 0; j < 4; ++j) { v[j] = xrow_unpack(ring[i][j]); s += (v[j].x * v[j].x + v[j].y * v[j].y) + (v[j].z * v[j].z + v[j].w * v[j].w); }
                if (row + 4 < r1) xrow_issue<XB>(F, row + 4, 1, lane, ring[i]);
                const float r = rsqrtf(wave_sum(s) * (1.0f / 1024.0f) + 1e-6f);
                GAS bf16* orow = WSP(bf16, WS_H) + (size_t)row * D;
#pragma unroll
                for (int j = 0; j < 4; ++j) {
                    f32x4 o; o.x = v[j].x * r * gm[j].x + sh[j].x; o.y = v[j].y * r * gm[j].y + sh[j].y; o.z = v[j].z * r * gm[j].z + sh[j].z; o.w = v[j].w * r * gm[j].w + sh[j].w;
                    u32x2 w; w.x = pk2(o.x, o.y); w.y = pk2(o.z, o.w);
                    *(GAS u32x2*)(orow + 256 * j + 4 * lane) = w;
                }
            }
        }
    }
}

namespace pg8 {
#ifndef WGM_
#define WGM_ 4
#endif
#ifndef PG8_SP2_
#define PG8_SP2_ 1
#endif
#ifndef PG8_ALIGN_
#define PG8_ALIGN_ 1
#endif
constexpr int BM = 256, BK = 64, HALF = 128, HTB = HALF * BK * 2, STAGE_BYTES = 8 * HTB, NXCD = 8, WGM = WGM_;
__device__ __forceinline__ int lds_byte(int r, int c) { const int st = (r >> 4) * 2 + (c >> 5), rr = r & 15, cc = c & 31, ob = rr * 64 + cc * 2; return st * 1024 + (ob ^ (((ob >> 9) & 1) << 5)); }
__device__ __forceinline__ void stage_rc(int b, int& R, int& C) { const int st = b / 1024, sb = b % 1024, swz = sb ^ (((sb >> 9) & 1) << 5); R = (st >> 1) * 16 + swz / 64; C = (st & 1) * 32 + (swz % 64) / 2; }
struct Unit { int pm, pn; };
template <int MR_>
struct OrderPlainT {
    static constexpr bool GATHER = false; static constexpr int MROWS = MR_;
    int nM, nN, nwg, G, c;
    __device__ __forceinline__ void init(int nM_, int nN_, int G_, int c_) { nM = nM_; nN = nN_; nwg = nM * nN; G = G_; c = c_; }
    __device__ __forceinline__ bool next(int i, Unit& u) const {
        const long L = (long)i * G + c; if (L >= nwg) return false;
        int wgid = (int)L; { const int q = nwg / NXCD, r = nwg % NXCD, xcd = wgid % NXCD, off = wgid / NXCD; wgid = (xcd < r ? xcd * (q + 1) : r * (q + 1) + (xcd - r) * q) + off; }
        const int nig = WGM * nN, gid = wgid / nig, fm = gid * WGM, gsz = (nM - fm) < WGM ? (nM - fm) : WGM;
        u.pm = fm + ((wgid % nig) % gsz); u.pn = (wgid % nig) / gsz; return true;
    }
    __device__ __forceinline__ int arow(int r) const { return r; }
    __device__ __forceinline__ size_t boff(const Unit&) const { return 0; }
};
using OrderPlain = OrderPlainT<256>;
struct OrderWinL1 {
    static constexpr bool GATHER = false; static constexpr int MROWS = 256;
    OrderPlain o; int G, c;
    __device__ __forceinline__ void init(int G_, int c_) { o.init(128, 15, G_, c_); G = G_; c = c_; }
    __device__ __forceinline__ bool next(int i, Unit& u) const {
        const long L = (long)i * G + c;
        if (L < 1920) return o.next(i, u);
        const int r = (int)(L - 1920); if (r >= 112) return false;
        const int q = r % 7; u.pm = 128 + r / 7; u.pn = q == 0 ? 4 : (q <= 4 ? 5 + q : 7 + q);
        return true;
    }
    __device__ __forceinline__ int arow(int r) const { return r; }
    __device__ __forceinline__ size_t boff(const Unit&) const { return 0; }
};
struct OrderMoe {
    static constexpr bool GATHER = true; static constexpr int MROWS = 256;
    OrderPlain o; const GAS int* rowidx; const GAS int* tilee; int t0; size_t bstride; bool gather;
    __device__ __forceinline__ bool next(int i, Unit& u) const { return o.next(i, u); }
    __device__ __forceinline__ int arow(int r) const { return gather ? rowidx[t0 * 256 + r] : r; }
    __device__ __forceinline__ size_t boff(const Unit& u) const { return (size_t)tilee[t0 + u.pm] * bstride; }
};

template <class Epi, class Sched>
__device__ __forceinline__ void gemm_phase(LAS unsigned char* lds, int tid_in, const GAS bf16* A, int lda, const GAS bf16* Bt, int ldb, int K, const Sched& S, const Epi& E) {
    unsigned tid_u = (unsigned)tid_in; asm volatile("" : "+v"(tid_u));
    const int tid = (int)tid_u, wid = __builtin_amdgcn_readfirstlane(tid >> 6), lane = tid & 63, wr = wid >> 2, wc = wid & 3, fr = lane & 15, fq = lane >> 4;
    const int nt = K / BK;
    constexpr int MR = Sched::MROWS, HR = MR / 2, WRR = HR / 2, NMF = WRR / 16;
    static_assert(MR == 256 || (MR == 192 && !Sched::GATHER), "unit rows");
    unsigned voffB[2];
    { int sR[2], sC[2];
#pragma unroll
      for (int i = 0; i < 2; ++i) { stage_rc(tid * 16 + i * 8192, sR[i], sC[i]);
        const int rho = sR[i] & 31, Rb = Epi::PERM ? ((sR[i] & ~31) + 8 * ((rho & 15) >> 2) + 4 * (rho >> 4) + (rho & 3)) : sR[i];
        voffB[i] = (unsigned)(Rb * ldb + sC[i]) * 2u; } }
#define PG8_GATHER_OFFS(pm_) do { unsigned _t = (unsigned)tid; asm volatile("" : "+v"(_t)); _Pragma("unroll") for (int i = 0; i < 2; ++i) { int _R, _C; stage_rc((int)_t * 16 + i * 8192, _R, _C); \
        vc0[i] = (unsigned)((size_t)S.arow((pm_) * BM + _R) * lda + _C) * 2u; vc1[i] = (unsigned)((size_t)S.arow((pm_) * BM + HALF + _R) * lda + _C) * 2u; } } while (0)
    const size_t kstep = (size_t)(BK * 2);
    const size_t hstepB = (size_t)HALF * ldb * 2, tstepB = 2 * hstepB;
    const unsigned ldsw = (unsigned)wid * 1024u;
    const int aoff = lds_byte(wr * WRR + fr, fq * 8), boff = lds_byte(wc * 32 + fr, fq * 8);
#define PG8_SA(b, h) (((b) * 2 + (h)) * HTB)
#define PG8_SB(b, h) ((4 + (b) * 2 + (h)) * HTB)
#define PG8_STAGE2(bufoff, gbase, uo, v0, v1) do { \
        __builtin_amdgcn_global_load_lds((const GAS unsigned*)((const GAS char*)(gbase) + (unsigned)((v0) + (unsigned)(uo))), (LAS unsigned*)(lds + (bufoff) + ldsw), 16, 0, 0); \
        __builtin_amdgcn_global_load_lds((const GAS unsigned*)((const GAS char*)(gbase) + (unsigned)((v1) + (unsigned)(uo))), (LAS unsigned*)(lds + (bufoff) + ldsw + 8192), 16, 0, 0); } while (0)
#define PG8_STAGEB(bufoff, gbase, uo) PG8_STAGE2(bufoff, gbase, uo, voffB[0], voffB[1])
#define PG8_LDA(dst, b, h) do { _Pragma("unroll") for (int m = 0; m < NMF; ++m) _Pragma("unroll") for (int k = 0; k < 2; ++k) dst[m][k] = *(const LAS bf16x8*)(lds + PG8_SA(b, h) + aoff + m * 2048 + k * 1024); } while (0)
#define PG8_LDB(dst, b, h) do { _Pragma("unroll") for (int n = 0; n < 2; ++n) _Pragma("unroll") for (int k = 0; k < 2; ++k) dst[n][k] = *(const LAS bf16x8*)(lds + PG8_SB(b, h) + boff + n * 2048 + k * 1024); } while (0)
#define PG8_MMA(ai, bj, At, Bt_) do { __builtin_amdgcn_s_setprio(1); _Pragma("unroll") for (int m = 0; m < NMF; ++m) _Pragma("unroll") for (int n = 0; n < 2; ++n) _Pragma("unroll") for (int k = 0; k < 2; ++k) \
        acc[ai][bj][m][n] = __builtin_amdgcn_mfma_f32_16x16x32_bf16(Bt_[n][k], At[m][k], acc[ai][bj][m][n], 0, 0, 0); __builtin_amdgcn_s_setprio(0); } while (0)
#define PG8_WAIT_V(n) asm volatile("s_waitcnt vmcnt(" #n ")" ::: "memory")
#define PG8_WAIT_L(n) asm volatile("s_waitcnt lgkmcnt(" #n ")" ::: "memory")
#define PG8_BAR __builtin_amdgcn_s_barrier()
#define PG8_SCHED __builtin_amdgcn_sched_barrier(0)
    Unit cur, nxt; int ui = 0;
    if (!S.next(0, cur)) return;
#ifndef STAGGER
#define STAGGER 0
#endif
    if (STAGGER) { const int grp = (int)(blockIdx.x >> 3) & 3;
        for (int i = 0; i < grp * STAGGER; ++i) __builtin_amdgcn_s_sleep(127); }
    f32x4 acc[2][2][4][2];
#pragma unroll
    for (int a = 0; a < 2; ++a)
#pragma unroll
        for (int b = 0; b < 2; ++b)
#pragma unroll
            for (int m = 0; m < NMF; ++m)
#pragma unroll
                for (int n = 0; n < 2; ++n) { float zf; asm volatile("v_mov_b32 %0, 0" : "=v"(zf)); acc[a][b][m][n] = (f32x4){zf, zf, zf, zf}; }
    bf16x8 At[4][2], B0[2][2], B1[2][2];
    constexpr bool GA = Sched::GATHER;
    const size_t hstepA = GA ? 0 : (size_t)HR * lda * 2, tstepA = (size_t)MR * lda * 2;
    unsigned vc0[2], vc1[2];
    if constexpr (GA) { PG8_GATHER_OFFS(cur.pm); }
    else { int sR, sC;
#pragma unroll
        for (int i = 0; i < 2; ++i) { stage_rc(tid * 16 + i * 8192, sR, sC); if (MR == 192 && sR >= HR) { sR = 0; sC = 0; }
            vc0[i] = (unsigned)(sR * lda + sC) * 2u; vc1[i] = 0u; } }
#define VC0(i) vc0[i]
#define VC1(i) (GA ? vc1[i] : vc0[i])
#define VN0(i) vc0[i]
#define VN1(i) VC1(i)
    const GAS char* cA = GA ? (const GAS char*)A : (const GAS char*)A + (size_t)cur.pm * tstepA;
    const GAS char* cB = (const GAS char*)Bt + S.boff(cur) * 2 + (size_t)cur.pn * tstepB;
    constexpr bool SP2 = PG8_SP2_ != 0, ALIGN_EPI = PG8_ALIGN_ != 0;
    const unsigned hsA = (unsigned)hstepA, hsB = (unsigned)hstepB;
    if constexpr (SP2) {
        PG8_STAGEB(PG8_SB(0, 0), cB, 0u); PG8_STAGEB(PG8_SB(0, 1), cB, hsB); PG8_STAGE2(PG8_SA(0, 0), cA, 0u, VC0(0), VC0(1)); PG8_STAGE2(PG8_SA(0, 1), cA, hsA, VC1(0), VC1(1));
        if (wr == 1) PG8_BAR;
        PG8_WAIT_V(2); PG8_BAR;
        PG8_STAGEB(PG8_SB(1, 0), cB, 128u); PG8_STAGE2(PG8_SA(1, 0), cA, 128u, VC0(0), VC0(1)); PG8_STAGEB(PG8_SB(1, 1), cB, hsB + 128u);
        PG8_WAIT_V(6); PG8_BAR;
    } else {
        PG8_STAGEB(PG8_SB(0, 0), cB, 0u); PG8_STAGE2(PG8_SA(0, 0), cA, 0u, VC0(0), VC0(1)); PG8_STAGEB(PG8_SB(0, 1), cB, hsB); PG8_STAGE2(PG8_SA(0, 1), cA, hsA, VC1(0), VC1(1));
        if (wr == 1) PG8_BAR;
        PG8_WAIT_V(4); PG8_BAR;
        PG8_STAGEB(PG8_SB(1, 0), cB, 128u); PG8_STAGE2(PG8_SA(1, 0), cA, 128u, VC0(0), VC0(1)); PG8_STAGEB(PG8_SB(1, 1), cB, hsB + 128u);
        PG8_WAIT_V(6); PG8_BAR;
    }
    for (;;) {
        const bool has_next = S.next(ui + 1, nxt);
        const GAS char* nB = cB; const GAS char* nA = cA;
        if (has_next) {
            nB = (const GAS char*)Bt + S.boff(nxt) * 2 + (size_t)nxt.pn * tstepB;
            if constexpr (!GA) nA = (const GAS char*)A + (size_t)nxt.pm * tstepA;
        }
        for (int t = 0; t < nt; t += 2) {
            const bool last = (t == nt - 2);
            if constexpr (Epi::HORNER) {
                if (t == 6 || t == 12) {
                    asm volatile("" ::: "memory");
                    const int seg = (t == 6) ? 0 : 1;
                    int hpm = cur.pm, hpn = cur.pn; asm volatile("" : "+s"(hpm), "+s"(hpn));
                    unsigned hln = (unsigned)lane; asm volatile("" : "+v"(hln)); const int hfr = (int)(hln & 15u), hfq = (int)(hln >> 4);
#pragma unroll
                    for (int ai = 0; ai < 2; ++ai) {
                        u32x4 ga[4][2], gb[4][2];
#pragma unroll
                        for (int m = 0; m < NMF; ++m)
#pragma unroll
                            for (int bj = 0; bj < 2; ++bj) {
                                const int row = hpm * MR + ai * HR + wr * WRR + m * 16 + hfr, col = hpn * BM + bj * HALF + wc * 32 + 8 * hfq;
                                ga[m][bj] = E.gate8(seg, row, col); gb[m][bj] = E.gate8(seg + 1, row, col);
                            }
                        if constexpr (NMF == 4) asm volatile("" : "+v"(ga[0][0]), "+v"(ga[0][1]), "+v"(ga[1][0]), "+v"(ga[1][1]), "+v"(ga[2][0]), "+v"(ga[2][1]), "+v"(ga[3][0]), "+v"(ga[3][1]),
                                          "+v"(gb[0][0]), "+v"(gb[0][1]), "+v"(gb[1][0]), "+v"(gb[1][1]), "+v"(gb[2][0]), "+v"(gb[2][1]), "+v"(gb[3][0]), "+v"(gb[3][1]) :: "memory");
                        else asm volatile("" : "+v"(ga[0][0]), "+v"(ga[0][1]), "+v"(ga[1][0]), "+v"(ga[1][1]), "+v"(ga[2][0]), "+v"(ga[2][1]),
                                          "+v"(gb[0][0]), "+v"(gb[0][1]), "+v"(gb[1][0]), "+v"(gb[1][1]), "+v"(gb[2][0]), "+v"(gb[2][1]) :: "memory");
#pragma unroll
                        for (int m = 0; m < NMF; ++m)
#pragma unroll
                            for (int bj = 0; bj < 2; ++bj) {
                                const unsigned aw[4] = {ga[m][bj].x, ga[m][bj].y, ga[m][bj].z, ga[m][bj].w}, bw[4] = {gb[m][bj].x, gb[m][bj].y, gb[m][bj].z, gb[m][bj].w};
#pragma unroll
                                for (int n = 0; n < 2; ++n) {
                                    f32x4& v = acc[ai][bj][m][n];
                                    v.x *= __uint_as_float(aw[2 * n] << 16) * __builtin_amdgcn_rcpf(__uint_as_float(bw[2 * n] << 16));
                                    v.y *= __uint_as_float(aw[2 * n] & 0xffff0000u) * __builtin_amdgcn_rcpf(__uint_as_float(bw[2 * n] & 0xffff0000u));
                                    v.z *= __uint_as_float(aw[2 * n + 1] << 16) * __builtin_amdgcn_rcpf(__uint_as_float(bw[2 * n + 1] << 16));
                                    v.w *= __uint_as_float(aw[2 * n + 1] & 0xffff0000u) * __builtin_amdgcn_rcpf(__uint_as_float(bw[2 * n + 1] & 0xffff0000u));
                                }
                            }
                    }
                    asm volatile("s_waitcnt vmcnt(0)" ::: "memory");
                }
            }
            const unsigned k1 = (unsigned)(t + 1) * 128u, k2 = last ? 0u : (unsigned)(t + 2) * 128u, k3 = k2 + 128u;
            const GAS char* pA2 = last ? nA : cA; const GAS char* pB2 = last ? nB : cB;
            if constexpr (SP2) {
            PG8_LDB(B0, 0, 0); PG8_LDB(B1, 0, 1); PG8_SCHED; PG8_LDA(At, 0, 0); PG8_STAGE2(PG8_SA(1, 1), cA, k1 + hsA, VC1(0), VC1(1));
            if constexpr (GA) { if (last && has_next) { asm volatile("" ::: "memory"); PG8_GATHER_OFFS(nxt.pm); asm volatile("" ::: "memory"); } }
            PG8_WAIT_V(8); PG8_WAIT_L(0); PG8_BAR; PG8_MMA(0, 0, At, B0); PG8_MMA(0, 1, At, B1); PG8_BAR; PG8_SCHED;
            PG8_LDA(At, 0, 1); PG8_STAGEB(PG8_SB(0, 0), pB2, k2); PG8_STAGEB(PG8_SB(0, 1), pB2, k2 + hsB); PG8_STAGE2(PG8_SA(0, 0), pA2, k2, VN0(0), VN0(1));
            PG8_WAIT_V(8); PG8_WAIT_L(0); PG8_BAR; PG8_MMA(1, 0, At, B0); PG8_MMA(1, 1, At, B1); PG8_BAR; PG8_SCHED;
            PG8_LDB(B0, 1, 0); PG8_LDB(B1, 1, 1); PG8_SCHED; PG8_LDA(At, 1, 0); PG8_STAGE2(PG8_SA(0, 1), pA2, k2 + hsA, VN1(0), VN1(1));
            PG8_WAIT_V(8); PG8_WAIT_L(0); PG8_BAR; PG8_MMA(0, 0, At, B0); PG8_MMA(0, 1, At, B1); PG8_BAR; PG8_SCHED;
            PG8_LDA(At, 1, 1); PG8_STAGEB(PG8_SB(1, 0), pB2, k3); PG8_STAGEB(PG8_SB(1, 1), pB2, k3 + hsB); PG8_STAGE2(PG8_SA(1, 0), pA2, k3, VN0(0), VN0(1));
            PG8_WAIT_V(8); PG8_WAIT_L(0); PG8_BAR; PG8_MMA(1, 0, At, B0); PG8_MMA(1, 1, At, B1); PG8_BAR; PG8_SCHED;
            } else {
            PG8_LDB(B0, 0, 0); PG8_SCHED; PG8_LDA(At, 0, 0); PG8_STAGE2(PG8_SA(1, 1), cA, k1 + hsA, VC1(0), VC1(1));
            if constexpr (GA) { if (last && has_next) { asm volatile("" ::: "memory"); PG8_GATHER_OFFS(nxt.pm); asm volatile("" ::: "memory"); } }
            PG8_WAIT_L(8); PG8_BAR; PG8_WAIT_L(0); PG8_MMA(0, 0, At, B0); PG8_BAR; PG8_SCHED;
            PG8_LDB(B1, 0, 1); PG8_STAGEB(PG8_SB(0, 0), pB2, k2);
            PG8_BAR; PG8_WAIT_L(0); PG8_MMA(0, 1, At, B1); PG8_BAR;
            PG8_LDA(At, 0, 1); PG8_STAGE2(PG8_SA(0, 0), pA2, k2, VN0(0), VN0(1));
            PG8_BAR; PG8_WAIT_L(0); PG8_MMA(1, 0, At, B0); PG8_BAR; PG8_SCHED;
            PG8_STAGEB(PG8_SB(0, 1), pB2, k2 + hsB);
            PG8_WAIT_V(6); PG8_BAR; PG8_MMA(1, 1, At, B1); PG8_BAR;
            PG8_LDB(B0, 1, 0); PG8_SCHED; PG8_LDA(At, 1, 0); PG8_STAGE2(PG8_SA(0, 1), pA2, k2 + hsA, VN1(0), VN1(1));
            PG8_WAIT_L(8); PG8_BAR; PG8_WAIT_L(0); PG8_MMA(0, 0, At, B0); PG8_BAR; PG8_SCHED;
            PG8_LDB(B1, 1, 1); PG8_STAGEB(PG8_SB(1, 0), pB2, k3);
            PG8_BAR; PG8_WAIT_L(0); PG8_MMA(0, 1, At, B1); PG8_BAR;
            PG8_LDA(At, 1, 1); PG8_STAGE2(PG8_SA(1, 0), pA2, k3, VN0(0), VN0(1));
            PG8_BAR; PG8_WAIT_L(0); PG8_MMA(1, 0, At, B0); PG8_BAR; PG8_SCHED;
            PG8_STAGEB(PG8_SB(1, 1), pB2, k3 + hsB);
            PG8_WAIT_V(6); PG8_BAR; PG8_MMA(1, 1, At, B1); PG8_BAR;
                    }
        }
        if constexpr (ALIGN_EPI) { if (wr == 0) PG8_BAR; }
#ifndef REP_EPI
#define REP_EPI 1
#endif
#pragma unroll 1
        for (int rpe = 0; rpe < ((Epi::COLVEC && Epi::BASE) ? 1 : REP_EPI); ++rpe) {
            int epm = cur.pm, epn = cur.pn; asm volatile("" : "+s"(epm), "+s"(epn));
            unsigned eln = (unsigned)lane; asm volatile("" : "+v"(eln)); const int efr = (int)(eln & 15u), efq = (int)(eln >> 4);
            constexpr bool PM = Epi::PERM;
#define PG8_COL(bj, n) (epn * BM + (bj) * HALF + wc * 32 + (PM ? 8 * efq + 4 * (n) : (n) * 16 + 4 * efq))
            f32x4 cv[2][2];
#pragma unroll
            for (int bj = 0; bj < 2; ++bj)
#pragma unroll
                for (int n = 0; n < 2; ++n) { if constexpr (Epi::COLVEC) cv[bj][n] = E.colvec(epm * MR, PG8_COL(bj, n)); else cv[bj][n] = (f32x4){0.f, 0.f, 0.f, 0.f}; }
            if constexpr (Epi::COLVEC) asm volatile("" : "+v"(cv[0][0]), "+v"(cv[0][1]), "+v"(cv[1][0]), "+v"(cv[1][1]) :: "memory");
            constexpr bool CV2 = Epi::COLVEC && Epi::ROWCV && MR != 256;
            f32x4 cv2[2][2];
            if constexpr (CV2) {
#pragma unroll
                for (int bj = 0; bj < 2; ++bj)
#pragma unroll
                    for (int n = 0; n < 2; ++n) cv2[bj][n] = E.colvec(epm * MR + MR - 1, PG8_COL(bj, n));
                asm volatile("" : "+v"(cv2[0][0]), "+v"(cv2[0][1]), "+v"(cv2[1][0]), "+v"(cv2[1][1]) :: "memory");
            }
#pragma unroll
            for (int ai = 0; ai < 2; ++ai) {
                f32x4 bs[4][2][2];
                if constexpr (Epi::BASE) {
#pragma unroll
                    for (int m = 0; m < NMF; ++m)
#pragma unroll
                        for (int bj = 0; bj < 2; ++bj) {
                            const int row = epm * MR + ai * HR + wr * WRR + m * 16 + efr;
                            if constexpr (PM) E.base8(row, PG8_COL(bj, 0), bs[m][bj][0], bs[m][bj][1]);
                            else {
#pragma unroll
                                for (int n = 0; n < 2; ++n) bs[m][bj][n] = E.base(row, PG8_COL(bj, n));
                            }
                        }
                    if constexpr (NMF == 4) asm volatile("" : "+v"(bs[0][0][0]), "+v"(bs[0][0][1]), "+v"(bs[0][1][0]), "+v"(bs[0][1][1]), "+v"(bs[1][0][0]), "+v"(bs[1][0][1]), "+v"(bs[1][1][0]), "+v"(bs[1][1][1]),
                                      "+v"(bs[2][0][0]), "+v"(bs[2][0][1]), "+v"(bs[2][1][0]), "+v"(bs[2][1][1]), "+v"(bs[3][0][0]), "+v"(bs[3][0][1]), "+v"(bs[3][1][0]), "+v"(bs[3][1][1]) :: "memory");
                    else asm volatile("" : "+v"(bs[0][0][0]), "+v"(bs[0][0][1]), "+v"(bs[0][1][0]), "+v"(bs[0][1][1]), "+v"(bs[1][0][0]), "+v"(bs[1][0][1]), "+v"(bs[1][1][0]), "+v"(bs[1][1][1]),
                                      "+v"(bs[2][0][0]), "+v"(bs[2][0][1]), "+v"(bs[2][1][0]), "+v"(bs[2][1][1]) :: "memory");
                }
#pragma unroll
                for (int m = 0; m < NMF; ++m) {
                    const int row = epm * MR + ai * HR + wr * WRR + m * 16 + efr;
                    bool alt = false; if constexpr (CV2) alt = E.rowgrp(epm * MR + ai * HR + wr * WRR + m * 16) != E.rowgrp(epm * MR);
#pragma unroll
                    for (int bj = 0; bj < 2; ++bj) {
                        if constexpr (Epi::PAIR) E.store_pair(row, epn * (BM / 2) + bj * (HALF / 2) + wc * 16 + 4 * efq, acc[ai][bj][m][0], acc[ai][bj][m][1]);
                        else if constexpr (PM) {
                            f32x4 b0 = (f32x4){0.f, 0.f, 0.f, 0.f}, b1 = b0; if constexpr (Epi::BASE) { b0 = bs[m][bj][0]; b1 = bs[m][bj][1]; }
                            E.store8(row, PG8_COL(bj, 0), acc[ai][bj][m][0], acc[ai][bj][m][1], (CV2 && alt) ? cv2[bj][0] : cv[bj][0], (CV2 && alt) ? cv2[bj][1] : cv[bj][1], b0, b1);
                        } else {
#pragma unroll
                            for (int n = 0; n < 2; ++n) { f32x4 bb = (f32x4){0.f, 0.f, 0.f, 0.f}; if constexpr (Epi::BASE) bb = bs[m][bj][n]; E.store(row, PG8_COL(bj, n), acc[ai][bj][m][n], (CV2 && alt) ? cv2[bj][n] : cv[bj][n], bb); }
                        }
                    }
                }
            }
#undef PG8_COL
        }
        if (!has_next) break;
#pragma unroll
        for (int a = 0; a < 2; ++a)
#pragma unroll
            for (int b = 0; b < 2; ++b)
#pragma unroll
                for (int m = 0; m < NMF; ++m)
#pragma unroll
                    for (int n = 0; n < 2; ++n) { float zf; asm volatile("v_mov_b32 %0, 0" : "=v"(zf)); acc[a][b][m][n] = (f32x4){zf, zf, zf, zf}; }
        cur = nxt; cB = nB; cA = nA; ++ui;
        if constexpr (ALIGN_EPI) { if (wr == 1) PG8_BAR; }
    }
    PG8_WAIT_V(0);
    if constexpr (!ALIGN_EPI) { if (wr == 0) PG8_BAR; }
    PG8_BAR;
#undef PG8_GATHER_OFFS
#undef VC0
#undef VC1
#undef VN0
#undef VN1
#undef PG8_SA
#undef PG8_SB
#undef PG8_STAGE2
#undef PG8_STAGEB
#undef PG8_LDA
#undef PG8_LDB
#undef PG8_MMA
#undef PG8_WAIT_V
#undef PG8_WAIT_L
#undef PG8_BAR
#undef PG8_SCHED
}
}

template <int MR = 256, class Epi>
__device__ __forceinline__ void gemm_fast(Frame& F, const GAS bf16* A, int lda, const GAS bf16* Bt, int ldb, int K, int M, int N, const Epi& E) {
    pg8::OrderPlainT<MR> S; S.init(M / MR, N / 256, F.G, F.wg);
    pg8::gemm_phase(F.lds, F.tid, A, lda, Bt, ldb, K, S, E);
}

__device__ __forceinline__ void st_bf16x4(GAS bf16* p, f32x4 v) { u32x2 w; w.x = pk2(v.x, v.y); w.y = pk2(v.z, v.w); *(GAS u32x2*)p = w; }
__device__ __forceinline__ f32x4 ld_bf16x4(const GAS bf16* p) { const u32x2 w = *(const GAS u32x2*)p; f32x4 v; v.x = __uint_as_float(w.x << 16); v.y = __uint_as_float(w.x & 0xffff0000u); v.z = __uint_as_float(w.y << 16); v.w = __uint_as_float(w.y & 0xffff0000u); return v; }

__device__ __forceinline__ void st_bf16x8(GAS bf16* p, f32x4 a, f32x4 b) { u32x4 w; w.x = pk2(a.x, a.y); w.y = pk2(a.z, a.w); w.z = pk2(b.x, b.y); w.w = pk2(b.z, b.w); *(GAS u32x4*)p = w; }
struct EpiWin {
    static constexpr bool HORNER = false, PAIR = false, COLVEC = true, BASE = false, PERM = true, ROWCV = false;
    const GAS float* bias; GAS bf16 *hytl, *hytc, *ret, *ml; GAS float* mlg;
    __device__ __forceinline__ f32x4 colvec(int, int col) const { return *(const GAS f32x4*)(bias + col); }
    __device__ __forceinline__ void store8(int row, int col, f32x4 v0, f32x4 v1, f32x4 c0, f32x4 c1, f32x4, f32x4) const {
        v0 += c0; v1 += c1;
        if (col < 1152) {
            const float v[8] = {v0.x, v0.y, v0.z, v0.w, v1.x, v1.y, v1.z, v1.w};
            if (row < TOKL) { const int b = row >> 11, t = row & 2047; GAS bf16* d = hytl + ((size_t)(b * 1152 + col)) * 2048 + t;
#pragma unroll
                for (int j = 0; j < 8; ++j) d[2048 * j] = (bf16)f2bf(v[j]); }
            else { const int r = row - TOKL, b = r >> 8, t = r & 255; GAS bf16* d = hytc + ((size_t)(b * 1152 + col)) * 256 + t;
#pragma unroll
                for (int j = 0; j < 8; ++j) d[256 * j] = (bf16)f2bf(v[j]); }
        } else if (col < 1168) { *(GAS f32x4*)(mlg + (size_t)row * 16 + (col - 1152)) = v0; *(GAS f32x4*)(mlg + (size_t)row * 16 + (col - 1152) + 4) = v1; }
        else if (col < 1280) { }
        else if (col < 2816) st_bf16x8(ret + (size_t)row * 1536 + (col - 1280), v0, v1);
        else st_bf16x8(ml + (size_t)row * 1024 + (col - 2816), v0, v1);
    }
};
struct EpiGate {
    static constexpr bool HORNER = false, PAIR = false, COLVEC = true, BASE = false, PERM = true, ROWCV = false;
    const GAS float* bias; GAS bf16* gates;
    __device__ __forceinline__ f32x4 colvec(int, int col) const { return *(const GAS f32x4*)(bias + col); }
    __device__ __forceinline__ void store8(int row, int col, f32x4 v0, f32x4 v1, f32x4 c0, f32x4 c1, f32x4, f32x4) const {
        v0 += c0; v1 += c1;
        f32x4 g0, g1;
        g0.x = fmaxf(sigmoidf_(v0.x), 1e-20f); g0.y = fmaxf(sigmoidf_(v0.y), 1e-20f); g0.z = fmaxf(sigmoidf_(v0.z), 1e-20f); g0.w = fmaxf(sigmoidf_(v0.w), 1e-20f);
        g1.x = fmaxf(sigmoidf_(v1.x), 1e-20f); g1.y = fmaxf(sigmoidf_(v1.y), 1e-20f); g1.z = fmaxf(sigmoidf_(v1.z), 1e-20f); g1.w = fmaxf(sigmoidf_(v1.w), 1e-20f);
        st_bf16x8(gates + (size_t)row * NGATE + col, g0, g1);
    }
};
struct EpiUp {
    static constexpr bool HORNER = true, PAIR = false, COLVEC = false, BASE = true, PERM = true, ROWCV = false;
    const GAS bf16* gates; GAS bf16* acc_out;
    __device__ __forceinline__ u32x4 gate8(int which, int row, int col) const { return *(const GAS u32x4*)(gates + (size_t)row * NGATE + which * 1024 + col); }
    __device__ __forceinline__ void base8(int row, int col, f32x4& b0, f32x4& b1) const {
        const u32x4 w = *(const GAS u32x4*)(gates + (size_t)row * NGATE + 2048 + col);
        b0.x = __uint_as_float(w.x << 16); b0.y = __uint_as_float(w.x & 0xffff0000u); b0.z = __uint_as_float(w.y << 16); b0.w = __uint_as_float(w.y & 0xffff0000u);
        b1.x = __uint_as_float(w.z << 16); b1.y = __uint_as_float(w.z & 0xffff0000u); b1.z = __uint_as_float(w.w << 16); b1.w = __uint_as_float(w.w & 0xffff0000u);
    }
    __device__ __forceinline__ void store8(int row, int col, f32x4 v0, f32x4 v1, f32x4, f32x4, f32x4 g0, f32x4 g1) const { st_bf16x8(acc_out + (size_t)row * D + col, v0 * g0, v1 * g1); }
};
template <bool IN_BF16>
struct EpiResidT {
    static constexpr bool HORNER = false, PAIR = false, COLVEC = true, BASE = true, PERM = true, ROWCV = true;
    const GAS void *xin_l, *xin_c; GAS bf16 *xout_l, *xout_c; const GAS float* modbase; int which;
    __device__ __forceinline__ int rowgrp(int row) const { return row < TOKL ? (row >> 11) : 16; }
    __device__ __forceinline__ f32x4 colvec(int row0, int col) const { const int r = row0 < TOKL ? (row0 >> 11) : 16; return *(const GAS f32x4*)(modbase + ((size_t)r * 6 + which) * 1024 + col); }
    __device__ __forceinline__ void base8(int row, int col, f32x4& b0, f32x4& b1) const {
        const size_t o = row < TOKL ? (size_t)row * D + col : (size_t)(row - TOKL) * D + col;
        if constexpr (IN_BF16) {
            const u32x4 w = *(const GAS u32x4*)((const GAS bf16*)(row < TOKL ? xin_l : xin_c) + o);
            b0.x = __uint_as_float(w.x << 16); b0.y = __uint_as_float(w.x & 0xffff0000u); b0.z = __uint_as_float(w.y << 16); b0.w = __uint_as_float(w.y & 0xffff0000u);
            b1.x = __uint_as_float(w.z << 16); b1.y = __uint_as_float(w.z & 0xffff0000u); b1.z = __uint_as_float(w.w << 16); b1.w = __uint_as_float(w.w & 0xffff0000u);
        } else { const GAS float* p = (const GAS float*)(row < TOKL ? xin_l : xin_c) + o; b0 = *(const GAS f32x4*)p; b1 = *(const GAS f32x4*)(p + 4); }
    }
    __device__ __forceinline__ void store8(int row, int col, f32x4 v0, f32x4 v1, f32x4 c0, f32x4 c1, f32x4 b0, f32x4 b1) const {
        st_bf16x8(row < TOKL ? xout_l + (size_t)row * D + col : xout_c + (size_t)(row - TOKL) * D + col, b0 + c0 * v0, b1 + c1 * v1);
    }
};
struct EpiSwiglu {
    static constexpr bool HORNER = false, PAIR = true, COLVEC = false, BASE = false, PERM = false, ROWCV = false;
    GAS bf16* act; int row_off;
    __device__ __forceinline__ void store_pair(int row, int col, f32x4 a, f32x4 b) const {
        f32x4 o; o.x = siluf_(a.x) * b.x; o.y = siluf_(a.y) * b.y; o.z = siluf_(a.z) * b.z; o.w = siluf_(a.w) * b.w;
        st_bf16x4(act + (size_t)(row - row_off) * DFF + col, o);
    }
    __device__ __forceinline__ void store(int, int, f32x4, f32x4, f32x4) const {}
};
struct EpiBf16Out {
    static constexpr bool HORNER = false, PAIR = false, COLVEC = false, BASE = false, PERM = true, ROWCV = false;
    GAS bf16* out; int ld; int row_add;
    __device__ __forceinline__ void store8(int row, int col, f32x4 v0, f32x4 v1, f32x4, f32x4, f32x4, f32x4) const { st_bf16x8(out + (size_t)(row + row_add) * ld + col, v0, v1); }
};

template <int L>
__device__ __forceinline__ void hyena_unit_fast(Frame& F, int layer, int c, const GAS bf16* hyt  , const GAS bf16* ft  , GAS bf16* yht  ) {
    constexpr int ZP = (L + 8) * 2;
    constexpr int PER = L / 32;
    constexpr int I = L / 128;
    constexpr int SPAN = L / 4, NSTEP = L / 32;
    constexpr int CP = (2 * L + 8) * 2;
    LAS unsigned char* zimg = F.lds;
    LAS unsigned char* cpy = F.lds + 16 * ZP;
    const GAS float* cw = inp(F, I_HYCONV) + layer * 3 * 1152;
    const GAS float* skip = inp(F, I_HYSKIP) + layer * 2 * 384;
    const int lane = F.lane, fr = lane & 15, fq = lane >> 4, w = F.wave;
    { unsigned long long a_ = (unsigned long long)hyt, b_ = (unsigned long long)yht; asm volatile("" : "+s"(a_), "+s"(b_)); hyt = (const GAS bf16*)a_; yht = (GAS bf16*)b_; }
    __syncthreads();
    {
        const int b = F.tid >> 5, sg = F.tid & 31, t0 = sg * PER; const GAS bf16* src = hyt + ((size_t)(b * 1152 + c)) * L + t0;
        const float w0 = cw[c], w1 = cw[1152 + c], w2 = cw[2304 + c];
        u32x4 raw[PER / 8];
#pragma unroll
        for (int j = 0; j < PER / 8; ++j) raw[j] = *(const GAS u32x4*)(src + 8 * j);
        float prev = t0 > 0 ? bf2f(src[-1]) : 0.f;
        const float nextv = t0 + PER < L ? bf2f(src[PER]) : 0.f;
#pragma unroll
        for (int j = 0; j < PER / 8; ++j) {
            const unsigned wv[4] = {raw[j].x, raw[j].y, raw[j].z, raw[j].w};
            float x[10]; x[0] = prev;
#pragma unroll
            for (int q = 0; q < 4; ++q) { x[1 + 2 * q] = __uint_as_float(wv[q] << 16); x[2 + 2 * q] = __uint_as_float(wv[q] & 0xffff0000u); }
            if (j + 1 < PER / 8) x[9] = __uint_as_float(raw[(j + 1 < PER / 8) ? j + 1 : j].x << 16); else x[9] = nextv;
            u32x4 o;
            o.x = pk2(w0 * x[0] + w1 * x[1] + w2 * x[2], w0 * x[1] + w1 * x[2] + w2 * x[3]); o.y = pk2(w0 * x[2] + w1 * x[3] + w2 * x[4], w0 * x[3] + w1 * x[4] + w2 * x[5]);
            o.z = pk2(w0 * x[4] + w1 * x[5] + w2 * x[6], w0 * x[5] + w1 * x[6] + w2 * x[7]); o.w = pk2(w0 * x[6] + w1 * x[7] + w2 * x[8], w0 * x[7] + w1 * x[8] + w2 * x[9]);
            *(LAS u32x4*)(zimg + b * ZP + (t0 + 8 * j) * 2) = o;
            prev = x[8];
        }
    }
    const int tbase = SPAN * (w >> 1) + 16 * (w & 1);
    const int flane = L - tbase + 8 * fq - fr;
    const int msh = fr & 7;
    const LAS unsigned char* fbase = cpy + msh * CP + 2 * (flane + msh);
#pragma unroll 1
    for (int o = 0; o < 2; ++o) {
        const GAS bf16* fsrc = ft + ((size_t)(o * 384 + c)) * (2 * L);
        for (int i = F.tid; i < CP / 16; i += NTHR) { u32x4 v = (u32x4){0u, 0u, 0u, 0u}; if (i < 2 * L / 8) v = *(const GAS u32x4*)(fsrc + 8 * i); if (i == 0) v.x &= 0xffff0000u; *(LAS u32x4*)(cpy + 16 * i) = v; }
        __syncthreads();
        for (int task = F.tid; task < 7 * (CP / 16); task += NTHR) {
            const int m = 1 + task / (CP / 16), x8 = task % (CP / 16);
            unsigned short e[8];
#pragma unroll
            for (int i = 0; i < 8; ++i) { const int idx = 8 * x8 - m + i; e[i] = idx >= 0 ? *(const LAS unsigned short*)(cpy + 2 * idx) : (unsigned short)0; }
            u32x4 v; v.x = e[0] | ((unsigned)e[1] << 16); v.y = e[2] | ((unsigned)e[3] << 16); v.z = e[4] | ((unsigned)e[5] << 16); v.w = e[6] | ((unsigned)e[7] << 16);
            *(LAS u32x4*)(cpy + m * CP + 16 * x8) = v;
        }
        __syncthreads();
        f32x4 acc[I];
#pragma unroll
        for (int i = 0; i < I; ++i) acc[i] = (f32x4){0.f, 0.f, 0.f, 0.f};
        bf16x8 ring[I];
#pragma unroll
        for (int i = 1; i < I; ++i) ring[(I - i) % I] = *(const LAS bf16x8*)(fbase - 64 * i);
        bf16x8 nf = *(const LAS bf16x8*)(fbase);
        const LAS unsigned char* zrow = zimg + fr * ZP + 16 * fq;
#pragma unroll 1
        for (int j0 = 0; j0 < NSTEP; j0 += I) {
#pragma unroll
            for (int jj = 0; jj < I; ++jj) {
                const int j = j0 + jj;
                ring[jj] = nf;
                if (j + 1 < NSTEP) nf = *(const LAS bf16x8*)(fbase + 64 * (j + 1));
                const bf16x8 zf = *(const LAS bf16x8*)(zrow + 64 * j);
#pragma unroll
                for (int i = 0; i < I; ++i) acc[i] = __builtin_amdgcn_mfma_f32_16x16x32_bf16(ring[(jj - i + I) % I], zf, acc[i], 0, 0, 0);
            }
        }
        unsigned el_ = (unsigned)lane; asm volatile("" : "+v"(el_)); const int efr = (int)(el_ & 15u), efq = (int)(el_ >> 4);
        const int etb = SPAN * (w >> 1) + 16 * (w & 1);
        const int gcol = (o == 0 ? 384 : 768) + c;
        const GAS bf16* gsrc = hyt + ((size_t)(efr * 1152 + gcol)) * L;
        const float w0 = cw[gcol], w1 = cw[1152 + gcol], w2 = cw[2304 + gcol], sk = skip[o * 384 + c];
        GAS bf16* dst = yht + ((size_t)(efr * 384 + c)) * L;
        constexpr int GI = I < 8 ? I : 8;
#pragma unroll
        for (int i0 = 0; i0 < I; i0 += GI) {
            u32x2 grv[GI]; unsigned short gmv[GI], gpv[GI];
#pragma unroll
            for (int ii = 0; ii < GI; ++ii) {
                const int t = etb + 32 * (i0 + ii) + 4 * efq;
                grv[ii] = *(const GAS u32x2*)(gsrc + t); gmv[ii] = t > 0 ? gsrc[t - 1] : (unsigned short)0; gpv[ii] = t + 4 < L ? gsrc[t + 4] : (unsigned short)0;
            }
            asm volatile("" ::: "memory");
#pragma unroll
            for (int ii = 0; ii < GI; ++ii) {
                const int i = i0 + ii;
                const int t = etb + 32 * i + 4 * efq;
                const u32x2 zr = *(const LAS u32x2*)(zimg + efr * ZP + t * 2);
                const u32x2 gr = grv[ii];
                const float gm = bf2f(gmv[ii]), gp = bf2f(gpv[ii]);
                const float g0 = __uint_as_float(gr.x << 16), g1 = __uint_as_float(gr.x & 0xffff0000u), g2 = __uint_as_float(gr.y << 16), g3 = __uint_as_float(gr.y & 0xffff0000u);
                const float z0 = __uint_as_float(zr.x << 16), z1 = __uint_as_float(zr.x & 0xffff0000u), z2 = __uint_as_float(zr.y << 16), z3 = __uint_as_float(zr.y & 0xffff0000u);
                const float o0 = (w0 * gm + w1 * g0 + w2 * g1) * (acc[i].x + sk * z0), o1 = (w0 * g0 + w1 * g1 + w2 * g2) * (acc[i].y + sk * z1);
                const float o2 = (w0 * g1 + w1 * g2 + w2 * g3) * (acc[i].z + sk * z2), o3 = (w0 * g2 + w1 * g3 + w2 * gp) * (acc[i].w + sk * z3);
                acc[i] = (f32x4){o0, o1, o2, o3};
            }
        }
        __syncthreads();
#pragma unroll
        for (int i = 0; i < I; ++i) {
            const int t = etb + 32 * i + 4 * efq;
            u32x2 ov; ov.x = pk2(acc[i].x, acc[i].y); ov.y = pk2(acc[i].z, acc[i].w);
            if (o == 0) *(LAS u32x2*)(zimg + efr * ZP + t * 2) = ov;
            else *(GAS u32x2*)(dst + t) = ov;
        }
    }
}

#ifndef REP_CH
#define REP_CH 1
#endif
#ifndef REP_CH_ML
#define REP_CH_ML REP_CH
#endif
#ifndef REP_CH_RET
#define REP_CH_RET REP_CH
#endif
constexpr int CH_PITCH = 144;
constexpr int CH_IMG = 64 * CH_PITCH;
constexpr int CH_WAVE_LDS = 3 * CH_IMG + 1024 + 512;
__device__ __forceinline__ void ds_tr16x8(unsigned addr, u32x2 (&lo)[4], u32x2 (&hi)[4]) {
    asm volatile("ds_read_b64_tr_b16 %0, %8\n\tds_read_b64_tr_b16 %1, %8 offset:32\n\tds_read_b64_tr_b16 %2, %8 offset:64\n\tds_read_b64_tr_b16 %3, %8 offset:96\n\t"
                 "ds_read_b64_tr_b16 %4, %8 offset:2304\n\tds_read_b64_tr_b16 %5, %8 offset:2336\n\tds_read_b64_tr_b16 %6, %8 offset:2368\n\tds_read_b64_tr_b16 %7, %8 offset:2400\n\t"
                 "s_waitcnt lgkmcnt(0)"
                 : "=&v"(lo[0]), "=&v"(lo[1]), "=&v"(lo[2]), "=&v"(lo[3]), "=&v"(hi[0]), "=&v"(hi[1]), "=&v"(hi[2]), "=&v"(hi[3]) : "v"(addr) : "memory");
}
static_assert(16 * CH_PITCH == 2304, "ds_tr16x8 offsets");
__device__ __forceinline__ void ds_tr16x4(unsigned addr, u32x2 (&lo)[2], u32x2 (&hi)[2]) {
    asm volatile("ds_read_b64_tr_b16 %0, %4\n\tds_read_b64_tr_b16 %1, %4 offset:32\n\tds_read_b64_tr_b16 %2, %4 offset:2304\n\tds_read_b64_tr_b16 %3, %4 offset:2336\n\ts_waitcnt lgkmcnt(0)"
                 : "=&v"(lo[0]), "=&v"(lo[1]), "=&v"(hi[0]), "=&v"(hi[1]) : "v"(addr) : "memory");
}
__device__ __forceinline__ float log_sigmoid_(float x) { return fminf(x, 0.f) - log1pf(__expf(-fabsf(x))); }
__device__ __forceinline__ bf16x8 mk_frag(u32x2 lo, u32x2 hi) { u32x4 w; w.x = lo.x; w.y = lo.y; w.z = hi.x; w.w = hi.y; return __builtin_bit_cast(bf16x8, w); }

template <bool IS_ML>
__device__ __forceinline__ void chain_fast(Frame& F, int layer, int b, int h, int dir, LAS unsigned char* img, int hf) {
    constexpr int NET = 2;
    const int lane = F.lane, fr = lane & 15, fq = lane >> 4;
    LAS unsigned char* Qi = img; LAS unsigned char* Ki = img + CH_IMG; LAS unsigned char* Vi = img + 2 * CH_IMG;
    const unsigned qa = (unsigned)(size_t)Qi, ka = (unsigned)(size_t)Ki, va = (unsigned)(size_t)Vi;
    const GAS bf16* RET = WSP(const bf16, WS_RET); const GAS bf16* ML = WSP(const bf16, WS_ML); const GAS float* MLG = WSP(const float, WS_MLG);
    const GAS float* rope = WSP(const float, WS_ROPE);
    GAS bf16* Y = WSP(bf16, WS_Y); GAS bf16* OB = WSP(bf16, WS_OB);
    float lgam = 0.f, bi_ = 0.f, bf_ = 0.f;
    if (!IS_ML) lgam = log_sigmoid_(inp(F, I_RETDECAY)[layer * 12 + dir * 6 + h]);
    else { bi_ = inp(F, I_MLGB)[layer * 16 + dir * 8 + h]; bf_ = inp(F, I_MLGB)[layer * 16 + dir * 8 + 4 + h]; }
    const GAS float* mlc = inp(F, I_MLCONV) + layer * 3 * 512;
    f32x4 C[4][NET];
#pragma unroll
    for (int dt = 0; dt < 4; ++dt)
#pragma unroll
        for (int et = 0; et < NET; ++et) C[dt][et] = (f32x4){0.f, 0.f, 0.f, 0.f};
    const int cq = lane & 7, pr0 = lane >> 3;
    LAS float* nvec = (LAS float*)(img + 3 * CH_IMG + 1024 + 256 * hf);
    if (IS_ML) nvec[lane] = 0.f;
    const LAS float* nq = nvec + 4 * fq;
#pragma unroll 1
    for (int step_ = 0; step_ < 36 * (IS_ML ? REP_CH_ML : REP_CH_RET); ++step_) {
        const int step = step_ % 36;
        if ((IS_ML ? REP_CH_ML : REP_CH_RET) > 1 && step == 0) {
            if (IS_ML) nvec[lane] = 0.f;
#pragma unroll
            for (int dt = 0; dt < 4; ++dt)
#pragma unroll
                for (int et = 0; et < NET; ++et) C[dt][et] = (f32x4){0.f, 0.f, 0.f, 0.f};
        }
        int rowbase, t0, L; bool lat;
        if (step < 4) { const int cc = dir ? 3 - step : step; rowbase = TOKL + b * LC + cc * 64; t0 = cc * 64; L = LC; lat = false; }
        else { const int cc = dir ? 35 - step : step - 4; rowbase = b * LL + cc * 64; t0 = cc * 64; L = LL; lat = true; }
        float g_i = 0.f, g_f = 0.f;
        if (IS_ML) { const int tlg = dir ? 63 - lane : lane; const GAS float* gp = MLG + (size_t)(rowbase + tlg) * 16 + dir * 8 + h; g_i = gp[0]; g_f = gp[4]; }
        if constexpr (!IS_ML) {
#pragma unroll
        for (int i4 = 0; i4 < 4; ++i4) {
            const int i = 4 * hf + i4;
            const int p = pr0 + 8 * i, tl = dir ? 63 - p : p, row = rowbase + tl, tpos = t0 + tl;
            float qv[8], kv[8]; u32x4 vraw;
            {
                const GAS bf16* base = RET + (size_t)row * 1536 + h * 64;
                const u32x4 qr = *(const GAS u32x4*)(base + 8 * cq), kr = *(const GAS u32x4*)(base + 384 + 8 * cq); vraw = *(const GAS u32x4*)(base + 768 + 8 * cq);
                const unsigned qw[4] = {qr.x, qr.y, qr.z, qr.w}, kw[4] = {kr.x, kr.y, kr.z, kr.w};
#pragma unroll
                for (int j = 0; j < 4; ++j) { qv[2 * j] = __uint_as_float(qw[j] << 16); qv[2 * j + 1] = __uint_as_float(qw[j] & 0xffff0000u); kv[2 * j] = __uint_as_float(kw[j] << 16); kv[2 * j + 1] = __uint_as_float(kw[j] & 0xffff0000u); }
                if (lat) {
                    const u32x4 qpr = *(const GAS u32x4*)(base + 8 * (cq ^ 2)), kpr = *(const GAS u32x4*)(base + 384 + 8 * (cq ^ 2));
                    const unsigned qpw[4] = {qpr.x, qpr.y, qpr.z, qpr.w}, kpw[4] = {kpr.x, kpr.y, kpr.z, kpr.w};
                    const int half = cq >> 2, hi = (cq >> 1) & 1, i0 = 8 * (cq & 1);
                    const GAS float* rp = rope + tpos * 64 + half * 32 + i0;
                    const f32x4 c0 = *(const GAS f32x4*)(rp), c1 = *(const GAS f32x4*)(rp + 4), s0 = *(const GAS f32x4*)(rp + 16), s1 = *(const GAS f32x4*)(rp + 20);
                    const float cs[8] = {c0.x, c0.y, c0.z, c0.w, c1.x, c1.y, c1.z, c1.w}, sn[8] = {s0.x, s0.y, s0.z, s0.w, s1.x, s1.y, s1.z, s1.w};
#pragma unroll
                    for (int j = 0; j < 8; ++j) {
                        const float qp = (j & 1) ? __uint_as_float(qpw[j >> 1] & 0xffff0000u) : __uint_as_float(qpw[j >> 1] << 16);
                        const float kp = (j & 1) ? __uint_as_float(kpw[j >> 1] & 0xffff0000u) : __uint_as_float(kpw[j >> 1] << 16);
                        qv[j] = hi ? qp * sn[j] + qv[j] * cs[j] : qv[j] * cs[j] - qp * sn[j];
                        kv[j] = hi ? kp * sn[j] + kv[j] * cs[j] : kv[j] * cs[j] - kp * sn[j];
                    }
                }
#pragma unroll
                for (int j = 0; j < 8; ++j) qv[j] *= 0.125f;
            }
            u32x4 qo, ko; qo.x = pk2(qv[0], qv[1]); qo.y = pk2(qv[2], qv[3]); qo.z = pk2(qv[4], qv[5]); qo.w = pk2(qv[6], qv[7]);
            ko.x = pk2(kv[0], kv[1]); ko.y = pk2(kv[2], kv[3]); ko.z = pk2(kv[4], kv[5]); ko.w = pk2(kv[6], kv[7]);
            *(LAS u32x4*)(Qi + p * CH_PITCH + 16 * cq) = qo; *(LAS u32x4*)(Ki + p * CH_PITCH + 16 * cq) = ko; *(LAS u32x4*)(Vi + p * CH_PITCH + 16 * cq) = vraw;
        }
        } else {
            const GAS float* wq = mlc + h * 64 + 8 * cq;
            u32x4 rr[2][3][4], vr[4];
#pragma unroll
            for (int i4 = 0; i4 < 4; ++i4) {
                const int p = pr0 + 8 * (4 * hf + i4), tl = dir ? 63 - p : p, row = rowbase + tl, tpos = t0 + tl;
                const GAS bf16* bb = ML + (size_t)row * 1024 + h * 64 + 8 * cq;
                const u32x4 z4 = (u32x4){0u, 0u, 0u, 0u};
#pragma unroll
                for (int qk = 0; qk < 2; ++qk) {
                    rr[qk][1][i4] = *(const GAS u32x4*)(bb + 256 * qk);
                    rr[qk][0][i4] = tpos > 0 ? *(const GAS u32x4*)(bb + 256 * qk - 1024) : z4;
                    rr[qk][2][i4] = tpos < L - 1 ? *(const GAS u32x4*)(bb + 256 * qk + 1024) : z4;
                }
                vr[i4] = *(const GAS u32x4*)(bb + 512);
            }
#pragma unroll
            for (int qk = 0; qk < 2; ++qk) {
                f32x4 wt[3][2];
#pragma unroll
                for (int tp = 0; tp < 3; ++tp) { wt[tp][0] = *(const GAS f32x4*)(wq + 256 * qk + 512 * tp); wt[tp][1] = *(const GAS f32x4*)(wq + 256 * qk + 512 * tp + 4); }
#pragma unroll
                for (int i4 = 0; i4 < 4; ++i4) {
                    const int p = pr0 + 8 * (4 * hf + i4);
                    const unsigned a0[4] = {rr[qk][0][i4].x, rr[qk][0][i4].y, rr[qk][0][i4].z, rr[qk][0][i4].w}, a1[4] = {rr[qk][1][i4].x, rr[qk][1][i4].y, rr[qk][1][i4].z, rr[qk][1][i4].w},
                                   a2[4] = {rr[qk][2][i4].x, rr[qk][2][i4].y, rr[qk][2][i4].z, rr[qk][2][i4].w};
                    float ov[8];
#pragma unroll
                    for (int j = 0; j < 8; ++j) {
                        const float x0 = (j & 1) ? __uint_as_float(a0[j >> 1] & 0xffff0000u) : __uint_as_float(a0[j >> 1] << 16);
                        const float x1 = (j & 1) ? __uint_as_float(a1[j >> 1] & 0xffff0000u) : __uint_as_float(a1[j >> 1] << 16);
                        const float x2 = (j & 1) ? __uint_as_float(a2[j >> 1] & 0xffff0000u) : __uint_as_float(a2[j >> 1] << 16);
                        const float r = siluf_(wt[0][j >> 2][j & 3] * x0 + wt[1][j >> 2][j & 3] * x1 + wt[2][j >> 2][j & 3] * x2);
                        ov[j] = qk == 0 ? r : r * 0.125f;
                    }
                    u32x4 o; o.x = pk2(ov[0], ov[1]); o.y = pk2(ov[2], ov[3]); o.z = pk2(ov[4], ov[5]); o.w = pk2(ov[6], ov[7]);
                    if (qk == 0) *(LAS u32x4*)(Qi + p * CH_PITCH + 16 * cq) = o;
                    else { *(LAS u32x4*)(Ki + p * CH_PITCH + 16 * cq) = o; *(LAS u32x4*)(Vi + p * CH_PITCH + 16 * cq) = vr[i4]; }
                }
            }
        }
        __builtin_amdgcn_sched_barrier(0);
        float f_p, i_p;
        if (!IS_ML) { f_p = lgam; i_p = 0.f; }
        else { i_p = g_i + bi_; f_p = log_sigmoid_(g_f + bf_); }
        float bsum = f_p;
#pragma unroll
        for (int o = 1; o < 64; o <<= 1) { const float t = lane_read(bsum, lane >= o ? lane - o : lane); if (lane >= o) bsum += t; }
        LAS float* gv = (LAS float*)(img + 3 * CH_IMG);
        const float b63 = __int_as_float(__builtin_amdgcn_readlane(__float_as_int(bsum), 63));
        const float adec = __expf(b63);
        if (hf == 0) { gv[lane] = bsum; gv[64 + lane] = bsum - i_p; gv[128 + lane] = __expf(bsum); gv[192 + lane] = __expf(b63 - (bsum - i_p)); }
        asm volatile("s_waitcnt lgkmcnt(0)" ::: "memory");
        __syncthreads();
        const LAS float* gq = gv + 4 * fq;
        const bf16x8 ones = (fr == 0) ? (bf16x8){0x3F80, 0x3F80, 0x3F80, 0x3F80, 0x3F80, 0x3F80, 0x3F80, 0x3F80} : (bf16x8){0, 0, 0, 0, 0, 0, 0, 0};
        const int tr_q = fr >> 2, tr_p = fr & 3;
#ifndef PT_UNROLL
#define PT_UNROLL 2
#endif
#pragma unroll PT_UNROLL
        for (int pt = 0; pt < 4; ++pt) {
            f32x4 ST[4];
            bf16x8 qn[2];
#pragma unroll
            for (int kk = 0; kk < 2; ++kk) qn[kk] = *(const LAS bf16x8*)(Qi + (16 * pt + fr) * CH_PITCH + (32 * kk + 8 * fq) * 2);
#pragma unroll
            for (int st = 0; st < 4; ++st) {
                ST[st] = (f32x4){0.f, 0.f, 0.f, 0.f};
                if (st <= pt) {
#pragma unroll
                    for (int kk = 0; kk < 2; ++kk) { const bf16x8 kf = *(const LAS bf16x8*)(Ki + (16 * st + fr) * CH_PITCH + (32 * kk + 8 * fq) * 2); ST[st] = __builtin_amdgcn_mfma_f32_16x16x32_bf16(kf, qn[kk], ST[st], 0, 0, 0); }
                }
            }
            const float bp = gv[16 * pt + fr];
#pragma unroll
            for (int st = 0; st < 4; ++st) {
                if (st <= pt) {
                    const f32x4 bis = *(const LAS f32x4*)(gq + 64 + 16 * st);
#pragma unroll
                    for (int j = 0; j < 4; ++j) { const int sidx = 16 * st + 4 * fq + j; const float w = (sidx <= 16 * pt + fr) ? __expf(bp - bis[j]) : 0.f; ST[st][j] *= w; }
                }
            }
            __builtin_amdgcn_sched_barrier(0);
            f32x4 acc[NET], accd = (f32x4){0.f, 0.f, 0.f, 0.f};
#pragma unroll
            for (int et = 0; et < NET; ++et) acc[et] = (f32x4){0.f, 0.f, 0.f, 0.f};
#pragma unroll
            for (int kk = 0; kk < 2; ++kk) {
                const u32x2 lo = *(const LAS u32x2*)(Qi + (16 * pt + fr) * CH_PITCH + (32 * kk + 4 * fq) * 2), hi = *(const LAS u32x2*)(Qi + (16 * pt + fr) * CH_PITCH + (32 * kk + 16 + 4 * fq) * 2);
                const bf16x8 qs = mk_frag(lo, hi);
#pragma unroll
                for (int et = 0; et < NET; ++et) {
                    u32x4 w; w.x = pk2(C[2 * kk][et].x, C[2 * kk][et].y); w.y = pk2(C[2 * kk][et].z, C[2 * kk][et].w); w.z = pk2(C[2 * kk + 1][et].x, C[2 * kk + 1][et].y); w.w = pk2(C[2 * kk + 1][et].z, C[2 * kk + 1][et].w);
                    acc[et] = __builtin_amdgcn_mfma_f32_16x16x32_bf16(qs, __builtin_bit_cast(bf16x8, w), acc[et], 0, 0, 0);
                }
                if (IS_ML) {
                    const f32x4 n0 = *(const LAS f32x4*)(nq + 32 * kk), n1 = *(const LAS f32x4*)(nq + 32 * kk + 16);
                    u32x4 w; w.x = pk2(n0.x, n0.y); w.y = pk2(n0.z, n0.w); w.z = pk2(n1.x, n1.y); w.w = pk2(n1.z, n1.w);
                    if (fr != 0) w = (u32x4){0u, 0u, 0u, 0u};
                    accd = __builtin_amdgcn_mfma_f32_16x16x32_bf16(qs, __builtin_bit_cast(bf16x8, w), accd, 0, 0, 0);
                }
            }
            { const f32x4 ap = *(const LAS f32x4*)(gq + 128 + 16 * pt);
#pragma unroll
              for (int j = 0; j < 4; ++j) {
#pragma unroll
                for (int et = 0; et < NET; ++et) acc[et][j] *= ap[j];
                accd[j] *= ap[j]; } }
            __builtin_amdgcn_sched_barrier(0);
#pragma unroll
            for (int kk = 0; kk < 2; ++kk) {
                if (2 * kk <= pt) {
                    u32x4 w; w.x = pk2(ST[2 * kk].x, ST[2 * kk].y); w.y = pk2(ST[2 * kk].z, ST[2 * kk].w); w.z = pk2(ST[2 * kk + 1].x, ST[2 * kk + 1].y); w.w = pk2(ST[2 * kk + 1].z, ST[2 * kk + 1].w);
                    const bf16x8 pf = __builtin_bit_cast(bf16x8, w);
                    u32x2 vlo[2], vhi[2];
                    ds_tr16x4(va + (32 * kk + 4 * fq + tr_q) * CH_PITCH + 8 * tr_p + 64 * hf, vlo, vhi);
#pragma unroll
                    for (int et = 0; et < NET; ++et) acc[et] = __builtin_amdgcn_mfma_f32_16x16x32_bf16(pf, mk_frag(vlo[et], vhi[et]), acc[et], 0, 0, 0);
                    if (IS_ML) accd = __builtin_amdgcn_mfma_f32_16x16x32_bf16(pf, ones, accd, 0, 0, 0);
                }
            }
            __builtin_amdgcn_sched_barrier(0);
#pragma unroll
            for (int j = 0; j < 4; ++j) {
                const int p = 16 * pt + 4 * fq + j, tl = dir ? 63 - p : p, row = rowbase + tl;
                float inv = 1.f;
                if (IS_ML) { const float den = lane_read(accd[j], lane & 48); inv = __builtin_amdgcn_rcpf(fmaxf(fabsf(den), 1.f)); }
                const int cof = (IS_ML ? 384 : 0) + h * 64 + 32 * hf + fr;
                const unsigned boff = dir == 0 ? (unsigned)(row * D + 384 + cof) * 2u : (unsigned)(row * 640 + cof) * 2u;
                GAS char* ob = dir == 0 ? (GAS char*)Y : (GAS char*)OB;
#pragma unroll
                for (int et = 0; et < NET; ++et) *(GAS bf16*)(ob + boff + 32 * et) = (bf16)f2bf(acc[et][j] * inv);
            }
        }
        __builtin_amdgcn_sched_barrier(0);
#pragma unroll
        for (int dt = 0; dt < 4; ++dt)
#pragma unroll
            for (int et = 0; et < NET; ++et) C[dt][et] *= adec;
        f32x4 accn[4];
        if (IS_ML) {
#pragma unroll
            for (int dt = 0; dt < 4; ++dt) { accn[dt] = *(const LAS f32x4*)(nq + 16 * dt) * adec; if (fr != 0) accn[dt] = (f32x4){0.f, 0.f, 0.f, 0.f}; }
        }
#pragma unroll
        for (int kk = 0; kk < 2; ++kk) {
            u32x2 vlo[2], vhi[2], klo[4], khi[4];
            ds_tr16x4(va + (32 * kk + 4 * fq + tr_q) * CH_PITCH + 8 * tr_p + 64 * hf, vlo, vhi);
            ds_tr16x8(ka + (32 * kk + 4 * fq + tr_q) * CH_PITCH + 8 * tr_p, klo, khi);
            const f32x4 wl = *(const LAS f32x4*)(gq + 192 + 32 * kk), wh = *(const LAS f32x4*)(gq + 192 + 32 * kk + 16);
#pragma unroll
            for (int dt = 0; dt < 4; ++dt) {
                u32x4 w;
                w.x = pk2(__uint_as_float(klo[dt].x << 16) * wl[0], __uint_as_float(klo[dt].x & 0xffff0000u) * wl[1]);
                w.y = pk2(__uint_as_float(klo[dt].y << 16) * wl[2], __uint_as_float(klo[dt].y & 0xffff0000u) * wl[3]);
                w.z = pk2(__uint_as_float(khi[dt].x << 16) * wh[0], __uint_as_float(khi[dt].x & 0xffff0000u) * wh[1]);
                w.w = pk2(__uint_as_float(khi[dt].y << 16) * wh[2], __uint_as_float(khi[dt].y & 0xffff0000u) * wh[3]);
                const bf16x8 kf = __builtin_bit_cast(bf16x8, w);
#pragma unroll
                for (int et = 0; et < NET; ++et) C[dt][et] = __builtin_amdgcn_mfma_f32_16x16x32_bf16(kf, mk_frag(vlo[et], vhi[et]), C[dt][et], 0, 0, 0);
                if (IS_ML) accn[dt] = __builtin_amdgcn_mfma_f32_16x16x32_bf16(kf, ones, accn[dt], 0, 0, 0);
            }
        }
        if (IS_ML) { if (fr == 0) {
#pragma unroll
            for (int dt = 0; dt < 4; ++dt) *(LAS f32x4*)(nvec + 4 * fq + 16 * dt) = accn[dt]; } }
        asm volatile("s_waitcnt lgkmcnt(0)" ::: "memory");
        __syncthreads();
    }
}

#ifndef REP_HY
#define REP_HY 1
#endif
constexpr int NCHWG = 160;
__device__ __forceinline__ void phase_mix(Frame& F, int layer) {
    const bool last = layer == 1;
    const GAS bf16* ftl = WSP(const bf16, WS_FTL) + (size_t)layer * 2 * 384 * 4096;
    if (F.wg < NCHWG) {
        if (F.wave >= 4) {
#pragma unroll 1
            for (int i = 0; i < 72 * (F.wg * 2 < 192 ? REP_CH_RET : REP_CH_ML); ++i) __syncthreads();
        } else {
            const int cl = F.wave >> 1, hf = F.wave & 1, c = F.wg * 2 + cl;
            LAS unsigned char* img = F.lds + cl * CH_WAVE_LDS;
            if (c < 192) { const int b = c / 12, r = c % 12; chain_fast<false>(F, layer, b, r >> 1, r & 1, img, hf); }
            else { const int i = c - 192; chain_fast<true>(F, layer, i >> 3, (i & 7) >> 1, i & 1, img, hf); }
        }
    } else {
        const int nh = F.G - NCHWG, w = F.wg - NCHWG;
#pragma unroll 1
        for (int rp = 0; rp < REP_HY; ++rp)
            for (int u = w; u < 384; u += nh) hyena_unit_fast<LL>(F, layer, u, WSP(const bf16, WS_HYTL), ftl, WSP(bf16, WS_YHTL));
        if (!last) for (int u = w; u < 384; u += nh) hyena_unit_fast<LC>(F, layer, u, WSP(const bf16, WS_HYTC), WSP(const bf16, WS_FTC), WSP(bf16, WS_YHTC));
    }
}

__device__ __forceinline__ void phase_combine(Frame& F, int layer, bool dummy = false) {
    const bool last = layer == 1;
    const int gw = F.wg * NWAVES + F.wave, NGW = F.G * NWAVES, lane = F.lane;
    const int nrows = last ? TOKL : TOK;
    GAS bf16* Y = WSP(bf16, WS_Y); const GAS bf16* OB = WSP(const bf16, WS_OB); const GAS bf16* RET = WSP(const bf16, WS_RET); const GAS bf16* ML = WSP(const bf16, WS_ML);
    const int rsub = lane >> 4, l16 = lane & 15;
    for (int row0 = gw * 4; row0 < nrows; row0 += NGW * 4) {
        const int row = row0 + rsub;
        GAS bf16* yo = dummy ? WSP(bf16, WS_U + 300 * MiB) + (size_t)(row & 8191) * D : Y + (size_t)row * D;
        u32x2 of[10], ob[10], gt[10];
#pragma unroll
        for (int hh = 0; hh < 10; ++hh) {
            const int cof = hh * 64 + 4 * l16;
            of[hh] = *(const GAS u32x2*)(Y + (size_t)row * D + 384 + cof); ob[hh] = *(const GAS u32x2*)(OB + (size_t)row * 640 + cof);
            gt[hh] = hh < 6 ? *(const GAS u32x2*)(RET + (size_t)row * 1536 + 1152 + cof) : *(const GAS u32x2*)(ML + (size_t)row * 1024 + 768 + (cof - 384));
        }
#pragma unroll
        for (int hh = 0; hh < 10; ++hh) {
            float x[4], g[4];
            x[0] = __uint_as_float(of[hh].x << 16) + __uint_as_float(ob[hh].x << 16); x[1] = __uint_as_float(of[hh].x & 0xffff0000u) + __uint_as_float(ob[hh].x & 0xffff0000u);
            x[2] = __uint_as_float(of[hh].y << 16) + __uint_as_float(ob[hh].y << 16); x[3] = __uint_as_float(of[hh].y & 0xffff0000u) + __uint_as_float(ob[hh].y & 0xffff0000u);
            g[0] = __uint_as_float(gt[hh].x << 16); g[1] = __uint_as_float(gt[hh].x & 0xffff0000u); g[2] = __uint_as_float(gt[hh].y << 16); g[3] = __uint_as_float(gt[hh].y & 0xffff0000u);
            float sm = (x[0] + x[1]) + (x[2] + x[3]);
            DPP_ADD(sm, 0xB1); DPP_ADD(sm, 0x4E); DPP_ADD(sm, 0x141); DPP_ADD(sm, 0x140);
            const float mu = sm * (1.f / 64.f);
#pragma unroll
            for (int j = 0; j < 4; ++j) x[j] -= mu;
            float sq = (x[0] * x[0] + x[1] * x[1]) + (x[2] * x[2] + x[3] * x[3]);
            DPP_ADD(sq, 0xB1); DPP_ADD(sq, 0x4E); DPP_ADD(sq, 0x141); DPP_ADD(sq, 0x140);
            const float rs = rsqrtf(sq * (1.f / 64.f) + 1e-6f);
            float o[4];
#pragma unroll
            for (int j = 0; j < 4; ++j) o[j] = x[j] * rs * (hh < 6 ? siluf_(g[j]) : sigmoidf_(g[j]));
            u32x2 w; w.x = pk2(o[0], o[1]); w.y = pk2(o[2], o[3]);
            *(GAS u32x2*)(yo + 384 + hh * 64 + 4 * l16) = w;
        }
    }
    LAS unsigned char* scr = F.lds + F.wave * 8704;
    const int nitL = NB * 6 * 32, nitC = last ? 0 : NB * 6 * 4;
    for (int it = gw; it < nitL + nitC; it += NGW) {
        const GAS bf16* src; int L, rowbase, b, cb, tb;
        if (it < nitL) { b = it / 192; const int r = it % 192; cb = r / 32; tb = r % 32; L = LL; src = WSP(const bf16, WS_YHTL); rowbase = b * LL; }
        else { const int i2 = it - nitL; b = i2 / 24; const int r = i2 % 24; cb = r / 4; tb = r % 4; L = LC; src = WSP(const bf16, WS_YHTC); rowbase = TOKL + b * LC; }
        u32x4 v[8];
#pragma unroll
        for (int i = 0; i < 8; ++i) { const int cc = (lane >> 3) + 8 * i; v[i] = *(const GAS u32x4*)(src + ((size_t)(b * 384 + cb * 64 + cc)) * L + tb * 64 + 8 * (lane & 7)); }
#pragma unroll
        for (int i = 0; i < 8; ++i) { const int cc = (lane >> 3) + 8 * i; *(LAS u32x4*)(scr + cc * 136 + 16 * (lane & 7)) = v[i]; }
        asm volatile("s_waitcnt lgkmcnt(0)" ::: "memory");
#pragma unroll
        for (int i = 0; i < 8; ++i) {
            const int tt = (lane >> 3) + 8 * i, c8 = 8 * (lane & 7);
            unsigned short e[8];
#pragma unroll
            for (int j = 0; j < 8; ++j) e[j] = *(const LAS unsigned short*)(scr + (c8 + j) * 136 + tt * 2);
            u32x4 o; o.x = e[0] | ((unsigned)e[1] << 16); o.y = e[2] | ((unsigned)e[3] << 16); o.z = e[4] | ((unsigned)e[5] << 16); o.w = e[6] | ((unsigned)e[7] << 16);
            *(GAS u32x4*)((dummy ? WSP(bf16, WS_U + 300 * MiB) : Y) + (size_t)(dummy ? ((rowbase + tb * 64 + tt) & 8191) : (rowbase + tb * 64 + tt)) * D + cb * 64 + c8) = o;
        }
        asm volatile("s_waitcnt lgkmcnt(0)" ::: "memory");
    }
}

__device__ __forceinline__ void phase_norm_router(Frame& F) {
    const int gw = F.wg * NWAVES + F.wave, lane = F.lane;
    const GAS float* g = inp(F, I_GFFN) + 1 * D; const GAS float* wr = inp(F, I_ROUTER); const GAS float* br = inp(F, I_ROUTERB);
    GAS unsigned* cnt = WSP(unsigned, WS_CTL) + CW_CNT;
    const int r0 = gw * 16, r1 = r0 + 16;
    f32x4 gm[4], sh[4], w0r[4][4], w1r[4][4]; u32x2 ring[4][4];
    { const GAS float* shp = mod_ptr(F, 1, r0, 3); const GAS float* scp = mod_ptr(F, 1, r0, 4);
#pragma unroll
      for (int j = 0; j < 4; ++j) { const f32x4 gg = *(const GAS f32x4*)(g + 256 * j + 4 * lane), sc = *(const GAS f32x4*)(scp + 256 * j + 4 * lane); sh[j] = *(const GAS f32x4*)(shp + 256 * j + 4 * lane);
          gm[j].x = gg.x * (1.f + sc.x); gm[j].y = gg.y * (1.f + sc.y); gm[j].z = gg.z * (1.f + sc.z); gm[j].w = gg.w * (1.f + sc.w);
#pragma unroll
          for (int i = 0; i < 4; ++i) { const int k = 256 * j + 4 * lane + i; w0r[j][i] = *(const GAS f32x4*)(wr + k * 8); w1r[j][i] = *(const GAS f32x4*)(wr + k * 8 + 4); } }
#pragma unroll
      for (int i = 0; i < 4; ++i) xrow_issue<true>(F, r0 + i, 2, lane, ring[i]); }
    float brr[8];
#pragma unroll
    for (int e = 0; e < 8; ++e) brr[e] = br[e];
#pragma unroll 1
    for (int rb = r0; rb < r1; rb += 4) {
#pragma unroll
      for (int i = 0; i < 4; ++i) {
        const int row = rb + i;
        f32x4 v[4]; float s = 0.f;
#pragma unroll
        for (int j = 0; j < 4; ++j) { v[j] = xrow_unpack(ring[i][j]); s += (v[j].x * v[j].x + v[j].y * v[j].y) + (v[j].z * v[j].z + v[j].w * v[j].w); }
        if (row + 4 < r1) xrow_issue<true>(F, row + 4, 2, lane, ring[i]);
        const float r = rsqrtf(wave_sum(s) * (1.0f / 1024.0f) + 1e-6f);
        GAS bf16* orow = WSP(bf16, WS_H) + (size_t)row * D;
        float lg[8];
#pragma unroll
        for (int e = 0; e < 8; ++e) lg[e] = 0.f;
#pragma unroll
        for (int j = 0; j < 4; ++j) {
            f32x4 o; o.x = v[j].x * r * gm[j].x + sh[j].x; o.y = v[j].y * r * gm[j].y + sh[j].y; o.z = v[j].z * r * gm[j].z + sh[j].z; o.w = v[j].w * r * gm[j].w + sh[j].w;
            u32x2 w; w.x = pk2(o.x, o.y); w.y = pk2(o.z, o.w);
            *(GAS u32x2*)(orow + 256 * j + 4 * lane) = w;
            const float xo[4] = {o.x, o.y, o.z, o.w};
#pragma unroll
            for (int i = 0; i < 4; ++i) { const float x = xo[i]; const f32x4 w0 = w0r[j][i], w1 = w1r[j][i];
                lg[0] += x * w0.x; lg[1] += x * w0.y; lg[2] += x * w0.z; lg[3] += x * w0.w; lg[4] += x * w1.x; lg[5] += x * w1.y; lg[6] += x * w1.z; lg[7] += x * w1.w; }
        }
#pragma unroll
        for (int e = 0; e < 8; ++e) lg[e] = wave_sum(lg[e]) + brr[e];
        int e0 = 0; float v0 = lg[0];
#pragma unroll
        for (int e = 1; e < 8; ++e) if (lg[e] > v0) { v0 = lg[e]; e0 = e; }
        int e1 = -1; float v1 = -3.0e38f;
#pragma unroll
        for (int e = 0; e < 8; ++e) if (e != e0 && lg[e] > v1) { v1 = lg[e]; e1 = e; }
        const float w1 = 1.f / (1.f + __expf(v0 - v1)), w0 = 1.f - w1;
        if (lane == 0) {
            const unsigned p0 = __hip_atomic_fetch_add(cnt + e0, 1u, __ATOMIC_RELAXED, __HIP_MEMORY_SCOPE_AGENT), p1 = __hip_atomic_fetch_add(cnt + e1, 1u, __ATOMIC_RELAXED, __HIP_MEMORY_SCOPE_AGENT);
            WSP(int, WS_TOPE)[row * 2] = e0; WSP(int, WS_TOPE)[row * 2 + 1] = e1;
            WSP(float, WS_TOPW)[row * 2] = w0; WSP(float, WS_TOPW)[row * 2 + 1] = w1;
            WSP(int, WS_TOPP)[row * 2] = (int)p0; WSP(int, WS_TOPP)[row * 2 + 1] = (int)p1;
        }
      }
    }
}
__device__ __forceinline__ void phase_route_tables(Frame& F) {
    const GAS unsigned* cnt = WSP(const unsigned, WS_CTL) + CW_CNT;
    int off[9]; off[0] = 0;
#pragma unroll
    for (int e = 0; e < 8; ++e) { const int c = (int)__hip_atomic_load(cnt + e, __ATOMIC_RELAXED, __HIP_MEMORY_SCOPE_AGENT); off[e + 1] = off[e] + ((c + 255) >> 8) * 256; }
    const int gt = F.wg * NTHR + F.tid, NGT = F.G * NTHR;
    GAS int* rowidx = WSP(int, WS_ROWIDX); GAS int* slot = WSP(int, WS_SLOT); GAS int* tilee = WSP(int, WS_TILEE);
    for (int i = gt; i < MAXTILES * 256; i += NGT) {
        int e = 0;
#pragma unroll
        for (int q = 1; q < 8; ++q) if (i >= off[q]) e = q;
        const int c = (int)cnt[e];
        if (i >= off[8] || i - off[e] >= c) rowidx[i] = 0;
    }
    for (int i = gt; i < TOKL * 2; i += NGT) {
        const int e = WSP(const int, WS_TOPE)[i], pos = WSP(const int, WS_TOPP)[i];
        int o = 0;
#pragma unroll
        for (int q = 0; q < 8; ++q) if (e == q) o = off[q];
        const int s = o + pos; slot[i] = s; rowidx[s] = i >> 1;
    }
    for (int i = gt; i < MAXTILES + 1; i += NGT) {
        if (i == MAXTILES) tilee[MAXTILES] = off[8] >> 8;
        else { int e = 0;
#pragma unroll
            for (int q = 1; q < 8; ++q) if (i * 256 >= off[q]) e = q;
            tilee[i] = e; }
    }
}

__device__ __forceinline__ void moe_pass_gemm1_fast(Frame& F, int t0, int t1) {
    pg8::OrderMoe S; S.o.init(t1 - t0, NFF1 / 256, F.G, F.wg); S.rowidx = WSP(const int, WS_ROWIDX); S.tilee = WSP(const int, WS_TILEE); S.t0 = t0; S.bstride = (size_t)NFF1 * D; S.gather = true;
    EpiSwiglu E{WSP(bf16, WS_MACT), 0};
    pg8::gemm_phase(F.lds, F.tid, WSP(const bf16, WS_H), D, WSP(const bf16, WS_MW13), D, D, S, E);
}
__device__ __forceinline__ void moe_pass_gemm2_fast(Frame& F, int t0, int t1) {
    pg8::OrderMoe S; S.o.init(t1 - t0, D / 256, F.G, F.wg); S.rowidx = WSP(const int, WS_ROWIDX); S.tilee = WSP(const int, WS_TILEE); S.t0 = t0; S.bstride = (size_t)D * DFF; S.gather = false;
    EpiBf16Out E{WSP(bf16, WS_EOUT), D, t0 * 256};
    pg8::gemm_phase(F.lds, F.tid, WSP(const bf16, WS_MACT), DFF, WSP(const bf16, WS_MW2), DFF, DFF, S, E);
}
__device__ __forceinline__ void phase_final(Frame& F, GAS float* dummy = nullptr) {
    const int gw = F.wg * NWAVES + F.wave, NGW = F.G * NWAVES, lane = F.lane;
    const GAS float* gf = inp(F, I_GFINAL); const GAS bf16* eo = WSP(const bf16, WS_EOUT);
#pragma unroll 2
    for (int row = gw; row < TOKL; row += NGW) {
        const int s0 = WSP(const int, WS_SLOT)[row * 2], s1 = WSP(const int, WS_SLOT)[row * 2 + 1];
        const float w0 = WSP(const float, WS_TOPW)[row * 2], w1 = WSP(const float, WS_TOPW)[row * 2 + 1];
        const GAS float* m5 = mod_ptr(F, 1, row, 5);
        GAS float* xr = outp(F) + (size_t)row * D; const GAS bf16* xb = WSP(const bf16, WS_XL2) + (size_t)row * D;
        f32x4 v[4]; float s = 0.f;
#pragma unroll
        for (int j = 0; j < 4; ++j) {
            const int c = 256 * j + 4 * lane;
            const f32x4 a = ld_bf16x4(eo + (size_t)s0 * D + c), b = ld_bf16x4(eo + (size_t)s1 * D + c), m = *(const GAS f32x4*)(m5 + c);
            v[j] = ld_bf16x4(xb + c) + m * (a * w0 + b * w1);
            s += (v[j].x * v[j].x + v[j].y * v[j].y) + (v[j].z * v[j].z + v[j].w * v[j].w);
        }
        const float r = rsqrtf(wave_sum(s) * (1.f / 1024.f) + 1e-6f);
#pragma unroll
        for (int j = 0; j < 4; ++j) { const int c = 256 * j + 4 * lane; const f32x4 g = *(const GAS f32x4*)(gf + c); GAS float* o_ = dummy ? dummy + (size_t)(row & 8191) * D : xr; *(GAS f32x4*)(o_ + c) = v[j] * r * g; }
    }
}

#ifndef MR_L0
#define MR_L0 192
#endif
#ifndef REP_WIN
#define REP_WIN 1
#endif
#ifndef REP_MIX
#define REP_MIX 1
#endif
#ifndef REP_GATE
#define REP_GATE 1
#endif
#ifndef REP_UP
#define REP_UP 1
#endif
#ifndef REP_FFN1
#define REP_FFN1 1
#endif
#ifndef REP_MOE
#define REP_MOE 1
#endif
#ifndef REP_NORM
#define REP_NORM 1
#endif
#ifndef REP_P0
#define REP_P0 1
#endif
__global__ void __launch_bounds__(NTHR, 2) hybrid_fwd(Params prm) {
    extern __shared__ __attribute__((aligned(16))) unsigned char lds_raw[];
    Frame F;
    F.lds = (LAS unsigned char*)lds_raw; F.ws = (GAS unsigned char*)prm.ws;
    F.tid = threadIdx.x; F.lane = F.tid & 63; F.wave = __builtin_amdgcn_readfirstlane(F.tid >> 6); F.G = gridDim.x; F.wg = blockIdx.x;
    volatile LAS unsigned* MISC = (volatile LAS unsigned*)(F.lds + MISC_OFF);
    if (F.tid < 64) MISC[F.tid] = 0u;
    if (F.tid < 33) { const unsigned long long v = F.tid < 32 ? (unsigned long long)prm.in[F.tid] : (unsigned long long)prm.out; *(LAS unsigned long long*)(F.lds + PTAB_OFF + 8 * F.tid) = v; }
    __syncthreads();
    XcdBarrier bar = xcd_barrier_post(WSP(unsigned, WS_CTL) + CW_BAR, MISC + 8);
#define RELAUNDER() do { { unsigned long long _w = (unsigned long long)F.ws; asm volatile("" : "+s"(_w)); F.ws = (GAS unsigned char*)_w; } \
        { unsigned _t = (unsigned)F.tid; asm volatile("" : "+v"(_t)); F.tid = (int)_t; F.lane = F.tid & 63; F.wave = __builtin_amdgcn_readfirstlane(F.tid >> 6); } \
        { unsigned _g = (unsigned)F.G, _b = (unsigned)F.wg; asm volatile("" : "+s"(_g), "+s"(_b)); F.G = (int)_g; F.wg = (int)_b; } \
        { unsigned _l = (unsigned)(size_t)F.lds; asm volatile("" : "+s"(_l)); F.lds = (LAS unsigned char*)(size_t)_l; } } while (0)
#define GRID_BAR() do { { unsigned long long _b = (unsigned long long)bar.bar; unsigned _x = bar.x; asm volatile("" : "+s"(_b), "+s"(_x)); bar.bar = (GAS unsigned*)_b; bar.x = _x; } xcd_barrier(bar); RELAUNDER(); } while (0)

    for (int rp = 0; rp < REP_P0; ++rp) { phase_p0(F); write_bias(F);
    GRID_BAR(); }
#pragma unroll 1
    for (int layer_ = 0; layer_ < 2; ++layer_) {
        int layer = layer_;
#define last (layer == 1)
#define rows_all TOK
#define rows_out (last ? TOKL : TOK)
#define modbase (WSP(const float, WS_MOD) + (size_t)layer * 17 * 6144)
#define LAYER_LAUNDER() asm volatile("" : "+s"(layer))
        for (int rp = 0; rp < REP_NORM; ++rp) { if (last) phase_norm<true>(F, layer, rows_all, 0); else phase_norm<false>(F, layer, rows_all, 0);
        if (layer == 0) { const int gw = F.wg * NWAVES + F.wave, NGW = F.G * NWAVES;
            for (int it = gw; it < 1536 + 96; it += NGW) filter_out_item(F, it); }
        { GRID_BAR(); LAYER_LAUNDER(); } }
        for (int rp = 0; rp < REP_WIN; ++rp) {
        { EpiWin E{WSP(const float, WS_BIAS) + layer * NWP, WSP(bf16, WS_HYTL), WSP(bf16, WS_HYTC), WSP(bf16, WS_RET), WSP(bf16, WS_ML), WSP(float, WS_MLG)};
          if (last) { pg8::OrderWinL1 S; S.init(F.G, F.wg); pg8::gemm_phase(F.lds, F.tid, WSP(const bf16, WS_H), D, WSP(const bf16, WS_WIN), D, D, S, E); }
          else gemm_fast(F, WSP(const bf16, WS_H), D, WSP(const bf16, WS_WIN), D, D, rows_all, NW1, E); }
        { GRID_BAR(); LAYER_LAUNDER(); } }
        for (int rp = 0; rp < REP_MIX; ++rp) { phase_mix(F, layer);
        { GRID_BAR(); LAYER_LAUNDER(); } }
#ifndef REP_COMB
#define REP_COMB 1
#endif
        for (int rp = REP_COMB - 1; rp > 0; --rp) { phase_combine(F, layer, true); { GRID_BAR(); LAYER_LAUNDER(); } }
        phase_combine(F, layer);
        { GRID_BAR(); LAYER_LAUNDER(); }
        for (int rp = 0; rp < REP_GATE; ++rp) {
        { EpiGate E{WSP(const float, WS_BIAS) + layer * NWP + NW1, WSP(bf16, WS_GATES)};
          gemm_fast(F, WSP(const bf16, WS_H), D, WSP(const bf16, WS_WIN) + (size_t)NW1 * D, D, D, rows_out, NGATE, E); }
        { GRID_BAR(); LAYER_LAUNDER(); } }
        for (int rp = 0; rp < REP_UP; ++rp) {
        { EpiUp E{WSP(const bf16, WS_GATES), WSP(bf16, WS_H)};
          if (last) gemm_fast(F, WSP(const bf16, WS_Y), D, WSP(const bf16, WS_WUP), D, D, TOKL, D, E);
          else gemm_fast<MR_L0>(F, WSP(const bf16, WS_Y), D, WSP(const bf16, WS_WUP), D, D, TOK, D, E); }
        { GRID_BAR(); LAYER_LAUNDER(); } }
#ifndef REP_OUT
#define REP_OUT 1
#endif
        if (last) { EpiResidT<true> E{(const GAS bf16*)outp(F), nullptr, WSP(bf16, WS_XL2), nullptr, modbase, 2};
            gemm_fast(F, WSP(const bf16, WS_H), D, WSP(const bf16, WS_WOUT), D, D, TOKL, D, E); }
        else { EpiResidT<false> E{inp(F, I_X), inp(F, I_CTX), (GAS bf16*)outp(F), WSP(bf16, WS_XC), modbase, 2};
            gemm_fast<MR_L0>(F, WSP(const bf16, WS_H), D, WSP(const bf16, WS_WOUT), D, D, TOK, D, E); }
        { GRID_BAR(); LAYER_LAUNDER(); }
        if (!last) {
            phase_norm<true>(F, layer, rows_out, 3);
            { const int gw = F.wg * NWAVES + F.wave, NGW = F.G * NWAVES; LAS float* scr = (LAS float*)(F.lds + F.wave * 8704);
              conv_weights_ffn(inp(F, I_FW1), inp(F, I_FW3), inp(F, I_FW2), WSP(bf16, WS_W13), WSP(bf16, WS_W2), gw, NGW, scr, F.lane);
              conv_weights_win(F, 1, gw, NGW, scr);
              conv_weights_upout(F, 1, gw, NGW, scr); }
            { GRID_BAR(); LAYER_LAUNDER(); }
            for (int rp = 0; rp < REP_FFN1; ++rp) {
            { EpiSwiglu E{WSP(bf16, WS_ACT), 0};
              gemm_fast(F, WSP(const bf16, WS_H), D, WSP(const bf16, WS_W13), D, D, rows_out, NFF1, E); }
            { GRID_BAR(); LAYER_LAUNDER(); } }
#ifndef REP_FFN2
#define REP_FFN2 1
#endif
            { EpiResidT<true> E{(const GAS bf16*)outp(F), WSP(const bf16, WS_XC), (GAS bf16*)outp(F), WSP(bf16, WS_XC), modbase, 5};
              gemm_fast<MR_L0>(F, WSP(const bf16, WS_ACT), DFF, WSP(const bf16, WS_W2), DFF, DFF, TOK, D, E); }
            { GRID_BAR(); LAYER_LAUNDER(); }
        }
    }
#undef LAYER_LAUNDER
#undef last
#undef rows_all
#undef rows_out
#undef modbase
    phase_norm_router(F);
    { const int gw = F.wg * NWAVES + F.wave, NGW = F.G * NWAVES; LAS float* scr = (LAS float*)(F.lds + F.wave * 8704);
#ifndef REP_MCONV
#define REP_MCONV 1
#endif
#pragma unroll 1
      for (int e = 0; e < NE * REP_MCONV; ++e)
          conv_weights_ffn(inp(F, I_MW1) + (size_t)(e % NE) * D * DFF, inp(F, I_MW3) + (size_t)(e % NE) * D * DFF, inp(F, I_MW2) + (size_t)(e % NE) * DFF * D,
                           WSP(bf16, WS_MW13) + (size_t)(e % NE) * NFF1 * D, WSP(bf16, WS_MW2) + (size_t)(e % NE) * D * DFF, gw, NGW, scr, F.lane); }
    GRID_BAR();
    phase_route_tables(F);
    GRID_BAR();
    const int ntiles = __builtin_amdgcn_readfirstlane(WSP(const int, WS_TILEE)[MAXTILES]);
#pragma unroll 1
    for (int p = 0; p < NPASS; ++p) {
        const int t0 = p * PASS_TILES, t1 = min(ntiles, t0 + PASS_TILES);
        for (int rp = 0; rp < REP_MOE; ++rp) {
        if (t0 < t1) moe_pass_gemm1_fast(F, t0, t1);
        GRID_BAR();
        if (t0 < t1) moe_pass_gemm2_fast(F, t0, t1);
        GRID_BAR(); }
    }
#ifndef REP_BAR
#define REP_BAR 0
#endif
    for (int rb = 0; rb < REP_BAR; ++rb) GRID_BAR();
#ifndef REP_FINAL
#define REP_FINAL 1
#endif
    for (int rp = REP_FINAL - 1; rp > 0; --rp) { phase_final(F, WSP(float, WS_H)); GRID_BAR(); }
    phase_final(F);
}

extern "C" void kernel_launch(void* const* d_in, const int* in_sizes, int n_in, void* d_out, int out_size, void* d_ws, size_t ws_size, hipStream_t stream) {
    static int grid = 0;
    if (grid == 0) {
        if (n_in != 32 || out_size != TOKL * D || ws_size < WS_END) { fprintf(stderr, "kernel_launch: unexpected arguments (n_in %d, out %d, ws %zu)\n", n_in, out_size, ws_size); grid = -1; return; }
        int dev = 0, cus = 0;
        if (hipGetDevice(&dev) != hipSuccess || hipDeviceGetAttribute(&cus, hipDeviceAttributeMultiprocessorCount, dev) != hipSuccess) { grid = -1; return; }
        if (hipFuncSetAttribute((const void*)hybrid_fwd, hipFuncAttributeMaxDynamicSharedMemorySize, LDS_BYTES) != hipSuccess) { grid = -1; return; }
        int per_cu = 0;
        (void)hipOccupancyMaxActiveBlocksPerMultiprocessor(&per_cu, (const void*)hybrid_fwd, NTHR, LDS_BYTES);
        (void)hipGetLastError();
        if (cus < 256) { fprintf(stderr, "kernel_launch: needs 256 compute units (one workgroup each), found %d\n", cus); grid = -1; return; }
        grid = 256;
    }
    if (grid < 0) return;
    (void)hipMemsetAsync((char*)d_ws + WS_CTL, 0, CTL_ZERO_BYTES, stream);
    Params p{};
    for (int i = 0; i < 32; ++i) p.in[i] = (const float*)d_in[i];
    p.out = (float*)d_out; p.ws = (unsigned char*)d_ws;
    hipLaunchKernelGGL(hybrid_fwd, dim3(grid), dim3(NTHR), LDS_BYTES, stream, p);
}
```

```cpp
#include <hip/hip_runtime.h>
#include <stdint.h>
#include <stdio.h>

#define LAS __attribute__((address_space(3)))
#define GAS __attribute__((address_space(1)))
typedef unsigned short bf16;
typedef short bf16x8 __attribute__((ext_vector_type(8)));
typedef float f32x4 __attribute__((ext_vector_type(4)));
typedef unsigned u32x4 __attribute__((ext_vector_type(4)));
typedef unsigned u32x2 __attribute__((ext_vector_type(2)));

constexpr int D = 1024, NB = 16, LL = 2048, LC = 256;
constexpr int TOKL = NB * LL, TOKC = NB * LC, TOK = TOKL + TOKC;
constexpr int HYW = 384, RETW = 384, MLW = 256;
constexpr int NIN = 6800, NW1 = 3840, NGATE = 3072, NWP = 6912;
constexpr int DFF = 2816, NFF1 = 5632, NE = 8;
constexpr int NWAVES = 8, NTHR = 512;
constexpr int MAXTILES = 272, PASS_TILES = 58, NPASS = 5;

constexpr size_t MiB = 1u << 20;
constexpr size_t WS_CTL = 0, CTL_ZERO_BYTES = 1 * MiB;
constexpr size_t WS_MOD = 1 * MiB;
constexpr size_t WS_BIAS = 2 * MiB;
constexpr size_t WS_ROPE = 2 * MiB + 256 * 1024;
constexpr size_t WS_TOPE = 3 * MiB;
constexpr size_t WS_TOPW = 3 * MiB + 256 * 1024;
constexpr size_t WS_TOPP = 3 * MiB + 512 * 1024;
constexpr size_t WS_SLOT = 3 * MiB + 768 * 1024;
constexpr size_t WS_ROWIDX = 4 * MiB;
constexpr size_t WS_TILEE = 4 * MiB + 512 * 1024;
constexpr size_t WS_FTL = 5 * MiB;
constexpr size_t WS_FTC = 17 * MiB;
constexpr size_t WS_WIN = 18 * MiB;
constexpr size_t WS_WUP = 32 * MiB;
constexpr size_t WS_WOUT = 34 * MiB;
constexpr size_t WS_XC = 36 * MiB;
constexpr size_t WS_H = 52 * MiB;
constexpr size_t WS_Y = 124 * MiB;
constexpr size_t WS_U = 196 * MiB;
constexpr size_t WS_RET = WS_U;
constexpr size_t WS_ML = WS_U + 108 * MiB;
constexpr size_t WS_MLG = WS_U + 180 * MiB;
constexpr size_t WS_OB = WS_U + 183 * MiB;
constexpr size_t WS_YHTL = WS_U + 228 * MiB;
constexpr size_t WS_YHTC = WS_U + 252 * MiB;
constexpr size_t WS_HYTL = WS_U + 255 * MiB;
constexpr size_t WS_HYTC = WS_U + 327 * MiB;
constexpr size_t WS_XL2 = WS_U + 284 * MiB;
constexpr size_t WS_END = WS_U + 348 * MiB;
constexpr size_t WS_GATES = WS_U;
constexpr size_t WS_ACT = WS_U;
constexpr size_t WS_W13 = WS_U + 204 * MiB;
constexpr size_t WS_W2 = WS_U + 216 * MiB;
constexpr size_t WS_MW13 = WS_Y;
constexpr size_t WS_MW2 = WS_Y + 88 * MiB;
constexpr size_t WS_MACT = WS_Y + 132 * MiB;
constexpr size_t WS_EOUT = WS_Y + 220 * MiB;
static_assert(WS_EOUT + (size_t)MAXTILES * 256 * 1024 * 2 <= WS_XL2, "map");
static_assert(WS_GATES + (size_t)TOK * NGATE * 2 <= WS_YHTL, "gates overlay");

constexpr int CW_BAR = 4096;
constexpr int CW_CNT = 16384;

constexpr int LDS_BYTES = 147456;
constexpr int MISC_OFF = 147456 - 256;

__device__ __forceinline__ float bf2f(bf16 b) { return __uint_as_float(((unsigned)b) << 16); }
typedef __bf16 bf2v_ __attribute__((ext_vector_type(2)));
typedef float f2v_ __attribute__((ext_vector_type(2)));
__device__ __forceinline__ unsigned pk2(float lo, float hi) { const f2v_ f = {lo, hi}; return __builtin_bit_cast(unsigned, __builtin_convertvector(f, bf2v_)); }
__device__ __forceinline__ unsigned f2bf(float f) { return pk2(f, 0.f) & 0xffffu; }
__device__ __forceinline__ float dpp_f(float v, int) { return v; }
#define DPP_ADD(v, ctrl) (v) += __int_as_float(__builtin_amdgcn_update_dpp(0, __float_as_int(v), (ctrl), 0xf, 0xf, true))
__device__ __forceinline__ float wave_sum(float v) {
    DPP_ADD(v, 0xB1);
    DPP_ADD(v, 0x4E);
    DPP_ADD(v, 0x141);
    DPP_ADD(v, 0x140);
    return __int_as_float(__builtin_amdgcn_readlane(__float_as_int(v), 0)) + __int_as_float(__builtin_amdgcn_readlane(__float_as_int(v), 16))
         + __int_as_float(__builtin_amdgcn_readlane(__float_as_int(v), 32)) + __int_as_float(__builtin_amdgcn_readlane(__float_as_int(v), 48));
}
__device__ __forceinline__ float lane_read(float v, int src_lane) { return __int_as_float(__builtin_amdgcn_ds_bpermute(src_lane << 2, __float_as_int(v))); }
__device__ __forceinline__ float sigmoidf_(float x) { return __builtin_amdgcn_rcpf(1.0f + __expf(-x)); }
__device__ __forceinline__ float siluf_(float x) { return x * __builtin_amdgcn_rcpf(1.0f + __expf(-x)); }

#define XB_TMO      128
#define XB_XCNT(j)  (256  + 64 * (j))
#define XB_XSUB(j)  (1280 + 64 * (j))
#define XB_XGEN(j)  (2304 + 64 * (j))
#define XB_TOP      3328
#define XB_TOPGEN   3392
#define XCD_BAR_WORDS 3456
#define XB_SPIN_CAP (1u << 22)
__device__ __forceinline__ unsigned xb_ld(GAS unsigned* p)              { return __hip_atomic_load(p, __ATOMIC_RELAXED, __HIP_MEMORY_SCOPE_AGENT); }
__device__ __forceinline__ unsigned xb_add(GAS unsigned* p, unsigned v) { return __hip_atomic_fetch_add(p, v, __ATOMIC_RELAXED, __HIP_MEMORY_SCOPE_AGENT); }
__device__ __forceinline__ unsigned xb_xcc_id() { return (unsigned)__builtin_amdgcn_s_getreg((3 << 11) | 20) & 0xFu; }
#ifndef XB_SLEEP
#define XB_SLEEP 0
#endif
#define XB_SPIN(cond, bar) do { unsigned _sp = 0; while (cond) { if (XB_SLEEP) __builtin_amdgcn_s_sleep(1); \
    if ((++_sp & 255u) == 0u) { if (xb_ld(&(bar)[XB_TMO])) break; if (_sp > XB_SPIN_CAP) { (void)__hip_atomic_fetch_add(&(bar)[XB_TMO], 1u, __ATOMIC_RELAXED, __HIP_MEMORY_SCOPE_AGENT); break; } } } } while (0)
struct XcdBarrier { GAS unsigned* bar; unsigned x; volatile LAS unsigned* st; };
__device__ __forceinline__ XcdBarrier xcd_barrier_post(GAS unsigned* bar, volatile LAS unsigned* st) {
    XcdBarrier b; b.bar = bar; b.x = xb_xcc_id(); b.st = st;
    if (threadIdx.x == 0) (void)xb_add(&bar[XB_XCNT(b.x)], 1u);
    return b;
}
__device__ __forceinline__ void xcd_barrier_complete(GAS unsigned* bar, unsigned x, unsigned& nloc, unsigned& nx) {
    const unsigned G = gridDim.x * gridDim.y * gridDim.z;
    unsigned sum, cnt, mine, sp = 0u;
    for (;;) {
        sum = 0u; cnt = 0u; mine = 0u;
#pragma unroll 1
        for (unsigned j = 0; j < 16; ++j) { const unsigned c = xb_ld(&bar[XB_XCNT(j)]); sum += c; cnt += (c > 0u) ? 1u : 0u; }
        mine = xb_ld(&bar[XB_XCNT(x)]);
        if (sum == G) break;
        __builtin_amdgcn_s_sleep(1);
        if ((++sp & 255u) == 0u) { if (xb_ld(&bar[XB_TMO])) break; if (sp > XB_SPIN_CAP) { (void)__hip_atomic_fetch_add(&bar[XB_TMO], 1u, __ATOMIC_RELAXED, __HIP_MEMORY_SCOPE_AGENT); break; } }
    }
    nloc = mine > 0u ? mine : 1u; nx = cnt > 0u ? cnt : 1u;
}
__device__ __forceinline__ void xcd_barrier(const XcdBarrier& b) {
    asm volatile("s_waitcnt vmcnt(0)" ::: "memory");
    __syncthreads();
    if (threadIdx.x == 0) {
        GAS unsigned* bar = b.bar;
        __builtin_amdgcn_s_waitcnt(0);
        unsigned nloc = b.st[0], nx = b.st[1];
        if (nloc == 0u) { xcd_barrier_complete(bar, b.x, nloc, nx); b.st[0] = nloc; b.st[1] = nx; }
        const unsigned old = xb_add(&bar[XB_XSUB(b.x)], 1u);
        const unsigned gen = old / nloc;
        if (old + 1u == (gen + 1u) * nloc) {
            __builtin_amdgcn_fence(__ATOMIC_RELEASE, "agent");
            asm volatile("s_waitcnt vmcnt(0)" ::: "memory");
            const unsigned og = xb_add(&bar[XB_TOP], 1u);
            const unsigned tg = og / nx;
            if (og + 1u == (tg + 1u) * nx) xb_add(&bar[XB_TOPGEN], 1u);
            else XB_SPIN(xb_ld(&bar[XB_TOPGEN]) == tg, bar);
            __builtin_amdgcn_fence(__ATOMIC_ACQUIRE, "agent");
            xb_add(&bar[XB_XGEN(b.x)], 1u);
            asm volatile("s_waitcnt vmcnt(0)" ::: "memory");
        } else {
            XB_SPIN(xb_ld(&bar[XB_XGEN(b.x)]) == gen, bar);
            __builtin_amdgcn_fence(__ATOMIC_ACQUIRE, "agent");
            asm volatile("s_waitcnt vmcnt(0)" ::: "memory");
        }
    }
    __syncthreads();
}

struct Params { const float* in[32]; float* out; unsigned char* ws; };
enum { I_X = 0, I_C, I_CTX, I_CCTX, I_WMOD, I_BMOD, I_GMIX, I_GFFN, I_WIN, I_BIN, I_HYCONV, I_HYF1, I_HYFB1, I_HYF2, I_HYFB2, I_HYF3, I_HYDECAY,
       I_HYSKIP, I_RETDECAY, I_MLCONV, I_MLGB, I_WUP, I_WOUT, I_FW1, I_FW3, I_FW2, I_ROUTER, I_ROUTERB, I_MW1, I_MW3, I_MW2, I_GFINAL };

struct Frame {
    LAS unsigned char* lds;
    GAS unsigned char* ws;
    int tid, lane, wave, G, wg;
};
#define WSP(T, off) ((GAS T*)(F.ws + (off)))
constexpr int PTAB_OFF = 147456 - 1024;
__device__ __forceinline__ const GAS float* inp(const Frame& F, int i) {
    const LAS unsigned* t = (const LAS unsigned*)(F.lds + PTAB_OFF) + 2 * i;
    const unsigned lo = __builtin_amdgcn_readfirstlane(t[0]), hi = __builtin_amdgcn_readfirstlane(t[1]);
    return (const GAS float*)(((unsigned long long)hi << 32) | lo);
}
__device__ __forceinline__ GAS float* outp(const Frame& F) { return (GAS float*)inp(F, 32); }

__device__ __forceinline__ int row_batch(int row) { return row < TOKL ? (row >> 11) : ((row - TOKL) >> 8); }
__device__ __forceinline__ const GAS float* mod_ptr(const Frame& F, int layer, int row, int which) {
    const int r = row < TOKL ? (row >> 11) : 16;
    return WSP(const float, WS_MOD) + ((size_t)(layer * 17 + r) * 6 + which) * 1024;
}

template <class RowMap>
__device__ __forceinline__ void tr_item(const GAS float* W, int K, int N, GAS bf16* WT, int ldT, RowMap rm, LAS float* scr, int item, int lane) {
    const int nblk = (N + 31) / 32, kb = item / nblk, nb = item % nblk, k0 = 64 * kb, n0 = 32 * nb;
    { f32x4 tv[8];
#pragma unroll
      for (int i = 0; i < 8; ++i) { const int kk = 8 * i + (lane >> 3); const int n = n0 + 4 * (lane & 7); tv[i] = (n < N) ? *(const GAS f32x4*)(W + (size_t)(k0 + kk) * N + n) : (f32x4){0.f, 0.f, 0.f, 0.f}; }
#pragma unroll
      for (int i = 0; i < 8; ++i) { const int kk = 8 * i + (lane >> 3); LAS float* d = scr + kk * 33 + 4 * (lane & 7); d[0] = tv[i].x; d[1] = tv[i].y; d[2] = tv[i].z; d[3] = tv[i].w; } }
    asm volatile("s_waitcnt lgkmcnt(0)" ::: "memory");
    const int c = lane & 7;
#pragma unroll
    for (int j = 0; j < 4; ++j) { const int nl = (lane >> 3) + 8 * j; const int n = n0 + nl; const LAS float* s = scr + (8 * c) * 33 + nl;
        u32x4 o; o.x = pk2(s[0 * 33], s[1 * 33]); o.y = pk2(s[2 * 33], s[3 * 33]); o.z = pk2(s[4 * 33], s[5 * 33]); o.w = pk2(s[6 * 33], s[7 * 33]);
        if (n < N) *(GAS u32x4*)(WT + (size_t)rm(n) * ldT + k0 + 8 * c) = o; }
    asm volatile("s_waitcnt lgkmcnt(0)" ::: "memory");
}
struct RmId { __device__ __forceinline__ int operator()(int n) const { return n; } };
__device__ __forceinline__ int win_row(int n) {
    if (n < 1152) return n;
    if (n < 2688) return 1280 + (n - 1152);
    if (n < 3712) return 2816 + (n - 2688);
    if (n < 3728) return 1152 + (n - 3712);
    return 3840 + (n - 3728);
}
struct RmWin { __device__ __forceinline__ int operator()(int n) const { return win_row(n); } };
struct RmW1 { __device__ __forceinline__ int operator()(int n) const { return (n >> 4) * 32 + (n & 15); } };
struct RmW3 { __device__ __forceinline__ int operator()(int n) const { return (n >> 4) * 32 + 16 + (n & 15); } };

__device__ __forceinline__ void conv_weights_win(Frame& F, int layer, int gw, int NGW, LAS float* scr) {
    const GAS float* W = inp(F, I_WIN) + (size_t)layer * D * NIN;
    const int items = (D / 64) * ((NIN + 31) / 32);
    for (int it = gw; it < items; it += NGW) tr_item(W, D, NIN, WSP(bf16, WS_WIN), D, RmWin(), scr, it, F.lane);
    GAS bf16* wt = WSP(bf16, WS_WIN);
    unsigned zz; asm volatile("v_mov_b32 %0, 0" : "=v"(zz));
    for (int i = gw * 64 + F.lane; i < 112 * 1024 / 8; i += NGW * 64) *(GAS u32x4*)(wt + (size_t)1168 * 1024 + (size_t)i * 8) = (u32x4){zz, zz, zz, zz};
}
__device__ __forceinline__ void conv_weights_upout(Frame& F, int layer, int gw, int NGW, LAS float* scr) {
    const int items = (D / 64) * (D / 32);
    for (int it = gw; it < items; it += NGW) tr_item(inp(F, I_WUP) + (size_t)layer * D * D, D, D, WSP(bf16, WS_WUP), D, RmId(), scr, it, F.lane);
    for (int it = gw; it < items; it += NGW) tr_item(inp(F, I_WOUT) + (size_t)layer * D * D, D, D, WSP(bf16, WS_WOUT), D, RmId(), scr, it, F.lane);
}
__device__ __forceinline__ void conv_weights_ffn(const GAS float* w1, const GAS float* w3, const GAS float* w2, GAS bf16* w13t, GAS bf16* w2t, int gw, int NGW, LAS float* scr, int lane) {
    const int i1 = (D / 64) * (DFF / 32), i2 = (DFF / 64) * (D / 32);
    for (int it = gw; it < i1; it += NGW) tr_item(w1, D, DFF, w13t, D, RmW1(), scr, it, lane);
    for (int it = gw; it < i1; it += NGW) tr_item(w3, D, DFF, w13t, D, RmW3(), scr, it, lane);
    for (int it = gw; it < i2; it += NGW) tr_item(w2, DFF, D, w2t, DFF, RmId(), scr, it, lane);
}

constexpr size_t WS_HID2 = WS_XC;
__device__ __forceinline__ void filter_hidden_item(Frame& F, int p) {
    const int sel = p < 2048 ? 0 : (p < 4096 ? 1 : 2), layer = sel == 1 ? 1 : 0, L = sel == 2 ? LC : LL, pbase = sel == 0 ? 0 : (sel == 1 ? 2048 : 4096);
    const GAS float* f1 = inp(F, I_HYF1) + layer * 33 * 64; const GAS float* fb1 = inp(F, I_HYFB1) + layer * 64;
    const GAS float* f2 = inp(F, I_HYF2) + layer * 64 * 64; const GAS float* fb2 = inp(F, I_HYFB2) + layer * 64;
    const int lane = F.lane;
    float w1[33], w2[64];
#pragma unroll
    for (int i = 0; i < 33; ++i) w1[i] = f1[i * 64 + lane];
#pragma unroll
    for (int i = 0; i < 64; ++i) w2[i] = f2[i * 64 + lane];
    const float b1 = fb1[lane], b2 = fb2[lane];
    const int pos = p - pbase;
    const float t = (float)pos / (float)(L - 1);
    const float w = 6.283185307179586f * (float)pos / (float)L;
    float feat = 0.f;
    if (lane == 0) feat = t;
    else if (lane < 17) { const float band = 1e-4f + (float)(lane - 1) * ((15.0f - 1e-4f) / 15.0f); feat = cosf(w * band); }
    else if (lane < 33) { const float band = 1e-4f + (float)(lane - 17) * ((15.0f - 1e-4f) / 15.0f); feat = -sinf(w * band); }
    float a1 = b1;
#pragma unroll
    for (int i = 0; i < 33; ++i) a1 += __int_as_float(__builtin_amdgcn_readlane(__float_as_int(feat), i)) * w1[i];
    const float h1 = sinf(a1);
    float a2 = b2;
#pragma unroll
    for (int i = 0; i < 64; ++i) a2 += __int_as_float(__builtin_amdgcn_readlane(__float_as_int(h1), i)) * w2[i];
    WSP(float, WS_HID2)[(size_t)p * 64 + lane] = sinf(a2);
}
__device__ __forceinline__ void filter_out_item(Frame& F, int item) {
    int sel, r;
    if (item < 768) { sel = 0; r = item; } else if (item < 1536) { sel = 1; r = item - 768; } else { sel = 2; r = item - 1536; }
    const int layer = sel == 1 ? 1 : 0, L = sel == 2 ? LC : LL, pb = r / 24, ch = r % 24, pbase = sel == 0 ? 0 : (sel == 1 ? 2048 : 4096);
    GAS bf16* FT = sel == 2 ? WSP(bf16, WS_FTC) : WSP(bf16, WS_FTL) + (size_t)layer * 2 * 384 * 4096;
    const GAS float* f3 = inp(F, I_HYF3) + (size_t)layer * 64 * 1536; const GAS float* dec = inp(F, I_HYDECAY) + layer * 1536;
    const int lane = F.lane, fr = lane & 15, fq = lane >> 4;
    const GAS float* hid = WSP(const float, WS_HID2) + (size_t)(pbase + pb * 64) * 64;
    f32x4 acc[4][4];
#pragma unroll
    for (int mt = 0; mt < 4; ++mt)
#pragma unroll
        for (int nt = 0; nt < 4; ++nt) acc[mt][nt] = (f32x4){0.f, 0.f, 0.f, 0.f};
#pragma unroll
    for (int ks = 0; ks < 16; ++ks) {
        float a[4], bb[4];
#pragma unroll
        for (int mt = 0; mt < 4; ++mt) a[mt] = hid[(16 * mt + fr) * 64 + 4 * ks + fq];
#pragma unroll
        for (int nt = 0; nt < 4; ++nt) bb[nt] = f3[(size_t)(4 * ks + fq) * 1536 + ch * 64 + 16 * nt + fr];
#pragma unroll
        for (int mt = 0; mt < 4; ++mt)
#pragma unroll
            for (int nt = 0; nt < 4; ++nt) acc[mt][nt] = __builtin_amdgcn_mfma_f32_16x16x4f32(a[mt], bb[nt], acc[mt][nt], 0, 0, 0);
    }
#pragma unroll
    for (int nt = 0; nt < 4; ++nt) {
        const int nn = ch * 64 + 16 * nt + fr, o = nn / 768, dir = (nn / 384) & 1, c = nn % 384;
        const float adec = fabsf(dec[nn]);
        GAS bf16* dst = FT + (size_t)(o * 384 + c) * (2 * L);
#pragma unroll
        for (int mt = 0; mt < 4; ++mt)
#pragma unroll
            for (int j = 0; j < 4; ++j) {
                const int pos = pb * 64 + 16 * mt + 4 * fq + j;
                const float t = (float)pos / (float)(L - 1);
                const float v = acc[mt][nt][j] * __expf(-t * adec);
                if (dir == 0) dst[L - pos] = (bf16)f2bf(v);
                else if (pos > 0) dst[L + pos] = (bf16)f2bf(v);
            }
    }
}

__device__ __forceinline__ void phase_p0(Frame& F) {
    const int gw = F.wg * NWAVES + F.wave, NGW = F.G * NWAVES;
    LAS float* sl = (LAS float*)F.lds;
    LAS float* red = (LAS float*)(F.lds + 17 * 4096);
    { f32x4 tv[9];
#pragma unroll
      for (int q = 0; q < 9; ++q) { const int i4 = F.tid + q * NTHR; if (i4 < 4352) { const int r = i4 >> 8, k4 = i4 & 255; tv[q] = r < 16 ? *(const GAS f32x4*)(inp(F, I_C) + r * 1024 + 4 * k4) : *(const GAS f32x4*)(inp(F, I_CCTX) + 4 * k4); } }
#pragma unroll
      for (int q = 0; q < 9; ++q) { const int i4 = F.tid + q * NTHR; if (i4 < 4352) { f32x4 o; o.x = siluf_(tv[q].x); o.y = siluf_(tv[q].y); o.z = siluf_(tv[q].z); o.w = siluf_(tv[q].w); *(LAS f32x4*)(sl + 4 * i4) = o; } } }
    __syncthreads();
    for (int item = F.wg; item < 2 * 384; item += F.G) {
        const int layer = item / 384, n0 = (item % 384) * 16, j = F.tid & 15, kp = F.tid >> 4;
        const GAS float* W = inp(F, I_WMOD) + (size_t)layer * D * 6144;
        float w[32];
#pragma unroll
        for (int i = 0; i < 32; ++i) w[i] = W[(size_t)(kp * 32 + i) * 6144 + n0 + j];
#pragma unroll
        for (int r = 0; r < 17; ++r) { float acc = 0.f;
#pragma unroll
            for (int q = 0; q < 8; ++q) { const f32x4 s4 = *(const LAS f32x4*)(sl + r * 1024 + kp * 32 + 4 * q); acc += (s4.x * w[4 * q] + s4.y * w[4 * q + 1]) + (s4.z * w[4 * q + 2] + s4.w * w[4 * q + 3]); }
            red[(kp * 17 + r) * 16 + j] = acc; }
        __syncthreads();
        if (F.tid < 272) { const int r = F.tid >> 4, jj = F.tid & 15; float s = inp(F, I_BMOD)[layer * 6144 + n0 + jj];
            for (int q = 0; q < 32; ++q) s += red[(q * 17 + r) * 16 + jj];
            WSP(float, WS_MOD)[(size_t)(layer * 17 + r) * 6144 + n0 + jj] = s; }
        __syncthreads();
    }
    __syncthreads();
    LAS float* scr = (LAS float*)(F.lds + F.wave * 8704);
    conv_weights_win(F, 0, gw, NGW, scr);
    conv_weights_upout(F, 0, gw, NGW, scr);
    for (int i = gw * 64 + F.lane; i < 2048 * 32; i += NGW * 64) {
        const int t = i >> 5, j = i & 31, half = j >> 4, ii = j & 15;
        const float inv = 1.0f / powf(10000.0f, (float)ii / 16.0f);
        const float ang = (float)(half == 0 ? (t >> 6) : (t & 63)) * inv;
        WSP(float, WS_ROPE)[t * 64 + half * 32 + ii] = cosf(ang);
        WSP(float, WS_ROPE)[t * 64 + half * 32 + 16 + ii] = sinf(ang);
    }
    for (int it = gw; it < 4352; it += NGW) filter_hidden_item(F, it);
}
__device__ __forceinline__ void write_bias(Frame& F) {
    const int gt = (F.wg * NWAVES + F.wave) * 64 + F.lane, NGT = F.G * NTHR;
    for (int i = gt; i < 2 * NWP; i += NGT) {
        const int l = i / NWP, r = i % NWP; float v = 0.f;
        int n = -1;
        if (r < 1152) n = r; else if (r < 1168) n = 3712 + (r - 1152); else if (r < 1280) n = -1; else if (r < 2816) n = 1152 + (r - 1280); else if (r < 3840) n = 2688 + (r - 2816); else n = 3728 + (r - 3840);
        if (n >= 0) v = inp(F, I_BIN)[l * NIN + n];
        WSP(float, WS_BIAS)[i] = v;
    }
}

template <bool XB> struct XRaw { typedef f32x4 T; };
template <> struct XRaw<true> { typedef u32x2 T; };
template <bool XB>
__device__ __forceinline__ void xrow_issue(const Frame& F, int row, int src, int lane, typename XRaw<XB>::T (&w)[4]) {
    if constexpr (!XB) { const GAS float* xr = row < TOKL ? inp(F, I_X) + (size_t)row * D : inp(F, I_CTX) + (size_t)(row - TOKL) * D;
#pragma unroll
        for (int j = 0; j < 4; ++j) w[j] = *(const GAS f32x4*)(xr + 256 * j + 4 * lane); }
    else { const GAS bf16* xr = src == 2 ? WSP(const bf16, WS_XL2) + (size_t)row * D : (row < TOKL ? (const GAS bf16*)outp(F) + (size_t)row * D : WSP(const bf16, WS_XC) + (size_t)(row - TOKL) * D);
#pragma unroll
        for (int j = 0; j < 4; ++j) w[j] = *(const GAS u32x2*)(xr + 256 * j + 4 * lane); }
}
__device__ __forceinline__ f32x4 xrow_unpack(f32x4 w) { return w; }
__device__ __forceinline__ f32x4 xrow_unpack(u32x2 w) { f32x4 v; v.x = __uint_as_float(w.x << 16); v.y = __uint_as_float(w.x & 0xffff0000u); v.z = __uint_as_float(w.y << 16); v.w = __uint_as_float(w.y & 0xffff0000u); return v; }
template <bool XB>
__device__ __forceinline__ void phase_norm(Frame& F, int layer, int nrows, int which) {
    const int gw = F.wg * NWAVES + F.wave, NGW = F.G * NWAVES, lane = F.lane;
    const GAS float* g = inp(F, which == 0 ? I_GMIX : I_GFFN) + layer * D;
    const int per = (nrows + NGW - 1) / NGW, r0 = gw * per, r1 = min(nrows, r0 + per);
    if (r0 >= r1) return;
    int grp = -1; f32x4 gm[4], sh[4]; typename XRaw<XB>::T ring[4][4];
#pragma unroll
    for (int i = 0; i < 4; ++i) if (r0 + i < r1) xrow_issue<XB>(F, r0 + i, 1, lane, ring[i]);
#pragma unroll 1
    for (int rb = r0; rb < r1; rb += 4) {
#pragma unroll
        for (int i = 0; i < 4; ++i) {
            const int row = rb + i;
            if (row < r1) {
                const int gr = row < TOKL ? (row >> 11) : 16;
                if (gr != grp) { grp = gr; const GAS float* shp = mod_ptr(F, layer, row, which); const GAS float* scp = mod_ptr(F, layer, row, which + 1);
#pragma unroll
                    for (int j = 0; j < 4; ++j) { const f32x4 gg = *(const GAS f32x4*)(g + 256 * j + 4 * lane), sc = *(const GAS f32x4*)(scp + 256 * j + 4 * lane); sh[j] = *(const GAS f32x4*)(shp + 256 * j + 4 * lane);
                        gm[j].x = gg.x * (1.f + sc.x); gm[j].y = gg.y * (1.f + sc.y); gm[j].z = gg.z * (1.f + sc.z); gm[j].w = gg.w * (1.f + sc.w); } }
                f32x4 v[4]; float s = 0.f;
#pragma unroll
                for (int j = 0; j < 4; ++j) { v[j] = xrow_unpack(ring[i][j]); s += (v[j].x * v[j].x + v[j].y * v[j].y) + (v[j].z * v[j].z + v[j].w * v[j].w); }
                if (row + 4 < r1) xrow_issue<XB>(F, row + 4, 1, lane, ring[i]);
                const float r = rsqrtf(wave_sum(s) * (1.0f / 1024.0f) + 1e-6f);
                GAS bf16* orow = WSP(bf16, WS_H) + (size_t)row * D;
#pragma unroll
                for (int j = 0; j < 4; ++j) {
                    f32x4 o; o.x = v[j].x * r * gm[j].x + sh[j].x; o.y = v[j].y * r * gm[j].y + sh[j].y; o.z = v[j].z * r * gm[j].z + sh[j].z; o.w = v[j].w * r * gm[j].w + sh[j].w;
                    u32x2 w; w.x = pk2(o.x, o.y); w.y = pk2(o.z, o.w);
                    *(GAS u32x2*)(orow + 256 * j + 4 * lane) = w;
                }
            }
        }
    }
}

namespace pg8 {
#ifndef WGM_
#define WGM_ 4
#endif
#ifndef PG8_SP2_
#define PG8_SP2_ 1
#endif
#ifndef PG8_ALIGN_
#define PG8_ALIGN_ 1
#endif
constexpr int BM = 256, BK = 64, HALF = 128, HTB = HALF * BK * 2, STAGE_BYTES = 8 * HTB, NXCD = 8, WGM = WGM_;
__device__ __forceinline__ int lds_byte(int r, int c) { const int st = (r >> 4) * 2 + (c >> 5), rr = r & 15, cc = c & 31, ob = rr * 64 + cc * 2; return st * 1024 + (ob ^ (((ob >> 9) & 1) << 5)); }
__device__ __forceinline__ void stage_rc(int b, int& R, int& C) { const int st = b / 1024, sb = b % 1024, swz = sb ^ (((sb >> 9) & 1) << 5); R = (st >> 1) * 16 + swz / 64; C = (st & 1) * 32 + (swz % 64) / 2; }
struct Unit { int pm, pn; };
template <int MR_>
struct OrderPlainT {
    static constexpr bool GATHER = false; static constexpr int MROWS = MR_;
    int nM, nN, nwg, G, c;
    __device__ __forceinline__ void init(int nM_, int nN_, int G_, int c_) { nM = nM_; nN = nN_; nwg = nM * nN; G = G_; c = c_; }
    __device__ __forceinline__ bool next(int i, Unit& u) const {
        const long L = (long)i * G + c; if (L >= nwg) return false;
        int wgid = (int)L; { const int q = nwg / NXCD, r = nwg % NXCD, xcd = wgid % NXCD, off = wgid / NXCD; wgid = (xcd < r ? xcd * (q + 1) : r * (q + 1) + (xcd - r) * q) + off; }
        const int nig = WGM * nN, gid = wgid / nig, fm = gid * WGM, gsz = (nM - fm) < WGM ? (nM - fm) : WGM;
        u.pm = fm + ((wgid % nig) % gsz); u.pn = (wgid % nig) / gsz; return true;
    }
    __device__ __forceinline__ int arow(int r) const { return r; }
    __device__ __forceinline__ size_t boff(const Unit&) const { return 0; }
};
using OrderPlain = OrderPlainT<256>;
struct OrderWinL1 {
    static constexpr bool GATHER = false; static constexpr int MROWS = 256;
    OrderPlain o; int G, c;
    __device__ __forceinline__ void init(int G_, int c_) { o.init(128, 15, G_, c_); G = G_; c = c_; }
    __device__ __forceinline__ bool next(int i, Unit& u) const {
        const long L = (long)i * G + c;
        if (L < 1920) return o.next(i, u);
        const int r = (int)(L - 1920); if (r >= 112) return false;
        const int q = r % 7; u.pm = 128 + r / 7; u.pn = q == 0 ? 4 : (q <= 4 ? 5 + q : 7 + q);
        return true;
    }
    __device__ __forceinline__ int arow(int r) const { return r; }
    __device__ __forceinline__ size_t boff(const Unit&) const { return 0; }
};
struct OrderMoe {
    static constexpr bool GATHER = true; static constexpr int MROWS = 256;
    OrderPlain o; const GAS int* rowidx; const GAS int* tilee; int t0; size_t bstride; bool gather;
    __device__ __forceinline__ bool next(int i, Unit& u) const { return o.next(i, u); }
    __device__ __forceinline__ int arow(int r) const { return gather ? rowidx[t0 * 256 + r] : r; }
    __device__ __forceinline__ size_t boff(const Unit& u) const { return (size_t)tilee[t0 + u.pm] * bstride; }
};

template <class Epi, class Sched>
__device__ __forceinline__ void gemm_phase(LAS unsigned char* lds, int tid_in, const GAS bf16* A, int lda, const GAS bf16* Bt, int ldb, int K, const Sched& S, const Epi& E) {
    unsigned tid_u = (unsigned)tid_in; asm volatile("" : "+v"(tid_u));
    const int tid = (int)tid_u, wid = __builtin_amdgcn_readfirstlane(tid >> 6), lane = tid & 63, wr = wid >> 2, wc = wid & 3, fr = lane & 15, fq = lane >> 4;
    const int nt = K / BK;
    constexpr int MR = Sched::MROWS, HR = MR / 2, WRR = HR / 2, NMF = WRR / 16;
    static_assert(MR == 256 || (MR == 192 && !Sched::GATHER), "unit rows");
    unsigned voffB[2];
    { int sR[2], sC[2];
#pragma unroll
      for (int i = 0; i < 2; ++i) { stage_rc(tid * 16 + i * 8192, sR[i], sC[i]);
        const int rho = sR[i] & 31, Rb = Epi::PERM ? ((sR[i] & ~31) + 8 * ((rho & 15) >> 2) + 4 * (rho >> 4) + (rho & 3)) : sR[i];
        voffB[i] = (unsigned)(Rb * ldb + sC[i]) * 2u; } }
#define PG8_GATHER_OFFS(pm_) do { unsigned _t = (unsigned)tid; asm volatile("" : "+v"(_t)); _Pragma("unroll") for (int i = 0; i < 2; ++i) { int _R, _C; stage_rc((int)_t * 16 + i * 8192, _R, _C); \
        vc0[i] = (unsigned)((size_t)S.arow((pm_) * BM + _R) * lda + _C) * 2u; vc1[i] = (unsigned)((size_t)S.arow((pm_) * BM + HALF + _R) * lda + _C) * 2u; } } while (0)
    const size_t kstep = (size_t)(BK * 2);
    const size_t hstepB = (size_t)HALF * ldb * 2, tstepB = 2 * hstepB;
    const unsigned ldsw = (unsigned)wid * 1024u;
    const int aoff = lds_byte(wr * WRR + fr, fq * 8), boff = lds_byte(wc * 32 + fr, fq * 8);
#define PG8_SA(b, h) (((b) * 2 + (h)) * HTB)
#define PG8_SB(b, h) ((4 + (b) * 2 + (h)) * HTB)
#define PG8_STAGE2(bufoff, gbase, uo, v0, v1) do { \
        __builtin_amdgcn_global_load_lds((const GAS unsigned*)((const GAS char*)(gbase) + (unsigned)((v0) + (unsigned)(uo))), (LAS unsigned*)(lds + (bufoff) + ldsw), 16, 0, 0); \
        __builtin_amdgcn_global_load_lds((const GAS unsigned*)((const GAS char*)(gbase) + (unsigned)((v1) + (unsigned)(uo))), (LAS unsigned*)(lds + (bufoff) + ldsw + 8192), 16, 0, 0); } while (0)
#define PG8_STAGEB(bufoff, gbase, uo) PG8_STAGE2(bufoff, gbase, uo, voffB[0], voffB[1])
#define PG8_LDA(dst, b, h) do { _Pragma("unroll") for (int m = 0; m < NMF; ++m) _Pragma("unroll") for (int k = 0; k < 2; ++k) dst[m][k] = *(const LAS bf16x8*)(lds + PG8_SA(b, h) + aoff + m * 2048 + k * 1024); } while (0)
#define PG8_LDB(dst, b, h) do { _Pragma("unroll") for (int n = 0; n < 2; ++n) _Pragma("unroll") for (int k = 0; k < 2; ++k) dst[n][k] = *(const LAS bf16x8*)(lds + PG8_SB(b, h) + boff + n * 2048 + k * 1024); } while (0)
#define PG8_MMA(ai, bj, At, Bt_) do { __builtin_amdgcn_s_setprio(1); _Pragma("unroll") for (int m = 0; m < NMF; ++m) _Pragma("unroll") for (int n = 0; n < 2; ++n) _Pragma("unroll") for (int k = 0; k < 2; ++k) \
        acc[ai][bj][m][n] = __builtin_amdgcn_mfma_f32_16x16x32_bf16(Bt_[n][k], At[m][k], acc[ai][bj][m][n], 0, 0, 0); __builtin_amdgcn_s_setprio(0); } while (0)
#define PG8_WAIT_V(n) asm volatile("s_waitcnt vmcnt(" #n ")" ::: "memory")
#define PG8_WAIT_L(n) asm volatile("s_waitcnt lgkmcnt(" #n ")" ::: "memory")
#define PG8_BAR __builtin_amdgcn_s_barrier()
#define PG8_SCHED __builtin_amdgcn_sched_barrier(0)
    Unit cur, nxt; int ui = 0;
    if (!S.next(0, cur)) return;
#ifndef STAGGER
#define STAGGER 0
#endif
    if (STAGGER) { const int grp = (int)(blockIdx.x >> 3) & 3;
        for (int i = 0; i < grp * STAGGER; ++i) __builtin_amdgcn_s_sleep(127); }
    f32x4 acc[2][2][4][2];
#pragma unroll
    for (int a = 0; a < 2; ++a)
#pragma unroll
        for (int b = 0; b < 2; ++b)
#pragma unroll
            for (int m = 0; m < NMF; ++m)
#pragma unroll
                for (int n = 0; n < 2; ++n) { float zf; asm volatile("v_mov_b32 %0, 0" : "=v"(zf)); acc[a][b][m][n] = (f32x4){zf, zf, zf, zf}; }
    bf16x8 At[4][2], B0[2][2], B1[2][2];
    constexpr bool GA = Sched::GATHER;
    const size_t hstepA = GA ? 0 : (size_t)HR * lda * 2, tstepA = (size_t)MR * lda * 2;
    unsigned vc0[2], vc1[2];
    if constexpr (GA) { PG8_GATHER_OFFS(cur.pm); }
    else { int sR, sC;
#pragma unroll
        for (int i = 0; i < 2; ++i) { stage_rc(tid * 16 + i * 8192, sR, sC); if (MR == 192 && sR >= HR) { sR = 0; sC = 0; }
            vc0[i] = (unsigned)(sR * lda + sC) * 2u; vc1[i] = 0u; } }
#define VC0(i) vc0[i]
#define VC1(i) (GA ? vc1[i] : vc0[i])
#define VN0(i) vc0[i]
#define VN1(i) VC1(i)
    const GAS char* cA = GA ? (const GAS char*)A : (const GAS char*)A + (size_t)cur.pm * tstepA;
    const GAS char* cB = (const GAS char*)Bt + S.boff(cur) * 2 + (size_t)cur.pn * tstepB;
    constexpr bool SP2 = PG8_SP2_ != 0, ALIGN_EPI = PG8_ALIGN_ != 0;
    const unsigned hsA = (unsigned)hstepA, hsB = (unsigned)hstepB;
    if constexpr (SP2) {
        PG8_STAGEB(PG8_SB(0, 0), cB, 0u); PG8_STAGEB(PG8_SB(0, 1), cB, hsB); PG8_STAGE2(PG8_SA(0, 0), cA, 0u, VC0(0), VC0(1)); PG8_STAGE2(PG8_SA(0, 1), cA, hsA, VC1(0), VC1(1));
        if (wr == 1) PG8_BAR;
        PG8_WAIT_V(2); PG8_BAR;
        PG8_STAGEB(PG8_SB(1, 0), cB, 128u); PG8_STAGE2(PG8_SA(1, 0), cA, 128u, VC0(0), VC0(1)); PG8_STAGEB(PG8_SB(1, 1), cB, hsB + 128u);
        PG8_WAIT_V(6); PG8_BAR;
    } else {
        PG8_STAGEB(PG8_SB(0, 0), cB, 0u); PG8_STAGE2(PG8_SA(0, 0), cA, 0u, VC0(0), VC0(1)); PG8_STAGEB(PG8_SB(0, 1), cB, hsB); PG8_STAGE2(PG8_SA(0, 1), cA, hsA, VC1(0), VC1(1));
        if (wr == 1) PG8_BAR;
        PG8_WAIT_V(4); PG8_BAR;
        PG8_STAGEB(PG8_SB(1, 0), cB, 128u); PG8_STAGE2(PG8_SA(1, 0), cA, 128u, VC0(0), VC0(1)); PG8_STAGEB(PG8_SB(1, 1), cB, hsB + 128u);
        PG8_WAIT_V(6); PG8_BAR;
    }
    for (;;) {
        const bool has_next = S.next(ui + 1, nxt);
        const GAS char* nB = cB; const GAS char* nA = cA;
        if (has_next) {
            nB = (const GAS char*)Bt + S.boff(nxt) * 2 + (size_t)nxt.pn * tstepB;
            if constexpr (!GA) nA = (const GAS char*)A + (size_t)nxt.pm * tstepA;
        }
        for (int t = 0; t < nt; t += 2) {
            const bool last = (t == nt - 2);
            if constexpr (Epi::HORNER) {
                if (t == 6 || t == 12) {
                    asm volatile("" ::: "memory");
                    const int seg = (t == 6) ? 0 : 1;
                    int hpm = cur.pm, hpn = cur.pn; asm volatile("" : "+s"(hpm), "+s"(hpn));
                    unsigned hln = (unsigned)lane; asm volatile("" : "+v"(hln)); const int hfr = (int)(hln & 15u), hfq = (int)(hln >> 4);
#pragma unroll
                    for (int ai = 0; ai < 2; ++ai) {
                        u32x4 ga[4][2], gb[4][2];
#pragma unroll
                        for (int m = 0; m < NMF; ++m)
#pragma unroll
                            for (int bj = 0; bj < 2; ++bj) {
                                const int row = hpm * MR + ai * HR + wr * WRR + m * 16 + hfr, col = hpn * BM + bj * HALF + wc * 32 + 8 * hfq;
                                ga[m][bj] = E.gate8(seg, row, col); gb[m][bj] = E.gate8(seg + 1, row, col);
                            }
                        if constexpr (NMF == 4) asm volatile("" : "+v"(ga[0][0]), "+v"(ga[0][1]), "+v"(ga[1][0]), "+v"(ga[1][1]), "+v"(ga[2][0]), "+v"(ga[2][1]), "+v"(ga[3][0]), "+v"(ga[3][1]),
                                          "+v"(gb[0][0]), "+v"(gb[0][1]), "+v"(gb[1][0]), "+v"(gb[1][1]), "+v"(gb[2][0]), "+v"(gb[2][1]), "+v"(gb[3][0]), "+v"(gb[3][1]) :: "memory");
                        else asm volatile("" : "+v"(ga[0][0]), "+v"(ga[0][1]), "+v"(ga[1][0]), "+v"(ga[1][1]), "+v"(ga[2][0]), "+v"(ga[2][1]),
                                          "+v"(gb[0][0]), "+v"(gb[0][1]), "+v"(gb[1][0]), "+v"(gb[1][1]), "+v"(gb[2][0]), "+v"(gb[2][1]) :: "memory");
#pragma unroll
                        for (int m = 0; m < NMF; ++m)
#pragma unroll
                            for (int bj = 0; bj < 2; ++bj) {
                                const unsigned aw[4] = {ga[m][bj].x, ga[m][bj].y, ga[m][bj].z, ga[m][bj].w}, bw[4] = {gb[m][bj].x, gb[m][bj].y, gb[m][bj].z, gb[m][bj].w};
#pragma unroll
                                for (int n = 0; n < 2; ++n) {
                                    f32x4& v = acc[ai][bj][m][n];
                                    v.x *= __uint_as_float(aw[2 * n] << 16) * __builtin_amdgcn_rcpf(__uint_as_float(bw[2 * n] << 16));
                                    v.y *= __uint_as_float(aw[2 * n] & 0xffff0000u) * __builtin_amdgcn_rcpf(__uint_as_float(bw[2 * n] & 0xffff0000u));
                                    v.z *= __uint_as_float(aw[2 * n + 1] << 16) * __builtin_amdgcn_rcpf(__uint_as_float(bw[2 * n + 1] << 16));
                                    v.w *= __uint_as_float(aw[2 * n + 1] & 0xffff0000u) * __builtin_amdgcn_rcpf(__uint_as_float(bw[2 * n + 1] & 0xffff0000u));
                                }
                            }
                    }
                    asm volatile("s_waitcnt vmcnt(0)" ::: "memory");
                }
            }
            const unsigned k1 = (unsigned)(t + 1) * 128u, k2 = last ? 0u : (unsigned)(t + 2) * 128u, k3 = k2 + 128u;
            const GAS char* pA2 = last ? nA : cA; const GAS char* pB2 = last ? nB : cB;
            if constexpr (SP2) {
            PG8_LDB(B0, 0, 0); PG8_LDB(B1, 0, 1); PG8_SCHED; PG8_LDA(At, 0, 0); PG8_STAGE2(PG8_SA(1, 1), cA, k1 + hsA, VC1(0), VC1(1));
            if constexpr (GA) { if (last && has_next) { asm volatile("" ::: "memory"); PG8_GATHER_OFFS(nxt.pm); asm volatile("" ::: "memory"); } }
            PG8_WAIT_V(8); PG8_WAIT_L(0); PG8_BAR; PG8_MMA(0, 0, At, B0); PG8_MMA(0, 1, At, B1); PG8_BAR; PG8_SCHED;
            PG8_LDA(At, 0, 1); PG8_STAGEB(PG8_SB(0, 0), pB2, k2); PG8_STAGEB(PG8_SB(0, 1), pB2, k2 + hsB); PG8_STAGE2(PG8_SA(0, 0), pA2, k2, VN0(0), VN0(1));
            PG8_WAIT_V(8); PG8_WAIT_L(0); PG8_BAR; PG8_MMA(1, 0, At, B0); PG8_MMA(1, 1, At, B1); PG8_BAR; PG8_SCHED;
            PG8_LDB(B0, 1, 0); PG8_LDB(B1, 1, 1); PG8_SCHED; PG8_LDA(At, 1, 0); PG8_STAGE2(PG8_SA(0, 1), pA2, k2 + hsA, VN1(0), VN1(1));
            PG8_WAIT_V(8); PG8_WAIT_L(0); PG8_BAR; PG8_MMA(0, 0, At, B0); PG8_MMA(0, 1, At, B1); PG8_BAR; PG8_SCHED;
            PG8_LDA(At, 1, 1); PG8_STAGEB(PG8_SB(1, 0), pB2, k3); PG8_STAGEB(PG8_SB(1, 1), pB2, k3 + hsB); PG8_STAGE2(PG8_SA(1, 0), pA2, k3, VN0(0), VN0(1));
            PG8_WAIT_V(8); PG8_WAIT_L(0); PG8_BAR; PG8_MMA(1, 0, At, B0); PG8_MMA(1, 1, At, B1); PG8_BAR; PG8_SCHED;
            } else {
            PG8_LDB(B0, 0, 0); PG8_SCHED; PG8_LDA(At, 0, 0); PG8_STAGE2(PG8_SA(1, 1), cA, k1 + hsA, VC1(0), VC1(1));
            if constexpr (GA) { if (last && has_next) { asm volatile("" ::: "memory"); PG8_GATHER_OFFS(nxt.pm); asm volatile("" ::: "memory"); } }
            PG8_WAIT_L(8); PG8_BAR; PG8_WAIT_L(0); PG8_MMA(0, 0, At, B0); PG8_BAR; PG8_SCHED;
            PG8_LDB(B1, 0, 1); PG8_STAGEB(PG8_SB(0, 0), pB2, k2);
            PG8_BAR; PG8_WAIT_L(0); PG8_MMA(0, 1, At, B1); PG8_BAR;
            PG8_LDA(At, 0, 1); PG8_STAGE2(PG8_SA(0, 0), pA2, k2, VN0(0), VN0(1));
            PG8_BAR; PG8_WAIT_L(0); PG8_MMA(1, 0, At, B0); PG8_BAR; PG8_SCHED;
            PG8_STAGEB(PG8_SB(0, 1), pB2, k2 + hsB);
            PG8_WAIT_V(6); PG8_BAR; PG8_MMA(1, 1, At, B1); PG8_BAR;
            PG8_LDB(B0, 1, 0); PG8_SCHED; PG8_LDA(At, 1, 0); PG8_STAGE2(PG8_SA(0, 1), pA2, k2 + hsA, VN1(0), VN1(1));
            PG8_WAIT_L(8); PG8_BAR; PG8_WAIT_L(0); PG8_MMA(0, 0, At, B0); PG8_BAR; PG8_SCHED;
            PG8_LDB(B1, 1, 1); PG8_STAGEB(PG8_SB(1, 0), pB2, k3);
            PG8_BAR; PG8_WAIT_L(0); PG8_MMA(0, 1, At, B1); PG8_BAR;
            PG8_LDA(At, 1, 1); PG8_STAGE2(PG8_SA(1, 0), pA2, k3, VN0(0), VN0(1));
            PG8_BAR; PG8_WAIT_L(0); PG8_MMA(1, 0, At, B0); PG8_BAR; PG8_SCHED;
            PG8_STAGEB(PG8_SB(1, 1), pB2, k3 + hsB);
            PG8_WAIT_V(6); PG8_BAR; PG8_MMA(1, 1, At, B1); PG8_BAR;
                    }
        }
        if constexpr (ALIGN_EPI) { if (wr == 0) PG8_BAR; }
#ifndef REP_EPI
#define REP_EPI 1
#endif
#pragma unroll 1
        for (int rpe = 0; rpe < ((Epi::COLVEC && Epi::BASE) ? 1 : REP_EPI); ++rpe) {
            int epm = cur.pm, epn = cur.pn; asm volatile("" : "+s"(epm), "+s"(epn));
            unsigned eln = (unsigned)lane; asm volatile("" : "+v"(eln)); const int efr = (int)(eln & 15u), efq = (int)(eln >> 4);
            constexpr bool PM = Epi::PERM;
#define PG8_COL(bj, n) (epn * BM + (bj) * HALF + wc * 32 + (PM ? 8 * efq + 4 * (n) : (n) * 16 + 4 * efq))
            f32x4 cv[2][2];
#pragma unroll
            for (int bj = 0; bj < 2; ++bj)
#pragma unroll
                for (int n = 0; n < 2; ++n) { if constexpr (Epi::COLVEC) cv[bj][n] = E.colvec(epm * MR, PG8_COL(bj, n)); else cv[bj][n] = (f32x4){0.f, 0.f, 0.f, 0.f}; }
            if constexpr (Epi::COLVEC) asm volatile("" : "+v"(cv[0][0]), "+v"(cv[0][1]), "+v"(cv[1][0]), "+v"(cv[1][1]) :: "memory");
            constexpr bool CV2 = Epi::COLVEC && Epi::ROWCV && MR != 256;
            f32x4 cv2[2][2];
            if constexpr (CV2) {
#pragma unroll
                for (int bj = 0; bj < 2; ++bj)
#pragma unroll
                    for (int n = 0; n < 2; ++n) cv2[bj][n] = E.colvec(epm * MR + MR - 1, PG8_COL(bj, n));
                asm volatile("" : "+v"(cv2[0][0]), "+v"(cv2[0][1]), "+v"(cv2[1][0]), "+v"(cv2[1][1]) :: "memory");
            }
#pragma unroll
            for (int ai = 0; ai < 2; ++ai) {
                f32x4 bs[4][2][2];
                if constexpr (Epi::BASE) {
#pragma unroll
                    for (int m = 0; m < NMF; ++m)
#pragma unroll
                        for (int bj = 0; bj < 2; ++bj) {
                            const int row = epm * MR + ai * HR + wr * WRR + m * 16 + efr;
                            if constexpr (PM) E.base8(row, PG8_COL(bj, 0), bs[m][bj][0], bs[m][bj][1]);
                            else {
#pragma unroll
                                for (int n = 0; n < 2; ++n) bs[m][bj][n] = E.base(row, PG8_COL(bj, n));
                            }
                        }
                    if constexpr (NMF == 4) asm volatile("" : "+v"(bs[0][0][0]), "+v"(bs[0][0][1]), "+v"(bs[0][1][0]), "+v"(bs[0][1][1]), "+v"(bs[1][0][0]), "+v"(bs[1][0][1]), "+v"(bs[1][1][0]), "+v"(bs[1][1][1]),
                                      "+v"(bs[2][0][0]), "+v"(bs[2][0][1]), "+v"(bs[2][1][0]), "+v"(bs[2][1][1]), "+v"(bs[3][0][0]), "+v"(bs[3][0][1]), "+v"(bs[3][1][0]), "+v"(bs[3][1][1]) :: "memory");
                    else asm volatile("" : "+v"(bs[0][0][0]), "+v"(bs[0][0][1]), "+v"(bs[0][1][0]), "+v"(bs[0][1][1]), "+v"(bs[1][0][0]), "+v"(bs[1][0][1]), "+v"(bs[1][1][0]), "+v"(bs[1][1][1]),
                                      "+v"(bs[2][0][0]), "+v"(bs[2][0][1]), "+v"(bs[2][1][0]), "+v"(bs[2][1][1]) :: "memory");
                }
#pragma unroll
                for (int m = 0; m < NMF; ++m) {
                    const int row = epm * MR + ai * HR + wr * WRR + m * 16 + efr;
                    bool alt = false; if constexpr (CV2) alt = E.rowgrp(epm * MR + ai * HR + wr * WRR + m * 16) != E.rowgrp(epm * MR);
#pragma unroll
                    for (int bj = 0; bj < 2; ++bj) {
                        if constexpr (Epi::PAIR) E.store_pair(row, epn * (BM / 2) + bj * (HALF / 2) + wc * 16 + 4 * efq, acc[ai][bj][m][0], acc[ai][bj][m][1]);
                        else if constexpr (PM) {
                            f32x4 b0 = (f32x4){0.f, 0.f, 0.f, 0.f}, b1 = b0; if constexpr (Epi::BASE) { b0 = bs[m][bj][0]; b1 = bs[m][bj][1]; }
                            E.store8(row, PG8_COL(bj, 0), acc[ai][bj][m][0], acc[ai][bj][m][1], (CV2 && alt) ? cv2[bj][0] : cv[bj][0], (CV2 && alt) ? cv2[bj][1] : cv[bj][1], b0, b1);
                        } else {
#pragma unroll
                            for (int n = 0; n < 2; ++n) { f32x4 bb = (f32x4){0.f, 0.f, 0.f, 0.f}; if constexpr (Epi::BASE) bb = bs[m][bj][n]; E.store(row, PG8_COL(bj, n), acc[ai][bj][m][n], (CV2 && alt) ? cv2[bj][n] : cv[bj][n], bb); }
                        }
                    }
                }
            }
#undef PG8_COL
        }
        if (!has_next) break;
#pragma unroll
        for (int a = 0; a < 2; ++a)
#pragma unroll
            for (int b = 0; b < 2; ++b)
#pragma unroll
                for (int m = 0; m < NMF; ++m)
#pragma unroll
                    for (int n = 0; n < 2; ++n) { float zf; asm volatile("v_mov_b32 %0, 0" : "=v"(zf)); acc[a][b][m][n] = (f32x4){zf, zf, zf, zf}; }
        cur = nxt; cB = nB; cA = nA; ++ui;
        if constexpr (ALIGN_EPI) { if (wr == 1) PG8_BAR; }
    }
    PG8_WAIT_V(0);
    if constexpr (!ALIGN_EPI) { if (wr == 0) PG8_BAR; }
    PG8_BAR;
#undef PG8_GATHER_OFFS
#undef VC0
#undef VC1
#undef VN0
#undef VN1
#undef PG8_SA
#undef PG8_SB
#undef PG8_STAGE2
#undef PG8_STAGEB
#undef PG8_LDA
#undef PG8_LDB
#undef PG8_MMA
#undef PG8_WAIT_V
#undef PG8_WAIT_L
#undef PG8_BAR
#undef PG8_SCHED
}
}

template <int MR = 256, class Epi>
__device__ __forceinline__ void gemm_fast(Frame& F, const GAS bf16* A, int lda, const GAS bf16* Bt, int ldb, int K, int M, int N, const Epi& E) {
    pg8::OrderPlainT<MR> S; S.init(M / MR, N / 256, F.G, F.wg);
    pg8::gemm_phase(F.lds, F.tid, A, lda, Bt, ldb, K, S, E);
}

__device__ __forceinline__ void st_bf16x4(GAS bf16* p, f32x4 v) { u32x2 w; w.x = pk2(v.x, v.y); w.y = pk2(v.z, v.w); *(GAS u32x2*)p = w; }
__device__ __forceinline__ f32x4 ld_bf16x4(const GAS bf16* p) { const u32x2 w = *(const GAS u32x2*)p; f32x4 v; v.x = __uint_as_float(w.x << 16); v.y = __uint_as_float(w.x & 0xffff0000u); v.z = __uint_as_float(w.y << 16); v.w = __uint_as_float(w.y & 0xffff0000u); return v; }

__device__ __forceinline__ void st_bf16x8(GAS bf16* p, f32x4 a, f32x4 b) { u32x4 w; w.x = pk2(a.x, a.y); w.y = pk2(a.z, a.w); w.z = pk2(b.x, b.y); w.w = pk2(b.z, b.w); *(GAS u32x4*)p = w; }
struct EpiWin {
    static constexpr bool HORNER = false, PAIR = false, COLVEC = true, BASE = false, PERM = true, ROWCV = false;
    const GAS float* bias; GAS bf16 *hytl, *hytc, *ret, *ml; GAS float* mlg;
    __device__ __forceinline__ f32x4 colvec(int, int col) const { return *(const GAS f32x4*)(bias + col); }
    __device__ __forceinline__ void store8(int row, int col, f32x4 v0, f32x4 v1, f32x4 c0, f32x4 c1, f32x4, f32x4) const {
        v0 += c0; v1 += c1;
        if (col < 1152) {
            const float v[8] = {v0.x, v0.y, v0.z, v0.w, v1.x, v1.y, v1.z, v1.w};
            if (row < TOKL) { const int b = row >> 11, t = row & 2047; GAS bf16* d = hytl + ((size_t)(b * 1152 + col)) * 2048 + t;
#pragma unroll
                for (int j = 0; j < 8; ++j) d[2048 * j] = (bf16)f2bf(v[j]); }
            else { const int r = row - TOKL, b = r >> 8, t = r & 255; GAS bf16* d = hytc + ((size_t)(b * 1152 + col)) * 256 + t;
#pragma unroll
                for (int j = 0; j < 8; ++j) d[256 * j] = (bf16)f2bf(v[j]); }
        } else if (col < 1168) { *(GAS f32x4*)(mlg + (size_t)row * 16 + (col - 1152)) = v0; *(GAS f32x4*)(mlg + (size_t)row * 16 + (col - 1152) + 4) = v1; }
        else if (col < 1280) { }
        else if (col < 2816) st_bf16x8(ret + (size_t)row * 1536 + (col - 1280), v0, v1);
        else st_bf16x8(ml + (size_t)row * 1024 + (col - 2816), v0, v1);
    }
};
struct EpiGate {
    static constexpr bool HORNER = false, PAIR = false, COLVEC = true, BASE = false, PERM = true, ROWCV = false;
    const GAS float* bias; GAS bf16* gates;
    __device__ __forceinline__ f32x4 colvec(int, int col) const { return *(const GAS f32x4*)(bias + col); }
    __device__ __forceinline__ void store8(int row, int col, f32x4 v0, f32x4 v1, f32x4 c0, f32x4 c1, f32x4, f32x4) const {
        v0 += c0; v1 += c1;
        f32x4 g0, g1;
        g0.x = fmaxf(sigmoidf_(v0.x), 1e-20f); g0.y = fmaxf(sigmoidf_(v0.y), 1e-20f); g0.z = fmaxf(sigmoidf_(v0.z), 1e-20f); g0.w = fmaxf(sigmoidf_(v0.w), 1e-20f);
        g1.x = fmaxf(sigmoidf_(v1.x), 1e-20f); g1.y = fmaxf(sigmoidf_(v1.y), 1e-20f); g1.z = fmaxf(sigmoidf_(v1.z), 1e-20f); g1.w = fmaxf(sigmoidf_(v1.w), 1e-20f);
        st_bf16x8(gates + (size_t)row * NGATE + col, g0, g1);
    }
};
struct EpiUp {
    static constexpr bool HORNER = true, PAIR = false, COLVEC = false, BASE = true, PERM = true, ROWCV = false;
    const GAS bf16* gates; GAS bf16* acc_out;
    __device__ __forceinline__ u32x4 gate8(int which, int row, int col) const { return *(const GAS u32x4*)(gates + (size_t)row * NGATE + which * 1024 + col); }
    __device__ __forceinline__ void base8(int row, int col, f32x4& b0, f32x4& b1) const {
        const u32x4 w = *(const GAS u32x4*)(gates + (size_t)row * NGATE + 2048 + col);
        b0.x = __uint_as_float(w.x << 16); b0.y = __uint_as_float(w.x & 0xffff0000u); b0.z = __uint_as_float(w.y << 16); b0.w = __uint_as_float(w.y & 0xffff0000u);
        b1.x = __uint_as_float(w.z << 16); b1.y = __uint_as_float(w.z & 0xffff0000u); b1.z = __uint_as_float(w.w << 16); b1.w = __uint_as_float(w.w & 0xffff0000u);
    }
    __device__ __forceinline__ void store8(int row, int col, f32x4 v0, f32x4 v1, f32x4, f32x4, f32x4 g0, f32x4 g1) const { st_bf16x8(acc_out + (size_t)row * D + col, v0 * g0, v1 * g1); }
};
template <bool IN_BF16>
struct EpiResidT {
    static constexpr bool HORNER = false, PAIR = false, COLVEC = true, BASE = true, PERM = true, ROWCV = true;
    const GAS void *xin_l, *xin_c; GAS bf16 *xout_l, *xout_c; const GAS float* modbase; int which;
    __device__ __forceinline__ int rowgrp(int row) const { return row < TOKL ? (row >> 11) : 16; }
    __device__ __forceinline__ f32x4 colvec(int row0, int col) const { const int r = row0 < TOKL ? (row0 >> 11) : 16; return *(const GAS f32x4*)(modbase + ((size_t)r * 6 + which) * 1024 + col); }
    __device__ __forceinline__ void base8(int row, int col, f32x4& b0, f32x4& b1) const {
        const size_t o = row < TOKL ? (size_t)row * D + col : (size_t)(row - TOKL) * D + col;
        if constexpr (IN_BF16) {
            const u32x4 w = *(const GAS u32x4*)((const GAS bf16*)(row < TOKL ? xin_l : xin_c) + o);
            b0.x = __uint_as_float(w.x << 16); b0.y = __uint_as_float(w.x & 0xffff0000u); b0.z = __uint_as_float(w.y << 16); b0.w = __uint_as_float(w.y & 0xffff0000u);
            b1.x = __uint_as_float(w.z << 16); b1.y = __uint_as_float(w.z & 0xffff0000u); b1.z = __uint_as_float(w.w << 16); b1.w = __uint_as_float(w.w & 0xffff0000u);
        } else { const GAS float* p = (const GAS float*)(row < TOKL ? xin_l : xin_c) + o; b0 = *(const GAS f32x4*)p; b1 = *(const GAS f32x4*)(p + 4); }
    }
    __device__ __forceinline__ void store8(int row, int col, f32x4 v0, f32x4 v1, f32x4 c0, f32x4 c1, f32x4 b0, f32x4 b1) const {
        st_bf16x8(row < TOKL ? xout_l + (size_t)row * D + col : xout_c + (size_t)(row - TOKL) * D + col, b0 + c0 * v0, b1 + c1 * v1);
    }
};
struct EpiSwiglu {
    static constexpr bool HORNER = false, PAIR = true, COLVEC = false, BASE = false, PERM = false, ROWCV = false;
    GAS bf16* act; int row_off;
    __device__ __forceinline__ void store_pair(int row, int col, f32x4 a, f32x4 b) const {
        f32x4 o; o.x = siluf_(a.x) * b.x; o.y = siluf_(a.y) * b.y; o.z = siluf_(a.z) * b.z; o.w = siluf_(a.w) * b.w;
        st_bf16x4(act + (size_t)(row - row_off) * DFF + col, o);
    }
    __device__ __forceinline__ void store(int, int, f32x4, f32x4, f32x4) const {}
};
struct EpiBf16Out {
    static constexpr bool HORNER = false, PAIR = false, COLVEC = false, BASE = false, PERM = true, ROWCV = false;
    GAS bf16* out; int ld; int row_add;
    __device__ __forceinline__ void store8(int row, int col, f32x4 v0, f32x4 v1, f32x4, f32x4, f32x4, f32x4) const { st_bf16x8(out + (size_t)(row + row_add) * ld + col, v0, v1); }
};

template <int L>
__device__ __forceinline__ void hyena_unit_fast(Frame& F, int layer, int c, const GAS bf16* hyt  , const GAS bf16* ft  , GAS bf16* yht  ) {
    constexpr int ZP = (L + 8) * 2;
    constexpr int PER = L / 32;
    constexpr int I = L / 128;
    constexpr int SPAN = L / 4, NSTEP = L / 32;
    constexpr int CP = (2 * L + 8) * 2;
    LAS unsigned char* zimg = F.lds;
    LAS unsigned char* cpy = F.lds + 16 * ZP;
    const GAS float* cw = inp(F, I_HYCONV) + layer * 3 * 1152;
    const GAS float* skip = inp(F, I_HYSKIP) + layer * 2 * 384;
    const int lane = F.lane, fr = lane & 15, fq = lane >> 4, w = F.wave;
    { unsigned long long a_ = (unsigned long long)hyt, b_ = (unsigned long long)yht; asm volatile("" : "+s"(a_), "+s"(b_)); hyt = (const GAS bf16*)a_; yht = (GAS bf16*)b_; }
    __syncthreads();
    {
        const int b = F.tid >> 5, sg = F.tid & 31, t0 = sg * PER; const GAS bf16* src = hyt + ((size_t)(b * 1152 + c)) * L + t0;
        const float w0 = cw[c], w1 = cw[1152 + c], w2 = cw[2304 + c];
        u32x4 raw[PER / 8];
#pragma unroll
        for (int j = 0; j < PER / 8; ++j) raw[j] = *(const GAS u32x4*)(src + 8 * j);
        float prev = t0 > 0 ? bf2f(src[-1]) : 0.f;
        const float nextv = t0 + PER < L ? bf2f(src[PER]) : 0.f;
#pragma unroll
        for (int j = 0; j < PER / 8; ++j) {
            const unsigned wv[4] = {raw[j].x, raw[j].y, raw[j].z, raw[j].w};
            float x[10]; x[0] = prev;
#pragma unroll
            for (int q = 0; q < 4; ++q) { x[1 + 2 * q] = __uint_as_float(wv[q] << 16); x[2 + 2 * q] = __uint_as_float(wv[q] & 0xffff0000u); }
            if (j + 1 < PER / 8) x[9] = __uint_as_float(raw[(j + 1 < PER / 8) ? j + 1 : j].x << 16); else x[9] = nextv;
            u32x4 o;
            o.x = pk2(w0 * x[0] + w1 * x[1] + w2 * x[2], w0 * x[1] + w1 * x[2] + w2 * x[3]); o.y = pk2(w0 * x[2] + w1 * x[3] + w2 * x[4], w0 * x[3] + w1 * x[4] + w2 * x[5]);
            o.z = pk2(w0 * x[4] + w1 * x[5] + w2 * x[6], w0 * x[5] + w1 * x[6] + w2 * x[7]); o.w = pk2(w0 * x[6] + w1 * x[7] + w2 * x[8], w0 * x[7] + w1 * x[8] + w2 * x[9]);
            *(LAS u32x4*)(zimg + b * ZP + (t0 + 8 * j) * 2) = o;
            prev = x[8];
        }
    }
    const int tbase = SPAN * (w >> 1) + 16 * (w & 1);
    const int flane = L - tbase + 8 * fq - fr;
    const int msh = fr & 7;
    const LAS unsigned char* fbase = cpy + msh * CP + 2 * (flane + msh);
#pragma unroll 1
    for (int o = 0; o < 2; ++o) {
        const GAS bf16* fsrc = ft + ((size_t)(o * 384 + c)) * (2 * L);
        for (int i = F.tid; i < CP / 16; i += NTHR) { u32x4 v = (u32x4){0u, 0u, 0u, 0u}; if (i < 2 * L / 8) v = *(const GAS u32x4*)(fsrc + 8 * i); if (i == 0) v.x &= 0xffff0000u; *(LAS u32x4*)(cpy + 16 * i) = v; }
        __syncthreads();
        for (int task = F.tid; task < 7 * (CP / 16); task += NTHR) {
            const int m = 1 + task / (CP / 16), x8 = task % (CP / 16);
            unsigned short e[8];
#pragma unroll
            for (int i = 0; i < 8; ++i) { const int idx = 8 * x8 - m + i; e[i] = idx >= 0 ? *(const LAS unsigned short*)(cpy + 2 * idx) : (unsigned short)0; }
            u32x4 v; v.x = e[0] | ((unsigned)e[1] << 16); v.y = e[2] | ((unsigned)e[3] << 16); v.z = e[4] | ((unsigned)e[5] << 16); v.w = e[6] | ((unsigned)e[7] << 16);
            *(LAS u32x4*)(cpy + m * CP + 16 * x8) = v;
        }
        __syncthreads();
        f32x4 acc[I];
#pragma unroll
        for (int i = 0; i < I; ++i) acc[i] = (f32x4){0.f, 0.f, 0.f, 0.f};
        bf16x8 ring[I];
#pragma unroll
        for (int i = 1; i < I; ++i) ring[(I - i) % I] = *(const LAS bf16x8*)(fbase - 64 * i);
        bf16x8 nf = *(const LAS bf16x8*)(fbase);
        const LAS unsigned char* zrow = zimg + fr * ZP + 16 * fq;
#pragma unroll 1
        for (int j0 = 0; j0 < NSTEP; j0 += I) {
#pragma unroll
            for (int jj = 0; jj < I; ++jj) {
                const int j = j0 + jj;
                ring[jj] = nf;
                if (j + 1 < NSTEP) nf = *(const LAS bf16x8*)(fbase + 64 * (j + 1));
                const bf16x8 zf = *(const LAS bf16x8*)(zrow + 64 * j);
#pragma unroll
                for (int i = 0; i < I; ++i) acc[i] = __builtin_amdgcn_mfma_f32_16x16x32_bf16(ring[(jj - i + I) % I], zf, acc[i], 0, 0, 0);
            }
        }
        unsigned el_ = (unsigned)lane; asm volatile("" : "+v"(el_)); const int efr = (int)(el_ & 15u), efq = (int)(el_ >> 4);
        const int etb = SPAN * (w >> 1) + 16 * (w & 1);
        const int gcol = (o == 0 ? 384 : 768) + c;
        const GAS bf16* gsrc = hyt + ((size_t)(efr * 1152 + gcol)) * L;
        const float w0 = cw[gcol], w1 = cw[1152 + gcol], w2 = cw[2304 + gcol], sk = skip[o * 384 + c];
        GAS bf16* dst = yht + ((size_t)(efr * 384 + c)) * L;
        constexpr int GI = I < 8 ? I : 8;
#pragma unroll
        for (int i0 = 0; i0 < I; i0 += GI) {
            u32x2 grv[GI]; unsigned short gmv[GI], gpv[GI];
#pragma unroll
            for (int ii = 0; ii < GI; ++ii) {
                const int t = etb + 32 * (i0 + ii) + 4 * efq;
                grv[ii] = *(const GAS u32x2*)(gsrc + t); gmv[ii] = t > 0 ? gsrc[t - 1] : (unsigned short)0; gpv[ii] = t + 4 < L ? gsrc[t + 4] : (unsigned short)0;
            }
            asm volatile("" ::: "memory");
#pragma unroll
            for (int ii = 0; ii < GI; ++ii) {
                const int i = i0 + ii;
                const int t = etb + 32 * i + 4 * efq;
                const u32x2 zr = *(const LAS u32x2*)(zimg + efr * ZP + t * 2);
                const u32x2 gr = grv[ii];
                const float gm = bf2f(gmv[ii]), gp = bf2f(gpv[ii]);
                const float g0 = __uint_as_float(gr.x << 16), g1 = __uint_as_float(gr.x & 0xffff0000u), g2 = __uint_as_float(gr.y << 16), g3 = __uint_as_float(gr.y & 0xffff0000u);
                const float z0 = __uint_as_float(zr.x << 16), z1 = __uint_as_float(zr.x & 0xffff0000u), z2 = __uint_as_float(zr.y << 16), z3 = __uint_as_float(zr.y & 0xffff0000u);
                const float o0 = (w0 * gm + w1 * g0 + w2 * g1) * (acc[i].x + sk * z0), o1 = (w0 * g0 + w1 * g1 + w2 * g2) * (acc[i].y + sk * z1);
                const float o2 = (w0 * g1 + w1 * g2 + w2 * g3) * (acc[i].z + sk * z2), o3 = (w0 * g2 + w1 * g3 + w2 * gp) * (acc[i].w + sk * z3);
                acc[i] = (f32x4){o0, o1, o2, o3};
            }
        }
        __syncthreads();
#pragma unroll
        for (int i = 0; i < I; ++i) {
            const int t = etb + 32 * i + 4 * efq;
            u32x2 ov; ov.x = pk2(acc[i].x, acc[i].y); ov.y = pk2(acc[i].z, acc[i].w);
            if (o == 0) *(LAS u32x2*)(zimg + efr * ZP + t * 2) = ov;
            else *(GAS u32x2*)(dst + t) = ov;
        }
    }
}

#ifndef REP_CH
#define REP_CH 1
#endif
#ifndef REP_CH_ML
#define REP_CH_ML REP_CH
#endif
#ifndef REP_CH_RET
#define REP_CH_RET REP_CH
#endif
constexpr int CH_PITCH = 144;
constexpr int CH_IMG = 64 * CH_PITCH;
constexpr int CH_WAVE_LDS = 3 * CH_IMG + 1024 + 512;
__device__ __forceinline__ void ds_tr16x8(unsigned addr, u32x2 (&lo)[4], u32x2 (&hi)[4]) {
    asm volatile("ds_read_b64_tr_b16 %0, %8\n\tds_read_b64_tr_b16 %1, %8 offset:32\n\tds_read_b64_tr_b16 %2, %8 offset:64\n\tds_read_b64_tr_b16 %3, %8 offset:96\n\t"
                 "ds_read_b64_tr_b16 %4, %8 offset:2304\n\tds_read_b64_tr_b16 %5, %8 offset:2336\n\tds_read_b64_tr_b16 %6, %8 offset:2368\n\tds_read_b64_tr_b16 %7, %8 offset:2400\n\t"
                 "s_waitcnt lgkmcnt(0)"
                 : "=&v"(lo[0]), "=&v"(lo[1]), "=&v"(lo[2]), "=&v"(lo[3]), "=&v"(hi[0]), "=&v"(hi[1]), "=&v"(hi[2]), "=&v"(hi[3]) : "v"(addr) : "memory");
}
static_assert(16 * CH_PITCH == 2304, "ds_tr16x8 offsets");
__device__ __forceinline__ void ds_tr16x4(unsigned addr, u32x2 (&lo)[2], u32x2 (&hi)[2]) {
    asm volatile("ds_read_b64_tr_b16 %0, %4\n\tds_read_b64_tr_b16 %1, %4 offset:32\n\tds_read_b64_tr_b16 %2, %4 offset:2304\n\tds_read_b64_tr_b16 %3, %4 offset:2336\n\ts_waitcnt lgkmcnt(0)"
                 : "=&v"(lo[0]), "=&v"(lo[1]), "=&v"(hi[0]), "=&v"(hi[1]) : "v"(addr) : "memory");
}
__device__ __forceinline__ float log_sigmoid_(float x) { return fminf(x, 0.f) - log1pf(__expf(-fabsf(x))); }
__device__ __forceinline__ bf16x8 mk_frag(u32x2 lo, u32x2 hi) { u32x4 w; w.x = lo.x; w.y = lo.y; w.z = hi.x; w.w = hi.y; return __builtin_bit_cast(bf16x8, w); }

template <bool IS_ML>
__device__ __forceinline__ void chain_fast(Frame& F, int layer, int b, int h, int dir, LAS unsigned char* img, int hf) {
    constexpr int NET = 2;
    const int lane = F.lane, fr = lane & 15, fq = lane >> 4;
    LAS unsigned char* Qi = img; LAS unsigned char* Ki = img + CH_IMG; LAS unsigned char* Vi = img + 2 * CH_IMG;
    const unsigned qa = (unsigned)(size_t)Qi, ka = (unsigned)(size_t)Ki, va = (unsigned)(size_t)Vi;
    const GAS bf16* RET = WSP(const bf16, WS_RET); const GAS bf16* ML = WSP(const bf16, WS_ML); const GAS float* MLG = WSP(const float, WS_MLG);
    const GAS float* rope = WSP(const float, WS_ROPE);
    GAS bf16* Y = WSP(bf16, WS_Y); GAS bf16* OB = WSP(bf16, WS_OB);
    float lgam = 0.f, bi_ = 0.f, bf_ = 0.f;
    if (!IS_ML) lgam = log_sigmoid_(inp(F, I_RETDECAY)[layer * 12 + dir * 6 + h]);
    else { bi_ = inp(F, I_MLGB)[layer * 16 + dir * 8 + h]; bf_ = inp(F, I_MLGB)[layer * 16 + dir * 8 + 4 + h]; }
    const GAS float* mlc = inp(F, I_MLCONV) + layer * 3 * 512;
    f32x4 C[4][NET];
#pragma unroll
    for (int dt = 0; dt < 4; ++dt)
#pragma unroll
        for (int et = 0; et < NET; ++et) C[dt][et] = (f32x4){0.f, 0.f, 0.f, 0.f};
    const int cq = lane & 7, pr0 = lane >> 3;
    LAS float* nvec = (LAS float*)(img + 3 * CH_IMG + 1024 + 256 * hf);
    if (IS_ML) nvec[lane] = 0.f;
    const LAS float* nq = nvec + 4 * fq;
    unsigned sink = 0u;
#pragma unroll 1
    for (int step_ = 0; step_ < 36 * (IS_ML ? REP_CH_ML : REP_CH_RET); ++step_) {
        const int step = step_ % 36;
        if ((IS_ML ? REP_CH_ML : REP_CH_RET) > 1 && step == 0) {
            if (IS_ML) nvec[lane] = 0.f;
#pragma unroll
            for (int dt = 0; dt < 4; ++dt)
#pragma unroll
                for (int et = 0; et < NET; ++et) C[dt][et] = (f32x4){0.f, 0.f, 0.f, 0.f};
        }
        int rowbase, t0, L; bool lat;
        if (step < 4) { const int cc = dir ? 3 - step : step; rowbase = TOKL + b * LC + cc * 64; t0 = cc * 64; L = LC; lat = false; }
        else { const int cc = dir ? 35 - step : step - 4; rowbase = b * LL + cc * 64; t0 = cc * 64; L = LL; lat = true; }
        float g_i = 0.f, g_f = 0.f;
        if (IS_ML) { const int tlg = dir ? 63 - lane : lane; const GAS float* gp = MLG + (size_t)(rowbase + tlg) * 16 + dir * 8 + h; g_i = gp[0]; g_f = gp[4]; }
        if constexpr (!IS_ML) {
#pragma unroll
        for (int i4 = 0; i4 < 4; ++i4) {
            const int i = 4 * hf + i4;
            const int p = pr0 + 8 * i, tl = dir ? 63 - p : p, row = rowbase + tl, tpos = t0 + tl;
            float qv[8], kv[8]; u32x4 vraw;
            {
                const GAS bf16* base = RET + (size_t)row * 1536 + h * 64;
                const u32x4 qr = *(const GAS u32x4*)(base + 8 * cq), kr = *(const GAS u32x4*)(base + 384 + 8 * cq); vraw = *(const GAS u32x4*)(base + 768 + 8 * cq);
                const unsigned qw[4] = {qr.x, qr.y, qr.z, qr.w}, kw[4] = {kr.x, kr.y, kr.z, kr.w};
#pragma unroll
                for (int j = 0; j < 4; ++j) { qv[2 * j] = __uint_as_float(qw[j] << 16); qv[2 * j + 1] = __uint_as_float(qw[j] & 0xffff0000u); kv[2 * j] = __uint_as_float(kw[j] << 16); kv[2 * j + 1] = __uint_as_float(kw[j] & 0xffff0000u); }
                if (lat) {
                    const u32x4 qpr = *(const GAS u32x4*)(base + 8 * (cq ^ 2)), kpr = *(const GAS u32x4*)(base + 384 + 8 * (cq ^ 2));
                    const unsigned qpw[4] = {qpr.x, qpr.y, qpr.z, qpr.w}, kpw[4] = {kpr.x, kpr.y, kpr.z, kpr.w};
                    const int half = cq >> 2, hi = (cq >> 1) & 1, i0 = 8 * (cq & 1);
                    const GAS float* rp = rope + tpos * 64 + half * 32 + i0;
                    const f32x4 c0 = *(const GAS f32x4*)(rp), c1 = *(const GAS f32x4*)(rp + 4), s0 = *(const GAS f32x4*)(rp + 16), s1 = *(const GAS f32x4*)(rp + 20);
                    const float cs[8] = {c0.x, c0.y, c0.z, c0.w, c1.x, c1.y, c1.z, c1.w}, sn[8] = {s0.x, s0.y, s0.z, s0.w, s1.x, s1.y, s1.z, s1.w};
#pragma unroll
                    for (int j = 0; j < 8; ++j) {
                        const float qp = (j & 1) ? __uint_as_float(qpw[j >> 1] & 0xffff0000u) : __uint_as_float(qpw[j >> 1] << 16);
                        const float kp = (j & 1) ? __uint_as_float(kpw[j >> 1] & 0xffff0000u) : __uint_as_float(kpw[j >> 1] << 16);
                        qv[j] = hi ? qp * sn[j] + qv[j] * cs[j] : qv[j] * cs[j] - qp * sn[j];
                        kv[j] = hi ? kp * sn[j] + kv[j] * cs[j] : kv[j] * cs[j] - kp * sn[j];
                    }
                }
#pragma unroll
                for (int j = 0; j < 8; ++j) qv[j] *= 0.125f;
            }
            u32x4 qo, ko; qo.x = pk2(qv[0], qv[1]); qo.y = pk2(qv[2], qv[3]); qo.z = pk2(qv[4], qv[5]); qo.w = pk2(qv[6], qv[7]);
            ko.x = pk2(kv[0], kv[1]); ko.y = pk2(kv[2], kv[3]); ko.z = pk2(kv[4], kv[5]); ko.w = pk2(kv[6], kv[7]);
            *(LAS u32x4*)(Qi + p * CH_PITCH + 16 * cq) = qo; *(LAS u32x4*)(Ki + p * CH_PITCH + 16 * cq) = ko; *(LAS u32x4*)(Vi + p * CH_PITCH + 16 * cq) = vraw;
        }
        } else {
            const GAS float* wq = mlc + h * 64 + 8 * cq;
            u32x4 rr[2][3][4], vr[4];
#pragma unroll
            for (int i4 = 0; i4 < 4; ++i4) {
                const int p = pr0 + 8 * (4 * hf + i4), tl = dir ? 63 - p : p, row = rowbase + tl, tpos = t0 + tl;
                const GAS bf16* bb = ML + (size_t)row * 1024 + h * 64 + 8 * cq;
                const u32x4 z4 = (u32x4){0u, 0u, 0u, 0u};
#pragma unroll
                for (int qk = 0; qk < 2; ++qk) {
                    rr[qk][1][i4] = *(const GAS u32x4*)(bb + 256 * qk);
                    rr[qk][0][i4] = tpos > 0 ? *(const GAS u32x4*)(bb + 256 * qk - 1024) : z4;
                    rr[qk][2][i4] = tpos < L - 1 ? *(const GAS u32x4*)(bb + 256 * qk + 1024) : z4;
                }
                vr[i4] = *(const GAS u32x4*)(bb + 512);
            }
#pragma unroll
            for (int qk = 0; qk < 2; ++qk) {
                f32x4 wt[3][2];
#pragma unroll
                for (int tp = 0; tp < 3; ++tp) { wt[tp][0] = *(const GAS f32x4*)(wq + 256 * qk + 512 * tp); wt[tp][1] = *(const GAS f32x4*)(wq + 256 * qk + 512 * tp + 4); }
#pragma unroll
                for (int i4 = 0; i4 < 4; ++i4) {
                    const int p = pr0 + 8 * (4 * hf + i4);
                    const unsigned a0[4] = {rr[qk][0][i4].x, rr[qk][0][i4].y, rr[qk][0][i4].z, rr[qk][0][i4].w}, a1[4] = {rr[qk][1][i4].x, rr[qk][1][i4].y, rr[qk][1][i4].z, rr[qk][1][i4].w},
                                   a2[4] = {rr[qk][2][i4].x, rr[qk][2][i4].y, rr[qk][2][i4].z, rr[qk][2][i4].w};
                    float ov[8];
#pragma unroll
                    for (int j = 0; j < 8; ++j) {
                        const float x0 = (j & 1) ? __uint_as_float(a0[j >> 1] & 0xffff0000u) : __uint_as_float(a0[j >> 1] << 16);
                        const float x1 = (j & 1) ? __uint_as_float(a1[j >> 1] & 0xffff0000u) : __uint_as_float(a1[j >> 1] << 16);
                        const float x2 = (j & 1) ? __uint_as_float(a2[j >> 1] & 0xffff0000u) : __uint_as_float(a2[j >> 1] << 16);
                        const float r = siluf_(wt[0][j >> 2][j & 3] * x0 + wt[1][j >> 2][j & 3] * x1 + wt[2][j >> 2][j & 3] * x2);
                        ov[j] = qk == 0 ? r : r * 0.125f;
                    }
                    u32x4 o; o.x = pk2(ov[0], ov[1]); o.y = pk2(ov[2], ov[3]); o.z = pk2(ov[4], ov[5]); o.w = pk2(ov[6], ov[7]);
                    if (qk == 0) *(LAS u32x4*)(Qi + p * CH_PITCH + 16 * cq) = o;
                    else { *(LAS u32x4*)(Ki + p * CH_PITCH + 16 * cq) = o; *(LAS u32x4*)(Vi + p * CH_PITCH + 16 * cq) = vr[i4]; }
                }
            }
        }
        __builtin_amdgcn_sched_barrier(0);
        float f_p, i_p;
        if (!IS_ML) { f_p = lgam; i_p = 0.f; }
        else { i_p = g_i + bi_; f_p = log_sigmoid_(g_f + bf_); }
        float bsum = f_p;
#pragma unroll
        for (int o = 1; o < 64; o <<= 1) { const float t = lane_read(bsum, lane >= o ? lane - o : lane); if (lane >= o) bsum += t; }
        LAS float* gv = (LAS float*)(img + 3 * CH_IMG);
        const float b63 = __int_as_float(__builtin_amdgcn_readlane(__float_as_int(bsum), 63));
        const float adec = __expf(b63);
        if (hf == 0) { gv[lane] = bsum; gv[64 + lane] = bsum - i_p; gv[128 + lane] = __expf(bsum); gv[192 + lane] = __expf(b63 - (bsum - i_p)); }
        asm volatile("s_waitcnt lgkmcnt(0)" ::: "memory");
        __syncthreads();
        unsigned tch0 = 0u, tch1 = 0u, tch2 = 0u;
#ifndef NO_TOUCH
        if (step + 1 < 36) {
            const int s1 = step + 1; int rb1;
            if (s1 < 4) { const int cc = dir ? 3 - s1 : s1; rb1 = TOKL + b * LC + cc * 64; }
            else { const int cc = dir ? 35 - s1 : s1 - 4; rb1 = b * LL + cc * 64; }
            const int li0 = hf * 96 + lane, li1 = hf * 96 + 64 + (lane & 31);
            if (!IS_ML) {
                tch0 = *(const GAS unsigned*)(RET + (size_t)(rb1 + li0 / 3) * 1536 + h * 64 + (li0 % 3) * 384);
                if (lane < 32) tch1 = *(const GAS unsigned*)(RET + (size_t)(rb1 + li1 / 3) * 1536 + h * 64 + (li1 % 3) * 384);
            } else {
                tch0 = *(const GAS unsigned*)(ML + (size_t)(rb1 + li0 / 3) * 1024 + h * 64 + (li0 % 3) * 256);
                if (lane < 32) tch1 = *(const GAS unsigned*)(ML + (size_t)(rb1 + li1 / 3) * 1024 + h * 64 + (li1 % 3) * 256);
                else if (hf == 0) tch2 = *(const GAS unsigned*)(MLG + (size_t)(rb1 + 2 * (lane & 31)) * 16);
            }
        }
#endif
        const LAS float* gq = gv + 4 * fq;
        const bf16x8 ones = (fr == 0) ? (bf16x8){0x3F80, 0x3F80, 0x3F80, 0x3F80, 0x3F80, 0x3F80, 0x3F80, 0x3F80} : (bf16x8){0, 0, 0, 0, 0, 0, 0, 0};
        const int tr_q = fr >> 2, tr_p = fr & 3;
#ifndef PT_UNROLL
#define PT_UNROLL 2
#endif
#pragma unroll PT_UNROLL
        for (int pt = 0; pt < 4; ++pt) {
            f32x4 ST[4];
            bf16x8 qn[2];
#pragma unroll
            for (int kk = 0; kk < 2; ++kk) qn[kk] = *(const LAS bf16x8*)(Qi + (16 * pt + fr) * CH_PITCH + (32 * kk + 8 * fq) * 2);
#pragma unroll
            for (int st = 0; st < 4; ++st) {
                ST[st] = (f32x4){0.f, 0.f, 0.f, 0.f};
                if (st <= pt) {
#pragma unroll
                    for (int kk = 0; kk < 2; ++kk) { const bf16x8 kf = *(const LAS bf16x8*)(Ki + (16 * st + fr) * CH_PITCH + (32 * kk + 8 * fq) * 2); ST[st] = __builtin_amdgcn_mfma_f32_16x16x32_bf16(kf, qn[kk], ST[st], 0, 0, 0); }
                }
            }
            const float bp = gv[16 * pt + fr];
#pragma unroll
            for (int st = 0; st < 4; ++st) {
                if (st <= pt) {
                    const f32x4 bis = *(const LAS f32x4*)(gq + 64 + 16 * st);
#pragma unroll
                    for (int j = 0; j < 4; ++j) { const int sidx = 16 * st + 4 * fq + j; const float w = (sidx <= 16 * pt + fr) ? __expf(bp - bis[j]) : 0.f; ST[st][j] *= w; }
                }
            }
            __builtin_amdgcn_sched_barrier(0);
            f32x4 acc[NET], accd = (f32x4){0.f, 0.f, 0.f, 0.f};
#pragma unroll
            for (int et = 0; et < NET; ++et) acc[et] = (f32x4){0.f, 0.f, 0.f, 0.f};
#pragma unroll
            for (int kk = 0; kk < 2; ++kk) {
                const u32x2 lo = *(const LAS u32x2*)(Qi + (16 * pt + fr) * CH_PITCH + (32 * kk + 4 * fq) * 2), hi = *(const LAS u32x2*)(Qi + (16 * pt + fr) * CH_PITCH + (32 * kk + 16 + 4 * fq) * 2);
                const bf16x8 qs = mk_frag(lo, hi);
#pragma unroll
                for (int et = 0; et < NET; ++et) {
                    u32x4 w; w.x = pk2(C[2 * kk][et].x, C[2 * kk][et].y); w.y = pk2(C[2 * kk][et].z, C[2 * kk][et].w); w.z = pk2(C[2 * kk + 1][et].x, C[2 * kk + 1][et].y); w.w = pk2(C[2 * kk + 1][et].z, C[2 * kk + 1][et].w);
                    acc[et] = __builtin_amdgcn_mfma_f32_16x16x32_bf16(qs, __builtin_bit_cast(bf16x8, w), acc[et], 0, 0, 0);
                }
                if (IS_ML) {
                    const f32x4 n0 = *(const LAS f32x4*)(nq + 32 * kk), n1 = *(const LAS f32x4*)(nq + 32 * kk + 16);
                    u32x4 w; w.x = pk2(n0.x, n0.y); w.y = pk2(n0.z, n0.w); w.z = pk2(n1.x, n1.y); w.w = pk2(n1.z, n1.w);
                    if (fr != 0) w = (u32x4){0u, 0u, 0u, 0u};
                    accd = __builtin_amdgcn_mfma_f32_16x16x32_bf16(qs, __builtin_bit_cast(bf16x8, w), accd, 0, 0, 0);
                }
            }
            { const f32x4 ap = *(const LAS f32x4*)(gq + 128 + 16 * pt);
#pragma unroll
              for (int j = 0; j < 4; ++j) {
#pragma unroll
                for (int et = 0; et < NET; ++et) acc[et][j] *= ap[j];
                accd[j] *= ap[j]; } }
            __builtin_amdgcn_sched_barrier(0);
#pragma unroll
            for (int kk = 0; kk < 2; ++kk) {
                if (2 * kk <= pt) {
                    u32x4 w; w.x = pk2(ST[2 * kk].x, ST[2 * kk].y); w.y = pk2(ST[2 * kk].z, ST[2 * kk].w); w.z = pk2(ST[2 * kk + 1].x, ST[2 * kk + 1].y); w.w = pk2(ST[2 * kk + 1].z, ST[2 * kk + 1].w);
                    const bf16x8 pf = __builtin_bit_cast(bf16x8, w);
                    u32x2 vlo[2], vhi[2];
                    ds_tr16x4(va + (32 * kk + 4 * fq + tr_q) * CH_PITCH + 8 * tr_p + 64 * hf, vlo, vhi);
#pragma unroll
                    for (int et = 0; et < NET; ++et) acc[et] = __builtin_amdgcn_mfma_f32_16x16x32_bf16(pf, mk_frag(vlo[et], vhi[et]), acc[et], 0, 0, 0);
                    if (IS_ML) accd = __builtin_amdgcn_mfma_f32_16x16x32_bf16(pf, ones, accd, 0, 0, 0);
                }
            }
            __builtin_amdgcn_sched_barrier(0);
#pragma unroll
            for (int j = 0; j < 4; ++j) {
                const int p = 16 * pt + 4 * fq + j, tl = dir ? 63 - p : p, row = rowbase + tl;
                float inv = 1.f;
                if (IS_ML) { const float den = lane_read(accd[j], lane & 48); inv = __builtin_amdgcn_rcpf(fmaxf(fabsf(den), 1.f)); }
                const int cof = (IS_ML ? 384 : 0) + h * 64 + 32 * hf + fr;
                const unsigned boff = dir == 0 ? (unsigned)(row * D + 384 + cof) * 2u : (unsigned)(row * 640 + cof) * 2u;
                GAS char* ob = dir == 0 ? (GAS char*)Y : (GAS char*)OB;
#pragma unroll
                for (int et = 0; et < NET; ++et) *(GAS bf16*)(ob + boff + 32 * et) = (bf16)f2bf(acc[et][j] * inv);
            }
        }
        __builtin_amdgcn_sched_barrier(0);
#pragma unroll
        for (int dt = 0; dt < 4; ++dt)
#pragma unroll
            for (int et = 0; et < NET; ++et) C[dt][et] *= adec;
        f32x4 accn[4];
        if (IS_ML) {
#pragma unroll
            for (int dt = 0; dt < 4; ++dt) { accn[dt] = *(const LAS f32x4*)(nq + 16 * dt) * adec; if (fr != 0) accn[dt] = (f32x4){0.f, 0.f, 0.f, 0.f}; }
        }
#pragma unroll
        for (int kk = 0; kk < 2; ++kk) {
            u32x2 vlo[2], vhi[2], klo[4], khi[4];
            ds_tr16x4(va + (32 * kk + 4 * fq + tr_q) * CH_PITCH + 8 * tr_p + 64 * hf, vlo, vhi);
            ds_tr16x8(ka + (32 * kk + 4 * fq + tr_q) * CH_PITCH + 8 * tr_p, klo, khi);
            const f32x4 wl = *(const LAS f32x4*)(gq + 192 + 32 * kk), wh = *(const LAS f32x4*)(gq + 192 + 32 * kk + 16);
#pragma unroll
            for (int dt = 0; dt < 4; ++dt) {
                u32x4 w;
                w.x = pk2(__uint_as_float(klo[dt].x << 16) * wl[0], __uint_as_float(klo[dt].x & 0xffff0000u) * wl[1]);
                w.y = pk2(__uint_as_float(klo[dt].y << 16) * wl[2], __uint_as_float(klo[dt].y & 0xffff0000u) * wl[3]);
                w.z = pk2(__uint_as_float(khi[dt].x << 16) * wh[0], __uint_as_float(khi[dt].x & 0xffff0000u) * wh[1]);
                w.w = pk2(__uint_as_float(khi[dt].y << 16) * wh[2], __uint_as_float(khi[dt].y & 0xffff0000u) * wh[3]);
                const bf16x8 kf = __builtin_bit_cast(bf16x8, w);
#pragma unroll
                for (int et = 0; et < NET; ++et) C[dt][et] = __builtin_amdgcn_mfma_f32_16x16x32_bf16(kf, mk_frag(vlo[et], vhi[et]), C[dt][et], 0, 0, 0);
                if (IS_ML) accn[dt] = __builtin_amdgcn_mfma_f32_16x16x32_bf16(kf, ones, accn[dt], 0, 0, 0);
            }
        }
        if (IS_ML) { if (fr == 0) {
#pragma unroll
            for (int dt = 0; dt < 4; ++dt) *(LAS f32x4*)(nvec + 4 * fq + 16 * dt) = accn[dt]; } }
        asm volatile("s_waitcnt lgkmcnt(0)" ::: "memory");
        __syncthreads();
        sink ^= tch0 ^ tch1 ^ tch2;
    }
    asm volatile("" :: "v"(sink));
}

#ifndef REP_HY
#define REP_HY 1
#endif
constexpr int NCHWG = 160;
__device__ __forceinline__ void phase_mix(Frame& F, int layer) {
    const bool last = layer == 1;
    const GAS bf16* ftl = WSP(const bf16, WS_FTL) + (size_t)layer * 2 * 384 * 4096;
    if (F.wg < NCHWG) {
        if (F.wave >= 4) {
#pragma unroll 1
            for (int i = 0; i < 72 * (F.wg * 2 < 192 ? REP_CH_RET : REP_CH_ML); ++i) __syncthreads();
        } else {
            const int cl = F.wave >> 1, hf = F.wave & 1, c = F.wg * 2 + cl;
            LAS unsigned char* img = F.lds + cl * CH_WAVE_LDS;
            if (c < 192) { const int b = c / 12, r = c % 12; chain_fast<false>(F, layer, b, r >> 1, r & 1, img, hf); }
            else { const int i = c - 192; chain_fast<true>(F, layer, i >> 3, (i & 7) >> 1, i & 1, img, hf); }
        }
    } else {
        const int nh = F.G - NCHWG, w = F.wg - NCHWG;
#pragma unroll 1
        for (int rp = 0; rp < REP_HY; ++rp)
            for (int u = w; u < 384; u += nh) hyena_unit_fast<LL>(F, layer, u, WSP(const bf16, WS_HYTL), ftl, WSP(bf16, WS_YHTL));
        if (!last) for (int u = w; u < 384; u += nh) hyena_unit_fast<LC>(F, layer, u, WSP(const bf16, WS_HYTC), WSP(const bf16, WS_FTC), WSP(bf16, WS_YHTC));
    }
}

__device__ __forceinline__ void phase_combine(Frame& F, int layer, bool dummy = false) {
    const bool last = layer == 1;
    const int gw = F.wg * NWAVES + F.wave, NGW = F.G * NWAVES, lane = F.lane;
    const int nrows = last ? TOKL : TOK;
    GAS bf16* Y = WSP(bf16, WS_Y); const GAS bf16* OB = WSP(const bf16, WS_OB); const GAS bf16* RET = WSP(const bf16, WS_RET); const GAS bf16* ML = WSP(const bf16, WS_ML);
    const int rsub = lane >> 4, l16 = lane & 15;
    for (int row0 = gw * 4; row0 < nrows; row0 += NGW * 4) {
        const int row = row0 + rsub;
        GAS bf16* yo = dummy ? WSP(bf16, WS_U + 300 * MiB) + (size_t)(row & 8191) * D : Y + (size_t)row * D;
        u32x2 of[10], ob[10], gt[10];
#pragma unroll
        for (int hh = 0; hh < 10; ++hh) {
            const int cof = hh * 64 + 4 * l16;
            of[hh] = *(const GAS u32x2*)(Y + (size_t)row * D + 384 + cof); ob[hh] = *(const GAS u32x2*)(OB + (size_t)row * 640 + cof);
            gt[hh] = hh < 6 ? *(const GAS u32x2*)(RET + (size_t)row * 1536 + 1152 + cof) : *(const GAS u32x2*)(ML + (size_t)row * 1024 + 768 + (cof - 384));
        }
#pragma unroll
        for (int hh = 0; hh < 10; ++hh) {
            float x[4], g[4];
            x[0] = __uint_as_float(of[hh].x << 16) + __uint_as_float(ob[hh].x << 16); x[1] = __uint_as_float(of[hh].x & 0xffff0000u) + __uint_as_float(ob[hh].x & 0xffff0000u);
            x[2] = __uint_as_float(of[hh].y << 16) + __uint_as_float(ob[hh].y << 16); x[3] = __uint_as_float(of[hh].y & 0xffff0000u) + __uint_as_float(ob[hh].y & 0xffff0000u);
            g[0] = __uint_as_float(gt[hh].x << 16); g[1] = __uint_as_float(gt[hh].x & 0xffff0000u); g[2] = __uint_as_float(gt[hh].y << 16); g[3] = __uint_as_float(gt[hh].y & 0xffff0000u);
            float sm = (x[0] + x[1]) + (x[2] + x[3]);
            DPP_ADD(sm, 0xB1); DPP_ADD(sm, 0x4E); DPP_ADD(sm, 0x141); DPP_ADD(sm, 0x140);
            const float mu = sm * (1.f / 64.f);
#pragma unroll
            for (int j = 0; j < 4; ++j) x[j] -= mu;
            float sq = (x[0] * x[0] + x[1] * x[1]) + (x[2] * x[2] + x[3] * x[3]);
            DPP_ADD(sq, 0xB1); DPP_ADD(sq, 0x4E); DPP_ADD(sq, 0x141); DPP_ADD(sq, 0x140);
            const float rs = rsqrtf(sq * (1.f / 64.f) + 1e-6f);
            float o[4];
#pragma unroll
            for (int j = 0; j < 4; ++j) o[j] = x[j] * rs * (hh < 6 ? siluf_(g[j]) : sigmoidf_(g[j]));
            u32x2 w; w.x = pk2(o[0], o[1]); w.y = pk2(o[2], o[3]);
            *(GAS u32x2*)(yo + 384 + hh * 64 + 4 * l16) = w;
        }
    }
    LAS unsigned char* scr = F.lds + F.wave * 8704;
    const int nitL = NB * 6 * 32, nitC = last ? 0 : NB * 6 * 4;
    for (int it = gw; it < nitL + nitC; it += NGW) {
        const GAS bf16* src; int L, rowbase, b, cb, tb;
        if (it < nitL) { b = it / 192; const int r = it % 192; cb = r / 32; tb = r % 32; L = LL; src = WSP(const bf16, WS_YHTL); rowbase = b * LL; }
        else { const int i2 = it - nitL; b = i2 / 24; const int r = i2 % 24; cb = r / 4; tb = r % 4; L = LC; src = WSP(const bf16, WS_YHTC); rowbase = TOKL + b * LC; }
        u32x4 v[8];
#pragma unroll
        for (int i = 0; i < 8; ++i) { const int cc = (lane >> 3) + 8 * i; v[i] = *(const GAS u32x4*)(src + ((size_t)(b * 384 + cb * 64 + cc)) * L + tb * 64 + 8 * (lane & 7)); }
#pragma unroll
        for (int i = 0; i < 8; ++i) { const int cc = (lane >> 3) + 8 * i; *(LAS u32x4*)(scr + cc * 136 + 16 * (lane & 7)) = v[i]; }
        asm volatile("s_waitcnt lgkmcnt(0)" ::: "memory");
#pragma unroll
        for (int i = 0; i < 8; ++i) {
            const int tt = (lane >> 3) + 8 * i, c8 = 8 * (lane & 7);
            unsigned short e[8];
#pragma unroll
            for (int j = 0; j < 8; ++j) e[j] = *(const LAS unsigned short*)(scr + (c8 + j) * 136 + tt * 2);
            u32x4 o; o.x = e[0] | ((unsigned)e[1] << 16); o.y = e[2] | ((unsigned)e[3] << 16); o.z = e[4] | ((unsigned)e[5] << 16); o.w = e[6] | ((unsigned)e[7] << 16);
            *(GAS u32x4*)((dummy ? WSP(bf16, WS_U + 300 * MiB) : Y) + (size_t)(dummy ? ((rowbase + tb * 64 + tt) & 8191) : (rowbase + tb * 64 + tt)) * D + cb * 64 + c8) = o;
        }
        asm volatile("s_waitcnt lgkmcnt(0)" ::: "memory");
    }
}

__device__ __forceinline__ void phase_norm_router(Frame& F) {
    const int gw = F.wg * NWAVES + F.wave, lane = F.lane;
    const GAS float* g = inp(F, I_GFFN) + 1 * D; const GAS float* wr = inp(F, I_ROUTER); const GAS float* br = inp(F, I_ROUTERB);
    GAS unsigned* cnt = WSP(unsigned, WS_CTL) + CW_CNT;
    const int r0 = gw * 16, r1 = r0 + 16;
    f32x4 gm[4], sh[4], w0r[4][4], w1r[4][4]; u32x2 ring[4][4];
    { const GAS float* shp = mod_ptr(F, 1, r0, 3); const GAS float* scp = mod_ptr(F, 1, r0, 4);
#pragma unroll
      for (int j = 0; j < 4; ++j) { const f32x4 gg = *(const GAS f32x4*)(g + 256 * j + 4 * lane), sc = *(const GAS f32x4*)(scp + 256 * j + 4 * lane); sh[j] = *(const GAS f32x4*)(shp + 256 * j + 4 * lane);
          gm[j].x = gg.x * (1.f + sc.x); gm[j].y = gg.y * (1.f + sc.y); gm[j].z = gg.z * (1.f + sc.z); gm[j].w = gg.w * (1.f + sc.w);
#pragma unroll
          for (int i = 0; i < 4; ++i) { const int k = 256 * j + 4 * lane + i; w0r[j][i] = *(const GAS f32x4*)(wr + k * 8); w1r[j][i] = *(const GAS f32x4*)(wr + k * 8 + 4); } }
#pragma unroll
      for (int i = 0; i < 4; ++i) xrow_issue<true>(F, r0 + i, 2, lane, ring[i]); }
    float brr[8];
#pragma unroll
    for (int e = 0; e < 8; ++e) brr[e] = br[e];
#pragma unroll 1
    for (int rb = r0; rb < r1; rb += 4) {
#pragma unroll
      for (int i = 0; i < 4; ++i) {
        const int row = rb + i;
        f32x4 v[4]; float s = 0.f;
#pragma unroll
        for (int j = 0; j < 4; ++j) { v[j] = xrow_unpack(ring[i][j]); s += (v[j].x * v[j].x + v[j].y * v[j].y) + (v[j].z * v[j].z + v[j].w * v[j].w); }
        if (row + 4 < r1) xrow_issue<true>(F, row + 4, 2, lane, ring[i]);
        const float r = rsqrtf(wave_sum(s) * (1.0f / 1024.0f) + 1e-6f);
        GAS bf16* orow = WSP(bf16, WS_H) + (size_t)row * D;
        float lg[8];
#pragma unroll
        for (int e = 0; e < 8; ++e) lg[e] = 0.f;
#pragma unroll
        for (int j = 0; j < 4; ++j) {
            f32x4 o; o.x = v[j].x * r * gm[j].x + sh[j].x; o.y = v[j].y * r * gm[j].y + sh[j].y; o.z = v[j].z * r * gm[j].z + sh[j].z; o.w = v[j].w * r * gm[j].w + sh[j].w;
            u32x2 w; w.x = pk2(o.x, o.y); w.y = pk2(o.z, o.w);
            *(GAS u32x2*)(orow + 256 * j + 4 * lane) = w;
            const float xo[4] = {o.x, o.y, o.z, o.w};
#pragma unroll
            for (int i = 0; i < 4; ++i) { const float x = xo[i]; const f32x4 w0 = w0r[j][i], w1 = w1r[j][i];
                lg[0] += x * w0.x; lg[1] += x * w0.y; lg[2] += x * w0.z; lg[3] += x * w0.w; lg[4] += x * w1.x; lg[5] += x * w1.y; lg[6] += x * w1.z; lg[7] += x * w1.w; }
        }
#pragma unroll
        for (int e = 0; e < 8; ++e) lg[e] = wave_sum(lg[e]) + brr[e];
        int e0 = 0; float v0 = lg[0];
#pragma unroll
        for (int e = 1; e < 8; ++e) if (lg[e] > v0) { v0 = lg[e]; e0 = e; }
        int e1 = -1; float v1 = -3.0e38f;
#pragma unroll
        for (int e = 0; e < 8; ++e) if (e != e0 && lg[e] > v1) { v1 = lg[e]; e1 = e; }
        const float w1 = 1.f / (1.f + __expf(v0 - v1)), w0 = 1.f - w1;
        if (lane == 0) {
            const unsigned p0 = __hip_atomic_fetch_add(cnt + e0, 1u, __ATOMIC_RELAXED, __HIP_MEMORY_SCOPE_AGENT), p1 = __hip_atomic_fetch_add(cnt + e1, 1u, __ATOMIC_RELAXED, __HIP_MEMORY_SCOPE_AGENT);
            WSP(int, WS_TOPE)[row * 2] = e0; WSP(int, WS_TOPE)[row * 2 + 1] = e1;
            WSP(float, WS_TOPW)[row * 2] = w0; WSP(float, WS_TOPW)[row * 2 + 1] = w1;
            WSP(int, WS_TOPP)[row * 2] = (int)p0; WSP(int, WS_TOPP)[row * 2 + 1] = (int)p1;
        }
      }
    }
}
__device__ __forceinline__ void phase_route_tables(Frame& F) {
    const GAS unsigned* cnt = WSP(const unsigned, WS_CTL) + CW_CNT;
    int off[9]; off[0] = 0;
#pragma unroll
    for (int e = 0; e < 8; ++e) { const int c = (int)__hip_atomic_load(cnt + e, __ATOMIC_RELAXED, __HIP_MEMORY_SCOPE_AGENT); off[e + 1] = off[e] + ((c + 255) >> 8) * 256; }
    const int gt = F.wg * NTHR + F.tid, NGT = F.G * NTHR;
    GAS int* rowidx = WSP(int, WS_ROWIDX); GAS int* slot = WSP(int, WS_SLOT); GAS int* tilee = WSP(int, WS_TILEE);
    for (int i = gt; i < MAXTILES * 256; i += NGT) {
        int e = 0;
#pragma unroll
        for (int q = 1; q < 8; ++q) if (i >= off[q]) e = q;
        const int c = (int)cnt[e];
        if (i >= off[8] || i - off[e] >= c) rowidx[i] = 0;
    }
    for (int i = gt; i < TOKL * 2; i += NGT) {
        const int e = WSP(const int, WS_TOPE)[i], pos = WSP(const int, WS_TOPP)[i];
        int o = 0;
#pragma unroll
        for (int q = 0; q < 8; ++q) if (e == q) o = off[q];
        const int s = o + pos; slot[i] = s; rowidx[s] = i >> 1;
    }
    for (int i = gt; i < MAXTILES + 1; i += NGT) {
        if (i == MAXTILES) tilee[MAXTILES] = off[8] >> 8;
        else { int e = 0;
#pragma unroll
            for (int q = 1; q < 8; ++q) if (i * 256 >= off[q]) e = q;
            tilee[i] = e; }
    }
}

__device__ __forceinline__ void moe_pass_gemm1_fast(Frame& F, int t0, int t1) {
    pg8::OrderMoe S; S.o.init(t1 - t0, NFF1 / 256, F.G, F.wg); S.rowidx = WSP(const int, WS_ROWIDX); S.tilee = WSP(const int, WS_TILEE); S.t0 = t0; S.bstride = (size_t)NFF1 * D; S.gather = true;
    EpiSwiglu E{WSP(bf16, WS_MACT), 0};
    pg8::gemm_phase(F.lds, F.tid, WSP(const bf16, WS_H), D, WSP(const bf16, WS_MW13), D, D, S, E);
}
__device__ __forceinline__ void moe_pass_gemm2_fast(Frame& F, int t0, int t1) {
    pg8::OrderMoe S; S.o.init(t1 - t0, D / 256, F.G, F.wg); S.rowidx = WSP(const int, WS_ROWIDX); S.tilee = WSP(const int, WS_TILEE); S.t0 = t0; S.bstride = (size_t)D * DFF; S.gather = false;
    EpiBf16Out E{WSP(bf16, WS_EOUT), D, t0 * 256};
    pg8::gemm_phase(F.lds, F.tid, WSP(const bf16, WS_MACT), DFF, WSP(const bf16, WS_MW2), DFF, DFF, S, E);
}
__device__ __forceinline__ void phase_final(Frame& F, GAS float* dummy = nullptr) {
    const int gw = F.wg * NWAVES + F.wave, NGW = F.G * NWAVES, lane = F.lane;
    const GAS float* gf = inp(F, I_GFINAL); const GAS bf16* eo = WSP(const bf16, WS_EOUT);
#pragma unroll 2
    for (int row = gw; row < TOKL; row += NGW) {
        const int s0 = WSP(const int, WS_SLOT)[row * 2], s1 = WSP(const int, WS_SLOT)[row * 2 + 1];
        const float w0 = WSP(const float, WS_TOPW)[row * 2], w1 = WSP(const float, WS_TOPW)[row * 2 + 1];
        const GAS float* m5 = mod_ptr(F, 1, row, 5);
        GAS float* xr = outp(F) + (size_t)row * D; const GAS bf16* xb = WSP(const bf16, WS_XL2) + (size_t)row * D;
        f32x4 v[4]; float s = 0.f;
#pragma unroll
        for (int j = 0; j < 4; ++j) {
            const int c = 256 * j + 4 * lane;
            const f32x4 a = ld_bf16x4(eo + (size_t)s0 * D + c), b = ld_bf16x4(eo + (size_t)s1 * D + c), m = *(const GAS f32x4*)(m5 + c);
            v[j] = ld_bf16x4(xb + c) + m * (a * w0 + b * w1);
            s += (v[j].x * v[j].x + v[j].y * v[j].y) + (v[j].z * v[j].z + v[j].w * v[j].w);
        }
        const float r = rsqrtf(wave_sum(s) * (1.f / 1024.f) + 1e-6f);
#pragma unroll
        for (int j = 0; j < 4; ++j) { const int c = 256 * j + 4 * lane; const f32x4 g = *(const GAS f32x4*)(gf + c); GAS float* o_ = dummy ? dummy + (size_t)(row & 8191) * D : xr; *(GAS f32x4*)(o_ + c) = v[j] * r * g; }
    }
}

#ifndef MR_L0
#define MR_L0 192
#endif
#ifndef REP_WIN
#define REP_WIN 1
#endif
#ifndef REP_MIX
#define REP_MIX 1
#endif
#ifndef REP_GATE
#define REP_GATE 1
#endif
#ifndef REP_UP
#define REP_UP 1
#endif
#ifndef REP_FFN1
#define REP_FFN1 1
#endif
#ifndef REP_MOE
#define REP_MOE 1
#endif
#ifndef REP_NORM
#define REP_NORM 1
#endif
#ifndef REP_P0
#define REP_P0 1
#endif
__global__ void __launch_bounds__(NTHR, 2) hybrid_fwd(Params prm) {
    extern __shared__ __attribute__((aligned(16))) unsigned char lds_raw[];
    Frame F;
    F.lds = (LAS unsigned char*)lds_raw; F.ws = (GAS unsigned char*)prm.ws;
    F.tid = threadIdx.x; F.lane = F.tid & 63; F.wave = __builtin_amdgcn_readfirstlane(F.tid >> 6); F.G = gridDim.x; F.wg = blockIdx.x;
    volatile LAS unsigned* MISC = (volatile LAS unsigned*)(F.lds + MISC_OFF);
    if (F.tid < 64) MISC[F.tid] = 0u;
    if (F.tid < 33) { const unsigned long long v = F.tid < 32 ? (unsigned long long)prm.in[F.tid] : (unsigned long long)prm.out; *(LAS unsigned long long*)(F.lds + PTAB_OFF + 8 * F.tid) = v; }
    __syncthreads();
    XcdBarrier bar = xcd_barrier_post(WSP(unsigned, WS_CTL) + CW_BAR, MISC + 8);
#define RELAUNDER() do { { unsigned long long _w = (unsigned long long)F.ws; asm volatile("" : "+s"(_w)); F.ws = (GAS unsigned char*)_w; } \
        { unsigned _t = (unsigned)F.tid; asm volatile("" : "+v"(_t)); F.tid = (int)_t; F.lane = F.tid & 63; F.wave = __builtin_amdgcn_readfirstlane(F.tid >> 6); } \
        { unsigned _g = (unsigned)F.G, _b = (unsigned)F.wg; asm volatile("" : "+s"(_g), "+s"(_b)); F.G = (int)_g; F.wg = (int)_b; } \
        { unsigned _l = (unsigned)(size_t)F.lds; asm volatile("" : "+s"(_l)); F.lds = (LAS unsigned char*)(size_t)_l; } } while (0)
#define GRID_BAR() do { { unsigned long long _b = (unsigned long long)bar.bar; unsigned _x = bar.x; asm volatile("" : "+s"(_b), "+s"(_x)); bar.bar = (GAS unsigned*)_b; bar.x = _x; } xcd_barrier(bar); RELAUNDER(); } while (0)

    for (int rp = 0; rp < REP_P0; ++rp) { phase_p0(F); write_bias(F);
    GRID_BAR(); }
#pragma unroll 1
    for (int layer_ = 0; layer_ < 2; ++layer_) {
        int layer = layer_;
#define last (layer == 1)
#define rows_all TOK
#define rows_out (last ? TOKL : TOK)
#define modbase (WSP(const float, WS_MOD) + (size_t)layer * 17 * 6144)
#define LAYER_LAUNDER() asm volatile("" : "+s"(layer))
        for (int rp = 0; rp < REP_NORM; ++rp) { if (last) phase_norm<true>(F, layer, rows_all, 0); else phase_norm<false>(F, layer, rows_all, 0);
        if (layer == 0) { const int gw = F.wg * NWAVES + F.wave, NGW = F.G * NWAVES;
            for (int it = gw; it < 1536 + 96; it += NGW) filter_out_item(F, it); }
        { GRID_BAR(); LAYER_LAUNDER(); } }
        for (int rp = 0; rp < REP_WIN; ++rp) {
        { EpiWin E{WSP(const float, WS_BIAS) + layer * NWP, WSP(bf16, WS_HYTL), WSP(bf16, WS_HYTC), WSP(bf16, WS_RET), WSP(bf16, WS_ML), WSP(float, WS_MLG)};
          if (last) { pg8::OrderWinL1 S; S.init(F.G, F.wg); pg8::gemm_phase(F.lds, F.tid, WSP(const bf16, WS_H), D, WSP(const bf16, WS_WIN), D, D, S, E); }
          else gemm_fast(F, WSP(const bf16, WS_H), D, WSP(const bf16, WS_WIN), D, D, rows_all, NW1, E); }
        { GRID_BAR(); LAYER_LAUNDER(); } }
        for (int rp = 0; rp < REP_MIX; ++rp) { phase_mix(F, layer);
        { GRID_BAR(); LAYER_LAUNDER(); } }
#ifndef REP_COMB
#define REP_COMB 1
#endif
        for (int rp = REP_COMB - 1; rp > 0; --rp) { phase_combine(F, layer, true); { GRID_BAR(); LAYER_LAUNDER(); } }
        phase_combine(F, layer);
        { GRID_BAR(); LAYER_LAUNDER(); }
        for (int rp = 0; rp < REP_GATE; ++rp) {
        { EpiGate E{WSP(const float, WS_BIAS) + layer * NWP + NW1, WSP(bf16, WS_GATES)};
          gemm_fast(F, WSP(const bf16, WS_H), D, WSP(const bf16, WS_WIN) + (size_t)NW1 * D, D, D, rows_out, NGATE, E); }
        { GRID_BAR(); LAYER_LAUNDER(); } }
        for (int rp = 0; rp < REP_UP; ++rp) {
        { EpiUp E{WSP(const bf16, WS_GATES), WSP(bf16, WS_H)};
          if (last) gemm_fast(F, WSP(const bf16, WS_Y), D, WSP(const bf16, WS_WUP), D, D, TOKL, D, E);
          else gemm_fast<MR_L0>(F, WSP(const bf16, WS_Y), D, WSP(const bf16, WS_WUP), D, D, TOK, D, E); }
        { GRID_BAR(); LAYER_LAUNDER(); } }
#ifndef REP_OUT
#define REP_OUT 1
#endif
        if (last) { EpiResidT<true> E{(const GAS bf16*)outp(F), nullptr, WSP(bf16, WS_XL2), nullptr, modbase, 2};
            gemm_fast(F, WSP(const bf16, WS_H), D, WSP(const bf16, WS_WOUT), D, D, TOKL, D, E); }
        else { EpiResidT<false> E{inp(F, I_X), inp(F, I_CTX), (GAS bf16*)outp(F), WSP(bf16, WS_XC), modbase, 2};
            gemm_fast<MR_L0>(F, WSP(const bf16, WS_H), D, WSP(const bf16, WS_WOUT), D, D, TOK, D, E); }
        { GRID_BAR(); LAYER_LAUNDER(); }
        if (!last) {
            phase_norm<true>(F, layer, rows_out, 3);
            { const int gw = F.wg * NWAVES + F.wave, NGW = F.G * NWAVES; LAS float* scr = (LAS float*)(F.lds + F.wave * 8704);
              conv_weights_ffn(inp(F, I_FW1), inp(F, I_FW3), inp(F, I_FW2), WSP(bf16, WS_W13), WSP(bf16, WS_W2), gw, NGW, scr, F.lane);
              conv_weights_win(F, 1, gw, NGW, scr);
              conv_weights_upout(F, 1, gw, NGW, scr); }
            { GRID_BAR(); LAYER_LAUNDER(); }
            for (int rp = 0; rp < REP_FFN1; ++rp) {
            { EpiSwiglu E{WSP(bf16, WS_ACT), 0};
              gemm_fast(F, WSP(const bf16, WS_H), D, WSP(const bf16, WS_W13), D, D, rows_out, NFF1, E); }
            { GRID_BAR(); LAYER_LAUNDER(); } }
#ifndef REP_FFN2
#define REP_FFN2 1
#endif
            { EpiResidT<true> E{(const GAS bf16*)outp(F), WSP(const bf16, WS_XC), (GAS bf16*)outp(F), WSP(bf16, WS_XC), modbase, 5};
              gemm_fast<MR_L0>(F, WSP(const bf16, WS_ACT), DFF, WSP(const bf16, WS_W2), DFF, DFF, TOK, D, E); }
            { GRID_BAR(); LAYER_LAUNDER(); }
        }
    }
#undef LAYER_LAUNDER
#undef last
#undef rows_all
#undef rows_out
#undef modbase
    phase_norm_router(F);
    { const int gw = F.wg * NWAVES + F.wave, NGW = F.G * NWAVES; LAS float* scr = (LAS float*)(F.lds + F.wave * 8704);
#ifndef REP_MCONV
#define REP_MCONV 1
#endif
#pragma unroll 1
      for (int e = 0; e < NE * REP_MCONV; ++e)
          conv_weights_ffn(inp(F, I_MW1) + (size_t)(e % NE) * D * DFF, inp(F, I_MW3) + (size_t)(e % NE) * D * DFF, inp(F, I_MW2) + (size_t)(e % NE) * DFF * D,
                           WSP(bf16, WS_MW13) + (size_t)(e % NE) * NFF1 * D, WSP(bf16, WS_MW2) + (size_t)(e % NE) * D * DFF, gw, NGW, scr, F.lane); }
    GRID_BAR();
    phase_route_tables(F);
    GRID_BAR();
    const int ntiles = __builtin_amdgcn_readfirstlane(WSP(const int, WS_TILEE)[MAXTILES]);
#pragma unroll 1
    for (int p = 0; p < NPASS; ++p) {
        const int t0 = p * PASS_TILES, t1 = min(ntiles, t0 + PASS_TILES);
        for (int rp = 0; rp < REP_MOE; ++rp) {
        if (t0 < t1) moe_pass_gemm1_fast(F, t0, t1);
        GRID_BAR();
        if (t0 < t1) moe_pass_gemm2_fast(F, t0, t1);
        GRID_BAR(); }
    }
#ifndef REP_BAR
#define REP_BAR 0
#endif
    for (int rb = 0; rb < REP_BAR; ++rb) GRID_BAR();
#ifndef REP_FINAL
#define REP_FINAL 1
#endif
    for (int rp = REP_FINAL - 1; rp > 0; --rp) { phase_final(F, WSP(float, WS_H)); GRID_BAR(); }
    phase_final(F);
}

extern "C" void kernel_launch(void* const* d_in, const int* in_sizes, int n_in, void* d_out, int out_size, void* d_ws, size_t ws_size, hipStream_t stream) {
    static int grid = 0;
    if (grid == 0) {
        if (n_in != 32 || out_size != TOKL * D || ws_size < WS_END) { fprintf(stderr, "kernel_launch: unexpected arguments (n_in %d, out %d, ws %zu)\n", n_in, out_size, ws_size); grid = -1; return; }
        int dev = 0, cus = 0;
        if (hipGetDevice(&dev) != hipSuccess || hipDeviceGetAttribute(&cus, hipDeviceAttributeMultiprocessorCount, dev) != hipSuccess) { grid = -1; return; }
        if (hipFuncSetAttribute((const void*)hybrid_fwd, hipFuncAttributeMaxDynamicSharedMemorySize, LDS_BYTES) != hipSuccess) { grid = -1; return; }
        int per_cu = 0;
        (void)hipOccupancyMaxActiveBlocksPerMultiprocessor(&per_cu, (const void*)hybrid_fwd, NTHR, LDS_BYTES);
        (void)hipGetLastError();
        if (cus < 256) { fprintf(stderr, "kernel_launch: needs 256 compute units (one workgroup each), found %d\n", cus); grid = -1; return; }
        grid = 256;
    }
    if (grid < 0) return;
    (void)hipMemsetAsync((char*)d_ws + WS_CTL, 0, CTL_ZERO_BYTES, stream);
    Params p{};
    for (int i = 0; i < 32; ++i) p.in[i] = (const float*)d_in[i];
    p.out = (float*)d_out; p.ws = (unsigned char*)d_ws;
    hipLaunchKernelGGL(hybrid_fwd, dim3(grid), dim3(NTHR), LDS_BYTES, stream, p);
}
```

```cpp
#include <hip/hip_runtime.h>
#include <stdint.h>
#include <stdio.h>

#define LAS __attribute__((address_space(3)))
#define GAS __attribute__((address_space(1)))
typedef unsigned short bf16;
typedef short bf16x8 __attribute__((ext_vector_type(8)));
typedef float f32x4 __attribute__((ext_vector_type(4)));
typedef unsigned u32x4 __attribute__((ext_vector_type(4)));
typedef unsigned u32x2 __attribute__((ext_vector_type(2)));

constexpr int D = 1024, NB = 16, LL = 2048, LC = 256;
constexpr int TOKL = NB * LL, TOKC = NB * LC, TOK = TOKL + TOKC;
constexpr int HYW = 384, RETW = 384, MLW = 256;
constexpr int NIN = 6800, NW1 = 3840, NGATE = 3072, NWP = 6912;
constexpr int DFF = 2816, NFF1 = 5632, NE = 8;
constexpr int NWAVES = 8, NTHR = 512;
constexpr int MAXTILES = 272, PASS_TILES = 58, NPASS = 5;

constexpr size_t MiB = 1u << 20;
constexpr size_t WS_CTL = 0, CTL_ZERO_BYTES = 1 * MiB;
constexpr size_t WS_MOD = 1 * MiB;
constexpr size_t WS_BIAS = 2 * MiB;
constexpr size_t WS_ROPE = 2 * MiB + 256 * 1024;
constexpr size_t WS_TOPE = 3 * MiB;
constexpr size_t WS_TOPW = 3 * MiB + 256 * 1024;
constexpr size_t WS_TOPP = 3 * MiB + 512 * 1024;
constexpr size_t WS_SLOT = 3 * MiB + 768 * 1024;
constexpr size_t WS_ROWIDX = 4 * MiB;
constexpr size_t WS_TILEE = 4 * MiB + 512 * 1024;
constexpr size_t WS_FTL = 5 * MiB;
constexpr size_t WS_FTC = 17 * MiB;
constexpr size_t WS_WIN = 18 * MiB;
constexpr size_t WS_WUP = 32 * MiB;
constexpr size_t WS_WOUT = 34 * MiB;
constexpr size_t WS_XC = 36 * MiB;
constexpr size_t WS_H = 52 * MiB;
constexpr size_t WS_Y = 124 * MiB;
constexpr size_t WS_U = 196 * MiB;
constexpr size_t WS_RET = WS_U;
constexpr size_t WS_ML = WS_U + 108 * MiB;
constexpr size_t WS_MLG = WS_U + 180 * MiB;
constexpr size_t WS_OB = WS_U + 183 * MiB;
constexpr size_t WS_YHTL = WS_U + 228 * MiB;
constexpr size_t WS_YHTC = WS_U + 252 * MiB;
constexpr size_t WS_HYTL = WS_U + 255 * MiB;
constexpr size_t WS_HYTC = WS_U + 327 * MiB;
constexpr size_t WS_XL2 = WS_U + 284 * MiB;
constexpr size_t WS_END = WS_U + 348 * MiB;
constexpr size_t WS_GATES = WS_U;
constexpr size_t WS_ACT = WS_U;
constexpr size_t WS_W13 = WS_U + 204 * MiB;
constexpr size_t WS_W2 = WS_U + 216 * MiB;
constexpr size_t WS_MW13 = WS_Y;
constexpr size_t WS_MW2 = WS_Y + 88 * MiB;
constexpr size_t WS_MACT = WS_Y + 132 * MiB;
constexpr size_t WS_EOUT = WS_Y + 220 * MiB;
static_assert(WS_EOUT + (size_t)MAXTILES * 256 * 1024 * 2 <= WS_XL2, "map");
static_assert(WS_GATES + (size_t)TOK * NGATE * 2 <= WS_YHTL, "gates overlay");

constexpr int CW_BAR = 4096;
constexpr int CW_CNT = 16384;

constexpr int LDS_BYTES = 147456;
constexpr int MISC_OFF = 147456 - 256;

__device__ __forceinline__ float bf2f(bf16 b) { return __uint_as_float(((unsigned)b) << 16); }
typedef __bf16 bf2v_ __attribute__((ext_vector_type(2)));
typedef float f2v_ __attribute__((ext_vector_type(2)));
__device__ __forceinline__ unsigned pk2(float lo, float hi) { const f2v_ f = {lo, hi}; return __builtin_bit_cast(unsigned, __builtin_convertvector(f, bf2v_)); }
__device__ __forceinline__ unsigned f2bf(float f) { return pk2(f, 0.f) & 0xffffu; }
__device__ __forceinline__ float dpp_f(float v, int) { return v; }
#define DPP_ADD(v, ctrl) (v) += __int_as_float(__builtin_amdgcn_update_dpp(0, __float_as_int(v), (ctrl), 0xf, 0xf, true))
__device__ __forceinline__ float wave_sum(float v) {
    DPP_ADD(v, 0xB1);
    DPP_ADD(v, 0x4E);
    DPP_ADD(v, 0x141);
    DPP_ADD(v, 0x140);
    return __int_as_float(__builtin_amdgcn_readlane(__float_as_int(v), 0)) + __int_as_float(__builtin_amdgcn_readlane(__float_as_int(v), 16))
         + __int_as_float(__builtin_amdgcn_readlane(__float_as_int(v), 32)) + __int_as_float(__builtin_amdgcn_readlane(__float_as_int(v), 48));
}
__device__ __forceinline__ float lane_read(float v, int src_lane) { return __int_as_float(__builtin_amdgcn_ds_bpermute(src_lane << 2, __float_as_int(v))); }
__device__ __forceinline__ float sigmoidf_(float x) { return __builtin_amdgcn_rcpf(1.0f + __expf(-x)); }
__device__ __forceinline__ float siluf_(float x) { return x * __builtin_amdgcn_rcpf(1.0f + __expf(-x)); }

#define XB_TMO      128
#define XB_XCNT(j)  (256  + 64 * (j))
#define XB_XSUB(j)  (1280 + 64 * (j))
#define XB_XGEN(j)  (2304 + 64 * (j))
#define XB_TOP      3328
#define XB_TOPGEN   3392
#define XCD_BAR_WORDS 3456
#define XB_SPIN_CAP (1u << 22)
__device__ __forceinline__ unsigned xb_ld(GAS unsigned* p)              { return __hip_atomic_load(p, __ATOMIC_RELAXED, __HIP_MEMORY_SCOPE_AGENT); }
__device__ __forceinline__ unsigned xb_add(GAS unsigned* p, unsigned v) { return __hip_atomic_fetch_add(p, v, __ATOMIC_RELAXED, __HIP_MEMORY_SCOPE_AGENT); }
__device__ __forceinline__ unsigned xb_xcc_id() { return (unsigned)__builtin_amdgcn_s_getreg((3 << 11) | 20) & 0xFu; }
#ifndef XB_SLEEP
#define XB_SLEEP 0
#endif
#define XB_SPIN(cond, bar) do { unsigned _sp = 0; while (cond) { if (XB_SLEEP) __builtin_amdgcn_s_sleep(1); \
    if ((++_sp & 255u) == 0u) { if (xb_ld(&(bar)[XB_TMO])) break; if (_sp > XB_SPIN_CAP) { (void)__hip_atomic_fetch_add(&(bar)[XB_TMO], 1u, __ATOMIC_RELAXED, __HIP_MEMORY_SCOPE_AGENT); break; } } } } while (0)
struct XcdBarrier { GAS unsigned* bar; unsigned x; volatile LAS unsigned* st; };
__device__ __forceinline__ XcdBarrier xcd_barrier_post(GAS unsigned* bar, volatile LAS unsigned* st) {
    XcdBarrier b; b.bar = bar; b.x = xb_xcc_id(); b.st = st;
    if (threadIdx.x == 0) (void)xb_add(&bar[XB_XCNT(b.x)], 1u);
    return b;
}
__device__ __forceinline__ void xcd_barrier_complete(GAS unsigned* bar, unsigned x, unsigned& nloc, unsigned& nx) {
    const unsigned G = gridDim.x * gridDim.y * gridDim.z;
    unsigned sum, cnt, mine, sp = 0u;
    for (;;) {
        sum = 0u; cnt = 0u; mine = 0u;
#pragma unroll 1
        for (unsigned j = 0; j < 16; ++j) { const unsigned c = xb_ld(&bar[XB_XCNT(j)]); sum += c; cnt += (c > 0u) ? 1u : 0u; }
        mine = xb_ld(&bar[XB_XCNT(x)]);
        if (sum == G) break;
        __builtin_amdgcn_s_sleep(1);
        if ((++sp & 255u) == 0u) { if (xb_ld(&bar[XB_TMO])) break; if (sp > XB_SPIN_CAP) { (void)__hip_atomic_fetch_add(&bar[XB_TMO], 1u, __ATOMIC_RELAXED, __HIP_MEMORY_SCOPE_AGENT); break; } }
    }
    nloc = mine > 0u ? mine : 1u; nx = cnt > 0u ? cnt : 1u;
}
__device__ __forceinline__ void xcd_barrier(const XcdBarrier& b) {
    asm volatile("s_waitcnt vmcnt(0)" ::: "memory");
    __syncthreads();
    if (threadIdx.x == 0) {
        GAS unsigned* bar = b.bar;
        __builtin_amdgcn_s_waitcnt(0);
        unsigned nloc = b.st[0], nx = b.st[1];
        if (nloc == 0u) { xcd_barrier_complete(bar, b.x, nloc, nx); b.st[0] = nloc; b.st[1] = nx; }
        const unsigned old = xb_add(&bar[XB_XSUB(b.x)], 1u);
        const unsigned gen = old / nloc;
        if (old + 1u == (gen + 1u) * nloc) {
            __builtin_amdgcn_fence(__ATOMIC_RELEASE, "agent");
            asm volatile("s_waitcnt vmcnt(0)" ::: "memory");
            const unsigned og = xb_add(&bar[XB_TOP], 1u);
            const unsigned tg = og / nx;
            if (og + 1u == (tg + 1u) * nx) xb_add(&bar[XB_TOPGEN], 1u);
            else XB_SPIN(xb_ld(&bar[XB_TOPGEN]) == tg, bar);
            __builtin_amdgcn_fence(__ATOMIC_ACQUIRE, "agent");
            xb_add(&bar[XB_XGEN(b.x)], 1u);
            asm volatile("s_waitcnt vmcnt(0)" ::: "memory");
        } else {
            XB_SPIN(xb_ld(&bar[XB_XGEN(b.x)]) == gen, bar);
            __builtin_amdgcn_fence(__ATOMIC_ACQUIRE, "agent");
            asm volatile("s_waitcnt vmcnt(0)" ::: "memory");
        }
    }
    __syncthreads();
}

struct Params { const float* in[32]; float* out; unsigned char* ws; };
enum { I_X = 0, I_C, I_CTX, I_CCTX, I_WMOD, I_BMOD, I_GMIX, I_GFFN, I_WIN, I_BIN, I_HYCONV, I_HYF1, I_HYFB1, I_HYF2, I_HYFB2, I_HYF3, I_HYDECAY,
       I_HYSKIP, I_RETDECAY, I_MLCONV, I_MLGB, I_WUP, I_WOUT, I_FW1, I_FW3, I_FW2, I_ROUTER, I_ROUTERB, I_MW1, I_MW3, I_MW2, I_GFINAL };

struct Frame {
    LAS unsigned char* lds;
    GAS unsigned char* ws;
    int tid, lane, wave, G, wg;
};
#define WSP(T, off) ((GAS T*)(F.ws + (off)))
constexpr int PTAB_OFF = 147456 - 1024;
__device__ __forceinline__ const GAS float* inp(const Frame& F, int i) {
    const LAS unsigned* t = (const LAS unsigned*)(F.lds + PTAB_OFF) + 2 * i;
    const unsigned lo = __builtin_amdgcn_readfirstlane(t[0]), hi = __builtin_amdgcn_readfirstlane(t[1]);
    return (const GAS float*)(((unsigned long long)hi << 32) | lo);
}
__device__ __forceinline__ GAS float* outp(const Frame& F) { return (GAS float*)inp(F, 32); }

__device__ __forceinline__ int row_batch(int row) { return row < TOKL ? (row >> 11) : ((row - TOKL) >> 8); }
__device__ __forceinline__ const GAS float* mod_ptr(const Frame& F, int layer, int row, int which) {
    const int r = row < TOKL ? (row >> 11) : 16;
    return WSP(const float, WS_MOD) + ((size_t)(layer * 17 + r) * 6 + which) * 1024;
}

template <class RowMap>
__device__ __forceinline__ void tr_item(const GAS float* W, int K, int N, GAS bf16* WT, int ldT, RowMap rm, LAS float* scr, int item, int lane) {
    const int nblk = (N + 31) / 32, kb = item / nblk, nb = item % nblk, k0 = 64 * kb, n0 = 32 * nb;
    { f32x4 tv[8];
#pragma unroll
      for (int i = 0; i < 8; ++i) { const int kk = 8 * i + (lane >> 3); const int n = n0 + 4 * (lane & 7); tv[i] = (n < N) ? *(const GAS f32x4*)(W + (size_t)(k0 + kk) * N + n) : (f32x4){0.f, 0.f, 0.f, 0.f}; }
#pragma unroll
      for (int i = 0; i < 8; ++i) { const int kk = 8 * i + (lane >> 3); LAS float* d = scr + kk * 33 + 4 * (lane & 7); d[0] = tv[i].x; d[1] = tv[i].y; d[2] = tv[i].z; d[3] = tv[i].w; } }
    asm volatile("s_waitcnt lgkmcnt(0)" ::: "memory");
    const int c = lane & 7;
#pragma unroll
    for (int j = 0; j < 4; ++j) { const int nl = (lane >> 3) + 8 * j; const int n = n0 + nl; const LAS float* s = scr + (8 * c) * 33 + nl;
        u32x4 o; o.x = pk2(s[0 * 33], s[1 * 33]); o.y = pk2(s[2 * 33], s[3 * 33]); o.z = pk2(s[4 * 33], s[5 * 33]); o.w = pk2(s[6 * 33], s[7 * 33]);
        if (n < N) *(GAS u32x4*)(WT + (size_t)rm(n) * ldT + k0 + 8 * c) = o; }
    asm volatile("s_waitcnt lgkmcnt(0)" ::: "memory");
}
struct RmId { __device__ __forceinline__ int operator()(int n) const { return n; } };
__device__ __forceinline__ int win_row(int n) {
    if (n < 1152) return n;
    if (n < 2688) return 1280 + (n - 1152);
    if (n < 3712) return 2816 + (n - 2688);
    if (n < 3728) return 1152 + (n - 3712);
    return 3840 + (n - 3728);
}
struct RmWin { __device__ __forceinline__ int operator()(int n) const { return win_row(n); } };
struct RmW1 { __device__ __forceinline__ int operator()(int n) const { return (n >> 4) * 32 + (n & 15); } };
struct RmW3 { __device__ __forceinline__ int operator()(int n) const { return (n >> 4) * 32 + 16 + (n & 15); } };

__device__ __forceinline__ void conv_weights_win(Frame& F, int layer, int gw, int NGW, LAS float* scr) {
    const GAS float* W = inp(F, I_WIN) + (size_t)layer * D * NIN;
    const int items = (D / 64) * ((NIN + 31) / 32);
    for (int it = gw; it < items; it += NGW) tr_item(W, D, NIN, WSP(bf16, WS_WIN), D, RmWin(), scr, it, F.lane);
    GAS bf16* wt = WSP(bf16, WS_WIN);
    unsigned zz; asm volatile("v_mov_b32 %0, 0" : "=v"(zz));
    for (int i = gw * 64 + F.lane; i < 112 * 1024 / 8; i += NGW * 64) *(GAS u32x4*)(wt + (size_t)1168 * 1024 + (size_t)i * 8) = (u32x4){zz, zz, zz, zz};
}
__device__ __forceinline__ void conv_weights_upout(Frame& F, int layer, int gw, int NGW, LAS float* scr) {
    const int items = (D / 64) * (D / 32);
    for (int it = gw; it < items; it += NGW) tr_item(inp(F, I_WUP) + (size_t)layer * D * D, D, D, WSP(bf16, WS_WUP), D, RmId(), scr, it, F.lane);
    for (int it = gw; it < items; it += NGW) tr_item(inp(F, I_WOUT) + (size_t)layer * D * D, D, D, WSP(bf16, WS_WOUT), D, RmId(), scr, it, F.lane);
}
__device__ __forceinline__ void conv_weights_ffn(const GAS float* w1, const GAS float* w3, const GAS float* w2, GAS bf16* w13t, GAS bf16* w2t, int gw, int NGW, LAS float* scr, int lane) {
    const int i1 = (D / 64) * (DFF / 32), i2 = (DFF / 64) * (D / 32);
    for (int it = gw; it < i1; it += NGW) tr_item(w1, D, DFF, w13t, D, RmW1(), scr, it, lane);
    for (int it = gw; it < i1; it += NGW) tr_item(w3, D, DFF, w13t, D, RmW3(), scr, it, lane);
    for (int it = gw; it < i2; it += NGW) tr_item(w2, DFF, D, w2t, DFF, RmId(), scr, it, lane);
}

constexpr size_t WS_HID2 = WS_XC;
__device__ __forceinline__ void filter_hidden_item(Frame& F, int p) {
    const int sel = p < 2048 ? 0 : (p < 4096 ? 1 : 2), layer = sel == 1 ? 1 : 0, L = sel == 2 ? LC : LL, pbase = sel == 0 ? 0 : (sel == 1 ? 2048 : 4096);
    const GAS float* f1 = inp(F, I_HYF1) + layer * 33 * 64; const GAS float* fb1 = inp(F, I_HYFB1) + layer * 64;
    const GAS float* f2 = inp(F, I_HYF2) + layer * 64 * 64; const GAS float* fb2 = inp(F, I_HYFB2) + layer * 64;
    const int lane = F.lane;
    float w1[33], w2[64];
#pragma unroll
    for (int i = 0; i < 33; ++i) w1[i] = f1[i * 64 + lane];
#pragma unroll
    for (int i = 0; i < 64; ++i) w2[i] = f2[i * 64 + lane];
    const float b1 = fb1[lane], b2 = fb2[lane];
    const int pos = p - pbase;
    const float t = (float)pos / (float)(L - 1);
    const float w = 6.283185307179586f * (float)pos / (float)L;
    float feat = 0.f;
    if (lane == 0) feat = t;
    else if (lane < 17) { const float band = 1e-4f + (float)(lane - 1) * ((15.0f - 1e-4f) / 15.0f); feat = cosf(w * band); }
    else if (lane < 33) { const float band = 1e-4f + (float)(lane - 17) * ((15.0f - 1e-4f) / 15.0f); feat = -sinf(w * band); }
    float a1 = b1;
#pragma unroll
    for (int i = 0; i < 33; ++i) a1 += __int_as_float(__builtin_amdgcn_readlane(__float_as_int(feat), i)) * w1[i];
    const float h1 = sinf(a1);
    float a2 = b2;
#pragma unroll
    for (int i = 0; i < 64; ++i) a2 += __int_as_float(__builtin_amdgcn_readlane(__float_as_int(h1), i)) * w2[i];
    WSP(float, WS_HID2)[(size_t)p * 64 + lane] = sinf(a2);
}
__device__ __forceinline__ void filter_out_item(Frame& F, int item) {
    int sel, r;
    if (item < 768) { sel = 0; r = item; } else if (item < 1536) { sel = 1; r = item - 768; } else { sel = 2; r = item - 1536; }
    const int layer = sel == 1 ? 1 : 0, L = sel == 2 ? LC : LL, pb = r / 24, ch = r % 24, pbase = sel == 0 ? 0 : (sel == 1 ? 2048 : 4096);
    GAS bf16* FT = sel == 2 ? WSP(bf16, WS_FTC) : WSP(bf16, WS_FTL) + (size_t)layer * 2 * 384 * 4096;
    const GAS float* f3 = inp(F, I_HYF3) + (size_t)layer * 64 * 1536; const GAS float* dec = inp(F, I_HYDECAY) + layer * 1536;
    const int lane = F.lane, fr = lane & 15, fq = lane >> 4;
    const GAS float* hid = WSP(const float, WS_HID2) + (size_t)(pbase + pb * 64) * 64;
    f32x4 acc[4][4];
#pragma unroll
    for (int mt = 0; mt < 4; ++mt)
#pragma unroll
        for (int nt = 0; nt < 4; ++nt) acc[mt][nt] = (f32x4){0.f, 0.f, 0.f, 0.f};
#pragma unroll
    for (int ks = 0; ks < 16; ++ks) {
        float a[4], bb[4];
#pragma unroll
        for (int mt = 0; mt < 4; ++mt) a[mt] = hid[(16 * mt + fr) * 64 + 4 * ks + fq];
#pragma unroll
        for (int nt = 0; nt < 4; ++nt) bb[nt] = f3[(size_t)(4 * ks + fq) * 1536 + ch * 64 + 16 * nt + fr];
#pragma unroll
        for (int mt = 0; mt < 4; ++mt)
#pragma unroll
            for (int nt = 0; nt < 4; ++nt) acc[mt][nt] = __builtin_amdgcn_mfma_f32_16x16x4f32(a[mt], bb[nt], acc[mt][nt], 0, 0, 0);
    }
#pragma unroll
    for (int nt = 0; nt < 4; ++nt) {
        const int nn = ch * 64 + 16 * nt + fr, o = nn / 768, dir = (nn / 384) & 1, c = nn % 384;
        const float adec = fabsf(dec[nn]);
        GAS bf16* dst = FT + (size_t)(o * 384 + c) * (2 * L);
#pragma unroll
        for (int mt = 0; mt < 4; ++mt)
#pragma unroll
            for (int j = 0; j < 4; ++j) {
                const int pos = pb * 64 + 16 * mt + 4 * fq + j;
                const float t = (float)pos / (float)(L - 1);
                const float v = acc[mt][nt][j] * __expf(-t * adec);
                if (dir == 0) dst[L - pos] = (bf16)f2bf(v);
                else if (pos > 0) dst[L + pos] = (bf16)f2bf(v);
            }
    }
}

__device__ __forceinline__ void phase_p0(Frame& F) {
    const int gw = F.wg * NWAVES + F.wave, NGW = F.G * NWAVES;
    LAS float* sl = (LAS float*)F.lds;
    LAS float* red = (LAS float*)(F.lds + 17 * 4096);
    { f32x4 tv[9];
#pragma unroll
      for (int q = 0; q < 9; ++q) { const int i4 = F.tid + q * NTHR; if (i4 < 4352) { const int r = i4 >> 8, k4 = i4 & 255; tv[q] = r < 16 ? *(const GAS f32x4*)(inp(F, I_C) + r * 1024 + 4 * k4) : *(const GAS f32x4*)(inp(F, I_CCTX) + 4 * k4); } }
#pragma unroll
      for (int q = 0; q < 9; ++q) { const int i4 = F.tid + q * NTHR; if (i4 < 4352) { f32x4 o; o.x = siluf_(tv[q].x); o.y = siluf_(tv[q].y); o.z = siluf_(tv[q].z); o.w = siluf_(tv[q].w); *(LAS f32x4*)(sl + 4 * i4) = o; } } }
    __syncthreads();
    for (int item = F.wg; item < 2 * 384; item += F.G) {
        const int layer = item / 384, n0 = (item % 384) * 16, j = F.tid & 15, kp = F.tid >> 4;
        const GAS float* W = inp(F, I_WMOD) + (size_t)layer * D * 6144;
        float w[32];
#pragma unroll
        for (int i = 0; i < 32; ++i) w[i] = W[(size_t)(kp * 32 + i) * 6144 + n0 + j];
#pragma unroll
        for (int r = 0; r < 17; ++r) { float acc = 0.f;
#pragma unroll
            for (int q = 0; q < 8; ++q) { const f32x4 s4 = *(const LAS f32x4*)(sl + r * 1024 + kp * 32 + 4 * q); acc += (s4.x * w[4 * q] + s4.y * w[4 * q + 1]) + (s4.z * w[4 * q + 2] + s4.w * w[4 * q + 3]); }
            red[(kp * 17 + r) * 16 + j] = acc; }
        __syncthreads();
        if (F.tid < 272) { const int r = F.tid >> 4, jj = F.tid & 15; float s = inp(F, I_BMOD)[layer * 6144 + n0 + jj];
            for (int q = 0; q < 32; ++q) s += red[(q * 17 + r) * 16 + jj];
            WSP(float, WS_MOD)[(size_t)(layer * 17 + r) * 6144 + n0 + jj] = s; }
        __syncthreads();
    }
    __syncthreads();
    LAS float* scr = (LAS float*)(F.lds + F.wave * 8704);
    conv_weights_win(F, 0, gw, NGW, scr);
    conv_weights_upout(F, 0, gw, NGW, scr);
    for (int i = gw * 64 + F.lane; i < 2048 * 32; i += NGW * 64) {
        const int t = i >> 5, j = i & 31, half = j >> 4, ii = j & 15;
        const float inv = 1.0f / powf(10000.0f, (float)ii / 16.0f);
        const float ang = (float)(half == 0 ? (t >> 6) : (t & 63)) * inv;
        WSP(float, WS_ROPE)[t * 64 + half * 32 + ii] = cosf(ang);
        WSP(float, WS_ROPE)[t * 64 + half * 32 + 16 + ii] = sinf(ang);
    }
    for (int it = gw; it < 4352; it += NGW) filter_hidden_item(F, it);
}
__device__ __forceinline__ void write_bias(Frame& F) {
    const int gt = (F.wg * NWAVES + F.wave) * 64 + F.lane, NGT = F.G * NTHR;
    for (int i = gt; i < 2 * NWP; i += NGT) {
        const int l = i / NWP, r = i % NWP; float v = 0.f;
        int n = -1;
        if (r < 1152) n = r; else if (r < 1168) n = 3712 + (r - 1152); else if (r < 1280) n = -1; else if (r < 2816) n = 1152 + (r - 1280); else if (r < 3840) n = 2688 + (r - 2816); else n = 3728 + (r - 3840);
        if (n >= 0) v = inp(F, I_BIN)[l * NIN + n];
        WSP(float, WS_BIAS)[i] = v;
    }
}

template <bool XB> struct XRaw { typedef f32x4 T; };
template <> struct XRaw<true> { typedef u32x2 T; };
template <bool XB>
__device__ __forceinline__ void xrow_issue(const Frame& F, int row, int src, int lane, typename XRaw<XB>::T (&w)[4]) {
    if constexpr (!XB) { const GAS float* xr = row < TOKL ? inp(F, I_X) + (size_t)row * D : inp(F, I_CTX) + (size_t)(row - TOKL) * D;
#pragma unroll
        for (int j = 0; j < 4; ++j) w[j] = *(const GAS f32x4*)(xr + 256 * j + 4 * lane); }
    else { const GAS bf16* xr = src == 2 ? WSP(const bf16, WS_XL2) + (size_t)row * D : (row < TOKL ? (const GAS bf16*)outp(F) + (size_t)row * D : WSP(const bf16, WS_XC) + (size_t)(row - TOKL) * D);
#pragma unroll
        for (int j = 0; j < 4; ++j) w[j] = *(const GAS u32x2*)(xr + 256 * j + 4 * lane); }
}
__device__ __forceinline__ f32x4 xrow_unpack(f32x4 w) { return w; }
__device__ __forceinline__ f32x4 xrow_unpack(u32x2 w) { f32x4 v; v.x = __uint_as_float(w.x << 16); v.y = __uint_as_float(w.x & 0xffff0000u); v.z = __uint_as_float(w.y << 16); v.w = __uint_as_float(w.y & 0xffff0000u); return v; }
template <bool XB>
__device__ __forceinline__ void phase_norm(Frame& F, int layer, int nrows, int which) {
    const int gw = F.wg * NWAVES + F.wave, NGW = F.G * NWAVES, lane = F.lane;
    const GAS float* g = inp(F, which == 0 ? I_GMIX : I_GFFN) + layer * D;
    const int per = (nrows + NGW - 1) / NGW, r0 = gw * per, r1 = min(nrows, r0 + per);
    if (r0 >= r1) return;
    int grp = -1; f32x4 gm[4], sh[4]; typename XRaw<XB>::T ring[4][4];
#pragma unroll
    for (int i = 0; i < 4; ++i) if (r0 + i < r1) xrow_issue<XB>(F, r0 + i, 1, lane, ring[i]);
#pragma unroll 1
    for (int rb = r0; rb < r1; rb += 4) {
#pragma unroll
        for (int i = 0; i < 4; ++i) {
            const int row = rb + i;
            if (row < r1) {
                const int gr = row < TOKL ? (row >> 11) : 16;
                if (gr != grp) { grp = gr; const GAS float* shp = mod_ptr(F, layer, row, which); const GAS float* scp = mod_ptr(F, layer, row, which + 1);
#pragma unroll
                    for (int j = 0; j < 4; ++j) { const f32x4 gg = *(const GAS f32x4*)(g + 256 * j + 4 * lane), sc = *(const GAS f32x4*)(scp + 256 * j + 4 * lane); sh[j] = *(const GAS f32x4*)(shp + 256 * j + 4 * lane);
                        gm[j].x = gg.x * (1.f + sc.x); gm[j].y = gg.y * (1.f + sc.y); gm[j].z = gg.z * (1.f + sc.z); gm[j].w = gg.w * (1.f + sc.w); } }
                f32x4 v[4]; float s = 0.f;
#pragma unroll
                for (int j = 0; j < 4; ++j) { v[j] = xrow_unpack(ring[i][j]); s += (v[j].x * v[j].x + v[j].y * v[j].y) + (v[j].z * v[j].z + v[j].w * v[j].w); }
                if (row + 4 < r1) xrow_issue<XB>(F, row + 4, 1, lane, ring[i]);
                const float r = rsqrtf(wave_sum(s) * (1.0f / 1024.0f) + 1e-6f);
                GAS bf16* orow = WSP(bf16, WS_H) + (size_t)row * D;
#pragma unroll
                for (int j = 0; j < 4; ++j) {
                    f32x4 o; o.x = v[j].x * r * gm[j].x + sh[j].x; o.y = v[j].y * r * gm[j].y + sh[j].y; o.z = v[j].z * r * gm[j].z + sh[j].z; o.w = v[j].w * r * gm[j].w + sh[j].w;
                    u32x2 w; w.x = pk2(o.x, o.y); w.y = pk2(o.z, o.w);
                    *(GAS u32x2*)(orow + 256 * j + 4 * lane) = w;
                }
            }
        }
    }
}

namespace pg8 {
#ifndef WGM_
#define WGM_ 4
#endif
#ifndef PG8_SP2_
#define PG8_SP2_ 1
#endif
#ifndef PG8_ALIGN_
#define PG8_ALIGN_ 1
#endif
constexpr int BM = 256, BK = 64, HALF = 128, HTB = HALF * BK * 2, STAGE_BYTES = 8 * HTB, NXCD = 8, WGM = WGM_;
__device__ __forceinline__ int lds_byte(int r, int c) { const int st = (r >> 4) * 2 + (c >> 5), rr = r & 15, cc = c & 31, ob = rr * 64 + cc * 2; return st * 1024 + (ob ^ (((ob >> 9) & 1) << 5)); }
__device__ __forceinline__ void stage_rc(int b, int& R, int& C) { const int st = b / 1024, sb = b % 1024, swz = sb ^ (((sb >> 9) & 1) << 5); R = (st >> 1) * 16 + swz / 64; C = (st & 1) * 32 + (swz % 64) / 2; }
struct Unit { int pm, pn; };
template <int MR_>
struct OrderPlainT {
    static constexpr bool GATHER = false; static constexpr int MROWS = MR_;
    int nM, nN, nwg, G, c;
    __device__ __forceinline__ void init(int nM_, int nN_, int G_, int c_) { nM = nM_; nN = nN_; nwg = nM * nN; G = G_; c = c_; }
    __device__ __forceinline__ bool next(int i, Unit& u) const {
        const long L = (long)i * G + c; if (L >= nwg) return false;
        int wgid = (int)L; { const int q = nwg / NXCD, r = nwg % NXCD, xcd = wgid % NXCD, off = wgid / NXCD; wgid = (xcd < r ? xcd * (q + 1) : r * (q + 1) + (xcd - r) * q) + off; }
        const int nig = WGM * nN, gid = wgid / nig, fm = gid * WGM, gsz = (nM - fm) < WGM ? (nM - fm) : WGM;
        u.pm = fm + ((wgid % nig) % gsz); u.pn = (wgid % nig) / gsz; return true;
    }
    __device__ __forceinline__ int arow(int r) const { return r; }
    __device__ __forceinline__ size_t boff(const Unit&) const { return 0; }
};
using OrderPlain = OrderPlainT<256>;
struct OrderWinL1 {
    static constexpr bool GATHER = false; static constexpr int MROWS = 256;
    OrderPlain o; int G, c;
    __device__ __forceinline__ void init(int G_, int c_) { o.init(128, 15, G_, c_); G = G_; c = c_; }
    __device__ __forceinline__ bool next(int i, Unit& u) const {
        const long L = (long)i * G + c;
        if (L < 1920) return o.next(i, u);
        const int r = (int)(L - 1920); if (r >= 112) return false;
        const int q = r % 7; u.pm = 128 + r / 7; u.pn = q == 0 ? 4 : (q <= 4 ? 5 + q : 7 + q);
        return true;
    }
    __device__ __forceinline__ int arow(int r) const { return r; }
    __device__ __forceinline__ size_t boff(const Unit&) const { return 0; }
};
struct OrderMoe {
    static constexpr bool GATHER = true; static constexpr int MROWS = 256;
    OrderPlain o; const GAS int* rowidx; const GAS int* tilee; int t0; size_t bstride; bool gather;
    __device__ __forceinline__ bool next(int i, Unit& u) const { return o.next(i, u); }
    __device__ __forceinline__ int arow(int r) const { return gather ? rowidx[t0 * 256 + r] : r; }
    __device__ __forceinline__ size_t boff(const Unit& u) const { return (size_t)tilee[t0 + u.pm] * bstride; }
};

template <class Epi, class Sched>
__device__ __forceinline__ void gemm_phase(LAS unsigned char* lds, int tid_in, const GAS bf16* A, int lda, const GAS bf16* Bt, int ldb, int K, const Sched& S, const Epi& E) {
    unsigned tid_u = (unsigned)tid_in; asm volatile("" : "+v"(tid_u));
    const int tid = (int)tid_u, wid = __builtin_amdgcn_readfirstlane(tid >> 6), lane = tid & 63, wr = wid >> 2, wc = wid & 3, fr = lane & 15, fq = lane >> 4;
    const int nt = K / BK;
    constexpr int MR = Sched::MROWS, HR = MR / 2, WRR = HR / 2, NMF = WRR / 16;
    static_assert(MR == 256 || (MR == 192 && !Sched::GATHER), "unit rows");
    unsigned voffB[2];
    { int sR[2], sC[2];
#pragma unroll
      for (int i = 0; i < 2; ++i) { stage_rc(tid * 16 + i * 8192, sR[i], sC[i]);
        const int rho = sR[i] & 31, Rb = Epi::PERM ? ((sR[i] & ~31) + 8 * ((rho & 15) >> 2) + 4 * (rho >> 4) + (rho & 3)) : sR[i];
        voffB[i] = (unsigned)(Rb * ldb + sC[i]) * 2u; } }
#define PG8_GATHER_OFFS(pm_) do { unsigned _t = (unsigned)tid; asm volatile("" : "+v"(_t)); _Pragma("unroll") for (int i = 0; i < 2; ++i) { int _R, _C; stage_rc((int)_t * 16 + i * 8192, _R, _C); \
        vc0[i] = (unsigned)((size_t)S.arow((pm_) * BM + _R) * lda + _C) * 2u; vc1[i] = (unsigned)((size_t)S.arow((pm_) * BM + HALF + _R) * lda + _C) * 2u; } } while (0)
    const size_t kstep = (size_t)(BK * 2);
    const size_t hstepB = (size_t)HALF * ldb * 2, tstepB = 2 * hstepB;
    const unsigned ldsw = (unsigned)wid * 1024u;
    const int aoff = lds_byte(wr * WRR + fr, fq * 8), boff = lds_byte(wc * 32 + fr, fq * 8);
#define PG8_SA(b, h) (((b) * 2 + (h)) * HTB)
#define PG8_SB(b, h) ((4 + (b) * 2 + (h)) * HTB)
#define PG8_STAGE2(bufoff, gbase, uo, v0, v1) do { \
        __builtin_amdgcn_global_load_lds((const GAS unsigned*)((const GAS char*)(gbase) + (unsigned)((v0) + (unsigned)(uo))), (LAS unsigned*)(lds + (bufoff) + ldsw), 16, 0, 0); \
        __builtin_amdgcn_global_load_lds((const GAS unsigned*)((const GAS char*)(gbase) + (unsigned)((v1) + (unsigned)(uo))), (LAS unsigned*)(lds + (bufoff) + ldsw + 8192), 16, 0, 0); } while (0)
#define PG8_STAGEB(bufoff, gbase, uo) PG8_STAGE2(bufoff, gbase, uo, voffB[0], voffB[1])
#define PG8_LDA(dst, b, h) do { _Pragma("unroll") for (int m = 0; m < NMF; ++m) _Pragma("unroll") for (int k = 0; k < 2; ++k) dst[m][k] = *(const LAS bf16x8*)(lds + PG8_SA(b, h) + aoff + m * 2048 + k * 1024); } while (0)
#define PG8_LDB(dst, b, h) do { _Pragma("unroll") for (int n = 0; n < 2; ++n) _Pragma("unroll") for (int k = 0; k < 2; ++k) dst[n][k] = *(const LAS bf16x8*)(lds + PG8_SB(b, h) + boff + n * 2048 + k * 1024); } while (0)
#define PG8_MMA(ai, bj, At, Bt_) do { __builtin_amdgcn_s_setprio(1); _Pragma("unroll") for (int m = 0; m < NMF; ++m) _Pragma("unroll") for (int n = 0; n < 2; ++n) _Pragma("unroll") for (int k = 0; k < 2; ++k) \
        acc[ai][bj][m][n] = __builtin_amdgcn_mfma_f32_16x16x32_bf16(Bt_[n][k], At[m][k], acc[ai][bj][m][n], 0, 0, 0); __builtin_amdgcn_s_setprio(0); } while (0)
#define PG8_WAIT_V(n) asm volatile("s_waitcnt vmcnt(" #n ")" ::: "memory")
#define PG8_WAIT_L(n) asm volatile("s_waitcnt lgkmcnt(" #n ")" ::: "memory")
#define PG8_BAR __builtin_amdgcn_s_barrier()
#define PG8_SCHED __builtin_amdgcn_sched_barrier(0)
    Unit cur, nxt; int ui = 0;
    if (!S.next(0, cur)) return;
#ifndef STAGGER
#define STAGGER 0
#endif
    if (STAGGER) { const int grp = (int)(blockIdx.x >> 3) & 3;
        for (int i = 0; i < grp * STAGGER; ++i) __builtin_amdgcn_s_sleep(127); }
    f32x4 acc[2][2][4][2];
#pragma unroll
    for (int a = 0; a < 2; ++a)
#pragma unroll
        for (int b = 0; b < 2; ++b)
#pragma unroll
            for (int m = 0; m < NMF; ++m)
#pragma unroll
                for (int n = 0; n < 2; ++n) { float zf; asm volatile("v_mov_b32 %0, 0" : "=v"(zf)); acc[a][b][m][n] = (f32x4){zf, zf, zf, zf}; }
    bf16x8 At[4][2], B0[2][2], B1[2][2];
    constexpr bool GA = Sched::GATHER;
    const size_t hstepA = GA ? 0 : (size_t)HR * lda * 2, tstepA = (size_t)MR * lda * 2;
    unsigned vc0[2], vc1[2];
    if constexpr (GA) { PG8_GATHER_OFFS(cur.pm); }
    else { int sR, sC;
#pragma unroll
        for (int i = 0; i < 2; ++i) { stage_rc(tid * 16 + i * 8192, sR, sC); if (MR == 192 && sR >= HR) { sR = 0; sC = 0; }
            vc0[i] = (unsigned)(sR * lda + sC) * 2u; vc1[i] = 0u; } }
#define VC0(i) vc0[i]
#define VC1(i) (GA ? vc1[i] : vc0[i])
#define VN0(i) vc0[i]
#define VN1(i) VC1(i)
    const GAS char* cA = GA ? (const GAS char*)A : (const GAS char*)A + (size_t)cur.pm * tstepA;
    const GAS char* cB = (const GAS char*)Bt + S.boff(cur) * 2 + (size_t)cur.pn * tstepB;
    constexpr bool SP2 = PG8_SP2_ != 0, ALIGN_EPI = PG8_ALIGN_ != 0;
    const unsigned hsA = (unsigned)hstepA, hsB = (unsigned)hstepB;
    if constexpr (SP2) {
        PG8_STAGEB(PG8_SB(0, 0), cB, 0u); PG8_STAGEB(PG8_SB(0, 1), cB, hsB); PG8_STAGE2(PG8_SA(0, 0), cA, 0u, VC0(0), VC0(1)); PG8_STAGE2(PG8_SA(0, 1), cA, hsA, VC1(0), VC1(1));
        if (wr == 1) PG8_BAR;
        PG8_WAIT_V(2); PG8_BAR;
        PG8_STAGEB(PG8_SB(1, 0), cB, 128u); PG8_STAGE2(PG8_SA(1, 0), cA, 128u, VC0(0), VC0(1)); PG8_STAGEB(PG8_SB(1, 1), cB, hsB + 128u);
        PG8_WAIT_V(6); PG8_BAR;
    } else {
        PG8_STAGEB(PG8_SB(0, 0), cB, 0u); PG8_STAGE2(PG8_SA(0, 0), cA, 0u, VC0(0), VC0(1)); PG8_STAGEB(PG8_SB(0, 1), cB, hsB); PG8_STAGE2(PG8_SA(0, 1), cA, hsA, VC1(0), VC1(1));
        if (wr == 1) PG8_BAR;
        PG8_WAIT_V(4); PG8_BAR;
        PG8_STAGEB(PG8_SB(1, 0), cB, 128u); PG8_STAGE2(PG8_SA(1, 0), cA, 128u, VC0(0), VC0(1)); PG8_STAGEB(PG8_SB(1, 1), cB, hsB + 128u);
        PG8_WAIT_V(6); PG8_BAR;
    }
    for (;;) {
        const bool has_next = S.next(ui + 1, nxt);
        const GAS char* nB = cB; const GAS char* nA = cA;
        if (has_next) {
            nB = (const GAS char*)Bt + S.boff(nxt) * 2 + (size_t)nxt.pn * tstepB;
            if constexpr (!GA) nA = (const GAS char*)A + (size_t)nxt.pm * tstepA;
        }
        for (int t = 0; t < nt; t += 2) {
            const bool last = (t == nt - 2);
            if constexpr (Epi::HORNER) {
                if (t == 6 || t == 12) {
                    asm volatile("" ::: "memory");
                    const int seg = (t == 6) ? 0 : 1;
                    int hpm = cur.pm, hpn = cur.pn; asm volatile("" : "+s"(hpm), "+s"(hpn));
                    unsigned hln = (unsigned)lane; asm volatile("" : "+v"(hln)); const int hfr = (int)(hln & 15u), hfq = (int)(hln >> 4);
#pragma unroll
                    for (int ai = 0; ai < 2; ++ai) {
                        u32x4 ga[4][2], gb[4][2];
#pragma unroll
                        for (int m = 0; m < NMF; ++m)
#pragma unroll
                            for (int bj = 0; bj < 2; ++bj) {
                                const int row = hpm * MR + ai * HR + wr * WRR + m * 16 + hfr, col = hpn * BM + bj * HALF + wc * 32 + 8 * hfq;
                                ga[m][bj] = E.gate8(seg, row, col); gb[m][bj] = E.gate8(seg + 1, row, col);
                            }
                        if constexpr (NMF == 4) asm volatile("" : "+v"(ga[0][0]), "+v"(ga[0][1]), "+v"(ga[1][0]), "+v"(ga[1][1]), "+v"(ga[2][0]), "+v"(ga[2][1]), "+v"(ga[3][0]), "+v"(ga[3][1]),
                                          "+v"(gb[0][0]), "+v"(gb[0][1]), "+v"(gb[1][0]), "+v"(gb[1][1]), "+v"(gb[2][0]), "+v"(gb[2][1]), "+v"(gb[3][0]), "+v"(gb[3][1]) :: "memory");
                        else asm volatile("" : "+v"(ga[0][0]), "+v"(ga[0][1]), "+v"(ga[1][0]), "+v"(ga[1][1]), "+v"(ga[2][0]), "+v"(ga[2][1]),
                                          "+v"(gb[0][0]), "+v"(gb[0][1]), "+v"(gb[1][0]), "+v"(gb[1][1]), "+v"(gb[2][0]), "+v"(gb[2][1]) :: "memory");
#pragma unroll
                        for (int m = 0; m < NMF; ++m)
#pragma unroll
                            for (int bj = 0; bj < 2; ++bj) {
                                const unsigned aw[4] = {ga[m][bj].x, ga[m][bj].y, ga[m][bj].z, ga[m][bj].w}, bw[4] = {gb[m][bj].x, gb[m][bj].y, gb[m][bj].z, gb[m][bj].w};
#pragma unroll
                                for (int n = 0; n < 2; ++n) {
                                    f32x4& v = acc[ai][bj][m][n];
                                    v.x *= __uint_as_float(aw[2 * n] << 16) * __builtin_amdgcn_rcpf(__uint_as_float(bw[2 * n] << 16));
                                    v.y *= __uint_as_float(aw[2 * n] & 0xffff0000u) * __builtin_amdgcn_rcpf(__uint_as_float(bw[2 * n] & 0xffff0000u));
                                    v.z *= __uint_as_float(aw[2 * n + 1] << 16) * __builtin_amdgcn_rcpf(__uint_as_float(bw[2 * n + 1] << 16));
                                    v.w *= __uint_as_float(aw[2 * n + 1] & 0xffff0000u) * __builtin_amdgcn_rcpf(__uint_as_float(bw[2 * n + 1] & 0xffff0000u));
                                }
                            }
                    }
                    asm volatile("s_waitcnt vmcnt(0)" ::: "memory");
                }
            }
            const unsigned k1 = (unsigned)(t + 1) * 128u, k2 = last ? 0u : (unsigned)(t + 2) * 128u, k3 = k2 + 128u;
            const GAS char* pA2 = last ? nA : cA; const GAS char* pB2 = last ? nB : cB;
            if constexpr (SP2) {
            PG8_LDB(B0, 0, 0); PG8_LDB(B1, 0, 1); PG8_SCHED; PG8_LDA(At, 0, 0); PG8_STAGE2(PG8_SA(1, 1), cA, k1 + hsA, VC1(0), VC1(1));
            if constexpr (GA) { if (last && has_next) { asm volatile("" ::: "memory"); PG8_GATHER_OFFS(nxt.pm); asm volatile("" ::: "memory"); } }
            PG8_WAIT_V(8); PG8_WAIT_L(0); PG8_BAR; PG8_MMA(0, 0, At, B0); PG8_MMA(0, 1, At, B1); PG8_BAR; PG8_SCHED;
            PG8_LDA(At, 0, 1); PG8_STAGEB(PG8_SB(0, 0), pB2, k2); PG8_STAGEB(PG8_SB(0, 1), pB2, k2 + hsB); PG8_STAGE2(PG8_SA(0, 0), pA2, k2, VN0(0), VN0(1));
            PG8_WAIT_V(8); PG8_WAIT_L(0); PG8_BAR; PG8_MMA(1, 0, At, B0); PG8_MMA(1, 1, At, B1); PG8_BAR; PG8_SCHED;
            PG8_LDB(B0, 1, 0); PG8_LDB(B1, 1, 1); PG8_SCHED; PG8_LDA(At, 1, 0); PG8_STAGE2(PG8_SA(0, 1), pA2, k2 + hsA, VN1(0), VN1(1));
            PG8_WAIT_V(8); PG8_WAIT_L(0); PG8_BAR; PG8_MMA(0, 0, At, B0); PG8_MMA(0, 1, At, B1); PG8_BAR; PG8_SCHED;
            PG8_LDA(At, 1, 1); PG8_STAGEB(PG8_SB(1, 0), pB2, k3); PG8_STAGEB(PG8_SB(1, 1), pB2, k3 + hsB); PG8_STAGE2(PG8_SA(1, 0), pA2, k3, VN0(0), VN0(1));
            PG8_WAIT_V(8); PG8_WAIT_L(0); PG8_BAR; PG8_MMA(1, 0, At, B0); PG8_MMA(1, 1, At, B1); PG8_BAR; PG8_SCHED;
            } else {
            PG8_LDB(B0, 0, 0); PG8_SCHED; PG8_LDA(At, 0, 0); PG8_STAGE2(PG8_SA(1, 1), cA, k1 + hsA, VC1(0), VC1(1));
            if constexpr (GA) { if (last && has_next) { asm volatile("" ::: "memory"); PG8_GATHER_OFFS(nxt.pm); asm volatile("" ::: "memory"); } }
            PG8_WAIT_L(8); PG8_BAR; PG8_WAIT_L(0); PG8_MMA(0, 0, At, B0); PG8_BAR; PG8_SCHED;
            PG8_LDB(B1, 0, 1); PG8_STAGEB(PG8_SB(0, 0), pB2, k2);
            PG8_BAR; PG8_WAIT_L(0); PG8_MMA(0, 1, At, B1); PG8_BAR;
            PG8_LDA(At, 0, 1); PG8_STAGE2(PG8_SA(0, 0), pA2, k2, VN0(0), VN0(1));
            PG8_BAR; PG8_WAIT_L(0); PG8_MMA(1, 0, At, B0); PG8_BAR; PG8_SCHED;
            PG8_STAGEB(PG8_SB(0, 1), pB2, k2 + hsB);
            PG8_WAIT_V(6); PG8_BAR; PG8_MMA(1, 1, At, B1); PG8_BAR;
            PG8_LDB(B0, 1, 0); PG8_SCHED; PG8_LDA(At, 1, 0); PG8_STAGE2(PG8_SA(0, 1), pA2, k2 + hsA, VN1(0), VN1(1));
            PG8_WAIT_L(8); PG8_BAR; PG8_WAIT_L(0); PG8_MMA(0, 0, At, B0); PG8_BAR; PG8_SCHED;
            PG8_LDB(B1, 1, 1); PG8_STAGEB(PG8_SB(1, 0), pB2, k3);
            PG8_BAR; PG8_WAIT_L(0); PG8_MMA(0, 1, At, B1); PG8_BAR;
            PG8_LDA(At, 1, 1); PG8_STAGE2(PG8_SA(1, 0), pA2, k3, VN0(0), VN0(1));
            PG8_BAR; PG8_WAIT_L(0); PG8_MMA(1, 0, At, B0); PG8_BAR; PG8_SCHED;
            PG8_STAGEB(PG8_SB(1, 1), pB2, k3 + hsB);
            PG8_WAIT_V(6); PG8_BAR; PG8_MMA(1, 1, At, B1); PG8_BAR;
                    }
        }
        if constexpr (ALIGN_EPI) { if (wr == 0) PG8_BAR; }
#ifndef REP_EPI
#define REP_EPI 1
#endif
#pragma unroll 1
        for (int rpe = 0; rpe < ((Epi::COLVEC && Epi::BASE) ? 1 : REP_EPI); ++rpe) {
            int epm = cur.pm, epn = cur.pn; asm volatile("" : "+s"(epm), "+s"(epn));
            unsigned eln = (unsigned)lane; asm volatile("" : "+v"(eln)); const int efr = (int)(eln & 15u), efq = (int)(eln >> 4);
            constexpr bool PM = Epi::PERM;
#define PG8_COL(bj, n) (epn * BM + (bj) * HALF + wc * 32 + (PM ? 8 * efq + 4 * (n) : (n) * 16 + 4 * efq))
            f32x4 cv[2][2];
#pragma unroll
            for (int bj = 0; bj < 2; ++bj)
#pragma unroll
                for (int n = 0; n < 2; ++n) { if constexpr (Epi::COLVEC) cv[bj][n] = E.colvec(epm * MR, PG8_COL(bj, n)); else cv[bj][n] = (f32x4){0.f, 0.f, 0.f, 0.f}; }
            if constexpr (Epi::COLVEC) asm volatile("" : "+v"(cv[0][0]), "+v"(cv[0][1]), "+v"(cv[1][0]), "+v"(cv[1][1]) :: "memory");
            constexpr bool CV2 = Epi::COLVEC && Epi::ROWCV && MR != 256;
            f32x4 cv2[2][2];
            if constexpr (CV2) {
#pragma unroll
                for (int bj = 0; bj < 2; ++bj)
#pragma unroll
                    for (int n = 0; n < 2; ++n) cv2[bj][n] = E.colvec(epm * MR + MR - 1, PG8_COL(bj, n));
                asm volatile("" : "+v"(cv2[0][0]), "+v"(cv2[0][1]), "+v"(cv2[1][0]), "+v"(cv2[1][1]) :: "memory");
            }
#pragma unroll
            for (int ai = 0; ai < 2; ++ai) {
                f32x4 bs[4][2][2];
                if constexpr (Epi::BASE) {
#pragma unroll
                    for (int m = 0; m < NMF; ++m)
#pragma unroll
                        for (int bj = 0; bj < 2; ++bj) {
                            const int row = epm * MR + ai * HR + wr * WRR + m * 16 + efr;
                            if constexpr (PM) E.base8(row, PG8_COL(bj, 0), bs[m][bj][0], bs[m][bj][1]);
                            else {
#pragma unroll
                                for (int n = 0; n < 2; ++n) bs[m][bj][n] = E.base(row, PG8_COL(bj, n));
                            }
                        }
                    if constexpr (NMF == 4) asm volatile("" : "+v"(bs[0][0][0]), "+v"(bs[0][0][1]), "+v"(bs[0][1][0]), "+v"(bs[0][1][1]), "+v"(bs[1][0][0]), "+v"(bs[1][0][1]), "+v"(bs[1][1][0]), "+v"(bs[1][1][1]),
                                      "+v"(bs[2][0][0]), "+v"(bs[2][0][1]), "+v"(bs[2][1][0]), "+v"(bs[2][1][1]), "+v"(bs[3][0][0]), "+v"(bs[3][0][1]), "+v"(bs[3][1][0]), "+v"(bs[3][1][1]) :: "memory");
                    else asm volatile("" : "+v"(bs[0][0][0]), "+v"(bs[0][0][1]), "+v"(bs[0][1][0]), "+v"(bs[0][1][1]), "+v"(bs[1][0][0]), "+v"(bs[1][0][1]), "+v"(bs[1][1][0]), "+v"(bs[1][1][1]),
                                      "+v"(bs[2][0][0]), "+v"(bs[2][0][1]), "+v"(bs[2][1][0]), "+v"(bs[2][1][1]) :: "memory");
                }
#pragma unroll
                for (int m = 0; m < NMF; ++m) {
                    const int row = epm * MR + ai * HR + wr * WRR + m * 16 + efr;
                    bool alt = false; if constexpr (CV2) alt = E.rowgrp(epm * MR + ai * HR + wr * WRR + m * 16) != E.rowgrp(epm * MR);
#pragma unroll
                    for (int bj = 0; bj < 2; ++bj) {
                        if constexpr (Epi::PAIR) E.store_pair(row, epn * (BM / 2) + bj * (HALF / 2) + wc * 16 + 4 * efq, acc[ai][bj][m][0], acc[ai][bj][m][1]);
                        else if constexpr (PM) {
                            f32x4 b0 = (f32x4){0.f, 0.f, 0.f, 0.f}, b1 = b0; if constexpr (Epi::BASE) { b0 = bs[m][bj][0]; b1 = bs[m][bj][1]; }
                            E.store8(row, PG8_COL(bj, 0), acc[ai][bj][m][0], acc[ai][bj][m][1], (CV2 && alt) ? cv2[bj][0] : cv[bj][0], (CV2 && alt) ? cv2[bj][1] : cv[bj][1], b0, b1);
                        } else {
#pragma unroll
                            for (int n = 0; n < 2; ++n) { f32x4 bb = (f32x4){0.f, 0.f, 0.f, 0.f}; if constexpr (Epi::BASE) bb = bs[m][bj][n]; E.store(row, PG8_COL(bj, n), acc[ai][bj][m][n], (CV2 && alt) ? cv2[bj][n] : cv[bj][n], bb); }
                        }
                    }
                }
            }
#undef PG8_COL
        }
        if (!has_next) break;
#pragma unroll
        for (int a = 0; a < 2; ++a)
#pragma unroll
            for (int b = 0; b < 2; ++b)
#pragma unroll
                for (int m = 0; m < NMF; ++m)
#pragma unroll
                    for (int n = 0; n < 2; ++n) { float zf; asm volatile("v_mov_b32 %0, 0" : "=v"(zf)); acc[a][b][m][n] = (f32x4){zf, zf, zf, zf}; }
        cur = nxt; cB = nB; cA = nA; ++ui;
        if constexpr (ALIGN_EPI) { if (wr == 1) PG8_BAR; }
    }
    PG8_WAIT_V(0);
    if constexpr (!ALIGN_EPI) { if (wr == 0) PG8_BAR; }
    PG8_BAR;
#undef PG8_GATHER_OFFS
#undef VC0
#undef VC1
#undef VN0
#undef VN1
#undef PG8_SA
#undef PG8_SB
#undef PG8_STAGE2
#undef PG8_STAGEB
#undef PG8_LDA
#undef PG8_LDB
#undef PG8_MMA
#undef PG8_WAIT_V
#undef PG8_WAIT_L
#undef PG8_BAR
#undef PG8_SCHED
}
}

template <int MR = 256, class Epi>
__device__ __forceinline__ void gemm_fast(Frame& F, const GAS bf16* A, int lda, const GAS bf16* Bt, int ldb, int K, int M, int N, const Epi& E) {
    pg8::OrderPlainT<MR> S; S.init(M / MR, N / 256, F.G, F.wg);
    pg8::gemm_phase(F.lds, F.tid, A, lda, Bt, ldb, K, S, E);
}

__device__ __forceinline__ void st_bf16x4(GAS bf16* p, f32x4 v) { u32x2 w; w.x = pk2(v.x, v.y); w.y = pk2(v.z, v.w); *(GAS u32x2*)p = w; }
__device__ __forceinline__ f32x4 ld_bf16x4(const GAS bf16* p) { const u32x2 w = *(const GAS u32x2*)p; f32x4 v; v.x = __uint_as_float(w.x << 16); v.y = __uint_as_float(w.x & 0xffff0000u); v.z = __uint_as_float(w.y << 16); v.w = __uint_as_float(w.y & 0xffff0000u); return v; }

__device__ __forceinline__ void st_bf16x8(GAS bf16* p, f32x4 a, f32x4 b) { u32x4 w; w.x = pk2(a.x, a.y); w.y = pk2(a.z, a.w); w.z = pk2(b.x, b.y); w.w = pk2(b.z, b.w); *(GAS u32x4*)p = w; }
struct EpiWin {
    static constexpr bool HORNER = false, PAIR = false, COLVEC = true, BASE = false, PERM = true, ROWCV = false;
    const GAS float* bias; GAS bf16 *hytl, *hytc, *ret, *ml; GAS float* mlg;
    __device__ __forceinline__ f32x4 colvec(int, int col) const { return *(const GAS f32x4*)(bias + col); }
    __device__ __forceinline__ void store8(int row, int col, f32x4 v0, f32x4 v1, f32x4 c0, f32x4 c1, f32x4, f32x4) const {
        v0 += c0; v1 += c1;
        if (col < 1152) {
            const float v[8] = {v0.x, v0.y, v0.z, v0.w, v1.x, v1.y, v1.z, v1.w};
            if (row < TOKL) { const int b = row >> 11, t = row & 2047; GAS bf16* d = hytl + ((size_t)(b * 1152 + col)) * 2048 + t;
#pragma unroll
                for (int j = 0; j < 8; ++j) d[2048 * j] = (bf16)f2bf(v[j]); }
            else { const int r = row - TOKL, b = r >> 8, t = r & 255; GAS bf16* d = hytc + ((size_t)(b * 1152 + col)) * 256 + t;
#pragma unroll
                for (int j = 0; j < 8; ++j) d[256 * j] = (bf16)f2bf(v[j]); }
        } else if (col < 1168) { *(GAS f32x4*)(mlg + (size_t)row * 16 + (col - 1152)) = v0; *(GAS f32x4*)(mlg + (size_t)row * 16 + (col - 1152) + 4) = v1; }
        else if (col < 1280) { }
        else if (col < 2816) st_bf16x8(ret + (size_t)row * 1536 + (col - 1280), v0, v1);
        else st_bf16x8(ml + (size_t)row * 1024 + (col - 2816), v0, v1);
    }
};
struct EpiGate {
    static constexpr bool HORNER = false, PAIR = false, COLVEC = true, BASE = false, PERM = true, ROWCV = false;
    const GAS float* bias; GAS bf16* gates;
    __device__ __forceinline__ f32x4 colvec(int, int col) const { return *(const GAS f32x4*)(bias + col); }
    __device__ __forceinline__ void store8(int row, int col, f32x4 v0, f32x4 v1, f32x4 c0, f32x4 c1, f32x4, f32x4) const {
        v0 += c0; v1 += c1;
        f32x4 g0, g1;
        g0.x = fmaxf(sigmoidf_(v0.x), 1e-20f); g0.y = fmaxf(sigmoidf_(v0.y), 1e-20f); g0.z = fmaxf(sigmoidf_(v0.z), 1e-20f); g0.w = fmaxf(sigmoidf_(v0.w), 1e-20f);
        g1.x = fmaxf(sigmoidf_(v1.x), 1e-20f); g1.y = fmaxf(sigmoidf_(v1.y), 1e-20f); g1.z = fmaxf(sigmoidf_(v1.z), 1e-20f); g1.w = fmaxf(sigmoidf_(v1.w), 1e-20f);
        st_bf16x8(gates + (size_t)row * NGATE + col, g0, g1);
    }
};
struct EpiUp {
    static constexpr bool HORNER = true, PAIR = false, COLVEC = false, BASE = true, PERM = true, ROWCV = false;
    const GAS bf16* gates; GAS bf16* acc_out;
    __device__ __forceinline__ u32x4 gate8(int which, int row, int col) const { return *(const GAS u32x4*)(gates + (size_t)row * NGATE + which * 1024 + col); }
    __device__ __forceinline__ void base8(int row, int col, f32x4& b0, f32x4& b1) const {
        const u32x4 w = *(const GAS u32x4*)(gates + (size_t)row * NGATE + 2048 + col);
        b0.x = __uint_as_float(w.x << 16); b0.y = __uint_as_float(w.x & 0xffff0000u); b0.z = __uint_as_float(w.y << 16); b0.w = __uint_as_float(w.y & 0xffff0000u);
        b1.x = __uint_as_float(w.z << 16); b1.y = __uint_as_float(w.z & 0xffff0000u); b1.z = __uint_as_float(w.w << 16); b1.w = __uint_as_float(w.w & 0xffff0000u);
    }
    __device__ __forceinline__ void store8(int row, int col, f32x4 v0, f32x4 v1, f32x4, f32x4, f32x4 g0, f32x4 g1) const { st_bf16x8(acc_out + (size_t)row * D + col, v0 * g0, v1 * g1); }
};
template <bool IN_BF16>
struct EpiResidT {
    static constexpr bool HORNER = false, PAIR = false, COLVEC = true, BASE = true, PERM = true, ROWCV = true;
    const GAS void *xin_l, *xin_c; GAS bf16 *xout_l, *xout_c; const GAS float* modbase; int which;
    __device__ __forceinline__ int rowgrp(int row) const { return row < TOKL ? (row >> 11) : 16; }
    __device__ __forceinline__ f32x4 colvec(int row0, int col) const { const int r = row0 < TOKL ? (row0 >> 11) : 16; return *(const GAS f32x4*)(modbase + ((size_t)r * 6 + which) * 1024 + col); }
    __device__ __forceinline__ void base8(int row, int col, f32x4& b0, f32x4& b1) const {
        const size_t o = row < TOKL ? (size_t)row * D + col : (size_t)(row - TOKL) * D + col;
        if constexpr (IN_BF16) {
            const u32x4 w = *(const GAS u32x4*)((const GAS bf16*)(row < TOKL ? xin_l : xin_c) + o);
            b0.x = __uint_as_float(w.x << 16); b0.y = __uint_as_float(w.x & 0xffff0000u); b0.z = __uint_as_float(w.y << 16); b0.w = __uint_as_float(w.y & 0xffff0000u);
            b1.x = __uint_as_float(w.z << 16); b1.y = __uint_as_float(w.z & 0xffff0000u); b1.z = __uint_as_float(w.w << 16); b1.w = __uint_as_float(w.w & 0xffff0000u);
        } else { const GAS float* p = (const GAS float*)(row < TOKL ? xin_l : xin_c) + o; b0 = *(const GAS f32x4*)p; b1 = *(const GAS f32x4*)(p + 4); }
    }
    __device__ __forceinline__ void store8(int row, int col, f32x4 v0, f32x4 v1, f32x4 c0, f32x4 c1, f32x4 b0, f32x4 b1) const {
        st_bf16x8(row < TOKL ? xout_l + (size_t)row * D + col : xout_c + (size_t)(row - TOKL) * D + col, b0 + c0 * v0, b1 + c1 * v1);
    }
};
struct EpiSwiglu {
    static constexpr bool HORNER = false, PAIR = true, COLVEC = false, BASE = false, PERM = false, ROWCV = false;
    GAS bf16* act; int row_off;
    __device__ __forceinline__ void store_pair(int row, int col, f32x4 a, f32x4 b) const {
        f32x4 o; o.x = siluf_(a.x) * b.x; o.y = siluf_(a.y) * b.y; o.z = siluf_(a.z) * b.z; o.w = siluf_(a.w) * b.w;
        st_bf16x4(act + (size_t)(row - row_off) * DFF + col, o);
    }
    __device__ __forceinline__ void store(int, int, f32x4, f32x4, f32x4) const {}
};
struct EpiBf16Out {
    static constexpr bool HORNER = false, PAIR = false, COLVEC = false, BASE = false, PERM = true, ROWCV = false;
    GAS bf16* out; int ld; int row_add;
    __device__ __forceinline__ void store8(int row, int col, f32x4 v0, f32x4 v1, f32x4, f32x4, f32x4, f32x4) const { st_bf16x8(out + (size_t)(row + row_add) * ld + col, v0, v1); }
};

template <int L>
__device__ __forceinline__ void hyena_unit_fast(Frame& F, int layer, int c, int cn  , const GAS bf16* hyt  , const GAS bf16* ft  , GAS bf16* yht  ) {
    constexpr int ZP = (L + 8) * 2;
    constexpr int PER = L / 32;
    constexpr int I = L / 128;
    constexpr int SPAN = L / 4, NSTEP = L / 32;
    constexpr int CP = (2 * L + 8) * 2;
    LAS unsigned char* zimg = F.lds;
    LAS unsigned char* cpy = F.lds + 16 * ZP;
    const GAS float* cw = inp(F, I_HYCONV) + layer * 3 * 1152;
    const GAS float* skip = inp(F, I_HYSKIP) + layer * 2 * 384;
    const int lane = F.lane, fr = lane & 15, fq = lane >> 4, w = F.wave;
    { unsigned long long a_ = (unsigned long long)hyt, b_ = (unsigned long long)yht; asm volatile("" : "+s"(a_), "+s"(b_)); hyt = (const GAS bf16*)a_; yht = (GAS bf16*)b_; }
    __syncthreads();
    {
        const int b = F.tid >> 5, sg = F.tid & 31, t0 = sg * PER; const GAS bf16* src = hyt + ((size_t)(b * 1152 + c)) * L + t0;
        const float w0 = cw[c], w1 = cw[1152 + c], w2 = cw[2304 + c];
        u32x4 raw[PER / 8];
#pragma unroll
        for (int j = 0; j < PER / 8; ++j) raw[j] = *(const GAS u32x4*)(src + 8 * j);
        float prev = t0 > 0 ? bf2f(src[-1]) : 0.f;
        const float nextv = t0 + PER < L ? bf2f(src[PER]) : 0.f;
#pragma unroll
        for (int j = 0; j < PER / 8; ++j) {
            const unsigned wv[4] = {raw[j].x, raw[j].y, raw[j].z, raw[j].w};
            float x[10]; x[0] = prev;
#pragma unroll
            for (int q = 0; q < 4; ++q) { x[1 + 2 * q] = __uint_as_float(wv[q] << 16); x[2 + 2 * q] = __uint_as_float(wv[q] & 0xffff0000u); }
            if (j + 1 < PER / 8) x[9] = __uint_as_float(raw[(j + 1 < PER / 8) ? j + 1 : j].x << 16); else x[9] = nextv;
            u32x4 o;
            o.x = pk2(w0 * x[0] + w1 * x[1] + w2 * x[2], w0 * x[1] + w1 * x[2] + w2 * x[3]); o.y = pk2(w0 * x[2] + w1 * x[3] + w2 * x[4], w0 * x[3] + w1 * x[4] + w2 * x[5]);
            o.z = pk2(w0 * x[4] + w1 * x[5] + w2 * x[6], w0 * x[5] + w1 * x[6] + w2 * x[7]); o.w = pk2(w0 * x[6] + w1 * x[7] + w2 * x[8], w0 * x[7] + w1 * x[8] + w2 * x[9]);
            *(LAS u32x4*)(zimg + b * ZP + (t0 + 8 * j) * 2) = o;
            prev = x[8];
        }
    }
    const int tbase = SPAN * (w >> 1) + 16 * (w & 1);
    const int flane = L - tbase + 8 * fq - fr;
    const int msh = fr & 7;
    const LAS unsigned char* fbase = cpy + msh * CP + 2 * (flane + msh);
#pragma unroll 1
    for (int o = 0; o < 2; ++o) {
        const GAS bf16* fsrc = ft + ((size_t)(o * 384 + c)) * (2 * L);
        for (int i = F.tid; i < CP / 16; i += NTHR) { u32x4 v = (u32x4){0u, 0u, 0u, 0u}; if (i < 2 * L / 8) v = *(const GAS u32x4*)(fsrc + 8 * i); if (i == 0) v.x &= 0xffff0000u; *(LAS u32x4*)(cpy + 16 * i) = v; }
        __syncthreads();
        for (int task = F.tid; task < 7 * (CP / 16); task += NTHR) {
            const int m = 1 + task / (CP / 16), x8 = task % (CP / 16);
            unsigned short e[8];
#pragma unroll
            for (int i = 0; i < 8; ++i) { const int idx = 8 * x8 - m + i; e[i] = idx >= 0 ? *(const LAS unsigned short*)(cpy + 2 * idx) : (unsigned short)0; }
            u32x4 v; v.x = e[0] | ((unsigned)e[1] << 16); v.y = e[2] | ((unsigned)e[3] << 16); v.z = e[4] | ((unsigned)e[5] << 16); v.w = e[6] | ((unsigned)e[7] << 16);
            *(LAS u32x4*)(cpy + m * CP + 16 * x8) = v;
        }
        __syncthreads();
        f32x4 acc[I];
#pragma unroll
        for (int i = 0; i < I; ++i) acc[i] = (f32x4){0.f, 0.f, 0.f, 0.f};
        bf16x8 ring[I];
#pragma unroll
        for (int i = 1; i < I; ++i) ring[(I - i) % I] = *(const LAS bf16x8*)(fbase - 64 * i);
        bf16x8 nf = *(const LAS bf16x8*)(fbase);
        const LAS unsigned char* zrow = zimg + fr * ZP + 16 * fq;
        unsigned tc0 = 0u, tc1 = 0u, tc2 = 0u;
#ifndef NO_TOUCH
        { const int tb = F.tid >> 5, tsg = F.tid & 31;
          tc0 = *(const GAS unsigned*)(hyt + ((size_t)(tb * 1152 + (o == 0 ? 384 : 768) + c)) * L + tsg * (L / 32));
          if (o == 0) { if (F.tid < L / 32) tc1 = *(const GAS unsigned*)(ft + ((size_t)(384 + c)) * (2 * L) + F.tid * 64); }
          else if (cn >= 0) { tc1 = *(const GAS unsigned*)(hyt + ((size_t)(tb * 1152 + cn)) * L + tsg * (L / 32)); if (F.tid < L / 32) tc2 = *(const GAS unsigned*)(ft + (size_t)cn * (2 * L) + F.tid * 64); } }
#endif
#pragma unroll 1
        for (int j0 = 0; j0 < NSTEP; j0 += I) {
#pragma unroll
            for (int jj = 0; jj < I; ++jj) {
                const int j = j0 + jj;
                ring[jj] = nf;
                if (j + 1 < NSTEP) nf = *(const LAS bf16x8*)(fbase + 64 * (j + 1));
                const bf16x8 zf = *(const LAS bf16x8*)(zrow + 64 * j);
#pragma unroll
                for (int i = 0; i < I; ++i) acc[i] = __builtin_amdgcn_mfma_f32_16x16x32_bf16(ring[(jj - i + I) % I], zf, acc[i], 0, 0, 0);
            }
        }
        unsigned el_ = (unsigned)lane; asm volatile("" : "+v"(el_)); const int efr = (int)(el_ & 15u), efq = (int)(el_ >> 4);
        const int etb = SPAN * (w >> 1) + 16 * (w & 1);
        const int gcol = (o == 0 ? 384 : 768) + c;
        const GAS bf16* gsrc = hyt + ((size_t)(efr * 1152 + gcol)) * L;
        const float w0 = cw[gcol], w1 = cw[1152 + gcol], w2 = cw[2304 + gcol], sk = skip[o * 384 + c];
        GAS bf16* dst = yht + ((size_t)(efr * 384 + c)) * L;
        constexpr int GI = I < 8 ? I : 8;
#pragma unroll
        for (int i0 = 0; i0 < I; i0 += GI) {
            u32x2 grv[GI]; unsigned short gmv[GI], gpv[GI];
#pragma unroll
            for (int ii = 0; ii < GI; ++ii) {
                const int t = etb + 32 * (i0 + ii) + 4 * efq;
                grv[ii] = *(const GAS u32x2*)(gsrc + t); gmv[ii] = t > 0 ? gsrc[t - 1] : (unsigned short)0; gpv[ii] = t + 4 < L ? gsrc[t + 4] : (unsigned short)0;
            }
            asm volatile("" ::: "memory");
#pragma unroll
            for (int ii = 0; ii < GI; ++ii) {
                const int i = i0 + ii;
                const int t = etb + 32 * i + 4 * efq;
                const u32x2 zr = *(const LAS u32x2*)(zimg + efr * ZP + t * 2);
                const u32x2 gr = grv[ii];
                const float gm = bf2f(gmv[ii]), gp = bf2f(gpv[ii]);
                const float g0 = __uint_as_float(gr.x << 16), g1 = __uint_as_float(gr.x & 0xffff0000u), g2 = __uint_as_float(gr.y << 16), g3 = __uint_as_float(gr.y & 0xffff0000u);
                const float z0 = __uint_as_float(zr.x << 16), z1 = __uint_as_float(zr.x & 0xffff0000u), z2 = __uint_as_float(zr.y << 16), z3 = __uint_as_float(zr.y & 0xffff0000u);
                const float o0 = (w0 * gm + w1 * g0 + w2 * g1) * (acc[i].x + sk * z0), o1 = (w0 * g0 + w1 * g1 + w2 * g2) * (acc[i].y + sk * z1);
                const float o2 = (w0 * g1 + w1 * g2 + w2 * g3) * (acc[i].z + sk * z2), o3 = (w0 * g2 + w1 * g3 + w2 * gp) * (acc[i].w + sk * z3);
                acc[i] = (f32x4){o0, o1, o2, o3};
            }
        }
        __syncthreads();
        { unsigned tk = tc0 ^ tc1 ^ tc2; asm volatile("" :: "v"(tk)); }
#pragma unroll
        for (int i = 0; i < I; ++i) {
            const int t = etb + 32 * i + 4 * efq;
            u32x2 ov; ov.x = pk2(acc[i].x, acc[i].y); ov.y = pk2(acc[i].z, acc[i].w);
            if (o == 0) *(LAS u32x2*)(zimg + efr * ZP + t * 2) = ov;
            else *(GAS u32x2*)(dst + t) = ov;
        }
    }
}

#ifndef REP_CH
#define REP_CH 1
#endif
#ifndef REP_CH_ML
#define REP_CH_ML REP_CH
#endif
#ifndef REP_CH_RET
#define REP_CH_RET REP_CH
#endif
constexpr int CH_PITCH = 144;
constexpr int CH_IMG = 64 * CH_PITCH;
constexpr int CH_WAVE_LDS = 3 * CH_IMG + 1024 + 512;
__device__ __forceinline__ void ds_tr16x8(unsigned addr, u32x2 (&lo)[4], u32x2 (&hi)[4]) {
    asm volatile("ds_read_b64_tr_b16 %0, %8\n\tds_read_b64_tr_b16 %1, %8 offset:32\n\tds_read_b64_tr_b16 %2, %8 offset:64\n\tds_read_b64_tr_b16 %3, %8 offset:96\n\t"
                 "ds_read_b64_tr_b16 %4, %8 offset:2304\n\tds_read_b64_tr_b16 %5, %8 offset:2336\n\tds_read_b64_tr_b16 %6, %8 offset:2368\n\tds_read_b64_tr_b16 %7, %8 offset:2400\n\t"
                 "s_waitcnt lgkmcnt(0)"
                 : "=&v"(lo[0]), "=&v"(lo[1]), "=&v"(lo[2]), "=&v"(lo[3]), "=&v"(hi[0]), "=&v"(hi[1]), "=&v"(hi[2]), "=&v"(hi[3]) : "v"(addr) : "memory");
}
static_assert(16 * CH_PITCH == 2304, "ds_tr16x8 offsets");
__device__ __forceinline__ void ds_tr16x4(unsigned addr, u32x2 (&lo)[2], u32x2 (&hi)[2]) {
    asm volatile("ds_read_b64_tr_b16 %0, %4\n\tds_read_b64_tr_b16 %1, %4 offset:32\n\tds_read_b64_tr_b16 %2, %4 offset:2304\n\tds_read_b64_tr_b16 %3, %4 offset:2336\n\ts_waitcnt lgkmcnt(0)"
                 : "=&v"(lo[0]), "=&v"(lo[1]), "=&v"(hi[0]), "=&v"(hi[1]) : "v"(addr) : "memory");
}
__device__ __forceinline__ float log_sigmoid_(float x) { return fminf(x, 0.f) - log1pf(__expf(-fabsf(x))); }
__device__ __forceinline__ bf16x8 mk_frag(u32x2 lo, u32x2 hi) { u32x4 w; w.x = lo.x; w.y = lo.y; w.z = hi.x; w.w = hi.y; return __builtin_bit_cast(bf16x8, w); }

template <bool IS_ML>
__device__ __forceinline__ void chain_fast(Frame& F, int layer, int b, int h, int dir, LAS unsigned char* img, int hf) {
    constexpr int NET = 2;
    const int lane = F.lane, fr = lane & 15, fq = lane >> 4;
    LAS unsigned char* Qi = img; LAS unsigned char* Ki = img + CH_IMG; LAS unsigned char* Vi = img + 2 * CH_IMG;
    const unsigned qa = (unsigned)(size_t)Qi, ka = (unsigned)(size_t)Ki, va = (unsigned)(size_t)Vi;
    const GAS bf16* RET = WSP(const bf16, WS_RET); const GAS bf16* ML = WSP(const bf16, WS_ML); const GAS float* MLG = WSP(const float, WS_MLG);
    const GAS float* rope = WSP(const float, WS_ROPE);
    GAS bf16* Y = WSP(bf16, WS_Y); GAS bf16* OB = WSP(bf16, WS_OB);
    float lgam = 0.f, bi_ = 0.f, bf_ = 0.f;
    if (!IS_ML) lgam = log_sigmoid_(inp(F, I_RETDECAY)[layer * 12 + dir * 6 + h]);
    else { bi_ = inp(F, I_MLGB)[layer * 16 + dir * 8 + h]; bf_ = inp(F, I_MLGB)[layer * 16 + dir * 8 + 4 + h]; }
    const GAS float* mlc = inp(F, I_MLCONV) + layer * 3 * 512;
    f32x4 C[4][NET];
#pragma unroll
    for (int dt = 0; dt < 4; ++dt)
#pragma unroll
        for (int et = 0; et < NET; ++et) C[dt][et] = (f32x4){0.f, 0.f, 0.f, 0.f};
    const int cq = lane & 7, pr0 = lane >> 3;
    LAS float* nvec = (LAS float*)(img + 3 * CH_IMG + 1024 + 256 * hf);
    if (IS_ML) nvec[lane] = 0.f;
    const LAS float* nq = nvec + 4 * fq;
    unsigned sink = 0u;
#pragma unroll 1
    for (int step_ = 0; step_ < 36 * (IS_ML ? REP_CH_ML : REP_CH_RET); ++step_) {
        const int step = step_ % 36;
        if ((IS_ML ? REP_CH_ML : REP_CH_RET) > 1 && step == 0) {
            if (IS_ML) nvec[lane] = 0.f;
#pragma unroll
            for (int dt = 0; dt < 4; ++dt)
#pragma unroll
                for (int et = 0; et < NET; ++et) C[dt][et] = (f32x4){0.f, 0.f, 0.f, 0.f};
        }
        int rowbase, t0, L; bool lat;
        if (step < 4) { const int cc = dir ? 3 - step : step; rowbase = TOKL + b * LC + cc * 64; t0 = cc * 64; L = LC; lat = false; }
        else { const int cc = dir ? 35 - step : step - 4; rowbase = b * LL + cc * 64; t0 = cc * 64; L = LL; lat = true; }
        float g_i = 0.f, g_f = 0.f;
        if (IS_ML) { const int tlg = dir ? 63 - lane : lane; const GAS float* gp = MLG + (size_t)(rowbase + tlg) * 16 + dir * 8 + h; g_i = gp[0]; g_f = gp[4]; }
        if constexpr (!IS_ML) {
#pragma unroll
        for (int i4 = 0; i4 < 4; ++i4) {
            const int i = 4 * hf + i4;
            const int p = pr0 + 8 * i, tl = dir ? 63 - p : p, row = rowbase + tl, tpos = t0 + tl;
            float qv[8], kv[8]; u32x4 vraw;
            {
                const GAS bf16* base = RET + (size_t)row * 1536 + h * 64;
                const u32x4 qr = *(const GAS u32x4*)(base + 8 * cq), kr = *(const GAS u32x4*)(base + 384 + 8 * cq); vraw = *(const GAS u32x4*)(base + 768 + 8 * cq);
                const unsigned qw[4] = {qr.x, qr.y, qr.z, qr.w}, kw[4] = {kr.x, kr.y, kr.z, kr.w};
#pragma unroll
                for (int j = 0; j < 4; ++j) { qv[2 * j] = __uint_as_float(qw[j] << 16); qv[2 * j + 1] = __uint_as_float(qw[j] & 0xffff0000u); kv[2 * j] = __uint_as_float(kw[j] << 16); kv[2 * j + 1] = __uint_as_float(kw[j] & 0xffff0000u); }
                if (lat) {
                    const u32x4 qpr = *(const GAS u32x4*)(base + 8 * (cq ^ 2)), kpr = *(const GAS u32x4*)(base + 384 + 8 * (cq ^ 2));
                    const unsigned qpw[4] = {qpr.x, qpr.y, qpr.z, qpr.w}, kpw[4] = {kpr.x, kpr.y, kpr.z, kpr.w};
                    const int half = cq >> 2, hi = (cq >> 1) & 1, i0 = 8 * (cq & 1);
                    const GAS float* rp = rope + tpos * 64 + half * 32 + i0;
                    const f32x4 c0 = *(const GAS f32x4*)(rp), c1 = *(const GAS f32x4*)(rp + 4), s0 = *(const GAS f32x4*)(rp + 16), s1 = *(const GAS f32x4*)(rp + 20);
                    const float cs[8] = {c0.x, c0.y, c0.z, c0.w, c1.x, c1.y, c1.z, c1.w}, sn[8] = {s0.x, s0.y, s0.z, s0.w, s1.x, s1.y, s1.z, s1.w};
#pragma unroll
                    for (int j = 0; j < 8; ++j) {
                        const float qp = (j & 1) ? __uint_as_float(qpw[j >> 1] & 0xffff0000u) : __uint_as_float(qpw[j >> 1] << 16);
                        const float kp = (j & 1) ? __uint_as_float(kpw[j >> 1] & 0xffff0000u) : __uint_as_float(kpw[j >> 1] << 16);
                        qv[j] = hi ? qp * sn[j] + qv[j] * cs[j] : qv[j] * cs[j] - qp * sn[j];
                        kv[j] = hi ? kp * sn[j] + kv[j] * cs[j] : kv[j] * cs[j] - kp * sn[j];
                    }
                }
#pragma unroll
                for (int j = 0; j < 8; ++j) qv[j] *= 0.125f;
            }
            u32x4 qo, ko; qo.x = pk2(qv[0], qv[1]); qo.y = pk2(qv[2], qv[3]); qo.z = pk2(qv[4], qv[5]); qo.w = pk2(qv[6], qv[7]);
            ko.x = pk2(kv[0], kv[1]); ko.y = pk2(kv[2], kv[3]); ko.z = pk2(kv[4], kv[5]); ko.w = pk2(kv[6], kv[7]);
            *(LAS u32x4*)(Qi + p * CH_PITCH + 16 * cq) = qo; *(LAS u32x4*)(Ki + p * CH_PITCH + 16 * cq) = ko; *(LAS u32x4*)(Vi + p * CH_PITCH + 16 * cq) = vraw;
        }
        } else {
            const GAS float* wq = mlc + h * 64 + 8 * cq;
            u32x4 rr[2][3][4], vr[4];
#pragma unroll
            for (int i4 = 0; i4 < 4; ++i4) {
                const int p = pr0 + 8 * (4 * hf + i4), tl = dir ? 63 - p : p, row = rowbase + tl, tpos = t0 + tl;
                const GAS bf16* bb = ML + (size_t)row * 1024 + h * 64 + 8 * cq;
                const u32x4 z4 = (u32x4){0u, 0u, 0u, 0u};
#pragma unroll
                for (int qk = 0; qk < 2; ++qk) {
                    rr[qk][1][i4] = *(const GAS u32x4*)(bb + 256 * qk);
                    rr[qk][0][i4] = tpos > 0 ? *(const GAS u32x4*)(bb + 256 * qk - 1024) : z4;
                    rr[qk][2][i4] = tpos < L - 1 ? *(const GAS u32x4*)(bb + 256 * qk + 1024) : z4;
                }
                vr[i4] = *(const GAS u32x4*)(bb + 512);
            }
#pragma unroll
            for (int qk = 0; qk < 2; ++qk) {
                f32x4 wt[3][2];
#pragma unroll
                for (int tp = 0; tp < 3; ++tp) { wt[tp][0] = *(const GAS f32x4*)(wq + 256 * qk + 512 * tp); wt[tp][1] = *(const GAS f32x4*)(wq + 256 * qk + 512 * tp + 4); }
#pragma unroll
                for (int i4 = 0; i4 < 4; ++i4) {
                    const int p = pr0 + 8 * (4 * hf + i4);
                    const unsigned a0[4] = {rr[qk][0][i4].x, rr[qk][0][i4].y, rr[qk][0][i4].z, rr[qk][0][i4].w}, a1[4] = {rr[qk][1][i4].x, rr[qk][1][i4].y, rr[qk][1][i4].z, rr[qk][1][i4].w},
                                   a2[4] = {rr[qk][2][i4].x, rr[qk][2][i4].y, rr[qk][2][i4].z, rr[qk][2][i4].w};
                    float ov[8];
#pragma unroll
                    for (int j = 0; j < 8; ++j) {
                        const float x0 = (j & 1) ? __uint_as_float(a0[j >> 1] & 0xffff0000u) : __uint_as_float(a0[j >> 1] << 16);
                        const float x1 = (j & 1) ? __uint_as_float(a1[j >> 1] & 0xffff0000u) : __uint_as_float(a1[j >> 1] << 16);
                        const float x2 = (j & 1) ? __uint_as_float(a2[j >> 1] & 0xffff0000u) : __uint_as_float(a2[j >> 1] << 16);
                        const float r = siluf_(wt[0][j >> 2][j & 3] * x0 + wt[1][j >> 2][j & 3] * x1 + wt[2][j >> 2][j & 3] * x2);
                        ov[j] = qk == 0 ? r : r * 0.125f;
                    }
                    u32x4 o; o.x = pk2(ov[0], ov[1]); o.y = pk2(ov[2], ov[3]); o.z = pk2(ov[4], ov[5]); o.w = pk2(ov[6], ov[7]);
                    if (qk == 0) *(LAS u32x4*)(Qi + p * CH_PITCH + 16 * cq) = o;
                    else { *(LAS u32x4*)(Ki + p * CH_PITCH + 16 * cq) = o; *(LAS u32x4*)(Vi + p * CH_PITCH + 16 * cq) = vr[i4]; }
                }
            }
        }
        __builtin_amdgcn_sched_barrier(0);
        float f_p, i_p;
        if (!IS_ML) { f_p = lgam; i_p = 0.f; }
        else { i_p = g_i + bi_; f_p = log_sigmoid_(g_f + bf_); }
        float bsum = f_p;
#pragma unroll
        for (int o = 1; o < 64; o <<= 1) { const float t = lane_read(bsum, lane >= o ? lane - o : lane); if (lane >= o) bsum += t; }
        LAS float* gv = (LAS float*)(img + 3 * CH_IMG);
        const float b63 = __int_as_float(__builtin_amdgcn_readlane(__float_as_int(bsum), 63));
        const float adec = __expf(b63);
        if (hf == 0) { gv[lane] = bsum; gv[64 + lane] = bsum - i_p; gv[128 + lane] = __expf(bsum); gv[192 + lane] = __expf(b63 - (bsum - i_p)); }
        asm volatile("s_waitcnt lgkmcnt(0)" ::: "memory");
        __syncthreads();
        unsigned tch0 = 0u, tch1 = 0u, tch2 = 0u;
#ifndef NO_TOUCH
        if (step + 1 < 36) {
            const int s1 = step + 1; int rb1;
            if (s1 < 4) { const int cc = dir ? 3 - s1 : s1; rb1 = TOKL + b * LC + cc * 64; }
            else { const int cc = dir ? 35 - s1 : s1 - 4; rb1 = b * LL + cc * 64; }
            const int li0 = hf * 96 + lane, li1 = hf * 96 + 64 + (lane & 31);
            if (!IS_ML) {
                tch0 = *(const GAS unsigned*)(RET + (size_t)(rb1 + li0 / 3) * 1536 + h * 64 + (li0 % 3) * 384);
                if (lane < 32) tch1 = *(const GAS unsigned*)(RET + (size_t)(rb1 + li1 / 3) * 1536 + h * 64 + (li1 % 3) * 384);
            } else {
                tch0 = *(const GAS unsigned*)(ML + (size_t)(rb1 + li0 / 3) * 1024 + h * 64 + (li0 % 3) * 256);
                if (lane < 32) tch1 = *(const GAS unsigned*)(ML + (size_t)(rb1 + li1 / 3) * 1024 + h * 64 + (li1 % 3) * 256);
                else if (hf == 0) tch2 = *(const GAS unsigned*)(MLG + (size_t)(rb1 + 2 * (lane & 31)) * 16);
            }
        }
#endif
        const LAS float* gq = gv + 4 * fq;
        const bf16x8 ones = (fr == 0) ? (bf16x8){0x3F80, 0x3F80, 0x3F80, 0x3F80, 0x3F80, 0x3F80, 0x3F80, 0x3F80} : (bf16x8){0, 0, 0, 0, 0, 0, 0, 0};
        const int tr_q = fr >> 2, tr_p = fr & 3;
#ifndef PT_UNROLL
#define PT_UNROLL 2
#endif
#pragma unroll PT_UNROLL
        for (int pt = 0; pt < 4; ++pt) {
            f32x4 ST[4];
            bf16x8 qn[2];
#pragma unroll
            for (int kk = 0; kk < 2; ++kk) qn[kk] = *(const LAS bf16x8*)(Qi + (16 * pt + fr) * CH_PITCH + (32 * kk + 8 * fq) * 2);
#pragma unroll
            for (int st = 0; st < 4; ++st) {
                ST[st] = (f32x4){0.f, 0.f, 0.f, 0.f};
                if (st <= pt) {
#pragma unroll
                    for (int kk = 0; kk < 2; ++kk) { const bf16x8 kf = *(const LAS bf16x8*)(Ki + (16 * st + fr) * CH_PITCH + (32 * kk + 8 * fq) * 2); ST[st] = __builtin_amdgcn_mfma_f32_16x16x32_bf16(kf, qn[kk], ST[st], 0, 0, 0); }
                }
            }
            const float bp = gv[16 * pt + fr];
#pragma unroll
            for (int st = 0; st < 4; ++st) {
                if (st <= pt) {
                    const f32x4 bis = *(const LAS f32x4*)(gq + 64 + 16 * st);
#pragma unroll
                    for (int j = 0; j < 4; ++j) { const int sidx = 16 * st + 4 * fq + j; const float w = (sidx <= 16 * pt + fr) ? __expf(bp - bis[j]) : 0.f; ST[st][j] *= w; }
                }
            }
            __builtin_amdgcn_sched_barrier(0);
            f32x4 acc[NET], accd = (f32x4){0.f, 0.f, 0.f, 0.f};
#pragma unroll
            for (int et = 0; et < NET; ++et) acc[et] = (f32x4){0.f, 0.f, 0.f, 0.f};
#pragma unroll
            for (int kk = 0; kk < 2; ++kk) {
                const u32x2 lo = *(const LAS u32x2*)(Qi + (16 * pt + fr) * CH_PITCH + (32 * kk + 4 * fq) * 2), hi = *(const LAS u32x2*)(Qi + (16 * pt + fr) * CH_PITCH + (32 * kk + 16 + 4 * fq) * 2);
                const bf16x8 qs = mk_frag(lo, hi);
#pragma unroll
                for (int et = 0; et < NET; ++et) {
                    u32x4 w; w.x = pk2(C[2 * kk][et].x, C[2 * kk][et].y); w.y = pk2(C[2 * kk][et].z, C[2 * kk][et].w); w.z = pk2(C[2 * kk + 1][et].x, C[2 * kk + 1][et].y); w.w = pk2(C[2 * kk + 1][et].z, C[2 * kk + 1][et].w);
                    acc[et] = __builtin_amdgcn_mfma_f32_16x16x32_bf16(qs, __builtin_bit_cast(bf16x8, w), acc[et], 0, 0, 0);
                }
                if (IS_ML) {
                    const f32x4 n0 = *(const LAS f32x4*)(nq + 32 * kk), n1 = *(const LAS f32x4*)(nq + 32 * kk + 16);
                    u32x4 w; w.x = pk2(n0.x, n0.y); w.y = pk2(n0.z, n0.w); w.z = pk2(n1.x, n1.y); w.w = pk2(n1.z, n1.w);
                    if (fr != 0) w = (u32x4){0u, 0u, 0u, 0u};
                    accd = __builtin_amdgcn_mfma_f32_16x16x32_bf16(qs, __builtin_bit_cast(bf16x8, w), accd, 0, 0, 0);
                }
            }
            { const f32x4 ap = *(const LAS f32x4*)(gq + 128 + 16 * pt);
#pragma unroll
              for (int j = 0; j < 4; ++j) {
#pragma unroll
                for (int et = 0; et < NET; ++et) acc[et][j] *= ap[j];
                accd[j] *= ap[j]; } }
            __builtin_amdgcn_sched_barrier(0);
#pragma unroll
            for (int kk = 0; kk < 2; ++kk) {
                if (2 * kk <= pt) {
                    u32x4 w; w.x = pk2(ST[2 * kk].x, ST[2 * kk].y); w.y = pk2(ST[2 * kk].z, ST[2 * kk].w); w.z = pk2(ST[2 * kk + 1].x, ST[2 * kk + 1].y); w.w = pk2(ST[2 * kk + 1].z, ST[2 * kk + 1].w);
                    const bf16x8 pf = __builtin_bit_cast(bf16x8, w);
                    u32x2 vlo[2], vhi[2];
                    ds_tr16x4(va + (32 * kk + 4 * fq + tr_q) * CH_PITCH + 8 * tr_p + 64 * hf, vlo, vhi);
#pragma unroll
                    for (int et = 0; et < NET; ++et) acc[et] = __builtin_amdgcn_mfma_f32_16x16x32_bf16(pf, mk_frag(vlo[et], vhi[et]), acc[et], 0, 0, 0);
                    if (IS_ML) accd = __builtin_amdgcn_mfma_f32_16x16x32_bf16(pf, ones, accd, 0, 0, 0);
                }
            }
            __builtin_amdgcn_sched_barrier(0);
#pragma unroll
            for (int j = 0; j < 4; ++j) {
                const int p = 16 * pt + 4 * fq + j, tl = dir ? 63 - p : p, row = rowbase + tl;
                float inv = 1.f;
                if (IS_ML) { const float den = lane_read(accd[j], lane & 48); inv = __builtin_amdgcn_rcpf(fmaxf(fabsf(den), 1.f)); }
                const int cof = (IS_ML ? 384 : 0) + h * 64 + 32 * hf + fr;
                const unsigned boff = dir == 0 ? (unsigned)(row * D + 384 + cof) * 2u : (unsigned)(row * 640 + cof) * 2u;
                GAS char* ob = dir == 0 ? (GAS char*)Y : (GAS char*)OB;
#pragma unroll
                for (int et = 0; et < NET; ++et) *(GAS bf16*)(ob + boff + 32 * et) = (bf16)f2bf(acc[et][j] * inv);
            }
        }
        __builtin_amdgcn_sched_barrier(0);
#pragma unroll
        for (int dt = 0; dt < 4; ++dt)
#pragma unroll
            for (int et = 0; et < NET; ++et) C[dt][et] *= adec;
        f32x4 accn[4];
        if (IS_ML) {
#pragma unroll
            for (int dt = 0; dt < 4; ++dt) { accn[dt] = *(const LAS f32x4*)(nq + 16 * dt) * adec; if (fr != 0) accn[dt] = (f32x4){0.f, 0.f, 0.f, 0.f}; }
        }
#pragma unroll
        for (int kk = 0; kk < 2; ++kk) {
            u32x2 vlo[2], vhi[2], klo[4], khi[4];
            ds_tr16x4(va + (32 * kk + 4 * fq + tr_q) * CH_PITCH + 8 * tr_p + 64 * hf, vlo, vhi);
            ds_tr16x8(ka + (32 * kk + 4 * fq + tr_q) * CH_PITCH + 8 * tr_p, klo, khi);
            const f32x4 wl = *(const LAS f32x4*)(gq + 192 + 32 * kk), wh = *(const LAS f32x4*)(gq + 192 + 32 * kk + 16);
#pragma unroll
            for (int dt = 0; dt < 4; ++dt) {
                u32x4 w;
                w.x = pk2(__uint_as_float(klo[dt].x << 16) * wl[0], __uint_as_float(klo[dt].x & 0xffff0000u) * wl[1]);
                w.y = pk2(__uint_as_float(klo[dt].y << 16) * wl[2], __uint_as_float(klo[dt].y & 0xffff0000u) * wl[3]);
                w.z = pk2(__uint_as_float(khi[dt].x << 16) * wh[0], __uint_as_float(khi[dt].x & 0xffff0000u) * wh[1]);
                w.w = pk2(__uint_as_float(khi[dt].y << 16) * wh[2], __uint_as_float(khi[dt].y & 0xffff0000u) * wh[3]);
                const bf16x8 kf = __builtin_bit_cast(bf16x8, w);
#pragma unroll
                for (int et = 0; et < NET; ++et) C[dt][et] = __builtin_amdgcn_mfma_f32_16x16x32_bf16(kf, mk_frag(vlo[et], vhi[et]), C[dt][et], 0, 0, 0);
                if (IS_ML) accn[dt] = __builtin_amdgcn_mfma_f32_16x16x32_bf16(kf, ones, accn[dt], 0, 0, 0);
            }
        }
        if (IS_ML) { if (fr == 0) {
#pragma unroll
            for (int dt = 0; dt < 4; ++dt) *(LAS f32x4*)(nvec + 4 * fq + 16 * dt) = accn[dt]; } }
        asm volatile("s_waitcnt lgkmcnt(0)" ::: "memory");
        __syncthreads();
        sink ^= tch0 ^ tch1 ^ tch2;
    }
    asm volatile("" :: "v"(sink));
}

#ifndef REP_HY
#define REP_HY 1
#endif
constexpr int NCHWG = 160;
__device__ __forceinline__ void phase_mix(Frame& F, int layer) {
    const bool last = layer == 1;
    const GAS bf16* ftl = WSP(const bf16, WS_FTL) + (size_t)layer * 2 * 384 * 4096;
    if (F.wg < NCHWG) {
        if (F.wave >= 4) {
#pragma unroll 1
            for (int i = 0; i < 72 * (F.wg * 2 < 192 ? REP_CH_RET : REP_CH_ML); ++i) __syncthreads();
        } else {
            const int cl = F.wave >> 1, hf = F.wave & 1, c = F.wg * 2 + cl;
            LAS unsigned char* img = F.lds + cl * CH_WAVE_LDS;
            if (c < 192) { const int b = c / 12, r = c % 12; chain_fast<false>(F, layer, b, r >> 1, r & 1, img, hf); }
            else { const int i = c - 192; chain_fast<true>(F, layer, i >> 3, (i & 7) >> 1, i & 1, img, hf); }
        }
    } else {
        const int nh = F.G - NCHWG, w = F.wg - NCHWG;
#pragma unroll 1
        for (int rp = 0; rp < REP_HY; ++rp)
            for (int u = w; u < 384; u += nh) hyena_unit_fast<LL>(F, layer, u, u + nh < 384 ? u + nh : -1, WSP(const bf16, WS_HYTL), ftl, WSP(bf16, WS_YHTL));
        if (!last) for (int u = w; u < 384; u += nh) hyena_unit_fast<LC>(F, layer, u, u + nh < 384 ? u + nh : -1, WSP(const bf16, WS_HYTC), WSP(const bf16, WS_FTC), WSP(bf16, WS_YHTC));
    }
}

__device__ __forceinline__ void phase_combine(Frame& F, int layer, bool dummy = false) {
    const bool last = layer == 1;
    const int gw = F.wg * NWAVES + F.wave, NGW = F.G * NWAVES, lane = F.lane;
    const int nrows = last ? TOKL : TOK;
    GAS bf16* Y = WSP(bf16, WS_Y); const GAS bf16* OB = WSP(const bf16, WS_OB); const GAS bf16* RET = WSP(const bf16, WS_RET); const GAS bf16* ML = WSP(const bf16, WS_ML);
    const int rsub = lane >> 4, l16 = lane & 15;
    for (int row0 = gw * 4; row0 < nrows; row0 += NGW * 4) {
        const int row = row0 + rsub;
        GAS bf16* yo = dummy ? WSP(bf16, WS_U + 300 * MiB) + (size_t)(row & 8191) * D : Y + (size_t)row * D;
        u32x2 of[10], ob[10], gt[10];
#pragma unroll
        for (int hh = 0; hh < 10; ++hh) {
            const int cof = hh * 64 + 4 * l16;
            of[hh] = *(const GAS u32x2*)(Y + (size_t)row * D + 384 + cof); ob[hh] = *(const GAS u32x2*)(OB + (size_t)row * 640 + cof);
            gt[hh] = hh < 6 ? *(const GAS u32x2*)(RET + (size_t)row * 1536 + 1152 + cof) : *(const GAS u32x2*)(ML + (size_t)row * 1024 + 768 + (cof - 384));
        }
#pragma unroll
        for (int hh = 0; hh < 10; ++hh) {
            float x[4], g[4];
            x[0] = __uint_as_float(of[hh].x << 16) + __uint_as_float(ob[hh].x << 16); x[1] = __uint_as_float(of[hh].x & 0xffff0000u) + __uint_as_float(ob[hh].x & 0xffff0000u);
            x[2] = __uint_as_float(of[hh].y << 16) + __uint_as_float(ob[hh].y << 16); x[3] = __uint_as_float(of[hh].y & 0xffff0000u) + __uint_as_float(ob[hh].y & 0xffff0000u);
            g[0] = __uint_as_float(gt[hh].x << 16); g[1] = __uint_as_float(gt[hh].x & 0xffff0000u); g[2] = __uint_as_float(gt[hh].y << 16); g[3] = __uint_as_float(gt[hh].y & 0xffff0000u);
            float sm = (x[0] + x[1]) + (x[2] + x[3]);
            DPP_ADD(sm, 0xB1); DPP_ADD(sm, 0x4E); DPP_ADD(sm, 0x141); DPP_ADD(sm, 0x140);
            const float mu = sm * (1.f / 64.f);
#pragma unroll
            for (int j = 0; j < 4; ++j) x[j] -= mu;
            float sq = (x[0] * x[0] + x[1] * x[1]) + (x[2] * x[2] + x[3] * x[3]);
            DPP_ADD(sq, 0xB1); DPP_ADD(sq, 0x4E); DPP_ADD(sq, 0x141); DPP_ADD(sq, 0x140);
            const float rs = rsqrtf(sq * (1.f / 64.f) + 1e-6f);
            float o[4];
#pragma unroll
            for (int j = 0; j < 4; ++j) o[j] = x[j] * rs * (hh < 6 ? siluf_(g[j]) : sigmoidf_(g[j]));
            u32x2 w; w.x = pk2(o[0], o[1]); w.y = pk2(o[2], o[3]);
            *(GAS u32x2*)(yo + 384 + hh * 64 + 4 * l16) = w;
        }
    }
    LAS unsigned char* scr = F.lds + F.wave * 8704;
    const int nitL = NB * 6 * 32, nitC = last ? 0 : NB * 6 * 4;
    for (int it = gw; it < nitL + nitC; it += NGW) {
        const GAS bf16* src; int L, rowbase, b, cb, tb;
        if (it < nitL) { b = it / 192; const int r = it % 192; cb = r / 32; tb = r % 32; L = LL; src = WSP(const bf16, WS_YHTL); rowbase = b * LL; }
        else { const int i2 = it - nitL; b = i2 / 24; const int r = i2 % 24; cb = r / 4; tb = r % 4; L = LC; src = WSP(const bf16, WS_YHTC); rowbase = TOKL + b * LC; }
        u32x4 v[8];
#pragma unroll
        for (int i = 0; i < 8; ++i) { const int cc = (lane >> 3) + 8 * i; v[i] = *(const GAS u32x4*)(src + ((size_t)(b * 384 + cb * 64 + cc)) * L + tb * 64 + 8 * (lane & 7)); }
#pragma unroll
        for (int i = 0; i < 8; ++i) { const int cc = (lane >> 3) + 8 * i; *(LAS u32x4*)(scr + cc * 136 + 16 * (lane & 7)) = v[i]; }
        asm volatile("s_waitcnt lgkmcnt(0)" ::: "memory");
#pragma unroll
        for (int i = 0; i < 8; ++i) {
            const int tt = (lane >> 3) + 8 * i, c8 = 8 * (lane & 7);
            unsigned short e[8];
#pragma unroll
            for (int j = 0; j < 8; ++j) e[j] = *(const LAS unsigned short*)(scr + (c8 + j) * 136 + tt * 2);
            u32x4 o; o.x = e[0] | ((unsigned)e[1] << 16); o.y = e[2] | ((unsigned)e[3] << 16); o.z = e[4] | ((unsigned)e[5] << 16); o.w = e[6] | ((unsigned)e[7] << 16);
            *(GAS u32x4*)((dummy ? WSP(bf16, WS_U + 300 * MiB) : Y) + (size_t)(dummy ? ((rowbase + tb * 64 + tt) & 8191) : (rowbase + tb * 64 + tt)) * D + cb * 64 + c8) = o;
        }
        asm volatile("s_waitcnt lgkmcnt(0)" ::: "memory");
    }
}

__device__ __forceinline__ void phase_norm_router(Frame& F) {
    const int gw = F.wg * NWAVES + F.wave, lane = F.lane;
    const GAS float* g = inp(F, I_GFFN) + 1 * D; const GAS float* wr = inp(F, I_ROUTER); const GAS float* br = inp(F, I_ROUTERB);
    GAS unsigned* cnt = WSP(unsigned, WS_CTL) + CW_CNT;
    const int r0 = gw * 16, r1 = r0 + 16;
    f32x4 gm[4], sh[4], w0r[4][4], w1r[4][4]; u32x2 ring[4][4];
    { const GAS float* shp = mod_ptr(F, 1, r0, 3); const GAS float* scp = mod_ptr(F, 1, r0, 4);
#pragma unroll
      for (int j = 0; j < 4; ++j) { const f32x4 gg = *(const GAS f32x4*)(g + 256 * j + 4 * lane), sc = *(const GAS f32x4*)(scp + 256 * j + 4 * lane); sh[j] = *(const GAS f32x4*)(shp + 256 * j + 4 * lane);
          gm[j].x = gg.x * (1.f + sc.x); gm[j].y = gg.y * (1.f + sc.y); gm[j].z = gg.z * (1.f + sc.z); gm[j].w = gg.w * (1.f + sc.w);
#pragma unroll
          for (int i = 0; i < 4; ++i) { const int k = 256 * j + 4 * lane + i; w0r[j][i] = *(const GAS f32x4*)(wr + k * 8); w1r[j][i] = *(const GAS f32x4*)(wr + k * 8 + 4); } }
#pragma unroll
      for (int i = 0; i < 4; ++i) xrow_issue<true>(F, r0 + i, 2, lane, ring[i]); }
    float brr[8];
#pragma unroll
    for (int e = 0; e < 8; ++e) brr[e] = br[e];
#pragma unroll 1
    for (int rb = r0; rb < r1; rb += 4) {
#pragma unroll
      for (int i = 0; i < 4; ++i) {
        const int row = rb + i;
        f32x4 v[4]; float s = 0.f;
#pragma unroll
        for (int j = 0; j < 4; ++j) { v[j] = xrow_unpack(ring[i][j]); s += (v[j].x * v[j].x + v[j].y * v[j].y) + (v[j].z * v[j].z + v[j].w * v[j].w); }
        if (row + 4 < r1) xrow_issue<true>(F, row + 4, 2, lane, ring[i]);
        const float r = rsqrtf(wave_sum(s) * (1.0f / 1024.0f) + 1e-6f);
        GAS bf16* orow = WSP(bf16, WS_H) + (size_t)row * D;
        float lg[8];
#pragma unroll
        for (int e = 0; e < 8; ++e) lg[e] = 0.f;
#pragma unroll
        for (int j = 0; j < 4; ++j) {
            f32x4 o; o.x = v[j].x * r * gm[j].x + sh[j].x; o.y = v[j].y * r * gm[j].y + sh[j].y; o.z = v[j].z * r * gm[j].z + sh[j].z; o.w = v[j].w * r * gm[j].w + sh[j].w;
            u32x2 w; w.x = pk2(o.x, o.y); w.y = pk2(o.z, o.w);
            *(GAS u32x2*)(orow + 256 * j + 4 * lane) = w;
            const float xo[4] = {o.x, o.y, o.z, o.w};
#pragma unroll
            for (int i = 0; i < 4; ++i) { const float x = xo[i]; const f32x4 w0 = w0r[j][i], w1 = w1r[j][i];
                lg[0] += x * w0.x; lg[1] += x * w0.y; lg[2] += x * w0.z; lg[3] += x * w0.w; lg[4] += x * w1.x; lg[5] += x * w1.y; lg[6] += x * w1.z; lg[7] += x * w1.w; }
        }
#pragma unroll
        for (int e = 0; e < 8; ++e) lg[e] = wave_sum(lg[e]) + brr[e];
        int e0 = 0; float v0 = lg[0];
#pragma unroll
        for (int e = 1; e < 8; ++e) if (lg[e] > v0) { v0 = lg[e]; e0 = e; }
        int e1 = -1; float v1 = -3.0e38f;
#pragma unroll
        for (int e = 0; e < 8; ++e) if (e != e0 && lg[e] > v1) { v1 = lg[e]; e1 = e; }
        const float w1 = 1.f / (1.f + __expf(v0 - v1)), w0 = 1.f - w1;
        if (lane == 0) {
            const unsigned p0 = __hip_atomic_fetch_add(cnt + e0, 1u, __ATOMIC_RELAXED, __HIP_MEMORY_SCOPE_AGENT), p1 = __hip_atomic_fetch_add(cnt + e1, 1u, __ATOMIC_RELAXED, __HIP_MEMORY_SCOPE_AGENT);
            WSP(int, WS_TOPE)[row * 2] = e0; WSP(int, WS_TOPE)[row * 2 + 1] = e1;
            WSP(float, WS_TOPW)[row * 2] = w0; WSP(float, WS_TOPW)[row * 2 + 1] = w1;
            WSP(int, WS_TOPP)[row * 2] = (int)p0; WSP(int, WS_TOPP)[row * 2 + 1] = (int)p1;
        }
      }
    }
}
__device__ __forceinline__ void phase_route_tables(Frame& F) {
    const GAS unsigned* cnt = WSP(const unsigned, WS_CTL) + CW_CNT;
    int off[9]; off[0] = 0;
#pragma unroll
    for (int e = 0; e < 8; ++e) { const int c = (int)__hip_atomic_load(cnt + e, __ATOMIC_RELAXED, __HIP_MEMORY_SCOPE_AGENT); off[e + 1] = off[e] + ((c + 255) >> 8) * 256; }
    const int gt = F.wg * NTHR + F.tid, NGT = F.G * NTHR;
    GAS int* rowidx = WSP(int, WS_ROWIDX); GAS int* slot = WSP(int, WS_SLOT); GAS int* tilee = WSP(int, WS_TILEE);
    for (int i = gt; i < MAXTILES * 256; i += NGT) {
        int e = 0;
#pragma unroll
        for (int q = 1; q < 8; ++q) if (i >= off[q]) e = q;
        const int c = (int)cnt[e];
        if (i >= off[8] || i - off[e] >= c) rowidx[i] = 0;
    }
    for (int i = gt; i < TOKL * 2; i += NGT) {
        const int e = WSP(const int, WS_TOPE)[i], pos = WSP(const int, WS_TOPP)[i];
        int o = 0;
#pragma unroll
        for (int q = 0; q < 8; ++q) if (e == q) o = off[q];
        const int s = o + pos; slot[i] = s; rowidx[s] = i >> 1;
    }
    for (int i = gt; i < MAXTILES + 1; i += NGT) {
        if (i == MAXTILES) tilee[MAXTILES] = off[8] >> 8;
        else { int e = 0;
#pragma unroll
            for (int q = 1; q < 8; ++q) if (i * 256 >= off[q]) e = q;
            tilee[i] = e; }
    }
}

__device__ __forceinline__ void moe_pass_gemm1_fast(Frame& F, int t0, int t1) {
    pg8::OrderMoe S; S.o.init(t1 - t0, NFF1 / 256, F.G, F.wg); S.rowidx = WSP(const int, WS_ROWIDX); S.tilee = WSP(const int, WS_TILEE); S.t0 = t0; S.bstride = (size_t)NFF1 * D; S.gather = true;
    EpiSwiglu E{WSP(bf16, WS_MACT), 0};
    pg8::gemm_phase(F.lds, F.tid, WSP(const bf16, WS_H), D, WSP(const bf16, WS_MW13), D, D, S, E);
}
__device__ __forceinline__ void moe_pass_gemm2_fast(Frame& F, int t0, int t1) {
    pg8::OrderMoe S; S.o.init(t1 - t0, D / 256, F.G, F.wg); S.rowidx = WSP(const int, WS_ROWIDX); S.tilee = WSP(const int, WS_TILEE); S.t0 = t0; S.bstride = (size_t)D * DFF; S.gather = false;
    EpiBf16Out E{WSP(bf16, WS_EOUT), D, t0 * 256};
    pg8::gemm_phase(F.lds, F.tid, WSP(const bf16, WS_MACT), DFF, WSP(const bf16, WS_MW2), DFF, DFF, S, E);
}
__device__ __forceinline__ void phase_final(Frame& F, GAS float* dummy = nullptr) {
    const int gw = F.wg * NWAVES + F.wave, NGW = F.G * NWAVES, lane = F.lane;
    const GAS float* gf = inp(F, I_GFINAL); const GAS bf16* eo = WSP(const bf16, WS_EOUT);
#pragma unroll 2
    for (int row = gw; row < TOKL; row += NGW) {
        const int s0 = WSP(const int, WS_SLOT)[row * 2], s1 = WSP(const int, WS_SLOT)[row * 2 + 1];
        const float w0 = WSP(const float, WS_TOPW)[row * 2], w1 = WSP(const float, WS_TOPW)[row * 2 + 1];
        const GAS float* m5 = mod_ptr(F, 1, row, 5);
        GAS float* xr = outp(F) + (size_t)row * D; const GAS bf16* xb = WSP(const bf16, WS_XL2) + (size_t)row * D;
        f32x4 v[4]; float s = 0.f;
#pragma unroll
        for (int j = 0; j < 4; ++j) {
            const int c = 256 * j + 4 * lane;
            const f32x4 a = ld_bf16x4(eo + (size_t)s0 * D + c), b = ld_bf16x4(eo + (size_t)s1 * D + c), m = *(const GAS f32x4*)(m5 + c);
            v[j] = ld_bf16x4(xb + c) + m * (a * w0 + b * w1);
            s += (v[j].x * v[j].x + v[j].y * v[j].y) + (v[j].z * v[j].z + v[j].w * v[j].w);
        }
        const float r = rsqrtf(wave_sum(s) * (1.f / 1024.f) + 1e-6f);
#pragma unroll
        for (int j = 0; j < 4; ++j) { const int c = 256 * j + 4 * lane; const f32x4 g = *(const GAS f32x4*)(gf + c); GAS float* o_ = dummy ? dummy + (size_t)(row & 8191) * D : xr; *(GAS f32x4*)(o_ + c) = v[j] * r * g; }
    }
}

#ifndef MR_L0
#define MR_L0 192
#endif
#ifndef REP_WIN
#define REP_WIN 1
#endif
#ifndef REP_MIX
#define REP_MIX 1
#endif
#ifndef REP_GATE
#define REP_GATE 1
#endif
#ifndef REP_UP
#define REP_UP 1
#endif
#ifndef REP_FFN1
#define REP_FFN1 1
#endif
#ifndef REP_MOE
#define REP_MOE 1
#endif
#ifndef REP_NORM
#define REP_NORM 1
#endif
#ifndef REP_P0
#define REP_P0 1
#endif
__global__ void __launch_bounds__(NTHR, 2) hybrid_fwd(Params prm) {
    extern __shared__ __attribute__((aligned(16))) unsigned char lds_raw[];
    Frame F;
    F.lds = (LAS unsigned char*)lds_raw; F.ws = (GAS unsigned char*)prm.ws;
    F.tid = threadIdx.x; F.lane = F.tid & 63; F.wave = __builtin_amdgcn_readfirstlane(F.tid >> 6); F.G = gridDim.x; F.wg = blockIdx.x;
    volatile LAS unsigned* MISC = (volatile LAS unsigned*)(F.lds + MISC_OFF);
    if (F.tid < 64) MISC[F.tid] = 0u;
    if (F.tid < 33) { const unsigned long long v = F.tid < 32 ? (unsigned long long)prm.in[F.tid] : (unsigned long long)prm.out; *(LAS unsigned long long*)(F.lds + PTAB_OFF + 8 * F.tid) = v; }
    __syncthreads();
    XcdBarrier bar = xcd_barrier_post(WSP(unsigned, WS_CTL) + CW_BAR, MISC + 8);
#define RELAUNDER() do { { unsigned long long _w = (unsigned long long)F.ws; asm volatile("" : "+s"(_w)); F.ws = (GAS unsigned char*)_w; } \
        { unsigned _t = (unsigned)F.tid; asm volatile("" : "+v"(_t)); F.tid = (int)_t; F.lane = F.tid & 63; F.wave = __builtin_amdgcn_readfirstlane(F.tid >> 6); } \
        { unsigned _g = (unsigned)F.G, _b = (unsigned)F.wg; asm volatile("" : "+s"(_g), "+s"(_b)); F.G = (int)_g; F.wg = (int)_b; } \
        { unsigned _l = (unsigned)(size_t)F.lds; asm volatile("" : "+s"(_l)); F.lds = (LAS unsigned char*)(size_t)_l; } } while (0)
#define GRID_BAR() do { { unsigned long long _b = (unsigned long long)bar.bar; unsigned _x = bar.x; asm volatile("" : "+s"(_b), "+s"(_x)); bar.bar = (GAS unsigned*)_b; bar.x = _x; } xcd_barrier(bar); RELAUNDER(); } while (0)

    for (int rp = 0; rp < REP_P0; ++rp) { phase_p0(F); write_bias(F);
    GRID_BAR(); }
#pragma unroll 1
    for (int layer_ = 0; layer_ < 2; ++layer_) {
        int layer = layer_;
#define last (layer == 1)
#define rows_all TOK
#define rows_out (last ? TOKL : TOK)
#define modbase (WSP(const float, WS_MOD) + (size_t)layer * 17 * 6144)
#define LAYER_LAUNDER() asm volatile("" : "+s"(layer))
        for (int rp = 0; rp < REP_NORM; ++rp) { if (last) phase_norm<true>(F, layer, rows_all, 0); else phase_norm<false>(F, layer, rows_all, 0);
        if (layer == 0) { const int gw = F.wg * NWAVES + F.wave, NGW = F.G * NWAVES;
            for (int it = gw; it < 1536 + 96; it += NGW) filter_out_item(F, it); }
        { GRID_BAR(); LAYER_LAUNDER(); } }
        for (int rp = 0; rp < REP_WIN; ++rp) {
        { EpiWin E{WSP(const float, WS_BIAS) + layer * NWP, WSP(bf16, WS_HYTL), WSP(bf16, WS_HYTC), WSP(bf16, WS_RET), WSP(bf16, WS_ML), WSP(float, WS_MLG)};
          if (last) { pg8::OrderWinL1 S; S.init(F.G, F.wg); pg8::gemm_phase(F.lds, F.tid, WSP(const bf16, WS_H), D, WSP(const bf16, WS_WIN), D, D, S, E); }
          else gemm_fast(F, WSP(const bf16, WS_H), D, WSP(const bf16, WS_WIN), D, D, rows_all, NW1, E); }
        { GRID_BAR(); LAYER_LAUNDER(); } }
        for (int rp = 0; rp < REP_MIX; ++rp) { phase_mix(F, layer);
        { GRID_BAR(); LAYER_LAUNDER(); } }
#ifndef REP_COMB
#define REP_COMB 1
#endif
        for (int rp = REP_COMB - 1; rp > 0; --rp) { phase_combine(F, layer, true); { GRID_BAR(); LAYER_LAUNDER(); } }
        phase_combine(F, layer);
        { GRID_BAR(); LAYER_LAUNDER(); }
        for (int rp = 0; rp < REP_GATE; ++rp) {
        { EpiGate E{WSP(const float, WS_BIAS) + layer * NWP + NW1, WSP(bf16, WS_GATES)};
          gemm_fast(F, WSP(const bf16, WS_H), D, WSP(const bf16, WS_WIN) + (size_t)NW1 * D, D, D, rows_out, NGATE, E); }
        { GRID_BAR(); LAYER_LAUNDER(); } }
        for (int rp = 0; rp < REP_UP; ++rp) {
        { EpiUp E{WSP(const bf16, WS_GATES), WSP(bf16, WS_H)};
          if (last) gemm_fast(F, WSP(const bf16, WS_Y), D, WSP(const bf16, WS_WUP), D, D, TOKL, D, E);
          else gemm_fast<MR_L0>(F, WSP(const bf16, WS_Y), D, WSP(const bf16, WS_WUP), D, D, TOK, D, E); }
        { GRID_BAR(); LAYER_LAUNDER(); } }
#ifndef REP_OUT
#define REP_OUT 1
#endif
        if (last) { EpiResidT<true> E{(const GAS bf16*)outp(F), nullptr, WSP(bf16, WS_XL2), nullptr, modbase, 2};
            gemm_fast(F, WSP(const bf16, WS_H), D, WSP(const bf16, WS_WOUT), D, D, TOKL, D, E); }
        else { EpiResidT<false> E{inp(F, I_X), inp(F, I_CTX), (GAS bf16*)outp(F), WSP(bf16, WS_XC), modbase, 2};
            gemm_fast<MR_L0>(F, WSP(const bf16, WS_H), D, WSP(const bf16, WS_WOUT), D, D, TOK, D, E); }
        { GRID_BAR(); LAYER_LAUNDER(); }
        if (!last) {
            phase_norm<true>(F, layer, rows_out, 3);
            { const int gw = F.wg * NWAVES + F.wave, NGW = F.G * NWAVES; LAS float* scr = (LAS float*)(F.lds + F.wave * 8704);
              conv_weights_ffn(inp(F, I_FW1), inp(F, I_FW3), inp(F, I_FW2), WSP(bf16, WS_W13), WSP(bf16, WS_W2), gw, NGW, scr, F.lane);
              conv_weights_win(F, 1, gw, NGW, scr);
              conv_weights_upout(F, 1, gw, NGW, scr); }
            { GRID_BAR(); LAYER_LAUNDER(); }
            for (int rp = 0; rp < REP_FFN1; ++rp) {
            { EpiSwiglu E{WSP(bf16, WS_ACT), 0};
              gemm_fast(F, WSP(const bf16, WS_H), D, WSP(const bf16, WS_W13), D, D, rows_out, NFF1, E); }
            { GRID_BAR(); LAYER_LAUNDER(); } }
#ifndef REP_FFN2
#define REP_FFN2 1
#endif
            { EpiResidT<true> E{(const GAS bf16*)outp(F), WSP(const bf16, WS_XC), (GAS bf16*)outp(F), WSP(bf16, WS_XC), modbase, 5};
              gemm_fast<MR_L0>(F, WSP(const bf16, WS_ACT), DFF, WSP(const bf16, WS_W2), DFF, DFF, TOK, D, E); }
            { GRID_BAR(); LAYER_LAUNDER(); }
        }
    }
#undef LAYER_LAUNDER
#undef last
#undef rows_all
#undef rows_out
#undef modbase
    phase_norm_router(F);
    { const int gw = F.wg * NWAVES + F.wave, NGW = F.G * NWAVES; LAS float* scr = (LAS float*)(F.lds + F.wave * 8704);
#ifndef REP_MCONV
#define REP_MCONV 1
#endif
#pragma unroll 1
      for (int e = 0; e < NE * REP_MCONV; ++e)
          conv_weights_ffn(inp(F, I_MW1) + (size_t)(e % NE) * D * DFF, inp(F, I_MW3) + (size_t)(e % NE) * D * DFF, inp(F, I_MW2) + (size_t)(e % NE) * DFF * D,
                           WSP(bf16, WS_MW13) + (size_t)(e % NE) * NFF1 * D, WSP(bf16, WS_MW2) + (size_t)(e % NE) * D * DFF, gw, NGW, scr, F.lane); }
    GRID_BAR();
    phase_route_tables(F);
    GRID_BAR();
    const int ntiles = __builtin_amdgcn_readfirstlane(WSP(const int, WS_TILEE)[MAXTILES]);
#pragma unroll 1
    for (int p = 0; p < NPASS; ++p) {
        const int t0 = p * PASS_TILES, t1 = min(ntiles, t0 + PASS_TILES);
        for (int rp = 0; rp < REP_MOE; ++rp) {
        if (t0 < t1) moe_pass_gemm1_fast(F, t0, t1);
        GRID_BAR();
        if (t0 < t1) moe_pass_gemm2_fast(F, t0, t1);
        GRID_BAR(); }
    }
#ifndef REP_BAR
#define REP_BAR 0
#endif
    for (int rb = 0; rb < REP_BAR; ++rb) GRID_BAR();
#ifndef REP_FINAL
#define REP_FINAL 1
#endif
    for (int rp = REP_FINAL - 1; rp > 0; --rp) { phase_final(F, WSP(float, WS_H)); GRID_BAR(); }
    phase_final(F);
}

extern "C" void kernel_launch(void* const* d_in, const int* in_sizes, int n_in, void* d_out, int out_size, void* d_ws, size_t ws_size, hipStream_t stream) {
    static int grid = 0;
    if (grid == 0) {
        if (n_in != 32 || out_size != TOKL * D || ws_size < WS_END) { fprintf(stderr, "kernel_launch: unexpected arguments (n_in %d, out %d, ws %zu)\n", n_in, out_size, ws_size); grid = -1; return; }
        int dev = 0, cus = 0;
        if (hipGetDevice(&dev) != hipSuccess || hipDeviceGetAttribute(&cus, hipDeviceAttributeMultiprocessorCount, dev) != hipSuccess) { grid = -1; return; }
        if (hipFuncSetAttribute((const void*)hybrid_fwd, hipFuncAttributeMaxDynamicSharedMemorySize, LDS_BYTES) != hipSuccess) { grid = -1; return; }
        int per_cu = 0;
        (void)hipOccupancyMaxActiveBlocksPerMultiprocessor(&per_cu, (const void*)hybrid_fwd, NTHR, LDS_BYTES);
        (void)hipGetLastError();
        if (cus < 256) { fprintf(stderr, "kernel_launch: needs 256 compute units (one workgroup each), found %d\n", cus); grid = -1; return; }
        grid = 256;
    }
    if (grid < 0) return;
    (void)hipMemsetAsync((char*)d_ws + WS_CTL, 0, CTL_ZERO_BYTES, stream);
    Params p{};
    for (int i = 0; i < 32; ++i) p.in[i] = (const float*)d_in[i];
    p.out = (float*)d_out; p.ws = (unsigned char*)d_ws;
    hipLaunchKernelGGL(hybrid_fwd, dim3(grid), dim3(NTHR), LDS_BYTES, stream, p);
}
```

```cpp
#include <hip/hip_runtime.h>
#include <stdint.h>
#include <stdio.h>

#define LAS __attribute__((address_space(3)))
#define GAS __attribute__((address_space(1)))
typedef unsigned short bf16;
typedef short bf16x8 __attribute__((ext_vector_type(8)));
typedef float f32x4 __attribute__((ext_vector_type(4)));
typedef unsigned u32x4 __attribute__((ext_vector_type(4)));
typedef unsigned u32x2 __attribute__((ext_vector_type(2)));

constexpr int D = 1024, NB = 16, LL = 2048, LC = 256;
constexpr int TOKL = NB * LL, TOKC = NB * LC, TOK = TOKL + TOKC;
constexpr int HYW = 384, RETW = 384, MLW = 256;
constexpr int NIN = 6800, NW1 = 3840, NGATE = 3072, NWP = 6912;
constexpr int DFF = 2816, NFF1 = 5632, NE = 8;
constexpr int NWAVES = 8, NTHR = 512;
constexpr int MAXTILES = 272, PASS_TILES = 58, NPASS = 5;

constexpr size_t MiB = 1u << 20;
constexpr size_t WS_CTL = 0, CTL_ZERO_BYTES = 1 * MiB;
constexpr size_t WS_MOD = 1 * MiB;
constexpr size_t WS_BIAS = 2 * MiB;
constexpr size_t WS_ROPE = 2 * MiB + 256 * 1024;
constexpr size_t WS_TOPE = 3 * MiB;
constexpr size_t WS_TOPW = 3 * MiB + 256 * 1024;
constexpr size_t WS_TOPP = 3 * MiB + 512 * 1024;
constexpr size_t WS_SLOT = 3 * MiB + 768 * 1024;
constexpr size_t WS_ROWIDX = 4 * MiB;
constexpr size_t WS_TILEE = 4 * MiB + 512 * 1024;
constexpr size_t WS_FTL = 5 * MiB;
constexpr size_t WS_FTC = 17 * MiB;
constexpr size_t WS_WIN = 18 * MiB;
constexpr size_t WS_WUP = 32 * MiB;
constexpr size_t WS_WOUT = 34 * MiB;
constexpr size_t WS_XC = 36 * MiB;
constexpr size_t WS_H = 52 * MiB;
constexpr size_t WS_Y = 124 * MiB;
constexpr size_t WS_U = 196 * MiB;
constexpr size_t WS_RET = WS_U;
constexpr size_t WS_ML = WS_U + 108 * MiB;
constexpr size_t WS_MLG = WS_U + 180 * MiB;
constexpr size_t WS_OB = WS_U + 183 * MiB;
constexpr size_t WS_YHTL = WS_U + 228 * MiB;
constexpr size_t WS_YHTC = WS_U + 252 * MiB;
constexpr size_t WS_HYTL = WS_U + 255 * MiB;
constexpr size_t WS_HYTC = WS_U + 327 * MiB;
constexpr size_t WS_XL2 = WS_U + 284 * MiB;
constexpr size_t WS_END = WS_U + 348 * MiB;
constexpr size_t WS_GATES = WS_U;
constexpr size_t WS_ACT = WS_U;
constexpr size_t WS_W13 = WS_U + 204 * MiB;
constexpr size_t WS_W2 = WS_U + 216 * MiB;
constexpr size_t WS_MW13 = WS_Y;
constexpr size_t WS_MW2 = WS_Y + 88 * MiB;
constexpr size_t WS_MACT = WS_Y + 132 * MiB;
constexpr size_t WS_EOUT = WS_Y + 220 * MiB;
static_assert(WS_EOUT + (size_t)MAXTILES * 256 * 1024 * 2 <= WS_XL2, "map");
static_assert(WS_GATES + (size_t)TOK * NGATE * 2 <= WS_YHTL, "gates overlay");

constexpr int CW_BAR = 4096;
constexpr int CW_CNT = 16384;

constexpr int LDS_BYTES = 147456;
constexpr int MISC_OFF = 147456 - 256;

__device__ __forceinline__ float bf2f(bf16 b) { return __uint_as_float(((unsigned)b) << 16); }
typedef __bf16 bf2v_ __attribute__((ext_vector_type(2)));
typedef float f2v_ __attribute__((ext_vector_type(2)));
__device__ __forceinline__ unsigned pk2(float lo, float hi) { const f2v_ f = {lo, hi}; return __builtin_bit_cast(unsigned, __builtin_convertvector(f, bf2v_)); }
__device__ __forceinline__ unsigned f2bf(float f) { return pk2(f, 0.f) & 0xffffu; }
__device__ __forceinline__ float dpp_f(float v, int) { return v; }
#define DPP_ADD(v, ctrl) (v) += __int_as_float(__builtin_amdgcn_update_dpp(0, __float_as_int(v), (ctrl), 0xf, 0xf, true))
__device__ __forceinline__ float wave_sum(float v) {
    DPP_ADD(v, 0xB1);
    DPP_ADD(v, 0x4E);
    DPP_ADD(v, 0x141);
    DPP_ADD(v, 0x140);
    return __int_as_float(__builtin_amdgcn_readlane(__float_as_int(v), 0)) + __int_as_float(__builtin_amdgcn_readlane(__float_as_int(v), 16))
         + __int_as_float(__builtin_amdgcn_readlane(__float_as_int(v), 32)) + __int_as_float(__builtin_amdgcn_readlane(__float_as_int(v), 48));
}
__device__ __forceinline__ float lane_read(float v, int src_lane) { return __int_as_float(__builtin_amdgcn_ds_bpermute(src_lane << 2, __float_as_int(v))); }
__device__ __forceinline__ float sigmoidf_(float x) { return __builtin_amdgcn_rcpf(1.0f + __expf(-x)); }
__device__ __forceinline__ float siluf_(float x) { return x * __builtin_amdgcn_rcpf(1.0f + __expf(-x)); }

#define XB_TMO      128
#define XB_XCNT(j)  (256  + 64 * (j))
#define XB_XSUB(j)  (1280 + 64 * (j))
#define XB_XGEN(j)  (2304 + 64 * (j))
#define XB_TOP      3328
#define XB_TOPGEN   3392
#define XCD_BAR_WORDS 3456
#define XB_SPIN_CAP (1u << 22)
__device__ __forceinline__ unsigned xb_ld(GAS unsigned* p)              { return __hip_atomic_load(p, __ATOMIC_RELAXED, __HIP_MEMORY_SCOPE_AGENT); }
__device__ __forceinline__ unsigned xb_add(GAS unsigned* p, unsigned v) { return __hip_atomic_fetch_add(p, v, __ATOMIC_RELAXED, __HIP_MEMORY_SCOPE_AGENT); }
__device__ __forceinline__ unsigned xb_xcc_id() { return (unsigned)__builtin_amdgcn_s_getreg((3 << 11) | 20) & 0xFu; }
#ifndef XB_SLEEP
#define XB_SLEEP 0
#endif
#define XB_SPIN(cond, bar) do { unsigned _sp = 0; while (cond) { if (XB_SLEEP) __builtin_amdgcn_s_sleep(1); \
    if ((++_sp & 255u) == 0u) { if (xb_ld(&(bar)[XB_TMO])) break; if (_sp > XB_SPIN_CAP) { (void)__hip_atomic_fetch_add(&(bar)[XB_TMO], 1u, __ATOMIC_RELAXED, __HIP_MEMORY_SCOPE_AGENT); break; } } } } while (0)
struct XcdBarrier { GAS unsigned* bar; unsigned x; volatile LAS unsigned* st; };
__device__ __forceinline__ XcdBarrier xcd_barrier_post(GAS unsigned* bar, volatile LAS unsigned* st) {
    XcdBarrier b; b.bar = bar; b.x = xb_xcc_id(); b.st = st;
    if (threadIdx.x == 0) (void)xb_add(&bar[XB_XCNT(b.x)], 1u);
    return b;
}
__device__ __forceinline__ void xcd_barrier_complete(GAS unsigned* bar, unsigned x, unsigned& nloc, unsigned& nx) {
    const unsigned G = gridDim.x * gridDim.y * gridDim.z;
    unsigned sum, cnt, mine, sp = 0u;
    for (;;) {
        sum = 0u; cnt = 0u; mine = 0u;
#pragma unroll 1
        for (unsigned j = 0; j < 16; ++j) { const unsigned c = xb_ld(&bar[XB_XCNT(j)]); sum += c; cnt += (c > 0u) ? 1u : 0u; }
        mine = xb_ld(&bar[XB_XCNT(x)]);
        if (sum == G) break;
        __builtin_amdgcn_s_sleep(1);
        if ((++sp & 255u) == 0u) { if (xb_ld(&bar[XB_TMO])) break; if (sp > XB_SPIN_CAP) { (void)__hip_atomic_fetch_add(&bar[XB_TMO], 1u, __ATOMIC_RELAXED, __HIP_MEMORY_SCOPE_AGENT); break; } }
    }
    nloc = mine > 0u ? mine : 1u; nx = cnt > 0u ? cnt : 1u;
}
__device__ __forceinline__ void xcd_barrier(const XcdBarrier& b) {
    asm volatile("s_waitcnt vmcnt(0)" ::: "memory");
    __syncthreads();
    if (threadIdx.x == 0) {
        GAS unsigned* bar = b.bar;
        __builtin_amdgcn_s_waitcnt(0);
        unsigned nloc = b.st[0], nx = b.st[1];
        if (nloc == 0u) { xcd_barrier_complete(bar, b.x, nloc, nx); b.st[0] = nloc; b.st[1] = nx; }
        const unsigned old = xb_add(&bar[XB_XSUB(b.x)], 1u);
        const unsigned gen = old / nloc;
        if (old + 1u == (gen + 1u) * nloc) {
            __builtin_amdgcn_fence(__ATOMIC_RELEASE, "agent");
            asm volatile("s_waitcnt vmcnt(0)" ::: "memory");
            const unsigned og = xb_add(&bar[XB_TOP], 1u);
            const unsigned tg = og / nx;
            if (og + 1u == (tg + 1u) * nx) xb_add(&bar[XB_TOPGEN], 1u);
            else XB_SPIN(xb_ld(&bar[XB_TOPGEN]) == tg, bar);
            __builtin_amdgcn_fence(__ATOMIC_ACQUIRE, "agent");
            xb_add(&bar[XB_XGEN(b.x)], 1u);
            asm volatile("s_waitcnt vmcnt(0)" ::: "memory");
        } else {
            XB_SPIN(xb_ld(&bar[XB_XGEN(b.x)]) == gen, bar);
            __builtin_amdgcn_fence(__ATOMIC_ACQUIRE, "agent");
            asm volatile("s_waitcnt vmcnt(0)" ::: "memory");
        }
    }
    __syncthreads();
}

struct Params { const float* in[32]; float* out; unsigned char* ws; };
enum { I_X = 0, I_C, I_CTX, I_CCTX, I_WMOD, I_BMOD, I_GMIX, I_GFFN, I_WIN, I_BIN, I_HYCONV, I_HYF1, I_HYFB1, I_HYF2, I_HYFB2, I_HYF3, I_HYDECAY,
       I_HYSKIP, I_RETDECAY, I_MLCONV, I_MLGB, I_WUP, I_WOUT, I_FW1, I_FW3, I_FW2, I_ROUTER, I_ROUTERB, I_MW1, I_MW3, I_MW2, I_GFINAL };

struct Frame {
    LAS unsigned char* lds;
    GAS unsigned char* ws;
    int tid, lane, wave, G, wg;
};
#define WSP(T, off) ((GAS T*)(F.ws + (off)))
constexpr int PTAB_OFF = 147456 - 1024;
__device__ __forceinline__ const GAS float* inp(const Frame& F, int i) {
    const LAS unsigned* t = (const LAS unsigned*)(F.lds + PTAB_OFF) + 2 * i;
    const unsigned lo = __builtin_amdgcn_readfirstlane(t[0]), hi = __builtin_amdgcn_readfirstlane(t[1]);
    return (const GAS float*)(((unsigned long long)hi << 32) | lo);
}
__device__ __forceinline__ GAS float* outp(const Frame& F) { return (GAS float*)inp(F, 32); }

__device__ __forceinline__ int row_batch(int row) { return row < TOKL ? (row >> 11) : ((row - TOKL) >> 8); }
__device__ __forceinline__ const GAS float* mod_ptr(const Frame& F, int layer, int row, int which) {
    const int r = row < TOKL ? (row >> 11) : 16;
    return WSP(const float, WS_MOD) + ((size_t)(layer * 17 + r) * 6 + which) * 1024;
}

template <class RowMap>
__device__ __forceinline__ void tr_item(const GAS float* W, int K, int N, GAS bf16* WT, int ldT, RowMap rm, LAS float* scr, int item, int lane) {
    const int nblk = (N + 31) / 32, kb = item / nblk, nb = item % nblk, k0 = 64 * kb, n0 = 32 * nb;
    { f32x4 tv[8];
#pragma unroll
      for (int i = 0; i < 8; ++i) { const int kk = 8 * i + (lane >> 3); const int n = n0 + 4 * (lane & 7); tv[i] = (n < N) ? *(const GAS f32x4*)(W + (size_t)(k0 + kk) * N + n) : (f32x4){0.f, 0.f, 0.f, 0.f}; }
#pragma unroll
      for (int i = 0; i < 8; ++i) { const int kk = 8 * i + (lane >> 3); LAS float* d = scr + kk * 33 + 4 * (lane & 7); d[0] = tv[i].x; d[1] = tv[i].y; d[2] = tv[i].z; d[3] = tv[i].w; } }
    asm volatile("s_waitcnt lgkmcnt(0)" ::: "memory");
    const int c = lane & 7;
#pragma unroll
    for (int j = 0; j < 4; ++j) { const int nl = (lane >> 3) + 8 * j; const int n = n0 + nl; const LAS float* s = scr + (8 * c) * 33 + nl;
        u32x4 o; o.x = pk2(s[0 * 33], s[1 * 33]); o.y = pk2(s[2 * 33], s[3 * 33]); o.z = pk2(s[4 * 33], s[5 * 33]); o.w = pk2(s[6 * 33], s[7 * 33]);
        if (n < N) *(GAS u32x4*)(WT + (size_t)rm(n) * ldT + k0 + 8 * c) = o; }
    asm volatile("s_waitcnt lgkmcnt(0)" ::: "memory");
}
struct RmId { __device__ __forceinline__ int operator()(int n) const { return n; } };
__device__ __forceinline__ int win_row(int n) {
    if (n < 1152) return n;
    if (n < 2688) return 1280 + (n - 1152);
    if (n < 3712) return 2816 + (n - 2688);
    if (n < 3728) return 1152 + (n - 3712);
    return 3840 + (n - 3728);
}
struct RmWin { __device__ __forceinline__ int operator()(int n) const { return win_row(n); } };
struct RmW1 { __device__ __forceinline__ int operator()(int n) const { return (n >> 4) * 32 + (n & 15); } };
struct RmW3 { __device__ __forceinline__ int operator()(int n) const { return (n >> 4) * 32 + 16 + (n & 15); } };

__device__ __forceinline__ void conv_weights_win(Frame& F, int layer, int gw, int NGW, LAS float* scr) {
    const GAS float* W = inp(F, I_WIN) + (size_t)layer * D * NIN;
    const int items = (D / 64) * ((NIN + 31) / 32);
    for (int it = gw; it < items; it += NGW) tr_item(W, D, NIN, WSP(bf16, WS_WIN), D, RmWin(), scr, it, F.lane);
    GAS bf16* wt = WSP(bf16, WS_WIN);
    unsigned zz; asm volatile("v_mov_b32 %0, 0" : "=v"(zz));
    for (int i = gw * 64 + F.lane; i < 112 * 1024 / 8; i += NGW * 64) *(GAS u32x4*)(wt + (size_t)1168 * 1024 + (size_t)i * 8) = (u32x4){zz, zz, zz, zz};
}
__device__ __forceinline__ void conv_weights_upout(Frame& F, int layer, int gw, int NGW, LAS float* scr) {
    const int items = (D / 64) * (D / 32);
    for (int it = gw; it < items; it += NGW) tr_item(inp(F, I_WUP) + (size_t)layer * D * D, D, D, WSP(bf16, WS_WUP), D, RmId(), scr, it, F.lane);
    for (int it = gw; it < items; it += NGW) tr_item(inp(F, I_WOUT) + (size_t)layer * D * D, D, D, WSP(bf16, WS_WOUT), D, RmId(), scr, it, F.lane);
}
__device__ __forceinline__ void conv_weights_ffn(const GAS float* w1, const GAS float* w3, const GAS float* w2, GAS bf16* w13t, GAS bf16* w2t, int gw, int NGW, LAS float* scr, int lane) {
    const int i1 = (D / 64) * (DFF / 32), i2 = (DFF / 64) * (D / 32);
    for (int it = gw; it < i1; it += NGW) tr_item(w1, D, DFF, w13t, D, RmW1(), scr, it, lane);
    for (int it = gw; it < i1; it += NGW) tr_item(w3, D, DFF, w13t, D, RmW3(), scr, it, lane);
    for (int it = gw; it < i2; it += NGW) tr_item(w2, DFF, D, w2t, DFF, RmId(), scr, it, lane);
}

constexpr size_t WS_HID2 = WS_XC;
__device__ __forceinline__ void filter_hidden_item(Frame& F, int p) {
    const int sel = p < 2048 ? 0 : (p < 4096 ? 1 : 2), layer = sel == 1 ? 1 : 0, L = sel == 2 ? LC : LL, pbase = sel == 0 ? 0 : (sel == 1 ? 2048 : 4096);
    const GAS float* f1 = inp(F, I_HYF1) + layer * 33 * 64; const GAS float* fb1 = inp(F, I_HYFB1) + layer * 64;
    const GAS float* f2 = inp(F, I_HYF2) + layer * 64 * 64; const GAS float* fb2 = inp(F, I_HYFB2) + layer * 64;
    const int lane = F.lane;
    float w1[33], w2[64];
#pragma unroll
    for (int i = 0; i < 33; ++i) w1[i] = f1[i * 64 + lane];
#pragma unroll
    for (int i = 0; i < 64; ++i) w2[i] = f2[i * 64 + lane];
    const float b1 = fb1[lane], b2 = fb2[lane];
    const int pos = p - pbase;
    const float t = (float)pos / (float)(L - 1);
    const float w = 6.283185307179586f * (float)pos / (float)L;
    float feat = 0.f;
    if (lane == 0) feat = t;
    else if (lane < 17) { const float band = 1e-4f + (float)(lane - 1) * ((15.0f - 1e-4f) / 15.0f); feat = cosf(w * band); }
    else if (lane < 33) { const float band = 1e-4f + (float)(lane - 17) * ((15.0f - 1e-4f) / 15.0f); feat = -sinf(w * band); }
    float a1 = b1;
#pragma unroll
    for (int i = 0; i < 33; ++i) a1 += __int_as_float(__builtin_amdgcn_readlane(__float_as_int(feat), i)) * w1[i];
    const float h1 = sinf(a1);
    float a2 = b2;
#pragma unroll
    for (int i = 0; i < 64; ++i) a2 += __int_as_float(__builtin_amdgcn_readlane(__float_as_int(h1), i)) * w2[i];
    WSP(float, WS_HID2)[(size_t)p * 64 + lane] = sinf(a2);
}
__device__ __forceinline__ void filter_out_item(Frame& F, int item) {
    int sel, r;
    if (item < 768) { sel = 0; r = item; } else if (item < 1536) { sel = 1; r = item - 768; } else { sel = 2; r = item - 1536; }
    const int layer = sel == 1 ? 1 : 0, L = sel == 2 ? LC : LL, pb = r / 24, ch = r % 24, pbase = sel == 0 ? 0 : (sel == 1 ? 2048 : 4096);
    GAS bf16* FT = sel == 2 ? WSP(bf16, WS_FTC) : WSP(bf16, WS_FTL) + (size_t)layer * 2 * 384 * 4096;
    const GAS float* f3 = inp(F, I_HYF3) + (size_t)layer * 64 * 1536; const GAS float* dec = inp(F, I_HYDECAY) + layer * 1536;
    const int lane = F.lane, fr = lane & 15, fq = lane >> 4;
    const GAS float* hid = WSP(const float, WS_HID2) + (size_t)(pbase + pb * 64) * 64;
    f32x4 acc[4][4];
#pragma unroll
    for (int mt = 0; mt < 4; ++mt)
#pragma unroll
        for (int nt = 0; nt < 4; ++nt) acc[mt][nt] = (f32x4){0.f, 0.f, 0.f, 0.f};
#pragma unroll
    for (int ks = 0; ks < 16; ++ks) {
        float a[4], bb[4];
#pragma unroll
        for (int mt = 0; mt < 4; ++mt) a[mt] = hid[(16 * mt + fr) * 64 + 4 * ks + fq];
#pragma unroll
        for (int nt = 0; nt < 4; ++nt) bb[nt] = f3[(size_t)(4 * ks + fq) * 1536 + ch * 64 + 16 * nt + fr];
#pragma unroll
        for (int mt = 0; mt < 4; ++mt)
#pragma unroll
            for (int nt = 0; nt < 4; ++nt) acc[mt][nt] = __builtin_amdgcn_mfma_f32_16x16x4f32(a[mt], bb[nt], acc[mt][nt], 0, 0, 0);
    }
#pragma unroll
    for (int nt = 0; nt < 4; ++nt) {
        const int nn = ch * 64 + 16 * nt + fr, o = nn / 768, dir = (nn / 384) & 1, c = nn % 384;
        const float adec = fabsf(dec[nn]);
        GAS bf16* dst = FT + (size_t)(o * 384 + c) * (2 * L);
#pragma unroll
        for (int mt = 0; mt < 4; ++mt)
#pragma unroll
            for (int j = 0; j < 4; ++j) {
                const int pos = pb * 64 + 16 * mt + 4 * fq + j;
                const float t = (float)pos / (float)(L - 1);
                const float v = acc[mt][nt][j] * __expf(-t * adec);
                if (dir == 0) dst[L - pos] = (bf16)f2bf(v);
                else if (pos > 0) dst[L + pos] = (bf16)f2bf(v);
            }
    }
}

__device__ __forceinline__ void phase_p0(Frame& F) {
    const int gw = F.wg * NWAVES + F.wave, NGW = F.G * NWAVES;
    LAS float* sl = (LAS float*)F.lds;
    LAS float* red = (LAS float*)(F.lds + 17 * 4096);
    { f32x4 tv[9];
#pragma unroll
      for (int q = 0; q < 9; ++q) { const int i4 = F.tid + q * NTHR; if (i4 < 4352) { const int r = i4 >> 8, k4 = i4 & 255; tv[q] = r < 16 ? *(const GAS f32x4*)(inp(F, I_C) + r * 1024 + 4 * k4) : *(const GAS f32x4*)(inp(F, I_CCTX) + 4 * k4); } }
#pragma unroll
      for (int q = 0; q < 9; ++q) { const int i4 = F.tid + q * NTHR; if (i4 < 4352) { f32x4 o; o.x = siluf_(tv[q].x); o.y = siluf_(tv[q].y); o.z = siluf_(tv[q].z); o.w = siluf_(tv[q].w); *(LAS f32x4*)(sl + 4 * i4) = o; } } }
    __syncthreads();
    for (int item = F.wg; item < 2 * 384; item += F.G) {
        const int layer = item / 384, n0 = (item % 384) * 16, j = F.tid & 15, kp = F.tid >> 4;
        const GAS float* W = inp(F, I_WMOD) + (size_t)layer * D * 6144;
        float w[32];
#pragma unroll
        for (int i = 0; i < 32; ++i) w[i] = W[(size_t)(kp * 32 + i) * 6144 + n0 + j];
#pragma unroll
        for (int r = 0; r < 17; ++r) { float acc = 0.f;
#pragma unroll
            for (int q = 0; q < 8; ++q) { const f32x4 s4 = *(const LAS f32x4*)(sl + r * 1024 + kp * 32 + 4 * q); acc += (s4.x * w[4 * q] + s4.y * w[4 * q + 1]) + (s4.z * w[4 * q + 2] + s4.w * w[4 * q + 3]); }
            red[(kp * 17 + r) * 16 + j] = acc; }
        __syncthreads();
        if (F.tid < 272) { const int r = F.tid >> 4, jj = F.tid & 15; float s = inp(F, I_BMOD)[layer * 6144 + n0 + jj];
            for (int q = 0; q < 32; ++q) s += red[(q * 17 + r) * 16 + jj];
            WSP(float, WS_MOD)[(size_t)(layer * 17 + r) * 6144 + n0 + jj] = s; }
        __syncthreads();
    }
    __syncthreads();
    LAS float* scr = (LAS float*)(F.lds + F.wave * 8704);
    conv_weights_win(F, 0, gw, NGW, scr);
    conv_weights_upout(F, 0, gw, NGW, scr);
    for (int i = gw * 64 + F.lane; i < 2048 * 32; i += NGW * 64) {
        const int t = i >> 5, j = i & 31, half = j >> 4, ii = j & 15;
        const float inv = 1.0f / powf(10000.0f, (float)ii / 16.0f);
        const float ang = (float)(half == 0 ? (t >> 6) : (t & 63)) * inv;
        WSP(float, WS_ROPE)[t * 64 + half * 32 + ii] = cosf(ang);
        WSP(float, WS_ROPE)[t * 64 + half * 32 + 16 + ii] = sinf(ang);
    }
    for (int it = gw; it < 4352; it += NGW) filter_hidden_item(F, it);
}
__device__ __forceinline__ void write_bias(Frame& F) {
    const int gt = (F.wg * NWAVES + F.wave) * 64 + F.lane, NGT = F.G * NTHR;
    for (int i = gt; i < 2 * NWP; i += NGT) {
        const int l = i / NWP, r = i % NWP; float v = 0.f;
        int n = -1;
        if (r < 1152) n = r; else if (r < 1168) n = 3712 + (r - 1152); else if (r < 1280) n = -1; else if (r < 2816) n = 1152 + (r - 1280); else if (r < 3840) n = 2688 + (r - 2816); else n = 3728 + (r - 3840);
        if (n >= 0) v = inp(F, I_BIN)[l * NIN + n];
        WSP(float, WS_BIAS)[i] = v;
    }
}

template <bool XB> struct XRaw { typedef f32x4 T; };
template <> struct XRaw<true> { typedef u32x2 T; };
template <bool XB>
__device__ __forceinline__ void xrow_issue(const Frame& F, int row, int src, int lane, typename XRaw<XB>::T (&w)[4]) {
    if constexpr (!XB) { const GAS float* xr = row < TOKL ? inp(F, I_X) + (size_t)row * D : inp(F, I_CTX) + (size_t)(row - TOKL) * D;
#pragma unroll
        for (int j = 0; j < 4; ++j) w[j] = *(const GAS f32x4*)(xr + 256 * j + 4 * lane); }
    else { const GAS bf16* xr = src == 2 ? WSP(const bf16, WS_XL2) + (size_t)row * D : (row < TOKL ? (const GAS bf16*)outp(F) + (size_t)row * D : WSP(const bf16, WS_XC) + (size_t)(row - TOKL) * D);
#pragma unroll
        for (int j = 0; j < 4; ++j) w[j] = *(const GAS u32x2*)(xr + 256 * j + 4 * lane); }
}
__device__ __forceinline__ f32x4 xrow_unpack(f32x4 w) { return w; }
__device__ __forceinline__ f32x4 xrow_unpack(u32x2 w) { f32x4 v; v.x = __uint_as_float(w.x << 16); v.y = __uint_as_float(w.x & 0xffff0000u); v.z = __uint_as_float(w.y << 16); v.w = __uint_as_float(w.y & 0xffff0000u); return v; }
template <bool XB>
__device__ __forceinline__ void phase_norm(Frame& F, int layer, int nrows, int which) {
    const int gw = F.wg * NWAVES + F.wave, NGW = F.G * NWAVES, lane = F.lane;
    const GAS float* g = inp(F, which == 0 ? I_GMIX : I_GFFN) + layer * D;
    const int per = (nrows + NGW - 1) / NGW, r0 = gw * per, r1 = min(nrows, r0 + per);
    if (r0 >= r1) return;
    int grp = -1; f32x4 gm[4], sh[4]; typename XRaw<XB>::T ring[4][4];
#pragma unroll
    for (int i = 0; i < 4; ++i) if (r0 + i < r1) xrow_issue<XB>(F, r0 + i, 1, lane, ring[i]);
#pragma unroll 1
    for (int rb = r0; rb < r1; rb += 4) {
#pragma unroll
        for (int i = 0; i < 4; ++i) {
            const int row = rb + i;
            if (row < r1) {
                const int gr = row < TOKL ? (row >> 11) : 16;
                if (gr != grp) { grp = gr; const GAS float* shp = mod_ptr(F, layer, row, which); const GAS float* scp = mod_ptr(F, layer, row, which + 1);
#pragma unroll
                    for (int j = 0; j < 4; ++j) { const f32x4 gg = *(const GAS f32x4*)(g + 256 * j + 4 * lane), sc = *(const GAS f32x4*)(scp + 256 * j + 4 * lane); sh[j] = *(const GAS f32x4*)(shp + 256 * j + 4 * lane);
                        gm[j].x = gg.x * (1.f + sc.x); gm[j].y = gg.y * (1.f + sc.y); gm[j].z = gg.z * (1.f + sc.z); gm[j].w = gg.w * (1.f + sc.w); } }
                f32x4 v[4]; float s = 0.f;
#pragma unroll
                for (int j = 0; j < 4; ++j) { v[j] = xrow_unpack(ring[i][j]); s += (v[j].x * v[j].x + v[j].y * v[j].y) + (v[j].z * v[j].z + v[j].w * v[j].w); }
                if (row + 4 < r1) xrow_issue<XB>(F, row + 4, 1, lane, ring[i]);
                const float r = rsqrtf(wave_sum(s) * (1.0f / 1024.0f) + 1e-6f);
                GAS bf16* orow = WSP(bf16, WS_H) + (size_t)row * D;
#pragma unroll
                for (int j = 0; j < 4; ++j) {
                    f32x4 o; o.x = v[j].x * r * gm[j].x + sh[j].x; o.y = v[j].y * r * gm[j].y + sh[j].y; o.z = v[j].z * r * gm[j].z + sh[j].z; o.w = v[j].w * r * gm[j].w + sh[j].w;
                    u32x2 w; w.x = pk2(o.x, o.y); w.y = pk2(o.z, o.w);
                    *(GAS u32x2*)(orow + 256 * j + 4 * lane) = w;
                }
            }
        }
    }
}

namespace pg8 {
#ifndef WGM_
#define WGM_ 4
#endif
#ifndef PG8_SP2_
#define PG8_SP2_ 1
#endif
#ifndef PG8_ALIGN_
#define PG8_ALIGN_ 1
#endif
constexpr int BM = 256, BK = 64, HALF = 128, HTB = HALF * BK * 2, STAGE_BYTES = 8 * HTB, NXCD = 8, WGM = WGM_;
__device__ __forceinline__ int lds_byte(int r, int c) { const int st = (r >> 4) * 2 + (c >> 5), rr = r & 15, cc = c & 31, ob = rr * 64 + cc * 2; return st * 1024 + (ob ^ (((ob >> 9) & 1) << 5)); }
__device__ __forceinline__ void stage_rc(int b, int& R, int& C) { const int st = b / 1024, sb = b % 1024, swz = sb ^ (((sb >> 9) & 1) << 5); R = (st >> 1) * 16 + swz / 64; C = (st & 1) * 32 + (swz % 64) / 2; }
struct Unit { int pm, pn; };
template <int MR_>
struct OrderPlainT {
    static constexpr bool GATHER = false; static constexpr int MROWS = MR_;
    int nM, nN, nwg, G, c;
    __device__ __forceinline__ void init(int nM_, int nN_, int G_, int c_) { nM = nM_; nN = nN_; nwg = nM * nN; G = G_; c = c_; }
    __device__ __forceinline__ bool next(int i, Unit& u) const {
        const long L = (long)i * G + c; if (L >= nwg) return false;
        int wgid = (int)L; { const int q = nwg / NXCD, r = nwg % NXCD, xcd = wgid % NXCD, off = wgid / NXCD; wgid = (xcd < r ? xcd * (q + 1) : r * (q + 1) + (xcd - r) * q) + off; }
        const int nig = WGM * nN, gid = wgid / nig, fm = gid * WGM, gsz = (nM - fm) < WGM ? (nM - fm) : WGM;
        u.pm = fm + ((wgid % nig) % gsz); u.pn = (wgid % nig) / gsz; return true;
    }
    __device__ __forceinline__ int arow(int r) const { return r; }
    __device__ __forceinline__ size_t boff(const Unit&) const { return 0; }
};
using OrderPlain = OrderPlainT<256>;
struct OrderWinL1 {
    static constexpr bool GATHER = false; static constexpr int MROWS = 256;
    OrderPlain o; int G, c;
    __device__ __forceinline__ void init(int G_, int c_) { o.init(128, 15, G_, c_); G = G_; c = c_; }
    __device__ __forceinline__ bool next(int i, Unit& u) const {
        const long L = (long)i * G + c;
        if (L < 1920) return o.next(i, u);
        const int r = (int)(L - 1920); if (r >= 112) return false;
        const int q = r % 7; u.pm = 128 + r / 7; u.pn = q == 0 ? 4 : (q <= 4 ? 5 + q : 7 + q);
        return true;
    }
    __device__ __forceinline__ int arow(int r) const { return r; }
    __device__ __forceinline__ size_t boff(const Unit&) const { return 0; }
};
struct OrderMoe {
    static constexpr bool GATHER = true; static constexpr int MROWS = 256;
    OrderPlain o; const GAS int* rowidx; const GAS int* tilee; int t0; size_t bstride; bool gather;
    __device__ __forceinline__ bool next(int i, Unit& u) const { return o.next(i, u); }
    __device__ __forceinline__ int arow(int r) const { return gather ? rowidx[t0 * 256 + r] : r; }
    __device__ __forceinline__ size_t boff(const Unit& u) const { return (size_t)tilee[t0 + u.pm] * bstride; }
};

template <class Epi, class Sched>
__device__ __forceinline__ void gemm_phase(LAS unsigned char* lds, int tid_in, const GAS bf16* A, int lda, const GAS bf16* Bt, int ldb, int K, const Sched& S, const Epi& E) {
    unsigned tid_u = (unsigned)tid_in; asm volatile("" : "+v"(tid_u));
    const int tid = (int)tid_u, wid = __builtin_amdgcn_readfirstlane(tid >> 6), lane = tid & 63, wr = wid >> 2, wc = wid & 3, fr = lane & 15, fq = lane >> 4;
    const int nt = K / BK;
    constexpr int MR = Sched::MROWS, HR = MR / 2, WRR = HR / 2, NMF = WRR / 16;
    static_assert(MR == 256 || (MR == 192 && !Sched::GATHER), "unit rows");
    unsigned voffB[2];
    { int sR[2], sC[2];
#pragma unroll
      for (int i = 0; i < 2; ++i) { stage_rc(tid * 16 + i * 8192, sR[i], sC[i]);
        const int rho = sR[i] & 31, Rb = Epi::PERM ? ((sR[i] & ~31) + 8 * ((rho & 15) >> 2) + 4 * (rho >> 4) + (rho & 3)) : sR[i];
        voffB[i] = (unsigned)(Rb * ldb + sC[i]) * 2u; } }
#define PG8_GATHER_OFFS(pm_) do { unsigned _t = (unsigned)tid; asm volatile("" : "+v"(_t)); _Pragma("unroll") for (int i = 0; i < 2; ++i) { int _R, _C; stage_rc((int)_t * 16 + i * 8192, _R, _C); \
        vc0[i] = (unsigned)((size_t)S.arow((pm_) * BM + _R) * lda + _C) * 2u; vc1[i] = (unsigned)((size_t)S.arow((pm_) * BM + HALF + _R) * lda + _C) * 2u; } } while (0)
    const size_t kstep = (size_t)(BK * 2);
    const size_t hstepB = (size_t)HALF * ldb * 2, tstepB = 2 * hstepB;
    const unsigned ldsw = (unsigned)wid * 1024u;
    const int aoff = lds_byte(wr * WRR + fr, fq * 8), boff = lds_byte(wc * 32 + fr, fq * 8);
#define PG8_SA(b, h) (((b) * 2 + (h)) * HTB)
#define PG8_SB(b, h) ((4 + (b) * 2 + (h)) * HTB)
#define PG8_STAGE2(bufoff, gbase, uo, v0, v1) do { \
        __builtin_amdgcn_global_load_lds((const GAS unsigned*)((const GAS char*)(gbase) + (unsigned)((v0) + (unsigned)(uo))), (LAS unsigned*)(lds + (bufoff) + ldsw), 16, 0, 0); \
        __builtin_amdgcn_global_load_lds((const GAS unsigned*)((const GAS char*)(gbase) + (unsigned)((v1) + (unsigned)(uo))), (LAS unsigned*)(lds + (bufoff) + ldsw + 8192), 16, 0, 0); } while (0)
#define PG8_STAGEB(bufoff, gbase, uo) PG8_STAGE2(bufoff, gbase, uo, voffB[0], voffB[1])
#define PG8_LDA(dst, b, h) do { _Pragma("unroll") for (int m = 0; m < NMF; ++m) _Pragma("unroll") for (int k = 0; k < 2; ++k) dst[m][k] = *(const LAS bf16x8*)(lds + PG8_SA(b, h) + aoff + m * 2048 + k * 1024); } while (0)
#define PG8_LDB(dst, b, h) do { _Pragma("unroll") for (int n = 0; n < 2; ++n) _Pragma("unroll") for (int k = 0; k < 2; ++k) dst[n][k] = *(const LAS bf16x8*)(lds + PG8_SB(b, h) + boff + n * 2048 + k * 1024); } while (0)
#define PG8_MMA(ai, bj, At, Bt_) do { __builtin_amdgcn_s_setprio(1); _Pragma("unroll") for (int m = 0; m < NMF; ++m) _Pragma("unroll") for (int n = 0; n < 2; ++n) _Pragma("unroll") for (int k = 0; k < 2; ++k) \
        acc[ai][bj][m][n] = __builtin_amdgcn_mfma_f32_16x16x32_bf16(Bt_[n][k], At[m][k], acc[ai][bj][m][n], 0, 0, 0); __builtin_amdgcn_s_setprio(0); } while (0)
#define PG8_WAIT_V(n) asm volatile("s_waitcnt vmcnt(" #n ")" ::: "memory")
#define PG8_WAIT_L(n) asm volatile("s_waitcnt lgkmcnt(" #n ")" ::: "memory")
#define PG8_BAR __builtin_amdgcn_s_barrier()
#define PG8_SCHED __builtin_amdgcn_sched_barrier(0)
    Unit cur, nxt; int ui = 0;
    if (!S.next(0, cur)) return;
#ifndef STAGGER
#define STAGGER 0
#endif
    if (STAGGER) { const int grp = (int)(blockIdx.x >> 3) & 3;
        for (int i = 0; i < grp * STAGGER; ++i) __builtin_amdgcn_s_sleep(127); }
    f32x4 acc[2][2][4][2];
#pragma unroll
    for (int a = 0; a < 2; ++a)
#pragma unroll
        for (int b = 0; b < 2; ++b)
#pragma unroll
            for (int m = 0; m < NMF; ++m)
#pragma unroll
                for (int n = 0; n < 2; ++n) { float zf; asm volatile("v_mov_b32 %0, 0" : "=v"(zf)); acc[a][b][m][n] = (f32x4){zf, zf, zf, zf}; }
    bf16x8 At[4][2], B0[2][2], B1[2][2];
    constexpr bool GA = Sched::GATHER;
    const size_t hstepA = GA ? 0 : (size_t)HR * lda * 2, tstepA = (size_t)MR * lda * 2;
    unsigned vc0[2], vc1[2];
    if constexpr (GA) { PG8_GATHER_OFFS(cur.pm); }
    else { int sR, sC;
#pragma unroll
        for (int i = 0; i < 2; ++i) { stage_rc(tid * 16 + i * 8192, sR, sC); if (MR == 192 && sR >= HR) { sR = 0; sC = 0; }
            vc0[i] = (unsigned)(sR * lda + sC) * 2u; vc1[i] = 0u; } }
#define VC0(i) vc0[i]
#define VC1(i) (GA ? vc1[i] : vc0[i])
#define VN0(i) vc0[i]
#define VN1(i) VC1(i)
    const GAS char* cA = GA ? (const GAS char*)A : (const GAS char*)A + (size_t)cur.pm * tstepA;
    const GAS char* cB = (const GAS char*)Bt + S.boff(cur) * 2 + (size_t)cur.pn * tstepB;
    constexpr bool SP2 = PG8_SP2_ != 0, ALIGN_EPI = PG8_ALIGN_ != 0;
    const unsigned hsA = (unsigned)hstepA, hsB = (unsigned)hstepB;
    if constexpr (SP2) {
        PG8_STAGEB(PG8_SB(0, 0), cB, 0u); PG8_STAGEB(PG8_SB(0, 1), cB, hsB); PG8_STAGE2(PG8_SA(0, 0), cA, 0u, VC0(0), VC0(1)); PG8_STAGE2(PG8_SA(0, 1), cA, hsA, VC1(0), VC1(1));
        if (wr == 1) PG8_BAR;
        PG8_WAIT_V(2); PG8_BAR;
        PG8_STAGEB(PG8_SB(1, 0), cB, 128u); PG8_STAGE2(PG8_SA(1, 0), cA, 128u, VC0(0), VC0(1)); PG8_STAGEB(PG8_SB(1, 1), cB, hsB + 128u);
        PG8_WAIT_V(6); PG8_BAR;
    } else {
        PG8_STAGEB(PG8_SB(0, 0), cB, 0u); PG8_STAGE2(PG8_SA(0, 0), cA, 0u, VC0(0), VC0(1)); PG8_STAGEB(PG8_SB(0, 1), cB, hsB); PG8_STAGE2(PG8_SA(0, 1), cA, hsA, VC1(0), VC1(1));
        if (wr == 1) PG8_BAR;
        PG8_WAIT_V(4); PG8_BAR;
        PG8_STAGEB(PG8_SB(1, 0), cB, 128u); PG8_STAGE2(PG8_SA(1, 0), cA, 128u, VC0(0), VC0(1)); PG8_STAGEB(PG8_SB(1, 1), cB, hsB + 128u);
        PG8_WAIT_V(6); PG8_BAR;
    }
    for (;;) {
        const bool has_next = S.next(ui + 1, nxt);
        const GAS char* nB = cB; const GAS char* nA = cA;
        if (has_next) {
            nB = (const GAS char*)Bt + S.boff(nxt) * 2 + (size_t)nxt.pn * tstepB;
            if constexpr (!GA) nA = (const GAS char*)A + (size_t)nxt.pm * tstepA;
        }
        for (int t = 0; t < nt; t += 2) {
            const bool last = (t == nt - 2);
            if constexpr (Epi::HORNER) {
                if (t == 6 || t == 12) {
                    asm volatile("" ::: "memory");
                    const int seg = (t == 6) ? 0 : 1;
                    int hpm = cur.pm, hpn = cur.pn; asm volatile("" : "+s"(hpm), "+s"(hpn));
                    unsigned hln = (unsigned)lane; asm volatile("" : "+v"(hln)); const int hfr = (int)(hln & 15u), hfq = (int)(hln >> 4);
#pragma unroll
                    for (int ai = 0; ai < 2; ++ai) {
                        u32x4 ga[4][2], gb[4][2];
#pragma unroll
                        for (int m = 0; m < NMF; ++m)
#pragma unroll
                            for (int bj = 0; bj < 2; ++bj) {
                                const int row = hpm * MR + ai * HR + wr * WRR + m * 16 + hfr, col = hpn * BM + bj * HALF + wc * 32 + 8 * hfq;
                                ga[m][bj] = E.gate8(seg, row, col); gb[m][bj] = E.gate8(seg + 1, row, col);
                            }
                        if constexpr (NMF == 4) asm volatile("" : "+v"(ga[0][0]), "+v"(ga[0][1]), "+v"(ga[1][0]), "+v"(ga[1][1]), "+v"(ga[2][0]), "+v"(ga[2][1]), "+v"(ga[3][0]), "+v"(ga[3][1]),
                                          "+v"(gb[0][0]), "+v"(gb[0][1]), "+v"(gb[1][0]), "+v"(gb[1][1]), "+v"(gb[2][0]), "+v"(gb[2][1]), "+v"(gb[3][0]), "+v"(gb[3][1]) :: "memory");
                        else asm volatile("" : "+v"(ga[0][0]), "+v"(ga[0][1]), "+v"(ga[1][0]), "+v"(ga[1][1]), "+v"(ga[2][0]), "+v"(ga[2][1]),
                                          "+v"(gb[0][0]), "+v"(gb[0][1]), "+v"(gb[1][0]), "+v"(gb[1][1]), "+v"(gb[2][0]), "+v"(gb[2][1]) :: "memory");
#pragma unroll
                        for (int m = 0; m < NMF; ++m)
#pragma unroll
                            for (int bj = 0; bj < 2; ++bj) {
                                const unsigned aw[4] = {ga[m][bj].x, ga[m][bj].y, ga[m][bj].z, ga[m][bj].w}, bw[4] = {gb[m][bj].x, gb[m][bj].y, gb[m][bj].z, gb[m][bj].w};
#pragma unroll
                                for (int n = 0; n < 2; ++n) {
                                    f32x4& v = acc[ai][bj][m][n];
                                    v.x *= __uint_as_float(aw[2 * n] << 16) * __builtin_amdgcn_rcpf(__uint_as_float(bw[2 * n] << 16));
                                    v.y *= __uint_as_float(aw[2 * n] & 0xffff0000u) * __builtin_amdgcn_rcpf(__uint_as_float(bw[2 * n] & 0xffff0000u));
                                    v.z *= __uint_as_float(aw[2 * n + 1] << 16) * __builtin_amdgcn_rcpf(__uint_as_float(bw[2 * n + 1] << 16));
                                    v.w *= __uint_as_float(aw[2 * n + 1] & 0xffff0000u) * __builtin_amdgcn_rcpf(__uint_as_float(bw[2 * n + 1] & 0xffff0000u));
                                }
                            }
                    }
                    asm volatile("s_waitcnt vmcnt(0)" ::: "memory");
                }
            }
            const unsigned k1 = (unsigned)(t + 1) * 128u, k2 = last ? 0u : (unsigned)(t + 2) * 128u, k3 = k2 + 128u;
            const GAS char* pA2 = last ? nA : cA; const GAS char* pB2 = last ? nB : cB;
            if constexpr (SP2) {
            PG8_LDB(B0, 0, 0); PG8_LDB(B1, 0, 1); PG8_SCHED; PG8_LDA(At, 0, 0); PG8_STAGE2(PG8_SA(1, 1), cA, k1 + hsA, VC1(0), VC1(1));
            if constexpr (GA) { if (last && has_next) { asm volatile("" ::: "memory"); PG8_GATHER_OFFS(nxt.pm); asm volatile("" ::: "memory"); } }
            PG8_WAIT_V(8); PG8_WAIT_L(0); PG8_BAR; PG8_MMA(0, 0, At, B0); PG8_MMA(0, 1, At, B1); PG8_BAR; PG8_SCHED;
            PG8_LDA(At, 0, 1); PG8_STAGEB(PG8_SB(0, 0), pB2, k2); PG8_STAGEB(PG8_SB(0, 1), pB2, k2 + hsB); PG8_STAGE2(PG8_SA(0, 0), pA2, k2, VN0(0), VN0(1));
            PG8_WAIT_V(8); PG8_WAIT_L(0); PG8_BAR; PG8_MMA(1, 0, At, B0); PG8_MMA(1, 1, At, B1); PG8_BAR; PG8_SCHED;
            PG8_LDB(B0, 1, 0); PG8_LDB(B1, 1, 1); PG8_SCHED; PG8_LDA(At, 1, 0); PG8_STAGE2(PG8_SA(0, 1), pA2, k2 + hsA, VN1(0), VN1(1));
            PG8_WAIT_V(8); PG8_WAIT_L(0); PG8_BAR; PG8_MMA(0, 0, At, B0); PG8_MMA(0, 1, At, B1); PG8_BAR; PG8_SCHED;
            PG8_LDA(At, 1, 1); PG8_STAGEB(PG8_SB(1, 0), pB2, k3); PG8_STAGEB(PG8_SB(1, 1), pB2, k3 + hsB); PG8_STAGE2(PG8_SA(1, 0), pA2, k3, VN0(0), VN0(1));
            PG8_WAIT_V(8); PG8_WAIT_L(0); PG8_BAR; PG8_MMA(1, 0, At, B0); PG8_MMA(1, 1, At, B1); PG8_BAR; PG8_SCHED;
            } else {
            PG8_LDB(B0, 0, 0); PG8_SCHED; PG8_LDA(At, 0, 0); PG8_STAGE2(PG8_SA(1, 1), cA, k1 + hsA, VC1(0), VC1(1));
            if constexpr (GA) { if (last && has_next) { asm volatile("" ::: "memory"); PG8_GATHER_OFFS(nxt.pm); asm volatile("" ::: "memory"); } }
            PG8_WAIT_L(8); PG8_BAR; PG8_WAIT_L(0); PG8_MMA(0, 0, At, B0); PG8_BAR; PG8_SCHED;
            PG8_LDB(B1, 0, 1); PG8_STAGEB(PG8_SB(0, 0), pB2, k2);
            PG8_BAR; PG8_WAIT_L(0); PG8_MMA(0, 1, At, B1); PG8_BAR;
            PG8_LDA(At, 0, 1); PG8_STAGE2(PG8_SA(0, 0), pA2, k2, VN0(0), VN0(1));
            PG8_BAR; PG8_WAIT_L(0); PG8_MMA(1, 0, At, B0); PG8_BAR; PG8_SCHED;
            PG8_STAGEB(PG8_SB(0, 1), pB2, k2 + hsB);
            PG8_WAIT_V(6); PG8_BAR; PG8_MMA(1, 1, At, B1); PG8_BAR;
            PG8_LDB(B0, 1, 0); PG8_SCHED; PG8_LDA(At, 1, 0); PG8_STAGE2(PG8_SA(0, 1), pA2, k2 + hsA, VN1(0), VN1(1));
            PG8_WAIT_L(8); PG8_BAR; PG8_WAIT_L(0); PG8_MMA(0, 0, At, B0); PG8_BAR; PG8_SCHED;
            PG8_LDB(B1, 1, 1); PG8_STAGEB(PG8_SB(1, 0), pB2, k3);
            PG8_BAR; PG8_WAIT_L(0); PG8_MMA(0, 1, At, B1); PG8_BAR;
            PG8_LDA(At, 1, 1); PG8_STAGE2(PG8_SA(1, 0), pA2, k3, VN0(0), VN0(1));
            PG8_BAR; PG8_WAIT_L(0); PG8_MMA(1, 0, At, B0); PG8_BAR; PG8_SCHED;
            PG8_STAGEB(PG8_SB(1, 1), pB2, k3 + hsB);
            PG8_WAIT_V(6); PG8_BAR; PG8_MMA(1, 1, At, B1); PG8_BAR;
                    }
        }
        if constexpr (ALIGN_EPI) { if (wr == 0) PG8_BAR; }
#ifndef REP_EPI
#define REP_EPI 1
#endif
#pragma unroll 1
        for (int rpe = 0; rpe < ((Epi::COLVEC && Epi::BASE) ? 1 : REP_EPI); ++rpe) {
            int epm = cur.pm, epn = cur.pn; asm volatile("" : "+s"(epm), "+s"(epn));
            unsigned eln = (unsigned)lane; asm volatile("" : "+v"(eln)); const int efr = (int)(eln & 15u), efq = (int)(eln >> 4);
            constexpr bool PM = Epi::PERM;
#define PG8_COL(bj, n) (epn * BM + (bj) * HALF + wc * 32 + (PM ? 8 * efq + 4 * (n) : (n) * 16 + 4 * efq))
            f32x4 cv[2][2];
#pragma unroll
            for (int bj = 0; bj < 2; ++bj)
#pragma unroll
                for (int n = 0; n < 2; ++n) { if constexpr (Epi::COLVEC) cv[bj][n] = E.colvec(epm * MR, PG8_COL(bj, n)); else cv[bj][n] = (f32x4){0.f, 0.f, 0.f, 0.f}; }
            if constexpr (Epi::COLVEC) asm volatile("" : "+v"(cv[0][0]), "+v"(cv[0][1]), "+v"(cv[1][0]), "+v"(cv[1][1]) :: "memory");
            constexpr bool CV2 = Epi::COLVEC && Epi::ROWCV && MR != 256;
            f32x4 cv2[2][2];
            if constexpr (CV2) {
#pragma unroll
                for (int bj = 0; bj < 2; ++bj)
#pragma unroll
                    for (int n = 0; n < 2; ++n) cv2[bj][n] = E.colvec(epm * MR + MR - 1, PG8_COL(bj, n));
                asm volatile("" : "+v"(cv2[0][0]), "+v"(cv2[0][1]), "+v"(cv2[1][0]), "+v"(cv2[1][1]) :: "memory");
            }
#pragma unroll
            for (int ai = 0; ai < 2; ++ai) {
                f32x4 bs[4][2][2];
                if constexpr (Epi::BASE) {
#pragma unroll
                    for (int m = 0; m < NMF; ++m)
#pragma unroll
                        for (int bj = 0; bj < 2; ++bj) {
                            const int row = epm * MR + ai * HR + wr * WRR + m * 16 + efr;
                            if constexpr (PM) E.base8(row, PG8_COL(bj, 0), bs[m][bj][0], bs[m][bj][1]);
                            else {
#pragma unroll
                                for (int n = 0; n < 2; ++n) bs[m][bj][n] = E.base(row, PG8_COL(bj, n));
                            }
                        }
                    if constexpr (NMF == 4) asm volatile("" : "+v"(bs[0][0][0]), "+v"(bs[0][0][1]), "+v"(bs[0][1][0]), "+v"(bs[0][1][1]), "+v"(bs[1][0][0]), "+v"(bs[1][0][1]), "+v"(bs[1][1][0]), "+v"(bs[1][1][1]),
                                      "+v"(bs[2][0][0]), "+v"(bs[2][0][1]), "+v"(bs[2][1][0]), "+v"(bs[2][1][1]), "+v"(bs[3][0][0]), "+v"(bs[3][0][1]), "+v"(bs[3][1][0]), "+v"(bs[3][1][1]) :: "memory");
                    else asm volatile("" : "+v"(bs[0][0][0]), "+v"(bs[0][0][1]), "+v"(bs[0][1][0]), "+v"(bs[0][1][1]), "+v"(bs[1][0][0]), "+v"(bs[1][0][1]), "+v"(bs[1][1][0]), "+v"(bs[1][1][1]),
                                      "+v"(bs[2][0][0]), "+v"(bs[2][0][1]), "+v"(bs[2][1][0]), "+v"(bs[2][1][1]) :: "memory");
                }
#pragma unroll
                for (int m = 0; m < NMF; ++m) {
                    const int row = epm * MR + ai * HR + wr * WRR + m * 16 + efr;
                    bool alt = false; if constexpr (CV2) alt = E.rowgrp(epm * MR + ai * HR + wr * WRR + m * 16) != E.rowgrp(epm * MR);
#pragma unroll
                    for (int bj = 0; bj < 2; ++bj) {
                        if constexpr (Epi::PAIR) E.store_pair(row, epn * (BM / 2) + bj * (HALF / 2) + wc * 16 + 4 * efq, acc[ai][bj][m][0], acc[ai][bj][m][1]);
                        else if constexpr (PM) {
                            f32x4 b0 = (f32x4){0.f, 0.f, 0.f, 0.f}, b1 = b0; if constexpr (Epi::BASE) { b0 = bs[m][bj][0]; b1 = bs[m][bj][1]; }
                            E.store8(row, PG8_COL(bj, 0), acc[ai][bj][m][0], acc[ai][bj][m][1], (CV2 && alt) ? cv2[bj][0] : cv[bj][0], (CV2 && alt) ? cv2[bj][1] : cv[bj][1], b0, b1);
                        } else {
#pragma unroll
                            for (int n = 0; n < 2; ++n) { f32x4 bb = (f32x4){0.f, 0.f, 0.f, 0.f}; if constexpr (Epi::BASE) bb = bs[m][bj][n]; E.store(row, PG8_COL(bj, n), acc[ai][bj][m][n], (CV2 && alt) ? cv2[bj][n] : cv[bj][n], bb); }
                        }
                    }
                }
            }
#undef PG8_COL
        }
        if (!has_next) break;
#pragma unroll
        for (int a = 0; a < 2; ++a)
#pragma unroll
            for (int b = 0; b < 2; ++b)
#pragma unroll
                for (int m = 0; m < NMF; ++m)
#pragma unroll
                    for (int n = 0; n < 2; ++n) { float zf; asm volatile("v_mov_b32 %0, 0" : "=v"(zf)); acc[a][b][m][n] = (f32x4){zf, zf, zf, zf}; }
        cur = nxt; cB = nB; cA = nA; ++ui;
        if constexpr (ALIGN_EPI) { if (wr == 1) PG8_BAR; }
    }
    PG8_WAIT_V(0);
    if constexpr (!ALIGN_EPI) { if (wr == 0) PG8_BAR; }
    PG8_BAR;
#undef PG8_GATHER_OFFS
#undef VC0
#undef VC1
#undef VN0
#undef VN1
#undef PG8_SA
#undef PG8_SB
#undef PG8_STAGE2
#undef PG8_STAGEB
#undef PG8_LDA
#undef PG8_LDB
#undef PG8_MMA
#undef PG8_WAIT_V
#undef PG8_WAIT_L
#undef PG8_BAR
#undef PG8_SCHED
}
}

template <int MR = 256, class Epi>
__device__ __forceinline__ void gemm_fast(Frame& F, const GAS bf16* A, int lda, const GAS bf16* Bt, int ldb, int K, int M, int N, const Epi& E) {
    pg8::OrderPlainT<MR> S; S.init(M / MR, N / 256, F.G, F.wg);
    pg8::gemm_phase(F.lds, F.tid, A, lda, Bt, ldb, K, S, E);
}

__device__ __forceinline__ void st_bf16x4(GAS bf16* p, f32x4 v) { u32x2 w; w.x = pk2(v.x, v.y); w.y = pk2(v.z, v.w); *(GAS u32x2*)p = w; }
__device__ __forceinline__ f32x4 ld_bf16x4(const GAS bf16* p) { const u32x2 w = *(const GAS u32x2*)p; f32x4 v; v.x = __uint_as_float(w.x << 16); v.y = __uint_as_float(w.x & 0xffff0000u); v.z = __uint_as_float(w.y << 16); v.w = __uint_as_float(w.y & 0xffff0000u); return v; }

__device__ __forceinline__ void st_bf16x8(GAS bf16* p, f32x4 a, f32x4 b) { u32x4 w; w.x = pk2(a.x, a.y); w.y = pk2(a.z, a.w); w.z = pk2(b.x, b.y); w.w = pk2(b.z, b.w); *(GAS u32x4*)p = w; }
struct EpiWin {
    static constexpr bool HORNER = false, PAIR = false, COLVEC = true, BASE = false, PERM = true, ROWCV = false;
    const GAS float* bias; GAS bf16 *hytl, *hytc, *ret, *ml; GAS float* mlg;
    __device__ __forceinline__ f32x4 colvec(int, int col) const { return *(const GAS f32x4*)(bias + col); }
    __device__ __forceinline__ void store8(int row, int col, f32x4 v0, f32x4 v1, f32x4 c0, f32x4 c1, f32x4, f32x4) const {
        v0 += c0; v1 += c1;
        if (col < 1152) {
            const float v[8] = {v0.x, v0.y, v0.z, v0.w, v1.x, v1.y, v1.z, v1.w};
            if (row < TOKL) { const int b = row >> 11, t = row & 2047; GAS bf16* d = hytl + ((size_t)(b * 1152 + col)) * 2048 + t;
#pragma unroll
                for (int j = 0; j < 8; ++j) d[2048 * j] = (bf16)f2bf(v[j]); }
            else { const int r = row - TOKL, b = r >> 8, t = r & 255; GAS bf16* d = hytc + ((size_t)(b * 1152 + col)) * 256 + t;
#pragma unroll
                for (int j = 0; j < 8; ++j) d[256 * j] = (bf16)f2bf(v[j]); }
        } else if (col < 1168) { *(GAS f32x4*)(mlg + (size_t)row * 16 + (col - 1152)) = v0; *(GAS f32x4*)(mlg + (size_t)row * 16 + (col - 1152) + 4) = v1; }
        else if (col < 1280) { }
        else if (col < 2816) st_bf16x8(ret + (size_t)row * 1536 + (col - 1280), v0, v1);
        else st_bf16x8(ml + (size_t)row * 1024 + (col - 2816), v0, v1);
    }
};
struct EpiGate {
    static constexpr bool HORNER = false, PAIR = false, COLVEC = true, BASE = false, PERM = true, ROWCV = false;
    const GAS float* bias; GAS bf16* gates;
    __device__ __forceinline__ f32x4 colvec(int, int col) const { return *(const GAS f32x4*)(bias + col); }
    __device__ __forceinline__ void store8(int row, int col, f32x4 v0, f32x4 v1, f32x4 c0, f32x4 c1, f32x4, f32x4) const {
        v0 += c0; v1 += c1;
        f32x4 g0, g1;
        g0.x = fmaxf(sigmoidf_(v0.x), 1e-20f); g0.y = fmaxf(sigmoidf_(v0.y), 1e-20f); g0.z = fmaxf(sigmoidf_(v0.z), 1e-20f); g0.w = fmaxf(sigmoidf_(v0.w), 1e-20f);
        g1.x = fmaxf(sigmoidf_(v1.x), 1e-20f); g1.y = fmaxf(sigmoidf_(v1.y), 1e-20f); g1.z = fmaxf(sigmoidf_(v1.z), 1e-20f); g1.w = fmaxf(sigmoidf_(v1.w), 1e-20f);
        st_bf16x8(gates + (size_t)row * NGATE + col, g0, g1);
    }
};
struct EpiUp {
    static constexpr bool HORNER = true, PAIR = false, COLVEC = false, BASE = true, PERM = true, ROWCV = false;
    const GAS bf16* gates; GAS bf16* acc_out;
    __device__ __forceinline__ u32x4 gate8(int which, int row, int col) const { return *(const GAS u32x4*)(gates + (size_t)row * NGATE + which * 1024 + col); }
    __device__ __forceinline__ void base8(int row, int col, f32x4& b0, f32x4& b1) const {
        const u32x4 w = *(const GAS u32x4*)(gates + (size_t)row * NGATE + 2048 + col);
        b0.x = __uint_as_float(w.x << 16); b0.y = __uint_as_float(w.x & 0xffff0000u); b0.z = __uint_as_float(w.y << 16); b0.w = __uint_as_float(w.y & 0xffff0000u);
        b1.x = __uint_as_float(w.z << 16); b1.y = __uint_as_float(w.z & 0xffff0000u); b1.z = __uint_as_float(w.w << 16); b1.w = __uint_as_float(w.w & 0xffff0000u);
    }
    __device__ __forceinline__ void store8(int row, int col, f32x4 v0, f32x4 v1, f32x4, f32x4, f32x4 g0, f32x4 g1) const { st_bf16x8(acc_out + (size_t)row * D + col, v0 * g0, v1 * g1); }
};
template <bool IN_BF16>
struct EpiResidT {
    static constexpr bool HORNER = false, PAIR = false, COLVEC = true, BASE = true, PERM = true, ROWCV = true;
    const GAS void *xin_l, *xin_c; GAS bf16 *xout_l, *xout_c; const GAS float* modbase; int which;
    __device__ __forceinline__ int rowgrp(int row) const { return row < TOKL ? (row >> 11) : 16; }
    __device__ __forceinline__ f32x4 colvec(int row0, int col) const { const int r = row0 < TOKL ? (row0 >> 11) : 16; return *(const GAS f32x4*)(modbase + ((size_t)r * 6 + which) * 1024 + col); }
    __device__ __forceinline__ void base8(int row, int col, f32x4& b0, f32x4& b1) const {
        const size_t o = row < TOKL ? (size_t)row * D + col : (size_t)(row - TOKL) * D + col;
        if constexpr (IN_BF16) {
            const u32x4 w = *(const GAS u32x4*)((const GAS bf16*)(row < TOKL ? xin_l : xin_c) + o);
            b0.x = __uint_as_float(w.x << 16); b0.y = __uint_as_float(w.x & 0xffff0000u); b0.z = __uint_as_float(w.y << 16); b0.w = __uint_as_float(w.y & 0xffff0000u);
            b1.x = __uint_as_float(w.z << 16); b1.y = __uint_as_float(w.z & 0xffff0000u); b1.z = __uint_as_float(w.w << 16); b1.w = __uint_as_float(w.w & 0xffff0000u);
        } else { const GAS float* p = (const GAS float*)(row < TOKL ? xin_l : xin_c) + o; b0 = *(const GAS f32x4*)p; b1 = *(const GAS f32x4*)(p + 4); }
    }
    __device__ __forceinline__ void store8(int row, int col, f32x4 v0, f32x4 v1, f32x4 c0, f32x4 c1, f32x4 b0, f32x4 b1) const {
        st_bf16x8(row < TOKL ? xout_l + (size_t)row * D + col : xout_c + (size_t)(row - TOKL) * D + col, b0 + c0 * v0, b1 + c1 * v1);
    }
};
struct EpiSwiglu {
    static constexpr bool HORNER = false, PAIR = true, COLVEC = false, BASE = false, PERM = false, ROWCV = false;
    GAS bf16* act; int row_off;
    __device__ __forceinline__ void store_pair(int row, int col, f32x4 a, f32x4 b) const {
        f32x4 o; o.x = siluf_(a.x) * b.x; o.y = siluf_(a.y) * b.y; o.z = siluf_(a.z) * b.z; o.w = siluf_(a.w) * b.w;
        st_bf16x4(act + (size_t)(row - row_off) * DFF + col, o);
    }
    __device__ __forceinline__ void store(int, int, f32x4, f32x4, f32x4) const {}
};
struct EpiBf16Out {
    static constexpr bool HORNER = false, PAIR = false, COLVEC = false, BASE = false, PERM = true, ROWCV = false;
    GAS bf16* out; int ld; int row_add;
    __device__ __forceinline__ void store8(int row, int col, f32x4 v0, f32x4 v1, f32x4, f32x4, f32x4, f32x4) const { st_bf16x8(out + (size_t)(row + row_add) * ld + col, v0, v1); }
};

template <int L>
__device__ __forceinline__ void hyena_unit_fast(Frame& F, int layer, int c, int cn  , const GAS bf16* hyt  , const GAS bf16* ft  , GAS bf16* yht  ) {
    constexpr int ZP = (L + 8) * 2;
    constexpr int PER = L / 32;
    constexpr int I = L / 128;
    constexpr int SPAN = L / 4, NSTEP = L / 32;
    constexpr int CP = (2 * L + 8) * 2;
    LAS unsigned char* zimg = F.lds;
    LAS unsigned char* cpy = F.lds + 16 * ZP;
    const GAS float* cw = inp(F, I_HYCONV) + layer * 3 * 1152;
    const GAS float* skip = inp(F, I_HYSKIP) + layer * 2 * 384;
    const int lane = F.lane, fr = lane & 15, fq = lane >> 4, w = F.wave;
    { unsigned long long a_ = (unsigned long long)hyt, b_ = (unsigned long long)yht; asm volatile("" : "+s"(a_), "+s"(b_)); hyt = (const GAS bf16*)a_; yht = (GAS bf16*)b_; }
    __syncthreads();
    {
        const int b = F.tid >> 5, sg = F.tid & 31, t0 = sg * PER; const GAS bf16* src = hyt + ((size_t)(b * 1152 + c)) * L + t0;
        const float w0 = cw[c], w1 = cw[1152 + c], w2 = cw[2304 + c];
        u32x4 raw[PER / 8];
#pragma unroll
        for (int j = 0; j < PER / 8; ++j) raw[j] = *(const GAS u32x4*)(src + 8 * j);
        float prev = t0 > 0 ? bf2f(src[-1]) : 0.f;
        const float nextv = t0 + PER < L ? bf2f(src[PER]) : 0.f;
#pragma unroll
        for (int j = 0; j < PER / 8; ++j) {
            const unsigned wv[4] = {raw[j].x, raw[j].y, raw[j].z, raw[j].w};
            float x[10]; x[0] = prev;
#pragma unroll
            for (int q = 0; q < 4; ++q) { x[1 + 2 * q] = __uint_as_float(wv[q] << 16); x[2 + 2 * q] = __uint_as_float(wv[q] & 0xffff0000u); }
            if (j + 1 < PER / 8) x[9] = __uint_as_float(raw[(j + 1 < PER / 8) ? j + 1 : j].x << 16); else x[9] = nextv;
            u32x4 o;
            o.x = pk2(w0 * x[0] + w1 * x[1] + w2 * x[2], w0 * x[1] + w1 * x[2] + w2 * x[3]); o.y = pk2(w0 * x[2] + w1 * x[3] + w2 * x[4], w0 * x[3] + w1 * x[4] + w2 * x[5]);
            o.z = pk2(w0 * x[4] + w1 * x[5] + w2 * x[6], w0 * x[5] + w1 * x[6] + w2 * x[7]); o.w = pk2(w0 * x[6] + w1 * x[7] + w2 * x[8], w0 * x[7] + w1 * x[8] + w2 * x[9]);
            *(LAS u32x4*)(zimg + b * ZP + (t0 + 8 * j) * 2) = o;
            prev = x[8];
        }
    }
    const int tbase = SPAN * (w >> 1) + 16 * (w & 1);
    const int flane = L - tbase + 8 * fq - fr;
    const int msh = fr & 7;
    const LAS unsigned char* fbase = cpy + msh * CP + 2 * (flane + msh);
#pragma unroll 1
    for (int o = 0; o < 2; ++o) {
        const GAS bf16* fsrc = ft + ((size_t)(o * 384 + c)) * (2 * L);
        for (int i = F.tid; i < CP / 16; i += NTHR) { u32x4 v = (u32x4){0u, 0u, 0u, 0u}; if (i < 2 * L / 8) v = *(const GAS u32x4*)(fsrc + 8 * i); if (i == 0) v.x &= 0xffff0000u; *(LAS u32x4*)(cpy + 16 * i) = v; }
        __syncthreads();
        for (int task = F.tid; task < 7 * (CP / 16); task += NTHR) {
            const int m = 1 + task / (CP / 16), x8 = task % (CP / 16);
            unsigned short e[8];
#pragma unroll
            for (int i = 0; i < 8; ++i) { const int idx = 8 * x8 - m + i; e[i] = idx >= 0 ? *(const LAS unsigned short*)(cpy + 2 * idx) : (unsigned short)0; }
            u32x4 v; v.x = e[0] | ((unsigned)e[1] << 16); v.y = e[2] | ((unsigned)e[3] << 16); v.z = e[4] | ((unsigned)e[5] << 16); v.w = e[6] | ((unsigned)e[7] << 16);
            *(LAS u32x4*)(cpy + m * CP + 16 * x8) = v;
        }
        __syncthreads();
        f32x4 acc[I];
#pragma unroll
        for (int i = 0; i < I; ++i) acc[i] = (f32x4){0.f, 0.f, 0.f, 0.f};
        bf16x8 ring[I];
#pragma unroll
        for (int i = 1; i < I; ++i) ring[(I - i) % I] = *(const LAS bf16x8*)(fbase - 64 * i);
        bf16x8 nf = *(const LAS bf16x8*)(fbase);
        const LAS unsigned char* zrow = zimg + fr * ZP + 16 * fq;
        unsigned tc0 = 0u, tc1 = 0u, tc2 = 0u;
#ifndef NO_TOUCH
        { const int tb = F.tid >> 5, tsg = F.tid & 31;
          tc0 = *(const GAS unsigned*)(hyt + ((size_t)(tb * 1152 + (o == 0 ? 384 : 768) + c)) * L + tsg * (L / 32));
          if (o == 0) { if (F.tid < L / 32) tc1 = *(const GAS unsigned*)(ft + ((size_t)(384 + c)) * (2 * L) + F.tid * 64); }
          else if (cn >= 0) { tc1 = *(const GAS unsigned*)(hyt + ((size_t)(tb * 1152 + cn)) * L + tsg * (L / 32)); if (F.tid < L / 32) tc2 = *(const GAS unsigned*)(ft + (size_t)cn * (2 * L) + F.tid * 64); } }
#endif
#pragma unroll 1
        for (int j0 = 0; j0 < NSTEP; j0 += I) {
#pragma unroll
            for (int jj = 0; jj < I; ++jj) {
                const int j = j0 + jj;
                ring[jj] = nf;
                if (j + 1 < NSTEP) nf = *(const LAS bf16x8*)(fbase + 64 * (j + 1));
                const bf16x8 zf = *(const LAS bf16x8*)(zrow + 64 * j);
#pragma unroll
                for (int i = 0; i < I; ++i) acc[i] = __builtin_amdgcn_mfma_f32_16x16x32_bf16(ring[(jj - i + I) % I], zf, acc[i], 0, 0, 0);
            }
        }
        unsigned el_ = (unsigned)lane; asm volatile("" : "+v"(el_)); const int efr = (int)(el_ & 15u), efq = (int)(el_ >> 4);
        const int etb = SPAN * (w >> 1) + 16 * (w & 1);
        const int gcol = (o == 0 ? 384 : 768) + c;
        const GAS bf16* gsrc = hyt + ((size_t)(efr * 1152 + gcol)) * L;
        const float w0 = cw[gcol], w1 = cw[1152 + gcol], w2 = cw[2304 + gcol], sk = skip[o * 384 + c];
        GAS bf16* dst = yht + ((size_t)(efr * 384 + c)) * L;
        constexpr int GI = I < 8 ? I : 8;
#pragma unroll
        for (int i0 = 0; i0 < I; i0 += GI) {
            u32x2 grv[GI]; unsigned short gmv[GI], gpv[GI];
#pragma unroll
            for (int ii = 0; ii < GI; ++ii) {
                const int t = etb + 32 * (i0 + ii) + 4 * efq;
                grv[ii] = *(const GAS u32x2*)(gsrc + t); gmv[ii] = t > 0 ? gsrc[t - 1] : (unsigned short)0; gpv[ii] = t + 4 < L ? gsrc[t + 4] : (unsigned short)0;
            }
            asm volatile("" ::: "memory");
#pragma unroll
            for (int ii = 0; ii < GI; ++ii) {
                const int i = i0 + ii;
                const int t = etb + 32 * i + 4 * efq;
                const u32x2 zr = *(const LAS u32x2*)(zimg + efr * ZP + t * 2);
                const u32x2 gr = grv[ii];
                const float gm = bf2f(gmv[ii]), gp = bf2f(gpv[ii]);
                const float g0 = __uint_as_float(gr.x << 16), g1 = __uint_as_float(gr.x & 0xffff0000u), g2 = __uint_as_float(gr.y << 16), g3 = __uint_as_float(gr.y & 0xffff0000u);
                const float z0 = __uint_as_float(zr.x << 16), z1 = __uint_as_float(zr.x & 0xffff0000u), z2 = __uint_as_float(zr.y << 16), z3 = __uint_as_float(zr.y & 0xffff0000u);
                const float o0 = (w0 * gm + w1 * g0 + w2 * g1) * (acc[i].x + sk * z0), o1 = (w0 * g0 + w1 * g1 + w2 * g2) * (acc[i].y + sk * z1);
                const float o2 = (w0 * g1 + w1 * g2 + w2 * g3) * (acc[i].z + sk * z2), o3 = (w0 * g2 + w1 * g3 + w2 * gp) * (acc[i].w + sk * z3);
                acc[i] = (f32x4){o0, o1, o2, o3};
            }
        }
        __syncthreads();
        { unsigned tk = tc0 ^ tc1 ^ tc2; asm volatile("" :: "v"(tk)); }
#pragma unroll
        for (int i = 0; i < I; ++i) {
            const int t = etb + 32 * i + 4 * efq;
            u32x2 ov; ov.x = pk2(acc[i].x, acc[i].y); ov.y = pk2(acc[i].z, acc[i].w);
            if (o == 0) *(LAS u32x2*)(zimg + efr * ZP + t * 2) = ov;
            else *(GAS u32x2*)(dst + t) = ov;
        }
    }
}

#ifndef REP_CH
#define REP_CH 1
#endif
#ifndef REP_CH_ML
#define REP_CH_ML REP_CH
#endif
#ifndef REP_CH_RET
#define REP_CH_RET REP_CH
#endif
constexpr int CH_PITCH = 144;
constexpr int CH_IMG = 64 * CH_PITCH;
constexpr int CH_WAVE_LDS = 3 * CH_IMG + 1024 + 512;
__device__ __forceinline__ void ds_tr16x8(unsigned addr, u32x2 (&lo)[4], u32x2 (&hi)[4]) {
    asm volatile("ds_read_b64_tr_b16 %0, %8\n\tds_read_b64_tr_b16 %1, %8 offset:32\n\tds_read_b64_tr_b16 %2, %8 offset:64\n\tds_read_b64_tr_b16 %3, %8 offset:96\n\t"
                 "ds_read_b64_tr_b16 %4, %8 offset:2304\n\tds_read_b64_tr_b16 %5, %8 offset:2336\n\tds_read_b64_tr_b16 %6, %8 offset:2368\n\tds_read_b64_tr_b16 %7, %8 offset:2400\n\t"
                 "s_waitcnt lgkmcnt(0)"
                 : "=&v"(lo[0]), "=&v"(lo[1]), "=&v"(lo[2]), "=&v"(lo[3]), "=&v"(hi[0]), "=&v"(hi[1]), "=&v"(hi[2]), "=&v"(hi[3]) : "v"(addr) : "memory");
}
static_assert(16 * CH_PITCH == 2304, "ds_tr16x8 offsets");
__device__ __forceinline__ void ds_tr16x4(unsigned addr, u32x2 (&lo)[2], u32x2 (&hi)[2]) {
    asm volatile("ds_read_b64_tr_b16 %0, %4\n\tds_read_b64_tr_b16 %1, %4 offset:32\n\tds_read_b64_tr_b16 %2, %4 offset:2304\n\tds_read_b64_tr_b16 %3, %4 offset:2336\n\ts_waitcnt lgkmcnt(0)"
                 : "=&v"(lo[0]), "=&v"(lo[1]), "=&v"(hi[0]), "=&v"(hi[1]) : "v"(addr) : "memory");
}
__device__ __forceinline__ float log_sigmoid_(float x) { return fminf(x, 0.f) - log1pf(__expf(-fabsf(x))); }
__device__ __forceinline__ bf16x8 mk_frag(u32x2 lo, u32x2 hi) { u32x4 w; w.x = lo.x; w.y = lo.y; w.z = hi.x; w.w = hi.y; return __builtin_bit_cast(bf16x8, w); }

template <bool IS_ML>
__device__ __forceinline__ void chain_fast(Frame& F, int layer, int b, int h, int dir, LAS unsigned char* img, int hf) {
    constexpr int NET = 2;
    const int lane = F.lane, fr = lane & 15, fq = lane >> 4;
    LAS unsigned char* Qi = img; LAS unsigned char* Ki = img + CH_IMG; LAS unsigned char* Vi = img + 2 * CH_IMG;
    const unsigned qa = (unsigned)(size_t)Qi, ka = (unsigned)(size_t)Ki, va = (unsigned)(size_t)Vi;
    const GAS bf16* RET = WSP(const bf16, WS_RET); const GAS bf16* ML = WSP(const bf16, WS_ML); const GAS float* MLG = WSP(const float, WS_MLG);
    const GAS float* rope = WSP(const float, WS_ROPE);
    GAS bf16* Y = WSP(bf16, WS_Y); GAS bf16* OB = WSP(bf16, WS_OB);
    float lgam = 0.f, bi_ = 0.f, bf_ = 0.f;
    if (!IS_ML) lgam = log_sigmoid_(inp(F, I_RETDECAY)[layer * 12 + dir * 6 + h]);
    else { bi_ = inp(F, I_MLGB)[layer * 16 + dir * 8 + h]; bf_ = inp(F, I_MLGB)[layer * 16 + dir * 8 + 4 + h]; }
    const GAS float* mlc = inp(F, I_MLCONV) + layer * 3 * 512;
    f32x4 C[4][NET];
#pragma unroll
    for (int dt = 0; dt < 4; ++dt)
#pragma unroll
        for (int et = 0; et < NET; ++et) C[dt][et] = (f32x4){0.f, 0.f, 0.f, 0.f};
    const int cq = lane & 7, pr0 = lane >> 3;
    LAS float* nvec = (LAS float*)(img + 3 * CH_IMG + 1024 + 256 * hf);
    if (IS_ML) nvec[lane] = 0.f;
    const LAS float* nq = nvec + 4 * fq;
    unsigned sink = 0u;
#pragma unroll 1
    for (int step_ = 0; step_ < 36 * (IS_ML ? REP_CH_ML : REP_CH_RET); ++step_) {
        const int step = step_ % 36;
        if ((IS_ML ? REP_CH_ML : REP_CH_RET) > 1 && step == 0) {
            if (IS_ML) nvec[lane] = 0.f;
#pragma unroll
            for (int dt = 0; dt < 4; ++dt)
#pragma unroll
                for (int et = 0; et < NET; ++et) C[dt][et] = (f32x4){0.f, 0.f, 0.f, 0.f};
        }
        int rowbase, t0, L; bool lat;
        if (step < 4) { const int cc = dir ? 3 - step : step; rowbase = TOKL + b * LC + cc * 64; t0 = cc * 64; L = LC; lat = false; }
        else { const int cc = dir ? 35 - step : step - 4; rowbase = b * LL + cc * 64; t0 = cc * 64; L = LL; lat = true; }
        float g_i = 0.f, g_f = 0.f;
        if (IS_ML) { const int tlg = dir ? 63 - lane : lane; const GAS float* gp = MLG + (size_t)(rowbase + tlg) * 16 + dir * 8 + h; g_i = gp[0]; g_f = gp[4]; }
        if constexpr (!IS_ML) {
#pragma unroll
        for (int i4 = 0; i4 < 4; ++i4) {
            const int i = 4 * hf + i4;
            const int p = pr0 + 8 * i, tl = dir ? 63 - p : p, row = rowbase + tl, tpos = t0 + tl;
            float qv[8], kv[8]; u32x4 vraw;
            {
                const GAS bf16* base = RET + (size_t)row * 1536 + h * 64;
                const u32x4 qr = *(const GAS u32x4*)(base + 8 * cq), kr = *(const GAS u32x4*)(base + 384 + 8 * cq); vraw = *(const GAS u32x4*)(base + 768 + 8 * cq);
                const unsigned qw[4] = {qr.x, qr.y, qr.z, qr.w}, kw[4] = {kr.x, kr.y, kr.z, kr.w};
#pragma unroll
                for (int j = 0; j < 4; ++j) { qv[2 * j] = __uint_as_float(qw[j] << 16); qv[2 * j + 1] = __uint_as_float(qw[j] & 0xffff0000u); kv[2 * j] = __uint_as_float(kw[j] << 16); kv[2 * j + 1] = __uint_as_float(kw[j] & 0xffff0000u); }
                if (lat) {
                    const u32x4 qpr = *(const GAS u32x4*)(base + 8 * (cq ^ 2)), kpr = *(const GAS u32x4*)(base + 384 + 8 * (cq ^ 2));
                    const unsigned qpw[4] = {qpr.x, qpr.y, qpr.z, qpr.w}, kpw[4] = {kpr.x, kpr.y, kpr.z, kpr.w};
                    const int half = cq >> 2, hi = (cq >> 1) & 1, i0 = 8 * (cq & 1);
                    const GAS float* rp = rope + tpos * 64 + half * 32 + i0;
                    const f32x4 c0 = *(const GAS f32x4*)(rp), c1 = *(const GAS f32x4*)(rp + 4), s0 = *(const GAS f32x4*)(rp + 16), s1 = *(const GAS f32x4*)(rp + 20);
                    const float cs[8] = {c0.x, c0.y, c0.z, c0.w, c1.x, c1.y, c1.z, c1.w}, sn[8] = {s0.x, s0.y, s0.z, s0.w, s1.x, s1.y, s1.z, s1.w};
#pragma unroll
                    for (int j = 0; j < 8; ++j) {
                        const float qp = (j & 1) ? __uint_as_float(qpw[j >> 1] & 0xffff0000u) : __uint_as_float(qpw[j >> 1] << 16);
                        const float kp = (j & 1) ? __uint_as_float(kpw[j >> 1] & 0xffff0000u) : __uint_as_float(kpw[j >> 1] << 16);
                        qv[j] = hi ? qp * sn[j] + qv[j] * cs[j] : qv[j] * cs[j] - qp * sn[j];
                        kv[j] = hi ? kp * sn[j] + kv[j] * cs[j] : kv[j] * cs[j] - kp * sn[j];
                    }
                }
#pragma unroll
                for (int j = 0; j < 8; ++j) qv[j] *= 0.125f;
            }
            u32x4 qo, ko; qo.x = pk2(qv[0], qv[1]); qo.y = pk2(qv[2], qv[3]); qo.z = pk2(qv[4], qv[5]); qo.w = pk2(qv[6], qv[7]);
            ko.x = pk2(kv[0], kv[1]); ko.y = pk2(kv[2], kv[3]); ko.z = pk2(kv[4], kv[5]); ko.w = pk2(kv[6], kv[7]);
            *(LAS u32x4*)(Qi + p * CH_PITCH + 16 * cq) = qo; *(LAS u32x4*)(Ki + p * CH_PITCH + 16 * cq) = ko; *(LAS u32x4*)(Vi + p * CH_PITCH + 16 * cq) = vraw;
        }
        } else {
            const GAS float* wq = mlc + h * 64 + 8 * cq;
            u32x4 rr[2][3][4], vr[4];
#pragma unroll
            for (int i4 = 0; i4 < 4; ++i4) {
                const int p = pr0 + 8 * (4 * hf + i4), tl = dir ? 63 - p : p, row = rowbase + tl, tpos = t0 + tl;
                const GAS bf16* bb = ML + (size_t)row * 1024 + h * 64 + 8 * cq;
                const u32x4 z4 = (u32x4){0u, 0u, 0u, 0u};
#pragma unroll
                for (int qk = 0; qk < 2; ++qk) {
                    rr[qk][1][i4] = *(const GAS u32x4*)(bb + 256 * qk);
                    rr[qk][0][i4] = tpos > 0 ? *(const GAS u32x4*)(bb + 256 * qk - 1024) : z4;
                    rr[qk][2][i4] = tpos < L - 1 ? *(const GAS u32x4*)(bb + 256 * qk + 1024) : z4;
                }
                vr[i4] = *(const GAS u32x4*)(bb + 512);
            }
#pragma unroll
            for (int qk = 0; qk < 2; ++qk) {
                f32x4 wt[3][2];
#pragma unroll
                for (int tp = 0; tp < 3; ++tp) { wt[tp][0] = *(const GAS f32x4*)(wq + 256 * qk + 512 * tp); wt[tp][1] = *(const GAS f32x4*)(wq + 256 * qk + 512 * tp + 4); }
#pragma unroll
                for (int i4 = 0; i4 < 4; ++i4) {
                    const int p = pr0 + 8 * (4 * hf + i4);
                    const unsigned a0[4] = {rr[qk][0][i4].x, rr[qk][0][i4].y, rr[qk][0][i4].z, rr[qk][0][i4].w}, a1[4] = {rr[qk][1][i4].x, rr[qk][1][i4].y, rr[qk][1][i4].z, rr[qk][1][i4].w},
                                   a2[4] = {rr[qk][2][i4].x, rr[qk][2][i4].y, rr[qk][2][i4].z, rr[qk][2][i4].w};
                    float ov[8];
#pragma unroll
                    for (int j = 0; j < 8; ++j) {
                        const float x0 = (j & 1) ? __uint_as_float(a0[j >> 1] & 0xffff0000u) : __uint_as_float(a0[j >> 1] << 16);
                        const float x1 = (j & 1) ? __uint_as_float(a1[j >> 1] & 0xffff0000u) : __uint_as_float(a1[j >> 1] << 16);
                        const float x2 = (j & 1) ? __uint_as_float(a2[j >> 1] & 0xffff0000u) : __uint_as_float(a2[j >> 1] << 16);
                        const float r = siluf_(wt[0][j >> 2][j & 3] * x0 + wt[1][j >> 2][j & 3] * x1 + wt[2][j >> 2][j & 3] * x2);
                        ov[j] = qk == 0 ? r : r * 0.125f;
                    }
                    u32x4 o; o.x = pk2(ov[0], ov[1]); o.y = pk2(ov[2], ov[3]); o.z = pk2(ov[4], ov[5]); o.w = pk2(ov[6], ov[7]);
                    if (qk == 0) *(LAS u32x4*)(Qi + p * CH_PITCH + 16 * cq) = o;
                    else { *(LAS u32x4*)(Ki + p * CH_PITCH + 16 * cq) = o; *(LAS u32x4*)(Vi + p * CH_PITCH + 16 * cq) = vr[i4]; }
                }
            }
        }
        __builtin_amdgcn_sched_barrier(0);
        float f_p, i_p;
        if (!IS_ML) { f_p = lgam; i_p = 0.f; }
        else { i_p = g_i + bi_; f_p = log_sigmoid_(g_f + bf_); }
        float bsum = f_p;
#pragma unroll
        for (int o = 1; o < 64; o <<= 1) { const float t = lane_read(bsum, lane >= o ? lane - o : lane); if (lane >= o) bsum += t; }
        LAS float* gv = (LAS float*)(img + 3 * CH_IMG);
        const float b63 = __int_as_float(__builtin_amdgcn_readlane(__float_as_int(bsum), 63));
        const float adec = __expf(b63);
        if (hf == 0) { gv[lane] = bsum; gv[64 + lane] = bsum - i_p; gv[128 + lane] = __expf(bsum); gv[192 + lane] = __expf(b63 - (bsum - i_p)); }
        asm volatile("s_waitcnt lgkmcnt(0)" ::: "memory");
        __syncthreads();
        unsigned tch0 = 0u, tch1 = 0u, tch2 = 0u;
#ifndef NO_TOUCH
        if (step + 1 < 36) {
            const int s1 = step + 1; int rb1;
            if (s1 < 4) { const int cc = dir ? 3 - s1 : s1; rb1 = TOKL + b * LC + cc * 64; }
            else { const int cc = dir ? 35 - s1 : s1 - 4; rb1 = b * LL + cc * 64; }
            const int li0 = hf * 96 + lane, li1 = hf * 96 + 64 + (lane & 31);
            if (!IS_ML) {
                tch0 = *(const GAS unsigned*)(RET + (size_t)(rb1 + li0 / 3) * 1536 + h * 64 + (li0 % 3) * 384);
                if (lane < 32) tch1 = *(const GAS unsigned*)(RET + (size_t)(rb1 + li1 / 3) * 1536 + h * 64 + (li1 % 3) * 384);
            } else {
                tch0 = *(const GAS unsigned*)(ML + (size_t)(rb1 + li0 / 3) * 1024 + h * 64 + (li0 % 3) * 256);
                if (lane < 32) tch1 = *(const GAS unsigned*)(ML + (size_t)(rb1 + li1 / 3) * 1024 + h * 64 + (li1 % 3) * 256);
                else if (hf == 0) tch2 = *(const GAS unsigned*)(MLG + (size_t)(rb1 + 2 * (lane & 31)) * 16);
            }
        }
#endif
        const LAS float* gq = gv + 4 * fq;
        const bf16x8 ones = (fr == 0) ? (bf16x8){0x3F80, 0x3F80, 0x3F80, 0x3F80, 0x3F80, 0x3F80, 0x3F80, 0x3F80} : (bf16x8){0, 0, 0, 0, 0, 0, 0, 0};
        const int tr_q = fr >> 2, tr_p = fr & 3;
#ifndef PT_UNROLL
#define PT_UNROLL 2
#endif
#pragma unroll PT_UNROLL
        for (int pt = 0; pt < 4; ++pt) {
            f32x4 ST[4];
            bf16x8 qn[2];
#pragma unroll
            for (int kk = 0; kk < 2; ++kk) qn[kk] = *(const LAS bf16x8*)(Qi + (16 * pt + fr) * CH_PITCH + (32 * kk + 8 * fq) * 2);
#pragma unroll
            for (int st = 0; st < 4; ++st) {
                ST[st] = (f32x4){0.f, 0.f, 0.f, 0.f};
                if (st <= pt) {
#pragma unroll
                    for (int kk = 0; kk < 2; ++kk) { const bf16x8 kf = *(const LAS bf16x8*)(Ki + (16 * st + fr) * CH_PITCH + (32 * kk + 8 * fq) * 2); ST[st] = __builtin_amdgcn_mfma_f32_16x16x32_bf16(kf, qn[kk], ST[st], 0, 0, 0); }
                }
            }
            const float bp = gv[16 * pt + fr];
#pragma unroll
            for (int st = 0; st < 4; ++st) {
                if (st <= pt) {
                    const f32x4 bis = *(const LAS f32x4*)(gq + 64 + 16 * st);
#pragma unroll
                    for (int j = 0; j < 4; ++j) { const int sidx = 16 * st + 4 * fq + j; const float w = (sidx <= 16 * pt + fr) ? __expf(bp - bis[j]) : 0.f; ST[st][j] *= w; }
                }
            }
            __builtin_amdgcn_sched_barrier(0);
            f32x4 acc[NET], accd = (f32x4){0.f, 0.f, 0.f, 0.f};
#pragma unroll
            for (int et = 0; et < NET; ++et) acc[et] = (f32x4){0.f, 0.f, 0.f, 0.f};
#pragma unroll
            for (int kk = 0; kk < 2; ++kk) {
                const u32x2 lo = *(const LAS u32x2*)(Qi + (16 * pt + fr) * CH_PITCH + (32 * kk + 4 * fq) * 2), hi = *(const LAS u32x2*)(Qi + (16 * pt + fr) * CH_PITCH + (32 * kk + 16 + 4 * fq) * 2);
                const bf16x8 qs = mk_frag(lo, hi);
#pragma unroll
                for (int et = 0; et < NET; ++et) {
                    u32x4 w; w.x = pk2(C[2 * kk][et].x, C[2 * kk][et].y); w.y = pk2(C[2 * kk][et].z, C[2 * kk][et].w); w.z = pk2(C[2 * kk + 1][et].x, C[2 * kk + 1][et].y); w.w = pk2(C[2 * kk + 1][et].z, C[2 * kk + 1][et].w);
                    acc[et] = __builtin_amdgcn_mfma_f32_16x16x32_bf16(__builtin_bit_cast(bf16x8, w), qs, acc[et], 0, 0, 0);
                }
                if (IS_ML) {
                    const f32x4 n0 = *(const LAS f32x4*)(nq + 32 * kk), n1 = *(const LAS f32x4*)(nq + 32 * kk + 16);
                    u32x4 w; w.x = pk2(n0.x, n0.y); w.y = pk2(n0.z, n0.w); w.z = pk2(n1.x, n1.y); w.w = pk2(n1.z, n1.w);
                    if (fr != 0) w = (u32x4){0u, 0u, 0u, 0u};
                    accd = __builtin_amdgcn_mfma_f32_16x16x32_bf16(__builtin_bit_cast(bf16x8, w), qs, accd, 0, 0, 0);
                }
            }
            { const float apv = gv[128 + 16 * pt + fr];
#pragma unroll
              for (int et = 0; et < NET; ++et) acc[et] *= apv;
              accd *= apv; }
            __builtin_amdgcn_sched_barrier(0);
#pragma unroll
            for (int kk = 0; kk < 2; ++kk) {
                if (2 * kk <= pt) {
                    u32x4 w; w.x = pk2(ST[2 * kk].x, ST[2 * kk].y); w.y = pk2(ST[2 * kk].z, ST[2 * kk].w); w.z = pk2(ST[2 * kk + 1].x, ST[2 * kk + 1].y); w.w = pk2(ST[2 * kk + 1].z, ST[2 * kk + 1].w);
                    const bf16x8 pf = __builtin_bit_cast(bf16x8, w);
                    u32x2 vlo[2], vhi[2];
                    ds_tr16x4(va + (32 * kk + 4 * fq + tr_q) * CH_PITCH + 8 * tr_p + 64 * hf, vlo, vhi);
#pragma unroll
                    for (int et = 0; et < NET; ++et) acc[et] = __builtin_amdgcn_mfma_f32_16x16x32_bf16(mk_frag(vlo[et], vhi[et]), pf, acc[et], 0, 0, 0);
                    if (IS_ML) accd = __builtin_amdgcn_mfma_f32_16x16x32_bf16(ones, pf, accd, 0, 0, 0);
                }
            }
            __builtin_amdgcn_sched_barrier(0);
            {
                const int p = 16 * pt + fr, tl = dir ? 63 - p : p, row = rowbase + tl;
                float inv = 1.f;
                if (IS_ML) { const float den = lane_read(accd[0], fr); inv = __builtin_amdgcn_rcpf(fmaxf(fabsf(den), 1.f)); }
                const int cof = (IS_ML ? 384 : 0) + h * 64 + 32 * hf + 4 * fq;
                const unsigned boff = dir == 0 ? (unsigned)(row * D + 384 + cof) * 2u : (unsigned)(row * 640 + cof) * 2u;
                GAS char* ob = dir == 0 ? (GAS char*)Y : (GAS char*)OB;
#pragma unroll
                for (int et = 0; et < NET; ++et) { u32x2 w; w.x = pk2(acc[et].x * inv, acc[et].y * inv); w.y = pk2(acc[et].z * inv, acc[et].w * inv); *(GAS u32x2*)(ob + boff + 32 * et) = w; }
            }
        }
        __builtin_amdgcn_sched_barrier(0);
#pragma unroll
        for (int dt = 0; dt < 4; ++dt)
#pragma unroll
            for (int et = 0; et < NET; ++et) C[dt][et] *= adec;
        f32x4 accn[4];
        if (IS_ML) {
#pragma unroll
            for (int dt = 0; dt < 4; ++dt) { accn[dt] = *(const LAS f32x4*)(nq + 16 * dt) * adec; if (fr != 0) accn[dt] = (f32x4){0.f, 0.f, 0.f, 0.f}; }
        }
#pragma unroll
        for (int kk = 0; kk < 2; ++kk) {
            u32x2 vlo[2], vhi[2], klo[4], khi[4];
            ds_tr16x4(va + (32 * kk + 4 * fq + tr_q) * CH_PITCH + 8 * tr_p + 64 * hf, vlo, vhi);
            ds_tr16x8(ka + (32 * kk + 4 * fq + tr_q) * CH_PITCH + 8 * tr_p, klo, khi);
            const f32x4 wl = *(const LAS f32x4*)(gq + 192 + 32 * kk), wh = *(const LAS f32x4*)(gq + 192 + 32 * kk + 16);
#pragma unroll
            for (int dt = 0; dt < 4; ++dt) {
                u32x4 w;
                w.x = pk2(__uint_as_float(klo[dt].x << 16) * wl[0], __uint_as_float(klo[dt].x & 0xffff0000u) * wl[1]);
                w.y = pk2(__uint_as_float(klo[dt].y << 16) * wl[2], __uint_as_float(klo[dt].y & 0xffff0000u) * wl[3]);
                w.z = pk2(__uint_as_float(khi[dt].x << 16) * wh[0], __uint_as_float(khi[dt].x & 0xffff0000u) * wh[1]);
                w.w = pk2(__uint_as_float(khi[dt].y << 16) * wh[2], __uint_as_float(khi[dt].y & 0xffff0000u) * wh[3]);
                const bf16x8 kf = __builtin_bit_cast(bf16x8, w);
#pragma unroll
                for (int et = 0; et < NET; ++et) C[dt][et] = __builtin_amdgcn_mfma_f32_16x16x32_bf16(kf, mk_frag(vlo[et], vhi[et]), C[dt][et], 0, 0, 0);
                if (IS_ML) accn[dt] = __builtin_amdgcn_mfma_f32_16x16x32_bf16(kf, ones, accn[dt], 0, 0, 0);
            }
        }
        if (IS_ML) { if (fr == 0) {
#pragma unroll
            for (int dt = 0; dt < 4; ++dt) *(LAS f32x4*)(nvec + 4 * fq + 16 * dt) = accn[dt]; } }
        asm volatile("s_waitcnt lgkmcnt(0)" ::: "memory");
        __syncthreads();
        sink ^= tch0 ^ tch1 ^ tch2;
    }
    asm volatile("" :: "v"(sink));
}

#ifndef REP_HY
#define REP_HY 1
#endif
constexpr int NCHWG = 160;
__device__ __forceinline__ void phase_mix(Frame& F, int layer) {
    const bool last = layer == 1;
    const GAS bf16* ftl = WSP(const bf16, WS_FTL) + (size_t)layer * 2 * 384 * 4096;
    if (F.wg < NCHWG) {
        if (F.wave >= 4) {
#pragma unroll 1
            for (int i = 0; i < 72 * (F.wg * 2 < 192 ? REP_CH_RET : REP_CH_ML); ++i) __syncthreads();
        } else {
            const int cl = F.wave >> 1, hf = F.wave & 1, c = F.wg * 2 + cl;
            LAS unsigned char* img = F.lds + cl * CH_WAVE_LDS;
            if (c < 192) { const int b = c / 12, r = c % 12; chain_fast<false>(F, layer, b, r >> 1, r & 1, img, hf); }
            else { const int i = c - 192; chain_fast<true>(F, layer, i >> 3, (i & 7) >> 1, i & 1, img, hf); }
        }
    } else {
        const int nh = F.G - NCHWG, w = F.wg - NCHWG;
#pragma unroll 1
        for (int rp = 0; rp < REP_HY; ++rp)
            for (int u = w; u < 384; u += nh) hyena_unit_fast<LL>(F, layer, u, u + nh < 384 ? u + nh : -1, WSP(const bf16, WS_HYTL), ftl, WSP(bf16, WS_YHTL));
        if (!last) for (int u = w; u < 384; u += nh) hyena_unit_fast<LC>(F, layer, u, u + nh < 384 ? u + nh : -1, WSP(const bf16, WS_HYTC), WSP(const bf16, WS_FTC), WSP(bf16, WS_YHTC));
    }
}

__device__ __forceinline__ void phase_combine(Frame& F, int layer, bool dummy = false) {
    const bool last = layer == 1;
    const int gw = F.wg * NWAVES + F.wave, NGW = F.G * NWAVES, lane = F.lane;
    const int nrows = last ? TOKL : TOK;
    GAS bf16* Y = WSP(bf16, WS_Y); const GAS bf16* OB = WSP(const bf16, WS_OB); const GAS bf16* RET = WSP(const bf16, WS_RET); const GAS bf16* ML = WSP(const bf16, WS_ML);
    const int rsub = lane >> 4, l16 = lane & 15;
    for (int row0 = gw * 4; row0 < nrows; row0 += NGW * 4) {
        const int row = row0 + rsub;
        GAS bf16* yo = dummy ? WSP(bf16, WS_U + 300 * MiB) + (size_t)(row & 8191) * D : Y + (size_t)row * D;
        u32x2 of[10], ob[10], gt[10];
#pragma unroll
        for (int hh = 0; hh < 10; ++hh) {
            const int cof = hh * 64 + 4 * l16;
            of[hh] = *(const GAS u32x2*)(Y + (size_t)row * D + 384 + cof); ob[hh] = *(const GAS u32x2*)(OB + (size_t)row * 640 + cof);
            gt[hh] = hh < 6 ? *(const GAS u32x2*)(RET + (size_t)row * 1536 + 1152 + cof) : *(const GAS u32x2*)(ML + (size_t)row * 1024 + 768 + (cof - 384));
        }
#pragma unroll
        for (int hh = 0; hh < 10; ++hh) {
            float x[4], g[4];
            x[0] = __uint_as_float(of[hh].x << 16) + __uint_as_float(ob[hh].x << 16); x[1] = __uint_as_float(of[hh].x & 0xffff0000u) + __uint_as_float(ob[hh].x & 0xffff0000u);
            x[2] = __uint_as_float(of[hh].y << 16) + __uint_as_float(ob[hh].y << 16); x[3] = __uint_as_float(of[hh].y & 0xffff0000u) + __uint_as_float(ob[hh].y & 0xffff0000u);
            g[0] = __uint_as_float(gt[hh].x << 16); g[1] = __uint_as_float(gt[hh].x & 0xffff0000u); g[2] = __uint_as_float(gt[hh].y << 16); g[3] = __uint_as_float(gt[hh].y & 0xffff0000u);
            float sm = (x[0] + x[1]) + (x[2] + x[3]);
            DPP_ADD(sm, 0xB1); DPP_ADD(sm, 0x4E); DPP_ADD(sm, 0x141); DPP_ADD(sm, 0x140);
            const float mu = sm * (1.f / 64.f);
#pragma unroll
            for (int j = 0; j < 4; ++j) x[j] -= mu;
            float sq = (x[0] * x[0] + x[1] * x[1]) + (x[2] * x[2] + x[3] * x[3]);
            DPP_ADD(sq, 0xB1); DPP_ADD(sq, 0x4E); DPP_ADD(sq, 0x141); DPP_ADD(sq, 0x140);
            const float rs = rsqrtf(sq * (1.f / 64.f) + 1e-6f);
            float o[4];
#pragma unroll
            for (int j = 0; j < 4; ++j) o[j] = x[j] * rs * (hh < 6 ? siluf_(g[j]) : sigmoidf_(g[j]));
            u32x2 w; w.x = pk2(o[0], o[1]); w.y = pk2(o[2], o[3]);
            *(GAS u32x2*)(yo + 384 + hh * 64 + 4 * l16) = w;
        }
    }
    LAS unsigned char* scr = F.lds + F.wave * 8704;
    const int nitL = NB * 6 * 32, nitC = last ? 0 : NB * 6 * 4;
    for (int it = gw; it < nitL + nitC; it += NGW) {
        const GAS bf16* src; int L, rowbase, b, cb, tb;
        if (it < nitL) { b = it / 192; const int r = it % 192; cb = r / 32; tb = r % 32; L = LL; src = WSP(const bf16, WS_YHTL); rowbase = b * LL; }
        else { const int i2 = it - nitL; b = i2 / 24; const int r = i2 % 24; cb = r / 4; tb = r % 4; L = LC; src = WSP(const bf16, WS_YHTC); rowbase = TOKL + b * LC; }
        u32x4 v[8];
#pragma unroll
        for (int i = 0; i < 8; ++i) { const int cc = (lane >> 3) + 8 * i; v[i] = *(const GAS u32x4*)(src + ((size_t)(b * 384 + cb * 64 + cc)) * L + tb * 64 + 8 * (lane & 7)); }
#pragma unroll
        for (int i = 0; i < 8; ++i) { const int cc = (lane >> 3) + 8 * i; *(LAS u32x4*)(scr + cc * 136 + 16 * (lane & 7)) = v[i]; }
        asm volatile("s_waitcnt lgkmcnt(0)" ::: "memory");
#pragma unroll
        for (int i = 0; i < 8; ++i) {
            const int tt = (lane >> 3) + 8 * i, c8 = 8 * (lane & 7);
            unsigned short e[8];
#pragma unroll
            for (int j = 0; j < 8; ++j) e[j] = *(const LAS unsigned short*)(scr + (c8 + j) * 136 + tt * 2);
            u32x4 o; o.x = e[0] | ((unsigned)e[1] << 16); o.y = e[2] | ((unsigned)e[3] << 16); o.z = e[4] | ((unsigned)e[5] << 16); o.w = e[6] | ((unsigned)e[7] << 16);
            *(GAS u32x4*)((dummy ? WSP(bf16, WS_U + 300 * MiB) : Y) + (size_t)(dummy ? ((rowbase + tb * 64 + tt) & 8191) : (rowbase + tb * 64 + tt)) * D + cb * 64 + c8) = o;
        }
        asm volatile("s_waitcnt lgkmcnt(0)" ::: "memory");
    }
}

__device__ __forceinline__ void phase_norm_router(Frame& F) {
    const int gw = F.wg * NWAVES + F.wave, lane = F.lane;
    const GAS float* g = inp(F, I_GFFN) + 1 * D; const GAS float* wr = inp(F, I_ROUTER); const GAS float* br = inp(F, I_ROUTERB);
    GAS unsigned* cnt = WSP(unsigned, WS_CTL) + CW_CNT;
    const int r0 = gw * 16, r1 = r0 + 16;
    f32x4 gm[4], sh[4], w0r[4][4], w1r[4][4]; u32x2 ring[4][4];
    { const GAS float* shp = mod_ptr(F, 1, r0, 3); const GAS float* scp = mod_ptr(F, 1, r0, 4);
#pragma unroll
      for (int j = 0; j < 4; ++j) { const f32x4 gg = *(const GAS f32x4*)(g + 256 * j + 4 * lane), sc = *(const GAS f32x4*)(scp + 256 * j + 4 * lane); sh[j] = *(const GAS f32x4*)(shp + 256 * j + 4 * lane);
          gm[j].x = gg.x * (1.f + sc.x); gm[j].y = gg.y * (1.f + sc.y); gm[j].z = gg.z * (1.f + sc.z); gm[j].w = gg.w * (1.f + sc.w);
#pragma unroll
          for (int i = 0; i < 4; ++i) { const int k = 256 * j + 4 * lane + i; w0r[j][i] = *(const GAS f32x4*)(wr + k * 8); w1r[j][i] = *(const GAS f32x4*)(wr + k * 8 + 4); } }
#pragma unroll
      for (int i = 0; i < 4; ++i) xrow_issue<true>(F, r0 + i, 2, lane, ring[i]); }
    float brr[8];
#pragma unroll
    for (int e = 0; e < 8; ++e) brr[e] = br[e];
#pragma unroll 1
    for (int rb = r0; rb < r1; rb += 4) {
#pragma unroll
      for (int i = 0; i < 4; ++i) {
        const int row = rb + i;
        f32x4 v[4]; float s = 0.f;
#pragma unroll
        for (int j = 0; j < 4; ++j) { v[j] = xrow_unpack(ring[i][j]); s += (v[j].x * v[j].x + v[j].y * v[j].y) + (v[j].z * v[j].z + v[j].w * v[j].w); }
        if (row + 4 < r1) xrow_issue<true>(F, row + 4, 2, lane, ring[i]);
        const float r = rsqrtf(wave_sum(s) * (1.0f / 1024.0f) + 1e-6f);
        GAS bf16* orow = WSP(bf16, WS_H) + (size_t)row * D;
        float lg[8];
#pragma unroll
        for (int e = 0; e < 8; ++e) lg[e] = 0.f;
#pragma unroll
        for (int j = 0; j < 4; ++j) {
            f32x4 o; o.x = v[j].x * r * gm[j].x + sh[j].x; o.y = v[j].y * r * gm[j].y + sh[j].y; o.z = v[j].z * r * gm[j].z + sh[j].z; o.w = v[j].w * r * gm[j].w + sh[j].w;
            u32x2 w; w.x = pk2(o.x, o.y); w.y = pk2(o.z, o.w);
            *(GAS u32x2*)(orow + 256 * j + 4 * lane) = w;
            const float xo[4] = {o.x, o.y, o.z, o.w};
#pragma unroll
            for (int i = 0; i < 4; ++i) { const float x = xo[i]; const f32x4 w0 = w0r[j][i], w1 = w1r[j][i];
                lg[0] += x * w0.x; lg[1] += x * w0.y; lg[2] += x * w0.z; lg[3] += x * w0.w; lg[4] += x * w1.x; lg[5] += x * w1.y; lg[6] += x * w1.z; lg[7] += x * w1.w; }
        }
#pragma unroll
        for (int e = 0; e < 8; ++e) lg[e] = wave_sum(lg[e]) + brr[e];
        int e0 = 0; float v0 = lg[0];
#pragma unroll
        for (int e = 1; e < 8; ++e) if (lg[e] > v0) { v0 = lg[e]; e0 = e; }
        int e1 = -1; float v1 = -3.0e38f;
#pragma unroll
        for (int e = 0; e < 8; ++e) if (e != e0 && lg[e] > v1) { v1 = lg[e]; e1 = e; }
        const float w1 = 1.f / (1.f + __expf(v0 - v1)), w0 = 1.f - w1;
        if (lane == 0) {
            const unsigned p0 = __hip_atomic_fetch_add(cnt + e0, 1u, __ATOMIC_RELAXED, __HIP_MEMORY_SCOPE_AGENT), p1 = __hip_atomic_fetch_add(cnt + e1, 1u, __ATOMIC_RELAXED, __HIP_MEMORY_SCOPE_AGENT);
            WSP(int, WS_TOPE)[row * 2] = e0; WSP(int, WS_TOPE)[row * 2 + 1] = e1;
            WSP(float, WS_TOPW)[row * 2] = w0; WSP(float, WS_TOPW)[row * 2 + 1] = w1;
            WSP(int, WS_TOPP)[row * 2] = (int)p0; WSP(int, WS_TOPP)[row * 2 + 1] = (int)p1;
        }
      }
    }
}
__device__ __forceinline__ void phase_route_tables(Frame& F) {
    const GAS unsigned* cnt = WSP(const unsigned, WS_CTL) + CW_CNT;
    int off[9]; off[0] = 0;
#pragma unroll
    for (int e = 0; e < 8; ++e) { const int c = (int)__hip_atomic_load(cnt + e, __ATOMIC_RELAXED, __HIP_MEMORY_SCOPE_AGENT); off[e + 1] = off[e] + ((c + 255) >> 8) * 256; }
    const int gt = F.wg * NTHR + F.tid, NGT = F.G * NTHR;
    GAS int* rowidx = WSP(int, WS_ROWIDX); GAS int* slot = WSP(int, WS_SLOT); GAS int* tilee = WSP(int, WS_TILEE);
    for (int i = gt; i < MAXTILES * 256; i += NGT) {
        int e = 0;
#pragma unroll
        for (int q = 1; q < 8; ++q) if (i >= off[q]) e = q;
        const int c = (int)cnt[e];
        if (i >= off[8] || i - off[e] >= c) rowidx[i] = 0;
    }
    for (int i = gt; i < TOKL * 2; i += NGT) {
        const int e = WSP(const int, WS_TOPE)[i], pos = WSP(const int, WS_TOPP)[i];
        int o = 0;
#pragma unroll
        for (int q = 0; q < 8; ++q) if (e == q) o = off[q];
        const int s = o + pos; slot[i] = s; rowidx[s] = i >> 1;
    }
    for (int i = gt; i < MAXTILES + 1; i += NGT) {
        if (i == MAXTILES) tilee[MAXTILES] = off[8] >> 8;
        else { int e = 0;
#pragma unroll
            for (int q = 1; q < 8; ++q) if (i * 256 >= off[q]) e = q;
            tilee[i] = e; }
    }
}

__device__ __forceinline__ void moe_pass_gemm1_fast(Frame& F, int t0, int t1) {
    pg8::OrderMoe S; S.o.init(t1 - t0, NFF1 / 256, F.G, F.wg); S.rowidx = WSP(const int, WS_ROWIDX); S.tilee = WSP(const int, WS_TILEE); S.t0 = t0; S.bstride = (size_t)NFF1 * D; S.gather = true;
    EpiSwiglu E{WSP(bf16, WS_MACT), 0};
    pg8::gemm_phase(F.lds, F.tid, WSP(const bf16, WS_H), D, WSP(const bf16, WS_MW13), D, D, S, E);
}
__device__ __forceinline__ void moe_pass_gemm2_fast(Frame& F, int t0, int t1) {
    pg8::OrderMoe S; S.o.init(t1 - t0, D / 256, F.G, F.wg); S.rowidx = WSP(const int, WS_ROWIDX); S.tilee = WSP(const int, WS_TILEE); S.t0 = t0; S.bstride = (size_t)D * DFF; S.gather = false;
    EpiBf16Out E{WSP(bf16, WS_EOUT), D, t0 * 256};
    pg8::gemm_phase(F.lds, F.tid, WSP(const bf16, WS_MACT), DFF, WSP(const bf16, WS_MW2), DFF, DFF, S, E);
}
__device__ __forceinline__ void phase_final(Frame& F, GAS float* dummy = nullptr) {
    const int gw = F.wg * NWAVES + F.wave, NGW = F.G * NWAVES, lane = F.lane;
    const GAS float* gf = inp(F, I_GFINAL); const GAS bf16* eo = WSP(const bf16, WS_EOUT);
#pragma unroll 2
    for (int row = gw; row < TOKL; row += NGW) {
        const int s0 = WSP(const int, WS_SLOT)[row * 2], s1 = WSP(const int, WS_SLOT)[row * 2 + 1];
        const float w0 = WSP(const float, WS_TOPW)[row * 2], w1 = WSP(const float, WS_TOPW)[row * 2 + 1];
        const GAS float* m5 = mod_ptr(F, 1, row, 5);
        GAS float* xr = outp(F) + (size_t)row * D; const GAS bf16* xb = WSP(const bf16, WS_XL2) + (size_t)row * D;
        f32x4 v[4]; float s = 0.f;
#pragma unroll
        for (int j = 0; j < 4; ++j) {
            const int c = 256 * j + 4 * lane;
            const f32x4 a = ld_bf16x4(eo + (size_t)s0 * D + c), b = ld_bf16x4(eo + (size_t)s1 * D + c), m = *(const GAS f32x4*)(m5 + c);
            v[j] = ld_bf16x4(xb + c) + m * (a * w0 + b * w1);
            s += (v[j].x * v[j].x + v[j].y * v[j].y) + (v[j].z * v[j].z + v[j].w * v[j].w);
        }
        const float r = rsqrtf(wave_sum(s) * (1.f / 1024.f) + 1e-6f);
#pragma unroll
        for (int j = 0; j < 4; ++j) { const int c = 256 * j + 4 * lane; const f32x4 g = *(const GAS f32x4*)(gf + c); GAS float* o_ = dummy ? dummy + (size_t)(row & 8191) * D : xr; *(GAS f32x4*)(o_ + c) = v[j] * r * g; }
    }
}

#ifndef MR_L0
#define MR_L0 192
#endif
#ifndef REP_WIN
#define REP_WIN 1
#endif
#ifndef REP_MIX
#define REP_MIX 1
#endif
#ifndef REP_GATE
#define REP_GATE 1
#endif
#ifndef REP_UP
#define REP_UP 1
#endif
#ifndef REP_FFN1
#define REP_FFN1 1
#endif
#ifndef REP_MOE
#define REP_MOE 1
#endif
#ifndef REP_NORM
#define REP_NORM 1
#endif
#ifndef REP_P0
#define REP_P0 1
#endif
__global__ void __launch_bounds__(NTHR, 2) hybrid_fwd(Params prm) {
    extern __shared__ __attribute__((aligned(16))) unsigned char lds_raw[];
    Frame F;
    F.lds = (LAS unsigned char*)lds_raw; F.ws = (GAS unsigned char*)prm.ws;
    F.tid = threadIdx.x; F.lane = F.tid & 63; F.wave = __builtin_amdgcn_readfirstlane(F.tid >> 6); F.G = gridDim.x; F.wg = blockIdx.x;
    volatile LAS unsigned* MISC = (volatile LAS unsigned*)(F.lds + MISC_OFF);
    if (F.tid < 64) MISC[F.tid] = 0u;
    if (F.tid < 33) { const unsigned long long v = F.tid < 32 ? (unsigned long long)prm.in[F.tid] : (unsigned long long)prm.out; *(LAS unsigned long long*)(F.lds + PTAB_OFF + 8 * F.tid) = v; }
    __syncthreads();
    XcdBarrier bar = xcd_barrier_post(WSP(unsigned, WS_CTL) + CW_BAR, MISC + 8);
#define RELAUNDER() do { { unsigned long long _w = (unsigned long long)F.ws; asm volatile("" : "+s"(_w)); F.ws = (GAS unsigned char*)_w; } \
        { unsigned _t = (unsigned)F.tid; asm volatile("" : "+v"(_t)); F.tid = (int)_t; F.lane = F.tid & 63; F.wave = __builtin_amdgcn_readfirstlane(F.tid >> 6); } \
        { unsigned _g = (unsigned)F.G, _b = (unsigned)F.wg; asm volatile("" : "+s"(_g), "+s"(_b)); F.G = (int)_g; F.wg = (int)_b; } \
        { unsigned _l = (unsigned)(size_t)F.lds; asm volatile("" : "+s"(_l)); F.lds = (LAS unsigned char*)(size_t)_l; } } while (0)
#define GRID_BAR() do { { unsigned long long _b = (unsigned long long)bar.bar; unsigned _x = bar.x; asm volatile("" : "+s"(_b), "+s"(_x)); bar.bar = (GAS unsigned*)_b; bar.x = _x; } xcd_barrier(bar); RELAUNDER(); } while (0)

    for (int rp = 0; rp < REP_P0; ++rp) { phase_p0(F); write_bias(F);
    GRID_BAR(); }
#pragma unroll 1
    for (int layer_ = 0; layer_ < 2; ++layer_) {
        int layer = layer_;
#define last (layer == 1)
#define rows_all TOK
#define rows_out (last ? TOKL : TOK)
#define modbase (WSP(const float, WS_MOD) + (size_t)layer * 17 * 6144)
#define LAYER_LAUNDER() asm volatile("" : "+s"(layer))
        for (int rp = 0; rp < REP_NORM; ++rp) { if (last) phase_norm<true>(F, layer, rows_all, 0); else phase_norm<false>(F, layer, rows_all, 0);
        if (layer == 0) { const int gw = F.wg * NWAVES + F.wave, NGW = F.G * NWAVES;
            for (int it = gw; it < 1536 + 96; it += NGW) filter_out_item(F, it); }
        { GRID_BAR(); LAYER_LAUNDER(); } }
        for (int rp = 0; rp < REP_WIN; ++rp) {
        { EpiWin E{WSP(const float, WS_BIAS) + layer * NWP, WSP(bf16, WS_HYTL), WSP(bf16, WS_HYTC), WSP(bf16, WS_RET), WSP(bf16, WS_ML), WSP(float, WS_MLG)};
          if (last) { pg8::OrderWinL1 S; S.init(F.G, F.wg); pg8::gemm_phase(F.lds, F.tid, WSP(const bf16, WS_H), D, WSP(const bf16, WS_WIN), D, D, S, E); }
          else gemm_fast(F, WSP(const bf16, WS_H), D, WSP(const bf16, WS_WIN), D, D, rows_all, NW1, E); }
        { GRID_BAR(); LAYER_LAUNDER(); } }
        for (int rp = 0; rp < REP_MIX; ++rp) { phase_mix(F, layer);
        { GRID_BAR(); LAYER_LAUNDER(); } }
#ifndef REP_COMB
#define REP_COMB 1
#endif
        for (int rp = REP_COMB - 1; rp > 0; --rp) { phase_combine(F, layer, true); { GRID_BAR(); LAYER_LAUNDER(); } }
        phase_combine(F, layer);
        { GRID_BAR(); LAYER_LAUNDER(); }
        for (int rp = 0; rp < REP_GATE; ++rp) {
        { EpiGate E{WSP(const float, WS_BIAS) + layer * NWP + NW1, WSP(bf16, WS_GATES)};
          gemm_fast(F, WSP(const bf16, WS_H), D, WSP(const bf16, WS_WIN) + (size_t)NW1 * D, D, D, rows_out, NGATE, E); }
        { GRID_BAR(); LAYER_LAUNDER(); } }
        for (int rp = 0; rp < REP_UP; ++rp) {
        { EpiUp E{WSP(const bf16, WS_GATES), WSP(bf16, WS_H)};
          if (last) gemm_fast(F, WSP(const bf16, WS_Y), D, WSP(const bf16, WS_WUP), D, D, TOKL, D, E);
          else gemm_fast<MR_L0>(F, WSP(const bf16, WS_Y), D, WSP(const bf16, WS_WUP), D, D, TOK, D, E); }
        { GRID_BAR(); LAYER_LAUNDER(); } }
#ifndef REP_OUT
#define REP_OUT 1
#endif
        if (last) { EpiResidT<true> E{(const GAS bf16*)outp(F), nullptr, WSP(bf16, WS_XL2), nullptr, modbase, 2};
            gemm_fast(F, WSP(const bf16, WS_H), D, WSP(const bf16, WS_WOUT), D, D, TOKL, D, E); }
        else { EpiResidT<false> E{inp(F, I_X), inp(F, I_CTX), (GAS bf16*)outp(F), WSP(bf16, WS_XC), modbase, 2};
            gemm_fast<MR_L0>(F, WSP(const bf16, WS_H), D, WSP(const bf16, WS_WOUT), D, D, TOK, D, E); }
        { GRID_BAR(); LAYER_LAUNDER(); }
        if (!last) {
            phase_norm<true>(F, layer, rows_out, 3);
            { const int gw = F.wg * NWAVES + F.wave, NGW = F.G * NWAVES; LAS float* scr = (LAS float*)(F.lds + F.wave * 8704);
              conv_weights_ffn(inp(F, I_FW1), inp(F, I_FW3), inp(F, I_FW2), WSP(bf16, WS_W13), WSP(bf16, WS_W2), gw, NGW, scr, F.lane);
              conv_weights_win(F, 1, gw, NGW, scr);
              conv_weights_upout(F, 1, gw, NGW, scr); }
            { GRID_BAR(); LAYER_LAUNDER(); }
            for (int rp = 0; rp < REP_FFN1; ++rp) {
            { EpiSwiglu E{WSP(bf16, WS_ACT), 0};
              gemm_fast(F, WSP(const bf16, WS_H), D, WSP(const bf16, WS_W13), D, D, rows_out, NFF1, E); }
            { GRID_BAR(); LAYER_LAUNDER(); } }
#ifndef REP_FFN2
#define REP_FFN2 1
#endif
            { EpiResidT<true> E{(const GAS bf16*)outp(F), WSP(const bf16, WS_XC), (GAS bf16*)outp(F), WSP(bf16, WS_XC), modbase, 5};
              gemm_fast<MR_L0>(F, WSP(const bf16, WS_ACT), DFF, WSP(const bf16, WS_W2), DFF, DFF, TOK, D, E); }
            { GRID_BAR(); LAYER_LAUNDER(); }
        }
    }
#undef LAYER_LAUNDER
#undef last
#undef rows_all
#undef rows_out
#undef modbase
    phase_norm_router(F);
    { const int gw = F.wg * NWAVES + F.wave, NGW = F.G * NWAVES; LAS float* scr = (LAS float*)(F.lds + F.wave * 8704);
#ifndef REP_MCONV
#define REP_MCONV 1
#endif
#pragma unroll 1
      for (int e = 0; e < NE * REP_MCONV; ++e)
          conv_weights_ffn(inp(F, I_MW1) + (size_t)(e % NE) * D * DFF, inp(F, I_MW3) + (size_t)(e % NE) * D * DFF, inp(F, I_MW2) + (size_t)(e % NE) * DFF * D,
                           WSP(bf16, WS_MW13) + (size_t)(e % NE) * NFF1 * D, WSP(bf16, WS_MW2) + (size_t)(e % NE) * D * DFF, gw, NGW, scr, F.lane); }
    GRID_BAR();
    phase_route_tables(F);
    GRID_BAR();
    const int ntiles = __builtin_amdgcn_readfirstlane(WSP(const int, WS_TILEE)[MAXTILES]);
#pragma unroll 1
    for (int p = 0; p < NPASS; ++p) {
        const int t0 = p * PASS_TILES, t1 = min(ntiles, t0 + PASS_TILES);
        for (int rp = 0; rp < REP_MOE; ++rp) {
        if (t0 < t1) moe_pass_gemm1_fast(F, t0, t1);
        GRID_BAR();
        if (t0 < t1) moe_pass_gemm2_fast(F, t0, t1);
        GRID_BAR(); }
    }
#ifndef REP_BAR
#define REP_BAR 0
#endif
    for (int rb = 0; rb < REP_BAR; ++rb) GRID_BAR();
#ifndef REP_FINAL
#define REP_FINAL 1
#endif
    for (int rp = REP_FINAL - 1; rp > 0; --rp) { phase_final(F, WSP(float, WS_H)); GRID_BAR(); }
    phase_final(F);
}

extern "C" void kernel_launch(void* const* d_in, const int* in_sizes, int n_in, void* d_out, int out_size, void* d_ws, size_t ws_size, hipStream_t stream) {
    static int grid = 0;
    if (grid == 0) {
        if (n_in != 32 || out_size != TOKL * D || ws_size < WS_END) { fprintf(stderr, "kernel_launch: unexpected arguments (n_in %d, out %d, ws %zu)\n", n_in, out_size, ws_size); grid = -1; return; }
        int dev = 0, cus = 0;
        if (hipGetDevice(&dev) != hipSuccess || hipDeviceGetAttribute(&cus, hipDeviceAttributeMultiprocessorCount, dev) != hipSuccess) { grid = -1; return; }
        if (hipFuncSetAttribute((const void*)hybrid_fwd, hipFuncAttributeMaxDynamicSharedMemorySize, LDS_BYTES) != hipSuccess) { grid = -1; return; }
        int per_cu = 0;
        (void)hipOccupancyMaxActiveBlocksPerMultiprocessor(&per_cu, (const void*)hybrid_fwd, NTHR, LDS_BYTES);
        (void)hipGetLastError();
        if (cus < 256) { fprintf(stderr, "kernel_launch: needs 256 compute units (one workgroup each), found %d\n", cus); grid = -1; return; }
        grid = 256;
    }
    if (grid < 0) return;
    (void)hipMemsetAsync((char*)d_ws + WS_CTL, 0, CTL_ZERO_BYTES, stream);
    Params p{};
    for (int i = 0; i < 32; ++i) p.in[i] = (const float*)d_in[i];
    p.out = (float*)d_out; p.ws = (unsigned char*)d_ws;
    hipLaunchKernelGGL(hybrid_fwd, dim3(grid), dim3(NTHR), LDS_BYTES, stream, p);
}
```

```cpp
#include <hip/hip_runtime.h>
#include <stdint.h>
#include <stdio.h>

#define LAS __attribute__((address_space(3)))
#define GAS __attribute__((address_space(1)))
typedef unsigned short bf16;
typedef short bf16x8 __attribute__((ext_vector_type(8)));
typedef float f32x4 __attribute__((ext_vector_type(4)));
typedef unsigned u32x4 __attribute__((ext_vector_type(4)));
typedef unsigned u32x2 __attribute__((ext_vector_type(2)));

constexpr int D = 1024, NB = 16, LL = 2048, LC = 256;
constexpr int TOKL = NB * LL, TOKC = NB * LC, TOK = TOKL + TOKC;
constexpr int HYW = 384, RETW = 384, MLW = 256;
constexpr int NIN = 6800, NW1 = 3840, NGATE = 3072, NWP = 6912;
constexpr int DFF = 2816, NFF1 = 5632, NE = 8;
constexpr int NWAVES = 8, NTHR = 512;
constexpr int MAXTILES = 272, PASS_TILES = 58, NPASS = 5;

constexpr size_t MiB = 1u << 20;
constexpr size_t WS_CTL = 0, CTL_ZERO_BYTES = 128 * 1024;
constexpr size_t WS_MOD = 1 * MiB;
constexpr size_t WS_BIAS = 2 * MiB;
constexpr size_t WS_ROPE = 2 * MiB + 256 * 1024;
constexpr size_t WS_TOPE = 3 * MiB;
constexpr size_t WS_TOPW = 3 * MiB + 256 * 1024;
constexpr size_t WS_TOPP = 3 * MiB + 512 * 1024;
constexpr size_t WS_SLOT = 3 * MiB + 768 * 1024;
constexpr size_t WS_ROWIDX = 4 * MiB;
constexpr size_t WS_TILEE = 4 * MiB + 512 * 1024;
constexpr size_t WS_FTL = 5 * MiB;
constexpr size_t WS_FTC = 17 * MiB;
constexpr size_t WS_WIN = 18 * MiB;
constexpr size_t WS_WUP = 32 * MiB;
constexpr size_t WS_WOUT = 34 * MiB;
constexpr size_t WS_XC = 36 * MiB;
constexpr size_t WS_H = 52 * MiB;
constexpr size_t WS_Y = 124 * MiB;
constexpr size_t WS_U = 196 * MiB;
constexpr size_t WS_RET = WS_U;
constexpr size_t WS_ML = WS_U + 108 * MiB;
constexpr size_t WS_MLG = WS_U + 180 * MiB;
constexpr size_t WS_OB = WS_U + 183 * MiB;
constexpr size_t WS_YHTL = WS_U + 228 * MiB;
constexpr size_t WS_YHTC = WS_U + 252 * MiB;
constexpr size_t WS_HYTL = WS_U + 255 * MiB;
constexpr size_t WS_HYTC = WS_U + 327 * MiB;
constexpr size_t WS_XL2 = WS_U + 284 * MiB;
constexpr size_t WS_END = WS_U + 348 * MiB;
constexpr size_t WS_GATES = WS_U;
constexpr size_t WS_ACT = WS_U;
constexpr size_t WS_W13 = WS_U + 204 * MiB;
constexpr size_t WS_W2 = WS_U + 216 * MiB;
constexpr size_t WS_MW13 = WS_Y;
constexpr size_t WS_MW2 = WS_Y + 88 * MiB;
constexpr size_t WS_MACT = WS_Y + 132 * MiB;
constexpr size_t WS_EOUT = WS_Y + 220 * MiB;
static_assert(WS_EOUT + (size_t)MAXTILES * 256 * 1024 * 2 <= WS_XL2, "map");
static_assert(WS_GATES + (size_t)TOK * NGATE * 2 <= WS_YHTL, "gates overlay");

constexpr int CW_BAR = 4096;
constexpr int CW_CNT = 16384;

constexpr int LDS_BYTES = 147456;
constexpr int MISC_OFF = 147456 - 256;

__device__ __forceinline__ float bf2f(bf16 b) { return __uint_as_float(((unsigned)b) << 16); }
typedef __bf16 bf2v_ __attribute__((ext_vector_type(2)));
typedef float f2v_ __attribute__((ext_vector_type(2)));
__device__ __forceinline__ unsigned pk2(float lo, float hi) { const f2v_ f = {lo, hi}; return __builtin_bit_cast(unsigned, __builtin_convertvector(f, bf2v_)); }
__device__ __forceinline__ unsigned f2bf(float f) { return pk2(f, 0.f) & 0xffffu; }
__device__ __forceinline__ float dpp_f(float v, int) { return v; }
#define DPP_ADD(v, ctrl) (v) += __int_as_float(__builtin_amdgcn_update_dpp(0, __float_as_int(v), (ctrl), 0xf, 0xf, true))
__device__ __forceinline__ float wave_sum(float v) {
    DPP_ADD(v, 0xB1);
    DPP_ADD(v, 0x4E);
    DPP_ADD(v, 0x141);
    DPP_ADD(v, 0x140);
    return __int_as_float(__builtin_amdgcn_readlane(__float_as_int(v), 0)) + __int_as_float(__builtin_amdgcn_readlane(__float_as_int(v), 16))
         + __int_as_float(__builtin_amdgcn_readlane(__float_as_int(v), 32)) + __int_as_float(__builtin_amdgcn_readlane(__float_as_int(v), 48));
}
__device__ __forceinline__ float lane_read(float v, int src_lane) { return __int_as_float(__builtin_amdgcn_ds_bpermute(src_lane << 2, __float_as_int(v))); }
__device__ __forceinline__ float sigmoidf_(float x) { return __builtin_amdgcn_rcpf(1.0f + __expf(-x)); }
__device__ __forceinline__ float siluf_(float x) { return x * __builtin_amdgcn_rcpf(1.0f + __expf(-x)); }

#define XB_TMO      128
#define XB_XCNT(j)  (256  + 64 * (j))
#define XB_XSUB(j)  (1280 + 64 * (j))
#define XB_XGEN(j)  (2304 + 64 * (j))
#define XB_TOP      3328
#define XB_TOPGEN   3392
#define XCD_BAR_WORDS 3456
#define XB_SPIN_CAP (1u << 22)
__device__ __forceinline__ unsigned xb_ld(GAS unsigned* p)              { return __hip_atomic_load(p, __ATOMIC_RELAXED, __HIP_MEMORY_SCOPE_AGENT); }
__device__ __forceinline__ unsigned xb_add(GAS unsigned* p, unsigned v) { return __hip_atomic_fetch_add(p, v, __ATOMIC_RELAXED, __HIP_MEMORY_SCOPE_AGENT); }
__device__ __forceinline__ unsigned xb_xcc_id() { return (unsigned)__builtin_amdgcn_s_getreg((3 << 11) | 20) & 0xFu; }
#ifndef XB_SLEEP
#define XB_SLEEP 0
#endif
#define XB_SPIN(cond, bar) do { unsigned _sp = 0; while (cond) { if (XB_SLEEP) __builtin_amdgcn_s_sleep(1); \
    if ((++_sp & 255u) == 0u) { if (xb_ld(&(bar)[XB_TMO])) break; if (_sp > XB_SPIN_CAP) { (void)__hip_atomic_fetch_add(&(bar)[XB_TMO], 1u, __ATOMIC_RELAXED, __HIP_MEMORY_SCOPE_AGENT); break; } } } } while (0)
struct XcdBarrier { GAS unsigned* bar; unsigned x; volatile LAS unsigned* st; };
__device__ __forceinline__ XcdBarrier xcd_barrier_post(GAS unsigned* bar, volatile LAS unsigned* st) {
    XcdBarrier b; b.bar = bar; b.x = xb_xcc_id(); b.st = st;
    if (threadIdx.x == 0) (void)xb_add(&bar[XB_XCNT(b.x)], 1u);
    return b;
}
__device__ __forceinline__ void xcd_barrier_complete(GAS unsigned* bar, unsigned x, unsigned& nloc, unsigned& nx) {
    const unsigned G = gridDim.x * gridDim.y * gridDim.z;
    unsigned sum, cnt, mine, sp = 0u;
    for (;;) {
        sum = 0u; cnt = 0u; mine = 0u;
#pragma unroll 1
        for (unsigned j = 0; j < 16; ++j) { const unsigned c = xb_ld(&bar[XB_XCNT(j)]); sum += c; cnt += (c > 0u) ? 1u : 0u; }
        mine = xb_ld(&bar[XB_XCNT(x)]);
        if (sum == G) break;
        __builtin_amdgcn_s_sleep(1);
        if ((++sp & 255u) == 0u) { if (xb_ld(&bar[XB_TMO])) break; if (sp > XB_SPIN_CAP) { (void)__hip_atomic_fetch_add(&bar[XB_TMO], 1u, __ATOMIC_RELAXED, __HIP_MEMORY_SCOPE_AGENT); break; } }
    }
    nloc = mine > 0u ? mine : 1u; nx = cnt > 0u ? cnt : 1u;
}
__device__ __forceinline__ void xcd_barrier(const XcdBarrier& b) {
    asm volatile("s_waitcnt vmcnt(0)" ::: "memory");
    __syncthreads();
    if (threadIdx.x == 0) {
        GAS unsigned* bar = b.bar;
        __builtin_amdgcn_s_waitcnt(0);
        unsigned nloc = b.st[0], nx = b.st[1];
        if (nloc == 0u) { xcd_barrier_complete(bar, b.x, nloc, nx); b.st[0] = nloc; b.st[1] = nx; }
        const unsigned old = xb_add(&bar[XB_XSUB(b.x)], 1u);
        const unsigned gen = old / nloc;
        if (old + 1u == (gen + 1u) * nloc) {
            __builtin_amdgcn_fence(__ATOMIC_RELEASE, "agent");
            asm volatile("s_waitcnt vmcnt(0)" ::: "memory");
            const unsigned og = xb_add(&bar[XB_TOP], 1u);
            const unsigned tg = og / nx;
            if (og + 1u == (tg + 1u) * nx) xb_add(&bar[XB_TOPGEN], 1u);
            else XB_SPIN(xb_ld(&bar[XB_TOPGEN]) == tg, bar);
            __builtin_amdgcn_fence(__ATOMIC_ACQUIRE, "agent");
            xb_add(&bar[XB_XGEN(b.x)], 1u);
            asm volatile("s_waitcnt vmcnt(0)" ::: "memory");
        } else {
            XB_SPIN(xb_ld(&bar[XB_XGEN(b.x)]) == gen, bar);
            __builtin_amdgcn_fence(__ATOMIC_ACQUIRE, "agent");
            asm volatile("s_waitcnt vmcnt(0)" ::: "memory");
        }
    }
    __syncthreads();
}

struct Params { const float* in[32]; float* out; unsigned char* ws; };
enum { I_X = 0, I_C, I_CTX, I_CCTX, I_WMOD, I_BMOD, I_GMIX, I_GFFN, I_WIN, I_BIN, I_HYCONV, I_HYF1, I_HYFB1, I_HYF2, I_HYFB2, I_HYF3, I_HYDECAY,
       I_HYSKIP, I_RETDECAY, I_MLCONV, I_MLGB, I_WUP, I_WOUT, I_FW1, I_FW3, I_FW2, I_ROUTER, I_ROUTERB, I_MW1, I_MW3, I_MW2, I_GFINAL };

struct Frame {
    LAS unsigned char* lds;
    GAS unsigned char* ws;
    int tid, lane, wave, G, wg;
};
#define WSP(T, off) ((GAS T*)(F.ws + (off)))
constexpr int PTAB_OFF = 147456 - 1024;
__device__ __forceinline__ const GAS float* inp(const Frame& F, int i) {
    const LAS unsigned* t = (const LAS unsigned*)(F.lds + PTAB_OFF) + 2 * i;
    const unsigned lo = __builtin_amdgcn_readfirstlane(t[0]), hi = __builtin_amdgcn_readfirstlane(t[1]);
    return (const GAS float*)(((unsigned long long)hi << 32) | lo);
}
__device__ __forceinline__ GAS float* outp(const Frame& F) { return (GAS float*)inp(F, 32); }

__device__ __forceinline__ int row_batch(int row) { return row < TOKL ? (row >> 11) : ((row - TOKL) >> 8); }
__device__ __forceinline__ const GAS float* mod_ptr(const Frame& F, int layer, int row, int which) {
    const int r = row < TOKL ? (row >> 11) : 16;
    return WSP(const float, WS_MOD) + ((size_t)(layer * 17 + r) * 6 + which) * 1024;
}

template <class RowMap>
__device__ __forceinline__ void tr_item(const GAS float* W, int K, int N, GAS bf16* WT, int ldT, RowMap rm, LAS float* scr, int item, int lane) {
    const int nblk = (N + 31) / 32, kb = item / nblk, nb = item % nblk, k0 = 64 * kb, n0 = 32 * nb;
    { f32x4 tv[8];
#pragma unroll
      for (int i = 0; i < 8; ++i) { const int kk = 8 * i + (lane >> 3); const int n = n0 + 4 * (lane & 7); tv[i] = (n < N) ? *(const GAS f32x4*)(W + (size_t)(k0 + kk) * N + n) : (f32x4){0.f, 0.f, 0.f, 0.f}; }
#pragma unroll
      for (int i = 0; i < 8; ++i) { const int kk = 8 * i + (lane >> 3); LAS float* d = scr + kk * 33 + 4 * (lane & 7); d[0] = tv[i].x; d[1] = tv[i].y; d[2] = tv[i].z; d[3] = tv[i].w; } }
    asm volatile("s_waitcnt lgkmcnt(0)" ::: "memory");
    const int c = lane & 7;
#pragma unroll
    for (int j = 0; j < 4; ++j) { const int nl = (lane >> 3) + 8 * j; const int n = n0 + nl; const LAS float* s = scr + (8 * c) * 33 + nl;
        u32x4 o; o.x = pk2(s[0 * 33], s[1 * 33]); o.y = pk2(s[2 * 33], s[3 * 33]); o.z = pk2(s[4 * 33], s[5 * 33]); o.w = pk2(s[6 * 33], s[7 * 33]);
        if (n < N) *(GAS u32x4*)(WT + (size_t)rm(n) * ldT + k0 + 8 * c) = o; }
    asm volatile("s_waitcnt lgkmcnt(0)" ::: "memory");
}
struct RmId { __device__ __forceinline__ int operator()(int n) const { return n; } };
__device__ __forceinline__ int win_row(int n) {
    if (n < 1152) return n;
    if (n < 2688) return 1280 + (n - 1152);
    if (n < 3712) return 2816 + (n - 2688);
    if (n < 3728) return 1152 + (n - 3712);
    return 3840 + (n - 3728);
}
struct RmWin { __device__ __forceinline__ int operator()(int n) const { return win_row(n); } };
struct RmW1 { __device__ __forceinline__ int operator()(int n) const { const int r = n & 31; return (n >> 7) * 256 + ((r >> 2) & 1) * 128 + ((n & 127) >> 5) * 32 + 4 * (r >> 3) + (r & 3); } };
struct RmW3 { __device__ __forceinline__ int operator()(int n) const { const int r = n & 31; return (n >> 7) * 256 + ((r >> 2) & 1) * 128 + ((n & 127) >> 5) * 32 + 16 + 4 * (r >> 3) + (r & 3); } };

__device__ __forceinline__ void conv_weights_win(Frame& F, int layer, int gw, int NGW, LAS float* scr) {
    const GAS float* W = inp(F, I_WIN) + (size_t)layer * D * NIN;
    const int items = (D / 64) * ((NIN + 31) / 32);
    for (int it = gw; it < items; it += NGW) tr_item(W, D, NIN, WSP(bf16, WS_WIN), D, RmWin(), scr, it, F.lane);
    GAS bf16* wt = WSP(bf16, WS_WIN);
    unsigned zz; asm volatile("v_mov_b32 %0, 0" : "=v"(zz));
    for (int i = gw * 64 + F.lane; i < 112 * 1024 / 8; i += NGW * 64) *(GAS u32x4*)(wt + (size_t)1168 * 1024 + (size_t)i * 8) = (u32x4){zz, zz, zz, zz};
}
__device__ __forceinline__ void conv_weights_upout(Frame& F, int layer, int gw, int NGW, LAS float* scr) {
    const int items = (D / 64) * (D / 32);
    for (int it = gw; it < items; it += NGW) tr_item(inp(F, I_WUP) + (size_t)layer * D * D, D, D, WSP(bf16, WS_WUP), D, RmId(), scr, it, F.lane);
    for (int it = gw; it < items; it += NGW) tr_item(inp(F, I_WOUT) + (size_t)layer * D * D, D, D, WSP(bf16, WS_WOUT), D, RmId(), scr, it, F.lane);
}
__device__ __forceinline__ void conv_weights_ffn(const GAS float* w1, const GAS float* w3, const GAS float* w2, GAS bf16* w13t, GAS bf16* w2t, int gw, int NGW, LAS float* scr, int lane) {
    const int i1 = (D / 64) * (DFF / 32), i2 = (DFF / 64) * (D / 32);
    for (int it = gw; it < i1; it += NGW) tr_item(w1, D, DFF, w13t, D, RmW1(), scr, it, lane);
    for (int it = gw; it < i1; it += NGW) tr_item(w3, D, DFF, w13t, D, RmW3(), scr, it, lane);
    for (int it = gw; it < i2; it += NGW) tr_item(w2, DFF, D, w2t, DFF, RmId(), scr, it, lane);
}

constexpr size_t WS_HID2 = WS_XC;
__device__ __forceinline__ void filter_hidden_item(Frame& F, int p) {
    const int sel = p < 2048 ? 0 : (p < 4096 ? 1 : 2), layer = sel == 1 ? 1 : 0, L = sel == 2 ? LC : LL, pbase = sel == 0 ? 0 : (sel == 1 ? 2048 : 4096);
    const GAS float* f1 = inp(F, I_HYF1) + layer * 33 * 64; const GAS float* fb1 = inp(F, I_HYFB1) + layer * 64;
    const GAS float* f2 = inp(F, I_HYF2) + layer * 64 * 64; const GAS float* fb2 = inp(F, I_HYFB2) + layer * 64;
    const int lane = F.lane;
    float w1[33], w2[64];
#pragma unroll
    for (int i = 0; i < 33; ++i) w1[i] = f1[i * 64 + lane];
#pragma unroll
    for (int i = 0; i < 64; ++i) w2[i] = f2[i * 64 + lane];
    const float b1 = fb1[lane], b2 = fb2[lane];
    const int pos = p - pbase;
    const float t = (float)pos / (float)(L - 1);
    const float w = 6.283185307179586f * (float)pos / (float)L;
    float feat = 0.f;
    if (lane == 0) feat = t;
    else if (lane < 17) { const float band = 1e-4f + (float)(lane - 1) * ((15.0f - 1e-4f) / 15.0f); feat = cosf(w * band); }
    else if (lane < 33) { const float band = 1e-4f + (float)(lane - 17) * ((15.0f - 1e-4f) / 15.0f); feat = -sinf(w * band); }
    float a1 = b1;
#pragma unroll
    for (int i = 0; i < 33; ++i) a1 += __int_as_float(__builtin_amdgcn_readlane(__float_as_int(feat), i)) * w1[i];
    const float h1 = sinf(a1);
    float a2 = b2;
#pragma unroll
    for (int i = 0; i < 64; ++i) a2 += __int_as_float(__builtin_amdgcn_readlane(__float_as_int(h1), i)) * w2[i];
    WSP(float, WS_HID2)[(size_t)p * 64 + lane] = sinf(a2);
}
__device__ __forceinline__ void filter_out_item(Frame& F, int item) {
    int sel, r;
    if (item < 768) { sel = 0; r = item; } else if (item < 1536) { sel = 1; r = item - 768; } else { sel = 2; r = item - 1536; }
    const int layer = sel == 1 ? 1 : 0, L = sel == 2 ? LC : LL, pb = r / 24, ch = r % 24, pbase = sel == 0 ? 0 : (sel == 1 ? 2048 : 4096);
    GAS bf16* FT = sel == 2 ? WSP(bf16, WS_FTC) : WSP(bf16, WS_FTL) + (size_t)layer * 2 * 384 * 4096;
    const GAS float* f3 = inp(F, I_HYF3) + (size_t)layer * 64 * 1536; const GAS float* dec = inp(F, I_HYDECAY) + layer * 1536;
    const int lane = F.lane, fr = lane & 15, fq = lane >> 4;
    const GAS float* hid = WSP(const float, WS_HID2) + (size_t)(pbase + pb * 64) * 64;
    f32x4 acc[4][4];
#pragma unroll
    for (int mt = 0; mt < 4; ++mt)
#pragma unroll
        for (int nt = 0; nt < 4; ++nt) acc[mt][nt] = (f32x4){0.f, 0.f, 0.f, 0.f};
#pragma unroll
    for (int ks = 0; ks < 16; ++ks) {
        float a[4], bb[4];
#pragma unroll
        for (int mt = 0; mt < 4; ++mt) a[mt] = hid[(16 * mt + fr) * 64 + 4 * ks + fq];
#pragma unroll
        for (int nt = 0; nt < 4; ++nt) bb[nt] = f3[(size_t)(4 * ks + fq) * 1536 + ch * 64 + 16 * nt + fr];
#pragma unroll
        for (int mt = 0; mt < 4; ++mt)
#pragma unroll
            for (int nt = 0; nt < 4; ++nt) acc[mt][nt] = __builtin_amdgcn_mfma_f32_16x16x4f32(a[mt], bb[nt], acc[mt][nt], 0, 0, 0);
    }
#pragma unroll
    for (int nt = 0; nt < 4; ++nt) {
        const int nn = ch * 64 + 16 * nt + fr, o = nn / 768, dir = (nn / 384) & 1, c = nn % 384;
        const float adec = fabsf(dec[nn]);
        GAS bf16* dst = FT + (size_t)(o * 384 + c) * (2 * L);
#pragma unroll
        for (int mt = 0; mt < 4; ++mt) {
            const int pos0 = pb * 64 + 16 * mt + 4 * fq;
            float v[4];
#pragma unroll
            for (int j = 0; j < 4; ++j) { const float t = (float)(pos0 + j) / (float)(L - 1); v[j] = acc[mt][nt][j] * __expf(-t * adec); }
            if (dir == 0) { u32x2 w; w.x = pk2(v[3], v[2]); w.y = pk2(v[1], v[0]); *(GAS u32x2*)(dst + L - pos0 - 3) = w; }
            else if (pos0 > 0) { u32x2 w; w.x = pk2(v[0], v[1]); w.y = pk2(v[2], v[3]); *(GAS u32x2*)(dst + L + pos0) = w; }
            else { dst[L + 1] = (bf16)f2bf(v[1]); dst[L + 2] = (bf16)f2bf(v[2]); dst[L + 3] = (bf16)f2bf(v[3]); }
        }
    }
}

__device__ __forceinline__ void phase_p0(Frame& F) {
    const int gw = F.wg * NWAVES + F.wave, NGW = F.G * NWAVES;
    LAS float* sl = (LAS float*)F.lds;
    LAS float* red = (LAS float*)(F.lds + 17 * 4096);
    { f32x4 tv[9];
#pragma unroll
      for (int q = 0; q < 9; ++q) { const int i4 = F.tid + q * NTHR; if (i4 < 4352) { const int r = i4 >> 8, k4 = i4 & 255; tv[q] = r < 16 ? *(const GAS f32x4*)(inp(F, I_C) + r * 1024 + 4 * k4) : *(const GAS f32x4*)(inp(F, I_CCTX) + 4 * k4); } }
#pragma unroll
      for (int q = 0; q < 9; ++q) { const int i4 = F.tid + q * NTHR; if (i4 < 4352) { f32x4 o; o.x = siluf_(tv[q].x); o.y = siluf_(tv[q].y); o.z = siluf_(tv[q].z); o.w = siluf_(tv[q].w); *(LAS f32x4*)(sl + 4 * i4) = o; } } }
    __syncthreads();
    {
        const int j = F.tid & 15, kp = F.tid >> 4;
        const int slot = 2 * ((F.wg >> 4) * 8 + (F.wg & 7)) + ((F.wg >> 3) & 1);
        float w[3][32];
#pragma unroll
        for (int it = 0; it < 3; ++it) { const int item = slot + it * 256, layer = item / 384, n0 = (item % 384) * 16;
            const GAS float* W = inp(F, I_WMOD) + (size_t)layer * D * 6144;
#pragma unroll
            for (int i = 0; i < 32; ++i) w[it][i] = W[(size_t)(kp * 32 + i) * 6144 + n0 + j]; }
#pragma unroll
        for (int it = 0; it < 3; ++it) { const int item = slot + it * 256, layer = item / 384, n0 = (item % 384) * 16;
#pragma unroll
            for (int r = 0; r < 17; ++r) { float acc = 0.f;
#pragma unroll
                for (int q = 0; q < 8; ++q) { const f32x4 s4 = *(const LAS f32x4*)(sl + r * 1024 + kp * 32 + 4 * q); acc += (s4.x * w[it][4 * q] + s4.y * w[it][4 * q + 1]) + (s4.z * w[it][4 * q + 2] + s4.w * w[it][4 * q + 3]); }
                red[(kp * 17 + r) * 16 + j] = acc; }
            __syncthreads();
            if (F.tid < 272) { const int r = F.tid >> 4, jj = F.tid & 15; float s = inp(F, I_BMOD)[layer * 6144 + n0 + jj];
                for (int q = 0; q < 32; ++q) s += red[(q * 17 + r) * 16 + jj];
                WSP(float, WS_MOD)[(size_t)(layer * 17 + r) * 6144 + n0 + jj] = s; }
            __syncthreads();
        }
    }
    __syncthreads();
    LAS float* scr = (LAS float*)(F.lds + F.wave * 8704);
    conv_weights_win(F, 0, gw, NGW, scr);
    conv_weights_upout(F, 0, gw, NGW, scr);
    for (int i = gw * 64 + F.lane; i < 2048 * 32; i += NGW * 64) {
        const int t = i >> 5, j = i & 31, half = j >> 4, ii = j & 15;
        const float inv = 1.0f / powf(10000.0f, (float)ii / 16.0f);
        const float ang = (float)(half == 0 ? (t >> 6) : (t & 63)) * inv;
        WSP(float, WS_ROPE)[t * 64 + half * 32 + ii] = cosf(ang);
        WSP(float, WS_ROPE)[t * 64 + half * 32 + 16 + ii] = sinf(ang);
    }
    for (int it = gw; it < 4352; it += NGW) filter_hidden_item(F, it);
}
__device__ __forceinline__ void write_bias(Frame& F) {
    const int gt = (F.wg * NWAVES + F.wave) * 64 + F.lane, NGT = F.G * NTHR;
    for (int i = gt; i < 2 * NWP; i += NGT) {
        const int l = i / NWP, r = i % NWP; float v = 0.f;
        int n = -1;
        if (r < 1152) n = r; else if (r < 1168) n = 3712 + (r - 1152); else if (r < 1280) n = -1; else if (r < 2816) n = 1152 + (r - 1280); else if (r < 3840) n = 2688 + (r - 2816); else n = 3728 + (r - 3840);
        if (n >= 0) v = inp(F, I_BIN)[l * NIN + n];
        WSP(float, WS_BIAS)[i] = v;
    }
}

template <bool XB> struct XRaw { typedef f32x4 T; };
template <> struct XRaw<true> { typedef u32x2 T; };
template <bool XB>
__device__ __forceinline__ void xrow_issue(const Frame& F, int row, int src, int lane, typename XRaw<XB>::T (&w)[4]) {
    if constexpr (!XB) { const GAS float* xr = row < TOKL ? inp(F, I_X) + (size_t)row * D : inp(F, I_CTX) + (size_t)(row - TOKL) * D;
#pragma unroll
        for (int j = 0; j < 4; ++j) w[j] = *(const GAS f32x4*)(xr + 256 * j + 4 * lane); }
    else { const GAS bf16* xr = src == 2 ? WSP(const bf16, WS_XL2) + (size_t)row * D : (row < TOKL ? (const GAS bf16*)outp(F) + (size_t)row * D : WSP(const bf16, WS_XC) + (size_t)(row - TOKL) * D);
#pragma unroll
        for (int j = 0; j < 4; ++j) w[j] = *(const GAS u32x2*)(xr + 256 * j + 4 * lane); }
}
__device__ __forceinline__ f32x4 xrow_unpack(f32x4 w) { return w; }
__device__ __forceinline__ f32x4 xrow_unpack(u32x2 w) { f32x4 v; v.x = __uint_as_float(w.x << 16); v.y = __uint_as_float(w.x & 0xffff0000u); v.z = __uint_as_float(w.y << 16); v.w = __uint_as_float(w.y & 0xffff0000u); return v; }
template <bool XB>
__device__ __forceinline__ void phase_norm(Frame& F, int layer, int nrows, int which) {
    const int gw = F.wg * NWAVES + F.wave, NGW = F.G * NWAVES, lane = F.lane;
    const GAS float* g = inp(F, which == 0 ? I_GMIX : I_GFFN) + layer * D;
    const int per = (nrows + NGW - 1) / NGW, r0 = gw * per, r1 = min(nrows, r0 + per);
    if (r0 >= r1) return;
    int grp = -1; f32x4 gm[4], sh[4]; typename XRaw<XB>::T ring[4][4];
#pragma unroll
    for (int i = 0; i < 4; ++i) if (r0 + i < r1) xrow_issue<XB>(F, r0 + i, 1, lane, ring[i]);
#pragma unroll 1
    for (int rb = r0; rb < r1; rb += 4) {
#pragma unroll
        for (int i = 0; i < 4; ++i) {
            const int row = rb + i;
            if (row < r1) {
                const int gr = row < TOKL ? (row >> 11) : 16;
                if (gr != grp) { grp = gr; const GAS float* shp = mod_ptr(F, layer, row, which); const GAS float* scp = mod_ptr(F, layer, row, which + 1);
#pragma unroll
                    for (int j = 0; j < 4; ++j) { const f32x4 gg = *(const GAS f32x4*)(g + 256 * j + 4 * lane), sc = *(const GAS f32x4*)(scp + 256 * j + 4 * lane); sh[j] = *(const GAS f32x4*)(shp + 256 * j + 4 * lane);
                        gm[j].x = gg.x * (1.f + sc.x); gm[j].y = gg.y * (1.f + sc.y); gm[j].z = gg.z * (1.f + sc.z); gm[j].w = gg.w * (1.f + sc.w); } }
                f32x4 v[4]; float s = 0.f;
#pragma unroll
                for (int j = 0; j < 4; ++j) { v[j] = xrow_unpack(ring[i][j]); s += (v[j].x * v[j].x + v[j].y * v[j].y) + (v[j].z * v[j].z + v[j].w * v[j].w); }
                if (row + 4 < r1) xrow_issue<XB>(F, row + 4, 1, lane, ring[i]);
                const float r = rsqrtf(wave_sum(s) * (1.0f / 1024.0f) + 1e-6f);
                GAS bf16* orow = WSP(bf16, WS_H) + (size_t)row * D;
#pragma unroll
                for (int j = 0; j < 4; ++j) {
                    f32x4 o; o.x = v[j].x * r * gm[j].x + sh[j].x; o.y = v[j].y * r * gm[j].y + sh[j].y; o.z = v[j].z * r * gm[j].z + sh[j].z; o.w = v[j].w * r * gm[j].w + sh[j].w;
                    u32x2 w; w.x = pk2(o.x, o.y); w.y = pk2(o.z, o.w);
                    *(GAS u32x2*)(orow + 256 * j + 4 * lane) = w;
                }
            }
        }
    }
}

namespace pg8 {
#ifndef WGM_
#define WGM_ 8
#endif
#ifndef PG8_SP2_
#define PG8_SP2_ 1
#endif
#ifndef PG8_ALIGN_
#define PG8_ALIGN_ 1
#endif
constexpr int BM = 256, BK = 64, HALF = 128, HTB = HALF * BK * 2, STAGE_BYTES = 8 * HTB, NXCD = 8, WGM = WGM_;
__device__ __forceinline__ int lds_byte(int r, int c) { const int st = (r >> 4) * 2 + (c >> 5), rr = r & 15, cc = c & 31, ob = rr * 64 + cc * 2; return st * 1024 + (ob ^ (((ob >> 9) & 1) << 5)); }
__device__ __forceinline__ void stage_rc(int b, int& R, int& C) { const int st = b / 1024, sb = b % 1024, swz = sb ^ (((sb >> 9) & 1) << 5); R = (st >> 1) * 16 + swz / 64; C = (st & 1) * 32 + (swz % 64) / 2; }
struct Unit { int pm, pn; };
template <int MR_>
struct OrderPlainT {
    static constexpr bool GATHER = false; static constexpr int MROWS = MR_;
    int nM, nN, nwg, G, c;
    __device__ __forceinline__ void init(int nM_, int nN_, int G_, int c_) { nM = nM_; nN = nN_; nwg = nM * nN; G = G_; c = c_; }
    __device__ __forceinline__ bool next(int i, Unit& u) const {
        const long L = (long)i * G + c; if (L >= nwg) return false;
        int wgid = (int)L; { const int q = nwg / NXCD, r = nwg % NXCD, xcd = wgid % NXCD, off = wgid / NXCD; wgid = (xcd < r ? xcd * (q + 1) : r * (q + 1) + (xcd - r) * q) + off; }
        const int nig = WGM * nN, gid = wgid / nig, fm = gid * WGM, gsz = (nM - fm) < WGM ? (nM - fm) : WGM;
        u.pm = fm + ((wgid % nig) % gsz); u.pn = (wgid % nig) / gsz; return true;
    }
    __device__ __forceinline__ int arow(int r) const { return r; }
    __device__ __forceinline__ size_t boff(const Unit&) const { return 0; }
};
using OrderPlain = OrderPlainT<256>;
struct OrderWinL1 {
    static constexpr bool GATHER = false; static constexpr int MROWS = 256;
    OrderPlain o; int G, c;
    __device__ __forceinline__ void init(int G_, int c_) { o.init(128, 15, G_, c_); G = G_; c = c_; }
    __device__ __forceinline__ bool next(int i, Unit& u) const {
        const long L = (long)i * G + c;
        if (L < 1920) return o.next(i, u);
        const int r = (int)(L - 1920); if (r >= 112) return false;
        const int q = r % 7; u.pm = 128 + r / 7; u.pn = q == 0 ? 4 : (q <= 4 ? 5 + q : 7 + q);
        return true;
    }
    __device__ __forceinline__ int arow(int r) const { return r; }
    __device__ __forceinline__ size_t boff(const Unit&) const { return 0; }
};
struct OrderMoe {
    static constexpr bool GATHER = true; static constexpr int MROWS = 256;
    OrderPlain o; const GAS int* rowidx; const GAS int* tilee; int t0; size_t bstride; bool gather;
    __device__ __forceinline__ bool next(int i, Unit& u) const { return o.next(i, u); }
    __device__ __forceinline__ int arow(int r) const { return gather ? rowidx[t0 * 256 + r] : r; }
    __device__ __forceinline__ size_t boff(const Unit& u) const { return (size_t)tilee[t0 + u.pm] * bstride; }
};

template <class Epi, class Sched>
__device__ __forceinline__ void gemm_phase(LAS unsigned char* lds, int tid_in, const GAS bf16* A, int lda, const GAS bf16* Bt, int ldb, int K, const Sched& S, const Epi& E) {
    unsigned tid_u = (unsigned)tid_in; asm volatile("" : "+v"(tid_u));
    const int tid = (int)tid_u, wid = __builtin_amdgcn_readfirstlane(tid >> 6), lane = tid & 63, wr = wid >> 2, wc = wid & 3, fr = lane & 15, fq = lane >> 4;
    const int nt = K / BK;
    constexpr int MR = Sched::MROWS, HR = MR / 2, WRR = HR / 2, NMF = WRR / 16;
    static_assert(MR == 256 || (MR == 192 && !Sched::GATHER), "unit rows");
    unsigned voffB[2];
    { int sR[2], sC[2];
#pragma unroll
      for (int i = 0; i < 2; ++i) { stage_rc(tid * 16 + i * 8192, sR[i], sC[i]);
        const int rho = sR[i] & 31, Rb = Epi::PERM ? ((sR[i] & ~31) + 8 * ((rho & 15) >> 2) + 4 * (rho >> 4) + (rho & 3)) : sR[i];
        voffB[i] = (unsigned)(Rb * ldb + sC[i]) * 2u; } }
#define PG8_GATHER_OFFS(pm_) do { unsigned _t = (unsigned)tid; asm volatile("" : "+v"(_t)); _Pragma("unroll") for (int i = 0; i < 2; ++i) { int _R, _C; stage_rc((int)_t * 16 + i * 8192, _R, _C); \
        vc0[i] = (unsigned)((size_t)S.arow((pm_) * BM + _R) * lda + _C) * 2u; vc1[i] = (unsigned)((size_t)S.arow((pm_) * BM + HALF + _R) * lda + _C) * 2u; } } while (0)
    const size_t kstep = (size_t)(BK * 2);
    const size_t hstepB = (size_t)HALF * ldb * 2, tstepB = 2 * hstepB;
    const unsigned ldsw = (unsigned)wid * 1024u;
    const int aoff = lds_byte(wr * WRR + fr, fq * 8), boff = lds_byte(wc * 32 + fr, fq * 8);
#define PG8_SA(b, h) (((b) * 2 + (h)) * HTB)
#define PG8_SB(b, h) ((4 + (b) * 2 + (h)) * HTB)
#define PG8_STAGE2(bufoff, gbase, uo, v0, v1) do { \
        __builtin_amdgcn_global_load_lds((const GAS unsigned*)((const GAS char*)(gbase) + (unsigned)((v0) + (unsigned)(uo))), (LAS unsigned*)(lds + (bufoff) + ldsw), 16, 0, 0); \
        __builtin_amdgcn_global_load_lds((const GAS unsigned*)((const GAS char*)(gbase) + (unsigned)((v1) + (unsigned)(uo))), (LAS unsigned*)(lds + (bufoff) + ldsw + 8192), 16, 0, 0); } while (0)
#define PG8_STAGEB(bufoff, gbase, uo) PG8_STAGE2(bufoff, gbase, uo, voffB[0], voffB[1])
#define PG8_LDA(dst, b, h) do { _Pragma("unroll") for (int m = 0; m < NMF; ++m) _Pragma("unroll") for (int k = 0; k < 2; ++k) dst[m][k] = *(const LAS bf16x8*)(lds + PG8_SA(b, h) + aoff + m * 2048 + k * 1024); } while (0)
#define PG8_LDB(dst, b, h) do { _Pragma("unroll") for (int n = 0; n < 2; ++n) _Pragma("unroll") for (int k = 0; k < 2; ++k) dst[n][k] = *(const LAS bf16x8*)(lds + PG8_SB(b, h) + boff + n * 2048 + k * 1024); } while (0)
#define PG8_MMA(ai, bj, At, Bt_) do { __builtin_amdgcn_s_setprio(1); _Pragma("unroll") for (int m = 0; m < NMF; ++m) _Pragma("unroll") for (int n = 0; n < 2; ++n) _Pragma("unroll") for (int k = 0; k < 2; ++k) \
        acc[ai][bj][m][n] = __builtin_amdgcn_mfma_f32_16x16x32_bf16(Bt_[n][k], At[m][k], acc[ai][bj][m][n], 0, 0, 0); __builtin_amdgcn_s_setprio(0); } while (0)
#define PG8_WAIT_V(n) asm volatile("s_waitcnt vmcnt(" #n ")" ::: "memory")
#define PG8_WAIT_L(n) asm volatile("s_waitcnt lgkmcnt(" #n ")" ::: "memory")
#define PG8_BAR __builtin_amdgcn_s_barrier()
#define PG8_SCHED __builtin_amdgcn_sched_barrier(0)
    Unit cur, nxt; int ui = 0;
    if (!S.next(0, cur)) return;
#ifndef STAGGER
#define STAGGER 0
#endif
    if (STAGGER) { const int grp = (int)(blockIdx.x >> 3) & 3;
        for (int i = 0; i < grp * STAGGER; ++i) __builtin_amdgcn_s_sleep(127); }
    f32x4 acc[2][2][4][2];
#pragma unroll
    for (int a = 0; a < 2; ++a)
#pragma unroll
        for (int b = 0; b < 2; ++b)
#pragma unroll
            for (int m = 0; m < NMF; ++m)
#pragma unroll
                for (int n = 0; n < 2; ++n) { float zf; asm volatile("v_mov_b32 %0, 0" : "=v"(zf)); acc[a][b][m][n] = (f32x4){zf, zf, zf, zf}; }
    bf16x8 At[4][2], B0[2][2], B1[2][2];
    constexpr bool GA = Sched::GATHER;
    const size_t hstepA = GA ? 0 : (size_t)HR * lda * 2, tstepA = (size_t)MR * lda * 2;
    unsigned vc0[2], vc1[2];
    if constexpr (GA) { PG8_GATHER_OFFS(cur.pm); }
    else { int sR, sC;
#pragma unroll
        for (int i = 0; i < 2; ++i) { stage_rc(tid * 16 + i * 8192, sR, sC); if (MR == 192 && sR >= HR) { sR = 0; sC = 0; }
            if constexpr (Epi::APERM) { static_assert(!Epi::APERM || (MR == 256 && !Epi::BASE && !Epi::HORNER), "APERM"); const int w_ = sR & 63; sR = (sR & ~63) + 4 * (w_ & 15) + (w_ >> 4); }
            vc0[i] = (unsigned)(sR * lda + sC) * 2u; vc1[i] = 0u; } }
#define VC0(i) vc0[i]
#define VC1(i) (GA ? vc1[i] : vc0[i])
#define VN0(i) vc0[i]
#define VN1(i) VC1(i)
    const GAS char* cA = GA ? (const GAS char*)A : (const GAS char*)A + (size_t)cur.pm * tstepA;
    const GAS char* cB = (const GAS char*)Bt + S.boff(cur) * 2 + (size_t)cur.pn * tstepB;
    constexpr bool SP2 = PG8_SP2_ != 0, ALIGN_EPI = PG8_ALIGN_ != 0;
    const unsigned hsA = (unsigned)hstepA, hsB = (unsigned)hstepB;
    if constexpr (SP2) {
        PG8_STAGEB(PG8_SB(0, 0), cB, 0u); PG8_STAGEB(PG8_SB(0, 1), cB, hsB); PG8_STAGE2(PG8_SA(0, 0), cA, 0u, VC0(0), VC0(1)); PG8_STAGE2(PG8_SA(0, 1), cA, hsA, VC1(0), VC1(1));
        if (wr == 1) PG8_BAR;
        PG8_WAIT_V(2); PG8_BAR;
        PG8_STAGEB(PG8_SB(1, 0), cB, 128u); PG8_STAGE2(PG8_SA(1, 0), cA, 128u, VC0(0), VC0(1)); PG8_STAGEB(PG8_SB(1, 1), cB, hsB + 128u);
        PG8_WAIT_V(6); PG8_BAR;
    } else {
        PG8_STAGEB(PG8_SB(0, 0), cB, 0u); PG8_STAGE2(PG8_SA(0, 0), cA, 0u, VC0(0), VC0(1)); PG8_STAGEB(PG8_SB(0, 1), cB, hsB); PG8_STAGE2(PG8_SA(0, 1), cA, hsA, VC1(0), VC1(1));
        if (wr == 1) PG8_BAR;
        PG8_WAIT_V(4); PG8_BAR;
        PG8_STAGEB(PG8_SB(1, 0), cB, 128u); PG8_STAGE2(PG8_SA(1, 0), cA, 128u, VC0(0), VC0(1)); PG8_STAGEB(PG8_SB(1, 1), cB, hsB + 128u);
        PG8_WAIT_V(6); PG8_BAR;
    }
    for (;;) {
        const bool has_next = S.next(ui + 1, nxt);
        const GAS char* nB = cB; const GAS char* nA = cA;
        if (has_next) {
            nB = (const GAS char*)Bt + S.boff(nxt) * 2 + (size_t)nxt.pn * tstepB;
            if constexpr (!GA) nA = (const GAS char*)A + (size_t)nxt.pm * tstepA;
        }
        for (int t = 0; t < nt; t += 2) {
            const bool last = (t == nt - 2);
            if constexpr (Epi::HORNER) {
                if (t == 6 || t == 12) {
                    asm volatile("" ::: "memory");
                    const int seg = (t == 6) ? 0 : 1;
                    int hpm = cur.pm, hpn = cur.pn; asm volatile("" : "+s"(hpm), "+s"(hpn));
                    unsigned hln = (unsigned)lane; asm volatile("" : "+v"(hln)); const int hfr = (int)(hln & 15u), hfq = (int)(hln >> 4);
#pragma unroll
                    for (int ai = 0; ai < 2; ++ai) {
                        u32x4 ga[4][2], gb[4][2];
#pragma unroll
                        for (int m = 0; m < NMF; ++m)
#pragma unroll
                            for (int bj = 0; bj < 2; ++bj) {
                                const int row = hpm * MR + ai * HR + wr * WRR + m * 16 + hfr, col = hpn * BM + bj * HALF + wc * 32 + 8 * hfq;
                                ga[m][bj] = E.gate8(seg, row, col); gb[m][bj] = E.gate8(seg + 1, row, col);
                            }
                        if constexpr (NMF == 4) asm volatile("" : "+v"(ga[0][0]), "+v"(ga[0][1]), "+v"(ga[1][0]), "+v"(ga[1][1]), "+v"(ga[2][0]), "+v"(ga[2][1]), "+v"(ga[3][0]), "+v"(ga[3][1]),
                                          "+v"(gb[0][0]), "+v"(gb[0][1]), "+v"(gb[1][0]), "+v"(gb[1][1]), "+v"(gb[2][0]), "+v"(gb[2][1]), "+v"(gb[3][0]), "+v"(gb[3][1]) :: "memory");
                        else asm volatile("" : "+v"(ga[0][0]), "+v"(ga[0][1]), "+v"(ga[1][0]), "+v"(ga[1][1]), "+v"(ga[2][0]), "+v"(ga[2][1]),
                                          "+v"(gb[0][0]), "+v"(gb[0][1]), "+v"(gb[1][0]), "+v"(gb[1][1]), "+v"(gb[2][0]), "+v"(gb[2][1]) :: "memory");
#pragma unroll
                        for (int m = 0; m < NMF; ++m)
#pragma unroll
                            for (int bj = 0; bj < 2; ++bj) {
                                const unsigned aw[4] = {ga[m][bj].x, ga[m][bj].y, ga[m][bj].z, ga[m][bj].w}, bw[4] = {gb[m][bj].x, gb[m][bj].y, gb[m][bj].z, gb[m][bj].w};
#pragma unroll
                                for (int n = 0; n < 2; ++n) {
                                    f32x4& v = acc[ai][bj][m][n];
                                    v.x *= __uint_as_float(aw[2 * n] << 16) * __builtin_amdgcn_rcpf(__uint_as_float(bw[2 * n] << 16));
                                    v.y *= __uint_as_float(aw[2 * n] & 0xffff0000u) * __builtin_amdgcn_rcpf(__uint_as_float(bw[2 * n] & 0xffff0000u));
                                    v.z *= __uint_as_float(aw[2 * n + 1] << 16) * __builtin_amdgcn_rcpf(__uint_as_float(bw[2 * n + 1] << 16));
                                    v.w *= __uint_as_float(aw[2 * n + 1] & 0xffff0000u) * __builtin_amdgcn_rcpf(__uint_as_float(bw[2 * n + 1] & 0xffff0000u));
                                }
                            }
                    }
                    asm volatile("s_waitcnt vmcnt(0)" ::: "memory");
                }
            }
            const unsigned k1 = (unsigned)(t + 1) * 128u, k2 = last ? 0u : (unsigned)(t + 2) * 128u, k3 = k2 + 128u;
            const GAS char* pA2 = last ? nA : cA; const GAS char* pB2 = last ? nB : cB;
            if constexpr (SP2) {
            PG8_LDB(B0, 0, 0); PG8_LDB(B1, 0, 1); PG8_SCHED; PG8_LDA(At, 0, 0); PG8_STAGE2(PG8_SA(1, 1), cA, k1 + hsA, VC1(0), VC1(1));
            if constexpr (GA) { if (last && has_next) { asm volatile("" ::: "memory"); PG8_GATHER_OFFS(nxt.pm); asm volatile("" ::: "memory"); } }
            PG8_WAIT_V(8); PG8_WAIT_L(0); PG8_BAR; PG8_MMA(0, 0, At, B0); PG8_MMA(0, 1, At, B1); PG8_BAR; PG8_SCHED;
            PG8_LDA(At, 0, 1); PG8_STAGEB(PG8_SB(0, 0), pB2, k2); PG8_STAGEB(PG8_SB(0, 1), pB2, k2 + hsB); PG8_STAGE2(PG8_SA(0, 0), pA2, k2, VN0(0), VN0(1));
            PG8_WAIT_V(8); PG8_WAIT_L(0); PG8_BAR; PG8_MMA(1, 0, At, B0); PG8_MMA(1, 1, At, B1); PG8_BAR; PG8_SCHED;
            PG8_LDB(B0, 1, 0); PG8_LDB(B1, 1, 1); PG8_SCHED; PG8_LDA(At, 1, 0); PG8_STAGE2(PG8_SA(0, 1), pA2, k2 + hsA, VN1(0), VN1(1));
            PG8_WAIT_V(8); PG8_WAIT_L(0); PG8_BAR; PG8_MMA(0, 0, At, B0); PG8_MMA(0, 1, At, B1); PG8_BAR; PG8_SCHED;
            PG8_LDA(At, 1, 1); PG8_STAGEB(PG8_SB(1, 0), pB2, k3); PG8_STAGEB(PG8_SB(1, 1), pB2, k3 + hsB); PG8_STAGE2(PG8_SA(1, 0), pA2, k3, VN0(0), VN0(1));
            PG8_WAIT_V(8); PG8_WAIT_L(0); PG8_BAR; PG8_MMA(1, 0, At, B0); PG8_MMA(1, 1, At, B1); PG8_BAR; PG8_SCHED;
            } else {
            PG8_LDB(B0, 0, 0); PG8_SCHED; PG8_LDA(At, 0, 0); PG8_STAGE2(PG8_SA(1, 1), cA, k1 + hsA, VC1(0), VC1(1));
            if constexpr (GA) { if (last && has_next) { asm volatile("" ::: "memory"); PG8_GATHER_OFFS(nxt.pm); asm volatile("" ::: "memory"); } }
            PG8_WAIT_L(8); PG8_BAR; PG8_WAIT_L(0); PG8_MMA(0, 0, At, B0); PG8_BAR; PG8_SCHED;
            PG8_LDB(B1, 0, 1); PG8_STAGEB(PG8_SB(0, 0), pB2, k2);
            PG8_BAR; PG8_WAIT_L(0); PG8_MMA(0, 1, At, B1); PG8_BAR;
            PG8_LDA(At, 0, 1); PG8_STAGE2(PG8_SA(0, 0), pA2, k2, VN0(0), VN0(1));
            PG8_BAR; PG8_WAIT_L(0); PG8_MMA(1, 0, At, B0); PG8_BAR; PG8_SCHED;
            PG8_STAGEB(PG8_SB(0, 1), pB2, k2 + hsB);
            PG8_WAIT_V(6); PG8_BAR; PG8_MMA(1, 1, At, B1); PG8_BAR;
            PG8_LDB(B0, 1, 0); PG8_SCHED; PG8_LDA(At, 1, 0); PG8_STAGE2(PG8_SA(0, 1), pA2, k2 + hsA, VN1(0), VN1(1));
            PG8_WAIT_L(8); PG8_BAR; PG8_WAIT_L(0); PG8_MMA(0, 0, At, B0); PG8_BAR; PG8_SCHED;
            PG8_LDB(B1, 1, 1); PG8_STAGEB(PG8_SB(1, 0), pB2, k3);
            PG8_BAR; PG8_WAIT_L(0); PG8_MMA(0, 1, At, B1); PG8_BAR;
            PG8_LDA(At, 1, 1); PG8_STAGE2(PG8_SA(1, 0), pA2, k3, VN0(0), VN0(1));
            PG8_BAR; PG8_WAIT_L(0); PG8_MMA(1, 0, At, B0); PG8_BAR; PG8_SCHED;
            PG8_STAGEB(PG8_SB(1, 1), pB2, k3 + hsB);
            PG8_WAIT_V(6); PG8_BAR; PG8_MMA(1, 1, At, B1); PG8_BAR;
                    }
        }
        if constexpr (ALIGN_EPI) { if (wr == 0) PG8_BAR; }
#ifndef REP_EPI
#define REP_EPI 1
#endif
#pragma unroll 1
        for (int rpe = 0; rpe < ((Epi::COLVEC && Epi::BASE) ? 1 : REP_EPI); ++rpe) {
            int epm = cur.pm, epn = cur.pn; asm volatile("" : "+s"(epm), "+s"(epn));
            unsigned eln = (unsigned)lane; asm volatile("" : "+v"(eln)); const int efr = (int)(eln & 15u), efq = (int)(eln >> 4);
            constexpr bool PM = Epi::PERM;
#define PG8_COL(bj, n) (epn * BM + (bj) * HALF + wc * 32 + (PM ? 8 * efq + 4 * (n) : (n) * 16 + 4 * efq))
            f32x4 cv[2][2];
#pragma unroll
            for (int bj = 0; bj < 2; ++bj)
#pragma unroll
                for (int n = 0; n < 2; ++n) { if constexpr (Epi::COLVEC) cv[bj][n] = E.colvec(epm * MR, PG8_COL(bj, n)); else cv[bj][n] = (f32x4){0.f, 0.f, 0.f, 0.f}; }
            if constexpr (Epi::COLVEC) asm volatile("" : "+v"(cv[0][0]), "+v"(cv[0][1]), "+v"(cv[1][0]), "+v"(cv[1][1]) :: "memory");
            constexpr bool CV2 = Epi::COLVEC && Epi::ROWCV && MR != 256;
            f32x4 cv2[2][2];
            if constexpr (CV2) {
#pragma unroll
                for (int bj = 0; bj < 2; ++bj)
#pragma unroll
                    for (int n = 0; n < 2; ++n) cv2[bj][n] = E.colvec(epm * MR + MR - 1, PG8_COL(bj, n));
                asm volatile("" : "+v"(cv2[0][0]), "+v"(cv2[0][1]), "+v"(cv2[1][0]), "+v"(cv2[1][1]) :: "memory");
            }
#pragma unroll
            for (int ai = 0; ai < 2; ++ai) {
                f32x4 bs[4][2][2];
                if constexpr (Epi::BASE) {
#pragma unroll
                    for (int m = 0; m < NMF; ++m)
#pragma unroll
                        for (int bj = 0; bj < 2; ++bj) {
                            const int row = epm * MR + ai * HR + wr * WRR + m * 16 + efr;
                            if constexpr (PM) E.base8(row, PG8_COL(bj, 0), bs[m][bj][0], bs[m][bj][1]);
                            else {
#pragma unroll
                                for (int n = 0; n < 2; ++n) bs[m][bj][n] = E.base(row, PG8_COL(bj, n));
                            }
                        }
                    if constexpr (NMF == 4) asm volatile("" : "+v"(bs[0][0][0]), "+v"(bs[0][0][1]), "+v"(bs[0][1][0]), "+v"(bs[0][1][1]), "+v"(bs[1][0][0]), "+v"(bs[1][0][1]), "+v"(bs[1][1][0]), "+v"(bs[1][1][1]),
                                      "+v"(bs[2][0][0]), "+v"(bs[2][0][1]), "+v"(bs[2][1][0]), "+v"(bs[2][1][1]), "+v"(bs[3][0][0]), "+v"(bs[3][0][1]), "+v"(bs[3][1][0]), "+v"(bs[3][1][1]) :: "memory");
                    else asm volatile("" : "+v"(bs[0][0][0]), "+v"(bs[0][0][1]), "+v"(bs[0][1][0]), "+v"(bs[0][1][1]), "+v"(bs[1][0][0]), "+v"(bs[1][0][1]), "+v"(bs[1][1][0]), "+v"(bs[1][1][1]),
                                      "+v"(bs[2][0][0]), "+v"(bs[2][0][1]), "+v"(bs[2][1][0]), "+v"(bs[2][1][1]) :: "memory");
                }
                if constexpr (Epi::APERM) {
#pragma unroll
                    for (int bj = 0; bj < 2; ++bj) {
                        const f32x4 t0[4] = {acc[ai][bj][0][0], acc[ai][bj][1][0], acc[ai][bj][2][0], acc[ai][bj][3][0]}, t1[4] = {acc[ai][bj][0][1], acc[ai][bj][1][1], acc[ai][bj][2][1], acc[ai][bj][3][1]};
                        E.store_m4(epm * MR + ai * HR + wr * WRR + 4 * efr, PG8_COL(bj, 0), t0, t1, cv[bj][0], cv[bj][1]);
                    }
                } else
#pragma unroll
                for (int m = 0; m < NMF; ++m) {
                    const int row = epm * MR + ai * HR + wr * WRR + m * 16 + efr;
                    bool alt = false; if constexpr (CV2) alt = E.rowgrp(epm * MR + ai * HR + wr * WRR + m * 16) != E.rowgrp(epm * MR);
                    if constexpr (Epi::PAIR) E.store_pair8(row, epn * (BM / 2) + wc * 32 + 8 * efq, acc[ai][0][m][0], acc[ai][0][m][1], acc[ai][1][m][0], acc[ai][1][m][1]);
#pragma unroll
                    for (int bj = 0; bj < 2; ++bj) {
                        if constexpr (Epi::PAIR) { }
                        else if constexpr (PM) {
                            f32x4 b0 = (f32x4){0.f, 0.f, 0.f, 0.f}, b1 = b0; if constexpr (Epi::BASE) { b0 = bs[m][bj][0]; b1 = bs[m][bj][1]; }
                            E.store8(row, PG8_COL(bj, 0), acc[ai][bj][m][0], acc[ai][bj][m][1], (CV2 && alt) ? cv2[bj][0] : cv[bj][0], (CV2 && alt) ? cv2[bj][1] : cv[bj][1], b0, b1);
                        } else {
#pragma unroll
                            for (int n = 0; n < 2; ++n) { f32x4 bb = (f32x4){0.f, 0.f, 0.f, 0.f}; if constexpr (Epi::BASE) bb = bs[m][bj][n]; E.store(row, PG8_COL(bj, n), acc[ai][bj][m][n], (CV2 && alt) ? cv2[bj][n] : cv[bj][n], bb); }
                        }
                    }
                }
            }
#undef PG8_COL
        }
        if (!has_next) break;
#pragma unroll
        for (int a = 0; a < 2; ++a)
#pragma unroll
            for (int b = 0; b < 2; ++b)
#pragma unroll
                for (int m = 0; m < NMF; ++m)
#pragma unroll
                    for (int n = 0; n < 2; ++n) { float zf; asm volatile("v_mov_b32 %0, 0" : "=v"(zf)); acc[a][b][m][n] = (f32x4){zf, zf, zf, zf}; }
        cur = nxt; cB = nB; cA = nA; ++ui;
        if constexpr (ALIGN_EPI) { if (wr == 1) PG8_BAR; }
    }
    PG8_WAIT_V(0);
    if constexpr (!ALIGN_EPI) { if (wr == 0) PG8_BAR; }
    PG8_BAR;
#undef PG8_GATHER_OFFS
#undef VC0
#undef VC1
#undef VN0
#undef VN1
#undef PG8_SA
#undef PG8_SB
#undef PG8_STAGE2
#undef PG8_STAGEB
#undef PG8_LDA
#undef PG8_LDB
#undef PG8_MMA
#undef PG8_WAIT_V
#undef PG8_WAIT_L
#undef PG8_BAR
#undef PG8_SCHED
}
}

template <int MR = 256, class Epi>
__device__ __forceinline__ void gemm_fast(Frame& F, const GAS bf16* A, int lda, const GAS bf16* Bt, int ldb, int K, int M, int N, const Epi& E) {
    pg8::OrderPlainT<MR> S; S.init(M / MR, N / 256, F.G, F.wg);
    pg8::gemm_phase(F.lds, F.tid, A, lda, Bt, ldb, K, S, E);
}

__device__ __forceinline__ void st_bf16x4(GAS bf16* p, f32x4 v) { u32x2 w; w.x = pk2(v.x, v.y); w.y = pk2(v.z, v.w); *(GAS u32x2*)p = w; }
__device__ __forceinline__ f32x4 ld_bf16x4(const GAS bf16* p) { const u32x2 w = *(const GAS u32x2*)p; f32x4 v; v.x = __uint_as_float(w.x << 16); v.y = __uint_as_float(w.x & 0xffff0000u); v.z = __uint_as_float(w.y << 16); v.w = __uint_as_float(w.y & 0xffff0000u); return v; }

__device__ __forceinline__ void st_bf16x8(GAS bf16* p, f32x4 a, f32x4 b) { u32x4 w; w.x = pk2(a.x, a.y); w.y = pk2(a.z, a.w); w.z = pk2(b.x, b.y); w.w = pk2(b.z, b.w); *(GAS u32x4*)p = w; }
struct EpiWin {
    static constexpr bool HORNER = false, PAIR = false, COLVEC = true, BASE = false, PERM = true, ROWCV = false, APERM = true;
    const GAS float* bias; GAS bf16 *hytl, *hytc, *ret, *ml; GAS float* mlg;
    __device__ __forceinline__ f32x4 colvec(int, int col) const { return *(const GAS f32x4*)(bias + col); }
    __device__ __forceinline__ void store8(int row, int col, f32x4 v0, f32x4 v1, f32x4 c0, f32x4 c1, f32x4, f32x4) const {
        v0 += c0; v1 += c1;
        if (col < 1152) {
            const float v[8] = {v0.x, v0.y, v0.z, v0.w, v1.x, v1.y, v1.z, v1.w};
            if (row < TOKL) { const int b = row >> 11, t = row & 2047; GAS bf16* d = hytl + ((size_t)(b * 1152 + col)) * 2048 + t;
#pragma unroll
                for (int j = 0; j < 8; ++j) d[2048 * j] = (bf16)f2bf(v[j]); }
            else { const int r = row - TOKL, b = r >> 8, t = r & 255; GAS bf16* d = hytc + ((size_t)(b * 1152 + col)) * 256 + t;
#pragma unroll
                for (int j = 0; j < 8; ++j) d[256 * j] = (bf16)f2bf(v[j]); }
        } else if (col < 1168) { *(GAS f32x4*)(mlg + (size_t)row * 16 + (col - 1152)) = v0; *(GAS f32x4*)(mlg + (size_t)row * 16 + (col - 1152) + 4) = v1; }
        else if (col < 1280) { }
        else if (col < 2816) st_bf16x8(ret + (size_t)row * 1536 + (col - 1280), v0, v1);
        else st_bf16x8(ml + (size_t)row * 1024 + (col - 2816), v0, v1);
    }
    __device__ __forceinline__ void store_m4(int row0, int col, const f32x4 (&v0)[4], const f32x4 (&v1)[4], f32x4 c0, f32x4 c1) const {
        if (col < 1152) {
            float a[4][8];
#pragma unroll
            for (int m = 0; m < 4; ++m) { const f32x4 x0 = v0[m] + c0, x1 = v1[m] + c1; a[m][0] = x0.x; a[m][1] = x0.y; a[m][2] = x0.z; a[m][3] = x0.w; a[m][4] = x1.x; a[m][5] = x1.y; a[m][6] = x1.z; a[m][7] = x1.w; }
            if (row0 < TOKL) { const int b = row0 >> 11, t = row0 & 2047; GAS bf16* d = hytl + ((size_t)(b * 1152 + col)) * 2048 + t;
#pragma unroll
                for (int j = 0; j < 8; ++j) { u32x2 w; w.x = pk2(a[0][j], a[1][j]); w.y = pk2(a[2][j], a[3][j]); *(GAS u32x2*)(d + 2048 * j) = w; } }
            else { const int r = row0 - TOKL, b = r >> 8, t = r & 255; GAS bf16* d = hytc + ((size_t)(b * 1152 + col)) * 256 + t;
#pragma unroll
                for (int j = 0; j < 8; ++j) { u32x2 w; w.x = pk2(a[0][j], a[1][j]); w.y = pk2(a[2][j], a[3][j]); *(GAS u32x2*)(d + 256 * j) = w; } }
        } else {
#pragma unroll
            for (int m = 0; m < 4; ++m) store8(row0 + m, col, v0[m], v1[m], c0, c1, c0, c1);
        }
    }
};
struct EpiGate {
    static constexpr bool HORNER = false, PAIR = false, COLVEC = true, BASE = false, PERM = true, ROWCV = false, APERM = false;
    const GAS float* bias; GAS bf16* gates;
    __device__ __forceinline__ f32x4 colvec(int, int col) const { return *(const GAS f32x4*)(bias + col); }
    __device__ __forceinline__ void store8(int row, int col, f32x4 v0, f32x4 v1, f32x4 c0, f32x4 c1, f32x4, f32x4) const {
        v0 += c0; v1 += c1;
        f32x4 g0, g1;
        g0.x = fmaxf(sigmoidf_(v0.x), 1e-20f); g0.y = fmaxf(sigmoidf_(v0.y), 1e-20f); g0.z = fmaxf(sigmoidf_(v0.z), 1e-20f); g0.w = fmaxf(sigmoidf_(v0.w), 1e-20f);
        g1.x = fmaxf(sigmoidf_(v1.x), 1e-20f); g1.y = fmaxf(sigmoidf_(v1.y), 1e-20f); g1.z = fmaxf(sigmoidf_(v1.z), 1e-20f); g1.w = fmaxf(sigmoidf_(v1.w), 1e-20f);
        st_bf16x8(gates + (size_t)row * NGATE + col, g0, g1);
    }
};
struct EpiUp {
    static constexpr bool HORNER = true, PAIR = false, COLVEC = false, BASE = true, PERM = true, ROWCV = false, APERM = false;
    const GAS bf16* gates; GAS bf16* acc_out;
    __device__ __forceinline__ u32x4 gate8(int which, int row, int col) const { return *(const GAS u32x4*)(gates + (size_t)row * NGATE + which * 1024 + col); }
    __device__ __forceinline__ void base8(int row, int col, f32x4& b0, f32x4& b1) const {
        const u32x4 w = *(const GAS u32x4*)(gates + (size_t)row * NGATE + 2048 + col);
        b0.x = __uint_as_float(w.x << 16); b0.y = __uint_as_float(w.x & 0xffff0000u); b0.z = __uint_as_float(w.y << 16); b0.w = __uint_as_float(w.y & 0xffff0000u);
        b1.x = __uint_as_float(w.z << 16); b1.y = __uint_as_float(w.z & 0xffff0000u); b1.z = __uint_as_float(w.w << 16); b1.w = __uint_as_float(w.w & 0xffff0000u);
    }
    __device__ __forceinline__ void store8(int row, int col, f32x4 v0, f32x4 v1, f32x4, f32x4, f32x4 g0, f32x4 g1) const { st_bf16x8(acc_out + (size_t)row * D + col, v0 * g0, v1 * g1); }
};
template <bool IN_BF16>
struct EpiResidT {
    static constexpr bool HORNER = false, PAIR = false, COLVEC = true, BASE = true, PERM = true, ROWCV = true, APERM = false;
    const GAS void *xin_l, *xin_c; GAS bf16 *xout_l, *xout_c; const GAS float* modbase; int which;
    __device__ __forceinline__ int rowgrp(int row) const { return row < TOKL ? (row >> 11) : 16; }
    __device__ __forceinline__ f32x4 colvec(int row0, int col) const { const int r = row0 < TOKL ? (row0 >> 11) : 16; return *(const GAS f32x4*)(modbase + ((size_t)r * 6 + which) * 1024 + col); }
    __device__ __forceinline__ void base8(int row, int col, f32x4& b0, f32x4& b1) const {
        const size_t o = row < TOKL ? (size_t)row * D + col : (size_t)(row - TOKL) * D + col;
        if constexpr (IN_BF16) {
            const u32x4 w = *(const GAS u32x4*)((const GAS bf16*)(row < TOKL ? xin_l : xin_c) + o);
            b0.x = __uint_as_float(w.x << 16); b0.y = __uint_as_float(w.x & 0xffff0000u); b0.z = __uint_as_float(w.y << 16); b0.w = __uint_as_float(w.y & 0xffff0000u);
            b1.x = __uint_as_float(w.z << 16); b1.y = __uint_as_float(w.z & 0xffff0000u); b1.z = __uint_as_float(w.w << 16); b1.w = __uint_as_float(w.w & 0xffff0000u);
        } else { const GAS float* p = (const GAS float*)(row < TOKL ? xin_l : xin_c) + o; b0 = *(const GAS f32x4*)p; b1 = *(const GAS f32x4*)(p + 4); }
    }
    __device__ __forceinline__ void store8(int row, int col, f32x4 v0, f32x4 v1, f32x4 c0, f32x4 c1, f32x4 b0, f32x4 b1) const {
        st_bf16x8(row < TOKL ? xout_l + (size_t)row * D + col : xout_c + (size_t)(row - TOKL) * D + col, b0 + c0 * v0, b1 + c1 * v1);
    }
};
struct EpiSwiglu {
    static constexpr bool HORNER = false, PAIR = true, COLVEC = false, BASE = false, PERM = false, ROWCV = false, APERM = false;
    GAS bf16* act; int row_off;
    __device__ __forceinline__ void store_pair8(int row, int col, f32x4 a0, f32x4 b0, f32x4 a1, f32x4 b1) const {
        f32x4 o0, o1; o0.x = siluf_(a0.x) * b0.x; o0.y = siluf_(a0.y) * b0.y; o0.z = siluf_(a0.z) * b0.z; o0.w = siluf_(a0.w) * b0.w;
        o1.x = siluf_(a1.x) * b1.x; o1.y = siluf_(a1.y) * b1.y; o1.z = siluf_(a1.z) * b1.z; o1.w = siluf_(a1.w) * b1.w;
        st_bf16x8(act + (size_t)(row - row_off) * DFF + col, o0, o1);
    }
    __device__ __forceinline__ void store(int, int, f32x4, f32x4, f32x4) const {}
};
struct EpiBf16Out {
    static constexpr bool HORNER = false, PAIR = false, COLVEC = false, BASE = false, PERM = true, ROWCV = false, APERM = false;
    GAS bf16* out; int ld; int row_add;
    __device__ __forceinline__ void store8(int row, int col, f32x4 v0, f32x4 v1, f32x4, f32x4, f32x4, f32x4) const { st_bf16x8(out + (size_t)(row + row_add) * ld + col, v0, v1); }
};

template <int L>
__device__ __forceinline__ void hyena_unit_fast(Frame& F, int layer, int c, int cn  , const GAS bf16* hyt  , const GAS bf16* ft  , GAS bf16* yht  ) {
    constexpr int ZP = (L + 8) * 2;
    constexpr int PER = L / 32;
    constexpr int I = L / 128;
    constexpr int SPAN = L / 4, NSTEP = L / 32;
    constexpr int CP = (2 * L + 8) * 2;
    LAS unsigned char* zimg = F.lds;
    LAS unsigned char* cpy = F.lds + 16 * ZP;
    const GAS float* cw = inp(F, I_HYCONV) + layer * 3 * 1152;
    const GAS float* skip = inp(F, I_HYSKIP) + layer * 2 * 384;
    const int lane = F.lane, fr = lane & 15, fq = lane >> 4, w = F.wave;
    { unsigned long long a_ = (unsigned long long)hyt, b_ = (unsigned long long)yht; asm volatile("" : "+s"(a_), "+s"(b_)); hyt = (const GAS bf16*)a_; yht = (GAS bf16*)b_; }
    __syncthreads();
    {
        const int b = F.tid >> 5, sg = F.tid & 31, t0 = sg * PER; const GAS bf16* src = hyt + ((size_t)(b * 1152 + c)) * L + t0;
        const float w0 = cw[c], w1 = cw[1152 + c], w2 = cw[2304 + c];
        u32x4 raw[PER / 8];
#pragma unroll
        for (int j = 0; j < PER / 8; ++j) raw[j] = *(const GAS u32x4*)(src + 8 * j);
        float prev = t0 > 0 ? bf2f(src[-1]) : 0.f;
        const float nextv = t0 + PER < L ? bf2f(src[PER]) : 0.f;
#pragma unroll
        for (int j = 0; j < PER / 8; ++j) {
            const unsigned wv[4] = {raw[j].x, raw[j].y, raw[j].z, raw[j].w};
            float x[10]; x[0] = prev;
#pragma unroll
            for (int q = 0; q < 4; ++q) { x[1 + 2 * q] = __uint_as_float(wv[q] << 16); x[2 + 2 * q] = __uint_as_float(wv[q] & 0xffff0000u); }
            if (j + 1 < PER / 8) x[9] = __uint_as_float(raw[(j + 1 < PER / 8) ? j + 1 : j].x << 16); else x[9] = nextv;
            u32x4 o;
            o.x = pk2(w0 * x[0] + w1 * x[1] + w2 * x[2], w0 * x[1] + w1 * x[2] + w2 * x[3]); o.y = pk2(w0 * x[2] + w1 * x[3] + w2 * x[4], w0 * x[3] + w1 * x[4] + w2 * x[5]);
            o.z = pk2(w0 * x[4] + w1 * x[5] + w2 * x[6], w0 * x[5] + w1 * x[6] + w2 * x[7]); o.w = pk2(w0 * x[6] + w1 * x[7] + w2 * x[8], w0 * x[7] + w1 * x[8] + w2 * x[9]);
            *(LAS u32x4*)(zimg + b * ZP + (t0 + 8 * j) * 2) = o;
            prev = x[8];
        }
    }
    const int tbase = SPAN * (w >> 1) + 16 * (w & 1);
    const int flane = L - tbase + 8 * fq - fr;
    const int msh = fr & 7;
    const LAS unsigned char* fbase = cpy + msh * CP + 2 * (flane + msh);
#pragma unroll 1
    for (int o = 0; o < 2; ++o) {
        const GAS bf16* fsrc = ft + ((size_t)(o * 384 + c)) * (2 * L);
        for (int i = F.tid; i < CP / 16; i += NTHR) { u32x4 v = (u32x4){0u, 0u, 0u, 0u}; if (i < 2 * L / 8) v = *(const GAS u32x4*)(fsrc + 8 * i); if (i == 0) v.x &= 0xffff0000u; *(LAS u32x4*)(cpy + 16 * i) = v; }
        __syncthreads();
        for (int task = F.tid; task < 7 * (CP / 16); task += NTHR) {
            const int m = 1 + task / (CP / 16), x8 = task % (CP / 16);
            unsigned short e[8];
#pragma unroll
            for (int i = 0; i < 8; ++i) { const int idx = 8 * x8 - m + i; e[i] = idx >= 0 ? *(const LAS unsigned short*)(cpy + 2 * idx) : (unsigned short)0; }
            u32x4 v; v.x = e[0] | ((unsigned)e[1] << 16); v.y = e[2] | ((unsigned)e[3] << 16); v.z = e[4] | ((unsigned)e[5] << 16); v.w = e[6] | ((unsigned)e[7] << 16);
            *(LAS u32x4*)(cpy + m * CP + 16 * x8) = v;
        }
        __syncthreads();
        f32x4 acc[I];
#pragma unroll
        for (int i = 0; i < I; ++i) acc[i] = (f32x4){0.f, 0.f, 0.f, 0.f};
        bf16x8 ring[I];
#pragma unroll
        for (int i = 1; i < I; ++i) ring[(I - i) % I] = *(const LAS bf16x8*)(fbase - 64 * i);
        bf16x8 nf = *(const LAS bf16x8*)(fbase);
        const LAS unsigned char* zrow = zimg + fr * ZP + 16 * fq;
        unsigned tc0 = 0u, tc1 = 0u, tc2 = 0u;
#ifndef NO_TOUCH
        { const int tb = F.tid >> 5, tsg = F.tid & 31;
          tc0 = *(const GAS unsigned*)(hyt + ((size_t)(tb * 1152 + (o == 0 ? 384 : 768) + c)) * L + tsg * (L / 32));
          if (o == 0) { if (F.tid < L / 32) tc1 = *(const GAS unsigned*)(ft + ((size_t)(384 + c)) * (2 * L) + F.tid * 64); }
          else if (cn >= 0) { tc1 = *(const GAS unsigned*)(hyt + ((size_t)(tb * 1152 + cn)) * L + tsg * (L / 32)); if (F.tid < L / 32) tc2 = *(const GAS unsigned*)(ft + (size_t)cn * (2 * L) + F.tid * 64); } }
#endif
#pragma unroll 1
        for (int j0 = 0; j0 < NSTEP; j0 += I) {
#pragma unroll
            for (int jj = 0; jj < I; ++jj) {
                const int j = j0 + jj;
                ring[jj] = nf;
                if (j + 1 < NSTEP) nf = *(const LAS bf16x8*)(fbase + 64 * (j + 1));
                const bf16x8 zf = *(const LAS bf16x8*)(zrow + 64 * j);
#pragma unroll
                for (int i = 0; i < I; ++i) acc[i] = __builtin_amdgcn_mfma_f32_16x16x32_bf16(ring[(jj - i + I) % I], zf, acc[i], 0, 0, 0);
            }
        }
        unsigned el_ = (unsigned)lane; asm volatile("" : "+v"(el_)); const int efr = (int)(el_ & 15u), efq = (int)(el_ >> 4);
        const int etb = SPAN * (w >> 1) + 16 * (w & 1);
        const int gcol = (o == 0 ? 384 : 768) + c;
        const GAS bf16* gsrc = hyt + ((size_t)(efr * 1152 + gcol)) * L;
        const float w0 = cw[gcol], w1 = cw[1152 + gcol], w2 = cw[2304 + gcol], sk = skip[o * 384 + c];
        GAS bf16* dst = yht + ((size_t)(efr * 384 + c)) * L;
        constexpr int GI = I < 8 ? I : 8;
#pragma unroll
        for (int i0 = 0; i0 < I; i0 += GI) {
            u32x2 grv[GI]; unsigned short gmv[GI], gpv[GI];
#pragma unroll
            for (int ii = 0; ii < GI; ++ii) {
                const int t = etb + 32 * (i0 + ii) + 4 * efq;
                grv[ii] = *(const GAS u32x2*)(gsrc + t); gmv[ii] = t > 0 ? gsrc[t - 1] : (unsigned short)0; gpv[ii] = t + 4 < L ? gsrc[t + 4] : (unsigned short)0;
            }
            asm volatile("" ::: "memory");
#pragma unroll
            for (int ii = 0; ii < GI; ++ii) {
                const int i = i0 + ii;
                const int t = etb + 32 * i + 4 * efq;
                const u32x2 zr = *(const LAS u32x2*)(zimg + efr * ZP + t * 2);
                const u32x2 gr = grv[ii];
                const float gm = bf2f(gmv[ii]), gp = bf2f(gpv[ii]);
                const float g0 = __uint_as_float(gr.x << 16), g1 = __uint_as_float(gr.x & 0xffff0000u), g2 = __uint_as_float(gr.y << 16), g3 = __uint_as_float(gr.y & 0xffff0000u);
                const float z0 = __uint_as_float(zr.x << 16), z1 = __uint_as_float(zr.x & 0xffff0000u), z2 = __uint_as_float(zr.y << 16), z3 = __uint_as_float(zr.y & 0xffff0000u);
                const float o0 = (w0 * gm + w1 * g0 + w2 * g1) * (acc[i].x + sk * z0), o1 = (w0 * g0 + w1 * g1 + w2 * g2) * (acc[i].y + sk * z1);
                const float o2 = (w0 * g1 + w1 * g2 + w2 * g3) * (acc[i].z + sk * z2), o3 = (w0 * g2 + w1 * g3 + w2 * gp) * (acc[i].w + sk * z3);
                acc[i] = (f32x4){o0, o1, o2, o3};
            }
        }
        __syncthreads();
        { unsigned tk = tc0 ^ tc1 ^ tc2; asm volatile("" :: "v"(tk)); }
#pragma unroll
        for (int i = 0; i < I; ++i) {
            const int t = etb + 32 * i + 4 * efq;
            u32x2 ov; ov.x = pk2(acc[i].x, acc[i].y); ov.y = pk2(acc[i].z, acc[i].w);
            if (o == 0) *(LAS u32x2*)(zimg + efr * ZP + t * 2) = ov;
            else *(GAS u32x2*)(dst + t) = ov;
        }
    }
}

#ifndef REP_CH
#define REP_CH 1
#endif
#ifndef REP_CH_ML
#define REP_CH_ML REP_CH
#endif
#ifndef REP_CH_RET
#define REP_CH_RET REP_CH
#endif
constexpr int CH_PITCH = 144;
constexpr int CH_IMG = 64 * CH_PITCH;
constexpr int CH_WAVE_LDS = 2 * (3 * CH_IMG + 1024) + 512;
static_assert(2 * CH_WAVE_LDS <= PTAB_OFF, "chain LDS");
__device__ __forceinline__ void ds_tr16x8(unsigned addr, u32x2 (&lo)[4], u32x2 (&hi)[4]) {
    asm volatile("ds_read_b64_tr_b16 %0, %8\n\tds_read_b64_tr_b16 %1, %8 offset:32\n\tds_read_b64_tr_b16 %2, %8 offset:64\n\tds_read_b64_tr_b16 %3, %8 offset:96\n\t"
                 "ds_read_b64_tr_b16 %4, %8 offset:2304\n\tds_read_b64_tr_b16 %5, %8 offset:2336\n\tds_read_b64_tr_b16 %6, %8 offset:2368\n\tds_read_b64_tr_b16 %7, %8 offset:2400\n\t"
                 "s_waitcnt lgkmcnt(0)"
                 : "=&v"(lo[0]), "=&v"(lo[1]), "=&v"(lo[2]), "=&v"(lo[3]), "=&v"(hi[0]), "=&v"(hi[1]), "=&v"(hi[2]), "=&v"(hi[3]) : "v"(addr) : "memory");
}
static_assert(16 * CH_PITCH == 2304, "ds_tr16x8 offsets");
__device__ __forceinline__ void ds_tr16x4(unsigned addr, u32x2 (&lo)[2], u32x2 (&hi)[2]) {
    asm volatile("ds_read_b64_tr_b16 %0, %4\n\tds_read_b64_tr_b16 %1, %4 offset:32\n\tds_read_b64_tr_b16 %2, %4 offset:2304\n\tds_read_b64_tr_b16 %3, %4 offset:2336\n\ts_waitcnt lgkmcnt(0)"
                 : "=&v"(lo[0]), "=&v"(lo[1]), "=&v"(hi[0]), "=&v"(hi[1]) : "v"(addr) : "memory");
}
__device__ __forceinline__ float log_sigmoid_(float x) { return fminf(x, 0.f) - log1pf(__expf(-fabsf(x))); }
__device__ __forceinline__ bf16x8 mk_frag(u32x2 lo, u32x2 hi) { u32x4 w; w.x = lo.x; w.y = lo.y; w.z = hi.x; w.w = hi.y; return __builtin_bit_cast(bf16x8, w); }

template <bool IS_ML>
__device__ __forceinline__ void chain_fast(Frame& F, int layer, int b, int h, int dir, LAS unsigned char* img, int hf, bool helper) {
    constexpr int NET = 2;
    constexpr int CH_BUF = 3 * CH_IMG + 1024;
    const int lane = F.lane, fr = lane & 15, fq = lane >> 4;
    const GAS bf16* RET = WSP(const bf16, WS_RET); const GAS bf16* ML = WSP(const bf16, WS_ML); const GAS float* MLG = WSP(const float, WS_MLG);
    const GAS float* rope = WSP(const float, WS_ROPE);
    GAS bf16* Y = WSP(bf16, WS_Y); GAS bf16* OB = WSP(bf16, WS_OB);
    const int cq = lane & 7, pr0 = lane >> 3;
    if (helper) {
        float lgam = 0.f, bi_ = 0.f, bf_ = 0.f;
        if (!IS_ML) lgam = log_sigmoid_(inp(F, I_RETDECAY)[layer * 12 + dir * 6 + h]);
        else { bi_ = inp(F, I_MLGB)[layer * 16 + dir * 8 + h]; bf_ = inp(F, I_MLGB)[layer * 16 + dir * 8 + 4 + h]; }
        const GAS float* mlc = inp(F, I_MLCONV) + layer * 3 * 512;
#pragma unroll 1
        for (int step = 0; step < 36; ++step) {
            LAS unsigned char* bufp = img + (step & 1) * CH_BUF;
            LAS unsigned char* Qi = bufp; LAS unsigned char* Ki = bufp + CH_IMG; LAS unsigned char* Vi = bufp + 2 * CH_IMG;
            int rowbase, t0, L; bool lat;
            if (step < 4) { const int cc = dir ? 3 - step : step; rowbase = TOKL + b * LC + cc * 64; t0 = cc * 64; L = LC; lat = false; }
            else { const int cc = dir ? 35 - step : step - 4; rowbase = b * LL + cc * 64; t0 = cc * 64; L = LL; lat = true; }
            float g_i = 0.f, g_f = 0.f;
            if (IS_ML) { const int tlg = dir ? 63 - lane : lane; const GAS float* gp = MLG + (size_t)(rowbase + tlg) * 16 + dir * 8 + h; g_i = gp[0]; g_f = gp[4]; }
            if constexpr (!IS_ML) {
    #pragma unroll
            for (int i4 = 0; i4 < 4; ++i4) {
                const int i = 4 * hf + i4;
                const int p = pr0 + 8 * i, tl = dir ? 63 - p : p, row = rowbase + tl, tpos = t0 + tl;
                float qv[8], kv[8]; u32x4 vraw;
                {
                    const GAS bf16* base = RET + (size_t)row * 1536 + h * 64;
                    const u32x4 qr = *(const GAS u32x4*)(base + 8 * cq), kr = *(const GAS u32x4*)(base + 384 + 8 * cq); vraw = *(const GAS u32x4*)(base + 768 + 8 * cq);
                    const unsigned qw[4] = {qr.x, qr.y, qr.z, qr.w}, kw[4] = {kr.x, kr.y, kr.z, kr.w};
    #pragma unroll
                    for (int j = 0; j < 4; ++j) { qv[2 * j] = __uint_as_float(qw[j] << 16); qv[2 * j + 1] = __uint_as_float(qw[j] & 0xffff0000u); kv[2 * j] = __uint_as_float(kw[j] << 16); kv[2 * j + 1] = __uint_as_float(kw[j] & 0xffff0000u); }
                    if (lat) {
                        const u32x4 qpr = *(const GAS u32x4*)(base + 8 * (cq ^ 2)), kpr = *(const GAS u32x4*)(base + 384 + 8 * (cq ^ 2));
                        const unsigned qpw[4] = {qpr.x, qpr.y, qpr.z, qpr.w}, kpw[4] = {kpr.x, kpr.y, kpr.z, kpr.w};
                        const int half = cq >> 2, hi = (cq >> 1) & 1, i0 = 8 * (cq & 1);
                        const GAS float* rp = rope + tpos * 64 + half * 32 + i0;
                        const f32x4 c0 = *(const GAS f32x4*)(rp), c1 = *(const GAS f32x4*)(rp + 4), s0 = *(const GAS f32x4*)(rp + 16), s1 = *(const GAS f32x4*)(rp + 20);
                        const float cs[8] = {c0.x, c0.y, c0.z, c0.w, c1.x, c1.y, c1.z, c1.w}, sn[8] = {s0.x, s0.y, s0.z, s0.w, s1.x, s1.y, s1.z, s1.w};
    #pragma unroll
                        for (int j = 0; j < 8; ++j) {
                            const float qp = (j & 1) ? __uint_as_float(qpw[j >> 1] & 0xffff0000u) : __uint_as_float(qpw[j >> 1] << 16);
                            const float kp = (j & 1) ? __uint_as_float(kpw[j >> 1] & 0xffff0000u) : __uint_as_float(kpw[j >> 1] << 16);
                            qv[j] = hi ? qp * sn[j] + qv[j] * cs[j] : qv[j] * cs[j] - qp * sn[j];
                            kv[j] = hi ? kp * sn[j] + kv[j] * cs[j] : kv[j] * cs[j] - kp * sn[j];
                        }
                    }
    #pragma unroll
                    for (int j = 0; j < 8; ++j) qv[j] *= 0.125f;
                }
                u32x4 qo, ko; qo.x = pk2(qv[0], qv[1]); qo.y = pk2(qv[2], qv[3]); qo.z = pk2(qv[4], qv[5]); qo.w = pk2(qv[6], qv[7]);
                ko.x = pk2(kv[0], kv[1]); ko.y = pk2(kv[2], kv[3]); ko.z = pk2(kv[4], kv[5]); ko.w = pk2(kv[6], kv[7]);
                *(LAS u32x4*)(Qi + p * CH_PITCH + 16 * cq) = qo; *(LAS u32x4*)(Ki + p * CH_PITCH + 16 * cq) = ko; { LAS unsigned char* vd = Vi + p * CH_PITCH + (cq >> 2) * 64 + (cq & 3) * 8; *(LAS u32x2*)vd = (u32x2){vraw.x, vraw.y}; *(LAS u32x2*)(vd + 32) = (u32x2){vraw.z, vraw.w}; }
            }
            } else {
                const GAS float* wq = mlc + h * 64 + 8 * cq;
                u32x4 rr[2][3][4], vr[4];
    #pragma unroll
                for (int i4 = 0; i4 < 4; ++i4) {
                    const int p = pr0 + 8 * (4 * hf + i4), tl = dir ? 63 - p : p, row = rowbase + tl, tpos = t0 + tl;
                    const GAS bf16* bb = ML + (size_t)row * 1024 + h * 64 + 8 * cq;
                    const u32x4 z4 = (u32x4){0u, 0u, 0u, 0u};
    #pragma unroll
                    for (int qk = 0; qk < 2; ++qk) {
                        rr[qk][1][i4] = *(const GAS u32x4*)(bb + 256 * qk);
                        rr[qk][0][i4] = tpos > 0 ? *(const GAS u32x4*)(bb + 256 * qk - 1024) : z4;
                        rr[qk][2][i4] = tpos < L - 1 ? *(const GAS u32x4*)(bb + 256 * qk + 1024) : z4;
                    }
                    vr[i4] = *(const GAS u32x4*)(bb + 512);
                }
    #pragma unroll
                for (int qk = 0; qk < 2; ++qk) {
                    f32x4 wt[3][2];
    #pragma unroll
                    for (int tp = 0; tp < 3; ++tp) { wt[tp][0] = *(const GAS f32x4*)(wq + 256 * qk + 512 * tp); wt[tp][1] = *(const GAS f32x4*)(wq + 256 * qk + 512 * tp + 4); }
    #pragma unroll
                    for (int i4 = 0; i4 < 4; ++i4) {
                        const int p = pr0 + 8 * (4 * hf + i4);
                        const unsigned a0[4] = {rr[qk][0][i4].x, rr[qk][0][i4].y, rr[qk][0][i4].z, rr[qk][0][i4].w}, a1[4] = {rr[qk][1][i4].x, rr[qk][1][i4].y, rr[qk][1][i4].z, rr[qk][1][i4].w},
                                       a2[4] = {rr[qk][2][i4].x, rr[qk][2][i4].y, rr[qk][2][i4].z, rr[qk][2][i4].w};
                        float ov[8];
    #pragma unroll
                        for (int j = 0; j < 8; ++j) {
                            const float x0 = (j & 1) ? __uint_as_float(a0[j >> 1] & 0xffff0000u) : __uint_as_float(a0[j >> 1] << 16);
                            const float x1 = (j & 1) ? __uint_as_float(a1[j >> 1] & 0xffff0000u) : __uint_as_float(a1[j >> 1] << 16);
                            const float x2 = (j & 1) ? __uint_as_float(a2[j >> 1] & 0xffff0000u) : __uint_as_float(a2[j >> 1] << 16);
                            const float r = siluf_(wt[0][j >> 2][j & 3] * x0 + wt[1][j >> 2][j & 3] * x1 + wt[2][j >> 2][j & 3] * x2);
                            ov[j] = qk == 0 ? r : r * 0.125f;
                        }
                        u32x4 o; o.x = pk2(ov[0], ov[1]); o.y = pk2(ov[2], ov[3]); o.z = pk2(ov[4], ov[5]); o.w = pk2(ov[6], ov[7]);
                        if (qk == 0) *(LAS u32x4*)(Qi + p * CH_PITCH + 16 * cq) = o;
                        else { *(LAS u32x4*)(Ki + p * CH_PITCH + 16 * cq) = o; LAS unsigned char* vd = Vi + p * CH_PITCH + (cq >> 2) * 64 + (cq & 3) * 8; *(LAS u32x2*)vd = (u32x2){vr[i4].x, vr[i4].y}; *(LAS u32x2*)(vd + 32) = (u32x2){vr[i4].z, vr[i4].w}; }
                    }
                }
            }
            __builtin_amdgcn_sched_barrier(0);
            float f_p, i_p;
            if (!IS_ML) { f_p = lgam; i_p = 0.f; }
            else { i_p = g_i + bi_; f_p = log_sigmoid_(g_f + bf_); }
            float bsum = f_p;
    #pragma unroll
            for (int o = 1; o < 64; o <<= 1) { const float t = lane_read(bsum, lane >= o ? lane - o : lane); if (lane >= o) bsum += t; }
            LAS float* gv = (LAS float*)(bufp + 3 * CH_IMG);
            const float b63 = __int_as_float(__builtin_amdgcn_readlane(__float_as_int(bsum), 63));
            if (hf == 0) { gv[lane] = bsum; gv[64 + lane] = bsum - i_p; gv[128 + lane] = __expf(bsum); gv[192 + lane] = __expf(b63 - (bsum - i_p)); }
            asm volatile("s_waitcnt lgkmcnt(0)" ::: "memory");
            __syncthreads();
        }
        __syncthreads();
        return;
    }
    f32x4 C[4][NET];
#pragma unroll
    for (int dt = 0; dt < 4; ++dt)
#pragma unroll
        for (int et = 0; et < NET; ++et) C[dt][et] = (f32x4){0.f, 0.f, 0.f, 0.f};
    LAS float* nvec = (LAS float*)(img + 2 * CH_BUF + 256 * hf);
    if (IS_ML) nvec[lane] = 0.f;
    const LAS float* nq = nvec + 4 * fq;
    asm volatile("s_waitcnt lgkmcnt(0)" ::: "memory");
    __syncthreads();
#pragma unroll 1
    for (int step = 0; step < 36; ++step) {
        LAS unsigned char* bufp = img + (step & 1) * CH_BUF;
        LAS unsigned char* Qi = bufp; LAS unsigned char* Ki = bufp + CH_IMG; LAS unsigned char* Vi = bufp + 2 * CH_IMG;
        const unsigned ka = (unsigned)(size_t)Ki, va = (unsigned)(size_t)Vi;
        int rowbase;
        if (step < 4) { const int cc = dir ? 3 - step : step; rowbase = TOKL + b * LC + cc * 64; }
        else { const int cc = dir ? 35 - step : step - 4; rowbase = b * LL + cc * 64; }
        const LAS float* gv = (const LAS float*)(bufp + 3 * CH_IMG);
        const float adec = __expf(gv[63]);
        const LAS float* gq = gv + 4 * fq;
        const bf16x8 ones = (fr == 0) ? (bf16x8){0x3F80, 0x3F80, 0x3F80, 0x3F80, 0x3F80, 0x3F80, 0x3F80, 0x3F80} : (bf16x8){0, 0, 0, 0, 0, 0, 0, 0};
        const int tr_q = fr >> 2, tr_p = fr & 3;
#ifndef PT_UNROLL
#define PT_UNROLL 2
#endif
        if (!(layer == 1 && step < 4)) {
#pragma unroll PT_UNROLL
        for (int pt = 0; pt < 4; ++pt) {
            f32x4 ST[4];
            bf16x8 qn[2];
#pragma unroll
            for (int kk = 0; kk < 2; ++kk) qn[kk] = *(const LAS bf16x8*)(Qi + (16 * pt + fr) * CH_PITCH + (32 * kk + 8 * fq) * 2);
#pragma unroll
            for (int st = 0; st < 4; ++st) {
                ST[st] = (f32x4){0.f, 0.f, 0.f, 0.f};
                if (st <= pt) {
#pragma unroll
                    for (int kk = 0; kk < 2; ++kk) { const bf16x8 kf = *(const LAS bf16x8*)(Ki + (16 * st + fr) * CH_PITCH + (32 * kk + 8 * fq) * 2); ST[st] = __builtin_amdgcn_mfma_f32_16x16x32_bf16(kf, qn[kk], ST[st], 0, 0, 0); }
                }
            }
            const float bp = gv[16 * pt + fr];
#pragma unroll
            for (int st = 0; st < 4; ++st) {
                if (st <= pt) {
                    const f32x4 bis = *(const LAS f32x4*)(gq + 64 + 16 * st);
#pragma unroll
                    for (int j = 0; j < 4; ++j) { const int sidx = 16 * st + 4 * fq + j; const float w = (sidx <= 16 * pt + fr) ? __expf(bp - bis[j]) : 0.f; ST[st][j] *= w; }
                }
            }
            __builtin_amdgcn_sched_barrier(0);
            f32x4 acc[NET], accd = (f32x4){0.f, 0.f, 0.f, 0.f};
#pragma unroll
            for (int et = 0; et < NET; ++et) acc[et] = (f32x4){0.f, 0.f, 0.f, 0.f};
#pragma unroll
            for (int kk = 0; kk < 2; ++kk) {
                const u32x2 lo = *(const LAS u32x2*)(Qi + (16 * pt + fr) * CH_PITCH + (32 * kk + 4 * fq) * 2), hi = *(const LAS u32x2*)(Qi + (16 * pt + fr) * CH_PITCH + (32 * kk + 16 + 4 * fq) * 2);
                const bf16x8 qs = mk_frag(lo, hi);
#pragma unroll
                for (int et = 0; et < NET; ++et) {
                    u32x4 w; w.x = pk2(C[2 * kk][et].x, C[2 * kk][et].y); w.y = pk2(C[2 * kk][et].z, C[2 * kk][et].w); w.z = pk2(C[2 * kk + 1][et].x, C[2 * kk + 1][et].y); w.w = pk2(C[2 * kk + 1][et].z, C[2 * kk + 1][et].w);
                    acc[et] = __builtin_amdgcn_mfma_f32_16x16x32_bf16(__builtin_bit_cast(bf16x8, w), qs, acc[et], 0, 0, 0);
                }
                if (IS_ML) {
                    const f32x4 n0 = *(const LAS f32x4*)(nq + 32 * kk), n1 = *(const LAS f32x4*)(nq + 32 * kk + 16);
                    u32x4 w; w.x = pk2(n0.x, n0.y); w.y = pk2(n0.z, n0.w); w.z = pk2(n1.x, n1.y); w.w = pk2(n1.z, n1.w);
                    if (fr != 0) w = (u32x4){0u, 0u, 0u, 0u};
                    accd = __builtin_amdgcn_mfma_f32_16x16x32_bf16(__builtin_bit_cast(bf16x8, w), qs, accd, 0, 0, 0);
                }
            }
            { const float apv = gv[128 + 16 * pt + fr];
#pragma unroll
              for (int et = 0; et < NET; ++et) acc[et] *= apv;
              accd *= apv; }
            __builtin_amdgcn_sched_barrier(0);
#pragma unroll
            for (int kk = 0; kk < 2; ++kk) {
                if (2 * kk <= pt) {
                    u32x4 w; w.x = pk2(ST[2 * kk].x, ST[2 * kk].y); w.y = pk2(ST[2 * kk].z, ST[2 * kk].w); w.z = pk2(ST[2 * kk + 1].x, ST[2 * kk + 1].y); w.w = pk2(ST[2 * kk + 1].z, ST[2 * kk + 1].w);
                    const bf16x8 pf = __builtin_bit_cast(bf16x8, w);
                    u32x2 vlo[2], vhi[2];
                    ds_tr16x4(va + (32 * kk + 4 * fq + tr_q) * CH_PITCH + 8 * tr_p + 64 * hf, vlo, vhi);
#pragma unroll
                    for (int et = 0; et < NET; ++et) acc[et] = __builtin_amdgcn_mfma_f32_16x16x32_bf16(mk_frag(vlo[et], vhi[et]), pf, acc[et], 0, 0, 0);
                    if (IS_ML) accd = __builtin_amdgcn_mfma_f32_16x16x32_bf16(ones, pf, accd, 0, 0, 0);
                }
            }
            __builtin_amdgcn_sched_barrier(0);
            {
                const int p = 16 * pt + fr, tl = dir ? 63 - p : p, row = rowbase + tl;
                float inv = 1.f;
                if (IS_ML) { const float den = lane_read(accd[0], fr); inv = __builtin_amdgcn_rcpf(fmaxf(fabsf(den), 1.f)); }
                const int cof = (IS_ML ? 384 : 0) + h * 64 + 32 * hf + 8 * fq;
                const unsigned boff = dir == 0 ? (unsigned)(row * D + 384 + cof) * 2u : (unsigned)(row * 640 + cof) * 2u;
                GAS char* ob = dir == 0 ? (GAS char*)Y : (GAS char*)OB;
                { u32x4 w; w.x = pk2(acc[0].x * inv, acc[0].y * inv); w.y = pk2(acc[0].z * inv, acc[0].w * inv); w.z = pk2(acc[1].x * inv, acc[1].y * inv); w.w = pk2(acc[1].z * inv, acc[1].w * inv);
                  *(GAS u32x4*)(ob + boff) = w; }
            }
        }
        }
        __builtin_amdgcn_sched_barrier(0);
#pragma unroll
        for (int dt = 0; dt < 4; ++dt)
#pragma unroll
            for (int et = 0; et < NET; ++et) C[dt][et] *= adec;
        f32x4 accn[4];
        if (IS_ML) {
#pragma unroll
            for (int dt = 0; dt < 4; ++dt) { accn[dt] = *(const LAS f32x4*)(nq + 16 * dt) * adec; if (fr != 0) accn[dt] = (f32x4){0.f, 0.f, 0.f, 0.f}; }
        }
#pragma unroll
        for (int kk = 0; kk < 2; ++kk) {
            u32x2 vlo[2], vhi[2], klo[4], khi[4];
            ds_tr16x4(va + (32 * kk + 4 * fq + tr_q) * CH_PITCH + 8 * tr_p + 64 * hf, vlo, vhi);
            ds_tr16x8(ka + (32 * kk + 4 * fq + tr_q) * CH_PITCH + 8 * tr_p, klo, khi);
            const f32x4 wl = *(const LAS f32x4*)(gq + 192 + 32 * kk), wh = *(const LAS f32x4*)(gq + 192 + 32 * kk + 16);
#pragma unroll
            for (int dt = 0; dt < 4; ++dt) {
                u32x4 w;
                w.x = pk2(__uint_as_float(klo[dt].x << 16) * wl[0], __uint_as_float(klo[dt].x & 0xffff0000u) * wl[1]);
                w.y = pk2(__uint_as_float(klo[dt].y << 16) * wl[2], __uint_as_float(klo[dt].y & 0xffff0000u) * wl[3]);
                w.z = pk2(__uint_as_float(khi[dt].x << 16) * wh[0], __uint_as_float(khi[dt].x & 0xffff0000u) * wh[1]);
                w.w = pk2(__uint_as_float(khi[dt].y << 16) * wh[2], __uint_as_float(khi[dt].y & 0xffff0000u) * wh[3]);
                const bf16x8 kf = __builtin_bit_cast(bf16x8, w);
#pragma unroll
                for (int et = 0; et < NET; ++et) C[dt][et] = __builtin_amdgcn_mfma_f32_16x16x32_bf16(kf, mk_frag(vlo[et], vhi[et]), C[dt][et], 0, 0, 0);
                if (IS_ML) accn[dt] = __builtin_amdgcn_mfma_f32_16x16x32_bf16(kf, ones, accn[dt], 0, 0, 0);
            }
        }
        if (IS_ML) { if (fr == 0) {
#pragma unroll
            for (int dt = 0; dt < 4; ++dt) *(LAS f32x4*)(nvec + 4 * fq + 16 * dt) = accn[dt]; } }
        asm volatile("s_waitcnt lgkmcnt(0)" ::: "memory");
        __syncthreads();
    }
}

#ifndef REP_HY
#define REP_HY 1
#endif
#ifndef HY_ON_HW
#define HY_ON_HW 288
#endif
constexpr int NCHWG = 160;
__device__ __forceinline__ void phase_mix(Frame& F, int layer) {
    const bool last = layer == 1;
    const GAS bf16* ftl = WSP(const bf16, WS_FTL) + (size_t)layer * 2 * 384 * 4096;
    int u0, ustride, ucnt;
    if (F.wg < NCHWG) {
        {
            const int wv = F.wave & 3, cl = wv >> 1, hf = wv & 1, c = F.wg * 2 + cl; const bool helper = F.wave >= 4;
            LAS unsigned char* img = F.lds + cl * CH_WAVE_LDS;
            if (c < 192) { const int b = c / 12, r = c % 12; chain_fast<false>(F, layer, b, r >> 1, r & 1, img, hf, helper); }
            else { const int i = c - 192; chain_fast<true>(F, layer, i >> 3, (i & 7) >> 1, i & 1, img, hf, helper); }
        }
        u0 = HY_ON_HW + F.wg; ustride = 96; ucnt = (F.wg < 96 && u0 < 384) ? 1 : 0;
    } else {
        const int w = F.wg - NCHWG;
        u0 = w; ustride = F.G - NCHWG; ucnt = (HY_ON_HW - w + ustride - 1) / ustride;
    }
#pragma unroll 1
    for (int rp = 0; rp < REP_HY; ++rp)
#pragma unroll 1
        for (int i = 0; i < ucnt; ++i) { const int u = u0 + i * ustride; hyena_unit_fast<LL>(F, layer, u, i + 1 < ucnt ? u + ustride : -1, WSP(const bf16, WS_HYTL), ftl, WSP(bf16, WS_YHTL)); }
    if (F.wg >= NCHWG && !last) { const int nh = F.G - NCHWG, w = F.wg - NCHWG;
        for (int u = w; u < 384; u += nh) hyena_unit_fast<LC>(F, layer, u, u + nh < 384 ? u + nh : -1, WSP(const bf16, WS_HYTC), WSP(const bf16, WS_FTC), WSP(bf16, WS_YHTC)); }
}
__device__ __forceinline__ void phase_combine(Frame& F, int layer, bool dummy = false) {
    const bool last = layer == 1;
    const int gw = F.wg * NWAVES + F.wave, NGW = F.G * NWAVES, lane = F.lane;
    const int nrows = last ? TOKL : TOK;
    GAS bf16* Y = WSP(bf16, WS_Y); const GAS bf16* OB = WSP(const bf16, WS_OB); const GAS bf16* RET = WSP(const bf16, WS_RET); const GAS bf16* ML = WSP(const bf16, WS_ML);
    const int rsub = lane >> 4, l16 = lane & 15;
    for (int row0 = gw * 4; row0 < nrows; row0 += NGW * 4) {
        const int row = row0 + rsub;
        GAS bf16* yo = dummy ? WSP(bf16, WS_U + 300 * MiB) + (size_t)(row & 8191) * D : Y + (size_t)row * D;
        u32x2 of[10], ob[10], gt[10];
#pragma unroll
        for (int hh = 0; hh < 10; ++hh) {
            const int cof = hh * 64 + 4 * l16;
            of[hh] = *(const GAS u32x2*)(Y + (size_t)row * D + 384 + cof); ob[hh] = *(const GAS u32x2*)(OB + (size_t)row * 640 + cof);
            gt[hh] = hh < 6 ? *(const GAS u32x2*)(RET + (size_t)row * 1536 + 1152 + cof) : *(const GAS u32x2*)(ML + (size_t)row * 1024 + 768 + (cof - 384));
        }
#pragma unroll
        for (int hh = 0; hh < 10; ++hh) {
            float x[4], g[4];
            x[0] = __uint_as_float(of[hh].x << 16) + __uint_as_float(ob[hh].x << 16); x[1] = __uint_as_float(of[hh].x & 0xffff0000u) + __uint_as_float(ob[hh].x & 0xffff0000u);
            x[2] = __uint_as_float(of[hh].y << 16) + __uint_as_float(ob[hh].y << 16); x[3] = __uint_as_float(of[hh].y & 0xffff0000u) + __uint_as_float(ob[hh].y & 0xffff0000u);
            g[0] = __uint_as_float(gt[hh].x << 16); g[1] = __uint_as_float(gt[hh].x & 0xffff0000u); g[2] = __uint_as_float(gt[hh].y << 16); g[3] = __uint_as_float(gt[hh].y & 0xffff0000u);
            float sm = (x[0] + x[1]) + (x[2] + x[3]);
            DPP_ADD(sm, 0xB1); DPP_ADD(sm, 0x4E); DPP_ADD(sm, 0x141); DPP_ADD(sm, 0x140);
            const float mu = sm * (1.f / 64.f);
#pragma unroll
            for (int j = 0; j < 4; ++j) x[j] -= mu;
            float sq = (x[0] * x[0] + x[1] * x[1]) + (x[2] * x[2] + x[3] * x[3]);
            DPP_ADD(sq, 0xB1); DPP_ADD(sq, 0x4E); DPP_ADD(sq, 0x141); DPP_ADD(sq, 0x140);
            const float rs = rsqrtf(sq * (1.f / 64.f) + 1e-6f);
            float o[4];
#pragma unroll
            for (int j = 0; j < 4; ++j) o[j] = x[j] * rs * (hh < 6 ? siluf_(g[j]) : sigmoidf_(g[j]));
            u32x2 w; w.x = pk2(o[0], o[1]); w.y = pk2(o[2], o[3]);
            *(GAS u32x2*)(yo + 384 + hh * 64 + 4 * l16) = w;
        }
    }
    LAS unsigned char* scr = F.lds + F.wave * 8704;
    const int nitL = NB * 6 * 32, nitC = last ? 0 : NB * 6 * 4;
    for (int it = gw; it < nitL + nitC; it += NGW) {
        const GAS bf16* src; int L, rowbase, b, cb, tb;
        if (it < nitL) { b = it / 192; const int r = it % 192; cb = r / 32; tb = r % 32; L = LL; src = WSP(const bf16, WS_YHTL); rowbase = b * LL; }
        else { const int i2 = it - nitL; b = i2 / 24; const int r = i2 % 24; cb = r / 4; tb = r % 4; L = LC; src = WSP(const bf16, WS_YHTC); rowbase = TOKL + b * LC; }
        u32x4 v[8];
#pragma unroll
        for (int i = 0; i < 8; ++i) { const int cc = (lane >> 3) + 8 * i; v[i] = *(const GAS u32x4*)(src + ((size_t)(b * 384 + cb * 64 + cc)) * L + tb * 64 + 8 * (lane & 7)); }
#pragma unroll
        for (int i = 0; i < 8; ++i) { const int cc = (lane >> 3) + 8 * i; *(LAS u32x4*)(scr + cc * 136 + 16 * (lane & 7)) = v[i]; }
        asm volatile("s_waitcnt lgkmcnt(0)" ::: "memory");
#pragma unroll
        for (int i = 0; i < 8; ++i) {
            const int tt = (lane >> 3) + 8 * i, c8 = 8 * (lane & 7);
            unsigned short e[8];
#pragma unroll
            for (int j = 0; j < 8; ++j) e[j] = *(const LAS unsigned short*)(scr + (c8 + j) * 136 + tt * 2);
            u32x4 o; o.x = e[0] | ((unsigned)e[1] << 16); o.y = e[2] | ((unsigned)e[3] << 16); o.z = e[4] | ((unsigned)e[5] << 16); o.w = e[6] | ((unsigned)e[7] << 16);
            *(GAS u32x4*)((dummy ? WSP(bf16, WS_U + 300 * MiB) : Y) + (size_t)(dummy ? ((rowbase + tb * 64 + tt) & 8191) : (rowbase + tb * 64 + tt)) * D + cb * 64 + c8) = o;
        }
        asm volatile("s_waitcnt lgkmcnt(0)" ::: "memory");
    }
}

__device__ __forceinline__ void phase_norm_router(Frame& F) {
    const int gw = F.wg * NWAVES + F.wave, lane = F.lane;
    const GAS float* g = inp(F, I_GFFN) + 1 * D; const GAS float* wr = inp(F, I_ROUTER); const GAS float* br = inp(F, I_ROUTERB);
    GAS unsigned* cnt = WSP(unsigned, WS_CTL) + CW_CNT;
    const int r0 = gw * 16, r1 = r0 + 16;
    f32x4 gm[4], sh[4], w0r[4][4], w1r[4][4]; u32x2 ring[4][4];
    { const GAS float* shp = mod_ptr(F, 1, r0, 3); const GAS float* scp = mod_ptr(F, 1, r0, 4);
#pragma unroll
      for (int j = 0; j < 4; ++j) { const f32x4 gg = *(const GAS f32x4*)(g + 256 * j + 4 * lane), sc = *(const GAS f32x4*)(scp + 256 * j + 4 * lane); sh[j] = *(const GAS f32x4*)(shp + 256 * j + 4 * lane);
          gm[j].x = gg.x * (1.f + sc.x); gm[j].y = gg.y * (1.f + sc.y); gm[j].z = gg.z * (1.f + sc.z); gm[j].w = gg.w * (1.f + sc.w);
#pragma unroll
          for (int i = 0; i < 4; ++i) { const int k = 256 * j + 4 * lane + i; w0r[j][i] = *(const GAS f32x4*)(wr + k * 8); w1r[j][i] = *(const GAS f32x4*)(wr + k * 8 + 4); } }
#pragma unroll
      for (int i = 0; i < 4; ++i) xrow_issue<true>(F, r0 + i, 2, lane, ring[i]); }
    float brr[8];
#pragma unroll
    for (int e = 0; e < 8; ++e) brr[e] = br[e];
    int my_e0 = 0, my_e1 = 0;
#pragma unroll 1
    for (int rb = r0; rb < r1; rb += 4) {
#pragma unroll
      for (int i = 0; i < 4; ++i) {
        const int row = rb + i;
        f32x4 v[4]; float s = 0.f;
#pragma unroll
        for (int j = 0; j < 4; ++j) { v[j] = xrow_unpack(ring[i][j]); s += (v[j].x * v[j].x + v[j].y * v[j].y) + (v[j].z * v[j].z + v[j].w * v[j].w); }
        if (row + 4 < r1) xrow_issue<true>(F, row + 4, 2, lane, ring[i]);
        const float r = rsqrtf(wave_sum(s) * (1.0f / 1024.0f) + 1e-6f);
        GAS bf16* orow = WSP(bf16, WS_H) + (size_t)row * D;
        float lg[8];
#pragma unroll
        for (int e = 0; e < 8; ++e) lg[e] = 0.f;
#pragma unroll
        for (int j = 0; j < 4; ++j) {
            f32x4 o; o.x = v[j].x * r * gm[j].x + sh[j].x; o.y = v[j].y * r * gm[j].y + sh[j].y; o.z = v[j].z * r * gm[j].z + sh[j].z; o.w = v[j].w * r * gm[j].w + sh[j].w;
            u32x2 w; w.x = pk2(o.x, o.y); w.y = pk2(o.z, o.w);
            *(GAS u32x2*)(orow + 256 * j + 4 * lane) = w;
            const float xo[4] = {o.x, o.y, o.z, o.w};
#pragma unroll
            for (int i = 0; i < 4; ++i) { const float x = xo[i]; const f32x4 w0 = w0r[j][i], w1 = w1r[j][i];
                lg[0] += x * w0.x; lg[1] += x * w0.y; lg[2] += x * w0.z; lg[3] += x * w0.w; lg[4] += x * w1.x; lg[5] += x * w1.y; lg[6] += x * w1.z; lg[7] += x * w1.w; }
        }
#pragma unroll
        for (int e = 0; e < 8; ++e) lg[e] = wave_sum(lg[e]) + brr[e];
        int e0 = 0; float v0 = lg[0];
#pragma unroll
        for (int e = 1; e < 8; ++e) if (lg[e] > v0) { v0 = lg[e]; e0 = e; }
        int e1 = -1; float v1 = -3.0e38f;
#pragma unroll
        for (int e = 0; e < 8; ++e) if (e != e0 && lg[e] > v1) { v1 = lg[e]; e1 = e; }
        const float w1 = 1.f / (1.f + __expf(v0 - v1)), w0 = 1.f - w1;
        if (lane == 0) {
            WSP(int, WS_TOPE)[row * 2] = e0; WSP(int, WS_TOPE)[row * 2 + 1] = e1;
            WSP(float, WS_TOPW)[row * 2] = w0; WSP(float, WS_TOPW)[row * 2 + 1] = w1;
        }
        if (lane == row - r0) { my_e0 = e0; my_e1 = e1; }
      }
    }
    {
        LAS unsigned* wc = (LAS unsigned*)(F.lds + 100000);
        const bool act = lane < 16;
        const unsigned long long lt = (1ull << lane) - 1ull;
        unsigned rank0 = 0u, rank1 = 0u, mycnt = 0u;
#pragma unroll
        for (int e = 0; e < 8; ++e) {
            const unsigned long long m0 = __ballot(act && my_e0 == e), m1 = __ballot(act && my_e1 == e);
            const unsigned c0 = (unsigned)__popcll(m0), c1 = (unsigned)__popcll(m1);
            if (my_e0 == e) rank0 = (unsigned)__popcll(m0 & lt);
            if (my_e1 == e) rank1 = c0 + (unsigned)__popcll(m1 & lt);
            if (lane == e) mycnt = c0 + c1;
        }
        if (lane < 8) wc[F.wave * 8 + lane] = mycnt;
        __syncthreads();
        if (F.wave == 0 && lane < 8) {
            unsigned tot = 0u, part[8];
#pragma unroll
            for (int w = 0; w < 8; ++w) { part[w] = tot; tot += wc[w * 8 + lane]; }
            const unsigned base = tot ? __hip_atomic_fetch_add(cnt + lane, tot, __ATOMIC_RELAXED, __HIP_MEMORY_SCOPE_AGENT) : 0u;
#pragma unroll
            for (int w = 0; w < 8; ++w) wc[64 + w * 8 + lane] = base + part[w];
        }
        __syncthreads();
        if (act) { const int row = r0 + lane;
            WSP(int, WS_TOPP)[row * 2] = (int)(wc[64 + F.wave * 8 + my_e0] + rank0); WSP(int, WS_TOPP)[row * 2 + 1] = (int)(wc[64 + F.wave * 8 + my_e1] + rank1); }
    }
}
__device__ __forceinline__ void phase_route_tables(Frame& F) {
    const GAS unsigned* cnt = WSP(const unsigned, WS_CTL) + CW_CNT;
    int off[9]; off[0] = 0;
#pragma unroll
    for (int e = 0; e < 8; ++e) { const int c = (int)__hip_atomic_load(cnt + e, __ATOMIC_RELAXED, __HIP_MEMORY_SCOPE_AGENT); off[e + 1] = off[e] + ((c + 255) >> 8) * 256; }
    const int gt = F.wg * NTHR + F.tid, NGT = F.G * NTHR;
    GAS int* rowidx = WSP(int, WS_ROWIDX); GAS int* slot = WSP(int, WS_SLOT); GAS int* tilee = WSP(int, WS_TILEE);
    for (int i = gt; i < MAXTILES * 256; i += NGT) {
        int e = 0;
#pragma unroll
        for (int q = 1; q < 8; ++q) if (i >= off[q]) e = q;
        const int c = (int)cnt[e];
        if (i >= off[8] || i - off[e] >= c) rowidx[i] = 0;
    }
    for (int i = gt; i < TOKL * 2; i += NGT) {
        const int e = WSP(const int, WS_TOPE)[i], pos = WSP(const int, WS_TOPP)[i];
        int o = 0;
#pragma unroll
        for (int q = 0; q < 8; ++q) if (e == q) o = off[q];
        const int s = o + pos; slot[i] = s; rowidx[s] = i >> 1;
    }
    for (int i = gt; i < MAXTILES + 1; i += NGT) {
        if (i == MAXTILES) tilee[MAXTILES] = off[8] >> 8;
        else { int e = 0;
#pragma unroll
            for (int q = 1; q < 8; ++q) if (i * 256 >= off[q]) e = q;
            tilee[i] = e; }
    }
}

__device__ __forceinline__ void moe_pass_gemm1_fast(Frame& F, int t0, int t1) {
    pg8::OrderMoe S; S.o.init(t1 - t0, NFF1 / 256, F.G, F.wg); S.rowidx = WSP(const int, WS_ROWIDX); S.tilee = WSP(const int, WS_TILEE); S.t0 = t0; S.bstride = (size_t)NFF1 * D; S.gather = true;
    EpiSwiglu E{WSP(bf16, WS_MACT), 0};
    pg8::gemm_phase(F.lds, F.tid, WSP(const bf16, WS_H), D, WSP(const bf16, WS_MW13), D, D, S, E);
}
__device__ __forceinline__ void moe_pass_gemm2_fast(Frame& F, int t0, int t1) {
    pg8::OrderMoe S; S.o.init(t1 - t0, D / 256, F.G, F.wg); S.rowidx = WSP(const int, WS_ROWIDX); S.tilee = WSP(const int, WS_TILEE); S.t0 = t0; S.bstride = (size_t)D * DFF; S.gather = false;
    EpiBf16Out E{WSP(bf16, WS_EOUT), D, t0 * 256};
    pg8::gemm_phase(F.lds, F.tid, WSP(const bf16, WS_MACT), DFF, WSP(const bf16, WS_MW2), DFF, DFF, S, E);
}
__device__ __forceinline__ void phase_final(Frame& F, GAS float* dummy = nullptr) {
    const int gw = F.wg * NWAVES + F.wave, NGW = F.G * NWAVES, lane = F.lane;
    const GAS float* gf = inp(F, I_GFINAL); const GAS bf16* eo = WSP(const bf16, WS_EOUT);
#pragma unroll 2
    for (int row = gw; row < TOKL; row += NGW) {
        const int s0 = WSP(const int, WS_SLOT)[row * 2], s1 = WSP(const int, WS_SLOT)[row * 2 + 1];
        const float w0 = WSP(const float, WS_TOPW)[row * 2], w1 = WSP(const float, WS_TOPW)[row * 2 + 1];
        const GAS float* m5 = mod_ptr(F, 1, row, 5);
        GAS float* xr = outp(F) + (size_t)row * D; const GAS bf16* xb = WSP(const bf16, WS_XL2) + (size_t)row * D;
        f32x4 v[4]; float s = 0.f;
#pragma unroll
        for (int j = 0; j < 4; ++j) {
            const int c = 256 * j + 4 * lane;
            const f32x4 a = ld_bf16x4(eo + (size_t)s0 * D + c), b = ld_bf16x4(eo + (size_t)s1 * D + c), m = *(const GAS f32x4*)(m5 + c);
            v[j] = ld_bf16x4(xb + c) + m * (a * w0 + b * w1);
            s += (v[j].x * v[j].x + v[j].y * v[j].y) + (v[j].z * v[j].z + v[j].w * v[j].w);
        }
        const float r = rsqrtf(wave_sum(s) * (1.f / 1024.f) + 1e-6f);
#pragma unroll
        for (int j = 0; j < 4; ++j) { const int c = 256 * j + 4 * lane; const f32x4 g = *(const GAS f32x4*)(gf + c); GAS float* o_ = dummy ? dummy + (size_t)(row & 8191) * D : xr; *(GAS f32x4*)(o_ + c) = v[j] * r * g; }
    }
}

#ifndef MR_L0
#define MR_L0 192
#endif
#ifndef REP_WIN
#define REP_WIN 1
#endif
#ifndef REP_MIX
#define REP_MIX 1
#endif
#ifndef REP_GATE
#define REP_GATE 1
#endif
#ifndef REP_UP
#define REP_UP 1
#endif
#ifndef REP_FFN1
#define REP_FFN1 1
#endif
#ifndef REP_MOE
#define REP_MOE 1
#endif
#ifndef REP_NORM
#define REP_NORM 1
#endif
#ifndef REP_P0
#define REP_P0 1
#endif
__global__ void __launch_bounds__(NTHR, 2) hybrid_fwd(Params prm) {
    extern __shared__ __attribute__((aligned(16))) unsigned char lds_raw[];
    Frame F;
    F.lds = (LAS unsigned char*)lds_raw; F.ws = (GAS unsigned char*)prm.ws;
    F.tid = threadIdx.x; F.lane = F.tid & 63; F.wave = __builtin_amdgcn_readfirstlane(F.tid >> 6); F.G = gridDim.x; F.wg = blockIdx.x;
    volatile LAS unsigned* MISC = (volatile LAS unsigned*)(F.lds + MISC_OFF);
    if (F.tid < 64) MISC[F.tid] = 0u;
    if (F.tid < 33) { const unsigned long long v = F.tid < 32 ? (unsigned long long)prm.in[F.tid] : (unsigned long long)prm.out; *(LAS unsigned long long*)(F.lds + PTAB_OFF + 8 * F.tid) = v; }
    __syncthreads();
    XcdBarrier bar = xcd_barrier_post(WSP(unsigned, WS_CTL) + CW_BAR, MISC + 8);
#define RELAUNDER() do { { unsigned long long _w = (unsigned long long)F.ws; asm volatile("" : "+s"(_w)); F.ws = (GAS unsigned char*)_w; } \
        { unsigned _t = (unsigned)F.tid; asm volatile("" : "+v"(_t)); F.tid = (int)_t; F.lane = F.tid & 63; F.wave = __builtin_amdgcn_readfirstlane(F.tid >> 6); } \
        { unsigned _g = (unsigned)F.G, _b = (unsigned)F.wg; asm volatile("" : "+s"(_g), "+s"(_b)); F.G = (int)_g; F.wg = (int)_b; } \
        { unsigned _l = (unsigned)(size_t)F.lds; asm volatile("" : "+s"(_l)); F.lds = (LAS unsigned char*)(size_t)_l; } } while (0)
#define GRID_BAR() do { { unsigned long long _b = (unsigned long long)bar.bar; unsigned _x = bar.x; asm volatile("" : "+s"(_b), "+s"(_x)); bar.bar = (GAS unsigned*)_b; bar.x = _x; } xcd_barrier(bar); RELAUNDER(); } while (0)

    for (int rp = 0; rp < REP_P0; ++rp) { phase_p0(F); write_bias(F);
    GRID_BAR(); }
#pragma unroll 1
    for (int layer_ = 0; layer_ < 2; ++layer_) {
        int layer = layer_;
#define last (layer == 1)
#define rows_all TOK
#define rows_out (last ? TOKL : TOK)
#define modbase (WSP(const float, WS_MOD) + (size_t)layer * 17 * 6144)
#define LAYER_LAUNDER() asm volatile("" : "+s"(layer))
        for (int rp = 0; rp < REP_NORM; ++rp) { if (last) phase_norm<true>(F, layer, rows_all, 0); else phase_norm<false>(F, layer, rows_all, 0);
        if (layer == 0) { const int gw = F.wg * NWAVES + F.wave, NGW = F.G * NWAVES;
            for (int it = gw; it < 1536 + 96; it += NGW) filter_out_item(F, it); }
        { GRID_BAR(); LAYER_LAUNDER(); } }
        for (int rp = 0; rp < REP_WIN; ++rp) {
        { EpiWin E{WSP(const float, WS_BIAS) + layer * NWP, WSP(bf16, WS_HYTL), WSP(bf16, WS_HYTC), WSP(bf16, WS_RET), WSP(bf16, WS_ML), WSP(float, WS_MLG)};
          if (last) { pg8::OrderWinL1 S; S.init(F.G, F.wg); pg8::gemm_phase(F.lds, F.tid, WSP(const bf16, WS_H), D, WSP(const bf16, WS_WIN), D, D, S, E); }
          else gemm_fast(F, WSP(const bf16, WS_H), D, WSP(const bf16, WS_WIN), D, D, rows_all, NW1, E); }
        { GRID_BAR(); LAYER_LAUNDER(); } }
        for (int rp = 0; rp < REP_MIX; ++rp) { phase_mix(F, layer);
        { GRID_BAR(); LAYER_LAUNDER(); } }
#ifndef REP_COMB
#define REP_COMB 1
#endif
        for (int rp = REP_COMB - 1; rp > 0; --rp) { phase_combine(F, layer, true); { GRID_BAR(); LAYER_LAUNDER(); } }
        phase_combine(F, layer);
        { GRID_BAR(); LAYER_LAUNDER(); }
        for (int rp = 0; rp < REP_GATE; ++rp) {
        { EpiGate E{WSP(const float, WS_BIAS) + layer * NWP + NW1, WSP(bf16, WS_GATES)};
          gemm_fast(F, WSP(const bf16, WS_H), D, WSP(const bf16, WS_WIN) + (size_t)NW1 * D, D, D, rows_out, NGATE, E); }
        { GRID_BAR(); LAYER_LAUNDER(); } }
        for (int rp = 0; rp < REP_UP; ++rp) {
        { EpiUp E{WSP(const bf16, WS_GATES), WSP(bf16, WS_H)};
          if (last) gemm_fast(F, WSP(const bf16, WS_Y), D, WSP(const bf16, WS_WUP), D, D, TOKL, D, E);
          else gemm_fast<MR_L0>(F, WSP(const bf16, WS_Y), D, WSP(const bf16, WS_WUP), D, D, TOK, D, E); }
        { GRID_BAR(); LAYER_LAUNDER(); } }
#ifndef REP_OUT
#define REP_OUT 1
#endif
        if (last) { EpiResidT<true> E{(const GAS bf16*)outp(F), nullptr, WSP(bf16, WS_XL2), nullptr, modbase, 2};
            gemm_fast(F, WSP(const bf16, WS_H), D, WSP(const bf16, WS_WOUT), D, D, TOKL, D, E); }
        else { EpiResidT<false> E{inp(F, I_X), inp(F, I_CTX), (GAS bf16*)outp(F), WSP(bf16, WS_XC), modbase, 2};
            gemm_fast<MR_L0>(F, WSP(const bf16, WS_H), D, WSP(const bf16, WS_WOUT), D, D, TOK, D, E); }
        { GRID_BAR(); LAYER_LAUNDER(); }
        if (!last) {
            phase_norm<true>(F, layer, rows_out, 3);
            { const int gw = F.wg * NWAVES + F.wave, NGW = F.G * NWAVES; LAS float* scr = (LAS float*)(F.lds + F.wave * 8704);
              conv_weights_ffn(inp(F, I_FW1), inp(F, I_FW3), inp(F, I_FW2), WSP(bf16, WS_W13), WSP(bf16, WS_W2), gw, NGW, scr, F.lane);
              conv_weights_win(F, 1, gw, NGW, scr);
              conv_weights_upout(F, 1, gw, NGW, scr); }
            { GRID_BAR(); LAYER_LAUNDER(); }
            for (int rp = 0; rp < REP_FFN1; ++rp) {
            { EpiSwiglu E{WSP(bf16, WS_ACT), 0};
              gemm_fast(F, WSP(const bf16, WS_H), D, WSP(const bf16, WS_W13), D, D, rows_out, NFF1, E); }
            { GRID_BAR(); LAYER_LAUNDER(); } }
#ifndef REP_FFN2
#define REP_FFN2 1
#endif
            { EpiResidT<true> E{(const GAS bf16*)outp(F), WSP(const bf16, WS_XC), (GAS bf16*)outp(F), WSP(bf16, WS_XC), modbase, 5};
              gemm_fast<MR_L0>(F, WSP(const bf16, WS_ACT), DFF, WSP(const bf16, WS_W2), DFF, DFF, TOK, D, E); }
            { GRID_BAR(); LAYER_LAUNDER(); }
        }
    }
#undef LAYER_LAUNDER
#undef last
#undef rows_all
#undef rows_out
#undef modbase
    phase_norm_router(F);
    { const int gw = F.wg * NWAVES + F.wave, NGW = F.G * NWAVES; LAS float* scr = (LAS float*)(F.lds + F.wave * 8704);
#ifndef REP_MCONV
#define REP_MCONV 1
#endif
#pragma unroll 1
      for (int e = 0; e < NE * REP_MCONV; ++e)
          conv_weights_ffn(inp(F, I_MW1) + (size_t)(e % NE) * D * DFF, inp(F, I_MW3) + (size_t)(e % NE) * D * DFF, inp(F, I_MW2) + (size_t)(e % NE) * DFF * D,
                           WSP(bf16, WS_MW13) + (size_t)(e % NE) * NFF1 * D, WSP(bf16, WS_MW2) + (size_t)(e % NE) * D * DFF, gw, NGW, scr, F.lane); }
    GRID_BAR();
    phase_route_tables(F);
    GRID_BAR();
    const int ntiles = __builtin_amdgcn_readfirstlane(WSP(const int, WS_TILEE)[MAXTILES]);
#pragma unroll 1
    for (int p = 0; p < NPASS; ++p) {
        const int t0 = p * PASS_TILES, t1 = min(ntiles, t0 + PASS_TILES);
        for (int rp = 0; rp < REP_MOE; ++rp) {
        if (t0 < t1) moe_pass_gemm1_fast(F, t0, t1);
        GRID_BAR();
        if (t0 < t1) moe_pass_gemm2_fast(F, t0, t1);
        GRID_BAR(); }
    }
#ifndef REP_BAR
#define REP_BAR 0
#endif
    for (int rb = 0; rb < REP_BAR; ++rb) GRID_BAR();
#ifndef REP_FINAL
#define REP_FINAL 1
#endif
    for (int rp = REP_FINAL - 1; rp > 0; --rp) { phase_final(F, WSP(float, WS_H)); GRID_BAR(); }
    phase_final(F);
}

extern "C" void kernel_launch(void* const* d_in, const int* in_sizes, int n_in, void* d_out, int out_size, void* d_ws, size_t ws_size, hipStream_t stream) {
    static int grid = 0;
    if (grid == 0) {
        if (n_in != 32 || out_size != TOKL * D || ws_size < WS_END) { fprintf(stderr, "kernel_launch: unexpected arguments (n_in %d, out %d, ws %zu)\n", n_in, out_size, ws_size); grid = -1; return; }
        int dev = 0, cus = 0;
        if (hipGetDevice(&dev) != hipSuccess || hipDeviceGetAttribute(&cus, hipDeviceAttributeMultiprocessorCount, dev) != hipSuccess) { grid = -1; return; }
        if (hipFuncSetAttribute((const void*)hybrid_fwd, hipFuncAttributeMaxDynamicSharedMemorySize, LDS_BYTES) != hipSuccess) { grid = -1; return; }
        int per_cu = 0;
        (void)hipOccupancyMaxActiveBlocksPerMultiprocessor(&per_cu, (const void*)hybrid_fwd, NTHR, LDS_BYTES);
        (void)hipGetLastError();
        if (cus < 256) { fprintf(stderr, "kernel_launch: needs 256 compute units (one workgroup each), found %d\n", cus); grid = -1; return; }
        grid = 256;
    }
    if (grid < 0) return;
    (void)hipMemsetAsync((char*)d_ws + WS_CTL, 0, CTL_ZERO_BYTES, stream);
    Params p{};
    for (int i = 0; i < 32; ++i) p.in[i] = (const float*)d_in[i];
    p.out = (float*)d_out; p.ws = (unsigned char*)d_ws;
    hipLaunchKernelGGL(hybrid_fwd, dim3(grid), dim3(NTHR), LDS_BYTES, stream, p);
}
```
